# Optimizing an MI355X kernel written in HIP

```python
import math
import jax, jax.numpy as jnp
from jax import lax
import numpy as np

D_MODEL = 1024
BATCH = 4
SEQ = 4096
DEPTH = 2
DEC_BATCH = 8
DEC_SEQ = 32
PAST_LEN = 2048

CHUNK = 64
N_EVEN = (DEPTH + 1) // 2
N_ODD = DEPTH // 2
SSM_WIDTH = D_MODEL // 2
SSM_GROUP = 16
SSM_GROUPS = SSM_WIDTH // SSM_GROUP
SSM_STATE = 64
DT_MIN = 1e-3
DT_MAX = 1e-1
HEAD_DIM = 64
N_HEADS = (D_MODEL // 2) // HEAD_DIM
N_KV_HEADS = 2
GQ = N_HEADS // N_KV_HEADS
WINDOW = 128
WINDOW_CHUNKS = WINDOW // CHUNK
ROPE_THETA = 10000.0
EVEN_IN = SSM_WIDTH + (N_HEADS + 2 * N_KV_HEADS) * HEAD_DIM
CONV_WIDTH = 3
N_MEM = 256
X_HEADS = 4
X_HEAD_DIM = D_MODEL // X_HEADS
D_FF = 2816
EPS = 1e-6
NEG = -1e30

kernel_name = 'hybrid_s5_swa_shortconv_stream_step'

F32 = jnp.float32


def rms_norm(x, g):
    xf = x.astype(F32)
    y = xf * lax.rsqrt(jnp.mean(xf * xf, axis=-1, keepdims=True) + EPS)
    return (y * g.astype(F32)).astype(x.dtype)


def rope(t, pos):
    half = HEAD_DIM // 2
    inv = ROPE_THETA ** (-jnp.arange(half, dtype=F32) * 2.0 / HEAD_DIM)
    ang = pos[:, None] * inv[None, :]
    cos = jnp.cos(ang)[None, :, None, :]
    sin = jnp.sin(ang)[None, :, None, :]
    tf = t.astype(F32)
    t1, t2 = tf[..., :half], tf[..., half:]
    return jnp.concatenate([t1 * cos - t2 * sin, t2 * cos + t1 * sin], axis=-1).astype(t.dtype)


def causal_conv(x, prev, w):
    seq = x.shape[1]
    xp = jnp.concatenate([prev.astype(x.dtype), x], axis=1)
    y = w[0] * xp[:, 0:seq]
    for j in range(1, CONV_WIDTH):
        y = y + w[j] * xp[:, j:j + seq]
    return y, xp[:, -(CONV_WIDTH - 1):]


def _scan_op(e1, e2):
    a1, b1 = e1
    a2, b2 = e2
    return a1 * a2, a2 * b1 + b2


def s5_mixer(u, h0_re, h0_im, a_re, a_im, log_dt, b_re, b_im, c_re, c_im, d, w_glu):
    bsz, seq, _ = u.shape
    uf = u.astype(F32).reshape(bsz, seq, SSM_GROUPS, SSM_GROUP)
    lam = lax.complex(a_re.astype(F32), a_im.astype(F32))
    dt = jnp.exp(log_dt.astype(F32))
    a_bar = jnp.exp(lam * dt)
    b_bar = ((a_bar - 1.0) / lam)[..., None] * lax.complex(b_re.astype(F32), b_im.astype(F32))
    bu = jnp.einsum('blgh,gph->blgp', uf.astype(jnp.complex64), b_bar)
    h0 = lax.complex(h0_re.astype(F32), h0_im.astype(F32))
    bu = bu.at[:, 0].add(a_bar[None] * h0)
    a_seq = jnp.broadcast_to(a_bar, bu.shape)
    _, h = lax.associative_scan(_scan_op, (a_seq, bu), axis=1)
    c = lax.complex(c_re.astype(F32), c_im.astype(F32))
    y = jnp.real(jnp.einsum('blgp,ghp->blgh', h, c)) + d.astype(F32) * uf
    y = y.reshape(bsz, seq, SSM_WIDTH)
    g = jax.nn.gelu(y)
    out = g * jax.nn.sigmoid(g @ w_glu.astype(F32))
    h_last = h[:, -1]
    return out.astype(u.dtype), jnp.real(h_last), jnp.imag(h_last)


def swa_attention(q, k, v, past_k, past_v, sinks, start):
    bsz, seq = q.shape[0], q.shape[1]
    n_blk = -(-seq // CHUNK)
    l_pad = n_blk * CHUNK
    pad = l_pad - seq
    front = WINDOW - past_k.shape[1]

    def pad4(t, a, b):
        return jnp.pad(t, ((0, 0), (a, b), (0, 0), (0, 0)))

    q = pad4(q, 0, pad)
    k_all = jnp.concatenate([pad4(past_k.astype(k.dtype), front, 0), pad4(k, 0, pad)], axis=1)
    v_all = jnp.concatenate([pad4(past_v.astype(v.dtype), front, 0), pad4(v, 0, pad)], axis=1)
    n_key = WINDOW + l_pad
    idx = jnp.arange(n_blk)[:, None] * CHUNK + jnp.arange(WINDOW + CHUNK)[None, :]
    k_blk = k_all[:, idx]
    v_blk = v_all[:, idx]
    slot = jnp.arange(n_key)
    k_pos = start - WINDOW + slot
    k_ok = (k_pos >= 0) & (slot < WINDOW + seq)
    k_pos_b = k_pos[idx]
    k_ok_b = k_ok[idx]
    q_pos = start + jnp.arange(l_pad).reshape(n_blk, CHUNK)
    q_chunk = q_pos // CHUNK
    k_chunk = k_pos_b // CHUNK
    mask = (k_ok_b[:, None, :]
            & (k_chunk[:, None, :] <= q_chunk[:, :, None])
            & (k_chunk[:, None, :] >= q_chunk[:, :, None] - WINDOW_CHUNKS))
    q_blk = q.reshape(bsz, n_blk, CHUNK, N_KV_HEADS, GQ, HEAD_DIM)
    s = jnp.einsum('bnqkgd,bnskd->bnkgqs', q_blk, k_blk, preferred_element_type=F32) * (HEAD_DIM ** -0.5)
    s = jnp.where(mask[None, :, None, None], s, NEG)
    sink = jnp.broadcast_to(sinks.astype(F32).reshape(1, 1, N_KV_HEADS, GQ, 1, 1), s.shape[:-1] + (1,))
    p = jax.nn.softmax(jnp.concatenate([s, sink], axis=-1), axis=-1)[..., :-1]
    o = jnp.einsum('bnkgqs,bnskd->bnqkgd', p.astype(v.dtype), v_blk)
    return o.reshape(bsz, l_pad, N_HEADS * HEAD_DIM)[:, :seq]


def cross_attention(h, mem_k, mem_v, wq, wo):
    bsz, seq, _ = h.shape
    q = (h @ wq).reshape(bsz, seq, X_HEADS, X_HEAD_DIM)
    s = jnp.einsum('blhd,bmhd->bhlm', q, mem_k, preferred_element_type=F32) * (X_HEAD_DIM ** -0.5)
    p = jax.nn.softmax(s, axis=-1).astype(mem_v.dtype)
    o = jnp.einsum('bhlm,bmhd->blhd', p, mem_v).reshape(bsz, seq, D_MODEL)
    return o @ wo


def conv_ffn(h, prev, w_up, conv_w, w_down):
    up = h @ w_up
    gate, val = up[..., :D_FF], up[..., D_FF:]
    gate_c, new_prev = causal_conv(gate, prev, conv_w)
    return (jax.nn.silu(gate_c) * val) @ w_down, new_prev


def trunk(x, start, past_k, past_v, ssm_re, ssm_im, conv_mix_prev, conv_ffn_prev, mem_k, mem_v, p):
    bsz, seq, _ = x.shape
    pos = (start + jnp.arange(seq)).astype(F32)
    new_k, new_v, new_re, new_im, new_cm, new_cf = [], [], [], [], [], []
    o0 = SSM_WIDTH
    o1 = o0 + N_HEADS * HEAD_DIM
    o2 = o1 + N_KV_HEADS * HEAD_DIM
    for layer in range(DEPTH):
        h = rms_norm(x, p['norm_mix'][layer])
        if layer % 2 == 0:
            e = layer // 2
            proj = h @ p['w_in_even'][e]
            u = proj[..., :o0]
            q = rope(proj[..., o0:o1].reshape(bsz, seq, N_HEADS, HEAD_DIM), pos)
            k = rope(proj[..., o1:o2].reshape(bsz, seq, N_KV_HEADS, HEAD_DIM), pos)
            v = proj[..., o2:].reshape(bsz, seq, N_KV_HEADS, HEAD_DIM)
            y_a, h_re, h_im = s5_mixer(u, ssm_re[e], ssm_im[e], p['ssm_a_re'][e], p['ssm_a_im'][e],
                                       p['ssm_log_dt'][e], p['ssm_b_re'][e], p['ssm_b_im'][e],
                                       p['ssm_c_re'][e], p['ssm_c_im'][e], p['ssm_d'][e], p['w_glu'][e])
            y_b = swa_attention(q, k, v, past_k[e], past_v[e], p['attn_sinks'][e], start)
            x = x + jnp.concatenate([y_a, y_b], axis=-1) @ p['w_out_even'][e]
            new_k.append(k)
            new_v.append(v)
            new_re.append(h_re)
            new_im.append(h_im)
        else:
            o = layer // 2
            proj = h @ p['w_in_odd'][o]
            gate_b, gate_c, z = jnp.split(proj, 3, axis=-1)
            z_conv, cm = causal_conv(gate_c * z, conv_mix_prev[o], p['conv_mix_w'][o])
            x = x + (gate_b * z_conv) @ p['w_out_odd'][o]
            new_cm.append(cm)
        h = rms_norm(x, p['norm_xattn'][layer])
        x = x + cross_attention(h, mem_k[layer], mem_v[layer], p['xattn_wq'][layer], p['xattn_wo'][layer])
        h = rms_norm(x, p['norm_ffn'][layer])
        f, cf = conv_ffn(h, conv_ffn_prev[layer], p['ffn_w_up'][layer], p['ffn_conv_w'][layer], p['ffn_w_down'][layer])
        x = x + f
        new_cf.append(cf)
    y = rms_norm(x, p['norm_final'])
    return (y, jnp.stack(new_k), jnp.stack(new_v), jnp.stack(new_re), jnp.stack(new_im),
            jnp.stack(new_cm), jnp.stack(new_cf))


def setup_inputs(seed: int = 0) -> dict:
    key = jax.random.key(seed)
    ks = iter(jax.random.split(key, 48))

    def nrm(shape, scale=1.0):
        return scale * jax.random.normal(next(ks), shape, F32)

    ne, no = N_EVEN, N_ODD
    win_rows = min(WINDOW, PAST_LEN)
    cw = CONV_WIDTH - 1
    inp = {}
    inp['x_prompt'] = nrm((BATCH, SEQ, D_MODEL))
    inp['x_sample'] = nrm((DEC_BATCH, DEC_SEQ, D_MODEL))
    inp['mem_prompt'] = nrm((BATCH, N_MEM, D_MODEL))
    inp['cache_win_k'] = nrm((ne, DEC_BATCH, win_rows, N_KV_HEADS, HEAD_DIM))
    inp['cache_win_v'] = nrm((ne, DEC_BATCH, win_rows, N_KV_HEADS, HEAD_DIM))
    inp['state_ssm_re'] = nrm((ne, DEC_BATCH, SSM_GROUPS, SSM_STATE), 0.05)
    inp['state_ssm_im'] = nrm((ne, DEC_BATCH, SSM_GROUPS, SSM_STATE), 0.05)
    inp['state_conv_mix'] = nrm((no, DEC_BATCH, cw, D_MODEL))
    inp['state_conv_ffn'] = nrm((DEPTH, DEC_BATCH, cw, D_FF))
    inp['cache_mem_k'] = nrm((DEPTH, DEC_BATCH, N_MEM, X_HEADS, X_HEAD_DIM))
    inp['cache_mem_v'] = nrm((DEPTH, DEC_BATCH, N_MEM, X_HEADS, X_HEAD_DIM))
    inp['norm_mix'] = 1.0 + nrm((DEPTH, D_MODEL), 0.02)
    inp['norm_xattn'] = 1.0 + nrm((DEPTH, D_MODEL), 0.02)
    inp['norm_ffn'] = 1.0 + nrm((DEPTH, D_MODEL), 0.02)
    inp['norm_final'] = 1.0 + nrm((D_MODEL,), 0.02)
    inp['w_in_even'] = nrm((ne, D_MODEL, EVEN_IN), D_MODEL ** -0.5)
    inp['w_out_even'] = nrm((ne, D_MODEL, D_MODEL), D_MODEL ** -0.5)
    inp['ssm_a_re'] = -0.5 + nrm((ne, SSM_GROUPS, SSM_STATE), 0.01)
    inp['ssm_a_im'] = jnp.pi * jnp.arange(SSM_STATE, dtype=F32) + nrm((ne, SSM_GROUPS, SSM_STATE), 0.01)
    inp['ssm_log_dt'] = jax.random.uniform(next(ks), (ne, SSM_GROUPS, SSM_STATE), F32,
                                           math.log(DT_MIN), math.log(DT_MAX))
    inp['ssm_b_re'] = nrm((ne, SSM_GROUPS, SSM_STATE, SSM_GROUP), (2 * SSM_GROUP) ** -0.5)
    inp['ssm_b_im'] = nrm((ne, SSM_GROUPS, SSM_STATE, SSM_GROUP), (2 * SSM_GROUP) ** -0.5)
    inp['ssm_c_re'] = nrm((ne, SSM_GROUPS, SSM_GROUP, SSM_STATE), SSM_STATE ** -0.5)
    inp['ssm_c_im'] = nrm((ne, SSM_GROUPS, SSM_GROUP, SSM_STATE), SSM_STATE ** -0.5)
    inp['ssm_d'] = nrm((ne, SSM_GROUPS, SSM_GROUP))
    inp['w_glu'] = nrm((ne, SSM_WIDTH, SSM_WIDTH), SSM_WIDTH ** -0.5)
    inp['attn_sinks'] = nrm((ne, N_HEADS), 0.5)
    inp['w_in_odd'] = nrm((no, D_MODEL, 3 * D_MODEL), D_MODEL ** -0.5)
    inp['conv_mix_w'] = nrm((no, CONV_WIDTH, D_MODEL), CONV_WIDTH ** -0.5)
    inp['w_out_odd'] = nrm((no, D_MODEL, D_MODEL), D_MODEL ** -0.5)
    inp['xattn_wq'] = nrm((DEPTH, D_MODEL, D_MODEL), D_MODEL ** -0.5)
    inp['xattn_wkv'] = nrm((DEPTH, D_MODEL, 2 * D_MODEL), D_MODEL ** -0.5)
    inp['xattn_wo'] = nrm((DEPTH, D_MODEL, D_MODEL), D_MODEL ** -0.5)
    inp['ffn_w_up'] = nrm((DEPTH, D_MODEL, 2 * D_FF), D_MODEL ** -0.5)
    inp['ffn_conv_w'] = nrm((DEPTH, CONV_WIDTH, D_FF), CONV_WIDTH ** -0.5)
    inp['ffn_w_down'] = nrm((DEPTH, D_FF, D_MODEL), D_FF ** -0.5)
    return inp


def reference(x_prompt, x_sample, mem_prompt, cache_win_k, cache_win_v, state_ssm_re, state_ssm_im,
              state_conv_mix, state_conv_ffn, cache_mem_k, cache_mem_v, norm_mix, norm_xattn, norm_ffn,
              norm_final, w_in_even, w_out_even, ssm_a_re, ssm_a_im, ssm_log_dt, ssm_b_re, ssm_b_im,
              ssm_c_re, ssm_c_im, ssm_d, w_glu, attn_sinks, w_in_odd, conv_mix_w, w_out_odd, xattn_wq,
              xattn_wkv, xattn_wo, ffn_w_up, ffn_conv_w, ffn_w_down):
    params = dict(norm_mix=norm_mix, norm_xattn=norm_xattn, norm_ffn=norm_ffn, norm_final=norm_final,
                  w_in_even=w_in_even, w_out_even=w_out_even, ssm_a_re=ssm_a_re, ssm_a_im=ssm_a_im,
                  ssm_log_dt=ssm_log_dt, ssm_b_re=ssm_b_re, ssm_b_im=ssm_b_im, ssm_c_re=ssm_c_re,
                  ssm_c_im=ssm_c_im, ssm_d=ssm_d, w_glu=w_glu, attn_sinks=attn_sinks, w_in_odd=w_in_odd,
                  conv_mix_w=conv_mix_w, w_out_odd=w_out_odd, xattn_wq=xattn_wq, xattn_wo=xattn_wo,
                  ffn_w_up=ffn_w_up, ffn_conv_w=ffn_conv_w, ffn_w_down=ffn_w_down)
    dt = x_prompt.dtype
    bp = x_prompt.shape[0]
    cw = CONV_WIDTH - 1
    kv = jnp.einsum('bmd,lde->lbme', mem_prompt, xattn_wkv)
    mem_k_p = kv[..., :D_MODEL].reshape(DEPTH, bp, N_MEM, X_HEADS, X_HEAD_DIM)
    mem_v_p = kv[..., D_MODEL:].reshape(DEPTH, bp, N_MEM, X_HEADS, X_HEAD_DIM)
    zk = jnp.zeros((N_EVEN, bp, WINDOW, N_KV_HEADS, HEAD_DIM), dt)
    zs = jnp.zeros((N_EVEN, bp, SSM_GROUPS, SSM_STATE), F32)
    zcm = jnp.zeros((N_ODD, bp, cw, D_MODEL), dt)
    zcf = jnp.zeros((DEPTH, bp, cw, D_FF), dt)
    y_prompt, k_p, v_p, ssm_re_p, ssm_im_p, conv_mix_p, conv_ffn_p = trunk(
        x_prompt, 0, zk, zk, zs, zs, zcm, zcf, mem_k_p, mem_v_p, params)
    win_k_p = k_p[:, :, -WINDOW:]
    win_v_p = v_p[:, :, -WINDOW:]
    y_sample, win_k_s, win_v_s, ssm_re_s, ssm_im_s, conv_mix_s, conv_ffn_s = trunk(
        x_sample, PAST_LEN, cache_win_k, cache_win_v, state_ssm_re, state_ssm_im,
        state_conv_mix, state_conv_ffn, cache_mem_k, cache_mem_v, params)
    return (y_prompt, y_sample, win_k_p, win_v_p, ssm_re_p, ssm_im_p, conv_mix_p, conv_ffn_p,
            mem_k_p, mem_v_p, win_k_s, win_v_s, ssm_re_s, ssm_im_s, conv_mix_s, conv_ffn_s)
```

```cpp
#include <hip/hip_runtime.h>
#include <hip/hip_cooperative_groups.h>
#include <cstdio>
#include <cstdint>
namespace cg = cooperative_groups;
__device__ __forceinline__ int fresh_tid() { int t = threadIdx.x; asm volatile("" : "+v"(t)); return t; }
namespace pg8 {
#define PG8_LAS __attribute__((address_space(3)))
typedef unsigned short bf16_t;
typedef short bf16x8 __attribute__((ext_vector_type(8)));
typedef float f32x4 __attribute__((ext_vector_type(4)));
typedef unsigned u32x4 __attribute__((ext_vector_type(4)));
constexpr int BM = 256, BK = 64, HALF = 128, HTB = HALF * BK * 2  , STAGE_BYTES = 8 * HTB, NXCD = 8, WGM = 8;

__host__ __device__ __forceinline__ int lds_byte(int r, int c) { const int st = (r >> 4) * 2 + (c >> 5), rr = r & 15, cc = c & 31, ob = rr * 64 + cc * 2; return st * 1024 + (ob ^ (((ob >> 9) & 1) << 5)); }
__host__ __device__ __forceinline__ void stage_rc(int b, int& R, int& C) { const int st = b / 1024, sb = b % 1024, swz = sb ^ (((sb >> 9) & 1) << 5); R = (st >> 1) * 16 + swz / 64; C = (st & 1) * 32 + (swz % 64) / 2; }
__host__ __device__ __forceinline__ int perm32(int rho) { const int n = rho >> 4, i = rho & 15; return 8 * (i >> 2) + 4 * n + (i & 3); }

struct Unit { int pm, pn; };
struct Gemm { const bf16_t* A; const bf16_t* Bt; int M, N, K; };

struct StaticOrder {
    int nM, nN, nwg, G, c;
    __host__ __device__ void init(int M, int N, int G_, int c_) { nM = M / BM; nN = N / BM; nwg = nM * nN; G = G_; c = c_; }
    __host__ __device__ bool next(int i, Unit& u) const {
        const long L = (long)i * G + c; if (L >= nwg) return false;
        int wgid = (int)L; { const int q = nwg / NXCD, r = nwg % NXCD, xcd = wgid % NXCD, off = wgid / NXCD; wgid = (xcd < r ? xcd * (q + 1) : r * (q + 1) + (xcd - r) * q) + off; }
        const int nig = WGM * nN, gid = wgid / nig, fm = gid * WGM, gsz = (nM - fm) < WGM ? (nM - fm) : WGM;
        u.pm = fm + ((wgid % nig) % gsz); u.pn = (wgid % nig) / gsz; return true;
    }
    __device__ __forceinline__ void a_ready(const Unit&) const {}
    __device__ __forceinline__ void done(const Unit&) const {}
};

__device__ __forceinline__ unsigned cvt_pk_bf16(float lo, float hi) { unsigned r; asm volatile("v_cvt_pk_bf16_f32 %0, %1, %2" : "=v"(r) : "v"(lo), "v"(hi)); return r; }
typedef float f32x2 __attribute__((ext_vector_type(2)));
template <class Epi, class Sched, bool ALIGN_EPI = false, bool SP2 = false>
__device__ __forceinline__ void gemm_phase(PG8_LAS unsigned char* lds, const Gemm g, const Sched& S, const Epi& E) {
    const int tid = fresh_tid(), wid = __builtin_amdgcn_readfirstlane(tid >> 6), lane = tid & 63, wr = wid >> 2, wc = wid & 3, fr = lane & 15, fq = lane >> 4;
    const int K = g.K, nt = K / BK;
    unsigned voffA[2], voffB[2];
#pragma unroll
    for (int i = 0; i < 2; ++i) { int R, C; stage_rc(tid * 16 + i * 8192, R, C); const int Rb = Epi::PERM ? ((R & ~31) + perm32(R & 31)) : R;
        voffA[i] = (unsigned)(R * K + C) * 2u; voffB[i] = (unsigned)(Rb * K + C) * 2u; }
    const size_t kstep = (size_t)(BK * 2);
    const size_t hstep = (size_t)HALF * K * 2;
    const size_t tstep = 2 * hstep;
    const unsigned ldsw = (unsigned)wid * 1024u;
    const int aoff = lds_byte(wr * 64 + fr, fq * 8), boff = lds_byte(wc * 32 + fr, fq * 8);
#define PG8_SA(b, h) (((b) * 2 + (h)) * HTB)
#define PG8_SB(b, h) ((4 + (b) * 2 + (h)) * HTB)
#define PG8_STAGE(bufoff, gbase, voff) do { _Pragma("unroll") for (int _i = 0; _i < 2; ++_i) \
        __builtin_amdgcn_global_load_lds((const unsigned*)((const char*)(gbase) + (voff)[_i]), (PG8_LAS unsigned*)(lds + (bufoff) + ldsw + _i * 8192), 16, 0, 0); } while (0)
#define PG8_LDA(dst, b, h) do { _Pragma("unroll") for (int m = 0; m < 4; ++m) _Pragma("unroll") for (int k = 0; k < 2; ++k) dst[m][k] = *(const PG8_LAS bf16x8*)(lds + PG8_SA(b, h) + aoff + m * 2048 + k * 1024); } while (0)
#define PG8_LDB(dst, b, h) do { _Pragma("unroll") for (int n = 0; n < 2; ++n) _Pragma("unroll") for (int k = 0; k < 2; ++k) dst[n][k] = *(const PG8_LAS bf16x8*)(lds + PG8_SB(b, h) + boff + n * 2048 + k * 1024); } while (0)
#define PG8_MMA(ai, bj, At, Bt) do { __builtin_amdgcn_s_setprio(1); _Pragma("unroll") for (int m = 0; m < 4; ++m) _Pragma("unroll") for (int n = 0; n < 2; ++n) _Pragma("unroll") for (int k = 0; k < 2; ++k) \
        acc[ai][bj][m][n] = __builtin_amdgcn_mfma_f32_16x16x32_bf16(Bt[n][k], At[m][k], acc[ai][bj][m][n], 0, 0, 0); __builtin_amdgcn_s_setprio(0); } while (0)
#define PG8_WAIT_V(n) asm volatile("s_waitcnt vmcnt(" #n ")" ::: "memory")
#define PG8_WAIT_L(n) asm volatile("s_waitcnt lgkmcnt(" #n ")" ::: "memory")
#define PG8_BAR __builtin_amdgcn_s_barrier()
#define PG8_SCHED __builtin_amdgcn_sched_barrier(0)
    Unit cur, nxt; int ui = 0;
    if (!S.next(0, cur)) return;
    f32x4 acc[2][2][4][2];
#pragma unroll
    for (int a = 0; a < 2; ++a)
#pragma unroll
        for (int b = 0; b < 2; ++b)
#pragma unroll
            for (int m = 0; m < 4; ++m)
#pragma unroll
                for (int n = 0; n < 2; ++n) acc[a][b][m][n] = (f32x4){0.f, 0.f, 0.f, 0.f};
    bf16x8 At[4][2], B0[2][2], B1[2][2];
    const char* cA = (const char*)g.A + (size_t)cur.pm * tstep; const char* cB = (const char*)g.Bt + (size_t)cur.pn * tstep;
    S.a_ready(cur);
    if constexpr (SP2) {
        PG8_STAGE(PG8_SB(0, 0), cB, voffB); PG8_STAGE(PG8_SB(0, 1), cB + hstep, voffB); PG8_STAGE(PG8_SA(0, 0), cA, voffA); PG8_STAGE(PG8_SA(0, 1), cA + hstep, voffA);
        if (wr == 1) PG8_BAR;
        PG8_WAIT_V(2); PG8_BAR;
        PG8_STAGE(PG8_SB(1, 0), cB + kstep, voffB); PG8_STAGE(PG8_SA(1, 0), cA + kstep, voffA); PG8_STAGE(PG8_SB(1, 1), cB + hstep + kstep, voffB);
        PG8_WAIT_V(6); PG8_BAR;
    } else {
        PG8_STAGE(PG8_SB(0, 0), cB, voffB); PG8_STAGE(PG8_SA(0, 0), cA, voffA); PG8_STAGE(PG8_SB(0, 1), cB + hstep, voffB); PG8_STAGE(PG8_SA(0, 1), cA + hstep, voffA);
        if (wr == 1) PG8_BAR;
        PG8_WAIT_V(4); PG8_BAR;
        PG8_STAGE(PG8_SB(1, 0), cB + kstep, voffB); PG8_STAGE(PG8_SA(1, 0), cA + kstep, voffA); PG8_STAGE(PG8_SB(1, 1), cB + hstep + kstep, voffB);
        PG8_WAIT_V(6); PG8_BAR;
    }
    for (;;) {
        const bool has_next = S.next(ui + 1, nxt);
        const char* nA = has_next ? (const char*)g.A + (size_t)nxt.pm * tstep : cA; const char* nB = has_next ? (const char*)g.Bt + (size_t)nxt.pn * tstep : cB;
        for (int t = 0; t < nt; t += 2) {
            const bool last = (t == nt - 2);
            const char* a1 = cA + (size_t)(t + 1) * kstep;
            const char* a2 = last ? nA : cA + (size_t)(t + 2) * kstep; const char* b2 = last ? nB : cB + (size_t)(t + 2) * kstep;
            const char* a3 = a2 + kstep; const char* b3 = b2 + kstep;
            if (last && has_next) S.a_ready(nxt);
            if constexpr (SP2) {
            PG8_LDB(B0, 0, 0); PG8_LDB(B1, 0, 1); PG8_SCHED; PG8_LDA(At, 0, 0); PG8_STAGE(PG8_SA(1, 1), a1 + hstep, voffA);
            PG8_WAIT_V(8); PG8_WAIT_L(0); PG8_BAR; PG8_MMA(0, 0, At, B0); PG8_MMA(0, 1, At, B1); PG8_BAR; PG8_SCHED;
            PG8_LDA(At, 0, 1); PG8_STAGE(PG8_SB(0, 0), b2, voffB); PG8_STAGE(PG8_SB(0, 1), b2 + hstep, voffB); PG8_STAGE(PG8_SA(0, 0), a2, voffA);
            PG8_WAIT_V(8); PG8_WAIT_L(0); PG8_BAR; PG8_MMA(1, 0, At, B0); PG8_MMA(1, 1, At, B1); PG8_BAR; PG8_SCHED;
            PG8_LDB(B0, 1, 0); PG8_LDB(B1, 1, 1); PG8_SCHED; PG8_LDA(At, 1, 0); PG8_STAGE(PG8_SA(0, 1), a2 + hstep, voffA);
            PG8_WAIT_V(8); PG8_WAIT_L(0); PG8_BAR; PG8_MMA(0, 0, At, B0); PG8_MMA(0, 1, At, B1); PG8_BAR; PG8_SCHED;
            PG8_LDA(At, 1, 1); PG8_STAGE(PG8_SB(1, 0), b3, voffB); PG8_STAGE(PG8_SB(1, 1), b3 + hstep, voffB); PG8_STAGE(PG8_SA(1, 0), a3, voffA);
            PG8_WAIT_V(8); PG8_WAIT_L(0); PG8_BAR; PG8_MMA(1, 0, At, B0); PG8_MMA(1, 1, At, B1); PG8_BAR; PG8_SCHED;
            } else {
            PG8_LDB(B0, 0, 0); PG8_SCHED; PG8_LDA(At, 0, 0); PG8_STAGE(PG8_SA(1, 1), a1 + hstep, voffA);
            PG8_WAIT_L(8); PG8_BAR; PG8_WAIT_L(0); PG8_MMA(0, 0, At, B0); PG8_BAR; PG8_SCHED;
            PG8_LDB(B1, 0, 1); PG8_STAGE(PG8_SB(0, 0), b2, voffB);
            PG8_BAR; PG8_WAIT_L(0); PG8_MMA(0, 1, At, B1); PG8_BAR;
            PG8_LDA(At, 0, 1); PG8_STAGE(PG8_SA(0, 0), a2, voffA);
            PG8_BAR; PG8_WAIT_L(0); PG8_MMA(1, 0, At, B0); PG8_BAR; PG8_SCHED;
            PG8_STAGE(PG8_SB(0, 1), b2 + hstep, voffB);
            PG8_WAIT_V(6); PG8_BAR; PG8_MMA(1, 1, At, B1); PG8_BAR;
            PG8_LDB(B0, 1, 0); PG8_SCHED; PG8_LDA(At, 1, 0); PG8_STAGE(PG8_SA(0, 1), a2 + hstep, voffA);
            PG8_WAIT_L(8); PG8_BAR; PG8_WAIT_L(0); PG8_MMA(0, 0, At, B0); PG8_BAR; PG8_SCHED;
            PG8_LDB(B1, 1, 1); PG8_STAGE(PG8_SB(1, 0), b3, voffB);
            PG8_BAR; PG8_WAIT_L(0); PG8_MMA(0, 1, At, B1); PG8_BAR;
            PG8_LDA(At, 1, 1); PG8_STAGE(PG8_SA(1, 0), a3, voffA);
            PG8_BAR; PG8_WAIT_L(0); PG8_MMA(1, 0, At, B0); PG8_BAR; PG8_SCHED;
            PG8_STAGE(PG8_SB(1, 1), b3 + hstep, voffB);
            PG8_WAIT_V(6); PG8_BAR; PG8_MMA(1, 1, At, B1); PG8_BAR;
            }
        }
        if constexpr (ALIGN_EPI) { if (wr == 0) PG8_BAR; }
        if constexpr (!Epi::AFTER_DRAIN) { E(acc, cur, wr, wc, fr, fq); S.done(cur); }
        if (!has_next) break;
#pragma unroll
        for (int a = 0; a < 2; ++a)
#pragma unroll
            for (int b = 0; b < 2; ++b)
#pragma unroll
                for (int m = 0; m < 4; ++m)
#pragma unroll
                    for (int n = 0; n < 2; ++n) acc[a][b][m][n] = (f32x4){0.f, 0.f, 0.f, 0.f};
        cur = nxt; cA = nA; cB = nB; ++ui;
        if constexpr (ALIGN_EPI) { if (wr == 1) PG8_BAR; }
    }
    PG8_WAIT_V(0);
    if constexpr (!ALIGN_EPI) { if (wr == 0) PG8_BAR; }
    PG8_BAR;
    if constexpr (Epi::AFTER_DRAIN) { E.fused(acc, cur, wr, wc, fr, fq, lds, wid, lane); S.done(cur); }
#undef PG8_SA
#undef PG8_SB
#undef PG8_STAGE
#undef PG8_LDA
#undef PG8_LDB
#undef PG8_MMA
#undef PG8_WAIT_V
#undef PG8_WAIT_L
#undef PG8_BAR
#undef PG8_SCHED
}
}
#define GAS __attribute__((address_space(1)))
#define LAS __attribute__((address_space(3)))
typedef unsigned short bf16;
typedef unsigned v4u __attribute__((ext_vector_type(4)));
typedef float f32x4 __attribute__((ext_vector_type(4)));
typedef short bf16x8 __attribute__((ext_vector_type(8)));
typedef GAS unsigned gu32;
typedef GAS unsigned long long gu64;
#define RLX_AGENT __ATOMIC_RELAXED, __HIP_MEMORY_SCOPE_AGENT
#define LDS_WAIT() asm volatile("s_waitcnt lgkmcnt(0)" ::: "memory")
#define VM_WAIT() asm volatile("s_waitcnt vmcnt(0)" ::: "memory")
__device__ __forceinline__ unsigned long long rt() { return __builtin_amdgcn_s_memrealtime(); }
__device__ __forceinline__ unsigned f2bf(float f) { unsigned u = __builtin_bit_cast(unsigned, f); return (u + 0x7fffu + ((u >> 16) & 1u)) >> 16; }
__device__ __forceinline__ unsigned pk2(float lo, float hi) { return f2bf(lo) | (f2bf(hi) << 16); }

#define XB_TMO      128
#define XB_XCNT(j)  (256  + 64 * (j))
#define XB_XSUB(j)  (1280 + 64 * (j))
#define XB_XGEN(j)  (2304 + 64 * (j))
#define XB_TOP      3328
#define XB_TOPGEN   3392
#define XCD_BAR_WORDS 3456
#define XB_SPIN_CAP (1u << 18)

__device__ __forceinline__ unsigned xb_ld(unsigned* p)              { return __hip_atomic_load(p, __ATOMIC_RELAXED, __HIP_MEMORY_SCOPE_AGENT); }
__device__ __forceinline__ unsigned xb_add(unsigned* p, unsigned v) { return __hip_atomic_fetch_add(p, v, __ATOMIC_RELAXED, __HIP_MEMORY_SCOPE_AGENT); }
__device__ __forceinline__ unsigned xb_xcc_id() { return (unsigned)__builtin_amdgcn_s_getreg((3 << 11) | 20) & 0xFu; }
#define XB_SPIN(cond, bar) do { unsigned _sp = 0; while (cond) { __builtin_amdgcn_s_sleep(1); \
    if ((++_sp & 255u) == 0u) { if (xb_ld(&(bar)[XB_TMO])) break; if (_sp > XB_SPIN_CAP) { atomicAdd(&(bar)[XB_TMO], 1u); break; } } } } while (0)

struct XcdBarrier {
    unsigned* bar; unsigned x;
    volatile LAS unsigned* st;
};

__device__ __forceinline__ XcdBarrier xcd_barrier_post(unsigned* bar, volatile LAS unsigned* st) {
    XcdBarrier b; b.bar = bar; b.x = xb_xcc_id(); b.st = st;
    if (threadIdx.x == 0) (void)xb_add(&bar[XB_XCNT(b.x)], 1u);
    return b;
}
__device__ __forceinline__ void xcd_barrier_complete(unsigned* bar, unsigned x, unsigned& nloc, unsigned& nx) {
    const unsigned G = gridDim.x * gridDim.y * gridDim.z;
    unsigned sum, cnt, mine, sp = 0u;
    for (;;) {
        sum = 0u; cnt = 0u; mine = 0u;
#pragma unroll
        for (unsigned j = 0; j < 16; ++j) { const unsigned c = xb_ld(&bar[XB_XCNT(j)]); sum += c; cnt += (c > 0u) ? 1u : 0u; mine = (j == x) ? c : mine; }
        if (sum == G) break;
        __builtin_amdgcn_s_sleep(1);
        if ((++sp & 255u) == 0u) { if (xb_ld(&bar[XB_TMO])) break; if (sp > XB_SPIN_CAP) { atomicAdd(&bar[XB_TMO], 1u); break; } }
    }
    nloc = mine > 0u ? mine : 1u; nx = cnt > 0u ? cnt : 1u;
}

__device__ __forceinline__ void xcd_barrier(const XcdBarrier& b) {
    asm volatile("s_waitcnt vmcnt(0)" ::: "memory");
    __syncthreads();
    if (threadIdx.x == 0) {
        unsigned* bar = b.bar;
        __builtin_amdgcn_s_waitcnt(0);
        unsigned nloc = b.st[0], nx = b.st[1];
        if (nloc == 0u) { xcd_barrier_complete(bar, b.x, nloc, nx); b.st[0] = nloc; b.st[1] = nx; }
        const unsigned old = xb_add(&bar[XB_XSUB(b.x)], 1u);
        const unsigned gen = old / nloc;
        if (old + 1u == (gen + 1u) * nloc) {
            __builtin_amdgcn_fence(__ATOMIC_RELEASE, "agent");
            asm volatile("s_waitcnt vmcnt(0)" ::: "memory");
            const unsigned og = xb_add(&bar[XB_TOP], 1u);
            const unsigned tg = og / nx;
            if (og + 1u == (tg + 1u) * nx) xb_add(&bar[XB_TOPGEN], 1u);
            else XB_SPIN(xb_ld(&bar[XB_TOPGEN]) == tg, bar);
            __builtin_amdgcn_fence(__ATOMIC_ACQUIRE, "agent");
            xb_add(&bar[XB_XGEN(b.x)], 1u);
            asm volatile("s_waitcnt vmcnt(0)" ::: "memory");
        } else {
            XB_SPIN(xb_ld(&bar[XB_XGEN(b.x)]) == gen, bar);
            __builtin_amdgcn_fence(__ATOMIC_ACQUIRE, "agent");
            asm volatile("s_waitcnt vmcnt(0)" ::: "memory");
        }
    }
    __syncthreads();
}
typedef unsigned u32x2v __attribute__((ext_vector_type(2)));
typedef float f32x2v __attribute__((ext_vector_type(2)));

constexpr int MP = 16384, MROWS = 16640, DMODEL = 1024, DFF = 2816, NBLK64 = MROWS / 64;
constexpr float RMS_EPS = 1e-6f;
constexpr size_t OFF_Y = 0, OFF_WKP = (size_t)MROWS * 1024, OFF_WVP = OFF_WKP + 65536, OFF_SRP = OFF_WVP + 65536, OFF_SIP = OFF_SRP + 8192,
    OFF_CMP = OFF_SIP + 8192, OFF_CFP = OFF_CMP + 8192, OFF_MKP = OFF_CFP + 45056, OFF_MVP = OFF_MKP + 2097152, OFF_WKS = OFF_MVP + 2097152,
    OFF_WVS = OFF_WKS + 32768, OFF_SRS = OFF_WVS + 32768, OFF_SIS = OFF_SRS + 16384, OFF_CMS = OFF_SIS + 16384, OFF_CFS = OFF_CMS + 16384;
constexpr size_t MiB = 1u << 20;
constexpr size_t WS_ROWSS = 0, WS_BAR = 512 * 1024, CTL_ZERO_BYTES = 1 * MiB;
constexpr size_t WS_ROPE = 1 * MiB, WS_SSM = 2 * MiB, WS_CKV = 3 * MiB, WS_SLOC = 4 * MiB, WS_MEMK = 8 * MiB, WS_MEMVT = 20 * MiB, WS_SIDE = 32 * MiB;
constexpr size_t SG_BYTES = (size_t)NBLK64 * 8 * DFF * 4, SV_BYTES = (size_t)NBLK64 * 4 * DFF * 4;
static_assert(WS_SIDE + SG_BYTES + SV_BYTES <= 66 * MiB, "side buffers");
constexpr size_t WS_WT = 66 * MiB, WS_XB = 128 * MiB, WS_TMP = 161 * MiB;
constexpr size_t WT_INEVEN = 0, WT_GLU = WT_INEVEN + 1280 * 1024, WT_OUTEVEN = WT_GLU + 512 * 512, WT_WQ = WT_OUTEVEN + 1024 * 1024, WT_WKV = WT_WQ + 2 * 1024 * 1024,
    WT_WO = WT_WKV + 2 * 2048 * 1024, WT_UP = WT_WO + 2 * 1024 * 1024, WT_DOWN = WT_UP + (size_t)2 * 5632 * 1024, WT_INODD = WT_DOWN + (size_t)2 * 2816 * 1024,
    WT_OUTODD = WT_INODD + 3072 * 1024, WT_END = WT_OUTODD + 1024 * 1024;
static_assert(WS_WT + WT_END * 2 <= WS_XB, "weights");
static_assert(WS_XB + (size_t)MROWS * 1024 * 2 <= WS_TMP, "xb");
constexpr size_t TMP_BYTES = (size_t)MROWS * DFF * 2;
constexpr size_t WS_PART = 251 * MiB, PART_ELEMS = (size_t)MROWS * 16;
static_assert(WS_PART + 2 * PART_ELEMS * 4 <= 256 * MiB, "part");
static_assert(WS_TMP + TMP_BYTES <= 256 * MiB, "ws");
constexpr size_t TMP_PROJ0 = 0, TMP_GBUF = (size_t)MROWS * 1280 * 2, TMP_YCAT = TMP_GBUF + (size_t)MROWS * 512 * 2, TMP_MEMB = TMP_YCAT;
static_assert(TMP_YCAT + (size_t)MROWS * 1024 * 2 <= TMP_BYTES, "tmp");
constexpr size_t TMP_QX = 0, TMP_OX = (size_t)MROWS * 1024 * 2, TMP_ACT = 0, TMP_GB = 0, TMP_ZC = (size_t)MROWS * 1024 * 2;
constexpr int LDS_BYTES = 147456, MISC_OFF = 131072 + 320;
constexpr int NPH = 22;

#define MFMA16(a, b, c) __builtin_amdgcn_mfma_f32_16x16x32_bf16(a, b, c, 0, 0, 0)
__device__ __forceinline__ float bflo(unsigned w) { return __uint_as_float(w << 16); }
__device__ __forceinline__ float bfhi(unsigned w) { return __uint_as_float(w & 0xffff0000u); }
__device__ __forceinline__ v4u pack8(f32x4 a, f32x4 b) { v4u w; w.x = pg8::cvt_pk_bf16(a[0], a[1]); w.y = pg8::cvt_pk_bf16(a[2], a[3]); w.z = pg8::cvt_pk_bf16(b[0], b[1]); w.w = pg8::cvt_pk_bf16(b[2], b[3]); return w; }
__device__ __forceinline__ float rstd_of(const float* part, int row) { const f32x4* p = (const f32x4*)(part + (size_t)row * 16); const f32x4 a = p[0] + p[1] + p[2] + p[3]; return rsqrtf(((a[0] + a[1]) + (a[2] + a[3])) * (1.0f / 1024.0f) + RMS_EPS); }
__device__ __forceinline__ float sigmoidf_(float x) { return 1.0f / (1.0f + __expf(-x)); }
__device__ __forceinline__ float dpp_ror1(float v) { return __builtin_bit_cast(float, __builtin_amdgcn_update_dpp(0, __builtin_bit_cast(int, v), 0x121, 0xf, 0xf, false)); }
__device__ __forceinline__ float dpp_ror2(float v) { return __builtin_bit_cast(float, __builtin_amdgcn_update_dpp(0, __builtin_bit_cast(int, v), 0x122, 0xf, 0xf, false)); }
__device__ __forceinline__ float wave_sum(float v) {
#pragma unroll
    for (int o = 1; o < 64; o <<= 1) v += __shfl_xor(v, o);
    return v;
}

typedef pg8::Unit Unit;
#define EPI_ARGS const f32x4 (&acc)[2][2][4][2], const Unit& u, int wr, int wc, int fr, int fq

struct EpiBf16 {
    static constexpr bool PERM = true, AFTER_DRAIN = false;
    bf16* O; int ldc; const float* rowss;
    __device__ __forceinline__ void operator()(EPI_ARGS) const {
        const int row0 = u.pm * 256 + wr * 64 + fr, col0 = u.pn * 256 + wc * 32 + 8 * fq;
#pragma unroll
        for (int ai = 0; ai < 2; ++ai)
#pragma unroll
            for (int m = 0; m < 4; ++m) { const int row = row0 + ai * 128 + m * 16; const float rs = rstd_of(rowss, row); bf16* rp = O + (size_t)row * ldc + col0;
#pragma unroll
                for (int bj = 0; bj < 2; ++bj) *(v4u*)(rp + bj * 128) = pack8(acc[ai][bj][m][0] * rs, acc[ai][bj][m][1] * rs); }
    }
};
struct EpiRes {
    static constexpr bool PERM = true, AFTER_DRAIN = false;
    const float* base_p; const float* base_s; float* xf; bf16* xb; float* rowss_next;
    __device__ __forceinline__ void operator()(EPI_ARGS) const {
        const float* base = u.pm < 64 ? base_p : base_s;
        const int row0 = u.pm * 256 + wr * 64 + fr, col0 = u.pn * 256 + wc * 32 + 8 * fq;
#pragma unroll
        for (int ai = 0; ai < 2; ++ai)
#pragma unroll
            for (int m = 0; m < 4; ++m) { const int row = row0 + ai * 128 + m * 16; const size_t off = (size_t)row * 1024 + col0; float ss = 0.f;
#pragma unroll
                for (int bj = 0; bj < 2; ++bj) { const f32x4 b0 = *(const f32x4*)(base + off + bj * 128), b1 = *(const f32x4*)(base + off + bj * 128 + 4);
                    const f32x4 v0 = acc[ai][bj][m][0] + b0, v1 = acc[ai][bj][m][1] + b1;
                    *(f32x4*)(xf + off + bj * 128) = v0; *(f32x4*)(xf + off + bj * 128 + 4) = v1; *(v4u*)(xb + off + bj * 128) = pack8(v0, v1);
                    ss += (v0[0] * v0[0] + v0[1] * v0[1]) + (v0[2] * v0[2] + v0[3] * v0[3]) + (v1[0] * v1[0] + v1[1] * v1[1]) + (v1[2] * v1[2] + v1[3] * v1[3]); }
                ss += __shfl_xor(ss, 16); ss += __shfl_xor(ss, 32);
                if (fq == 0) rowss_next[(size_t)row * 16 + u.pn * 4 + wc] = ss; }
    }
};
struct EpiGlu {
    static constexpr bool PERM = true, AFTER_DRAIN = false;
    const bf16* g; bf16* ycat;
    __device__ __forceinline__ void operator()(EPI_ARGS) const {
        const int row0 = u.pm * 256 + wr * 64 + fr, col0 = u.pn * 256 + wc * 32 + 8 * fq;
#pragma unroll
        for (int ai = 0; ai < 2; ++ai)
#pragma unroll
            for (int m = 0; m < 4; ++m) { const int row = row0 + ai * 128 + m * 16;
#pragma unroll
                for (int bj = 0; bj < 2; ++bj) { const int col = col0 + bj * 128; const v4u gw = *(const v4u*)(g + (size_t)row * 512 + col);
                    const f32x4 a0 = acc[ai][bj][m][0], a1 = acc[ai][bj][m][1]; f32x4 o0, o1;
                    o0[0] = bflo(gw.x) * sigmoidf_(a0[0]); o0[1] = bfhi(gw.x) * sigmoidf_(a0[1]); o0[2] = bflo(gw.y) * sigmoidf_(a0[2]); o0[3] = bfhi(gw.y) * sigmoidf_(a0[3]);
                    o1[0] = bflo(gw.z) * sigmoidf_(a1[0]); o1[1] = bfhi(gw.z) * sigmoidf_(a1[1]); o1[2] = bflo(gw.w) * sigmoidf_(a1[2]); o1[3] = bfhi(gw.w) * sigmoidf_(a1[3]);
                    *(v4u*)(ycat + (size_t)row * 1024 + col) = pack8(o0, o1); } }
    }
};
struct EpiKV {
    static constexpr bool PERM = true, AFTER_DRAIN = false;
    float* out; bf16* memk;
    __device__ __forceinline__ void operator()(EPI_ARGS) const {
        const int row0 = u.pm * 256 + wr * 64 + fr, col0 = u.pn * 256 + wc * 32 + 8 * fq;
#pragma unroll
        for (int ai = 0; ai < 2; ++ai)
#pragma unroll
            for (int m = 0; m < 4; ++m) { const int row = row0 + ai * 128 + m * 16;
#pragma unroll
                for (int bj = 0; bj < 2; ++bj) { const int c = col0 + bj * 128, l = c >> 11, e = c & 2047, isv = e >> 10, dc = e & 1023;
                    float* op = out + (isv ? OFF_MVP : OFF_MKP) + (size_t)l * 1048576 + (size_t)row * 1024 + dc;
                    *(f32x4*)op = acc[ai][bj][m][0]; *(f32x4*)(op + 4) = acc[ai][bj][m][1];
                    if (!isv) *(v4u*)(memk + (size_t)l * 12 * 262144 + (size_t)row * 1024 + dc) = pack8(acc[ai][bj][m][0], acc[ai][bj][m][1]); } }
    }
};
struct EpiIn0 {
    static constexpr bool PERM = true, AFTER_DRAIN = false;
    bf16* proj; const float* rowss; const float* ropec; const float* ropes; float* out;
    __device__ __forceinline__ void operator()(EPI_ARGS) const {
        const int pn = u.pn;
#pragma unroll
        for (int ai = 0; ai < 2; ++ai)
#pragma unroll
            for (int m = 0; m < 4; ++m) { const int row = u.pm * 256 + ai * 128 + wr * 64 + m * 16 + fr; const float rs = rstd_of(rowss, row);
                const int pos = row < MP ? (row & 4095) : 2048 + (row & 31);
                bf16* rp = proj + (size_t)row * 1280;
                float* wk = nullptr; float* wv = nullptr;
                if (pn == 4) { if (row >= MP) { wk = out + OFF_WKS + (size_t)(row - MP) * 128; wv = out + OFF_WVS + (size_t)(row - MP) * 128; }
                               else if ((row & 4095) >= 3968) { const size_t o = (size_t)((row >> 12) * 128 + (row & 4095) - 3968) * 128; wk = out + OFF_WKP + o; wv = out + OFF_WVP + o; } }
#pragma unroll
                for (int bj = 0; bj < 2; ++bj) { const f32x4 v0 = acc[ai][bj][m][0] * rs, v1 = acc[ai][bj][m][1] * rs;
                    const bool rope = (pn == 2 || pn == 3 || (pn == 4 && bj == 0));
                    if (!rope) { const int col = pn * 256 + bj * 128 + wc * 32 + 8 * fq; *(v4u*)(rp + col) = pack8(v0, v1);
                        if (pn == 4 && wv) { *(f32x4*)(wv + wc * 32 + 8 * fq) = v0; *(f32x4*)(wv + wc * 32 + 8 * fq + 4) = v1; } }
                    else { const int gbase = pn * 256 + bj * 128 + (wc >> 1) * 64, d1 = 16 * (wc & 1) + 4 * fq;
                        const f32x4 c4 = *(const f32x4*)(ropec + pos * 32 + d1), s4 = *(const f32x4*)(ropes + pos * 32 + d1);
                        f32x4 o1 = v0 * c4 - v1 * s4, o2 = v1 * c4 + v0 * s4;
                        if (pn != 4) { o1 = o1 * 0.125f; o2 = o2 * 0.125f; }
                        u32x2v w1, w2; w1.x = pg8::cvt_pk_bf16(o1[0], o1[1]); w1.y = pg8::cvt_pk_bf16(o1[2], o1[3]); w2.x = pg8::cvt_pk_bf16(o2[0], o2[1]); w2.y = pg8::cvt_pk_bf16(o2[2], o2[3]);
                        *(u32x2v*)(rp + gbase + d1) = w1; *(u32x2v*)(rp + gbase + d1 + 32) = w2;
                        if (pn == 4 && wk) { const int cc = (wc >> 1) * 64 + d1; *(f32x4*)(wk + cc) = o1; *(f32x4*)(wk + cc + 32) = o2; } } } }
    }
};
struct EpiFfnUp {
    static constexpr bool PERM = true, AFTER_DRAIN = false;
    bf16* act; const float* rowss; const float* cw; float* SG; float* SV;
    __device__ __forceinline__ void operator()(EPI_ARGS) const {
        const int c0 = u.pn * 128 + wc * 32 + 8 * fq; const bool sample = u.pm == 64;
        const f32x4 w0a = *(const f32x4*)(cw + c0), w0b = *(const f32x4*)(cw + c0 + 4), w1a = *(const f32x4*)(cw + DFF + c0), w1b = *(const f32x4*)(cw + DFF + c0 + 4),
                    w2a = *(const f32x4*)(cw + 2 * DFF + c0), w2b = *(const f32x4*)(cw + 2 * DFF + c0 + 4);
#pragma unroll
        for (int ai = 0; ai < 2; ++ai) { f32x4 gp0 = {0.f, 0.f, 0.f, 0.f}, gp1 = {0.f, 0.f, 0.f, 0.f}; const int blk = u.pm * 4 + ai * 2 + wr;
#pragma unroll
            for (int m = 0; m < 4; ++m) { const int row = u.pm * 256 + ai * 128 + wr * 64 + m * 16 + fr; const float rs = rstd_of(rowss, row);
                const f32x4 g0 = acc[ai][0][m][0] * rs, g1 = acc[ai][0][m][1] * rs, v0 = acc[ai][1][m][0] * rs, v1 = acc[ai][1][m][1] * rs;
                f32x4 a0, a1;
#pragma unroll
                for (int j = 0; j < 4; ++j) {
                    const float r1pa = dpp_ror1(gp0[j]), r1ca = dpp_ror1(g0[j]), r2pa = dpp_ror2(gp0[j]), r2ca = dpp_ror2(g0[j]);
                    const float r1pb = dpp_ror1(gp1[j]), r1cb = dpp_ror1(g1[j]), r2pb = dpp_ror2(gp1[j]), r2cb = dpp_ror2(g1[j]);
                    const float p1a = fr == 0 ? r1pa : r1ca, p2a = fr < 2 ? r2pa : r2ca;
                    const float p1b = fr == 0 ? r1pb : r1cb, p2b = fr < 2 ? r2pb : r2cb;
                    const float ca = w0a[j] * p2a + w1a[j] * p1a + w2a[j] * g0[j], cb = w0b[j] * p2b + w1b[j] * p1b + w2b[j] * g1[j];
                    a0[j] = ca * sigmoidf_(ca) * v0[j]; a1[j] = cb * sigmoidf_(cb) * v1[j]; }
                const bool valid = (m > 0 || fr >= 2) && !(sample && m == 2 && fr < 2);
                if (valid) *(v4u*)(act + (size_t)row * DFF + c0) = pack8(a0, a1);
                if ((m & 1) == 0 && fr < 2) { float* sg = SG + (size_t)(blk * 8 + 2 * m + fr) * DFF + c0; *(f32x4*)sg = g0; *(f32x4*)(sg + 4) = g1;
                                              float* sv = SV + (size_t)(blk * 4 + m + fr) * DFF + c0; *(f32x4*)sv = v0; *(f32x4*)(sv + 4) = v1; }
                if ((m & 1) == 1 && fr >= 14) { float* sg = SG + (size_t)(blk * 8 + 2 * m + fr - 14) * DFF + c0; *(f32x4*)sg = g0; *(f32x4*)(sg + 4) = g1; }
                gp0 = g0; gp1 = g1; } }
    }
};
struct EpiInOdd {
    static constexpr bool PERM = true, AFTER_DRAIN = false;
    bf16* gb; bf16* zc; const float* rowss; const float* cw; float* SG;
    __device__ __forceinline__ void operator()(EPI_ARGS) const {
        if (u.pn < 4) {
            const int row0 = u.pm * 256 + wr * 64 + fr, col0 = u.pn * 256 + wc * 32 + 8 * fq;
#pragma unroll
            for (int ai = 0; ai < 2; ++ai)
#pragma unroll
                for (int m = 0; m < 4; ++m) { const int row = row0 + ai * 128 + m * 16; const float rs = rstd_of(rowss, row); bf16* rp = gb + (size_t)row * 1024 + col0;
#pragma unroll
                    for (int bj = 0; bj < 2; ++bj) *(v4u*)(rp + bj * 128) = pack8(acc[ai][bj][m][0] * rs, acc[ai][bj][m][1] * rs); }
            return;
        }
        const int c0 = (u.pn - 4) * 128 + wc * 32 + 8 * fq; const bool sample = u.pm == 64;
        const f32x4 w0a = *(const f32x4*)(cw + c0), w0b = *(const f32x4*)(cw + c0 + 4), w1a = *(const f32x4*)(cw + 1024 + c0), w1b = *(const f32x4*)(cw + 1024 + c0 + 4),
                    w2a = *(const f32x4*)(cw + 2048 + c0), w2b = *(const f32x4*)(cw + 2048 + c0 + 4);
#pragma unroll
        for (int ai = 0; ai < 2; ++ai) { f32x4 gp0 = {0.f, 0.f, 0.f, 0.f}, gp1 = {0.f, 0.f, 0.f, 0.f}; const int blk = u.pm * 4 + ai * 2 + wr;
#pragma unroll
            for (int m = 0; m < 4; ++m) { const int row = u.pm * 256 + ai * 128 + wr * 64 + m * 16 + fr; const float rs = rstd_of(rowss, row); const float rs2 = rs * rs;
                const f32x4 g0 = acc[ai][0][m][0] * acc[ai][1][m][0] * rs2, g1 = acc[ai][0][m][1] * acc[ai][1][m][1] * rs2;
                f32x4 a0, a1;
#pragma unroll
                for (int j = 0; j < 4; ++j) {
                    const float r1pa = dpp_ror1(gp0[j]), r1ca = dpp_ror1(g0[j]), r2pa = dpp_ror2(gp0[j]), r2ca = dpp_ror2(g0[j]);
                    const float r1pb = dpp_ror1(gp1[j]), r1cb = dpp_ror1(g1[j]), r2pb = dpp_ror2(gp1[j]), r2cb = dpp_ror2(g1[j]);
                    const float p1a = fr == 0 ? r1pa : r1ca, p2a = fr < 2 ? r2pa : r2ca;
                    const float p1b = fr == 0 ? r1pb : r1cb, p2b = fr < 2 ? r2pb : r2cb;
                    a0[j] = w0a[j] * p2a + w1a[j] * p1a + w2a[j] * g0[j]; a1[j] = w0b[j] * p2b + w1b[j] * p1b + w2b[j] * g1[j]; }
                const bool valid = (m > 0 || fr >= 2) && !(sample && m == 2 && fr < 2);
                if (valid) *(v4u*)(zc + (size_t)row * 1024 + c0) = pack8(a0, a1);
                if ((m & 1) == 0 && fr < 2) { float* sg = SG + (size_t)(blk * 8 + 2 * m + fr) * 1024 + c0; *(f32x4*)sg = g0; *(f32x4*)(sg + 4) = g1; }
                if ((m & 1) == 1 && fr >= 14) { float* sg = SG + (size_t)(blk * 8 + 2 * m + fr - 14) * 1024 + c0; *(f32x4*)sg = g0; *(f32x4*)(sg + 4) = g1; }
                gp0 = g0; gp1 = g1; } }
    }
};

__device__ __forceinline__ int rowmap(int mode, int n) {
    if (mode == 1) { if (n >= 512 && n < 1152) { const int d = n & 63; return (n & ~63) | (32 * ((d >> 4) & 1) + 8 * ((d >> 2) & 3) + 4 * (d >> 5) + (d & 3)); } return n; }
    if (mode == 2) { return n < DFF ? ((n >> 7) * 256 + (n & 127)) : (((n - DFF) >> 7) * 256 + 128 + ((n - DFF) & 127)); }
    if (mode == 3) { if (n < 1024) return n; const int c = (n - 1024) & 1023, z = n >= 2048 ? 1 : 0; return 1024 + (c >> 7) * 256 + z * 128 + (c & 127); }
    return n;
}
__device__ __forceinline__ void tr_item(const float* W, int K, int N, bf16* WT, const float* gain, float scale, int mode, LAS float* scr, int item, int lane) {
    const int nblk = N / 32, kb = item / nblk, nb = item % nblk, k0 = 64 * kb, n0 = 32 * nb;
#pragma unroll 8
    for (int i = 0; i < 32; ++i) { const int kk = 2 * i + (lane >> 5); const float gs = gain ? gain[k0 + kk] * scale : scale; scr[kk * 33 + (lane & 31)] = W[(size_t)(k0 + kk) * N + n0 + (lane & 31)] * gs; }
    LDS_WAIT(); asm volatile("" ::: "memory");
    const int c = lane & 7;
#pragma unroll
    for (int j = 0; j < 4; ++j) { const int n = (lane >> 3) + 8 * j; const LAS float* s = scr + (8 * c) * 33 + n;
        v4u o; o.x = pg8::cvt_pk_bf16(s[0 * 33], s[1 * 33]); o.y = pg8::cvt_pk_bf16(s[2 * 33], s[3 * 33]); o.z = pg8::cvt_pk_bf16(s[4 * 33], s[5 * 33]); o.w = pg8::cvt_pk_bf16(s[6 * 33], s[7 * 33]);
        *(v4u*)(WT + (size_t)rowmap(mode, n0 + n) * K + k0 + 8 * c) = o; }
    LDS_WAIT(); asm volatile("" ::: "memory");
}
__device__ __forceinline__ double dexp_(double y) {
    const double k = rint(y * 1.4426950408889634); const double r = (y - k * 0.6931471803691238) - k * 1.9082149292705877e-10;
    double p = 1.0 / 6227020800.0;
    p = p * r + 1.0 / 479001600.0; p = p * r + 1.0 / 39916800.0; p = p * r + 1.0 / 3628800.0; p = p * r + 1.0 / 362880.0; p = p * r + 1.0 / 40320.0; p = p * r + 1.0 / 5040.0;
    p = p * r + 1.0 / 720.0; p = p * r + 1.0 / 120.0; p = p * r + 1.0 / 24.0; p = p * r + 1.0 / 6.0; p = p * r + 0.5; p = p * r + 1.0; p = p * r + 1.0;
    const long long bits = (long long)(1023 + (int)k) << 52; return p * __builtin_bit_cast(double, bits);
}
__device__ __forceinline__ void dsincos_(double x, double& s, double& c) {
    const double k = rint(x * 0.6366197723675814); const double r = (x - k * 1.5707963267948966) - k * 6.123233995736766e-17; const double r2 = r * r;
    const double sp = r * (1.0 + r2 * (-1.0 / 6.0 + r2 * (1.0 / 120.0 + r2 * (-1.0 / 5040.0 + r2 * (1.0 / 362880.0 + r2 * (-1.0 / 39916800.0 + r2 * (1.0 / 6227020800.0)))))));
    const double cp = 1.0 + r2 * (-0.5 + r2 * (1.0 / 24.0 + r2 * (-1.0 / 720.0 + r2 * (1.0 / 40320.0 + r2 * (-1.0 / 3628800.0 + r2 * (1.0 / 479001600.0 + r2 * (-1.0 / 87178291200.0)))))));
    const int q = ((int)k) & 3;
    s = q == 0 ? sp : q == 1 ? cp : q == 2 ? -sp : -cp; c = q == 0 ? cp : q == 1 ? -sp : q == 2 ? -cp : sp;
}

__device__ __forceinline__ const bf16* kvptr(const bf16* proj, const bf16* cb, int sample, int b, int c, int kvh, int kk, int isv) {
    if (!sample) { int pos = (c - 2) * 64 + kk; pos = pos < 0 ? 0 : pos; return proj + (size_t)(b * 4096 + pos) * 1280 + 1024 + isv * 128 + kvh * 64; }
    if (kk < 128) return cb + (size_t)(b * 128 + kk) * 128 + kvh * 64;
    int t = kk - 128; t = t > 31 ? 31 : t; return proj + (size_t)(MP + b * 32 + t) * 1280 + 1024 + isv * 128 + kvh * 64;
}
__device__ __forceinline__ void swa_phase(const bf16* proj, const bf16* ckb, const bf16* cvb, const float* sinks, bf16* ycat, LAS unsigned char* lds, int tid, int wave, int lane, int G) {
    LAS bf16* VT = (LAS bf16*)lds;
    const int fr = lane & 15, quad = lane >> 4;
    for (int it = blockIdx.x; it < 528; it += G) {
        int b, c, kvh, sample;
        if (it < 512) { sample = 0; b = it >> 7; c = (it >> 1) & 63; kvh = it & 1; } else { sample = 1; b = (it - 512) >> 1; c = 0; kvh = it & 1; }
        __syncthreads();
#pragma unroll
        for (int i = 0; i < 3; ++i) { const int idx = tid + 512 * i, kk = idx % 192, dg = idx / 192; const v4u w = *(const v4u*)(kvptr(proj, cvb, sample, b, c, kvh, kk, 1) + dg * 8);
            LAS bf16* vp = VT + (dg * 8) * 200 + kk;
            vp[0] = (bf16)(w.x & 0xffffu); vp[200] = (bf16)(w.x >> 16); vp[400] = (bf16)(w.y & 0xffffu); vp[600] = (bf16)(w.y >> 16);
            vp[800] = (bf16)(w.z & 0xffffu); vp[1000] = (bf16)(w.z >> 16); vp[1200] = (bf16)(w.w & 0xffffu); vp[1400] = (bf16)(w.w >> 16); }
        __syncthreads();
        const int gq = wave >> 1, qhalf = wave & 1, head = kvh * 4 + gq;
        if (!(sample && qhalf)) {
            const int plo = sample ? 0 : (c >= 2 ? 0 : (2 - c) * 2), phi = sample ? 5 : 6;
            bf16x8 qf[2][2];
#pragma unroll
            for (int qb = 0; qb < 2; ++qb) { const int q = qhalf * 32 + qb * 16 + fr; const int row = sample ? MP + b * 32 + (q & 31) : b * 4096 + c * 64 + q;
                const bf16* qp = proj + (size_t)row * 1280 + 512 + head * 64 + quad * 8; qf[qb][0] = *(const bf16x8*)qp; qf[qb][1] = *(const bf16x8*)(qp + 32); }
            f32x4 s[12][2];
#pragma unroll
            for (int kb = 0; kb < 12; ++kb) { const int key = 32 * (kb >> 1) + (fr >> 2) * 8 + 4 * (kb & 1) + (fr & 3); const bf16* kp = kvptr(proj, ckb, sample, b, c, kvh, key, 0) + quad * 8;
                const bf16x8 k0 = *(const bf16x8*)kp, k1 = *(const bf16x8*)(kp + 32);
#pragma unroll
                for (int qb = 0; qb < 2; ++qb) { f32x4 a = {0.f, 0.f, 0.f, 0.f}; a = MFMA16(k0, qf[qb][0], a); a = MFMA16(k1, qf[qb][1], a); s[kb][qb] = a; } }
            const float sink = sinks[head];
            bf16x8 pf[6][2];
#pragma unroll
            for (int qb = 0; qb < 2; ++qb) { float mx = sink;
#pragma unroll
                for (int kb = 0; kb < 12; ++kb) { const bool pv = (kb >> 1) >= plo && (kb >> 1) < phi;
#pragma unroll
                    for (int j = 0; j < 4; ++j) { const float v = pv ? s[kb][qb][j] : -1e30f; s[kb][qb][j] = v; mx = fmaxf(mx, v); } }
                mx = fmaxf(mx, __shfl_xor(mx, 16)); mx = fmaxf(mx, __shfl_xor(mx, 32));
                float sum = 0.f;
#pragma unroll
                for (int kb = 0; kb < 12; ++kb)
#pragma unroll
                    for (int j = 0; j < 4; ++j) { const float e = __expf(s[kb][qb][j] - mx); s[kb][qb][j] = e; sum += e; }
                sum += __shfl_xor(sum, 16); sum += __shfl_xor(sum, 32); sum += __expf(sink - mx);
                const float inv = 1.0f / sum;
#pragma unroll
                for (int pr = 0; pr < 6; ++pr) pf[pr][qb] = __builtin_bit_cast(bf16x8, pack8(s[2 * pr][qb] * inv, s[2 * pr + 1][qb] * inv)); }
#pragma unroll
            for (int db = 0; db < 4; ++db) { bf16x8 vf[6];
#pragma unroll
                for (int pr = 0; pr < 6; ++pr) vf[pr] = *(const LAS bf16x8*)(VT + (db * 16 + fr) * 200 + 32 * pr + quad * 8);
#pragma unroll
                for (int qb = 0; qb < 2; ++qb) { f32x4 o = {0.f, 0.f, 0.f, 0.f};
#pragma unroll
                    for (int pr = 0; pr < 6; ++pr) o = MFMA16(pf[pr][qb], vf[pr], o);
#pragma unroll
                    for (int j = 0; j < 4; ++j) { const int q = qhalf * 32 + qb * 16 + quad * 4 + j;
                        if (!sample || q < 32) { const int row = sample ? MP + b * 32 + q : b * 4096 + c * 64 + q; ycat[(size_t)row * 1024 + 512 + head * 64 + db * 16 + fr] = (bf16)f2bf(o[j]); } } } }
        }
    }
    __syncthreads();
}

__device__ __forceinline__ void xattn_phase(const bf16* qx, const bf16* memk_l, const bf16* memvT_l, bf16* ox, int wave, int lane, int G) {
    const int fr = lane & 15, quad = lane >> 4;
    for (int t = wave * G + (int)blockIdx.x; t < 4160; t += 8 * G) {
        int bb, h, row0;
        if (t < 4096) { const int pair = t >> 8; bb = pair >> 2; h = pair & 3; row0 = bb * 4096 + (t & 255) * 16; }
        else { const int s = t - 4096, b = s >> 3; h = (s >> 1) & 3; bb = 4 + b; row0 = MP + b * 32 + (s & 1) * 16; }
        bf16x8 qf[8];
#pragma unroll
        for (int ks = 0; ks < 8; ++ks) qf[ks] = *(const bf16x8*)(qx + (size_t)(row0 + fr) * 1024 + h * 256 + ks * 32 + quad * 8);
        const bf16* kbase = memk_l + (size_t)bb * 262144 + h * 256 + quad * 8;
        f32x4 s[16];
#pragma unroll
        for (int kb = 0; kb < 16; ++kb) { const int key = 32 * (kb >> 1) + (fr >> 2) * 8 + 4 * (kb & 1) + (fr & 3); const bf16* kp = kbase + (size_t)key * 1024; f32x4 a = {0.f, 0.f, 0.f, 0.f};
#pragma unroll
            for (int ks = 0; ks < 8; ++ks) a = MFMA16(*(const bf16x8*)(kp + ks * 32), qf[ks], a);
            s[kb] = a; }
        float mx = -1e30f;
#pragma unroll
        for (int kb = 0; kb < 16; ++kb)
#pragma unroll
            for (int j = 0; j < 4; ++j) mx = fmaxf(mx, s[kb][j]);
        mx = fmaxf(mx, __shfl_xor(mx, 16)); mx = fmaxf(mx, __shfl_xor(mx, 32));
        float sum = 0.f;
#pragma unroll
        for (int kb = 0; kb < 16; ++kb)
#pragma unroll
            for (int j = 0; j < 4; ++j) { const float e = __expf(s[kb][j] - mx); s[kb][j] = e; sum += e; }
        sum += __shfl_xor(sum, 16); sum += __shfl_xor(sum, 32);
        const float inv = 1.0f / sum;
        bf16x8 pf[8];
#pragma unroll
        for (int pr = 0; pr < 8; ++pr) pf[pr] = __builtin_bit_cast(bf16x8, pack8(s[2 * pr] * inv, s[2 * pr + 1] * inv));
        const bf16* vbase = memvT_l + (size_t)bb * 262144 + (size_t)(h * 256 + fr) * 256 + quad * 8;
#pragma unroll 4
        for (int db = 0; db < 16; ++db) { f32x4 o = {0.f, 0.f, 0.f, 0.f};
#pragma unroll
            for (int pr = 0; pr < 8; ++pr) o = MFMA16(pf[pr], *(const bf16x8*)(vbase + (size_t)db * 4096 + pr * 32), o);
#pragma unroll
            for (int j = 0; j < 4; ++j) ox[(size_t)(row0 + quad * 4 + j) * 1024 + h * 256 + db * 16 + fr] = (bf16)f2bf(o[j]); }
    }
}

__device__ __forceinline__ void s5_stage_u(const bf16* up, LAS float* ubuf, int lane) {
    const v4u w0 = *(const v4u*)up, w1 = *(const v4u*)(up + 8);
    LAS f32x4* d = (LAS f32x4*)(ubuf + lane * 16);
    d[0] = (f32x4){bflo(w0.x), bfhi(w0.x), bflo(w0.y), bfhi(w0.y)}; d[1] = (f32x4){bflo(w0.z), bfhi(w0.z), bflo(w0.w), bfhi(w0.w)};
    d[2] = (f32x4){bflo(w1.x), bfhi(w1.x), bflo(w1.y), bfhi(w1.y)}; d[3] = (f32x4){bflo(w1.z), bfhi(w1.z), bflo(w1.w), bfhi(w1.w)};
}
#define S5_STEP(sidx) do { const LAS f32x4* up_ = (const LAS f32x4*)(ubuf + (sidx) * 16); const f32x4 u0 = up_[0], u1 = up_[1], u2 = up_[2], u3 = up_[3]; \
    float br = 0.f, bi = 0.f; \
    br += bb[0][0] * u0[0] + bb[0][2] * u0[1]; bi += bb[0][1] * u0[0] + bb[0][3] * u0[1]; br += bb[1][0] * u0[2] + bb[1][2] * u0[3]; bi += bb[1][1] * u0[2] + bb[1][3] * u0[3]; \
    br += bb[2][0] * u1[0] + bb[2][2] * u1[1]; bi += bb[2][1] * u1[0] + bb[2][3] * u1[1]; br += bb[3][0] * u1[2] + bb[3][2] * u1[3]; bi += bb[3][1] * u1[2] + bb[3][3] * u1[3]; \
    br += bb[4][0] * u2[0] + bb[4][2] * u2[1]; bi += bb[4][1] * u2[0] + bb[4][3] * u2[1]; br += bb[5][0] * u2[2] + bb[5][2] * u2[3]; bi += bb[5][1] * u2[2] + bb[5][3] * u2[3]; \
    br += bb[6][0] * u3[0] + bb[6][2] * u3[1]; bi += bb[6][1] * u3[0] + bb[6][3] * u3[1]; br += bb[7][0] * u3[2] + bb[7][2] * u3[3]; bi += bb[7][1] * u3[2] + bb[7][3] * u3[3]; \
    const float nr_ = ar * hr - ai * hi + br, ni_ = ar * hi + ai * hr + bi; hr = nr_; hi = ni_; } while (0)

__device__ __forceinline__ void s5_local(const bf16* proj, const float* abar, const float* bbar, float* sloc, LAS float* ubuf, int slot, int nslots, int lane) {
    for (int t = slot; t < 8192; t += nslots) {
        const int chunk = t & 63, g = (t >> 6) & 31, b = t >> 11;
        s5_stage_u(proj + (size_t)(b * 4096 + chunk * 64 + lane) * 1280 + g * 16, ubuf, lane);
        const float ar = abar[(g * 64 + lane) * 2], ai = abar[(g * 64 + lane) * 2 + 1];
        f32x4 bb[8];
#pragma unroll
        for (int i = 0; i < 8; ++i) bb[i] = *(const f32x4*)(bbar + (size_t)(g * 64 + lane) * 32 + i * 4);
        float hr = 0.f, hi = 0.f;
#pragma unroll 4
        for (int s = 0; s < 64; ++s) S5_STEP(s);
        *(f32x2v*)(sloc + (size_t)t * 128 + lane * 2) = (f32x2v){hr, hi};
    }
}
__device__ __forceinline__ void s5_out(const bf16* proj, const float* abar, const float* bbar, const float* sloc, const float* st_re, const float* st_im, const float* c_re, const float* c_im,
                                       const float* dcoef, bf16* gbuf, float* out, LAS float* ubuf, LAS unsigned* hbuf, int slot, int nslots, int lane) {
    const int fr = lane & 15, quad = lane >> 4;
    for (int t = slot; t < 8192 + 256; t += nslots) {
        const int sample = t >= 8192; int b, g, chunk, nblk, rowbase;
        if (!sample) { chunk = t & 63; g = (t >> 6) & 31; b = t >> 11; nblk = 4; rowbase = b * 4096 + chunk * 64; } else { const int s = t - 8192; g = s & 31; b = s >> 5; chunk = 0; nblk = 2; rowbase = MP + b * 32; }
        if (lane < nblk * 16) s5_stage_u(proj + (size_t)(rowbase + lane) * 1280 + g * 16, ubuf, lane);
        const float ar = abar[(g * 64 + lane) * 2], ai = abar[(g * 64 + lane) * 2 + 1];
        f32x4 bb[8];
#pragma unroll
        for (int i = 0; i < 8; ++i) bb[i] = *(const f32x4*)(bbar + (size_t)(g * 64 + lane) * 32 + i * 4);
        float hr, hi;
        if (!sample) { float pr = ar, pi = ai;
#pragma unroll
            for (int i = 0; i < 6; ++i) { const float t1 = pr * pr - pi * pi; pi = 2.f * pr * pi; pr = t1; }
            hr = 0.f; hi = 0.f; const float* sp = sloc + (size_t)(t - chunk) * 128 + lane * 2;
            for (int cc = 0; cc < chunk; ++cc) { const f32x2v sv = *(const f32x2v*)(sp + (size_t)cc * 128); const float nr = pr * hr - pi * hi + sv.x, ni = pr * hi + pi * hr + sv.y; hr = nr; hi = ni; } }
        else { hr = st_re[(b * 32 + g) * 64 + lane]; hi = st_im[(b * 32 + g) * 64 + lane]; }
        bf16x8 cf[4];
#pragma unroll
        for (int ks = 0; ks < 4; ++ks) { const f32x4 cr = *(const f32x4*)(c_re + (size_t)(g * 16 + fr) * 64 + ks * 16 + quad * 4), ci = *(const f32x4*)(c_im + (size_t)(g * 16 + fr) * 64 + ks * 16 + quad * 4);
            v4u w; w.x = pg8::cvt_pk_bf16(cr[0], -ci[0]); w.y = pg8::cvt_pk_bf16(cr[1], -ci[1]); w.z = pg8::cvt_pk_bf16(cr[2], -ci[2]); w.w = pg8::cvt_pk_bf16(cr[3], -ci[3]); cf[ks] = __builtin_bit_cast(bf16x8, w); }
        const float dco = dcoef[g * 16 + fr];
        for (int blk = 0; blk < nblk; ++blk) {
#pragma unroll 4
            for (int s = 0; s < 16; ++s) { S5_STEP(blk * 16 + s); hbuf[s * 68 + lane] = pg8::cvt_pk_bf16(hr, hi); }
            f32x4 y = {0.f, 0.f, 0.f, 0.f};
#pragma unroll
            for (int ks = 0; ks < 4; ++ks) { const bf16x8 a = *(const LAS bf16x8*)(hbuf + fr * 68 + ks * 16 + quad * 4); y = MFMA16(a, cf[ks], y); }
#pragma unroll
            for (int j = 0; j < 4; ++j) { const int s = blk * 16 + quad * 4 + j; const float uu = ubuf[s * 16 + fr]; const float yv = y[j] + dco * uu;
                const float z = 0.7978845608028654f * (yv + 0.044715f * yv * yv * yv); const float th = 1.0f - 2.0f / (1.0f + __expf(2.0f * z)); const float gl = 0.5f * yv * (1.0f + th);
                gbuf[(size_t)(rowbase + s) * 512 + g * 16 + fr] = (bf16)f2bf(gl); }
        }
        if (!sample && chunk == 63) { out[OFF_SRP + (b * 32 + g) * 64 + lane] = hr; out[OFF_SIP + (b * 32 + g) * 64 + lane] = hi; }
        if (sample) { out[OFF_SRS + (b * 32 + g) * 64 + lane] = hr; out[OFF_SIS + (b * 32 + g) * 64 + lane] = hi; }
    }
}

struct Params { const float* in[36]; float* out; unsigned char* ws; int use_cg, pad; };

__global__ void __launch_bounds__(512, 2) mega_fwd(Params P) {
    extern __shared__ __attribute__((aligned(16))) unsigned char lds_raw[];
    LAS unsigned char* lds = (LAS unsigned char*)lds_raw;
    volatile LAS unsigned* MISC = (volatile LAS unsigned*)(lds + MISC_OFF);
    const int G = gridDim.x, NGW = G * 8, NT = G * 512;
    unsigned char* ws = P.ws; float* out = P.out;
    for (int u = threadIdx.x; u < (LDS_BYTES - 131072) / 4; u += 512) ((LAS unsigned*)(lds + 131072))[u] = 0u;
    __syncthreads();
    XcdBarrier bar = xcd_barrier_post((unsigned*)(ws + WS_BAR), MISC + 8);
#ifndef STOP_AFTER
#define STOP_AFTER 1000
#endif
    int ph = 0;
#define RUN (ph < STOP_AFTER)
#define FRESH() const int tid = fresh_tid(), lane = tid & 63, wave = __builtin_amdgcn_readfirstlane(tid >> 6); const int gw = blockIdx.x * 8 + wave, gt = blockIdx.x * 512 + tid; (void)gw; (void)gt; (void)lane; LAS float* wscr = (LAS float*)(lds + 32768 + wave * 12288); (void)wscr;
#define SEAM() do { if (P.use_cg) cg::this_grid().sync(); else xcd_barrier(bar); ++ph; } while (0)

    float* part = (float*)(ws + WS_PART);
#define PARTBUF(k) (part + (size_t)((k) & 1) * PART_ELEMS)
    float* ropec = (float*)(ws + WS_ROPE); float* ropes = ropec + 4096 * 32;
    float* abar = (float*)(ws + WS_SSM); float* bbar = abar + 32 * 64 * 2;
    bf16* ckb = (bf16*)(ws + WS_CKV); bf16* cvb = ckb + 8 * 128 * 128;
    float* sloc = (float*)(ws + WS_SLOC);
    bf16* memk = (bf16*)(ws + WS_MEMK); bf16* memvT = (bf16*)(ws + WS_MEMVT);
    float* SG = (float*)(ws + WS_SIDE); float* SV = (float*)(ws + WS_SIDE + SG_BYTES);
    bf16* WT = (bf16*)(ws + WS_WT); bf16* xb = (bf16*)(ws + WS_XB); unsigned char* tmp = ws + WS_TMP;
    bf16* proj0 = (bf16*)(tmp + TMP_PROJ0); bf16* gbuf = (bf16*)(tmp + TMP_GBUF); bf16* ycat = (bf16*)(tmp + TMP_YCAT); bf16* memb = (bf16*)(tmp + TMP_MEMB);
    bf16* qx = (bf16*)(tmp + TMP_QX); bf16* ox = (bf16*)(tmp + TMP_OX); bf16* act = (bf16*)(tmp + TMP_ACT); bf16* gbm = (bf16*)(tmp + TMP_GB); bf16* zc = (bf16*)(tmp + TMP_ZC);

    if (RUN) { FRESH()
        {
            constexpr int NITEMS = 640 + 128 + 512 + 2 * 512 + 2 * 1024 + 2 * 512 + 2 * 2816 + 2 * 1408 + 1536 + 512 + 2048;
            for (int it = gw; it < NITEMS; it += NGW) { int r = it;
#define TR(Wp, K_, N_, WTp, gainp, sc, mode) { const int ni_ = ((K_) / 64) * ((N_) / 32); if (r < ni_) { tr_item(Wp, K_, N_, WTp, gainp, sc, mode, wscr, r, lane); continue; } r -= ni_; }
                TR(P.in[15], 1024, 1280, WT + WT_INEVEN, P.in[11], 1.f, 1)
                TR(P.in[25], 512, 512, WT + WT_GLU, nullptr, 1.f, 0)
                TR(P.in[16], 1024, 1024, WT + WT_OUTEVEN, nullptr, 1.f, 0)
                TR(P.in[30], 1024, 1024, WT + WT_WQ, P.in[12], 0.0625f, 0)
                TR(P.in[30] + 1048576, 1024, 1024, WT + WT_WQ + 1048576, P.in[12] + 1024, 0.0625f, 0)
                TR(P.in[31], 1024, 2048, WT + WT_WKV, nullptr, 1.f, 0)
                TR(P.in[31] + 2097152, 1024, 2048, WT + WT_WKV + 2097152, nullptr, 1.f, 0)
                TR(P.in[32], 1024, 1024, WT + WT_WO, nullptr, 1.f, 0)
                TR(P.in[32] + 1048576, 1024, 1024, WT + WT_WO + 1048576, nullptr, 1.f, 0)
                TR(P.in[33], 1024, 5632, WT + WT_UP, P.in[13], 1.f, 2)
                TR(P.in[33] + (size_t)1024 * 5632, 1024, 5632, WT + WT_UP + (size_t)5632 * 1024, P.in[13] + 1024, 1.f, 2)
                TR(P.in[35], 2816, 1024, WT + WT_DOWN, nullptr, 1.f, 0)
                TR(P.in[35] + (size_t)2816 * 1024, 2816, 1024, WT + WT_DOWN + (size_t)2816 * 1024, nullptr, 1.f, 0)
                TR(P.in[27], 1024, 3072, WT + WT_INODD, P.in[11] + 1024, 1.f, 3)
                TR(P.in[29], 1024, 1024, WT + WT_OUTODD, nullptr, 1.f, 0)
                { const int mi = r >> 7, l = mi >> 3, b = mi & 7; tr_item(P.in[10] + (size_t)mi * 262144, 256, 1024, memvT + (size_t)(l * 12 + 4 + b) * 262144, nullptr, 1.f, 0, wscr, r & 127, lane); }
            }
        }
        for (int m = gw; m < MROWS; m += NGW) { const float* xr = m < MP ? P.in[0] + (size_t)m * 1024 : P.in[1] + (size_t)(m - MP) * 1024; float ss = 0.f;
#pragma unroll
            for (int j = 0; j < 4; ++j) { const f32x4 v = *(const f32x4*)(xr + (lane + 64 * j) * 4); ss += (v[0] * v[0] + v[1] * v[1]) + (v[2] * v[2] + v[3] * v[3]);
                u32x2v w; w.x = pg8::cvt_pk_bf16(v[0], v[1]); w.y = pg8::cvt_pk_bf16(v[2], v[3]); *(u32x2v*)(xb + (size_t)m * 1024 + (lane + 64 * j) * 4) = w; }
            ss = wave_sum(ss); if (lane < 16) PARTBUF(0)[(size_t)m * 16 + lane] = lane == 0 ? ss : 0.f; }
        for (int i = gt; i < 262144; i += NT) { const f32x4 v = *(const f32x4*)(P.in[2] + (size_t)i * 4); u32x2v w; w.x = pg8::cvt_pk_bf16(v[0], v[1]); w.y = pg8::cvt_pk_bf16(v[2], v[3]); *(u32x2v*)(memb + (size_t)i * 4) = w; }
        for (int i = gt; i < 1048576; i += NT) { const size_t e = (size_t)i * 4; const int lb = (int)(e >> 18), l = lb >> 3, b = lb & 7; const f32x4 v = *(const f32x4*)(P.in[9] + e);
            u32x2v w; w.x = pg8::cvt_pk_bf16(v[0], v[1]); w.y = pg8::cvt_pk_bf16(v[2], v[3]); *(u32x2v*)(memk + (size_t)(l * 12 + 4 + b) * 262144 + (e & 262143)) = w; }
        for (int i = gt; i < 65536; i += NT) { const int j = i & 32767; const float* src = (i < 32768 ? P.in[3] : P.in[4]) + (size_t)j * 4; bf16* dst = (i < 32768 ? ckb : cvb) + (size_t)j * 4;
            const f32x4 v = *(const f32x4*)src; u32x2v w; w.x = pg8::cvt_pk_bf16(v[0], v[1]); w.y = pg8::cvt_pk_bf16(v[2], v[3]); *(u32x2v*)dst = w; }
        for (int i = gt; i < 4096 * 32; i += NT) { const int pos = i >> 5, d = i & 31; const double inv = dexp_(-(double)d * (9.210340371976184 / 32.0)); double s, c; dsincos_((double)pos * inv, s, c); ropec[i] = (float)c; ropes[i] = (float)s; }
        for (int i = gt; i < 2048; i += NT) { const double are = P.in[17][i], aim = P.in[18][i], dt = dexp_((double)P.in[19][i]); double s, c; dsincos_(aim * dt, s, c); const double mag = dexp_(are * dt);
            const double br = mag * c, bi = mag * s; abar[2 * i] = (float)br; abar[2 * i + 1] = (float)bi;
            const double nr = br - 1.0, ni = bi, den = are * are + aim * aim; const double qr = (nr * are + ni * aim) / den, qi = (ni * are - nr * aim) / den;
#pragma unroll 4
            for (int h = 0; h < 16; ++h) { const double xr = P.in[20][(size_t)i * 16 + h], xi = P.in[21][(size_t)i * 16 + h]; bbar[(size_t)i * 32 + 2 * h] = (float)(qr * xr - qi * xi); bbar[(size_t)i * 32 + 2 * h + 1] = (float)(qr * xi + qi * xr); } }
    }
    SEAM();
    if (RUN) {
        { pg8::Gemm g{memb, WT + WT_WKV, 1024, 4096, 1024}; pg8::StaticOrder S; S.init(1024, 4096, G, (int)blockIdx.x); EpiKV E{out, memk};
          pg8::gemm_phase<EpiKV, pg8::StaticOrder, true, true>(lds, g, S, E); }
        { pg8::Gemm g{xb, WT + WT_INEVEN, MROWS, 1280, 1024}; pg8::StaticOrder S; S.init(MROWS, 1280, G, (int)blockIdx.x); EpiIn0 E{proj0, PARTBUF(0), ropec, ropes, out};
          pg8::gemm_phase<EpiIn0, pg8::StaticOrder, true, true>(lds, g, S, E); }
    }
    SEAM();
    if (RUN) { FRESH()
        swa_phase(proj0, ckb, cvb, P.in[26], ycat, lds, tid, wave, lane, G);
        s5_local(proj0, abar, bbar, sloc, wscr, wave * G + (int)blockIdx.x, NGW, lane);
        for (int it = wave * G + (int)blockIdx.x; it < 1024; it += NGW) { const int mi = it >> 7, l = mi >> 2, b = mi & 3;
            tr_item(out + OFF_MVP + (size_t)mi * 262144, 256, 1024, memvT + (size_t)(l * 12 + b) * 262144, nullptr, 1.f, 0, wscr, it & 127, lane); }
    }
    SEAM();
    if (RUN) { FRESH() s5_out(proj0, abar, bbar, sloc, P.in[5], P.in[6], P.in[22], P.in[23], P.in[24], gbuf, out, wscr, (LAS unsigned*)(wscr + 1024), wave * G + (int)blockIdx.x, NGW, lane); }
    SEAM();
    if (RUN) { pg8::Gemm g{gbuf, WT + WT_GLU, MROWS, 512, 512}; pg8::StaticOrder S; S.init(MROWS, 512, G, (int)blockIdx.x); EpiGlu E{gbuf, ycat};
        pg8::gemm_phase<EpiGlu, pg8::StaticOrder, true, true>(lds, g, S, E); }
    SEAM();

    for (int l = 0; l < 2; ++l) {
        if (l == 1) {
            if (RUN) { pg8::Gemm g{xb, WT + WT_INODD, MROWS, 3072, 1024}; pg8::StaticOrder S; S.init(MROWS, 3072, G, (int)blockIdx.x); EpiInOdd E{gbm, zc, PARTBUF(3), P.in[28], SG};
                pg8::gemm_phase<EpiInOdd, pg8::StaticOrder, true, true>(lds, g, S, E); }
            SEAM();
            if (RUN) { FRESH()
                const float* cw = P.in[28]; const float* st = P.in[7];
                for (int i = gt; i < MROWS * 128; i += NT) { const int row = i >> 7, c0 = (i & 127) * 8, blk = row >> 6, r = row & 63;
                    const bool smp = row >= MP; const int rr = smp ? (r & 31) : r;
                    f32x4 z0, z1;
                    if (rr < 2) { const int sb = smp ? (r >> 5) * 4 : 0;
                        f32x4 pa0, pa1, pb0, pb1;
                        if (smp) { const int b = (blk - 256) * 2 + (r >> 5); const float* s0 = st + (size_t)(b * 2) * 1024 + c0; pa0 = *(const f32x4*)s0; pa1 = *(const f32x4*)(s0 + 4); pb0 = *(const f32x4*)(s0 + 1024); pb1 = *(const f32x4*)(s0 + 1028); }
                        else if ((blk & 63) == 0) { pa0 = pa1 = pb0 = pb1 = (f32x4){0.f, 0.f, 0.f, 0.f}; }
                        else { const float* s0 = SG + (size_t)((blk - 1) * 8 + 6) * 1024 + c0; pa0 = *(const f32x4*)s0; pa1 = *(const f32x4*)(s0 + 4); pb0 = *(const f32x4*)(s0 + 1024); pb1 = *(const f32x4*)(s0 + 1028); }
                        const float* sc = SG + (size_t)(blk * 8 + sb) * 1024 + c0; const f32x4 x00 = *(const f32x4*)sc, x01 = *(const f32x4*)(sc + 4);
                        f32x4 xm2a, xm2b, xm1a, xm1b, xca, xcb;
                        if (rr == 0) { xm2a = pa0; xm2b = pa1; xm1a = pb0; xm1b = pb1; xca = x00; xcb = x01; }
                        else { xm2a = pb0; xm2b = pb1; xm1a = x00; xm1b = x01; xca = *(const f32x4*)(sc + 1024); xcb = *(const f32x4*)(sc + 1028); }
                        const f32x4 w0a = *(const f32x4*)(cw + c0), w0b = *(const f32x4*)(cw + c0 + 4), w1a = *(const f32x4*)(cw + 1024 + c0), w1b = *(const f32x4*)(cw + 1028 + c0), w2a = *(const f32x4*)(cw + 2048 + c0), w2b = *(const f32x4*)(cw + 2052 + c0);
                        z0 = w0a * xm2a + w1a * xm1a + w2a * xca; z1 = w0b * xm2b + w1b * xm1b + w2b * xcb; }
                    else { const v4u zw = *(const v4u*)(zc + (size_t)row * 1024 + c0); z0 = (f32x4){bflo(zw.x), bfhi(zw.x), bflo(zw.y), bfhi(zw.y)}; z1 = (f32x4){bflo(zw.z), bfhi(zw.z), bflo(zw.w), bfhi(zw.w)}; }
                    const v4u gw_ = *(const v4u*)(gbm + (size_t)row * 1024 + c0);
                    const f32x4 g0 = (f32x4){bflo(gw_.x), bfhi(gw_.x), bflo(gw_.y), bfhi(gw_.y)}, g1 = (f32x4){bflo(gw_.z), bfhi(gw_.z), bflo(gw_.w), bfhi(gw_.w)};
                    *(v4u*)(gbm + (size_t)row * 1024 + c0) = pack8(g0 * z0, g1 * z1); }
                for (int i = gt; i < 4 * 2 * 1024; i += NT) { const int c = i & 1023, j = (i >> 10) & 1, b = i >> 11; out[OFF_CMP + i] = SG[(size_t)((64 * b + 63) * 8 + 6 + j) * 1024 + c]; }
                for (int i = gt; i < 8 * 2 * 1024; i += NT) { const int c = i & 1023, j = (i >> 10) & 1, b = i >> 11; out[OFF_CMS + i] = SG[(size_t)((256 + (b >> 1)) * 8 + (b & 1) * 4 + 2 + j) * 1024 + c]; }
            }
            SEAM();
        }
        if (RUN) { pg8::Gemm g{l == 0 ? ycat : gbm, WT + (l == 0 ? WT_OUTEVEN : WT_OUTODD), MROWS, 1024, 1024}; pg8::StaticOrder S; S.init(MROWS, 1024, G, (int)blockIdx.x);
            EpiRes E{l == 0 ? P.in[0] : out, l == 0 ? P.in[1] - (size_t)MP * 1024 : out, out, xb, PARTBUF(l == 0 ? 1 : 4)};
            pg8::gemm_phase<EpiRes, pg8::StaticOrder, true, true>(lds, g, S, E); }
        SEAM();
        if (RUN) { pg8::Gemm g{xb, WT + WT_WQ + (size_t)l * 1048576, MROWS, 1024, 1024}; pg8::StaticOrder S; S.init(MROWS, 1024, G, (int)blockIdx.x); EpiBf16 E{qx, 1024, PARTBUF(l == 0 ? 1 : 4)};
            pg8::gemm_phase<EpiBf16, pg8::StaticOrder, true, true>(lds, g, S, E); }
        SEAM();
        if (RUN) { FRESH() xattn_phase(qx, memk + (size_t)l * 12 * 262144, memvT + (size_t)l * 12 * 262144, ox, wave, lane, G); }
        SEAM();
        if (RUN) { pg8::Gemm g{ox, WT + WT_WO + (size_t)l * 1048576, MROWS, 1024, 1024}; pg8::StaticOrder S; S.init(MROWS, 1024, G, (int)blockIdx.x); EpiRes E{out, out, out, xb, PARTBUF(l == 0 ? 2 : 5)};
            pg8::gemm_phase<EpiRes, pg8::StaticOrder, true, true>(lds, g, S, E); }
        SEAM();
        if (RUN) { pg8::Gemm g{xb, WT + WT_UP + (size_t)l * 5632 * 1024, MROWS, 5632, 1024}; pg8::StaticOrder S; S.init(MROWS, 5632, G, (int)blockIdx.x);
            EpiFfnUp E{act, PARTBUF(l == 0 ? 2 : 5), P.in[34] + (size_t)l * 3 * DFF, SG, SV};
            pg8::gemm_phase<EpiFfnUp, pg8::StaticOrder, true, true>(lds, g, S, E); }
        SEAM();
        if (RUN) { FRESH()
            const float* cw = P.in[34] + (size_t)l * 3 * DFF; const float* st = P.in[8] + (size_t)l * 8 * 2 * DFF;
            for (int i = gt; i < 528 * 352; i += NT) { const int fi = i / 352, c0 = (i % 352) * 8; int blk, row, rr, sb, vb; bool smp = fi >= 512;
                if (!smp) { blk = fi >> 1; rr = fi & 1; row = blk * 64 + rr; sb = 0; vb = 0; } else { const int s = fi - 512, half = (s >> 1) & 1; blk = 256 + (s >> 2); rr = s & 1; row = blk * 64 + half * 32 + rr; sb = half * 4; vb = half * 2; }
                f32x4 pa0, pa1, pb0, pb1;
                if (smp) { const int b = (blk - 256) * 2 + (sb >> 2); const float* s0 = st + (size_t)(b * 2) * DFF + c0; pa0 = *(const f32x4*)s0; pa1 = *(const f32x4*)(s0 + 4); pb0 = *(const f32x4*)(s0 + DFF); pb1 = *(const f32x4*)(s0 + DFF + 4); }
                else if ((blk & 63) == 0) { pa0 = pa1 = pb0 = pb1 = (f32x4){0.f, 0.f, 0.f, 0.f}; }
                else { const float* s0 = SG + (size_t)((blk - 1) * 8 + 6) * DFF + c0; pa0 = *(const f32x4*)s0; pa1 = *(const f32x4*)(s0 + 4); pb0 = *(const f32x4*)(s0 + DFF); pb1 = *(const f32x4*)(s0 + DFF + 4); }
                const float* sc = SG + (size_t)(blk * 8 + sb) * DFF + c0; const f32x4 x00 = *(const f32x4*)sc, x01 = *(const f32x4*)(sc + 4);
                f32x4 xm2a, xm2b, xm1a, xm1b, xca, xcb;
                if (rr == 0) { xm2a = pa0; xm2b = pa1; xm1a = pb0; xm1b = pb1; xca = x00; xcb = x01; }
                else { xm2a = pb0; xm2b = pb1; xm1a = x00; xm1b = x01; xca = *(const f32x4*)(sc + DFF); xcb = *(const f32x4*)(sc + DFF + 4); }
                const f32x4 w0a = *(const f32x4*)(cw + c0), w0b = *(const f32x4*)(cw + c0 + 4), w1a = *(const f32x4*)(cw + DFF + c0), w1b = *(const f32x4*)(cw + DFF + c0 + 4), w2a = *(const f32x4*)(cw + 2 * DFF + c0), w2b = *(const f32x4*)(cw + 2 * DFF + c0 + 4);
                const f32x4 ga = w0a * xm2a + w1a * xm1a + w2a * xca, gb_ = w0b * xm2b + w1b * xm1b + w2b * xcb;
                const float* sv = SV + (size_t)(blk * 4 + vb + rr) * DFF + c0; const f32x4 va = *(const f32x4*)sv, vb_ = *(const f32x4*)(sv + 4);
                f32x4 a0, a1;
#pragma unroll
                for (int j = 0; j < 4; ++j) { a0[j] = ga[j] * sigmoidf_(ga[j]) * va[j]; a1[j] = gb_[j] * sigmoidf_(gb_[j]) * vb_[j]; }
                *(v4u*)(act + (size_t)row * DFF + c0) = pack8(a0, a1); }
            for (int i = gt; i < 4 * 2 * DFF; i += NT) { const int c = i % DFF, j = (i / DFF) & 1, b = i / (2 * DFF); out[OFF_CFP + (size_t)l * 4 * 2 * DFF + i] = SG[(size_t)((64 * b + 63) * 8 + 6 + j) * DFF + c]; }
            for (int i = gt; i < 8 * 2 * DFF; i += NT) { const int c = i % DFF, j = (i / DFF) & 1, b = i / (2 * DFF); out[OFF_CFS + (size_t)l * 8 * 2 * DFF + i] = SG[(size_t)((256 + (b >> 1)) * 8 + (b & 1) * 4 + 2 + j) * DFF + c]; }
        }
        SEAM();
        if (RUN) { pg8::Gemm g{act, WT + WT_DOWN + (size_t)l * 2816 * 1024, MROWS, 1024, DFF}; pg8::StaticOrder S; S.init(MROWS, 1024, G, (int)blockIdx.x); EpiRes E{out, out, out, xb, PARTBUF(l == 0 ? 3 : 6)};
            pg8::gemm_phase<EpiRes, pg8::StaticOrder, true, true>(lds, g, S, E); }
        SEAM();
    }
    if (RUN) { FRESH()
        const float* gf = P.in[14];
        for (int m = gw; m < MROWS; m += NGW) { const float rs = rstd_of(PARTBUF(6), m); float* xr = out + (size_t)m * 1024;
#pragma unroll
            for (int j = 0; j < 4; ++j) { const int c = (lane + 64 * j) * 4; const f32x4 v = *(const f32x4*)(xr + c), gg = *(const f32x4*)(gf + c); *(f32x4*)(xr + c) = v * rs * gg; } }
    }
}

extern "C" void kernel_launch(void* const* d_in, const int* in_sizes, int n_in, void* d_out, int out_size, void* d_ws, size_t ws_size, hipStream_t stream) {
    static int grid = 0;
    if (grid == 0) {
        int dev = 0, cus = 0, per_cu = 0;
        if (n_in != 36 || ws_size < 256 * MiB) { fprintf(stderr, "kernel_launch: unexpected n_in %d / ws %zu\n", n_in, ws_size); grid = -1; return; }
        (void)hipGetDevice(&dev); (void)hipDeviceGetAttribute(&cus, hipDeviceAttributeMultiprocessorCount, dev);
        if (hipFuncSetAttribute((const void*)mega_fwd, hipFuncAttributeMaxDynamicSharedMemorySize, LDS_BYTES) != hipSuccess) { fprintf(stderr, "kernel_launch: hipFuncSetAttribute failed\n"); grid = -1; return; }
        if (hipOccupancyMaxActiveBlocksPerMultiprocessor(&per_cu, (const void*)mega_fwd, 512, LDS_BYTES) != hipSuccess || per_cu < 1) per_cu = 1;
        (void)hipGetLastError();
        grid = cus * 1;
        if (grid > 256) grid = 256;
    }
    if (grid < 0) return;
    (void)hipMemsetAsync(d_ws, 0, CTL_ZERO_BYTES, stream);
    Params p{};
    for (int i = 0; i < 36; ++i) p.in[i] = (const float*)d_in[i];
    p.out = (float*)d_out; p.ws = (unsigned char*)d_ws; p.use_cg = 0; p.pad = 0;
    void* args[] = {&p};
    hipError_t e = hipLaunchCooperativeKernel((const void*)mega_fwd, dim3(grid), dim3(512), args, LDS_BYTES, stream);
    if (e != hipSuccess) fprintf(stderr, "cooperative launch failed: %s (grid %d)\n", hipGetErrorString(e), grid);
}
```

```cpp
#include <hip/hip_runtime.h>
#include <hip/hip_cooperative_groups.h>
#include <cstdio>
#include <cstdint>
namespace cg = cooperative_groups;
__device__ __forceinline__ int fresh_tid(int wave_s) { unsigned z = 0u; asm volatile("" : "+s"(z)); int t = wave_s * 64 + (int)__builtin_amdgcn_mbcnt_hi(~0u, __builtin_amdgcn_mbcnt_lo(~0u, z)); asm volatile("" : "+v"(t)); return t; }
namespace pg8 {
#define PG8_LAS __attribute__((address_space(3)))
typedef unsigned short bf16_t;
typedef short bf16x8 __attribute__((ext_vector_type(8)));
typedef float f32x4 __attribute__((ext_vector_type(4)));
typedef unsigned u32x4 __attribute__((ext_vector_type(4)));
constexpr int BM = 256, BK = 64, HALF = 128, HTB = HALF * BK * 2  , STAGE_BYTES = 8 * HTB, NXCD = 8, WGM = 8;

__host__ __device__ __forceinline__ int lds_byte(int r, int c) { const int st = (r >> 4) * 2 + (c >> 5), rr = r & 15, cc = c & 31, ob = rr * 64 + cc * 2; return st * 1024 + (ob ^ (((ob >> 9) & 1) << 5)); }
__host__ __device__ __forceinline__ void stage_rc(int b, int& R, int& C) { const int st = b / 1024, sb = b % 1024, swz = sb ^ (((sb >> 9) & 1) << 5); R = (st >> 1) * 16 + swz / 64; C = (st & 1) * 32 + (swz % 64) / 2; }
__host__ __device__ __forceinline__ int perm32(int rho) { const int n = rho >> 4, i = rho & 15; return 8 * (i >> 2) + 4 * n + (i & 3); }

struct Unit { int pm, pn; };
struct Gemm { const bf16_t* A; const bf16_t* Bt; int M, N, K; };

template <bool FULL> struct StaticOrderT {
    int nM, nN, nwg, G, c;
    __host__ __device__ void init(int M, int N, int G_, int c_) { nM = M / BM; nN = N / BM; nwg = nM * nN; G = G_; c = c_; }
    __host__ __device__ bool next(int i, Unit& u) const {
        const long L = (long)i * G + c; if (!(FULL && i == 0) && L >= nwg) return false;
        int wgid = (int)L; { const int q = nwg / NXCD, r = nwg % NXCD, xcd = wgid % NXCD, off = wgid / NXCD; wgid = (xcd < r ? xcd * (q + 1) : r * (q + 1) + (xcd - r) * q) + off; }
        const int nig = WGM * nN, gid = wgid / nig, fm = gid * WGM, gsz = (nM - fm) < WGM ? (nM - fm) : WGM;
        u.pm = fm + ((wgid % nig) % gsz); u.pn = (wgid % nig) / gsz; return true;
    }
    __device__ __forceinline__ void a_ready(const Unit&) const {}
    __device__ __forceinline__ void done(const Unit&) const {}
};

typedef StaticOrderT<false> StaticOrder; typedef StaticOrderT<true> StaticOrderF;
__device__ __forceinline__ unsigned cvt_pk_bf16(float lo, float hi) { unsigned r; asm volatile("v_cvt_pk_bf16_f32 %0, %1, %2" : "=v"(r) : "v"(lo), "v"(hi)); return r; }
typedef float f32x2 __attribute__((ext_vector_type(2)));
template <class Epi, class Sched, bool ALIGN_EPI = false, bool SP2 = false>
__device__ __forceinline__ void gemm_phase(PG8_LAS unsigned char* lds, const Gemm g, const Sched& S, const Epi& E, const int wave_s) {
    const int tid = fresh_tid(wave_s), wid = __builtin_amdgcn_readfirstlane(tid >> 6), lane = tid & 63, wr = wid >> 2, wc = wid & 3, fr = lane & 15, fq = lane >> 4;
    const int K = g.K, nt = K / BK;
    unsigned voffA[2], voffB[2];
#pragma unroll
    for (int i = 0; i < 2; ++i) { int R, C; stage_rc(tid * 16 + i * 8192, R, C); const int Rb = Epi::PERM ? ((R & ~31) + perm32(R & 31)) : R;
        voffA[i] = (unsigned)(R * K + C) * 2u; voffB[i] = (unsigned)(Rb * K + C) * 2u; }
    const size_t kstep = (size_t)(BK * 2);
    const size_t hstep = (size_t)HALF * K * 2;
    const size_t tstep = 2 * hstep;
    const unsigned ldsw = (unsigned)wid * 1024u;
    const int aoff = lds_byte(wr * 64 + fr, fq * 8), boff = lds_byte(wc * 32 + fr, fq * 8);
#define PG8_SA(b, h) (((b) * 2 + (h)) * HTB)
#define PG8_SB(b, h) ((4 + (b) * 2 + (h)) * HTB)
#define PG8_STAGE(bufoff, gbase, voff) do { _Pragma("unroll") for (int _i = 0; _i < 2; ++_i) \
        __builtin_amdgcn_global_load_lds((const unsigned*)((const char*)(gbase) + (voff)[_i]), (PG8_LAS unsigned*)(lds + (bufoff) + ldsw + _i * 8192), 16, 0, 0); } while (0)
#define PG8_LDA(dst, b, h) do { _Pragma("unroll") for (int m = 0; m < 4; ++m) _Pragma("unroll") for (int k = 0; k < 2; ++k) dst[m][k] = *(const PG8_LAS bf16x8*)(lds + PG8_SA(b, h) + aoff + m * 2048 + k * 1024); } while (0)
#define PG8_LDB(dst, b, h) do { _Pragma("unroll") for (int n = 0; n < 2; ++n) _Pragma("unroll") for (int k = 0; k < 2; ++k) dst[n][k] = *(const PG8_LAS bf16x8*)(lds + PG8_SB(b, h) + boff + n * 2048 + k * 1024); } while (0)
#define PG8_MMA(ai, bj, At, Bt) do { __builtin_amdgcn_s_setprio(1); _Pragma("unroll") for (int m = 0; m < 4; ++m) _Pragma("unroll") for (int n = 0; n < 2; ++n) _Pragma("unroll") for (int k = 0; k < 2; ++k) \
        acc[ai][bj][m][n] = __builtin_amdgcn_mfma_f32_16x16x32_bf16(Bt[n][k], At[m][k], acc[ai][bj][m][n], 0, 0, 0); __builtin_amdgcn_s_setprio(0); } while (0)
#define PG8_WAIT_V(n) asm volatile("s_waitcnt vmcnt(" #n ")" ::: "memory")
#define PG8_WAIT_L(n) asm volatile("s_waitcnt lgkmcnt(" #n ")" ::: "memory")
#define PG8_BAR __builtin_amdgcn_s_barrier()
#define PG8_SCHED __builtin_amdgcn_sched_barrier(0)
    Unit cur, nxt; int ui = 0;
    if (!S.next(0, cur)) return;
    f32x4 acc[2][2][4][2];
#pragma unroll
    for (int a = 0; a < 2; ++a)
#pragma unroll
        for (int b = 0; b < 2; ++b)
#pragma unroll
            for (int m = 0; m < 4; ++m)
#pragma unroll
                for (int n = 0; n < 2; ++n) acc[a][b][m][n] = (f32x4){0.f, 0.f, 0.f, 0.f};
    bf16x8 At[4][2], B0[2][2], B1[2][2];
    const char* cA = (const char*)g.A + (size_t)cur.pm * tstep; const char* cB = (const char*)g.Bt + (size_t)cur.pn * tstep;
    S.a_ready(cur);
    if constexpr (SP2) {
        PG8_STAGE(PG8_SB(0, 0), cB, voffB); PG8_STAGE(PG8_SB(0, 1), cB + hstep, voffB); PG8_STAGE(PG8_SA(0, 0), cA, voffA); PG8_STAGE(PG8_SA(0, 1), cA + hstep, voffA);
        if (wr == 1) PG8_BAR;
        PG8_WAIT_V(2); PG8_BAR;
        PG8_STAGE(PG8_SB(1, 0), cB + kstep, voffB); PG8_STAGE(PG8_SA(1, 0), cA + kstep, voffA); PG8_STAGE(PG8_SB(1, 1), cB + hstep + kstep, voffB);
        PG8_WAIT_V(6); PG8_BAR;
    } else {
        PG8_STAGE(PG8_SB(0, 0), cB, voffB); PG8_STAGE(PG8_SA(0, 0), cA, voffA); PG8_STAGE(PG8_SB(0, 1), cB + hstep, voffB); PG8_STAGE(PG8_SA(0, 1), cA + hstep, voffA);
        if (wr == 1) PG8_BAR;
        PG8_WAIT_V(4); PG8_BAR;
        PG8_STAGE(PG8_SB(1, 0), cB + kstep, voffB); PG8_STAGE(PG8_SA(1, 0), cA + kstep, voffA); PG8_STAGE(PG8_SB(1, 1), cB + hstep + kstep, voffB);
        PG8_WAIT_V(6); PG8_BAR;
    }
    for (;;) {
        const bool has_next = S.next(ui + 1, nxt);
        const char* nA = has_next ? (const char*)g.A + (size_t)nxt.pm * tstep : cA; const char* nB = has_next ? (const char*)g.Bt + (size_t)nxt.pn * tstep : cB;
        for (int t = 0; t < nt; t += 2) {
            const bool last = (t == nt - 2);
            const char* a1 = cA + (size_t)(t + 1) * kstep;
            const char* a2 = last ? nA : cA + (size_t)(t + 2) * kstep; const char* b2 = last ? nB : cB + (size_t)(t + 2) * kstep;
            const char* a3 = a2 + kstep; const char* b3 = b2 + kstep;
            if (last && has_next) S.a_ready(nxt);
            if constexpr (SP2) {
            PG8_LDB(B0, 0, 0); PG8_LDB(B1, 0, 1); PG8_SCHED; PG8_LDA(At, 0, 0); PG8_STAGE(PG8_SA(1, 1), a1 + hstep, voffA);
            PG8_WAIT_V(8); PG8_WAIT_L(0); PG8_BAR; PG8_MMA(0, 0, At, B0); PG8_MMA(0, 1, At, B1); PG8_BAR; PG8_SCHED;
            PG8_LDA(At, 0, 1); PG8_STAGE(PG8_SB(0, 0), b2, voffB); PG8_STAGE(PG8_SB(0, 1), b2 + hstep, voffB); PG8_STAGE(PG8_SA(0, 0), a2, voffA);
            PG8_WAIT_V(8); PG8_WAIT_L(0); PG8_BAR; PG8_MMA(1, 0, At, B0); PG8_MMA(1, 1, At, B1); PG8_BAR; PG8_SCHED;
            PG8_LDB(B0, 1, 0); PG8_LDB(B1, 1, 1); PG8_SCHED; PG8_LDA(At, 1, 0); PG8_STAGE(PG8_SA(0, 1), a2 + hstep, voffA);
            PG8_WAIT_V(8); PG8_WAIT_L(0); PG8_BAR; PG8_MMA(0, 0, At, B0); PG8_MMA(0, 1, At, B1); PG8_BAR; PG8_SCHED;
            PG8_LDA(At, 1, 1); PG8_STAGE(PG8_SB(1, 0), b3, voffB); PG8_STAGE(PG8_SB(1, 1), b3 + hstep, voffB); PG8_STAGE(PG8_SA(1, 0), a3, voffA);
            PG8_WAIT_V(8); PG8_WAIT_L(0); PG8_BAR; PG8_MMA(1, 0, At, B0); PG8_MMA(1, 1, At, B1); PG8_BAR; PG8_SCHED;
            } else {
            PG8_LDB(B0, 0, 0); PG8_SCHED; PG8_LDA(At, 0, 0); PG8_STAGE(PG8_SA(1, 1), a1 + hstep, voffA);
            PG8_WAIT_L(8); PG8_BAR; PG8_WAIT_L(0); PG8_MMA(0, 0, At, B0); PG8_BAR; PG8_SCHED;
            PG8_LDB(B1, 0, 1); PG8_STAGE(PG8_SB(0, 0), b2, voffB);
            PG8_BAR; PG8_WAIT_L(0); PG8_MMA(0, 1, At, B1); PG8_BAR;
            PG8_LDA(At, 0, 1); PG8_STAGE(PG8_SA(0, 0), a2, voffA);
            PG8_BAR; PG8_WAIT_L(0); PG8_MMA(1, 0, At, B0); PG8_BAR; PG8_SCHED;
            PG8_STAGE(PG8_SB(0, 1), b2 + hstep, voffB);
            PG8_WAIT_V(6); PG8_BAR; PG8_MMA(1, 1, At, B1); PG8_BAR;
            PG8_LDB(B0, 1, 0); PG8_SCHED; PG8_LDA(At, 1, 0); PG8_STAGE(PG8_SA(0, 1), a2 + hstep, voffA);
            PG8_WAIT_L(8); PG8_BAR; PG8_WAIT_L(0); PG8_MMA(0, 0, At, B0); PG8_BAR; PG8_SCHED;
            PG8_LDB(B1, 1, 1); PG8_STAGE(PG8_SB(1, 0), b3, voffB);
            PG8_BAR; PG8_WAIT_L(0); PG8_MMA(0, 1, At, B1); PG8_BAR;
            PG8_LDA(At, 1, 1); PG8_STAGE(PG8_SA(1, 0), a3, voffA);
            PG8_BAR; PG8_WAIT_L(0); PG8_MMA(1, 0, At, B0); PG8_BAR; PG8_SCHED;
            PG8_STAGE(PG8_SB(1, 1), b3 + hstep, voffB);
            PG8_WAIT_V(6); PG8_BAR; PG8_MMA(1, 1, At, B1); PG8_BAR;
            }
        }
        if constexpr (ALIGN_EPI) { if (wr == 0) PG8_BAR; }
        if constexpr (!Epi::AFTER_DRAIN) { E(acc, cur, wr, wc, fr, fq); S.done(cur); }
        if (!has_next) break;
#pragma unroll
        for (int a = 0; a < 2; ++a)
#pragma unroll
            for (int b = 0; b < 2; ++b)
#pragma unroll
                for (int m = 0; m < 4; ++m)
#pragma unroll
                    for (int n = 0; n < 2; ++n) acc[a][b][m][n] = (f32x4){0.f, 0.f, 0.f, 0.f};
        cur = nxt; cA = nA; cB = nB; ++ui;
        if constexpr (ALIGN_EPI) { if (wr == 1) PG8_BAR; }
    }
    PG8_WAIT_V(0);
    if constexpr (!ALIGN_EPI) { if (wr == 0) PG8_BAR; }
    PG8_BAR;
    if constexpr (Epi::AFTER_DRAIN) { E.fused(acc, cur, wr, wc, fr, fq, lds, wid, lane); S.done(cur); }
#undef PG8_SA
#undef PG8_SB
#undef PG8_STAGE
#undef PG8_LDA
#undef PG8_LDB
#undef PG8_MMA
#undef PG8_WAIT_V
#undef PG8_WAIT_L
#undef PG8_BAR
#undef PG8_SCHED
}
}
#define GAS __attribute__((address_space(1)))
#define LAS __attribute__((address_space(3)))
typedef unsigned short bf16;
typedef unsigned v4u __attribute__((ext_vector_type(4)));
typedef float f32x4 __attribute__((ext_vector_type(4)));
typedef short bf16x8 __attribute__((ext_vector_type(8)));
typedef GAS unsigned gu32;
typedef GAS unsigned long long gu64;
#define RLX_AGENT __ATOMIC_RELAXED, __HIP_MEMORY_SCOPE_AGENT
#define LDS_WAIT() asm volatile("s_waitcnt lgkmcnt(0)" ::: "memory")
#define VM_WAIT() asm volatile("s_waitcnt vmcnt(0)" ::: "memory")
__device__ __forceinline__ unsigned long long rt() { return __builtin_amdgcn_s_memrealtime(); }
__device__ __forceinline__ unsigned f2bf(float f) { unsigned u = __builtin_bit_cast(unsigned, f); return (u + 0x7fffu + ((u >> 16) & 1u)) >> 16; }
__device__ __forceinline__ unsigned pk2(float lo, float hi) { return f2bf(lo) | (f2bf(hi) << 16); }

#define XB_TMO      128
#define XB_XCNT(j)  (256  + 64 * (j))
#define XB_XSUB(j)  (1280 + 64 * (j))
#define XB_XGEN(j)  (2304 + 64 * (j))
#define XB_TOP      3328
#define XB_TOPGEN   3392
#define XCD_BAR_WORDS 3456
#define XB_SPIN_CAP (1u << 18)

__device__ __forceinline__ unsigned xb_ld(unsigned* p)              { return __hip_atomic_load(p, __ATOMIC_RELAXED, __HIP_MEMORY_SCOPE_AGENT); }
__device__ __forceinline__ unsigned xb_add(unsigned* p, unsigned v) { return __hip_atomic_fetch_add(p, v, __ATOMIC_RELAXED, __HIP_MEMORY_SCOPE_AGENT); }
__device__ __forceinline__ unsigned xb_xcc_id() { return (unsigned)__builtin_amdgcn_s_getreg((3 << 11) | 20) & 0xFu; }
#define XB_SPIN(cond, bar) do { unsigned _sp = 0; while (cond) { __builtin_amdgcn_s_sleep(1); \
    if ((++_sp & 255u) == 0u) { if (xb_ld(&(bar)[XB_TMO])) break; if (_sp > XB_SPIN_CAP) { atomicAdd(&(bar)[XB_TMO], 1u); break; } } } } while (0)

struct XcdBarrier {
    unsigned* bar; unsigned x;
    volatile LAS unsigned* st;
};

__device__ __forceinline__ XcdBarrier xcd_barrier_post(unsigned* bar, volatile LAS unsigned* st) {
    XcdBarrier b; b.bar = bar; b.x = xb_xcc_id(); b.st = st;
    if (threadIdx.x == 0) (void)xb_add(&bar[XB_XCNT(b.x)], 1u);
    return b;
}
__device__ __forceinline__ void xcd_barrier_complete(unsigned* bar, unsigned x, unsigned& nloc, unsigned& nx) {
    const unsigned G = gridDim.x * gridDim.y * gridDim.z;
    unsigned sum, cnt, mine, sp = 0u;
    for (;;) {
        sum = 0u; cnt = 0u; mine = 0u;
#pragma unroll
        for (unsigned j = 0; j < 16; ++j) { const unsigned c = xb_ld(&bar[XB_XCNT(j)]); sum += c; cnt += (c > 0u) ? 1u : 0u; mine = (j == x) ? c : mine; }
        if (sum == G) break;
        __builtin_amdgcn_s_sleep(1);
        if ((++sp & 255u) == 0u) { if (xb_ld(&bar[XB_TMO])) break; if (sp > XB_SPIN_CAP) { atomicAdd(&bar[XB_TMO], 1u); break; } }
    }
    nloc = mine > 0u ? mine : 1u; nx = cnt > 0u ? cnt : 1u;
}

__device__ __forceinline__ void xcd_barrier(const XcdBarrier& b) {
    asm volatile("s_waitcnt vmcnt(0)" ::: "memory");
    __syncthreads();
    if (threadIdx.x == 0) {
        unsigned* bar = b.bar;
        __builtin_amdgcn_s_waitcnt(0);
        unsigned nloc = b.st[0], nx = b.st[1];
        if (nloc == 0u) { xcd_barrier_complete(bar, b.x, nloc, nx); b.st[0] = nloc; b.st[1] = nx; }
        const unsigned old = xb_add(&bar[XB_XSUB(b.x)], 1u);
        const unsigned gen = old / nloc;
        if (old + 1u == (gen + 1u) * nloc) {
            __builtin_amdgcn_fence(__ATOMIC_RELEASE, "agent");
            asm volatile("s_waitcnt vmcnt(0)" ::: "memory");
            const unsigned og = xb_add(&bar[XB_TOP], 1u);
            const unsigned tg = og / nx;
            if (og + 1u == (tg + 1u) * nx) xb_add(&bar[XB_TOPGEN], 1u);
            else XB_SPIN(xb_ld(&bar[XB_TOPGEN]) == tg, bar);
            __builtin_amdgcn_fence(__ATOMIC_ACQUIRE, "agent");
            xb_add(&bar[XB_XGEN(b.x)], 1u);
            asm volatile("s_waitcnt vmcnt(0)" ::: "memory");
        } else {
            XB_SPIN(xb_ld(&bar[XB_XGEN(b.x)]) == gen, bar);
            __builtin_amdgcn_fence(__ATOMIC_ACQUIRE, "agent");
            asm volatile("s_waitcnt vmcnt(0)" ::: "memory");
        }
    }
    __syncthreads();
}
typedef unsigned u32x2v __attribute__((ext_vector_type(2)));
typedef float f32x2v __attribute__((ext_vector_type(2)));

constexpr int MP = 16384, MROWS = 16640, DMODEL = 1024, DFF = 2816, NBLK64 = MROWS / 64;
constexpr float RMS_EPS = 1e-6f;
constexpr size_t OFF_Y = 0, OFF_WKP = (size_t)MROWS * 1024, OFF_WVP = OFF_WKP + 65536, OFF_SRP = OFF_WVP + 65536, OFF_SIP = OFF_SRP + 8192,
    OFF_CMP = OFF_SIP + 8192, OFF_CFP = OFF_CMP + 8192, OFF_MKP = OFF_CFP + 45056, OFF_MVP = OFF_MKP + 2097152, OFF_WKS = OFF_MVP + 2097152,
    OFF_WVS = OFF_WKS + 32768, OFF_SRS = OFF_WVS + 32768, OFF_SIS = OFF_SRS + 16384, OFF_CMS = OFF_SIS + 16384, OFF_CFS = OFF_CMS + 16384;
constexpr size_t MiB = 1u << 20;
constexpr size_t WS_ROWSS = 0, WS_BAR = 512 * 1024, CTL_ZERO_BYTES = 1 * MiB;
constexpr size_t WS_ROPE = 1 * MiB, WS_SSM = 2 * MiB, WS_CKV = 3 * MiB, WS_SLOC = 4 * MiB, WS_MEMK = 8 * MiB, WS_MEMVT = 20 * MiB, WS_SIDE = 32 * MiB;
constexpr size_t SG_BYTES = (size_t)NBLK64 * 8 * DFF * 4, SV_BYTES = (size_t)NBLK64 * 4 * DFF * 4;
static_assert(WS_SIDE + SG_BYTES + SV_BYTES <= 66 * MiB, "side buffers");
constexpr size_t WS_WT = 66 * MiB, WS_XB = 128 * MiB, WS_TMP = 161 * MiB;
constexpr size_t WT_INEVEN = 0, WT_GLU = WT_INEVEN + 1280 * 1024, WT_OUTEVEN = WT_GLU + 512 * 512, WT_WQ = WT_OUTEVEN + 1024 * 1024, WT_WKV = WT_WQ + 2 * 1024 * 1024,
    WT_WO = WT_WKV + 2 * 2048 * 1024, WT_UP = WT_WO + 2 * 1024 * 1024, WT_DOWN = WT_UP + (size_t)2 * 5632 * 1024, WT_INODD = WT_DOWN + (size_t)2 * 2816 * 1024,
    WT_OUTODD = WT_INODD + 3072 * 1024, WT_END = WT_OUTODD + 1024 * 1024;
static_assert(WS_WT + WT_END * 2 <= WS_XB, "weights");
static_assert(WS_XB + (size_t)MROWS * 1024 * 2 <= WS_TMP, "xb");
constexpr size_t TMP_BYTES = (size_t)MROWS * DFF * 2;
constexpr size_t WS_PART = 251 * MiB, PART_ELEMS = (size_t)MROWS * 16;
static_assert(WS_PART + 2 * PART_ELEMS * 4 <= 256 * MiB, "part");
static_assert(WS_TMP + TMP_BYTES <= 256 * MiB, "ws");
constexpr size_t TMP_PROJ0 = 0, TMP_GBUF = (size_t)MROWS * 1280 * 2, TMP_YCAT = TMP_GBUF + (size_t)MROWS * 512 * 2, TMP_MEMB = TMP_YCAT;
static_assert(TMP_YCAT + (size_t)MROWS * 1024 * 2 <= TMP_BYTES, "tmp");
constexpr size_t TMP_QX = 0, TMP_OX = (size_t)MROWS * 1024 * 2, TMP_ACT = 0, TMP_GB = 0, TMP_ZC = (size_t)MROWS * 1024 * 2;
constexpr int LDS_BYTES = 147456, MISC_OFF = 147456 - 512;
constexpr int NPH = 22;

#define MFMA16(a, b, c) __builtin_amdgcn_mfma_f32_16x16x32_bf16(a, b, c, 0, 0, 0)
__device__ __forceinline__ float bflo(unsigned w) { return __uint_as_float(w << 16); }
__device__ __forceinline__ float bfhi(unsigned w) { return __uint_as_float(w & 0xffff0000u); }
__device__ __forceinline__ v4u pack8(f32x4 a, f32x4 b) { v4u w; w.x = pg8::cvt_pk_bf16(a[0], a[1]); w.y = pg8::cvt_pk_bf16(a[2], a[3]); w.z = pg8::cvt_pk_bf16(b[0], b[1]); w.w = pg8::cvt_pk_bf16(b[2], b[3]); return w; }
__device__ __forceinline__ float rstd_of(const float* part, int row) { const f32x4* p = (const f32x4*)(part + (size_t)row * 16); const f32x4 a = p[0] + p[1] + p[2] + p[3]; return rsqrtf(((a[0] + a[1]) + (a[2] + a[3])) * (1.0f / 1024.0f) + RMS_EPS); }
__device__ __forceinline__ float sigmoidf_(float x) { return 1.0f / (1.0f + __expf(-x)); }
__device__ __forceinline__ float dpp_ror1(float v) { return __builtin_bit_cast(float, __builtin_amdgcn_update_dpp(0, __builtin_bit_cast(int, v), 0x121, 0xf, 0xf, false)); }
__device__ __forceinline__ float dpp_ror2(float v) { return __builtin_bit_cast(float, __builtin_amdgcn_update_dpp(0, __builtin_bit_cast(int, v), 0x122, 0xf, 0xf, false)); }
__device__ __forceinline__ float wave_sum(float v) {
#pragma unroll
    for (int o = 1; o < 64; o <<= 1) v += __shfl_xor(v, o);
    return v;
}

typedef pg8::Unit Unit;
#define EPI_ARGS const f32x4 (&acc)[2][2][4][2], const Unit& u, int wr, int wc, int fr, int fq

struct EpiBf16 {
    static constexpr bool PERM = true, AFTER_DRAIN = false;
    bf16* O; int ldc; const float* rowss;
    __device__ __forceinline__ void operator()(EPI_ARGS) const {
        const int row0 = u.pm * 256 + wr * 64 + fr, col0 = u.pn * 256 + wc * 32 + 8 * fq;
#pragma unroll
        for (int ai = 0; ai < 2; ++ai)
#pragma unroll
            for (int m = 0; m < 4; ++m) { const int row = row0 + ai * 128 + m * 16; const float rs = rstd_of(rowss, row); bf16* rp = O + (size_t)row * ldc + col0;
#pragma unroll
                for (int bj = 0; bj < 2; ++bj) *(v4u*)(rp + bj * 128) = pack8(acc[ai][bj][m][0] * rs, acc[ai][bj][m][1] * rs); }
    }
};
struct EpiRes {
    static constexpr bool PERM = true, AFTER_DRAIN = false;
    const float* base_p; const float* base_s; float* xf; bf16* xb; float* rowss_next;
    __device__ __forceinline__ void operator()(EPI_ARGS) const {
        const float* base = u.pm < 64 ? base_p : base_s;
        const int row0 = u.pm * 256 + wr * 64 + fr, col0 = u.pn * 256 + wc * 32 + 8 * fq;
#pragma unroll
        for (int ai = 0; ai < 2; ++ai)
#pragma unroll
            for (int m = 0; m < 4; ++m) { const int row = row0 + ai * 128 + m * 16; const size_t off = (size_t)row * 1024 + col0; float ss = 0.f;
#pragma unroll
                for (int bj = 0; bj < 2; ++bj) { const f32x4 b0 = *(const f32x4*)(base + off + bj * 128), b1 = *(const f32x4*)(base + off + bj * 128 + 4);
                    const f32x4 v0 = acc[ai][bj][m][0] + b0, v1 = acc[ai][bj][m][1] + b1;
                    *(f32x4*)(xf + off + bj * 128) = v0; *(f32x4*)(xf + off + bj * 128 + 4) = v1; *(v4u*)(xb + off + bj * 128) = pack8(v0, v1);
                    ss += (v0[0] * v0[0] + v0[1] * v0[1]) + (v0[2] * v0[2] + v0[3] * v0[3]) + (v1[0] * v1[0] + v1[1] * v1[1]) + (v1[2] * v1[2] + v1[3] * v1[3]); }
                ss += __shfl_xor(ss, 16); ss += __shfl_xor(ss, 32);
                if (fq == 0) rowss_next[(size_t)row * 16 + u.pn * 4 + wc] = ss; }
    }
};
struct EpiGlu {
    static constexpr bool PERM = true, AFTER_DRAIN = false;
    const bf16* g; bf16* ycat;
    __device__ __forceinline__ void operator()(EPI_ARGS) const {
        const int row0 = u.pm * 256 + wr * 64 + fr, col0 = u.pn * 256 + wc * 32 + 8 * fq;
#pragma unroll
        for (int ai = 0; ai < 2; ++ai)
#pragma unroll
            for (int m = 0; m < 4; ++m) { const int row = row0 + ai * 128 + m * 16;
#pragma unroll
                for (int bj = 0; bj < 2; ++bj) { const int col = col0 + bj * 128; const v4u gw = *(const v4u*)(g + (size_t)row * 512 + col);
                    const f32x4 a0 = acc[ai][bj][m][0], a1 = acc[ai][bj][m][1]; f32x4 o0, o1;
                    o0[0] = bflo(gw.x) * sigmoidf_(a0[0]); o0[1] = bfhi(gw.x) * sigmoidf_(a0[1]); o0[2] = bflo(gw.y) * sigmoidf_(a0[2]); o0[3] = bfhi(gw.y) * sigmoidf_(a0[3]);
                    o1[0] = bflo(gw.z) * sigmoidf_(a1[0]); o1[1] = bfhi(gw.z) * sigmoidf_(a1[1]); o1[2] = bflo(gw.w) * sigmoidf_(a1[2]); o1[3] = bfhi(gw.w) * sigmoidf_(a1[3]);
                    *(v4u*)(ycat + (size_t)row * 1024 + col) = pack8(o0, o1); } }
    }
};
struct EpiKV {
    static constexpr bool PERM = true, AFTER_DRAIN = false;
    float* out; bf16* memk;
    __device__ __forceinline__ void operator()(EPI_ARGS) const {
        const int row0 = u.pm * 256 + wr * 64 + fr, col0 = u.pn * 256 + wc * 32 + 8 * fq;
#pragma unroll
        for (int ai = 0; ai < 2; ++ai)
#pragma unroll
            for (int m = 0; m < 4; ++m) { const int row = row0 + ai * 128 + m * 16;
#pragma unroll
                for (int bj = 0; bj < 2; ++bj) { const int c = col0 + bj * 128, l = c >> 11, e = c & 2047, isv = e >> 10, dc = e & 1023;
                    float* op = out + (isv ? OFF_MVP : OFF_MKP) + (size_t)l * 1048576 + (size_t)row * 1024 + dc;
                    *(f32x4*)op = acc[ai][bj][m][0]; *(f32x4*)(op + 4) = acc[ai][bj][m][1];
                    if (!isv) *(v4u*)(memk + (size_t)l * 12 * 262144 + (size_t)row * 1024 + dc) = pack8(acc[ai][bj][m][0], acc[ai][bj][m][1]); } }
    }
};
struct EpiIn0 {
    static constexpr bool PERM = true, AFTER_DRAIN = false;
    bf16* proj; const float* rowss; const float* ropec; const float* ropes; float* out;
    __device__ __forceinline__ void operator()(EPI_ARGS) const {
        const int pn = u.pn;
#pragma unroll
        for (int ai = 0; ai < 2; ++ai)
#pragma unroll
            for (int m = 0; m < 4; ++m) { const int row = u.pm * 256 + ai * 128 + wr * 64 + m * 16 + fr; const float rs = rstd_of(rowss, row);
                const int pos = row < MP ? (row & 4095) : 2048 + (row & 31);
                bf16* rp = proj + (size_t)row * 1280;
                float* wk = nullptr; float* wv = nullptr;
                if (pn == 4) { if (row >= MP) { wk = out + OFF_WKS + (size_t)(row - MP) * 128; wv = out + OFF_WVS + (size_t)(row - MP) * 128; }
                               else if ((row & 4095) >= 3968) { const size_t o = (size_t)((row >> 12) * 128 + (row & 4095) - 3968) * 128; wk = out + OFF_WKP + o; wv = out + OFF_WVP + o; } }
#pragma unroll
                for (int bj = 0; bj < 2; ++bj) { const f32x4 v0 = acc[ai][bj][m][0] * rs, v1 = acc[ai][bj][m][1] * rs;
                    const bool rope = (pn == 2 || pn == 3 || (pn == 4 && bj == 0));
                    if (!rope) { const int col = pn * 256 + bj * 128 + wc * 32 + 8 * fq; *(v4u*)(rp + col) = pack8(v0, v1);
                        if (pn == 4 && wv) { *(f32x4*)(wv + wc * 32 + 8 * fq) = v0; *(f32x4*)(wv + wc * 32 + 8 * fq + 4) = v1; } }
                    else { const int gbase = pn * 256 + bj * 128 + (wc >> 1) * 64, d1 = 16 * (wc & 1) + 4 * fq;
                        const f32x4 c4 = *(const f32x4*)(ropec + pos * 32 + d1), s4 = *(const f32x4*)(ropes + pos * 32 + d1);
                        f32x4 o1 = v0 * c4 - v1 * s4, o2 = v1 * c4 + v0 * s4;
                        if (pn != 4) { o1 = o1 * 0.125f; o2 = o2 * 0.125f; }
                        u32x2v w1, w2; w1.x = pg8::cvt_pk_bf16(o1[0], o1[1]); w1.y = pg8::cvt_pk_bf16(o1[2], o1[3]); w2.x = pg8::cvt_pk_bf16(o2[0], o2[1]); w2.y = pg8::cvt_pk_bf16(o2[2], o2[3]);
                        *(u32x2v*)(rp + gbase + d1) = w1; *(u32x2v*)(rp + gbase + d1 + 32) = w2;
                        if (pn == 4 && wk) { const int cc = (wc >> 1) * 64 + d1; *(f32x4*)(wk + cc) = o1; *(f32x4*)(wk + cc + 32) = o2; } } } }
    }
};
struct EpiFfnUp {
    static constexpr bool PERM = true, AFTER_DRAIN = false;
    bf16* act; const float* rowss; const float* cw; float* SG; float* SV;
    __device__ __forceinline__ void operator()(EPI_ARGS) const {
        const int c0 = u.pn * 128 + wc * 32 + 8 * fq; const bool sample = u.pm == 64;
        const f32x4 w0a = *(const f32x4*)(cw + c0), w0b = *(const f32x4*)(cw + c0 + 4), w1a = *(const f32x4*)(cw + DFF + c0), w1b = *(const f32x4*)(cw + DFF + c0 + 4),
                    w2a = *(const f32x4*)(cw + 2 * DFF + c0), w2b = *(const f32x4*)(cw + 2 * DFF + c0 + 4);
#pragma unroll
        for (int ai = 0; ai < 2; ++ai) { f32x4 gp0 = {0.f, 0.f, 0.f, 0.f}, gp1 = {0.f, 0.f, 0.f, 0.f}; const int blk = u.pm * 4 + ai * 2 + wr;
#pragma unroll
            for (int m = 0; m < 4; ++m) { const int row = u.pm * 256 + ai * 128 + wr * 64 + m * 16 + fr; const float rs = rstd_of(rowss, row);
                const f32x4 g0 = acc[ai][0][m][0] * rs, g1 = acc[ai][0][m][1] * rs, v0 = acc[ai][1][m][0] * rs, v1 = acc[ai][1][m][1] * rs;
                f32x4 a0, a1;
#pragma unroll
                for (int j = 0; j < 4; ++j) {
                    const float r1pa = dpp_ror1(gp0[j]), r1ca = dpp_ror1(g0[j]), r2pa = dpp_ror2(gp0[j]), r2ca = dpp_ror2(g0[j]);
                    const float r1pb = dpp_ror1(gp1[j]), r1cb = dpp_ror1(g1[j]), r2pb = dpp_ror2(gp1[j]), r2cb = dpp_ror2(g1[j]);
                    const float p1a = fr == 0 ? r1pa : r1ca, p2a = fr < 2 ? r2pa : r2ca;
                    const float p1b = fr == 0 ? r1pb : r1cb, p2b = fr < 2 ? r2pb : r2cb;
                    const float ca = w0a[j] * p2a + w1a[j] * p1a + w2a[j] * g0[j], cb = w0b[j] * p2b + w1b[j] * p1b + w2b[j] * g1[j];
                    a0[j] = ca * sigmoidf_(ca) * v0[j]; a1[j] = cb * sigmoidf_(cb) * v1[j]; }
                const bool valid = (m > 0 || fr >= 2) && !(sample && m == 2 && fr < 2);
                if (valid) *(v4u*)(act + (size_t)row * DFF + c0) = pack8(a0, a1);
                if ((m & 1) == 0 && fr < 2) { float* sg = SG + (size_t)(blk * 8 + 2 * m + fr) * DFF + c0; *(f32x4*)sg = g0; *(f32x4*)(sg + 4) = g1;
                                              float* sv = SV + (size_t)(blk * 4 + m + fr) * DFF + c0; *(f32x4*)sv = v0; *(f32x4*)(sv + 4) = v1; }
                if ((m & 1) == 1 && fr >= 14) { float* sg = SG + (size_t)(blk * 8 + 2 * m + fr - 14) * DFF + c0; *(f32x4*)sg = g0; *(f32x4*)(sg + 4) = g1; }
                gp0 = g0; gp1 = g1; } }
    }
};
struct EpiInOdd {
    static constexpr bool PERM = true, AFTER_DRAIN = false;
    bf16* gb; bf16* zc; const float* rowss; const float* cw; float* SG;
    __device__ __forceinline__ void operator()(EPI_ARGS) const {
        if (u.pn < 4) {
            const int row0 = u.pm * 256 + wr * 64 + fr, col0 = u.pn * 256 + wc * 32 + 8 * fq;
#pragma unroll
            for (int ai = 0; ai < 2; ++ai)
#pragma unroll
                for (int m = 0; m < 4; ++m) { const int row = row0 + ai * 128 + m * 16; const float rs = rstd_of(rowss, row); bf16* rp = gb + (size_t)row * 1024 + col0;
#pragma unroll
                    for (int bj = 0; bj < 2; ++bj) *(v4u*)(rp + bj * 128) = pack8(acc[ai][bj][m][0] * rs, acc[ai][bj][m][1] * rs); }
            return;
        }
        const int c0 = (u.pn - 4) * 128 + wc * 32 + 8 * fq; const bool sample = u.pm == 64;
        const f32x4 w0a = *(const f32x4*)(cw + c0), w0b = *(const f32x4*)(cw + c0 + 4), w1a = *(const f32x4*)(cw + 1024 + c0), w1b = *(const f32x4*)(cw + 1024 + c0 + 4),
                    w2a = *(const f32x4*)(cw + 2048 + c0), w2b = *(const f32x4*)(cw + 2048 + c0 + 4);
#pragma unroll
        for (int ai = 0; ai < 2; ++ai) { f32x4 gp0 = {0.f, 0.f, 0.f, 0.f}, gp1 = {0.f, 0.f, 0.f, 0.f}; const int blk = u.pm * 4 + ai * 2 + wr;
#pragma unroll
            for (int m = 0; m < 4; ++m) { const int row = u.pm * 256 + ai * 128 + wr * 64 + m * 16 + fr; const float rs = rstd_of(rowss, row); const float rs2 = rs * rs;
                const f32x4 g0 = acc[ai][0][m][0] * acc[ai][1][m][0] * rs2, g1 = acc[ai][0][m][1] * acc[ai][1][m][1] * rs2;
                f32x4 a0, a1;
#pragma unroll
                for (int j = 0; j < 4; ++j) {
                    const float r1pa = dpp_ror1(gp0[j]), r1ca = dpp_ror1(g0[j]), r2pa = dpp_ror2(gp0[j]), r2ca = dpp_ror2(g0[j]);
                    const float r1pb = dpp_ror1(gp1[j]), r1cb = dpp_ror1(g1[j]), r2pb = dpp_ror2(gp1[j]), r2cb = dpp_ror2(g1[j]);
                    const float p1a = fr == 0 ? r1pa : r1ca, p2a = fr < 2 ? r2pa : r2ca;
                    const float p1b = fr == 0 ? r1pb : r1cb, p2b = fr < 2 ? r2pb : r2cb;
                    a0[j] = w0a[j] * p2a + w1a[j] * p1a + w2a[j] * g0[j]; a1[j] = w0b[j] * p2b + w1b[j] * p1b + w2b[j] * g1[j]; }
                const bool valid = (m > 0 || fr >= 2) && !(sample && m == 2 && fr < 2);
                if (valid) *(v4u*)(zc + (size_t)row * 1024 + c0) = pack8(a0, a1);
                if ((m & 1) == 0 && fr < 2) { float* sg = SG + (size_t)(blk * 8 + 2 * m + fr) * 1024 + c0; *(f32x4*)sg = g0; *(f32x4*)(sg + 4) = g1; }
                if ((m & 1) == 1 && fr >= 14) { float* sg = SG + (size_t)(blk * 8 + 2 * m + fr - 14) * 1024 + c0; *(f32x4*)sg = g0; *(f32x4*)(sg + 4) = g1; }
                gp0 = g0; gp1 = g1; } }
    }
};

__device__ __forceinline__ int rowmap(int mode, int n) {
    if (mode == 1) { if (n >= 512 && n < 1152) { const int d = n & 63; return (n & ~63) | (32 * ((d >> 4) & 1) + 8 * ((d >> 2) & 3) + 4 * (d >> 5) + (d & 3)); } return n; }
    if (mode == 2) { return n < DFF ? ((n >> 7) * 256 + (n & 127)) : (((n - DFF) >> 7) * 256 + 128 + ((n - DFF) & 127)); }
    if (mode == 3) { if (n < 1024) return n; const int c = (n - 1024) & 1023, z = n >= 2048 ? 1 : 0; return 1024 + (c >> 7) * 256 + z * 128 + (c & 127); }
    return n;
}
__device__ __forceinline__ void tr_item(const float* W, int K, int N, bf16* WT, const float* gain, float scale, int mode, LAS float* scr, int item, int lane) {
    const int nblk = N / 32, kb = item / nblk, nb = item % nblk, k0 = 64 * kb, n0 = 32 * nb;
#pragma unroll 8
    for (int i = 0; i < 32; ++i) { const int kk = 2 * i + (lane >> 5); const float gs = gain ? gain[k0 + kk] * scale : scale; scr[kk * 33 + (lane & 31)] = W[(size_t)(k0 + kk) * N + n0 + (lane & 31)] * gs; }
    LDS_WAIT(); asm volatile("" ::: "memory");
    const int c = lane & 7;
#pragma unroll
    for (int j = 0; j < 4; ++j) { const int n = (lane >> 3) + 8 * j; const LAS float* s = scr + (8 * c) * 33 + n;
        v4u o; o.x = pg8::cvt_pk_bf16(s[0 * 33], s[1 * 33]); o.y = pg8::cvt_pk_bf16(s[2 * 33], s[3 * 33]); o.z = pg8::cvt_pk_bf16(s[4 * 33], s[5 * 33]); o.w = pg8::cvt_pk_bf16(s[6 * 33], s[7 * 33]);
        *(v4u*)(WT + (size_t)rowmap(mode, n0 + n) * K + k0 + 8 * c) = o; }
    LDS_WAIT(); asm volatile("" ::: "memory");
}
__device__ __forceinline__ double dexp_(double y) {
    const double k = rint(y * 1.4426950408889634); const double r = (y - k * 0.6931471803691238) - k * 1.9082149292705877e-10;
    double p = 1.0 / 6227020800.0;
    p = p * r + 1.0 / 479001600.0; p = p * r + 1.0 / 39916800.0; p = p * r + 1.0 / 3628800.0; p = p * r + 1.0 / 362880.0; p = p * r + 1.0 / 40320.0; p = p * r + 1.0 / 5040.0;
    p = p * r + 1.0 / 720.0; p = p * r + 1.0 / 120.0; p = p * r + 1.0 / 24.0; p = p * r + 1.0 / 6.0; p = p * r + 0.5; p = p * r + 1.0; p = p * r + 1.0;
    const long long bits = (long long)(1023 + (int)k) << 52; return p * __builtin_bit_cast(double, bits);
}
__device__ __forceinline__ void dsincos_(double x, double& s, double& c) {
    const double k = rint(x * 0.6366197723675814); const double r = (x - k * 1.5707963267948966) - k * 6.123233995736766e-17; const double r2 = r * r;
    const double sp = r * (1.0 + r2 * (-1.0 / 6.0 + r2 * (1.0 / 120.0 + r2 * (-1.0 / 5040.0 + r2 * (1.0 / 362880.0 + r2 * (-1.0 / 39916800.0 + r2 * (1.0 / 6227020800.0)))))));
    const double cp = 1.0 + r2 * (-0.5 + r2 * (1.0 / 24.0 + r2 * (-1.0 / 720.0 + r2 * (1.0 / 40320.0 + r2 * (-1.0 / 3628800.0 + r2 * (1.0 / 479001600.0 + r2 * (-1.0 / 87178291200.0)))))));
    const int q = ((int)k) & 3;
    s = q == 0 ? sp : q == 1 ? cp : q == 2 ? -sp : -cp; c = q == 0 ? cp : q == 1 ? -sp : q == 2 ? -cp : sp;
}

__device__ __forceinline__ const bf16* kvptr(const bf16* proj, const bf16* cb, int sample, int b, int c, int kvh, int kk, int isv) {
    if (!sample) { int pos = (c - 2) * 64 + kk; pos = pos < 0 ? 0 : pos; return proj + (size_t)(b * 4096 + pos) * 1280 + 1024 + isv * 128 + kvh * 64; }
    if (kk < 128) return cb + (size_t)(b * 128 + kk) * 128 + kvh * 64;
    int t = kk - 128; t = t > 31 ? 31 : t; return proj + (size_t)(MP + b * 32 + t) * 1280 + 1024 + isv * 128 + kvh * 64;
}
__device__ __forceinline__ void swa_phase(const bf16* proj, const bf16* ckb, const bf16* cvb, const float* sinks, bf16* ycat, LAS unsigned char* lds, int tid, int wave, int lane, int G) {
    LAS bf16* VT = (LAS bf16*)lds;
    const int fr = lane & 15, quad = lane >> 4;
    for (int it = blockIdx.x; it < 528; it += G) {
        int b, c, kvh, sample;
        if (it < 512) { sample = 0; b = it >> 7; c = (it >> 1) & 63; kvh = it & 1; } else { sample = 1; b = (it - 512) >> 1; c = 0; kvh = it & 1; }
        __syncthreads();
#pragma unroll
        for (int i = 0; i < 3; ++i) { const int idx = tid + 512 * i, kk = idx % 192, dg = idx / 192; const v4u w = *(const v4u*)(kvptr(proj, cvb, sample, b, c, kvh, kk, 1) + dg * 8);
            LAS bf16* vp = VT + (dg * 8) * 200 + kk;
            vp[0] = (bf16)(w.x & 0xffffu); vp[200] = (bf16)(w.x >> 16); vp[400] = (bf16)(w.y & 0xffffu); vp[600] = (bf16)(w.y >> 16);
            vp[800] = (bf16)(w.z & 0xffffu); vp[1000] = (bf16)(w.z >> 16); vp[1200] = (bf16)(w.w & 0xffffu); vp[1400] = (bf16)(w.w >> 16); }
        __syncthreads();
        const int gq = wave >> 1, qhalf = wave & 1, head = kvh * 4 + gq;
        if (!(sample && qhalf)) {
            const int plo = sample ? 0 : (c >= 2 ? 0 : (2 - c) * 2), phi = sample ? 5 : 6;
            bf16x8 qf[2][2];
#pragma unroll
            for (int qb = 0; qb < 2; ++qb) { const int q = qhalf * 32 + qb * 16 + fr; const int row = sample ? MP + b * 32 + (q & 31) : b * 4096 + c * 64 + q;
                const bf16* qp = proj + (size_t)row * 1280 + 512 + head * 64 + quad * 8; qf[qb][0] = *(const bf16x8*)qp; qf[qb][1] = *(const bf16x8*)(qp + 32); }
            f32x4 s[12][2];
#pragma unroll
            for (int kb = 0; kb < 12; ++kb) { const int key = 32 * (kb >> 1) + (fr >> 2) * 8 + 4 * (kb & 1) + (fr & 3); const bf16* kp = kvptr(proj, ckb, sample, b, c, kvh, key, 0) + quad * 8;
                const bf16x8 k0 = *(const bf16x8*)kp, k1 = *(const bf16x8*)(kp + 32);
#pragma unroll
                for (int qb = 0; qb < 2; ++qb) { f32x4 a = {0.f, 0.f, 0.f, 0.f}; a = MFMA16(k0, qf[qb][0], a); a = MFMA16(k1, qf[qb][1], a); s[kb][qb] = a; } }
            const float sink = sinks[head];
            bf16x8 pf[6][2];
#pragma unroll
            for (int qb = 0; qb < 2; ++qb) { float mx = sink;
#pragma unroll
                for (int kb = 0; kb < 12; ++kb) { const bool pv = (kb >> 1) >= plo && (kb >> 1) < phi;
#pragma unroll
                    for (int j = 0; j < 4; ++j) { const float v = pv ? s[kb][qb][j] : -1e30f; s[kb][qb][j] = v; mx = fmaxf(mx, v); } }
                mx = fmaxf(mx, __shfl_xor(mx, 16)); mx = fmaxf(mx, __shfl_xor(mx, 32));
                float sum = 0.f;
#pragma unroll
                for (int kb = 0; kb < 12; ++kb)
#pragma unroll
                    for (int j = 0; j < 4; ++j) { const float e = __expf(s[kb][qb][j] - mx); s[kb][qb][j] = e; sum += e; }
                sum += __shfl_xor(sum, 16); sum += __shfl_xor(sum, 32); sum += __expf(sink - mx);
                const float inv = 1.0f / sum;
#pragma unroll
                for (int pr = 0; pr < 6; ++pr) pf[pr][qb] = __builtin_bit_cast(bf16x8, pack8(s[2 * pr][qb] * inv, s[2 * pr + 1][qb] * inv)); }
#pragma unroll
            for (int db = 0; db < 4; ++db) { bf16x8 vf[6];
#pragma unroll
                for (int pr = 0; pr < 6; ++pr) vf[pr] = *(const LAS bf16x8*)(VT + (db * 16 + fr) * 200 + 32 * pr + quad * 8);
#pragma unroll
                for (int qb = 0; qb < 2; ++qb) { f32x4 o = {0.f, 0.f, 0.f, 0.f};
#pragma unroll
                    for (int pr = 0; pr < 6; ++pr) o = MFMA16(pf[pr][qb], vf[pr], o);
#pragma unroll
                    for (int j = 0; j < 4; ++j) { const int q = qhalf * 32 + qb * 16 + quad * 4 + j;
                        if (!sample || q < 32) { const int row = sample ? MP + b * 32 + q : b * 4096 + c * 64 + q; ycat[(size_t)row * 1024 + 512 + head * 64 + db * 16 + fr] = (bf16)f2bf(o[j]); } } } }
        }
    }
    __syncthreads();
}

__device__ __forceinline__ void xattn_phase(const bf16* qx, const bf16* memk_l, const bf16* memvT_l, bf16* ox, int wave, int lane, int G) {
    const int fr = lane & 15, quad = lane >> 4;
    for (int t = wave * G + (int)blockIdx.x; t < 4160; t += 8 * G) {
        int bb, h, row0;
        if (t < 4096) { const int pair = t >> 8; bb = pair >> 2; h = pair & 3; row0 = bb * 4096 + (t & 255) * 16; }
        else { const int s = t - 4096, b = s >> 3; h = (s >> 1) & 3; bb = 4 + b; row0 = MP + b * 32 + (s & 1) * 16; }
        bf16x8 qf[8];
#pragma unroll
        for (int ks = 0; ks < 8; ++ks) qf[ks] = *(const bf16x8*)(qx + (size_t)(row0 + fr) * 1024 + h * 256 + ks * 32 + quad * 8);
        const bf16* kbase = memk_l + (size_t)bb * 262144 + h * 256 + quad * 8;
        f32x4 s[16];
#pragma unroll
        for (int kb = 0; kb < 16; ++kb) { const int key = 32 * (kb >> 1) + (fr >> 2) * 8 + 4 * (kb & 1) + (fr & 3); const bf16* kp = kbase + (size_t)key * 1024; f32x4 a = {0.f, 0.f, 0.f, 0.f};
#pragma unroll
            for (int ks = 0; ks < 8; ++ks) a = MFMA16(*(const bf16x8*)(kp + ks * 32), qf[ks], a);
            s[kb] = a; }
        float mx = -1e30f;
#pragma unroll
        for (int kb = 0; kb < 16; ++kb)
#pragma unroll
            for (int j = 0; j < 4; ++j) mx = fmaxf(mx, s[kb][j]);
        mx = fmaxf(mx, __shfl_xor(mx, 16)); mx = fmaxf(mx, __shfl_xor(mx, 32));
        float sum = 0.f;
#pragma unroll
        for (int kb = 0; kb < 16; ++kb)
#pragma unroll
            for (int j = 0; j < 4; ++j) { const float e = __expf(s[kb][j] - mx); s[kb][j] = e; sum += e; }
        sum += __shfl_xor(sum, 16); sum += __shfl_xor(sum, 32);
        const float inv = 1.0f / sum;
        bf16x8 pf[8];
#pragma unroll
        for (int pr = 0; pr < 8; ++pr) pf[pr] = __builtin_bit_cast(bf16x8, pack8(s[2 * pr] * inv, s[2 * pr + 1] * inv));
        const bf16* vbase = memvT_l + (size_t)bb * 262144 + (size_t)(h * 256 + fr) * 256 + quad * 8;
#pragma unroll 4
        for (int db = 0; db < 16; ++db) { f32x4 o = {0.f, 0.f, 0.f, 0.f};
#pragma unroll
            for (int pr = 0; pr < 8; ++pr) o = MFMA16(pf[pr], *(const bf16x8*)(vbase + (size_t)db * 4096 + pr * 32), o);
#pragma unroll
            for (int j = 0; j < 4; ++j) ox[(size_t)(row0 + quad * 4 + j) * 1024 + h * 256 + db * 16 + fr] = (bf16)f2bf(o[j]); }
    }
}


__device__ __forceinline__ void xstage(const bf16* src, size_t rowstride, LAS unsigned char* lds, int tid) {
    v4u t[16];
#pragma unroll
    for (int i = 0; i < 16; ++i) { const int row = (tid >> 5) + 16 * i, ch = tid & 31; t[i] = *(const GAS v4u*)((const GAS bf16*)src + (size_t)row * rowstride + ch * 8); }
#pragma unroll
    for (int i = 0; i < 16; ++i) { const int row = (tid >> 5) + 16 * i, ch = tid & 31; *(LAS v4u*)(lds + row * 528 + ch * 16) = t[i]; }
}
__device__ __forceinline__ void xattn_phase2(const bf16* qx, const bf16* memk_l, const bf16* memvT_l, bf16* ox, LAS unsigned char* lds, int tid, int wave, int lane, int G) {
    const int fr = lane & 15, quad = lane >> 4;
    for (int it = blockIdx.x; it < 256 + 32; it += G) {
        int bb, h, rowbase, nqb; bool active;
        if (it < 256) { bb = it >> 6; h = (it >> 4) & 3; rowbase = bb * 4096 + (it & 15) * 256; nqb = 2; active = true; }
        else { const int s = it - 256, b = s >> 2; h = s & 3; bb = 4 + b; rowbase = MP + b * 32; nqb = 1; active = wave < 2; }
        __syncthreads();
        xstage(memk_l + (size_t)bb * 262144 + h * 256, 1024, lds, tid);
        __syncthreads();
        bf16x8 pf[2][8];
#pragma unroll
        for (int qi = 0; qi < 2; ++qi) {
            if (qi < nqb && active) {
                const int row0 = rowbase + qi * 128 + wave * 16;
                bf16x8 qf[8];
#pragma unroll
                for (int ks = 0; ks < 8; ++ks) qf[ks] = *(const GAS bf16x8*)((const GAS bf16*)qx + (size_t)(row0 + fr) * 1024 + h * 256 + ks * 32 + quad * 8);
                f32x4 s[16];
#pragma unroll
                for (int kb = 0; kb < 16; ++kb) { const int key = 32 * (kb >> 1) + (fr >> 2) * 8 + 4 * (kb & 1) + (fr & 3); const LAS unsigned char* kp = lds + key * 528 + quad * 16; f32x4 a = {0.f, 0.f, 0.f, 0.f};
#pragma unroll
                    for (int ks = 0; ks < 8; ++ks) a = MFMA16(*(const LAS bf16x8*)(kp + ks * 64), qf[ks], a);
                    s[kb] = a; }
                float mx = -1e30f;
#pragma unroll
                for (int kb = 0; kb < 16; ++kb)
#pragma unroll
                    for (int j = 0; j < 4; ++j) mx = fmaxf(mx, s[kb][j]);
                mx = fmaxf(mx, __shfl_xor(mx, 16)); mx = fmaxf(mx, __shfl_xor(mx, 32));
                float sum = 0.f;
#pragma unroll
                for (int kb = 0; kb < 16; ++kb)
#pragma unroll
                    for (int j = 0; j < 4; ++j) { const float e = __expf(s[kb][j] - mx); s[kb][j] = e; sum += e; }
                sum += __shfl_xor(sum, 16); sum += __shfl_xor(sum, 32);
                const float inv = 1.0f / sum;
#pragma unroll
                for (int pr = 0; pr < 8; ++pr) pf[qi][pr] = __builtin_bit_cast(bf16x8, pack8(s[2 * pr] * inv, s[2 * pr + 1] * inv));
            }
        }
        __syncthreads();
        xstage(memvT_l + (size_t)bb * 262144 + (size_t)h * 65536, 256, lds, tid);
        __syncthreads();
#pragma unroll
        for (int qi = 0; qi < 2; ++qi) {
            if (qi < nqb && active) {
                const int row0 = rowbase + qi * 128 + wave * 16;
#pragma unroll 4
                for (int db = 0; db < 16; ++db) { f32x4 o = {0.f, 0.f, 0.f, 0.f}; const LAS unsigned char* vp = lds + (db * 16 + fr) * 528 + quad * 16;
#pragma unroll
                    for (int pr = 0; pr < 8; ++pr) o = MFMA16(*(const LAS bf16x8*)(vp + pr * 64), pf[qi][pr], o);
                    u32x2v w; w.x = pk2(o[0], o[1]); w.y = pk2(o[2], o[3]);
                    *(GAS u32x2v*)((GAS bf16*)ox + (size_t)(row0 + fr) * 1024 + h * 256 + db * 16 + quad * 4) = w; }
            }
        }
    }
    __syncthreads();
}

__device__ __forceinline__ void s5_stage_u(const bf16* up, LAS float* ubuf, int lane) {
    const v4u w0 = *(const v4u*)up, w1 = *(const v4u*)(up + 8);
    LAS f32x4* d = (LAS f32x4*)(ubuf + lane * 16);
    d[0] = (f32x4){bflo(w0.x), bfhi(w0.x), bflo(w0.y), bfhi(w0.y)}; d[1] = (f32x4){bflo(w0.z), bfhi(w0.z), bflo(w0.w), bfhi(w0.w)};
    d[2] = (f32x4){bflo(w1.x), bfhi(w1.x), bflo(w1.y), bfhi(w1.y)}; d[3] = (f32x4){bflo(w1.z), bfhi(w1.z), bflo(w1.w), bfhi(w1.w)};
}
#define S5_STEP(sidx) do { const LAS f32x4* up_ = (const LAS f32x4*)(ubuf + (sidx) * 16); const f32x4 u0 = up_[0], u1 = up_[1], u2 = up_[2], u3 = up_[3]; \
    float br = 0.f, bi = 0.f; \
    br += bb[0][0] * u0[0] + bb[0][2] * u0[1]; bi += bb[0][1] * u0[0] + bb[0][3] * u0[1]; br += bb[1][0] * u0[2] + bb[1][2] * u0[3]; bi += bb[1][1] * u0[2] + bb[1][3] * u0[3]; \
    br += bb[2][0] * u1[0] + bb[2][2] * u1[1]; bi += bb[2][1] * u1[0] + bb[2][3] * u1[1]; br += bb[3][0] * u1[2] + bb[3][2] * u1[3]; bi += bb[3][1] * u1[2] + bb[3][3] * u1[3]; \
    br += bb[4][0] * u2[0] + bb[4][2] * u2[1]; bi += bb[4][1] * u2[0] + bb[4][3] * u2[1]; br += bb[5][0] * u2[2] + bb[5][2] * u2[3]; bi += bb[5][1] * u2[2] + bb[5][3] * u2[3]; \
    br += bb[6][0] * u3[0] + bb[6][2] * u3[1]; bi += bb[6][1] * u3[0] + bb[6][3] * u3[1]; br += bb[7][0] * u3[2] + bb[7][2] * u3[3]; bi += bb[7][1] * u3[2] + bb[7][3] * u3[3]; \
    const float nr_ = ar * hr - ai * hi + br, ni_ = ar * hi + ai * hr + bi; hr = nr_; hi = ni_; } while (0)

__device__ __forceinline__ void s5_local(const bf16* proj, const float* abar, const float* bbar, float* sloc, LAS float* ubuf, int slot, int nslots, int lane) {
    for (int t = slot; t < 8192; t += nslots) {
        const int chunk = t & 63, g = (t >> 6) & 31, b = t >> 11;
        s5_stage_u(proj + (size_t)(b * 4096 + chunk * 64 + lane) * 1280 + g * 16, ubuf, lane);
        const float ar = abar[(g * 64 + lane) * 2], ai = abar[(g * 64 + lane) * 2 + 1];
        f32x4 bb[8];
#pragma unroll
        for (int i = 0; i < 8; ++i) bb[i] = *(const f32x4*)(bbar + (size_t)(g * 64 + lane) * 32 + i * 4);
        float hr = 0.f, hi = 0.f;
#pragma unroll 4
        for (int s = 0; s < 64; ++s) S5_STEP(s);
        *(f32x2v*)(sloc + (size_t)t * 128 + lane * 2) = (f32x2v){hr, hi};
    }
}
__device__ __forceinline__ void s5_out(const bf16* proj, const float* abar, const float* bbar, const float* sloc, const float* st_re, const float* st_im, const float* c_re, const float* c_im,
                                       const float* dcoef, bf16* gbuf, float* out, LAS float* ubuf, LAS unsigned* hbuf, int slot, int nslots, int lane) {
    const int fr = lane & 15, quad = lane >> 4;
    for (int t = slot; t < 8192 + 256; t += nslots) {
        const int sample = t >= 8192; int b, g, chunk, nblk, rowbase;
        if (!sample) { chunk = t & 63; g = (t >> 6) & 31; b = t >> 11; nblk = 4; rowbase = b * 4096 + chunk * 64; } else { const int s = t - 8192; g = s & 31; b = s >> 5; chunk = 0; nblk = 2; rowbase = MP + b * 32; }
        if (lane < nblk * 16) s5_stage_u(proj + (size_t)(rowbase + lane) * 1280 + g * 16, ubuf, lane);
        const float ar = abar[(g * 64 + lane) * 2], ai = abar[(g * 64 + lane) * 2 + 1];
        f32x4 bb[8];
#pragma unroll
        for (int i = 0; i < 8; ++i) bb[i] = *(const f32x4*)(bbar + (size_t)(g * 64 + lane) * 32 + i * 4);
        float hr, hi;
        if (!sample) { float pr = ar, pi = ai;
#pragma unroll
            for (int i = 0; i < 6; ++i) { const float t1 = pr * pr - pi * pi; pi = 2.f * pr * pi; pr = t1; }
            hr = 0.f; hi = 0.f; const float* sp = sloc + (size_t)(t - chunk) * 128 + lane * 2;
            for (int cc = 0; cc < chunk; ++cc) { const f32x2v sv = *(const f32x2v*)(sp + (size_t)cc * 128); const float nr = pr * hr - pi * hi + sv.x, ni = pr * hi + pi * hr + sv.y; hr = nr; hi = ni; } }
        else { hr = st_re[(b * 32 + g) * 64 + lane]; hi = st_im[(b * 32 + g) * 64 + lane]; }
        bf16x8 cf[4];
#pragma unroll
        for (int ks = 0; ks < 4; ++ks) { const f32x4 cr = *(const f32x4*)(c_re + (size_t)(g * 16 + fr) * 64 + ks * 16 + quad * 4), ci = *(const f32x4*)(c_im + (size_t)(g * 16 + fr) * 64 + ks * 16 + quad * 4);
            v4u w; w.x = pg8::cvt_pk_bf16(cr[0], -ci[0]); w.y = pg8::cvt_pk_bf16(cr[1], -ci[1]); w.z = pg8::cvt_pk_bf16(cr[2], -ci[2]); w.w = pg8::cvt_pk_bf16(cr[3], -ci[3]); cf[ks] = __builtin_bit_cast(bf16x8, w); }
        const float dco = dcoef[g * 16 + fr];
        for (int blk = 0; blk < nblk; ++blk) {
#pragma unroll 4
            for (int s = 0; s < 16; ++s) { S5_STEP(blk * 16 + s); hbuf[s * 68 + lane] = pg8::cvt_pk_bf16(hr, hi); }
            f32x4 y = {0.f, 0.f, 0.f, 0.f};
#pragma unroll
            for (int ks = 0; ks < 4; ++ks) { const bf16x8 a = *(const LAS bf16x8*)(hbuf + fr * 68 + ks * 16 + quad * 4); y = MFMA16(a, cf[ks], y); }
#pragma unroll
            for (int j = 0; j < 4; ++j) { const int s = blk * 16 + quad * 4 + j; const float uu = ubuf[s * 16 + fr]; const float yv = y[j] + dco * uu;
                const float z = 0.7978845608028654f * (yv + 0.044715f * yv * yv * yv); const float th = 1.0f - 2.0f / (1.0f + __expf(2.0f * z)); const float gl = 0.5f * yv * (1.0f + th);
                gbuf[(size_t)(rowbase + s) * 512 + g * 16 + fr] = (bf16)f2bf(gl); }
        }
        if (!sample && chunk == 63) { out[OFF_SRP + (b * 32 + g) * 64 + lane] = hr; out[OFF_SIP + (b * 32 + g) * 64 + lane] = hi; }
        if (sample) { out[OFF_SRS + (b * 32 + g) * 64 + lane] = hr; out[OFF_SIS + (b * 32 + g) * 64 + lane] = hi; }
    }
}

struct Params { const float* in[36]; float* out; unsigned char* ws; int use_cg, pad; };

__global__ void __launch_bounds__(512, 2) mega_fwd(Params P) {
    extern __shared__ __attribute__((aligned(16))) unsigned char lds_raw[];
    LAS unsigned char* lds = (LAS unsigned char*)lds_raw;
    volatile LAS unsigned* MISC = (volatile LAS unsigned*)(lds + MISC_OFF);
    const int G = gridDim.x, NGW = G * 8, NT = G * 512;
    const int wave_s = __builtin_amdgcn_readfirstlane(threadIdx.x >> 6);
    for (int u = threadIdx.x; u < (LDS_BYTES - 131072) / 4; u += 512) ((LAS unsigned*)(lds + 131072))[u] = 0u;
    __syncthreads();
    XcdBarrier bar = xcd_barrier_post((unsigned*)(P.ws + WS_BAR), MISC + 8);
#ifndef STOP_AFTER
#define STOP_AFTER 1000
#endif
    int ph = 0;
#define RUN (ph < STOP_AFTER)
#define FRESH() const int tid = fresh_tid(wave_s), lane = tid & 63, wave = __builtin_amdgcn_readfirstlane(tid >> 6); const int gw = blockIdx.x * 8 + wave, gt = blockIdx.x * 512 + tid; (void)gw; (void)gt; (void)lane; LAS float* wscr = (LAS float*)(lds + 32768 + wave * 12288); (void)wscr;
#define SEAM() do { if (P.use_cg) cg::this_grid().sync(); else xcd_barrier(bar); ++ph; } while (0)

#define part ((float*)(ws + WS_PART))
#define PARTBUF(k) (part + (size_t)((k) & 1) * PART_ELEMS)
#define ropec ((float*)(ws + WS_ROPE))
#define ropes (ropec + 4096 * 32)
#define abar ((float*)(ws + WS_SSM))
#define bbar (abar + 32 * 64 * 2)
#define ckb ((bf16*)(ws + WS_CKV))
#define cvb (ckb + 8 * 128 * 128)
#define sloc ((float*)(ws + WS_SLOC))
#define memk ((bf16*)(ws + WS_MEMK))
#define memvT ((bf16*)(ws + WS_MEMVT))
#define SG ((float*)(ws + WS_SIDE))
#define SV ((float*)(ws + WS_SIDE + SG_BYTES))
#define WT ((bf16*)(ws + WS_WT))
#define xb ((bf16*)(ws + WS_XB))
#define tmp (ws + WS_TMP)
#define proj0 ((bf16*)(tmp + TMP_PROJ0))
#define gbuf ((bf16*)(tmp + TMP_GBUF))
#define ycat ((bf16*)(tmp + TMP_YCAT))
#define memb ((bf16*)(tmp + TMP_MEMB))
#define qx ((bf16*)(tmp + TMP_QX))
#define ox ((bf16*)(tmp + TMP_OX))
#define act ((bf16*)(tmp + TMP_ACT))
#define gbm ((bf16*)(tmp + TMP_GB))
#define zc ((bf16*)(tmp + TMP_ZC))
#define PTRS() unsigned char* ws = P.ws; float* out = P.out; asm volatile("" : "+s"(ws), "+s"(out));
    if (RUN) { PTRS() FRESH()
        {
            constexpr int NITEMS = 640 + 128 + 512 + 2 * 512 + 2 * 1024 + 2 * 512 + 2 * 2816 + 2 * 1408 + 1536 + 512 + 2048;
            for (int it = gw; it < NITEMS; it += NGW) { int r = it;
#define TR(Wp, K_, N_, WTp, gainp, sc, mode) { const int ni_ = ((K_) / 64) * ((N_) / 32); if (r < ni_) { tr_item(Wp, K_, N_, WTp, gainp, sc, mode, wscr, r, lane); continue; } r -= ni_; }
                TR(P.in[15], 1024, 1280, WT + WT_INEVEN, P.in[11], 1.f, 1)
                TR(P.in[25], 512, 512, WT + WT_GLU, nullptr, 1.f, 0)
                TR(P.in[16], 1024, 1024, WT + WT_OUTEVEN, nullptr, 1.f, 0)
                TR(P.in[30], 1024, 1024, WT + WT_WQ, P.in[12], 0.0625f, 0)
                TR(P.in[30] + 1048576, 1024, 1024, WT + WT_WQ + 1048576, P.in[12] + 1024, 0.0625f, 0)
                TR(P.in[31], 1024, 2048, WT + WT_WKV, nullptr, 1.f, 0)
                TR(P.in[31] + 2097152, 1024, 2048, WT + WT_WKV + 2097152, nullptr, 1.f, 0)
                TR(P.in[32], 1024, 1024, WT + WT_WO, nullptr, 1.f, 0)
                TR(P.in[32] + 1048576, 1024, 1024, WT + WT_WO + 1048576, nullptr, 1.f, 0)
                TR(P.in[33], 1024, 5632, WT + WT_UP, P.in[13], 1.f, 2)
                TR(P.in[33] + (size_t)1024 * 5632, 1024, 5632, WT + WT_UP + (size_t)5632 * 1024, P.in[13] + 1024, 1.f, 2)
                TR(P.in[35], 2816, 1024, WT + WT_DOWN, nullptr, 1.f, 0)
                TR(P.in[35] + (size_t)2816 * 1024, 2816, 1024, WT + WT_DOWN + (size_t)2816 * 1024, nullptr, 1.f, 0)
                TR(P.in[27], 1024, 3072, WT + WT_INODD, P.in[11] + 1024, 1.f, 3)
                TR(P.in[29], 1024, 1024, WT + WT_OUTODD, nullptr, 1.f, 0)
                { const int mi = r >> 7, l = mi >> 3, b = mi & 7; tr_item(P.in[10] + (size_t)mi * 262144, 256, 1024, memvT + (size_t)(l * 12 + 4 + b) * 262144, nullptr, 1.f, 0, wscr, r & 127, lane); }
            }
        }
        for (int m = gw; m < MROWS; m += NGW) { const float* xr = m < MP ? P.in[0] + (size_t)m * 1024 : P.in[1] + (size_t)(m - MP) * 1024; float ss = 0.f;
#pragma unroll
            for (int j = 0; j < 4; ++j) { const f32x4 v = *(const f32x4*)(xr + (lane + 64 * j) * 4); ss += (v[0] * v[0] + v[1] * v[1]) + (v[2] * v[2] + v[3] * v[3]);
                u32x2v w; w.x = pg8::cvt_pk_bf16(v[0], v[1]); w.y = pg8::cvt_pk_bf16(v[2], v[3]); *(u32x2v*)(xb + (size_t)m * 1024 + (lane + 64 * j) * 4) = w; }
            ss = wave_sum(ss); if (lane < 16) PARTBUF(0)[(size_t)m * 16 + lane] = lane == 0 ? ss : 0.f; }
        for (int i = gt; i < 262144; i += NT) { const f32x4 v = *(const f32x4*)(P.in[2] + (size_t)i * 4); u32x2v w; w.x = pg8::cvt_pk_bf16(v[0], v[1]); w.y = pg8::cvt_pk_bf16(v[2], v[3]); *(u32x2v*)(memb + (size_t)i * 4) = w; }
        for (int i = gt; i < 1048576; i += NT) { const size_t e = (size_t)i * 4; const int lb = (int)(e >> 18), l = lb >> 3, b = lb & 7; const f32x4 v = *(const f32x4*)(P.in[9] + e);
            u32x2v w; w.x = pg8::cvt_pk_bf16(v[0], v[1]); w.y = pg8::cvt_pk_bf16(v[2], v[3]); *(u32x2v*)(memk + (size_t)(l * 12 + 4 + b) * 262144 + (e & 262143)) = w; }
        for (int i = gt; i < 65536; i += NT) { const int j = i & 32767; const float* src = (i < 32768 ? P.in[3] : P.in[4]) + (size_t)j * 4; bf16* dst = (i < 32768 ? ckb : cvb) + (size_t)j * 4;
            const f32x4 v = *(const f32x4*)src; u32x2v w; w.x = pg8::cvt_pk_bf16(v[0], v[1]); w.y = pg8::cvt_pk_bf16(v[2], v[3]); *(u32x2v*)dst = w; }
        for (int i = gt; i < 4096 * 32; i += NT) { const int pos = i >> 5, d = i & 31; const double inv = dexp_(-(double)d * (9.210340371976184 / 32.0)); double s, c; dsincos_((double)pos * inv, s, c); ropec[i] = (float)c; ropes[i] = (float)s; }
        for (int i = gt; i < 2048; i += NT) { const double are = P.in[17][i], aim = P.in[18][i], dt = dexp_((double)P.in[19][i]); double s, c; dsincos_(aim * dt, s, c); const double mag = dexp_(are * dt);
            const double br = mag * c, bi = mag * s; abar[2 * i] = (float)br; abar[2 * i + 1] = (float)bi;
            const double nr = br - 1.0, ni = bi, den = are * are + aim * aim; const double qr = (nr * are + ni * aim) / den, qi = (ni * are - nr * aim) / den;
#pragma unroll 4
            for (int h = 0; h < 16; ++h) { const double xr = P.in[20][(size_t)i * 16 + h], xi = P.in[21][(size_t)i * 16 + h]; bbar[(size_t)i * 32 + 2 * h] = (float)(qr * xr - qi * xi); bbar[(size_t)i * 32 + 2 * h + 1] = (float)(qr * xi + qi * xr); } }
    }
    SEAM();
    if (RUN) { PTRS()
        { pg8::Gemm g{memb, WT + WT_WKV, 1024, 4096, 1024}; pg8::StaticOrder S; S.init(1024, 4096, G, (int)blockIdx.x); EpiKV E{out, memk};
          pg8::gemm_phase<EpiKV, pg8::StaticOrder, true, true>(lds, g, S, E, wave_s); }
        { pg8::Gemm g{xb, WT + WT_INEVEN, MROWS, 1280, 1024}; pg8::StaticOrderF S; S.init(MROWS, 1280, G, (int)blockIdx.x); EpiIn0 E{proj0, PARTBUF(0), ropec, ropes, out};
          pg8::gemm_phase<EpiIn0, pg8::StaticOrderF, true, true>(lds, g, S, E, wave_s); }
    }
    SEAM();
    if (RUN) { PTRS() FRESH()
        swa_phase(proj0, ckb, cvb, P.in[26], ycat, lds, tid, wave, lane, G);
        s5_local(proj0, abar, bbar, sloc, wscr, wave * G + (int)blockIdx.x, NGW, lane);
        for (int it = wave * G + (int)blockIdx.x; it < 1024; it += NGW) { const int mi = it >> 7, l = mi >> 2, b = mi & 3;
            tr_item(out + OFF_MVP + (size_t)mi * 262144, 256, 1024, memvT + (size_t)(l * 12 + b) * 262144, nullptr, 1.f, 0, wscr, it & 127, lane); }
    }
    SEAM();
    if (RUN) { PTRS() FRESH() s5_out(proj0, abar, bbar, sloc, P.in[5], P.in[6], P.in[22], P.in[23], P.in[24], gbuf, out, wscr, (LAS unsigned*)(wscr + 1024), wave * G + (int)blockIdx.x, NGW, lane); }
    SEAM();
    if (RUN) { PTRS() pg8::Gemm g{gbuf, WT + WT_GLU, MROWS, 512, 512}; pg8::StaticOrder S; S.init(MROWS, 512, G, (int)blockIdx.x); EpiGlu E{gbuf, ycat};
        pg8::gemm_phase<EpiGlu, pg8::StaticOrder, true, true>(lds, g, S, E, wave_s); }
    SEAM();

#pragma unroll
    for (int l = 0; l < 2; ++l) {
        if (l == 1) {
            if (RUN) { PTRS() pg8::Gemm g{xb, WT + WT_INODD, MROWS, 3072, 1024}; pg8::StaticOrderF S; S.init(MROWS, 3072, G, (int)blockIdx.x); EpiInOdd E{gbm, zc, PARTBUF(3), P.in[28], SG};
                pg8::gemm_phase<EpiInOdd, pg8::StaticOrderF, true, true>(lds, g, S, E, wave_s); }
            SEAM();
            if (RUN) { PTRS() FRESH()
                const float* cw = P.in[28]; const float* st = P.in[7];
                for (int i = gt; i < MROWS * 128; i += NT) { const int row = i >> 7, c0 = (i & 127) * 8, blk = row >> 6, r = row & 63;
                    const bool smp = row >= MP; const int rr = smp ? (r & 31) : r;
                    f32x4 z0, z1;
                    if (rr < 2) { const int sb = smp ? (r >> 5) * 4 : 0;
                        f32x4 pa0, pa1, pb0, pb1;
                        if (smp) { const int b = (blk - 256) * 2 + (r >> 5); const float* s0 = st + (size_t)(b * 2) * 1024 + c0; pa0 = *(const f32x4*)s0; pa1 = *(const f32x4*)(s0 + 4); pb0 = *(const f32x4*)(s0 + 1024); pb1 = *(const f32x4*)(s0 + 1028); }
                        else if ((blk & 63) == 0) { pa0 = pa1 = pb0 = pb1 = (f32x4){0.f, 0.f, 0.f, 0.f}; }
                        else { const float* s0 = SG + (size_t)((blk - 1) * 8 + 6) * 1024 + c0; pa0 = *(const f32x4*)s0; pa1 = *(const f32x4*)(s0 + 4); pb0 = *(const f32x4*)(s0 + 1024); pb1 = *(const f32x4*)(s0 + 1028); }
                        const float* sc = SG + (size_t)(blk * 8 + sb) * 1024 + c0; const f32x4 x00 = *(const f32x4*)sc, x01 = *(const f32x4*)(sc + 4);
                        f32x4 xm2a, xm2b, xm1a, xm1b, xca, xcb;
                        if (rr == 0) { xm2a = pa0; xm2b = pa1; xm1a = pb0; xm1b = pb1; xca = x00; xcb = x01; }
                        else { xm2a = pb0; xm2b = pb1; xm1a = x00; xm1b = x01; xca = *(const f32x4*)(sc + 1024); xcb = *(const f32x4*)(sc + 1028); }
                        const f32x4 w0a = *(const f32x4*)(cw + c0), w0b = *(const f32x4*)(cw + c0 + 4), w1a = *(const f32x4*)(cw + 1024 + c0), w1b = *(const f32x4*)(cw + 1028 + c0), w2a = *(const f32x4*)(cw + 2048 + c0), w2b = *(const f32x4*)(cw + 2052 + c0);
                        z0 = w0a * xm2a + w1a * xm1a + w2a * xca; z1 = w0b * xm2b + w1b * xm1b + w2b * xcb; }
                    else { const v4u zw = *(const v4u*)(zc + (size_t)row * 1024 + c0); z0 = (f32x4){bflo(zw.x), bfhi(zw.x), bflo(zw.y), bfhi(zw.y)}; z1 = (f32x4){bflo(zw.z), bfhi(zw.z), bflo(zw.w), bfhi(zw.w)}; }
                    const v4u gw_ = *(const v4u*)(gbm + (size_t)row * 1024 + c0);
                    const f32x4 g0 = (f32x4){bflo(gw_.x), bfhi(gw_.x), bflo(gw_.y), bfhi(gw_.y)}, g1 = (f32x4){bflo(gw_.z), bfhi(gw_.z), bflo(gw_.w), bfhi(gw_.w)};
                    *(v4u*)(gbm + (size_t)row * 1024 + c0) = pack8(g0 * z0, g1 * z1); }
                for (int i = gt; i < 4 * 2 * 1024; i += NT) { const int c = i & 1023, j = (i >> 10) & 1, b = i >> 11; out[OFF_CMP + i] = SG[(size_t)((64 * b + 63) * 8 + 6 + j) * 1024 + c]; }
                for (int i = gt; i < 8 * 2 * 1024; i += NT) { const int c = i & 1023, j = (i >> 10) & 1, b = i >> 11; out[OFF_CMS + i] = SG[(size_t)((256 + (b >> 1)) * 8 + (b & 1) * 4 + 2 + j) * 1024 + c]; }
            }
            SEAM();
        }
        if (RUN) { PTRS() pg8::Gemm g{(bf16*)(tmp + (size_t)(1 - l) * TMP_YCAT), WT + WT_OUTEVEN + (size_t)l * (WT_OUTODD - WT_OUTEVEN), MROWS, 1024, 1024}; pg8::StaticOrderF S; S.init(MROWS, 1024, G, (int)blockIdx.x);
            EpiRes E{l == 0 ? P.in[0] : out, l == 0 ? P.in[1] - (size_t)MP * 1024 : out, out, xb, PARTBUF(1 + 3 * l)};
            pg8::gemm_phase<EpiRes, pg8::StaticOrderF, true, true>(lds, g, S, E, wave_s); }
        SEAM();
        if (RUN) { PTRS() pg8::Gemm g{xb, WT + WT_WQ + (size_t)l * 1048576, MROWS, 1024, 1024}; pg8::StaticOrderF S; S.init(MROWS, 1024, G, (int)blockIdx.x); EpiBf16 E{qx, 1024, PARTBUF(1 + 3 * l)};
            pg8::gemm_phase<EpiBf16, pg8::StaticOrderF, true, true>(lds, g, S, E, wave_s); }
        SEAM();
        if (RUN) { PTRS() FRESH() xattn_phase2(qx, memk + (size_t)l * 12 * 262144, memvT + (size_t)l * 12 * 262144, ox, lds, tid, wave, lane, G); }
        SEAM();
        if (RUN) { PTRS() pg8::Gemm g{ox, WT + WT_WO + (size_t)l * 1048576, MROWS, 1024, 1024}; pg8::StaticOrderF S; S.init(MROWS, 1024, G, (int)blockIdx.x); EpiRes E{out, out, out, xb, PARTBUF(2 + 3 * l)};
            pg8::gemm_phase<EpiRes, pg8::StaticOrderF, true, true>(lds, g, S, E, wave_s); }
        SEAM();
        if (RUN) { PTRS() pg8::Gemm g{xb, WT + WT_UP + (size_t)l * 5632 * 1024, MROWS, 5632, 1024}; pg8::StaticOrderF S; S.init(MROWS, 5632, G, (int)blockIdx.x);
            EpiFfnUp E{act, PARTBUF(2 + 3 * l), P.in[34] + (size_t)l * 3 * DFF, SG, SV};
            pg8::gemm_phase<EpiFfnUp, pg8::StaticOrderF, true, true>(lds, g, S, E, wave_s); }
        SEAM();
        if (RUN) { PTRS() FRESH()
            const float* cw = P.in[34] + (size_t)l * 3 * DFF; const float* st = P.in[8] + (size_t)l * 8 * 2 * DFF;
            for (int i = gt; i < 528 * 352; i += NT) { const int fi = i / 352, c0 = (i % 352) * 8; int blk, row, rr, sb, vb; bool smp = fi >= 512;
                if (!smp) { blk = fi >> 1; rr = fi & 1; row = blk * 64 + rr; sb = 0; vb = 0; } else { const int s = fi - 512, half = (s >> 1) & 1; blk = 256 + (s >> 2); rr = s & 1; row = blk * 64 + half * 32 + rr; sb = half * 4; vb = half * 2; }
                f32x4 pa0, pa1, pb0, pb1;
                if (smp) { const int b = (blk - 256) * 2 + (sb >> 2); const float* s0 = st + (size_t)(b * 2) * DFF + c0; pa0 = *(const f32x4*)s0; pa1 = *(const f32x4*)(s0 + 4); pb0 = *(const f32x4*)(s0 + DFF); pb1 = *(const f32x4*)(s0 + DFF + 4); }
                else if ((blk & 63) == 0) { pa0 = pa1 = pb0 = pb1 = (f32x4){0.f, 0.f, 0.f, 0.f}; }
                else { const float* s0 = SG + (size_t)((blk - 1) * 8 + 6) * DFF + c0; pa0 = *(const f32x4*)s0; pa1 = *(const f32x4*)(s0 + 4); pb0 = *(const f32x4*)(s0 + DFF); pb1 = *(const f32x4*)(s0 + DFF + 4); }
                const float* sc = SG + (size_t)(blk * 8 + sb) * DFF + c0; const f32x4 x00 = *(const f32x4*)sc, x01 = *(const f32x4*)(sc + 4);
                f32x4 xm2a, xm2b, xm1a, xm1b, xca, xcb;
                if (rr == 0) { xm2a = pa0; xm2b = pa1; xm1a = pb0; xm1b = pb1; xca = x00; xcb = x01; }
                else { xm2a = pb0; xm2b = pb1; xm1a = x00; xm1b = x01; xca = *(const f32x4*)(sc + DFF); xcb = *(const f32x4*)(sc + DFF + 4); }
                const f32x4 w0a = *(const f32x4*)(cw + c0), w0b = *(const f32x4*)(cw + c0 + 4), w1a = *(const f32x4*)(cw + DFF + c0), w1b = *(const f32x4*)(cw + DFF + c0 + 4), w2a = *(const f32x4*)(cw + 2 * DFF + c0), w2b = *(const f32x4*)(cw + 2 * DFF + c0 + 4);
                const f32x4 ga = w0a * xm2a + w1a * xm1a + w2a * xca, gb_ = w0b * xm2b + w1b * xm1b + w2b * xcb;
                const float* sv = SV + (size_t)(blk * 4 + vb + rr) * DFF + c0; const f32x4 va = *(const f32x4*)sv, vb_ = *(const f32x4*)(sv + 4);
                f32x4 a0, a1;
#pragma unroll
                for (int j = 0; j < 4; ++j) { a0[j] = ga[j] * sigmoidf_(ga[j]) * va[j]; a1[j] = gb_[j] * sigmoidf_(gb_[j]) * vb_[j]; }
                *(v4u*)(act + (size_t)row * DFF + c0) = pack8(a0, a1); }
            for (int i = gt; i < 4 * 2 * DFF; i += NT) { const int c = i % DFF, j = (i / DFF) & 1, b = i / (2 * DFF); out[OFF_CFP + (size_t)l * 4 * 2 * DFF + i] = SG[(size_t)((64 * b + 63) * 8 + 6 + j) * DFF + c]; }
            for (int i = gt; i < 8 * 2 * DFF; i += NT) { const int c = i % DFF, j = (i / DFF) & 1, b = i / (2 * DFF); out[OFF_CFS + (size_t)l * 8 * 2 * DFF + i] = SG[(size_t)((256 + (b >> 1)) * 8 + (b & 1) * 4 + 2 + j) * DFF + c]; }
        }
        SEAM();
        if (RUN) { PTRS() pg8::Gemm g{act, WT + WT_DOWN + (size_t)l * 2816 * 1024, MROWS, 1024, DFF}; pg8::StaticOrderF S; S.init(MROWS, 1024, G, (int)blockIdx.x); EpiRes E{out, out, out, xb, PARTBUF(3 + 3 * l)};
            pg8::gemm_phase<EpiRes, pg8::StaticOrderF, true, true>(lds, g, S, E, wave_s); }
        SEAM();
    }
    if (RUN) { PTRS() FRESH()
        const float* gf = P.in[14];
        for (int m = gw; m < MROWS; m += NGW) { const float rs = rstd_of(PARTBUF(6), m); float* xr = out + (size_t)m * 1024;
#pragma unroll
            for (int j = 0; j < 4; ++j) { const int c = (lane + 64 * j) * 4; const f32x4 v = *(const f32x4*)(xr + c), gg = *(const f32x4*)(gf + c); *(f32x4*)(xr + c) = v * rs * gg; } }
    }
}

extern "C" void kernel_launch(void* const* d_in, const int* in_sizes, int n_in, void* d_out, int out_size, void* d_ws, size_t ws_size, hipStream_t stream) {
    static int grid = 0;
    if (grid == 0) {
        int dev = 0, cus = 0, per_cu = 0;
        if (n_in != 36 || ws_size < 256 * MiB) { fprintf(stderr, "kernel_launch: unexpected n_in %d / ws %zu\n", n_in, ws_size); grid = -1; return; }
        (void)hipGetDevice(&dev); (void)hipDeviceGetAttribute(&cus, hipDeviceAttributeMultiprocessorCount, dev);
        if (hipFuncSetAttribute((const void*)mega_fwd, hipFuncAttributeMaxDynamicSharedMemorySize, LDS_BYTES) != hipSuccess) { fprintf(stderr, "kernel_launch: hipFuncSetAttribute failed\n"); grid = -1; return; }
        if (hipOccupancyMaxActiveBlocksPerMultiprocessor(&per_cu, (const void*)mega_fwd, 512, LDS_BYTES) != hipSuccess || per_cu < 1) per_cu = 1;
        (void)hipGetLastError();
        grid = cus * 1;
        if (grid > 256) grid = 256;
    }
    if (grid < 0) return;
    (void)hipMemsetAsync(d_ws, 0, CTL_ZERO_BYTES, stream);
    Params p{};
    for (int i = 0; i < 36; ++i) p.in[i] = (const float*)d_in[i];
    p.out = (float*)d_out; p.ws = (unsigned char*)d_ws; p.use_cg = 0; p.pad = 0;
    void* args[] = {&p};
    hipError_t e = hipLaunchCooperativeKernel((const void*)mega_fwd, dim3(grid), dim3(512), args, LDS_BYTES, stream);
    if (e != hipSuccess) fprintf(stderr, "cooperative launch failed: %s (grid %d)\n", hipGetErrorString(e), grid);
}
```

```cpp
#include <hip/hip_runtime.h>
#include <hip/hip_cooperative_groups.h>
#include <cstdio>
#include <cstdint>
namespace cg = cooperative_groups;
__device__ __forceinline__ int fresh_tid(int wave_s) { unsigned z = 0u; asm volatile("" : "+s"(z)); int t = wave_s * 64 + (int)__builtin_amdgcn_mbcnt_hi(~0u, __builtin_amdgcn_mbcnt_lo(~0u, z)); asm volatile("" : "+v"(t)); return t; }
namespace pg8 {
#define PG8_LAS __attribute__((address_space(3)))
typedef unsigned short bf16_t;
typedef short bf16x8 __attribute__((ext_vector_type(8)));
typedef float f32x4 __attribute__((ext_vector_type(4)));
typedef unsigned u32x4 __attribute__((ext_vector_type(4)));
constexpr int BM = 256, BK = 64, HALF = 128, HTB = HALF * BK * 2  , STAGE_BYTES = 8 * HTB, NXCD = 8, WGM = 8;

__host__ __device__ __forceinline__ int lds_byte(int r, int c) { const int st = (r >> 4) * 2 + (c >> 5), rr = r & 15, cc = c & 31, ob = rr * 64 + cc * 2; return st * 1024 + (ob ^ (((ob >> 9) & 1) << 5)); }
__host__ __device__ __forceinline__ void stage_rc(int b, int& R, int& C) { const int st = b / 1024, sb = b % 1024, swz = sb ^ (((sb >> 9) & 1) << 5); R = (st >> 1) * 16 + swz / 64; C = (st & 1) * 32 + (swz % 64) / 2; }
__host__ __device__ __forceinline__ int perm32(int rho) { const int n = rho >> 4, i = rho & 15; return 8 * (i >> 2) + 4 * n + (i & 3); }

struct Unit { int pm, pn; };
struct Gemm { const bf16_t* A; const bf16_t* Bt; int M, N, K; };

template <bool FULL> struct StaticOrderT {
    int nM, nN, nwg, G, c;
    __host__ __device__ void init(int M, int N, int G_, int c_) { nM = M / BM; nN = N / BM; nwg = nM * nN; G = G_; c = c_; }
    __host__ __device__ bool next(int i, Unit& u) const {
        const long L = (long)i * G + c; if (!(FULL && i == 0) && L >= nwg) return false;
        int wgid = (int)L; { const int q = nwg / NXCD, r = nwg % NXCD, xcd = wgid % NXCD, off = wgid / NXCD; wgid = (xcd < r ? xcd * (q + 1) : r * (q + 1) + (xcd - r) * q) + off; }
        const int nig = WGM * nN, gid = wgid / nig, fm = gid * WGM, gsz = (nM - fm) < WGM ? (nM - fm) : WGM;
        u.pm = fm + ((wgid % nig) % gsz); u.pn = (wgid % nig) / gsz; return true;
    }
    __device__ __forceinline__ void a_ready(const Unit&) const {}
    __device__ __forceinline__ void done(const Unit&) const {}
};

typedef StaticOrderT<false> StaticOrder; typedef StaticOrderT<true> StaticOrderF;
__device__ __forceinline__ unsigned cvt_pk_bf16(float lo, float hi) { unsigned r; asm volatile("v_cvt_pk_bf16_f32 %0, %1, %2" : "=v"(r) : "v"(lo), "v"(hi)); return r; }
typedef float f32x2 __attribute__((ext_vector_type(2)));
template <class Epi, class Sched, bool ALIGN_EPI = false, bool SP2 = false>
__device__ __forceinline__ void gemm_phase(PG8_LAS unsigned char* lds, const Gemm g, const Sched& S, const Epi& E, const int wave_s) {
    const int tid = fresh_tid(wave_s), wid = __builtin_amdgcn_readfirstlane(tid >> 6), lane = tid & 63, wr = wid >> 2, wc = wid & 3, fr = lane & 15, fq = lane >> 4;
    const int K = g.K, nt = K / BK;
    unsigned voffA[2], voffB[2];
#pragma unroll
    for (int i = 0; i < 2; ++i) { int R, C; stage_rc(tid * 16 + i * 8192, R, C); const int Rb = Epi::PERM ? ((R & ~31) + perm32(R & 31)) : R;
        voffA[i] = (unsigned)(R * K + C) * 2u; voffB[i] = (unsigned)(Rb * K + C) * 2u; }
    const size_t kstep = (size_t)(BK * 2);
    const size_t hstep = (size_t)HALF * K * 2;
    const size_t tstep = 2 * hstep;
    const unsigned ldsw = (unsigned)wid * 1024u;
    const int aoff = lds_byte(wr * 64 + fr, fq * 8), boff = lds_byte(wc * 32 + fr, fq * 8);
#define PG8_SA(b, h) (((b) * 2 + (h)) * HTB)
#define PG8_SB(b, h) ((4 + (b) * 2 + (h)) * HTB)
#define PG8_STAGE(bufoff, gbase, voff) do { _Pragma("unroll") for (int _i = 0; _i < 2; ++_i) \
        __builtin_amdgcn_global_load_lds((const unsigned*)((const char*)(gbase) + (voff)[_i]), (PG8_LAS unsigned*)(lds + (bufoff) + ldsw + _i * 8192), 16, 0, 0); } while (0)
#define PG8_LDA(dst, b, h) do { _Pragma("unroll") for (int m = 0; m < 4; ++m) _Pragma("unroll") for (int k = 0; k < 2; ++k) dst[m][k] = *(const PG8_LAS bf16x8*)(lds + PG8_SA(b, h) + aoff + m * 2048 + k * 1024); } while (0)
#define PG8_LDB(dst, b, h) do { _Pragma("unroll") for (int n = 0; n < 2; ++n) _Pragma("unroll") for (int k = 0; k < 2; ++k) dst[n][k] = *(const PG8_LAS bf16x8*)(lds + PG8_SB(b, h) + boff + n * 2048 + k * 1024); } while (0)
#define PG8_MMA(ai, bj, At, Bt) do { __builtin_amdgcn_s_setprio(1); _Pragma("unroll") for (int m = 0; m < 4; ++m) _Pragma("unroll") for (int n = 0; n < 2; ++n) _Pragma("unroll") for (int k = 0; k < 2; ++k) \
        acc[ai][bj][m][n] = __builtin_amdgcn_mfma_f32_16x16x32_bf16(Bt[n][k], At[m][k], acc[ai][bj][m][n], 0, 0, 0); __builtin_amdgcn_s_setprio(0); } while (0)
#define PG8_WAIT_V(n) asm volatile("s_waitcnt vmcnt(" #n ")" ::: "memory")
#define PG8_WAIT_L(n) asm volatile("s_waitcnt lgkmcnt(" #n ")" ::: "memory")
#define PG8_BAR __builtin_amdgcn_s_barrier()
#define PG8_SCHED __builtin_amdgcn_sched_barrier(0)
    Unit cur, nxt; int ui = 0;
    if (!S.next(0, cur)) return;
    f32x4 acc[2][2][4][2];
#pragma unroll
    for (int a = 0; a < 2; ++a)
#pragma unroll
        for (int b = 0; b < 2; ++b)
#pragma unroll
            for (int m = 0; m < 4; ++m)
#pragma unroll
                for (int n = 0; n < 2; ++n) acc[a][b][m][n] = (f32x4){0.f, 0.f, 0.f, 0.f};
    bf16x8 At[4][2], B0[2][2], B1[2][2];
    const char* cA = (const char*)g.A + (size_t)cur.pm * tstep; const char* cB = (const char*)g.Bt + (size_t)cur.pn * tstep;
    S.a_ready(cur);
    if constexpr (SP2) {
        PG8_STAGE(PG8_SB(0, 0), cB, voffB); PG8_STAGE(PG8_SB(0, 1), cB + hstep, voffB); PG8_STAGE(PG8_SA(0, 0), cA, voffA); PG8_STAGE(PG8_SA(0, 1), cA + hstep, voffA);
        if (wr == 1) PG8_BAR;
        PG8_WAIT_V(2); PG8_BAR;
        PG8_STAGE(PG8_SB(1, 0), cB + kstep, voffB); PG8_STAGE(PG8_SA(1, 0), cA + kstep, voffA); PG8_STAGE(PG8_SB(1, 1), cB + hstep + kstep, voffB);
        PG8_WAIT_V(6); PG8_BAR;
    } else {
        PG8_STAGE(PG8_SB(0, 0), cB, voffB); PG8_STAGE(PG8_SA(0, 0), cA, voffA); PG8_STAGE(PG8_SB(0, 1), cB + hstep, voffB); PG8_STAGE(PG8_SA(0, 1), cA + hstep, voffA);
        if (wr == 1) PG8_BAR;
        PG8_WAIT_V(4); PG8_BAR;
        PG8_STAGE(PG8_SB(1, 0), cB + kstep, voffB); PG8_STAGE(PG8_SA(1, 0), cA + kstep, voffA); PG8_STAGE(PG8_SB(1, 1), cB + hstep + kstep, voffB);
        PG8_WAIT_V(6); PG8_BAR;
    }
    for (;;) {
        const bool has_next = S.next(ui + 1, nxt);
        const char* nA = has_next ? (const char*)g.A + (size_t)nxt.pm * tstep : cA; const char* nB = has_next ? (const char*)g.Bt + (size_t)nxt.pn * tstep : cB;
        for (int t = 0; t < nt; t += 2) {
            const bool last = (t == nt - 2);
            const char* a1 = cA + (size_t)(t + 1) * kstep;
            const char* a2 = last ? nA : cA + (size_t)(t + 2) * kstep; const char* b2 = last ? nB : cB + (size_t)(t + 2) * kstep;
            const char* a3 = a2 + kstep; const char* b3 = b2 + kstep;
            if (last && has_next) S.a_ready(nxt);
            if constexpr (SP2) {
            PG8_LDB(B0, 0, 0); PG8_LDB(B1, 0, 1); PG8_SCHED; PG8_LDA(At, 0, 0); PG8_STAGE(PG8_SA(1, 1), a1 + hstep, voffA);
            PG8_WAIT_V(8); PG8_WAIT_L(0); PG8_BAR; PG8_MMA(0, 0, At, B0); PG8_MMA(0, 1, At, B1); PG8_BAR; PG8_SCHED;
            PG8_LDA(At, 0, 1); PG8_STAGE(PG8_SB(0, 0), b2, voffB); PG8_STAGE(PG8_SB(0, 1), b2 + hstep, voffB); PG8_STAGE(PG8_SA(0, 0), a2, voffA);
            PG8_WAIT_V(8); PG8_WAIT_L(0); PG8_BAR; PG8_MMA(1, 0, At, B0); PG8_MMA(1, 1, At, B1); PG8_BAR; PG8_SCHED;
            PG8_LDB(B0, 1, 0); PG8_LDB(B1, 1, 1); PG8_SCHED; PG8_LDA(At, 1, 0); PG8_STAGE(PG8_SA(0, 1), a2 + hstep, voffA);
            PG8_WAIT_V(8); PG8_WAIT_L(0); PG8_BAR; PG8_MMA(0, 0, At, B0); PG8_MMA(0, 1, At, B1); PG8_BAR; PG8_SCHED;
            PG8_LDA(At, 1, 1); PG8_STAGE(PG8_SB(1, 0), b3, voffB); PG8_STAGE(PG8_SB(1, 1), b3 + hstep, voffB); PG8_STAGE(PG8_SA(1, 0), a3, voffA);
            PG8_WAIT_V(8); PG8_WAIT_L(0); PG8_BAR; PG8_MMA(1, 0, At, B0); PG8_MMA(1, 1, At, B1); PG8_BAR; PG8_SCHED;
            } else {
            PG8_LDB(B0, 0, 0); PG8_SCHED; PG8_LDA(At, 0, 0); PG8_STAGE(PG8_SA(1, 1), a1 + hstep, voffA);
            PG8_WAIT_L(8); PG8_BAR; PG8_WAIT_L(0); PG8_MMA(0, 0, At, B0); PG8_BAR; PG8_SCHED;
            PG8_LDB(B1, 0, 1); PG8_STAGE(PG8_SB(0, 0), b2, voffB);
            PG8_BAR; PG8_WAIT_L(0); PG8_MMA(0, 1, At, B1); PG8_BAR;
            PG8_LDA(At, 0, 1); PG8_STAGE(PG8_SA(0, 0), a2, voffA);
            PG8_BAR; PG8_WAIT_L(0); PG8_MMA(1, 0, At, B0); PG8_BAR; PG8_SCHED;
            PG8_STAGE(PG8_SB(0, 1), b2 + hstep, voffB);
            PG8_WAIT_V(6); PG8_BAR; PG8_MMA(1, 1, At, B1); PG8_BAR;
            PG8_LDB(B0, 1, 0); PG8_SCHED; PG8_LDA(At, 1, 0); PG8_STAGE(PG8_SA(0, 1), a2 + hstep, voffA);
            PG8_WAIT_L(8); PG8_BAR; PG8_WAIT_L(0); PG8_MMA(0, 0, At, B0); PG8_BAR; PG8_SCHED;
            PG8_LDB(B1, 1, 1); PG8_STAGE(PG8_SB(1, 0), b3, voffB);
            PG8_BAR; PG8_WAIT_L(0); PG8_MMA(0, 1, At, B1); PG8_BAR;
            PG8_LDA(At, 1, 1); PG8_STAGE(PG8_SA(1, 0), a3, voffA);
            PG8_BAR; PG8_WAIT_L(0); PG8_MMA(1, 0, At, B0); PG8_BAR; PG8_SCHED;
            PG8_STAGE(PG8_SB(1, 1), b3 + hstep, voffB);
            PG8_WAIT_V(6); PG8_BAR; PG8_MMA(1, 1, At, B1); PG8_BAR;
            }
        }
        if constexpr (ALIGN_EPI) { if (wr == 0) PG8_BAR; }
        if constexpr (!Epi::AFTER_DRAIN) { E(acc, cur, wr, wc, fr, fq); S.done(cur); }
        if (!has_next) break;
#pragma unroll
        for (int a = 0; a < 2; ++a)
#pragma unroll
            for (int b = 0; b < 2; ++b)
#pragma unroll
                for (int m = 0; m < 4; ++m)
#pragma unroll
                    for (int n = 0; n < 2; ++n) acc[a][b][m][n] = (f32x4){0.f, 0.f, 0.f, 0.f};
        cur = nxt; cA = nA; cB = nB; ++ui;
        if constexpr (ALIGN_EPI) { if (wr == 1) PG8_BAR; }
    }
    PG8_WAIT_V(0);
    if constexpr (!ALIGN_EPI) { if (wr == 0) PG8_BAR; }
    PG8_BAR;
    if constexpr (Epi::AFTER_DRAIN) { E.fused(acc, cur, wr, wc, fr, fq, lds, wid, lane); S.done(cur); }
#undef PG8_SA
#undef PG8_SB
#undef PG8_STAGE
#undef PG8_LDA
#undef PG8_LDB
#undef PG8_MMA
#undef PG8_WAIT_V
#undef PG8_WAIT_L
#undef PG8_BAR
#undef PG8_SCHED
}
}
#define GAS __attribute__((address_space(1)))
#define LAS __attribute__((address_space(3)))
typedef unsigned short bf16;
typedef unsigned v4u __attribute__((ext_vector_type(4)));
typedef float f32x4 __attribute__((ext_vector_type(4)));
typedef short bf16x8 __attribute__((ext_vector_type(8)));
typedef GAS unsigned gu32;
typedef GAS unsigned long long gu64;
#define RLX_AGENT __ATOMIC_RELAXED, __HIP_MEMORY_SCOPE_AGENT
#define LDS_WAIT() asm volatile("s_waitcnt lgkmcnt(0)" ::: "memory")
#define VM_WAIT() asm volatile("s_waitcnt vmcnt(0)" ::: "memory")
__device__ __forceinline__ unsigned long long rt() { return __builtin_amdgcn_s_memrealtime(); }
__device__ __forceinline__ unsigned f2bf(float f) { unsigned u = __builtin_bit_cast(unsigned, f); return (u + 0x7fffu + ((u >> 16) & 1u)) >> 16; }
__device__ __forceinline__ unsigned pk2(float lo, float hi) { return f2bf(lo) | (f2bf(hi) << 16); }

#define XB_TMO      128
#define XB_XCNT(j)  (256  + 64 * (j))
#define XB_XSUB(j)  (1280 + 64 * (j))
#define XB_XGEN(j)  (2304 + 64 * (j))
#define XB_TOP      3328
#define XB_TOPGEN   3392
#define XCD_BAR_WORDS 3456
#define XB_SPIN_CAP (1u << 18)

__device__ __forceinline__ unsigned xb_ld(unsigned* p)              { return __hip_atomic_load(p, __ATOMIC_RELAXED, __HIP_MEMORY_SCOPE_AGENT); }
__device__ __forceinline__ unsigned xb_add(unsigned* p, unsigned v) { return __hip_atomic_fetch_add(p, v, __ATOMIC_RELAXED, __HIP_MEMORY_SCOPE_AGENT); }
__device__ __forceinline__ unsigned xb_xcc_id() { return (unsigned)__builtin_amdgcn_s_getreg((3 << 11) | 20) & 0xFu; }
#define XB_SPIN(cond, bar) do { unsigned _sp = 0; while (cond) { __builtin_amdgcn_s_sleep(1); \
    if ((++_sp & 255u) == 0u) { if (xb_ld(&(bar)[XB_TMO])) break; if (_sp > XB_SPIN_CAP) { atomicAdd(&(bar)[XB_TMO], 1u); break; } } } } while (0)

struct XcdBarrier {
    unsigned* bar; unsigned x;
    volatile LAS unsigned* st;
};

__device__ __forceinline__ XcdBarrier xcd_barrier_post(unsigned* bar, volatile LAS unsigned* st) {
    XcdBarrier b; b.bar = bar; b.x = xb_xcc_id(); b.st = st;
    if (threadIdx.x == 0) (void)xb_add(&bar[XB_XCNT(b.x)], 1u);
    return b;
}
__device__ __forceinline__ void xcd_barrier_complete(unsigned* bar, unsigned x, unsigned& nloc, unsigned& nx) {
    const unsigned G = gridDim.x * gridDim.y * gridDim.z;
    unsigned sum, cnt, mine, sp = 0u;
    for (;;) {
        sum = 0u; cnt = 0u; mine = 0u;
#pragma unroll
        for (unsigned j = 0; j < 16; ++j) { const unsigned c = xb_ld(&bar[XB_XCNT(j)]); sum += c; cnt += (c > 0u) ? 1u : 0u; mine = (j == x) ? c : mine; }
        if (sum == G) break;
        __builtin_amdgcn_s_sleep(1);
        if ((++sp & 255u) == 0u) { if (xb_ld(&bar[XB_TMO])) break; if (sp > XB_SPIN_CAP) { atomicAdd(&bar[XB_TMO], 1u); break; } }
    }
    nloc = mine > 0u ? mine : 1u; nx = cnt > 0u ? cnt : 1u;
}

__device__ __forceinline__ void xcd_barrier(const XcdBarrier& b) {
    asm volatile("s_waitcnt vmcnt(0)" ::: "memory");
    __syncthreads();
    if (threadIdx.x == 0) {
        unsigned* bar = b.bar;
        __builtin_amdgcn_s_waitcnt(0);
        unsigned nloc = b.st[0], nx = b.st[1];
        if (nloc == 0u) { xcd_barrier_complete(bar, b.x, nloc, nx); b.st[0] = nloc; b.st[1] = nx; }
        const unsigned old = xb_add(&bar[XB_XSUB(b.x)], 1u);
        const unsigned gen = old / nloc;
        if (old + 1u == (gen + 1u) * nloc) {
            __builtin_amdgcn_fence(__ATOMIC_RELEASE, "agent");
            asm volatile("s_waitcnt vmcnt(0)" ::: "memory");
            const unsigned og = xb_add(&bar[XB_TOP], 1u);
            const unsigned tg = og / nx;
            if (og + 1u == (tg + 1u) * nx) xb_add(&bar[XB_TOPGEN], 1u);
            else XB_SPIN(xb_ld(&bar[XB_TOPGEN]) == tg, bar);
            __builtin_amdgcn_fence(__ATOMIC_ACQUIRE, "agent");
            xb_add(&bar[XB_XGEN(b.x)], 1u);
            asm volatile("s_waitcnt vmcnt(0)" ::: "memory");
        } else {
            XB_SPIN(xb_ld(&bar[XB_XGEN(b.x)]) == gen, bar);
            __builtin_amdgcn_fence(__ATOMIC_ACQUIRE, "agent");
            asm volatile("s_waitcnt vmcnt(0)" ::: "memory");
        }
    }
    __syncthreads();
}
typedef unsigned u32x2v __attribute__((ext_vector_type(2)));
typedef float f32x2v __attribute__((ext_vector_type(2)));

constexpr int MP = 16384, MROWS = 16640, DMODEL = 1024, DFF = 2816, NBLK64 = MROWS / 64;
constexpr float RMS_EPS = 1e-6f;
constexpr size_t OFF_Y = 0, OFF_WKP = (size_t)MROWS * 1024, OFF_WVP = OFF_WKP + 65536, OFF_SRP = OFF_WVP + 65536, OFF_SIP = OFF_SRP + 8192,
    OFF_CMP = OFF_SIP + 8192, OFF_CFP = OFF_CMP + 8192, OFF_MKP = OFF_CFP + 45056, OFF_MVP = OFF_MKP + 2097152, OFF_WKS = OFF_MVP + 2097152,
    OFF_WVS = OFF_WKS + 32768, OFF_SRS = OFF_WVS + 32768, OFF_SIS = OFF_SRS + 16384, OFF_CMS = OFF_SIS + 16384, OFF_CFS = OFF_CMS + 16384;
constexpr size_t MiB = 1u << 20;
constexpr size_t WS_ROWSS = 0, WS_BAR = 512 * 1024, CTL_ZERO_BYTES = 1 * MiB;
constexpr size_t WS_ROPE = 1 * MiB, WS_SSM = 2 * MiB, WS_CKV = 3 * MiB, WS_SLOC = 4 * MiB, WS_MEMK = 8 * MiB, WS_MEMVT = 20 * MiB, WS_SIDE = 32 * MiB;
constexpr size_t SG_BYTES = (size_t)NBLK64 * 8 * DFF * 4, SV_BYTES = (size_t)NBLK64 * 4 * DFF * 4;
static_assert(WS_SIDE + SG_BYTES + SV_BYTES <= 66 * MiB, "side buffers");
constexpr size_t WS_WT = 66 * MiB, WS_XB = 128 * MiB, WS_TMP = 161 * MiB;
constexpr size_t WT_INEVEN = 0, WT_GLU = WT_INEVEN + 1280 * 1024, WT_OUTEVEN = WT_GLU + 512 * 512, WT_WQ = WT_OUTEVEN + 1024 * 1024, WT_WKV = WT_WQ + 2 * 1024 * 1024,
    WT_WO = WT_WKV + 2 * 2048 * 1024, WT_UP = WT_WO + 2 * 1024 * 1024, WT_DOWN = WT_UP + (size_t)2 * 5632 * 1024, WT_INODD = WT_DOWN + (size_t)2 * 2816 * 1024,
    WT_OUTODD = WT_INODD + 3072 * 1024, WT_END = WT_OUTODD + 1024 * 1024;
static_assert(WS_WT + WT_END * 2 <= WS_XB, "weights");
static_assert(WS_XB + (size_t)MROWS * 1024 * 2 <= WS_TMP, "xb");
constexpr size_t TMP_BYTES = (size_t)MROWS * DFF * 2;
constexpr size_t WS_PART = 251 * MiB, PART_ELEMS = (size_t)MROWS * 16;
static_assert(WS_PART + 2 * PART_ELEMS * 4 <= 256 * MiB, "part");
static_assert(WS_TMP + TMP_BYTES <= 256 * MiB, "ws");
constexpr size_t TMP_PROJ0 = 0, TMP_GBUF = (size_t)MROWS * 1280 * 2, TMP_YCAT = TMP_GBUF + (size_t)MROWS * 512 * 2, TMP_MEMB = TMP_YCAT;
static_assert(TMP_YCAT + (size_t)MROWS * 1024 * 2 <= TMP_BYTES, "tmp");
constexpr size_t TMP_QX = 0, TMP_OX = (size_t)MROWS * 1024 * 2, TMP_ACT = 0, TMP_GB = 0, TMP_ZC = (size_t)MROWS * 1024 * 2;
constexpr int LDS_BYTES = 147456, MISC_OFF = 147456 - 512;
constexpr int NPH = 22;

#define MFMA16(a, b, c) __builtin_amdgcn_mfma_f32_16x16x32_bf16(a, b, c, 0, 0, 0)
__device__ __forceinline__ float bflo(unsigned w) { return __uint_as_float(w << 16); }
__device__ __forceinline__ float bfhi(unsigned w) { return __uint_as_float(w & 0xffff0000u); }
__device__ __forceinline__ v4u pack8(f32x4 a, f32x4 b) { v4u w; w.x = pg8::cvt_pk_bf16(a[0], a[1]); w.y = pg8::cvt_pk_bf16(a[2], a[3]); w.z = pg8::cvt_pk_bf16(b[0], b[1]); w.w = pg8::cvt_pk_bf16(b[2], b[3]); return w; }
__device__ __forceinline__ float rstd_of(const float* part, int row) { const f32x4* p = (const f32x4*)(part + (size_t)row * 16); const f32x4 a = p[0] + p[1] + p[2] + p[3]; return rsqrtf(((a[0] + a[1]) + (a[2] + a[3])) * (1.0f / 1024.0f) + RMS_EPS); }
__device__ __forceinline__ float sigmoidf_(float x) { return 1.0f / (1.0f + __expf(-x)); }
__device__ __forceinline__ float dpp_ror1(float v) { return __builtin_bit_cast(float, __builtin_amdgcn_update_dpp(0, __builtin_bit_cast(int, v), 0x121, 0xf, 0xf, false)); }
__device__ __forceinline__ float dpp_ror2(float v) { return __builtin_bit_cast(float, __builtin_amdgcn_update_dpp(0, __builtin_bit_cast(int, v), 0x122, 0xf, 0xf, false)); }
__device__ __forceinline__ float wave_sum(float v) {
#pragma unroll
    for (int o = 1; o < 64; o <<= 1) v += __shfl_xor(v, o);
    return v;
}

typedef pg8::Unit Unit;
#define EPI_ARGS const f32x4 (&acc)[2][2][4][2], const Unit& u, int wr, int wc, int fr, int fq

struct EpiBf16 {
    static constexpr bool PERM = true, AFTER_DRAIN = false;
    bf16* O; int ldc; const float* rowss;
    __device__ __forceinline__ void operator()(EPI_ARGS) const {
        const int row0 = u.pm * 256 + wr * 64 + fr, col0 = u.pn * 256 + wc * 32 + 8 * fq;
#pragma unroll
        for (int ai = 0; ai < 2; ++ai)
#pragma unroll
            for (int m = 0; m < 4; ++m) { const int row = row0 + ai * 128 + m * 16; const float rs = rstd_of(rowss, row); bf16* rp = O + (size_t)row * ldc + col0;
#pragma unroll
                for (int bj = 0; bj < 2; ++bj) *(v4u*)(rp + bj * 128) = pack8(acc[ai][bj][m][0] * rs, acc[ai][bj][m][1] * rs); }
    }
};
struct EpiRes {
    static constexpr bool PERM = true, AFTER_DRAIN = false;
    const float* base_p; const float* base_s; float* xf; bf16* xb; float* rowss_next;
    __device__ __forceinline__ void operator()(EPI_ARGS) const {
        const float* base = u.pm < 64 ? base_p : base_s;
        const int row0 = u.pm * 256 + wr * 64 + fr, col0 = u.pn * 256 + wc * 32 + 8 * fq;
#pragma unroll
        for (int ai = 0; ai < 2; ++ai)
#pragma unroll
            for (int m = 0; m < 4; ++m) { const int row = row0 + ai * 128 + m * 16; const size_t off = (size_t)row * 1024 + col0; float ss = 0.f;
#pragma unroll
                for (int bj = 0; bj < 2; ++bj) { const f32x4 b0 = *(const f32x4*)(base + off + bj * 128), b1 = *(const f32x4*)(base + off + bj * 128 + 4);
                    const f32x4 v0 = acc[ai][bj][m][0] + b0, v1 = acc[ai][bj][m][1] + b1;
                    *(f32x4*)(xf + off + bj * 128) = v0; *(f32x4*)(xf + off + bj * 128 + 4) = v1; *(v4u*)(xb + off + bj * 128) = pack8(v0, v1);
                    ss += (v0[0] * v0[0] + v0[1] * v0[1]) + (v0[2] * v0[2] + v0[3] * v0[3]) + (v1[0] * v1[0] + v1[1] * v1[1]) + (v1[2] * v1[2] + v1[3] * v1[3]); }
                ss += __shfl_xor(ss, 16); ss += __shfl_xor(ss, 32);
                if (fq == 0) rowss_next[(size_t)row * 16 + u.pn * 4 + wc] = ss; }
    }
};
struct EpiGlu {
    static constexpr bool PERM = true, AFTER_DRAIN = false;
    const bf16* g; bf16* ycat;
    __device__ __forceinline__ void operator()(EPI_ARGS) const {
        const int row0 = u.pm * 256 + wr * 64 + fr, col0 = u.pn * 256 + wc * 32 + 8 * fq;
#pragma unroll
        for (int ai = 0; ai < 2; ++ai)
#pragma unroll
            for (int m = 0; m < 4; ++m) { const int row = row0 + ai * 128 + m * 16;
#pragma unroll
                for (int bj = 0; bj < 2; ++bj) { const int col = col0 + bj * 128; const v4u gw = *(const v4u*)(g + (size_t)row * 512 + col);
                    const f32x4 a0 = acc[ai][bj][m][0], a1 = acc[ai][bj][m][1]; f32x4 o0, o1;
                    o0[0] = bflo(gw.x) * sigmoidf_(a0[0]); o0[1] = bfhi(gw.x) * sigmoidf_(a0[1]); o0[2] = bflo(gw.y) * sigmoidf_(a0[2]); o0[3] = bfhi(gw.y) * sigmoidf_(a0[3]);
                    o1[0] = bflo(gw.z) * sigmoidf_(a1[0]); o1[1] = bfhi(gw.z) * sigmoidf_(a1[1]); o1[2] = bflo(gw.w) * sigmoidf_(a1[2]); o1[3] = bfhi(gw.w) * sigmoidf_(a1[3]);
                    *(v4u*)(ycat + (size_t)row * 1024 + col) = pack8(o0, o1); } }
    }
};
struct EpiKV {
    static constexpr bool PERM = true, AFTER_DRAIN = false;
    float* out; bf16* memk;
    __device__ __forceinline__ void operator()(EPI_ARGS) const {
        const int row0 = u.pm * 256 + wr * 64 + fr, col0 = u.pn * 256 + wc * 32 + 8 * fq;
#pragma unroll
        for (int ai = 0; ai < 2; ++ai)
#pragma unroll
            for (int m = 0; m < 4; ++m) { const int row = row0 + ai * 128 + m * 16;
#pragma unroll
                for (int bj = 0; bj < 2; ++bj) { const int c = col0 + bj * 128, l = c >> 11, e = c & 2047, isv = e >> 10, dc = e & 1023;
                    float* op = out + (isv ? OFF_MVP : OFF_MKP) + (size_t)l * 1048576 + (size_t)row * 1024 + dc;
                    *(f32x4*)op = acc[ai][bj][m][0]; *(f32x4*)(op + 4) = acc[ai][bj][m][1];
                    if (!isv) *(v4u*)(memk + (size_t)l * 12 * 262144 + (size_t)row * 1024 + dc) = pack8(acc[ai][bj][m][0], acc[ai][bj][m][1]); } }
    }
};
struct EpiIn0 {
    static constexpr bool PERM = true, AFTER_DRAIN = false;
    bf16* proj; const float* rowss; const float* ropec; const float* ropes; float* out;
    __device__ __forceinline__ void operator()(EPI_ARGS) const {
        const int pn = u.pn;
#pragma unroll
        for (int ai = 0; ai < 2; ++ai)
#pragma unroll
            for (int m = 0; m < 4; ++m) { const int row = u.pm * 256 + ai * 128 + wr * 64 + m * 16 + fr; const float rs = rstd_of(rowss, row);
                const int pos = row < MP ? (row & 4095) : 2048 + (row & 31);
                bf16* rp = proj + (size_t)row * 1280;
                float* wk = nullptr; float* wv = nullptr;
                if (pn == 4) { if (row >= MP) { wk = out + OFF_WKS + (size_t)(row - MP) * 128; wv = out + OFF_WVS + (size_t)(row - MP) * 128; }
                               else if ((row & 4095) >= 3968) { const size_t o = (size_t)((row >> 12) * 128 + (row & 4095) - 3968) * 128; wk = out + OFF_WKP + o; wv = out + OFF_WVP + o; } }
#pragma unroll
                for (int bj = 0; bj < 2; ++bj) { const f32x4 v0 = acc[ai][bj][m][0] * rs, v1 = acc[ai][bj][m][1] * rs;
                    const bool rope = (pn == 2 || pn == 3 || (pn == 4 && bj == 0));
                    if (!rope) { const int col = pn * 256 + bj * 128 + wc * 32 + 8 * fq; *(v4u*)(rp + col) = pack8(v0, v1);
                        if (pn == 4 && wv) { *(f32x4*)(wv + wc * 32 + 8 * fq) = v0; *(f32x4*)(wv + wc * 32 + 8 * fq + 4) = v1; } }
                    else { const int gbase = pn * 256 + bj * 128 + (wc >> 1) * 64, d1 = 16 * (wc & 1) + 4 * fq;
                        const f32x4 c4 = *(const f32x4*)(ropec + pos * 32 + d1), s4 = *(const f32x4*)(ropes + pos * 32 + d1);
                        f32x4 o1 = v0 * c4 - v1 * s4, o2 = v1 * c4 + v0 * s4;
                        if (pn != 4) { o1 = o1 * 0.125f; o2 = o2 * 0.125f; }
                        u32x2v w1, w2; w1.x = pg8::cvt_pk_bf16(o1[0], o1[1]); w1.y = pg8::cvt_pk_bf16(o1[2], o1[3]); w2.x = pg8::cvt_pk_bf16(o2[0], o2[1]); w2.y = pg8::cvt_pk_bf16(o2[2], o2[3]);
                        *(u32x2v*)(rp + gbase + d1) = w1; *(u32x2v*)(rp + gbase + d1 + 32) = w2;
                        if (pn == 4 && wk) { const int cc = (wc >> 1) * 64 + d1; *(f32x4*)(wk + cc) = o1; *(f32x4*)(wk + cc + 32) = o2; } } } }
    }
};
struct EpiFfnUp {
    static constexpr bool PERM = true, AFTER_DRAIN = false;
    bf16* act; const float* rowss; const float* cw; float* SG; float* SV;
    __device__ __forceinline__ void operator()(EPI_ARGS) const {
        const int c0 = u.pn * 128 + wc * 32 + 8 * fq; const bool sample = u.pm == 64;
        const f32x4 w0a = *(const f32x4*)(cw + c0), w0b = *(const f32x4*)(cw + c0 + 4), w1a = *(const f32x4*)(cw + DFF + c0), w1b = *(const f32x4*)(cw + DFF + c0 + 4),
                    w2a = *(const f32x4*)(cw + 2 * DFF + c0), w2b = *(const f32x4*)(cw + 2 * DFF + c0 + 4);
#pragma unroll
        for (int ai = 0; ai < 2; ++ai) { f32x4 gp0 = {0.f, 0.f, 0.f, 0.f}, gp1 = {0.f, 0.f, 0.f, 0.f}; const int blk = u.pm * 4 + ai * 2 + wr;
#pragma unroll
            for (int m = 0; m < 4; ++m) { const int row = u.pm * 256 + ai * 128 + wr * 64 + m * 16 + fr; const float rs = rstd_of(rowss, row);
                const f32x4 g0 = acc[ai][0][m][0] * rs, g1 = acc[ai][0][m][1] * rs, v0 = acc[ai][1][m][0] * rs, v1 = acc[ai][1][m][1] * rs;
                f32x4 a0, a1;
#pragma unroll
                for (int j = 0; j < 4; ++j) {
                    const float r1pa = dpp_ror1(gp0[j]), r1ca = dpp_ror1(g0[j]), r2pa = dpp_ror2(gp0[j]), r2ca = dpp_ror2(g0[j]);
                    const float r1pb = dpp_ror1(gp1[j]), r1cb = dpp_ror1(g1[j]), r2pb = dpp_ror2(gp1[j]), r2cb = dpp_ror2(g1[j]);
                    const float p1a = fr == 0 ? r1pa : r1ca, p2a = fr < 2 ? r2pa : r2ca;
                    const float p1b = fr == 0 ? r1pb : r1cb, p2b = fr < 2 ? r2pb : r2cb;
                    const float ca = w0a[j] * p2a + w1a[j] * p1a + w2a[j] * g0[j], cb = w0b[j] * p2b + w1b[j] * p1b + w2b[j] * g1[j];
                    a0[j] = ca * sigmoidf_(ca) * v0[j]; a1[j] = cb * sigmoidf_(cb) * v1[j]; }
                const bool valid = (m > 0 || fr >= 2) && !(sample && m == 2 && fr < 2);
                if (valid) *(v4u*)(act + (size_t)row * DFF + c0) = pack8(a0, a1);
                if ((m & 1) == 0 && fr < 2) { float* sg = SG + (size_t)(blk * 8 + 2 * m + fr) * DFF + c0; *(f32x4*)sg = g0; *(f32x4*)(sg + 4) = g1;
                                              float* sv = SV + (size_t)(blk * 4 + m + fr) * DFF + c0; *(f32x4*)sv = v0; *(f32x4*)(sv + 4) = v1; }
                if ((m & 1) == 1 && fr >= 14) { float* sg = SG + (size_t)(blk * 8 + 2 * m + fr - 14) * DFF + c0; *(f32x4*)sg = g0; *(f32x4*)(sg + 4) = g1; }
                gp0 = g0; gp1 = g1; } }
    }
};
struct EpiInOdd {
    static constexpr bool PERM = true, AFTER_DRAIN = false;
    bf16* gb; bf16* zc; const float* rowss; const float* cw; float* SG;
    __device__ __forceinline__ void operator()(EPI_ARGS) const {
        if (u.pn < 4) {
            const int row0 = u.pm * 256 + wr * 64 + fr, col0 = u.pn * 256 + wc * 32 + 8 * fq;
#pragma unroll
            for (int ai = 0; ai < 2; ++ai)
#pragma unroll
                for (int m = 0; m < 4; ++m) { const int row = row0 + ai * 128 + m * 16; const float rs = rstd_of(rowss, row); bf16* rp = gb + (size_t)row * 1024 + col0;
#pragma unroll
                    for (int bj = 0; bj < 2; ++bj) *(v4u*)(rp + bj * 128) = pack8(acc[ai][bj][m][0] * rs, acc[ai][bj][m][1] * rs); }
            return;
        }
        const int c0 = (u.pn - 4) * 128 + wc * 32 + 8 * fq; const bool sample = u.pm == 64;
        const f32x4 w0a = *(const f32x4*)(cw + c0), w0b = *(const f32x4*)(cw + c0 + 4), w1a = *(const f32x4*)(cw + 1024 + c0), w1b = *(const f32x4*)(cw + 1024 + c0 + 4),
                    w2a = *(const f32x4*)(cw + 2048 + c0), w2b = *(const f32x4*)(cw + 2048 + c0 + 4);
#pragma unroll
        for (int ai = 0; ai < 2; ++ai) { f32x4 gp0 = {0.f, 0.f, 0.f, 0.f}, gp1 = {0.f, 0.f, 0.f, 0.f}; const int blk = u.pm * 4 + ai * 2 + wr;
#pragma unroll
            for (int m = 0; m < 4; ++m) { const int row = u.pm * 256 + ai * 128 + wr * 64 + m * 16 + fr; const float rs = rstd_of(rowss, row); const float rs2 = rs * rs;
                const f32x4 g0 = acc[ai][0][m][0] * acc[ai][1][m][0] * rs2, g1 = acc[ai][0][m][1] * acc[ai][1][m][1] * rs2;
                f32x4 a0, a1;
#pragma unroll
                for (int j = 0; j < 4; ++j) {
                    const float r1pa = dpp_ror1(gp0[j]), r1ca = dpp_ror1(g0[j]), r2pa = dpp_ror2(gp0[j]), r2ca = dpp_ror2(g0[j]);
                    const float r1pb = dpp_ror1(gp1[j]), r1cb = dpp_ror1(g1[j]), r2pb = dpp_ror2(gp1[j]), r2cb = dpp_ror2(g1[j]);
                    const float p1a = fr == 0 ? r1pa : r1ca, p2a = fr < 2 ? r2pa : r2ca;
                    const float p1b = fr == 0 ? r1pb : r1cb, p2b = fr < 2 ? r2pb : r2cb;
                    a0[j] = w0a[j] * p2a + w1a[j] * p1a + w2a[j] * g0[j]; a1[j] = w0b[j] * p2b + w1b[j] * p1b + w2b[j] * g1[j]; }
                const bool valid = (m > 0 || fr >= 2) && !(sample && m == 2 && fr < 2);
                if (valid) *(v4u*)(zc + (size_t)row * 1024 + c0) = pack8(a0, a1);
                if ((m & 1) == 0 && fr < 2) { float* sg = SG + (size_t)(blk * 8 + 2 * m + fr) * 1024 + c0; *(f32x4*)sg = g0; *(f32x4*)(sg + 4) = g1; }
                if ((m & 1) == 1 && fr >= 14) { float* sg = SG + (size_t)(blk * 8 + 2 * m + fr - 14) * 1024 + c0; *(f32x4*)sg = g0; *(f32x4*)(sg + 4) = g1; }
                gp0 = g0; gp1 = g1; } }
    }
};

__device__ __forceinline__ int rowmap(int mode, int n) {
    if (mode == 1) { if (n >= 512 && n < 1152) { const int d = n & 63; return (n & ~63) | (32 * ((d >> 4) & 1) + 8 * ((d >> 2) & 3) + 4 * (d >> 5) + (d & 3)); } return n; }
    if (mode == 2) { return n < DFF ? ((n >> 7) * 256 + (n & 127)) : (((n - DFF) >> 7) * 256 + 128 + ((n - DFF) & 127)); }
    if (mode == 3) { if (n < 1024) return n; const int c = (n - 1024) & 1023, z = n >= 2048 ? 1 : 0; return 1024 + (c >> 7) * 256 + z * 128 + (c & 127); }
    return n;
}
__device__ __forceinline__ void tr_item(const float* W, int K, int N, bf16* WT, const float* gain, float scale, int mode, LAS float* scr, int item, int lane) {
    const int nblk = N / 32, kb = item / nblk, nb = item % nblk, k0 = 64 * kb, n0 = 32 * nb;
#pragma unroll
    for (int i = 0; i < 8; ++i) { const int idx = lane + 64 * i, kk = idx >> 3, n4 = (idx & 7) * 4; const float gs = gain ? gain[k0 + kk] * scale : scale;
        const f32x4 w = *(const f32x4*)(W + (size_t)(k0 + kk) * N + n0 + n4); LAS float* d = scr + kk * 33 + n4; d[0] = w[0] * gs; d[1] = w[1] * gs; d[2] = w[2] * gs; d[3] = w[3] * gs; }
    LDS_WAIT(); asm volatile("" ::: "memory");
    const int c = lane & 7;
#pragma unroll
    for (int j = 0; j < 4; ++j) { const int n = (lane >> 3) + 8 * j; const LAS float* s = scr + (8 * c) * 33 + n;
        v4u o; o.x = pg8::cvt_pk_bf16(s[0 * 33], s[1 * 33]); o.y = pg8::cvt_pk_bf16(s[2 * 33], s[3 * 33]); o.z = pg8::cvt_pk_bf16(s[4 * 33], s[5 * 33]); o.w = pg8::cvt_pk_bf16(s[6 * 33], s[7 * 33]);
        *(v4u*)(WT + (size_t)rowmap(mode, n0 + n) * K + k0 + 8 * c) = o; }
    LDS_WAIT(); asm volatile("" ::: "memory");
}
__device__ __forceinline__ double dexp_(double y) {
    const double k = rint(y * 1.4426950408889634); const double r = (y - k * 0.6931471803691238) - k * 1.9082149292705877e-10;
    double p = 1.0 / 6227020800.0;
    p = p * r + 1.0 / 479001600.0; p = p * r + 1.0 / 39916800.0; p = p * r + 1.0 / 3628800.0; p = p * r + 1.0 / 362880.0; p = p * r + 1.0 / 40320.0; p = p * r + 1.0 / 5040.0;
    p = p * r + 1.0 / 720.0; p = p * r + 1.0 / 120.0; p = p * r + 1.0 / 24.0; p = p * r + 1.0 / 6.0; p = p * r + 0.5; p = p * r + 1.0; p = p * r + 1.0;
    const long long bits = (long long)(1023 + (int)k) << 52; return p * __builtin_bit_cast(double, bits);
}
__device__ __forceinline__ void dsincos_(double x, double& s, double& c) {
    const double k = rint(x * 0.6366197723675814); const double r = (x - k * 1.5707963267948966) - k * 6.123233995736766e-17; const double r2 = r * r;
    const double sp = r * (1.0 + r2 * (-1.0 / 6.0 + r2 * (1.0 / 120.0 + r2 * (-1.0 / 5040.0 + r2 * (1.0 / 362880.0 + r2 * (-1.0 / 39916800.0 + r2 * (1.0 / 6227020800.0)))))));
    const double cp = 1.0 + r2 * (-0.5 + r2 * (1.0 / 24.0 + r2 * (-1.0 / 720.0 + r2 * (1.0 / 40320.0 + r2 * (-1.0 / 3628800.0 + r2 * (1.0 / 479001600.0 + r2 * (-1.0 / 87178291200.0)))))));
    const int q = ((int)k) & 3;
    s = q == 0 ? sp : q == 1 ? cp : q == 2 ? -sp : -cp; c = q == 0 ? cp : q == 1 ? -sp : q == 2 ? -cp : sp;
}

__device__ __forceinline__ const bf16* kvptr(const bf16* proj, const bf16* cb, int sample, int b, int c, int kvh, int kk, int isv) {
    if (!sample) { int pos = (c - 2) * 64 + kk; pos = pos < 0 ? 0 : pos; return proj + (size_t)(b * 4096 + pos) * 1280 + 1024 + isv * 128 + kvh * 64; }
    if (kk < 128) return cb + (size_t)(b * 128 + kk) * 128 + kvh * 64;
    int t = kk - 128; t = t > 31 ? 31 : t; return proj + (size_t)(MP + b * 32 + t) * 1280 + 1024 + isv * 128 + kvh * 64;
}
__device__ __forceinline__ void swa_phase(const bf16* proj, const bf16* ckb, const bf16* cvb, const float* sinks, bf16* ycat, LAS unsigned char* lds, int tid, int wave, int lane, int G) {
    LAS bf16* VT = (LAS bf16*)lds;
    const int fr = lane & 15, quad = lane >> 4;
    for (int it = blockIdx.x; it < 528; it += G) {
        int b, c, kvh, sample;
        if (it < 512) { sample = 0; b = it >> 7; c = (it >> 1) & 63; kvh = it & 1; } else { sample = 1; b = (it - 512) >> 1; c = 0; kvh = it & 1; }
        __syncthreads();
#pragma unroll
        for (int i = 0; i < 3; ++i) { const int idx = tid + 512 * i, kk = idx % 192, dg = idx / 192; const v4u w = *(const v4u*)(kvptr(proj, cvb, sample, b, c, kvh, kk, 1) + dg * 8);
            LAS bf16* vp = VT + (dg * 8) * 200 + kk;
            vp[0] = (bf16)(w.x & 0xffffu); vp[200] = (bf16)(w.x >> 16); vp[400] = (bf16)(w.y & 0xffffu); vp[600] = (bf16)(w.y >> 16);
            vp[800] = (bf16)(w.z & 0xffffu); vp[1000] = (bf16)(w.z >> 16); vp[1200] = (bf16)(w.w & 0xffffu); vp[1400] = (bf16)(w.w >> 16); }
        __syncthreads();
        const int gq = wave >> 1, qhalf = wave & 1, head = kvh * 4 + gq;
        if (!(sample && qhalf)) {
            const int plo = sample ? 0 : (c >= 2 ? 0 : (2 - c) * 2), phi = sample ? 5 : 6;
            bf16x8 qf[2][2];
#pragma unroll
            for (int qb = 0; qb < 2; ++qb) { const int q = qhalf * 32 + qb * 16 + fr; const int row = sample ? MP + b * 32 + (q & 31) : b * 4096 + c * 64 + q;
                const bf16* qp = proj + (size_t)row * 1280 + 512 + head * 64 + quad * 8; qf[qb][0] = *(const bf16x8*)qp; qf[qb][1] = *(const bf16x8*)(qp + 32); }
            f32x4 s[12][2];
#pragma unroll
            for (int kb = 0; kb < 12; ++kb) { const int key = 32 * (kb >> 1) + (fr >> 2) * 8 + 4 * (kb & 1) + (fr & 3); const bf16* kp = kvptr(proj, ckb, sample, b, c, kvh, key, 0) + quad * 8;
                const bf16x8 k0 = *(const bf16x8*)kp, k1 = *(const bf16x8*)(kp + 32);
#pragma unroll
                for (int qb = 0; qb < 2; ++qb) { f32x4 a = {0.f, 0.f, 0.f, 0.f}; a = MFMA16(k0, qf[qb][0], a); a = MFMA16(k1, qf[qb][1], a); s[kb][qb] = a; } }
            const float sink = sinks[head];
            bf16x8 pf[6][2];
#pragma unroll
            for (int qb = 0; qb < 2; ++qb) { float mx = sink;
#pragma unroll
                for (int kb = 0; kb < 12; ++kb) { const bool pv = (kb >> 1) >= plo && (kb >> 1) < phi;
#pragma unroll
                    for (int j = 0; j < 4; ++j) { const float v = pv ? s[kb][qb][j] : -1e30f; s[kb][qb][j] = v; mx = fmaxf(mx, v); } }
                mx = fmaxf(mx, __shfl_xor(mx, 16)); mx = fmaxf(mx, __shfl_xor(mx, 32));
                float sum = 0.f;
#pragma unroll
                for (int kb = 0; kb < 12; ++kb)
#pragma unroll
                    for (int j = 0; j < 4; ++j) { const float e = __expf(s[kb][qb][j] - mx); s[kb][qb][j] = e; sum += e; }
                sum += __shfl_xor(sum, 16); sum += __shfl_xor(sum, 32); sum += __expf(sink - mx);
                const float inv = 1.0f / sum;
#pragma unroll
                for (int pr = 0; pr < 6; ++pr) pf[pr][qb] = __builtin_bit_cast(bf16x8, pack8(s[2 * pr][qb] * inv, s[2 * pr + 1][qb] * inv)); }
#pragma unroll
            for (int db = 0; db < 4; ++db) { bf16x8 vf[6];
#pragma unroll
                for (int pr = 0; pr < 6; ++pr) vf[pr] = *(const LAS bf16x8*)(VT + (db * 16 + fr) * 200 + 32 * pr + quad * 8);
#pragma unroll
                for (int qb = 0; qb < 2; ++qb) { f32x4 o = {0.f, 0.f, 0.f, 0.f};
#pragma unroll
                    for (int pr = 0; pr < 6; ++pr) o = MFMA16(pf[pr][qb], vf[pr], o);
#pragma unroll
                    for (int j = 0; j < 4; ++j) { const int q = qhalf * 32 + qb * 16 + quad * 4 + j;
                        if (!sample || q < 32) { const int row = sample ? MP + b * 32 + q : b * 4096 + c * 64 + q; ycat[(size_t)row * 1024 + 512 + head * 64 + db * 16 + fr] = (bf16)f2bf(o[j]); } } } }
        }
    }
    __syncthreads();
}

__device__ __forceinline__ void xattn_phase(const bf16* qx, const bf16* memk_l, const bf16* memvT_l, bf16* ox, int wave, int lane, int G) {
    const int fr = lane & 15, quad = lane >> 4;
    for (int t = wave * G + (int)blockIdx.x; t < 4160; t += 8 * G) {
        int bb, h, row0;
        if (t < 4096) { const int pair = t >> 8; bb = pair >> 2; h = pair & 3; row0 = bb * 4096 + (t & 255) * 16; }
        else { const int s = t - 4096, b = s >> 3; h = (s >> 1) & 3; bb = 4 + b; row0 = MP + b * 32 + (s & 1) * 16; }
        bf16x8 qf[8];
#pragma unroll
        for (int ks = 0; ks < 8; ++ks) qf[ks] = *(const bf16x8*)(qx + (size_t)(row0 + fr) * 1024 + h * 256 + ks * 32 + quad * 8);
        const bf16* kbase = memk_l + (size_t)bb * 262144 + h * 256 + quad * 8;
        f32x4 s[16];
#pragma unroll
        for (int kb = 0; kb < 16; ++kb) { const int key = 32 * (kb >> 1) + (fr >> 2) * 8 + 4 * (kb & 1) + (fr & 3); const bf16* kp = kbase + (size_t)key * 1024; f32x4 a = {0.f, 0.f, 0.f, 0.f};
#pragma unroll
            for (int ks = 0; ks < 8; ++ks) a = MFMA16(*(const bf16x8*)(kp + ks * 32), qf[ks], a);
            s[kb] = a; }
        float mx = -1e30f;
#pragma unroll
        for (int kb = 0; kb < 16; ++kb)
#pragma unroll
            for (int j = 0; j < 4; ++j) mx = fmaxf(mx, s[kb][j]);
        mx = fmaxf(mx, __shfl_xor(mx, 16)); mx = fmaxf(mx, __shfl_xor(mx, 32));
        float sum = 0.f;
#pragma unroll
        for (int kb = 0; kb < 16; ++kb)
#pragma unroll
            for (int j = 0; j < 4; ++j) { const float e = __expf(s[kb][j] - mx); s[kb][j] = e; sum += e; }
        sum += __shfl_xor(sum, 16); sum += __shfl_xor(sum, 32);
        const float inv = 1.0f / sum;
        bf16x8 pf[8];
#pragma unroll
        for (int pr = 0; pr < 8; ++pr) pf[pr] = __builtin_bit_cast(bf16x8, pack8(s[2 * pr] * inv, s[2 * pr + 1] * inv));
        const bf16* vbase = memvT_l + (size_t)bb * 262144 + (size_t)(h * 256 + fr) * 256 + quad * 8;
#pragma unroll 4
        for (int db = 0; db < 16; ++db) { f32x4 o = {0.f, 0.f, 0.f, 0.f};
#pragma unroll
            for (int pr = 0; pr < 8; ++pr) o = MFMA16(pf[pr], *(const bf16x8*)(vbase + (size_t)db * 4096 + pr * 32), o);
#pragma unroll
            for (int j = 0; j < 4; ++j) ox[(size_t)(row0 + quad * 4 + j) * 1024 + h * 256 + db * 16 + fr] = (bf16)f2bf(o[j]); }
    }
}


__device__ __forceinline__ void xstage(const bf16* src, size_t rowstride, LAS unsigned char* lds, int tid) {
    v4u t[16];
#pragma unroll
    for (int i = 0; i < 16; ++i) { const int row = (tid >> 5) + 16 * i, ch = tid & 31; t[i] = *(const GAS v4u*)((const GAS bf16*)src + (size_t)row * rowstride + ch * 8); }
#pragma unroll
    for (int i = 0; i < 16; ++i) { const int row = (tid >> 5) + 16 * i, ch = tid & 31; *(LAS v4u*)(lds + row * 528 + ch * 16) = t[i]; }
}
__device__ __forceinline__ void xattn_phase2(const bf16* qx, const bf16* memk_l, const bf16* memvT_l, bf16* ox, LAS unsigned char* lds, int tid, int wave, int lane, int G) {
    const int fr = lane & 15, quad = lane >> 4;
    for (int it = blockIdx.x; it < 256 + 32; it += G) {
        int bb, h, rowbase, nqb; bool active;
        if (it < 256) { bb = it >> 6; h = (it >> 4) & 3; rowbase = bb * 4096 + (it & 15) * 256; nqb = 2; active = true; }
        else { const int s = it - 256, b = s >> 2; h = s & 3; bb = 4 + b; rowbase = MP + b * 32; nqb = 1; active = wave < 2; }
        __syncthreads();
        xstage(memk_l + (size_t)bb * 262144 + h * 256, 1024, lds, tid);
        __syncthreads();
        bf16x8 pf[2][8];
#pragma unroll
        for (int qi = 0; qi < 2; ++qi) {
            if (qi < nqb && active) {
                const int row0 = rowbase + qi * 128 + wave * 16;
                bf16x8 qf[8];
#pragma unroll
                for (int ks = 0; ks < 8; ++ks) qf[ks] = *(const GAS bf16x8*)((const GAS bf16*)qx + (size_t)(row0 + fr) * 1024 + h * 256 + ks * 32 + quad * 8);
                f32x4 s[16];
#pragma unroll
                for (int kb = 0; kb < 16; ++kb) { const int key = 32 * (kb >> 1) + (fr >> 2) * 8 + 4 * (kb & 1) + (fr & 3); const LAS unsigned char* kp = lds + key * 528 + quad * 16; f32x4 a = {0.f, 0.f, 0.f, 0.f};
#pragma unroll
                    for (int ks = 0; ks < 8; ++ks) a = MFMA16(*(const LAS bf16x8*)(kp + ks * 64), qf[ks], a);
                    s[kb] = a; }
                float mx = -1e30f;
#pragma unroll
                for (int kb = 0; kb < 16; ++kb)
#pragma unroll
                    for (int j = 0; j < 4; ++j) mx = fmaxf(mx, s[kb][j]);
                mx = fmaxf(mx, __shfl_xor(mx, 16)); mx = fmaxf(mx, __shfl_xor(mx, 32));
                float sum = 0.f;
#pragma unroll
                for (int kb = 0; kb < 16; ++kb)
#pragma unroll
                    for (int j = 0; j < 4; ++j) { const float e = __expf(s[kb][j] - mx); s[kb][j] = e; sum += e; }
                sum += __shfl_xor(sum, 16); sum += __shfl_xor(sum, 32);
                const float inv = 1.0f / sum;
#pragma unroll
                for (int pr = 0; pr < 8; ++pr) pf[qi][pr] = __builtin_bit_cast(bf16x8, pack8(s[2 * pr] * inv, s[2 * pr + 1] * inv));
            }
        }
        __syncthreads();
        xstage(memvT_l + (size_t)bb * 262144 + (size_t)h * 65536, 256, lds, tid);
        __syncthreads();
#pragma unroll
        for (int qi = 0; qi < 2; ++qi) {
            if (qi < nqb && active) {
                const int row0 = rowbase + qi * 128 + wave * 16;
#pragma unroll 4
                for (int db = 0; db < 16; ++db) { f32x4 o = {0.f, 0.f, 0.f, 0.f}; const LAS unsigned char* vp = lds + (db * 16 + fr) * 528 + quad * 16;
#pragma unroll
                    for (int pr = 0; pr < 8; ++pr) o = MFMA16(*(const LAS bf16x8*)(vp + pr * 64), pf[qi][pr], o);
                    u32x2v w; w.x = pk2(o[0], o[1]); w.y = pk2(o[2], o[3]);
                    *(GAS u32x2v*)((GAS bf16*)ox + (size_t)(row0 + fr) * 1024 + h * 256 + db * 16 + quad * 4) = w; }
            }
        }
    }
    __syncthreads();
}

__device__ __forceinline__ void s5_stage_u(const bf16* up, LAS float* ubuf, int lane) {
    const v4u w0 = *(const v4u*)up, w1 = *(const v4u*)(up + 8);
    LAS f32x4* d = (LAS f32x4*)(ubuf + lane * 16);
    d[0] = (f32x4){bflo(w0.x), bfhi(w0.x), bflo(w0.y), bfhi(w0.y)}; d[1] = (f32x4){bflo(w0.z), bfhi(w0.z), bflo(w0.w), bfhi(w0.w)};
    d[2] = (f32x4){bflo(w1.x), bfhi(w1.x), bflo(w1.y), bfhi(w1.y)}; d[3] = (f32x4){bflo(w1.z), bfhi(w1.z), bflo(w1.w), bfhi(w1.w)};
}
#define S5_STEP(sidx) do { const LAS f32x4* up_ = (const LAS f32x4*)(ubuf + (sidx) * 16); const f32x4 u0 = up_[0], u1 = up_[1], u2 = up_[2], u3 = up_[3]; \
    float br = 0.f, bi = 0.f; \
    br += bb[0][0] * u0[0] + bb[0][2] * u0[1]; bi += bb[0][1] * u0[0] + bb[0][3] * u0[1]; br += bb[1][0] * u0[2] + bb[1][2] * u0[3]; bi += bb[1][1] * u0[2] + bb[1][3] * u0[3]; \
    br += bb[2][0] * u1[0] + bb[2][2] * u1[1]; bi += bb[2][1] * u1[0] + bb[2][3] * u1[1]; br += bb[3][0] * u1[2] + bb[3][2] * u1[3]; bi += bb[3][1] * u1[2] + bb[3][3] * u1[3]; \
    br += bb[4][0] * u2[0] + bb[4][2] * u2[1]; bi += bb[4][1] * u2[0] + bb[4][3] * u2[1]; br += bb[5][0] * u2[2] + bb[5][2] * u2[3]; bi += bb[5][1] * u2[2] + bb[5][3] * u2[3]; \
    br += bb[6][0] * u3[0] + bb[6][2] * u3[1]; bi += bb[6][1] * u3[0] + bb[6][3] * u3[1]; br += bb[7][0] * u3[2] + bb[7][2] * u3[3]; bi += bb[7][1] * u3[2] + bb[7][3] * u3[3]; \
    const float nr_ = ar * hr - ai * hi + br, ni_ = ar * hi + ai * hr + bi; hr = nr_; hi = ni_; } while (0)

__device__ __forceinline__ void s5_local(const bf16* proj, const float* abar, const float* bbar, float* sloc, LAS float* ubuf, int slot, int nslots, int lane) {
    for (int t = slot; t < 8192; t += nslots) {
        const int chunk = t & 63, g = (t >> 6) & 31, b = t >> 11;
        s5_stage_u(proj + (size_t)(b * 4096 + chunk * 64 + lane) * 1280 + g * 16, ubuf, lane);
        const float ar = abar[(g * 64 + lane) * 2], ai = abar[(g * 64 + lane) * 2 + 1];
        f32x4 bb[8];
#pragma unroll
        for (int i = 0; i < 8; ++i) bb[i] = *(const f32x4*)(bbar + (size_t)(g * 64 + lane) * 32 + i * 4);
        float hr = 0.f, hi = 0.f;
#pragma unroll 4
        for (int s = 0; s < 64; ++s) S5_STEP(s);
        *(f32x2v*)(sloc + (size_t)t * 128 + lane * 2) = (f32x2v){hr, hi};
    }
}
__device__ __forceinline__ void s5_out(const bf16* proj, const float* abar, const float* bbar, const float* sloc, const float* st_re, const float* st_im, const float* c_re, const float* c_im,
                                       const float* dcoef, bf16* gbuf, float* out, LAS float* ubuf, LAS unsigned* hbuf, int slot, int nslots, int lane) {
    const int fr = lane & 15, quad = lane >> 4;
    for (int t = slot; t < 8192 + 256; t += nslots) {
        const int sample = t >= 8192; int b, g, chunk, nblk, rowbase;
        if (!sample) { chunk = t & 63; g = (t >> 6) & 31; b = t >> 11; nblk = 4; rowbase = b * 4096 + chunk * 64; } else { const int s = t - 8192; g = s & 31; b = s >> 5; chunk = 0; nblk = 2; rowbase = MP + b * 32; }
        if (lane < nblk * 16) s5_stage_u(proj + (size_t)(rowbase + lane) * 1280 + g * 16, ubuf, lane);
        const float ar = abar[(g * 64 + lane) * 2], ai = abar[(g * 64 + lane) * 2 + 1];
        f32x4 bb[8];
#pragma unroll
        for (int i = 0; i < 8; ++i) bb[i] = *(const f32x4*)(bbar + (size_t)(g * 64 + lane) * 32 + i * 4);
        float hr, hi;
        if (!sample) { float pr = ar, pi = ai;
#pragma unroll
            for (int i = 0; i < 6; ++i) { const float t1 = pr * pr - pi * pi; pi = 2.f * pr * pi; pr = t1; }
            hr = 0.f; hi = 0.f; const float* sp = sloc + (size_t)(t - chunk) * 128 + lane * 2;
            for (int cc = 0; cc < chunk; ++cc) { const f32x2v sv = *(const f32x2v*)(sp + (size_t)cc * 128); const float nr = pr * hr - pi * hi + sv.x, ni = pr * hi + pi * hr + sv.y; hr = nr; hi = ni; } }
        else { hr = st_re[(b * 32 + g) * 64 + lane]; hi = st_im[(b * 32 + g) * 64 + lane]; }
        bf16x8 cf[4];
#pragma unroll
        for (int ks = 0; ks < 4; ++ks) { const f32x4 cr = *(const f32x4*)(c_re + (size_t)(g * 16 + fr) * 64 + ks * 16 + quad * 4), ci = *(const f32x4*)(c_im + (size_t)(g * 16 + fr) * 64 + ks * 16 + quad * 4);
            v4u w; w.x = pg8::cvt_pk_bf16(cr[0], -ci[0]); w.y = pg8::cvt_pk_bf16(cr[1], -ci[1]); w.z = pg8::cvt_pk_bf16(cr[2], -ci[2]); w.w = pg8::cvt_pk_bf16(cr[3], -ci[3]); cf[ks] = __builtin_bit_cast(bf16x8, w); }
        const float dco = dcoef[g * 16 + fr];
        for (int blk = 0; blk < nblk; ++blk) {
#pragma unroll 4
            for (int s = 0; s < 16; ++s) { S5_STEP(blk * 16 + s); hbuf[s * 68 + lane] = pg8::cvt_pk_bf16(hr, hi); }
            f32x4 y = {0.f, 0.f, 0.f, 0.f};
#pragma unroll
            for (int ks = 0; ks < 4; ++ks) { const bf16x8 a = *(const LAS bf16x8*)(hbuf + fr * 68 + ks * 16 + quad * 4); y = MFMA16(a, cf[ks], y); }
#pragma unroll
            for (int j = 0; j < 4; ++j) { const int s = blk * 16 + quad * 4 + j; const float uu = ubuf[s * 16 + fr]; const float yv = y[j] + dco * uu;
                const float z = 0.7978845608028654f * (yv + 0.044715f * yv * yv * yv); const float th = 1.0f - 2.0f / (1.0f + __expf(2.0f * z)); const float gl = 0.5f * yv * (1.0f + th);
                gbuf[(size_t)(rowbase + s) * 512 + g * 16 + fr] = (bf16)f2bf(gl); }
        }
        if (!sample && chunk == 63) { out[OFF_SRP + (b * 32 + g) * 64 + lane] = hr; out[OFF_SIP + (b * 32 + g) * 64 + lane] = hi; }
        if (sample) { out[OFF_SRS + (b * 32 + g) * 64 + lane] = hr; out[OFF_SIS + (b * 32 + g) * 64 + lane] = hi; }
    }
}

struct Params { const float* in[36]; float* out; unsigned char* ws; int use_cg, pad; };

__global__ void __launch_bounds__(512, 2) mega_fwd(Params P) {
    extern __shared__ __attribute__((aligned(16))) unsigned char lds_raw[];
    LAS unsigned char* lds = (LAS unsigned char*)lds_raw;
    volatile LAS unsigned* MISC = (volatile LAS unsigned*)(lds + MISC_OFF);
    const int G = gridDim.x, NGW = G * 8, NT = G * 512;
    const int wave_s = __builtin_amdgcn_readfirstlane(threadIdx.x >> 6);
    for (int u = threadIdx.x; u < (LDS_BYTES - 131072) / 4; u += 512) ((LAS unsigned*)(lds + 131072))[u] = 0u;
    __syncthreads();
    XcdBarrier bar = xcd_barrier_post((unsigned*)(P.ws + WS_BAR), MISC + 8);
#ifndef STOP_AFTER
#define STOP_AFTER 1000
#endif
    int ph = 0;
#define RUN (ph < STOP_AFTER)
#define FRESH() const int tid = fresh_tid(wave_s), lane = tid & 63, wave = __builtin_amdgcn_readfirstlane(tid >> 6); const int gw = blockIdx.x * 8 + wave, gt = blockIdx.x * 512 + tid; (void)gw; (void)gt; (void)lane; LAS float* wscr = (LAS float*)(lds + 32768 + wave * 12288); (void)wscr;
#define SEAM() do { if (P.use_cg) cg::this_grid().sync(); else xcd_barrier(bar); ++ph; } while (0)

#define part ((float*)(ws + WS_PART))
#define PARTBUF(k) (part + (size_t)((k) & 1) * PART_ELEMS)
#define ropec ((float*)(ws + WS_ROPE))
#define ropes (ropec + 4096 * 32)
#define abar ((float*)(ws + WS_SSM))
#define bbar (abar + 32 * 64 * 2)
#define ckb ((bf16*)(ws + WS_CKV))
#define cvb (ckb + 8 * 128 * 128)
#define sloc ((float*)(ws + WS_SLOC))
#define memk ((bf16*)(ws + WS_MEMK))
#define memvT ((bf16*)(ws + WS_MEMVT))
#define SG ((float*)(ws + WS_SIDE))
#define SV ((float*)(ws + WS_SIDE + SG_BYTES))
#define WT ((bf16*)(ws + WS_WT))
#define xb ((bf16*)(ws + WS_XB))
#define tmp (ws + WS_TMP)
#define proj0 ((bf16*)(tmp + TMP_PROJ0))
#define gbuf ((bf16*)(tmp + TMP_GBUF))
#define ycat ((bf16*)(tmp + TMP_YCAT))
#define memb ((bf16*)(tmp + TMP_MEMB))
#define qx ((bf16*)(tmp + TMP_QX))
#define ox ((bf16*)(tmp + TMP_OX))
#define act ((bf16*)(tmp + TMP_ACT))
#define gbm ((bf16*)(tmp + TMP_GB))
#define zc ((bf16*)(tmp + TMP_ZC))
#define PTRS() unsigned char* ws = P.ws; float* out = P.out; asm volatile("" : "+s"(ws), "+s"(out));
    if (RUN) { PTRS() FRESH()
        {
            constexpr int NITEMS = 640 + 128 + 512 + 2 * 512 + 2 * 1024 + 2 * 512 + 2 * 2816 + 2 * 1408 + 1536 + 512 + 2048;
            for (int it = gw; it < NITEMS; it += NGW) { int r = it;
#define TR(Wp, K_, N_, WTp, gainp, sc, mode) { const int ni_ = ((K_) / 64) * ((N_) / 32); if (r < ni_) { tr_item(Wp, K_, N_, WTp, gainp, sc, mode, wscr, r, lane); continue; } r -= ni_; }
                TR(P.in[15], 1024, 1280, WT + WT_INEVEN, P.in[11], 1.f, 1)
                TR(P.in[25], 512, 512, WT + WT_GLU, nullptr, 1.f, 0)
                TR(P.in[16], 1024, 1024, WT + WT_OUTEVEN, nullptr, 1.f, 0)
                TR(P.in[30], 1024, 1024, WT + WT_WQ, P.in[12], 0.0625f, 0)
                TR(P.in[30] + 1048576, 1024, 1024, WT + WT_WQ + 1048576, P.in[12] + 1024, 0.0625f, 0)
                TR(P.in[31], 1024, 2048, WT + WT_WKV, nullptr, 1.f, 0)
                TR(P.in[31] + 2097152, 1024, 2048, WT + WT_WKV + 2097152, nullptr, 1.f, 0)
                TR(P.in[32], 1024, 1024, WT + WT_WO, nullptr, 1.f, 0)
                TR(P.in[32] + 1048576, 1024, 1024, WT + WT_WO + 1048576, nullptr, 1.f, 0)
                TR(P.in[33], 1024, 5632, WT + WT_UP, P.in[13], 1.f, 2)
                TR(P.in[33] + (size_t)1024 * 5632, 1024, 5632, WT + WT_UP + (size_t)5632 * 1024, P.in[13] + 1024, 1.f, 2)
                TR(P.in[35], 2816, 1024, WT + WT_DOWN, nullptr, 1.f, 0)
                TR(P.in[35] + (size_t)2816 * 1024, 2816, 1024, WT + WT_DOWN + (size_t)2816 * 1024, nullptr, 1.f, 0)
                TR(P.in[27], 1024, 3072, WT + WT_INODD, P.in[11] + 1024, 1.f, 3)
                TR(P.in[29], 1024, 1024, WT + WT_OUTODD, nullptr, 1.f, 0)
                { const int mi = r >> 7, l = mi >> 3, b = mi & 7; tr_item(P.in[10] + (size_t)mi * 262144, 256, 1024, memvT + (size_t)(l * 12 + 4 + b) * 262144, nullptr, 1.f, 0, wscr, r & 127, lane); }
            }
        }
        for (int m = gw; m < MROWS; m += NGW) { const float* xr = m < MP ? P.in[0] + (size_t)m * 1024 : P.in[1] + (size_t)(m - MP) * 1024; float ss = 0.f;
#pragma unroll
            for (int j = 0; j < 4; ++j) { const f32x4 v = *(const f32x4*)(xr + (lane + 64 * j) * 4); ss += (v[0] * v[0] + v[1] * v[1]) + (v[2] * v[2] + v[3] * v[3]);
                u32x2v w; w.x = pg8::cvt_pk_bf16(v[0], v[1]); w.y = pg8::cvt_pk_bf16(v[2], v[3]); *(u32x2v*)(xb + (size_t)m * 1024 + (lane + 64 * j) * 4) = w; }
            ss = wave_sum(ss); if (lane < 16) PARTBUF(0)[(size_t)m * 16 + lane] = lane == 0 ? ss : 0.f; }
        for (int i = gt; i < 262144; i += NT) { const f32x4 v = *(const f32x4*)(P.in[2] + (size_t)i * 4); u32x2v w; w.x = pg8::cvt_pk_bf16(v[0], v[1]); w.y = pg8::cvt_pk_bf16(v[2], v[3]); *(u32x2v*)(memb + (size_t)i * 4) = w; }
        for (int i = gt; i < 1048576; i += NT) { const size_t e = (size_t)i * 4; const int lb = (int)(e >> 18), l = lb >> 3, b = lb & 7; const f32x4 v = *(const f32x4*)(P.in[9] + e);
            u32x2v w; w.x = pg8::cvt_pk_bf16(v[0], v[1]); w.y = pg8::cvt_pk_bf16(v[2], v[3]); *(u32x2v*)(memk + (size_t)(l * 12 + 4 + b) * 262144 + (e & 262143)) = w; }
        for (int i = gt; i < 65536; i += NT) { const int j = i & 32767; const float* src = (i < 32768 ? P.in[3] : P.in[4]) + (size_t)j * 4; bf16* dst = (i < 32768 ? ckb : cvb) + (size_t)j * 4;
            const f32x4 v = *(const f32x4*)src; u32x2v w; w.x = pg8::cvt_pk_bf16(v[0], v[1]); w.y = pg8::cvt_pk_bf16(v[2], v[3]); *(u32x2v*)dst = w; }
        for (int i = gt; i < 4096 * 32; i += NT) { const int pos = i >> 5, d = i & 31; const double inv = dexp_(-(double)d * (9.210340371976184 / 32.0)); double s, c; dsincos_((double)pos * inv, s, c); ropec[i] = (float)c; ropes[i] = (float)s; }
        for (int i = gt; i < 2048; i += NT) { const double are = P.in[17][i], aim = P.in[18][i], dt = dexp_((double)P.in[19][i]); double s, c; dsincos_(aim * dt, s, c); const double mag = dexp_(are * dt);
            const double br = mag * c, bi = mag * s; abar[2 * i] = (float)br; abar[2 * i + 1] = (float)bi;
            const double nr = br - 1.0, ni = bi, den = are * are + aim * aim; const double qr = (nr * are + ni * aim) / den, qi = (ni * are - nr * aim) / den;
#pragma unroll 4
            for (int h = 0; h < 16; ++h) { const double xr = P.in[20][(size_t)i * 16 + h], xi = P.in[21][(size_t)i * 16 + h]; bbar[(size_t)i * 32 + 2 * h] = (float)(qr * xr - qi * xi); bbar[(size_t)i * 32 + 2 * h + 1] = (float)(qr * xi + qi * xr); } }
    }
    SEAM();
    if (RUN) { PTRS()
        if (G < 128 || (int)blockIdx.x >= G - 64) { pg8::Gemm g{memb, WT + WT_WKV, 1024, 4096, 1024}; pg8::StaticOrder S;
            if (G < 128) S.init(1024, 4096, G, (int)blockIdx.x); else S.init(1024, 4096, 64, (int)blockIdx.x - (G - 64)); EpiKV E{out, memk};
          pg8::gemm_phase<EpiKV, pg8::StaticOrder, true, true>(lds, g, S, E, wave_s); }
        { pg8::Gemm g{xb, WT + WT_INEVEN, MROWS, 1280, 1024}; pg8::StaticOrderF S; S.init(MROWS, 1280, G, (int)blockIdx.x); EpiIn0 E{proj0, PARTBUF(0), ropec, ropes, out};
          pg8::gemm_phase<EpiIn0, pg8::StaticOrderF, true, true>(lds, g, S, E, wave_s); }
    }
    SEAM();
    if (RUN) { PTRS() FRESH()
        swa_phase(proj0, ckb, cvb, P.in[26], ycat, lds, tid, wave, lane, G);
        s5_local(proj0, abar, bbar, sloc, wscr, wave * G + (int)blockIdx.x, NGW, lane);
        for (int it = wave * G + (int)blockIdx.x; it < 1024; it += NGW) { const int mi = it >> 7, l = mi >> 2, b = mi & 3;
            tr_item(out + OFF_MVP + (size_t)mi * 262144, 256, 1024, memvT + (size_t)(l * 12 + b) * 262144, nullptr, 1.f, 0, wscr, it & 127, lane); }
    }
    SEAM();
    if (RUN) { PTRS() FRESH() s5_out(proj0, abar, bbar, sloc, P.in[5], P.in[6], P.in[22], P.in[23], P.in[24], gbuf, out, wscr, (LAS unsigned*)(wscr + 1024), wave * G + (int)blockIdx.x, NGW, lane); }
    SEAM();
    if (RUN) { PTRS() pg8::Gemm g{gbuf, WT + WT_GLU, MROWS, 512, 512}; pg8::StaticOrder S; S.init(MROWS, 512, G, (int)blockIdx.x); EpiGlu E{gbuf, ycat};
        pg8::gemm_phase<EpiGlu, pg8::StaticOrder, true, true>(lds, g, S, E, wave_s); }
    SEAM();

#pragma unroll
    for (int l = 0; l < 2; ++l) {
        if (l == 1) {
            if (RUN) { PTRS() pg8::Gemm g{xb, WT + WT_INODD, MROWS, 3072, 1024}; pg8::StaticOrderF S; S.init(MROWS, 3072, G, (int)blockIdx.x); EpiInOdd E{gbm, zc, PARTBUF(3), P.in[28], SG};
                pg8::gemm_phase<EpiInOdd, pg8::StaticOrderF, true, true>(lds, g, S, E, wave_s); }
            SEAM();
            if (RUN) { PTRS() FRESH()
                const float* cw = P.in[28]; const float* st = P.in[7];
                for (int i = gt; i < MROWS * 128; i += NT) { const int row = i >> 7, c0 = (i & 127) * 8, blk = row >> 6, r = row & 63;
                    const bool smp = row >= MP; const int rr = smp ? (r & 31) : r;
                    f32x4 z0, z1;
                    if (rr < 2) { const int sb = smp ? (r >> 5) * 4 : 0;
                        f32x4 pa0, pa1, pb0, pb1;
                        if (smp) { const int b = (blk - 256) * 2 + (r >> 5); const float* s0 = st + (size_t)(b * 2) * 1024 + c0; pa0 = *(const f32x4*)s0; pa1 = *(const f32x4*)(s0 + 4); pb0 = *(const f32x4*)(s0 + 1024); pb1 = *(const f32x4*)(s0 + 1028); }
                        else if ((blk & 63) == 0) { pa0 = pa1 = pb0 = pb1 = (f32x4){0.f, 0.f, 0.f, 0.f}; }
                        else { const float* s0 = SG + (size_t)((blk - 1) * 8 + 6) * 1024 + c0; pa0 = *(const f32x4*)s0; pa1 = *(const f32x4*)(s0 + 4); pb0 = *(const f32x4*)(s0 + 1024); pb1 = *(const f32x4*)(s0 + 1028); }
                        const float* sc = SG + (size_t)(blk * 8 + sb) * 1024 + c0; const f32x4 x00 = *(const f32x4*)sc, x01 = *(const f32x4*)(sc + 4);
                        f32x4 xm2a, xm2b, xm1a, xm1b, xca, xcb;
                        if (rr == 0) { xm2a = pa0; xm2b = pa1; xm1a = pb0; xm1b = pb1; xca = x00; xcb = x01; }
                        else { xm2a = pb0; xm2b = pb1; xm1a = x00; xm1b = x01; xca = *(const f32x4*)(sc + 1024); xcb = *(const f32x4*)(sc + 1028); }
                        const f32x4 w0a = *(const f32x4*)(cw + c0), w0b = *(const f32x4*)(cw + c0 + 4), w1a = *(const f32x4*)(cw + 1024 + c0), w1b = *(const f32x4*)(cw + 1028 + c0), w2a = *(const f32x4*)(cw + 2048 + c0), w2b = *(const f32x4*)(cw + 2052 + c0);
                        z0 = w0a * xm2a + w1a * xm1a + w2a * xca; z1 = w0b * xm2b + w1b * xm1b + w2b * xcb; }
                    else { const v4u zw = *(const v4u*)(zc + (size_t)row * 1024 + c0); z0 = (f32x4){bflo(zw.x), bfhi(zw.x), bflo(zw.y), bfhi(zw.y)}; z1 = (f32x4){bflo(zw.z), bfhi(zw.z), bflo(zw.w), bfhi(zw.w)}; }
                    const v4u gw_ = *(const v4u*)(gbm + (size_t)row * 1024 + c0);
                    const f32x4 g0 = (f32x4){bflo(gw_.x), bfhi(gw_.x), bflo(gw_.y), bfhi(gw_.y)}, g1 = (f32x4){bflo(gw_.z), bfhi(gw_.z), bflo(gw_.w), bfhi(gw_.w)};
                    *(v4u*)(gbm + (size_t)row * 1024 + c0) = pack8(g0 * z0, g1 * z1); }
                for (int i = gt; i < 4 * 2 * 1024; i += NT) { const int c = i & 1023, j = (i >> 10) & 1, b = i >> 11; out[OFF_CMP + i] = SG[(size_t)((64 * b + 63) * 8 + 6 + j) * 1024 + c]; }
                for (int i = gt; i < 8 * 2 * 1024; i += NT) { const int c = i & 1023, j = (i >> 10) & 1, b = i >> 11; out[OFF_CMS + i] = SG[(size_t)((256 + (b >> 1)) * 8 + (b & 1) * 4 + 2 + j) * 1024 + c]; }
            }
            SEAM();
        }
        if (RUN) { PTRS() pg8::Gemm g{(bf16*)(tmp + (size_t)(1 - l) * TMP_YCAT), WT + WT_OUTEVEN + (size_t)l * (WT_OUTODD - WT_OUTEVEN), MROWS, 1024, 1024}; pg8::StaticOrderF S; S.init(MROWS, 1024, G, (int)blockIdx.x);
            EpiRes E{l == 0 ? P.in[0] : out, l == 0 ? P.in[1] - (size_t)MP * 1024 : out, out, xb, PARTBUF(1 + 3 * l)};
            pg8::gemm_phase<EpiRes, pg8::StaticOrderF, true, true>(lds, g, S, E, wave_s); }
        SEAM();
        if (RUN) { PTRS() pg8::Gemm g{xb, WT + WT_WQ + (size_t)l * 1048576, MROWS, 1024, 1024}; pg8::StaticOrderF S; S.init(MROWS, 1024, G, (int)blockIdx.x); EpiBf16 E{qx, 1024, PARTBUF(1 + 3 * l)};
            pg8::gemm_phase<EpiBf16, pg8::StaticOrderF, true, true>(lds, g, S, E, wave_s); }
        SEAM();
        if (RUN) { PTRS() FRESH() xattn_phase2(qx, memk + (size_t)l * 12 * 262144, memvT + (size_t)l * 12 * 262144, ox, lds, tid, wave, lane, G); }
        SEAM();
        if (RUN) { PTRS() pg8::Gemm g{ox, WT + WT_WO + (size_t)l * 1048576, MROWS, 1024, 1024}; pg8::StaticOrderF S; S.init(MROWS, 1024, G, (int)blockIdx.x); EpiRes E{out, out, out, xb, PARTBUF(2 + 3 * l)};
            pg8::gemm_phase<EpiRes, pg8::StaticOrderF, true, true>(lds, g, S, E, wave_s); }
        SEAM();
        if (RUN) { PTRS() pg8::Gemm g{xb, WT + WT_UP + (size_t)l * 5632 * 1024, MROWS, 5632, 1024}; pg8::StaticOrderF S; S.init(MROWS, 5632, G, (int)blockIdx.x);
            EpiFfnUp E{act, PARTBUF(2 + 3 * l), P.in[34] + (size_t)l * 3 * DFF, SG, SV};
            pg8::gemm_phase<EpiFfnUp, pg8::StaticOrderF, true, true>(lds, g, S, E, wave_s); }
        SEAM();
        if (RUN) { PTRS() FRESH()
            const float* cw = P.in[34] + (size_t)l * 3 * DFF; const float* st = P.in[8] + (size_t)l * 8 * 2 * DFF;
            for (int i = gt; i < 528 * 352; i += NT) { const int fi = i / 352, c0 = (i % 352) * 8; int blk, row, rr, sb, vb; bool smp = fi >= 512;
                if (!smp) { blk = fi >> 1; rr = fi & 1; row = blk * 64 + rr; sb = 0; vb = 0; } else { const int s = fi - 512, half = (s >> 1) & 1; blk = 256 + (s >> 2); rr = s & 1; row = blk * 64 + half * 32 + rr; sb = half * 4; vb = half * 2; }
                f32x4 pa0, pa1, pb0, pb1;
                if (smp) { const int b = (blk - 256) * 2 + (sb >> 2); const float* s0 = st + (size_t)(b * 2) * DFF + c0; pa0 = *(const f32x4*)s0; pa1 = *(const f32x4*)(s0 + 4); pb0 = *(const f32x4*)(s0 + DFF); pb1 = *(const f32x4*)(s0 + DFF + 4); }
                else if ((blk & 63) == 0) { pa0 = pa1 = pb0 = pb1 = (f32x4){0.f, 0.f, 0.f, 0.f}; }
                else { const float* s0 = SG + (size_t)((blk - 1) * 8 + 6) * DFF + c0; pa0 = *(const f32x4*)s0; pa1 = *(const f32x4*)(s0 + 4); pb0 = *(const f32x4*)(s0 + DFF); pb1 = *(const f32x4*)(s0 + DFF + 4); }
                const float* sc = SG + (size_t)(blk * 8 + sb) * DFF + c0; const f32x4 x00 = *(const f32x4*)sc, x01 = *(const f32x4*)(sc + 4);
                f32x4 xm2a, xm2b, xm1a, xm1b, xca, xcb;
                if (rr == 0) { xm2a = pa0; xm2b = pa1; xm1a = pb0; xm1b = pb1; xca = x00; xcb = x01; }
                else { xm2a = pb0; xm2b = pb1; xm1a = x00; xm1b = x01; xca = *(const f32x4*)(sc + DFF); xcb = *(const f32x4*)(sc + DFF + 4); }
                const f32x4 w0a = *(const f32x4*)(cw + c0), w0b = *(const f32x4*)(cw + c0 + 4), w1a = *(const f32x4*)(cw + DFF + c0), w1b = *(const f32x4*)(cw + DFF + c0 + 4), w2a = *(const f32x4*)(cw + 2 * DFF + c0), w2b = *(const f32x4*)(cw + 2 * DFF + c0 + 4);
                const f32x4 ga = w0a * xm2a + w1a * xm1a + w2a * xca, gb_ = w0b * xm2b + w1b * xm1b + w2b * xcb;
                const float* sv = SV + (size_t)(blk * 4 + vb + rr) * DFF + c0; const f32x4 va = *(const f32x4*)sv, vb_ = *(const f32x4*)(sv + 4);
                f32x4 a0, a1;
#pragma unroll
                for (int j = 0; j < 4; ++j) { a0[j] = ga[j] * sigmoidf_(ga[j]) * va[j]; a1[j] = gb_[j] * sigmoidf_(gb_[j]) * vb_[j]; }
                *(v4u*)(act + (size_t)row * DFF + c0) = pack8(a0, a1); }
            for (int i = gt; i < 4 * 2 * DFF; i += NT) { const int c = i % DFF, j = (i / DFF) & 1, b = i / (2 * DFF); out[OFF_CFP + (size_t)l * 4 * 2 * DFF + i] = SG[(size_t)((64 * b + 63) * 8 + 6 + j) * DFF + c]; }
            for (int i = gt; i < 8 * 2 * DFF; i += NT) { const int c = i % DFF, j = (i / DFF) & 1, b = i / (2 * DFF); out[OFF_CFS + (size_t)l * 8 * 2 * DFF + i] = SG[(size_t)((256 + (b >> 1)) * 8 + (b & 1) * 4 + 2 + j) * DFF + c]; }
        }
        SEAM();
        if (RUN) { PTRS() pg8::Gemm g{act, WT + WT_DOWN + (size_t)l * 2816 * 1024, MROWS, 1024, DFF}; pg8::StaticOrderF S; S.init(MROWS, 1024, G, (int)blockIdx.x); EpiRes E{out, out, out, xb, PARTBUF(3 + 3 * l)};
            pg8::gemm_phase<EpiRes, pg8::StaticOrderF, true, true>(lds, g, S, E, wave_s); }
        SEAM();
    }
    if (RUN) { PTRS() FRESH()
        const float* gf = P.in[14];
        for (int m = gw; m < MROWS; m += NGW) { const float rs = rstd_of(PARTBUF(6), m); float* xr = out + (size_t)m * 1024;
#pragma unroll
            for (int j = 0; j < 4; ++j) { const int c = (lane + 64 * j) * 4; const f32x4 v = *(const f32x4*)(xr + c), gg = *(const f32x4*)(gf + c); *(f32x4*)(xr + c) = v * rs * gg; } }
    }
}

extern "C" void kernel_launch(void* const* d_in, const int* in_sizes, int n_in, void* d_out, int out_size, void* d_ws, size_t ws_size, hipStream_t stream) {
    static int grid = 0;
    if (grid == 0) {
        int dev = 0, cus = 0, per_cu = 0;
        if (n_in != 36 || ws_size < 256 * MiB) { fprintf(stderr, "kernel_launch: unexpected n_in %d / ws %zu\n", n_in, ws_size); grid = -1; return; }
        (void)hipGetDevice(&dev); (void)hipDeviceGetAttribute(&cus, hipDeviceAttributeMultiprocessorCount, dev);
        if (hipFuncSetAttribute((const void*)mega_fwd, hipFuncAttributeMaxDynamicSharedMemorySize, LDS_BYTES) != hipSuccess) { fprintf(stderr, "kernel_launch: hipFuncSetAttribute failed\n"); grid = -1; return; }
        if (hipOccupancyMaxActiveBlocksPerMultiprocessor(&per_cu, (const void*)mega_fwd, 512, LDS_BYTES) != hipSuccess || per_cu < 1) per_cu = 1;
        (void)hipGetLastError();
        grid = cus * 1;
        if (grid > 256) grid = 256;
    }
    if (grid < 0) return;
    (void)hipMemsetAsync(d_ws, 0, CTL_ZERO_BYTES, stream);
    Params p{};
    for (int i = 0; i < 36; ++i) p.in[i] = (const float*)d_in[i];
    p.out = (float*)d_out; p.ws = (unsigned char*)d_ws; p.use_cg = 0; p.pad = 0;
    void* args[] = {&p};
    hipError_t e = hipLaunchCooperativeKernel((const void*)mega_fwd, dim3(grid), dim3(512), args, LDS_BYTES, stream);
    if (e != hipSuccess) fprintf(stderr, "cooperative launch failed: %s (grid %d)\n", hipGetErrorString(e), grid);
}
```

```cpp
#include <hip/hip_runtime.h>
#include <hip/hip_cooperative_groups.h>
#include <cstdio>
#include <cstdint>
namespace cg = cooperative_groups;
__device__ __forceinline__ int fresh_tid(int wave_s) { unsigned z = 0u; asm volatile("" : "+s"(z)); int t = wave_s * 64 + (int)__builtin_amdgcn_mbcnt_hi(~0u, __builtin_amdgcn_mbcnt_lo(~0u, z)); asm volatile("" : "+v"(t)); return t; }
namespace pg8 {
#define PG8_LAS __attribute__((address_space(3)))
typedef unsigned short bf16_t;
typedef short bf16x8 __attribute__((ext_vector_type(8)));
typedef float f32x4 __attribute__((ext_vector_type(4)));
typedef unsigned u32x4 __attribute__((ext_vector_type(4)));
constexpr int BM = 256, BK = 64, HALF = 128, HTB = HALF * BK * 2  , STAGE_BYTES = 8 * HTB, NXCD = 8, WGM = 8;

__host__ __device__ __forceinline__ int lds_byte(int r, int c) { const int st = (r >> 4) * 2 + (c >> 5), rr = r & 15, cc = c & 31, ob = rr * 64 + cc * 2; return st * 1024 + (ob ^ (((ob >> 9) & 1) << 5)); }
__host__ __device__ __forceinline__ void stage_rc(int b, int& R, int& C) { const int st = b / 1024, sb = b % 1024, swz = sb ^ (((sb >> 9) & 1) << 5); R = (st >> 1) * 16 + swz / 64; C = (st & 1) * 32 + (swz % 64) / 2; }
__host__ __device__ __forceinline__ int perm32(int rho) { const int n = rho >> 4, i = rho & 15; return 8 * (i >> 2) + 4 * n + (i & 3); }

struct Unit { int pm, pn; };
struct Gemm { const bf16_t* A; const bf16_t* Bt; int M, N, K; };

template <bool FULL> struct StaticOrderT {
    int nM, nN, nwg, G, c;
    __host__ __device__ void init(int M, int N, int G_, int c_) { nM = M / BM; nN = N / BM; nwg = nM * nN; G = G_; c = c_; }
    __host__ __device__ bool next(int i, Unit& u) const {
        const long L = (long)i * G + c; if (!(FULL && i == 0) && L >= nwg) return false;
        int wgid = (int)L; { const int q = nwg / NXCD, r = nwg % NXCD, xcd = wgid % NXCD, off = wgid / NXCD; wgid = (xcd < r ? xcd * (q + 1) : r * (q + 1) + (xcd - r) * q) + off; }
        const int nig = WGM * nN, gid = wgid / nig, fm = gid * WGM, gsz = (nM - fm) < WGM ? (nM - fm) : WGM;
        u.pm = fm + ((wgid % nig) % gsz); u.pn = (wgid % nig) / gsz; return true;
    }
    __device__ __forceinline__ void a_ready(const Unit&) const {}
    __device__ __forceinline__ void done(const Unit&) const {}
};

typedef StaticOrderT<false> StaticOrder; typedef StaticOrderT<true> StaticOrderF;
__device__ __forceinline__ unsigned cvt_pk_bf16(float lo, float hi) { unsigned r; asm volatile("v_cvt_pk_bf16_f32 %0, %1, %2" : "=v"(r) : "v"(lo), "v"(hi)); return r; }
typedef float f32x2 __attribute__((ext_vector_type(2)));
template <class Epi, class Sched, bool ALIGN_EPI = false, bool SP2 = false>
__device__ __forceinline__ void gemm_phase(PG8_LAS unsigned char* lds, const Gemm g, const Sched& S, const Epi& E, const int wave_s) {
    const int tid = fresh_tid(wave_s), wid = __builtin_amdgcn_readfirstlane(tid >> 6), lane = tid & 63, wr = wid >> 2, wc = wid & 3, fr = lane & 15, fq = lane >> 4;
    const int K = g.K, nt = K / BK;
    unsigned voffA[2], voffB[2];
#pragma unroll
    for (int i = 0; i < 2; ++i) { int R, C; stage_rc(tid * 16 + i * 8192, R, C); const int Rb = Epi::PERM ? ((R & ~31) + perm32(R & 31)) : R;
        voffA[i] = (unsigned)(R * K + C) * 2u; voffB[i] = (unsigned)(Rb * K + C) * 2u; }
    const size_t kstep = (size_t)(BK * 2);
    const size_t hstep = (size_t)HALF * K * 2;
    const size_t tstep = 2 * hstep;
    const unsigned ldsw = (unsigned)wid * 1024u;
    const int aoff = lds_byte(wr * 64 + fr, fq * 8), boff = lds_byte(wc * 32 + fr, fq * 8);
#define PG8_SA(b, h) (((b) * 2 + (h)) * HTB)
#define PG8_SB(b, h) ((4 + (b) * 2 + (h)) * HTB)
#define PG8_STAGE(bufoff, gbase, voff) do { _Pragma("unroll") for (int _i = 0; _i < 2; ++_i) \
        __builtin_amdgcn_global_load_lds((const unsigned*)((const char*)(gbase) + (voff)[_i]), (PG8_LAS unsigned*)(lds + (bufoff) + ldsw + _i * 8192), 16, 0, 0); } while (0)
#define PG8_LDA(dst, b, h) do { _Pragma("unroll") for (int m = 0; m < 4; ++m) _Pragma("unroll") for (int k = 0; k < 2; ++k) dst[m][k] = *(const PG8_LAS bf16x8*)(lds + PG8_SA(b, h) + aoff + m * 2048 + k * 1024); } while (0)
#define PG8_LDB(dst, b, h) do { _Pragma("unroll") for (int n = 0; n < 2; ++n) _Pragma("unroll") for (int k = 0; k < 2; ++k) dst[n][k] = *(const PG8_LAS bf16x8*)(lds + PG8_SB(b, h) + boff + n * 2048 + k * 1024); } while (0)
#define PG8_MMA(ai, bj, At, Bt) do { __builtin_amdgcn_s_setprio(1); _Pragma("unroll") for (int m = 0; m < 4; ++m) _Pragma("unroll") for (int n = 0; n < 2; ++n) _Pragma("unroll") for (int k = 0; k < 2; ++k) \
        acc[ai][bj][m][n] = __builtin_amdgcn_mfma_f32_16x16x32_bf16(Bt[n][k], At[m][k], acc[ai][bj][m][n], 0, 0, 0); __builtin_amdgcn_s_setprio(0); } while (0)
#define PG8_WAIT_V(n) asm volatile("s_waitcnt vmcnt(" #n ")" ::: "memory")
#define PG8_WAIT_L(n) asm volatile("s_waitcnt lgkmcnt(" #n ")" ::: "memory")
#define PG8_BAR __builtin_amdgcn_s_barrier()
#define PG8_SCHED __builtin_amdgcn_sched_barrier(0)
    Unit cur, nxt; int ui = 0;
    if (!S.next(0, cur)) return;
    f32x4 acc[2][2][4][2];
#pragma unroll
    for (int a = 0; a < 2; ++a)
#pragma unroll
        for (int b = 0; b < 2; ++b)
#pragma unroll
            for (int m = 0; m < 4; ++m)
#pragma unroll
                for (int n = 0; n < 2; ++n) acc[a][b][m][n] = (f32x4){0.f, 0.f, 0.f, 0.f};
    bf16x8 At[4][2], B0[2][2], B1[2][2];
    const char* cA = (const char*)g.A + (size_t)cur.pm * tstep; const char* cB = (const char*)g.Bt + (size_t)cur.pn * tstep;
    S.a_ready(cur);
    if constexpr (SP2) {
        PG8_STAGE(PG8_SB(0, 0), cB, voffB); PG8_STAGE(PG8_SB(0, 1), cB + hstep, voffB); PG8_STAGE(PG8_SA(0, 0), cA, voffA); PG8_STAGE(PG8_SA(0, 1), cA + hstep, voffA);
        if (wr == 1) PG8_BAR;
        PG8_WAIT_V(2); PG8_BAR;
        PG8_STAGE(PG8_SB(1, 0), cB + kstep, voffB); PG8_STAGE(PG8_SA(1, 0), cA + kstep, voffA); PG8_STAGE(PG8_SB(1, 1), cB + hstep + kstep, voffB);
        PG8_WAIT_V(6); PG8_BAR;
    } else {
        PG8_STAGE(PG8_SB(0, 0), cB, voffB); PG8_STAGE(PG8_SA(0, 0), cA, voffA); PG8_STAGE(PG8_SB(0, 1), cB + hstep, voffB); PG8_STAGE(PG8_SA(0, 1), cA + hstep, voffA);
        if (wr == 1) PG8_BAR;
        PG8_WAIT_V(4); PG8_BAR;
        PG8_STAGE(PG8_SB(1, 0), cB + kstep, voffB); PG8_STAGE(PG8_SA(1, 0), cA + kstep, voffA); PG8_STAGE(PG8_SB(1, 1), cB + hstep + kstep, voffB);
        PG8_WAIT_V(6); PG8_BAR;
    }
    for (;;) {
        const bool has_next = S.next(ui + 1, nxt);
        const char* nA = has_next ? (const char*)g.A + (size_t)nxt.pm * tstep : cA; const char* nB = has_next ? (const char*)g.Bt + (size_t)nxt.pn * tstep : cB;
        for (int t = 0; t < nt; t += 2) {
            const bool last = (t == nt - 2);
            const char* a1 = cA + (size_t)(t + 1) * kstep;
            const char* a2 = last ? nA : cA + (size_t)(t + 2) * kstep; const char* b2 = last ? nB : cB + (size_t)(t + 2) * kstep;
            const char* a3 = a2 + kstep; const char* b3 = b2 + kstep;
            if (last && has_next) S.a_ready(nxt);
            if constexpr (SP2) {
            PG8_LDB(B0, 0, 0); PG8_LDB(B1, 0, 1); PG8_SCHED; PG8_LDA(At, 0, 0); PG8_STAGE(PG8_SA(1, 1), a1 + hstep, voffA);
            PG8_WAIT_V(8); PG8_WAIT_L(0); PG8_BAR; PG8_MMA(0, 0, At, B0); PG8_MMA(0, 1, At, B1); PG8_BAR; PG8_SCHED;
            PG8_LDA(At, 0, 1); PG8_STAGE(PG8_SB(0, 0), b2, voffB); PG8_STAGE(PG8_SB(0, 1), b2 + hstep, voffB); PG8_STAGE(PG8_SA(0, 0), a2, voffA);
            PG8_WAIT_V(8); PG8_WAIT_L(0); PG8_BAR; PG8_MMA(1, 0, At, B0); PG8_MMA(1, 1, At, B1); PG8_BAR; PG8_SCHED;
            PG8_LDB(B0, 1, 0); PG8_LDB(B1, 1, 1); PG8_SCHED; PG8_LDA(At, 1, 0); PG8_STAGE(PG8_SA(0, 1), a2 + hstep, voffA);
            PG8_WAIT_V(8); PG8_WAIT_L(0); PG8_BAR; PG8_MMA(0, 0, At, B0); PG8_MMA(0, 1, At, B1); PG8_BAR; PG8_SCHED;
            PG8_LDA(At, 1, 1); PG8_STAGE(PG8_SB(1, 0), b3, voffB); PG8_STAGE(PG8_SB(1, 1), b3 + hstep, voffB); PG8_STAGE(PG8_SA(1, 0), a3, voffA);
            PG8_WAIT_V(8); PG8_WAIT_L(0); PG8_BAR; PG8_MMA(1, 0, At, B0); PG8_MMA(1, 1, At, B1); PG8_BAR; PG8_SCHED;
            } else {
            PG8_LDB(B0, 0, 0); PG8_SCHED; PG8_LDA(At, 0, 0); PG8_STAGE(PG8_SA(1, 1), a1 + hstep, voffA);
            PG8_WAIT_L(8); PG8_BAR; PG8_WAIT_L(0); PG8_MMA(0, 0, At, B0); PG8_BAR; PG8_SCHED;
            PG8_LDB(B1, 0, 1); PG8_STAGE(PG8_SB(0, 0), b2, voffB);
            PG8_BAR; PG8_WAIT_L(0); PG8_MMA(0, 1, At, B1); PG8_BAR;
            PG8_LDA(At, 0, 1); PG8_STAGE(PG8_SA(0, 0), a2, voffA);
            PG8_BAR; PG8_WAIT_L(0); PG8_MMA(1, 0, At, B0); PG8_BAR; PG8_SCHED;
            PG8_STAGE(PG8_SB(0, 1), b2 + hstep, voffB);
            PG8_WAIT_V(6); PG8_BAR; PG8_MMA(1, 1, At, B1); PG8_BAR;
            PG8_LDB(B0, 1, 0); PG8_SCHED; PG8_LDA(At, 1, 0); PG8_STAGE(PG8_SA(0, 1), a2 + hstep, voffA);
            PG8_WAIT_L(8); PG8_BAR; PG8_WAIT_L(0); PG8_MMA(0, 0, At, B0); PG8_BAR; PG8_SCHED;
            PG8_LDB(B1, 1, 1); PG8_STAGE(PG8_SB(1, 0), b3, voffB);
            PG8_BAR; PG8_WAIT_L(0); PG8_MMA(0, 1, At, B1); PG8_BAR;
            PG8_LDA(At, 1, 1); PG8_STAGE(PG8_SA(1, 0), a3, voffA);
            PG8_BAR; PG8_WAIT_L(0); PG8_MMA(1, 0, At, B0); PG8_BAR; PG8_SCHED;
            PG8_STAGE(PG8_SB(1, 1), b3 + hstep, voffB);
            PG8_WAIT_V(6); PG8_BAR; PG8_MMA(1, 1, At, B1); PG8_BAR;
            }
        }
        if constexpr (ALIGN_EPI) { if (wr == 0) PG8_BAR; }
        if constexpr (!Epi::AFTER_DRAIN) { E(acc, cur, wr, wc, fr, fq); S.done(cur); }
        if (!has_next) break;
#pragma unroll
        for (int a = 0; a < 2; ++a)
#pragma unroll
            for (int b = 0; b < 2; ++b)
#pragma unroll
                for (int m = 0; m < 4; ++m)
#pragma unroll
                    for (int n = 0; n < 2; ++n) acc[a][b][m][n] = (f32x4){0.f, 0.f, 0.f, 0.f};
        cur = nxt; cA = nA; cB = nB; ++ui;
        if constexpr (ALIGN_EPI) { if (wr == 1) PG8_BAR; }
    }
    PG8_WAIT_V(0);
    if constexpr (!ALIGN_EPI) { if (wr == 0) PG8_BAR; }
    PG8_BAR;
    if constexpr (Epi::AFTER_DRAIN) { E.fused(acc, cur, wr, wc, fr, fq, lds, wid, lane); S.done(cur); }
#undef PG8_SA
#undef PG8_SB
#undef PG8_STAGE
#undef PG8_LDA
#undef PG8_LDB
#undef PG8_MMA
#undef PG8_WAIT_V
#undef PG8_WAIT_L
#undef PG8_BAR
#undef PG8_SCHED
}
}
#define GAS __attribute__((address_space(1)))
#define LAS __attribute__((address_space(3)))
typedef unsigned short bf16;
typedef unsigned v4u __attribute__((ext_vector_type(4)));
typedef float f32x4 __attribute__((ext_vector_type(4)));
typedef short bf16x8 __attribute__((ext_vector_type(8)));
typedef GAS unsigned gu32;
typedef GAS unsigned long long gu64;
#define RLX_AGENT __ATOMIC_RELAXED, __HIP_MEMORY_SCOPE_AGENT
#define LDS_WAIT() asm volatile("s_waitcnt lgkmcnt(0)" ::: "memory")
#define VM_WAIT() asm volatile("s_waitcnt vmcnt(0)" ::: "memory")
__device__ __forceinline__ unsigned long long rt() { return __builtin_amdgcn_s_memrealtime(); }
__device__ __forceinline__ unsigned f2bf(float f) { unsigned u = __builtin_bit_cast(unsigned, f); return (u + 0x7fffu + ((u >> 16) & 1u)) >> 16; }
__device__ __forceinline__ unsigned pk2(float lo, float hi) { return f2bf(lo) | (f2bf(hi) << 16); }

#define XB_TMO      128
#define XB_XCNT(j)  (256  + 64 * (j))
#define XB_XSUB(j)  (1280 + 64 * (j))
#define XB_XGEN(j)  (2304 + 64 * (j))
#define XB_TOP      3328
#define XB_TOPGEN   3392
#define XCD_BAR_WORDS 3456
#define XB_SPIN_CAP (1u << 18)

__device__ __forceinline__ unsigned xb_ld(unsigned* p)              { return __hip_atomic_load(p, __ATOMIC_RELAXED, __HIP_MEMORY_SCOPE_AGENT); }
__device__ __forceinline__ unsigned xb_add(unsigned* p, unsigned v) { return __hip_atomic_fetch_add(p, v, __ATOMIC_RELAXED, __HIP_MEMORY_SCOPE_AGENT); }
__device__ __forceinline__ unsigned xb_xcc_id() { return (unsigned)__builtin_amdgcn_s_getreg((3 << 11) | 20) & 0xFu; }
#define XB_SPIN(cond, bar) do { unsigned _sp = 0; while (cond) { __builtin_amdgcn_s_sleep(1); \
    if ((++_sp & 255u) == 0u) { if (xb_ld(&(bar)[XB_TMO])) break; if (_sp > XB_SPIN_CAP) { atomicAdd(&(bar)[XB_TMO], 1u); break; } } } } while (0)

struct XcdBarrier {
    unsigned* bar; unsigned x;
    volatile LAS unsigned* st;
};

__device__ __forceinline__ XcdBarrier xcd_barrier_post(unsigned* bar, volatile LAS unsigned* st) {
    XcdBarrier b; b.bar = bar; b.x = xb_xcc_id(); b.st = st;
    if (threadIdx.x == 0) (void)xb_add(&bar[XB_XCNT(b.x)], 1u);
    return b;
}
__device__ __forceinline__ void xcd_barrier_complete(unsigned* bar, unsigned x, unsigned& nloc, unsigned& nx) {
    const unsigned G = gridDim.x * gridDim.y * gridDim.z;
    unsigned sum, cnt, mine, sp = 0u;
    for (;;) {
        sum = 0u; cnt = 0u; mine = 0u;
#pragma unroll
        for (unsigned j = 0; j < 16; ++j) { const unsigned c = xb_ld(&bar[XB_XCNT(j)]); sum += c; cnt += (c > 0u) ? 1u : 0u; mine = (j == x) ? c : mine; }
        if (sum == G) break;
        __builtin_amdgcn_s_sleep(1);
        if ((++sp & 255u) == 0u) { if (xb_ld(&bar[XB_TMO])) break; if (sp > XB_SPIN_CAP) { atomicAdd(&bar[XB_TMO], 1u); break; } }
    }
    nloc = mine > 0u ? mine : 1u; nx = cnt > 0u ? cnt : 1u;
}

__device__ __forceinline__ void xcd_barrier(const XcdBarrier& b) {
    asm volatile("s_waitcnt vmcnt(0)" ::: "memory");
    __syncthreads();
    if (threadIdx.x == 0) {
        unsigned* bar = b.bar;
        __builtin_amdgcn_s_waitcnt(0);
        unsigned nloc = b.st[0], nx = b.st[1];
        if (nloc == 0u) { xcd_barrier_complete(bar, b.x, nloc, nx); b.st[0] = nloc; b.st[1] = nx; }
        const unsigned old = xb_add(&bar[XB_XSUB(b.x)], 1u);
        const unsigned gen = old / nloc;
        if (old + 1u == (gen + 1u) * nloc) {
            __builtin_amdgcn_fence(__ATOMIC_RELEASE, "agent");
            asm volatile("s_waitcnt vmcnt(0)" ::: "memory");
            const unsigned og = xb_add(&bar[XB_TOP], 1u);
            const unsigned tg = og / nx;
            if (og + 1u == (tg + 1u) * nx) xb_add(&bar[XB_TOPGEN], 1u);
            else XB_SPIN(xb_ld(&bar[XB_TOPGEN]) == tg, bar);
            __builtin_amdgcn_fence(__ATOMIC_ACQUIRE, "agent");
            xb_add(&bar[XB_XGEN(b.x)], 1u);
            asm volatile("s_waitcnt vmcnt(0)" ::: "memory");
        } else {
            XB_SPIN(xb_ld(&bar[XB_XGEN(b.x)]) == gen, bar);
            __builtin_amdgcn_fence(__ATOMIC_ACQUIRE, "agent");
            asm volatile("s_waitcnt vmcnt(0)" ::: "memory");
        }
    }
    __syncthreads();
}
typedef unsigned u32x2v __attribute__((ext_vector_type(2)));
typedef float f32x2v __attribute__((ext_vector_type(2)));

constexpr int MP = 16384, MROWS = 16640, DMODEL = 1024, DFF = 2816, NBLK64 = MROWS / 64;
constexpr float RMS_EPS = 1e-6f;
constexpr size_t OFF_Y = 0, OFF_WKP = (size_t)MROWS * 1024, OFF_WVP = OFF_WKP + 65536, OFF_SRP = OFF_WVP + 65536, OFF_SIP = OFF_SRP + 8192,
    OFF_CMP = OFF_SIP + 8192, OFF_CFP = OFF_CMP + 8192, OFF_MKP = OFF_CFP + 45056, OFF_MVP = OFF_MKP + 2097152, OFF_WKS = OFF_MVP + 2097152,
    OFF_WVS = OFF_WKS + 32768, OFF_SRS = OFF_WVS + 32768, OFF_SIS = OFF_SRS + 16384, OFF_CMS = OFF_SIS + 16384, OFF_CFS = OFF_CMS + 16384;
constexpr size_t MiB = 1u << 20;
constexpr size_t WS_ROWSS = 0, WS_BAR = 512 * 1024, CTL_ZERO_BYTES = 1 * MiB;
constexpr size_t WS_ROPE = 1 * MiB, WS_SSM = 2 * MiB, WS_CKV = 3 * MiB, WS_SLOC = 4 * MiB, WS_MEMK = 8 * MiB, WS_MEMVT = 20 * MiB, WS_SIDE = 32 * MiB;
constexpr size_t SG_BYTES = (size_t)NBLK64 * 8 * DFF * 4, SV_BYTES = (size_t)NBLK64 * 4 * DFF * 4;
static_assert(WS_SIDE + SG_BYTES + SV_BYTES <= 66 * MiB, "side buffers");
constexpr size_t WS_WT = 66 * MiB, WS_XB = 128 * MiB, WS_TMP = 161 * MiB;
constexpr size_t WT_INEVEN = 0, WT_GLU = WT_INEVEN + 1280 * 1024, WT_OUTEVEN = WT_GLU + 512 * 512, WT_WQ = WT_OUTEVEN + 1024 * 1024, WT_WKV = WT_WQ + 2 * 1024 * 1024,
    WT_WO = WT_WKV + 2 * 2048 * 1024, WT_UP = WT_WO + 2 * 1024 * 1024, WT_DOWN = WT_UP + (size_t)2 * 5632 * 1024, WT_INODD = WT_DOWN + (size_t)2 * 2816 * 1024,
    WT_OUTODD = WT_INODD + 3072 * 1024, WT_END = WT_OUTODD + 1024 * 1024;
static_assert(WS_WT + WT_END * 2 <= WS_XB, "weights");
static_assert(WS_XB + (size_t)MROWS * 1024 * 2 <= WS_TMP, "xb");
constexpr size_t TMP_BYTES = (size_t)MROWS * DFF * 2;
constexpr size_t WS_PART = 251 * MiB, PART_ELEMS = (size_t)MROWS * 16;
static_assert(WS_PART + 2 * PART_ELEMS * 4 <= 256 * MiB, "part");
static_assert(WS_TMP + TMP_BYTES <= 256 * MiB, "ws");
constexpr size_t TMP_PROJ0 = 0, TMP_GBUF = (size_t)MROWS * 1280 * 2, TMP_YCAT = TMP_GBUF + (size_t)MROWS * 512 * 2, TMP_MEMB = TMP_YCAT;
static_assert(TMP_YCAT + (size_t)MROWS * 1024 * 2 <= TMP_BYTES, "tmp");
constexpr size_t TMP_QX = 0, TMP_OX = (size_t)MROWS * 1024 * 2, TMP_ACT = 0, TMP_GB = 0, TMP_ZC = (size_t)MROWS * 1024 * 2;
constexpr int LDS_BYTES = 147456, MISC_OFF = 147456 - 512;
constexpr int NPH = 22;

#define MFMA16(a, b, c) __builtin_amdgcn_mfma_f32_16x16x32_bf16(a, b, c, 0, 0, 0)
__device__ __forceinline__ float bflo(unsigned w) { return __uint_as_float(w << 16); }
__device__ __forceinline__ float bfhi(unsigned w) { return __uint_as_float(w & 0xffff0000u); }
__device__ __forceinline__ v4u pack8(f32x4 a, f32x4 b) { v4u w; w.x = pg8::cvt_pk_bf16(a[0], a[1]); w.y = pg8::cvt_pk_bf16(a[2], a[3]); w.z = pg8::cvt_pk_bf16(b[0], b[1]); w.w = pg8::cvt_pk_bf16(b[2], b[3]); return w; }
__device__ __forceinline__ float rstd_of(const float* part, int row) { const f32x4* p = (const f32x4*)(part + (size_t)row * 16); const f32x4 a = p[0] + p[1] + p[2] + p[3]; return rsqrtf(((a[0] + a[1]) + (a[2] + a[3])) * (1.0f / 1024.0f) + RMS_EPS); }
__device__ __forceinline__ float sigmoidf_(float x) { return 1.0f / (1.0f + __expf(-x)); }
__device__ __forceinline__ float dpp_ror1(float v) { return __builtin_bit_cast(float, __builtin_amdgcn_update_dpp(0, __builtin_bit_cast(int, v), 0x121, 0xf, 0xf, false)); }
__device__ __forceinline__ float dpp_ror2(float v) { return __builtin_bit_cast(float, __builtin_amdgcn_update_dpp(0, __builtin_bit_cast(int, v), 0x122, 0xf, 0xf, false)); }
__device__ __forceinline__ float wave_sum(float v) {
#pragma unroll
    for (int o = 1; o < 64; o <<= 1) v += __shfl_xor(v, o);
    return v;
}

typedef pg8::Unit Unit;
#define EPI_ARGS const f32x4 (&acc)[2][2][4][2], const Unit& u, int wr, int wc, int fr, int fq

struct EpiBf16 {
    static constexpr bool PERM = true, AFTER_DRAIN = false;
    bf16* O; int ldc; const float* rowss;
    __device__ __forceinline__ void operator()(EPI_ARGS) const {
        const int row0 = u.pm * 256 + wr * 64 + fr, col0 = u.pn * 256 + wc * 32 + 8 * fq;
#pragma unroll
        for (int ai = 0; ai < 2; ++ai)
#pragma unroll
            for (int m = 0; m < 4; ++m) { const int row = row0 + ai * 128 + m * 16; const float rs = rstd_of(rowss, row); bf16* rp = O + (size_t)row * ldc + col0;
#pragma unroll
                for (int bj = 0; bj < 2; ++bj) *(v4u*)(rp + bj * 128) = pack8(acc[ai][bj][m][0] * rs, acc[ai][bj][m][1] * rs); }
    }
};
struct EpiRes {
    static constexpr bool PERM = true, AFTER_DRAIN = false;
    const float* base_p; const float* base_s; bf16* xb; float* rowss_next; int f32base;
    __device__ __forceinline__ void operator()(EPI_ARGS) const {
        const float* base = u.pm < 64 ? base_p : base_s;
        const int row0 = u.pm * 256 + wr * 64 + fr, col0 = u.pn * 256 + wc * 32 + 8 * fq;
#pragma unroll
        for (int ai = 0; ai < 2; ++ai)
#pragma unroll
            for (int m = 0; m < 4; ++m) { const int row = row0 + ai * 128 + m * 16; const size_t off = (size_t)row * 1024 + col0; float ss = 0.f;
#pragma unroll
                for (int bj = 0; bj < 2; ++bj) { f32x4 b0, b1;
                    if (f32base) { b0 = *(const f32x4*)(base + off + bj * 128); b1 = *(const f32x4*)(base + off + bj * 128 + 4); }
                    else { const v4u w = *(const v4u*)(xb + off + bj * 128); b0 = (f32x4){bflo(w.x), bfhi(w.x), bflo(w.y), bfhi(w.y)}; b1 = (f32x4){bflo(w.z), bfhi(w.z), bflo(w.w), bfhi(w.w)}; }
                    const f32x4 v0 = acc[ai][bj][m][0] + b0, v1 = acc[ai][bj][m][1] + b1;
                    *(v4u*)(xb + off + bj * 128) = pack8(v0, v1);
                    ss += (v0[0] * v0[0] + v0[1] * v0[1]) + (v0[2] * v0[2] + v0[3] * v0[3]) + (v1[0] * v1[0] + v1[1] * v1[1]) + (v1[2] * v1[2] + v1[3] * v1[3]); }
                ss += __shfl_xor(ss, 16); ss += __shfl_xor(ss, 32);
                if (fq == 0) rowss_next[(size_t)row * 16 + u.pn * 4 + wc] = ss; }
    }
};
struct EpiGlu {
    static constexpr bool PERM = true, AFTER_DRAIN = false;
    const bf16* g; bf16* ycat;
    __device__ __forceinline__ void operator()(EPI_ARGS) const {
        const int row0 = u.pm * 256 + wr * 64 + fr, col0 = u.pn * 256 + wc * 32 + 8 * fq;
#pragma unroll
        for (int ai = 0; ai < 2; ++ai)
#pragma unroll
            for (int m = 0; m < 4; ++m) { const int row = row0 + ai * 128 + m * 16;
#pragma unroll
                for (int bj = 0; bj < 2; ++bj) { const int col = col0 + bj * 128; const v4u gw = *(const v4u*)(g + (size_t)row * 512 + col);
                    const f32x4 a0 = acc[ai][bj][m][0], a1 = acc[ai][bj][m][1]; f32x4 o0, o1;
                    o0[0] = bflo(gw.x) * sigmoidf_(a0[0]); o0[1] = bfhi(gw.x) * sigmoidf_(a0[1]); o0[2] = bflo(gw.y) * sigmoidf_(a0[2]); o0[3] = bfhi(gw.y) * sigmoidf_(a0[3]);
                    o1[0] = bflo(gw.z) * sigmoidf_(a1[0]); o1[1] = bfhi(gw.z) * sigmoidf_(a1[1]); o1[2] = bflo(gw.w) * sigmoidf_(a1[2]); o1[3] = bfhi(gw.w) * sigmoidf_(a1[3]);
                    *(v4u*)(ycat + (size_t)row * 1024 + col) = pack8(o0, o1); } }
    }
};
struct EpiKV {
    static constexpr bool PERM = true, AFTER_DRAIN = false;
    float* out; bf16* memk;
    __device__ __forceinline__ void operator()(EPI_ARGS) const {
        const int row0 = u.pm * 256 + wr * 64 + fr, col0 = u.pn * 256 + wc * 32 + 8 * fq;
#pragma unroll
        for (int ai = 0; ai < 2; ++ai)
#pragma unroll
            for (int m = 0; m < 4; ++m) { const int row = row0 + ai * 128 + m * 16;
#pragma unroll
                for (int bj = 0; bj < 2; ++bj) { const int c = col0 + bj * 128, l = c >> 11, e = c & 2047, isv = e >> 10, dc = e & 1023;
                    float* op = out + (isv ? OFF_MVP : OFF_MKP) + (size_t)l * 1048576 + (size_t)row * 1024 + dc;
                    *(f32x4*)op = acc[ai][bj][m][0]; *(f32x4*)(op + 4) = acc[ai][bj][m][1];
                    if (!isv) *(v4u*)(memk + (size_t)l * 12 * 262144 + (size_t)row * 1024 + dc) = pack8(acc[ai][bj][m][0], acc[ai][bj][m][1]); } }
    }
};
struct EpiIn0 {
    static constexpr bool PERM = true, AFTER_DRAIN = false;
    bf16* proj; const float* rowss; const float* ropec; const float* ropes; float* out;
    __device__ __forceinline__ void operator()(EPI_ARGS) const {
        const int pn = u.pn;
#pragma unroll
        for (int ai = 0; ai < 2; ++ai)
#pragma unroll
            for (int m = 0; m < 4; ++m) { const int row = u.pm * 256 + ai * 128 + wr * 64 + m * 16 + fr; const float rs = rstd_of(rowss, row);
                const int pos = row < MP ? (row & 4095) : 2048 + (row & 31);
                bf16* rp = proj + (size_t)row * 1280;
                float* wk = nullptr; float* wv = nullptr;
                if (pn == 4) { if (row >= MP) { wk = out + OFF_WKS + (size_t)(row - MP) * 128; wv = out + OFF_WVS + (size_t)(row - MP) * 128; }
                               else if ((row & 4095) >= 3968) { const size_t o = (size_t)((row >> 12) * 128 + (row & 4095) - 3968) * 128; wk = out + OFF_WKP + o; wv = out + OFF_WVP + o; } }
#pragma unroll
                for (int bj = 0; bj < 2; ++bj) { const f32x4 v0 = acc[ai][bj][m][0] * rs, v1 = acc[ai][bj][m][1] * rs;
                    const bool rope = (pn == 2 || pn == 3 || (pn == 4 && bj == 0));
                    if (!rope) { const int col = pn * 256 + bj * 128 + wc * 32 + 8 * fq; *(v4u*)(rp + col) = pack8(v0, v1);
                        if (pn == 4 && wv) { *(f32x4*)(wv + wc * 32 + 8 * fq) = v0; *(f32x4*)(wv + wc * 32 + 8 * fq + 4) = v1; } }
                    else { const int gbase = pn * 256 + bj * 128 + (wc >> 1) * 64, d1 = 16 * (wc & 1) + 4 * fq;
                        const f32x4 c4 = *(const f32x4*)(ropec + pos * 32 + d1), s4 = *(const f32x4*)(ropes + pos * 32 + d1);
                        f32x4 o1 = v0 * c4 - v1 * s4, o2 = v1 * c4 + v0 * s4;
                        if (pn != 4) { o1 = o1 * 0.125f; o2 = o2 * 0.125f; }
                        u32x2v w1, w2; w1.x = pg8::cvt_pk_bf16(o1[0], o1[1]); w1.y = pg8::cvt_pk_bf16(o1[2], o1[3]); w2.x = pg8::cvt_pk_bf16(o2[0], o2[1]); w2.y = pg8::cvt_pk_bf16(o2[2], o2[3]);
                        *(u32x2v*)(rp + gbase + d1) = w1; *(u32x2v*)(rp + gbase + d1 + 32) = w2;
                        if (pn == 4 && wk) { const int cc = (wc >> 1) * 64 + d1; *(f32x4*)(wk + cc) = o1; *(f32x4*)(wk + cc + 32) = o2; } } } }
    }
};
struct EpiFfnUp {
    static constexpr bool PERM = true, AFTER_DRAIN = false;
    bf16* act; const float* rowss; const float* cw; float* SG; float* SV;
    __device__ __forceinline__ void operator()(EPI_ARGS) const {
        const int c0 = u.pn * 128 + wc * 32 + 8 * fq; const bool sample = u.pm == 64;
        const f32x4 w0a = *(const f32x4*)(cw + c0), w0b = *(const f32x4*)(cw + c0 + 4), w1a = *(const f32x4*)(cw + DFF + c0), w1b = *(const f32x4*)(cw + DFF + c0 + 4),
                    w2a = *(const f32x4*)(cw + 2 * DFF + c0), w2b = *(const f32x4*)(cw + 2 * DFF + c0 + 4);
#pragma unroll
        for (int ai = 0; ai < 2; ++ai) { f32x4 gp0 = {0.f, 0.f, 0.f, 0.f}, gp1 = {0.f, 0.f, 0.f, 0.f}; const int blk = u.pm * 4 + ai * 2 + wr;
#pragma unroll
            for (int m = 0; m < 4; ++m) { const int row = u.pm * 256 + ai * 128 + wr * 64 + m * 16 + fr; const float rs = rstd_of(rowss, row);
                const f32x4 g0 = acc[ai][0][m][0] * rs, g1 = acc[ai][0][m][1] * rs, v0 = acc[ai][1][m][0] * rs, v1 = acc[ai][1][m][1] * rs;
                f32x4 a0, a1;
#pragma unroll
                for (int j = 0; j < 4; ++j) {
                    const float r1pa = dpp_ror1(gp0[j]), r1ca = dpp_ror1(g0[j]), r2pa = dpp_ror2(gp0[j]), r2ca = dpp_ror2(g0[j]);
                    const float r1pb = dpp_ror1(gp1[j]), r1cb = dpp_ror1(g1[j]), r2pb = dpp_ror2(gp1[j]), r2cb = dpp_ror2(g1[j]);
                    const float p1a = fr == 0 ? r1pa : r1ca, p2a = fr < 2 ? r2pa : r2ca;
                    const float p1b = fr == 0 ? r1pb : r1cb, p2b = fr < 2 ? r2pb : r2cb;
                    const float ca = w0a[j] * p2a + w1a[j] * p1a + w2a[j] * g0[j], cb = w0b[j] * p2b + w1b[j] * p1b + w2b[j] * g1[j];
                    a0[j] = ca * sigmoidf_(ca) * v0[j]; a1[j] = cb * sigmoidf_(cb) * v1[j]; }
                const bool valid = (m > 0 || fr >= 2) && !(sample && m == 2 && fr < 2);
                if (valid) *(v4u*)(act + (size_t)row * DFF + c0) = pack8(a0, a1);
                if ((m & 1) == 0 && fr < 2) { float* sg = SG + (size_t)(blk * 8 + 2 * m + fr) * DFF + c0; *(f32x4*)sg = g0; *(f32x4*)(sg + 4) = g1;
                                              float* sv = SV + (size_t)(blk * 4 + m + fr) * DFF + c0; *(f32x4*)sv = v0; *(f32x4*)(sv + 4) = v1; }
                if ((m & 1) == 1 && fr >= 14) { float* sg = SG + (size_t)(blk * 8 + 2 * m + fr - 14) * DFF + c0; *(f32x4*)sg = g0; *(f32x4*)(sg + 4) = g1; }
                gp0 = g0; gp1 = g1; } }
    }
};
struct EpiInOdd {
    static constexpr bool PERM = true, AFTER_DRAIN = false;
    bf16* gb; bf16* zc; const float* rowss; const float* cw; float* SG;
    __device__ __forceinline__ void operator()(EPI_ARGS) const {
        if (u.pn < 4) {
            const int row0 = u.pm * 256 + wr * 64 + fr, col0 = u.pn * 256 + wc * 32 + 8 * fq;
#pragma unroll
            for (int ai = 0; ai < 2; ++ai)
#pragma unroll
                for (int m = 0; m < 4; ++m) { const int row = row0 + ai * 128 + m * 16; const float rs = rstd_of(rowss, row); bf16* rp = gb + (size_t)row * 1024 + col0;
#pragma unroll
                    for (int bj = 0; bj < 2; ++bj) *(v4u*)(rp + bj * 128) = pack8(acc[ai][bj][m][0] * rs, acc[ai][bj][m][1] * rs); }
            return;
        }
        const int c0 = (u.pn - 4) * 128 + wc * 32 + 8 * fq; const bool sample = u.pm == 64;
        const f32x4 w0a = *(const f32x4*)(cw + c0), w0b = *(const f32x4*)(cw + c0 + 4), w1a = *(const f32x4*)(cw + 1024 + c0), w1b = *(const f32x4*)(cw + 1024 + c0 + 4),
                    w2a = *(const f32x4*)(cw + 2048 + c0), w2b = *(const f32x4*)(cw + 2048 + c0 + 4);
#pragma unroll
        for (int ai = 0; ai < 2; ++ai) { f32x4 gp0 = {0.f, 0.f, 0.f, 0.f}, gp1 = {0.f, 0.f, 0.f, 0.f}; const int blk = u.pm * 4 + ai * 2 + wr;
#pragma unroll
            for (int m = 0; m < 4; ++m) { const int row = u.pm * 256 + ai * 128 + wr * 64 + m * 16 + fr; const float rs = rstd_of(rowss, row); const float rs2 = rs * rs;
                const f32x4 g0 = acc[ai][0][m][0] * acc[ai][1][m][0] * rs2, g1 = acc[ai][0][m][1] * acc[ai][1][m][1] * rs2;
                f32x4 a0, a1;
#pragma unroll
                for (int j = 0; j < 4; ++j) {
                    const float r1pa = dpp_ror1(gp0[j]), r1ca = dpp_ror1(g0[j]), r2pa = dpp_ror2(gp0[j]), r2ca = dpp_ror2(g0[j]);
                    const float r1pb = dpp_ror1(gp1[j]), r1cb = dpp_ror1(g1[j]), r2pb = dpp_ror2(gp1[j]), r2cb = dpp_ror2(g1[j]);
                    const float p1a = fr == 0 ? r1pa : r1ca, p2a = fr < 2 ? r2pa : r2ca;
                    const float p1b = fr == 0 ? r1pb : r1cb, p2b = fr < 2 ? r2pb : r2cb;
                    a0[j] = w0a[j] * p2a + w1a[j] * p1a + w2a[j] * g0[j]; a1[j] = w0b[j] * p2b + w1b[j] * p1b + w2b[j] * g1[j]; }
                const bool valid = (m > 0 || fr >= 2) && !(sample && m == 2 && fr < 2);
                if (valid) *(v4u*)(zc + (size_t)row * 1024 + c0) = pack8(a0, a1);
                if ((m & 1) == 0 && fr < 2) { float* sg = SG + (size_t)(blk * 8 + 2 * m + fr) * 1024 + c0; *(f32x4*)sg = g0; *(f32x4*)(sg + 4) = g1; }
                if ((m & 1) == 1 && fr >= 14) { float* sg = SG + (size_t)(blk * 8 + 2 * m + fr - 14) * 1024 + c0; *(f32x4*)sg = g0; *(f32x4*)(sg + 4) = g1; }
                gp0 = g0; gp1 = g1; } }
    }
};

__device__ __forceinline__ int rowmap(int mode, int n) {
    if (mode == 1) { if (n >= 512 && n < 1152) { const int d = n & 63; return (n & ~63) | (32 * ((d >> 4) & 1) + 8 * ((d >> 2) & 3) + 4 * (d >> 5) + (d & 3)); } return n; }
    if (mode == 2) { return n < DFF ? ((n >> 7) * 256 + (n & 127)) : (((n - DFF) >> 7) * 256 + 128 + ((n - DFF) & 127)); }
    if (mode == 3) { if (n < 1024) return n; const int c = (n - 1024) & 1023, z = n >= 2048 ? 1 : 0; return 1024 + (c >> 7) * 256 + z * 128 + (c & 127); }
    return n;
}
__device__ __forceinline__ void tr_item(const float* W, int K, int N, bf16* WT, const float* gain, float scale, int mode, LAS float* scr, int item, int lane) {
    const int nblk = N / 32, kb = item / nblk, nb = item % nblk, k0 = 64 * kb, n0 = 32 * nb;
#pragma unroll
    for (int i = 0; i < 8; ++i) { const int idx = lane + 64 * i, kk = idx >> 3, n4 = (idx & 7) * 4; const float gs = gain ? gain[k0 + kk] * scale : scale;
        const f32x4 w = *(const f32x4*)(W + (size_t)(k0 + kk) * N + n0 + n4); LAS float* d = scr + kk * 33 + n4; d[0] = w[0] * gs; d[1] = w[1] * gs; d[2] = w[2] * gs; d[3] = w[3] * gs; }
    LDS_WAIT(); asm volatile("" ::: "memory");
    const int c = lane & 7;
#pragma unroll
    for (int j = 0; j < 4; ++j) { const int n = (lane >> 3) + 8 * j; const LAS float* s = scr + (8 * c) * 33 + n;
        v4u o; o.x = pg8::cvt_pk_bf16(s[0 * 33], s[1 * 33]); o.y = pg8::cvt_pk_bf16(s[2 * 33], s[3 * 33]); o.z = pg8::cvt_pk_bf16(s[4 * 33], s[5 * 33]); o.w = pg8::cvt_pk_bf16(s[6 * 33], s[7 * 33]);
        *(v4u*)(WT + (size_t)rowmap(mode, n0 + n) * K + k0 + 8 * c) = o; }
    LDS_WAIT(); asm volatile("" ::: "memory");
}
__device__ __forceinline__ double dexp_(double y) {
    const double k = rint(y * 1.4426950408889634); const double r = (y - k * 0.6931471803691238) - k * 1.9082149292705877e-10;
    double p = 1.0 / 6227020800.0;
    p = p * r + 1.0 / 479001600.0; p = p * r + 1.0 / 39916800.0; p = p * r + 1.0 / 3628800.0; p = p * r + 1.0 / 362880.0; p = p * r + 1.0 / 40320.0; p = p * r + 1.0 / 5040.0;
    p = p * r + 1.0 / 720.0; p = p * r + 1.0 / 120.0; p = p * r + 1.0 / 24.0; p = p * r + 1.0 / 6.0; p = p * r + 0.5; p = p * r + 1.0; p = p * r + 1.0;
    const long long bits = (long long)(1023 + (int)k) << 52; return p * __builtin_bit_cast(double, bits);
}
__device__ __forceinline__ void dsincos_(double x, double& s, double& c) {
    const double k = rint(x * 0.6366197723675814); const double r = (x - k * 1.5707963267948966) - k * 6.123233995736766e-17; const double r2 = r * r;
    const double sp = r * (1.0 + r2 * (-1.0 / 6.0 + r2 * (1.0 / 120.0 + r2 * (-1.0 / 5040.0 + r2 * (1.0 / 362880.0 + r2 * (-1.0 / 39916800.0 + r2 * (1.0 / 6227020800.0)))))));
    const double cp = 1.0 + r2 * (-0.5 + r2 * (1.0 / 24.0 + r2 * (-1.0 / 720.0 + r2 * (1.0 / 40320.0 + r2 * (-1.0 / 3628800.0 + r2 * (1.0 / 479001600.0 + r2 * (-1.0 / 87178291200.0)))))));
    const int q = ((int)k) & 3;
    s = q == 0 ? sp : q == 1 ? cp : q == 2 ? -sp : -cp; c = q == 0 ? cp : q == 1 ? -sp : q == 2 ? -cp : sp;
}

__device__ __forceinline__ const bf16* kvptr(const bf16* proj, const bf16* cb, int sample, int b, int c, int kvh, int kk, int isv) {
    if (!sample) { int pos = (c - 2) * 64 + kk; pos = pos < 0 ? 0 : pos; return proj + (size_t)(b * 4096 + pos) * 1280 + 1024 + isv * 128 + kvh * 64; }
    if (kk < 128) return cb + (size_t)(b * 128 + kk) * 128 + kvh * 64;
    int t = kk - 128; t = t > 31 ? 31 : t; return proj + (size_t)(MP + b * 32 + t) * 1280 + 1024 + isv * 128 + kvh * 64;
}
__device__ __forceinline__ void swa_phase(const bf16* proj, const bf16* ckb, const bf16* cvb, const float* sinks, bf16* ycat, LAS unsigned char* lds, int tid, int wave, int lane, int G) {
    LAS bf16* VT = (LAS bf16*)lds;
    const int fr = lane & 15, quad = lane >> 4;
    for (int it = blockIdx.x; it < 528; it += G) {
        int b, c, kvh, sample;
        if (it < 512) { sample = 0; b = it >> 7; c = (it >> 1) & 63; kvh = it & 1; } else { sample = 1; b = (it - 512) >> 1; c = 0; kvh = it & 1; }
        __syncthreads();
#pragma unroll
        for (int i = 0; i < 3; ++i) { const int idx = tid + 512 * i, kk = idx % 192, dg = idx / 192; const v4u w = *(const v4u*)(kvptr(proj, cvb, sample, b, c, kvh, kk, 1) + dg * 8);
            LAS bf16* vp = VT + (dg * 8) * 200 + kk;
            vp[0] = (bf16)(w.x & 0xffffu); vp[200] = (bf16)(w.x >> 16); vp[400] = (bf16)(w.y & 0xffffu); vp[600] = (bf16)(w.y >> 16);
            vp[800] = (bf16)(w.z & 0xffffu); vp[1000] = (bf16)(w.z >> 16); vp[1200] = (bf16)(w.w & 0xffffu); vp[1400] = (bf16)(w.w >> 16); }
        __syncthreads();
        const int gq = wave >> 1, qhalf = wave & 1, head = kvh * 4 + gq;
        if (!(sample && qhalf)) {
            const int plo = sample ? 0 : (c >= 2 ? 0 : (2 - c) * 2), phi = sample ? 5 : 6;
            bf16x8 qf[2][2];
#pragma unroll
            for (int qb = 0; qb < 2; ++qb) { const int q = qhalf * 32 + qb * 16 + fr; const int row = sample ? MP + b * 32 + (q & 31) : b * 4096 + c * 64 + q;
                const bf16* qp = proj + (size_t)row * 1280 + 512 + head * 64 + quad * 8; qf[qb][0] = *(const bf16x8*)qp; qf[qb][1] = *(const bf16x8*)(qp + 32); }
            f32x4 s[12][2];
#pragma unroll
            for (int kb = 0; kb < 12; ++kb) { const int key = 32 * (kb >> 1) + (fr >> 2) * 8 + 4 * (kb & 1) + (fr & 3); const bf16* kp = kvptr(proj, ckb, sample, b, c, kvh, key, 0) + quad * 8;
                const bf16x8 k0 = *(const bf16x8*)kp, k1 = *(const bf16x8*)(kp + 32);
#pragma unroll
                for (int qb = 0; qb < 2; ++qb) { f32x4 a = {0.f, 0.f, 0.f, 0.f}; a = MFMA16(k0, qf[qb][0], a); a = MFMA16(k1, qf[qb][1], a); s[kb][qb] = a; } }
            const float sink = sinks[head];
            bf16x8 pf[6][2];
#pragma unroll
            for (int qb = 0; qb < 2; ++qb) { float mx = sink;
#pragma unroll
                for (int kb = 0; kb < 12; ++kb) { const bool pv = (kb >> 1) >= plo && (kb >> 1) < phi;
#pragma unroll
                    for (int j = 0; j < 4; ++j) { const float v = pv ? s[kb][qb][j] : -1e30f; s[kb][qb][j] = v; mx = fmaxf(mx, v); } }
                mx = fmaxf(mx, __shfl_xor(mx, 16)); mx = fmaxf(mx, __shfl_xor(mx, 32));
                float sum = 0.f;
#pragma unroll
                for (int kb = 0; kb < 12; ++kb)
#pragma unroll
                    for (int j = 0; j < 4; ++j) { const float e = __expf(s[kb][qb][j] - mx); s[kb][qb][j] = e; sum += e; }
                sum += __shfl_xor(sum, 16); sum += __shfl_xor(sum, 32); sum += __expf(sink - mx);
                const float inv = 1.0f / sum;
#pragma unroll
                for (int pr = 0; pr < 6; ++pr) pf[pr][qb] = __builtin_bit_cast(bf16x8, pack8(s[2 * pr][qb] * inv, s[2 * pr + 1][qb] * inv)); }
#pragma unroll
            for (int db = 0; db < 4; ++db) { bf16x8 vf[6];
#pragma unroll
                for (int pr = 0; pr < 6; ++pr) vf[pr] = *(const LAS bf16x8*)(VT + (db * 16 + fr) * 200 + 32 * pr + quad * 8);
#pragma unroll
                for (int qb = 0; qb < 2; ++qb) { f32x4 o = {0.f, 0.f, 0.f, 0.f};
#pragma unroll
                    for (int pr = 0; pr < 6; ++pr) o = MFMA16(pf[pr][qb], vf[pr], o);
#pragma unroll
                    for (int j = 0; j < 4; ++j) { const int q = qhalf * 32 + qb * 16 + quad * 4 + j;
                        if (!sample || q < 32) { const int row = sample ? MP + b * 32 + q : b * 4096 + c * 64 + q; ycat[(size_t)row * 1024 + 512 + head * 64 + db * 16 + fr] = (bf16)f2bf(o[j]); } } } }
        }
    }
    __syncthreads();
}

__device__ __forceinline__ void xattn_phase(const bf16* qx, const bf16* memk_l, const bf16* memvT_l, bf16* ox, int wave, int lane, int G) {
    const int fr = lane & 15, quad = lane >> 4;
    for (int t = wave * G + (int)blockIdx.x; t < 4160; t += 8 * G) {
        int bb, h, row0;
        if (t < 4096) { const int pair = t >> 8; bb = pair >> 2; h = pair & 3; row0 = bb * 4096 + (t & 255) * 16; }
        else { const int s = t - 4096, b = s >> 3; h = (s >> 1) & 3; bb = 4 + b; row0 = MP + b * 32 + (s & 1) * 16; }
        bf16x8 qf[8];
#pragma unroll
        for (int ks = 0; ks < 8; ++ks) qf[ks] = *(const bf16x8*)(qx + (size_t)(row0 + fr) * 1024 + h * 256 + ks * 32 + quad * 8);
        const bf16* kbase = memk_l + (size_t)bb * 262144 + h * 256 + quad * 8;
        f32x4 s[16];
#pragma unroll
        for (int kb = 0; kb < 16; ++kb) { const int key = 32 * (kb >> 1) + (fr >> 2) * 8 + 4 * (kb & 1) + (fr & 3); const bf16* kp = kbase + (size_t)key * 1024; f32x4 a = {0.f, 0.f, 0.f, 0.f};
#pragma unroll
            for (int ks = 0; ks < 8; ++ks) a = MFMA16(*(const bf16x8*)(kp + ks * 32), qf[ks], a);
            s[kb] = a; }
        float mx = -1e30f;
#pragma unroll
        for (int kb = 0; kb < 16; ++kb)
#pragma unroll
            for (int j = 0; j < 4; ++j) mx = fmaxf(mx, s[kb][j]);
        mx = fmaxf(mx, __shfl_xor(mx, 16)); mx = fmaxf(mx, __shfl_xor(mx, 32));
        float sum = 0.f;
#pragma unroll
        for (int kb = 0; kb < 16; ++kb)
#pragma unroll
            for (int j = 0; j < 4; ++j) { const float e = __expf(s[kb][j] - mx); s[kb][j] = e; sum += e; }
        sum += __shfl_xor(sum, 16); sum += __shfl_xor(sum, 32);
        const float inv = 1.0f / sum;
        bf16x8 pf[8];
#pragma unroll
        for (int pr = 0; pr < 8; ++pr) pf[pr] = __builtin_bit_cast(bf16x8, pack8(s[2 * pr] * inv, s[2 * pr + 1] * inv));
        const bf16* vbase = memvT_l + (size_t)bb * 262144 + (size_t)(h * 256 + fr) * 256 + quad * 8;
#pragma unroll 4
        for (int db = 0; db < 16; ++db) { f32x4 o = {0.f, 0.f, 0.f, 0.f};
#pragma unroll
            for (int pr = 0; pr < 8; ++pr) o = MFMA16(pf[pr], *(const bf16x8*)(vbase + (size_t)db * 4096 + pr * 32), o);
#pragma unroll
            for (int j = 0; j < 4; ++j) ox[(size_t)(row0 + quad * 4 + j) * 1024 + h * 256 + db * 16 + fr] = (bf16)f2bf(o[j]); }
    }
}


__device__ __forceinline__ void xstage(const bf16* src, size_t rowstride, LAS unsigned char* lds, int tid) {
    v4u t[16];
#pragma unroll
    for (int i = 0; i < 16; ++i) { const int row = (tid >> 5) + 16 * i, ch = tid & 31; t[i] = *(const GAS v4u*)((const GAS bf16*)src + (size_t)row * rowstride + ch * 8); }
#pragma unroll
    for (int i = 0; i < 16; ++i) { const int row = (tid >> 5) + 16 * i, ch = tid & 31; *(LAS v4u*)(lds + row * 528 + ch * 16) = t[i]; }
}
__device__ __forceinline__ void xattn_phase2(const bf16* qx, const bf16* memk_l, const bf16* memvT_l, bf16* ox, LAS unsigned char* lds, int tid, int wave, int lane, int G) {
    const int fr = lane & 15, quad = lane >> 4;
    for (int it = blockIdx.x; it < 256 + 32; it += G) {
        int bb, h, rowbase, nqb; bool active;
        if (it < 256) { bb = it >> 6; h = (it >> 4) & 3; rowbase = bb * 4096 + (it & 15) * 256; nqb = 2; active = true; }
        else { const int s = it - 256, b = s >> 2; h = s & 3; bb = 4 + b; rowbase = MP + b * 32; nqb = 1; active = wave < 2; }
        __syncthreads();
        xstage(memk_l + (size_t)bb * 262144 + h * 256, 1024, lds, tid);
        __syncthreads();
        bf16x8 pf[2][8];
#pragma unroll
        for (int qi = 0; qi < 2; ++qi) {
            if (qi < nqb && active) {
                const int row0 = rowbase + qi * 128 + wave * 16;
                bf16x8 qf[8];
#pragma unroll
                for (int ks = 0; ks < 8; ++ks) qf[ks] = *(const GAS bf16x8*)((const GAS bf16*)qx + (size_t)(row0 + fr) * 1024 + h * 256 + ks * 32 + quad * 8);
                f32x4 s[16];
#pragma unroll
                for (int kb = 0; kb < 16; ++kb) { const int key = 32 * (kb >> 1) + (fr >> 2) * 8 + 4 * (kb & 1) + (fr & 3); const LAS unsigned char* kp = lds + key * 528 + quad * 16; f32x4 a = {0.f, 0.f, 0.f, 0.f};
#pragma unroll
                    for (int ks = 0; ks < 8; ++ks) a = MFMA16(*(const LAS bf16x8*)(kp + ks * 64), qf[ks], a);
                    s[kb] = a; }
                float mx = -1e30f;
#pragma unroll
                for (int kb = 0; kb < 16; ++kb)
#pragma unroll
                    for (int j = 0; j < 4; ++j) mx = fmaxf(mx, s[kb][j]);
                mx = fmaxf(mx, __shfl_xor(mx, 16)); mx = fmaxf(mx, __shfl_xor(mx, 32));
                float sum = 0.f;
#pragma unroll
                for (int kb = 0; kb < 16; ++kb)
#pragma unroll
                    for (int j = 0; j < 4; ++j) { const float e = __expf(s[kb][j] - mx); s[kb][j] = e; sum += e; }
                sum += __shfl_xor(sum, 16); sum += __shfl_xor(sum, 32);
                const float inv = 1.0f / sum;
#pragma unroll
                for (int pr = 0; pr < 8; ++pr) pf[qi][pr] = __builtin_bit_cast(bf16x8, pack8(s[2 * pr] * inv, s[2 * pr + 1] * inv));
            }
        }
        __syncthreads();
        xstage(memvT_l + (size_t)bb * 262144 + (size_t)h * 65536, 256, lds, tid);
        __syncthreads();
#pragma unroll
        for (int qi = 0; qi < 2; ++qi) {
            if (qi < nqb && active) {
                const int row0 = rowbase + qi * 128 + wave * 16;
#pragma unroll 4
                for (int db = 0; db < 16; ++db) { f32x4 o = {0.f, 0.f, 0.f, 0.f}; const LAS unsigned char* vp = lds + (db * 16 + fr) * 528 + quad * 16;
#pragma unroll
                    for (int pr = 0; pr < 8; ++pr) o = MFMA16(*(const LAS bf16x8*)(vp + pr * 64), pf[qi][pr], o);
                    u32x2v w; w.x = pk2(o[0], o[1]); w.y = pk2(o[2], o[3]);
                    *(GAS u32x2v*)((GAS bf16*)ox + (size_t)(row0 + fr) * 1024 + h * 256 + db * 16 + quad * 4) = w; }
            }
        }
    }
    __syncthreads();
}

__device__ __forceinline__ void s5_stage_u(const bf16* up, LAS float* ubuf, int lane) {
    const v4u w0 = *(const v4u*)up, w1 = *(const v4u*)(up + 8);
    LAS f32x4* d = (LAS f32x4*)(ubuf + lane * 16);
    d[0] = (f32x4){bflo(w0.x), bfhi(w0.x), bflo(w0.y), bfhi(w0.y)}; d[1] = (f32x4){bflo(w0.z), bfhi(w0.z), bflo(w0.w), bfhi(w0.w)};
    d[2] = (f32x4){bflo(w1.x), bfhi(w1.x), bflo(w1.y), bfhi(w1.y)}; d[3] = (f32x4){bflo(w1.z), bfhi(w1.z), bflo(w1.w), bfhi(w1.w)};
}
#define S5_STEP(sidx) do { const LAS f32x4* up_ = (const LAS f32x4*)(ubuf + (sidx) * 16); const f32x4 u0 = up_[0], u1 = up_[1], u2 = up_[2], u3 = up_[3]; \
    float br = 0.f, bi = 0.f; \
    br += bb[0][0] * u0[0] + bb[0][2] * u0[1]; bi += bb[0][1] * u0[0] + bb[0][3] * u0[1]; br += bb[1][0] * u0[2] + bb[1][2] * u0[3]; bi += bb[1][1] * u0[2] + bb[1][3] * u0[3]; \
    br += bb[2][0] * u1[0] + bb[2][2] * u1[1]; bi += bb[2][1] * u1[0] + bb[2][3] * u1[1]; br += bb[3][0] * u1[2] + bb[3][2] * u1[3]; bi += bb[3][1] * u1[2] + bb[3][3] * u1[3]; \
    br += bb[4][0] * u2[0] + bb[4][2] * u2[1]; bi += bb[4][1] * u2[0] + bb[4][3] * u2[1]; br += bb[5][0] * u2[2] + bb[5][2] * u2[3]; bi += bb[5][1] * u2[2] + bb[5][3] * u2[3]; \
    br += bb[6][0] * u3[0] + bb[6][2] * u3[1]; bi += bb[6][1] * u3[0] + bb[6][3] * u3[1]; br += bb[7][0] * u3[2] + bb[7][2] * u3[3]; bi += bb[7][1] * u3[2] + bb[7][3] * u3[3]; \
    const float nr_ = ar * hr - ai * hi + br, ni_ = ar * hi + ai * hr + bi; hr = nr_; hi = ni_; } while (0)

__device__ __forceinline__ void s5_local(const bf16* proj, const float* abar, const float* bbar, float* sloc, LAS float* ubuf, int slot, int nslots, int lane) {
    for (int t = slot; t < 8192; t += nslots) {
        const int chunk = t & 63, g = (t >> 6) & 31, b = t >> 11;
        s5_stage_u(proj + (size_t)(b * 4096 + chunk * 64 + lane) * 1280 + g * 16, ubuf, lane);
        const float ar = abar[(g * 64 + lane) * 2], ai = abar[(g * 64 + lane) * 2 + 1];
        f32x4 bb[8];
#pragma unroll
        for (int i = 0; i < 8; ++i) bb[i] = *(const f32x4*)(bbar + (size_t)(g * 64 + lane) * 32 + i * 4);
        float hr = 0.f, hi = 0.f;
#pragma unroll 4
        for (int s = 0; s < 64; ++s) S5_STEP(s);
        *(f32x2v*)(sloc + (size_t)t * 128 + lane * 2) = (f32x2v){hr, hi};
    }
}
__device__ __forceinline__ void s5_out(const bf16* proj, const float* abar, const float* bbar, const float* sloc, const float* st_re, const float* st_im, const float* c_re, const float* c_im,
                                       const float* dcoef, bf16* gbuf, float* out, LAS float* ubuf, LAS unsigned* hbuf, int slot, int nslots, int lane) {
    const int fr = lane & 15, quad = lane >> 4;
    for (int t = slot; t < 8192 + 256; t += nslots) {
        const int sample = t >= 8192; int b, g, chunk, nblk, rowbase;
        if (!sample) { chunk = t & 63; g = (t >> 6) & 31; b = t >> 11; nblk = 4; rowbase = b * 4096 + chunk * 64; } else { const int s = t - 8192; g = s & 31; b = s >> 5; chunk = 0; nblk = 2; rowbase = MP + b * 32; }
        if (lane < nblk * 16) s5_stage_u(proj + (size_t)(rowbase + lane) * 1280 + g * 16, ubuf, lane);
        const float ar = abar[(g * 64 + lane) * 2], ai = abar[(g * 64 + lane) * 2 + 1];
        f32x4 bb[8];
#pragma unroll
        for (int i = 0; i < 8; ++i) bb[i] = *(const f32x4*)(bbar + (size_t)(g * 64 + lane) * 32 + i * 4);
        float hr, hi;
        if (!sample) { float pr = ar, pi = ai;
#pragma unroll
            for (int i = 0; i < 6; ++i) { const float t1 = pr * pr - pi * pi; pi = 2.f * pr * pi; pr = t1; }
            hr = 0.f; hi = 0.f; const float* sp = sloc + (size_t)(t - chunk) * 128 + lane * 2;
#pragma unroll 16
            for (int cc = 0; cc < chunk; ++cc) { const f32x2v sv = *(const f32x2v*)(sp + (size_t)cc * 128); const float nr = pr * hr - pi * hi + sv.x, ni = pr * hi + pi * hr + sv.y; hr = nr; hi = ni; } }
        else { hr = st_re[(b * 32 + g) * 64 + lane]; hi = st_im[(b * 32 + g) * 64 + lane]; }
        bf16x8 cf[4];
#pragma unroll
        for (int ks = 0; ks < 4; ++ks) { const f32x4 cr = *(const f32x4*)(c_re + (size_t)(g * 16 + fr) * 64 + ks * 16 + quad * 4), ci = *(const f32x4*)(c_im + (size_t)(g * 16 + fr) * 64 + ks * 16 + quad * 4);
            v4u w; w.x = pg8::cvt_pk_bf16(cr[0], -ci[0]); w.y = pg8::cvt_pk_bf16(cr[1], -ci[1]); w.z = pg8::cvt_pk_bf16(cr[2], -ci[2]); w.w = pg8::cvt_pk_bf16(cr[3], -ci[3]); cf[ks] = __builtin_bit_cast(bf16x8, w); }
        const float dco = dcoef[g * 16 + fr];
        for (int blk = 0; blk < nblk; ++blk) {
#pragma unroll 4
            for (int s = 0; s < 16; ++s) { S5_STEP(blk * 16 + s); hbuf[s * 68 + lane] = pg8::cvt_pk_bf16(hr, hi); }
            f32x4 y = {0.f, 0.f, 0.f, 0.f};
#pragma unroll
            for (int ks = 0; ks < 4; ++ks) { const bf16x8 a = *(const LAS bf16x8*)(hbuf + fr * 68 + ks * 16 + quad * 4); y = MFMA16(a, cf[ks], y); }
#pragma unroll
            for (int j = 0; j < 4; ++j) { const int s = blk * 16 + quad * 4 + j; const float uu = ubuf[s * 16 + fr]; const float yv = y[j] + dco * uu;
                const float z = 0.7978845608028654f * (yv + 0.044715f * yv * yv * yv); const float th = 1.0f - 2.0f / (1.0f + __expf(2.0f * z)); const float gl = 0.5f * yv * (1.0f + th);
                gbuf[(size_t)(rowbase + s) * 512 + g * 16 + fr] = (bf16)f2bf(gl); }
        }
        if (!sample && chunk == 63) { out[OFF_SRP + (b * 32 + g) * 64 + lane] = hr; out[OFF_SIP + (b * 32 + g) * 64 + lane] = hi; }
        if (sample) { out[OFF_SRS + (b * 32 + g) * 64 + lane] = hr; out[OFF_SIS + (b * 32 + g) * 64 + lane] = hi; }
    }
}

struct Params { const float* in[36]; float* out; unsigned char* ws; int use_cg, pad; };

__global__ void __launch_bounds__(512, 2) mega_fwd(Params P) {
    extern __shared__ __attribute__((aligned(16))) unsigned char lds_raw[];
    LAS unsigned char* lds = (LAS unsigned char*)lds_raw;
    volatile LAS unsigned* MISC = (volatile LAS unsigned*)(lds + MISC_OFF);
    const int G = gridDim.x, NGW = G * 8, NT = G * 512;
    const int wave_s = __builtin_amdgcn_readfirstlane(threadIdx.x >> 6);
    for (int u = threadIdx.x; u < (LDS_BYTES - 131072) / 4; u += 512) ((LAS unsigned*)(lds + 131072))[u] = 0u;
    __syncthreads();
    XcdBarrier bar = xcd_barrier_post((unsigned*)(P.ws + WS_BAR), MISC + 8);
#ifndef STOP_AFTER
#define STOP_AFTER 1000
#endif
    int ph = 0;
#define RUN (ph < STOP_AFTER)
#define FRESH() const int tid = fresh_tid(wave_s), lane = tid & 63, wave = __builtin_amdgcn_readfirstlane(tid >> 6); const int gw = blockIdx.x * 8 + wave, gt = blockIdx.x * 512 + tid; (void)gw; (void)gt; (void)lane; LAS float* wscr = (LAS float*)(lds + 32768 + wave * 12288); (void)wscr;
#define SEAM() do { if (P.use_cg) cg::this_grid().sync(); else xcd_barrier(bar); ++ph; } while (0)

#define part ((float*)(ws + WS_PART))
#define PARTBUF(k) (part + (size_t)((k) & 1) * PART_ELEMS)
#define ropec ((float*)(ws + WS_ROPE))
#define ropes (ropec + 4096 * 32)
#define abar ((float*)(ws + WS_SSM))
#define bbar (abar + 32 * 64 * 2)
#define ckb ((bf16*)(ws + WS_CKV))
#define cvb (ckb + 8 * 128 * 128)
#define sloc ((float*)(ws + WS_SLOC))
#define memk ((bf16*)(ws + WS_MEMK))
#define memvT ((bf16*)(ws + WS_MEMVT))
#define SG ((float*)(ws + WS_SIDE))
#define SV ((float*)(ws + WS_SIDE + SG_BYTES))
#define WT ((bf16*)(ws + WS_WT))
#define xb ((bf16*)(ws + WS_XB))
#define tmp (ws + WS_TMP)
#define proj0 ((bf16*)(tmp + TMP_PROJ0))
#define gbuf ((bf16*)(tmp + TMP_GBUF))
#define ycat ((bf16*)(tmp + TMP_YCAT))
#define memb ((bf16*)(tmp + TMP_MEMB))
#define qx ((bf16*)(tmp + TMP_QX))
#define ox ((bf16*)(tmp + TMP_OX))
#define act ((bf16*)(tmp + TMP_ACT))
#define gbm ((bf16*)(tmp + TMP_GB))
#define zc ((bf16*)(tmp + TMP_ZC))
#define PTRS() unsigned char* ws = P.ws; float* out = P.out; asm volatile("" : "+s"(ws), "+s"(out));
    if (RUN) { PTRS() FRESH()
        {
            constexpr int NITEMS = 640 + 128 + 512 + 2 * 512 + 2 * 1024 + 2 * 512 + 2 * 2816 + 2 * 1408 + 1536 + 512 + 2048;
            for (int it = gw; it < NITEMS; it += NGW) { int r = it;
#define TR(Wp, K_, N_, WTp, gainp, sc, mode) { const int ni_ = ((K_) / 64) * ((N_) / 32); if (r < ni_) { tr_item(Wp, K_, N_, WTp, gainp, sc, mode, wscr, r, lane); continue; } r -= ni_; }
                TR(P.in[15], 1024, 1280, WT + WT_INEVEN, P.in[11], 1.f, 1)
                TR(P.in[25], 512, 512, WT + WT_GLU, nullptr, 1.f, 0)
                TR(P.in[16], 1024, 1024, WT + WT_OUTEVEN, nullptr, 1.f, 0)
                TR(P.in[30], 1024, 1024, WT + WT_WQ, P.in[12], 0.0625f, 0)
                TR(P.in[30] + 1048576, 1024, 1024, WT + WT_WQ + 1048576, P.in[12] + 1024, 0.0625f, 0)
                TR(P.in[31], 1024, 2048, WT + WT_WKV, nullptr, 1.f, 0)
                TR(P.in[31] + 2097152, 1024, 2048, WT + WT_WKV + 2097152, nullptr, 1.f, 0)
                TR(P.in[32], 1024, 1024, WT + WT_WO, nullptr, 1.f, 0)
                TR(P.in[32] + 1048576, 1024, 1024, WT + WT_WO + 1048576, nullptr, 1.f, 0)
                TR(P.in[33], 1024, 5632, WT + WT_UP, P.in[13], 1.f, 2)
                TR(P.in[33] + (size_t)1024 * 5632, 1024, 5632, WT + WT_UP + (size_t)5632 * 1024, P.in[13] + 1024, 1.f, 2)
                TR(P.in[35], 2816, 1024, WT + WT_DOWN, nullptr, 1.f, 0)
                TR(P.in[35] + (size_t)2816 * 1024, 2816, 1024, WT + WT_DOWN + (size_t)2816 * 1024, nullptr, 1.f, 0)
                TR(P.in[27], 1024, 3072, WT + WT_INODD, P.in[11] + 1024, 1.f, 3)
                TR(P.in[29], 1024, 1024, WT + WT_OUTODD, nullptr, 1.f, 0)
                { const int mi = r >> 7, l = mi >> 3, b = mi & 7; tr_item(P.in[10] + (size_t)mi * 262144, 256, 1024, memvT + (size_t)(l * 12 + 4 + b) * 262144, nullptr, 1.f, 0, wscr, r & 127, lane); }
            }
        }
        for (int m = gw; m < MROWS; m += NGW) { const float* xr = m < MP ? P.in[0] + (size_t)m * 1024 : P.in[1] + (size_t)(m - MP) * 1024; float ss = 0.f;
#pragma unroll
            for (int j = 0; j < 4; ++j) { const f32x4 v = *(const f32x4*)(xr + (lane + 64 * j) * 4); ss += (v[0] * v[0] + v[1] * v[1]) + (v[2] * v[2] + v[3] * v[3]);
                u32x2v w; w.x = pg8::cvt_pk_bf16(v[0], v[1]); w.y = pg8::cvt_pk_bf16(v[2], v[3]); *(u32x2v*)(xb + (size_t)m * 1024 + (lane + 64 * j) * 4) = w; }
            ss = wave_sum(ss); if (lane < 16) PARTBUF(0)[(size_t)m * 16 + lane] = lane == 0 ? ss : 0.f; }
        for (int i = gt; i < 262144; i += NT) { const f32x4 v = *(const f32x4*)(P.in[2] + (size_t)i * 4); u32x2v w; w.x = pg8::cvt_pk_bf16(v[0], v[1]); w.y = pg8::cvt_pk_bf16(v[2], v[3]); *(u32x2v*)(memb + (size_t)i * 4) = w; }
        for (int i = gt; i < 1048576; i += NT) { const size_t e = (size_t)i * 4; const int lb = (int)(e >> 18), l = lb >> 3, b = lb & 7; const f32x4 v = *(const f32x4*)(P.in[9] + e);
            u32x2v w; w.x = pg8::cvt_pk_bf16(v[0], v[1]); w.y = pg8::cvt_pk_bf16(v[2], v[3]); *(u32x2v*)(memk + (size_t)(l * 12 + 4 + b) * 262144 + (e & 262143)) = w; }
        for (int i = gt; i < 65536; i += NT) { const int j = i & 32767; const float* src = (i < 32768 ? P.in[3] : P.in[4]) + (size_t)j * 4; bf16* dst = (i < 32768 ? ckb : cvb) + (size_t)j * 4;
            const f32x4 v = *(const f32x4*)src; u32x2v w; w.x = pg8::cvt_pk_bf16(v[0], v[1]); w.y = pg8::cvt_pk_bf16(v[2], v[3]); *(u32x2v*)dst = w; }
        for (int i = gt; i < 4096 * 32; i += NT) { const int pos = i >> 5, d = i & 31; const double inv = dexp_(-(double)d * (9.210340371976184 / 32.0)); double s, c; dsincos_((double)pos * inv, s, c); ropec[i] = (float)c; ropes[i] = (float)s; }
        for (int i = gt; i < 2048; i += NT) { const double are = P.in[17][i], aim = P.in[18][i], dt = dexp_((double)P.in[19][i]); double s, c; dsincos_(aim * dt, s, c); const double mag = dexp_(are * dt);
            const double br = mag * c, bi = mag * s; abar[2 * i] = (float)br; abar[2 * i + 1] = (float)bi;
            const double nr = br - 1.0, ni = bi, den = are * are + aim * aim; const double qr = (nr * are + ni * aim) / den, qi = (ni * are - nr * aim) / den;
#pragma unroll 4
            for (int h = 0; h < 16; ++h) { const double xr = P.in[20][(size_t)i * 16 + h], xi = P.in[21][(size_t)i * 16 + h]; bbar[(size_t)i * 32 + 2 * h] = (float)(qr * xr - qi * xi); bbar[(size_t)i * 32 + 2 * h + 1] = (float)(qr * xi + qi * xr); } }
    }
    SEAM();
    if (RUN) { PTRS()
        if (G < 128 || (int)blockIdx.x >= G - 64) { pg8::Gemm g{memb, WT + WT_WKV, 1024, 4096, 1024}; pg8::StaticOrder S;
            if (G < 128) S.init(1024, 4096, G, (int)blockIdx.x); else S.init(1024, 4096, 64, (int)blockIdx.x - (G - 64)); EpiKV E{out, memk};
          pg8::gemm_phase<EpiKV, pg8::StaticOrder, true, true>(lds, g, S, E, wave_s); }
        { pg8::Gemm g{xb, WT + WT_INEVEN, MROWS, 1280, 1024}; pg8::StaticOrderF S; S.init(MROWS, 1280, G, (int)blockIdx.x); EpiIn0 E{proj0, PARTBUF(0), ropec, ropes, out};
          pg8::gemm_phase<EpiIn0, pg8::StaticOrderF, true, true>(lds, g, S, E, wave_s); }
    }
    SEAM();
    if (RUN) { PTRS() FRESH()
        swa_phase(proj0, ckb, cvb, P.in[26], ycat, lds, tid, wave, lane, G);
        s5_local(proj0, abar, bbar, sloc, wscr, wave * G + (int)blockIdx.x, NGW, lane);
        for (int it = wave * G + (int)blockIdx.x; it < 1024; it += NGW) { const int mi = it >> 7, l = mi >> 2, b = mi & 3;
            tr_item(out + OFF_MVP + (size_t)mi * 262144, 256, 1024, memvT + (size_t)(l * 12 + b) * 262144, nullptr, 1.f, 0, wscr, it & 127, lane); }
    }
    SEAM();
    if (RUN) { PTRS() FRESH() s5_out(proj0, abar, bbar, sloc, P.in[5], P.in[6], P.in[22], P.in[23], P.in[24], gbuf, out, wscr, (LAS unsigned*)(wscr + 1024), wave * G + (int)blockIdx.x, NGW, lane); }
    SEAM();
    if (RUN) { PTRS() pg8::Gemm g{gbuf, WT + WT_GLU, MROWS, 512, 512}; pg8::StaticOrder S; S.init(MROWS, 512, G, (int)blockIdx.x); EpiGlu E{gbuf, ycat};
        pg8::gemm_phase<EpiGlu, pg8::StaticOrder, true, true>(lds, g, S, E, wave_s); }
    SEAM();

#pragma unroll
    for (int l = 0; l < 2; ++l) {
        if (l == 1) {
            if (RUN) { PTRS() pg8::Gemm g{xb, WT + WT_INODD, MROWS, 3072, 1024}; pg8::StaticOrderF S; S.init(MROWS, 3072, G, (int)blockIdx.x); EpiInOdd E{gbm, zc, PARTBUF(3), P.in[28], SG};
                pg8::gemm_phase<EpiInOdd, pg8::StaticOrderF, true, true>(lds, g, S, E, wave_s); }
            SEAM();
            if (RUN) { PTRS() FRESH()
                const float* cw = P.in[28]; const float* st = P.in[7];
                for (int i = gt; i < MROWS * 128; i += NT) { const int row = i >> 7, c0 = (i & 127) * 8, blk = row >> 6, r = row & 63;
                    const bool smp = row >= MP; const int rr = smp ? (r & 31) : r;
                    f32x4 z0, z1;
                    if (rr < 2) { const int sb = smp ? (r >> 5) * 4 : 0;
                        f32x4 pa0, pa1, pb0, pb1;
                        if (smp) { const int b = (blk - 256) * 2 + (r >> 5); const float* s0 = st + (size_t)(b * 2) * 1024 + c0; pa0 = *(const f32x4*)s0; pa1 = *(const f32x4*)(s0 + 4); pb0 = *(const f32x4*)(s0 + 1024); pb1 = *(const f32x4*)(s0 + 1028); }
                        else if ((blk & 63) == 0) { pa0 = pa1 = pb0 = pb1 = (f32x4){0.f, 0.f, 0.f, 0.f}; }
                        else { const float* s0 = SG + (size_t)((blk - 1) * 8 + 6) * 1024 + c0; pa0 = *(const f32x4*)s0; pa1 = *(const f32x4*)(s0 + 4); pb0 = *(const f32x4*)(s0 + 1024); pb1 = *(const f32x4*)(s0 + 1028); }
                        const float* sc = SG + (size_t)(blk * 8 + sb) * 1024 + c0; const f32x4 x00 = *(const f32x4*)sc, x01 = *(const f32x4*)(sc + 4);
                        f32x4 xm2a, xm2b, xm1a, xm1b, xca, xcb;
                        if (rr == 0) { xm2a = pa0; xm2b = pa1; xm1a = pb0; xm1b = pb1; xca = x00; xcb = x01; }
                        else { xm2a = pb0; xm2b = pb1; xm1a = x00; xm1b = x01; xca = *(const f32x4*)(sc + 1024); xcb = *(const f32x4*)(sc + 1028); }
                        const f32x4 w0a = *(const f32x4*)(cw + c0), w0b = *(const f32x4*)(cw + c0 + 4), w1a = *(const f32x4*)(cw + 1024 + c0), w1b = *(const f32x4*)(cw + 1028 + c0), w2a = *(const f32x4*)(cw + 2048 + c0), w2b = *(const f32x4*)(cw + 2052 + c0);
                        z0 = w0a * xm2a + w1a * xm1a + w2a * xca; z1 = w0b * xm2b + w1b * xm1b + w2b * xcb; }
                    else { const v4u zw = *(const v4u*)(zc + (size_t)row * 1024 + c0); z0 = (f32x4){bflo(zw.x), bfhi(zw.x), bflo(zw.y), bfhi(zw.y)}; z1 = (f32x4){bflo(zw.z), bfhi(zw.z), bflo(zw.w), bfhi(zw.w)}; }
                    const v4u gw_ = *(const v4u*)(gbm + (size_t)row * 1024 + c0);
                    const f32x4 g0 = (f32x4){bflo(gw_.x), bfhi(gw_.x), bflo(gw_.y), bfhi(gw_.y)}, g1 = (f32x4){bflo(gw_.z), bfhi(gw_.z), bflo(gw_.w), bfhi(gw_.w)};
                    *(v4u*)(gbm + (size_t)row * 1024 + c0) = pack8(g0 * z0, g1 * z1); }
                for (int i = gt; i < 4 * 2 * 1024; i += NT) { const int c = i & 1023, j = (i >> 10) & 1, b = i >> 11; out[OFF_CMP + i] = SG[(size_t)((64 * b + 63) * 8 + 6 + j) * 1024 + c]; }
                for (int i = gt; i < 8 * 2 * 1024; i += NT) { const int c = i & 1023, j = (i >> 10) & 1, b = i >> 11; out[OFF_CMS + i] = SG[(size_t)((256 + (b >> 1)) * 8 + (b & 1) * 4 + 2 + j) * 1024 + c]; }
            }
            SEAM();
        }
        if (RUN) { PTRS() pg8::Gemm g{(bf16*)(tmp + (size_t)(1 - l) * TMP_YCAT), WT + WT_OUTEVEN + (size_t)l * (WT_OUTODD - WT_OUTEVEN), MROWS, 1024, 1024}; pg8::StaticOrderF S; S.init(MROWS, 1024, G, (int)blockIdx.x);
            EpiRes E{P.in[0], P.in[1] - (size_t)MP * 1024, xb, PARTBUF(1 + 3 * l), l == 0 ? 1 : 0};
            pg8::gemm_phase<EpiRes, pg8::StaticOrderF, true, true>(lds, g, S, E, wave_s); }
        SEAM();
        if (RUN) { PTRS() pg8::Gemm g{xb, WT + WT_WQ + (size_t)l * 1048576, MROWS, 1024, 1024}; pg8::StaticOrderF S; S.init(MROWS, 1024, G, (int)blockIdx.x); EpiBf16 E{qx, 1024, PARTBUF(1 + 3 * l)};
            pg8::gemm_phase<EpiBf16, pg8::StaticOrderF, true, true>(lds, g, S, E, wave_s); }
        SEAM();
        if (RUN) { PTRS() FRESH() xattn_phase2(qx, memk + (size_t)l * 12 * 262144, memvT + (size_t)l * 12 * 262144, ox, lds, tid, wave, lane, G); }
        SEAM();
        if (RUN) { PTRS() pg8::Gemm g{ox, WT + WT_WO + (size_t)l * 1048576, MROWS, 1024, 1024}; pg8::StaticOrderF S; S.init(MROWS, 1024, G, (int)blockIdx.x); EpiRes E{P.in[0], P.in[0], xb, PARTBUF(2 + 3 * l), 0};
            pg8::gemm_phase<EpiRes, pg8::StaticOrderF, true, true>(lds, g, S, E, wave_s); }
        SEAM();
        if (RUN) { PTRS() pg8::Gemm g{xb, WT + WT_UP + (size_t)l * 5632 * 1024, MROWS, 5632, 1024}; pg8::StaticOrderF S; S.init(MROWS, 5632, G, (int)blockIdx.x);
            EpiFfnUp E{act, PARTBUF(2 + 3 * l), P.in[34] + (size_t)l * 3 * DFF, SG, SV};
            pg8::gemm_phase<EpiFfnUp, pg8::StaticOrderF, true, true>(lds, g, S, E, wave_s); }
        SEAM();
        if (RUN) { PTRS() FRESH()
            const float* cw = P.in[34] + (size_t)l * 3 * DFF; const float* st = P.in[8] + (size_t)l * 8 * 2 * DFF;
            for (int i = gt; i < 528 * 352; i += NT) { const int fi = i / 352, c0 = (i % 352) * 8; int blk, row, rr, sb, vb; bool smp = fi >= 512;
                if (!smp) { blk = fi >> 1; rr = fi & 1; row = blk * 64 + rr; sb = 0; vb = 0; } else { const int s = fi - 512, half = (s >> 1) & 1; blk = 256 + (s >> 2); rr = s & 1; row = blk * 64 + half * 32 + rr; sb = half * 4; vb = half * 2; }
                f32x4 pa0, pa1, pb0, pb1;
                if (smp) { const int b = (blk - 256) * 2 + (sb >> 2); const float* s0 = st + (size_t)(b * 2) * DFF + c0; pa0 = *(const f32x4*)s0; pa1 = *(const f32x4*)(s0 + 4); pb0 = *(const f32x4*)(s0 + DFF); pb1 = *(const f32x4*)(s0 + DFF + 4); }
                else if ((blk & 63) == 0) { pa0 = pa1 = pb0 = pb1 = (f32x4){0.f, 0.f, 0.f, 0.f}; }
                else { const float* s0 = SG + (size_t)((blk - 1) * 8 + 6) * DFF + c0; pa0 = *(const f32x4*)s0; pa1 = *(const f32x4*)(s0 + 4); pb0 = *(const f32x4*)(s0 + DFF); pb1 = *(const f32x4*)(s0 + DFF + 4); }
                const float* sc = SG + (size_t)(blk * 8 + sb) * DFF + c0; const f32x4 x00 = *(const f32x4*)sc, x01 = *(const f32x4*)(sc + 4);
                f32x4 xm2a, xm2b, xm1a, xm1b, xca, xcb;
                if (rr == 0) { xm2a = pa0; xm2b = pa1; xm1a = pb0; xm1b = pb1; xca = x00; xcb = x01; }
                else { xm2a = pb0; xm2b = pb1; xm1a = x00; xm1b = x01; xca = *(const f32x4*)(sc + DFF); xcb = *(const f32x4*)(sc + DFF + 4); }
                const f32x4 w0a = *(const f32x4*)(cw + c0), w0b = *(const f32x4*)(cw + c0 + 4), w1a = *(const f32x4*)(cw + DFF + c0), w1b = *(const f32x4*)(cw + DFF + c0 + 4), w2a = *(const f32x4*)(cw + 2 * DFF + c0), w2b = *(const f32x4*)(cw + 2 * DFF + c0 + 4);
                const f32x4 ga = w0a * xm2a + w1a * xm1a + w2a * xca, gb_ = w0b * xm2b + w1b * xm1b + w2b * xcb;
                const float* sv = SV + (size_t)(blk * 4 + vb + rr) * DFF + c0; const f32x4 va = *(const f32x4*)sv, vb_ = *(const f32x4*)(sv + 4);
                f32x4 a0, a1;
#pragma unroll
                for (int j = 0; j < 4; ++j) { a0[j] = ga[j] * sigmoidf_(ga[j]) * va[j]; a1[j] = gb_[j] * sigmoidf_(gb_[j]) * vb_[j]; }
                *(v4u*)(act + (size_t)row * DFF + c0) = pack8(a0, a1); }
            for (int i = gt; i < 4 * 2 * DFF; i += NT) { const int c = i % DFF, j = (i / DFF) & 1, b = i / (2 * DFF); out[OFF_CFP + (size_t)l * 4 * 2 * DFF + i] = SG[(size_t)((64 * b + 63) * 8 + 6 + j) * DFF + c]; }
            for (int i = gt; i < 8 * 2 * DFF; i += NT) { const int c = i % DFF, j = (i / DFF) & 1, b = i / (2 * DFF); out[OFF_CFS + (size_t)l * 8 * 2 * DFF + i] = SG[(size_t)((256 + (b >> 1)) * 8 + (b & 1) * 4 + 2 + j) * DFF + c]; }
        }
        SEAM();
        if (RUN) { PTRS() pg8::Gemm g{act, WT + WT_DOWN + (size_t)l * 2816 * 1024, MROWS, 1024, DFF}; pg8::StaticOrderF S; S.init(MROWS, 1024, G, (int)blockIdx.x); EpiRes E{P.in[0], P.in[0], xb, PARTBUF(3 + 3 * l), 0};
            pg8::gemm_phase<EpiRes, pg8::StaticOrderF, true, true>(lds, g, S, E, wave_s); }
        SEAM();
    }
    if (RUN) { PTRS() FRESH()
        const float* gf = P.in[14];
        for (int m = gw; m < MROWS; m += NGW) { const float rs = rstd_of(PARTBUF(6), m); float* xr = out + (size_t)m * 1024; const bf16* xbr = xb + (size_t)m * 1024;
#pragma unroll
            for (int j = 0; j < 4; ++j) { const int c = (lane + 64 * j) * 4; const u32x2v w = *(const u32x2v*)(xbr + c); const f32x4 v = (f32x4){bflo(w.x), bfhi(w.x), bflo(w.y), bfhi(w.y)}, gg = *(const f32x4*)(gf + c); *(f32x4*)(xr + c) = v * rs * gg; } }
    }
}

extern "C" void kernel_launch(void* const* d_in, const int* in_sizes, int n_in, void* d_out, int out_size, void* d_ws, size_t ws_size, hipStream_t stream) {
    static int grid = 0;
    if (grid == 0) {
        int dev = 0, cus = 0, per_cu = 0;
        if (n_in != 36 || ws_size < 256 * MiB) { fprintf(stderr, "kernel_launch: unexpected n_in %d / ws %zu\n", n_in, ws_size); grid = -1; return; }
        (void)hipGetDevice(&dev); (void)hipDeviceGetAttribute(&cus, hipDeviceAttributeMultiprocessorCount, dev);
        if (hipFuncSetAttribute((const void*)mega_fwd, hipFuncAttributeMaxDynamicSharedMemorySize, LDS_BYTES) != hipSuccess) { fprintf(stderr, "kernel_launch: hipFuncSetAttribute failed\n"); grid = -1; return; }
        if (hipOccupancyMaxActiveBlocksPerMultiprocessor(&per_cu, (const void*)mega_fwd, 512, LDS_BYTES) != hipSuccess || per_cu < 1) per_cu = 1;
        (void)hipGetLastError();
        grid = cus * 1;
        if (grid > 256) grid = 256;
    }
    if (grid < 0) return;
    (void)hipMemsetAsync(d_ws, 0, CTL_ZERO_BYTES, stream);
    Params p{};
    for (int i = 0; i < 36; ++i) p.in[i] = (const float*)d_in[i];
    p.out = (float*)d_out; p.ws = (unsigned char*)d_ws; p.use_cg = 0; p.pad = 0;
    void* args[] = {&p};
    hipError_t e = hipLaunchCooperativeKernel((const void*)mega_fwd, dim3(grid), dim3(512), args, LDS_BYTES, stream);
    if (e != hipSuccess) fprintf(stderr, "cooperative launch failed: %s (grid %d)\n", hipGetErrorString(e), grid);
}
```

```cpp
#include <hip/hip_runtime.h>
#include <hip/hip_cooperative_groups.h>
#include <cstdio>
#include <cstdint>
namespace cg = cooperative_groups;
__device__ __forceinline__ int fresh_tid(int wave_s) { unsigned z = 0u; asm volatile("" : "+s"(z)); int t = wave_s * 64 + (int)__builtin_amdgcn_mbcnt_hi(~0u, __builtin_amdgcn_mbcnt_lo(~0u, z)); asm volatile("" : "+v"(t)); return t; }
namespace pg8 {
#define PG8_LAS __attribute__((address_space(3)))
typedef unsigned short bf16_t;
typedef short bf16x8 __attribute__((ext_vector_type(8)));
typedef float f32x4 __attribute__((ext_vector_type(4)));
typedef unsigned u32x4 __attribute__((ext_vector_type(4)));
constexpr int BM = 256, BK = 64, HALF = 128, HTB = HALF * BK * 2  , STAGE_BYTES = 8 * HTB, NXCD = 8, WGM = 8;

__host__ __device__ __forceinline__ int lds_byte(int r, int c) { const int st = (r >> 4) * 2 + (c >> 5), rr = r & 15, cc = c & 31, ob = rr * 64 + cc * 2; return st * 1024 + (ob ^ (((ob >> 9) & 1) << 5)); }
__host__ __device__ __forceinline__ void stage_rc(int b, int& R, int& C) { const int st = b / 1024, sb = b % 1024, swz = sb ^ (((sb >> 9) & 1) << 5); R = (st >> 1) * 16 + swz / 64; C = (st & 1) * 32 + (swz % 64) / 2; }
__host__ __device__ __forceinline__ int perm32(int rho) { const int n = rho >> 4, i = rho & 15; return 8 * (i >> 2) + 4 * n + (i & 3); }

struct Unit { int pm, pn; };
struct Gemm { const bf16_t* A; const bf16_t* Bt; int M, N, K; };

template <bool FULL> struct StaticOrderT {
    int nM, nN, nwg, G, c;
    __host__ __device__ void init(int M, int N, int G_, int c_) { nM = M / BM; nN = N / BM; nwg = nM * nN; G = G_; c = c_; }
    __host__ __device__ bool next(int i, Unit& u) const {
        const long L = (long)i * G + c; if (!(FULL && i == 0) && L >= nwg) return false;
        int wgid = (int)L; { const int q = nwg / NXCD, r = nwg % NXCD, xcd = wgid % NXCD, off = wgid / NXCD; wgid = (xcd < r ? xcd * (q + 1) : r * (q + 1) + (xcd - r) * q) + off; }
        const int nig = WGM * nN, gid = wgid / nig, fm = gid * WGM, gsz = (nM - fm) < WGM ? (nM - fm) : WGM;
        u.pm = fm + ((wgid % nig) % gsz); u.pn = (wgid % nig) / gsz; return true;
    }
    __device__ __forceinline__ void a_ready(const Unit&) const {}
    __device__ __forceinline__ void done(const Unit&) const {}
};

typedef StaticOrderT<false> StaticOrder; typedef StaticOrderT<true> StaticOrderF;
__device__ __forceinline__ unsigned cvt_pk_bf16(float lo, float hi) { unsigned r; asm volatile("v_cvt_pk_bf16_f32 %0, %1, %2" : "=v"(r) : "v"(lo), "v"(hi)); return r; }
typedef float f32x2 __attribute__((ext_vector_type(2)));
template <class Epi, class Sched, bool ALIGN_EPI = false, bool SP2 = false>
__device__ __forceinline__ void gemm_phase(PG8_LAS unsigned char* lds, const Gemm g, const Sched& S, const Epi& E, const int wave_s) {
    const int tid = fresh_tid(wave_s), wid = __builtin_amdgcn_readfirstlane(tid >> 6), lane = tid & 63, wr = wid >> 2, wc = wid & 3, fr = lane & 15, fq = lane >> 4;
    const int K = g.K, nt = K / BK;
    unsigned voffA[2], voffB[2];
#pragma unroll
    for (int i = 0; i < 2; ++i) { int R, C; stage_rc(tid * 16 + i * 8192, R, C); const int Rb = Epi::PERM ? ((R & ~31) + perm32(R & 31)) : R;
        voffA[i] = (unsigned)(R * K + C) * 2u; voffB[i] = (unsigned)(Rb * K + C) * 2u; }
    const size_t kstep = (size_t)(BK * 2);
    const size_t hstep = (size_t)HALF * K * 2;
    const size_t tstep = 2 * hstep;
    const unsigned ldsw = (unsigned)wid * 1024u;
    const int aoff = lds_byte(wr * 64 + fr, fq * 8), boff = lds_byte(wc * 32 + fr, fq * 8);
#define PG8_SA(b, h) (((b) * 2 + (h)) * HTB)
#define PG8_SB(b, h) ((4 + (b) * 2 + (h)) * HTB)
#define PG8_STAGE(bufoff, gbase, voff) do { _Pragma("unroll") for (int _i = 0; _i < 2; ++_i) \
        __builtin_amdgcn_global_load_lds((const unsigned*)((const char*)(gbase) + (voff)[_i]), (PG8_LAS unsigned*)(lds + (bufoff) + ldsw + _i * 8192), 16, 0, 0); } while (0)
#define PG8_LDA(dst, b, h) do { _Pragma("unroll") for (int m = 0; m < 4; ++m) _Pragma("unroll") for (int k = 0; k < 2; ++k) dst[m][k] = *(const PG8_LAS bf16x8*)(lds + PG8_SA(b, h) + aoff + m * 2048 + k * 1024); } while (0)
#define PG8_LDB(dst, b, h) do { _Pragma("unroll") for (int n = 0; n < 2; ++n) _Pragma("unroll") for (int k = 0; k < 2; ++k) dst[n][k] = *(const PG8_LAS bf16x8*)(lds + PG8_SB(b, h) + boff + n * 2048 + k * 1024); } while (0)
#define PG8_MMA(ai, bj, At, Bt) do { __builtin_amdgcn_s_setprio(1); _Pragma("unroll") for (int m = 0; m < 4; ++m) _Pragma("unroll") for (int n = 0; n < 2; ++n) _Pragma("unroll") for (int k = 0; k < 2; ++k) \
        acc[ai][bj][m][n] = __builtin_amdgcn_mfma_f32_16x16x32_bf16(Bt[n][k], At[m][k], acc[ai][bj][m][n], 0, 0, 0); __builtin_amdgcn_s_setprio(0); } while (0)
#define PG8_WAIT_V(n) asm volatile("s_waitcnt vmcnt(" #n ")" ::: "memory")
#define PG8_WAIT_L(n) asm volatile("s_waitcnt lgkmcnt(" #n ")" ::: "memory")
#define PG8_BAR __builtin_amdgcn_s_barrier()
#define PG8_SCHED __builtin_amdgcn_sched_barrier(0)
    Unit cur, nxt; int ui = 0;
    if (!S.next(0, cur)) return;
    f32x4 acc[2][2][4][2];
#pragma unroll
    for (int a = 0; a < 2; ++a)
#pragma unroll
        for (int b = 0; b < 2; ++b)
#pragma unroll
            for (int m = 0; m < 4; ++m)
#pragma unroll
                for (int n = 0; n < 2; ++n) acc[a][b][m][n] = (f32x4){0.f, 0.f, 0.f, 0.f};
    bf16x8 At[4][2], B0[2][2], B1[2][2];
    const char* cA = (const char*)g.A + (size_t)cur.pm * tstep; const char* cB = (const char*)g.Bt + (size_t)cur.pn * tstep;
    S.a_ready(cur);
    if constexpr (SP2) {
        PG8_STAGE(PG8_SB(0, 0), cB, voffB); PG8_STAGE(PG8_SB(0, 1), cB + hstep, voffB); PG8_STAGE(PG8_SA(0, 0), cA, voffA); PG8_STAGE(PG8_SA(0, 1), cA + hstep, voffA);
        if (wr == 1) PG8_BAR;
        PG8_WAIT_V(2); PG8_BAR;
        PG8_STAGE(PG8_SB(1, 0), cB + kstep, voffB); PG8_STAGE(PG8_SA(1, 0), cA + kstep, voffA); PG8_STAGE(PG8_SB(1, 1), cB + hstep + kstep, voffB);
        PG8_WAIT_V(6); PG8_BAR;
    } else {
        PG8_STAGE(PG8_SB(0, 0), cB, voffB); PG8_STAGE(PG8_SA(0, 0), cA, voffA); PG8_STAGE(PG8_SB(0, 1), cB + hstep, voffB); PG8_STAGE(PG8_SA(0, 1), cA + hstep, voffA);
        if (wr == 1) PG8_BAR;
        PG8_WAIT_V(4); PG8_BAR;
        PG8_STAGE(PG8_SB(1, 0), cB + kstep, voffB); PG8_STAGE(PG8_SA(1, 0), cA + kstep, voffA); PG8_STAGE(PG8_SB(1, 1), cB + hstep + kstep, voffB);
        PG8_WAIT_V(6); PG8_BAR;
    }
    for (;;) {
        const bool has_next = S.next(ui + 1, nxt);
        const char* nA = has_next ? (const char*)g.A + (size_t)nxt.pm * tstep : cA; const char* nB = has_next ? (const char*)g.Bt + (size_t)nxt.pn * tstep : cB;
        for (int t = 0; t < nt; t += 2) {
            const bool last = (t == nt - 2);
            const char* a1 = cA + (size_t)(t + 1) * kstep;
            const char* a2 = last ? nA : cA + (size_t)(t + 2) * kstep; const char* b2 = last ? nB : cB + (size_t)(t + 2) * kstep;
            const char* a3 = a2 + kstep; const char* b3 = b2 + kstep;
            if (last && has_next) S.a_ready(nxt);
            if constexpr (SP2) {
            PG8_LDB(B0, 0, 0); PG8_LDB(B1, 0, 1); PG8_SCHED; PG8_LDA(At, 0, 0); PG8_STAGE(PG8_SA(1, 1), a1 + hstep, voffA);
            PG8_WAIT_V(8); PG8_WAIT_L(0); PG8_BAR; PG8_MMA(0, 0, At, B0); PG8_MMA(0, 1, At, B1); PG8_BAR; PG8_SCHED;
            PG8_LDA(At, 0, 1); PG8_STAGE(PG8_SB(0, 0), b2, voffB); PG8_STAGE(PG8_SB(0, 1), b2 + hstep, voffB); PG8_STAGE(PG8_SA(0, 0), a2, voffA);
            PG8_WAIT_V(8); PG8_WAIT_L(0); PG8_BAR; PG8_MMA(1, 0, At, B0); PG8_MMA(1, 1, At, B1); PG8_BAR; PG8_SCHED;
            PG8_LDB(B0, 1, 0); PG8_LDB(B1, 1, 1); PG8_SCHED; PG8_LDA(At, 1, 0); PG8_STAGE(PG8_SA(0, 1), a2 + hstep, voffA);
            PG8_WAIT_V(8); PG8_WAIT_L(0); PG8_BAR; PG8_MMA(0, 0, At, B0); PG8_MMA(0, 1, At, B1); PG8_BAR; PG8_SCHED;
            PG8_LDA(At, 1, 1); PG8_STAGE(PG8_SB(1, 0), b3, voffB); PG8_STAGE(PG8_SB(1, 1), b3 + hstep, voffB); PG8_STAGE(PG8_SA(1, 0), a3, voffA);
            PG8_WAIT_V(8); PG8_WAIT_L(0); PG8_BAR; PG8_MMA(1, 0, At, B0); PG8_MMA(1, 1, At, B1); PG8_BAR; PG8_SCHED;
            } else {
            PG8_LDB(B0, 0, 0); PG8_SCHED; PG8_LDA(At, 0, 0); PG8_STAGE(PG8_SA(1, 1), a1 + hstep, voffA);
            PG8_WAIT_L(8); PG8_BAR; PG8_WAIT_L(0); PG8_MMA(0, 0, At, B0); PG8_BAR; PG8_SCHED;
            PG8_LDB(B1, 0, 1); PG8_STAGE(PG8_SB(0, 0), b2, voffB);
            PG8_BAR; PG8_WAIT_L(0); PG8_MMA(0, 1, At, B1); PG8_BAR;
            PG8_LDA(At, 0, 1); PG8_STAGE(PG8_SA(0, 0), a2, voffA);
            PG8_BAR; PG8_WAIT_L(0); PG8_MMA(1, 0, At, B0); PG8_BAR; PG8_SCHED;
            PG8_STAGE(PG8_SB(0, 1), b2 + hstep, voffB);
            PG8_WAIT_V(6); PG8_BAR; PG8_MMA(1, 1, At, B1); PG8_BAR;
            PG8_LDB(B0, 1, 0); PG8_SCHED; PG8_LDA(At, 1, 0); PG8_STAGE(PG8_SA(0, 1), a2 + hstep, voffA);
            PG8_WAIT_L(8); PG8_BAR; PG8_WAIT_L(0); PG8_MMA(0, 0, At, B0); PG8_BAR; PG8_SCHED;
            PG8_LDB(B1, 1, 1); PG8_STAGE(PG8_SB(1, 0), b3, voffB);
            PG8_BAR; PG8_WAIT_L(0); PG8_MMA(0, 1, At, B1); PG8_BAR;
            PG8_LDA(At, 1, 1); PG8_STAGE(PG8_SA(1, 0), a3, voffA);
            PG8_BAR; PG8_WAIT_L(0); PG8_MMA(1, 0, At, B0); PG8_BAR; PG8_SCHED;
            PG8_STAGE(PG8_SB(1, 1), b3 + hstep, voffB);
            PG8_WAIT_V(6); PG8_BAR; PG8_MMA(1, 1, At, B1); PG8_BAR;
            }
        }
        if constexpr (ALIGN_EPI) { if (wr == 0) PG8_BAR; }
        if constexpr (!Epi::AFTER_DRAIN) { E(acc, cur, wr, wc, fr, fq); S.done(cur); }
        if (!has_next) break;
#pragma unroll
        for (int a = 0; a < 2; ++a)
#pragma unroll
            for (int b = 0; b < 2; ++b)
#pragma unroll
                for (int m = 0; m < 4; ++m)
#pragma unroll
                    for (int n = 0; n < 2; ++n) acc[a][b][m][n] = (f32x4){0.f, 0.f, 0.f, 0.f};
        cur = nxt; cA = nA; cB = nB; ++ui;
        if constexpr (ALIGN_EPI) { if (wr == 1) PG8_BAR; }
    }
    PG8_WAIT_V(0);
    if constexpr (!ALIGN_EPI) { if (wr == 0) PG8_BAR; }
    PG8_BAR;
    if constexpr (Epi::AFTER_DRAIN) { E.fused(acc, cur, wr, wc, fr, fq, lds, wid, lane); S.done(cur); }
#undef PG8_SA
#undef PG8_SB
#undef PG8_STAGE
#undef PG8_LDA
#undef PG8_LDB
#undef PG8_MMA
#undef PG8_WAIT_V
#undef PG8_WAIT_L
#undef PG8_BAR
#undef PG8_SCHED
}
}
#define GAS __attribute__((address_space(1)))
#define LAS __attribute__((address_space(3)))
typedef unsigned short bf16;
typedef unsigned v4u __attribute__((ext_vector_type(4)));
typedef float f32x4 __attribute__((ext_vector_type(4)));
typedef short bf16x8 __attribute__((ext_vector_type(8)));
typedef GAS unsigned gu32;
typedef GAS unsigned long long gu64;
#define RLX_AGENT __ATOMIC_RELAXED, __HIP_MEMORY_SCOPE_AGENT
#define LDS_WAIT() asm volatile("s_waitcnt lgkmcnt(0)" ::: "memory")
#define VM_WAIT() asm volatile("s_waitcnt vmcnt(0)" ::: "memory")
__device__ __forceinline__ unsigned long long rt() { return __builtin_amdgcn_s_memrealtime(); }
__device__ __forceinline__ unsigned f2bf(float f) { unsigned u = __builtin_bit_cast(unsigned, f); return (u + 0x7fffu + ((u >> 16) & 1u)) >> 16; }
__device__ __forceinline__ unsigned pk2(float lo, float hi) { return f2bf(lo) | (f2bf(hi) << 16); }

#define XB_TMO      128
#define XB_XCNT(j)  (256  + 64 * (j))
#define XB_XSUB(j)  (1280 + 64 * (j))
#define XB_XGEN(j)  (2304 + 64 * (j))
#define XB_TOP      3328
#define XB_TOPGEN   3392
#define XCD_BAR_WORDS 3456
#define XB_SPIN_CAP (1u << 18)

__device__ __forceinline__ unsigned xb_ld(unsigned* p)              { return __hip_atomic_load(p, __ATOMIC_RELAXED, __HIP_MEMORY_SCOPE_AGENT); }
__device__ __forceinline__ unsigned xb_add(unsigned* p, unsigned v) { return __hip_atomic_fetch_add(p, v, __ATOMIC_RELAXED, __HIP_MEMORY_SCOPE_AGENT); }
__device__ __forceinline__ unsigned xb_xcc_id() { return (unsigned)__builtin_amdgcn_s_getreg((3 << 11) | 20) & 0xFu; }
#define XB_SPIN(cond, bar) do { unsigned _sp = 0; while (cond) { __builtin_amdgcn_s_sleep(1); \
    if ((++_sp & 255u) == 0u) { if (xb_ld(&(bar)[XB_TMO])) break; if (_sp > XB_SPIN_CAP) { atomicAdd(&(bar)[XB_TMO], 1u); break; } } } } while (0)

struct XcdBarrier {
    unsigned* bar; unsigned x;
    volatile LAS unsigned* st;
};

__device__ __forceinline__ XcdBarrier xcd_barrier_post(unsigned* bar, volatile LAS unsigned* st) {
    XcdBarrier b; b.bar = bar; b.x = xb_xcc_id(); b.st = st;
    if (threadIdx.x == 0) (void)xb_add(&bar[XB_XCNT(b.x)], 1u);
    return b;
}
__device__ __forceinline__ void xcd_barrier_complete(unsigned* bar, unsigned x, unsigned& nloc, unsigned& nx) {
    const unsigned G = gridDim.x * gridDim.y * gridDim.z;
    unsigned sum, cnt, mine, sp = 0u;
    for (;;) {
        sum = 0u; cnt = 0u; mine = 0u;
#pragma unroll
        for (unsigned j = 0; j < 16; ++j) { const unsigned c = xb_ld(&bar[XB_XCNT(j)]); sum += c; cnt += (c > 0u) ? 1u : 0u; mine = (j == x) ? c : mine; }
        if (sum == G) break;
        __builtin_amdgcn_s_sleep(1);
        if ((++sp & 255u) == 0u) { if (xb_ld(&bar[XB_TMO])) break; if (sp > XB_SPIN_CAP) { atomicAdd(&bar[XB_TMO], 1u); break; } }
    }
    nloc = mine > 0u ? mine : 1u; nx = cnt > 0u ? cnt : 1u;
}

__device__ __forceinline__ void xcd_barrier(const XcdBarrier& b) {
    asm volatile("s_waitcnt vmcnt(0)" ::: "memory");
    __syncthreads();
    if (threadIdx.x == 0) {
        unsigned* bar = b.bar;
        __builtin_amdgcn_s_waitcnt(0);
        unsigned nloc = b.st[0], nx = b.st[1];
        if (nloc == 0u) { xcd_barrier_complete(bar, b.x, nloc, nx); b.st[0] = nloc; b.st[1] = nx; }
        const unsigned old = xb_add(&bar[XB_XSUB(b.x)], 1u);
        const unsigned gen = old / nloc;
        if (old + 1u == (gen + 1u) * nloc) {
            __builtin_amdgcn_fence(__ATOMIC_RELEASE, "agent");
            asm volatile("s_waitcnt vmcnt(0)" ::: "memory");
            const unsigned og = xb_add(&bar[XB_TOP], 1u);
            const unsigned tg = og / nx;
            if (og + 1u == (tg + 1u) * nx) xb_add(&bar[XB_TOPGEN], 1u);
            else XB_SPIN(xb_ld(&bar[XB_TOPGEN]) == tg, bar);
            __builtin_amdgcn_fence(__ATOMIC_ACQUIRE, "agent");
            xb_add(&bar[XB_XGEN(b.x)], 1u);
            asm volatile("s_waitcnt vmcnt(0)" ::: "memory");
        } else {
            XB_SPIN(xb_ld(&bar[XB_XGEN(b.x)]) == gen, bar);
            __builtin_amdgcn_fence(__ATOMIC_ACQUIRE, "agent");
            asm volatile("s_waitcnt vmcnt(0)" ::: "memory");
        }
    }
    __syncthreads();
}
typedef unsigned u32x2v __attribute__((ext_vector_type(2)));
typedef float f32x2v __attribute__((ext_vector_type(2)));

constexpr int MP = 16384, MROWS = 16640, DMODEL = 1024, DFF = 2816, NBLK64 = MROWS / 64;
constexpr float RMS_EPS = 1e-6f;
constexpr size_t OFF_Y = 0, OFF_WKP = (size_t)MROWS * 1024, OFF_WVP = OFF_WKP + 65536, OFF_SRP = OFF_WVP + 65536, OFF_SIP = OFF_SRP + 8192,
    OFF_CMP = OFF_SIP + 8192, OFF_CFP = OFF_CMP + 8192, OFF_MKP = OFF_CFP + 45056, OFF_MVP = OFF_MKP + 2097152, OFF_WKS = OFF_MVP + 2097152,
    OFF_WVS = OFF_WKS + 32768, OFF_SRS = OFF_WVS + 32768, OFF_SIS = OFF_SRS + 16384, OFF_CMS = OFF_SIS + 16384, OFF_CFS = OFF_CMS + 16384;
constexpr size_t MiB = 1u << 20;
constexpr size_t WS_ROWSS = 0, WS_BAR = 512 * 1024, CTL_ZERO_BYTES = 1 * MiB;
constexpr size_t WS_ROPE = 1 * MiB, WS_SSM = 2 * MiB, WS_CKV = 3 * MiB, WS_SLOC = 4 * MiB, WS_MEMK = 8 * MiB, WS_MEMVT = 20 * MiB, WS_SIDE = 32 * MiB;
constexpr size_t SG_BYTES = (size_t)NBLK64 * 8 * DFF * 4, SV_BYTES = (size_t)NBLK64 * 4 * DFF * 4;
static_assert(WS_SIDE + SG_BYTES + SV_BYTES <= 66 * MiB, "side buffers");
constexpr size_t WS_WT = 66 * MiB, WS_XB = 128 * MiB, WS_TMP = 161 * MiB;
constexpr size_t WT_INEVEN = 0, WT_GLU = WT_INEVEN + 1280 * 1024, WT_OUTEVEN = WT_GLU + 512 * 512, WT_WQ = WT_OUTEVEN + 1024 * 1024, WT_WKV = WT_WQ + 2 * 1024 * 1024,
    WT_WO = WT_WKV + 2 * 2048 * 1024, WT_UP = WT_WO + 2 * 1024 * 1024, WT_DOWN = WT_UP + (size_t)2 * 5632 * 1024, WT_INODD = WT_DOWN + (size_t)2 * 2816 * 1024,
    WT_OUTODD = WT_INODD + 3072 * 1024, WT_END = WT_OUTODD + 1024 * 1024;
static_assert(WS_WT + WT_END * 2 <= WS_XB, "weights");
static_assert(WS_XB + (size_t)MROWS * 1024 * 2 <= WS_TMP, "xb");
constexpr size_t TMP_BYTES = (size_t)MROWS * DFF * 2;
constexpr size_t WS_PART = 251 * MiB, PART_ELEMS = (size_t)MROWS * 16;
static_assert(WS_PART + 2 * PART_ELEMS * 4 <= 256 * MiB, "part");
static_assert(WS_TMP + TMP_BYTES <= 256 * MiB, "ws");
constexpr size_t TMP_PROJ0 = 0, TMP_GBUF = (size_t)MROWS * 1280 * 2, TMP_YCAT = TMP_GBUF + (size_t)MROWS * 512 * 2, TMP_MEMB = TMP_YCAT;
static_assert(TMP_YCAT + (size_t)MROWS * 1024 * 2 <= TMP_BYTES, "tmp");
constexpr size_t TMP_QX = 0, TMP_OX = (size_t)MROWS * 1024 * 2, TMP_ACT = 0, TMP_GB = 0, TMP_ZC = (size_t)MROWS * 1024 * 2;
constexpr int LDS_BYTES = 147456, MISC_OFF = 147456 - 512;
constexpr int NPH = 22;

#define MFMA16(a, b, c) __builtin_amdgcn_mfma_f32_16x16x32_bf16(a, b, c, 0, 0, 0)
__device__ __forceinline__ float bflo(unsigned w) { return __uint_as_float(w << 16); }
__device__ __forceinline__ float bfhi(unsigned w) { return __uint_as_float(w & 0xffff0000u); }
__device__ __forceinline__ v4u pack8(f32x4 a, f32x4 b) { v4u w; w.x = pg8::cvt_pk_bf16(a[0], a[1]); w.y = pg8::cvt_pk_bf16(a[2], a[3]); w.z = pg8::cvt_pk_bf16(b[0], b[1]); w.w = pg8::cvt_pk_bf16(b[2], b[3]); return w; }
__device__ __forceinline__ float rstd_of(const float* part, int row) { const f32x4* p = (const f32x4*)(part + (size_t)row * 16); const f32x4 a = p[0] + p[1] + p[2] + p[3]; return rsqrtf(((a[0] + a[1]) + (a[2] + a[3])) * (1.0f / 1024.0f) + RMS_EPS); }
__device__ __forceinline__ float sigmoidf_(float x) { return 1.0f / (1.0f + __expf(-x)); }
__device__ __forceinline__ float dpp_ror1(float v) { return __builtin_bit_cast(float, __builtin_amdgcn_update_dpp(0, __builtin_bit_cast(int, v), 0x121, 0xf, 0xf, false)); }
__device__ __forceinline__ float dpp_ror2(float v) { return __builtin_bit_cast(float, __builtin_amdgcn_update_dpp(0, __builtin_bit_cast(int, v), 0x122, 0xf, 0xf, false)); }
__device__ __forceinline__ float wave_sum(float v) {
#pragma unroll
    for (int o = 1; o < 64; o <<= 1) v += __shfl_xor(v, o);
    return v;
}

typedef pg8::Unit Unit;
#define EPI_ARGS const f32x4 (&acc)[2][2][4][2], const Unit& u, int wr, int wc, int fr, int fq

struct EpiBf16 {
    static constexpr bool PERM = true, AFTER_DRAIN = false;
    bf16* O; int ldc; const float* rowss;
    __device__ __forceinline__ void operator()(EPI_ARGS) const {
        const int row0 = u.pm * 256 + wr * 64 + fr, col0 = u.pn * 256 + wc * 32 + 8 * fq;
#pragma unroll
        for (int ai = 0; ai < 2; ++ai)
#pragma unroll
            for (int m = 0; m < 4; ++m) { const int row = row0 + ai * 128 + m * 16; const float rs = rstd_of(rowss, row); bf16* rp = O + (size_t)row * ldc + col0;
#pragma unroll
                for (int bj = 0; bj < 2; ++bj) *(v4u*)(rp + bj * 128) = pack8(acc[ai][bj][m][0] * rs, acc[ai][bj][m][1] * rs); }
    }
};
struct EpiRes {
    static constexpr bool PERM = true, AFTER_DRAIN = false;
    const float* base_p; const float* base_s; bf16* xb; float* rowss_next; int f32base;
    __device__ __forceinline__ void operator()(EPI_ARGS) const {
        const float* base = u.pm < 64 ? base_p : base_s;
        const int row0 = u.pm * 256 + wr * 64 + fr, col0 = u.pn * 256 + wc * 32 + 8 * fq;
#pragma unroll
        for (int ai = 0; ai < 2; ++ai)
#pragma unroll
            for (int m = 0; m < 4; ++m) { const int row = row0 + ai * 128 + m * 16; const size_t off = (size_t)row * 1024 + col0; float ss = 0.f;
#pragma unroll
                for (int bj = 0; bj < 2; ++bj) { f32x4 b0, b1;
                    if (f32base) { b0 = *(const f32x4*)(base + off + bj * 128); b1 = *(const f32x4*)(base + off + bj * 128 + 4); }
                    else { const v4u w = *(const v4u*)(xb + off + bj * 128); b0 = (f32x4){bflo(w.x), bfhi(w.x), bflo(w.y), bfhi(w.y)}; b1 = (f32x4){bflo(w.z), bfhi(w.z), bflo(w.w), bfhi(w.w)}; }
                    const f32x4 v0 = acc[ai][bj][m][0] + b0, v1 = acc[ai][bj][m][1] + b1;
                    *(v4u*)(xb + off + bj * 128) = pack8(v0, v1);
                    ss += (v0[0] * v0[0] + v0[1] * v0[1]) + (v0[2] * v0[2] + v0[3] * v0[3]) + (v1[0] * v1[0] + v1[1] * v1[1]) + (v1[2] * v1[2] + v1[3] * v1[3]); }
                ss += __shfl_xor(ss, 16); ss += __shfl_xor(ss, 32);
                if (fq == 0) rowss_next[(size_t)row * 16 + u.pn * 4 + wc] = ss; }
    }
};
struct EpiGlu {
    static constexpr bool PERM = true, AFTER_DRAIN = false;
    const bf16* g; bf16* ycat;
    __device__ __forceinline__ void operator()(EPI_ARGS) const {
        const int row0 = u.pm * 256 + wr * 64 + fr, col0 = u.pn * 256 + wc * 32 + 8 * fq;
#pragma unroll
        for (int ai = 0; ai < 2; ++ai)
#pragma unroll
            for (int m = 0; m < 4; ++m) { const int row = row0 + ai * 128 + m * 16;
#pragma unroll
                for (int bj = 0; bj < 2; ++bj) { const int col = col0 + bj * 128; const v4u gw = *(const v4u*)(g + (size_t)row * 512 + col);
                    const f32x4 a0 = acc[ai][bj][m][0], a1 = acc[ai][bj][m][1]; f32x4 o0, o1;
                    o0[0] = bflo(gw.x) * sigmoidf_(a0[0]); o0[1] = bfhi(gw.x) * sigmoidf_(a0[1]); o0[2] = bflo(gw.y) * sigmoidf_(a0[2]); o0[3] = bfhi(gw.y) * sigmoidf_(a0[3]);
                    o1[0] = bflo(gw.z) * sigmoidf_(a1[0]); o1[1] = bfhi(gw.z) * sigmoidf_(a1[1]); o1[2] = bflo(gw.w) * sigmoidf_(a1[2]); o1[3] = bfhi(gw.w) * sigmoidf_(a1[3]);
                    *(v4u*)(ycat + (size_t)row * 1024 + col) = pack8(o0, o1); } }
    }
};
struct EpiKV {
    static constexpr bool PERM = true, AFTER_DRAIN = false;
    float* out; bf16* memk;
    __device__ __forceinline__ void operator()(EPI_ARGS) const {
        const int row0 = u.pm * 256 + wr * 64 + fr, col0 = u.pn * 256 + wc * 32 + 8 * fq;
#pragma unroll
        for (int ai = 0; ai < 2; ++ai)
#pragma unroll
            for (int m = 0; m < 4; ++m) { const int row = row0 + ai * 128 + m * 16;
#pragma unroll
                for (int bj = 0; bj < 2; ++bj) { const int c = col0 + bj * 128, l = c >> 11, e = c & 2047, isv = e >> 10, dc = e & 1023;
                    float* op = out + (isv ? OFF_MVP : OFF_MKP) + (size_t)l * 1048576 + (size_t)row * 1024 + dc;
                    *(f32x4*)op = acc[ai][bj][m][0]; *(f32x4*)(op + 4) = acc[ai][bj][m][1];
                    if (!isv) *(v4u*)(memk + (size_t)l * 12 * 262144 + (size_t)row * 1024 + dc) = pack8(acc[ai][bj][m][0], acc[ai][bj][m][1]); } }
    }
};
struct EpiIn0 {
    static constexpr bool PERM = true, AFTER_DRAIN = false;
    bf16* proj; const float* rowss; const float* ropec; const float* ropes; float* out;
    __device__ __forceinline__ void operator()(EPI_ARGS) const {
        const int pn = u.pn;
#pragma unroll
        for (int ai = 0; ai < 2; ++ai)
#pragma unroll
            for (int m = 0; m < 4; ++m) { const int row = u.pm * 256 + ai * 128 + wr * 64 + m * 16 + fr; const float rs = rstd_of(rowss, row);
                const int pos = row < MP ? (row & 4095) : 2048 + (row & 31);
                bf16* rp = proj + (size_t)row * 1280;
                float* wk = nullptr; float* wv = nullptr;
                if (pn == 4) { if (row >= MP) { wk = out + OFF_WKS + (size_t)(row - MP) * 128; wv = out + OFF_WVS + (size_t)(row - MP) * 128; }
                               else if ((row & 4095) >= 3968) { const size_t o = (size_t)((row >> 12) * 128 + (row & 4095) - 3968) * 128; wk = out + OFF_WKP + o; wv = out + OFF_WVP + o; } }
#pragma unroll
                for (int bj = 0; bj < 2; ++bj) { const f32x4 v0 = acc[ai][bj][m][0] * rs, v1 = acc[ai][bj][m][1] * rs;
                    const bool rope = (pn == 2 || pn == 3 || (pn == 4 && bj == 0));
                    if (!rope) { const int col = pn * 256 + bj * 128 + wc * 32 + 8 * fq; *(v4u*)(rp + col) = pack8(v0, v1);
                        if (pn == 4 && wv) { *(f32x4*)(wv + wc * 32 + 8 * fq) = v0; *(f32x4*)(wv + wc * 32 + 8 * fq + 4) = v1; } }
                    else { const int gbase = pn * 256 + bj * 128 + (wc >> 1) * 64, d1 = 16 * (wc & 1) + 4 * fq;
                        const f32x4 c4 = *(const f32x4*)(ropec + pos * 32 + d1), s4 = *(const f32x4*)(ropes + pos * 32 + d1);
                        f32x4 o1 = v0 * c4 - v1 * s4, o2 = v1 * c4 + v0 * s4;
                        if (pn != 4) { o1 = o1 * 0.125f; o2 = o2 * 0.125f; }
                        u32x2v w1, w2; w1.x = pg8::cvt_pk_bf16(o1[0], o1[1]); w1.y = pg8::cvt_pk_bf16(o1[2], o1[3]); w2.x = pg8::cvt_pk_bf16(o2[0], o2[1]); w2.y = pg8::cvt_pk_bf16(o2[2], o2[3]);
                        *(u32x2v*)(rp + gbase + d1) = w1; *(u32x2v*)(rp + gbase + d1 + 32) = w2;
                        if (pn == 4 && wk) { const int cc = (wc >> 1) * 64 + d1; *(f32x4*)(wk + cc) = o1; *(f32x4*)(wk + cc + 32) = o2; } } } }
    }
};
struct EpiFfnUp {
    static constexpr bool PERM = true, AFTER_DRAIN = false;
    bf16* act; const float* rowss; const float* cw; float* SG; float* SV;
    __device__ __forceinline__ void operator()(EPI_ARGS) const {
        const int c0 = u.pn * 128 + wc * 32 + 8 * fq; const bool sample = u.pm == 64;
        const f32x4 w0a = *(const f32x4*)(cw + c0), w0b = *(const f32x4*)(cw + c0 + 4), w1a = *(const f32x4*)(cw + DFF + c0), w1b = *(const f32x4*)(cw + DFF + c0 + 4),
                    w2a = *(const f32x4*)(cw + 2 * DFF + c0), w2b = *(const f32x4*)(cw + 2 * DFF + c0 + 4);
#pragma unroll
        for (int ai = 0; ai < 2; ++ai) { f32x4 gp0 = {0.f, 0.f, 0.f, 0.f}, gp1 = {0.f, 0.f, 0.f, 0.f}; const int blk = u.pm * 4 + ai * 2 + wr;
#pragma unroll
            for (int m = 0; m < 4; ++m) { const int row = u.pm * 256 + ai * 128 + wr * 64 + m * 16 + fr; const float rs = rstd_of(rowss, row);
                const f32x4 g0 = acc[ai][0][m][0] * rs, g1 = acc[ai][0][m][1] * rs, v0 = acc[ai][1][m][0] * rs, v1 = acc[ai][1][m][1] * rs;
                f32x4 a0, a1;
#pragma unroll
                for (int j = 0; j < 4; ++j) {
                    const float r1pa = dpp_ror1(gp0[j]), r1ca = dpp_ror1(g0[j]), r2pa = dpp_ror2(gp0[j]), r2ca = dpp_ror2(g0[j]);
                    const float r1pb = dpp_ror1(gp1[j]), r1cb = dpp_ror1(g1[j]), r2pb = dpp_ror2(gp1[j]), r2cb = dpp_ror2(g1[j]);
                    const float p1a = fr == 0 ? r1pa : r1ca, p2a = fr < 2 ? r2pa : r2ca;
                    const float p1b = fr == 0 ? r1pb : r1cb, p2b = fr < 2 ? r2pb : r2cb;
                    const float ca = w0a[j] * p2a + w1a[j] * p1a + w2a[j] * g0[j], cb = w0b[j] * p2b + w1b[j] * p1b + w2b[j] * g1[j];
                    a0[j] = ca * sigmoidf_(ca) * v0[j]; a1[j] = cb * sigmoidf_(cb) * v1[j]; }
                const bool valid = (m > 0 || fr >= 2) && !(sample && m == 2 && fr < 2);
                if (valid) *(v4u*)(act + (size_t)row * DFF + c0) = pack8(a0, a1);
                if ((m & 1) == 0 && fr < 2) { float* sg = SG + (size_t)(blk * 8 + 2 * m + fr) * DFF + c0; *(f32x4*)sg = g0; *(f32x4*)(sg + 4) = g1;
                                              float* sv = SV + (size_t)(blk * 4 + m + fr) * DFF + c0; *(f32x4*)sv = v0; *(f32x4*)(sv + 4) = v1; }
                if ((m & 1) == 1 && fr >= 14) { float* sg = SG + (size_t)(blk * 8 + 2 * m + fr - 14) * DFF + c0; *(f32x4*)sg = g0; *(f32x4*)(sg + 4) = g1; }
                gp0 = g0; gp1 = g1; } }
    }
};
struct EpiInOdd {
    static constexpr bool PERM = true, AFTER_DRAIN = false;
    bf16* gb; bf16* zc; const float* rowss; const float* cw; float* SG;
    __device__ __forceinline__ void operator()(EPI_ARGS) const {
        if (u.pn < 4) {
            const int row0 = u.pm * 256 + wr * 64 + fr, col0 = u.pn * 256 + wc * 32 + 8 * fq;
#pragma unroll
            for (int ai = 0; ai < 2; ++ai)
#pragma unroll
                for (int m = 0; m < 4; ++m) { const int row = row0 + ai * 128 + m * 16; const float rs = rstd_of(rowss, row); bf16* rp = gb + (size_t)row * 1024 + col0;
#pragma unroll
                    for (int bj = 0; bj < 2; ++bj) *(v4u*)(rp + bj * 128) = pack8(acc[ai][bj][m][0] * rs, acc[ai][bj][m][1] * rs); }
            return;
        }
        const int c0 = (u.pn - 4) * 128 + wc * 32 + 8 * fq; const bool sample = u.pm == 64;
        const f32x4 w0a = *(const f32x4*)(cw + c0), w0b = *(const f32x4*)(cw + c0 + 4), w1a = *(const f32x4*)(cw + 1024 + c0), w1b = *(const f32x4*)(cw + 1024 + c0 + 4),
                    w2a = *(const f32x4*)(cw + 2048 + c0), w2b = *(const f32x4*)(cw + 2048 + c0 + 4);
#pragma unroll
        for (int ai = 0; ai < 2; ++ai) { f32x4 gp0 = {0.f, 0.f, 0.f, 0.f}, gp1 = {0.f, 0.f, 0.f, 0.f}; const int blk = u.pm * 4 + ai * 2 + wr;
#pragma unroll
            for (int m = 0; m < 4; ++m) { const int row = u.pm * 256 + ai * 128 + wr * 64 + m * 16 + fr; const float rs = rstd_of(rowss, row); const float rs2 = rs * rs;
                const f32x4 g0 = acc[ai][0][m][0] * acc[ai][1][m][0] * rs2, g1 = acc[ai][0][m][1] * acc[ai][1][m][1] * rs2;
                f32x4 a0, a1;
#pragma unroll
                for (int j = 0; j < 4; ++j) {
                    const float r1pa = dpp_ror1(gp0[j]), r1ca = dpp_ror1(g0[j]), r2pa = dpp_ror2(gp0[j]), r2ca = dpp_ror2(g0[j]);
                    const float r1pb = dpp_ror1(gp1[j]), r1cb = dpp_ror1(g1[j]), r2pb = dpp_ror2(gp1[j]), r2cb = dpp_ror2(g1[j]);
                    const float p1a = fr == 0 ? r1pa : r1ca, p2a = fr < 2 ? r2pa : r2ca;
                    const float p1b = fr == 0 ? r1pb : r1cb, p2b = fr < 2 ? r2pb : r2cb;
                    a0[j] = w0a[j] * p2a + w1a[j] * p1a + w2a[j] * g0[j]; a1[j] = w0b[j] * p2b + w1b[j] * p1b + w2b[j] * g1[j]; }
                const bool valid = (m > 0 || fr >= 2) && !(sample && m == 2 && fr < 2);
                if (valid) *(v4u*)(zc + (size_t)row * 1024 + c0) = pack8(a0, a1);
                if ((m & 1) == 0 && fr < 2) { float* sg = SG + (size_t)(blk * 8 + 2 * m + fr) * 1024 + c0; *(f32x4*)sg = g0; *(f32x4*)(sg + 4) = g1; }
                if ((m & 1) == 1 && fr >= 14) { float* sg = SG + (size_t)(blk * 8 + 2 * m + fr - 14) * 1024 + c0; *(f32x4*)sg = g0; *(f32x4*)(sg + 4) = g1; }
                gp0 = g0; gp1 = g1; } }
    }
};

__device__ __forceinline__ int rowmap(int mode, int n) {
    if (mode == 1) { if (n >= 512 && n < 1152) { const int d = n & 63; return (n & ~63) | (32 * ((d >> 4) & 1) + 8 * ((d >> 2) & 3) + 4 * (d >> 5) + (d & 3)); } return n; }
    if (mode == 2) { return n < DFF ? ((n >> 7) * 256 + (n & 127)) : (((n - DFF) >> 7) * 256 + 128 + ((n - DFF) & 127)); }
    if (mode == 3) { if (n < 1024) return n; const int c = (n - 1024) & 1023, z = n >= 2048 ? 1 : 0; return 1024 + (c >> 7) * 256 + z * 128 + (c & 127); }
    return n;
}
__device__ __forceinline__ void tr_item(const float* W, int K, int N, bf16* WT, const float* gain, float scale, int mode, LAS float* scr, int item, int lane) {
    const int nblk = N / 32, kb = item / nblk, nb = item % nblk, k0 = 64 * kb, n0 = 32 * nb;
#pragma unroll
    for (int i = 0; i < 8; ++i) { const int idx = lane + 64 * i, kk = idx >> 3, n4 = (idx & 7) * 4; const float gs = gain ? gain[k0 + kk] * scale : scale;
        const f32x4 w = *(const f32x4*)(W + (size_t)(k0 + kk) * N + n0 + n4); LAS float* d = scr + kk * 33 + n4; d[0] = w[0] * gs; d[1] = w[1] * gs; d[2] = w[2] * gs; d[3] = w[3] * gs; }
    LDS_WAIT(); asm volatile("" ::: "memory");
    const int c = lane & 7;
#pragma unroll
    for (int j = 0; j < 4; ++j) { const int n = (lane >> 3) + 8 * j; const LAS float* s = scr + (8 * c) * 33 + n;
        v4u o; o.x = pg8::cvt_pk_bf16(s[0 * 33], s[1 * 33]); o.y = pg8::cvt_pk_bf16(s[2 * 33], s[3 * 33]); o.z = pg8::cvt_pk_bf16(s[4 * 33], s[5 * 33]); o.w = pg8::cvt_pk_bf16(s[6 * 33], s[7 * 33]);
        *(v4u*)(WT + (size_t)rowmap(mode, n0 + n) * K + k0 + 8 * c) = o; }
    LDS_WAIT(); asm volatile("" ::: "memory");
}
__device__ __forceinline__ double dexp_(double y) {
    const double k = rint(y * 1.4426950408889634); const double r = (y - k * 0.6931471803691238) - k * 1.9082149292705877e-10;
    double p = 1.0 / 6227020800.0;
    p = p * r + 1.0 / 479001600.0; p = p * r + 1.0 / 39916800.0; p = p * r + 1.0 / 3628800.0; p = p * r + 1.0 / 362880.0; p = p * r + 1.0 / 40320.0; p = p * r + 1.0 / 5040.0;
    p = p * r + 1.0 / 720.0; p = p * r + 1.0 / 120.0; p = p * r + 1.0 / 24.0; p = p * r + 1.0 / 6.0; p = p * r + 0.5; p = p * r + 1.0; p = p * r + 1.0;
    const long long bits = (long long)(1023 + (int)k) << 52; return p * __builtin_bit_cast(double, bits);
}
__device__ __forceinline__ void dsincos_(double x, double& s, double& c) {
    const double k = rint(x * 0.6366197723675814); const double r = (x - k * 1.5707963267948966) - k * 6.123233995736766e-17; const double r2 = r * r;
    const double sp = r * (1.0 + r2 * (-1.0 / 6.0 + r2 * (1.0 / 120.0 + r2 * (-1.0 / 5040.0 + r2 * (1.0 / 362880.0 + r2 * (-1.0 / 39916800.0 + r2 * (1.0 / 6227020800.0)))))));
    const double cp = 1.0 + r2 * (-0.5 + r2 * (1.0 / 24.0 + r2 * (-1.0 / 720.0 + r2 * (1.0 / 40320.0 + r2 * (-1.0 / 3628800.0 + r2 * (1.0 / 479001600.0 + r2 * (-1.0 / 87178291200.0)))))));
    const int q = ((int)k) & 3;
    s = q == 0 ? sp : q == 1 ? cp : q == 2 ? -sp : -cp; c = q == 0 ? cp : q == 1 ? -sp : q == 2 ? -cp : sp;
}

__device__ __forceinline__ const bf16* kvptr(const bf16* proj, const bf16* cb, int sample, int b, int c, int kvh, int kk, int isv) {
    if (!sample) { int pos = (c - 2) * 64 + kk; pos = pos < 0 ? 0 : pos; return proj + (size_t)(b * 4096 + pos) * 1280 + 1024 + isv * 128 + kvh * 64; }
    if (kk < 128) return cb + (size_t)(b * 128 + kk) * 128 + kvh * 64;
    int t = kk - 128; t = t > 31 ? 31 : t; return proj + (size_t)(MP + b * 32 + t) * 1280 + 1024 + isv * 128 + kvh * 64;
}
__device__ __forceinline__ void swa_phase(const bf16* proj, const bf16* ckb, const bf16* cvb, const float* sinks, bf16* ycat, LAS unsigned char* lds, int tid, int wave, int lane, int G) {
    LAS bf16* VT = (LAS bf16*)lds;
    const int fr = lane & 15, quad = lane >> 4;
    for (int it = blockIdx.x; it < 528; it += G) {
        int b, c, kvh, sample;
        if (it < 512) { sample = 0; b = it >> 7; c = (it >> 1) & 63; kvh = it & 1; } else { sample = 1; b = (it - 512) >> 1; c = 0; kvh = it & 1; }
        __syncthreads();
#pragma unroll
        for (int i = 0; i < 3; ++i) { const int idx = tid + 512 * i, kk = idx % 192, dg = idx / 192; const v4u w = *(const v4u*)(kvptr(proj, cvb, sample, b, c, kvh, kk, 1) + dg * 8);
            LAS bf16* vp = VT + (dg * 8) * 200 + kk;
            vp[0] = (bf16)(w.x & 0xffffu); vp[200] = (bf16)(w.x >> 16); vp[400] = (bf16)(w.y & 0xffffu); vp[600] = (bf16)(w.y >> 16);
            vp[800] = (bf16)(w.z & 0xffffu); vp[1000] = (bf16)(w.z >> 16); vp[1200] = (bf16)(w.w & 0xffffu); vp[1400] = (bf16)(w.w >> 16); }
        __syncthreads();
        const int gq = wave >> 1, qhalf = wave & 1, head = kvh * 4 + gq;
        if (!(sample && qhalf)) {
            const int plo = sample ? 0 : (c >= 2 ? 0 : (2 - c) * 2), phi = sample ? 5 : 6;
            bf16x8 qf[2][2];
#pragma unroll
            for (int qb = 0; qb < 2; ++qb) { const int q = qhalf * 32 + qb * 16 + fr; const int row = sample ? MP + b * 32 + (q & 31) : b * 4096 + c * 64 + q;
                const bf16* qp = proj + (size_t)row * 1280 + 512 + head * 64 + quad * 8; qf[qb][0] = *(const bf16x8*)qp; qf[qb][1] = *(const bf16x8*)(qp + 32); }
            f32x4 s[12][2];
#pragma unroll
            for (int kb = 0; kb < 12; ++kb) { const int key = 32 * (kb >> 1) + (fr >> 2) * 8 + 4 * (kb & 1) + (fr & 3); const bf16* kp = kvptr(proj, ckb, sample, b, c, kvh, key, 0) + quad * 8;
                const bf16x8 k0 = *(const bf16x8*)kp, k1 = *(const bf16x8*)(kp + 32);
#pragma unroll
                for (int qb = 0; qb < 2; ++qb) { f32x4 a = {0.f, 0.f, 0.f, 0.f}; a = MFMA16(k0, qf[qb][0], a); a = MFMA16(k1, qf[qb][1], a); s[kb][qb] = a; } }
            const float sink = sinks[head];
            bf16x8 pf[6][2];
#pragma unroll
            for (int qb = 0; qb < 2; ++qb) { float mx = sink;
#pragma unroll
                for (int kb = 0; kb < 12; ++kb) { const bool pv = (kb >> 1) >= plo && (kb >> 1) < phi;
#pragma unroll
                    for (int j = 0; j < 4; ++j) { const float v = pv ? s[kb][qb][j] : -1e30f; s[kb][qb][j] = v; mx = fmaxf(mx, v); } }
                mx = fmaxf(mx, __shfl_xor(mx, 16)); mx = fmaxf(mx, __shfl_xor(mx, 32));
                float sum = 0.f;
#pragma unroll
                for (int kb = 0; kb < 12; ++kb)
#pragma unroll
                    for (int j = 0; j < 4; ++j) { const float e = __expf(s[kb][qb][j] - mx); s[kb][qb][j] = e; sum += e; }
                sum += __shfl_xor(sum, 16); sum += __shfl_xor(sum, 32); sum += __expf(sink - mx);
                const float inv = 1.0f / sum;
#pragma unroll
                for (int pr = 0; pr < 6; ++pr) pf[pr][qb] = __builtin_bit_cast(bf16x8, pack8(s[2 * pr][qb] * inv, s[2 * pr + 1][qb] * inv)); }
#pragma unroll
            for (int db = 0; db < 4; ++db) { bf16x8 vf[6];
#pragma unroll
                for (int pr = 0; pr < 6; ++pr) vf[pr] = *(const LAS bf16x8*)(VT + (db * 16 + fr) * 200 + 32 * pr + quad * 8);
#pragma unroll
                for (int qb = 0; qb < 2; ++qb) { f32x4 o = {0.f, 0.f, 0.f, 0.f};
#pragma unroll
                    for (int pr = 0; pr < 6; ++pr) o = MFMA16(pf[pr][qb], vf[pr], o);
#pragma unroll
                    for (int j = 0; j < 4; ++j) { const int q = qhalf * 32 + qb * 16 + quad * 4 + j;
                        if (!sample || q < 32) { const int row = sample ? MP + b * 32 + q : b * 4096 + c * 64 + q; ycat[(size_t)row * 1024 + 512 + head * 64 + db * 16 + fr] = (bf16)f2bf(o[j]); } } } }
        }
    }
    __syncthreads();
}

__device__ __forceinline__ void xattn_phase(const bf16* qx, const bf16* memk_l, const bf16* memvT_l, bf16* ox, int wave, int lane, int G) {
    const int fr = lane & 15, quad = lane >> 4;
    for (int t = wave * G + (int)blockIdx.x; t < 4160; t += 8 * G) {
        int bb, h, row0;
        if (t < 4096) { const int pair = t >> 8; bb = pair >> 2; h = pair & 3; row0 = bb * 4096 + (t & 255) * 16; }
        else { const int s = t - 4096, b = s >> 3; h = (s >> 1) & 3; bb = 4 + b; row0 = MP + b * 32 + (s & 1) * 16; }
        bf16x8 qf[8];
#pragma unroll
        for (int ks = 0; ks < 8; ++ks) qf[ks] = *(const bf16x8*)(qx + (size_t)(row0 + fr) * 1024 + h * 256 + ks * 32 + quad * 8);
        const bf16* kbase = memk_l + (size_t)bb * 262144 + h * 256 + quad * 8;
        f32x4 s[16];
#pragma unroll
        for (int kb = 0; kb < 16; ++kb) { const int key = 32 * (kb >> 1) + (fr >> 2) * 8 + 4 * (kb & 1) + (fr & 3); const bf16* kp = kbase + (size_t)key * 1024; f32x4 a = {0.f, 0.f, 0.f, 0.f};
#pragma unroll
            for (int ks = 0; ks < 8; ++ks) a = MFMA16(*(const bf16x8*)(kp + ks * 32), qf[ks], a);
            s[kb] = a; }
        float mx = -1e30f;
#pragma unroll
        for (int kb = 0; kb < 16; ++kb)
#pragma unroll
            for (int j = 0; j < 4; ++j) mx = fmaxf(mx, s[kb][j]);
        mx = fmaxf(mx, __shfl_xor(mx, 16)); mx = fmaxf(mx, __shfl_xor(mx, 32));
        float sum = 0.f;
#pragma unroll
        for (int kb = 0; kb < 16; ++kb)
#pragma unroll
            for (int j = 0; j < 4; ++j) { const float e = __expf(s[kb][j] - mx); s[kb][j] = e; sum += e; }
        sum += __shfl_xor(sum, 16); sum += __shfl_xor(sum, 32);
        const float inv = 1.0f / sum;
        bf16x8 pf[8];
#pragma unroll
        for (int pr = 0; pr < 8; ++pr) pf[pr] = __builtin_bit_cast(bf16x8, pack8(s[2 * pr] * inv, s[2 * pr + 1] * inv));
        const bf16* vbase = memvT_l + (size_t)bb * 262144 + (size_t)(h * 256 + fr) * 256 + quad * 8;
#pragma unroll 4
        for (int db = 0; db < 16; ++db) { f32x4 o = {0.f, 0.f, 0.f, 0.f};
#pragma unroll
            for (int pr = 0; pr < 8; ++pr) o = MFMA16(pf[pr], *(const bf16x8*)(vbase + (size_t)db * 4096 + pr * 32), o);
#pragma unroll
            for (int j = 0; j < 4; ++j) ox[(size_t)(row0 + quad * 4 + j) * 1024 + h * 256 + db * 16 + fr] = (bf16)f2bf(o[j]); }
    }
}


__device__ __forceinline__ void xstage(const bf16* src, size_t rowstride, LAS unsigned char* lds, int tid) {
    v4u t[16];
#pragma unroll
    for (int i = 0; i < 16; ++i) { const int row = (tid >> 5) + 16 * i, ch = tid & 31; t[i] = *(const GAS v4u*)((const GAS bf16*)src + (size_t)row * rowstride + ch * 8); }
#pragma unroll
    for (int i = 0; i < 16; ++i) { const int row = (tid >> 5) + 16 * i, ch = tid & 31; *(LAS v4u*)(lds + row * 528 + ch * 16) = t[i]; }
}
__device__ __forceinline__ void xattn_phase2(const bf16* qx, const bf16* memk_l, const bf16* memvT_l, bf16* ox, LAS unsigned char* lds, int tid, int wave, int lane, int G) {
    const int fr = lane & 15, quad = lane >> 4;
    for (int it = blockIdx.x; it < 256 + 32; it += G) {
        int bb, h, rowbase, nqb; bool active;
        if (it < 256) { bb = it >> 6; h = (it >> 4) & 3; rowbase = bb * 4096 + (it & 15) * 256; nqb = 2; active = true; }
        else { const int s = it - 256, b = s >> 2; h = s & 3; bb = 4 + b; rowbase = MP + b * 32; nqb = 1; active = wave < 2; }
        __syncthreads();
        xstage(memk_l + (size_t)bb * 262144 + h * 256, 1024, lds, tid);
        __syncthreads();
        bf16x8 pf[2][8];
#pragma unroll
        for (int qi = 0; qi < 2; ++qi) {
            if (qi < nqb && active) {
                const int row0 = rowbase + qi * 128 + wave * 16;
                bf16x8 qf[8];
#pragma unroll
                for (int ks = 0; ks < 8; ++ks) qf[ks] = *(const GAS bf16x8*)((const GAS bf16*)qx + (size_t)(row0 + fr) * 1024 + h * 256 + ks * 32 + quad * 8);
                f32x4 s[16];
#pragma unroll
                for (int kb = 0; kb < 16; ++kb) { const int key = 32 * (kb >> 1) + (fr >> 2) * 8 + 4 * (kb & 1) + (fr & 3); const LAS unsigned char* kp = lds + key * 528 + quad * 16; f32x4 a = {0.f, 0.f, 0.f, 0.f};
#pragma unroll
                    for (int ks = 0; ks < 8; ++ks) a = MFMA16(*(const LAS bf16x8*)(kp + ks * 64), qf[ks], a);
                    s[kb] = a; }
                float mx = -1e30f;
#pragma unroll
                for (int kb = 0; kb < 16; ++kb)
#pragma unroll
                    for (int j = 0; j < 4; ++j) mx = fmaxf(mx, s[kb][j]);
                mx = fmaxf(mx, __shfl_xor(mx, 16)); mx = fmaxf(mx, __shfl_xor(mx, 32));
                float sum = 0.f;
#pragma unroll
                for (int kb = 0; kb < 16; ++kb)
#pragma unroll
                    for (int j = 0; j < 4; ++j) { const float e = __expf(s[kb][j] - mx); s[kb][j] = e; sum += e; }
                sum += __shfl_xor(sum, 16); sum += __shfl_xor(sum, 32);
                const float inv = 1.0f / sum;
#pragma unroll
                for (int pr = 0; pr < 8; ++pr) pf[qi][pr] = __builtin_bit_cast(bf16x8, pack8(s[2 * pr] * inv, s[2 * pr + 1] * inv));
            }
        }
        __syncthreads();
        xstage(memvT_l + (size_t)bb * 262144 + (size_t)h * 65536, 256, lds, tid);
        __syncthreads();
#pragma unroll
        for (int qi = 0; qi < 2; ++qi) {
            if (qi < nqb && active) {
                const int row0 = rowbase + qi * 128 + wave * 16;
#pragma unroll 4
                for (int db = 0; db < 16; ++db) { f32x4 o = {0.f, 0.f, 0.f, 0.f}; const LAS unsigned char* vp = lds + (db * 16 + fr) * 528 + quad * 16;
#pragma unroll
                    for (int pr = 0; pr < 8; ++pr) o = MFMA16(*(const LAS bf16x8*)(vp + pr * 64), pf[qi][pr], o);
                    u32x2v w; w.x = pk2(o[0], o[1]); w.y = pk2(o[2], o[3]);
                    *(GAS u32x2v*)((GAS bf16*)ox + (size_t)(row0 + fr) * 1024 + h * 256 + db * 16 + quad * 4) = w; }
            }
        }
    }
    __syncthreads();
}

__device__ __forceinline__ void s5_stage_u(const bf16* up, LAS float* ubuf, int lane) {
    const v4u w0 = *(const v4u*)up, w1 = *(const v4u*)(up + 8);
    LAS f32x4* d = (LAS f32x4*)(ubuf + lane * 16);
    d[0] = (f32x4){bflo(w0.x), bfhi(w0.x), bflo(w0.y), bfhi(w0.y)}; d[1] = (f32x4){bflo(w0.z), bfhi(w0.z), bflo(w0.w), bfhi(w0.w)};
    d[2] = (f32x4){bflo(w1.x), bfhi(w1.x), bflo(w1.y), bfhi(w1.y)}; d[3] = (f32x4){bflo(w1.z), bfhi(w1.z), bflo(w1.w), bfhi(w1.w)};
}
__device__ __forceinline__ f32x2v lo2_(f32x4 v) { return __builtin_shufflevector(v, v, 0, 1); }
__device__ __forceinline__ f32x2v hi2_(f32x4 v) { return __builtin_shufflevector(v, v, 2, 3); }
#define S5_STEP(sidx) do { const LAS f32x4* up_ = (const LAS f32x4*)(ubuf + (sidx) * 16); const f32x4 u0 = up_[0], u1 = up_[1], u2 = up_[2], u3 = up_[3]; \
    f32x2v ac_ = lo2_(bb[0]) * u0[0]; ac_ = hi2_(bb[0]) * u0[1] + ac_; ac_ = lo2_(bb[1]) * u0[2] + ac_; ac_ = hi2_(bb[1]) * u0[3] + ac_; \
    ac_ = lo2_(bb[2]) * u1[0] + ac_; ac_ = hi2_(bb[2]) * u1[1] + ac_; ac_ = lo2_(bb[3]) * u1[2] + ac_; ac_ = hi2_(bb[3]) * u1[3] + ac_; \
    ac_ = lo2_(bb[4]) * u2[0] + ac_; ac_ = hi2_(bb[4]) * u2[1] + ac_; ac_ = lo2_(bb[5]) * u2[2] + ac_; ac_ = hi2_(bb[5]) * u2[3] + ac_; \
    ac_ = lo2_(bb[6]) * u3[0] + ac_; ac_ = hi2_(bb[6]) * u3[1] + ac_; ac_ = lo2_(bb[7]) * u3[2] + ac_; ac_ = hi2_(bb[7]) * u3[3] + ac_; \
    const float nr_ = ar * hr - ai * hi + ac_.x, ni_ = ar * hi + ai * hr + ac_.y; hr = nr_; hi = ni_; } while (0)

__device__ __forceinline__ void s5_local(const bf16* proj, const float* abar, const float* bbar, float* sloc, LAS float* ubuf, int slot, int nslots, int lane) {
    for (int t = slot; t < 8192; t += nslots) {
        const int chunk = t & 63, g = (t >> 6) & 31, b = t >> 11;
        s5_stage_u(proj + (size_t)(b * 4096 + chunk * 64 + lane) * 1280 + g * 16, ubuf, lane);
        const float ar = abar[(g * 64 + lane) * 2], ai = abar[(g * 64 + lane) * 2 + 1];
        f32x4 bb[8];
#pragma unroll
        for (int i = 0; i < 8; ++i) bb[i] = *(const f32x4*)(bbar + (size_t)(g * 64 + lane) * 32 + i * 4);
        float hr = 0.f, hi = 0.f;
#pragma unroll 4
        for (int s = 0; s < 64; ++s) S5_STEP(s);
        *(f32x2v*)(sloc + (size_t)t * 128 + lane * 2) = (f32x2v){hr, hi};
    }
}
__device__ __forceinline__ void s5_out(const bf16* proj, const float* abar, const float* bbar, const float* sloc, const float* st_re, const float* st_im, const float* c_re, const float* c_im,
                                       const float* dcoef, bf16* gbuf, float* out, LAS float* ubuf, LAS unsigned* hbuf, int slot, int nslots, int lane) {
    const int fr = lane & 15, quad = lane >> 4;
    for (int t = slot; t < 8192 + 256; t += nslots) {
        const int sample = t >= 8192; int b, g, chunk, nblk, rowbase;
        if (!sample) { chunk = t & 63; g = (t >> 6) & 31; b = t >> 11; nblk = 4; rowbase = b * 4096 + chunk * 64; } else { const int s = t - 8192; g = s & 31; b = s >> 5; chunk = 0; nblk = 2; rowbase = MP + b * 32; }
        if (lane < nblk * 16) s5_stage_u(proj + (size_t)(rowbase + lane) * 1280 + g * 16, ubuf, lane);
        const float ar = abar[(g * 64 + lane) * 2], ai = abar[(g * 64 + lane) * 2 + 1];
        f32x4 bb[8];
#pragma unroll
        for (int i = 0; i < 8; ++i) bb[i] = *(const f32x4*)(bbar + (size_t)(g * 64 + lane) * 32 + i * 4);
        float hr, hi;
        if (!sample) { float pr = ar, pi = ai;
#pragma unroll
            for (int i = 0; i < 6; ++i) { const float t1 = pr * pr - pi * pi; pi = 2.f * pr * pi; pr = t1; }
            hr = 0.f; hi = 0.f; const float* sp = sloc + (size_t)(t - chunk) * 128 + lane * 2;
#pragma unroll 16
            for (int cc = 0; cc < chunk; ++cc) { const f32x2v sv = *(const f32x2v*)(sp + (size_t)cc * 128); const float nr = pr * hr - pi * hi + sv.x, ni = pr * hi + pi * hr + sv.y; hr = nr; hi = ni; } }
        else { hr = st_re[(b * 32 + g) * 64 + lane]; hi = st_im[(b * 32 + g) * 64 + lane]; }
        bf16x8 cf[4];
#pragma unroll
        for (int ks = 0; ks < 4; ++ks) { const f32x4 cr = *(const f32x4*)(c_re + (size_t)(g * 16 + fr) * 64 + ks * 16 + quad * 4), ci = *(const f32x4*)(c_im + (size_t)(g * 16 + fr) * 64 + ks * 16 + quad * 4);
            v4u w; w.x = pg8::cvt_pk_bf16(cr[0], -ci[0]); w.y = pg8::cvt_pk_bf16(cr[1], -ci[1]); w.z = pg8::cvt_pk_bf16(cr[2], -ci[2]); w.w = pg8::cvt_pk_bf16(cr[3], -ci[3]); cf[ks] = __builtin_bit_cast(bf16x8, w); }
        const float dco = dcoef[g * 16 + fr];
        for (int blk = 0; blk < nblk; ++blk) {
#pragma unroll 4
            for (int s = 0; s < 16; ++s) { S5_STEP(blk * 16 + s); hbuf[s * 68 + lane] = pg8::cvt_pk_bf16(hr, hi); }
            f32x4 y = {0.f, 0.f, 0.f, 0.f};
#pragma unroll
            for (int ks = 0; ks < 4; ++ks) { const bf16x8 a = *(const LAS bf16x8*)(hbuf + fr * 68 + ks * 16 + quad * 4); y = MFMA16(a, cf[ks], y); }
#pragma unroll
            for (int j = 0; j < 4; ++j) { const int s = blk * 16 + quad * 4 + j; const float uu = ubuf[s * 16 + fr]; const float yv = y[j] + dco * uu;
                const float z = 0.7978845608028654f * (yv + 0.044715f * yv * yv * yv); const float th = 1.0f - 2.0f / (1.0f + __expf(2.0f * z)); const float gl = 0.5f * yv * (1.0f + th);
                gbuf[(size_t)(rowbase + s) * 512 + g * 16 + fr] = (bf16)f2bf(gl); }
        }
        if (!sample && chunk == 63) { out[OFF_SRP + (b * 32 + g) * 64 + lane] = hr; out[OFF_SIP + (b * 32 + g) * 64 + lane] = hi; }
        if (sample) { out[OFF_SRS + (b * 32 + g) * 64 + lane] = hr; out[OFF_SIS + (b * 32 + g) * 64 + lane] = hi; }
    }
}

struct Params { const float* in[36]; float* out; unsigned char* ws; int use_cg, pad; };

__global__ void __launch_bounds__(512, 2) mega_fwd(Params P) {
    extern __shared__ __attribute__((aligned(16))) unsigned char lds_raw[];
    LAS unsigned char* lds = (LAS unsigned char*)lds_raw;
    volatile LAS unsigned* MISC = (volatile LAS unsigned*)(lds + MISC_OFF);
    const int G = gridDim.x, NGW = G * 8, NT = G * 512;
    const int wave_s = __builtin_amdgcn_readfirstlane(threadIdx.x >> 6);
    for (int u = threadIdx.x; u < (LDS_BYTES - 131072) / 4; u += 512) ((LAS unsigned*)(lds + 131072))[u] = 0u;
    __syncthreads();
    XcdBarrier bar = xcd_barrier_post((unsigned*)(P.ws + WS_BAR), MISC + 8);
#ifndef STOP_AFTER
#define STOP_AFTER 1000
#endif
    int ph = 0;
#define RUN (ph < STOP_AFTER)
#define FRESH() const int tid = fresh_tid(wave_s), lane = tid & 63, wave = __builtin_amdgcn_readfirstlane(tid >> 6); const int gw = blockIdx.x * 8 + wave, gt = blockIdx.x * 512 + tid; (void)gw; (void)gt; (void)lane; LAS float* wscr = (LAS float*)(lds + 32768 + wave * 12288); (void)wscr;
#define SEAM() do { if (P.use_cg) cg::this_grid().sync(); else xcd_barrier(bar); ++ph; } while (0)

#define part ((float*)(ws + WS_PART))
#define PARTBUF(k) (part + (size_t)((k) & 1) * PART_ELEMS)
#define ropec ((float*)(ws + WS_ROPE))
#define ropes (ropec + 4096 * 32)
#define abar ((float*)(ws + WS_SSM))
#define bbar (abar + 32 * 64 * 2)
#define ckb ((bf16*)(ws + WS_CKV))
#define cvb (ckb + 8 * 128 * 128)
#define sloc ((float*)(ws + WS_SLOC))
#define memk ((bf16*)(ws + WS_MEMK))
#define memvT ((bf16*)(ws + WS_MEMVT))
#define SG ((float*)(ws + WS_SIDE))
#define SV ((float*)(ws + WS_SIDE + SG_BYTES))
#define WT ((bf16*)(ws + WS_WT))
#define xb ((bf16*)(ws + WS_XB))
#define tmp (ws + WS_TMP)
#define proj0 ((bf16*)(tmp + TMP_PROJ0))
#define gbuf ((bf16*)(tmp + TMP_GBUF))
#define ycat ((bf16*)(tmp + TMP_YCAT))
#define memb ((bf16*)(tmp + TMP_MEMB))
#define qx ((bf16*)(tmp + TMP_QX))
#define ox ((bf16*)(tmp + TMP_OX))
#define act ((bf16*)(tmp + TMP_ACT))
#define gbm ((bf16*)(tmp + TMP_GB))
#define zc ((bf16*)(tmp + TMP_ZC))
#define PTRS() unsigned char* ws = P.ws; float* out = P.out; asm volatile("" : "+s"(ws), "+s"(out));
    if (RUN) { PTRS() FRESH()
        {
            constexpr int NITEMS = 640 + 128 + 512 + 2 * 512 + 2 * 1024 + 2 * 512 + 2 * 2816 + 2 * 1408 + 1536 + 512 + 2048;
            for (int it = gw; it < NITEMS; it += NGW) { int r = it;
#define TR(Wp, K_, N_, WTp, gainp, sc, mode) { const int ni_ = ((K_) / 64) * ((N_) / 32); if (r < ni_) { tr_item(Wp, K_, N_, WTp, gainp, sc, mode, wscr, r, lane); continue; } r -= ni_; }
                TR(P.in[15], 1024, 1280, WT + WT_INEVEN, P.in[11], 1.f, 1)
                TR(P.in[25], 512, 512, WT + WT_GLU, nullptr, 1.f, 0)
                TR(P.in[16], 1024, 1024, WT + WT_OUTEVEN, nullptr, 1.f, 0)
                TR(P.in[30], 1024, 1024, WT + WT_WQ, P.in[12], 0.0625f, 0)
                TR(P.in[30] + 1048576, 1024, 1024, WT + WT_WQ + 1048576, P.in[12] + 1024, 0.0625f, 0)
                TR(P.in[31], 1024, 2048, WT + WT_WKV, nullptr, 1.f, 0)
                TR(P.in[31] + 2097152, 1024, 2048, WT + WT_WKV + 2097152, nullptr, 1.f, 0)
                TR(P.in[32], 1024, 1024, WT + WT_WO, nullptr, 1.f, 0)
                TR(P.in[32] + 1048576, 1024, 1024, WT + WT_WO + 1048576, nullptr, 1.f, 0)
                TR(P.in[33], 1024, 5632, WT + WT_UP, P.in[13], 1.f, 2)
                TR(P.in[33] + (size_t)1024 * 5632, 1024, 5632, WT + WT_UP + (size_t)5632 * 1024, P.in[13] + 1024, 1.f, 2)
                TR(P.in[35], 2816, 1024, WT + WT_DOWN, nullptr, 1.f, 0)
                TR(P.in[35] + (size_t)2816 * 1024, 2816, 1024, WT + WT_DOWN + (size_t)2816 * 1024, nullptr, 1.f, 0)
                TR(P.in[27], 1024, 3072, WT + WT_INODD, P.in[11] + 1024, 1.f, 3)
                TR(P.in[29], 1024, 1024, WT + WT_OUTODD, nullptr, 1.f, 0)
                { const int mi = r >> 7, l = mi >> 3, b = mi & 7; tr_item(P.in[10] + (size_t)mi * 262144, 256, 1024, memvT + (size_t)(l * 12 + 4 + b) * 262144, nullptr, 1.f, 0, wscr, r & 127, lane); }
            }
        }
        for (int m = gw; m < MROWS; m += NGW) { const float* xr = m < MP ? P.in[0] + (size_t)m * 1024 : P.in[1] + (size_t)(m - MP) * 1024; float ss = 0.f;
#pragma unroll
            for (int j = 0; j < 4; ++j) { const f32x4 v = *(const f32x4*)(xr + (lane + 64 * j) * 4); ss += (v[0] * v[0] + v[1] * v[1]) + (v[2] * v[2] + v[3] * v[3]);
                u32x2v w; w.x = pg8::cvt_pk_bf16(v[0], v[1]); w.y = pg8::cvt_pk_bf16(v[2], v[3]); *(u32x2v*)(xb + (size_t)m * 1024 + (lane + 64 * j) * 4) = w; }
            ss = wave_sum(ss); if (lane < 16) PARTBUF(0)[(size_t)m * 16 + lane] = lane == 0 ? ss : 0.f; }
        for (int i = gt; i < 262144; i += NT) { const f32x4 v = *(const f32x4*)(P.in[2] + (size_t)i * 4); u32x2v w; w.x = pg8::cvt_pk_bf16(v[0], v[1]); w.y = pg8::cvt_pk_bf16(v[2], v[3]); *(u32x2v*)(memb + (size_t)i * 4) = w; }
        for (int i = gt; i < 1048576; i += NT) { const size_t e = (size_t)i * 4; const int lb = (int)(e >> 18), l = lb >> 3, b = lb & 7; const f32x4 v = *(const f32x4*)(P.in[9] + e);
            u32x2v w; w.x = pg8::cvt_pk_bf16(v[0], v[1]); w.y = pg8::cvt_pk_bf16(v[2], v[3]); *(u32x2v*)(memk + (size_t)(l * 12 + 4 + b) * 262144 + (e & 262143)) = w; }
        for (int i = gt; i < 65536; i += NT) { const int j = i & 32767; const float* src = (i < 32768 ? P.in[3] : P.in[4]) + (size_t)j * 4; bf16* dst = (i < 32768 ? ckb : cvb) + (size_t)j * 4;
            const f32x4 v = *(const f32x4*)src; u32x2v w; w.x = pg8::cvt_pk_bf16(v[0], v[1]); w.y = pg8::cvt_pk_bf16(v[2], v[3]); *(u32x2v*)dst = w; }
        for (int i = gt; i < 4096 * 32; i += NT) { const int pos = i >> 5, d = i & 31; const double inv = dexp_(-(double)d * (9.210340371976184 / 32.0)); double s, c; dsincos_((double)pos * inv, s, c); ropec[i] = (float)c; ropes[i] = (float)s; }
        for (int i = gt; i < 2048; i += NT) { const double are = P.in[17][i], aim = P.in[18][i], dt = dexp_((double)P.in[19][i]); double s, c; dsincos_(aim * dt, s, c); const double mag = dexp_(are * dt);
            const double br = mag * c, bi = mag * s; abar[2 * i] = (float)br; abar[2 * i + 1] = (float)bi;
            const double nr = br - 1.0, ni = bi, den = are * are + aim * aim; const double qr = (nr * are + ni * aim) / den, qi = (ni * are - nr * aim) / den;
#pragma unroll 4
            for (int h = 0; h < 16; ++h) { const double xr = P.in[20][(size_t)i * 16 + h], xi = P.in[21][(size_t)i * 16 + h]; bbar[(size_t)i * 32 + 2 * h] = (float)(qr * xr - qi * xi); bbar[(size_t)i * 32 + 2 * h + 1] = (float)(qr * xi + qi * xr); } }
    }
    SEAM();
    if (RUN) { PTRS()
        if (G < 128 || (int)blockIdx.x >= G - 64) { pg8::Gemm g{memb, WT + WT_WKV, 1024, 4096, 1024}; pg8::StaticOrder S;
            if (G < 128) S.init(1024, 4096, G, (int)blockIdx.x); else S.init(1024, 4096, 64, (int)blockIdx.x - (G - 64)); EpiKV E{out, memk};
          pg8::gemm_phase<EpiKV, pg8::StaticOrder, true, true>(lds, g, S, E, wave_s); }
        { pg8::Gemm g{xb, WT + WT_INEVEN, MROWS, 1280, 1024}; pg8::StaticOrderF S; S.init(MROWS, 1280, G, (int)blockIdx.x); EpiIn0 E{proj0, PARTBUF(0), ropec, ropes, out};
          pg8::gemm_phase<EpiIn0, pg8::StaticOrderF, true, true>(lds, g, S, E, wave_s); }
    }
    SEAM();
    if (RUN) { PTRS() FRESH()
        swa_phase(proj0, ckb, cvb, P.in[26], ycat, lds, tid, wave, lane, G);
        s5_local(proj0, abar, bbar, sloc, wscr, wave * G + (int)blockIdx.x, NGW, lane);
        for (int it = wave * G + (int)blockIdx.x; it < 1024; it += NGW) { const int mi = it >> 7, l = mi >> 2, b = mi & 3;
            tr_item(out + OFF_MVP + (size_t)mi * 262144, 256, 1024, memvT + (size_t)(l * 12 + b) * 262144, nullptr, 1.f, 0, wscr, it & 127, lane); }
    }
    SEAM();
    if (RUN) { PTRS() FRESH() s5_out(proj0, abar, bbar, sloc, P.in[5], P.in[6], P.in[22], P.in[23], P.in[24], gbuf, out, wscr, (LAS unsigned*)(wscr + 1024), wave * G + (int)blockIdx.x, NGW, lane); }
    SEAM();
    if (RUN) { PTRS() pg8::Gemm g{gbuf, WT + WT_GLU, MROWS, 512, 512}; pg8::StaticOrder S; S.init(MROWS, 512, G, (int)blockIdx.x); EpiGlu E{gbuf, ycat};
        pg8::gemm_phase<EpiGlu, pg8::StaticOrder, true, true>(lds, g, S, E, wave_s); }
    SEAM();

#pragma unroll
    for (int l = 0; l < 2; ++l) {
        if (l == 1) {
            if (RUN) { PTRS() pg8::Gemm g{xb, WT + WT_INODD, MROWS, 3072, 1024}; pg8::StaticOrderF S; S.init(MROWS, 3072, G, (int)blockIdx.x); EpiInOdd E{gbm, zc, PARTBUF(3), P.in[28], SG};
                pg8::gemm_phase<EpiInOdd, pg8::StaticOrderF, true, true>(lds, g, S, E, wave_s); }
            SEAM();
            if (RUN) { PTRS() FRESH()
                const float* cw = P.in[28]; const float* st = P.in[7];
                for (int i = gt; i < MROWS * 128; i += NT) { const int row = i >> 7, c0 = (i & 127) * 8, blk = row >> 6, r = row & 63;
                    const bool smp = row >= MP; const int rr = smp ? (r & 31) : r;
                    f32x4 z0, z1;
                    if (rr < 2) { const int sb = smp ? (r >> 5) * 4 : 0;
                        f32x4 pa0, pa1, pb0, pb1;
                        if (smp) { const int b = (blk - 256) * 2 + (r >> 5); const float* s0 = st + (size_t)(b * 2) * 1024 + c0; pa0 = *(const f32x4*)s0; pa1 = *(const f32x4*)(s0 + 4); pb0 = *(const f32x4*)(s0 + 1024); pb1 = *(const f32x4*)(s0 + 1028); }
                        else if ((blk & 63) == 0) { pa0 = pa1 = pb0 = pb1 = (f32x4){0.f, 0.f, 0.f, 0.f}; }
                        else { const float* s0 = SG + (size_t)((blk - 1) * 8 + 6) * 1024 + c0; pa0 = *(const f32x4*)s0; pa1 = *(const f32x4*)(s0 + 4); pb0 = *(const f32x4*)(s0 + 1024); pb1 = *(const f32x4*)(s0 + 1028); }
                        const float* sc = SG + (size_t)(blk * 8 + sb) * 1024 + c0; const f32x4 x00 = *(const f32x4*)sc, x01 = *(const f32x4*)(sc + 4);
                        f32x4 xm2a, xm2b, xm1a, xm1b, xca, xcb;
                        if (rr == 0) { xm2a = pa0; xm2b = pa1; xm1a = pb0; xm1b = pb1; xca = x00; xcb = x01; }
                        else { xm2a = pb0; xm2b = pb1; xm1a = x00; xm1b = x01; xca = *(const f32x4*)(sc + 1024); xcb = *(const f32x4*)(sc + 1028); }
                        const f32x4 w0a = *(const f32x4*)(cw + c0), w0b = *(const f32x4*)(cw + c0 + 4), w1a = *(const f32x4*)(cw + 1024 + c0), w1b = *(const f32x4*)(cw + 1028 + c0), w2a = *(const f32x4*)(cw + 2048 + c0), w2b = *(const f32x4*)(cw + 2052 + c0);
                        z0 = w0a * xm2a + w1a * xm1a + w2a * xca; z1 = w0b * xm2b + w1b * xm1b + w2b * xcb; }
                    else { const v4u zw = *(const v4u*)(zc + (size_t)row * 1024 + c0); z0 = (f32x4){bflo(zw.x), bfhi(zw.x), bflo(zw.y), bfhi(zw.y)}; z1 = (f32x4){bflo(zw.z), bfhi(zw.z), bflo(zw.w), bfhi(zw.w)}; }
                    const v4u gw_ = *(const v4u*)(gbm + (size_t)row * 1024 + c0);
                    const f32x4 g0 = (f32x4){bflo(gw_.x), bfhi(gw_.x), bflo(gw_.y), bfhi(gw_.y)}, g1 = (f32x4){bflo(gw_.z), bfhi(gw_.z), bflo(gw_.w), bfhi(gw_.w)};
                    *(v4u*)(gbm + (size_t)row * 1024 + c0) = pack8(g0 * z0, g1 * z1); }
                for (int i = gt; i < 4 * 2 * 1024; i += NT) { const int c = i & 1023, j = (i >> 10) & 1, b = i >> 11; out[OFF_CMP + i] = SG[(size_t)((64 * b + 63) * 8 + 6 + j) * 1024 + c]; }
                for (int i = gt; i < 8 * 2 * 1024; i += NT) { const int c = i & 1023, j = (i >> 10) & 1, b = i >> 11; out[OFF_CMS + i] = SG[(size_t)((256 + (b >> 1)) * 8 + (b & 1) * 4 + 2 + j) * 1024 + c]; }
            }
            SEAM();
        }
        if (RUN) { PTRS() pg8::Gemm g{(bf16*)(tmp + (size_t)(1 - l) * TMP_YCAT), WT + WT_OUTEVEN + (size_t)l * (WT_OUTODD - WT_OUTEVEN), MROWS, 1024, 1024}; pg8::StaticOrderF S; S.init(MROWS, 1024, G, (int)blockIdx.x);
            EpiRes E{P.in[0], P.in[1] - (size_t)MP * 1024, xb, PARTBUF(1 + 3 * l), l == 0 ? 1 : 0};
            pg8::gemm_phase<EpiRes, pg8::StaticOrderF, true, true>(lds, g, S, E, wave_s); }
        SEAM();
        if (RUN) { PTRS() pg8::Gemm g{xb, WT + WT_WQ + (size_t)l * 1048576, MROWS, 1024, 1024}; pg8::StaticOrderF S; S.init(MROWS, 1024, G, (int)blockIdx.x); EpiBf16 E{qx, 1024, PARTBUF(1 + 3 * l)};
            pg8::gemm_phase<EpiBf16, pg8::StaticOrderF, true, true>(lds, g, S, E, wave_s); }
        SEAM();
        if (RUN) { PTRS() FRESH() xattn_phase2(qx, memk + (size_t)l * 12 * 262144, memvT + (size_t)l * 12 * 262144, ox, lds, tid, wave, lane, G); }
        SEAM();
        if (RUN) { PTRS() pg8::Gemm g{ox, WT + WT_WO + (size_t)l * 1048576, MROWS, 1024, 1024}; pg8::StaticOrderF S; S.init(MROWS, 1024, G, (int)blockIdx.x); EpiRes E{P.in[0], P.in[0], xb, PARTBUF(2 + 3 * l), 0};
            pg8::gemm_phase<EpiRes, pg8::StaticOrderF, true, true>(lds, g, S, E, wave_s); }
        SEAM();
        if (RUN) { PTRS() pg8::Gemm g{xb, WT + WT_UP + (size_t)l * 5632 * 1024, MROWS, 5632, 1024}; pg8::StaticOrderF S; S.init(MROWS, 5632, G, (int)blockIdx.x);
            EpiFfnUp E{act, PARTBUF(2 + 3 * l), P.in[34] + (size_t)l * 3 * DFF, SG, SV};
            pg8::gemm_phase<EpiFfnUp, pg8::StaticOrderF, true, true>(lds, g, S, E, wave_s); }
        SEAM();
        if (RUN) { PTRS() FRESH()
            const float* cw = P.in[34] + (size_t)l * 3 * DFF; const float* st = P.in[8] + (size_t)l * 8 * 2 * DFF;
            for (int i = gt; i < 528 * 352; i += NT) { const int fi = i / 352, c0 = (i % 352) * 8; int blk, row, rr, sb, vb; bool smp = fi >= 512;
                if (!smp) { blk = fi >> 1; rr = fi & 1; row = blk * 64 + rr; sb = 0; vb = 0; } else { const int s = fi - 512, half = (s >> 1) & 1; blk = 256 + (s >> 2); rr = s & 1; row = blk * 64 + half * 32 + rr; sb = half * 4; vb = half * 2; }
                f32x4 pa0, pa1, pb0, pb1;
                if (smp) { const int b = (blk - 256) * 2 + (sb >> 2); const float* s0 = st + (size_t)(b * 2) * DFF + c0; pa0 = *(const f32x4*)s0; pa1 = *(const f32x4*)(s0 + 4); pb0 = *(const f32x4*)(s0 + DFF); pb1 = *(const f32x4*)(s0 + DFF + 4); }
                else if ((blk & 63) == 0) { pa0 = pa1 = pb0 = pb1 = (f32x4){0.f, 0.f, 0.f, 0.f}; }
                else { const float* s0 = SG + (size_t)((blk - 1) * 8 + 6) * DFF + c0; pa0 = *(const f32x4*)s0; pa1 = *(const f32x4*)(s0 + 4); pb0 = *(const f32x4*)(s0 + DFF); pb1 = *(const f32x4*)(s0 + DFF + 4); }
                const float* sc = SG + (size_t)(blk * 8 + sb) * DFF + c0; const f32x4 x00 = *(const f32x4*)sc, x01 = *(const f32x4*)(sc + 4);
                f32x4 xm2a, xm2b, xm1a, xm1b, xca, xcb;
                if (rr == 0) { xm2a = pa0; xm2b = pa1; xm1a = pb0; xm1b = pb1; xca = x00; xcb = x01; }
                else { xm2a = pb0; xm2b = pb1; xm1a = x00; xm1b = x01; xca = *(const f32x4*)(sc + DFF); xcb = *(const f32x4*)(sc + DFF + 4); }
                const f32x4 w0a = *(const f32x4*)(cw + c0), w0b = *(const f32x4*)(cw + c0 + 4), w1a = *(const f32x4*)(cw + DFF + c0), w1b = *(const f32x4*)(cw + DFF + c0 + 4), w2a = *(const f32x4*)(cw + 2 * DFF + c0), w2b = *(const f32x4*)(cw + 2 * DFF + c0 + 4);
                const f32x4 ga = w0a * xm2a + w1a * xm1a + w2a * xca, gb_ = w0b * xm2b + w1b * xm1b + w2b * xcb;
                const float* sv = SV + (size_t)(blk * 4 + vb + rr) * DFF + c0; const f32x4 va = *(const f32x4*)sv, vb_ = *(const f32x4*)(sv + 4);
                f32x4 a0, a1;
#pragma unroll
                for (int j = 0; j < 4; ++j) { a0[j] = ga[j] * sigmoidf_(ga[j]) * va[j]; a1[j] = gb_[j] * sigmoidf_(gb_[j]) * vb_[j]; }
                *(v4u*)(act + (size_t)row * DFF + c0) = pack8(a0, a1); }
            for (int i = gt; i < 4 * 2 * DFF; i += NT) { const int c = i % DFF, j = (i / DFF) & 1, b = i / (2 * DFF); out[OFF_CFP + (size_t)l * 4 * 2 * DFF + i] = SG[(size_t)((64 * b + 63) * 8 + 6 + j) * DFF + c]; }
            for (int i = gt; i < 8 * 2 * DFF; i += NT) { const int c = i % DFF, j = (i / DFF) & 1, b = i / (2 * DFF); out[OFF_CFS + (size_t)l * 8 * 2 * DFF + i] = SG[(size_t)((256 + (b >> 1)) * 8 + (b & 1) * 4 + 2 + j) * DFF + c]; }
        }
        SEAM();
        if (RUN) { PTRS() pg8::Gemm g{act, WT + WT_DOWN + (size_t)l * 2816 * 1024, MROWS, 1024, DFF}; pg8::StaticOrderF S; S.init(MROWS, 1024, G, (int)blockIdx.x); EpiRes E{P.in[0], P.in[0], xb, PARTBUF(3 + 3 * l), 0};
            pg8::gemm_phase<EpiRes, pg8::StaticOrderF, true, true>(lds, g, S, E, wave_s); }
        SEAM();
    }
    if (RUN) { PTRS() FRESH()
        const float* gf = P.in[14];
        for (int m = gw; m < MROWS; m += NGW) { const float rs = rstd_of(PARTBUF(6), m); float* xr = out + (size_t)m * 1024; const bf16* xbr = xb + (size_t)m * 1024;
#pragma unroll
            for (int j = 0; j < 4; ++j) { const int c = (lane + 64 * j) * 4; const u32x2v w = *(const u32x2v*)(xbr + c); const f32x4 v = (f32x4){bflo(w.x), bfhi(w.x), bflo(w.y), bfhi(w.y)}, gg = *(const f32x4*)(gf + c); *(f32x4*)(xr + c) = v * rs * gg; } }
    }
}

extern "C" void kernel_launch(void* const* d_in, const int* in_sizes, int n_in, void* d_out, int out_size, void* d_ws, size_t ws_size, hipStream_t stream) {
    static int grid = 0;
    if (grid == 0) {
        int dev = 0, cus = 0, per_cu = 0;
        if (n_in != 36 || ws_size < 256 * MiB) { fprintf(stderr, "kernel_launch: unexpected n_in %d / ws %zu\n", n_in, ws_size); grid = -1; return; }
        (void)hipGetDevice(&dev); (void)hipDeviceGetAttribute(&cus, hipDeviceAttributeMultiprocessorCount, dev);
        if (hipFuncSetAttribute((const void*)mega_fwd, hipFuncAttributeMaxDynamicSharedMemorySize, LDS_BYTES) != hipSuccess) { fprintf(stderr, "kernel_launch: hipFuncSetAttribute failed\n"); grid = -1; return; }
        if (hipOccupancyMaxActiveBlocksPerMultiprocessor(&per_cu, (const void*)mega_fwd, 512, LDS_BYTES) != hipSuccess || per_cu < 1) per_cu = 1;
        (void)hipGetLastError();
        grid = cus * 1;
        if (grid > 256) grid = 256;
    }
    if (grid < 0) return;
    (void)hipMemsetAsync(d_ws, 0, CTL_ZERO_BYTES, stream);
    Params p{};
    for (int i = 0; i < 36; ++i) p.in[i] = (const float*)d_in[i];
    p.out = (float*)d_out; p.ws = (unsigned char*)d_ws; p.use_cg = 0; p.pad = 0;
    void* args[] = {&p};
    hipError_t e = hipLaunchCooperativeKernel((const void*)mega_fwd, dim3(grid), dim3(512), args, LDS_BYTES, stream);
    if (e != hipSuccess) fprintf(stderr, "cooperative launch failed: %s (grid %d)\n", hipGetErrorString(e), grid);
}
```

```cpp
#include <hip/hip_runtime.h>
#include <hip/hip_cooperative_groups.h>
#include <cstdio>
#include <cstdint>
namespace cg = cooperative_groups;
__device__ __forceinline__ int fresh_tid(int wave_s) { unsigned z = 0u; asm volatile("" : "+s"(z)); int t = wave_s * 64 + (int)__builtin_amdgcn_mbcnt_hi(~0u, __builtin_amdgcn_mbcnt_lo(~0u, z)); asm volatile("" : "+v"(t)); return t; }
namespace pg8 {
#define PG8_LAS __attribute__((address_space(3)))
typedef unsigned short bf16_t;
typedef short bf16x8 __attribute__((ext_vector_type(8)));
typedef float f32x4 __attribute__((ext_vector_type(4)));
typedef unsigned u32x4 __attribute__((ext_vector_type(4)));
constexpr int BM = 256, BK = 64, HALF = 128, HTB = HALF * BK * 2  , STAGE_BYTES = 8 * HTB, NXCD = 8, WGM = 8;

__host__ __device__ __forceinline__ int lds_byte(int r, int c) { const int st = (r >> 4) * 2 + (c >> 5), rr = r & 15, cc = c & 31, ob = rr * 64 + cc * 2; return st * 1024 + (ob ^ (((ob >> 9) & 1) << 5)); }
__host__ __device__ __forceinline__ void stage_rc(int b, int& R, int& C) { const int st = b / 1024, sb = b % 1024, swz = sb ^ (((sb >> 9) & 1) << 5); R = (st >> 1) * 16 + swz / 64; C = (st & 1) * 32 + (swz % 64) / 2; }
__host__ __device__ __forceinline__ int perm32(int rho) { const int n = rho >> 4, i = rho & 15; return 8 * (i >> 2) + 4 * n + (i & 3); }

struct Unit { int pm, pn; };
struct Gemm { const bf16_t* A; const bf16_t* Bt; int M, N, K; };

template <bool FULL> struct StaticOrderT {
    int nM, nN, nwg, G, c;
    __host__ __device__ void init(int M, int N, int G_, int c_) { nM = M / BM; nN = N / BM; nwg = nM * nN; G = G_; c = c_; }
    __host__ __device__ bool next(int i, Unit& u) const {
        const long L = (long)i * G + c; if (!(FULL && i == 0) && L >= nwg) return false;
        int wgid = (int)L; { const int q = nwg / NXCD, r = nwg % NXCD, xcd = wgid % NXCD, off = wgid / NXCD; wgid = (xcd < r ? xcd * (q + 1) : r * (q + 1) + (xcd - r) * q) + off; }
        const int nig = WGM * nN, gid = wgid / nig, fm = gid * WGM, gsz = (nM - fm) < WGM ? (nM - fm) : WGM;
        u.pm = fm + ((wgid % nig) % gsz); u.pn = (wgid % nig) / gsz; return true;
    }
    __device__ __forceinline__ void a_ready(const Unit&) const {}
    __device__ __forceinline__ void done(const Unit&) const {}
};

typedef StaticOrderT<false> StaticOrder; typedef StaticOrderT<true> StaticOrderF;
__device__ __forceinline__ unsigned cvt_pk_bf16(float lo, float hi) { unsigned r; asm volatile("v_cvt_pk_bf16_f32 %0, %1, %2" : "=v"(r) : "v"(lo), "v"(hi)); return r; }
typedef float f32x2 __attribute__((ext_vector_type(2)));
template <class Epi, class Sched, bool ALIGN_EPI = false, bool SP2 = false>
__device__ __forceinline__ void gemm_phase(PG8_LAS unsigned char* lds, const Gemm g, const Sched& S, const Epi& E, const int wave_s) {
    const int tid = fresh_tid(wave_s), wid = __builtin_amdgcn_readfirstlane(tid >> 6), lane = tid & 63, wr = wid >> 2, wc = wid & 3, fr = lane & 15, fq = lane >> 4;
    const int K = g.K, nt = K / BK;
    unsigned voffA[2], voffB[2];
#pragma unroll
    for (int i = 0; i < 2; ++i) { int R, C; stage_rc(tid * 16 + i * 8192, R, C); const int Rb = Epi::PERM ? ((R & ~31) + perm32(R & 31)) : R;
        voffA[i] = (unsigned)(R * K + C) * 2u; voffB[i] = (unsigned)(Rb * K + C) * 2u; }
    const size_t kstep = (size_t)(BK * 2);
    const size_t hstep = (size_t)HALF * K * 2;
    const size_t tstep = 2 * hstep;
    const unsigned ldsw = (unsigned)wid * 1024u;
    const int aoff = lds_byte(wr * 64 + fr, fq * 8), boff = lds_byte(wc * 32 + fr, fq * 8);
#define PG8_SA(b, h) (((b) * 2 + (h)) * HTB)
#define PG8_SB(b, h) ((4 + (b) * 2 + (h)) * HTB)
#define PG8_STAGE(bufoff, gbase, voff) do { _Pragma("unroll") for (int _i = 0; _i < 2; ++_i) \
        __builtin_amdgcn_global_load_lds((const unsigned*)((const char*)(gbase) + (voff)[_i]), (PG8_LAS unsigned*)(lds + (bufoff) + ldsw + _i * 8192), 16, 0, 0); } while (0)
#define PG8_LDA(dst, b, h) do { _Pragma("unroll") for (int m = 0; m < 4; ++m) _Pragma("unroll") for (int k = 0; k < 2; ++k) dst[m][k] = *(const PG8_LAS bf16x8*)(lds + PG8_SA(b, h) + aoff + m * 2048 + k * 1024); } while (0)
#define PG8_LDB(dst, b, h) do { _Pragma("unroll") for (int n = 0; n < 2; ++n) _Pragma("unroll") for (int k = 0; k < 2; ++k) dst[n][k] = *(const PG8_LAS bf16x8*)(lds + PG8_SB(b, h) + boff + n * 2048 + k * 1024); } while (0)
#define PG8_MMA(ai, bj, At, Bt) do { __builtin_amdgcn_s_setprio(1); _Pragma("unroll") for (int m = 0; m < 4; ++m) _Pragma("unroll") for (int n = 0; n < 2; ++n) _Pragma("unroll") for (int k = 0; k < 2; ++k) \
        acc[ai][bj][m][n] = __builtin_amdgcn_mfma_f32_16x16x32_bf16(Bt[n][k], At[m][k], acc[ai][bj][m][n], 0, 0, 0); __builtin_amdgcn_s_setprio(0); } while (0)
#define PG8_WAIT_V(n) asm volatile("s_waitcnt vmcnt(" #n ")" ::: "memory")
#define PG8_WAIT_L(n) asm volatile("s_waitcnt lgkmcnt(" #n ")" ::: "memory")
#define PG8_BAR __builtin_amdgcn_s_barrier()
#define PG8_SCHED __builtin_amdgcn_sched_barrier(0)
    Unit cur, nxt; int ui = 0;
    if (!S.next(0, cur)) return;
    f32x4 acc[2][2][4][2];
#pragma unroll
    for (int a = 0; a < 2; ++a)
#pragma unroll
        for (int b = 0; b < 2; ++b)
#pragma unroll
            for (int m = 0; m < 4; ++m)
#pragma unroll
                for (int n = 0; n < 2; ++n) acc[a][b][m][n] = (f32x4){0.f, 0.f, 0.f, 0.f};
    bf16x8 At[4][2], B0[2][2], B1[2][2];
    const char* cA = (const char*)g.A + (size_t)cur.pm * tstep; const char* cB = (const char*)g.Bt + (size_t)cur.pn * tstep;
    S.a_ready(cur);
    if constexpr (SP2) {
        PG8_STAGE(PG8_SB(0, 0), cB, voffB); PG8_STAGE(PG8_SB(0, 1), cB + hstep, voffB); PG8_STAGE(PG8_SA(0, 0), cA, voffA); PG8_STAGE(PG8_SA(0, 1), cA + hstep, voffA);
        if (wr == 1) PG8_BAR;
        PG8_WAIT_V(2); PG8_BAR;
        PG8_STAGE(PG8_SB(1, 0), cB + kstep, voffB); PG8_STAGE(PG8_SA(1, 0), cA + kstep, voffA); PG8_STAGE(PG8_SB(1, 1), cB + hstep + kstep, voffB);
        PG8_WAIT_V(6); PG8_BAR;
    } else {
        PG8_STAGE(PG8_SB(0, 0), cB, voffB); PG8_STAGE(PG8_SA(0, 0), cA, voffA); PG8_STAGE(PG8_SB(0, 1), cB + hstep, voffB); PG8_STAGE(PG8_SA(0, 1), cA + hstep, voffA);
        if (wr == 1) PG8_BAR;
        PG8_WAIT_V(4); PG8_BAR;
        PG8_STAGE(PG8_SB(1, 0), cB + kstep, voffB); PG8_STAGE(PG8_SA(1, 0), cA + kstep, voffA); PG8_STAGE(PG8_SB(1, 1), cB + hstep + kstep, voffB);
        PG8_WAIT_V(6); PG8_BAR;
    }
    for (;;) {
        const bool has_next = S.next(ui + 1, nxt);
        const char* nA = has_next ? (const char*)g.A + (size_t)nxt.pm * tstep : cA; const char* nB = has_next ? (const char*)g.Bt + (size_t)nxt.pn * tstep : cB;
        for (int t = 0; t < nt; t += 2) {
            const bool last = (t == nt - 2);
            const char* a1 = cA + (size_t)(t + 1) * kstep;
            const char* a2 = last ? nA : cA + (size_t)(t + 2) * kstep; const char* b2 = last ? nB : cB + (size_t)(t + 2) * kstep;
            const char* a3 = a2 + kstep; const char* b3 = b2 + kstep;
            if (last && has_next) S.a_ready(nxt);
            if constexpr (SP2) {
            PG8_LDB(B0, 0, 0); PG8_LDB(B1, 0, 1); PG8_SCHED; PG8_LDA(At, 0, 0); PG8_STAGE(PG8_SA(1, 1), a1 + hstep, voffA);
            PG8_WAIT_V(8); PG8_WAIT_L(0); PG8_BAR; PG8_MMA(0, 0, At, B0); PG8_MMA(0, 1, At, B1); PG8_BAR; PG8_SCHED;
            PG8_LDA(At, 0, 1); PG8_STAGE(PG8_SB(0, 0), b2, voffB); PG8_STAGE(PG8_SB(0, 1), b2 + hstep, voffB); PG8_STAGE(PG8_SA(0, 0), a2, voffA);
            PG8_WAIT_V(8); PG8_WAIT_L(0); PG8_BAR; PG8_MMA(1, 0, At, B0); PG8_MMA(1, 1, At, B1); PG8_BAR; PG8_SCHED;
            PG8_LDB(B0, 1, 0); PG8_LDB(B1, 1, 1); PG8_SCHED; PG8_LDA(At, 1, 0); PG8_STAGE(PG8_SA(0, 1), a2 + hstep, voffA);
            PG8_WAIT_V(8); PG8_WAIT_L(0); PG8_BAR; PG8_MMA(0, 0, At, B0); PG8_MMA(0, 1, At, B1); PG8_BAR; PG8_SCHED;
            PG8_LDA(At, 1, 1); PG8_STAGE(PG8_SB(1, 0), b3, voffB); PG8_STAGE(PG8_SB(1, 1), b3 + hstep, voffB); PG8_STAGE(PG8_SA(1, 0), a3, voffA);
            PG8_WAIT_V(8); PG8_WAIT_L(0); PG8_BAR; PG8_MMA(1, 0, At, B0); PG8_MMA(1, 1, At, B1); PG8_BAR; PG8_SCHED;
            } else {
            PG8_LDB(B0, 0, 0); PG8_SCHED; PG8_LDA(At, 0, 0); PG8_STAGE(PG8_SA(1, 1), a1 + hstep, voffA);
            PG8_WAIT_L(8); PG8_BAR; PG8_WAIT_L(0); PG8_MMA(0, 0, At, B0); PG8_BAR; PG8_SCHED;
            PG8_LDB(B1, 0, 1); PG8_STAGE(PG8_SB(0, 0), b2, voffB);
            PG8_BAR; PG8_WAIT_L(0); PG8_MMA(0, 1, At, B1); PG8_BAR;
            PG8_LDA(At, 0, 1); PG8_STAGE(PG8_SA(0, 0), a2, voffA);
            PG8_BAR; PG8_WAIT_L(0); PG8_MMA(1, 0, At, B0); PG8_BAR; PG8_SCHED;
            PG8_STAGE(PG8_SB(0, 1), b2 + hstep, voffB);
            PG8_WAIT_V(6); PG8_BAR; PG8_MMA(1, 1, At, B1); PG8_BAR;
            PG8_LDB(B0, 1, 0); PG8_SCHED; PG8_LDA(At, 1, 0); PG8_STAGE(PG8_SA(0, 1), a2 + hstep, voffA);
            PG8_WAIT_L(8); PG8_BAR; PG8_WAIT_L(0); PG8_MMA(0, 0, At, B0); PG8_BAR; PG8_SCHED;
            PG8_LDB(B1, 1, 1); PG8_STAGE(PG8_SB(1, 0), b3, voffB);
            PG8_BAR; PG8_WAIT_L(0); PG8_MMA(0, 1, At, B1); PG8_BAR;
            PG8_LDA(At, 1, 1); PG8_STAGE(PG8_SA(1, 0), a3, voffA);
            PG8_BAR; PG8_WAIT_L(0); PG8_MMA(1, 0, At, B0); PG8_BAR; PG8_SCHED;
            PG8_STAGE(PG8_SB(1, 1), b3 + hstep, voffB);
            PG8_WAIT_V(6); PG8_BAR; PG8_MMA(1, 1, At, B1); PG8_BAR;
            }
        }
        if constexpr (ALIGN_EPI) { if (wr == 0) PG8_BAR; }
        if constexpr (!Epi::AFTER_DRAIN) { E(acc, cur, wr, wc, fr, fq); S.done(cur); }
        if (!has_next) break;
#pragma unroll
        for (int a = 0; a < 2; ++a)
#pragma unroll
            for (int b = 0; b < 2; ++b)
#pragma unroll
                for (int m = 0; m < 4; ++m)
#pragma unroll
                    for (int n = 0; n < 2; ++n) acc[a][b][m][n] = (f32x4){0.f, 0.f, 0.f, 0.f};
        cur = nxt; cA = nA; cB = nB; ++ui;
        if constexpr (ALIGN_EPI) { if (wr == 1) PG8_BAR; }
    }
    PG8_WAIT_V(0);
    if constexpr (!ALIGN_EPI) { if (wr == 0) PG8_BAR; }
    PG8_BAR;
    if constexpr (Epi::AFTER_DRAIN) { E.fused(acc, cur, wr, wc, fr, fq, lds, wid, lane); S.done(cur); }
#undef PG8_SA
#undef PG8_SB
#undef PG8_STAGE
#undef PG8_LDA
#undef PG8_LDB
#undef PG8_MMA
#undef PG8_WAIT_V
#undef PG8_WAIT_L
#undef PG8_BAR
#undef PG8_SCHED
}
}
#define GAS __attribute__((address_space(1)))
#define LAS __attribute__((address_space(3)))
typedef unsigned short bf16;
typedef unsigned v4u __attribute__((ext_vector_type(4)));
typedef float f32x4 __attribute__((ext_vector_type(4)));
typedef short bf16x8 __attribute__((ext_vector_type(8)));
typedef GAS unsigned gu32;
typedef GAS unsigned long long gu64;
#define RLX_AGENT __ATOMIC_RELAXED, __HIP_MEMORY_SCOPE_AGENT
#define LDS_WAIT() asm volatile("s_waitcnt lgkmcnt(0)" ::: "memory")
#define VM_WAIT() asm volatile("s_waitcnt vmcnt(0)" ::: "memory")
__device__ __forceinline__ unsigned long long rt() { return __builtin_amdgcn_s_memrealtime(); }
__device__ __forceinline__ unsigned f2bf(float f) { unsigned u = __builtin_bit_cast(unsigned, f); return (u + 0x7fffu + ((u >> 16) & 1u)) >> 16; }
__device__ __forceinline__ unsigned pk2(float lo, float hi) { return f2bf(lo) | (f2bf(hi) << 16); }

#define XB_TMO      128
#define XB_XCNT(j)  (256  + 64 * (j))
#define XB_XSUB(j)  (1280 + 64 * (j))
#define XB_XGEN(j)  (2304 + 64 * (j))
#define XB_TOP      3328
#define XB_TOPGEN   3392
#define XCD_BAR_WORDS 3456
#define XB_SPIN_CAP (1u << 18)

__device__ __forceinline__ unsigned xb_ld(unsigned* p)              { return __hip_atomic_load(p, __ATOMIC_RELAXED, __HIP_MEMORY_SCOPE_AGENT); }
__device__ __forceinline__ unsigned xb_add(unsigned* p, unsigned v) { return __hip_atomic_fetch_add(p, v, __ATOMIC_RELAXED, __HIP_MEMORY_SCOPE_AGENT); }
__device__ __forceinline__ unsigned xb_xcc_id() { return (unsigned)__builtin_amdgcn_s_getreg((3 << 11) | 20) & 0xFu; }
#define XB_SPIN(cond, bar) do { unsigned _sp = 0; while (cond) { __builtin_amdgcn_s_sleep(1); \
    if ((++_sp & 255u) == 0u) { if (xb_ld(&(bar)[XB_TMO])) break; if (_sp > XB_SPIN_CAP) { atomicAdd(&(bar)[XB_TMO], 1u); break; } } } } while (0)

struct XcdBarrier {
    unsigned* bar; unsigned x;
    volatile LAS unsigned* st;
};

__device__ __forceinline__ XcdBarrier xcd_barrier_post(unsigned* bar, volatile LAS unsigned* st) {
    XcdBarrier b; b.bar = bar; b.x = xb_xcc_id(); b.st = st;
    if (threadIdx.x == 0) (void)xb_add(&bar[XB_XCNT(b.x)], 1u);
    return b;
}
__device__ __forceinline__ void xcd_barrier_complete(unsigned* bar, unsigned x, unsigned& nloc, unsigned& nx) {
    const unsigned G = gridDim.x * gridDim.y * gridDim.z;
    unsigned sum, cnt, mine, sp = 0u;
    for (;;) {
        sum = 0u; cnt = 0u; mine = 0u;
#pragma unroll
        for (unsigned j = 0; j < 16; ++j) { const unsigned c = xb_ld(&bar[XB_XCNT(j)]); sum += c; cnt += (c > 0u) ? 1u : 0u; mine = (j == x) ? c : mine; }
        if (sum == G) break;
        __builtin_amdgcn_s_sleep(1);
        if ((++sp & 255u) == 0u) { if (xb_ld(&bar[XB_TMO])) break; if (sp > XB_SPIN_CAP) { atomicAdd(&bar[XB_TMO], 1u); break; } }
    }
    nloc = mine > 0u ? mine : 1u; nx = cnt > 0u ? cnt : 1u;
}

__device__ __forceinline__ void xcd_barrier(const XcdBarrier& b) {
    asm volatile("s_waitcnt vmcnt(0)" ::: "memory");
    __syncthreads();
    if (threadIdx.x == 0) {
        unsigned* bar = b.bar;
        __builtin_amdgcn_s_waitcnt(0);
        unsigned nloc = b.st[0], nx = b.st[1];
        if (nloc == 0u) { xcd_barrier_complete(bar, b.x, nloc, nx); b.st[0] = nloc; b.st[1] = nx; }
        const unsigned old = xb_add(&bar[XB_XSUB(b.x)], 1u);
        const unsigned gen = old / nloc;
        if (old + 1u == (gen + 1u) * nloc) {
            __builtin_amdgcn_fence(__ATOMIC_RELEASE, "agent");
            asm volatile("s_waitcnt vmcnt(0)" ::: "memory");
            const unsigned og = xb_add(&bar[XB_TOP], 1u);
            const unsigned tg = og / nx;
            if (og + 1u == (tg + 1u) * nx) xb_add(&bar[XB_TOPGEN], 1u);
            else XB_SPIN(xb_ld(&bar[XB_TOPGEN]) == tg, bar);
            __builtin_amdgcn_fence(__ATOMIC_ACQUIRE, "agent");
            xb_add(&bar[XB_XGEN(b.x)], 1u);
            asm volatile("s_waitcnt vmcnt(0)" ::: "memory");
        } else {
            XB_SPIN(xb_ld(&bar[XB_XGEN(b.x)]) == gen, bar);
            __builtin_amdgcn_fence(__ATOMIC_ACQUIRE, "agent");
            asm volatile("s_waitcnt vmcnt(0)" ::: "memory");
        }
    }
    __syncthreads();
}
typedef unsigned u32x2v __attribute__((ext_vector_type(2)));
typedef float f32x2v __attribute__((ext_vector_type(2)));

constexpr int MP = 16384, MROWS = 16640, DMODEL = 1024, DFF = 2816, NBLK64 = MROWS / 64;
constexpr float RMS_EPS = 1e-6f;
constexpr size_t OFF_Y = 0, OFF_WKP = (size_t)MROWS * 1024, OFF_WVP = OFF_WKP + 65536, OFF_SRP = OFF_WVP + 65536, OFF_SIP = OFF_SRP + 8192,
    OFF_CMP = OFF_SIP + 8192, OFF_CFP = OFF_CMP + 8192, OFF_MKP = OFF_CFP + 45056, OFF_MVP = OFF_MKP + 2097152, OFF_WKS = OFF_MVP + 2097152,
    OFF_WVS = OFF_WKS + 32768, OFF_SRS = OFF_WVS + 32768, OFF_SIS = OFF_SRS + 16384, OFF_CMS = OFF_SIS + 16384, OFF_CFS = OFF_CMS + 16384;
constexpr size_t MiB = 1u << 20;
constexpr size_t WS_ROWSS = 0, WS_BAR = 512 * 1024, CTL_ZERO_BYTES = 1 * MiB;
constexpr size_t WS_ROPE = 1 * MiB, WS_SSM = 2 * MiB, WS_CKV = 3 * MiB, WS_SLOC = 4 * MiB, WS_MEMK = 8 * MiB, WS_MEMVT = 20 * MiB, WS_SIDE = 32 * MiB;
constexpr size_t SG_BYTES = (size_t)NBLK64 * 8 * DFF * 4, SV_BYTES = (size_t)NBLK64 * 4 * DFF * 4;
static_assert(WS_SIDE + SG_BYTES + SV_BYTES <= 66 * MiB, "side buffers");
constexpr size_t WS_WT = 66 * MiB, WS_XB = 128 * MiB, WS_TMP = 161 * MiB;
constexpr size_t WT_INEVEN = 0, WT_GLU = WT_INEVEN + 1280 * 1024, WT_OUTEVEN = WT_GLU + 512 * 512, WT_WQ = WT_OUTEVEN + 1024 * 1024, WT_WKV = WT_WQ + 2 * 1024 * 1024,
    WT_WO = WT_WKV + 2 * 2048 * 1024, WT_UP = WT_WO + 2 * 1024 * 1024, WT_DOWN = WT_UP + (size_t)2 * 5632 * 1024, WT_INODD = WT_DOWN + (size_t)2 * 2816 * 1024,
    WT_OUTODD = WT_INODD + 3072 * 1024, WT_END = WT_OUTODD + 1024 * 1024;
static_assert(WS_WT + WT_END * 2 <= WS_XB, "weights");
static_assert(WS_XB + (size_t)MROWS * 1024 * 2 <= WS_TMP, "xb");
constexpr size_t TMP_BYTES = (size_t)MROWS * DFF * 2;
constexpr size_t WS_PART = 251 * MiB, PART_ELEMS = (size_t)MROWS * 16;
static_assert(WS_PART + 2 * PART_ELEMS * 4 <= 256 * MiB, "part");
static_assert(WS_TMP + TMP_BYTES <= 256 * MiB, "ws");
constexpr size_t TMP_PROJ0 = 0, TMP_GBUF = (size_t)MROWS * 1280 * 2, TMP_YCAT = TMP_GBUF + (size_t)MROWS * 512 * 2, TMP_MEMB = TMP_YCAT;
static_assert(TMP_YCAT + (size_t)MROWS * 1024 * 2 <= TMP_BYTES, "tmp");
constexpr size_t TMP_QX = 0, TMP_OX = (size_t)MROWS * 1024 * 2, TMP_ACT = 0, TMP_GB = 0, TMP_ZC = (size_t)MROWS * 1024 * 2;
constexpr int LDS_BYTES = 147456, MISC_OFF = 147456 - 512;
constexpr int NPH = 22;

#define MFMA16(a, b, c) __builtin_amdgcn_mfma_f32_16x16x32_bf16(a, b, c, 0, 0, 0)
__device__ __forceinline__ float bflo(unsigned w) { return __uint_as_float(w << 16); }
__device__ __forceinline__ float bfhi(unsigned w) { return __uint_as_float(w & 0xffff0000u); }
__device__ __forceinline__ v4u pack8(f32x4 a, f32x4 b) { v4u w; w.x = pg8::cvt_pk_bf16(a[0], a[1]); w.y = pg8::cvt_pk_bf16(a[2], a[3]); w.z = pg8::cvt_pk_bf16(b[0], b[1]); w.w = pg8::cvt_pk_bf16(b[2], b[3]); return w; }
__device__ __forceinline__ float rstd_of(const float* part, int row) { const f32x4* p = (const f32x4*)(part + (size_t)row * 16); const f32x4 a = p[0] + p[1] + p[2] + p[3]; return rsqrtf(((a[0] + a[1]) + (a[2] + a[3])) * (1.0f / 1024.0f) + RMS_EPS); }
__device__ __forceinline__ float sigmoidf_(float x) { return 1.0f / (1.0f + __expf(-x)); }
__device__ __forceinline__ float dpp_ror1(float v) { return __builtin_bit_cast(float, __builtin_amdgcn_update_dpp(0, __builtin_bit_cast(int, v), 0x121, 0xf, 0xf, false)); }
__device__ __forceinline__ float dpp_ror2(float v) { return __builtin_bit_cast(float, __builtin_amdgcn_update_dpp(0, __builtin_bit_cast(int, v), 0x122, 0xf, 0xf, false)); }
__device__ __forceinline__ float wave_sum(float v) {
#pragma unroll
    for (int o = 1; o < 64; o <<= 1) v += __shfl_xor(v, o);
    return v;
}

typedef pg8::Unit Unit;
#define EPI_ARGS const f32x4 (&acc)[2][2][4][2], const Unit& u, int wr, int wc, int fr, int fq

struct EpiBf16 {
    static constexpr bool PERM = true, AFTER_DRAIN = false;
    bf16* O; int ldc; const float* rowss;
    __device__ __forceinline__ void operator()(EPI_ARGS) const {
        const int row0 = u.pm * 256 + wr * 64 + fr, col0 = u.pn * 256 + wc * 32 + 8 * fq;
#pragma unroll
        for (int ai = 0; ai < 2; ++ai)
#pragma unroll
            for (int m = 0; m < 4; ++m) { const int row = row0 + ai * 128 + m * 16; const float rs = rstd_of(rowss, row); bf16* rp = O + (size_t)row * ldc + col0;
#pragma unroll
                for (int bj = 0; bj < 2; ++bj) *(v4u*)(rp + bj * 128) = pack8(acc[ai][bj][m][0] * rs, acc[ai][bj][m][1] * rs); }
    }
};
struct EpiRes {
    static constexpr bool PERM = true, AFTER_DRAIN = false;
    const float* base_p; const float* base_s; bf16* xb; float* rowss_next; int f32base;
    __device__ __forceinline__ void operator()(EPI_ARGS) const {
        const float* base = u.pm < 64 ? base_p : base_s;
        const int row0 = u.pm * 256 + wr * 64 + fr, col0 = u.pn * 256 + wc * 32 + 8 * fq;
#pragma unroll
        for (int ai = 0; ai < 2; ++ai)
#pragma unroll
            for (int m = 0; m < 4; ++m) { const int row = row0 + ai * 128 + m * 16; const size_t off = (size_t)row * 1024 + col0; float ss = 0.f;
#pragma unroll
                for (int bj = 0; bj < 2; ++bj) { f32x4 b0, b1;
                    if (f32base) { b0 = *(const f32x4*)(base + off + bj * 128); b1 = *(const f32x4*)(base + off + bj * 128 + 4); }
                    else { const v4u w = *(const v4u*)(xb + off + bj * 128); b0 = (f32x4){bflo(w.x), bfhi(w.x), bflo(w.y), bfhi(w.y)}; b1 = (f32x4){bflo(w.z), bfhi(w.z), bflo(w.w), bfhi(w.w)}; }
                    const f32x4 v0 = acc[ai][bj][m][0] + b0, v1 = acc[ai][bj][m][1] + b1;
                    *(v4u*)(xb + off + bj * 128) = pack8(v0, v1);
                    ss += (v0[0] * v0[0] + v0[1] * v0[1]) + (v0[2] * v0[2] + v0[3] * v0[3]) + (v1[0] * v1[0] + v1[1] * v1[1]) + (v1[2] * v1[2] + v1[3] * v1[3]); }
                ss += __shfl_xor(ss, 16); ss += __shfl_xor(ss, 32);
                if (fq == 0) rowss_next[(size_t)row * 16 + u.pn * 4 + wc] = ss; }
    }
};
struct EpiGlu {
    static constexpr bool PERM = true, AFTER_DRAIN = false;
    const bf16* g; bf16* ycat;
    __device__ __forceinline__ void operator()(EPI_ARGS) const {
        const int row0 = u.pm * 256 + wr * 64 + fr, col0 = u.pn * 256 + wc * 32 + 8 * fq;
#pragma unroll
        for (int ai = 0; ai < 2; ++ai)
#pragma unroll
            for (int m = 0; m < 4; ++m) { const int row = row0 + ai * 128 + m * 16;
#pragma unroll
                for (int bj = 0; bj < 2; ++bj) { const int col = col0 + bj * 128; const v4u gw = *(const v4u*)(g + (size_t)row * 512 + col);
                    const f32x4 a0 = acc[ai][bj][m][0], a1 = acc[ai][bj][m][1]; f32x4 o0, o1;
                    o0[0] = bflo(gw.x) * sigmoidf_(a0[0]); o0[1] = bfhi(gw.x) * sigmoidf_(a0[1]); o0[2] = bflo(gw.y) * sigmoidf_(a0[2]); o0[3] = bfhi(gw.y) * sigmoidf_(a0[3]);
                    o1[0] = bflo(gw.z) * sigmoidf_(a1[0]); o1[1] = bfhi(gw.z) * sigmoidf_(a1[1]); o1[2] = bflo(gw.w) * sigmoidf_(a1[2]); o1[3] = bfhi(gw.w) * sigmoidf_(a1[3]);
                    *(v4u*)(ycat + (size_t)row * 1024 + col) = pack8(o0, o1); } }
    }
};
struct EpiKV {
    static constexpr bool PERM = true, AFTER_DRAIN = false;
    float* out; bf16* memk;
    __device__ __forceinline__ void operator()(EPI_ARGS) const {
        const int row0 = u.pm * 256 + wr * 64 + fr, col0 = u.pn * 256 + wc * 32 + 8 * fq;
#pragma unroll
        for (int ai = 0; ai < 2; ++ai)
#pragma unroll
            for (int m = 0; m < 4; ++m) { const int row = row0 + ai * 128 + m * 16;
#pragma unroll
                for (int bj = 0; bj < 2; ++bj) { const int c = col0 + bj * 128, l = c >> 11, e = c & 2047, isv = e >> 10, dc = e & 1023;
                    float* op = out + (isv ? OFF_MVP : OFF_MKP) + (size_t)l * 1048576 + (size_t)row * 1024 + dc;
                    *(f32x4*)op = acc[ai][bj][m][0]; *(f32x4*)(op + 4) = acc[ai][bj][m][1];
                    if (!isv) *(v4u*)(memk + (size_t)l * 12 * 262144 + (size_t)row * 1024 + dc) = pack8(acc[ai][bj][m][0], acc[ai][bj][m][1]); } }
    }
};
struct EpiIn0 {
    static constexpr bool PERM = true, AFTER_DRAIN = false;
    bf16* proj; const float* rowss; const float* ropec; const float* ropes; float* out;
    __device__ __forceinline__ void operator()(EPI_ARGS) const {
        const int pn = u.pn;
#pragma unroll
        for (int ai = 0; ai < 2; ++ai)
#pragma unroll
            for (int m = 0; m < 4; ++m) { const int row = u.pm * 256 + ai * 128 + wr * 64 + m * 16 + fr; const float rs = rstd_of(rowss, row);
                const int pos = row < MP ? (row & 4095) : 2048 + (row & 31);
                bf16* rp = proj + (size_t)row * 1280;
                float* wk = nullptr; float* wv = nullptr;
                if (pn == 4) { if (row >= MP) { wk = out + OFF_WKS + (size_t)(row - MP) * 128; wv = out + OFF_WVS + (size_t)(row - MP) * 128; }
                               else if ((row & 4095) >= 3968) { const size_t o = (size_t)((row >> 12) * 128 + (row & 4095) - 3968) * 128; wk = out + OFF_WKP + o; wv = out + OFF_WVP + o; } }
#pragma unroll
                for (int bj = 0; bj < 2; ++bj) { const f32x4 v0 = acc[ai][bj][m][0] * rs, v1 = acc[ai][bj][m][1] * rs;
                    const bool rope = (pn == 2 || pn == 3 || (pn == 4 && bj == 0));
                    if (!rope) { const int col = pn * 256 + bj * 128 + wc * 32 + 8 * fq; *(v4u*)(rp + col) = pack8(v0, v1);
                        if (pn == 4 && wv) { *(f32x4*)(wv + wc * 32 + 8 * fq) = v0; *(f32x4*)(wv + wc * 32 + 8 * fq + 4) = v1; } }
                    else { const int gbase = pn * 256 + bj * 128 + (wc >> 1) * 64, d1 = 16 * (wc & 1) + 4 * fq;
                        const f32x4 c4 = *(const f32x4*)(ropec + pos * 32 + d1), s4 = *(const f32x4*)(ropes + pos * 32 + d1);
                        f32x4 o1 = v0 * c4 - v1 * s4, o2 = v1 * c4 + v0 * s4;
                        if (pn != 4) { o1 = o1 * 0.125f; o2 = o2 * 0.125f; }
                        u32x2v w1, w2; w1.x = pg8::cvt_pk_bf16(o1[0], o1[1]); w1.y = pg8::cvt_pk_bf16(o1[2], o1[3]); w2.x = pg8::cvt_pk_bf16(o2[0], o2[1]); w2.y = pg8::cvt_pk_bf16(o2[2], o2[3]);
                        *(u32x2v*)(rp + gbase + d1) = w1; *(u32x2v*)(rp + gbase + d1 + 32) = w2;
                        if (pn == 4 && wk) { const int cc = (wc >> 1) * 64 + d1; *(f32x4*)(wk + cc) = o1; *(f32x4*)(wk + cc + 32) = o2; } } } }
    }
};
struct EpiFfnUp {
    static constexpr bool PERM = true, AFTER_DRAIN = false;
    bf16* act; const float* rowss; const float* cw; float* SG; float* SV;
    __device__ __forceinline__ void operator()(EPI_ARGS) const {
        const int c0 = u.pn * 128 + wc * 32 + 8 * fq; const bool sample = u.pm == 64;
        const f32x4 w0a = *(const f32x4*)(cw + c0), w0b = *(const f32x4*)(cw + c0 + 4), w1a = *(const f32x4*)(cw + DFF + c0), w1b = *(const f32x4*)(cw + DFF + c0 + 4),
                    w2a = *(const f32x4*)(cw + 2 * DFF + c0), w2b = *(const f32x4*)(cw + 2 * DFF + c0 + 4);
#pragma unroll
        for (int ai = 0; ai < 2; ++ai) { f32x4 gp0 = {0.f, 0.f, 0.f, 0.f}, gp1 = {0.f, 0.f, 0.f, 0.f}; const int blk = u.pm * 4 + ai * 2 + wr;
#pragma unroll
            for (int m = 0; m < 4; ++m) { const int row = u.pm * 256 + ai * 128 + wr * 64 + m * 16 + fr; const float rs = rstd_of(rowss, row);
                const f32x4 g0 = acc[ai][0][m][0] * rs, g1 = acc[ai][0][m][1] * rs, v0 = acc[ai][1][m][0] * rs, v1 = acc[ai][1][m][1] * rs;
                f32x4 a0, a1;
#pragma unroll
                for (int j = 0; j < 4; ++j) {
                    const float r1pa = dpp_ror1(gp0[j]), r1ca = dpp_ror1(g0[j]), r2pa = dpp_ror2(gp0[j]), r2ca = dpp_ror2(g0[j]);
                    const float r1pb = dpp_ror1(gp1[j]), r1cb = dpp_ror1(g1[j]), r2pb = dpp_ror2(gp1[j]), r2cb = dpp_ror2(g1[j]);
                    const float p1a = fr == 0 ? r1pa : r1ca, p2a = fr < 2 ? r2pa : r2ca;
                    const float p1b = fr == 0 ? r1pb : r1cb, p2b = fr < 2 ? r2pb : r2cb;
                    const float ca = w0a[j] * p2a + w1a[j] * p1a + w2a[j] * g0[j], cb = w0b[j] * p2b + w1b[j] * p1b + w2b[j] * g1[j];
                    a0[j] = ca * sigmoidf_(ca) * v0[j]; a1[j] = cb * sigmoidf_(cb) * v1[j]; }
                const bool valid = (m > 0 || fr >= 2) && !(sample && m == 2 && fr < 2);
                if (valid) *(v4u*)(act + (size_t)row * DFF + c0) = pack8(a0, a1);
                if ((m & 1) == 0 && fr < 2) { float* sg = SG + (size_t)(blk * 8 + 2 * m + fr) * DFF + c0; *(f32x4*)sg = g0; *(f32x4*)(sg + 4) = g1;
                                              float* sv = SV + (size_t)(blk * 4 + m + fr) * DFF + c0; *(f32x4*)sv = v0; *(f32x4*)(sv + 4) = v1; }
                if ((m & 1) == 1 && fr >= 14) { float* sg = SG + (size_t)(blk * 8 + 2 * m + fr - 14) * DFF + c0; *(f32x4*)sg = g0; *(f32x4*)(sg + 4) = g1; }
                gp0 = g0; gp1 = g1; } }
    }
};
struct EpiInOdd {
    static constexpr bool PERM = true, AFTER_DRAIN = false;
    bf16* gb; bf16* zc; const float* rowss; const float* cw; float* SG;
    __device__ __forceinline__ void operator()(EPI_ARGS) const {
        if (u.pn < 4) {
            const int row0 = u.pm * 256 + wr * 64 + fr, col0 = u.pn * 256 + wc * 32 + 8 * fq;
#pragma unroll
            for (int ai = 0; ai < 2; ++ai)
#pragma unroll
                for (int m = 0; m < 4; ++m) { const int row = row0 + ai * 128 + m * 16; const float rs = rstd_of(rowss, row); bf16* rp = gb + (size_t)row * 1024 + col0;
#pragma unroll
                    for (int bj = 0; bj < 2; ++bj) *(v4u*)(rp + bj * 128) = pack8(acc[ai][bj][m][0] * rs, acc[ai][bj][m][1] * rs); }
            return;
        }
        const int c0 = (u.pn - 4) * 128 + wc * 32 + 8 * fq; const bool sample = u.pm == 64;
        const f32x4 w0a = *(const f32x4*)(cw + c0), w0b = *(const f32x4*)(cw + c0 + 4), w1a = *(const f32x4*)(cw + 1024 + c0), w1b = *(const f32x4*)(cw + 1024 + c0 + 4),
                    w2a = *(const f32x4*)(cw + 2048 + c0), w2b = *(const f32x4*)(cw + 2048 + c0 + 4);
#pragma unroll
        for (int ai = 0; ai < 2; ++ai) { f32x4 gp0 = {0.f, 0.f, 0.f, 0.f}, gp1 = {0.f, 0.f, 0.f, 0.f}; const int blk = u.pm * 4 + ai * 2 + wr;
#pragma unroll
            for (int m = 0; m < 4; ++m) { const int row = u.pm * 256 + ai * 128 + wr * 64 + m * 16 + fr; const float rs = rstd_of(rowss, row); const float rs2 = rs * rs;
                const f32x4 g0 = acc[ai][0][m][0] * acc[ai][1][m][0] * rs2, g1 = acc[ai][0][m][1] * acc[ai][1][m][1] * rs2;
                f32x4 a0, a1;
#pragma unroll
                for (int j = 0; j < 4; ++j) {
                    const float r1pa = dpp_ror1(gp0[j]), r1ca = dpp_ror1(g0[j]), r2pa = dpp_ror2(gp0[j]), r2ca = dpp_ror2(g0[j]);
                    const float r1pb = dpp_ror1(gp1[j]), r1cb = dpp_ror1(g1[j]), r2pb = dpp_ror2(gp1[j]), r2cb = dpp_ror2(g1[j]);
                    const float p1a = fr == 0 ? r1pa : r1ca, p2a = fr < 2 ? r2pa : r2ca;
                    const float p1b = fr == 0 ? r1pb : r1cb, p2b = fr < 2 ? r2pb : r2cb;
                    a0[j] = w0a[j] * p2a + w1a[j] * p1a + w2a[j] * g0[j]; a1[j] = w0b[j] * p2b + w1b[j] * p1b + w2b[j] * g1[j]; }
                const bool valid = (m > 0 || fr >= 2) && !(sample && m == 2 && fr < 2);
                if (valid) *(v4u*)(zc + (size_t)row * 1024 + c0) = pack8(a0, a1);
                if ((m & 1) == 0 && fr < 2) { float* sg = SG + (size_t)(blk * 8 + 2 * m + fr) * 1024 + c0; *(f32x4*)sg = g0; *(f32x4*)(sg + 4) = g1; }
                if ((m & 1) == 1 && fr >= 14) { float* sg = SG + (size_t)(blk * 8 + 2 * m + fr - 14) * 1024 + c0; *(f32x4*)sg = g0; *(f32x4*)(sg + 4) = g1; }
                gp0 = g0; gp1 = g1; } }
    }
};

__device__ __forceinline__ int rowmap(int mode, int n) {
    if (mode == 1) { if (n >= 512 && n < 1152) { const int d = n & 63; return (n & ~63) | (32 * ((d >> 4) & 1) + 8 * ((d >> 2) & 3) + 4 * (d >> 5) + (d & 3)); } return n; }
    if (mode == 2) { return n < DFF ? ((n >> 7) * 256 + (n & 127)) : (((n - DFF) >> 7) * 256 + 128 + ((n - DFF) & 127)); }
    if (mode == 3) { if (n < 1024) return n; const int c = (n - 1024) & 1023, z = n >= 2048 ? 1 : 0; return 1024 + (c >> 7) * 256 + z * 128 + (c & 127); }
    return n;
}
__device__ __forceinline__ void tr_item(const float* W, int K, int N, bf16* WT, const float* gain, float scale, int mode, LAS float* scr, int item, int lane) {
    const int nblk = N / 32, kb = item / nblk, nb = item % nblk, k0 = 64 * kb, n0 = 32 * nb;
#pragma unroll
    for (int i = 0; i < 8; ++i) { const int idx = lane + 64 * i, kk = idx >> 3, n4 = (idx & 7) * 4; const float gs = gain ? gain[k0 + kk] * scale : scale;
        const f32x4 w = *(const f32x4*)(W + (size_t)(k0 + kk) * N + n0 + n4); LAS float* d = scr + kk * 33 + n4; d[0] = w[0] * gs; d[1] = w[1] * gs; d[2] = w[2] * gs; d[3] = w[3] * gs; }
    LDS_WAIT(); asm volatile("" ::: "memory");
    const int c = lane & 7;
#pragma unroll
    for (int j = 0; j < 4; ++j) { const int n = (lane >> 3) + 8 * j; const LAS float* s = scr + (8 * c) * 33 + n;
        v4u o; o.x = pg8::cvt_pk_bf16(s[0 * 33], s[1 * 33]); o.y = pg8::cvt_pk_bf16(s[2 * 33], s[3 * 33]); o.z = pg8::cvt_pk_bf16(s[4 * 33], s[5 * 33]); o.w = pg8::cvt_pk_bf16(s[6 * 33], s[7 * 33]);
        *(v4u*)(WT + (size_t)rowmap(mode, n0 + n) * K + k0 + 8 * c) = o; }
    LDS_WAIT(); asm volatile("" ::: "memory");
}
__device__ __forceinline__ double dexp_(double y) {
    const double k = rint(y * 1.4426950408889634); const double r = (y - k * 0.6931471803691238) - k * 1.9082149292705877e-10;
    double p = 1.0 / 6227020800.0;
    p = p * r + 1.0 / 479001600.0; p = p * r + 1.0 / 39916800.0; p = p * r + 1.0 / 3628800.0; p = p * r + 1.0 / 362880.0; p = p * r + 1.0 / 40320.0; p = p * r + 1.0 / 5040.0;
    p = p * r + 1.0 / 720.0; p = p * r + 1.0 / 120.0; p = p * r + 1.0 / 24.0; p = p * r + 1.0 / 6.0; p = p * r + 0.5; p = p * r + 1.0; p = p * r + 1.0;
    const long long bits = (long long)(1023 + (int)k) << 52; return p * __builtin_bit_cast(double, bits);
}
__device__ __forceinline__ void dsincos_(double x, double& s, double& c) {
    const double k = rint(x * 0.6366197723675814); const double r = (x - k * 1.5707963267948966) - k * 6.123233995736766e-17; const double r2 = r * r;
    const double sp = r * (1.0 + r2 * (-1.0 / 6.0 + r2 * (1.0 / 120.0 + r2 * (-1.0 / 5040.0 + r2 * (1.0 / 362880.0 + r2 * (-1.0 / 39916800.0 + r2 * (1.0 / 6227020800.0)))))));
    const double cp = 1.0 + r2 * (-0.5 + r2 * (1.0 / 24.0 + r2 * (-1.0 / 720.0 + r2 * (1.0 / 40320.0 + r2 * (-1.0 / 3628800.0 + r2 * (1.0 / 479001600.0 + r2 * (-1.0 / 87178291200.0)))))));
    const int q = ((int)k) & 3;
    s = q == 0 ? sp : q == 1 ? cp : q == 2 ? -sp : -cp; c = q == 0 ? cp : q == 1 ? -sp : q == 2 ? -cp : sp;
}

__device__ __forceinline__ const bf16* kvptr(const bf16* proj, const bf16* cb, int sample, int b, int c, int kvh, int kk, int isv) {
    if (!sample) { int pos = (c - 2) * 64 + kk; pos = pos < 0 ? 0 : pos; return proj + (size_t)(b * 4096 + pos) * 1280 + 1024 + isv * 128 + kvh * 64; }
    if (kk < 128) return cb + (size_t)(b * 128 + kk) * 128 + kvh * 64;
    int t = kk - 128; t = t > 31 ? 31 : t; return proj + (size_t)(MP + b * 32 + t) * 1280 + 1024 + isv * 128 + kvh * 64;
}
__device__ __forceinline__ void swa_phase(const bf16* proj, const bf16* ckb, const bf16* cvb, const float* sinks, bf16* ycat, LAS unsigned char* lds, int tid, int wave, int lane, int G) {
    LAS bf16* VT = (LAS bf16*)lds;
    const int fr = lane & 15, quad = lane >> 4;
    for (int it = blockIdx.x; it < 528; it += G) {
        int b, c, kvh, sample;
        if (it < 512) { sample = 0; b = it >> 7; c = (it >> 1) & 63; kvh = it & 1; } else { sample = 1; b = (it - 512) >> 1; c = 0; kvh = it & 1; }
        __syncthreads();
#pragma unroll
        for (int i = 0; i < 3; ++i) { const int idx = tid + 512 * i, kk = idx % 192, dg = idx / 192; const v4u w = *(const v4u*)(kvptr(proj, cvb, sample, b, c, kvh, kk, 1) + dg * 8);
            LAS bf16* vp = VT + (dg * 8) * 200 + kk;
            vp[0] = (bf16)(w.x & 0xffffu); vp[200] = (bf16)(w.x >> 16); vp[400] = (bf16)(w.y & 0xffffu); vp[600] = (bf16)(w.y >> 16);
            vp[800] = (bf16)(w.z & 0xffffu); vp[1000] = (bf16)(w.z >> 16); vp[1200] = (bf16)(w.w & 0xffffu); vp[1400] = (bf16)(w.w >> 16); }
        __syncthreads();
        const int gq = wave >> 1, qhalf = wave & 1, head = kvh * 4 + gq;
        if (!(sample && qhalf)) {
            const int plo = sample ? 0 : (c >= 2 ? 0 : (2 - c) * 2), phi = sample ? 5 : 6;
            bf16x8 qf[2][2];
#pragma unroll
            for (int qb = 0; qb < 2; ++qb) { const int q = qhalf * 32 + qb * 16 + fr; const int row = sample ? MP + b * 32 + (q & 31) : b * 4096 + c * 64 + q;
                const bf16* qp = proj + (size_t)row * 1280 + 512 + head * 64 + quad * 8; qf[qb][0] = *(const bf16x8*)qp; qf[qb][1] = *(const bf16x8*)(qp + 32); }
            f32x4 s[12][2];
#pragma unroll
            for (int kb = 0; kb < 12; ++kb) { const int key = 32 * (kb >> 1) + (fr >> 2) * 8 + 4 * (kb & 1) + (fr & 3); const bf16* kp = kvptr(proj, ckb, sample, b, c, kvh, key, 0) + quad * 8;
                const bf16x8 k0 = *(const bf16x8*)kp, k1 = *(const bf16x8*)(kp + 32);
#pragma unroll
                for (int qb = 0; qb < 2; ++qb) { f32x4 a = {0.f, 0.f, 0.f, 0.f}; a = MFMA16(k0, qf[qb][0], a); a = MFMA16(k1, qf[qb][1], a); s[kb][qb] = a; } }
            const float sink = sinks[head];
            bf16x8 pf[6][2];
#pragma unroll
            for (int qb = 0; qb < 2; ++qb) { float mx = sink;
#pragma unroll
                for (int kb = 0; kb < 12; ++kb) { const bool pv = (kb >> 1) >= plo && (kb >> 1) < phi;
#pragma unroll
                    for (int j = 0; j < 4; ++j) { const float v = pv ? s[kb][qb][j] : -1e30f; s[kb][qb][j] = v; mx = fmaxf(mx, v); } }
                mx = fmaxf(mx, __shfl_xor(mx, 16)); mx = fmaxf(mx, __shfl_xor(mx, 32));
                float sum = 0.f;
#pragma unroll
                for (int kb = 0; kb < 12; ++kb)
#pragma unroll
                    for (int j = 0; j < 4; ++j) { const float e = __expf(s[kb][qb][j] - mx); s[kb][qb][j] = e; sum += e; }
                sum += __shfl_xor(sum, 16); sum += __shfl_xor(sum, 32); sum += __expf(sink - mx);
                const float inv = 1.0f / sum;
#pragma unroll
                for (int pr = 0; pr < 6; ++pr) pf[pr][qb] = __builtin_bit_cast(bf16x8, pack8(s[2 * pr][qb] * inv, s[2 * pr + 1][qb] * inv)); }
#pragma unroll
            for (int db = 0; db < 4; ++db) { bf16x8 vf[6];
#pragma unroll
                for (int pr = 0; pr < 6; ++pr) vf[pr] = *(const LAS bf16x8*)(VT + (db * 16 + fr) * 200 + 32 * pr + quad * 8);
#pragma unroll
                for (int qb = 0; qb < 2; ++qb) { f32x4 o = {0.f, 0.f, 0.f, 0.f};
#pragma unroll
                    for (int pr = 0; pr < 6; ++pr) o = MFMA16(pf[pr][qb], vf[pr], o);
#pragma unroll
                    for (int j = 0; j < 4; ++j) { const int q = qhalf * 32 + qb * 16 + quad * 4 + j;
                        if (!sample || q < 32) { const int row = sample ? MP + b * 32 + q : b * 4096 + c * 64 + q; ycat[(size_t)row * 1024 + 512 + head * 64 + db * 16 + fr] = (bf16)f2bf(o[j]); } } } }
        }
    }
    __syncthreads();
}

__device__ __forceinline__ void xattn_phase(const bf16* qx, const bf16* memk_l, const bf16* memvT_l, bf16* ox, int wave, int lane, int G) {
    const int fr = lane & 15, quad = lane >> 4;
    for (int t = wave * G + (int)blockIdx.x; t < 4160; t += 8 * G) {
        int bb, h, row0;
        if (t < 4096) { const int pair = t >> 8; bb = pair >> 2; h = pair & 3; row0 = bb * 4096 + (t & 255) * 16; }
        else { const int s = t - 4096, b = s >> 3; h = (s >> 1) & 3; bb = 4 + b; row0 = MP + b * 32 + (s & 1) * 16; }
        bf16x8 qf[8];
#pragma unroll
        for (int ks = 0; ks < 8; ++ks) qf[ks] = *(const bf16x8*)(qx + (size_t)(row0 + fr) * 1024 + h * 256 + ks * 32 + quad * 8);
        const bf16* kbase = memk_l + (size_t)bb * 262144 + h * 256 + quad * 8;
        f32x4 s[16];
#pragma unroll
        for (int kb = 0; kb < 16; ++kb) { const int key = 32 * (kb >> 1) + (fr >> 2) * 8 + 4 * (kb & 1) + (fr & 3); const bf16* kp = kbase + (size_t)key * 1024; f32x4 a = {0.f, 0.f, 0.f, 0.f};
#pragma unroll
            for (int ks = 0; ks < 8; ++ks) a = MFMA16(*(const bf16x8*)(kp + ks * 32), qf[ks], a);
            s[kb] = a; }
        float mx = -1e30f;
#pragma unroll
        for (int kb = 0; kb < 16; ++kb)
#pragma unroll
            for (int j = 0; j < 4; ++j) mx = fmaxf(mx, s[kb][j]);
        mx = fmaxf(mx, __shfl_xor(mx, 16)); mx = fmaxf(mx, __shfl_xor(mx, 32));
        float sum = 0.f;
#pragma unroll
        for (int kb = 0; kb < 16; ++kb)
#pragma unroll
            for (int j = 0; j < 4; ++j) { const float e = __expf(s[kb][j] - mx); s[kb][j] = e; sum += e; }
        sum += __shfl_xor(sum, 16); sum += __shfl_xor(sum, 32);
        const float inv = 1.0f / sum;
        bf16x8 pf[8];
#pragma unroll
        for (int pr = 0; pr < 8; ++pr) pf[pr] = __builtin_bit_cast(bf16x8, pack8(s[2 * pr] * inv, s[2 * pr + 1] * inv));
        const bf16* vbase = memvT_l + (size_t)bb * 262144 + (size_t)(h * 256 + fr) * 256 + quad * 8;
#pragma unroll 4
        for (int db = 0; db < 16; ++db) { f32x4 o = {0.f, 0.f, 0.f, 0.f};
#pragma unroll
            for (int pr = 0; pr < 8; ++pr) o = MFMA16(pf[pr], *(const bf16x8*)(vbase + (size_t)db * 4096 + pr * 32), o);
#pragma unroll
            for (int j = 0; j < 4; ++j) ox[(size_t)(row0 + quad * 4 + j) * 1024 + h * 256 + db * 16 + fr] = (bf16)f2bf(o[j]); }
    }
}


__device__ __forceinline__ void xstage(const bf16* src, size_t rowstride, LAS unsigned char* lds, int tid) {
    v4u t[16];
#pragma unroll
    for (int i = 0; i < 16; ++i) { const int row = (tid >> 5) + 16 * i, ch = tid & 31; t[i] = *(const GAS v4u*)((const GAS bf16*)src + (size_t)row * rowstride + ch * 8); }
#pragma unroll
    for (int i = 0; i < 16; ++i) { const int row = (tid >> 5) + 16 * i, ch = tid & 31; *(LAS v4u*)(lds + row * 528 + ch * 16) = t[i]; }
}
__device__ __forceinline__ void xattn_phase2(const bf16* qx, const bf16* memk_l, const bf16* memvT_l, bf16* ox, LAS unsigned char* lds, int tid, int wave, int lane, int G) {
    const int fr = lane & 15, quad = lane >> 4;
    for (int it = blockIdx.x; it < 256 + 32; it += G) {
        int bb, h, rowbase, nqb; bool active;
        if (it < 256) { bb = it >> 6; h = (it >> 4) & 3; rowbase = bb * 4096 + (it & 15) * 256; nqb = 2; active = true; }
        else { const int s = it - 256, b = s >> 2; h = s & 3; bb = 4 + b; rowbase = MP + b * 32; nqb = 1; active = wave < 2; }
        __syncthreads();
        xstage(memk_l + (size_t)bb * 262144 + h * 256, 1024, lds, tid);
        __syncthreads();
        bf16x8 pf[2][8];
#pragma unroll
        for (int qi = 0; qi < 2; ++qi) {
            if (qi < nqb && active) {
                const int row0 = rowbase + qi * 128 + wave * 16;
                bf16x8 qf[8];
#pragma unroll
                for (int ks = 0; ks < 8; ++ks) qf[ks] = *(const GAS bf16x8*)((const GAS bf16*)qx + (size_t)(row0 + fr) * 1024 + h * 256 + ks * 32 + quad * 8);
                f32x4 s[16];
#pragma unroll
                for (int kb = 0; kb < 16; ++kb) { const int key = 32 * (kb >> 1) + (fr >> 2) * 8 + 4 * (kb & 1) + (fr & 3); const LAS unsigned char* kp = lds + key * 528 + quad * 16; f32x4 a = {0.f, 0.f, 0.f, 0.f};
#pragma unroll
                    for (int ks = 0; ks < 8; ++ks) a = MFMA16(*(const LAS bf16x8*)(kp + ks * 64), qf[ks], a);
                    s[kb] = a; }
                float mx = -1e30f;
#pragma unroll
                for (int kb = 0; kb < 16; ++kb)
#pragma unroll
                    for (int j = 0; j < 4; ++j) mx = fmaxf(mx, s[kb][j]);
                mx = fmaxf(mx, __shfl_xor(mx, 16)); mx = fmaxf(mx, __shfl_xor(mx, 32));
                float sum = 0.f;
#pragma unroll
                for (int kb = 0; kb < 16; ++kb)
#pragma unroll
                    for (int j = 0; j < 4; ++j) { const float e = __expf(s[kb][j] - mx); s[kb][j] = e; sum += e; }
                sum += __shfl_xor(sum, 16); sum += __shfl_xor(sum, 32);
                const float inv = 1.0f / sum;
#pragma unroll
                for (int pr = 0; pr < 8; ++pr) pf[qi][pr] = __builtin_bit_cast(bf16x8, pack8(s[2 * pr] * inv, s[2 * pr + 1] * inv));
            }
        }
        __syncthreads();
        xstage(memvT_l + (size_t)bb * 262144 + (size_t)h * 65536, 256, lds, tid);
        __syncthreads();
#pragma unroll
        for (int qi = 0; qi < 2; ++qi) {
            if (qi < nqb && active) {
                const int row0 = rowbase + qi * 128 + wave * 16;
#pragma unroll 4
                for (int db = 0; db < 16; ++db) { f32x4 o = {0.f, 0.f, 0.f, 0.f}; const LAS unsigned char* vp = lds + (db * 16 + fr) * 528 + quad * 16;
#pragma unroll
                    for (int pr = 0; pr < 8; ++pr) o = MFMA16(*(const LAS bf16x8*)(vp + pr * 64), pf[qi][pr], o);
                    u32x2v w; w.x = pk2(o[0], o[1]); w.y = pk2(o[2], o[3]);
                    *(GAS u32x2v*)((GAS bf16*)ox + (size_t)(row0 + fr) * 1024 + h * 256 + db * 16 + quad * 4) = w; }
            }
        }
    }
    __syncthreads();
}

__device__ __forceinline__ void s5_stage_u(const bf16* up, LAS float* ubuf, int lane) {
    const v4u w0 = *(const v4u*)up, w1 = *(const v4u*)(up + 8);
    LAS f32x4* d = (LAS f32x4*)(ubuf + lane * 16);
    d[0] = (f32x4){bflo(w0.x), bfhi(w0.x), bflo(w0.y), bfhi(w0.y)}; d[1] = (f32x4){bflo(w0.z), bfhi(w0.z), bflo(w0.w), bfhi(w0.w)};
    d[2] = (f32x4){bflo(w1.x), bfhi(w1.x), bflo(w1.y), bfhi(w1.y)}; d[3] = (f32x4){bflo(w1.z), bfhi(w1.z), bflo(w1.w), bfhi(w1.w)};
}
__device__ __forceinline__ f32x2v lo2_(f32x4 v) { return __builtin_shufflevector(v, v, 0, 1); }
__device__ __forceinline__ f32x2v hi2_(f32x4 v) { return __builtin_shufflevector(v, v, 2, 3); }
#define S5_STEP(sidx) do { const LAS f32x4* up_ = (const LAS f32x4*)(ubuf + (sidx) * 16); const f32x4 u0 = up_[0], u1 = up_[1], u2 = up_[2], u3 = up_[3]; \
    f32x2v ac_ = lo2_(bb[0]) * u0[0]; ac_ = hi2_(bb[0]) * u0[1] + ac_; ac_ = lo2_(bb[1]) * u0[2] + ac_; ac_ = hi2_(bb[1]) * u0[3] + ac_; \
    ac_ = lo2_(bb[2]) * u1[0] + ac_; ac_ = hi2_(bb[2]) * u1[1] + ac_; ac_ = lo2_(bb[3]) * u1[2] + ac_; ac_ = hi2_(bb[3]) * u1[3] + ac_; \
    ac_ = lo2_(bb[4]) * u2[0] + ac_; ac_ = hi2_(bb[4]) * u2[1] + ac_; ac_ = lo2_(bb[5]) * u2[2] + ac_; ac_ = hi2_(bb[5]) * u2[3] + ac_; \
    ac_ = lo2_(bb[6]) * u3[0] + ac_; ac_ = hi2_(bb[6]) * u3[1] + ac_; ac_ = lo2_(bb[7]) * u3[2] + ac_; ac_ = hi2_(bb[7]) * u3[3] + ac_; \
    const float nr_ = ar * hr - ai * hi + ac_.x, ni_ = ar * hi + ai * hr + ac_.y; hr = nr_; hi = ni_; } while (0)

__device__ __forceinline__ void s5_local(const bf16* proj, const float* abar, const float* bbar, float* sloc, LAS float* ubuf, int slot, int nslots, int lane) {
    for (int t = slot; t < 8192; t += nslots) {
        const int chunk = t & 63, g = (t >> 6) & 31, b = t >> 11;
        s5_stage_u(proj + (size_t)(b * 4096 + chunk * 64 + lane) * 1280 + g * 16, ubuf, lane);
        const float ar = abar[(g * 64 + lane) * 2], ai = abar[(g * 64 + lane) * 2 + 1];
        f32x4 bb[8];
#pragma unroll
        for (int i = 0; i < 8; ++i) bb[i] = *(const f32x4*)(bbar + (size_t)(g * 64 + lane) * 32 + i * 4);
        float hr = 0.f, hi = 0.f;
#pragma unroll 4
        for (int s = 0; s < 64; ++s) S5_STEP(s);
        *(f32x2v*)(sloc + (size_t)t * 128 + lane * 2) = (f32x2v){hr, hi};
    }
}
__device__ __forceinline__ void s5_out(const bf16* proj, const float* abar, const float* bbar, const float* sloc, const float* st_re, const float* st_im, const float* c_re, const float* c_im,
                                       const float* dcoef, bf16* gbuf, float* out, LAS float* ubuf, LAS unsigned* hbuf, int slot, int nslots, int lane) {
    const int fr = lane & 15, quad = lane >> 4;
    for (int t = slot; t < 8192 + 256; t += nslots) {
        const int sample = t >= 8192; int b, g, chunk, nblk, rowbase;
        if (!sample) { chunk = t & 63; g = (t >> 6) & 31; b = t >> 11; nblk = 4; rowbase = b * 4096 + chunk * 64; } else { const int s = t - 8192; g = s & 31; b = s >> 5; chunk = 0; nblk = 2; rowbase = MP + b * 32; }
        if (lane < nblk * 16) s5_stage_u(proj + (size_t)(rowbase + lane) * 1280 + g * 16, ubuf, lane);
        const float ar = abar[(g * 64 + lane) * 2], ai = abar[(g * 64 + lane) * 2 + 1];
        f32x4 bb[8];
#pragma unroll
        for (int i = 0; i < 8; ++i) bb[i] = *(const f32x4*)(bbar + (size_t)(g * 64 + lane) * 32 + i * 4);
        float hr, hi;
        if (!sample) { float pr = ar, pi = ai;
#pragma unroll
            for (int i = 0; i < 6; ++i) { const float t1 = pr * pr - pi * pi; pi = 2.f * pr * pi; pr = t1; }
            hr = 0.f; hi = 0.f; const float* sp = sloc + (size_t)(t - chunk) * 128 + lane * 2;
#pragma unroll 16
            for (int cc = 0; cc < chunk; ++cc) { const f32x2v sv = *(const f32x2v*)(sp + (size_t)cc * 128); const float nr = pr * hr - pi * hi + sv.x, ni = pr * hi + pi * hr + sv.y; hr = nr; hi = ni; } }
        else { hr = st_re[(b * 32 + g) * 64 + lane]; hi = st_im[(b * 32 + g) * 64 + lane]; }
        bf16x8 cf[4];
#pragma unroll
        for (int ks = 0; ks < 4; ++ks) { const f32x4 cr = *(const f32x4*)(c_re + (size_t)(g * 16 + fr) * 64 + ks * 16 + quad * 4), ci = *(const f32x4*)(c_im + (size_t)(g * 16 + fr) * 64 + ks * 16 + quad * 4);
            v4u w; w.x = pg8::cvt_pk_bf16(cr[0], -ci[0]); w.y = pg8::cvt_pk_bf16(cr[1], -ci[1]); w.z = pg8::cvt_pk_bf16(cr[2], -ci[2]); w.w = pg8::cvt_pk_bf16(cr[3], -ci[3]); cf[ks] = __builtin_bit_cast(bf16x8, w); }
        const float dco = dcoef[g * 16 + fr];
        for (int blk = 0; blk < nblk; ++blk) {
#pragma unroll 4
            for (int s = 0; s < 16; ++s) { S5_STEP(blk * 16 + s); hbuf[s * 68 + lane] = pg8::cvt_pk_bf16(hr, hi); }
            f32x4 y = {0.f, 0.f, 0.f, 0.f};
#pragma unroll
            for (int ks = 0; ks < 4; ++ks) { const bf16x8 a = *(const LAS bf16x8*)(hbuf + fr * 68 + ks * 16 + quad * 4); y = MFMA16(a, cf[ks], y); }
#pragma unroll
            for (int j = 0; j < 4; ++j) { const int s = blk * 16 + quad * 4 + j; const float uu = ubuf[s * 16 + fr]; const float yv = y[j] + dco * uu;
                const float z = 0.7978845608028654f * (yv + 0.044715f * yv * yv * yv); const float th = 1.0f - 2.0f / (1.0f + __expf(2.0f * z)); const float gl = 0.5f * yv * (1.0f + th);
                gbuf[(size_t)(rowbase + s) * 512 + g * 16 + fr] = (bf16)f2bf(gl); }
        }
        if (!sample && chunk == 63) { out[OFF_SRP + (b * 32 + g) * 64 + lane] = hr; out[OFF_SIP + (b * 32 + g) * 64 + lane] = hi; }
        if (sample) { out[OFF_SRS + (b * 32 + g) * 64 + lane] = hr; out[OFF_SIS + (b * 32 + g) * 64 + lane] = hi; }
    }
}


template <int KIND>
__device__ __forceinline__ void sample_gemm(const bf16* A, const bf16* Bt, int K, LAS unsigned char* lds, int tid, int wave, int lane,
                                            bf16* xbp, const float* base_f32, float* part_next, const float* part_cur, bf16* O) {
    const int fr = lane & 15, quad = lane >> 4;
    LAS f32x4* red = (LAS f32x4*)lds;
    LAS float* ssred = (LAS float*)(lds + 32768);
    for (int tile = blockIdx.x; tile < 256; tile += gridDim.x) {
        const int r0 = MP + (tile >> 4) * 16, c0 = (tile & 15) * 64, kw = K >> 3;
        const bf16* ap = A + (size_t)(r0 + fr) * K + wave * kw + quad * 8;
        const bf16* bp = Bt + (size_t)(c0 + fr) * K + wave * kw + quad * 8;
        f32x4 acc[4];
#pragma unroll
        for (int cb = 0; cb < 4; ++cb) acc[cb] = (f32x4){0.f, 0.f, 0.f, 0.f};
        const int nks = kw >> 5;
        for (int k0 = 0; k0 < nks; k0 += 4) {
            bf16x8 a[4], b[4][4];
#pragma unroll
            for (int i = 0; i < 4; ++i) { const int ks = (k0 + i < nks) ? k0 + i : nks - 1;
                a[i] = *(const bf16x8*)(ap + ks * 32);
#pragma unroll
                for (int cb = 0; cb < 4; ++cb) b[i][cb] = *(const bf16x8*)(bp + (size_t)cb * 16 * K + ks * 32); }
            __builtin_amdgcn_sched_barrier(0);
#pragma unroll
            for (int i = 0; i < 4; ++i) if (k0 + i < nks) {
#pragma unroll
                for (int cb = 0; cb < 4; ++cb) acc[cb] = MFMA16(b[i][cb], a[i], acc[cb]); }
        }
#pragma unroll
        for (int cb = 0; cb < 4; ++cb) red[(wave * 4 + cb) * 64 + lane] = acc[cb] * 1.0f;
        __syncthreads();
        if (tid < 256) { const int cb = tid >> 6, l2 = tid & 63; f32x4 v = red[cb * 64 + l2];
#pragma unroll
            for (int w = 1; w < 8; ++w) v = v + red[(w * 4 + cb) * 64 + l2];
            const int row = r0 + (l2 & 15), col = c0 + cb * 16 + 4 * (l2 >> 4); const size_t off = (size_t)row * 1024 + col;
            if (KIND == 0) { f32x4 bs;
                if (base_f32) bs = *(const f32x4*)(base_f32 + off);
                else { const u32x2v w = *(const u32x2v*)(xbp + off); bs = (f32x4){bflo(w.x), bfhi(w.x), bflo(w.y), bfhi(w.y)}; }
                v = v + bs; u32x2v o; o.x = pk2(v[0], v[1]); o.y = pk2(v[2], v[3]); *(u32x2v*)(xbp + off) = o;
                float ss = (v[0] * v[0] + v[1] * v[1]) + (v[2] * v[2] + v[3] * v[3]); ss += __shfl_xor(ss, 16); ss += __shfl_xor(ss, 32);
                if ((l2 >> 4) == 0) ssred[cb * 16 + (l2 & 15)] = ss; }
            else { const float rs = rstd_of(part_cur, row); u32x2v o; o.x = pk2(v[0] * rs, v[1] * rs); o.y = pk2(v[2] * rs, v[3] * rs); *(u32x2v*)(O + off) = o; }
        }
        if (KIND == 0) { __syncthreads(); if (tid < 16) part_next[(size_t)(r0 + tid) * 16 + (tile & 15)] = (ssred[tid] + ssred[16 + tid]) + (ssred[32 + tid] + ssred[48 + tid]); }
        __syncthreads();
    }
}

struct Params { const float* in[36]; float* out; unsigned char* ws; int use_cg, pad; };

__global__ void __launch_bounds__(512, 2) mega_fwd(Params P) {
    extern __shared__ __attribute__((aligned(16))) unsigned char lds_raw[];
    LAS unsigned char* lds = (LAS unsigned char*)lds_raw;
    volatile LAS unsigned* MISC = (volatile LAS unsigned*)(lds + MISC_OFF);
    const int G = gridDim.x, NGW = G * 8, NT = G * 512;
    const int wave_s = __builtin_amdgcn_readfirstlane(threadIdx.x >> 6);
    for (int u = threadIdx.x; u < (LDS_BYTES - 131072) / 4; u += 512) ((LAS unsigned*)(lds + 131072))[u] = 0u;
    __syncthreads();
    XcdBarrier bar = xcd_barrier_post((unsigned*)(P.ws + WS_BAR), MISC + 8);
#ifndef STOP_AFTER
#define STOP_AFTER 1000
#endif
    int ph = 0;
#define RUN (ph < STOP_AFTER)
#define FRESH() const int tid = fresh_tid(wave_s), lane = tid & 63, wave = __builtin_amdgcn_readfirstlane(tid >> 6); const int gw = blockIdx.x * 8 + wave, gt = blockIdx.x * 512 + tid; (void)gw; (void)gt; (void)lane; LAS float* wscr = (LAS float*)(lds + 32768 + wave * 12288); (void)wscr;
#define SEAM() do { if (P.use_cg) cg::this_grid().sync(); else xcd_barrier(bar); ++ph; } while (0)

#define part ((float*)(ws + WS_PART))
#define PARTBUF(k) (part + (size_t)((k) & 1) * PART_ELEMS)
#define ropec ((float*)(ws + WS_ROPE))
#define ropes (ropec + 4096 * 32)
#define abar ((float*)(ws + WS_SSM))
#define bbar (abar + 32 * 64 * 2)
#define ckb ((bf16*)(ws + WS_CKV))
#define cvb (ckb + 8 * 128 * 128)
#define sloc ((float*)(ws + WS_SLOC))
#define memk ((bf16*)(ws + WS_MEMK))
#define memvT ((bf16*)(ws + WS_MEMVT))
#define SG ((float*)(ws + WS_SIDE))
#define SV ((float*)(ws + WS_SIDE + SG_BYTES))
#define WT ((bf16*)(ws + WS_WT))
#define xb ((bf16*)(ws + WS_XB))
#define tmp (ws + WS_TMP)
#define proj0 ((bf16*)(tmp + TMP_PROJ0))
#define gbuf ((bf16*)(tmp + TMP_GBUF))
#define ycat ((bf16*)(tmp + TMP_YCAT))
#define memb ((bf16*)(tmp + TMP_MEMB))
#define qx ((bf16*)(tmp + TMP_QX))
#define ox ((bf16*)(tmp + TMP_OX))
#define act ((bf16*)(tmp + TMP_ACT))
#define gbm ((bf16*)(tmp + TMP_GB))
#define zc ((bf16*)(tmp + TMP_ZC))
#define PTRS() unsigned char* ws = P.ws; float* out = P.out; asm volatile("" : "+s"(ws), "+s"(out));
    if (RUN) { PTRS() FRESH()
        {
            constexpr int NITEMS = 640 + 128 + 512 + 2 * 512 + 2 * 1024 + 2 * 512 + 2 * 2816 + 2 * 1408 + 1536 + 512 + 2048;
            for (int it = gw; it < NITEMS; it += NGW) { int r = it;
#define TR(Wp, K_, N_, WTp, gainp, sc, mode) { const int ni_ = ((K_) / 64) * ((N_) / 32); if (r < ni_) { tr_item(Wp, K_, N_, WTp, gainp, sc, mode, wscr, r, lane); continue; } r -= ni_; }
                TR(P.in[15], 1024, 1280, WT + WT_INEVEN, P.in[11], 1.f, 1)
                TR(P.in[25], 512, 512, WT + WT_GLU, nullptr, 1.f, 0)
                TR(P.in[16], 1024, 1024, WT + WT_OUTEVEN, nullptr, 1.f, 0)
                TR(P.in[30], 1024, 1024, WT + WT_WQ, P.in[12], 0.0625f, 0)
                TR(P.in[30] + 1048576, 1024, 1024, WT + WT_WQ + 1048576, P.in[12] + 1024, 0.0625f, 0)
                TR(P.in[31], 1024, 2048, WT + WT_WKV, nullptr, 1.f, 0)
                TR(P.in[31] + 2097152, 1024, 2048, WT + WT_WKV + 2097152, nullptr, 1.f, 0)
                TR(P.in[32], 1024, 1024, WT + WT_WO, nullptr, 1.f, 0)
                TR(P.in[32] + 1048576, 1024, 1024, WT + WT_WO + 1048576, nullptr, 1.f, 0)
                TR(P.in[33], 1024, 5632, WT + WT_UP, P.in[13], 1.f, 2)
                TR(P.in[33] + (size_t)1024 * 5632, 1024, 5632, WT + WT_UP + (size_t)5632 * 1024, P.in[13] + 1024, 1.f, 2)
                TR(P.in[35], 2816, 1024, WT + WT_DOWN, nullptr, 1.f, 0)
                TR(P.in[35] + (size_t)2816 * 1024, 2816, 1024, WT + WT_DOWN + (size_t)2816 * 1024, nullptr, 1.f, 0)
                TR(P.in[27], 1024, 3072, WT + WT_INODD, P.in[11] + 1024, 1.f, 3)
                TR(P.in[29], 1024, 1024, WT + WT_OUTODD, nullptr, 1.f, 0)
                { const int mi = r >> 7, l = mi >> 3, b = mi & 7; tr_item(P.in[10] + (size_t)mi * 262144, 256, 1024, memvT + (size_t)(l * 12 + 4 + b) * 262144, nullptr, 1.f, 0, wscr, r & 127, lane); }
            }
        }
        for (int m = gw; m < MROWS; m += NGW) { const float* xr = m < MP ? P.in[0] + (size_t)m * 1024 : P.in[1] + (size_t)(m - MP) * 1024; float ss = 0.f;
#pragma unroll
            for (int j = 0; j < 4; ++j) { const f32x4 v = *(const f32x4*)(xr + (lane + 64 * j) * 4); ss += (v[0] * v[0] + v[1] * v[1]) + (v[2] * v[2] + v[3] * v[3]);
                u32x2v w; w.x = pg8::cvt_pk_bf16(v[0], v[1]); w.y = pg8::cvt_pk_bf16(v[2], v[3]); *(u32x2v*)(xb + (size_t)m * 1024 + (lane + 64 * j) * 4) = w; }
            ss = wave_sum(ss); if (lane < 16) PARTBUF(0)[(size_t)m * 16 + lane] = lane == 0 ? ss : 0.f; }
        for (int i = gt; i < 262144; i += NT) { const f32x4 v = *(const f32x4*)(P.in[2] + (size_t)i * 4); u32x2v w; w.x = pg8::cvt_pk_bf16(v[0], v[1]); w.y = pg8::cvt_pk_bf16(v[2], v[3]); *(u32x2v*)(memb + (size_t)i * 4) = w; }
        for (int i = gt; i < 1048576; i += NT) { const size_t e = (size_t)i * 4; const int lb = (int)(e >> 18), l = lb >> 3, b = lb & 7; const f32x4 v = *(const f32x4*)(P.in[9] + e);
            u32x2v w; w.x = pg8::cvt_pk_bf16(v[0], v[1]); w.y = pg8::cvt_pk_bf16(v[2], v[3]); *(u32x2v*)(memk + (size_t)(l * 12 + 4 + b) * 262144 + (e & 262143)) = w; }
        for (int i = gt; i < 65536; i += NT) { const int j = i & 32767; const float* src = (i < 32768 ? P.in[3] : P.in[4]) + (size_t)j * 4; bf16* dst = (i < 32768 ? ckb : cvb) + (size_t)j * 4;
            const f32x4 v = *(const f32x4*)src; u32x2v w; w.x = pg8::cvt_pk_bf16(v[0], v[1]); w.y = pg8::cvt_pk_bf16(v[2], v[3]); *(u32x2v*)dst = w; }
        for (int i = gt; i < 4096 * 32; i += NT) { const int pos = i >> 5, d = i & 31; const double inv = dexp_(-(double)d * (9.210340371976184 / 32.0)); double s, c; dsincos_((double)pos * inv, s, c); ropec[i] = (float)c; ropes[i] = (float)s; }
        for (int i = gt; i < 2048; i += NT) { const double are = P.in[17][i], aim = P.in[18][i], dt = dexp_((double)P.in[19][i]); double s, c; dsincos_(aim * dt, s, c); const double mag = dexp_(are * dt);
            const double br = mag * c, bi = mag * s; abar[2 * i] = (float)br; abar[2 * i + 1] = (float)bi;
            const double nr = br - 1.0, ni = bi, den = are * are + aim * aim; const double qr = (nr * are + ni * aim) / den, qi = (ni * are - nr * aim) / den;
#pragma unroll 4
            for (int h = 0; h < 16; ++h) { const double xr = P.in[20][(size_t)i * 16 + h], xi = P.in[21][(size_t)i * 16 + h]; bbar[(size_t)i * 32 + 2 * h] = (float)(qr * xr - qi * xi); bbar[(size_t)i * 32 + 2 * h + 1] = (float)(qr * xi + qi * xr); } }
    }
    SEAM();
    if (RUN) { PTRS()
        if (G < 128 || (int)blockIdx.x >= G - 64) { pg8::Gemm g{memb, WT + WT_WKV, 1024, 4096, 1024}; pg8::StaticOrder S;
            if (G < 128) S.init(1024, 4096, G, (int)blockIdx.x); else S.init(1024, 4096, 64, (int)blockIdx.x - (G - 64)); EpiKV E{out, memk};
          pg8::gemm_phase<EpiKV, pg8::StaticOrder, true, true>(lds, g, S, E, wave_s); }
        { pg8::Gemm g{xb, WT + WT_INEVEN, MROWS, 1280, 1024}; pg8::StaticOrderF S; S.init(MROWS, 1280, G, (int)blockIdx.x); EpiIn0 E{proj0, PARTBUF(0), ropec, ropes, out};
          pg8::gemm_phase<EpiIn0, pg8::StaticOrderF, true, true>(lds, g, S, E, wave_s); }
    }
    SEAM();
    if (RUN) { PTRS() FRESH()
        swa_phase(proj0, ckb, cvb, P.in[26], ycat, lds, tid, wave, lane, G);
        s5_local(proj0, abar, bbar, sloc, wscr, wave * G + (int)blockIdx.x, NGW, lane);
        for (int it = wave * G + (int)blockIdx.x; it < 1024; it += NGW) { const int mi = it >> 7, l = mi >> 2, b = mi & 3;
            tr_item(out + OFF_MVP + (size_t)mi * 262144, 256, 1024, memvT + (size_t)(l * 12 + b) * 262144, nullptr, 1.f, 0, wscr, it & 127, lane); }
    }
    SEAM();
    if (RUN) { PTRS() FRESH() s5_out(proj0, abar, bbar, sloc, P.in[5], P.in[6], P.in[22], P.in[23], P.in[24], gbuf, out, wscr, (LAS unsigned*)(wscr + 1024), wave * G + (int)blockIdx.x, NGW, lane); }
    SEAM();
    if (RUN) { PTRS() pg8::Gemm g{gbuf, WT + WT_GLU, MROWS, 512, 512}; pg8::StaticOrder S; S.init(MROWS, 512, G, (int)blockIdx.x); EpiGlu E{gbuf, ycat};
        pg8::gemm_phase<EpiGlu, pg8::StaticOrder, true, true>(lds, g, S, E, wave_s); }
    SEAM();

#pragma unroll
    for (int l = 0; l < 2; ++l) {
        if (l == 1) {
            if (RUN) { PTRS() pg8::Gemm g{xb, WT + WT_INODD, MROWS, 3072, 1024}; pg8::StaticOrderF S; S.init(MROWS, 3072, G, (int)blockIdx.x); EpiInOdd E{gbm, zc, PARTBUF(3), P.in[28], SG};
                pg8::gemm_phase<EpiInOdd, pg8::StaticOrderF, true, true>(lds, g, S, E, wave_s); }
            SEAM();
            if (RUN) { PTRS() FRESH()
                const float* cw = P.in[28]; const float* st = P.in[7];
                for (int i = gt; i < MROWS * 128; i += NT) { const int row = i >> 7, c0 = (i & 127) * 8, blk = row >> 6, r = row & 63;
                    const bool smp = row >= MP; const int rr = smp ? (r & 31) : r;
                    f32x4 z0, z1;
                    if (rr < 2) { const int sb = smp ? (r >> 5) * 4 : 0;
                        f32x4 pa0, pa1, pb0, pb1;
                        if (smp) { const int b = (blk - 256) * 2 + (r >> 5); const float* s0 = st + (size_t)(b * 2) * 1024 + c0; pa0 = *(const f32x4*)s0; pa1 = *(const f32x4*)(s0 + 4); pb0 = *(const f32x4*)(s0 + 1024); pb1 = *(const f32x4*)(s0 + 1028); }
                        else if ((blk & 63) == 0) { pa0 = pa1 = pb0 = pb1 = (f32x4){0.f, 0.f, 0.f, 0.f}; }
                        else { const float* s0 = SG + (size_t)((blk - 1) * 8 + 6) * 1024 + c0; pa0 = *(const f32x4*)s0; pa1 = *(const f32x4*)(s0 + 4); pb0 = *(const f32x4*)(s0 + 1024); pb1 = *(const f32x4*)(s0 + 1028); }
                        const float* sc = SG + (size_t)(blk * 8 + sb) * 1024 + c0; const f32x4 x00 = *(const f32x4*)sc, x01 = *(const f32x4*)(sc + 4);
                        f32x4 xm2a, xm2b, xm1a, xm1b, xca, xcb;
                        if (rr == 0) { xm2a = pa0; xm2b = pa1; xm1a = pb0; xm1b = pb1; xca = x00; xcb = x01; }
                        else { xm2a = pb0; xm2b = pb1; xm1a = x00; xm1b = x01; xca = *(const f32x4*)(sc + 1024); xcb = *(const f32x4*)(sc + 1028); }
                        const f32x4 w0a = *(const f32x4*)(cw + c0), w0b = *(const f32x4*)(cw + c0 + 4), w1a = *(const f32x4*)(cw + 1024 + c0), w1b = *(const f32x4*)(cw + 1028 + c0), w2a = *(const f32x4*)(cw + 2048 + c0), w2b = *(const f32x4*)(cw + 2052 + c0);
                        z0 = w0a * xm2a + w1a * xm1a + w2a * xca; z1 = w0b * xm2b + w1b * xm1b + w2b * xcb; }
                    else { const v4u zw = *(const v4u*)(zc + (size_t)row * 1024 + c0); z0 = (f32x4){bflo(zw.x), bfhi(zw.x), bflo(zw.y), bfhi(zw.y)}; z1 = (f32x4){bflo(zw.z), bfhi(zw.z), bflo(zw.w), bfhi(zw.w)}; }
                    const v4u gw_ = *(const v4u*)(gbm + (size_t)row * 1024 + c0);
                    const f32x4 g0 = (f32x4){bflo(gw_.x), bfhi(gw_.x), bflo(gw_.y), bfhi(gw_.y)}, g1 = (f32x4){bflo(gw_.z), bfhi(gw_.z), bflo(gw_.w), bfhi(gw_.w)};
                    *(v4u*)(gbm + (size_t)row * 1024 + c0) = pack8(g0 * z0, g1 * z1); }
                for (int i = gt; i < 4 * 2 * 1024; i += NT) { const int c = i & 1023, j = (i >> 10) & 1, b = i >> 11; out[OFF_CMP + i] = SG[(size_t)((64 * b + 63) * 8 + 6 + j) * 1024 + c]; }
                for (int i = gt; i < 8 * 2 * 1024; i += NT) { const int c = i & 1023, j = (i >> 10) & 1, b = i >> 11; out[OFF_CMS + i] = SG[(size_t)((256 + (b >> 1)) * 8 + (b & 1) * 4 + 2 + j) * 1024 + c]; }
            }
            SEAM();
        }
        if (RUN) { PTRS() pg8::Gemm g{(bf16*)(tmp + (size_t)(1 - l) * TMP_YCAT), WT + WT_OUTEVEN + (size_t)l * (WT_OUTODD - WT_OUTEVEN), MP, 1024, 1024}; pg8::StaticOrderF S; S.init(MP, 1024, G, (int)blockIdx.x);
            EpiRes E{P.in[0], P.in[1] - (size_t)MP * 1024, xb, PARTBUF(1 + 3 * l), l == 0 ? 1 : 0};
            pg8::gemm_phase<EpiRes, pg8::StaticOrderF, true, true>(lds, g, S, E, wave_s);
            { FRESH() sample_gemm<0>((bf16*)(tmp + (size_t)(1 - l) * TMP_YCAT), WT + WT_OUTEVEN + (size_t)l * (WT_OUTODD - WT_OUTEVEN), 1024, lds, tid, wave, lane, xb, l == 0 ? P.in[1] - (size_t)MP * 1024 : (const float*)nullptr, PARTBUF(1 + 3 * l), nullptr, nullptr); } }
        SEAM();
        if (RUN) { PTRS() pg8::Gemm g{xb, WT + WT_WQ + (size_t)l * 1048576, MP, 1024, 1024}; pg8::StaticOrderF S; S.init(MP, 1024, G, (int)blockIdx.x); EpiBf16 E{qx, 1024, PARTBUF(1 + 3 * l)};
            pg8::gemm_phase<EpiBf16, pg8::StaticOrderF, true, true>(lds, g, S, E, wave_s);
            { FRESH() sample_gemm<1>(xb, WT + WT_WQ + (size_t)l * 1048576, 1024, lds, tid, wave, lane, nullptr, nullptr, nullptr, PARTBUF(1 + 3 * l), qx); } }
        SEAM();
        if (RUN) { PTRS() FRESH() xattn_phase2(qx, memk + (size_t)l * 12 * 262144, memvT + (size_t)l * 12 * 262144, ox, lds, tid, wave, lane, G); }
        SEAM();
        if (RUN) { PTRS() pg8::Gemm g{ox, WT + WT_WO + (size_t)l * 1048576, MP, 1024, 1024}; pg8::StaticOrderF S; S.init(MP, 1024, G, (int)blockIdx.x); EpiRes E{P.in[0], P.in[0], xb, PARTBUF(2 + 3 * l), 0};
            pg8::gemm_phase<EpiRes, pg8::StaticOrderF, true, true>(lds, g, S, E, wave_s);
            { FRESH() sample_gemm<0>(ox, WT + WT_WO + (size_t)l * 1048576, 1024, lds, tid, wave, lane, xb, nullptr, PARTBUF(2 + 3 * l), nullptr, nullptr); } }
        SEAM();
        if (RUN) { PTRS() pg8::Gemm g{xb, WT + WT_UP + (size_t)l * 5632 * 1024, MROWS, 5632, 1024}; pg8::StaticOrderF S; S.init(MROWS, 5632, G, (int)blockIdx.x);
            EpiFfnUp E{act, PARTBUF(2 + 3 * l), P.in[34] + (size_t)l * 3 * DFF, SG, SV};
            pg8::gemm_phase<EpiFfnUp, pg8::StaticOrderF, true, true>(lds, g, S, E, wave_s); }
        SEAM();
        if (RUN) { PTRS() FRESH()
            const float* cw = P.in[34] + (size_t)l * 3 * DFF; const float* st = P.in[8] + (size_t)l * 8 * 2 * DFF;
            for (int i = gt; i < 528 * 352; i += NT) { const int fi = i / 352, c0 = (i % 352) * 8; int blk, row, rr, sb, vb; bool smp = fi >= 512;
                if (!smp) { blk = fi >> 1; rr = fi & 1; row = blk * 64 + rr; sb = 0; vb = 0; } else { const int s = fi - 512, half = (s >> 1) & 1; blk = 256 + (s >> 2); rr = s & 1; row = blk * 64 + half * 32 + rr; sb = half * 4; vb = half * 2; }
                f32x4 pa0, pa1, pb0, pb1;
                if (smp) { const int b = (blk - 256) * 2 + (sb >> 2); const float* s0 = st + (size_t)(b * 2) * DFF + c0; pa0 = *(const f32x4*)s0; pa1 = *(const f32x4*)(s0 + 4); pb0 = *(const f32x4*)(s0 + DFF); pb1 = *(const f32x4*)(s0 + DFF + 4); }
                else if ((blk & 63) == 0) { pa0 = pa1 = pb0 = pb1 = (f32x4){0.f, 0.f, 0.f, 0.f}; }
                else { const float* s0 = SG + (size_t)((blk - 1) * 8 + 6) * DFF + c0; pa0 = *(const f32x4*)s0; pa1 = *(const f32x4*)(s0 + 4); pb0 = *(const f32x4*)(s0 + DFF); pb1 = *(const f32x4*)(s0 + DFF + 4); }
                const float* sc = SG + (size_t)(blk * 8 + sb) * DFF + c0; const f32x4 x00 = *(const f32x4*)sc, x01 = *(const f32x4*)(sc + 4);
                f32x4 xm2a, xm2b, xm1a, xm1b, xca, xcb;
                if (rr == 0) { xm2a = pa0; xm2b = pa1; xm1a = pb0; xm1b = pb1; xca = x00; xcb = x01; }
                else { xm2a = pb0; xm2b = pb1; xm1a = x00; xm1b = x01; xca = *(const f32x4*)(sc + DFF); xcb = *(const f32x4*)(sc + DFF + 4); }
                const f32x4 w0a = *(const f32x4*)(cw + c0), w0b = *(const f32x4*)(cw + c0 + 4), w1a = *(const f32x4*)(cw + DFF + c0), w1b = *(const f32x4*)(cw + DFF + c0 + 4), w2a = *(const f32x4*)(cw + 2 * DFF + c0), w2b = *(const f32x4*)(cw + 2 * DFF + c0 + 4);
                const f32x4 ga = w0a * xm2a + w1a * xm1a + w2a * xca, gb_ = w0b * xm2b + w1b * xm1b + w2b * xcb;
                const float* sv = SV + (size_t)(blk * 4 + vb + rr) * DFF + c0; const f32x4 va = *(const f32x4*)sv, vb_ = *(const f32x4*)(sv + 4);
                f32x4 a0, a1;
#pragma unroll
                for (int j = 0; j < 4; ++j) { a0[j] = ga[j] * sigmoidf_(ga[j]) * va[j]; a1[j] = gb_[j] * sigmoidf_(gb_[j]) * vb_[j]; }
                *(v4u*)(act + (size_t)row * DFF + c0) = pack8(a0, a1); }
            for (int i = gt; i < 4 * 2 * DFF; i += NT) { const int c = i % DFF, j = (i / DFF) & 1, b = i / (2 * DFF); out[OFF_CFP + (size_t)l * 4 * 2 * DFF + i] = SG[(size_t)((64 * b + 63) * 8 + 6 + j) * DFF + c]; }
            for (int i = gt; i < 8 * 2 * DFF; i += NT) { const int c = i % DFF, j = (i / DFF) & 1, b = i / (2 * DFF); out[OFF_CFS + (size_t)l * 8 * 2 * DFF + i] = SG[(size_t)((256 + (b >> 1)) * 8 + (b & 1) * 4 + 2 + j) * DFF + c]; }
        }
        SEAM();
        if (RUN) { PTRS() pg8::Gemm g{act, WT + WT_DOWN + (size_t)l * 2816 * 1024, MP, 1024, DFF}; pg8::StaticOrderF S; S.init(MP, 1024, G, (int)blockIdx.x); EpiRes E{P.in[0], P.in[0], xb, PARTBUF(3 + 3 * l), 0};
            pg8::gemm_phase<EpiRes, pg8::StaticOrderF, true, true>(lds, g, S, E, wave_s);
            { FRESH() sample_gemm<0>(act, WT + WT_DOWN + (size_t)l * 2816 * 1024, DFF, lds, tid, wave, lane, xb, nullptr, PARTBUF(3 + 3 * l), nullptr, nullptr); } }
        SEAM();
    }
    if (RUN) { PTRS() FRESH()
        const float* gf = P.in[14];
        for (int m = gw; m < MROWS; m += NGW) { const float rs = rstd_of(PARTBUF(6), m); float* xr = out + (size_t)m * 1024; const bf16* xbr = xb + (size_t)m * 1024;
#pragma unroll
            for (int j = 0; j < 4; ++j) { const int c = (lane + 64 * j) * 4; const u32x2v w = *(const u32x2v*)(xbr + c); const f32x4 v = (f32x4){bflo(w.x), bfhi(w.x), bflo(w.y), bfhi(w.y)}, gg = *(const f32x4*)(gf + c); *(f32x4*)(xr + c) = v * rs * gg; } }
    }
}

extern "C" void kernel_launch(void* const* d_in, const int* in_sizes, int n_in, void* d_out, int out_size, void* d_ws, size_t ws_size, hipStream_t stream) {
    static int grid = 0;
    if (grid == 0) {
        int dev = 0, cus = 0, per_cu = 0;
        if (n_in != 36 || ws_size < 256 * MiB) { fprintf(stderr, "kernel_launch: unexpected n_in %d / ws %zu\n", n_in, ws_size); grid = -1; return; }
        (void)hipGetDevice(&dev); (void)hipDeviceGetAttribute(&cus, hipDeviceAttributeMultiprocessorCount, dev);
        if (hipFuncSetAttribute((const void*)mega_fwd, hipFuncAttributeMaxDynamicSharedMemorySize, LDS_BYTES) != hipSuccess) { fprintf(stderr, "kernel_launch: hipFuncSetAttribute failed\n"); grid = -1; return; }
        if (hipOccupancyMaxActiveBlocksPerMultiprocessor(&per_cu, (const void*)mega_fwd, 512, LDS_BYTES) != hipSuccess || per_cu < 1) per_cu = 1;
        (void)hipGetLastError();
        grid = cus * 1;
        if (grid > 256) grid = 256;
    }
    if (grid < 0) return;
    (void)hipMemsetAsync(d_ws, 0, CTL_ZERO_BYTES, stream);
    Params p{};
    for (int i = 0; i < 36; ++i) p.in[i] = (const float*)d_in[i];
    p.out = (float*)d_out; p.ws = (unsigned char*)d_ws; p.use_cg = 0; p.pad = 0;
    void* args[] = {&p};
    hipError_t e = hipLaunchCooperativeKernel((const void*)mega_fwd, dim3(grid), dim3(512), args, LDS_BYTES, stream);
    if (e != hipSuccess) fprintf(stderr, "cooperative launch failed: %s (grid %d)\n", hipGetErrorString(e), grid);
}
```

```cpp
#include <hip/hip_runtime.h>
#include <hip/hip_cooperative_groups.h>
#include <cstdio>
#include <cstdint>
namespace cg = cooperative_groups;
__device__ __forceinline__ int fresh_tid(int wave_s) { unsigned z = 0u; asm volatile("" : "+s"(z)); int t = wave_s * 64 + (int)__builtin_amdgcn_mbcnt_hi(~0u, __builtin_amdgcn_mbcnt_lo(~0u, z)); asm volatile("" : "+v"(t)); return t; }
namespace pg8 {
#define PG8_LAS __attribute__((address_space(3)))
typedef unsigned short bf16_t;
typedef short bf16x8 __attribute__((ext_vector_type(8)));
typedef float f32x4 __attribute__((ext_vector_type(4)));
typedef unsigned u32x4 __attribute__((ext_vector_type(4)));
constexpr int BM = 256, BK = 64, HALF = 128, HTB = HALF * BK * 2  , STAGE_BYTES = 8 * HTB, NXCD = 8, WGM = 8;

__host__ __device__ __forceinline__ int lds_byte(int r, int c) { const int st = (r >> 4) * 2 + (c >> 5), rr = r & 15, cc = c & 31, ob = rr * 64 + cc * 2; return st * 1024 + (ob ^ (((ob >> 9) & 1) << 5)); }
__host__ __device__ __forceinline__ void stage_rc(int b, int& R, int& C) { const int st = b / 1024, sb = b % 1024, swz = sb ^ (((sb >> 9) & 1) << 5); R = (st >> 1) * 16 + swz / 64; C = (st & 1) * 32 + (swz % 64) / 2; }
__host__ __device__ __forceinline__ int perm32(int rho) { const int n = rho >> 4, i = rho & 15; return 8 * (i >> 2) + 4 * n + (i & 3); }

struct Unit { int pm, pn; };
struct Gemm { const bf16_t* A; const bf16_t* Bt; int M, N, K; };

template <bool FULL> struct StaticOrderT {
    int nM, nN, nwg, G, c;
    __host__ __device__ void init(int M, int N, int G_, int c_) { nM = M / BM; nN = N / BM; nwg = nM * nN; G = G_; c = c_; }
    __host__ __device__ bool next(int i, Unit& u) const {
        const long L = (long)i * G + c; if (!(FULL && i == 0) && L >= nwg) return false;
        int wgid = (int)L; { const int q = nwg / NXCD, r = nwg % NXCD, xcd = wgid % NXCD, off = wgid / NXCD; wgid = (xcd < r ? xcd * (q + 1) : r * (q + 1) + (xcd - r) * q) + off; }
        const int nig = WGM * nN, gid = wgid / nig, fm = gid * WGM, gsz = (nM - fm) < WGM ? (nM - fm) : WGM;
        u.pm = fm + ((wgid % nig) % gsz); u.pn = (wgid % nig) / gsz; return true;
    }
    __device__ __forceinline__ void a_ready(const Unit&) const {}
    __device__ __forceinline__ void done(const Unit&) const {}
};

typedef StaticOrderT<false> StaticOrder; typedef StaticOrderT<true> StaticOrderF;
__device__ __forceinline__ unsigned cvt_pk_bf16(float lo, float hi) { unsigned r; asm volatile("v_cvt_pk_bf16_f32 %0, %1, %2" : "=v"(r) : "v"(lo), "v"(hi)); return r; }
typedef float f32x2 __attribute__((ext_vector_type(2)));
template <class Epi, class Sched, bool ALIGN_EPI = false, bool SP2 = false>
__device__ __forceinline__ void gemm_phase(PG8_LAS unsigned char* lds, const Gemm g, const Sched& S, const Epi& E, const int wave_s) {
    const int tid = fresh_tid(wave_s), wid = __builtin_amdgcn_readfirstlane(tid >> 6), lane = tid & 63, wr = wid >> 2, wc = wid & 3, fr = lane & 15, fq = lane >> 4;
    const int K = g.K, nt = K / BK;
    unsigned voffA[2], voffB[2];
#pragma unroll
    for (int i = 0; i < 2; ++i) { int R, C; stage_rc(tid * 16 + i * 8192, R, C); const int Rb = Epi::PERM ? ((R & ~31) + perm32(R & 31)) : R;
        voffA[i] = (unsigned)(R * K + C) * 2u; voffB[i] = (unsigned)(Rb * K + C) * 2u; }
    const size_t kstep = (size_t)(BK * 2);
    const size_t hstep = (size_t)HALF * K * 2;
    const size_t tstep = 2 * hstep;
    const unsigned ldsw = (unsigned)wid * 1024u;
    const int aoff = lds_byte(wr * 64 + fr, fq * 8), boff = lds_byte(wc * 32 + fr, fq * 8);
#define PG8_SA(b, h) (((b) * 2 + (h)) * HTB)
#define PG8_SB(b, h) ((4 + (b) * 2 + (h)) * HTB)
#define PG8_STAGE(bufoff, gbase, voff) do { _Pragma("unroll") for (int _i = 0; _i < 2; ++_i) \
        __builtin_amdgcn_global_load_lds((const unsigned*)((const char*)(gbase) + (voff)[_i]), (PG8_LAS unsigned*)(lds + (bufoff) + ldsw + _i * 8192), 16, 0, 0); } while (0)
#define PG8_LDA(dst, b, h) do { _Pragma("unroll") for (int m = 0; m < 4; ++m) _Pragma("unroll") for (int k = 0; k < 2; ++k) dst[m][k] = *(const PG8_LAS bf16x8*)(lds + PG8_SA(b, h) + aoff + m * 2048 + k * 1024); } while (0)
#define PG8_LDB(dst, b, h) do { _Pragma("unroll") for (int n = 0; n < 2; ++n) _Pragma("unroll") for (int k = 0; k < 2; ++k) dst[n][k] = *(const PG8_LAS bf16x8*)(lds + PG8_SB(b, h) + boff + n * 2048 + k * 1024); } while (0)
#define PG8_MMA(ai, bj, At, Bt) do { __builtin_amdgcn_s_setprio(1); _Pragma("unroll") for (int m = 0; m < 4; ++m) _Pragma("unroll") for (int n = 0; n < 2; ++n) _Pragma("unroll") for (int k = 0; k < 2; ++k) \
        acc[ai][bj][m][n] = __builtin_amdgcn_mfma_f32_16x16x32_bf16(Bt[n][k], At[m][k], acc[ai][bj][m][n], 0, 0, 0); __builtin_amdgcn_s_setprio(0); } while (0)
#define PG8_WAIT_V(n) asm volatile("s_waitcnt vmcnt(" #n ")" ::: "memory")
#define PG8_WAIT_L(n) asm volatile("s_waitcnt lgkmcnt(" #n ")" ::: "memory")
#define PG8_BAR __builtin_amdgcn_s_barrier()
#define PG8_SCHED __builtin_amdgcn_sched_barrier(0)
    Unit cur, nxt; int ui = 0;
    if (!S.next(0, cur)) return;
    f32x4 acc[2][2][4][2];
#pragma unroll
    for (int a = 0; a < 2; ++a)
#pragma unroll
        for (int b = 0; b < 2; ++b)
#pragma unroll
            for (int m = 0; m < 4; ++m)
#pragma unroll
                for (int n = 0; n < 2; ++n) acc[a][b][m][n] = (f32x4){0.f, 0.f, 0.f, 0.f};
    bf16x8 At[4][2], B0[2][2], B1[2][2];
    const char* cA = (const char*)g.A + (size_t)cur.pm * tstep; const char* cB = (const char*)g.Bt + (size_t)cur.pn * tstep;
    S.a_ready(cur);
    if constexpr (SP2) {
        PG8_STAGE(PG8_SB(0, 0), cB, voffB); PG8_STAGE(PG8_SB(0, 1), cB + hstep, voffB); PG8_STAGE(PG8_SA(0, 0), cA, voffA); PG8_STAGE(PG8_SA(0, 1), cA + hstep, voffA);
        if (wr == 1) PG8_BAR;
        PG8_WAIT_V(2); PG8_BAR;
        PG8_STAGE(PG8_SB(1, 0), cB + kstep, voffB); PG8_STAGE(PG8_SA(1, 0), cA + kstep, voffA); PG8_STAGE(PG8_SB(1, 1), cB + hstep + kstep, voffB);
        PG8_WAIT_V(6); PG8_BAR;
    } else {
        PG8_STAGE(PG8_SB(0, 0), cB, voffB); PG8_STAGE(PG8_SA(0, 0), cA, voffA); PG8_STAGE(PG8_SB(0, 1), cB + hstep, voffB); PG8_STAGE(PG8_SA(0, 1), cA + hstep, voffA);
        if (wr == 1) PG8_BAR;
        PG8_WAIT_V(4); PG8_BAR;
        PG8_STAGE(PG8_SB(1, 0), cB + kstep, voffB); PG8_STAGE(PG8_SA(1, 0), cA + kstep, voffA); PG8_STAGE(PG8_SB(1, 1), cB + hstep + kstep, voffB);
        PG8_WAIT_V(6); PG8_BAR;
    }
    for (;;) {
        const bool has_next = S.next(ui + 1, nxt);
        const char* nA = has_next ? (const char*)g.A + (size_t)nxt.pm * tstep : cA; const char* nB = has_next ? (const char*)g.Bt + (size_t)nxt.pn * tstep : cB;
        for (int t = 0; t < nt; t += 2) {
            const bool last = (t == nt - 2);
            const char* a1 = cA + (size_t)(t + 1) * kstep;
            const char* a2 = last ? nA : cA + (size_t)(t + 2) * kstep; const char* b2 = last ? nB : cB + (size_t)(t + 2) * kstep;
            const char* a3 = a2 + kstep; const char* b3 = b2 + kstep;
            if (last && has_next) S.a_ready(nxt);
            if constexpr (SP2) {
            PG8_LDB(B0, 0, 0); PG8_LDB(B1, 0, 1); PG8_SCHED; PG8_LDA(At, 0, 0); PG8_STAGE(PG8_SA(1, 1), a1 + hstep, voffA);
            PG8_WAIT_V(8); PG8_WAIT_L(0); PG8_BAR; PG8_MMA(0, 0, At, B0); PG8_MMA(0, 1, At, B1); PG8_BAR; PG8_SCHED;
            PG8_LDA(At, 0, 1); PG8_STAGE(PG8_SB(0, 0), b2, voffB); PG8_STAGE(PG8_SB(0, 1), b2 + hstep, voffB); PG8_STAGE(PG8_SA(0, 0), a2, voffA);
            PG8_WAIT_V(8); PG8_WAIT_L(0); PG8_BAR; PG8_MMA(1, 0, At, B0); PG8_MMA(1, 1, At, B1); PG8_BAR; PG8_SCHED;
            PG8_LDB(B0, 1, 0); PG8_LDB(B1, 1, 1); PG8_SCHED; PG8_LDA(At, 1, 0); PG8_STAGE(PG8_SA(0, 1), a2 + hstep, voffA);
            PG8_WAIT_V(8); PG8_WAIT_L(0); PG8_BAR; PG8_MMA(0, 0, At, B0); PG8_MMA(0, 1, At, B1); PG8_BAR; PG8_SCHED;
            PG8_LDA(At, 1, 1); PG8_STAGE(PG8_SB(1, 0), b3, voffB); PG8_STAGE(PG8_SB(1, 1), b3 + hstep, voffB); PG8_STAGE(PG8_SA(1, 0), a3, voffA);
            PG8_WAIT_V(8); PG8_WAIT_L(0); PG8_BAR; PG8_MMA(1, 0, At, B0); PG8_MMA(1, 1, At, B1); PG8_BAR; PG8_SCHED;
            } else {
            PG8_LDB(B0, 0, 0); PG8_SCHED; PG8_LDA(At, 0, 0); PG8_STAGE(PG8_SA(1, 1), a1 + hstep, voffA);
            PG8_WAIT_L(8); PG8_BAR; PG8_WAIT_L(0); PG8_MMA(0, 0, At, B0); PG8_BAR; PG8_SCHED;
            PG8_LDB(B1, 0, 1); PG8_STAGE(PG8_SB(0, 0), b2, voffB);
            PG8_BAR; PG8_WAIT_L(0); PG8_MMA(0, 1, At, B1); PG8_BAR;
            PG8_LDA(At, 0, 1); PG8_STAGE(PG8_SA(0, 0), a2, voffA);
            PG8_BAR; PG8_WAIT_L(0); PG8_MMA(1, 0, At, B0); PG8_BAR; PG8_SCHED;
            PG8_STAGE(PG8_SB(0, 1), b2 + hstep, voffB);
            PG8_WAIT_V(6); PG8_BAR; PG8_MMA(1, 1, At, B1); PG8_BAR;
            PG8_LDB(B0, 1, 0); PG8_SCHED; PG8_LDA(At, 1, 0); PG8_STAGE(PG8_SA(0, 1), a2 + hstep, voffA);
            PG8_WAIT_L(8); PG8_BAR; PG8_WAIT_L(0); PG8_MMA(0, 0, At, B0); PG8_BAR; PG8_SCHED;
            PG8_LDB(B1, 1, 1); PG8_STAGE(PG8_SB(1, 0), b3, voffB);
            PG8_BAR; PG8_WAIT_L(0); PG8_MMA(0, 1, At, B1); PG8_BAR;
            PG8_LDA(At, 1, 1); PG8_STAGE(PG8_SA(1, 0), a3, voffA);
            PG8_BAR; PG8_WAIT_L(0); PG8_MMA(1, 0, At, B0); PG8_BAR; PG8_SCHED;
            PG8_STAGE(PG8_SB(1, 1), b3 + hstep, voffB);
            PG8_WAIT_V(6); PG8_BAR; PG8_MMA(1, 1, At, B1); PG8_BAR;
            }
        }
        if constexpr (ALIGN_EPI) { if (wr == 0) PG8_BAR; }
        if constexpr (!Epi::AFTER_DRAIN) { E(acc, cur, wr, wc, fr, fq); S.done(cur); }
        if (!has_next) break;
#pragma unroll
        for (int a = 0; a < 2; ++a)
#pragma unroll
            for (int b = 0; b < 2; ++b)
#pragma unroll
                for (int m = 0; m < 4; ++m)
#pragma unroll
                    for (int n = 0; n < 2; ++n) acc[a][b][m][n] = (f32x4){0.f, 0.f, 0.f, 0.f};
        cur = nxt; cA = nA; cB = nB; ++ui;
        if constexpr (ALIGN_EPI) { if (wr == 1) PG8_BAR; }
    }
    PG8_WAIT_V(0);
    if constexpr (!ALIGN_EPI) { if (wr == 0) PG8_BAR; }
    PG8_BAR;
    if constexpr (Epi::AFTER_DRAIN) { E.fused(acc, cur, wr, wc, fr, fq, lds, wid, lane); S.done(cur); }
#undef PG8_SA
#undef PG8_SB
#undef PG8_STAGE
#undef PG8_LDA
#undef PG8_LDB
#undef PG8_MMA
#undef PG8_WAIT_V
#undef PG8_WAIT_L
#undef PG8_BAR
#undef PG8_SCHED
}
}
#define GAS __attribute__((address_space(1)))
#define LAS __attribute__((address_space(3)))
typedef unsigned short bf16;
typedef unsigned v4u __attribute__((ext_vector_type(4)));
typedef float f32x4 __attribute__((ext_vector_type(4)));
typedef short bf16x8 __attribute__((ext_vector_type(8)));
typedef GAS unsigned gu32;
typedef GAS unsigned long long gu64;
#define RLX_AGENT __ATOMIC_RELAXED, __HIP_MEMORY_SCOPE_AGENT
#define LDS_WAIT() asm volatile("s_waitcnt lgkmcnt(0)" ::: "memory")
#define VM_WAIT() asm volatile("s_waitcnt vmcnt(0)" ::: "memory")
__device__ __forceinline__ unsigned long long rt() { return __builtin_amdgcn_s_memrealtime(); }
__device__ __forceinline__ unsigned f2bf(float f) { unsigned u = __builtin_bit_cast(unsigned, f); return (u + 0x7fffu + ((u >> 16) & 1u)) >> 16; }
__device__ __forceinline__ unsigned pk2(float lo, float hi) { return f2bf(lo) | (f2bf(hi) << 16); }

#define XB_TMO      128
#define XB_XCNT(j)  (256  + 64 * (j))
#define XB_XSUB(j)  (1280 + 64 * (j))
#define XB_XGEN(j)  (2304 + 64 * (j))
#define XB_TOP      3328
#define XB_TOPGEN   3392
#define XCD_BAR_WORDS 3456
#define XB_SPIN_CAP (1u << 18)

__device__ __forceinline__ unsigned xb_ld(unsigned* p)              { return __hip_atomic_load(p, __ATOMIC_RELAXED, __HIP_MEMORY_SCOPE_AGENT); }
__device__ __forceinline__ unsigned xb_add(unsigned* p, unsigned v) { return __hip_atomic_fetch_add(p, v, __ATOMIC_RELAXED, __HIP_MEMORY_SCOPE_AGENT); }
__device__ __forceinline__ unsigned xb_xcc_id() { return (unsigned)__builtin_amdgcn_s_getreg((3 << 11) | 20) & 0xFu; }
#define XB_SPIN(cond, bar) do { unsigned _sp = 0; while (cond) { __builtin_amdgcn_s_sleep(1); \
    if ((++_sp & 255u) == 0u) { if (xb_ld(&(bar)[XB_TMO])) break; if (_sp > XB_SPIN_CAP) { atomicAdd(&(bar)[XB_TMO], 1u); break; } } } } while (0)

struct XcdBarrier {
    unsigned* bar; unsigned x;
    volatile LAS unsigned* st;
};

__device__ __forceinline__ XcdBarrier xcd_barrier_post(unsigned* bar, volatile LAS unsigned* st) {
    XcdBarrier b; b.bar = bar; b.x = xb_xcc_id(); b.st = st;
    if (threadIdx.x == 0) (void)xb_add(&bar[XB_XCNT(b.x)], 1u);
    return b;
}
__device__ __forceinline__ void xcd_barrier_complete(unsigned* bar, unsigned x, unsigned& nloc, unsigned& nx) {
    const unsigned G = gridDim.x * gridDim.y * gridDim.z;
    unsigned sum, cnt, mine, sp = 0u;
    for (;;) {
        sum = 0u; cnt = 0u; mine = 0u;
#pragma unroll
        for (unsigned j = 0; j < 16; ++j) { const unsigned c = xb_ld(&bar[XB_XCNT(j)]); sum += c; cnt += (c > 0u) ? 1u : 0u; mine = (j == x) ? c : mine; }
        if (sum == G) break;
        __builtin_amdgcn_s_sleep(1);
        if ((++sp & 255u) == 0u) { if (xb_ld(&bar[XB_TMO])) break; if (sp > XB_SPIN_CAP) { atomicAdd(&bar[XB_TMO], 1u); break; } }
    }
    nloc = mine > 0u ? mine : 1u; nx = cnt > 0u ? cnt : 1u;
}

__device__ __forceinline__ void xcd_barrier(const XcdBarrier& b) {
    asm volatile("s_waitcnt vmcnt(0)" ::: "memory");
    __syncthreads();
    if (threadIdx.x == 0) {
        unsigned* bar = b.bar;
        __builtin_amdgcn_s_waitcnt(0);
        unsigned nloc = b.st[0], nx = b.st[1];
        if (nloc == 0u) { xcd_barrier_complete(bar, b.x, nloc, nx); b.st[0] = nloc; b.st[1] = nx; }
        const unsigned old = xb_add(&bar[XB_XSUB(b.x)], 1u);
        const unsigned gen = old / nloc;
        if (old + 1u == (gen + 1u) * nloc) {
            __builtin_amdgcn_fence(__ATOMIC_RELEASE, "agent");
            asm volatile("s_waitcnt vmcnt(0)" ::: "memory");
            const unsigned og = xb_add(&bar[XB_TOP], 1u);
            const unsigned tg = og / nx;
            if (og + 1u == (tg + 1u) * nx) xb_add(&bar[XB_TOPGEN], 1u);
            else XB_SPIN(xb_ld(&bar[XB_TOPGEN]) == tg, bar);
            __builtin_amdgcn_fence(__ATOMIC_ACQUIRE, "agent");
            xb_add(&bar[XB_XGEN(b.x)], 1u);
            asm volatile("s_waitcnt vmcnt(0)" ::: "memory");
        } else {
            XB_SPIN(xb_ld(&bar[XB_XGEN(b.x)]) == gen, bar);
            __builtin_amdgcn_fence(__ATOMIC_ACQUIRE, "agent");
            asm volatile("s_waitcnt vmcnt(0)" ::: "memory");
        }
    }
    __syncthreads();
}
typedef unsigned u32x2v __attribute__((ext_vector_type(2)));
typedef float f32x2v __attribute__((ext_vector_type(2)));

constexpr int MP = 16384, MROWS = 16640, DMODEL = 1024, DFF = 2816, NBLK64 = MROWS / 64;
constexpr float RMS_EPS = 1e-6f;
constexpr size_t OFF_Y = 0, OFF_WKP = (size_t)MROWS * 1024, OFF_WVP = OFF_WKP + 65536, OFF_SRP = OFF_WVP + 65536, OFF_SIP = OFF_SRP + 8192,
    OFF_CMP = OFF_SIP + 8192, OFF_CFP = OFF_CMP + 8192, OFF_MKP = OFF_CFP + 45056, OFF_MVP = OFF_MKP + 2097152, OFF_WKS = OFF_MVP + 2097152,
    OFF_WVS = OFF_WKS + 32768, OFF_SRS = OFF_WVS + 32768, OFF_SIS = OFF_SRS + 16384, OFF_CMS = OFF_SIS + 16384, OFF_CFS = OFF_CMS + 16384;
constexpr size_t MiB = 1u << 20;
constexpr size_t WS_ROWSS = 0, WS_BAR = 512 * 1024, CTL_ZERO_BYTES = 1 * MiB;
constexpr size_t WS_ROPE = 1 * MiB, WS_SSM = 2 * MiB, WS_CKV = 3 * MiB, WS_SLOC = 4 * MiB, WS_MEMK = 8 * MiB, WS_MEMVT = 20 * MiB, WS_SIDE = 32 * MiB;
constexpr size_t SG_BYTES = (size_t)NBLK64 * 8 * DFF * 4, SV_BYTES = (size_t)NBLK64 * 4 * DFF * 4;
static_assert(WS_SIDE + SG_BYTES + SV_BYTES <= 66 * MiB, "side buffers");
constexpr size_t WS_WT = 66 * MiB, WS_XB = 128 * MiB, WS_TMP = 161 * MiB;
constexpr size_t WT_INEVEN = 0, WT_GLU = WT_INEVEN + 1280 * 1024, WT_OUTEVEN = WT_GLU + 512 * 512, WT_WQ = WT_OUTEVEN + 1024 * 1024, WT_WKV = WT_WQ + 2 * 1024 * 1024,
    WT_WO = WT_WKV + 2 * 2048 * 1024, WT_UP = WT_WO + 2 * 1024 * 1024, WT_DOWN = WT_UP + (size_t)2 * 5632 * 1024, WT_INODD = WT_DOWN + (size_t)2 * 2816 * 1024,
    WT_OUTODD = WT_INODD + 3072 * 1024, WT_END = WT_OUTODD + 1024 * 1024;
static_assert(WS_WT + WT_END * 2 <= WS_XB, "weights");
static_assert(WS_XB + (size_t)MROWS * 1024 * 2 <= WS_TMP, "xb");
constexpr size_t TMP_BYTES = (size_t)MROWS * DFF * 2;
constexpr size_t WS_PART = 251 * MiB, PART_ELEMS = (size_t)MROWS * 16;
static_assert(WS_PART + 2 * PART_ELEMS * 4 <= 256 * MiB, "part");
static_assert(WS_TMP + TMP_BYTES <= 256 * MiB, "ws");
constexpr size_t TMP_PROJ0 = 0, TMP_GBUF = (size_t)MROWS * 1280 * 2, TMP_YCAT = TMP_GBUF + (size_t)MROWS * 512 * 2, TMP_MEMB = TMP_YCAT;
static_assert(TMP_YCAT + (size_t)MROWS * 1024 * 2 <= TMP_BYTES, "tmp");
constexpr size_t TMP_QX = 0, TMP_OX = (size_t)MROWS * 1024 * 2, TMP_ACT = 0, TMP_GB = 0, TMP_ZC = (size_t)MROWS * 1024 * 2;
constexpr int LDS_BYTES = 147456, MISC_OFF = 147456 - 512;
constexpr int NPH = 22;

#define MFMA16(a, b, c) __builtin_amdgcn_mfma_f32_16x16x32_bf16(a, b, c, 0, 0, 0)
__device__ __forceinline__ float bflo(unsigned w) { return __uint_as_float(w << 16); }
__device__ __forceinline__ float bfhi(unsigned w) { return __uint_as_float(w & 0xffff0000u); }
__device__ __forceinline__ v4u pack8(f32x4 a, f32x4 b) { v4u w; w.x = pg8::cvt_pk_bf16(a[0], a[1]); w.y = pg8::cvt_pk_bf16(a[2], a[3]); w.z = pg8::cvt_pk_bf16(b[0], b[1]); w.w = pg8::cvt_pk_bf16(b[2], b[3]); return w; }
__device__ __forceinline__ float rstd_of(const float* part, int row) { const f32x4* p = (const f32x4*)(part + (size_t)row * 16); const f32x4 a = p[0] + p[1] + p[2] + p[3]; return rsqrtf(((a[0] + a[1]) + (a[2] + a[3])) * (1.0f / 1024.0f) + RMS_EPS); }
__device__ __forceinline__ float sigmoidf_(float x) { return 1.0f / (1.0f + __expf(-x)); }
__device__ __forceinline__ float dpp_ror1(float v) { return __builtin_bit_cast(float, __builtin_amdgcn_update_dpp(0, __builtin_bit_cast(int, v), 0x121, 0xf, 0xf, false)); }
__device__ __forceinline__ float dpp_ror2(float v) { return __builtin_bit_cast(float, __builtin_amdgcn_update_dpp(0, __builtin_bit_cast(int, v), 0x122, 0xf, 0xf, false)); }
__device__ __forceinline__ float wave_sum(float v) {
#pragma unroll
    for (int o = 1; o < 64; o <<= 1) v += __shfl_xor(v, o);
    return v;
}

typedef pg8::Unit Unit;
#define EPI_ARGS const f32x4 (&acc)[2][2][4][2], const Unit& u, int wr, int wc, int fr, int fq

struct EpiBf16 {
    static constexpr bool PERM = true, AFTER_DRAIN = false;
    bf16* O; int ldc; const float* rowss;
    __device__ __forceinline__ void operator()(EPI_ARGS) const {
        const int row0 = u.pm * 256 + wr * 64 + fr, col0 = u.pn * 256 + wc * 32 + 8 * fq;
#pragma unroll
        for (int ai = 0; ai < 2; ++ai)
#pragma unroll
            for (int m = 0; m < 4; ++m) { const int row = row0 + ai * 128 + m * 16; const float rs = rstd_of(rowss, row); bf16* rp = O + (size_t)row * ldc + col0;
#pragma unroll
                for (int bj = 0; bj < 2; ++bj) *(v4u*)(rp + bj * 128) = pack8(acc[ai][bj][m][0] * rs, acc[ai][bj][m][1] * rs); }
    }
};
struct EpiRes {
    static constexpr bool PERM = true, AFTER_DRAIN = false;
    const float* base_p; const float* base_s; bf16* xb; float* rowss_next; int f32base;
    __device__ __forceinline__ void operator()(EPI_ARGS) const {
        const float* base = u.pm < 64 ? base_p : base_s;
        const int row0 = u.pm * 256 + wr * 64 + fr, col0 = u.pn * 256 + wc * 32 + 8 * fq;
#pragma unroll
        for (int ai = 0; ai < 2; ++ai)
#pragma unroll
            for (int m = 0; m < 4; ++m) { const int row = row0 + ai * 128 + m * 16; const size_t off = (size_t)row * 1024 + col0; float ss = 0.f;
#pragma unroll
                for (int bj = 0; bj < 2; ++bj) { f32x4 b0, b1;
                    if (f32base) { b0 = *(const f32x4*)(base + off + bj * 128); b1 = *(const f32x4*)(base + off + bj * 128 + 4); }
                    else { const v4u w = *(const v4u*)(xb + off + bj * 128); b0 = (f32x4){bflo(w.x), bfhi(w.x), bflo(w.y), bfhi(w.y)}; b1 = (f32x4){bflo(w.z), bfhi(w.z), bflo(w.w), bfhi(w.w)}; }
                    const f32x4 v0 = acc[ai][bj][m][0] + b0, v1 = acc[ai][bj][m][1] + b1;
                    *(v4u*)(xb + off + bj * 128) = pack8(v0, v1);
                    ss += (v0[0] * v0[0] + v0[1] * v0[1]) + (v0[2] * v0[2] + v0[3] * v0[3]) + (v1[0] * v1[0] + v1[1] * v1[1]) + (v1[2] * v1[2] + v1[3] * v1[3]); }
                ss += __shfl_xor(ss, 16); ss += __shfl_xor(ss, 32);
                if (fq == 0) rowss_next[(size_t)row * 16 + u.pn * 4 + wc] = ss; }
    }
};
struct EpiGlu {
    static constexpr bool PERM = true, AFTER_DRAIN = false;
    const bf16* g; bf16* ycat;
    __device__ __forceinline__ void operator()(EPI_ARGS) const {
        const int row0 = u.pm * 256 + wr * 64 + fr, col0 = u.pn * 256 + wc * 32 + 8 * fq;
#pragma unroll
        for (int ai = 0; ai < 2; ++ai)
#pragma unroll
            for (int m = 0; m < 4; ++m) { const int row = row0 + ai * 128 + m * 16;
#pragma unroll
                for (int bj = 0; bj < 2; ++bj) { const int col = col0 + bj * 128; const v4u gw = *(const v4u*)(g + (size_t)row * 512 + col);
                    const f32x4 a0 = acc[ai][bj][m][0], a1 = acc[ai][bj][m][1]; f32x4 o0, o1;
                    o0[0] = bflo(gw.x) * sigmoidf_(a0[0]); o0[1] = bfhi(gw.x) * sigmoidf_(a0[1]); o0[2] = bflo(gw.y) * sigmoidf_(a0[2]); o0[3] = bfhi(gw.y) * sigmoidf_(a0[3]);
                    o1[0] = bflo(gw.z) * sigmoidf_(a1[0]); o1[1] = bfhi(gw.z) * sigmoidf_(a1[1]); o1[2] = bflo(gw.w) * sigmoidf_(a1[2]); o1[3] = bfhi(gw.w) * sigmoidf_(a1[3]);
                    *(v4u*)(ycat + (size_t)row * 1024 + col) = pack8(o0, o1); } }
    }
};
struct EpiKV {
    static constexpr bool PERM = true, AFTER_DRAIN = false;
    float* out; bf16* memk;
    __device__ __forceinline__ void operator()(EPI_ARGS) const {
        const int row0 = u.pm * 256 + wr * 64 + fr, col0 = u.pn * 256 + wc * 32 + 8 * fq;
#pragma unroll
        for (int ai = 0; ai < 2; ++ai)
#pragma unroll
            for (int m = 0; m < 4; ++m) { const int row = row0 + ai * 128 + m * 16;
#pragma unroll
                for (int bj = 0; bj < 2; ++bj) { const int c = col0 + bj * 128, l = c >> 11, e = c & 2047, isv = e >> 10, dc = e & 1023;
                    float* op = out + (isv ? OFF_MVP : OFF_MKP) + (size_t)l * 1048576 + (size_t)row * 1024 + dc;
                    *(f32x4*)op = acc[ai][bj][m][0]; *(f32x4*)(op + 4) = acc[ai][bj][m][1];
                    if (!isv) *(v4u*)(memk + (size_t)l * 12 * 262144 + (size_t)row * 1024 + dc) = pack8(acc[ai][bj][m][0], acc[ai][bj][m][1]); } }
    }
};
struct EpiIn0 {
    static constexpr bool PERM = true, AFTER_DRAIN = false;
    bf16* proj; const float* rowss; const float* ropec; const float* ropes; float* out;
    __device__ __forceinline__ void operator()(EPI_ARGS) const {
        const int pn = u.pn;
#pragma unroll
        for (int ai = 0; ai < 2; ++ai)
#pragma unroll
            for (int m = 0; m < 4; ++m) { const int row = u.pm * 256 + ai * 128 + wr * 64 + m * 16 + fr; const float rs = rstd_of(rowss, row);
                const int pos = row < MP ? (row & 4095) : 2048 + (row & 31);
                bf16* rp = proj + (size_t)row * 1280;
                float* wk = nullptr; float* wv = nullptr;
                if (pn == 4) { if (row >= MP) { wk = out + OFF_WKS + (size_t)(row - MP) * 128; wv = out + OFF_WVS + (size_t)(row - MP) * 128; }
                               else if ((row & 4095) >= 3968) { const size_t o = (size_t)((row >> 12) * 128 + (row & 4095) - 3968) * 128; wk = out + OFF_WKP + o; wv = out + OFF_WVP + o; } }
#pragma unroll
                for (int bj = 0; bj < 2; ++bj) { const f32x4 v0 = acc[ai][bj][m][0] * rs, v1 = acc[ai][bj][m][1] * rs;
                    const bool rope = (pn == 2 || pn == 3 || (pn == 4 && bj == 0));
                    if (!rope) { const int col = pn * 256 + bj * 128 + wc * 32 + 8 * fq; *(v4u*)(rp + col) = pack8(v0, v1);
                        if (pn == 4 && wv) { *(f32x4*)(wv + wc * 32 + 8 * fq) = v0; *(f32x4*)(wv + wc * 32 + 8 * fq + 4) = v1; } }
                    else { const int gbase = pn * 256 + bj * 128 + (wc >> 1) * 64, d1 = 16 * (wc & 1) + 4 * fq;
                        const f32x4 c4 = *(const f32x4*)(ropec + pos * 32 + d1), s4 = *(const f32x4*)(ropes + pos * 32 + d1);
                        f32x4 o1 = v0 * c4 - v1 * s4, o2 = v1 * c4 + v0 * s4;
                        if (pn != 4) { o1 = o1 * 0.125f; o2 = o2 * 0.125f; }
                        u32x2v w1, w2; w1.x = pg8::cvt_pk_bf16(o1[0], o1[1]); w1.y = pg8::cvt_pk_bf16(o1[2], o1[3]); w2.x = pg8::cvt_pk_bf16(o2[0], o2[1]); w2.y = pg8::cvt_pk_bf16(o2[2], o2[3]);
                        *(u32x2v*)(rp + gbase + d1) = w1; *(u32x2v*)(rp + gbase + d1 + 32) = w2;
                        if (pn == 4 && wk) { const int cc = (wc >> 1) * 64 + d1; *(f32x4*)(wk + cc) = o1; *(f32x4*)(wk + cc + 32) = o2; } } } }
    }
};
struct EpiFfnUp {
    static constexpr bool PERM = true, AFTER_DRAIN = false;
    bf16* act; const float* rowss; const float* cw; float* SG; float* SV;
    __device__ __forceinline__ void operator()(EPI_ARGS) const {
        const int c0 = u.pn * 128 + wc * 32 + 8 * fq; const bool sample = u.pm == 64;
        const f32x4 w0a = *(const f32x4*)(cw + c0), w0b = *(const f32x4*)(cw + c0 + 4), w1a = *(const f32x4*)(cw + DFF + c0), w1b = *(const f32x4*)(cw + DFF + c0 + 4),
                    w2a = *(const f32x4*)(cw + 2 * DFF + c0), w2b = *(const f32x4*)(cw + 2 * DFF + c0 + 4);
#pragma unroll
        for (int ai = 0; ai < 2; ++ai) { f32x4 gp0 = {0.f, 0.f, 0.f, 0.f}, gp1 = {0.f, 0.f, 0.f, 0.f}; const int blk = u.pm * 4 + ai * 2 + wr;
#pragma unroll
            for (int m = 0; m < 4; ++m) { const int row = u.pm * 256 + ai * 128 + wr * 64 + m * 16 + fr; const float rs = rstd_of(rowss, row);
                const f32x4 g0 = acc[ai][0][m][0] * rs, g1 = acc[ai][0][m][1] * rs, v0 = acc[ai][1][m][0] * rs, v1 = acc[ai][1][m][1] * rs;
                f32x4 a0, a1;
#pragma unroll
                for (int j = 0; j < 4; ++j) {
                    const float r1pa = dpp_ror1(gp0[j]), r1ca = dpp_ror1(g0[j]), r2pa = dpp_ror2(gp0[j]), r2ca = dpp_ror2(g0[j]);
                    const float r1pb = dpp_ror1(gp1[j]), r1cb = dpp_ror1(g1[j]), r2pb = dpp_ror2(gp1[j]), r2cb = dpp_ror2(g1[j]);
                    const float p1a = fr == 0 ? r1pa : r1ca, p2a = fr < 2 ? r2pa : r2ca;
                    const float p1b = fr == 0 ? r1pb : r1cb, p2b = fr < 2 ? r2pb : r2cb;
                    const float ca = w0a[j] * p2a + w1a[j] * p1a + w2a[j] * g0[j], cb = w0b[j] * p2b + w1b[j] * p1b + w2b[j] * g1[j];
                    a0[j] = ca * sigmoidf_(ca) * v0[j]; a1[j] = cb * sigmoidf_(cb) * v1[j]; }
                const bool valid = (m > 0 || fr >= 2) && !(sample && m == 2 && fr < 2);
                if (valid) *(v4u*)(act + (size_t)row * DFF + c0) = pack8(a0, a1);
                if ((m & 1) == 0 && fr < 2) { float* sg = SG + (size_t)(blk * 8 + 2 * m + fr) * DFF + c0; *(f32x4*)sg = g0; *(f32x4*)(sg + 4) = g1;
                                              float* sv = SV + (size_t)(blk * 4 + m + fr) * DFF + c0; *(f32x4*)sv = v0; *(f32x4*)(sv + 4) = v1; }
                if ((m & 1) == 1 && fr >= 14) { float* sg = SG + (size_t)(blk * 8 + 2 * m + fr - 14) * DFF + c0; *(f32x4*)sg = g0; *(f32x4*)(sg + 4) = g1; }
                gp0 = g0; gp1 = g1; } }
    }
};
struct EpiInOdd {
    static constexpr bool PERM = true, AFTER_DRAIN = false;
    bf16* gb; bf16* zc; const float* rowss; const float* cw; float* SG;
    __device__ __forceinline__ void operator()(EPI_ARGS) const {
        if (u.pn < 4) {
            const int row0 = u.pm * 256 + wr * 64 + fr, col0 = u.pn * 256 + wc * 32 + 8 * fq;
#pragma unroll
            for (int ai = 0; ai < 2; ++ai)
#pragma unroll
                for (int m = 0; m < 4; ++m) { const int row = row0 + ai * 128 + m * 16; const float rs = rstd_of(rowss, row); bf16* rp = gb + (size_t)row * 1024 + col0;
#pragma unroll
                    for (int bj = 0; bj < 2; ++bj) *(v4u*)(rp + bj * 128) = pack8(acc[ai][bj][m][0] * rs, acc[ai][bj][m][1] * rs); }
            return;
        }
        const int c0 = (u.pn - 4) * 128 + wc * 32 + 8 * fq; const bool sample = u.pm == 64;
        const f32x4 w0a = *(const f32x4*)(cw + c0), w0b = *(const f32x4*)(cw + c0 + 4), w1a = *(const f32x4*)(cw + 1024 + c0), w1b = *(const f32x4*)(cw + 1024 + c0 + 4),
                    w2a = *(const f32x4*)(cw + 2048 + c0), w2b = *(const f32x4*)(cw + 2048 + c0 + 4);
#pragma unroll
        for (int ai = 0; ai < 2; ++ai) { f32x4 gp0 = {0.f, 0.f, 0.f, 0.f}, gp1 = {0.f, 0.f, 0.f, 0.f}; const int blk = u.pm * 4 + ai * 2 + wr;
#pragma unroll
            for (int m = 0; m < 4; ++m) { const int row = u.pm * 256 + ai * 128 + wr * 64 + m * 16 + fr; const float rs = rstd_of(rowss, row); const float rs2 = rs * rs;
                const f32x4 g0 = acc[ai][0][m][0] * acc[ai][1][m][0] * rs2, g1 = acc[ai][0][m][1] * acc[ai][1][m][1] * rs2;
                f32x4 a0, a1;
#pragma unroll
                for (int j = 0; j < 4; ++j) {
                    const float r1pa = dpp_ror1(gp0[j]), r1ca = dpp_ror1(g0[j]), r2pa = dpp_ror2(gp0[j]), r2ca = dpp_ror2(g0[j]);
                    const float r1pb = dpp_ror1(gp1[j]), r1cb = dpp_ror1(g1[j]), r2pb = dpp_ror2(gp1[j]), r2cb = dpp_ror2(g1[j]);
                    const float p1a = fr == 0 ? r1pa : r1ca, p2a = fr < 2 ? r2pa : r2ca;
                    const float p1b = fr == 0 ? r1pb : r1cb, p2b = fr < 2 ? r2pb : r2cb;
                    a0[j] = w0a[j] * p2a + w1a[j] * p1a + w2a[j] * g0[j]; a1[j] = w0b[j] * p2b + w1b[j] * p1b + w2b[j] * g1[j]; }
                const bool valid = (m > 0 || fr >= 2) && !(sample && m == 2 && fr < 2);
                if (valid) *(v4u*)(zc + (size_t)row * 1024 + c0) = pack8(a0, a1);
                if ((m & 1) == 0 && fr < 2) { float* sg = SG + (size_t)(blk * 8 + 2 * m + fr) * 1024 + c0; *(f32x4*)sg = g0; *(f32x4*)(sg + 4) = g1; }
                if ((m & 1) == 1 && fr >= 14) { float* sg = SG + (size_t)(blk * 8 + 2 * m + fr - 14) * 1024 + c0; *(f32x4*)sg = g0; *(f32x4*)(sg + 4) = g1; }
                gp0 = g0; gp1 = g1; } }
    }
};

__device__ __forceinline__ int rowmap(int mode, int n) {
    if (mode == 1) { if (n >= 512 && n < 1152) { const int d = n & 63; return (n & ~63) | (32 * ((d >> 4) & 1) + 8 * ((d >> 2) & 3) + 4 * (d >> 5) + (d & 3)); } return n; }
    if (mode == 2) { return n < DFF ? ((n >> 7) * 256 + (n & 127)) : (((n - DFF) >> 7) * 256 + 128 + ((n - DFF) & 127)); }
    if (mode == 3) { if (n < 1024) return n; const int c = (n - 1024) & 1023, z = n >= 2048 ? 1 : 0; return 1024 + (c >> 7) * 256 + z * 128 + (c & 127); }
    return n;
}
__device__ __forceinline__ void tr_item(const float* W, int K, int N, bf16* WT, const float* gain, float scale, int mode, LAS float* scr, int item, int lane) {
    const int nblk = N / 32, kb = item / nblk, nb = item % nblk, k0 = 64 * kb, n0 = 32 * nb;
#pragma unroll
    for (int i = 0; i < 8; ++i) { const int idx = lane + 64 * i, kk = idx >> 3, n4 = (idx & 7) * 4; const float gs = gain ? gain[k0 + kk] * scale : scale;
        const f32x4 w = *(const f32x4*)(W + (size_t)(k0 + kk) * N + n0 + n4); LAS float* d = scr + kk * 33 + n4; d[0] = w[0] * gs; d[1] = w[1] * gs; d[2] = w[2] * gs; d[3] = w[3] * gs; }
    LDS_WAIT(); asm volatile("" ::: "memory");
    const int c = lane & 7;
#pragma unroll
    for (int j = 0; j < 4; ++j) { const int n = (lane >> 3) + 8 * j; const LAS float* s = scr + (8 * c) * 33 + n;
        v4u o; o.x = pg8::cvt_pk_bf16(s[0 * 33], s[1 * 33]); o.y = pg8::cvt_pk_bf16(s[2 * 33], s[3 * 33]); o.z = pg8::cvt_pk_bf16(s[4 * 33], s[5 * 33]); o.w = pg8::cvt_pk_bf16(s[6 * 33], s[7 * 33]);
        *(v4u*)(WT + (size_t)rowmap(mode, n0 + n) * K + k0 + 8 * c) = o; }
    LDS_WAIT(); asm volatile("" ::: "memory");
}
__device__ __forceinline__ double dexp_(double y) {
    const double k = rint(y * 1.4426950408889634); const double r = (y - k * 0.6931471803691238) - k * 1.9082149292705877e-10;
    double p = 1.0 / 6227020800.0;
    p = p * r + 1.0 / 479001600.0; p = p * r + 1.0 / 39916800.0; p = p * r + 1.0 / 3628800.0; p = p * r + 1.0 / 362880.0; p = p * r + 1.0 / 40320.0; p = p * r + 1.0 / 5040.0;
    p = p * r + 1.0 / 720.0; p = p * r + 1.0 / 120.0; p = p * r + 1.0 / 24.0; p = p * r + 1.0 / 6.0; p = p * r + 0.5; p = p * r + 1.0; p = p * r + 1.0;
    const long long bits = (long long)(1023 + (int)k) << 52; return p * __builtin_bit_cast(double, bits);
}
__device__ __forceinline__ void dsincos_(double x, double& s, double& c) {
    const double k = rint(x * 0.6366197723675814); const double r = (x - k * 1.5707963267948966) - k * 6.123233995736766e-17; const double r2 = r * r;
    const double sp = r * (1.0 + r2 * (-1.0 / 6.0 + r2 * (1.0 / 120.0 + r2 * (-1.0 / 5040.0 + r2 * (1.0 / 362880.0 + r2 * (-1.0 / 39916800.0 + r2 * (1.0 / 6227020800.0)))))));
    const double cp = 1.0 + r2 * (-0.5 + r2 * (1.0 / 24.0 + r2 * (-1.0 / 720.0 + r2 * (1.0 / 40320.0 + r2 * (-1.0 / 3628800.0 + r2 * (1.0 / 479001600.0 + r2 * (-1.0 / 87178291200.0)))))));
    const int q = ((int)k) & 3;
    s = q == 0 ? sp : q == 1 ? cp : q == 2 ? -sp : -cp; c = q == 0 ? cp : q == 1 ? -sp : q == 2 ? -cp : sp;
}

__device__ __forceinline__ const bf16* kvptr(const bf16* proj, const bf16* cb, int sample, int b, int c, int kvh, int kk, int isv) {
    if (!sample) { int pos = (c - 2) * 64 + kk; pos = pos < 0 ? 0 : pos; return proj + (size_t)(b * 4096 + pos) * 1280 + 1024 + isv * 128 + kvh * 64; }
    if (kk < 128) return cb + (size_t)(b * 128 + kk) * 128 + kvh * 64;
    int t = kk - 128; t = t > 31 ? 31 : t; return proj + (size_t)(MP + b * 32 + t) * 1280 + 1024 + isv * 128 + kvh * 64;
}
__device__ __forceinline__ void swa_phase(const bf16* proj, const bf16* ckb, const bf16* cvb, const float* sinks, bf16* ycat, LAS unsigned char* lds, int tid, int wave, int lane, int G) {
    LAS bf16* VT = (LAS bf16*)lds;
    const int fr = lane & 15, quad = lane >> 4;
    for (int it = blockIdx.x; it < 528; it += G) {
        int b, c, kvh, sample;
        if (it < 512) { sample = 0; b = it >> 7; c = (it >> 1) & 63; kvh = it & 1; } else { sample = 1; b = (it - 512) >> 1; c = 0; kvh = it & 1; }
        __syncthreads();
#pragma unroll
        for (int i = 0; i < 3; ++i) { const int idx = tid + 512 * i, kk = idx % 192, dg = idx / 192; const v4u w = *(const v4u*)(kvptr(proj, cvb, sample, b, c, kvh, kk, 1) + dg * 8);
            LAS bf16* vp = VT + (dg * 8) * 200 + kk;
            vp[0] = (bf16)(w.x & 0xffffu); vp[200] = (bf16)(w.x >> 16); vp[400] = (bf16)(w.y & 0xffffu); vp[600] = (bf16)(w.y >> 16);
            vp[800] = (bf16)(w.z & 0xffffu); vp[1000] = (bf16)(w.z >> 16); vp[1200] = (bf16)(w.w & 0xffffu); vp[1400] = (bf16)(w.w >> 16); }
        __syncthreads();
        const int gq = wave >> 1, qhalf = wave & 1, head = kvh * 4 + gq;
        if (!(sample && qhalf)) {
            const int plo = sample ? 0 : (c >= 2 ? 0 : (2 - c) * 2), phi = sample ? 5 : 6;
            bf16x8 qf[2][2];
#pragma unroll
            for (int qb = 0; qb < 2; ++qb) { const int q = qhalf * 32 + qb * 16 + fr; const int row = sample ? MP + b * 32 + (q & 31) : b * 4096 + c * 64 + q;
                const bf16* qp = proj + (size_t)row * 1280 + 512 + head * 64 + quad * 8; qf[qb][0] = *(const bf16x8*)qp; qf[qb][1] = *(const bf16x8*)(qp + 32); }
            f32x4 s[12][2];
#pragma unroll
            for (int kb = 0; kb < 12; ++kb) { const int key = 32 * (kb >> 1) + (fr >> 2) * 8 + 4 * (kb & 1) + (fr & 3); const bf16* kp = kvptr(proj, ckb, sample, b, c, kvh, key, 0) + quad * 8;
                const bf16x8 k0 = *(const bf16x8*)kp, k1 = *(const bf16x8*)(kp + 32);
#pragma unroll
                for (int qb = 0; qb < 2; ++qb) { f32x4 a = {0.f, 0.f, 0.f, 0.f}; a = MFMA16(k0, qf[qb][0], a); a = MFMA16(k1, qf[qb][1], a); s[kb][qb] = a; } }
            const float sink = sinks[head];
            bf16x8 pf[6][2];
#pragma unroll
            for (int qb = 0; qb < 2; ++qb) { float mx = sink;
#pragma unroll
                for (int kb = 0; kb < 12; ++kb) { const bool pv = (kb >> 1) >= plo && (kb >> 1) < phi;
#pragma unroll
                    for (int j = 0; j < 4; ++j) { const float v = pv ? s[kb][qb][j] : -1e30f; s[kb][qb][j] = v; mx = fmaxf(mx, v); } }
                mx = fmaxf(mx, __shfl_xor(mx, 16)); mx = fmaxf(mx, __shfl_xor(mx, 32));
                float sum = 0.f;
#pragma unroll
                for (int kb = 0; kb < 12; ++kb)
#pragma unroll
                    for (int j = 0; j < 4; ++j) { const float e = __expf(s[kb][qb][j] - mx); s[kb][qb][j] = e; sum += e; }
                sum += __shfl_xor(sum, 16); sum += __shfl_xor(sum, 32); sum += __expf(sink - mx);
                const float inv = 1.0f / sum;
#pragma unroll
                for (int pr = 0; pr < 6; ++pr) pf[pr][qb] = __builtin_bit_cast(bf16x8, pack8(s[2 * pr][qb] * inv, s[2 * pr + 1][qb] * inv)); }
#pragma unroll
            for (int db = 0; db < 4; ++db) { bf16x8 vf[6];
#pragma unroll
                for (int pr = 0; pr < 6; ++pr) vf[pr] = *(const LAS bf16x8*)(VT + (db * 16 + fr) * 200 + 32 * pr + quad * 8);
#pragma unroll
                for (int qb = 0; qb < 2; ++qb) { f32x4 o = {0.f, 0.f, 0.f, 0.f};
#pragma unroll
                    for (int pr = 0; pr < 6; ++pr) o = MFMA16(pf[pr][qb], vf[pr], o);
#pragma unroll
                    for (int j = 0; j < 4; ++j) { const int q = qhalf * 32 + qb * 16 + quad * 4 + j;
                        if (!sample || q < 32) { const int row = sample ? MP + b * 32 + q : b * 4096 + c * 64 + q; ycat[(size_t)row * 1024 + 512 + head * 64 + db * 16 + fr] = (bf16)f2bf(o[j]); } } } }
        }
    }
    __syncthreads();
}

__device__ __forceinline__ void xattn_phase(const bf16* qx, const bf16* memk_l, const bf16* memvT_l, bf16* ox, int wave, int lane, int G) {
    const int fr = lane & 15, quad = lane >> 4;
    for (int t = wave * G + (int)blockIdx.x; t < 4160; t += 8 * G) {
        int bb, h, row0;
        if (t < 4096) { const int pair = t >> 8; bb = pair >> 2; h = pair & 3; row0 = bb * 4096 + (t & 255) * 16; }
        else { const int s = t - 4096, b = s >> 3; h = (s >> 1) & 3; bb = 4 + b; row0 = MP + b * 32 + (s & 1) * 16; }
        bf16x8 qf[8];
#pragma unroll
        for (int ks = 0; ks < 8; ++ks) qf[ks] = *(const bf16x8*)(qx + (size_t)(row0 + fr) * 1024 + h * 256 + ks * 32 + quad * 8);
        const bf16* kbase = memk_l + (size_t)bb * 262144 + h * 256 + quad * 8;
        f32x4 s[16];
#pragma unroll
        for (int kb = 0; kb < 16; ++kb) { const int key = 32 * (kb >> 1) + (fr >> 2) * 8 + 4 * (kb & 1) + (fr & 3); const bf16* kp = kbase + (size_t)key * 1024; f32x4 a = {0.f, 0.f, 0.f, 0.f};
#pragma unroll
            for (int ks = 0; ks < 8; ++ks) a = MFMA16(*(const bf16x8*)(kp + ks * 32), qf[ks], a);
            s[kb] = a; }
        float mx = -1e30f;
#pragma unroll
        for (int kb = 0; kb < 16; ++kb)
#pragma unroll
            for (int j = 0; j < 4; ++j) mx = fmaxf(mx, s[kb][j]);
        mx = fmaxf(mx, __shfl_xor(mx, 16)); mx = fmaxf(mx, __shfl_xor(mx, 32));
        float sum = 0.f;
#pragma unroll
        for (int kb = 0; kb < 16; ++kb)
#pragma unroll
            for (int j = 0; j < 4; ++j) { const float e = __expf(s[kb][j] - mx); s[kb][j] = e; sum += e; }
        sum += __shfl_xor(sum, 16); sum += __shfl_xor(sum, 32);
        const float inv = 1.0f / sum;
        bf16x8 pf[8];
#pragma unroll
        for (int pr = 0; pr < 8; ++pr) pf[pr] = __builtin_bit_cast(bf16x8, pack8(s[2 * pr] * inv, s[2 * pr + 1] * inv));
        const bf16* vbase = memvT_l + (size_t)bb * 262144 + (size_t)(h * 256 + fr) * 256 + quad * 8;
#pragma unroll 4
        for (int db = 0; db < 16; ++db) { f32x4 o = {0.f, 0.f, 0.f, 0.f};
#pragma unroll
            for (int pr = 0; pr < 8; ++pr) o = MFMA16(pf[pr], *(const bf16x8*)(vbase + (size_t)db * 4096 + pr * 32), o);
#pragma unroll
            for (int j = 0; j < 4; ++j) ox[(size_t)(row0 + quad * 4 + j) * 1024 + h * 256 + db * 16 + fr] = (bf16)f2bf(o[j]); }
    }
}


__device__ __forceinline__ void xstage(const bf16* src, size_t rowstride, LAS unsigned char* lds, int tid) {
    v4u t[16];
#pragma unroll
    for (int i = 0; i < 16; ++i) { const int row = (tid >> 5) + 16 * i, ch = tid & 31; t[i] = *(const GAS v4u*)((const GAS bf16*)src + (size_t)row * rowstride + ch * 8); }
#pragma unroll
    for (int i = 0; i < 16; ++i) { const int row = (tid >> 5) + 16 * i, ch = tid & 31; *(LAS v4u*)(lds + row * 528 + ch * 16) = t[i]; }
}
__device__ __forceinline__ void xattn_phase2(const bf16* qx, const bf16* memk_l, const bf16* memvT_l, bf16* ox, LAS unsigned char* lds, int tid, int wave, int lane, int G) {
    const int fr = lane & 15, quad = lane >> 4;
    for (int it = blockIdx.x; it < 256 + 32; it += G) {
        int bb, h, rowbase, nqb; bool active;
        if (it < 256) { bb = it >> 6; h = (it >> 4) & 3; rowbase = bb * 4096 + (it & 15) * 256; nqb = 2; active = true; }
        else { const int s = it - 256, b = s >> 2; h = s & 3; bb = 4 + b; rowbase = MP + b * 32; nqb = 1; active = wave < 2; }
        __syncthreads();
        xstage(memk_l + (size_t)bb * 262144 + h * 256, 1024, lds, tid);
        __syncthreads();
        bf16x8 pf[2][8];
#pragma unroll
        for (int qi = 0; qi < 2; ++qi) {
            if (qi < nqb && active) {
                const int row0 = rowbase + qi * 128 + wave * 16;
                bf16x8 qf[8];
#pragma unroll
                for (int ks = 0; ks < 8; ++ks) qf[ks] = *(const GAS bf16x8*)((const GAS bf16*)qx + (size_t)(row0 + fr) * 1024 + h * 256 + ks * 32 + quad * 8);
                f32x4 s[16];
#pragma unroll
                for (int kb = 0; kb < 16; ++kb) { const int key = 32 * (kb >> 1) + (fr >> 2) * 8 + 4 * (kb & 1) + (fr & 3); const LAS unsigned char* kp = lds + key * 528 + quad * 16; f32x4 a = {0.f, 0.f, 0.f, 0.f};
#pragma unroll
                    for (int ks = 0; ks < 8; ++ks) a = MFMA16(*(const LAS bf16x8*)(kp + ks * 64), qf[ks], a);
                    s[kb] = a; }
                float mx = -1e30f;
#pragma unroll
                for (int kb = 0; kb < 16; ++kb)
#pragma unroll
                    for (int j = 0; j < 4; ++j) mx = fmaxf(mx, s[kb][j]);
                mx = fmaxf(mx, __shfl_xor(mx, 16)); mx = fmaxf(mx, __shfl_xor(mx, 32));
                float sum = 0.f;
#pragma unroll
                for (int kb = 0; kb < 16; ++kb)
#pragma unroll
                    for (int j = 0; j < 4; ++j) { const float e = __expf(s[kb][j] - mx); s[kb][j] = e; sum += e; }
                sum += __shfl_xor(sum, 16); sum += __shfl_xor(sum, 32);
                const float inv = 1.0f / sum;
#pragma unroll
                for (int pr = 0; pr < 8; ++pr) pf[qi][pr] = __builtin_bit_cast(bf16x8, pack8(s[2 * pr] * inv, s[2 * pr + 1] * inv));
            }
        }
        __syncthreads();
        xstage(memvT_l + (size_t)bb * 262144 + (size_t)h * 65536, 256, lds, tid);
        __syncthreads();
#pragma unroll
        for (int qi = 0; qi < 2; ++qi) {
            if (qi < nqb && active) {
                const int row0 = rowbase + qi * 128 + wave * 16;
#pragma unroll 4
                for (int db = 0; db < 16; ++db) { f32x4 o = {0.f, 0.f, 0.f, 0.f}; const LAS unsigned char* vp = lds + (db * 16 + fr) * 528 + quad * 16;
#pragma unroll
                    for (int pr = 0; pr < 8; ++pr) o = MFMA16(*(const LAS bf16x8*)(vp + pr * 64), pf[qi][pr], o);
                    u32x2v w; w.x = pk2(o[0], o[1]); w.y = pk2(o[2], o[3]);
                    *(GAS u32x2v*)((GAS bf16*)ox + (size_t)(row0 + fr) * 1024 + h * 256 + db * 16 + quad * 4) = w; }
            }
        }
    }
    __syncthreads();
}

__device__ __forceinline__ void s5_stage_u(const bf16* up, LAS float* ubuf, int lane) {
    const v4u w0 = *(const v4u*)up, w1 = *(const v4u*)(up + 8);
    LAS f32x4* d = (LAS f32x4*)(ubuf + lane * 16);
    d[0] = (f32x4){bflo(w0.x), bfhi(w0.x), bflo(w0.y), bfhi(w0.y)}; d[1] = (f32x4){bflo(w0.z), bfhi(w0.z), bflo(w0.w), bfhi(w0.w)};
    d[2] = (f32x4){bflo(w1.x), bfhi(w1.x), bflo(w1.y), bfhi(w1.y)}; d[3] = (f32x4){bflo(w1.z), bfhi(w1.z), bflo(w1.w), bfhi(w1.w)};
}
__device__ __forceinline__ f32x2v lo2_(f32x4 v) { return __builtin_shufflevector(v, v, 0, 1); }
__device__ __forceinline__ f32x2v hi2_(f32x4 v) { return __builtin_shufflevector(v, v, 2, 3); }
#define S5_STEP(sidx) do { const LAS f32x4* up_ = (const LAS f32x4*)(ubuf + (sidx) * 16); const f32x4 u0 = up_[0], u1 = up_[1], u2 = up_[2], u3 = up_[3]; \
    f32x2v ac_ = lo2_(bb[0]) * u0[0]; ac_ = hi2_(bb[0]) * u0[1] + ac_; ac_ = lo2_(bb[1]) * u0[2] + ac_; ac_ = hi2_(bb[1]) * u0[3] + ac_; \
    ac_ = lo2_(bb[2]) * u1[0] + ac_; ac_ = hi2_(bb[2]) * u1[1] + ac_; ac_ = lo2_(bb[3]) * u1[2] + ac_; ac_ = hi2_(bb[3]) * u1[3] + ac_; \
    ac_ = lo2_(bb[4]) * u2[0] + ac_; ac_ = hi2_(bb[4]) * u2[1] + ac_; ac_ = lo2_(bb[5]) * u2[2] + ac_; ac_ = hi2_(bb[5]) * u2[3] + ac_; \
    ac_ = lo2_(bb[6]) * u3[0] + ac_; ac_ = hi2_(bb[6]) * u3[1] + ac_; ac_ = lo2_(bb[7]) * u3[2] + ac_; ac_ = hi2_(bb[7]) * u3[3] + ac_; \
    const float nr_ = ar * hr - ai * hi + ac_.x, ni_ = ar * hi + ai * hr + ac_.y; hr = nr_; hi = ni_; } while (0)

typedef short bf16x4_t __attribute__((ext_vector_type(4)));
#define MFMA16K16(a, b, c) __builtin_amdgcn_mfma_f32_16x16x16bf16_1k(a, b, c, 0, 0, 0)
__device__ __forceinline__ void s5_bu_block(const bf16* urow0, const bf16x4_t (&bcf)[8], LAS float* bul, int fr, int quad) {
    const bf16x4_t a = *(const bf16x4_t*)(urow0 + (size_t)fr * 1280 + quad * 4);
#pragma unroll
    for (int cb = 0; cb < 8; ++cb) { f32x4 d = {0.f, 0.f, 0.f, 0.f}; d = MFMA16K16(a, bcf[cb], d);
#pragma unroll
        for (int j = 0; j < 4; ++j) bul[(quad * 4 + j) * 130 + cb * 16 + fr] = d[j]; }
}
__device__ __forceinline__ void s5_local(const bf16* proj, const float* abar, const bf16* bbt, float* sloc, LAS float* bul, int slot, int nslots, int lane) {
    const int fr = lane & 15, quad = lane >> 4;
    for (int t = slot; t < 8192; t += nslots) {
        const int chunk = t & 63, g = (t >> 6) & 31, b = t >> 11;
        const float ar = abar[(g * 64 + lane) * 2], ai = abar[(g * 64 + lane) * 2 + 1];
        bf16x4_t bcf[8];
#pragma unroll
        for (int cb = 0; cb < 8; ++cb) bcf[cb] = *(const bf16x4_t*)(bbt + (size_t)(g * 128 + cb * 16 + fr) * 16 + quad * 4);
        float hr = 0.f, hi = 0.f;
        for (int blk = 0; blk < 4; ++blk) {
            s5_bu_block(proj + (size_t)(b * 4096 + chunk * 64 + blk * 16) * 1280 + g * 16, bcf, bul, fr, quad);
#pragma unroll 4
            for (int s = 0; s < 16; ++s) { const f32x2v bu = *(const LAS f32x2v*)(bul + s * 130 + 2 * lane); const float nr = ar * hr - ai * hi + bu.x, ni = ar * hi + ai * hr + bu.y; hr = nr; hi = ni; }
        }
        *(f32x2v*)(sloc + (size_t)t * 128 + lane * 2) = (f32x2v){hr, hi};
    }
}
__device__ __forceinline__ void s5_out(const bf16* proj, const float* abar, const bf16* bbt, const float* sloc, const float* st_re, const float* st_im, const float* c_re, const float* c_im,
                                       const float* dcoef, bf16* gbuf, float* out, LAS float* bul, LAS unsigned* hbuf, int slot, int nslots, int lane) {
    const int fr = lane & 15, quad = lane >> 4;
    for (int t = slot; t < 8192 + 256; t += nslots) {
        const int sample = t >= 8192; int b, g, chunk, nblk, rowbase;
        if (!sample) { chunk = t & 63; g = (t >> 6) & 31; b = t >> 11; nblk = 4; rowbase = b * 4096 + chunk * 64; } else { const int s = t - 8192; g = s & 31; b = s >> 5; chunk = 0; nblk = 2; rowbase = MP + b * 32; }
        const float ar = abar[(g * 64 + lane) * 2], ai = abar[(g * 64 + lane) * 2 + 1];
        bf16x4_t bcf[8];
#pragma unroll
        for (int cb = 0; cb < 8; ++cb) bcf[cb] = *(const bf16x4_t*)(bbt + (size_t)(g * 128 + cb * 16 + fr) * 16 + quad * 4);
        float hr, hi;
        if (!sample) { float pr = ar, pi = ai;
#pragma unroll
            for (int i = 0; i < 6; ++i) { const float t1 = pr * pr - pi * pi; pi = 2.f * pr * pi; pr = t1; }
            hr = 0.f; hi = 0.f; const float* sp = sloc + (size_t)(t - chunk) * 128 + lane * 2;
#pragma unroll 16
            for (int cc = 0; cc < chunk; ++cc) { const f32x2v sv = *(const f32x2v*)(sp + (size_t)cc * 128); const float nr = pr * hr - pi * hi + sv.x, ni = pr * hi + pi * hr + sv.y; hr = nr; hi = ni; } }
        else { hr = st_re[(b * 32 + g) * 64 + lane]; hi = st_im[(b * 32 + g) * 64 + lane]; }
        bf16x8 cf[4];
#pragma unroll
        for (int ks = 0; ks < 4; ++ks) { const f32x4 cr = *(const f32x4*)(c_re + (size_t)(g * 16 + fr) * 64 + ks * 16 + quad * 4), ci = *(const f32x4*)(c_im + (size_t)(g * 16 + fr) * 64 + ks * 16 + quad * 4);
            v4u w; w.x = pg8::cvt_pk_bf16(cr[0], -ci[0]); w.y = pg8::cvt_pk_bf16(cr[1], -ci[1]); w.z = pg8::cvt_pk_bf16(cr[2], -ci[2]); w.w = pg8::cvt_pk_bf16(cr[3], -ci[3]); cf[ks] = __builtin_bit_cast(bf16x8, w); }
        const float dco = dcoef[g * 16 + fr];
        for (int blk = 0; blk < nblk; ++blk) {
            const bf16* urow0 = proj + (size_t)(rowbase + blk * 16) * 1280 + g * 16;
            s5_bu_block(urow0, bcf, bul, fr, quad);
#pragma unroll 4
            for (int s = 0; s < 16; ++s) { const f32x2v bu = *(const LAS f32x2v*)(bul + s * 130 + 2 * lane); const float nr = ar * hr - ai * hi + bu.x, ni = ar * hi + ai * hr + bu.y; hr = nr; hi = ni; hbuf[s * 68 + lane] = pk2(hr, hi); }
            f32x4 y = {0.f, 0.f, 0.f, 0.f};
#pragma unroll
            for (int ks = 0; ks < 4; ++ks) { const bf16x8 a = *(const LAS bf16x8*)(hbuf + fr * 68 + ks * 16 + quad * 4); y = MFMA16(a, cf[ks], y); }
#pragma unroll
            for (int j = 0; j < 4; ++j) { const int s = blk * 16 + quad * 4 + j; const float uu = bflo((unsigned)urow0[(size_t)(quad * 4 + j) * 1280 + fr]); const float yv = y[j] + dco * uu;
                const float z = 0.7978845608028654f * (yv + 0.044715f * yv * yv * yv); const float th = 1.0f - 2.0f / (1.0f + __expf(2.0f * z)); const float gl = 0.5f * yv * (1.0f + th);
                gbuf[(size_t)(rowbase + s) * 512 + g * 16 + fr] = (bf16)f2bf(gl); }
        }
        if (!sample && chunk == 63) { out[OFF_SRP + (b * 32 + g) * 64 + lane] = hr; out[OFF_SIP + (b * 32 + g) * 64 + lane] = hi; }
        if (sample) { out[OFF_SRS + (b * 32 + g) * 64 + lane] = hr; out[OFF_SIS + (b * 32 + g) * 64 + lane] = hi; }
    }
}

template <int KIND>
__device__ __forceinline__ void sample_gemm(const bf16* A, const bf16* Bt, int K, LAS unsigned char* lds, int tid, int wave, int lane,
                                            bf16* xbp, const float* base_f32, float* part_next, const float* part_cur, bf16* O) {
    const int fr = lane & 15, quad = lane >> 4;
    LAS f32x4* red = (LAS f32x4*)lds;
    LAS float* ssred = (LAS float*)(lds + 32768);
    for (int tile = blockIdx.x; tile < 256; tile += gridDim.x) {
        const int r0 = MP + (tile >> 4) * 16, c0 = (tile & 15) * 64, kw = K >> 3;
        const bf16* ap = A + (size_t)(r0 + fr) * K + wave * kw + quad * 8;
        const bf16* bp = Bt + (size_t)(c0 + fr) * K + wave * kw + quad * 8;
        f32x4 acc[4];
#pragma unroll
        for (int cb = 0; cb < 4; ++cb) acc[cb] = (f32x4){0.f, 0.f, 0.f, 0.f};
        const int nks = kw >> 5;
        for (int k0 = 0; k0 < nks; k0 += 4) {
            bf16x8 a[4], b[4][4];
#pragma unroll
            for (int i = 0; i < 4; ++i) { const int ks = (k0 + i < nks) ? k0 + i : nks - 1;
                a[i] = *(const bf16x8*)(ap + ks * 32);
#pragma unroll
                for (int cb = 0; cb < 4; ++cb) b[i][cb] = *(const bf16x8*)(bp + (size_t)cb * 16 * K + ks * 32); }
            __builtin_amdgcn_sched_barrier(0);
#pragma unroll
            for (int i = 0; i < 4; ++i) if (k0 + i < nks) {
#pragma unroll
                for (int cb = 0; cb < 4; ++cb) acc[cb] = MFMA16(b[i][cb], a[i], acc[cb]); }
        }
#pragma unroll
        for (int cb = 0; cb < 4; ++cb) red[(wave * 4 + cb) * 64 + lane] = acc[cb] * 1.0f;
        __syncthreads();
        if (tid < 256) { const int cb = tid >> 6, l2 = tid & 63; f32x4 v = red[cb * 64 + l2];
#pragma unroll
            for (int w = 1; w < 8; ++w) v = v + red[(w * 4 + cb) * 64 + l2];
            const int row = r0 + (l2 & 15), col = c0 + cb * 16 + 4 * (l2 >> 4); const size_t off = (size_t)row * 1024 + col;
            if (KIND == 0) { f32x4 bs;
                if (base_f32) bs = *(const f32x4*)(base_f32 + off);
                else { const u32x2v w = *(const u32x2v*)(xbp + off); bs = (f32x4){bflo(w.x), bfhi(w.x), bflo(w.y), bfhi(w.y)}; }
                v = v + bs; u32x2v o; o.x = pk2(v[0], v[1]); o.y = pk2(v[2], v[3]); *(u32x2v*)(xbp + off) = o;
                float ss = (v[0] * v[0] + v[1] * v[1]) + (v[2] * v[2] + v[3] * v[3]); ss += __shfl_xor(ss, 16); ss += __shfl_xor(ss, 32);
                if ((l2 >> 4) == 0) ssred[cb * 16 + (l2 & 15)] = ss; }
            else { const float rs = rstd_of(part_cur, row); u32x2v o; o.x = pk2(v[0] * rs, v[1] * rs); o.y = pk2(v[2] * rs, v[3] * rs); *(u32x2v*)(O + off) = o; }
        }
        if (KIND == 0) { __syncthreads(); if (tid < 16) part_next[(size_t)(r0 + tid) * 16 + (tile & 15)] = (ssred[tid] + ssred[16 + tid]) + (ssred[32 + tid] + ssred[48 + tid]); }
        __syncthreads();
    }
}

struct Params { const float* in[36]; float* out; unsigned char* ws; int use_cg, pad; };

__global__ void __launch_bounds__(512, 2) mega_fwd(Params P) {
    extern __shared__ __attribute__((aligned(16))) unsigned char lds_raw[];
    LAS unsigned char* lds = (LAS unsigned char*)lds_raw;
    volatile LAS unsigned* MISC = (volatile LAS unsigned*)(lds + MISC_OFF);
    const int G = gridDim.x, NGW = G * 8, NT = G * 512;
    const int wave_s = __builtin_amdgcn_readfirstlane(threadIdx.x >> 6);
    for (int u = threadIdx.x; u < (LDS_BYTES - 131072) / 4; u += 512) ((LAS unsigned*)(lds + 131072))[u] = 0u;
    __syncthreads();
    XcdBarrier bar = xcd_barrier_post((unsigned*)(P.ws + WS_BAR), MISC + 8);
#ifndef STOP_AFTER
#define STOP_AFTER 1000
#endif
    int ph = 0;
#define RUN (ph < STOP_AFTER)
#define FRESH() const int tid = fresh_tid(wave_s), lane = tid & 63, wave = __builtin_amdgcn_readfirstlane(tid >> 6); const int gw = blockIdx.x * 8 + wave, gt = blockIdx.x * 512 + tid; (void)gw; (void)gt; (void)lane; LAS float* wscr = (LAS float*)(lds + 32768 + wave * 12288); (void)wscr;
#define SEAM() do { if (P.use_cg) cg::this_grid().sync(); else xcd_barrier(bar); ++ph; } while (0)

#define part ((float*)(ws + WS_PART))
#define PARTBUF(k) (part + (size_t)((k) & 1) * PART_ELEMS)
#define ropec ((float*)(ws + WS_ROPE))
#define ropes (ropec + 4096 * 32)
#define abar ((float*)(ws + WS_SSM))
#define bbar (abar + 32 * 64 * 2)
#define bbt ((bf16*)(bbar + 32 * 64 * 32))
#define ckb ((bf16*)(ws + WS_CKV))
#define cvb (ckb + 8 * 128 * 128)
#define sloc ((float*)(ws + WS_SLOC))
#define memk ((bf16*)(ws + WS_MEMK))
#define memvT ((bf16*)(ws + WS_MEMVT))
#define SG ((float*)(ws + WS_SIDE))
#define SV ((float*)(ws + WS_SIDE + SG_BYTES))
#define WT ((bf16*)(ws + WS_WT))
#define xb ((bf16*)(ws + WS_XB))
#define tmp (ws + WS_TMP)
#define proj0 ((bf16*)(tmp + TMP_PROJ0))
#define gbuf ((bf16*)(tmp + TMP_GBUF))
#define ycat ((bf16*)(tmp + TMP_YCAT))
#define memb ((bf16*)(tmp + TMP_MEMB))
#define qx ((bf16*)(tmp + TMP_QX))
#define ox ((bf16*)(tmp + TMP_OX))
#define act ((bf16*)(tmp + TMP_ACT))
#define gbm ((bf16*)(tmp + TMP_GB))
#define zc ((bf16*)(tmp + TMP_ZC))
#define PTRS() unsigned char* ws = P.ws; float* out = P.out; asm volatile("" : "+s"(ws), "+s"(out));
    if (RUN) { PTRS() FRESH()
        {
            constexpr int NITEMS = 640 + 128 + 512 + 2 * 512 + 2 * 1024 + 2 * 512 + 2 * 2816 + 2 * 1408 + 1536 + 512 + 2048;
            for (int it = gw; it < NITEMS; it += NGW) { int r = it;
#define TR(Wp, K_, N_, WTp, gainp, sc, mode) { const int ni_ = ((K_) / 64) * ((N_) / 32); if (r < ni_) { tr_item(Wp, K_, N_, WTp, gainp, sc, mode, wscr, r, lane); continue; } r -= ni_; }
                TR(P.in[15], 1024, 1280, WT + WT_INEVEN, P.in[11], 1.f, 1)
                TR(P.in[25], 512, 512, WT + WT_GLU, nullptr, 1.f, 0)
                TR(P.in[16], 1024, 1024, WT + WT_OUTEVEN, nullptr, 1.f, 0)
                TR(P.in[30], 1024, 1024, WT + WT_WQ, P.in[12], 0.0625f, 0)
                TR(P.in[30] + 1048576, 1024, 1024, WT + WT_WQ + 1048576, P.in[12] + 1024, 0.0625f, 0)
                TR(P.in[31], 1024, 2048, WT + WT_WKV, nullptr, 1.f, 0)
                TR(P.in[31] + 2097152, 1024, 2048, WT + WT_WKV + 2097152, nullptr, 1.f, 0)
                TR(P.in[32], 1024, 1024, WT + WT_WO, nullptr, 1.f, 0)
                TR(P.in[32] + 1048576, 1024, 1024, WT + WT_WO + 1048576, nullptr, 1.f, 0)
                TR(P.in[33], 1024, 5632, WT + WT_UP, P.in[13], 1.f, 2)
                TR(P.in[33] + (size_t)1024 * 5632, 1024, 5632, WT + WT_UP + (size_t)5632 * 1024, P.in[13] + 1024, 1.f, 2)
                TR(P.in[35], 2816, 1024, WT + WT_DOWN, nullptr, 1.f, 0)
                TR(P.in[35] + (size_t)2816 * 1024, 2816, 1024, WT + WT_DOWN + (size_t)2816 * 1024, nullptr, 1.f, 0)
                TR(P.in[27], 1024, 3072, WT + WT_INODD, P.in[11] + 1024, 1.f, 3)
                TR(P.in[29], 1024, 1024, WT + WT_OUTODD, nullptr, 1.f, 0)
                { const int mi = r >> 7, l = mi >> 3, b = mi & 7; tr_item(P.in[10] + (size_t)mi * 262144, 256, 1024, memvT + (size_t)(l * 12 + 4 + b) * 262144, nullptr, 1.f, 0, wscr, r & 127, lane); }
            }
        }
        for (int m = gw; m < MROWS; m += NGW) { const float* xr = m < MP ? P.in[0] + (size_t)m * 1024 : P.in[1] + (size_t)(m - MP) * 1024; float ss = 0.f;
#pragma unroll
            for (int j = 0; j < 4; ++j) { const f32x4 v = *(const f32x4*)(xr + (lane + 64 * j) * 4); ss += (v[0] * v[0] + v[1] * v[1]) + (v[2] * v[2] + v[3] * v[3]);
                u32x2v w; w.x = pg8::cvt_pk_bf16(v[0], v[1]); w.y = pg8::cvt_pk_bf16(v[2], v[3]); *(u32x2v*)(xb + (size_t)m * 1024 + (lane + 64 * j) * 4) = w; }
            ss = wave_sum(ss); if (lane < 16) PARTBUF(0)[(size_t)m * 16 + lane] = lane == 0 ? ss : 0.f; }
        for (int i = gt; i < 262144; i += NT) { const f32x4 v = *(const f32x4*)(P.in[2] + (size_t)i * 4); u32x2v w; w.x = pg8::cvt_pk_bf16(v[0], v[1]); w.y = pg8::cvt_pk_bf16(v[2], v[3]); *(u32x2v*)(memb + (size_t)i * 4) = w; }
        for (int i = gt; i < 1048576; i += NT) { const size_t e = (size_t)i * 4; const int lb = (int)(e >> 18), l = lb >> 3, b = lb & 7; const f32x4 v = *(const f32x4*)(P.in[9] + e);
            u32x2v w; w.x = pg8::cvt_pk_bf16(v[0], v[1]); w.y = pg8::cvt_pk_bf16(v[2], v[3]); *(u32x2v*)(memk + (size_t)(l * 12 + 4 + b) * 262144 + (e & 262143)) = w; }
        for (int i = gt; i < 65536; i += NT) { const int j = i & 32767; const float* src = (i < 32768 ? P.in[3] : P.in[4]) + (size_t)j * 4; bf16* dst = (i < 32768 ? ckb : cvb) + (size_t)j * 4;
            const f32x4 v = *(const f32x4*)src; u32x2v w; w.x = pg8::cvt_pk_bf16(v[0], v[1]); w.y = pg8::cvt_pk_bf16(v[2], v[3]); *(u32x2v*)dst = w; }
        for (int i = gt; i < 4096 * 32; i += NT) { const int pos = i >> 5, d = i & 31; const double inv = dexp_(-(double)d * (9.210340371976184 / 32.0)); double s, c; dsincos_((double)pos * inv, s, c); ropec[i] = (float)c; ropes[i] = (float)s; }
        for (int i = gt; i < 2048; i += NT) { const double are = P.in[17][i], aim = P.in[18][i], dt = dexp_((double)P.in[19][i]); double s, c; dsincos_(aim * dt, s, c); const double mag = dexp_(are * dt);
            const double br = mag * c, bi = mag * s; abar[2 * i] = (float)br; abar[2 * i + 1] = (float)bi;
            const double nr = br - 1.0, ni = bi, den = are * are + aim * aim; const double qr = (nr * are + ni * aim) / den, qi = (ni * are - nr * aim) / den;
#pragma unroll 4
            for (int h = 0; h < 16; ++h) { const double xr = P.in[20][(size_t)i * 16 + h], xi = P.in[21][(size_t)i * 16 + h]; const float fre = (float)(qr * xr - qi * xi), fim = (float)(qr * xi + qi * xr); bbar[(size_t)i * 32 + 2 * h] = fre; bbar[(size_t)i * 32 + 2 * h + 1] = fim;
                bbt[((size_t)i * 2) * 16 + h] = (bf16)f2bf(fre); bbt[((size_t)i * 2 + 1) * 16 + h] = (bf16)f2bf(fim); } }
    }
    SEAM();
    if (RUN) { PTRS()
        if (G < 128 || (int)blockIdx.x >= G - 64) { pg8::Gemm g{memb, WT + WT_WKV, 1024, 4096, 1024}; pg8::StaticOrder S;
            if (G < 128) S.init(1024, 4096, G, (int)blockIdx.x); else S.init(1024, 4096, 64, (int)blockIdx.x - (G - 64)); EpiKV E{out, memk};
          pg8::gemm_phase<EpiKV, pg8::StaticOrder, true, true>(lds, g, S, E, wave_s); }
        { pg8::Gemm g{xb, WT + WT_INEVEN, MROWS, 1280, 1024}; pg8::StaticOrderF S; S.init(MROWS, 1280, G, (int)blockIdx.x); EpiIn0 E{proj0, PARTBUF(0), ropec, ropes, out};
          pg8::gemm_phase<EpiIn0, pg8::StaticOrderF, true, true>(lds, g, S, E, wave_s); }
    }
    SEAM();
    if (RUN) { PTRS() FRESH()
        swa_phase(proj0, ckb, cvb, P.in[26], ycat, lds, tid, wave, lane, G);
        s5_local(proj0, abar, bbt, sloc, wscr, wave * G + (int)blockIdx.x, NGW, lane);
        for (int it = wave * G + (int)blockIdx.x; it < 1024; it += NGW) { const int mi = it >> 7, l = mi >> 2, b = mi & 3;
            tr_item(out + OFF_MVP + (size_t)mi * 262144, 256, 1024, memvT + (size_t)(l * 12 + b) * 262144, nullptr, 1.f, 0, wscr, it & 127, lane); }
    }
    SEAM();
    if (RUN) { PTRS() FRESH() s5_out(proj0, abar, bbt, sloc, P.in[5], P.in[6], P.in[22], P.in[23], P.in[24], gbuf, out, (LAS float*)(lds + wave * 16384), (LAS unsigned*)(lds + wave * 16384 + 8448), wave * G + (int)blockIdx.x, NGW, lane); }
    SEAM();
    if (RUN) { PTRS() pg8::Gemm g{gbuf, WT + WT_GLU, MROWS, 512, 512}; pg8::StaticOrder S; S.init(MROWS, 512, G, (int)blockIdx.x); EpiGlu E{gbuf, ycat};
        pg8::gemm_phase<EpiGlu, pg8::StaticOrder, true, true>(lds, g, S, E, wave_s); }
    SEAM();

#pragma unroll
    for (int l = 0; l < 2; ++l) {
        if (l == 1) {
            if (RUN) { PTRS() pg8::Gemm g{xb, WT + WT_INODD, MROWS, 3072, 1024}; pg8::StaticOrderF S; S.init(MROWS, 3072, G, (int)blockIdx.x); EpiInOdd E{gbm, zc, PARTBUF(3), P.in[28], SG};
                pg8::gemm_phase<EpiInOdd, pg8::StaticOrderF, true, true>(lds, g, S, E, wave_s); }
            SEAM();
            if (RUN) { PTRS() FRESH()
                const float* cw = P.in[28]; const float* st = P.in[7];
                for (int i = gt; i < MROWS * 128; i += NT) { const int row = i >> 7, c0 = (i & 127) * 8, blk = row >> 6, r = row & 63;
                    const bool smp = row >= MP; const int rr = smp ? (r & 31) : r;
                    f32x4 z0, z1;
                    if (rr < 2) { const int sb = smp ? (r >> 5) * 4 : 0;
                        f32x4 pa0, pa1, pb0, pb1;
                        if (smp) { const int b = (blk - 256) * 2 + (r >> 5); const float* s0 = st + (size_t)(b * 2) * 1024 + c0; pa0 = *(const f32x4*)s0; pa1 = *(const f32x4*)(s0 + 4); pb0 = *(const f32x4*)(s0 + 1024); pb1 = *(const f32x4*)(s0 + 1028); }
                        else if ((blk & 63) == 0) { pa0 = pa1 = pb0 = pb1 = (f32x4){0.f, 0.f, 0.f, 0.f}; }
                        else { const float* s0 = SG + (size_t)((blk - 1) * 8 + 6) * 1024 + c0; pa0 = *(const f32x4*)s0; pa1 = *(const f32x4*)(s0 + 4); pb0 = *(const f32x4*)(s0 + 1024); pb1 = *(const f32x4*)(s0 + 1028); }
                        const float* sc = SG + (size_t)(blk * 8 + sb) * 1024 + c0; const f32x4 x00 = *(const f32x4*)sc, x01 = *(const f32x4*)(sc + 4);
                        f32x4 xm2a, xm2b, xm1a, xm1b, xca, xcb;
                        if (rr == 0) { xm2a = pa0; xm2b = pa1; xm1a = pb0; xm1b = pb1; xca = x00; xcb = x01; }
                        else { xm2a = pb0; xm2b = pb1; xm1a = x00; xm1b = x01; xca = *(const f32x4*)(sc + 1024); xcb = *(const f32x4*)(sc + 1028); }
                        const f32x4 w0a = *(const f32x4*)(cw + c0), w0b = *(const f32x4*)(cw + c0 + 4), w1a = *(const f32x4*)(cw + 1024 + c0), w1b = *(const f32x4*)(cw + 1028 + c0), w2a = *(const f32x4*)(cw + 2048 + c0), w2b = *(const f32x4*)(cw + 2052 + c0);
                        z0 = w0a * xm2a + w1a * xm1a + w2a * xca; z1 = w0b * xm2b + w1b * xm1b + w2b * xcb; }
                    else { const v4u zw = *(const v4u*)(zc + (size_t)row * 1024 + c0); z0 = (f32x4){bflo(zw.x), bfhi(zw.x), bflo(zw.y), bfhi(zw.y)}; z1 = (f32x4){bflo(zw.z), bfhi(zw.z), bflo(zw.w), bfhi(zw.w)}; }
                    const v4u gw_ = *(const v4u*)(gbm + (size_t)row * 1024 + c0);
                    const f32x4 g0 = (f32x4){bflo(gw_.x), bfhi(gw_.x), bflo(gw_.y), bfhi(gw_.y)}, g1 = (f32x4){bflo(gw_.z), bfhi(gw_.z), bflo(gw_.w), bfhi(gw_.w)};
                    *(v4u*)(gbm + (size_t)row * 1024 + c0) = pack8(g0 * z0, g1 * z1); }
                for (int i = gt; i < 4 * 2 * 1024; i += NT) { const int c = i & 1023, j = (i >> 10) & 1, b = i >> 11; out[OFF_CMP + i] = SG[(size_t)((64 * b + 63) * 8 + 6 + j) * 1024 + c]; }
                for (int i = gt; i < 8 * 2 * 1024; i += NT) { const int c = i & 1023, j = (i >> 10) & 1, b = i >> 11; out[OFF_CMS + i] = SG[(size_t)((256 + (b >> 1)) * 8 + (b & 1) * 4 + 2 + j) * 1024 + c]; }
            }
            SEAM();
        }
        if (RUN) { PTRS() pg8::Gemm g{(bf16*)(tmp + (size_t)(1 - l) * TMP_YCAT), WT + WT_OUTEVEN + (size_t)l * (WT_OUTODD - WT_OUTEVEN), MP, 1024, 1024}; pg8::StaticOrderF S; S.init(MP, 1024, G, (int)blockIdx.x);
            EpiRes E{P.in[0], P.in[1] - (size_t)MP * 1024, xb, PARTBUF(1 + 3 * l), l == 0 ? 1 : 0};
            pg8::gemm_phase<EpiRes, pg8::StaticOrderF, true, true>(lds, g, S, E, wave_s);
            { FRESH() sample_gemm<0>((bf16*)(tmp + (size_t)(1 - l) * TMP_YCAT), WT + WT_OUTEVEN + (size_t)l * (WT_OUTODD - WT_OUTEVEN), 1024, lds, tid, wave, lane, xb, l == 0 ? P.in[1] - (size_t)MP * 1024 : (const float*)nullptr, PARTBUF(1 + 3 * l), nullptr, nullptr); } }
        SEAM();
        if (RUN) { PTRS() pg8::Gemm g{xb, WT + WT_WQ + (size_t)l * 1048576, MP, 1024, 1024}; pg8::StaticOrderF S; S.init(MP, 1024, G, (int)blockIdx.x); EpiBf16 E{qx, 1024, PARTBUF(1 + 3 * l)};
            pg8::gemm_phase<EpiBf16, pg8::StaticOrderF, true, true>(lds, g, S, E, wave_s);
            { FRESH() sample_gemm<1>(xb, WT + WT_WQ + (size_t)l * 1048576, 1024, lds, tid, wave, lane, nullptr, nullptr, nullptr, PARTBUF(1 + 3 * l), qx); } }
        SEAM();
        if (RUN) { PTRS() FRESH() xattn_phase2(qx, memk + (size_t)l * 12 * 262144, memvT + (size_t)l * 12 * 262144, ox, lds, tid, wave, lane, G); }
        SEAM();
        if (RUN) { PTRS() pg8::Gemm g{ox, WT + WT_WO + (size_t)l * 1048576, MP, 1024, 1024}; pg8::StaticOrderF S; S.init(MP, 1024, G, (int)blockIdx.x); EpiRes E{P.in[0], P.in[0], xb, PARTBUF(2 + 3 * l), 0};
            pg8::gemm_phase<EpiRes, pg8::StaticOrderF, true, true>(lds, g, S, E, wave_s);
            { FRESH() sample_gemm<0>(ox, WT + WT_WO + (size_t)l * 1048576, 1024, lds, tid, wave, lane, xb, nullptr, PARTBUF(2 + 3 * l), nullptr, nullptr); } }
        SEAM();
        if (RUN) { PTRS() pg8::Gemm g{xb, WT + WT_UP + (size_t)l * 5632 * 1024, MROWS, 5632, 1024}; pg8::StaticOrderF S; S.init(MROWS, 5632, G, (int)blockIdx.x);
            EpiFfnUp E{act, PARTBUF(2 + 3 * l), P.in[34] + (size_t)l * 3 * DFF, SG, SV};
            pg8::gemm_phase<EpiFfnUp, pg8::StaticOrderF, true, true>(lds, g, S, E, wave_s); }
        SEAM();
        if (RUN) { PTRS() FRESH()
            const float* cw = P.in[34] + (size_t)l * 3 * DFF; const float* st = P.in[8] + (size_t)l * 8 * 2 * DFF;
            for (int i = gt; i < 528 * 352; i += NT) { const int fi = i / 352, c0 = (i % 352) * 8; int blk, row, rr, sb, vb; bool smp = fi >= 512;
                if (!smp) { blk = fi >> 1; rr = fi & 1; row = blk * 64 + rr; sb = 0; vb = 0; } else { const int s = fi - 512, half = (s >> 1) & 1; blk = 256 + (s >> 2); rr = s & 1; row = blk * 64 + half * 32 + rr; sb = half * 4; vb = half * 2; }
                f32x4 pa0, pa1, pb0, pb1;
                if (smp) { const int b = (blk - 256) * 2 + (sb >> 2); const float* s0 = st + (size_t)(b * 2) * DFF + c0; pa0 = *(const f32x4*)s0; pa1 = *(const f32x4*)(s0 + 4); pb0 = *(const f32x4*)(s0 + DFF); pb1 = *(const f32x4*)(s0 + DFF + 4); }
                else if ((blk & 63) == 0) { pa0 = pa1 = pb0 = pb1 = (f32x4){0.f, 0.f, 0.f, 0.f}; }
                else { const float* s0 = SG + (size_t)((blk - 1) * 8 + 6) * DFF + c0; pa0 = *(const f32x4*)s0; pa1 = *(const f32x4*)(s0 + 4); pb0 = *(const f32x4*)(s0 + DFF); pb1 = *(const f32x4*)(s0 + DFF + 4); }
                const float* sc = SG + (size_t)(blk * 8 + sb) * DFF + c0; const f32x4 x00 = *(const f32x4*)sc, x01 = *(const f32x4*)(sc + 4);
                f32x4 xm2a, xm2b, xm1a, xm1b, xca, xcb;
                if (rr == 0) { xm2a = pa0; xm2b = pa1; xm1a = pb0; xm1b = pb1; xca = x00; xcb = x01; }
                else { xm2a = pb0; xm2b = pb1; xm1a = x00; xm1b = x01; xca = *(const f32x4*)(sc + DFF); xcb = *(const f32x4*)(sc + DFF + 4); }
                const f32x4 w0a = *(const f32x4*)(cw + c0), w0b = *(const f32x4*)(cw + c0 + 4), w1a = *(const f32x4*)(cw + DFF + c0), w1b = *(const f32x4*)(cw + DFF + c0 + 4), w2a = *(const f32x4*)(cw + 2 * DFF + c0), w2b = *(const f32x4*)(cw + 2 * DFF + c0 + 4);
                const f32x4 ga = w0a * xm2a + w1a * xm1a + w2a * xca, gb_ = w0b * xm2b + w1b * xm1b + w2b * xcb;
                const float* sv = SV + (size_t)(blk * 4 + vb + rr) * DFF + c0; const f32x4 va = *(const f32x4*)sv, vb_ = *(const f32x4*)(sv + 4);
                f32x4 a0, a1;
#pragma unroll
                for (int j = 0; j < 4; ++j) { a0[j] = ga[j] * sigmoidf_(ga[j]) * va[j]; a1[j] = gb_[j] * sigmoidf_(gb_[j]) * vb_[j]; }
                *(v4u*)(act + (size_t)row * DFF + c0) = pack8(a0, a1); }
            for (int i = gt; i < 4 * 2 * DFF; i += NT) { const int c = i % DFF, j = (i / DFF) & 1, b = i / (2 * DFF); out[OFF_CFP + (size_t)l * 4 * 2 * DFF + i] = SG[(size_t)((64 * b + 63) * 8 + 6 + j) * DFF + c]; }
            for (int i = gt; i < 8 * 2 * DFF; i += NT) { const int c = i % DFF, j = (i / DFF) & 1, b = i / (2 * DFF); out[OFF_CFS + (size_t)l * 8 * 2 * DFF + i] = SG[(size_t)((256 + (b >> 1)) * 8 + (b & 1) * 4 + 2 + j) * DFF + c]; }
        }
        SEAM();
        if (RUN) { PTRS() pg8::Gemm g{act, WT + WT_DOWN + (size_t)l * 2816 * 1024, MP, 1024, DFF}; pg8::StaticOrderF S; S.init(MP, 1024, G, (int)blockIdx.x); EpiRes E{P.in[0], P.in[0], xb, PARTBUF(3 + 3 * l), 0};
            pg8::gemm_phase<EpiRes, pg8::StaticOrderF, true, true>(lds, g, S, E, wave_s);
            { FRESH() sample_gemm<0>(act, WT + WT_DOWN + (size_t)l * 2816 * 1024, DFF, lds, tid, wave, lane, xb, nullptr, PARTBUF(3 + 3 * l), nullptr, nullptr); } }
        SEAM();
    }
    if (RUN) { PTRS() FRESH()
        const float* gf = P.in[14];
        for (int m = gw; m < MROWS; m += NGW) { const float rs = rstd_of(PARTBUF(6), m); float* xr = out + (size_t)m * 1024; const bf16* xbr = xb + (size_t)m * 1024;
#pragma unroll
            for (int j = 0; j < 4; ++j) { const int c = (lane + 64 * j) * 4; const u32x2v w = *(const u32x2v*)(xbr + c); const f32x4 v = (f32x4){bflo(w.x), bfhi(w.x), bflo(w.y), bfhi(w.y)}, gg = *(const f32x4*)(gf + c); *(f32x4*)(xr + c) = v * rs * gg; } }
    }
}

extern "C" void kernel_launch(void* const* d_in, const int* in_sizes, int n_in, void* d_out, int out_size, void* d_ws, size_t ws_size, hipStream_t stream) {
    static int grid = 0;
    if (grid == 0) {
        int dev = 0, cus = 0, per_cu = 0;
        if (n_in != 36 || ws_size < 256 * MiB) { fprintf(stderr, "kernel_launch: unexpected n_in %d / ws %zu\n", n_in, ws_size); grid = -1; return; }
        (void)hipGetDevice(&dev); (void)hipDeviceGetAttribute(&cus, hipDeviceAttributeMultiprocessorCount, dev);
        if (hipFuncSetAttribute((const void*)mega_fwd, hipFuncAttributeMaxDynamicSharedMemorySize, LDS_BYTES) != hipSuccess) { fprintf(stderr, "kernel_launch: hipFuncSetAttribute failed\n"); grid = -1; return; }
        if (hipOccupancyMaxActiveBlocksPerMultiprocessor(&per_cu, (const void*)mega_fwd, 512, LDS_BYTES) != hipSuccess || per_cu < 1) per_cu = 1;
        (void)hipGetLastError();
        grid = cus * 1;
        if (grid > 256) grid = 256;
    }
    if (grid < 0) return;
    (void)hipMemsetAsync(d_ws, 0, CTL_ZERO_BYTES, stream);
    Params p{};
    for (int i = 0; i < 36; ++i) p.in[i] = (const float*)d_in[i];
    p.out = (float*)d_out; p.ws = (unsigned char*)d_ws; p.use_cg = 0; p.pad = 0;
    void* args[] = {&p};
    hipError_t e = hipLaunchCooperativeKernel((const void*)mega_fwd, dim3(grid), dim3(512), args, LDS_BYTES, stream);
    if (e != hipSuccess) fprintf(stderr, "cooperative launch failed: %s (grid %d)\n", hipGetErrorString(e), grid);
}
```

```cpp
#include <hip/hip_runtime.h>
#include <hip/hip_cooperative_groups.h>
#include <cstdio>
#include <cstdint>
namespace cg = cooperative_groups;
__device__ __forceinline__ int fresh_tid(int wave_s) { unsigned z = 0u; asm volatile("" : "+s"(z)); int t = wave_s * 64 + (int)__builtin_amdgcn_mbcnt_hi(~0u, __builtin_amdgcn_mbcnt_lo(~0u, z)); asm volatile("" : "+v"(t)); return t; }
namespace pg8 {
#define PG8_LAS __attribute__((address_space(3)))
typedef unsigned short bf16_t;
typedef short bf16x8 __attribute__((ext_vector_type(8)));
typedef float f32x4 __attribute__((ext_vector_type(4)));
typedef unsigned u32x4 __attribute__((ext_vector_type(4)));
constexpr int BM = 256, BK = 64, HALF = 128, HTB = HALF * BK * 2  , STAGE_BYTES = 8 * HTB, NXCD = 8, WGM = 8;

__host__ __device__ __forceinline__ int lds_byte(int r, int c) { const int st = (r >> 4) * 2 + (c >> 5), rr = r & 15, cc = c & 31, ob = rr * 64 + cc * 2; return st * 1024 + (ob ^ (((ob >> 9) & 1) << 5)); }
__host__ __device__ __forceinline__ void stage_rc(int b, int& R, int& C) { const int st = b / 1024, sb = b % 1024, swz = sb ^ (((sb >> 9) & 1) << 5); R = (st >> 1) * 16 + swz / 64; C = (st & 1) * 32 + (swz % 64) / 2; }
__host__ __device__ __forceinline__ int perm32(int rho) { const int n = rho >> 4, i = rho & 15; return 8 * (i >> 2) + 4 * n + (i & 3); }

struct Unit { int pm, pn; };
struct Gemm { const bf16_t* A; const bf16_t* Bt; int M, N, K; };

template <bool FULL> struct StaticOrderT {
    int nM, nN, nwg, G, c;
    __host__ __device__ void init(int M, int N, int G_, int c_) { nM = M / BM; nN = N / BM; nwg = nM * nN; G = G_; c = c_; }
    __host__ __device__ bool next(int i, Unit& u) const {
        const long L = (long)i * G + c; if (!(FULL && i == 0) && L >= nwg) return false;
        int wgid = (int)L; { const int q = nwg / NXCD, r = nwg % NXCD, xcd = wgid % NXCD, off = wgid / NXCD; wgid = (xcd < r ? xcd * (q + 1) : r * (q + 1) + (xcd - r) * q) + off; }
        const int nig = WGM * nN, gid = wgid / nig, fm = gid * WGM, gsz = (nM - fm) < WGM ? (nM - fm) : WGM;
        u.pm = fm + ((wgid % nig) % gsz); u.pn = (wgid % nig) / gsz; return true;
    }
    __device__ __forceinline__ void a_ready(const Unit&) const {}
    __device__ __forceinline__ void done(const Unit&) const {}
};

typedef StaticOrderT<false> StaticOrder; typedef StaticOrderT<true> StaticOrderF;
__device__ __forceinline__ unsigned cvt_pk_bf16(float lo, float hi) { unsigned r; asm volatile("v_cvt_pk_bf16_f32 %0, %1, %2" : "=v"(r) : "v"(lo), "v"(hi)); return r; }
typedef float f32x2 __attribute__((ext_vector_type(2)));
template <class Epi, class Sched, bool ALIGN_EPI = false, bool SP2 = false>
__device__ __forceinline__ void gemm_phase(PG8_LAS unsigned char* lds, const Gemm g, const Sched& S, const Epi& E, const int wave_s) {
    const int tid = fresh_tid(wave_s), wid = __builtin_amdgcn_readfirstlane(tid >> 6), lane = tid & 63, wr = wid >> 2, wc = wid & 3, fr = lane & 15, fq = lane >> 4;
    const int K = g.K, nt = K / BK;
    unsigned voffA[2], voffB[2];
#pragma unroll
    for (int i = 0; i < 2; ++i) { int R, C; stage_rc(tid * 16 + i * 8192, R, C); const int Rb = Epi::PERM ? ((R & ~31) + perm32(R & 31)) : R;
        voffA[i] = (unsigned)(R * K + C) * 2u; voffB[i] = (unsigned)(Rb * K + C) * 2u; }
    const size_t kstep = (size_t)(BK * 2);
    const size_t hstep = (size_t)HALF * K * 2;
    const size_t tstep = 2 * hstep;
    const unsigned ldsw = (unsigned)wid * 1024u;
    const int aoff = lds_byte(wr * 64 + fr, fq * 8), boff = lds_byte(wc * 32 + fr, fq * 8);
#define PG8_SA(b, h) (((b) * 2 + (h)) * HTB)
#define PG8_SB(b, h) ((4 + (b) * 2 + (h)) * HTB)
#define PG8_STAGE(bufoff, gbase, voff) do { _Pragma("unroll") for (int _i = 0; _i < 2; ++_i) \
        __builtin_amdgcn_global_load_lds((const unsigned*)((const char*)(gbase) + (voff)[_i]), (PG8_LAS unsigned*)(lds + (bufoff) + ldsw + _i * 8192), 16, 0, 0); } while (0)
#define PG8_LDA(dst, b, h) do { _Pragma("unroll") for (int m = 0; m < 4; ++m) _Pragma("unroll") for (int k = 0; k < 2; ++k) dst[m][k] = *(const PG8_LAS bf16x8*)(lds + PG8_SA(b, h) + aoff + m * 2048 + k * 1024); } while (0)
#define PG8_LDB(dst, b, h) do { _Pragma("unroll") for (int n = 0; n < 2; ++n) _Pragma("unroll") for (int k = 0; k < 2; ++k) dst[n][k] = *(const PG8_LAS bf16x8*)(lds + PG8_SB(b, h) + boff + n * 2048 + k * 1024); } while (0)
#define PG8_MMA(ai, bj, At, Bt) do { __builtin_amdgcn_s_setprio(1); _Pragma("unroll") for (int m = 0; m < 4; ++m) _Pragma("unroll") for (int n = 0; n < 2; ++n) _Pragma("unroll") for (int k = 0; k < 2; ++k) \
        acc[ai][bj][m][n] = __builtin_amdgcn_mfma_f32_16x16x32_bf16(Bt[n][k], At[m][k], acc[ai][bj][m][n], 0, 0, 0); __builtin_amdgcn_s_setprio(0); } while (0)
#define PG8_WAIT_V(n) asm volatile("s_waitcnt vmcnt(" #n ")" ::: "memory")
#define PG8_WAIT_L(n) asm volatile("s_waitcnt lgkmcnt(" #n ")" ::: "memory")
#define PG8_BAR __builtin_amdgcn_s_barrier()
#define PG8_SCHED __builtin_amdgcn_sched_barrier(0)
    Unit cur, nxt; int ui = 0;
    if (!S.next(0, cur)) return;
    f32x4 acc[2][2][4][2];
#pragma unroll
    for (int a = 0; a < 2; ++a)
#pragma unroll
        for (int b = 0; b < 2; ++b)
#pragma unroll
            for (int m = 0; m < 4; ++m)
#pragma unroll
                for (int n = 0; n < 2; ++n) acc[a][b][m][n] = (f32x4){0.f, 0.f, 0.f, 0.f};
    bf16x8 At[4][2], B0[2][2], B1[2][2];
    const char* cA = (const char*)g.A + (size_t)cur.pm * tstep; const char* cB = (const char*)g.Bt + (size_t)cur.pn * tstep;
    S.a_ready(cur);
    if constexpr (SP2) {
        PG8_STAGE(PG8_SB(0, 0), cB, voffB); PG8_STAGE(PG8_SB(0, 1), cB + hstep, voffB); PG8_STAGE(PG8_SA(0, 0), cA, voffA); PG8_STAGE(PG8_SA(0, 1), cA + hstep, voffA);
        if (wr == 1) PG8_BAR;
        PG8_WAIT_V(2); PG8_BAR;
        PG8_STAGE(PG8_SB(1, 0), cB + kstep, voffB); PG8_STAGE(PG8_SA(1, 0), cA + kstep, voffA); PG8_STAGE(PG8_SB(1, 1), cB + hstep + kstep, voffB);
        PG8_WAIT_V(6); PG8_BAR;
    } else {
        PG8_STAGE(PG8_SB(0, 0), cB, voffB); PG8_STAGE(PG8_SA(0, 0), cA, voffA); PG8_STAGE(PG8_SB(0, 1), cB + hstep, voffB); PG8_STAGE(PG8_SA(0, 1), cA + hstep, voffA);
        if (wr == 1) PG8_BAR;
        PG8_WAIT_V(4); PG8_BAR;
        PG8_STAGE(PG8_SB(1, 0), cB + kstep, voffB); PG8_STAGE(PG8_SA(1, 0), cA + kstep, voffA); PG8_STAGE(PG8_SB(1, 1), cB + hstep + kstep, voffB);
        PG8_WAIT_V(6); PG8_BAR;
    }
    for (;;) {
        const bool has_next = S.next(ui + 1, nxt);
        const char* nA = has_next ? (const char*)g.A + (size_t)nxt.pm * tstep : cA; const char* nB = has_next ? (const char*)g.Bt + (size_t)nxt.pn * tstep : cB;
        for (int t = 0; t < nt; t += 2) {
            const bool last = (t == nt - 2);
            const char* a1 = cA + (size_t)(t + 1) * kstep;
            const char* a2 = last ? nA : cA + (size_t)(t + 2) * kstep; const char* b2 = last ? nB : cB + (size_t)(t + 2) * kstep;
            const char* a3 = a2 + kstep; const char* b3 = b2 + kstep;
            if (last && has_next) S.a_ready(nxt);
            if constexpr (SP2) {
            PG8_LDB(B0, 0, 0); PG8_LDB(B1, 0, 1); PG8_SCHED; PG8_LDA(At, 0, 0); PG8_STAGE(PG8_SA(1, 1), a1 + hstep, voffA);
            PG8_WAIT_V(8); PG8_WAIT_L(0); PG8_BAR; PG8_MMA(0, 0, At, B0); PG8_MMA(0, 1, At, B1); PG8_BAR; PG8_SCHED;
            PG8_LDA(At, 0, 1); PG8_STAGE(PG8_SB(0, 0), b2, voffB); PG8_STAGE(PG8_SB(0, 1), b2 + hstep, voffB); PG8_STAGE(PG8_SA(0, 0), a2, voffA);
            PG8_WAIT_V(8); PG8_WAIT_L(0); PG8_BAR; PG8_MMA(1, 0, At, B0); PG8_MMA(1, 1, At, B1); PG8_BAR; PG8_SCHED;
            PG8_LDB(B0, 1, 0); PG8_LDB(B1, 1, 1); PG8_SCHED; PG8_LDA(At, 1, 0); PG8_STAGE(PG8_SA(0, 1), a2 + hstep, voffA);
            PG8_WAIT_V(8); PG8_WAIT_L(0); PG8_BAR; PG8_MMA(0, 0, At, B0); PG8_MMA(0, 1, At, B1); PG8_BAR; PG8_SCHED;
            PG8_LDA(At, 1, 1); PG8_STAGE(PG8_SB(1, 0), b3, voffB); PG8_STAGE(PG8_SB(1, 1), b3 + hstep, voffB); PG8_STAGE(PG8_SA(1, 0), a3, voffA);
            PG8_WAIT_V(8); PG8_WAIT_L(0); PG8_BAR; PG8_MMA(1, 0, At, B0); PG8_MMA(1, 1, At, B1); PG8_BAR; PG8_SCHED;
            } else {
            PG8_LDB(B0, 0, 0); PG8_SCHED; PG8_LDA(At, 0, 0); PG8_STAGE(PG8_SA(1, 1), a1 + hstep, voffA);
            PG8_WAIT_L(8); PG8_BAR; PG8_WAIT_L(0); PG8_MMA(0, 0, At, B0); PG8_BAR; PG8_SCHED;
            PG8_LDB(B1, 0, 1); PG8_STAGE(PG8_SB(0, 0), b2, voffB);
            PG8_BAR; PG8_WAIT_L(0); PG8_MMA(0, 1, At, B1); PG8_BAR;
            PG8_LDA(At, 0, 1); PG8_STAGE(PG8_SA(0, 0), a2, voffA);
            PG8_BAR; PG8_WAIT_L(0); PG8_MMA(1, 0, At, B0); PG8_BAR; PG8_SCHED;
            PG8_STAGE(PG8_SB(0, 1), b2 + hstep, voffB);
            PG8_WAIT_V(6); PG8_BAR; PG8_MMA(1, 1, At, B1); PG8_BAR;
            PG8_LDB(B0, 1, 0); PG8_SCHED; PG8_LDA(At, 1, 0); PG8_STAGE(PG8_SA(0, 1), a2 + hstep, voffA);
            PG8_WAIT_L(8); PG8_BAR; PG8_WAIT_L(0); PG8_MMA(0, 0, At, B0); PG8_BAR; PG8_SCHED;
            PG8_LDB(B1, 1, 1); PG8_STAGE(PG8_SB(1, 0), b3, voffB);
            PG8_BAR; PG8_WAIT_L(0); PG8_MMA(0, 1, At, B1); PG8_BAR;
            PG8_LDA(At, 1, 1); PG8_STAGE(PG8_SA(1, 0), a3, voffA);
            PG8_BAR; PG8_WAIT_L(0); PG8_MMA(1, 0, At, B0); PG8_BAR; PG8_SCHED;
            PG8_STAGE(PG8_SB(1, 1), b3 + hstep, voffB);
            PG8_WAIT_V(6); PG8_BAR; PG8_MMA(1, 1, At, B1); PG8_BAR;
            }
        }
        if constexpr (ALIGN_EPI) { if (wr == 0) PG8_BAR; }
        if constexpr (!Epi::AFTER_DRAIN) { E(acc, cur, wr, wc, fr, fq); S.done(cur); }
        if (!has_next) break;
#pragma unroll
        for (int a = 0; a < 2; ++a)
#pragma unroll
            for (int b = 0; b < 2; ++b)
#pragma unroll
                for (int m = 0; m < 4; ++m)
#pragma unroll
                    for (int n = 0; n < 2; ++n) acc[a][b][m][n] = (f32x4){0.f, 0.f, 0.f, 0.f};
        cur = nxt; cA = nA; cB = nB; ++ui;
        if constexpr (ALIGN_EPI) { if (wr == 1) PG8_BAR; }
    }
    PG8_WAIT_V(0);
    if constexpr (!ALIGN_EPI) { if (wr == 0) PG8_BAR; }
    PG8_BAR;
    if constexpr (Epi::AFTER_DRAIN) { E.fused(acc, cur, wr, wc, fr, fq, lds, wid, lane); S.done(cur); }
#undef PG8_SA
#undef PG8_SB
#undef PG8_STAGE
#undef PG8_LDA
#undef PG8_LDB
#undef PG8_MMA
#undef PG8_WAIT_V
#undef PG8_WAIT_L
#undef PG8_BAR
#undef PG8_SCHED
}
}
#define GAS __attribute__((address_space(1)))
#define LAS __attribute__((address_space(3)))
typedef unsigned short bf16;
typedef unsigned v4u __attribute__((ext_vector_type(4)));
typedef float f32x4 __attribute__((ext_vector_type(4)));
typedef short bf16x8 __attribute__((ext_vector_type(8)));
typedef GAS unsigned gu32;
typedef GAS unsigned long long gu64;
#define RLX_AGENT __ATOMIC_RELAXED, __HIP_MEMORY_SCOPE_AGENT
#define LDS_WAIT() asm volatile("s_waitcnt lgkmcnt(0)" ::: "memory")
#define VM_WAIT() asm volatile("s_waitcnt vmcnt(0)" ::: "memory")
__device__ __forceinline__ unsigned long long rt() { return __builtin_amdgcn_s_memrealtime(); }
__device__ __forceinline__ unsigned f2bf(float f) { unsigned u = __builtin_bit_cast(unsigned, f); return (u + 0x7fffu + ((u >> 16) & 1u)) >> 16; }
__device__ __forceinline__ unsigned pk2(float lo, float hi) { return f2bf(lo) | (f2bf(hi) << 16); }

#define XB_TMO      128
#define XB_XCNT(j)  (256  + 64 * (j))
#define XB_XSUB(j)  (1280 + 64 * (j))
#define XB_XGEN(j)  (2304 + 64 * (j))
#define XB_TOP      3328
#define XB_TOPGEN   3392
#define XCD_BAR_WORDS 3456
#define XB_SPIN_CAP (1u << 18)

__device__ __forceinline__ unsigned xb_ld(unsigned* p)              { return __hip_atomic_load(p, __ATOMIC_RELAXED, __HIP_MEMORY_SCOPE_AGENT); }
__device__ __forceinline__ unsigned xb_add(unsigned* p, unsigned v) { return __hip_atomic_fetch_add(p, v, __ATOMIC_RELAXED, __HIP_MEMORY_SCOPE_AGENT); }
__device__ __forceinline__ unsigned xb_xcc_id() { return (unsigned)__builtin_amdgcn_s_getreg((3 << 11) | 20) & 0xFu; }
#define XB_SPIN(cond, bar) do { unsigned _sp = 0; while (cond) { __builtin_amdgcn_s_sleep(1); \
    if ((++_sp & 255u) == 0u) { if (xb_ld(&(bar)[XB_TMO])) break; if (_sp > XB_SPIN_CAP) { atomicAdd(&(bar)[XB_TMO], 1u); break; } } } } while (0)

struct XcdBarrier {
    unsigned* bar; unsigned x;
    volatile LAS unsigned* st;
};

__device__ __forceinline__ XcdBarrier xcd_barrier_post(unsigned* bar, volatile LAS unsigned* st) {
    XcdBarrier b; b.bar = bar; b.x = xb_xcc_id(); b.st = st;
    if (threadIdx.x == 0) (void)xb_add(&bar[XB_XCNT(b.x)], 1u);
    return b;
}
__device__ __forceinline__ void xcd_barrier_complete(unsigned* bar, unsigned x, unsigned& nloc, unsigned& nx) {
    const unsigned G = gridDim.x * gridDim.y * gridDim.z;
    unsigned sum, cnt, mine, sp = 0u;
    for (;;) {
        sum = 0u; cnt = 0u; mine = 0u;
#pragma unroll
        for (unsigned j = 0; j < 16; ++j) { const unsigned c = xb_ld(&bar[XB_XCNT(j)]); sum += c; cnt += (c > 0u) ? 1u : 0u; mine = (j == x) ? c : mine; }
        if (sum == G) break;
        __builtin_amdgcn_s_sleep(1);
        if ((++sp & 255u) == 0u) { if (xb_ld(&bar[XB_TMO])) break; if (sp > XB_SPIN_CAP) { atomicAdd(&bar[XB_TMO], 1u); break; } }
    }
    nloc = mine > 0u ? mine : 1u; nx = cnt > 0u ? cnt : 1u;
}

__device__ __forceinline__ void xcd_barrier(const XcdBarrier& b) {
    asm volatile("s_waitcnt vmcnt(0)" ::: "memory");
    __syncthreads();
    if (threadIdx.x == 0) {
        unsigned* bar = b.bar;
        __builtin_amdgcn_s_waitcnt(0);
        unsigned nloc = b.st[0], nx = b.st[1];
        if (nloc == 0u) { xcd_barrier_complete(bar, b.x, nloc, nx); b.st[0] = nloc; b.st[1] = nx; }
        const unsigned old = xb_add(&bar[XB_XSUB(b.x)], 1u);
        const unsigned gen = old / nloc;
        if (old + 1u == (gen + 1u) * nloc) {
            __builtin_amdgcn_fence(__ATOMIC_RELEASE, "agent");
            asm volatile("s_waitcnt vmcnt(0)" ::: "memory");
            const unsigned og = xb_add(&bar[XB_TOP], 1u);
            const unsigned tg = og / nx;
            if (og + 1u == (tg + 1u) * nx) xb_add(&bar[XB_TOPGEN], 1u);
            else XB_SPIN(xb_ld(&bar[XB_TOPGEN]) == tg, bar);
            __builtin_amdgcn_fence(__ATOMIC_ACQUIRE, "agent");
            xb_add(&bar[XB_XGEN(b.x)], 1u);
            asm volatile("s_waitcnt vmcnt(0)" ::: "memory");
        } else {
            XB_SPIN(xb_ld(&bar[XB_XGEN(b.x)]) == gen, bar);
            __builtin_amdgcn_fence(__ATOMIC_ACQUIRE, "agent");
            asm volatile("s_waitcnt vmcnt(0)" ::: "memory");
        }
    }
    __syncthreads();
}
typedef unsigned u32x2v __attribute__((ext_vector_type(2)));
typedef float f32x2v __attribute__((ext_vector_type(2)));

constexpr int MP = 16384, MROWS = 16640, DMODEL = 1024, DFF = 2816, NBLK64 = MROWS / 64;
constexpr float RMS_EPS = 1e-6f;
constexpr size_t OFF_Y = 0, OFF_WKP = (size_t)MROWS * 1024, OFF_WVP = OFF_WKP + 65536, OFF_SRP = OFF_WVP + 65536, OFF_SIP = OFF_SRP + 8192,
    OFF_CMP = OFF_SIP + 8192, OFF_CFP = OFF_CMP + 8192, OFF_MKP = OFF_CFP + 45056, OFF_MVP = OFF_MKP + 2097152, OFF_WKS = OFF_MVP + 2097152,
    OFF_WVS = OFF_WKS + 32768, OFF_SRS = OFF_WVS + 32768, OFF_SIS = OFF_SRS + 16384, OFF_CMS = OFF_SIS + 16384, OFF_CFS = OFF_CMS + 16384;
constexpr size_t MiB = 1u << 20;
constexpr size_t WS_ROWSS = 0, WS_BAR = 512 * 1024, CTL_ZERO_BYTES = 1 * MiB;
constexpr size_t WS_ROPE = 1 * MiB, WS_SSM = 2 * MiB, WS_CKV = 3 * MiB, WS_SLOC = 4 * MiB, WS_MEMK = 8 * MiB, WS_MEMVT = 20 * MiB, WS_SIDE = 32 * MiB;
constexpr size_t SG_BYTES = (size_t)NBLK64 * 8 * DFF * 4, SV_BYTES = (size_t)NBLK64 * 4 * DFF * 4;
static_assert(WS_SIDE + SG_BYTES + SV_BYTES <= 66 * MiB, "side buffers");
constexpr size_t WS_WT = 66 * MiB, WS_XB = 128 * MiB, WS_TMP = 161 * MiB;
constexpr size_t WT_INEVEN = 0, WT_GLU = WT_INEVEN + 1280 * 1024, WT_OUTEVEN = WT_GLU + 512 * 512, WT_WQ = WT_OUTEVEN + 1024 * 1024, WT_WKV = WT_WQ + 2 * 1024 * 1024,
    WT_WO = WT_WKV + 2 * 2048 * 1024, WT_UP = WT_WO + 2 * 1024 * 1024, WT_DOWN = WT_UP + (size_t)2 * 5632 * 1024, WT_INODD = WT_DOWN + (size_t)2 * 2816 * 1024,
    WT_OUTODD = WT_INODD + 3072 * 1024, WT_END = WT_OUTODD + 1024 * 1024;
static_assert(WS_WT + WT_END * 2 <= WS_XB, "weights");
static_assert(WS_XB + (size_t)MROWS * 1024 * 2 <= WS_TMP, "xb");
constexpr size_t TMP_BYTES = (size_t)MROWS * DFF * 2;
constexpr size_t WS_PART = 251 * MiB, PART_ELEMS = (size_t)MROWS * 16;
static_assert(WS_PART + 2 * PART_ELEMS * 4 <= 256 * MiB, "part");
static_assert(WS_TMP + TMP_BYTES <= 256 * MiB, "ws");
constexpr size_t TMP_PROJ0 = 0, TMP_GBUF = (size_t)MROWS * 1280 * 2, TMP_YCAT = TMP_GBUF + (size_t)MROWS * 512 * 2, TMP_MEMB = TMP_YCAT;
static_assert(TMP_YCAT + (size_t)MROWS * 1024 * 2 <= TMP_BYTES, "tmp");
constexpr size_t TMP_QX = 0, TMP_OX = (size_t)MROWS * 1024 * 2, TMP_ACT = 0, TMP_GB = 0, TMP_ZC = (size_t)MROWS * 1024 * 2;
constexpr int LDS_BYTES = 147456, MISC_OFF = 147456 - 512;
constexpr int NPH = 22;

#define MFMA16(a, b, c) __builtin_amdgcn_mfma_f32_16x16x32_bf16(a, b, c, 0, 0, 0)
__device__ __forceinline__ float bflo(unsigned w) { return __uint_as_float(w << 16); }
__device__ __forceinline__ float bfhi(unsigned w) { return __uint_as_float(w & 0xffff0000u); }
__device__ __forceinline__ v4u pack8(f32x4 a, f32x4 b) { v4u w; w.x = pg8::cvt_pk_bf16(a[0], a[1]); w.y = pg8::cvt_pk_bf16(a[2], a[3]); w.z = pg8::cvt_pk_bf16(b[0], b[1]); w.w = pg8::cvt_pk_bf16(b[2], b[3]); return w; }
__device__ __forceinline__ float rstd_of(const float* part, int row) { const f32x4* p = (const f32x4*)(part + (size_t)row * 16); const f32x4 a = p[0] + p[1] + p[2] + p[3]; return rsqrtf(((a[0] + a[1]) + (a[2] + a[3])) * (1.0f / 1024.0f) + RMS_EPS); }
__device__ __forceinline__ float sigmoidf_(float x) { return 1.0f / (1.0f + __expf(-x)); }
__device__ __forceinline__ float dpp_ror1(float v) { return __builtin_bit_cast(float, __builtin_amdgcn_update_dpp(0, __builtin_bit_cast(int, v), 0x121, 0xf, 0xf, false)); }
__device__ __forceinline__ float dpp_ror2(float v) { return __builtin_bit_cast(float, __builtin_amdgcn_update_dpp(0, __builtin_bit_cast(int, v), 0x122, 0xf, 0xf, false)); }
__device__ __forceinline__ float wave_sum(float v) {
#pragma unroll
    for (int o = 1; o < 64; o <<= 1) v += __shfl_xor(v, o);
    return v;
}

typedef pg8::Unit Unit;
#define EPI_ARGS const f32x4 (&acc)[2][2][4][2], const Unit& u, int wr, int wc, int fr, int fq

struct EpiBf16 {
    static constexpr bool PERM = true, AFTER_DRAIN = false;
    bf16* O; int ldc; const float* rowss;
    __device__ __forceinline__ void operator()(EPI_ARGS) const {
        const int row0 = u.pm * 256 + wr * 64 + fr, col0 = u.pn * 256 + wc * 32 + 8 * fq;
#pragma unroll
        for (int ai = 0; ai < 2; ++ai)
#pragma unroll
            for (int m = 0; m < 4; ++m) { const int row = row0 + ai * 128 + m * 16; const float rs = rstd_of(rowss, row); bf16* rp = O + (size_t)row * ldc + col0;
#pragma unroll
                for (int bj = 0; bj < 2; ++bj) *(v4u*)(rp + bj * 128) = pack8(acc[ai][bj][m][0] * rs, acc[ai][bj][m][1] * rs); }
    }
};
struct EpiRes {
    static constexpr bool PERM = true, AFTER_DRAIN = false;
    const float* base_p; const float* base_s; bf16* xb; float* rowss_next; int f32base;
    __device__ __forceinline__ void operator()(EPI_ARGS) const {
        const float* base = u.pm < 64 ? base_p : base_s;
        const int row0 = u.pm * 256 + wr * 64 + fr, col0 = u.pn * 256 + wc * 32 + 8 * fq;
#pragma unroll
        for (int ai = 0; ai < 2; ++ai)
#pragma unroll
            for (int m = 0; m < 4; ++m) { const int row = row0 + ai * 128 + m * 16; const size_t off = (size_t)row * 1024 + col0; float ss = 0.f;
#pragma unroll
                for (int bj = 0; bj < 2; ++bj) { f32x4 b0, b1;
                    if (f32base) { b0 = *(const f32x4*)(base + off + bj * 128); b1 = *(const f32x4*)(base + off + bj * 128 + 4); }
                    else { const v4u w = *(const v4u*)(xb + off + bj * 128); b0 = (f32x4){bflo(w.x), bfhi(w.x), bflo(w.y), bfhi(w.y)}; b1 = (f32x4){bflo(w.z), bfhi(w.z), bflo(w.w), bfhi(w.w)}; }
                    const f32x4 v0 = acc[ai][bj][m][0] + b0, v1 = acc[ai][bj][m][1] + b1;
                    *(v4u*)(xb + off + bj * 128) = pack8(v0, v1);
                    ss += (v0[0] * v0[0] + v0[1] * v0[1]) + (v0[2] * v0[2] + v0[3] * v0[3]) + (v1[0] * v1[0] + v1[1] * v1[1]) + (v1[2] * v1[2] + v1[3] * v1[3]); }
                ss += __shfl_xor(ss, 16); ss += __shfl_xor(ss, 32);
                if (fq == 0) rowss_next[(size_t)row * 16 + u.pn * 4 + wc] = ss; }
    }
};
struct EpiGlu {
    static constexpr bool PERM = true, AFTER_DRAIN = false;
    const bf16* g; bf16* ycat;
    __device__ __forceinline__ void operator()(EPI_ARGS) const {
        const int row0 = u.pm * 256 + wr * 64 + fr, col0 = u.pn * 256 + wc * 32 + 8 * fq;
#pragma unroll
        for (int ai = 0; ai < 2; ++ai)
#pragma unroll
            for (int m = 0; m < 4; ++m) { const int row = row0 + ai * 128 + m * 16;
#pragma unroll
                for (int bj = 0; bj < 2; ++bj) { const int col = col0 + bj * 128; const v4u gw = *(const v4u*)(g + (size_t)row * 512 + col);
                    const f32x4 a0 = acc[ai][bj][m][0], a1 = acc[ai][bj][m][1]; f32x4 o0, o1;
                    o0[0] = bflo(gw.x) * sigmoidf_(a0[0]); o0[1] = bfhi(gw.x) * sigmoidf_(a0[1]); o0[2] = bflo(gw.y) * sigmoidf_(a0[2]); o0[3] = bfhi(gw.y) * sigmoidf_(a0[3]);
                    o1[0] = bflo(gw.z) * sigmoidf_(a1[0]); o1[1] = bfhi(gw.z) * sigmoidf_(a1[1]); o1[2] = bflo(gw.w) * sigmoidf_(a1[2]); o1[3] = bfhi(gw.w) * sigmoidf_(a1[3]);
                    *(v4u*)(ycat + (size_t)row * 1024 + col) = pack8(o0, o1); } }
    }
};
struct EpiKV {
    static constexpr bool PERM = true, AFTER_DRAIN = false;
    float* out; bf16* memk;
    __device__ __forceinline__ void operator()(EPI_ARGS) const {
        const int row0 = u.pm * 256 + wr * 64 + fr, col0 = u.pn * 256 + wc * 32 + 8 * fq;
#pragma unroll
        for (int ai = 0; ai < 2; ++ai)
#pragma unroll
            for (int m = 0; m < 4; ++m) { const int row = row0 + ai * 128 + m * 16;
#pragma unroll
                for (int bj = 0; bj < 2; ++bj) { const int c = col0 + bj * 128, l = c >> 11, e = c & 2047, isv = e >> 10, dc = e & 1023;
                    float* op = out + (isv ? OFF_MVP : OFF_MKP) + (size_t)l * 1048576 + (size_t)row * 1024 + dc;
                    *(f32x4*)op = acc[ai][bj][m][0]; *(f32x4*)(op + 4) = acc[ai][bj][m][1];
                    if (!isv) *(v4u*)(memk + (size_t)l * 12 * 262144 + (size_t)row * 1024 + dc) = pack8(acc[ai][bj][m][0], acc[ai][bj][m][1]); } }
    }
};
struct EpiIn0 {
    static constexpr bool PERM = true, AFTER_DRAIN = false;
    bf16* proj; const float* rowss; const float* ropec; const float* ropes; float* out;
    __device__ __forceinline__ void operator()(EPI_ARGS) const {
        const int pn = u.pn;
#pragma unroll
        for (int ai = 0; ai < 2; ++ai)
#pragma unroll
            for (int m = 0; m < 4; ++m) { const int row = u.pm * 256 + ai * 128 + wr * 64 + m * 16 + fr; const float rs = rstd_of(rowss, row);
                const int pos = row < MP ? (row & 4095) : 2048 + (row & 31);
                bf16* rp = proj + (size_t)row * 1280;
                float* wk = nullptr; float* wv = nullptr;
                if (pn == 4) { if (row >= MP) { wk = out + OFF_WKS + (size_t)(row - MP) * 128; wv = out + OFF_WVS + (size_t)(row - MP) * 128; }
                               else if ((row & 4095) >= 3968) { const size_t o = (size_t)((row >> 12) * 128 + (row & 4095) - 3968) * 128; wk = out + OFF_WKP + o; wv = out + OFF_WVP + o; } }
#pragma unroll
                for (int bj = 0; bj < 2; ++bj) { const f32x4 v0 = acc[ai][bj][m][0] * rs, v1 = acc[ai][bj][m][1] * rs;
                    const bool rope = (pn == 2 || pn == 3 || (pn == 4 && bj == 0));
                    if (!rope) { const int col = pn * 256 + bj * 128 + wc * 32 + 8 * fq; *(v4u*)(rp + col) = pack8(v0, v1);
                        if (pn == 4 && wv) { *(f32x4*)(wv + wc * 32 + 8 * fq) = v0; *(f32x4*)(wv + wc * 32 + 8 * fq + 4) = v1; } }
                    else { const int gbase = pn * 256 + bj * 128 + (wc >> 1) * 64, d1 = 16 * (wc & 1) + 4 * fq;
                        const f32x4 c4 = *(const f32x4*)(ropec + pos * 32 + d1), s4 = *(const f32x4*)(ropes + pos * 32 + d1);
                        f32x4 o1 = v0 * c4 - v1 * s4, o2 = v1 * c4 + v0 * s4;
                        if (pn != 4) { o1 = o1 * 0.125f; o2 = o2 * 0.125f; }
                        u32x2v w1, w2; w1.x = pg8::cvt_pk_bf16(o1[0], o1[1]); w1.y = pg8::cvt_pk_bf16(o1[2], o1[3]); w2.x = pg8::cvt_pk_bf16(o2[0], o2[1]); w2.y = pg8::cvt_pk_bf16(o2[2], o2[3]);
                        *(u32x2v*)(rp + gbase + d1) = w1; *(u32x2v*)(rp + gbase + d1 + 32) = w2;
                        if (pn == 4 && wk) { const int cc = (wc >> 1) * 64 + d1; *(f32x4*)(wk + cc) = o1; *(f32x4*)(wk + cc + 32) = o2; } } } }
    }
};
struct EpiFfnUp {
    static constexpr bool PERM = true, AFTER_DRAIN = false;
    bf16* act; const float* rowss; const float* cw; float* SG; float* SV;
    __device__ __forceinline__ void operator()(EPI_ARGS) const {
        const int c0 = u.pn * 128 + wc * 32 + 8 * fq; const bool sample = u.pm == 64;
        const f32x4 w0a = *(const f32x4*)(cw + c0), w0b = *(const f32x4*)(cw + c0 + 4), w1a = *(const f32x4*)(cw + DFF + c0), w1b = *(const f32x4*)(cw + DFF + c0 + 4),
                    w2a = *(const f32x4*)(cw + 2 * DFF + c0), w2b = *(const f32x4*)(cw + 2 * DFF + c0 + 4);
#pragma unroll
        for (int ai = 0; ai < 2; ++ai) { f32x4 gp0 = {0.f, 0.f, 0.f, 0.f}, gp1 = {0.f, 0.f, 0.f, 0.f}; const int blk = u.pm * 4 + ai * 2 + wr;
#pragma unroll
            for (int m = 0; m < 4; ++m) { const int row = u.pm * 256 + ai * 128 + wr * 64 + m * 16 + fr; const float rs = rstd_of(rowss, row);
                const f32x4 g0 = acc[ai][0][m][0] * rs, g1 = acc[ai][0][m][1] * rs, v0 = acc[ai][1][m][0] * rs, v1 = acc[ai][1][m][1] * rs;
                f32x4 a0, a1;
#pragma unroll
                for (int j = 0; j < 4; ++j) {
                    const float r1pa = dpp_ror1(gp0[j]), r1ca = dpp_ror1(g0[j]), r2pa = dpp_ror2(gp0[j]), r2ca = dpp_ror2(g0[j]);
                    const float r1pb = dpp_ror1(gp1[j]), r1cb = dpp_ror1(g1[j]), r2pb = dpp_ror2(gp1[j]), r2cb = dpp_ror2(g1[j]);
                    const float p1a = fr == 0 ? r1pa : r1ca, p2a = fr < 2 ? r2pa : r2ca;
                    const float p1b = fr == 0 ? r1pb : r1cb, p2b = fr < 2 ? r2pb : r2cb;
                    const float ca = w0a[j] * p2a + w1a[j] * p1a + w2a[j] * g0[j], cb = w0b[j] * p2b + w1b[j] * p1b + w2b[j] * g1[j];
                    a0[j] = ca * sigmoidf_(ca) * v0[j]; a1[j] = cb * sigmoidf_(cb) * v1[j]; }
                const bool valid = (m > 0 || fr >= 2) && !(sample && m == 2 && fr < 2);
                if (valid) *(v4u*)(act + (size_t)row * DFF + c0) = pack8(a0, a1);
                if ((m & 1) == 0 && fr < 2) { float* sg = SG + (size_t)(blk * 8 + 2 * m + fr) * DFF + c0; *(f32x4*)sg = g0; *(f32x4*)(sg + 4) = g1;
                                              float* sv = SV + (size_t)(blk * 4 + m + fr) * DFF + c0; *(f32x4*)sv = v0; *(f32x4*)(sv + 4) = v1; }
                if ((m & 1) == 1 && fr >= 14) { float* sg = SG + (size_t)(blk * 8 + 2 * m + fr - 14) * DFF + c0; *(f32x4*)sg = g0; *(f32x4*)(sg + 4) = g1; }
                gp0 = g0; gp1 = g1; } }
    }
};
struct EpiInOdd {
    static constexpr bool PERM = true, AFTER_DRAIN = false;
    bf16* gb; bf16* zc; const float* rowss; const float* cw; float* SG;
    __device__ __forceinline__ void operator()(EPI_ARGS) const {
        if (u.pn < 4) {
            const int row0 = u.pm * 256 + wr * 64 + fr, col0 = u.pn * 256 + wc * 32 + 8 * fq;
#pragma unroll
            for (int ai = 0; ai < 2; ++ai)
#pragma unroll
                for (int m = 0; m < 4; ++m) { const int row = row0 + ai * 128 + m * 16; const float rs = rstd_of(rowss, row); bf16* rp = gb + (size_t)row * 1024 + col0;
#pragma unroll
                    for (int bj = 0; bj < 2; ++bj) *(v4u*)(rp + bj * 128) = pack8(acc[ai][bj][m][0] * rs, acc[ai][bj][m][1] * rs); }
            return;
        }
        const int c0 = (u.pn - 4) * 128 + wc * 32 + 8 * fq; const bool sample = u.pm == 64;
        const f32x4 w0a = *(const f32x4*)(cw + c0), w0b = *(const f32x4*)(cw + c0 + 4), w1a = *(const f32x4*)(cw + 1024 + c0), w1b = *(const f32x4*)(cw + 1024 + c0 + 4),
                    w2a = *(const f32x4*)(cw + 2048 + c0), w2b = *(const f32x4*)(cw + 2048 + c0 + 4);
#pragma unroll
        for (int ai = 0; ai < 2; ++ai) { f32x4 gp0 = {0.f, 0.f, 0.f, 0.f}, gp1 = {0.f, 0.f, 0.f, 0.f}; const int blk = u.pm * 4 + ai * 2 + wr;
#pragma unroll
            for (int m = 0; m < 4; ++m) { const int row = u.pm * 256 + ai * 128 + wr * 64 + m * 16 + fr; const float rs = rstd_of(rowss, row); const float rs2 = rs * rs;
                const f32x4 g0 = acc[ai][0][m][0] * acc[ai][1][m][0] * rs2, g1 = acc[ai][0][m][1] * acc[ai][1][m][1] * rs2;
                f32x4 a0, a1;
#pragma unroll
                for (int j = 0; j < 4; ++j) {
                    const float r1pa = dpp_ror1(gp0[j]), r1ca = dpp_ror1(g0[j]), r2pa = dpp_ror2(gp0[j]), r2ca = dpp_ror2(g0[j]);
                    const float r1pb = dpp_ror1(gp1[j]), r1cb = dpp_ror1(g1[j]), r2pb = dpp_ror2(gp1[j]), r2cb = dpp_ror2(g1[j]);
                    const float p1a = fr == 0 ? r1pa : r1ca, p2a = fr < 2 ? r2pa : r2ca;
                    const float p1b = fr == 0 ? r1pb : r1cb, p2b = fr < 2 ? r2pb : r2cb;
                    a0[j] = w0a[j] * p2a + w1a[j] * p1a + w2a[j] * g0[j]; a1[j] = w0b[j] * p2b + w1b[j] * p1b + w2b[j] * g1[j]; }
                const bool valid = (m > 0 || fr >= 2) && !(sample && m == 2 && fr < 2);
                if (valid) *(v4u*)(zc + (size_t)row * 1024 + c0) = pack8(a0, a1);
                if ((m & 1) == 0 && fr < 2) { float* sg = SG + (size_t)(blk * 8 + 2 * m + fr) * 1024 + c0; *(f32x4*)sg = g0; *(f32x4*)(sg + 4) = g1; }
                if ((m & 1) == 1 && fr >= 14) { float* sg = SG + (size_t)(blk * 8 + 2 * m + fr - 14) * 1024 + c0; *(f32x4*)sg = g0; *(f32x4*)(sg + 4) = g1; }
                gp0 = g0; gp1 = g1; } }
    }
};

__device__ __forceinline__ int rowmap(int mode, int n) {
    if (mode == 1) { if (n >= 512 && n < 1152) { const int d = n & 63; return (n & ~63) | (32 * ((d >> 4) & 1) + 8 * ((d >> 2) & 3) + 4 * (d >> 5) + (d & 3)); } return n; }
    if (mode == 2) { return n < DFF ? ((n >> 7) * 256 + (n & 127)) : (((n - DFF) >> 7) * 256 + 128 + ((n - DFF) & 127)); }
    if (mode == 3) { if (n < 1024) return n; const int c = (n - 1024) & 1023, z = n >= 2048 ? 1 : 0; return 1024 + (c >> 7) * 256 + z * 128 + (c & 127); }
    return n;
}
__device__ __forceinline__ void tr_item(const float* W, int K, int N, bf16* WT, const float* gain, float scale, int mode, LAS float* scr, int item, int lane) {
    const int nblk = N / 32, kb = item / nblk, nb = item % nblk, k0 = 64 * kb, n0 = 32 * nb;
#pragma unroll
    for (int i = 0; i < 8; ++i) { const int idx = lane + 64 * i, kk = idx >> 3, n4 = (idx & 7) * 4; const float gs = gain ? gain[k0 + kk] * scale : scale;
        const f32x4 w = *(const f32x4*)(W + (size_t)(k0 + kk) * N + n0 + n4); LAS float* d = scr + kk * 33 + n4; d[0] = w[0] * gs; d[1] = w[1] * gs; d[2] = w[2] * gs; d[3] = w[3] * gs; }
    LDS_WAIT(); asm volatile("" ::: "memory");
    const int c = lane & 7;
#pragma unroll
    for (int j = 0; j < 4; ++j) { const int n = (lane >> 3) + 8 * j; const LAS float* s = scr + (8 * c) * 33 + n;
        v4u o; o.x = pg8::cvt_pk_bf16(s[0 * 33], s[1 * 33]); o.y = pg8::cvt_pk_bf16(s[2 * 33], s[3 * 33]); o.z = pg8::cvt_pk_bf16(s[4 * 33], s[5 * 33]); o.w = pg8::cvt_pk_bf16(s[6 * 33], s[7 * 33]);
        *(v4u*)(WT + (size_t)rowmap(mode, n0 + n) * K + k0 + 8 * c) = o; }
    LDS_WAIT(); asm volatile("" ::: "memory");
}
__device__ __forceinline__ double dexp_(double y) {
    const double k = rint(y * 1.4426950408889634); const double r = (y - k * 0.6931471803691238) - k * 1.9082149292705877e-10;
    double p = 1.0 / 6227020800.0;
    p = p * r + 1.0 / 479001600.0; p = p * r + 1.0 / 39916800.0; p = p * r + 1.0 / 3628800.0; p = p * r + 1.0 / 362880.0; p = p * r + 1.0 / 40320.0; p = p * r + 1.0 / 5040.0;
    p = p * r + 1.0 / 720.0; p = p * r + 1.0 / 120.0; p = p * r + 1.0 / 24.0; p = p * r + 1.0 / 6.0; p = p * r + 0.5; p = p * r + 1.0; p = p * r + 1.0;
    const long long bits = (long long)(1023 + (int)k) << 52; return p * __builtin_bit_cast(double, bits);
}
__device__ __forceinline__ void dsincos_(double x, double& s, double& c) {
    const double k = rint(x * 0.6366197723675814); const double r = (x - k * 1.5707963267948966) - k * 6.123233995736766e-17; const double r2 = r * r;
    const double sp = r * (1.0 + r2 * (-1.0 / 6.0 + r2 * (1.0 / 120.0 + r2 * (-1.0 / 5040.0 + r2 * (1.0 / 362880.0 + r2 * (-1.0 / 39916800.0 + r2 * (1.0 / 6227020800.0)))))));
    const double cp = 1.0 + r2 * (-0.5 + r2 * (1.0 / 24.0 + r2 * (-1.0 / 720.0 + r2 * (1.0 / 40320.0 + r2 * (-1.0 / 3628800.0 + r2 * (1.0 / 479001600.0 + r2 * (-1.0 / 87178291200.0)))))));
    const int q = ((int)k) & 3;
    s = q == 0 ? sp : q == 1 ? cp : q == 2 ? -sp : -cp; c = q == 0 ? cp : q == 1 ? -sp : q == 2 ? -cp : sp;
}

__device__ __forceinline__ const bf16* kvptr(const bf16* proj, const bf16* cb, int sample, int b, int c, int kvh, int kk, int isv) {
    if (!sample) { int pos = (c - 2) * 64 + kk; pos = pos < 0 ? 0 : pos; return proj + (size_t)(b * 4096 + pos) * 1280 + 1024 + isv * 128 + kvh * 64; }
    if (kk < 128) return cb + (size_t)(b * 128 + kk) * 128 + kvh * 64;
    int t = kk - 128; t = t > 31 ? 31 : t; return proj + (size_t)(MP + b * 32 + t) * 1280 + 1024 + isv * 128 + kvh * 64;
}
__device__ __forceinline__ void swa_phase(const bf16* proj, const bf16* ckb, const bf16* cvb, const float* sinks, bf16* ycat, LAS unsigned char* lds, int tid, int wave, int lane, int G) {
    LAS bf16* VT = (LAS bf16*)lds;
    const int fr = lane & 15, quad = lane >> 4;
    for (int it = blockIdx.x; it < 528; it += G) {
        int b, c, kvh, sample;
        if (it < 512) { sample = 0; b = it >> 7; c = (it >> 1) & 63; kvh = it & 1; } else { sample = 1; b = (it - 512) >> 1; c = 0; kvh = it & 1; }
        __syncthreads();
#pragma unroll
        for (int i = 0; i < 3; ++i) { const int idx = tid + 512 * i, kk = idx % 192, dg = idx / 192; const v4u w = *(const v4u*)(kvptr(proj, cvb, sample, b, c, kvh, kk, 1) + dg * 8);
            LAS bf16* vp = VT + (dg * 8) * 200 + kk;
            vp[0] = (bf16)(w.x & 0xffffu); vp[200] = (bf16)(w.x >> 16); vp[400] = (bf16)(w.y & 0xffffu); vp[600] = (bf16)(w.y >> 16);
            vp[800] = (bf16)(w.z & 0xffffu); vp[1000] = (bf16)(w.z >> 16); vp[1200] = (bf16)(w.w & 0xffffu); vp[1400] = (bf16)(w.w >> 16); }
        __syncthreads();
        const int gq = wave >> 1, qhalf = wave & 1, head = kvh * 4 + gq;
        if (!(sample && qhalf)) {
            const int plo = sample ? 0 : (c >= 2 ? 0 : (2 - c) * 2), phi = sample ? 5 : 6;
            bf16x8 qf[2][2];
#pragma unroll
            for (int qb = 0; qb < 2; ++qb) { const int q = qhalf * 32 + qb * 16 + fr; const int row = sample ? MP + b * 32 + (q & 31) : b * 4096 + c * 64 + q;
                const bf16* qp = proj + (size_t)row * 1280 + 512 + head * 64 + quad * 8; qf[qb][0] = *(const bf16x8*)qp; qf[qb][1] = *(const bf16x8*)(qp + 32); }
            f32x4 s[12][2];
#pragma unroll
            for (int kb = 0; kb < 12; ++kb) { const int key = 32 * (kb >> 1) + (fr >> 2) * 8 + 4 * (kb & 1) + (fr & 3); const bf16* kp = kvptr(proj, ckb, sample, b, c, kvh, key, 0) + quad * 8;
                const bf16x8 k0 = *(const bf16x8*)kp, k1 = *(const bf16x8*)(kp + 32);
#pragma unroll
                for (int qb = 0; qb < 2; ++qb) { f32x4 a = {0.f, 0.f, 0.f, 0.f}; a = MFMA16(k0, qf[qb][0], a); a = MFMA16(k1, qf[qb][1], a); s[kb][qb] = a; } }
            const float sink = sinks[head];
            bf16x8 pf[6][2];
#pragma unroll
            for (int qb = 0; qb < 2; ++qb) { float mx = sink;
#pragma unroll
                for (int kb = 0; kb < 12; ++kb) { const bool pv = (kb >> 1) >= plo && (kb >> 1) < phi;
#pragma unroll
                    for (int j = 0; j < 4; ++j) { const float v = pv ? s[kb][qb][j] : -1e30f; s[kb][qb][j] = v; mx = fmaxf(mx, v); } }
                mx = fmaxf(mx, __shfl_xor(mx, 16)); mx = fmaxf(mx, __shfl_xor(mx, 32));
                float sum = 0.f;
#pragma unroll
                for (int kb = 0; kb < 12; ++kb)
#pragma unroll
                    for (int j = 0; j < 4; ++j) { const float e = __expf(s[kb][qb][j] - mx); s[kb][qb][j] = e; sum += e; }
                sum += __shfl_xor(sum, 16); sum += __shfl_xor(sum, 32); sum += __expf(sink - mx);
                const float inv = 1.0f / sum;
#pragma unroll
                for (int pr = 0; pr < 6; ++pr) pf[pr][qb] = __builtin_bit_cast(bf16x8, pack8(s[2 * pr][qb] * inv, s[2 * pr + 1][qb] * inv)); }
#pragma unroll
            for (int db = 0; db < 4; ++db) { bf16x8 vf[6];
#pragma unroll
                for (int pr = 0; pr < 6; ++pr) vf[pr] = *(const LAS bf16x8*)(VT + (db * 16 + fr) * 200 + 32 * pr + quad * 8);
#pragma unroll
                for (int qb = 0; qb < 2; ++qb) { f32x4 o = {0.f, 0.f, 0.f, 0.f};
#pragma unroll
                    for (int pr = 0; pr < 6; ++pr) o = MFMA16(pf[pr][qb], vf[pr], o);
#pragma unroll
                    for (int j = 0; j < 4; ++j) { const int q = qhalf * 32 + qb * 16 + quad * 4 + j;
                        if (!sample || q < 32) { const int row = sample ? MP + b * 32 + q : b * 4096 + c * 64 + q; ycat[(size_t)row * 1024 + 512 + head * 64 + db * 16 + fr] = (bf16)f2bf(o[j]); } } } }
        }
    }
    __syncthreads();
}

__device__ __forceinline__ void xattn_phase(const bf16* qx, const bf16* memk_l, const bf16* memvT_l, bf16* ox, int wave, int lane, int G) {
    const int fr = lane & 15, quad = lane >> 4;
    for (int t = wave * G + (int)blockIdx.x; t < 4160; t += 8 * G) {
        int bb, h, row0;
        if (t < 4096) { const int pair = t >> 8; bb = pair >> 2; h = pair & 3; row0 = bb * 4096 + (t & 255) * 16; }
        else { const int s = t - 4096, b = s >> 3; h = (s >> 1) & 3; bb = 4 + b; row0 = MP + b * 32 + (s & 1) * 16; }
        bf16x8 qf[8];
#pragma unroll
        for (int ks = 0; ks < 8; ++ks) qf[ks] = *(const bf16x8*)(qx + (size_t)(row0 + fr) * 1024 + h * 256 + ks * 32 + quad * 8);
        const bf16* kbase = memk_l + (size_t)bb * 262144 + h * 256 + quad * 8;
        f32x4 s[16];
#pragma unroll
        for (int kb = 0; kb < 16; ++kb) { const int key = 32 * (kb >> 1) + (fr >> 2) * 8 + 4 * (kb & 1) + (fr & 3); const bf16* kp = kbase + (size_t)key * 1024; f32x4 a = {0.f, 0.f, 0.f, 0.f};
#pragma unroll
            for (int ks = 0; ks < 8; ++ks) a = MFMA16(*(const bf16x8*)(kp + ks * 32), qf[ks], a);
            s[kb] = a; }
        float mx = -1e30f;
#pragma unroll
        for (int kb = 0; kb < 16; ++kb)
#pragma unroll
            for (int j = 0; j < 4; ++j) mx = fmaxf(mx, s[kb][j]);
        mx = fmaxf(mx, __shfl_xor(mx, 16)); mx = fmaxf(mx, __shfl_xor(mx, 32));
        float sum = 0.f;
#pragma unroll
        for (int kb = 0; kb < 16; ++kb)
#pragma unroll
            for (int j = 0; j < 4; ++j) { const float e = __expf(s[kb][j] - mx); s[kb][j] = e; sum += e; }
        sum += __shfl_xor(sum, 16); sum += __shfl_xor(sum, 32);
        const float inv = 1.0f / sum;
        bf16x8 pf[8];
#pragma unroll
        for (int pr = 0; pr < 8; ++pr) pf[pr] = __builtin_bit_cast(bf16x8, pack8(s[2 * pr] * inv, s[2 * pr + 1] * inv));
        const bf16* vbase = memvT_l + (size_t)bb * 262144 + (size_t)(h * 256 + fr) * 256 + quad * 8;
#pragma unroll 4
        for (int db = 0; db < 16; ++db) { f32x4 o = {0.f, 0.f, 0.f, 0.f};
#pragma unroll
            for (int pr = 0; pr < 8; ++pr) o = MFMA16(pf[pr], *(const bf16x8*)(vbase + (size_t)db * 4096 + pr * 32), o);
#pragma unroll
            for (int j = 0; j < 4; ++j) ox[(size_t)(row0 + quad * 4 + j) * 1024 + h * 256 + db * 16 + fr] = (bf16)f2bf(o[j]); }
    }
}


__device__ __forceinline__ void xstage(const bf16* src, size_t rowstride, LAS unsigned char* lds, int tid) {
    v4u t[16];
#pragma unroll
    for (int i = 0; i < 16; ++i) { const int row = (tid >> 5) + 16 * i, ch = tid & 31; t[i] = *(const GAS v4u*)((const GAS bf16*)src + (size_t)row * rowstride + ch * 8); }
#pragma unroll
    for (int i = 0; i < 16; ++i) { const int row = (tid >> 5) + 16 * i, ch = tid & 31; *(LAS v4u*)(lds + row * 528 + ch * 16) = t[i]; }
}
__device__ __forceinline__ void xattn_phase2(const bf16* qx, const bf16* memk_l, const bf16* memvT_l, bf16* ox, LAS unsigned char* lds, int tid, int wave, int lane, int G) {
    const int fr = lane & 15, quad = lane >> 4;
    for (int it = blockIdx.x; it < 256 + 32; it += G) {
        int bb, h, rowbase, nqb; bool active;
        if (it < 256) { bb = it >> 6; h = (it >> 4) & 3; rowbase = bb * 4096 + (it & 15) * 256; nqb = 2; active = true; }
        else { const int s = it - 256, b = s >> 2; h = s & 3; bb = 4 + b; rowbase = MP + b * 32; nqb = 1; active = wave < 2; }
        __syncthreads();
        xstage(memk_l + (size_t)bb * 262144 + h * 256, 1024, lds, tid);
        __syncthreads();
        bf16x8 pf[2][8];
#pragma unroll
        for (int qi = 0; qi < 2; ++qi) {
            if (qi < nqb && active) {
                const int row0 = rowbase + qi * 128 + wave * 16;
                bf16x8 qf[8];
#pragma unroll
                for (int ks = 0; ks < 8; ++ks) qf[ks] = *(const GAS bf16x8*)((const GAS bf16*)qx + (size_t)(row0 + fr) * 1024 + h * 256 + ks * 32 + quad * 8);
                f32x4 s[16];
#pragma unroll
                for (int kb = 0; kb < 16; ++kb) { const int key = 32 * (kb >> 1) + (fr >> 2) * 8 + 4 * (kb & 1) + (fr & 3); const LAS unsigned char* kp = lds + key * 528 + quad * 16; f32x4 a = {0.f, 0.f, 0.f, 0.f};
#pragma unroll
                    for (int ks = 0; ks < 8; ++ks) a = MFMA16(*(const LAS bf16x8*)(kp + ks * 64), qf[ks], a);
                    s[kb] = a; }
                float mx = -1e30f;
#pragma unroll
                for (int kb = 0; kb < 16; ++kb)
#pragma unroll
                    for (int j = 0; j < 4; ++j) mx = fmaxf(mx, s[kb][j]);
                mx = fmaxf(mx, __shfl_xor(mx, 16)); mx = fmaxf(mx, __shfl_xor(mx, 32));
                float sum = 0.f;
#pragma unroll
                for (int kb = 0; kb < 16; ++kb)
#pragma unroll
                    for (int j = 0; j < 4; ++j) { const float e = __expf(s[kb][j] - mx); s[kb][j] = e; sum += e; }
                sum += __shfl_xor(sum, 16); sum += __shfl_xor(sum, 32);
                const float inv = 1.0f / sum;
#pragma unroll
                for (int pr = 0; pr < 8; ++pr) pf[qi][pr] = __builtin_bit_cast(bf16x8, pack8(s[2 * pr] * inv, s[2 * pr + 1] * inv));
            }
        }
        __syncthreads();
        xstage(memvT_l + (size_t)bb * 262144 + (size_t)h * 65536, 256, lds, tid);
        __syncthreads();
#pragma unroll
        for (int qi = 0; qi < 2; ++qi) {
            if (qi < nqb && active) {
                const int row0 = rowbase + qi * 128 + wave * 16;
#pragma unroll 4
                for (int db = 0; db < 16; ++db) { f32x4 o = {0.f, 0.f, 0.f, 0.f}; const LAS unsigned char* vp = lds + (db * 16 + fr) * 528 + quad * 16;
#pragma unroll
                    for (int pr = 0; pr < 8; ++pr) o = MFMA16(*(const LAS bf16x8*)(vp + pr * 64), pf[qi][pr], o);
                    u32x2v w; w.x = pk2(o[0], o[1]); w.y = pk2(o[2], o[3]);
                    *(GAS u32x2v*)((GAS bf16*)ox + (size_t)(row0 + fr) * 1024 + h * 256 + db * 16 + quad * 4) = w; }
            }
        }
    }
    __syncthreads();
}

__device__ __forceinline__ void s5_stage_u(const bf16* up, LAS float* ubuf, int lane) {
    const v4u w0 = *(const v4u*)up, w1 = *(const v4u*)(up + 8);
    LAS f32x4* d = (LAS f32x4*)(ubuf + lane * 16);
    d[0] = (f32x4){bflo(w0.x), bfhi(w0.x), bflo(w0.y), bfhi(w0.y)}; d[1] = (f32x4){bflo(w0.z), bfhi(w0.z), bflo(w0.w), bfhi(w0.w)};
    d[2] = (f32x4){bflo(w1.x), bfhi(w1.x), bflo(w1.y), bfhi(w1.y)}; d[3] = (f32x4){bflo(w1.z), bfhi(w1.z), bflo(w1.w), bfhi(w1.w)};
}
__device__ __forceinline__ f32x2v lo2_(f32x4 v) { return __builtin_shufflevector(v, v, 0, 1); }
__device__ __forceinline__ f32x2v hi2_(f32x4 v) { return __builtin_shufflevector(v, v, 2, 3); }
#define S5_STEP(sidx) do { const LAS f32x4* up_ = (const LAS f32x4*)(ubuf + (sidx) * 16); const f32x4 u0 = up_[0], u1 = up_[1], u2 = up_[2], u3 = up_[3]; \
    f32x2v ac_ = lo2_(bb[0]) * u0[0]; ac_ = hi2_(bb[0]) * u0[1] + ac_; ac_ = lo2_(bb[1]) * u0[2] + ac_; ac_ = hi2_(bb[1]) * u0[3] + ac_; \
    ac_ = lo2_(bb[2]) * u1[0] + ac_; ac_ = hi2_(bb[2]) * u1[1] + ac_; ac_ = lo2_(bb[3]) * u1[2] + ac_; ac_ = hi2_(bb[3]) * u1[3] + ac_; \
    ac_ = lo2_(bb[4]) * u2[0] + ac_; ac_ = hi2_(bb[4]) * u2[1] + ac_; ac_ = lo2_(bb[5]) * u2[2] + ac_; ac_ = hi2_(bb[5]) * u2[3] + ac_; \
    ac_ = lo2_(bb[6]) * u3[0] + ac_; ac_ = hi2_(bb[6]) * u3[1] + ac_; ac_ = lo2_(bb[7]) * u3[2] + ac_; ac_ = hi2_(bb[7]) * u3[3] + ac_; \
    const float nr_ = ar * hr - ai * hi + ac_.x, ni_ = ar * hi + ai * hr + ac_.y; hr = nr_; hi = ni_; } while (0)

typedef short bf16x4_t __attribute__((ext_vector_type(4)));
#define MFMA16K16(a, b, c) __builtin_amdgcn_mfma_f32_16x16x16bf16_1k(a, b, c, 0, 0, 0)
__device__ __forceinline__ void s5_bu_block(const bf16* urow0, const bf16x4_t (&bcf)[8], LAS float* bul, int fr, int quad) {
    const bf16x4_t a = *(const bf16x4_t*)(urow0 + (size_t)fr * 1280 + quad * 4);
#pragma unroll
    for (int cb = 0; cb < 8; ++cb) { f32x4 d = {0.f, 0.f, 0.f, 0.f}; d = MFMA16K16(a, bcf[cb], d);
#pragma unroll
        for (int j = 0; j < 4; ++j) bul[(quad * 4 + j) * 130 + cb * 16 + fr] = d[j]; }
}
__device__ __forceinline__ void s5_local(const bf16* proj, const float* abar, const bf16* bbt, float* sloc, LAS float* bul, int slot, int nslots, int lane) {
    const int fr = lane & 15, quad = lane >> 4;
    for (int t = slot; t < 8192; t += nslots) {
        const int chunk = t & 63, g = (t >> 6) & 31, b = t >> 11;
        const float ar = abar[(g * 64 + lane) * 2], ai = abar[(g * 64 + lane) * 2 + 1];
        bf16x4_t bcf[8];
#pragma unroll
        for (int cb = 0; cb < 8; ++cb) bcf[cb] = *(const bf16x4_t*)(bbt + (size_t)(g * 128 + cb * 16 + fr) * 16 + quad * 4);
        float hr = 0.f, hi = 0.f;
        for (int blk = 0; blk < 4; ++blk) {
            s5_bu_block(proj + (size_t)(b * 4096 + chunk * 64 + blk * 16) * 1280 + g * 16, bcf, bul, fr, quad);
#pragma unroll 4
            for (int s = 0; s < 16; ++s) { const f32x2v bu = *(const LAS f32x2v*)(bul + s * 130 + 2 * lane); const float nr = ar * hr - ai * hi + bu.x, ni = ar * hi + ai * hr + bu.y; hr = nr; hi = ni; }
        }
        *(f32x2v*)(sloc + (size_t)t * 128 + lane * 2) = (f32x2v){hr, hi};
    }
}
__device__ __forceinline__ void s5_out(const bf16* proj, const float* abar, const bf16* bbt, const float* sloc, const float* st_re, const float* st_im, const float* c_re, const float* c_im,
                                       const float* dcoef, bf16* gbuf, float* out, LAS float* bul, LAS unsigned* hbuf, int slot, int nslots, int lane) {
    const int fr = lane & 15, quad = lane >> 4;
    for (int t = slot; t < 8192 + 256; t += nslots) {
        const int sample = t >= 8192; int b, g, chunk, nblk, rowbase;
        if (!sample) { chunk = t & 63; g = (t >> 6) & 31; b = t >> 11; nblk = 4; rowbase = b * 4096 + chunk * 64; } else { const int s = t - 8192; g = s & 31; b = s >> 5; chunk = 0; nblk = 2; rowbase = MP + b * 32; }
        const float ar = abar[(g * 64 + lane) * 2], ai = abar[(g * 64 + lane) * 2 + 1];
        bf16x4_t bcf[8];
#pragma unroll
        for (int cb = 0; cb < 8; ++cb) bcf[cb] = *(const bf16x4_t*)(bbt + (size_t)(g * 128 + cb * 16 + fr) * 16 + quad * 4);
        float hr, hi;
        if (!sample) { float pr = ar, pi = ai;
#pragma unroll
            for (int i = 0; i < 6; ++i) { const float t1 = pr * pr - pi * pi; pi = 2.f * pr * pi; pr = t1; }
            hr = 0.f; hi = 0.f; const float* sp = sloc + (size_t)(t - chunk) * 128 + lane * 2;
#pragma unroll 16
            for (int cc = 0; cc < chunk; ++cc) { const f32x2v sv = *(const f32x2v*)(sp + (size_t)cc * 128); const float nr = pr * hr - pi * hi + sv.x, ni = pr * hi + pi * hr + sv.y; hr = nr; hi = ni; } }
        else { hr = st_re[(b * 32 + g) * 64 + lane]; hi = st_im[(b * 32 + g) * 64 + lane]; }
        bf16x8 cf[4];
#pragma unroll
        for (int ks = 0; ks < 4; ++ks) { const f32x4 cr = *(const f32x4*)(c_re + (size_t)(g * 16 + fr) * 64 + ks * 16 + quad * 4), ci = *(const f32x4*)(c_im + (size_t)(g * 16 + fr) * 64 + ks * 16 + quad * 4);
            v4u w; w.x = pg8::cvt_pk_bf16(cr[0], -ci[0]); w.y = pg8::cvt_pk_bf16(cr[1], -ci[1]); w.z = pg8::cvt_pk_bf16(cr[2], -ci[2]); w.w = pg8::cvt_pk_bf16(cr[3], -ci[3]); cf[ks] = __builtin_bit_cast(bf16x8, w); }
        const float dco = dcoef[g * 16 + fr];
        for (int blk = 0; blk < nblk; ++blk) {
            const bf16* urow0 = proj + (size_t)(rowbase + blk * 16) * 1280 + g * 16;
            s5_bu_block(urow0, bcf, bul, fr, quad);
#pragma unroll 4
            for (int s = 0; s < 16; ++s) { const f32x2v bu = *(const LAS f32x2v*)(bul + s * 130 + 2 * lane); const float nr = ar * hr - ai * hi + bu.x, ni = ar * hi + ai * hr + bu.y; hr = nr; hi = ni; hbuf[s * 68 + lane] = pg8::cvt_pk_bf16(hr, hi); }
            f32x4 y = {0.f, 0.f, 0.f, 0.f};
#pragma unroll
            for (int ks = 0; ks < 4; ++ks) { const bf16x8 a = *(const LAS bf16x8*)(hbuf + fr * 68 + ks * 16 + quad * 4); y = MFMA16(a, cf[ks], y); }
#pragma unroll
            for (int j = 0; j < 4; ++j) { const int s = blk * 16 + quad * 4 + j; const float uu = bflo((unsigned)urow0[(size_t)(quad * 4 + j) * 1280 + fr]); const float yv = y[j] + dco * uu;
                const float z = 0.7978845608028654f * (yv + 0.044715f * yv * yv * yv); const float th = 1.0f - 2.0f / (1.0f + __expf(2.0f * z)); const float gl = 0.5f * yv * (1.0f + th);
                gbuf[(size_t)(rowbase + s) * 512 + g * 16 + fr] = (bf16)f2bf(gl); }
        }
        if (!sample && chunk == 63) { out[OFF_SRP + (b * 32 + g) * 64 + lane] = hr; out[OFF_SIP + (b * 32 + g) * 64 + lane] = hi; }
        if (sample) { out[OFF_SRS + (b * 32 + g) * 64 + lane] = hr; out[OFF_SIS + (b * 32 + g) * 64 + lane] = hi; }
    }
}

template <int KIND>
__device__ __forceinline__ void sample_gemm(const bf16* A, const bf16* Bt, int K, LAS unsigned char* lds, int tid, int wave, int lane,
                                            bf16* xbp, const float* base_f32, float* part_next, const float* part_cur, bf16* O) {
    const int fr = lane & 15, quad = lane >> 4;
    LAS f32x4* red = (LAS f32x4*)lds;
    LAS float* ssred = (LAS float*)(lds + 32768);
    for (int tile = blockIdx.x; tile < 256; tile += gridDim.x) {
        const int r0 = MP + (tile >> 4) * 16, c0 = (tile & 15) * 64, kw = K >> 3;
        const bf16* ap = A + (size_t)(r0 + fr) * K + wave * kw + quad * 8;
        const bf16* bp = Bt + (size_t)(c0 + fr) * K + wave * kw + quad * 8;
        f32x4 acc[4];
#pragma unroll
        for (int cb = 0; cb < 4; ++cb) acc[cb] = (f32x4){0.f, 0.f, 0.f, 0.f};
        const int nks = kw >> 5;
        for (int k0 = 0; k0 < nks; k0 += 4) {
            bf16x8 a[4], b[4][4];
#pragma unroll
            for (int i = 0; i < 4; ++i) { const int ks = (k0 + i < nks) ? k0 + i : nks - 1;
                a[i] = *(const bf16x8*)(ap + ks * 32);
#pragma unroll
                for (int cb = 0; cb < 4; ++cb) b[i][cb] = *(const bf16x8*)(bp + (size_t)cb * 16 * K + ks * 32); }
            __builtin_amdgcn_sched_barrier(0);
#pragma unroll
            for (int i = 0; i < 4; ++i) if (k0 + i < nks) {
#pragma unroll
                for (int cb = 0; cb < 4; ++cb) acc[cb] = MFMA16(b[i][cb], a[i], acc[cb]); }
        }
#pragma unroll
        for (int cb = 0; cb < 4; ++cb) red[(wave * 4 + cb) * 64 + lane] = acc[cb] * 1.0f;
        __syncthreads();
        if (tid < 256) { const int cb = tid >> 6, l2 = tid & 63; f32x4 v = red[cb * 64 + l2];
#pragma unroll
            for (int w = 1; w < 8; ++w) v = v + red[(w * 4 + cb) * 64 + l2];
            const int row = r0 + (l2 & 15), col = c0 + cb * 16 + 4 * (l2 >> 4); const size_t off = (size_t)row * 1024 + col;
            if (KIND == 0) { f32x4 bs;
                if (base_f32) bs = *(const f32x4*)(base_f32 + off);
                else { const u32x2v w = *(const u32x2v*)(xbp + off); bs = (f32x4){bflo(w.x), bfhi(w.x), bflo(w.y), bfhi(w.y)}; }
                v = v + bs; u32x2v o; o.x = pk2(v[0], v[1]); o.y = pk2(v[2], v[3]); *(u32x2v*)(xbp + off) = o;
                float ss = (v[0] * v[0] + v[1] * v[1]) + (v[2] * v[2] + v[3] * v[3]); ss += __shfl_xor(ss, 16); ss += __shfl_xor(ss, 32);
                if ((l2 >> 4) == 0) ssred[cb * 16 + (l2 & 15)] = ss; }
            else { const float rs = rstd_of(part_cur, row); u32x2v o; o.x = pk2(v[0] * rs, v[1] * rs); o.y = pk2(v[2] * rs, v[3] * rs); *(u32x2v*)(O + off) = o; }
        }
        if (KIND == 0) { __syncthreads(); if (tid < 16) part_next[(size_t)(r0 + tid) * 16 + (tile & 15)] = (ssred[tid] + ssred[16 + tid]) + (ssred[32 + tid] + ssred[48 + tid]); }
        __syncthreads();
    }
}

struct Params { const float* in[36]; float* out; unsigned char* ws; int use_cg, pad; };

__global__ void __launch_bounds__(512, 2) mega_fwd(Params P) {
    extern __shared__ __attribute__((aligned(16))) unsigned char lds_raw[];
    LAS unsigned char* lds = (LAS unsigned char*)lds_raw;
    volatile LAS unsigned* MISC = (volatile LAS unsigned*)(lds + MISC_OFF);
    const int G = gridDim.x, NGW = G * 8, NT = G * 512;
    const int wave_s = __builtin_amdgcn_readfirstlane(threadIdx.x >> 6);
    for (int u = threadIdx.x; u < (LDS_BYTES - 131072) / 4; u += 512) ((LAS unsigned*)(lds + 131072))[u] = 0u;
    __syncthreads();
    XcdBarrier bar = xcd_barrier_post((unsigned*)(P.ws + WS_BAR), MISC + 8);
#ifndef STOP_AFTER
#define STOP_AFTER 1000
#endif
    int ph = 0;
#define RUN (ph < STOP_AFTER)
#define FRESH() const int tid = fresh_tid(wave_s), lane = tid & 63, wave = __builtin_amdgcn_readfirstlane(tid >> 6); const int gw = blockIdx.x * 8 + wave, gt = blockIdx.x * 512 + tid; (void)gw; (void)gt; (void)lane; LAS float* wscr = (LAS float*)(lds + 32768 + wave * 12288); (void)wscr;
#define SEAM() do { if (P.use_cg) cg::this_grid().sync(); else xcd_barrier(bar); ++ph; } while (0)

#define part ((float*)(ws + WS_PART))
#define PARTBUF(k) (part + (size_t)((k) & 1) * PART_ELEMS)
#define ropec ((float*)(ws + WS_ROPE))
#define ropes (ropec + 4096 * 32)
#define abar ((float*)(ws + WS_SSM))
#define bbar (abar + 32 * 64 * 2)
#define bbt ((bf16*)(bbar + 32 * 64 * 32))
#define ckb ((bf16*)(ws + WS_CKV))
#define cvb (ckb + 8 * 128 * 128)
#define sloc ((float*)(ws + WS_SLOC))
#define memk ((bf16*)(ws + WS_MEMK))
#define memvT ((bf16*)(ws + WS_MEMVT))
#define SG ((float*)(ws + WS_SIDE))
#define SV ((float*)(ws + WS_SIDE + SG_BYTES))
#define WT ((bf16*)(ws + WS_WT))
#define xb ((bf16*)(ws + WS_XB))
#define tmp (ws + WS_TMP)
#define proj0 ((bf16*)(tmp + TMP_PROJ0))
#define gbuf ((bf16*)(tmp + TMP_GBUF))
#define ycat ((bf16*)(tmp + TMP_YCAT))
#define memb ((bf16*)(tmp + TMP_MEMB))
#define qx ((bf16*)(tmp + TMP_QX))
#define ox ((bf16*)(tmp + TMP_OX))
#define act ((bf16*)(tmp + TMP_ACT))
#define gbm ((bf16*)(tmp + TMP_GB))
#define zc ((bf16*)(tmp + TMP_ZC))
#define PTRS() unsigned char* ws = P.ws; float* out = P.out; asm volatile("" : "+s"(ws), "+s"(out));
    if (RUN) { PTRS() FRESH()
        {
            constexpr int NITEMS = 640 + 128 + 512 + 2 * 512 + 2 * 1024 + 2 * 512 + 2 * 2816 + 2 * 1408 + 1536 + 512 + 2048;
            for (int it = gw; it < NITEMS; it += NGW) { int r = it;
#define TR(Wp, K_, N_, WTp, gainp, sc, mode) { const int ni_ = ((K_) / 64) * ((N_) / 32); if (r < ni_) { tr_item(Wp, K_, N_, WTp, gainp, sc, mode, wscr, r, lane); continue; } r -= ni_; }
                TR(P.in[15], 1024, 1280, WT + WT_INEVEN, P.in[11], 1.f, 1)
                TR(P.in[25], 512, 512, WT + WT_GLU, nullptr, 1.f, 0)
                TR(P.in[16], 1024, 1024, WT + WT_OUTEVEN, nullptr, 1.f, 0)
                TR(P.in[30], 1024, 1024, WT + WT_WQ, P.in[12], 0.0625f, 0)
                TR(P.in[30] + 1048576, 1024, 1024, WT + WT_WQ + 1048576, P.in[12] + 1024, 0.0625f, 0)
                TR(P.in[31], 1024, 2048, WT + WT_WKV, nullptr, 1.f, 0)
                TR(P.in[31] + 2097152, 1024, 2048, WT + WT_WKV + 2097152, nullptr, 1.f, 0)
                TR(P.in[32], 1024, 1024, WT + WT_WO, nullptr, 1.f, 0)
                TR(P.in[32] + 1048576, 1024, 1024, WT + WT_WO + 1048576, nullptr, 1.f, 0)
                TR(P.in[33], 1024, 5632, WT + WT_UP, P.in[13], 1.f, 2)
                TR(P.in[33] + (size_t)1024 * 5632, 1024, 5632, WT + WT_UP + (size_t)5632 * 1024, P.in[13] + 1024, 1.f, 2)
                TR(P.in[35], 2816, 1024, WT + WT_DOWN, nullptr, 1.f, 0)
                TR(P.in[35] + (size_t)2816 * 1024, 2816, 1024, WT + WT_DOWN + (size_t)2816 * 1024, nullptr, 1.f, 0)
                TR(P.in[27], 1024, 3072, WT + WT_INODD, P.in[11] + 1024, 1.f, 3)
                TR(P.in[29], 1024, 1024, WT + WT_OUTODD, nullptr, 1.f, 0)
                { const int mi = r >> 7, l = mi >> 3, b = mi & 7; tr_item(P.in[10] + (size_t)mi * 262144, 256, 1024, memvT + (size_t)(l * 12 + 4 + b) * 262144, nullptr, 1.f, 0, wscr, r & 127, lane); }
            }
        }
        for (int m = gw; m < MROWS; m += NGW) { const float* xr = m < MP ? P.in[0] + (size_t)m * 1024 : P.in[1] + (size_t)(m - MP) * 1024; float ss = 0.f;
#pragma unroll
            for (int j = 0; j < 4; ++j) { const f32x4 v = *(const f32x4*)(xr + (lane + 64 * j) * 4); ss += (v[0] * v[0] + v[1] * v[1]) + (v[2] * v[2] + v[3] * v[3]);
                u32x2v w; w.x = pg8::cvt_pk_bf16(v[0], v[1]); w.y = pg8::cvt_pk_bf16(v[2], v[3]); *(u32x2v*)(xb + (size_t)m * 1024 + (lane + 64 * j) * 4) = w; }
            ss = wave_sum(ss); if (lane < 16) PARTBUF(0)[(size_t)m * 16 + lane] = lane == 0 ? ss : 0.f; }
        for (int i = gt; i < 262144; i += NT) { const f32x4 v = *(const f32x4*)(P.in[2] + (size_t)i * 4); u32x2v w; w.x = pg8::cvt_pk_bf16(v[0], v[1]); w.y = pg8::cvt_pk_bf16(v[2], v[3]); *(u32x2v*)(memb + (size_t)i * 4) = w; }
        for (int i = gt; i < 1048576; i += NT) { const size_t e = (size_t)i * 4; const int lb = (int)(e >> 18), l = lb >> 3, b = lb & 7; const f32x4 v = *(const f32x4*)(P.in[9] + e);
            u32x2v w; w.x = pg8::cvt_pk_bf16(v[0], v[1]); w.y = pg8::cvt_pk_bf16(v[2], v[3]); *(u32x2v*)(memk + (size_t)(l * 12 + 4 + b) * 262144 + (e & 262143)) = w; }
        for (int i = gt; i < 65536; i += NT) { const int j = i & 32767; const float* src = (i < 32768 ? P.in[3] : P.in[4]) + (size_t)j * 4; bf16* dst = (i < 32768 ? ckb : cvb) + (size_t)j * 4;
            const f32x4 v = *(const f32x4*)src; u32x2v w; w.x = pg8::cvt_pk_bf16(v[0], v[1]); w.y = pg8::cvt_pk_bf16(v[2], v[3]); *(u32x2v*)dst = w; }
        for (int i = gt; i < 4096 * 32; i += NT) { const int pos = i >> 5, d = i & 31; const double inv = dexp_(-(double)d * (9.210340371976184 / 32.0)); double s, c; dsincos_((double)pos * inv, s, c); ropec[i] = (float)c; ropes[i] = (float)s; }
        for (int i = gt; i < 2048; i += NT) { const double are = P.in[17][i], aim = P.in[18][i], dt = dexp_((double)P.in[19][i]); double s, c; dsincos_(aim * dt, s, c); const double mag = dexp_(are * dt);
            const double br = mag * c, bi = mag * s; abar[2 * i] = (float)br; abar[2 * i + 1] = (float)bi;
            const double nr = br - 1.0, ni = bi, den = are * are + aim * aim; const double qr = (nr * are + ni * aim) / den, qi = (ni * are - nr * aim) / den;
#pragma unroll 4
            for (int h = 0; h < 16; ++h) { const double xr = P.in[20][(size_t)i * 16 + h], xi = P.in[21][(size_t)i * 16 + h]; const float fre = (float)(qr * xr - qi * xi), fim = (float)(qr * xi + qi * xr); bbar[(size_t)i * 32 + 2 * h] = fre; bbar[(size_t)i * 32 + 2 * h + 1] = fim;
                bbt[((size_t)i * 2) * 16 + h] = (bf16)f2bf(fre); bbt[((size_t)i * 2 + 1) * 16 + h] = (bf16)f2bf(fim); } }
    }
    SEAM();
    if (RUN) { PTRS()
        if (G < 128 || (int)blockIdx.x >= G - 64) { pg8::Gemm g{memb, WT + WT_WKV, 1024, 4096, 1024}; pg8::StaticOrder S;
            if (G < 128) S.init(1024, 4096, G, (int)blockIdx.x); else S.init(1024, 4096, 64, (int)blockIdx.x - (G - 64)); EpiKV E{out, memk};
          pg8::gemm_phase<EpiKV, pg8::StaticOrder, true, true>(lds, g, S, E, wave_s); }
        { pg8::Gemm g{xb, WT + WT_INEVEN, MROWS, 1280, 1024}; pg8::StaticOrderF S; S.init(MROWS, 1280, G, (int)blockIdx.x); EpiIn0 E{proj0, PARTBUF(0), ropec, ropes, out};
          pg8::gemm_phase<EpiIn0, pg8::StaticOrderF, true, true>(lds, g, S, E, wave_s); }
    }
    SEAM();
    if (RUN) { PTRS() FRESH()
        swa_phase(proj0, ckb, cvb, P.in[26], ycat, lds, tid, wave, lane, G);
        s5_local(proj0, abar, bbt, sloc, wscr, wave * G + (int)blockIdx.x, NGW, lane);
        for (int it = wave * G + (int)blockIdx.x; it < 1024; it += NGW) { const int mi = it >> 7, l = mi >> 2, b = mi & 3;
            tr_item(out + OFF_MVP + (size_t)mi * 262144, 256, 1024, memvT + (size_t)(l * 12 + b) * 262144, nullptr, 1.f, 0, wscr, it & 127, lane); }
    }
    SEAM();
    if (RUN) { PTRS() FRESH() s5_out(proj0, abar, bbt, sloc, P.in[5], P.in[6], P.in[22], P.in[23], P.in[24], gbuf, out, (LAS float*)(lds + wave * 16384), (LAS unsigned*)(lds + wave * 16384 + 8448), wave * G + (int)blockIdx.x, NGW, lane); }
    SEAM();
    if (RUN) { PTRS() pg8::Gemm g{gbuf, WT + WT_GLU, MROWS, 512, 512}; pg8::StaticOrder S; S.init(MROWS, 512, G, (int)blockIdx.x); EpiGlu E{gbuf, ycat};
        pg8::gemm_phase<EpiGlu, pg8::StaticOrder, true, true>(lds, g, S, E, wave_s); }
    SEAM();

#pragma unroll
    for (int l = 0; l < 2; ++l) {
        if (l == 1) {
            if (RUN) { PTRS() pg8::Gemm g{xb, WT + WT_INODD, MROWS, 3072, 1024}; pg8::StaticOrderF S; S.init(MROWS, 3072, G, (int)blockIdx.x); EpiInOdd E{gbm, zc, PARTBUF(3), P.in[28], SG};
                pg8::gemm_phase<EpiInOdd, pg8::StaticOrderF, true, true>(lds, g, S, E, wave_s); }
            SEAM();
            if (RUN) { PTRS() FRESH()
                const float* cw = P.in[28]; const float* st = P.in[7];
                for (int i = gt; i < MROWS * 128; i += NT) { const int row = i >> 7, c0 = (i & 127) * 8, blk = row >> 6, r = row & 63;
                    const bool smp = row >= MP; const int rr = smp ? (r & 31) : r;
                    f32x4 z0, z1;
                    if (rr < 2) { const int sb = smp ? (r >> 5) * 4 : 0;
                        f32x4 pa0, pa1, pb0, pb1;
                        if (smp) { const int b = (blk - 256) * 2 + (r >> 5); const float* s0 = st + (size_t)(b * 2) * 1024 + c0; pa0 = *(const f32x4*)s0; pa1 = *(const f32x4*)(s0 + 4); pb0 = *(const f32x4*)(s0 + 1024); pb1 = *(const f32x4*)(s0 + 1028); }
                        else if ((blk & 63) == 0) { pa0 = pa1 = pb0 = pb1 = (f32x4){0.f, 0.f, 0.f, 0.f}; }
                        else { const float* s0 = SG + (size_t)((blk - 1) * 8 + 6) * 1024 + c0; pa0 = *(const f32x4*)s0; pa1 = *(const f32x4*)(s0 + 4); pb0 = *(const f32x4*)(s0 + 1024); pb1 = *(const f32x4*)(s0 + 1028); }
                        const float* sc = SG + (size_t)(blk * 8 + sb) * 1024 + c0; const f32x4 x00 = *(const f32x4*)sc, x01 = *(const f32x4*)(sc + 4);
                        f32x4 xm2a, xm2b, xm1a, xm1b, xca, xcb;
                        if (rr == 0) { xm2a = pa0; xm2b = pa1; xm1a = pb0; xm1b = pb1; xca = x00; xcb = x01; }
                        else { xm2a = pb0; xm2b = pb1; xm1a = x00; xm1b = x01; xca = *(const f32x4*)(sc + 1024); xcb = *(const f32x4*)(sc + 1028); }
                        const f32x4 w0a = *(const f32x4*)(cw + c0), w0b = *(const f32x4*)(cw + c0 + 4), w1a = *(const f32x4*)(cw + 1024 + c0), w1b = *(const f32x4*)(cw + 1028 + c0), w2a = *(const f32x4*)(cw + 2048 + c0), w2b = *(const f32x4*)(cw + 2052 + c0);
                        z0 = w0a * xm2a + w1a * xm1a + w2a * xca; z1 = w0b * xm2b + w1b * xm1b + w2b * xcb; }
                    else { const v4u zw = *(const v4u*)(zc + (size_t)row * 1024 + c0); z0 = (f32x4){bflo(zw.x), bfhi(zw.x), bflo(zw.y), bfhi(zw.y)}; z1 = (f32x4){bflo(zw.z), bfhi(zw.z), bflo(zw.w), bfhi(zw.w)}; }
                    const v4u gw_ = *(const v4u*)(gbm + (size_t)row * 1024 + c0);
                    const f32x4 g0 = (f32x4){bflo(gw_.x), bfhi(gw_.x), bflo(gw_.y), bfhi(gw_.y)}, g1 = (f32x4){bflo(gw_.z), bfhi(gw_.z), bflo(gw_.w), bfhi(gw_.w)};
                    *(v4u*)(gbm + (size_t)row * 1024 + c0) = pack8(g0 * z0, g1 * z1); }
                for (int i = gt; i < 4 * 2 * 1024; i += NT) { const int c = i & 1023, j = (i >> 10) & 1, b = i >> 11; out[OFF_CMP + i] = SG[(size_t)((64 * b + 63) * 8 + 6 + j) * 1024 + c]; }
                for (int i = gt; i < 8 * 2 * 1024; i += NT) { const int c = i & 1023, j = (i >> 10) & 1, b = i >> 11; out[OFF_CMS + i] = SG[(size_t)((256 + (b >> 1)) * 8 + (b & 1) * 4 + 2 + j) * 1024 + c]; }
            }
            SEAM();
        }
        if (RUN) { PTRS() pg8::Gemm g{(bf16*)(tmp + (size_t)(1 - l) * TMP_YCAT), WT + WT_OUTEVEN + (size_t)l * (WT_OUTODD - WT_OUTEVEN), MP, 1024, 1024}; pg8::StaticOrderF S; S.init(MP, 1024, G, (int)blockIdx.x);
            EpiRes E{P.in[0], P.in[1] - (size_t)MP * 1024, xb, PARTBUF(1 + 3 * l), l == 0 ? 1 : 0};
            pg8::gemm_phase<EpiRes, pg8::StaticOrderF, true, true>(lds, g, S, E, wave_s);
            { FRESH() sample_gemm<0>((bf16*)(tmp + (size_t)(1 - l) * TMP_YCAT), WT + WT_OUTEVEN + (size_t)l * (WT_OUTODD - WT_OUTEVEN), 1024, lds, tid, wave, lane, xb, l == 0 ? P.in[1] - (size_t)MP * 1024 : (const float*)nullptr, PARTBUF(1 + 3 * l), nullptr, nullptr); } }
        SEAM();
        if (RUN) { PTRS() pg8::Gemm g{xb, WT + WT_WQ + (size_t)l * 1048576, MP, 1024, 1024}; pg8::StaticOrderF S; S.init(MP, 1024, G, (int)blockIdx.x); EpiBf16 E{qx, 1024, PARTBUF(1 + 3 * l)};
            pg8::gemm_phase<EpiBf16, pg8::StaticOrderF, true, true>(lds, g, S, E, wave_s);
            { FRESH() sample_gemm<1>(xb, WT + WT_WQ + (size_t)l * 1048576, 1024, lds, tid, wave, lane, nullptr, nullptr, nullptr, PARTBUF(1 + 3 * l), qx); } }
        SEAM();
        if (RUN) { PTRS() FRESH() xattn_phase2(qx, memk + (size_t)l * 12 * 262144, memvT + (size_t)l * 12 * 262144, ox, lds, tid, wave, lane, G); }
        SEAM();
        if (RUN) { PTRS() pg8::Gemm g{ox, WT + WT_WO + (size_t)l * 1048576, MP, 1024, 1024}; pg8::StaticOrderF S; S.init(MP, 1024, G, (int)blockIdx.x); EpiRes E{P.in[0], P.in[0], xb, PARTBUF(2 + 3 * l), 0};
            pg8::gemm_phase<EpiRes, pg8::StaticOrderF, true, true>(lds, g, S, E, wave_s);
            { FRESH() sample_gemm<0>(ox, WT + WT_WO + (size_t)l * 1048576, 1024, lds, tid, wave, lane, xb, nullptr, PARTBUF(2 + 3 * l), nullptr, nullptr); } }
        SEAM();
        if (RUN) { PTRS() pg8::Gemm g{xb, WT + WT_UP + (size_t)l * 5632 * 1024, MROWS, 5632, 1024}; pg8::StaticOrderF S; S.init(MROWS, 5632, G, (int)blockIdx.x);
            EpiFfnUp E{act, PARTBUF(2 + 3 * l), P.in[34] + (size_t)l * 3 * DFF, SG, SV};
            pg8::gemm_phase<EpiFfnUp, pg8::StaticOrderF, true, true>(lds, g, S, E, wave_s); }
        SEAM();
        if (RUN) { PTRS() FRESH()
            const float* cw = P.in[34] + (size_t)l * 3 * DFF; const float* st = P.in[8] + (size_t)l * 8 * 2 * DFF;
            for (int i = gt; i < 528 * 352; i += NT) { const int fi = i / 352, c0 = (i % 352) * 8; int blk, row, rr, sb, vb; bool smp = fi >= 512;
                if (!smp) { blk = fi >> 1; rr = fi & 1; row = blk * 64 + rr; sb = 0; vb = 0; } else { const int s = fi - 512, half = (s >> 1) & 1; blk = 256 + (s >> 2); rr = s & 1; row = blk * 64 + half * 32 + rr; sb = half * 4; vb = half * 2; }
                f32x4 pa0, pa1, pb0, pb1;
                if (smp) { const int b = (blk - 256) * 2 + (sb >> 2); const float* s0 = st + (size_t)(b * 2) * DFF + c0; pa0 = *(const f32x4*)s0; pa1 = *(const f32x4*)(s0 + 4); pb0 = *(const f32x4*)(s0 + DFF); pb1 = *(const f32x4*)(s0 + DFF + 4); }
                else if ((blk & 63) == 0) { pa0 = pa1 = pb0 = pb1 = (f32x4){0.f, 0.f, 0.f, 0.f}; }
                else { const float* s0 = SG + (size_t)((blk - 1) * 8 + 6) * DFF + c0; pa0 = *(const f32x4*)s0; pa1 = *(const f32x4*)(s0 + 4); pb0 = *(const f32x4*)(s0 + DFF); pb1 = *(const f32x4*)(s0 + DFF + 4); }
                const float* sc = SG + (size_t)(blk * 8 + sb) * DFF + c0; const f32x4 x00 = *(const f32x4*)sc, x01 = *(const f32x4*)(sc + 4);
                f32x4 xm2a, xm2b, xm1a, xm1b, xca, xcb;
                if (rr == 0) { xm2a = pa0; xm2b = pa1; xm1a = pb0; xm1b = pb1; xca = x00; xcb = x01; }
                else { xm2a = pb0; xm2b = pb1; xm1a = x00; xm1b = x01; xca = *(const f32x4*)(sc + DFF); xcb = *(const f32x4*)(sc + DFF + 4); }
                const f32x4 w0a = *(const f32x4*)(cw + c0), w0b = *(const f32x4*)(cw + c0 + 4), w1a = *(const f32x4*)(cw + DFF + c0), w1b = *(const f32x4*)(cw + DFF + c0 + 4), w2a = *(const f32x4*)(cw + 2 * DFF + c0), w2b = *(const f32x4*)(cw + 2 * DFF + c0 + 4);
                const f32x4 ga = w0a * xm2a + w1a * xm1a + w2a * xca, gb_ = w0b * xm2b + w1b * xm1b + w2b * xcb;
                const float* sv = SV + (size_t)(blk * 4 + vb + rr) * DFF + c0; const f32x4 va = *(const f32x4*)sv, vb_ = *(const f32x4*)(sv + 4);
                f32x4 a0, a1;
#pragma unroll
                for (int j = 0; j < 4; ++j) { a0[j] = ga[j] * sigmoidf_(ga[j]) * va[j]; a1[j] = gb_[j] * sigmoidf_(gb_[j]) * vb_[j]; }
                *(v4u*)(act + (size_t)row * DFF + c0) = pack8(a0, a1); }
            for (int i = gt; i < 4 * 2 * DFF; i += NT) { const int c = i % DFF, j = (i / DFF) & 1, b = i / (2 * DFF); out[OFF_CFP + (size_t)l * 4 * 2 * DFF + i] = SG[(size_t)((64 * b + 63) * 8 + 6 + j) * DFF + c]; }
            for (int i = gt; i < 8 * 2 * DFF; i += NT) { const int c = i % DFF, j = (i / DFF) & 1, b = i / (2 * DFF); out[OFF_CFS + (size_t)l * 8 * 2 * DFF + i] = SG[(size_t)((256 + (b >> 1)) * 8 + (b & 1) * 4 + 2 + j) * DFF + c]; }
        }
        SEAM();
        if (RUN) { PTRS() pg8::Gemm g{act, WT + WT_DOWN + (size_t)l * 2816 * 1024, MP, 1024, DFF}; pg8::StaticOrderF S; S.init(MP, 1024, G, (int)blockIdx.x); EpiRes E{P.in[0], P.in[0], xb, PARTBUF(3 + 3 * l), 0};
            pg8::gemm_phase<EpiRes, pg8::StaticOrderF, true, true>(lds, g, S, E, wave_s);
            { FRESH() sample_gemm<0>(act, WT + WT_DOWN + (size_t)l * 2816 * 1024, DFF, lds, tid, wave, lane, xb, nullptr, PARTBUF(3 + 3 * l), nullptr, nullptr); } }
        SEAM();
    }
    if (RUN) { PTRS() FRESH()
        const float* gf = P.in[14];
        for (int m = gw; m < MROWS; m += NGW) { const float rs = rstd_of(PARTBUF(6), m); float* xr = out + (size_t)m * 1024; const bf16* xbr = xb + (size_t)m * 1024;
#pragma unroll
            for (int j = 0; j < 4; ++j) { const int c = (lane + 64 * j) * 4; const u32x2v w = *(const u32x2v*)(xbr + c); const f32x4 v = (f32x4){bflo(w.x), bfhi(w.x), bflo(w.y), bfhi(w.y)}, gg = *(const f32x4*)(gf + c); *(f32x4*)(xr + c) = v * rs * gg; } }
    }
}

extern "C" void kernel_launch(void* const* d_in, const int* in_sizes, int n_in, void* d_out, int out_size, void* d_ws, size_t ws_size, hipStream_t stream) {
    static int grid = 0;
    if (grid == 0) {
        int dev = 0, cus = 0, per_cu = 0;
        if (n_in != 36 || ws_size < 256 * MiB) { fprintf(stderr, "kernel_launch: unexpected n_in %d / ws %zu\n", n_in, ws_size); grid = -1; return; }
        (void)hipGetDevice(&dev); (void)hipDeviceGetAttribute(&cus, hipDeviceAttributeMultiprocessorCount, dev);
        if (hipFuncSetAttribute((const void*)mega_fwd, hipFuncAttributeMaxDynamicSharedMemorySize, LDS_BYTES) != hipSuccess) { fprintf(stderr, "kernel_launch: hipFuncSetAttribute failed\n"); grid = -1; return; }
        if (hipOccupancyMaxActiveBlocksPerMultiprocessor(&per_cu, (const void*)mega_fwd, 512, LDS_BYTES) != hipSuccess || per_cu < 1) per_cu = 1;
        (void)hipGetLastError();
        grid = cus * 1;
        if (grid > 256) grid = 256;
    }
    if (grid < 0) return;
    (void)hipMemsetAsync(d_ws, 0, CTL_ZERO_BYTES, stream);
    Params p{};
    for (int i = 0; i < 36; ++i) p.in[i] = (const float*)d_in[i];
    p.out = (float*)d_out; p.ws = (unsigned char*)d_ws; p.use_cg = 0; p.pad = 0;
    void* args[] = {&p};
    hipError_t e = hipLaunchCooperativeKernel((const void*)mega_fwd, dim3(grid), dim3(512), args, LDS_BYTES, stream);
    if (e != hipSuccess) fprintf(stderr, "cooperative launch failed: %s (grid %d)\n", hipGetErrorString(e), grid);
}
```

```cpp
#include <hip/hip_runtime.h>
#include <hip/hip_cooperative_groups.h>
#include <cstdio>
#include <cstdint>
namespace cg = cooperative_groups;
__device__ __forceinline__ int fresh_tid(int wave_s) { unsigned z = 0u; asm volatile("" : "+s"(z)); int t = wave_s * 64 + (int)__builtin_amdgcn_mbcnt_hi(~0u, __builtin_amdgcn_mbcnt_lo(~0u, z)); asm volatile("" : "+v"(t)); return t; }
namespace pg8 {
#define PG8_LAS __attribute__((address_space(3)))
typedef unsigned short bf16_t;
typedef short bf16x8 __attribute__((ext_vector_type(8)));
typedef float f32x4 __attribute__((ext_vector_type(4)));
typedef unsigned u32x4 __attribute__((ext_vector_type(4)));
constexpr int BM = 256, BK = 64, HALF = 128, HTB = HALF * BK * 2  , STAGE_BYTES = 8 * HTB, NXCD = 8, WGM = 8;

__host__ __device__ __forceinline__ int lds_byte(int r, int c) { const int st = (r >> 4) * 2 + (c >> 5), rr = r & 15, cc = c & 31, ob = rr * 64 + cc * 2; return st * 1024 + (ob ^ (((ob >> 9) & 1) << 5)); }
__host__ __device__ __forceinline__ void stage_rc(int b, int& R, int& C) { const int st = b / 1024, sb = b % 1024, swz = sb ^ (((sb >> 9) & 1) << 5); R = (st >> 1) * 16 + swz / 64; C = (st & 1) * 32 + (swz % 64) / 2; }
__host__ __device__ __forceinline__ int perm32(int rho) { const int n = rho >> 4, i = rho & 15; return 8 * (i >> 2) + 4 * n + (i & 3); }

struct Unit { int pm, pn; };
struct Gemm { const bf16_t* A; const bf16_t* Bt; int M, N, K; };

template <bool FULL> struct StaticOrderT {
    int nM, nN, nwg, G, c;
    __host__ __device__ void init(int M, int N, int G_, int c_) { nM = M / BM; nN = N / BM; nwg = nM * nN; G = G_; c = c_; }
    __host__ __device__ bool next(int i, Unit& u) const {
        const long L = (long)i * G + c; if (!(FULL && i == 0) && L >= nwg) return false;
        int wgid = (int)L; { const int q = nwg / NXCD, r = nwg % NXCD, xcd = wgid % NXCD, off = wgid / NXCD; wgid = (xcd < r ? xcd * (q + 1) : r * (q + 1) + (xcd - r) * q) + off; }
        const int nig = WGM * nN, gid = wgid / nig, fm = gid * WGM, gsz = (nM - fm) < WGM ? (nM - fm) : WGM;
        u.pm = fm + ((wgid % nig) % gsz); u.pn = (wgid % nig) / gsz; return true;
    }
    __device__ __forceinline__ void a_ready(const Unit&) const {}
    __device__ __forceinline__ void done(const Unit&) const {}
};

typedef StaticOrderT<false> StaticOrder; typedef StaticOrderT<true> StaticOrderF;
__device__ __forceinline__ unsigned cvt_pk_bf16(float lo, float hi) { unsigned r; asm volatile("v_cvt_pk_bf16_f32 %0, %1, %2" : "=v"(r) : "v"(lo), "v"(hi)); return r; }
typedef float f32x2 __attribute__((ext_vector_type(2)));
template <class Epi, class Sched, bool ALIGN_EPI = false, bool SP2 = false>
__device__ __forceinline__ void gemm_phase(PG8_LAS unsigned char* lds, const Gemm g, const Sched& S, const Epi& E, const int wave_s) {
    const int tid = fresh_tid(wave_s), wid = __builtin_amdgcn_readfirstlane(tid >> 6), lane = tid & 63, wr = wid >> 2, wc = wid & 3, fr = lane & 15, fq = lane >> 4;
    const int K = g.K, nt = K / BK;
    unsigned voffA[2], voffB[2];
#pragma unroll
    for (int i = 0; i < 2; ++i) { int R, C; stage_rc(tid * 16 + i * 8192, R, C); const int Rb = Epi::PERM ? ((R & ~31) + perm32(R & 31)) : R;
        voffA[i] = (unsigned)(R * K + C) * 2u; voffB[i] = (unsigned)(Rb * K + C) * 2u; }
    const size_t kstep = (size_t)(BK * 2);
    const size_t hstep = (size_t)HALF * K * 2;
    const size_t tstep = 2 * hstep;
    const unsigned ldsw = (unsigned)wid * 1024u;
    const int aoff = lds_byte(wr * 64 + fr, fq * 8), boff = lds_byte(wc * 32 + fr, fq * 8);
#define PG8_SA(b, h) (((b) * 2 + (h)) * HTB)
#define PG8_SB(b, h) ((4 + (b) * 2 + (h)) * HTB)
#define PG8_STAGE(bufoff, gbase, voff) do { _Pragma("unroll") for (int _i = 0; _i < 2; ++_i) \
        __builtin_amdgcn_global_load_lds((const unsigned*)((const char*)(gbase) + (voff)[_i]), (PG8_LAS unsigned*)(lds + (bufoff) + ldsw + _i * 8192), 16, 0, 0); } while (0)
#define PG8_LDA(dst, b, h) do { _Pragma("unroll") for (int m = 0; m < 4; ++m) _Pragma("unroll") for (int k = 0; k < 2; ++k) dst[m][k] = *(const PG8_LAS bf16x8*)(lds + PG8_SA(b, h) + aoff + m * 2048 + k * 1024); } while (0)
#define PG8_LDB(dst, b, h) do { _Pragma("unroll") for (int n = 0; n < 2; ++n) _Pragma("unroll") for (int k = 0; k < 2; ++k) dst[n][k] = *(const PG8_LAS bf16x8*)(lds + PG8_SB(b, h) + boff + n * 2048 + k * 1024); } while (0)
#define PG8_MMA(ai, bj, At, Bt) do { __builtin_amdgcn_s_setprio(1); _Pragma("unroll") for (int m = 0; m < 4; ++m) _Pragma("unroll") for (int n = 0; n < 2; ++n) _Pragma("unroll") for (int k = 0; k < 2; ++k) \
        acc[ai][bj][m][n] = __builtin_amdgcn_mfma_f32_16x16x32_bf16(Bt[n][k], At[m][k], acc[ai][bj][m][n], 0, 0, 0); __builtin_amdgcn_s_setprio(0); } while (0)
#define PG8_WAIT_V(n) asm volatile("s_waitcnt vmcnt(" #n ")" ::: "memory")
#define PG8_WAIT_L(n) asm volatile("s_waitcnt lgkmcnt(" #n ")" ::: "memory")
#define PG8_BAR __builtin_amdgcn_s_barrier()
#define PG8_SCHED __builtin_amdgcn_sched_barrier(0)
    Unit cur, nxt; int ui = 0;
    if (!S.next(0, cur)) return;
    f32x4 acc[2][2][4][2];
#pragma unroll
    for (int a = 0; a < 2; ++a)
#pragma unroll
        for (int b = 0; b < 2; ++b)
#pragma unroll
            for (int m = 0; m < 4; ++m)
#pragma unroll
                for (int n = 0; n < 2; ++n) acc[a][b][m][n] = (f32x4){0.f, 0.f, 0.f, 0.f};
    bf16x8 At[4][2], B0[2][2], B1[2][2];
    const char* cA = (const char*)g.A + (size_t)cur.pm * tstep; const char* cB = (const char*)g.Bt + (size_t)cur.pn * tstep;
    S.a_ready(cur);
    if constexpr (SP2) {
        PG8_STAGE(PG8_SB(0, 0), cB, voffB); PG8_STAGE(PG8_SB(0, 1), cB + hstep, voffB); PG8_STAGE(PG8_SA(0, 0), cA, voffA); PG8_STAGE(PG8_SA(0, 1), cA + hstep, voffA);
        if (wr == 1) PG8_BAR;
        PG8_WAIT_V(2); PG8_BAR;
        PG8_STAGE(PG8_SB(1, 0), cB + kstep, voffB); PG8_STAGE(PG8_SA(1, 0), cA + kstep, voffA); PG8_STAGE(PG8_SB(1, 1), cB + hstep + kstep, voffB);
        PG8_WAIT_V(6); PG8_BAR;
    } else {
        PG8_STAGE(PG8_SB(0, 0), cB, voffB); PG8_STAGE(PG8_SA(0, 0), cA, voffA); PG8_STAGE(PG8_SB(0, 1), cB + hstep, voffB); PG8_STAGE(PG8_SA(0, 1), cA + hstep, voffA);
        if (wr == 1) PG8_BAR;
        PG8_WAIT_V(4); PG8_BAR;
        PG8_STAGE(PG8_SB(1, 0), cB + kstep, voffB); PG8_STAGE(PG8_SA(1, 0), cA + kstep, voffA); PG8_STAGE(PG8_SB(1, 1), cB + hstep + kstep, voffB);
        PG8_WAIT_V(6); PG8_BAR;
    }
    for (;;) {
        const bool has_next = S.next(ui + 1, nxt);
        const char* nA = has_next ? (const char*)g.A + (size_t)nxt.pm * tstep : cA; const char* nB = has_next ? (const char*)g.Bt + (size_t)nxt.pn * tstep : cB;
        for (int t = 0; t < nt; t += 2) {
            const bool last = (t == nt - 2);
            const char* a1 = cA + (size_t)(t + 1) * kstep;
            const char* a2 = last ? nA : cA + (size_t)(t + 2) * kstep; const char* b2 = last ? nB : cB + (size_t)(t + 2) * kstep;
            const char* a3 = a2 + kstep; const char* b3 = b2 + kstep;
            if (last && has_next) S.a_ready(nxt);
            if constexpr (SP2) {
            PG8_LDB(B0, 0, 0); PG8_LDB(B1, 0, 1); PG8_SCHED; PG8_LDA(At, 0, 0); PG8_STAGE(PG8_SA(1, 1), a1 + hstep, voffA);
            PG8_WAIT_V(8); PG8_WAIT_L(0); PG8_BAR; PG8_MMA(0, 0, At, B0); PG8_MMA(0, 1, At, B1); PG8_BAR; PG8_SCHED;
            PG8_LDA(At, 0, 1); PG8_STAGE(PG8_SB(0, 0), b2, voffB); PG8_STAGE(PG8_SB(0, 1), b2 + hstep, voffB); PG8_STAGE(PG8_SA(0, 0), a2, voffA);
            PG8_WAIT_V(8); PG8_WAIT_L(0); PG8_BAR; PG8_MMA(1, 0, At, B0); PG8_MMA(1, 1, At, B1); PG8_BAR; PG8_SCHED;
            PG8_LDB(B0, 1, 0); PG8_LDB(B1, 1, 1); PG8_SCHED; PG8_LDA(At, 1, 0); PG8_STAGE(PG8_SA(0, 1), a2 + hstep, voffA);
            PG8_WAIT_V(8); PG8_WAIT_L(0); PG8_BAR; PG8_MMA(0, 0, At, B0); PG8_MMA(0, 1, At, B1); PG8_BAR; PG8_SCHED;
            PG8_LDA(At, 1, 1); PG8_STAGE(PG8_SB(1, 0), b3, voffB); PG8_STAGE(PG8_SB(1, 1), b3 + hstep, voffB); PG8_STAGE(PG8_SA(1, 0), a3, voffA);
            PG8_WAIT_V(8); PG8_WAIT_L(0); PG8_BAR; PG8_MMA(1, 0, At, B0); PG8_MMA(1, 1, At, B1); PG8_BAR; PG8_SCHED;
            } else {
            PG8_LDB(B0, 0, 0); PG8_SCHED; PG8_LDA(At, 0, 0); PG8_STAGE(PG8_SA(1, 1), a1 + hstep, voffA);
            PG8_WAIT_L(8); PG8_BAR; PG8_WAIT_L(0); PG8_MMA(0, 0, At, B0); PG8_BAR; PG8_SCHED;
            PG8_LDB(B1, 0, 1); PG8_STAGE(PG8_SB(0, 0), b2, voffB);
            PG8_BAR; PG8_WAIT_L(0); PG8_MMA(0, 1, At, B1); PG8_BAR;
            PG8_LDA(At, 0, 1); PG8_STAGE(PG8_SA(0, 0), a2, voffA);
            PG8_BAR; PG8_WAIT_L(0); PG8_MMA(1, 0, At, B0); PG8_BAR; PG8_SCHED;
            PG8_STAGE(PG8_SB(0, 1), b2 + hstep, voffB);
            PG8_WAIT_V(6); PG8_BAR; PG8_MMA(1, 1, At, B1); PG8_BAR;
            PG8_LDB(B0, 1, 0); PG8_SCHED; PG8_LDA(At, 1, 0); PG8_STAGE(PG8_SA(0, 1), a2 + hstep, voffA);
            PG8_WAIT_L(8); PG8_BAR; PG8_WAIT_L(0); PG8_MMA(0, 0, At, B0); PG8_BAR; PG8_SCHED;
            PG8_LDB(B1, 1, 1); PG8_STAGE(PG8_SB(1, 0), b3, voffB);
            PG8_BAR; PG8_WAIT_L(0); PG8_MMA(0, 1, At, B1); PG8_BAR;
            PG8_LDA(At, 1, 1); PG8_STAGE(PG8_SA(1, 0), a3, voffA);
            PG8_BAR; PG8_WAIT_L(0); PG8_MMA(1, 0, At, B0); PG8_BAR; PG8_SCHED;
            PG8_STAGE(PG8_SB(1, 1), b3 + hstep, voffB);
            PG8_WAIT_V(6); PG8_BAR; PG8_MMA(1, 1, At, B1); PG8_BAR;
            }
        }
        if constexpr (ALIGN_EPI) { if (wr == 0) PG8_BAR; }
        if constexpr (!Epi::AFTER_DRAIN) { E(acc, cur, wr, wc, fr, fq); S.done(cur); }
        if (!has_next) break;
#pragma unroll
        for (int a = 0; a < 2; ++a)
#pragma unroll
            for (int b = 0; b < 2; ++b)
#pragma unroll
                for (int m = 0; m < 4; ++m)
#pragma unroll
                    for (int n = 0; n < 2; ++n) acc[a][b][m][n] = (f32x4){0.f, 0.f, 0.f, 0.f};
        cur = nxt; cA = nA; cB = nB; ++ui;
        if constexpr (ALIGN_EPI) { if (wr == 1) PG8_BAR; }
    }
    PG8_WAIT_V(0);
    if constexpr (!ALIGN_EPI) { if (wr == 0) PG8_BAR; }
    PG8_BAR;
    if constexpr (Epi::AFTER_DRAIN) { E.fused(acc, cur, wr, wc, fr, fq, lds, wid, lane); S.done(cur); }
#undef PG8_SA
#undef PG8_SB
#undef PG8_STAGE
#undef PG8_LDA
#undef PG8_LDB
#undef PG8_MMA
#undef PG8_WAIT_V
#undef PG8_WAIT_L
#undef PG8_BAR
#undef PG8_SCHED
}
}
#define GAS __attribute__((address_space(1)))
#define LAS __attribute__((address_space(3)))
typedef unsigned short bf16;
typedef unsigned v4u __attribute__((ext_vector_type(4)));
typedef float f32x4 __attribute__((ext_vector_type(4)));
typedef short bf16x8 __attribute__((ext_vector_type(8)));
typedef GAS unsigned gu32;
typedef GAS unsigned long long gu64;
#define RLX_AGENT __ATOMIC_RELAXED, __HIP_MEMORY_SCOPE_AGENT
#define LDS_WAIT() asm volatile("s_waitcnt lgkmcnt(0)" ::: "memory")
#define VM_WAIT() asm volatile("s_waitcnt vmcnt(0)" ::: "memory")
__device__ __forceinline__ unsigned long long rt() { return __builtin_amdgcn_s_memrealtime(); }
__device__ __forceinline__ unsigned f2bf(float f) { unsigned u = __builtin_bit_cast(unsigned, f); return (u + 0x7fffu + ((u >> 16) & 1u)) >> 16; }
__device__ __forceinline__ unsigned pk2(float lo, float hi) { return f2bf(lo) | (f2bf(hi) << 16); }

#define XB_TMO      128
#define XB_XCNT(j)  (256  + 64 * (j))
#define XB_XSUB(j)  (1280 + 64 * (j))
#define XB_XGEN(j)  (2304 + 64 * (j))
#define XB_TOP      3328
#define XB_TOPGEN   3392
#define XCD_BAR_WORDS 3456
#define XB_SPIN_CAP (1u << 18)

__device__ __forceinline__ unsigned xb_ld(unsigned* p)              { return __hip_atomic_load(p, __ATOMIC_RELAXED, __HIP_MEMORY_SCOPE_AGENT); }
__device__ __forceinline__ unsigned xb_add(unsigned* p, unsigned v) { return __hip_atomic_fetch_add(p, v, __ATOMIC_RELAXED, __HIP_MEMORY_SCOPE_AGENT); }
__device__ __forceinline__ unsigned xb_xcc_id() { return (unsigned)__builtin_amdgcn_s_getreg((3 << 11) | 20) & 0xFu; }
#define XB_SPIN(cond, bar) do { unsigned _sp = 0; while (cond) { __builtin_amdgcn_s_sleep(1); \
    if ((++_sp & 255u) == 0u) { if (xb_ld(&(bar)[XB_TMO])) break; if (_sp > XB_SPIN_CAP) { atomicAdd(&(bar)[XB_TMO], 1u); break; } } } } while (0)

struct XcdBarrier {
    unsigned* bar; unsigned x;
    volatile LAS unsigned* st;
};

__device__ __forceinline__ XcdBarrier xcd_barrier_post(unsigned* bar, volatile LAS unsigned* st) {
    XcdBarrier b; b.bar = bar; b.x = xb_xcc_id(); b.st = st;
    if (threadIdx.x == 0) (void)xb_add(&bar[XB_XCNT(b.x)], 1u);
    return b;
}
__device__ __forceinline__ void xcd_barrier_complete(unsigned* bar, unsigned x, unsigned& nloc, unsigned& nx) {
    const unsigned G = gridDim.x * gridDim.y * gridDim.z;
    unsigned sum, cnt, mine, sp = 0u;
    for (;;) {
        sum = 0u; cnt = 0u; mine = 0u;
#pragma unroll
        for (unsigned j = 0; j < 16; ++j) { const unsigned c = xb_ld(&bar[XB_XCNT(j)]); sum += c; cnt += (c > 0u) ? 1u : 0u; mine = (j == x) ? c : mine; }
        if (sum == G) break;
        __builtin_amdgcn_s_sleep(1);
        if ((++sp & 255u) == 0u) { if (xb_ld(&bar[XB_TMO])) break; if (sp > XB_SPIN_CAP) { atomicAdd(&bar[XB_TMO], 1u); break; } }
    }
    nloc = mine > 0u ? mine : 1u; nx = cnt > 0u ? cnt : 1u;
}

__device__ __forceinline__ void xcd_barrier(const XcdBarrier& b) {
    asm volatile("s_waitcnt vmcnt(0)" ::: "memory");
    __syncthreads();
    if (threadIdx.x == 0) {
        unsigned* bar = b.bar;
        __builtin_amdgcn_s_waitcnt(0);
        unsigned nloc = b.st[0], nx = b.st[1];
        if (nloc == 0u) { xcd_barrier_complete(bar, b.x, nloc, nx); b.st[0] = nloc; b.st[1] = nx; }
        const unsigned old = xb_add(&bar[XB_XSUB(b.x)], 1u);
        const unsigned gen = old / nloc;
        if (old + 1u == (gen + 1u) * nloc) {
            __builtin_amdgcn_fence(__ATOMIC_RELEASE, "agent");
            asm volatile("s_waitcnt vmcnt(0)" ::: "memory");
            const unsigned og = xb_add(&bar[XB_TOP], 1u);
            const unsigned tg = og / nx;
            if (og + 1u == (tg + 1u) * nx) xb_add(&bar[XB_TOPGEN], 1u);
            else XB_SPIN(xb_ld(&bar[XB_TOPGEN]) == tg, bar);
            __builtin_amdgcn_fence(__ATOMIC_ACQUIRE, "agent");
            xb_add(&bar[XB_XGEN(b.x)], 1u);
            asm volatile("s_waitcnt vmcnt(0)" ::: "memory");
        } else {
            XB_SPIN(xb_ld(&bar[XB_XGEN(b.x)]) == gen, bar);
            __builtin_amdgcn_fence(__ATOMIC_ACQUIRE, "agent");
            asm volatile("s_waitcnt vmcnt(0)" ::: "memory");
        }
    }
    __syncthreads();
}
typedef unsigned u32x2v __attribute__((ext_vector_type(2)));
typedef float f32x2v __attribute__((ext_vector_type(2)));

constexpr int MP = 16384, MROWS = 16640, DMODEL = 1024, DFF = 2816, NBLK64 = MROWS / 64;
constexpr float RMS_EPS = 1e-6f;
constexpr size_t OFF_Y = 0, OFF_WKP = (size_t)MROWS * 1024, OFF_WVP = OFF_WKP + 65536, OFF_SRP = OFF_WVP + 65536, OFF_SIP = OFF_SRP + 8192,
    OFF_CMP = OFF_SIP + 8192, OFF_CFP = OFF_CMP + 8192, OFF_MKP = OFF_CFP + 45056, OFF_MVP = OFF_MKP + 2097152, OFF_WKS = OFF_MVP + 2097152,
    OFF_WVS = OFF_WKS + 32768, OFF_SRS = OFF_WVS + 32768, OFF_SIS = OFF_SRS + 16384, OFF_CMS = OFF_SIS + 16384, OFF_CFS = OFF_CMS + 16384;
constexpr size_t MiB = 1u << 20;
constexpr size_t WS_ROWSS = 0, WS_BAR = 512 * 1024, CTL_ZERO_BYTES = 1 * MiB;
constexpr size_t WS_ROPE = 1 * MiB, WS_SSM = 2 * MiB, WS_CKV = 3 * MiB, WS_SLOC = 4 * MiB, WS_MEMK = 8 * MiB, WS_MEMVT = 20 * MiB, WS_SIDE = 32 * MiB;
constexpr size_t SG_BYTES = (size_t)NBLK64 * 8 * DFF * 4, SV_BYTES = (size_t)NBLK64 * 4 * DFF * 4;
static_assert(WS_SIDE + SG_BYTES + SV_BYTES <= 66 * MiB, "side buffers");
constexpr size_t WS_WT = 66 * MiB, WS_XB = 128 * MiB, WS_TMP = 161 * MiB;
constexpr size_t WT_INEVEN = 0, WT_GLU = WT_INEVEN + 1280 * 1024, WT_OUTEVEN = WT_GLU + 512 * 512, WT_WQ = WT_OUTEVEN + 1024 * 1024, WT_WKV = WT_WQ + 2 * 1024 * 1024,
    WT_WO = WT_WKV + 2 * 2048 * 1024, WT_UP = WT_WO + 2 * 1024 * 1024, WT_DOWN = WT_UP + (size_t)2 * 5632 * 1024, WT_INODD = WT_DOWN + (size_t)2 * 2816 * 1024,
    WT_OUTODD = WT_INODD + 3072 * 1024, WT_END = WT_OUTODD + 1024 * 1024;
static_assert(WS_WT + WT_END * 2 <= WS_XB, "weights");
static_assert(WS_XB + (size_t)MROWS * 1024 * 2 <= WS_TMP, "xb");
constexpr size_t TMP_BYTES = (size_t)MROWS * DFF * 2;
constexpr size_t WS_PART = 251 * MiB, PART_ELEMS = (size_t)MROWS * 16;
static_assert(WS_PART + 2 * PART_ELEMS * 4 <= 256 * MiB, "part");
static_assert(WS_TMP + TMP_BYTES <= 256 * MiB, "ws");
constexpr size_t TMP_PROJ0 = 0, TMP_GBUF = (size_t)MROWS * 1280 * 2, TMP_YCAT = TMP_GBUF + (size_t)MROWS * 512 * 2, TMP_MEMB = TMP_YCAT;
static_assert(TMP_YCAT + (size_t)MROWS * 1024 * 2 <= TMP_BYTES, "tmp");
constexpr size_t TMP_QX = 0, TMP_OX = (size_t)MROWS * 1024 * 2, TMP_ACT = 0, TMP_GB = 0, TMP_ZC = (size_t)MROWS * 1024 * 2;
constexpr int LDS_BYTES = 147456, MISC_OFF = 147456 - 512;
constexpr int NPH = 22;

#define MFMA16(a, b, c) __builtin_amdgcn_mfma_f32_16x16x32_bf16(a, b, c, 0, 0, 0)
__device__ __forceinline__ float bflo(unsigned w) { return __uint_as_float(w << 16); }
__device__ __forceinline__ float bfhi(unsigned w) { return __uint_as_float(w & 0xffff0000u); }
__device__ __forceinline__ v4u pack8(f32x4 a, f32x4 b) { v4u w; w.x = pg8::cvt_pk_bf16(a[0], a[1]); w.y = pg8::cvt_pk_bf16(a[2], a[3]); w.z = pg8::cvt_pk_bf16(b[0], b[1]); w.w = pg8::cvt_pk_bf16(b[2], b[3]); return w; }
__device__ __forceinline__ float rstd_of(const float* part, int row) { const f32x4* p = (const f32x4*)(part + (size_t)row * 16); const f32x4 a = p[0] + p[1] + p[2] + p[3]; return rsqrtf(((a[0] + a[1]) + (a[2] + a[3])) * (1.0f / 1024.0f) + RMS_EPS); }
__device__ __forceinline__ float sigmoidf_(float x) { return 1.0f / (1.0f + __expf(-x)); }
__device__ __forceinline__ float dpp_ror1(float v) { return __builtin_bit_cast(float, __builtin_amdgcn_update_dpp(0, __builtin_bit_cast(int, v), 0x121, 0xf, 0xf, false)); }
__device__ __forceinline__ float dpp_ror2(float v) { return __builtin_bit_cast(float, __builtin_amdgcn_update_dpp(0, __builtin_bit_cast(int, v), 0x122, 0xf, 0xf, false)); }
__device__ __forceinline__ float wave_sum(float v) {
#pragma unroll
    for (int o = 1; o < 64; o <<= 1) v += __shfl_xor(v, o);
    return v;
}

typedef pg8::Unit Unit;
#define EPI_ARGS const f32x4 (&acc)[2][2][4][2], const Unit& u, int wr, int wc, int fr, int fq

struct EpiBf16 {
    static constexpr bool PERM = true, AFTER_DRAIN = false;
    bf16* O; int ldc; const float* rowss;
    __device__ __forceinline__ void operator()(EPI_ARGS) const {
        const int row0 = u.pm * 256 + wr * 64 + fr, col0 = u.pn * 256 + wc * 32 + 8 * fq;
#pragma unroll
        for (int ai = 0; ai < 2; ++ai)
#pragma unroll
            for (int m = 0; m < 4; ++m) { const int row = row0 + ai * 128 + m * 16; const float rs = rstd_of(rowss, row); bf16* rp = O + (size_t)row * ldc + col0;
#pragma unroll
                for (int bj = 0; bj < 2; ++bj) *(v4u*)(rp + bj * 128) = pack8(acc[ai][bj][m][0] * rs, acc[ai][bj][m][1] * rs); }
    }
};
struct EpiRes {
    static constexpr bool PERM = true, AFTER_DRAIN = false;
    const float* base_p; const float* base_s; bf16* xb; float* rowss_next; int f32base;
    __device__ __forceinline__ void operator()(EPI_ARGS) const {
        const float* base = u.pm < 64 ? base_p : base_s;
        const int row0 = u.pm * 256 + wr * 64 + fr, col0 = u.pn * 256 + wc * 32 + 8 * fq;
#pragma unroll
        for (int ai = 0; ai < 2; ++ai)
#pragma unroll
            for (int m = 0; m < 4; ++m) { const int row = row0 + ai * 128 + m * 16; const size_t off = (size_t)row * 1024 + col0; float ss = 0.f;
#pragma unroll
                for (int bj = 0; bj < 2; ++bj) { f32x4 b0, b1;
                    if (f32base) { b0 = *(const f32x4*)(base + off + bj * 128); b1 = *(const f32x4*)(base + off + bj * 128 + 4); }
                    else { const v4u w = *(const v4u*)(xb + off + bj * 128); b0 = (f32x4){bflo(w.x), bfhi(w.x), bflo(w.y), bfhi(w.y)}; b1 = (f32x4){bflo(w.z), bfhi(w.z), bflo(w.w), bfhi(w.w)}; }
                    const f32x4 v0 = acc[ai][bj][m][0] + b0, v1 = acc[ai][bj][m][1] + b1;
                    *(v4u*)(xb + off + bj * 128) = pack8(v0, v1);
                    ss += (v0[0] * v0[0] + v0[1] * v0[1]) + (v0[2] * v0[2] + v0[3] * v0[3]) + (v1[0] * v1[0] + v1[1] * v1[1]) + (v1[2] * v1[2] + v1[3] * v1[3]); }
                ss += __shfl_xor(ss, 16); ss += __shfl_xor(ss, 32);
                if (fq == 0) rowss_next[(size_t)row * 16 + u.pn * 4 + wc] = ss; }
    }
};
struct EpiGlu {
    static constexpr bool PERM = true, AFTER_DRAIN = false;
    const bf16* g; bf16* ycat;
    __device__ __forceinline__ void operator()(EPI_ARGS) const {
        const int row0 = u.pm * 256 + wr * 64 + fr, col0 = u.pn * 256 + wc * 32 + 8 * fq;
#pragma unroll
        for (int ai = 0; ai < 2; ++ai)
#pragma unroll
            for (int m = 0; m < 4; ++m) { const int row = row0 + ai * 128 + m * 16;
#pragma unroll
                for (int bj = 0; bj < 2; ++bj) { const int col = col0 + bj * 128; const v4u gw = *(const v4u*)(g + (size_t)row * 512 + col);
                    const f32x4 a0 = acc[ai][bj][m][0], a1 = acc[ai][bj][m][1]; f32x4 o0, o1;
                    o0[0] = bflo(gw.x) * sigmoidf_(a0[0]); o0[1] = bfhi(gw.x) * sigmoidf_(a0[1]); o0[2] = bflo(gw.y) * sigmoidf_(a0[2]); o0[3] = bfhi(gw.y) * sigmoidf_(a0[3]);
                    o1[0] = bflo(gw.z) * sigmoidf_(a1[0]); o1[1] = bfhi(gw.z) * sigmoidf_(a1[1]); o1[2] = bflo(gw.w) * sigmoidf_(a1[2]); o1[3] = bfhi(gw.w) * sigmoidf_(a1[3]);
                    *(v4u*)(ycat + (size_t)row * 1024 + col) = pack8(o0, o1); } }
    }
};
struct EpiKV {
    static constexpr bool PERM = true, AFTER_DRAIN = false;
    float* out; bf16* memk;
    __device__ __forceinline__ void operator()(EPI_ARGS) const {
        const int row0 = u.pm * 256 + wr * 64 + fr, col0 = u.pn * 256 + wc * 32 + 8 * fq;
#pragma unroll
        for (int ai = 0; ai < 2; ++ai)
#pragma unroll
            for (int m = 0; m < 4; ++m) { const int row = row0 + ai * 128 + m * 16;
#pragma unroll
                for (int bj = 0; bj < 2; ++bj) { const int c = col0 + bj * 128, l = c >> 11, e = c & 2047, isv = e >> 10, dc = e & 1023;
                    float* op = out + (isv ? OFF_MVP : OFF_MKP) + (size_t)l * 1048576 + (size_t)row * 1024 + dc;
                    *(f32x4*)op = acc[ai][bj][m][0]; *(f32x4*)(op + 4) = acc[ai][bj][m][1];
                    if (!isv) *(v4u*)(memk + (size_t)l * 12 * 262144 + (size_t)row * 1024 + dc) = pack8(acc[ai][bj][m][0], acc[ai][bj][m][1]); } }
    }
};
struct EpiIn0 {
    static constexpr bool PERM = true, AFTER_DRAIN = false;
    bf16* proj; const float* rowss; const float* ropec; const float* ropes; float* out;
    __device__ __forceinline__ void operator()(EPI_ARGS) const {
        const int pn = u.pn;
#pragma unroll
        for (int ai = 0; ai < 2; ++ai)
#pragma unroll
            for (int m = 0; m < 4; ++m) { const int row = u.pm * 256 + ai * 128 + wr * 64 + m * 16 + fr; const float rs = rstd_of(rowss, row);
                const int pos = row < MP ? (row & 4095) : 2048 + (row & 31);
                bf16* rp = proj + (size_t)row * 1280;
                float* wk = nullptr; float* wv = nullptr;
                if (pn == 4) { if (row >= MP) { wk = out + OFF_WKS + (size_t)(row - MP) * 128; wv = out + OFF_WVS + (size_t)(row - MP) * 128; }
                               else if ((row & 4095) >= 3968) { const size_t o = (size_t)((row >> 12) * 128 + (row & 4095) - 3968) * 128; wk = out + OFF_WKP + o; wv = out + OFF_WVP + o; } }
#pragma unroll
                for (int bj = 0; bj < 2; ++bj) { const f32x4 v0 = acc[ai][bj][m][0] * rs, v1 = acc[ai][bj][m][1] * rs;
                    const bool rope = (pn == 2 || pn == 3 || (pn == 4 && bj == 0));
                    if (!rope) { const int col = pn * 256 + bj * 128 + wc * 32 + 8 * fq; *(v4u*)(rp + col) = pack8(v0, v1);
                        if (pn == 4 && wv) { *(f32x4*)(wv + wc * 32 + 8 * fq) = v0; *(f32x4*)(wv + wc * 32 + 8 * fq + 4) = v1; } }
                    else { const int gbase = pn * 256 + bj * 128 + (wc >> 1) * 64, d1 = 16 * (wc & 1) + 4 * fq;
                        const f32x4 c4 = *(const f32x4*)(ropec + pos * 32 + d1), s4 = *(const f32x4*)(ropes + pos * 32 + d1);
                        f32x4 o1 = v0 * c4 - v1 * s4, o2 = v1 * c4 + v0 * s4;
                        if (pn != 4) { o1 = o1 * 0.125f; o2 = o2 * 0.125f; }
                        u32x2v w1, w2; w1.x = pg8::cvt_pk_bf16(o1[0], o1[1]); w1.y = pg8::cvt_pk_bf16(o1[2], o1[3]); w2.x = pg8::cvt_pk_bf16(o2[0], o2[1]); w2.y = pg8::cvt_pk_bf16(o2[2], o2[3]);
                        *(u32x2v*)(rp + gbase + d1) = w1; *(u32x2v*)(rp + gbase + d1 + 32) = w2;
                        if (pn == 4 && wk) { const int cc = (wc >> 1) * 64 + d1; *(f32x4*)(wk + cc) = o1; *(f32x4*)(wk + cc + 32) = o2; } } } }
    }
};
struct EpiFfnUp {
    static constexpr bool PERM = true, AFTER_DRAIN = false;
    bf16* act; const float* rowss; const float* cw; float* SG; float* SV;
    __device__ __forceinline__ void operator()(EPI_ARGS) const {
        const int c0 = u.pn * 128 + wc * 32 + 8 * fq; const bool sample = u.pm == 64;
        const f32x4 w0a = *(const f32x4*)(cw + c0), w0b = *(const f32x4*)(cw + c0 + 4), w1a = *(const f32x4*)(cw + DFF + c0), w1b = *(const f32x4*)(cw + DFF + c0 + 4),
                    w2a = *(const f32x4*)(cw + 2 * DFF + c0), w2b = *(const f32x4*)(cw + 2 * DFF + c0 + 4);
#pragma unroll
        for (int ai = 0; ai < 2; ++ai) { f32x4 gp0 = {0.f, 0.f, 0.f, 0.f}, gp1 = {0.f, 0.f, 0.f, 0.f}; const int blk = u.pm * 4 + ai * 2 + wr;
#pragma unroll
            for (int m = 0; m < 4; ++m) { const int row = u.pm * 256 + ai * 128 + wr * 64 + m * 16 + fr; const float rs = rstd_of(rowss, row);
                const f32x4 g0 = acc[ai][0][m][0] * rs, g1 = acc[ai][0][m][1] * rs, v0 = acc[ai][1][m][0] * rs, v1 = acc[ai][1][m][1] * rs;
                f32x4 p1a, p2a, p1b, p2b;
#pragma unroll
                for (int j = 0; j < 4; ++j) { const float s1a = fr == 15 ? gp0[j] : g0[j], s2a = fr >= 14 ? gp0[j] : g0[j], s1b = fr == 15 ? gp1[j] : g1[j], s2b = fr >= 14 ? gp1[j] : g1[j];
                    p1a[j] = dpp_ror1(s1a); p2a[j] = dpp_ror2(s2a); p1b[j] = dpp_ror1(s1b); p2b[j] = dpp_ror2(s2b); }
                const f32x4 ca = w0a * p2a + w1a * p1a + w2a * g0, cb = w0b * p2b + w1b * p1b + w2b * g1;
                f32x4 sa, sb;
#pragma unroll
                for (int j = 0; j < 4; ++j) { sa[j] = sigmoidf_(ca[j]); sb[j] = sigmoidf_(cb[j]); }
                const f32x4 a0 = ca * sa * v0, a1 = cb * sb * v1;
                const bool valid = (m > 0 || fr >= 2) && !(sample && m == 2 && fr < 2);
                if (valid) *(v4u*)(act + (size_t)row * DFF + c0) = pack8(a0, a1);
                if ((m & 1) == 0 && fr < 2) { float* sg = SG + (size_t)(blk * 8 + 2 * m + fr) * DFF + c0; *(f32x4*)sg = g0; *(f32x4*)(sg + 4) = g1;
                                              float* sv = SV + (size_t)(blk * 4 + m + fr) * DFF + c0; *(f32x4*)sv = v0; *(f32x4*)(sv + 4) = v1; }
                if ((m & 1) == 1 && fr >= 14) { float* sg = SG + (size_t)(blk * 8 + 2 * m + fr - 14) * DFF + c0; *(f32x4*)sg = g0; *(f32x4*)(sg + 4) = g1; }
                gp0 = g0; gp1 = g1; } }
    }
};
struct EpiInOdd {
    static constexpr bool PERM = true, AFTER_DRAIN = false;
    bf16* gb; bf16* zc; const float* rowss; const float* cw; float* SG;
    __device__ __forceinline__ void operator()(EPI_ARGS) const {
        if (u.pn < 4) {
            const int row0 = u.pm * 256 + wr * 64 + fr, col0 = u.pn * 256 + wc * 32 + 8 * fq;
#pragma unroll
            for (int ai = 0; ai < 2; ++ai)
#pragma unroll
                for (int m = 0; m < 4; ++m) { const int row = row0 + ai * 128 + m * 16; const float rs = rstd_of(rowss, row); bf16* rp = gb + (size_t)row * 1024 + col0;
#pragma unroll
                    for (int bj = 0; bj < 2; ++bj) *(v4u*)(rp + bj * 128) = pack8(acc[ai][bj][m][0] * rs, acc[ai][bj][m][1] * rs); }
            return;
        }
        const int c0 = (u.pn - 4) * 128 + wc * 32 + 8 * fq; const bool sample = u.pm == 64;
        const f32x4 w0a = *(const f32x4*)(cw + c0), w0b = *(const f32x4*)(cw + c0 + 4), w1a = *(const f32x4*)(cw + 1024 + c0), w1b = *(const f32x4*)(cw + 1024 + c0 + 4),
                    w2a = *(const f32x4*)(cw + 2048 + c0), w2b = *(const f32x4*)(cw + 2048 + c0 + 4);
#pragma unroll
        for (int ai = 0; ai < 2; ++ai) { f32x4 gp0 = {0.f, 0.f, 0.f, 0.f}, gp1 = {0.f, 0.f, 0.f, 0.f}; const int blk = u.pm * 4 + ai * 2 + wr;
#pragma unroll
            for (int m = 0; m < 4; ++m) { const int row = u.pm * 256 + ai * 128 + wr * 64 + m * 16 + fr; const float rs = rstd_of(rowss, row); const float rs2 = rs * rs;
                const f32x4 g0 = acc[ai][0][m][0] * acc[ai][1][m][0] * rs2, g1 = acc[ai][0][m][1] * acc[ai][1][m][1] * rs2;
                f32x4 p1a, p2a, p1b, p2b;
#pragma unroll
                for (int j = 0; j < 4; ++j) { const float s1a = fr == 15 ? gp0[j] : g0[j], s2a = fr >= 14 ? gp0[j] : g0[j], s1b = fr == 15 ? gp1[j] : g1[j], s2b = fr >= 14 ? gp1[j] : g1[j];
                    p1a[j] = dpp_ror1(s1a); p2a[j] = dpp_ror2(s2a); p1b[j] = dpp_ror1(s1b); p2b[j] = dpp_ror2(s2b); }
                const f32x4 a0 = w0a * p2a + w1a * p1a + w2a * g0, a1 = w0b * p2b + w1b * p1b + w2b * g1;
                const bool valid = (m > 0 || fr >= 2) && !(sample && m == 2 && fr < 2);
                if (valid) *(v4u*)(zc + (size_t)row * 1024 + c0) = pack8(a0, a1);
                if ((m & 1) == 0 && fr < 2) { float* sg = SG + (size_t)(blk * 8 + 2 * m + fr) * 1024 + c0; *(f32x4*)sg = g0; *(f32x4*)(sg + 4) = g1; }
                if ((m & 1) == 1 && fr >= 14) { float* sg = SG + (size_t)(blk * 8 + 2 * m + fr - 14) * 1024 + c0; *(f32x4*)sg = g0; *(f32x4*)(sg + 4) = g1; }
                gp0 = g0; gp1 = g1; } }
    }
};

__device__ __forceinline__ int rowmap(int mode, int n) {
    if (mode == 1) { if (n >= 512 && n < 1152) { const int d = n & 63; return (n & ~63) | (32 * ((d >> 4) & 1) + 8 * ((d >> 2) & 3) + 4 * (d >> 5) + (d & 3)); } return n; }
    if (mode == 2) { return n < DFF ? ((n >> 7) * 256 + (n & 127)) : (((n - DFF) >> 7) * 256 + 128 + ((n - DFF) & 127)); }
    if (mode == 3) { if (n < 1024) return n; const int c = (n - 1024) & 1023, z = n >= 2048 ? 1 : 0; return 1024 + (c >> 7) * 256 + z * 128 + (c & 127); }
    return n;
}
__device__ __forceinline__ void tr_item(const float* W, int K, int N, bf16* WT, const float* gain, float scale, int mode, LAS float* scr, int item, int lane) {
    const int nblk = N / 32, kb = item / nblk, nb = item % nblk, k0 = 64 * kb, n0 = 32 * nb;
#pragma unroll
    for (int i = 0; i < 8; ++i) { const int idx = lane + 64 * i, kk = idx >> 3, n4 = (idx & 7) * 4; const float gs = gain ? gain[k0 + kk] * scale : scale;
        const f32x4 w = *(const f32x4*)(W + (size_t)(k0 + kk) * N + n0 + n4); LAS float* d = scr + kk * 33 + n4; d[0] = w[0] * gs; d[1] = w[1] * gs; d[2] = w[2] * gs; d[3] = w[3] * gs; }
    LDS_WAIT(); asm volatile("" ::: "memory");
    const int c = lane & 7;
#pragma unroll
    for (int j = 0; j < 4; ++j) { const int n = (lane >> 3) + 8 * j; const LAS float* s = scr + (8 * c) * 33 + n;
        v4u o; o.x = pg8::cvt_pk_bf16(s[0 * 33], s[1 * 33]); o.y = pg8::cvt_pk_bf16(s[2 * 33], s[3 * 33]); o.z = pg8::cvt_pk_bf16(s[4 * 33], s[5 * 33]); o.w = pg8::cvt_pk_bf16(s[6 * 33], s[7 * 33]);
        *(v4u*)(WT + (size_t)rowmap(mode, n0 + n) * K + k0 + 8 * c) = o; }
    LDS_WAIT(); asm volatile("" ::: "memory");
}
__device__ __forceinline__ double dexp_(double y) {
    const double k = rint(y * 1.4426950408889634); const double r = (y - k * 0.6931471803691238) - k * 1.9082149292705877e-10;
    double p = 1.0 / 6227020800.0;
    p = p * r + 1.0 / 479001600.0; p = p * r + 1.0 / 39916800.0; p = p * r + 1.0 / 3628800.0; p = p * r + 1.0 / 362880.0; p = p * r + 1.0 / 40320.0; p = p * r + 1.0 / 5040.0;
    p = p * r + 1.0 / 720.0; p = p * r + 1.0 / 120.0; p = p * r + 1.0 / 24.0; p = p * r + 1.0 / 6.0; p = p * r + 0.5; p = p * r + 1.0; p = p * r + 1.0;
    const long long bits = (long long)(1023 + (int)k) << 52; return p * __builtin_bit_cast(double, bits);
}
__device__ __forceinline__ void dsincos_(double x, double& s, double& c) {
    const double k = rint(x * 0.6366197723675814); const double r = (x - k * 1.5707963267948966) - k * 6.123233995736766e-17; const double r2 = r * r;
    const double sp = r * (1.0 + r2 * (-1.0 / 6.0 + r2 * (1.0 / 120.0 + r2 * (-1.0 / 5040.0 + r2 * (1.0 / 362880.0 + r2 * (-1.0 / 39916800.0 + r2 * (1.0 / 6227020800.0)))))));
    const double cp = 1.0 + r2 * (-0.5 + r2 * (1.0 / 24.0 + r2 * (-1.0 / 720.0 + r2 * (1.0 / 40320.0 + r2 * (-1.0 / 3628800.0 + r2 * (1.0 / 479001600.0 + r2 * (-1.0 / 87178291200.0)))))));
    const int q = ((int)k) & 3;
    s = q == 0 ? sp : q == 1 ? cp : q == 2 ? -sp : -cp; c = q == 0 ? cp : q == 1 ? -sp : q == 2 ? -cp : sp;
}

__device__ __forceinline__ const bf16* kvptr(const bf16* proj, const bf16* cb, int sample, int b, int c, int kvh, int kk, int isv) {
    if (!sample) { int pos = (c - 2) * 64 + kk; pos = pos < 0 ? 0 : pos; return proj + (size_t)(b * 4096 + pos) * 1280 + 1024 + isv * 128 + kvh * 64; }
    if (kk < 128) return cb + (size_t)(b * 128 + kk) * 128 + kvh * 64;
    int t = kk - 128; t = t > 31 ? 31 : t; return proj + (size_t)(MP + b * 32 + t) * 1280 + 1024 + isv * 128 + kvh * 64;
}
__device__ __forceinline__ void swa_phase(const bf16* proj, const bf16* ckb, const bf16* cvb, const float* sinks, bf16* ycat, LAS unsigned char* lds, int tid, int wave, int lane, int G) {
    LAS bf16* VT = (LAS bf16*)lds;
    const int fr = lane & 15, quad = lane >> 4;
    for (int it = blockIdx.x; it < 528; it += G) {
        int b, c, kvh, sample;
        if (it < 512) { sample = 0; b = it >> 7; c = (it >> 1) & 63; kvh = it & 1; } else { sample = 1; b = (it - 512) >> 1; c = 0; kvh = it & 1; }
        __syncthreads();
#pragma unroll
        for (int i = 0; i < 3; ++i) { const int idx = tid + 512 * i, kk = idx % 192, dg = idx / 192; const v4u w = *(const v4u*)(kvptr(proj, cvb, sample, b, c, kvh, kk, 1) + dg * 8);
            LAS bf16* vp = VT + (dg * 8) * 200 + kk;
            vp[0] = (bf16)(w.x & 0xffffu); vp[200] = (bf16)(w.x >> 16); vp[400] = (bf16)(w.y & 0xffffu); vp[600] = (bf16)(w.y >> 16);
            vp[800] = (bf16)(w.z & 0xffffu); vp[1000] = (bf16)(w.z >> 16); vp[1200] = (bf16)(w.w & 0xffffu); vp[1400] = (bf16)(w.w >> 16); }
        __syncthreads();
        const int gq = wave >> 1, qhalf = wave & 1, head = kvh * 4 + gq;
        if (!(sample && qhalf)) {
            const int plo = sample ? 0 : (c >= 2 ? 0 : (2 - c) * 2), phi = sample ? 5 : 6;
            bf16x8 qf[2][2];
#pragma unroll
            for (int qb = 0; qb < 2; ++qb) { const int q = qhalf * 32 + qb * 16 + fr; const int row = sample ? MP + b * 32 + (q & 31) : b * 4096 + c * 64 + q;
                const bf16* qp = proj + (size_t)row * 1280 + 512 + head * 64 + quad * 8; qf[qb][0] = *(const bf16x8*)qp; qf[qb][1] = *(const bf16x8*)(qp + 32); }
            f32x4 s[12][2];
#pragma unroll
            for (int kb = 0; kb < 12; ++kb) { const int key = 32 * (kb >> 1) + (fr >> 2) * 8 + 4 * (kb & 1) + (fr & 3); const bf16* kp = kvptr(proj, ckb, sample, b, c, kvh, key, 0) + quad * 8;
                const bf16x8 k0 = *(const bf16x8*)kp, k1 = *(const bf16x8*)(kp + 32);
#pragma unroll
                for (int qb = 0; qb < 2; ++qb) { f32x4 a = {0.f, 0.f, 0.f, 0.f}; a = MFMA16(k0, qf[qb][0], a); a = MFMA16(k1, qf[qb][1], a); s[kb][qb] = a; } }
            const float sink = sinks[head];
            bf16x8 pf[6][2];
#pragma unroll
            for (int qb = 0; qb < 2; ++qb) { float mx = sink;
#pragma unroll
                for (int kb = 0; kb < 12; ++kb) { const bool pv = (kb >> 1) >= plo && (kb >> 1) < phi;
#pragma unroll
                    for (int j = 0; j < 4; ++j) { const float v = pv ? s[kb][qb][j] : -1e30f; s[kb][qb][j] = v; mx = fmaxf(mx, v); } }
                mx = fmaxf(mx, __shfl_xor(mx, 16)); mx = fmaxf(mx, __shfl_xor(mx, 32));
                float sum = 0.f;
#pragma unroll
                for (int kb = 0; kb < 12; ++kb)
#pragma unroll
                    for (int j = 0; j < 4; ++j) { const float e = __expf(s[kb][qb][j] - mx); s[kb][qb][j] = e; sum += e; }
                sum += __shfl_xor(sum, 16); sum += __shfl_xor(sum, 32); sum += __expf(sink - mx);
                const float inv = 1.0f / sum;
#pragma unroll
                for (int pr = 0; pr < 6; ++pr) pf[pr][qb] = __builtin_bit_cast(bf16x8, pack8(s[2 * pr][qb] * inv, s[2 * pr + 1][qb] * inv)); }
#pragma unroll
            for (int db = 0; db < 4; ++db) { bf16x8 vf[6];
#pragma unroll
                for (int pr = 0; pr < 6; ++pr) vf[pr] = *(const LAS bf16x8*)(VT + (db * 16 + fr) * 200 + 32 * pr + quad * 8);
#pragma unroll
                for (int qb = 0; qb < 2; ++qb) { f32x4 o = {0.f, 0.f, 0.f, 0.f};
#pragma unroll
                    for (int pr = 0; pr < 6; ++pr) o = MFMA16(pf[pr][qb], vf[pr], o);
#pragma unroll
                    for (int j = 0; j < 4; ++j) { const int q = qhalf * 32 + qb * 16 + quad * 4 + j;
                        if (!sample || q < 32) { const int row = sample ? MP + b * 32 + q : b * 4096 + c * 64 + q; ycat[(size_t)row * 1024 + 512 + head * 64 + db * 16 + fr] = (bf16)f2bf(o[j]); } } } }
        }
    }
    __syncthreads();
}

__device__ __forceinline__ void xattn_phase(const bf16* qx, const bf16* memk_l, const bf16* memvT_l, bf16* ox, int wave, int lane, int G) {
    const int fr = lane & 15, quad = lane >> 4;
    for (int t = wave * G + (int)blockIdx.x; t < 4160; t += 8 * G) {
        int bb, h, row0;
        if (t < 4096) { const int pair = t >> 8; bb = pair >> 2; h = pair & 3; row0 = bb * 4096 + (t & 255) * 16; }
        else { const int s = t - 4096, b = s >> 3; h = (s >> 1) & 3; bb = 4 + b; row0 = MP + b * 32 + (s & 1) * 16; }
        bf16x8 qf[8];
#pragma unroll
        for (int ks = 0; ks < 8; ++ks) qf[ks] = *(const bf16x8*)(qx + (size_t)(row0 + fr) * 1024 + h * 256 + ks * 32 + quad * 8);
        const bf16* kbase = memk_l + (size_t)bb * 262144 + h * 256 + quad * 8;
        f32x4 s[16];
#pragma unroll
        for (int kb = 0; kb < 16; ++kb) { const int key = 32 * (kb >> 1) + (fr >> 2) * 8 + 4 * (kb & 1) + (fr & 3); const bf16* kp = kbase + (size_t)key * 1024; f32x4 a = {0.f, 0.f, 0.f, 0.f};
#pragma unroll
            for (int ks = 0; ks < 8; ++ks) a = MFMA16(*(const bf16x8*)(kp + ks * 32), qf[ks], a);
            s[kb] = a; }
        float mx = -1e30f;
#pragma unroll
        for (int kb = 0; kb < 16; ++kb)
#pragma unroll
            for (int j = 0; j < 4; ++j) mx = fmaxf(mx, s[kb][j]);
        mx = fmaxf(mx, __shfl_xor(mx, 16)); mx = fmaxf(mx, __shfl_xor(mx, 32));
        float sum = 0.f;
#pragma unroll
        for (int kb = 0; kb < 16; ++kb)
#pragma unroll
            for (int j = 0; j < 4; ++j) { const float e = __expf(s[kb][j] - mx); s[kb][j] = e; sum += e; }
        sum += __shfl_xor(sum, 16); sum += __shfl_xor(sum, 32);
        const float inv = 1.0f / sum;
        bf16x8 pf[8];
#pragma unroll
        for (int pr = 0; pr < 8; ++pr) pf[pr] = __builtin_bit_cast(bf16x8, pack8(s[2 * pr] * inv, s[2 * pr + 1] * inv));
        const bf16* vbase = memvT_l + (size_t)bb * 262144 + (size_t)(h * 256 + fr) * 256 + quad * 8;
#pragma unroll 4
        for (int db = 0; db < 16; ++db) { f32x4 o = {0.f, 0.f, 0.f, 0.f};
#pragma unroll
            for (int pr = 0; pr < 8; ++pr) o = MFMA16(pf[pr], *(const bf16x8*)(vbase + (size_t)db * 4096 + pr * 32), o);
#pragma unroll
            for (int j = 0; j < 4; ++j) ox[(size_t)(row0 + quad * 4 + j) * 1024 + h * 256 + db * 16 + fr] = (bf16)f2bf(o[j]); }
    }
}


__device__ __forceinline__ void xstage(const bf16* src, size_t rowstride, LAS unsigned char* lds, int tid) {
    v4u t[16];
#pragma unroll
    for (int i = 0; i < 16; ++i) { const int row = (tid >> 5) + 16 * i, ch = tid & 31; t[i] = *(const GAS v4u*)((const GAS bf16*)src + (size_t)row * rowstride + ch * 8); }
#pragma unroll
    for (int i = 0; i < 16; ++i) { const int row = (tid >> 5) + 16 * i, ch = tid & 31; *(LAS v4u*)(lds + row * 528 + ch * 16) = t[i]; }
}
__device__ __forceinline__ void xattn_phase2(const bf16* qx, const bf16* memk_l, const bf16* memvT_l, bf16* ox, LAS unsigned char* lds, int tid, int wave, int lane, int G) {
    const int fr = lane & 15, quad = lane >> 4;
    for (int it = blockIdx.x; it < 256 + 32; it += G) {
        int bb, h, rowbase, nqb; bool active;
        if (it < 256) { bb = it >> 6; h = (it >> 4) & 3; rowbase = bb * 4096 + (it & 15) * 256; nqb = 2; active = true; }
        else { const int s = it - 256, b = s >> 2; h = s & 3; bb = 4 + b; rowbase = MP + b * 32; nqb = 1; active = wave < 2; }
        __syncthreads();
        xstage(memk_l + (size_t)bb * 262144 + h * 256, 1024, lds, tid);
        __syncthreads();
        bf16x8 pf[2][8];
#pragma unroll
        for (int qi = 0; qi < 2; ++qi) {
            if (qi < nqb && active) {
                const int row0 = rowbase + qi * 128 + wave * 16;
                bf16x8 qf[8];
#pragma unroll
                for (int ks = 0; ks < 8; ++ks) qf[ks] = *(const GAS bf16x8*)((const GAS bf16*)qx + (size_t)(row0 + fr) * 1024 + h * 256 + ks * 32 + quad * 8);
                f32x4 s[16];
#pragma unroll
                for (int kb = 0; kb < 16; ++kb) { const int key = 32 * (kb >> 1) + (fr >> 2) * 8 + 4 * (kb & 1) + (fr & 3); const LAS unsigned char* kp = lds + key * 528 + quad * 16; f32x4 a = {0.f, 0.f, 0.f, 0.f};
#pragma unroll
                    for (int ks = 0; ks < 8; ++ks) a = MFMA16(*(const LAS bf16x8*)(kp + ks * 64), qf[ks], a);
                    s[kb] = a; }
                float mx = -1e30f;
#pragma unroll
                for (int kb = 0; kb < 16; ++kb)
#pragma unroll
                    for (int j = 0; j < 4; ++j) mx = fmaxf(mx, s[kb][j]);
                mx = fmaxf(mx, __shfl_xor(mx, 16)); mx = fmaxf(mx, __shfl_xor(mx, 32));
                float sum = 0.f;
#pragma unroll
                for (int kb = 0; kb < 16; ++kb)
#pragma unroll
                    for (int j = 0; j < 4; ++j) { const float e = __expf(s[kb][j] - mx); s[kb][j] = e; sum += e; }
                sum += __shfl_xor(sum, 16); sum += __shfl_xor(sum, 32);
                const float inv = 1.0f / sum;
#pragma unroll
                for (int pr = 0; pr < 8; ++pr) pf[qi][pr] = __builtin_bit_cast(bf16x8, pack8(s[2 * pr] * inv, s[2 * pr + 1] * inv));
            }
        }
        __syncthreads();
        xstage(memvT_l + (size_t)bb * 262144 + (size_t)h * 65536, 256, lds, tid);
        __syncthreads();
#pragma unroll
        for (int qi = 0; qi < 2; ++qi) {
            if (qi < nqb && active) {
                const int row0 = rowbase + qi * 128 + wave * 16;
#pragma unroll 4
                for (int db = 0; db < 16; ++db) { f32x4 o = {0.f, 0.f, 0.f, 0.f}; const LAS unsigned char* vp = lds + (db * 16 + fr) * 528 + quad * 16;
#pragma unroll
                    for (int pr = 0; pr < 8; ++pr) o = MFMA16(*(const LAS bf16x8*)(vp + pr * 64), pf[qi][pr], o);
                    u32x2v w; w.x = pk2(o[0], o[1]); w.y = pk2(o[2], o[3]);
                    *(GAS u32x2v*)((GAS bf16*)ox + (size_t)(row0 + fr) * 1024 + h * 256 + db * 16 + quad * 4) = w; }
            }
        }
    }
    __syncthreads();
}

__device__ __forceinline__ void s5_stage_u(const bf16* up, LAS float* ubuf, int lane) {
    const v4u w0 = *(const v4u*)up, w1 = *(const v4u*)(up + 8);
    LAS f32x4* d = (LAS f32x4*)(ubuf + lane * 16);
    d[0] = (f32x4){bflo(w0.x), bfhi(w0.x), bflo(w0.y), bfhi(w0.y)}; d[1] = (f32x4){bflo(w0.z), bfhi(w0.z), bflo(w0.w), bfhi(w0.w)};
    d[2] = (f32x4){bflo(w1.x), bfhi(w1.x), bflo(w1.y), bfhi(w1.y)}; d[3] = (f32x4){bflo(w1.z), bfhi(w1.z), bflo(w1.w), bfhi(w1.w)};
}
__device__ __forceinline__ f32x2v lo2_(f32x4 v) { return __builtin_shufflevector(v, v, 0, 1); }
__device__ __forceinline__ f32x2v hi2_(f32x4 v) { return __builtin_shufflevector(v, v, 2, 3); }
#define S5_STEP(sidx) do { const LAS f32x4* up_ = (const LAS f32x4*)(ubuf + (sidx) * 16); const f32x4 u0 = up_[0], u1 = up_[1], u2 = up_[2], u3 = up_[3]; \
    f32x2v ac_ = lo2_(bb[0]) * u0[0]; ac_ = hi2_(bb[0]) * u0[1] + ac_; ac_ = lo2_(bb[1]) * u0[2] + ac_; ac_ = hi2_(bb[1]) * u0[3] + ac_; \
    ac_ = lo2_(bb[2]) * u1[0] + ac_; ac_ = hi2_(bb[2]) * u1[1] + ac_; ac_ = lo2_(bb[3]) * u1[2] + ac_; ac_ = hi2_(bb[3]) * u1[3] + ac_; \
    ac_ = lo2_(bb[4]) * u2[0] + ac_; ac_ = hi2_(bb[4]) * u2[1] + ac_; ac_ = lo2_(bb[5]) * u2[2] + ac_; ac_ = hi2_(bb[5]) * u2[3] + ac_; \
    ac_ = lo2_(bb[6]) * u3[0] + ac_; ac_ = hi2_(bb[6]) * u3[1] + ac_; ac_ = lo2_(bb[7]) * u3[2] + ac_; ac_ = hi2_(bb[7]) * u3[3] + ac_; \
    const float nr_ = ar * hr - ai * hi + ac_.x, ni_ = ar * hi + ai * hr + ac_.y; hr = nr_; hi = ni_; } while (0)

typedef short bf16x4_t __attribute__((ext_vector_type(4)));
#define MFMA16K16(a, b, c) __builtin_amdgcn_mfma_f32_16x16x16bf16_1k(a, b, c, 0, 0, 0)
__device__ __forceinline__ void s5_bu_block(const bf16* urow0, const bf16x4_t (&bcf)[8], LAS float* bul, int fr, int quad) {
    const bf16x4_t a = *(const bf16x4_t*)(urow0 + (size_t)fr * 1280 + quad * 4);
#pragma unroll
    for (int cb = 0; cb < 8; ++cb) { f32x4 d = {0.f, 0.f, 0.f, 0.f}; d = MFMA16K16(a, bcf[cb], d);
#pragma unroll
        for (int j = 0; j < 4; ++j) bul[(quad * 4 + j) * 130 + cb * 16 + fr] = d[j]; }
}
__device__ __forceinline__ void s5_local(const bf16* proj, const float* abar, const bf16* bbt, float* sloc, LAS float* bul, int slot, int nslots, int lane) {
    const int fr = lane & 15, quad = lane >> 4;
    for (int t = slot; t < 8192; t += nslots) {
        const int chunk = t & 63, g = (t >> 6) & 31, b = t >> 11;
        const float ar = abar[(g * 64 + lane) * 2], ai = abar[(g * 64 + lane) * 2 + 1];
        bf16x4_t bcf[8];
#pragma unroll
        for (int cb = 0; cb < 8; ++cb) bcf[cb] = *(const bf16x4_t*)(bbt + (size_t)(g * 128 + cb * 16 + fr) * 16 + quad * 4);
        float hr = 0.f, hi = 0.f;
        for (int blk = 0; blk < 4; ++blk) {
            s5_bu_block(proj + (size_t)(b * 4096 + chunk * 64 + blk * 16) * 1280 + g * 16, bcf, bul, fr, quad);
#pragma unroll 4
            for (int s = 0; s < 16; ++s) { const f32x2v bu = *(const LAS f32x2v*)(bul + s * 130 + 2 * lane); const float nr = ar * hr - ai * hi + bu.x, ni = ar * hi + ai * hr + bu.y; hr = nr; hi = ni; }
        }
        *(f32x2v*)(sloc + (size_t)t * 128 + lane * 2) = (f32x2v){hr, hi};
    }
}
__device__ __forceinline__ void s5_out(const bf16* proj, const float* abar, const bf16* bbt, const float* sloc, const float* st_re, const float* st_im, const float* c_re, const float* c_im,
                                       const float* dcoef, bf16* gbuf, float* out, LAS float* bul, LAS unsigned* hbuf, int slot, int nslots, int lane) {
    const int fr = lane & 15, quad = lane >> 4;
    for (int t = slot; t < 8192 + 256; t += nslots) {
        const int sample = t >= 8192; int b, g, chunk, nblk, rowbase;
        if (!sample) { chunk = t & 63; g = (t >> 6) & 31; b = t >> 11; nblk = 4; rowbase = b * 4096 + chunk * 64; } else { const int s = t - 8192; g = s & 31; b = s >> 5; chunk = 0; nblk = 2; rowbase = MP + b * 32; }
        const float ar = abar[(g * 64 + lane) * 2], ai = abar[(g * 64 + lane) * 2 + 1];
        bf16x4_t bcf[8];
#pragma unroll
        for (int cb = 0; cb < 8; ++cb) bcf[cb] = *(const bf16x4_t*)(bbt + (size_t)(g * 128 + cb * 16 + fr) * 16 + quad * 4);
        float hr, hi;
        if (!sample) { float pr = ar, pi = ai;
#pragma unroll
            for (int i = 0; i < 6; ++i) { const float t1 = pr * pr - pi * pi; pi = 2.f * pr * pi; pr = t1; }
            hr = 0.f; hi = 0.f; const float* sp = sloc + (size_t)(t - chunk) * 128 + lane * 2;
#pragma unroll 16
            for (int cc = 0; cc < chunk; ++cc) { const f32x2v sv = *(const f32x2v*)(sp + (size_t)cc * 128); const float nr = pr * hr - pi * hi + sv.x, ni = pr * hi + pi * hr + sv.y; hr = nr; hi = ni; } }
        else { hr = st_re[(b * 32 + g) * 64 + lane]; hi = st_im[(b * 32 + g) * 64 + lane]; }
        bf16x8 cf[4];
#pragma unroll
        for (int ks = 0; ks < 4; ++ks) { const f32x4 cr = *(const f32x4*)(c_re + (size_t)(g * 16 + fr) * 64 + ks * 16 + quad * 4), ci = *(const f32x4*)(c_im + (size_t)(g * 16 + fr) * 64 + ks * 16 + quad * 4);
            v4u w; w.x = pg8::cvt_pk_bf16(cr[0], -ci[0]); w.y = pg8::cvt_pk_bf16(cr[1], -ci[1]); w.z = pg8::cvt_pk_bf16(cr[2], -ci[2]); w.w = pg8::cvt_pk_bf16(cr[3], -ci[3]); cf[ks] = __builtin_bit_cast(bf16x8, w); }
        const float dco = dcoef[g * 16 + fr];
        for (int blk = 0; blk < nblk; ++blk) {
            const bf16* urow0 = proj + (size_t)(rowbase + blk * 16) * 1280 + g * 16;
            s5_bu_block(urow0, bcf, bul, fr, quad);
#pragma unroll 4
            for (int s = 0; s < 16; ++s) { const f32x2v bu = *(const LAS f32x2v*)(bul + s * 130 + 2 * lane); const float nr = ar * hr - ai * hi + bu.x, ni = ar * hi + ai * hr + bu.y; hr = nr; hi = ni; hbuf[s * 68 + lane] = pg8::cvt_pk_bf16(hr, hi); }
            f32x4 y = {0.f, 0.f, 0.f, 0.f};
#pragma unroll
            for (int ks = 0; ks < 4; ++ks) { const bf16x8 a = *(const LAS bf16x8*)(hbuf + fr * 68 + ks * 16 + quad * 4); y = MFMA16(a, cf[ks], y); }
#pragma unroll
            for (int j = 0; j < 4; ++j) { const int s = blk * 16 + quad * 4 + j; const float uu = bflo((unsigned)urow0[(size_t)(quad * 4 + j) * 1280 + fr]); const float yv = y[j] + dco * uu;
                const float z = 0.7978845608028654f * (yv + 0.044715f * yv * yv * yv); const float th = 1.0f - 2.0f / (1.0f + __expf(2.0f * z)); const float gl = 0.5f * yv * (1.0f + th);
                gbuf[(size_t)(rowbase + s) * 512 + g * 16 + fr] = (bf16)f2bf(gl); }
        }
        if (!sample && chunk == 63) { out[OFF_SRP + (b * 32 + g) * 64 + lane] = hr; out[OFF_SIP + (b * 32 + g) * 64 + lane] = hi; }
        if (sample) { out[OFF_SRS + (b * 32 + g) * 64 + lane] = hr; out[OFF_SIS + (b * 32 + g) * 64 + lane] = hi; }
    }
}

template <int KIND>
__device__ __forceinline__ void sample_gemm(const bf16* A, const bf16* Bt, int K, LAS unsigned char* lds, int tid, int wave, int lane,
                                            bf16* xbp, const float* base_f32, float* part_next, const float* part_cur, bf16* O) {
    const int fr = lane & 15, quad = lane >> 4;
    LAS f32x4* red = (LAS f32x4*)lds;
    LAS float* ssred = (LAS float*)(lds + 32768);
    for (int tile = blockIdx.x; tile < 256; tile += gridDim.x) {
        const int r0 = MP + (tile >> 4) * 16, c0 = (tile & 15) * 64, kw = K >> 3;
        const bf16* ap = A + (size_t)(r0 + fr) * K + wave * kw + quad * 8;
        const bf16* bp = Bt + (size_t)(c0 + fr) * K + wave * kw + quad * 8;
        f32x4 acc[4];
#pragma unroll
        for (int cb = 0; cb < 4; ++cb) acc[cb] = (f32x4){0.f, 0.f, 0.f, 0.f};
        const int nks = kw >> 5;
        for (int k0 = 0; k0 < nks; k0 += 4) {
            bf16x8 a[4], b[4][4];
#pragma unroll
            for (int i = 0; i < 4; ++i) { const int ks = (k0 + i < nks) ? k0 + i : nks - 1;
                a[i] = *(const bf16x8*)(ap + ks * 32);
#pragma unroll
                for (int cb = 0; cb < 4; ++cb) b[i][cb] = *(const bf16x8*)(bp + (size_t)cb * 16 * K + ks * 32); }
            __builtin_amdgcn_sched_barrier(0);
#pragma unroll
            for (int i = 0; i < 4; ++i) if (k0 + i < nks) {
#pragma unroll
                for (int cb = 0; cb < 4; ++cb) acc[cb] = MFMA16(b[i][cb], a[i], acc[cb]); }
        }
#pragma unroll
        for (int cb = 0; cb < 4; ++cb) red[(wave * 4 + cb) * 64 + lane] = acc[cb] * 1.0f;
        __syncthreads();
        if (tid < 256) { const int cb = tid >> 6, l2 = tid & 63; f32x4 v = red[cb * 64 + l2];
#pragma unroll
            for (int w = 1; w < 8; ++w) v = v + red[(w * 4 + cb) * 64 + l2];
            const int row = r0 + (l2 & 15), col = c0 + cb * 16 + 4 * (l2 >> 4); const size_t off = (size_t)row * 1024 + col;
            if (KIND == 0) { f32x4 bs;
                if (base_f32) bs = *(const f32x4*)(base_f32 + off);
                else { const u32x2v w = *(const u32x2v*)(xbp + off); bs = (f32x4){bflo(w.x), bfhi(w.x), bflo(w.y), bfhi(w.y)}; }
                v = v + bs; u32x2v o; o.x = pk2(v[0], v[1]); o.y = pk2(v[2], v[3]); *(u32x2v*)(xbp + off) = o;
                float ss = (v[0] * v[0] + v[1] * v[1]) + (v[2] * v[2] + v[3] * v[3]); ss += __shfl_xor(ss, 16); ss += __shfl_xor(ss, 32);
                if ((l2 >> 4) == 0) ssred[cb * 16 + (l2 & 15)] = ss; }
            else { const float rs = rstd_of(part_cur, row); u32x2v o; o.x = pk2(v[0] * rs, v[1] * rs); o.y = pk2(v[2] * rs, v[3] * rs); *(u32x2v*)(O + off) = o; }
        }
        if (KIND == 0) { __syncthreads(); if (tid < 16) part_next[(size_t)(r0 + tid) * 16 + (tile & 15)] = (ssred[tid] + ssred[16 + tid]) + (ssred[32 + tid] + ssred[48 + tid]); }
        __syncthreads();
    }
}

struct Params { const float* in[36]; float* out; unsigned char* ws; int use_cg, pad; };

__global__ void __launch_bounds__(512, 2) mega_fwd(Params P) {
    extern __shared__ __attribute__((aligned(16))) unsigned char lds_raw[];
    LAS unsigned char* lds = (LAS unsigned char*)lds_raw;
    volatile LAS unsigned* MISC = (volatile LAS unsigned*)(lds + MISC_OFF);
    const int G = gridDim.x, NGW = G * 8, NT = G * 512;
    const int wave_s = __builtin_amdgcn_readfirstlane(threadIdx.x >> 6);
    for (int u = threadIdx.x; u < (LDS_BYTES - 131072) / 4; u += 512) ((LAS unsigned*)(lds + 131072))[u] = 0u;
    __syncthreads();
    XcdBarrier bar = xcd_barrier_post((unsigned*)(P.ws + WS_BAR), MISC + 8);
#ifndef STOP_AFTER
#define STOP_AFTER 1000
#endif
    int ph = 0;
#define RUN (ph < STOP_AFTER)
#define FRESH() const int tid = fresh_tid(wave_s), lane = tid & 63, wave = __builtin_amdgcn_readfirstlane(tid >> 6); const int gw = blockIdx.x * 8 + wave, gt = blockIdx.x * 512 + tid; (void)gw; (void)gt; (void)lane; LAS float* wscr = (LAS float*)(lds + 32768 + wave * 12288); (void)wscr;
#define SEAM() do { if (P.use_cg) cg::this_grid().sync(); else xcd_barrier(bar); ++ph; } while (0)

#define part ((float*)(ws + WS_PART))
#define PARTBUF(k) (part + (size_t)((k) & 1) * PART_ELEMS)
#define ropec ((float*)(ws + WS_ROPE))
#define ropes (ropec + 4096 * 32)
#define abar ((float*)(ws + WS_SSM))
#define bbar (abar + 32 * 64 * 2)
#define bbt ((bf16*)(bbar + 32 * 64 * 32))
#define ckb ((bf16*)(ws + WS_CKV))
#define cvb (ckb + 8 * 128 * 128)
#define sloc ((float*)(ws + WS_SLOC))
#define memk ((bf16*)(ws + WS_MEMK))
#define memvT ((bf16*)(ws + WS_MEMVT))
#define SG ((float*)(ws + WS_SIDE))
#define SV ((float*)(ws + WS_SIDE + SG_BYTES))
#define WT ((bf16*)(ws + WS_WT))
#define xb ((bf16*)(ws + WS_XB))
#define tmp (ws + WS_TMP)
#define proj0 ((bf16*)(tmp + TMP_PROJ0))
#define gbuf ((bf16*)(tmp + TMP_GBUF))
#define ycat ((bf16*)(tmp + TMP_YCAT))
#define memb ((bf16*)(tmp + TMP_MEMB))
#define qx ((bf16*)(tmp + TMP_QX))
#define ox ((bf16*)(tmp + TMP_OX))
#define act ((bf16*)(tmp + TMP_ACT))
#define gbm ((bf16*)(tmp + TMP_GB))
#define zc ((bf16*)(tmp + TMP_ZC))
#define PTRS() unsigned char* ws = P.ws; float* out = P.out; asm volatile("" : "+s"(ws), "+s"(out));
    if (RUN) { PTRS() FRESH()
        {
            constexpr int NITEMS = 640 + 128 + 512 + 2 * 512 + 2 * 1024 + 2 * 512 + 2 * 2816 + 2 * 1408 + 1536 + 512 + 2048;
            for (int it = gw; it < NITEMS; it += NGW) { int r = it;
#define TR(Wp, K_, N_, WTp, gainp, sc, mode) { const int ni_ = ((K_) / 64) * ((N_) / 32); if (r < ni_) { tr_item(Wp, K_, N_, WTp, gainp, sc, mode, wscr, r, lane); continue; } r -= ni_; }
                TR(P.in[15], 1024, 1280, WT + WT_INEVEN, P.in[11], 1.f, 1)
                TR(P.in[25], 512, 512, WT + WT_GLU, nullptr, 1.f, 0)
                TR(P.in[16], 1024, 1024, WT + WT_OUTEVEN, nullptr, 1.f, 0)
                TR(P.in[30], 1024, 1024, WT + WT_WQ, P.in[12], 0.0625f, 0)
                TR(P.in[30] + 1048576, 1024, 1024, WT + WT_WQ + 1048576, P.in[12] + 1024, 0.0625f, 0)
                TR(P.in[31], 1024, 2048, WT + WT_WKV, nullptr, 1.f, 0)
                TR(P.in[31] + 2097152, 1024, 2048, WT + WT_WKV + 2097152, nullptr, 1.f, 0)
                TR(P.in[32], 1024, 1024, WT + WT_WO, nullptr, 1.f, 0)
                TR(P.in[32] + 1048576, 1024, 1024, WT + WT_WO + 1048576, nullptr, 1.f, 0)
                TR(P.in[33], 1024, 5632, WT + WT_UP, P.in[13], 1.f, 2)
                TR(P.in[33] + (size_t)1024 * 5632, 1024, 5632, WT + WT_UP + (size_t)5632 * 1024, P.in[13] + 1024, 1.f, 2)
                TR(P.in[35], 2816, 1024, WT + WT_DOWN, nullptr, 1.f, 0)
                TR(P.in[35] + (size_t)2816 * 1024, 2816, 1024, WT + WT_DOWN + (size_t)2816 * 1024, nullptr, 1.f, 0)
                TR(P.in[27], 1024, 3072, WT + WT_INODD, P.in[11] + 1024, 1.f, 3)
                TR(P.in[29], 1024, 1024, WT + WT_OUTODD, nullptr, 1.f, 0)
                { const int mi = r >> 7, l = mi >> 3, b = mi & 7; tr_item(P.in[10] + (size_t)mi * 262144, 256, 1024, memvT + (size_t)(l * 12 + 4 + b) * 262144, nullptr, 1.f, 0, wscr, r & 127, lane); }
            }
        }
        for (int m = gw; m < MROWS; m += NGW) { const float* xr = m < MP ? P.in[0] + (size_t)m * 1024 : P.in[1] + (size_t)(m - MP) * 1024; float ss = 0.f;
#pragma unroll
            for (int j = 0; j < 4; ++j) { const f32x4 v = *(const f32x4*)(xr + (lane + 64 * j) * 4); ss += (v[0] * v[0] + v[1] * v[1]) + (v[2] * v[2] + v[3] * v[3]);
                u32x2v w; w.x = pg8::cvt_pk_bf16(v[0], v[1]); w.y = pg8::cvt_pk_bf16(v[2], v[3]); *(u32x2v*)(xb + (size_t)m * 1024 + (lane + 64 * j) * 4) = w; }
            ss = wave_sum(ss); if (lane < 16) PARTBUF(0)[(size_t)m * 16 + lane] = lane == 0 ? ss : 0.f; }
        for (int i = gt; i < 262144; i += NT) { const f32x4 v = *(const f32x4*)(P.in[2] + (size_t)i * 4); u32x2v w; w.x = pg8::cvt_pk_bf16(v[0], v[1]); w.y = pg8::cvt_pk_bf16(v[2], v[3]); *(u32x2v*)(memb + (size_t)i * 4) = w; }
        for (int i = gt; i < 1048576; i += NT) { const size_t e = (size_t)i * 4; const int lb = (int)(e >> 18), l = lb >> 3, b = lb & 7; const f32x4 v = *(const f32x4*)(P.in[9] + e);
            u32x2v w; w.x = pg8::cvt_pk_bf16(v[0], v[1]); w.y = pg8::cvt_pk_bf16(v[2], v[3]); *(u32x2v*)(memk + (size_t)(l * 12 + 4 + b) * 262144 + (e & 262143)) = w; }
        for (int i = gt; i < 65536; i += NT) { const int j = i & 32767; const float* src = (i < 32768 ? P.in[3] : P.in[4]) + (size_t)j * 4; bf16* dst = (i < 32768 ? ckb : cvb) + (size_t)j * 4;
            const f32x4 v = *(const f32x4*)src; u32x2v w; w.x = pg8::cvt_pk_bf16(v[0], v[1]); w.y = pg8::cvt_pk_bf16(v[2], v[3]); *(u32x2v*)dst = w; }
        for (int i = gt; i < 4096 * 32; i += NT) { const int pos = i >> 5, d = i & 31; const double inv = dexp_(-(double)d * (9.210340371976184 / 32.0)); double s, c; dsincos_((double)pos * inv, s, c); ropec[i] = (float)c; ropes[i] = (float)s; }
        for (int i = gt; i < 2048; i += NT) { const double are = P.in[17][i], aim = P.in[18][i], dt = dexp_((double)P.in[19][i]); double s, c; dsincos_(aim * dt, s, c); const double mag = dexp_(are * dt);
            const double br = mag * c, bi = mag * s; abar[2 * i] = (float)br; abar[2 * i + 1] = (float)bi;
            const double nr = br - 1.0, ni = bi, den = are * are + aim * aim; const double qr = (nr * are + ni * aim) / den, qi = (ni * are - nr * aim) / den;
#pragma unroll 4
            for (int h = 0; h < 16; ++h) { const double xr = P.in[20][(size_t)i * 16 + h], xi = P.in[21][(size_t)i * 16 + h]; const float fre = (float)(qr * xr - qi * xi), fim = (float)(qr * xi + qi * xr); bbar[(size_t)i * 32 + 2 * h] = fre; bbar[(size_t)i * 32 + 2 * h + 1] = fim;
                bbt[((size_t)i * 2) * 16 + h] = (bf16)f2bf(fre); bbt[((size_t)i * 2 + 1) * 16 + h] = (bf16)f2bf(fim); } }
    }
    SEAM();
    if (RUN) { PTRS()
        if (G < 128 || (int)blockIdx.x >= G - 64) { pg8::Gemm g{memb, WT + WT_WKV, 1024, 4096, 1024}; pg8::StaticOrder S;
            if (G < 128) S.init(1024, 4096, G, (int)blockIdx.x); else S.init(1024, 4096, 64, (int)blockIdx.x - (G - 64)); EpiKV E{out, memk};
          pg8::gemm_phase<EpiKV, pg8::StaticOrder, true, true>(lds, g, S, E, wave_s); }
        { pg8::Gemm g{xb, WT + WT_INEVEN, MROWS, 1280, 1024}; pg8::StaticOrderF S; S.init(MROWS, 1280, G, (int)blockIdx.x); EpiIn0 E{proj0, PARTBUF(0), ropec, ropes, out};
          pg8::gemm_phase<EpiIn0, pg8::StaticOrderF, true, true>(lds, g, S, E, wave_s); }
    }
    SEAM();
    if (RUN) { PTRS() FRESH()
        swa_phase(proj0, ckb, cvb, P.in[26], ycat, lds, tid, wave, lane, G);
        s5_local(proj0, abar, bbt, sloc, wscr, wave * G + (int)blockIdx.x, NGW, lane);
        for (int it = wave * G + (int)blockIdx.x; it < 1024; it += NGW) { const int mi = it >> 7, l = mi >> 2, b = mi & 3;
            tr_item(out + OFF_MVP + (size_t)mi * 262144, 256, 1024, memvT + (size_t)(l * 12 + b) * 262144, nullptr, 1.f, 0, wscr, it & 127, lane); }
    }
    SEAM();
    if (RUN) { PTRS() FRESH() s5_out(proj0, abar, bbt, sloc, P.in[5], P.in[6], P.in[22], P.in[23], P.in[24], gbuf, out, (LAS float*)(lds + wave * 16384), (LAS unsigned*)(lds + wave * 16384 + 8448), wave * G + (int)blockIdx.x, NGW, lane); }
    SEAM();
    if (RUN) { PTRS() pg8::Gemm g{gbuf, WT + WT_GLU, MROWS, 512, 512}; pg8::StaticOrder S; S.init(MROWS, 512, G, (int)blockIdx.x); EpiGlu E{gbuf, ycat};
        pg8::gemm_phase<EpiGlu, pg8::StaticOrder, true, true>(lds, g, S, E, wave_s); }
    SEAM();

#pragma unroll
    for (int l = 0; l < 2; ++l) {
        if (l == 1) {
            if (RUN) { PTRS() pg8::Gemm g{xb, WT + WT_INODD, MROWS, 3072, 1024}; pg8::StaticOrderF S; S.init(MROWS, 3072, G, (int)blockIdx.x); EpiInOdd E{gbm, zc, PARTBUF(3), P.in[28], SG};
                pg8::gemm_phase<EpiInOdd, pg8::StaticOrderF, true, true>(lds, g, S, E, wave_s); }
            SEAM();
            if (RUN) { PTRS() FRESH()
                const float* cw = P.in[28]; const float* st = P.in[7];
                for (int i = gt; i < MROWS * 128; i += NT) { const int row = i >> 7, c0 = (i & 127) * 8, blk = row >> 6, r = row & 63;
                    const bool smp = row >= MP; const int rr = smp ? (r & 31) : r;
                    f32x4 z0, z1;
                    if (rr < 2) { const int sb = smp ? (r >> 5) * 4 : 0;
                        f32x4 pa0, pa1, pb0, pb1;
                        if (smp) { const int b = (blk - 256) * 2 + (r >> 5); const float* s0 = st + (size_t)(b * 2) * 1024 + c0; pa0 = *(const f32x4*)s0; pa1 = *(const f32x4*)(s0 + 4); pb0 = *(const f32x4*)(s0 + 1024); pb1 = *(const f32x4*)(s0 + 1028); }
                        else if ((blk & 63) == 0) { pa0 = pa1 = pb0 = pb1 = (f32x4){0.f, 0.f, 0.f, 0.f}; }
                        else { const float* s0 = SG + (size_t)((blk - 1) * 8 + 6) * 1024 + c0; pa0 = *(const f32x4*)s0; pa1 = *(const f32x4*)(s0 + 4); pb0 = *(const f32x4*)(s0 + 1024); pb1 = *(const f32x4*)(s0 + 1028); }
                        const float* sc = SG + (size_t)(blk * 8 + sb) * 1024 + c0; const f32x4 x00 = *(const f32x4*)sc, x01 = *(const f32x4*)(sc + 4);
                        f32x4 xm2a, xm2b, xm1a, xm1b, xca, xcb;
                        if (rr == 0) { xm2a = pa0; xm2b = pa1; xm1a = pb0; xm1b = pb1; xca = x00; xcb = x01; }
                        else { xm2a = pb0; xm2b = pb1; xm1a = x00; xm1b = x01; xca = *(const f32x4*)(sc + 1024); xcb = *(const f32x4*)(sc + 1028); }
                        const f32x4 w0a = *(const f32x4*)(cw + c0), w0b = *(const f32x4*)(cw + c0 + 4), w1a = *(const f32x4*)(cw + 1024 + c0), w1b = *(const f32x4*)(cw + 1028 + c0), w2a = *(const f32x4*)(cw + 2048 + c0), w2b = *(const f32x4*)(cw + 2052 + c0);
                        z0 = w0a * xm2a + w1a * xm1a + w2a * xca; z1 = w0b * xm2b + w1b * xm1b + w2b * xcb; }
                    else { const v4u zw = *(const v4u*)(zc + (size_t)row * 1024 + c0); z0 = (f32x4){bflo(zw.x), bfhi(zw.x), bflo(zw.y), bfhi(zw.y)}; z1 = (f32x4){bflo(zw.z), bfhi(zw.z), bflo(zw.w), bfhi(zw.w)}; }
                    const v4u gw_ = *(const v4u*)(gbm + (size_t)row * 1024 + c0);
                    const f32x4 g0 = (f32x4){bflo(gw_.x), bfhi(gw_.x), bflo(gw_.y), bfhi(gw_.y)}, g1 = (f32x4){bflo(gw_.z), bfhi(gw_.z), bflo(gw_.w), bfhi(gw_.w)};
                    *(v4u*)(gbm + (size_t)row * 1024 + c0) = pack8(g0 * z0, g1 * z1); }
                for (int i = gt; i < 4 * 2 * 1024; i += NT) { const int c = i & 1023, j = (i >> 10) & 1, b = i >> 11; out[OFF_CMP + i] = SG[(size_t)((64 * b + 63) * 8 + 6 + j) * 1024 + c]; }
                for (int i = gt; i < 8 * 2 * 1024; i += NT) { const int c = i & 1023, j = (i >> 10) & 1, b = i >> 11; out[OFF_CMS + i] = SG[(size_t)((256 + (b >> 1)) * 8 + (b & 1) * 4 + 2 + j) * 1024 + c]; }
            }
            SEAM();
        }
        if (RUN) { PTRS() pg8::Gemm g{(bf16*)(tmp + (size_t)(1 - l) * TMP_YCAT), WT + WT_OUTEVEN + (size_t)l * (WT_OUTODD - WT_OUTEVEN), MP, 1024, 1024}; pg8::StaticOrderF S; S.init(MP, 1024, G, (int)blockIdx.x);
            EpiRes E{P.in[0], P.in[1] - (size_t)MP * 1024, xb, PARTBUF(1 + 3 * l), l == 0 ? 1 : 0};
            pg8::gemm_phase<EpiRes, pg8::StaticOrderF, true, true>(lds, g, S, E, wave_s);
            { FRESH() sample_gemm<0>((bf16*)(tmp + (size_t)(1 - l) * TMP_YCAT), WT + WT_OUTEVEN + (size_t)l * (WT_OUTODD - WT_OUTEVEN), 1024, lds, tid, wave, lane, xb, l == 0 ? P.in[1] - (size_t)MP * 1024 : (const float*)nullptr, PARTBUF(1 + 3 * l), nullptr, nullptr); } }
        SEAM();
        if (RUN) { PTRS() pg8::Gemm g{xb, WT + WT_WQ + (size_t)l * 1048576, MP, 1024, 1024}; pg8::StaticOrderF S; S.init(MP, 1024, G, (int)blockIdx.x); EpiBf16 E{qx, 1024, PARTBUF(1 + 3 * l)};
            pg8::gemm_phase<EpiBf16, pg8::StaticOrderF, true, true>(lds, g, S, E, wave_s);
            { FRESH() sample_gemm<1>(xb, WT + WT_WQ + (size_t)l * 1048576, 1024, lds, tid, wave, lane, nullptr, nullptr, nullptr, PARTBUF(1 + 3 * l), qx); } }
        SEAM();
        if (RUN) { PTRS() FRESH() xattn_phase2(qx, memk + (size_t)l * 12 * 262144, memvT + (size_t)l * 12 * 262144, ox, lds, tid, wave, lane, G); }
        SEAM();
        if (RUN) { PTRS() pg8::Gemm g{ox, WT + WT_WO + (size_t)l * 1048576, MP, 1024, 1024}; pg8::StaticOrderF S; S.init(MP, 1024, G, (int)blockIdx.x); EpiRes E{P.in[0], P.in[0], xb, PARTBUF(2 + 3 * l), 0};
            pg8::gemm_phase<EpiRes, pg8::StaticOrderF, true, true>(lds, g, S, E, wave_s);
            { FRESH() sample_gemm<0>(ox, WT + WT_WO + (size_t)l * 1048576, 1024, lds, tid, wave, lane, xb, nullptr, PARTBUF(2 + 3 * l), nullptr, nullptr); } }
        SEAM();
        if (RUN) { PTRS() pg8::Gemm g{xb, WT + WT_UP + (size_t)l * 5632 * 1024, MROWS, 5632, 1024}; pg8::StaticOrderF S; S.init(MROWS, 5632, G, (int)blockIdx.x);
            EpiFfnUp E{act, PARTBUF(2 + 3 * l), P.in[34] + (size_t)l * 3 * DFF, SG, SV};
            pg8::gemm_phase<EpiFfnUp, pg8::StaticOrderF, true, true>(lds, g, S, E, wave_s); }
        SEAM();
        if (RUN) { PTRS() FRESH()
            const float* cw = P.in[34] + (size_t)l * 3 * DFF; const float* st = P.in[8] + (size_t)l * 8 * 2 * DFF;
            for (int i = gt; i < 528 * 352; i += NT) { const int fi = i / 352, c0 = (i % 352) * 8; int blk, row, rr, sb, vb; bool smp = fi >= 512;
                if (!smp) { blk = fi >> 1; rr = fi & 1; row = blk * 64 + rr; sb = 0; vb = 0; } else { const int s = fi - 512, half = (s >> 1) & 1; blk = 256 + (s >> 2); rr = s & 1; row = blk * 64 + half * 32 + rr; sb = half * 4; vb = half * 2; }
                f32x4 pa0, pa1, pb0, pb1;
                if (smp) { const int b = (blk - 256) * 2 + (sb >> 2); const float* s0 = st + (size_t)(b * 2) * DFF + c0; pa0 = *(const f32x4*)s0; pa1 = *(const f32x4*)(s0 + 4); pb0 = *(const f32x4*)(s0 + DFF); pb1 = *(const f32x4*)(s0 + DFF + 4); }
                else if ((blk & 63) == 0) { pa0 = pa1 = pb0 = pb1 = (f32x4){0.f, 0.f, 0.f, 0.f}; }
                else { const float* s0 = SG + (size_t)((blk - 1) * 8 + 6) * DFF + c0; pa0 = *(const f32x4*)s0; pa1 = *(const f32x4*)(s0 + 4); pb0 = *(const f32x4*)(s0 + DFF); pb1 = *(const f32x4*)(s0 + DFF + 4); }
                const float* sc = SG + (size_t)(blk * 8 + sb) * DFF + c0; const f32x4 x00 = *(const f32x4*)sc, x01 = *(const f32x4*)(sc + 4);
                f32x4 xm2a, xm2b, xm1a, xm1b, xca, xcb;
                if (rr == 0) { xm2a = pa0; xm2b = pa1; xm1a = pb0; xm1b = pb1; xca = x00; xcb = x01; }
                else { xm2a = pb0; xm2b = pb1; xm1a = x00; xm1b = x01; xca = *(const f32x4*)(sc + DFF); xcb = *(const f32x4*)(sc + DFF + 4); }
                const f32x4 w0a = *(const f32x4*)(cw + c0), w0b = *(const f32x4*)(cw + c0 + 4), w1a = *(const f32x4*)(cw + DFF + c0), w1b = *(const f32x4*)(cw + DFF + c0 + 4), w2a = *(const f32x4*)(cw + 2 * DFF + c0), w2b = *(const f32x4*)(cw + 2 * DFF + c0 + 4);
                const f32x4 ga = w0a * xm2a + w1a * xm1a + w2a * xca, gb_ = w0b * xm2b + w1b * xm1b + w2b * xcb;
                const float* sv = SV + (size_t)(blk * 4 + vb + rr) * DFF + c0; const f32x4 va = *(const f32x4*)sv, vb_ = *(const f32x4*)(sv + 4);
                f32x4 a0, a1;
#pragma unroll
                for (int j = 0; j < 4; ++j) { a0[j] = ga[j] * sigmoidf_(ga[j]) * va[j]; a1[j] = gb_[j] * sigmoidf_(gb_[j]) * vb_[j]; }
                *(v4u*)(act + (size_t)row * DFF + c0) = pack8(a0, a1); }
            for (int i = gt; i < 4 * 2 * DFF; i += NT) { const int c = i % DFF, j = (i / DFF) & 1, b = i / (2 * DFF); out[OFF_CFP + (size_t)l * 4 * 2 * DFF + i] = SG[(size_t)((64 * b + 63) * 8 + 6 + j) * DFF + c]; }
            for (int i = gt; i < 8 * 2 * DFF; i += NT) { const int c = i % DFF, j = (i / DFF) & 1, b = i / (2 * DFF); out[OFF_CFS + (size_t)l * 8 * 2 * DFF + i] = SG[(size_t)((256 + (b >> 1)) * 8 + (b & 1) * 4 + 2 + j) * DFF + c]; }
        }
        SEAM();
        if (RUN) { PTRS() pg8::Gemm g{act, WT + WT_DOWN + (size_t)l * 2816 * 1024, MP, 1024, DFF}; pg8::StaticOrderF S; S.init(MP, 1024, G, (int)blockIdx.x); EpiRes E{P.in[0], P.in[0], xb, PARTBUF(3 + 3 * l), 0};
            pg8::gemm_phase<EpiRes, pg8::StaticOrderF, true, true>(lds, g, S, E, wave_s);
            { FRESH() sample_gemm<0>(act, WT + WT_DOWN + (size_t)l * 2816 * 1024, DFF, lds, tid, wave, lane, xb, nullptr, PARTBUF(3 + 3 * l), nullptr, nullptr); } }
        SEAM();
    }
    if (RUN) { PTRS() FRESH()
        const float* gf = P.in[14];
        for (int m = gw; m < MROWS; m += NGW) { const float rs = rstd_of(PARTBUF(6), m); float* xr = out + (size_t)m * 1024; const bf16* xbr = xb + (size_t)m * 1024;
#pragma unroll
            for (int j = 0; j < 4; ++j) { const int c = (lane + 64 * j) * 4; const u32x2v w = *(const u32x2v*)(xbr + c); const f32x4 v = (f32x4){bflo(w.x), bfhi(w.x), bflo(w.y), bfhi(w.y)}, gg = *(const f32x4*)(gf + c); *(f32x4*)(xr + c) = v * rs * gg; } }
    }
}

extern "C" void kernel_launch(void* const* d_in, const int* in_sizes, int n_in, void* d_out, int out_size, void* d_ws, size_t ws_size, hipStream_t stream) {
    static int grid = 0;
    if (grid == 0) {
        int dev = 0, cus = 0, per_cu = 0;
        if (n_in != 36 || ws_size < 256 * MiB) { fprintf(stderr, "kernel_launch: unexpected n_in %d / ws %zu\n", n_in, ws_size); grid = -1; return; }
        (void)hipGetDevice(&dev); (void)hipDeviceGetAttribute(&cus, hipDeviceAttributeMultiprocessorCount, dev);
        if (hipFuncSetAttribute((const void*)mega_fwd, hipFuncAttributeMaxDynamicSharedMemorySize, LDS_BYTES) != hipSuccess) { fprintf(stderr, "kernel_launch: hipFuncSetAttribute failed\n"); grid = -1; return; }
        if (hipOccupancyMaxActiveBlocksPerMultiprocessor(&per_cu, (const void*)mega_fwd, 512, LDS_BYTES) != hipSuccess || per_cu < 1) per_cu = 1;
        (void)hipGetLastError();
        grid = cus * 1;
        if (grid > 256) grid = 256;
    }
    if (grid < 0) return;
    (void)hipMemsetAsync(d_ws, 0, CTL_ZERO_BYTES, stream);
    Params p{};
    for (int i = 0; i < 36; ++i) p.in[i] = (const float*)d_in[i];
    p.out = (float*)d_out; p.ws = (unsigned char*)d_ws; p.use_cg = 0; p.pad = 0;
    void* args[] = {&p};
    hipError_t e = hipLaunchCooperativeKernel((const void*)mega_fwd, dim3(grid), dim3(512), args, LDS_BYTES, stream);
    if (e != hipSuccess) fprintf(stderr, "cooperative launch failed: %s (grid %d)\n", hipGetErrorString(e), grid);
}
```

```cpp
#include <hip/hip_runtime.h>
#include <hip/hip_cooperative_groups.h>
#include <cstdio>
#include <cstdint>
namespace cg = cooperative_groups;
__device__ __forceinline__ int fresh_tid(int wave_s) { unsigned z = 0u; asm volatile("" : "+s"(z)); int t = wave_s * 64 + (int)__builtin_amdgcn_mbcnt_hi(~0u, __builtin_amdgcn_mbcnt_lo(~0u, z)); asm volatile("" : "+v"(t)); return t; }
namespace pg8 {
#define PG8_LAS __attribute__((address_space(3)))
typedef unsigned short bf16_t;
typedef short bf16x8 __attribute__((ext_vector_type(8)));
typedef float f32x4 __attribute__((ext_vector_type(4)));
typedef unsigned u32x4 __attribute__((ext_vector_type(4)));
constexpr int BM = 256, BK = 64, HALF = 128, HTB = HALF * BK * 2  , STAGE_BYTES = 8 * HTB, NXCD = 8, WGM = 8;

__host__ __device__ __forceinline__ int lds_byte(int r, int c) { const int st = (r >> 4) * 2 + (c >> 5), rr = r & 15, cc = c & 31, ob = rr * 64 + cc * 2; return st * 1024 + (ob ^ (((ob >> 9) & 1) << 5)); }
__host__ __device__ __forceinline__ void stage_rc(int b, int& R, int& C) { const int st = b / 1024, sb = b % 1024, swz = sb ^ (((sb >> 9) & 1) << 5); R = (st >> 1) * 16 + swz / 64; C = (st & 1) * 32 + (swz % 64) / 2; }
__host__ __device__ __forceinline__ int perm32(int rho) { const int n = rho >> 4, i = rho & 15; return 8 * (i >> 2) + 4 * n + (i & 3); }

struct Unit { int pm, pn; };
struct Gemm { const bf16_t* A; const bf16_t* Bt; int M, N, K; };

template <bool FULL> struct StaticOrderT {
    int nM, nN, nwg, G, c;
    __host__ __device__ void init(int M, int N, int G_, int c_) { nM = M / BM; nN = N / BM; nwg = nM * nN; G = G_; c = c_; }
    __host__ __device__ bool next(int i, Unit& u) const {
        const long L = (long)i * G + c; if (!(FULL && i == 0) && L >= nwg) return false;
        int wgid = (int)L; { const int q = nwg / NXCD, r = nwg % NXCD, xcd = wgid % NXCD, off = wgid / NXCD; wgid = (xcd < r ? xcd * (q + 1) : r * (q + 1) + (xcd - r) * q) + off; }
        const int nig = WGM * nN, gid = wgid / nig, fm = gid * WGM, gsz = (nM - fm) < WGM ? (nM - fm) : WGM;
        u.pm = fm + ((wgid % nig) % gsz); u.pn = (wgid % nig) / gsz; return true;
    }
    __device__ __forceinline__ void a_ready(const Unit&) const {}
    __device__ __forceinline__ void done(const Unit&) const {}
};

typedef StaticOrderT<false> StaticOrder; typedef StaticOrderT<true> StaticOrderF;
__device__ __forceinline__ unsigned cvt_pk_bf16(float lo, float hi) { unsigned r; asm volatile("v_cvt_pk_bf16_f32 %0, %1, %2" : "=v"(r) : "v"(lo), "v"(hi)); return r; }
typedef float f32x2 __attribute__((ext_vector_type(2)));
template <class Epi, class Sched, bool ALIGN_EPI = false, bool SP2 = false>
__device__ __forceinline__ void gemm_phase(PG8_LAS unsigned char* lds, const Gemm g, const Sched& S, const Epi& E, const int wave_s) {
    const int tid = fresh_tid(wave_s), wid = __builtin_amdgcn_readfirstlane(tid >> 6), lane = tid & 63, wr = wid >> 2, wc = wid & 3, fr = lane & 15, fq = lane >> 4;
    const int K = g.K, nt = K / BK;
    unsigned voffA[2], voffB[2];
#pragma unroll
    for (int i = 0; i < 2; ++i) { int R, C; stage_rc(tid * 16 + i * 8192, R, C); const int Rb = Epi::PERM ? ((R & ~31) + perm32(R & 31)) : R;
        voffA[i] = (unsigned)(R * K + C) * 2u; voffB[i] = (unsigned)(Rb * K + C) * 2u; }
    const size_t kstep = (size_t)(BK * 2);
    const size_t hstep = (size_t)HALF * K * 2;
    const size_t tstep = 2 * hstep;
    const unsigned ldsw = (unsigned)wid * 1024u;
    const int aoff = lds_byte(wr * 64 + fr, fq * 8), boff = lds_byte(wc * 32 + fr, fq * 8);
#define PG8_SA(b, h) (((b) * 2 + (h)) * HTB)
#define PG8_SB(b, h) ((4 + (b) * 2 + (h)) * HTB)
#define PG8_STAGE(bufoff, gbase, voff) do { _Pragma("unroll") for (int _i = 0; _i < 2; ++_i) \
        __builtin_amdgcn_global_load_lds((const unsigned*)((const char*)(gbase) + (voff)[_i]), (PG8_LAS unsigned*)(lds + (bufoff) + ldsw + _i * 8192), 16, 0, 0); } while (0)
#define PG8_LDA(dst, b, h) do { _Pragma("unroll") for (int m = 0; m < 4; ++m) _Pragma("unroll") for (int k = 0; k < 2; ++k) dst[m][k] = *(const PG8_LAS bf16x8*)(lds + PG8_SA(b, h) + aoff + m * 2048 + k * 1024); } while (0)
#define PG8_LDB(dst, b, h) do { _Pragma("unroll") for (int n = 0; n < 2; ++n) _Pragma("unroll") for (int k = 0; k < 2; ++k) dst[n][k] = *(const PG8_LAS bf16x8*)(lds + PG8_SB(b, h) + boff + n * 2048 + k * 1024); } while (0)
#define PG8_MMA(ai, bj, At, Bt) do { __builtin_amdgcn_s_setprio(1); _Pragma("unroll") for (int m = 0; m < 4; ++m) _Pragma("unroll") for (int n = 0; n < 2; ++n) _Pragma("unroll") for (int k = 0; k < 2; ++k) \
        acc[ai][bj][m][n] = __builtin_amdgcn_mfma_f32_16x16x32_bf16(Bt[n][k], At[m][k], acc[ai][bj][m][n], 0, 0, 0); __builtin_amdgcn_s_setprio(0); } while (0)
#define PG8_WAIT_V(n) asm volatile("s_waitcnt vmcnt(" #n ")" ::: "memory")
#define PG8_WAIT_L(n) asm volatile("s_waitcnt lgkmcnt(" #n ")" ::: "memory")
#define PG8_BAR __builtin_amdgcn_s_barrier()
#define PG8_SCHED __builtin_amdgcn_sched_barrier(0)
    Unit cur, nxt; int ui = 0;
    if (!S.next(0, cur)) return;
    f32x4 acc[2][2][4][2];
#pragma unroll
    for (int a = 0; a < 2; ++a)
#pragma unroll
        for (int b = 0; b < 2; ++b)
#pragma unroll
            for (int m = 0; m < 4; ++m)
#pragma unroll
                for (int n = 0; n < 2; ++n) acc[a][b][m][n] = (f32x4){0.f, 0.f, 0.f, 0.f};
    bf16x8 At[4][2], B0[2][2], B1[2][2];
    const char* cA = (const char*)g.A + (size_t)cur.pm * tstep; const char* cB = (const char*)g.Bt + (size_t)cur.pn * tstep;
    S.a_ready(cur);
    if constexpr (SP2) {
        PG8_STAGE(PG8_SB(0, 0), cB, voffB); PG8_STAGE(PG8_SB(0, 1), cB + hstep, voffB); PG8_STAGE(PG8_SA(0, 0), cA, voffA); PG8_STAGE(PG8_SA(0, 1), cA + hstep, voffA);
        if (wr == 1) PG8_BAR;
        PG8_WAIT_V(2); PG8_BAR;
        PG8_STAGE(PG8_SB(1, 0), cB + kstep, voffB); PG8_STAGE(PG8_SA(1, 0), cA + kstep, voffA); PG8_STAGE(PG8_SB(1, 1), cB + hstep + kstep, voffB);
        PG8_WAIT_V(6); PG8_BAR;
    } else {
        PG8_STAGE(PG8_SB(0, 0), cB, voffB); PG8_STAGE(PG8_SA(0, 0), cA, voffA); PG8_STAGE(PG8_SB(0, 1), cB + hstep, voffB); PG8_STAGE(PG8_SA(0, 1), cA + hstep, voffA);
        if (wr == 1) PG8_BAR;
        PG8_WAIT_V(4); PG8_BAR;
        PG8_STAGE(PG8_SB(1, 0), cB + kstep, voffB); PG8_STAGE(PG8_SA(1, 0), cA + kstep, voffA); PG8_STAGE(PG8_SB(1, 1), cB + hstep + kstep, voffB);
        PG8_WAIT_V(6); PG8_BAR;
    }
    for (;;) {
        const bool has_next = S.next(ui + 1, nxt);
        const char* nA = has_next ? (const char*)g.A + (size_t)nxt.pm * tstep : cA; const char* nB = has_next ? (const char*)g.Bt + (size_t)nxt.pn * tstep : cB;
        for (int t = 0; t < nt; t += 2) {
            const bool last = (t == nt - 2);
            const char* a1 = cA + (size_t)(t + 1) * kstep;
            const char* a2 = last ? nA : cA + (size_t)(t + 2) * kstep; const char* b2 = last ? nB : cB + (size_t)(t + 2) * kstep;
            const char* a3 = a2 + kstep; const char* b3 = b2 + kstep;
            if (last && has_next) S.a_ready(nxt);
            if constexpr (SP2) {
            PG8_LDB(B0, 0, 0); PG8_LDB(B1, 0, 1); PG8_SCHED; PG8_LDA(At, 0, 0); PG8_STAGE(PG8_SA(1, 1), a1 + hstep, voffA);
            PG8_WAIT_V(8); PG8_WAIT_L(0); PG8_BAR; PG8_MMA(0, 0, At, B0); PG8_MMA(0, 1, At, B1); PG8_BAR; PG8_SCHED;
            PG8_LDA(At, 0, 1); PG8_STAGE(PG8_SB(0, 0), b2, voffB); PG8_STAGE(PG8_SB(0, 1), b2 + hstep, voffB); PG8_STAGE(PG8_SA(0, 0), a2, voffA);
            PG8_WAIT_V(8); PG8_WAIT_L(0); PG8_BAR; PG8_MMA(1, 0, At, B0); PG8_MMA(1, 1, At, B1); PG8_BAR; PG8_SCHED;
            PG8_LDB(B0, 1, 0); PG8_LDB(B1, 1, 1); PG8_SCHED; PG8_LDA(At, 1, 0); PG8_STAGE(PG8_SA(0, 1), a2 + hstep, voffA);
            PG8_WAIT_V(8); PG8_WAIT_L(0); PG8_BAR; PG8_MMA(0, 0, At, B0); PG8_MMA(0, 1, At, B1); PG8_BAR; PG8_SCHED;
            PG8_LDA(At, 1, 1); PG8_STAGE(PG8_SB(1, 0), b3, voffB); PG8_STAGE(PG8_SB(1, 1), b3 + hstep, voffB); PG8_STAGE(PG8_SA(1, 0), a3, voffA);
            PG8_WAIT_V(8); PG8_WAIT_L(0); PG8_BAR; PG8_MMA(1, 0, At, B0); PG8_MMA(1, 1, At, B1); PG8_BAR; PG8_SCHED;
            } else {
            PG8_LDB(B0, 0, 0); PG8_SCHED; PG8_LDA(At, 0, 0); PG8_STAGE(PG8_SA(1, 1), a1 + hstep, voffA);
            PG8_WAIT_L(8); PG8_BAR; PG8_WAIT_L(0); PG8_MMA(0, 0, At, B0); PG8_BAR; PG8_SCHED;
            PG8_LDB(B1, 0, 1); PG8_STAGE(PG8_SB(0, 0), b2, voffB);
            PG8_BAR; PG8_WAIT_L(0); PG8_MMA(0, 1, At, B1); PG8_BAR;
            PG8_LDA(At, 0, 1); PG8_STAGE(PG8_SA(0, 0), a2, voffA);
            PG8_BAR; PG8_WAIT_L(0); PG8_MMA(1, 0, At, B0); PG8_BAR; PG8_SCHED;
            PG8_STAGE(PG8_SB(0, 1), b2 + hstep, voffB);
            PG8_WAIT_V(6); PG8_BAR; PG8_MMA(1, 1, At, B1); PG8_BAR;
            PG8_LDB(B0, 1, 0); PG8_SCHED; PG8_LDA(At, 1, 0); PG8_STAGE(PG8_SA(0, 1), a2 + hstep, voffA);
            PG8_WAIT_L(8); PG8_BAR; PG8_WAIT_L(0); PG8_MMA(0, 0, At, B0); PG8_BAR; PG8_SCHED;
            PG8_LDB(B1, 1, 1); PG8_STAGE(PG8_SB(1, 0), b3, voffB);
            PG8_BAR; PG8_WAIT_L(0); PG8_MMA(0, 1, At, B1); PG8_BAR;
            PG8_LDA(At, 1, 1); PG8_STAGE(PG8_SA(1, 0), a3, voffA);
            PG8_BAR; PG8_WAIT_L(0); PG8_MMA(1, 0, At, B0); PG8_BAR; PG8_SCHED;
            PG8_STAGE(PG8_SB(1, 1), b3 + hstep, voffB);
            PG8_WAIT_V(6); PG8_BAR; PG8_MMA(1, 1, At, B1); PG8_BAR;
            }
        }
        if constexpr (ALIGN_EPI) { if (wr == 0) PG8_BAR; }
        if constexpr (!Epi::AFTER_DRAIN) { E(acc, cur, wr, wc, fr, fq); S.done(cur); }
        if (!has_next) break;
#pragma unroll
        for (int a = 0; a < 2; ++a)
#pragma unroll
            for (int b = 0; b < 2; ++b)
#pragma unroll
                for (int m = 0; m < 4; ++m)
#pragma unroll
                    for (int n = 0; n < 2; ++n) acc[a][b][m][n] = (f32x4){0.f, 0.f, 0.f, 0.f};
        cur = nxt; cA = nA; cB = nB; ++ui;
        if constexpr (ALIGN_EPI) { if (wr == 1) PG8_BAR; }
    }
    PG8_WAIT_V(0);
    if constexpr (!ALIGN_EPI) { if (wr == 0) PG8_BAR; }
    PG8_BAR;
    if constexpr (Epi::AFTER_DRAIN) { E.fused(acc, cur, wr, wc, fr, fq, lds, wid, lane); S.done(cur); }
#undef PG8_SA
#undef PG8_SB
#undef PG8_STAGE
#undef PG8_LDA
#undef PG8_LDB
#undef PG8_MMA
#undef PG8_WAIT_V
#undef PG8_WAIT_L
#undef PG8_BAR
#undef PG8_SCHED
}
}
#define GAS __attribute__((address_space(1)))
#define LAS __attribute__((address_space(3)))
typedef unsigned short bf16;
typedef unsigned v4u __attribute__((ext_vector_type(4)));
typedef float f32x4 __attribute__((ext_vector_type(4)));
typedef short bf16x8 __attribute__((ext_vector_type(8)));
typedef GAS unsigned gu32;
typedef GAS unsigned long long gu64;
#define RLX_AGENT __ATOMIC_RELAXED, __HIP_MEMORY_SCOPE_AGENT
#define LDS_WAIT() asm volatile("s_waitcnt lgkmcnt(0)" ::: "memory")
#define VM_WAIT() asm volatile("s_waitcnt vmcnt(0)" ::: "memory")
__device__ __forceinline__ unsigned long long rt() { return __builtin_amdgcn_s_memrealtime(); }
__device__ __forceinline__ unsigned f2bf(float f) { unsigned u = __builtin_bit_cast(unsigned, f); return (u + 0x7fffu + ((u >> 16) & 1u)) >> 16; }
__device__ __forceinline__ unsigned pk2(float lo, float hi) { return f2bf(lo) | (f2bf(hi) << 16); }

#define XB_TMO      128
#define XB_XCNT(j)  (256  + 64 * (j))
#define XB_XSUB(j)  (1280 + 64 * (j))
#define XB_XGEN(j)  (2304 + 64 * (j))
#define XB_TOP      3328
#define XB_TOPGEN   3392
#define XCD_BAR_WORDS 3456
#define XB_SPIN_CAP (1u << 18)

__device__ __forceinline__ unsigned xb_ld(unsigned* p)              { return __hip_atomic_load(p, __ATOMIC_RELAXED, __HIP_MEMORY_SCOPE_AGENT); }
__device__ __forceinline__ unsigned xb_add(unsigned* p, unsigned v) { return __hip_atomic_fetch_add(p, v, __ATOMIC_RELAXED, __HIP_MEMORY_SCOPE_AGENT); }
__device__ __forceinline__ unsigned xb_xcc_id() { return (unsigned)__builtin_amdgcn_s_getreg((3 << 11) | 20) & 0xFu; }
#define XB_SPIN(cond, bar) do { unsigned _sp = 0; while (cond) { __builtin_amdgcn_s_sleep(1); \
    if ((++_sp & 255u) == 0u) { if (xb_ld(&(bar)[XB_TMO])) break; if (_sp > XB_SPIN_CAP) { atomicAdd(&(bar)[XB_TMO], 1u); break; } } } } while (0)

struct XcdBarrier {
    unsigned* bar; unsigned x;
    volatile LAS unsigned* st;
};

__device__ __forceinline__ XcdBarrier xcd_barrier_post(unsigned* bar, volatile LAS unsigned* st) {
    XcdBarrier b; b.bar = bar; b.x = xb_xcc_id(); b.st = st;
    if (threadIdx.x == 0) (void)xb_add(&bar[XB_XCNT(b.x)], 1u);
    return b;
}
__device__ __forceinline__ void xcd_barrier_complete(unsigned* bar, unsigned x, unsigned& nloc, unsigned& nx) {
    const unsigned G = gridDim.x * gridDim.y * gridDim.z;
    unsigned sum, cnt, mine, sp = 0u;
    for (;;) {
        sum = 0u; cnt = 0u; mine = 0u;
#pragma unroll
        for (unsigned j = 0; j < 16; ++j) { const unsigned c = xb_ld(&bar[XB_XCNT(j)]); sum += c; cnt += (c > 0u) ? 1u : 0u; mine = (j == x) ? c : mine; }
        if (sum == G) break;
        __builtin_amdgcn_s_sleep(1);
        if ((++sp & 255u) == 0u) { if (xb_ld(&bar[XB_TMO])) break; if (sp > XB_SPIN_CAP) { atomicAdd(&bar[XB_TMO], 1u); break; } }
    }
    nloc = mine > 0u ? mine : 1u; nx = cnt > 0u ? cnt : 1u;
}

__device__ __forceinline__ void xcd_barrier(const XcdBarrier& b) {
    asm volatile("s_waitcnt vmcnt(0)" ::: "memory");
    __syncthreads();
    if (threadIdx.x == 0) {
        unsigned* bar = b.bar;
        __builtin_amdgcn_s_waitcnt(0);
        unsigned nloc = b.st[0], nx = b.st[1];
        if (nloc == 0u) { xcd_barrier_complete(bar, b.x, nloc, nx); b.st[0] = nloc; b.st[1] = nx; }
        const unsigned old = xb_add(&bar[XB_XSUB(b.x)], 1u);
        const unsigned gen = old / nloc;
        if (old + 1u == (gen + 1u) * nloc) {
            __builtin_amdgcn_fence(__ATOMIC_RELEASE, "agent");
            asm volatile("s_waitcnt vmcnt(0)" ::: "memory");
            const unsigned og = xb_add(&bar[XB_TOP], 1u);
            const unsigned tg = og / nx;
            if (og + 1u == (tg + 1u) * nx) xb_add(&bar[XB_TOPGEN], 1u);
            else XB_SPIN(xb_ld(&bar[XB_TOPGEN]) == tg, bar);
            __builtin_amdgcn_fence(__ATOMIC_ACQUIRE, "agent");
            xb_add(&bar[XB_XGEN(b.x)], 1u);
            asm volatile("s_waitcnt vmcnt(0)" ::: "memory");
        } else {
            XB_SPIN(xb_ld(&bar[XB_XGEN(b.x)]) == gen, bar);
            __builtin_amdgcn_fence(__ATOMIC_ACQUIRE, "agent");
            asm volatile("s_waitcnt vmcnt(0)" ::: "memory");
        }
    }
    __syncthreads();
}
typedef unsigned u32x2v __attribute__((ext_vector_type(2)));
typedef float f32x2v __attribute__((ext_vector_type(2)));

constexpr int MP = 16384, MROWS = 16640, DMODEL = 1024, DFF = 2816, NBLK64 = MROWS / 64;
constexpr float RMS_EPS = 1e-6f;
constexpr size_t OFF_Y = 0, OFF_WKP = (size_t)MROWS * 1024, OFF_WVP = OFF_WKP + 65536, OFF_SRP = OFF_WVP + 65536, OFF_SIP = OFF_SRP + 8192,
    OFF_CMP = OFF_SIP + 8192, OFF_CFP = OFF_CMP + 8192, OFF_MKP = OFF_CFP + 45056, OFF_MVP = OFF_MKP + 2097152, OFF_WKS = OFF_MVP + 2097152,
    OFF_WVS = OFF_WKS + 32768, OFF_SRS = OFF_WVS + 32768, OFF_SIS = OFF_SRS + 16384, OFF_CMS = OFF_SIS + 16384, OFF_CFS = OFF_CMS + 16384;
constexpr size_t MiB = 1u << 20;
constexpr size_t WS_ROWSS = 0, WS_BAR = 512 * 1024, CTL_ZERO_BYTES = 1 * MiB;
constexpr size_t WS_ROPE = 1 * MiB, WS_SSM = 2 * MiB, WS_CKV = 3 * MiB, WS_SLOC = 4 * MiB, WS_MEMK = 8 * MiB, WS_MEMVT = 20 * MiB, WS_SIDE = 32 * MiB;
constexpr size_t SG_BYTES = (size_t)NBLK64 * 8 * DFF * 4, SV_BYTES = (size_t)NBLK64 * 4 * DFF * 4;
static_assert(WS_SIDE + SG_BYTES + SV_BYTES <= 66 * MiB, "side buffers");
constexpr size_t WS_WT = 66 * MiB, WS_XB = 128 * MiB, WS_TMP = 161 * MiB;
constexpr size_t WT_INEVEN = 0, WT_GLU = WT_INEVEN + 1280 * 1024, WT_OUTEVEN = WT_GLU + 512 * 512, WT_WQ = WT_OUTEVEN + 1024 * 1024, WT_WKV = WT_WQ + 2 * 1024 * 1024,
    WT_WO = WT_WKV + 2 * 2048 * 1024, WT_UP = WT_WO + 2 * 1024 * 1024, WT_DOWN = WT_UP + (size_t)2 * 5632 * 1024, WT_INODD = WT_DOWN + (size_t)2 * 2816 * 1024,
    WT_OUTODD = WT_INODD + 3072 * 1024, WT_END = WT_OUTODD + 1024 * 1024;
static_assert(WS_WT + WT_END * 2 <= WS_XB, "weights");
static_assert(WS_XB + (size_t)MROWS * 1024 * 2 <= WS_TMP, "xb");
constexpr size_t TMP_BYTES = (size_t)MROWS * DFF * 2;
constexpr size_t WS_PART = 251 * MiB, PART_ELEMS = (size_t)MROWS * 16;
static_assert(WS_PART + 2 * PART_ELEMS * 4 <= 256 * MiB, "part");
static_assert(WS_TMP + TMP_BYTES <= 256 * MiB, "ws");
constexpr size_t TMP_PROJ0 = 0, TMP_GBUF = (size_t)MROWS * 1280 * 2, TMP_YCAT = TMP_GBUF + (size_t)MROWS * 512 * 2, TMP_MEMB = TMP_YCAT;
static_assert(TMP_YCAT + (size_t)MROWS * 1024 * 2 <= TMP_BYTES, "tmp");
constexpr size_t TMP_QX = 0, TMP_OX = (size_t)MROWS * 1024 * 2, TMP_ACT = 0, TMP_GB = 0, TMP_ZC = (size_t)MROWS * 1024 * 2;
constexpr int LDS_BYTES = 147456, MISC_OFF = 147456 - 512;
constexpr int NPH = 22;

#define MFMA16(a, b, c) __builtin_amdgcn_mfma_f32_16x16x32_bf16(a, b, c, 0, 0, 0)
__device__ __forceinline__ float bflo(unsigned w) { return __uint_as_float(w << 16); }
__device__ __forceinline__ float bfhi(unsigned w) { return __uint_as_float(w & 0xffff0000u); }
__device__ __forceinline__ v4u pack8(f32x4 a, f32x4 b) { v4u w; w.x = pg8::cvt_pk_bf16(a[0], a[1]); w.y = pg8::cvt_pk_bf16(a[2], a[3]); w.z = pg8::cvt_pk_bf16(b[0], b[1]); w.w = pg8::cvt_pk_bf16(b[2], b[3]); return w; }
__device__ __forceinline__ float rstd_of(const float* part, int row) { const f32x4* p = (const f32x4*)(part + (size_t)row * 16); const f32x4 a = p[0] + p[1] + p[2] + p[3]; return rsqrtf(((a[0] + a[1]) + (a[2] + a[3])) * (1.0f / 1024.0f) + RMS_EPS); }
__device__ __forceinline__ float sigmoidf_(float x) { return 1.0f / (1.0f + __expf(-x)); }
__device__ __forceinline__ float dpp_ror1(float v) { return __builtin_bit_cast(float, __builtin_amdgcn_update_dpp(0, __builtin_bit_cast(int, v), 0x121, 0xf, 0xf, false)); }
__device__ __forceinline__ float dpp_ror2(float v) { return __builtin_bit_cast(float, __builtin_amdgcn_update_dpp(0, __builtin_bit_cast(int, v), 0x122, 0xf, 0xf, false)); }
__device__ __forceinline__ float wave_sum(float v) {
#pragma unroll
    for (int o = 1; o < 64; o <<= 1) v += __shfl_xor(v, o);
    return v;
}

typedef pg8::Unit Unit;
#define EPI_ARGS const f32x4 (&acc)[2][2][4][2], const Unit& u, int wr, int wc, int fr, int fq

struct EpiBf16 {
    static constexpr bool PERM = true, AFTER_DRAIN = false;
    bf16* O; int ldc; const float* rowss;
    __device__ __forceinline__ void operator()(EPI_ARGS) const {
        const int row0 = u.pm * 256 + wr * 64 + fr, col0 = u.pn * 256 + wc * 32 + 8 * fq;
#pragma unroll
        for (int ai = 0; ai < 2; ++ai)
#pragma unroll
            for (int m = 0; m < 4; ++m) { const int row = row0 + ai * 128 + m * 16; const float rs = rstd_of(rowss, row); bf16* rp = O + (size_t)row * ldc + col0;
#pragma unroll
                for (int bj = 0; bj < 2; ++bj) *(v4u*)(rp + bj * 128) = pack8(acc[ai][bj][m][0] * rs, acc[ai][bj][m][1] * rs); }
    }
};
struct EpiRes {
    static constexpr bool PERM = true, AFTER_DRAIN = false;
    const float* base_p; const float* base_s; bf16* xb; float* rowss_next; int f32base;
    __device__ __forceinline__ void operator()(EPI_ARGS) const {
        const float* base = u.pm < 64 ? base_p : base_s;
        const int row0 = u.pm * 256 + wr * 64 + fr, col0 = u.pn * 256 + wc * 32 + 8 * fq;
#pragma unroll
        for (int ai = 0; ai < 2; ++ai)
#pragma unroll
            for (int m = 0; m < 4; ++m) { const int row = row0 + ai * 128 + m * 16; const size_t off = (size_t)row * 1024 + col0; float ss = 0.f;
#pragma unroll
                for (int bj = 0; bj < 2; ++bj) { f32x4 b0, b1;
                    if (f32base) { b0 = *(const f32x4*)(base + off + bj * 128); b1 = *(const f32x4*)(base + off + bj * 128 + 4); }
                    else { const v4u w = *(const v4u*)(xb + off + bj * 128); b0 = (f32x4){bflo(w.x), bfhi(w.x), bflo(w.y), bfhi(w.y)}; b1 = (f32x4){bflo(w.z), bfhi(w.z), bflo(w.w), bfhi(w.w)}; }
                    const f32x4 v0 = acc[ai][bj][m][0] + b0, v1 = acc[ai][bj][m][1] + b1;
                    *(v4u*)(xb + off + bj * 128) = pack8(v0, v1);
                    ss += (v0[0] * v0[0] + v0[1] * v0[1]) + (v0[2] * v0[2] + v0[3] * v0[3]) + (v1[0] * v1[0] + v1[1] * v1[1]) + (v1[2] * v1[2] + v1[3] * v1[3]); }
                ss += __shfl_xor(ss, 16); ss += __shfl_xor(ss, 32);
                if (fq == 0) rowss_next[(size_t)row * 16 + u.pn * 4 + wc] = ss; }
    }
};
struct EpiGlu {
    static constexpr bool PERM = true, AFTER_DRAIN = false;
    const bf16* g; bf16* ycat;
    __device__ __forceinline__ void operator()(EPI_ARGS) const {
        const int row0 = u.pm * 256 + wr * 64 + fr, col0 = u.pn * 256 + wc * 32 + 8 * fq;
#pragma unroll
        for (int ai = 0; ai < 2; ++ai)
#pragma unroll
            for (int m = 0; m < 4; ++m) { const int row = row0 + ai * 128 + m * 16;
#pragma unroll
                for (int bj = 0; bj < 2; ++bj) { const int col = col0 + bj * 128; const v4u gw = *(const v4u*)(g + (size_t)row * 512 + col);
                    const f32x4 a0 = acc[ai][bj][m][0], a1 = acc[ai][bj][m][1]; f32x4 o0, o1;
                    o0[0] = bflo(gw.x) * sigmoidf_(a0[0]); o0[1] = bfhi(gw.x) * sigmoidf_(a0[1]); o0[2] = bflo(gw.y) * sigmoidf_(a0[2]); o0[3] = bfhi(gw.y) * sigmoidf_(a0[3]);
                    o1[0] = bflo(gw.z) * sigmoidf_(a1[0]); o1[1] = bfhi(gw.z) * sigmoidf_(a1[1]); o1[2] = bflo(gw.w) * sigmoidf_(a1[2]); o1[3] = bfhi(gw.w) * sigmoidf_(a1[3]);
                    *(v4u*)(ycat + (size_t)row * 1024 + col) = pack8(o0, o1); } }
    }
};
struct EpiKV {
    static constexpr bool PERM = true, AFTER_DRAIN = false;
    float* out; bf16* memk;
    __device__ __forceinline__ void operator()(EPI_ARGS) const {
        const int row0 = u.pm * 256 + wr * 64 + fr, col0 = u.pn * 256 + wc * 32 + 8 * fq;
#pragma unroll
        for (int ai = 0; ai < 2; ++ai)
#pragma unroll
            for (int m = 0; m < 4; ++m) { const int row = row0 + ai * 128 + m * 16;
#pragma unroll
                for (int bj = 0; bj < 2; ++bj) { const int c = col0 + bj * 128, l = c >> 11, e = c & 2047, isv = e >> 10, dc = e & 1023;
                    float* op = out + (isv ? OFF_MVP : OFF_MKP) + (size_t)l * 1048576 + (size_t)row * 1024 + dc;
                    *(f32x4*)op = acc[ai][bj][m][0]; *(f32x4*)(op + 4) = acc[ai][bj][m][1];
                    if (!isv) *(v4u*)(memk + (size_t)l * 12 * 262144 + (size_t)row * 1024 + dc) = pack8(acc[ai][bj][m][0], acc[ai][bj][m][1]); } }
    }
};
struct EpiIn0 {
    static constexpr bool PERM = true, AFTER_DRAIN = false;
    bf16* proj; const float* rowss; const float* ropec; const float* ropes; float* out;
    __device__ __forceinline__ void operator()(EPI_ARGS) const {
        const int pn = u.pn;
#pragma unroll
        for (int ai = 0; ai < 2; ++ai)
#pragma unroll
            for (int m = 0; m < 4; ++m) { const int row = u.pm * 256 + ai * 128 + wr * 64 + m * 16 + fr; const float rs = rstd_of(rowss, row);
                const int pos = row < MP ? (row & 4095) : 2048 + (row & 31);
                bf16* rp = proj + (size_t)row * 1280;
                float* wk = nullptr; float* wv = nullptr;
                if (pn == 4) { if (row >= MP) { wk = out + OFF_WKS + (size_t)(row - MP) * 128; wv = out + OFF_WVS + (size_t)(row - MP) * 128; }
                               else if ((row & 4095) >= 3968) { const size_t o = (size_t)((row >> 12) * 128 + (row & 4095) - 3968) * 128; wk = out + OFF_WKP + o; wv = out + OFF_WVP + o; } }
#pragma unroll
                for (int bj = 0; bj < 2; ++bj) { const f32x4 v0 = acc[ai][bj][m][0] * rs, v1 = acc[ai][bj][m][1] * rs;
                    const bool rope = (pn == 2 || pn == 3 || (pn == 4 && bj == 0));
                    if (!rope) { const int col = pn * 256 + bj * 128 + wc * 32 + 8 * fq; *(v4u*)(rp + col) = pack8(v0, v1);
                        if (pn == 4 && wv) { *(f32x4*)(wv + wc * 32 + 8 * fq) = v0; *(f32x4*)(wv + wc * 32 + 8 * fq + 4) = v1; } }
                    else { const int gbase = pn * 256 + bj * 128 + (wc >> 1) * 64, d1 = 16 * (wc & 1) + 4 * fq;
                        const f32x4 c4 = *(const f32x4*)(ropec + pos * 32 + d1), s4 = *(const f32x4*)(ropes + pos * 32 + d1);
                        f32x4 o1 = v0 * c4 - v1 * s4, o2 = v1 * c4 + v0 * s4;
                        if (pn != 4) { o1 = o1 * 0.125f; o2 = o2 * 0.125f; }
                        u32x2v w1, w2; w1.x = pg8::cvt_pk_bf16(o1[0], o1[1]); w1.y = pg8::cvt_pk_bf16(o1[2], o1[3]); w2.x = pg8::cvt_pk_bf16(o2[0], o2[1]); w2.y = pg8::cvt_pk_bf16(o2[2], o2[3]);
                        *(u32x2v*)(rp + gbase + d1) = w1; *(u32x2v*)(rp + gbase + d1 + 32) = w2;
                        if (pn == 4 && wk) { const int cc = (wc >> 1) * 64 + d1; *(f32x4*)(wk + cc) = o1; *(f32x4*)(wk + cc + 32) = o2; } } } }
    }
};
struct EpiFfnUp {
    static constexpr bool PERM = true, AFTER_DRAIN = false;
    bf16* act; const float* rowss; const float* cw; float* SG; float* SV;
    __device__ __forceinline__ void operator()(EPI_ARGS) const {
        const int c0 = u.pn * 128 + wc * 32 + 8 * fq; const bool sample = u.pm == 64;
        const f32x4 w0a = *(const f32x4*)(cw + c0), w0b = *(const f32x4*)(cw + c0 + 4), w1a = *(const f32x4*)(cw + DFF + c0), w1b = *(const f32x4*)(cw + DFF + c0 + 4),
                    w2a = *(const f32x4*)(cw + 2 * DFF + c0), w2b = *(const f32x4*)(cw + 2 * DFF + c0 + 4);
#pragma unroll
        for (int ai = 0; ai < 2; ++ai) { f32x4 gp0 = {0.f, 0.f, 0.f, 0.f}, gp1 = {0.f, 0.f, 0.f, 0.f}; const int blk = u.pm * 4 + ai * 2 + wr;
#pragma unroll
            for (int m = 0; m < 4; ++m) { const int row = u.pm * 256 + ai * 128 + wr * 64 + m * 16 + fr; const float rs = rstd_of(rowss, row);
                const f32x4 g0 = acc[ai][0][m][0] * rs, g1 = acc[ai][0][m][1] * rs, v0 = acc[ai][1][m][0] * rs, v1 = acc[ai][1][m][1] * rs;
                f32x4 p1a, p2a, p1b, p2b;
#pragma unroll
                for (int j = 0; j < 4; ++j) { const float s1a = fr == 15 ? gp0[j] : g0[j], s2a = fr >= 14 ? gp0[j] : g0[j], s1b = fr == 15 ? gp1[j] : g1[j], s2b = fr >= 14 ? gp1[j] : g1[j];
                    p1a[j] = dpp_ror1(s1a); p2a[j] = dpp_ror2(s2a); p1b[j] = dpp_ror1(s1b); p2b[j] = dpp_ror2(s2b); }
                const f32x4 ca = w0a * p2a + w1a * p1a + w2a * g0, cb = w0b * p2b + w1b * p1b + w2b * g1;
                f32x4 sa, sb;
#pragma unroll
                for (int j = 0; j < 4; ++j) { sa[j] = sigmoidf_(ca[j]); sb[j] = sigmoidf_(cb[j]); }
                const f32x4 a0 = ca * sa * v0, a1 = cb * sb * v1;
                const bool valid = (m > 0 || fr >= 2) && !(sample && m == 2 && fr < 2);
                if (valid) *(v4u*)(act + (size_t)row * DFF + c0) = pack8(a0, a1);
                if ((m & 1) == 0 && fr < 2) { float* sg = SG + (size_t)(blk * 8 + 2 * m + fr) * DFF + c0; *(f32x4*)sg = g0; *(f32x4*)(sg + 4) = g1;
                                              float* sv = SV + (size_t)(blk * 4 + m + fr) * DFF + c0; *(f32x4*)sv = v0; *(f32x4*)(sv + 4) = v1; }
                if ((m & 1) == 1 && fr >= 14) { float* sg = SG + (size_t)(blk * 8 + 2 * m + fr - 14) * DFF + c0; *(f32x4*)sg = g0; *(f32x4*)(sg + 4) = g1; }
                gp0 = g0; gp1 = g1; } }
    }
};
struct EpiInOdd {
    static constexpr bool PERM = true, AFTER_DRAIN = false;
    bf16* gb; bf16* zc; const float* rowss; const float* cw; float* SG;
    __device__ __forceinline__ void operator()(EPI_ARGS) const {
        if (u.pn < 4) {
            const int row0 = u.pm * 256 + wr * 64 + fr, col0 = u.pn * 256 + wc * 32 + 8 * fq;
#pragma unroll
            for (int ai = 0; ai < 2; ++ai)
#pragma unroll
                for (int m = 0; m < 4; ++m) { const int row = row0 + ai * 128 + m * 16; const float rs = rstd_of(rowss, row); bf16* rp = gb + (size_t)row * 1024 + col0;
#pragma unroll
                    for (int bj = 0; bj < 2; ++bj) *(v4u*)(rp + bj * 128) = pack8(acc[ai][bj][m][0] * rs, acc[ai][bj][m][1] * rs); }
            return;
        }
        const int c0 = (u.pn - 4) * 128 + wc * 32 + 8 * fq; const bool sample = u.pm == 64;
        const f32x4 w0a = *(const f32x4*)(cw + c0), w0b = *(const f32x4*)(cw + c0 + 4), w1a = *(const f32x4*)(cw + 1024 + c0), w1b = *(const f32x4*)(cw + 1024 + c0 + 4),
                    w2a = *(const f32x4*)(cw + 2048 + c0), w2b = *(const f32x4*)(cw + 2048 + c0 + 4);
#pragma unroll
        for (int ai = 0; ai < 2; ++ai) { f32x4 gp0 = {0.f, 0.f, 0.f, 0.f}, gp1 = {0.f, 0.f, 0.f, 0.f}; const int blk = u.pm * 4 + ai * 2 + wr;
#pragma unroll
            for (int m = 0; m < 4; ++m) { const int row = u.pm * 256 + ai * 128 + wr * 64 + m * 16 + fr; const float rs = rstd_of(rowss, row); const float rs2 = rs * rs;
                const f32x4 g0 = acc[ai][0][m][0] * acc[ai][1][m][0] * rs2, g1 = acc[ai][0][m][1] * acc[ai][1][m][1] * rs2;
                f32x4 p1a, p2a, p1b, p2b;
#pragma unroll
                for (int j = 0; j < 4; ++j) { const float s1a = fr == 15 ? gp0[j] : g0[j], s2a = fr >= 14 ? gp0[j] : g0[j], s1b = fr == 15 ? gp1[j] : g1[j], s2b = fr >= 14 ? gp1[j] : g1[j];
                    p1a[j] = dpp_ror1(s1a); p2a[j] = dpp_ror2(s2a); p1b[j] = dpp_ror1(s1b); p2b[j] = dpp_ror2(s2b); }
                const f32x4 a0 = w0a * p2a + w1a * p1a + w2a * g0, a1 = w0b * p2b + w1b * p1b + w2b * g1;
                const bool valid = (m > 0 || fr >= 2) && !(sample && m == 2 && fr < 2);
                if (valid) *(v4u*)(zc + (size_t)row * 1024 + c0) = pack8(a0, a1);
                if ((m & 1) == 0 && fr < 2) { float* sg = SG + (size_t)(blk * 8 + 2 * m + fr) * 1024 + c0; *(f32x4*)sg = g0; *(f32x4*)(sg + 4) = g1; }
                if ((m & 1) == 1 && fr >= 14) { float* sg = SG + (size_t)(blk * 8 + 2 * m + fr - 14) * 1024 + c0; *(f32x4*)sg = g0; *(f32x4*)(sg + 4) = g1; }
                gp0 = g0; gp1 = g1; } }
    }
};

__device__ __forceinline__ int rowmap(int mode, int n) {
    if (mode == 1) { if (n >= 512 && n < 1152) { const int d = n & 63; return (n & ~63) | (32 * ((d >> 4) & 1) + 8 * ((d >> 2) & 3) + 4 * (d >> 5) + (d & 3)); } return n; }
    if (mode == 2) { return n < DFF ? ((n >> 7) * 256 + (n & 127)) : (((n - DFF) >> 7) * 256 + 128 + ((n - DFF) & 127)); }
    if (mode == 3) { if (n < 1024) return n; const int c = (n - 1024) & 1023, z = n >= 2048 ? 1 : 0; return 1024 + (c >> 7) * 256 + z * 128 + (c & 127); }
    return n;
}
__device__ __forceinline__ void tr_item(const float* W, int K, int N, bf16* WT, const float* gain, float scale, int mode, LAS float* scr, int item, int lane) {
    const int nblk = N / 32, kb = item / nblk, nb = item % nblk, k0 = 64 * kb, n0 = 32 * nb;
#pragma unroll
    for (int i = 0; i < 8; ++i) { const int idx = lane + 64 * i, kk = idx >> 3, n4 = (idx & 7) * 4; const float gs = gain ? gain[k0 + kk] * scale : scale;
        const f32x4 w = *(const f32x4*)(W + (size_t)(k0 + kk) * N + n0 + n4); LAS float* d = scr + kk * 33 + n4; d[0] = w[0] * gs; d[1] = w[1] * gs; d[2] = w[2] * gs; d[3] = w[3] * gs; }
    LDS_WAIT(); asm volatile("" ::: "memory");
    const int c = lane & 7;
#pragma unroll
    for (int j = 0; j < 4; ++j) { const int n = (lane >> 3) + 8 * j; const LAS float* s = scr + (8 * c) * 33 + n;
        v4u o; o.x = pg8::cvt_pk_bf16(s[0 * 33], s[1 * 33]); o.y = pg8::cvt_pk_bf16(s[2 * 33], s[3 * 33]); o.z = pg8::cvt_pk_bf16(s[4 * 33], s[5 * 33]); o.w = pg8::cvt_pk_bf16(s[6 * 33], s[7 * 33]);
        *(v4u*)(WT + (size_t)rowmap(mode, n0 + n) * K + k0 + 8 * c) = o; }
    LDS_WAIT(); asm volatile("" ::: "memory");
}
__device__ __forceinline__ double dexp_(double y) {
    const double k = rint(y * 1.4426950408889634); const double r = (y - k * 0.6931471803691238) - k * 1.9082149292705877e-10;
    double p = 1.0 / 6227020800.0;
    p = p * r + 1.0 / 479001600.0; p = p * r + 1.0 / 39916800.0; p = p * r + 1.0 / 3628800.0; p = p * r + 1.0 / 362880.0; p = p * r + 1.0 / 40320.0; p = p * r + 1.0 / 5040.0;
    p = p * r + 1.0 / 720.0; p = p * r + 1.0 / 120.0; p = p * r + 1.0 / 24.0; p = p * r + 1.0 / 6.0; p = p * r + 0.5; p = p * r + 1.0; p = p * r + 1.0;
    const long long bits = (long long)(1023 + (int)k) << 52; return p * __builtin_bit_cast(double, bits);
}
__device__ __forceinline__ void dsincos_(double x, double& s, double& c) {
    const double k = rint(x * 0.6366197723675814); const double r = (x - k * 1.5707963267948966) - k * 6.123233995736766e-17; const double r2 = r * r;
    const double sp = r * (1.0 + r2 * (-1.0 / 6.0 + r2 * (1.0 / 120.0 + r2 * (-1.0 / 5040.0 + r2 * (1.0 / 362880.0 + r2 * (-1.0 / 39916800.0 + r2 * (1.0 / 6227020800.0)))))));
    const double cp = 1.0 + r2 * (-0.5 + r2 * (1.0 / 24.0 + r2 * (-1.0 / 720.0 + r2 * (1.0 / 40320.0 + r2 * (-1.0 / 3628800.0 + r2 * (1.0 / 479001600.0 + r2 * (-1.0 / 87178291200.0)))))));
    const int q = ((int)k) & 3;
    s = q == 0 ? sp : q == 1 ? cp : q == 2 ? -sp : -cp; c = q == 0 ? cp : q == 1 ? -sp : q == 2 ? -cp : sp;
}

__device__ __forceinline__ const bf16* kvptr(const bf16* proj, const bf16* cb, int sample, int b, int c, int kvh, int kk, int isv) {
    if (!sample) { int pos = (c - 2) * 64 + kk; pos = pos < 0 ? 0 : pos; return proj + (size_t)(b * 4096 + pos) * 1280 + 1024 + isv * 128 + kvh * 64; }
    if (kk < 128) return cb + (size_t)(b * 128 + kk) * 128 + kvh * 64;
    int t = kk - 128; t = t > 31 ? 31 : t; return proj + (size_t)(MP + b * 32 + t) * 1280 + 1024 + isv * 128 + kvh * 64;
}
__device__ __forceinline__ void swa_phase(const bf16* proj, const bf16* ckb, const bf16* cvb, const float* sinks, bf16* ycat, LAS unsigned char* lds, int tid, int wave, int lane, int G) {
    LAS bf16* VT = (LAS bf16*)lds;
    const int fr = lane & 15, quad = lane >> 4;
    for (int it = blockIdx.x; it < 528; it += G) {
        int b, c, kvh, sample;
        if (it < 512) { sample = 0; b = it >> 7; c = (it >> 1) & 63; kvh = it & 1; } else { sample = 1; b = (it - 512) >> 1; c = 0; kvh = it & 1; }
        __syncthreads();
#pragma unroll
        for (int i = 0; i < 3; ++i) { const int idx = tid + 512 * i, kk = idx % 192, dg = idx / 192; const v4u w = *(const v4u*)(kvptr(proj, cvb, sample, b, c, kvh, kk, 1) + dg * 8);
            LAS bf16* vp = VT + (dg * 8) * 200 + kk;
            vp[0] = (bf16)(w.x & 0xffffu); vp[200] = (bf16)(w.x >> 16); vp[400] = (bf16)(w.y & 0xffffu); vp[600] = (bf16)(w.y >> 16);
            vp[800] = (bf16)(w.z & 0xffffu); vp[1000] = (bf16)(w.z >> 16); vp[1200] = (bf16)(w.w & 0xffffu); vp[1400] = (bf16)(w.w >> 16); }
        __syncthreads();
        const int gq = wave >> 1, qhalf = wave & 1, head = kvh * 4 + gq;
        if (!(sample && qhalf)) {
            const int plo = sample ? 0 : (c >= 2 ? 0 : (2 - c) * 2), phi = sample ? 5 : 6;
            bf16x8 qf[2][2];
#pragma unroll
            for (int qb = 0; qb < 2; ++qb) { const int q = qhalf * 32 + qb * 16 + fr; const int row = sample ? MP + b * 32 + (q & 31) : b * 4096 + c * 64 + q;
                const bf16* qp = proj + (size_t)row * 1280 + 512 + head * 64 + quad * 8; qf[qb][0] = *(const bf16x8*)qp; qf[qb][1] = *(const bf16x8*)(qp + 32); }
            f32x4 s[12][2];
#pragma unroll
            for (int kb = 0; kb < 12; ++kb) { const int key = 32 * (kb >> 1) + (fr >> 2) * 8 + 4 * (kb & 1) + (fr & 3); const bf16* kp = kvptr(proj, ckb, sample, b, c, kvh, key, 0) + quad * 8;
                const bf16x8 k0 = *(const bf16x8*)kp, k1 = *(const bf16x8*)(kp + 32);
#pragma unroll
                for (int qb = 0; qb < 2; ++qb) { f32x4 a = {0.f, 0.f, 0.f, 0.f}; a = MFMA16(k0, qf[qb][0], a); a = MFMA16(k1, qf[qb][1], a); s[kb][qb] = a; } }
            const float sink = sinks[head];
            bf16x8 pf[6][2];
#pragma unroll
            for (int qb = 0; qb < 2; ++qb) { float mx = sink;
#pragma unroll
                for (int kb = 0; kb < 12; ++kb) { const bool pv = (kb >> 1) >= plo && (kb >> 1) < phi;
#pragma unroll
                    for (int j = 0; j < 4; ++j) { const float v = pv ? s[kb][qb][j] : -1e30f; s[kb][qb][j] = v; mx = fmaxf(mx, v); } }
                mx = fmaxf(mx, __shfl_xor(mx, 16)); mx = fmaxf(mx, __shfl_xor(mx, 32));
                float sum = 0.f;
#pragma unroll
                for (int kb = 0; kb < 12; ++kb)
#pragma unroll
                    for (int j = 0; j < 4; ++j) { const float e = __expf(s[kb][qb][j] - mx); s[kb][qb][j] = e; sum += e; }
                sum += __shfl_xor(sum, 16); sum += __shfl_xor(sum, 32); sum += __expf(sink - mx);
                const float inv = 1.0f / sum;
#pragma unroll
                for (int pr = 0; pr < 6; ++pr) pf[pr][qb] = __builtin_bit_cast(bf16x8, pack8(s[2 * pr][qb] * inv, s[2 * pr + 1][qb] * inv)); }
#pragma unroll
            for (int db = 0; db < 4; ++db) { bf16x8 vf[6];
#pragma unroll
                for (int pr = 0; pr < 6; ++pr) vf[pr] = *(const LAS bf16x8*)(VT + (db * 16 + fr) * 200 + 32 * pr + quad * 8);
#pragma unroll
                for (int qb = 0; qb < 2; ++qb) { f32x4 o = {0.f, 0.f, 0.f, 0.f};
#pragma unroll
                    for (int pr = 0; pr < 6; ++pr) o = MFMA16(pf[pr][qb], vf[pr], o);
#pragma unroll
                    for (int j = 0; j < 4; ++j) { const int q = qhalf * 32 + qb * 16 + quad * 4 + j;
                        if (!sample || q < 32) { const int row = sample ? MP + b * 32 + q : b * 4096 + c * 64 + q; ycat[(size_t)row * 1024 + 512 + head * 64 + db * 16 + fr] = (bf16)f2bf(o[j]); } } } }
        }
    }
    __syncthreads();
}

__device__ __forceinline__ void xattn_phase(const bf16* qx, const bf16* memk_l, const bf16* memvT_l, bf16* ox, int wave, int lane, int G) {
    const int fr = lane & 15, quad = lane >> 4;
    for (int t = wave * G + (int)blockIdx.x; t < 4160; t += 8 * G) {
        int bb, h, row0;
        if (t < 4096) { const int pair = t >> 8; bb = pair >> 2; h = pair & 3; row0 = bb * 4096 + (t & 255) * 16; }
        else { const int s = t - 4096, b = s >> 3; h = (s >> 1) & 3; bb = 4 + b; row0 = MP + b * 32 + (s & 1) * 16; }
        bf16x8 qf[8];
#pragma unroll
        for (int ks = 0; ks < 8; ++ks) qf[ks] = *(const bf16x8*)(qx + (size_t)(row0 + fr) * 1024 + h * 256 + ks * 32 + quad * 8);
        const bf16* kbase = memk_l + (size_t)bb * 262144 + h * 256 + quad * 8;
        f32x4 s[16];
#pragma unroll
        for (int kb = 0; kb < 16; ++kb) { const int key = 32 * (kb >> 1) + (fr >> 2) * 8 + 4 * (kb & 1) + (fr & 3); const bf16* kp = kbase + (size_t)key * 1024; f32x4 a = {0.f, 0.f, 0.f, 0.f};
#pragma unroll
            for (int ks = 0; ks < 8; ++ks) a = MFMA16(*(const bf16x8*)(kp + ks * 32), qf[ks], a);
            s[kb] = a; }
        float mx = -1e30f;
#pragma unroll
        for (int kb = 0; kb < 16; ++kb)
#pragma unroll
            for (int j = 0; j < 4; ++j) mx = fmaxf(mx, s[kb][j]);
        mx = fmaxf(mx, __shfl_xor(mx, 16)); mx = fmaxf(mx, __shfl_xor(mx, 32));
        float sum = 0.f;
#pragma unroll
        for (int kb = 0; kb < 16; ++kb)
#pragma unroll
            for (int j = 0; j < 4; ++j) { const float e = __expf(s[kb][j] - mx); s[kb][j] = e; sum += e; }
        sum += __shfl_xor(sum, 16); sum += __shfl_xor(sum, 32);
        const float inv = 1.0f / sum;
        bf16x8 pf[8];
#pragma unroll
        for (int pr = 0; pr < 8; ++pr) pf[pr] = __builtin_bit_cast(bf16x8, pack8(s[2 * pr] * inv, s[2 * pr + 1] * inv));
        const bf16* vbase = memvT_l + (size_t)bb * 262144 + (size_t)(h * 256 + fr) * 256 + quad * 8;
#pragma unroll 4
        for (int db = 0; db < 16; ++db) { f32x4 o = {0.f, 0.f, 0.f, 0.f};
#pragma unroll
            for (int pr = 0; pr < 8; ++pr) o = MFMA16(pf[pr], *(const bf16x8*)(vbase + (size_t)db * 4096 + pr * 32), o);
#pragma unroll
            for (int j = 0; j < 4; ++j) ox[(size_t)(row0 + quad * 4 + j) * 1024 + h * 256 + db * 16 + fr] = (bf16)f2bf(o[j]); }
    }
}


__device__ __forceinline__ void xstage(const bf16* src, size_t rowstride, LAS unsigned char* lds, int tid) {
    v4u t[16];
#pragma unroll
    for (int i = 0; i < 16; ++i) { const int row = (tid >> 5) + 16 * i, ch = tid & 31; t[i] = *(const GAS v4u*)((const GAS bf16*)src + (size_t)row * rowstride + ch * 8); }
#pragma unroll
    for (int i = 0; i < 16; ++i) { const int row = (tid >> 5) + 16 * i, ch = tid & 31; *(LAS v4u*)(lds + row * 528 + ch * 16) = t[i]; }
}
__device__ __forceinline__ void xattn_phase2(const bf16* qx, const bf16* memk_l, const bf16* memvT_l, bf16* ox, LAS unsigned char* lds, int tid, int wave, int lane, int G) {
    const int fr = lane & 15, quad = lane >> 4;
    for (int it = blockIdx.x; it < 256 + 32; it += G) {
        int bb, h, rowbase, nqb; bool active;
        if (it < 256) { bb = it >> 6; h = (it >> 4) & 3; rowbase = bb * 4096 + (it & 15) * 256; nqb = 2; active = true; }
        else { const int s = it - 256, b = s >> 2; h = s & 3; bb = 4 + b; rowbase = MP + b * 32; nqb = 1; active = wave < 2; }
        __syncthreads();
        xstage(memk_l + (size_t)bb * 262144 + h * 256, 1024, lds, tid);
        __syncthreads();
        bf16x8 pf[2][8];
#pragma unroll
        for (int qi = 0; qi < 2; ++qi) {
            if (qi < nqb && active) {
                const int row0 = rowbase + qi * 128 + wave * 16;
                bf16x8 qf[8];
#pragma unroll
                for (int ks = 0; ks < 8; ++ks) qf[ks] = *(const GAS bf16x8*)((const GAS bf16*)qx + (size_t)(row0 + fr) * 1024 + h * 256 + ks * 32 + quad * 8);
                f32x4 s[16];
#pragma unroll
                for (int kb = 0; kb < 16; ++kb) { const int key = 32 * (kb >> 1) + (fr >> 2) * 8 + 4 * (kb & 1) + (fr & 3); const LAS unsigned char* kp = lds + key * 528 + quad * 16; f32x4 a = {0.f, 0.f, 0.f, 0.f};
#pragma unroll
                    for (int ks = 0; ks < 8; ++ks) a = MFMA16(*(const LAS bf16x8*)(kp + ks * 64), qf[ks], a);
                    s[kb] = a; }
                float mx = -1e30f;
#pragma unroll
                for (int kb = 0; kb < 16; ++kb)
#pragma unroll
                    for (int j = 0; j < 4; ++j) mx = fmaxf(mx, s[kb][j]);
                mx = fmaxf(mx, __shfl_xor(mx, 16)); mx = fmaxf(mx, __shfl_xor(mx, 32));
                float sum = 0.f;
#pragma unroll
                for (int kb = 0; kb < 16; ++kb)
#pragma unroll
                    for (int j = 0; j < 4; ++j) { const float e = __expf(s[kb][j] - mx); s[kb][j] = e; sum += e; }
                sum += __shfl_xor(sum, 16); sum += __shfl_xor(sum, 32);
                const float inv = 1.0f / sum;
#pragma unroll
                for (int pr = 0; pr < 8; ++pr) pf[qi][pr] = __builtin_bit_cast(bf16x8, pack8(s[2 * pr] * inv, s[2 * pr + 1] * inv));
            }
        }
        __syncthreads();
        xstage(memvT_l + (size_t)bb * 262144 + (size_t)h * 65536, 256, lds, tid);
        __syncthreads();
#pragma unroll
        for (int qi = 0; qi < 2; ++qi) {
            if (qi < nqb && active) {
                const int row0 = rowbase + qi * 128 + wave * 16;
#pragma unroll 4
                for (int db = 0; db < 16; ++db) { f32x4 o = {0.f, 0.f, 0.f, 0.f}; const LAS unsigned char* vp = lds + (db * 16 + fr) * 528 + quad * 16;
#pragma unroll
                    for (int pr = 0; pr < 8; ++pr) o = MFMA16(*(const LAS bf16x8*)(vp + pr * 64), pf[qi][pr], o);
                    u32x2v w; w.x = pk2(o[0], o[1]); w.y = pk2(o[2], o[3]);
                    *(GAS u32x2v*)((GAS bf16*)ox + (size_t)(row0 + fr) * 1024 + h * 256 + db * 16 + quad * 4) = w; }
            }
        }
    }
    __syncthreads();
}

__device__ __forceinline__ void s5_stage_u(const bf16* up, LAS float* ubuf, int lane) {
    const v4u w0 = *(const v4u*)up, w1 = *(const v4u*)(up + 8);
    LAS f32x4* d = (LAS f32x4*)(ubuf + lane * 16);
    d[0] = (f32x4){bflo(w0.x), bfhi(w0.x), bflo(w0.y), bfhi(w0.y)}; d[1] = (f32x4){bflo(w0.z), bfhi(w0.z), bflo(w0.w), bfhi(w0.w)};
    d[2] = (f32x4){bflo(w1.x), bfhi(w1.x), bflo(w1.y), bfhi(w1.y)}; d[3] = (f32x4){bflo(w1.z), bfhi(w1.z), bflo(w1.w), bfhi(w1.w)};
}
__device__ __forceinline__ f32x2v lo2_(f32x4 v) { return __builtin_shufflevector(v, v, 0, 1); }
__device__ __forceinline__ f32x2v hi2_(f32x4 v) { return __builtin_shufflevector(v, v, 2, 3); }
#define S5_STEP(sidx) do { const LAS f32x4* up_ = (const LAS f32x4*)(ubuf + (sidx) * 16); const f32x4 u0 = up_[0], u1 = up_[1], u2 = up_[2], u3 = up_[3]; \
    f32x2v ac_ = lo2_(bb[0]) * u0[0]; ac_ = hi2_(bb[0]) * u0[1] + ac_; ac_ = lo2_(bb[1]) * u0[2] + ac_; ac_ = hi2_(bb[1]) * u0[3] + ac_; \
    ac_ = lo2_(bb[2]) * u1[0] + ac_; ac_ = hi2_(bb[2]) * u1[1] + ac_; ac_ = lo2_(bb[3]) * u1[2] + ac_; ac_ = hi2_(bb[3]) * u1[3] + ac_; \
    ac_ = lo2_(bb[4]) * u2[0] + ac_; ac_ = hi2_(bb[4]) * u2[1] + ac_; ac_ = lo2_(bb[5]) * u2[2] + ac_; ac_ = hi2_(bb[5]) * u2[3] + ac_; \
    ac_ = lo2_(bb[6]) * u3[0] + ac_; ac_ = hi2_(bb[6]) * u3[1] + ac_; ac_ = lo2_(bb[7]) * u3[2] + ac_; ac_ = hi2_(bb[7]) * u3[3] + ac_; \
    const float nr_ = ar * hr - ai * hi + ac_.x, ni_ = ar * hi + ai * hr + ac_.y; hr = nr_; hi = ni_; } while (0)

typedef short bf16x4_t __attribute__((ext_vector_type(4)));
#define MFMA16K16(a, b, c) __builtin_amdgcn_mfma_f32_16x16x16bf16_1k(a, b, c, 0, 0, 0)
__device__ __forceinline__ void s5_bu_block(const bf16* urow0, const bf16x4_t (&bcf)[8], LAS float* bul, int fr, int quad) {
    const bf16x4_t a = *(const bf16x4_t*)(urow0 + (size_t)fr * 1280 + quad * 4);
#pragma unroll
    for (int cb = 0; cb < 8; ++cb) { f32x4 d = {0.f, 0.f, 0.f, 0.f}; d = MFMA16K16(a, bcf[cb], d);
#pragma unroll
        for (int j = 0; j < 4; ++j) bul[(quad * 4 + j) * 130 + cb * 16 + fr] = d[j]; }
}
__device__ __forceinline__ void s5_local(const bf16* proj, const float* abar, const bf16* bbt, float* sloc, LAS float* bul, int slot, int nslots, int lane) {
    const int fr = lane & 15, quad = lane >> 4;
    for (int t = slot; t < 8192; t += nslots) {
        const int chunk = t & 63, g = (t >> 6) & 31, b = t >> 11;
        const float ar = abar[(g * 64 + lane) * 2], ai = abar[(g * 64 + lane) * 2 + 1];
        bf16x4_t bcf[8];
#pragma unroll
        for (int cb = 0; cb < 8; ++cb) bcf[cb] = *(const bf16x4_t*)(bbt + (size_t)(g * 128 + cb * 16 + fr) * 16 + quad * 4);
        float hr = 0.f, hi = 0.f;
        for (int blk = 0; blk < 4; ++blk) {
            s5_bu_block(proj + (size_t)(b * 4096 + chunk * 64 + blk * 16) * 1280 + g * 16, bcf, bul, fr, quad);
#pragma unroll 4
            for (int s = 0; s < 16; ++s) { const f32x2v bu = *(const LAS f32x2v*)(bul + s * 130 + 2 * lane); const float nr = ar * hr - ai * hi + bu.x, ni = ar * hi + ai * hr + bu.y; hr = nr; hi = ni; }
        }
        *(f32x2v*)(sloc + (size_t)t * 128 + lane * 2) = (f32x2v){hr, hi};
    }
}
__device__ __forceinline__ void s5_out(const bf16* proj, const float* abar, const bf16* bbt, const float* sloc, const float* st_re, const float* st_im, const float* c_re, const float* c_im,
                                       const float* dcoef, bf16* gbuf, float* out, LAS float* bul, LAS unsigned* hbuf, int slot, int nslots, int lane) {
    const int fr = lane & 15, quad = lane >> 4;
    for (int t = slot; t < 8192 + 256; t += nslots) {
        const int sample = t >= 8192; int b, g, chunk, nblk, rowbase;
        if (!sample) { chunk = t & 63; g = (t >> 6) & 31; b = t >> 11; nblk = 4; rowbase = b * 4096 + chunk * 64; } else { const int s = t - 8192; g = s & 31; b = s >> 5; chunk = 0; nblk = 2; rowbase = MP + b * 32; }
        const float ar = abar[(g * 64 + lane) * 2], ai = abar[(g * 64 + lane) * 2 + 1];
        bf16x4_t bcf[8];
#pragma unroll
        for (int cb = 0; cb < 8; ++cb) bcf[cb] = *(const bf16x4_t*)(bbt + (size_t)(g * 128 + cb * 16 + fr) * 16 + quad * 4);
        float hr, hi;
        if (!sample) { float pr = ar, pi = ai;
#pragma unroll
            for (int i = 0; i < 6; ++i) { const float t1 = pr * pr - pi * pi; pi = 2.f * pr * pi; pr = t1; }
            hr = 0.f; hi = 0.f; const float* sp = sloc + (size_t)(t - chunk) * 128 + lane * 2;
#pragma unroll 16
            for (int cc = 0; cc < chunk; ++cc) { const f32x2v sv = *(const f32x2v*)(sp + (size_t)cc * 128); const float nr = pr * hr - pi * hi + sv.x, ni = pr * hi + pi * hr + sv.y; hr = nr; hi = ni; } }
        else { hr = st_re[(b * 32 + g) * 64 + lane]; hi = st_im[(b * 32 + g) * 64 + lane]; }
        bf16x8 cf[4];
#pragma unroll
        for (int ks = 0; ks < 4; ++ks) { const f32x4 cr = *(const f32x4*)(c_re + (size_t)(g * 16 + fr) * 64 + ks * 16 + quad * 4), ci = *(const f32x4*)(c_im + (size_t)(g * 16 + fr) * 64 + ks * 16 + quad * 4);
            v4u w; w.x = pg8::cvt_pk_bf16(cr[0], -ci[0]); w.y = pg8::cvt_pk_bf16(cr[1], -ci[1]); w.z = pg8::cvt_pk_bf16(cr[2], -ci[2]); w.w = pg8::cvt_pk_bf16(cr[3], -ci[3]); cf[ks] = __builtin_bit_cast(bf16x8, w); }
        const float dco = dcoef[g * 16 + fr];
        for (int blk = 0; blk < nblk; ++blk) {
            const bf16* urow0 = proj + (size_t)(rowbase + blk * 16) * 1280 + g * 16;
            s5_bu_block(urow0, bcf, bul, fr, quad);
#pragma unroll 4
            for (int s = 0; s < 16; ++s) { const f32x2v bu = *(const LAS f32x2v*)(bul + s * 130 + 2 * lane); const float nr = ar * hr - ai * hi + bu.x, ni = ar * hi + ai * hr + bu.y; hr = nr; hi = ni; hbuf[s * 68 + lane] = pg8::cvt_pk_bf16(hr, hi); }
            f32x4 y = {0.f, 0.f, 0.f, 0.f};
#pragma unroll
            for (int ks = 0; ks < 4; ++ks) { const bf16x8 a = *(const LAS bf16x8*)(hbuf + fr * 68 + ks * 16 + quad * 4); y = MFMA16(a, cf[ks], y); }
#pragma unroll
            for (int j = 0; j < 4; ++j) { const int s = blk * 16 + quad * 4 + j; const float uu = bflo((unsigned)urow0[(size_t)(quad * 4 + j) * 1280 + fr]); const float yv = y[j] + dco * uu;
                const float z = 0.7978845608028654f * (yv + 0.044715f * yv * yv * yv); const float th = 1.0f - 2.0f / (1.0f + __expf(2.0f * z)); const float gl = 0.5f * yv * (1.0f + th);
                gbuf[(size_t)(rowbase + s) * 512 + g * 16 + fr] = (bf16)f2bf(gl); }
        }
        if (!sample && chunk == 63) { out[OFF_SRP + (b * 32 + g) * 64 + lane] = hr; out[OFF_SIP + (b * 32 + g) * 64 + lane] = hi; }
        if (sample) { out[OFF_SRS + (b * 32 + g) * 64 + lane] = hr; out[OFF_SIS + (b * 32 + g) * 64 + lane] = hi; }
    }
}

template <int KIND>
__device__ __forceinline__ void sample_gemm(const bf16* A, const bf16* Bt, int K, LAS unsigned char* lds, int tid, int wave, int lane,
                                            bf16* xbp, const float* base_f32, float* part_next, const float* part_cur, bf16* O) {
    const int fr = lane & 15, quad = lane >> 4;
    LAS f32x4* red = (LAS f32x4*)lds;
    LAS float* ssred = (LAS float*)(lds + 32768);
    for (int tile = blockIdx.x; tile < 256; tile += gridDim.x) {
        const int r0 = MP + (tile >> 4) * 16, c0 = (tile & 15) * 64, kw = K >> 3;
        const bf16* ap = A + (size_t)(r0 + fr) * K + wave * kw + quad * 8;
        const bf16* bp = Bt + (size_t)(c0 + fr) * K + wave * kw + quad * 8;
        f32x4 acc[4];
#pragma unroll
        for (int cb = 0; cb < 4; ++cb) acc[cb] = (f32x4){0.f, 0.f, 0.f, 0.f};
        const int nks = kw >> 5;
        for (int k0 = 0; k0 < nks; k0 += 4) {
            bf16x8 a[4], b[4][4];
#pragma unroll
            for (int i = 0; i < 4; ++i) { const int ks = (k0 + i < nks) ? k0 + i : nks - 1;
                a[i] = *(const bf16x8*)(ap + ks * 32);
#pragma unroll
                for (int cb = 0; cb < 4; ++cb) b[i][cb] = *(const bf16x8*)(bp + (size_t)cb * 16 * K + ks * 32); }
            __builtin_amdgcn_sched_barrier(0);
#pragma unroll
            for (int i = 0; i < 4; ++i) if (k0 + i < nks) {
#pragma unroll
                for (int cb = 0; cb < 4; ++cb) acc[cb] = MFMA16(b[i][cb], a[i], acc[cb]); }
        }
#pragma unroll
        for (int cb = 0; cb < 4; ++cb) red[(wave * 4 + cb) * 64 + lane] = acc[cb] * 1.0f;
        __syncthreads();
        if (tid < 256) { const int cb = tid >> 6, l2 = tid & 63; f32x4 v = red[cb * 64 + l2];
#pragma unroll
            for (int w = 1; w < 8; ++w) v = v + red[(w * 4 + cb) * 64 + l2];
            const int row = r0 + (l2 & 15), col = c0 + cb * 16 + 4 * (l2 >> 4); const size_t off = (size_t)row * 1024 + col;
            if (KIND == 0) { f32x4 bs;
                if (base_f32) bs = *(const f32x4*)(base_f32 + off);
                else { const u32x2v w = *(const u32x2v*)(xbp + off); bs = (f32x4){bflo(w.x), bfhi(w.x), bflo(w.y), bfhi(w.y)}; }
                v = v + bs; u32x2v o; o.x = pk2(v[0], v[1]); o.y = pk2(v[2], v[3]); *(u32x2v*)(xbp + off) = o;
                float ss = (v[0] * v[0] + v[1] * v[1]) + (v[2] * v[2] + v[3] * v[3]); ss += __shfl_xor(ss, 16); ss += __shfl_xor(ss, 32);
                if ((l2 >> 4) == 0) ssred[cb * 16 + (l2 & 15)] = ss; }
            else { const float rs = rstd_of(part_cur, row); u32x2v o; o.x = pk2(v[0] * rs, v[1] * rs); o.y = pk2(v[2] * rs, v[3] * rs); *(u32x2v*)(O + off) = o; }
        }
        if (KIND == 0) { __syncthreads(); if (tid < 16) part_next[(size_t)(r0 + tid) * 16 + (tile & 15)] = (ssred[tid] + ssred[16 + tid]) + (ssred[32 + tid] + ssred[48 + tid]); }
        __syncthreads();
    }
}

struct Params { const float* in[36]; float* out; unsigned char* ws; int use_cg, pad; };

__global__ void __launch_bounds__(512, 2) mega_fwd(Params P) {
    extern __shared__ __attribute__((aligned(16))) unsigned char lds_raw[];
    LAS unsigned char* lds = (LAS unsigned char*)lds_raw;
    volatile LAS unsigned* MISC = (volatile LAS unsigned*)(lds + MISC_OFF);
    const int G = gridDim.x, NGW = G * 8, NT = G * 512;
    const int wave_s = __builtin_amdgcn_readfirstlane(threadIdx.x >> 6);
    for (int u = threadIdx.x; u < (LDS_BYTES - 131072) / 4; u += 512) ((LAS unsigned*)(lds + 131072))[u] = 0u;
    __syncthreads();
    XcdBarrier bar = xcd_barrier_post((unsigned*)(P.ws + WS_BAR), MISC + 8);
#ifndef STOP_AFTER
#define STOP_AFTER 1000
#endif
    int ph = 0;
#define RUN (ph < STOP_AFTER)
#define FRESH() const int tid = fresh_tid(wave_s), lane = tid & 63, wave = __builtin_amdgcn_readfirstlane(tid >> 6); const int gw = blockIdx.x * 8 + wave, gt = blockIdx.x * 512 + tid; (void)gw; (void)gt; (void)lane; LAS float* wscr = (LAS float*)(lds + 32768 + wave * 12288); (void)wscr;
#define SEAM() do { if (P.use_cg) cg::this_grid().sync(); else xcd_barrier(bar); ++ph; } while (0)

#define part ((float*)(ws + WS_PART))
#define PARTBUF(k) (part + (size_t)((k) & 1) * PART_ELEMS)
#define ropec ((float*)(ws + WS_ROPE))
#define ropes (ropec + 4096 * 32)
#define abar ((float*)(ws + WS_SSM))
#define bbar (abar + 32 * 64 * 2)
#define bbt ((bf16*)(bbar + 32 * 64 * 32))
#define ckb ((bf16*)(ws + WS_CKV))
#define cvb (ckb + 8 * 128 * 128)
#define sloc ((float*)(ws + WS_SLOC))
#define memk ((bf16*)(ws + WS_MEMK))
#define memvT ((bf16*)(ws + WS_MEMVT))
#define SG ((float*)(ws + WS_SIDE))
#define SV ((float*)(ws + WS_SIDE + SG_BYTES))
#define WT ((bf16*)(ws + WS_WT))
#define xb ((bf16*)(ws + WS_XB))
#define tmp (ws + WS_TMP)
#define proj0 ((bf16*)(tmp + TMP_PROJ0))
#define gbuf ((bf16*)(tmp + TMP_GBUF))
#define ycat ((bf16*)(tmp + TMP_YCAT))
#define memb ((bf16*)(tmp + TMP_MEMB))
#define qx ((bf16*)(tmp + TMP_QX))
#define ox ((bf16*)(tmp + TMP_OX))
#define act ((bf16*)(tmp + TMP_ACT))
#define gbm ((bf16*)(tmp + TMP_GB))
#define zc ((bf16*)(tmp + TMP_ZC))
#define PTRS() unsigned char* ws = P.ws; float* out = P.out; asm volatile("" : "+s"(ws), "+s"(out));
    if (RUN) { PTRS() FRESH()
        {
            constexpr int NITEMS = 640 + 128 + 512 + 512 + 2 * 1024 + 512 + 2816 + 1408 + 2048;
            for (int it = gw; it < NITEMS; it += NGW) { int r = it;
#define TR(Wp, K_, N_, WTp, gainp, sc, mode) { const int ni_ = ((K_) / 64) * ((N_) / 32); if (r < ni_) { tr_item(Wp, K_, N_, WTp, gainp, sc, mode, wscr, r, lane); continue; } r -= ni_; }
                TR(P.in[15], 1024, 1280, WT + WT_INEVEN, P.in[11], 1.f, 1)
                TR(P.in[25], 512, 512, WT + WT_GLU, nullptr, 1.f, 0)
                TR(P.in[16], 1024, 1024, WT + WT_OUTEVEN, nullptr, 1.f, 0)
                TR(P.in[30], 1024, 1024, WT + WT_WQ, P.in[12], 0.0625f, 0)
                TR(P.in[31], 1024, 2048, WT + WT_WKV, nullptr, 1.f, 0)
                TR(P.in[31] + 2097152, 1024, 2048, WT + WT_WKV + 2097152, nullptr, 1.f, 0)
                TR(P.in[32], 1024, 1024, WT + WT_WO, nullptr, 1.f, 0)
                TR(P.in[33], 1024, 5632, WT + WT_UP, P.in[13], 1.f, 2)
                TR(P.in[35], 2816, 1024, WT + WT_DOWN, nullptr, 1.f, 0)
                { const int mi = r >> 7, l = mi >> 3, b = mi & 7; tr_item(P.in[10] + (size_t)mi * 262144, 256, 1024, memvT + (size_t)(l * 12 + 4 + b) * 262144, nullptr, 1.f, 0, wscr, r & 127, lane); }
            }
        }
        for (int m = gw; m < MROWS; m += NGW) { const float* xr = m < MP ? P.in[0] + (size_t)m * 1024 : P.in[1] + (size_t)(m - MP) * 1024; float ss = 0.f;
#pragma unroll
            for (int j = 0; j < 4; ++j) { const f32x4 v = *(const f32x4*)(xr + (lane + 64 * j) * 4); ss += (v[0] * v[0] + v[1] * v[1]) + (v[2] * v[2] + v[3] * v[3]);
                u32x2v w; w.x = pg8::cvt_pk_bf16(v[0], v[1]); w.y = pg8::cvt_pk_bf16(v[2], v[3]); *(u32x2v*)(xb + (size_t)m * 1024 + (lane + 64 * j) * 4) = w; }
            ss = wave_sum(ss); if (lane < 16) PARTBUF(0)[(size_t)m * 16 + lane] = lane == 0 ? ss : 0.f; }
        for (int i = gt; i < 262144; i += NT) { const f32x4 v = *(const f32x4*)(P.in[2] + (size_t)i * 4); u32x2v w; w.x = pg8::cvt_pk_bf16(v[0], v[1]); w.y = pg8::cvt_pk_bf16(v[2], v[3]); *(u32x2v*)(memb + (size_t)i * 4) = w; }
        for (int i = gt; i < 1048576; i += NT) { const size_t e = (size_t)i * 4; const int lb = (int)(e >> 18), l = lb >> 3, b = lb & 7; const f32x4 v = *(const f32x4*)(P.in[9] + e);
            u32x2v w; w.x = pg8::cvt_pk_bf16(v[0], v[1]); w.y = pg8::cvt_pk_bf16(v[2], v[3]); *(u32x2v*)(memk + (size_t)(l * 12 + 4 + b) * 262144 + (e & 262143)) = w; }
        for (int i = gt; i < 65536; i += NT) { const int j = i & 32767; const float* src = (i < 32768 ? P.in[3] : P.in[4]) + (size_t)j * 4; bf16* dst = (i < 32768 ? ckb : cvb) + (size_t)j * 4;
            const f32x4 v = *(const f32x4*)src; u32x2v w; w.x = pg8::cvt_pk_bf16(v[0], v[1]); w.y = pg8::cvt_pk_bf16(v[2], v[3]); *(u32x2v*)dst = w; }
        for (int i = gt; i < 4096 * 32; i += NT) { const int pos = i >> 5, d = i & 31; const double inv = dexp_(-(double)d * (9.210340371976184 / 32.0)); double s, c; dsincos_((double)pos * inv, s, c); ropec[i] = (float)c; ropes[i] = (float)s; }
        for (int i = gt; i < 2048; i += NT) { const double are = P.in[17][i], aim = P.in[18][i], dt = dexp_((double)P.in[19][i]); double s, c; dsincos_(aim * dt, s, c); const double mag = dexp_(are * dt);
            const double br = mag * c, bi = mag * s; abar[2 * i] = (float)br; abar[2 * i + 1] = (float)bi;
            const double nr = br - 1.0, ni = bi, den = are * are + aim * aim; const double qr = (nr * are + ni * aim) / den, qi = (ni * are - nr * aim) / den;
#pragma unroll 4
            for (int h = 0; h < 16; ++h) { const double xr = P.in[20][(size_t)i * 16 + h], xi = P.in[21][(size_t)i * 16 + h]; const float fre = (float)(qr * xr - qi * xi), fim = (float)(qr * xi + qi * xr); bbar[(size_t)i * 32 + 2 * h] = fre; bbar[(size_t)i * 32 + 2 * h + 1] = fim;
                bbt[((size_t)i * 2) * 16 + h] = (bf16)f2bf(fre); bbt[((size_t)i * 2 + 1) * 16 + h] = (bf16)f2bf(fim); } }
    }
    SEAM();
    if (RUN) { PTRS()
        if (G < 128 || (int)blockIdx.x >= G - 64) { pg8::Gemm g{memb, WT + WT_WKV, 1024, 4096, 1024}; pg8::StaticOrder S;
            if (G < 128) S.init(1024, 4096, G, (int)blockIdx.x); else S.init(1024, 4096, 64, (int)blockIdx.x - (G - 64)); EpiKV E{out, memk};
          pg8::gemm_phase<EpiKV, pg8::StaticOrder, true, true>(lds, g, S, E, wave_s); }
        { pg8::Gemm g{xb, WT + WT_INEVEN, MROWS, 1280, 1024}; pg8::StaticOrderF S; S.init(MROWS, 1280, G, (int)blockIdx.x); EpiIn0 E{proj0, PARTBUF(0), ropec, ropes, out};
          pg8::gemm_phase<EpiIn0, pg8::StaticOrderF, true, true>(lds, g, S, E, wave_s); }
        {
            FRESH()
            const int bx = (int)blockIdx.x, n2 = 325 - G;
            int slot = -1, nw = 1;
            if (G == 256) { if (bx >= n2 && bx < G - 64) { slot = (bx - n2) * 8 + wave; nw = (G - 64 - n2) * 8; } } else { slot = gw; nw = NGW; }
            if (slot >= 0) for (int it = slot; it < 2816 + 1408; it += nw) { int r = it;
                TR(P.in[33] + (size_t)1024 * 5632, 1024, 5632, WT + WT_UP + (size_t)5632 * 1024, P.in[13] + 1024, 1.f, 2)
                tr_item(P.in[35] + (size_t)2816 * 1024, 2816, 1024, WT + WT_DOWN + (size_t)2816 * 1024, nullptr, 1.f, 0, wscr, r, lane); }
        }
    }
    SEAM();
    if (RUN) { PTRS() FRESH()
        swa_phase(proj0, ckb, cvb, P.in[26], ycat, lds, tid, wave, lane, G);
        s5_local(proj0, abar, bbt, sloc, wscr, wave * G + (int)blockIdx.x, NGW, lane);
        for (int it = wave * G + (int)blockIdx.x; it < 1024; it += NGW) { const int mi = it >> 7, l = mi >> 2, b = mi & 3;
            tr_item(out + OFF_MVP + (size_t)mi * 262144, 256, 1024, memvT + (size_t)(l * 12 + b) * 262144, nullptr, 1.f, 0, wscr, it & 127, lane); }
    }
    SEAM();
    if (RUN) { PTRS() FRESH() s5_out(proj0, abar, bbt, sloc, P.in[5], P.in[6], P.in[22], P.in[23], P.in[24], gbuf, out, (LAS float*)(lds + wave * 16384), (LAS unsigned*)(lds + wave * 16384 + 8448), wave * G + (int)blockIdx.x, NGW, lane); }
    SEAM();
    if (RUN) { PTRS() pg8::Gemm g{gbuf, WT + WT_GLU, MROWS, 512, 512}; pg8::StaticOrder S; S.init(MROWS, 512, G, (int)blockIdx.x); EpiGlu E{gbuf, ycat};
        pg8::gemm_phase<EpiGlu, pg8::StaticOrder, true, true>(lds, g, S, E, wave_s);
        {
            FRESH()
            const int bx = (int)blockIdx.x; int slot = -1, nw = 1;
            if (G > 130) { if (bx >= 130) { slot = (bx - 130) * 8 + wave; nw = (G - 130) * 8; } } else { slot = gw; nw = NGW; }
            if (slot >= 0) for (int it = slot; it < 1536 + 512; it += nw) { int r = it;
                TR(P.in[27], 1024, 3072, WT + WT_INODD, P.in[11] + 1024, 1.f, 3)
                tr_item(P.in[29], 1024, 1024, WT + WT_OUTODD, nullptr, 1.f, 0, wscr, r, lane); }
        } }
    SEAM();

#pragma unroll
    for (int l = 0; l < 2; ++l) {
        if (l == 1) {
            if (RUN) { PTRS() pg8::Gemm g{xb, WT + WT_INODD, MROWS, 3072, 1024}; pg8::StaticOrderF S; S.init(MROWS, 3072, G, (int)blockIdx.x); EpiInOdd E{gbm, zc, PARTBUF(3), P.in[28], SG};
                pg8::gemm_phase<EpiInOdd, pg8::StaticOrderF, true, true>(lds, g, S, E, wave_s); }
            SEAM();
            if (RUN) { PTRS() FRESH()
                const float* cw = P.in[28]; const float* st = P.in[7];
                for (int i = gt; i < MROWS * 128; i += NT) { const int row = i >> 7, c0 = (i & 127) * 8, blk = row >> 6, r = row & 63;
                    const bool smp = row >= MP; const int rr = smp ? (r & 31) : r;
                    f32x4 z0, z1;
                    if (rr < 2) { const int sb = smp ? (r >> 5) * 4 : 0;
                        f32x4 pa0, pa1, pb0, pb1;
                        if (smp) { const int b = (blk - 256) * 2 + (r >> 5); const float* s0 = st + (size_t)(b * 2) * 1024 + c0; pa0 = *(const f32x4*)s0; pa1 = *(const f32x4*)(s0 + 4); pb0 = *(const f32x4*)(s0 + 1024); pb1 = *(const f32x4*)(s0 + 1028); }
                        else if ((blk & 63) == 0) { pa0 = pa1 = pb0 = pb1 = (f32x4){0.f, 0.f, 0.f, 0.f}; }
                        else { const float* s0 = SG + (size_t)((blk - 1) * 8 + 6) * 1024 + c0; pa0 = *(const f32x4*)s0; pa1 = *(const f32x4*)(s0 + 4); pb0 = *(const f32x4*)(s0 + 1024); pb1 = *(const f32x4*)(s0 + 1028); }
                        const float* sc = SG + (size_t)(blk * 8 + sb) * 1024 + c0; const f32x4 x00 = *(const f32x4*)sc, x01 = *(const f32x4*)(sc + 4);
                        f32x4 xm2a, xm2b, xm1a, xm1b, xca, xcb;
                        if (rr == 0) { xm2a = pa0; xm2b = pa1; xm1a = pb0; xm1b = pb1; xca = x00; xcb = x01; }
                        else { xm2a = pb0; xm2b = pb1; xm1a = x00; xm1b = x01; xca = *(const f32x4*)(sc + 1024); xcb = *(const f32x4*)(sc + 1028); }
                        const f32x4 w0a = *(const f32x4*)(cw + c0), w0b = *(const f32x4*)(cw + c0 + 4), w1a = *(const f32x4*)(cw + 1024 + c0), w1b = *(const f32x4*)(cw + 1028 + c0), w2a = *(const f32x4*)(cw + 2048 + c0), w2b = *(const f32x4*)(cw + 2052 + c0);
                        z0 = w0a * xm2a + w1a * xm1a + w2a * xca; z1 = w0b * xm2b + w1b * xm1b + w2b * xcb; }
                    else { const v4u zw = *(const v4u*)(zc + (size_t)row * 1024 + c0); z0 = (f32x4){bflo(zw.x), bfhi(zw.x), bflo(zw.y), bfhi(zw.y)}; z1 = (f32x4){bflo(zw.z), bfhi(zw.z), bflo(zw.w), bfhi(zw.w)}; }
                    const v4u gw_ = *(const v4u*)(gbm + (size_t)row * 1024 + c0);
                    const f32x4 g0 = (f32x4){bflo(gw_.x), bfhi(gw_.x), bflo(gw_.y), bfhi(gw_.y)}, g1 = (f32x4){bflo(gw_.z), bfhi(gw_.z), bflo(gw_.w), bfhi(gw_.w)};
                    *(v4u*)(gbm + (size_t)row * 1024 + c0) = pack8(g0 * z0, g1 * z1); }
                for (int i = gt; i < 4 * 2 * 1024; i += NT) { const int c = i & 1023, j = (i >> 10) & 1, b = i >> 11; out[OFF_CMP + i] = SG[(size_t)((64 * b + 63) * 8 + 6 + j) * 1024 + c]; }
                for (int i = gt; i < 8 * 2 * 1024; i += NT) { const int c = i & 1023, j = (i >> 10) & 1, b = i >> 11; out[OFF_CMS + i] = SG[(size_t)((256 + (b >> 1)) * 8 + (b & 1) * 4 + 2 + j) * 1024 + c]; }
            }
            SEAM();
        }
        if (RUN) { PTRS() pg8::Gemm g{(bf16*)(tmp + (size_t)(1 - l) * TMP_YCAT), WT + WT_OUTEVEN + (size_t)l * (WT_OUTODD - WT_OUTEVEN), MP, 1024, 1024}; pg8::StaticOrderF S; S.init(MP, 1024, G, (int)blockIdx.x);
            EpiRes E{P.in[0], P.in[1] - (size_t)MP * 1024, xb, PARTBUF(1 + 3 * l), l == 0 ? 1 : 0};
            pg8::gemm_phase<EpiRes, pg8::StaticOrderF, true, true>(lds, g, S, E, wave_s);
            { FRESH() sample_gemm<0>((bf16*)(tmp + (size_t)(1 - l) * TMP_YCAT), WT + WT_OUTEVEN + (size_t)l * (WT_OUTODD - WT_OUTEVEN), 1024, lds, tid, wave, lane, xb, l == 0 ? P.in[1] - (size_t)MP * 1024 : (const float*)nullptr, PARTBUF(1 + 3 * l), nullptr, nullptr); } }
        SEAM();
        if (RUN) { PTRS() pg8::Gemm g{xb, WT + WT_WQ + (size_t)l * 1048576, MP, 1024, 1024}; pg8::StaticOrderF S; S.init(MP, 1024, G, (int)blockIdx.x); EpiBf16 E{qx, 1024, PARTBUF(1 + 3 * l)};
            pg8::gemm_phase<EpiBf16, pg8::StaticOrderF, true, true>(lds, g, S, E, wave_s);
            { FRESH() sample_gemm<1>(xb, WT + WT_WQ + (size_t)l * 1048576, 1024, lds, tid, wave, lane, nullptr, nullptr, nullptr, PARTBUF(1 + 3 * l), qx); } }
        SEAM();
        if (RUN) { PTRS() FRESH() xattn_phase2(qx, memk + (size_t)l * 12 * 262144, memvT + (size_t)l * 12 * 262144, ox, lds, tid, wave, lane, G); }
        SEAM();
        if (RUN) { PTRS() pg8::Gemm g{ox, WT + WT_WO + (size_t)l * 1048576, MP, 1024, 1024}; pg8::StaticOrderF S; S.init(MP, 1024, G, (int)blockIdx.x); EpiRes E{P.in[0], P.in[0], xb, PARTBUF(2 + 3 * l), 0};
            pg8::gemm_phase<EpiRes, pg8::StaticOrderF, true, true>(lds, g, S, E, wave_s);
            { FRESH() sample_gemm<0>(ox, WT + WT_WO + (size_t)l * 1048576, 1024, lds, tid, wave, lane, xb, nullptr, PARTBUF(2 + 3 * l), nullptr, nullptr); } }
        SEAM();
        if (RUN) { PTRS() pg8::Gemm g{xb, WT + WT_UP + (size_t)l * 5632 * 1024, MROWS, 5632, 1024}; pg8::StaticOrderF S; S.init(MROWS, 5632, G, (int)blockIdx.x);
            EpiFfnUp E{act, PARTBUF(2 + 3 * l), P.in[34] + (size_t)l * 3 * DFF, SG, SV};
            pg8::gemm_phase<EpiFfnUp, pg8::StaticOrderF, true, true>(lds, g, S, E, wave_s);
            if (l == 0) {
                FRESH()
                const int bx = (int)blockIdx.x, nb = 1430 % G; int slot = -1, nw = 1;
                if (nb > 0 && nb < G) { if (bx >= nb) { slot = (bx - nb) * 8 + wave; nw = (G - nb) * 8; } } else { slot = gw; nw = NGW; }
                if (slot >= 0) for (int it = slot; it < 512 + 512; it += nw) { int r = it;
                    TR(P.in[30] + 1048576, 1024, 1024, WT + WT_WQ + 1048576, P.in[12] + 1024, 0.0625f, 0)
                    tr_item(P.in[32] + 1048576, 1024, 1024, WT + WT_WO + 1048576, nullptr, 1.f, 0, wscr, r, lane); }
            } }
        SEAM();
        if (RUN) { PTRS() FRESH()
            const float* cw = P.in[34] + (size_t)l * 3 * DFF; const float* st = P.in[8] + (size_t)l * 8 * 2 * DFF;
            for (int i = gt; i < 528 * 352; i += NT) { const int fi = i / 352, c0 = (i % 352) * 8; int blk, row, rr, sb, vb; bool smp = fi >= 512;
                if (!smp) { blk = fi >> 1; rr = fi & 1; row = blk * 64 + rr; sb = 0; vb = 0; } else { const int s = fi - 512, half = (s >> 1) & 1; blk = 256 + (s >> 2); rr = s & 1; row = blk * 64 + half * 32 + rr; sb = half * 4; vb = half * 2; }
                f32x4 pa0, pa1, pb0, pb1;
                if (smp) { const int b = (blk - 256) * 2 + (sb >> 2); const float* s0 = st + (size_t)(b * 2) * DFF + c0; pa0 = *(const f32x4*)s0; pa1 = *(const f32x4*)(s0 + 4); pb0 = *(const f32x4*)(s0 + DFF); pb1 = *(const f32x4*)(s0 + DFF + 4); }
                else if ((blk & 63) == 0) { pa0 = pa1 = pb0 = pb1 = (f32x4){0.f, 0.f, 0.f, 0.f}; }
                else { const float* s0 = SG + (size_t)((blk - 1) * 8 + 6) * DFF + c0; pa0 = *(const f32x4*)s0; pa1 = *(const f32x4*)(s0 + 4); pb0 = *(const f32x4*)(s0 + DFF); pb1 = *(const f32x4*)(s0 + DFF + 4); }
                const float* sc = SG + (size_t)(blk * 8 + sb) * DFF + c0; const f32x4 x00 = *(const f32x4*)sc, x01 = *(const f32x4*)(sc + 4);
                f32x4 xm2a, xm2b, xm1a, xm1b, xca, xcb;
                if (rr == 0) { xm2a = pa0; xm2b = pa1; xm1a = pb0; xm1b = pb1; xca = x00; xcb = x01; }
                else { xm2a = pb0; xm2b = pb1; xm1a = x00; xm1b = x01; xca = *(const f32x4*)(sc + DFF); xcb = *(const f32x4*)(sc + DFF + 4); }
                const f32x4 w0a = *(const f32x4*)(cw + c0), w0b = *(const f32x4*)(cw + c0 + 4), w1a = *(const f32x4*)(cw + DFF + c0), w1b = *(const f32x4*)(cw + DFF + c0 + 4), w2a = *(const f32x4*)(cw + 2 * DFF + c0), w2b = *(const f32x4*)(cw + 2 * DFF + c0 + 4);
                const f32x4 ga = w0a * xm2a + w1a * xm1a + w2a * xca, gb_ = w0b * xm2b + w1b * xm1b + w2b * xcb;
                const float* sv = SV + (size_t)(blk * 4 + vb + rr) * DFF + c0; const f32x4 va = *(const f32x4*)sv, vb_ = *(const f32x4*)(sv + 4);
                f32x4 a0, a1;
#pragma unroll
                for (int j = 0; j < 4; ++j) { a0[j] = ga[j] * sigmoidf_(ga[j]) * va[j]; a1[j] = gb_[j] * sigmoidf_(gb_[j]) * vb_[j]; }
                *(v4u*)(act + (size_t)row * DFF + c0) = pack8(a0, a1); }
            for (int i = gt; i < 4 * 2 * DFF; i += NT) { const int c = i % DFF, j = (i / DFF) & 1, b = i / (2 * DFF); out[OFF_CFP + (size_t)l * 4 * 2 * DFF + i] = SG[(size_t)((64 * b + 63) * 8 + 6 + j) * DFF + c]; }
            for (int i = gt; i < 8 * 2 * DFF; i += NT) { const int c = i % DFF, j = (i / DFF) & 1, b = i / (2 * DFF); out[OFF_CFS + (size_t)l * 8 * 2 * DFF + i] = SG[(size_t)((256 + (b >> 1)) * 8 + (b & 1) * 4 + 2 + j) * DFF + c]; }
        }
        SEAM();
        if (RUN) { PTRS() pg8::Gemm g{act, WT + WT_DOWN + (size_t)l * 2816 * 1024, MP, 1024, DFF}; pg8::StaticOrderF S; S.init(MP, 1024, G, (int)blockIdx.x); EpiRes E{P.in[0], P.in[0], xb, PARTBUF(3 + 3 * l), 0};
            pg8::gemm_phase<EpiRes, pg8::StaticOrderF, true, true>(lds, g, S, E, wave_s);
            { FRESH() sample_gemm<0>(act, WT + WT_DOWN + (size_t)l * 2816 * 1024, DFF, lds, tid, wave, lane, xb, nullptr, PARTBUF(3 + 3 * l), nullptr, nullptr); } }
        SEAM();
    }
    if (RUN) { PTRS() FRESH()
        const float* gf = P.in[14];
        for (int m = gw; m < MROWS; m += NGW) { const float rs = rstd_of(PARTBUF(6), m); float* xr = out + (size_t)m * 1024; const bf16* xbr = xb + (size_t)m * 1024;
#pragma unroll
            for (int j = 0; j < 4; ++j) { const int c = (lane + 64 * j) * 4; const u32x2v w = *(const u32x2v*)(xbr + c); const f32x4 v = (f32x4){bflo(w.x), bfhi(w.x), bflo(w.y), bfhi(w.y)}, gg = *(const f32x4*)(gf + c); *(f32x4*)(xr + c) = v * rs * gg; } }
    }
}

extern "C" void kernel_launch(void* const* d_in, const int* in_sizes, int n_in, void* d_out, int out_size, void* d_ws, size_t ws_size, hipStream_t stream) {
    static int grid = 0;
    if (grid == 0) {
        int dev = 0, cus = 0, per_cu = 0;
        if (n_in != 36 || ws_size < 256 * MiB) { fprintf(stderr, "kernel_launch: unexpected n_in %d / ws %zu\n", n_in, ws_size); grid = -1; return; }
        (void)hipGetDevice(&dev); (void)hipDeviceGetAttribute(&cus, hipDeviceAttributeMultiprocessorCount, dev);
        if (hipFuncSetAttribute((const void*)mega_fwd, hipFuncAttributeMaxDynamicSharedMemorySize, LDS_BYTES) != hipSuccess) { fprintf(stderr, "kernel_launch: hipFuncSetAttribute failed\n"); grid = -1; return; }
        if (hipOccupancyMaxActiveBlocksPerMultiprocessor(&per_cu, (const void*)mega_fwd, 512, LDS_BYTES) != hipSuccess || per_cu < 1) per_cu = 1;
        (void)hipGetLastError();
        grid = cus * 1;
        if (grid > 256) grid = 256;
    }
    if (grid < 0) return;
    (void)hipMemsetAsync(d_ws, 0, CTL_ZERO_BYTES, stream);
    Params p{};
    for (int i = 0; i < 36; ++i) p.in[i] = (const float*)d_in[i];
    p.out = (float*)d_out; p.ws = (unsigned char*)d_ws; p.use_cg = 0; p.pad = 0;
    void* args[] = {&p};
    hipError_t e = hipLaunchCooperativeKernel((const void*)mega_fwd, dim3(grid), dim3(512), args, LDS_BYTES, stream);
    if (e != hipSuccess) fprintf(stderr, "cooperative launch failed: %s (grid %d)\n", hipGetErrorString(e), grid);
}
```

```cpp
#include <hip/hip_runtime.h>
#include <hip/hip_cooperative_groups.h>
#include <cstdio>
#include <cstdint>
namespace cg = cooperative_groups;
__device__ __forceinline__ int fresh_tid(int wave_s) { unsigned z = 0u; asm volatile("" : "+s"(z)); int t = wave_s * 64 + (int)__builtin_amdgcn_mbcnt_hi(~0u, __builtin_amdgcn_mbcnt_lo(~0u, z)); asm volatile("" : "+v"(t)); return t; }
namespace pg8 {
#define PG8_LAS __attribute__((address_space(3)))
typedef unsigned short bf16_t;
typedef short bf16x8 __attribute__((ext_vector_type(8)));
typedef float f32x4 __attribute__((ext_vector_type(4)));
typedef unsigned u32x4 __attribute__((ext_vector_type(4)));
constexpr int BM = 256, BK = 64, HALF = 128, HTB = HALF * BK * 2  , STAGE_BYTES = 8 * HTB, NXCD = 8, WGM = 8;

__host__ __device__ __forceinline__ int lds_byte(int r, int c) { const int st = (r >> 4) * 2 + (c >> 5), rr = r & 15, cc = c & 31, ob = rr * 64 + cc * 2; return st * 1024 + (ob ^ (((ob >> 9) & 1) << 5)); }
__host__ __device__ __forceinline__ void stage_rc(int b, int& R, int& C) { const int st = b / 1024, sb = b % 1024, swz = sb ^ (((sb >> 9) & 1) << 5); R = (st >> 1) * 16 + swz / 64; C = (st & 1) * 32 + (swz % 64) / 2; }
__host__ __device__ __forceinline__ int perm32(int rho) { const int n = rho >> 4, i = rho & 15; return 8 * (i >> 2) + 4 * n + (i & 3); }

struct Unit { int pm, pn; };
struct Gemm { const bf16_t* A; const bf16_t* Bt; int M, N, K; };

template <bool FULL> struct StaticOrderT {
    int nM, nN, nwg, G, c;
    __host__ __device__ void init(int M, int N, int G_, int c_) { nM = M / BM; nN = N / BM; nwg = nM * nN; G = G_; c = c_; }
    __host__ __device__ bool next(int i, Unit& u) const {
        const long L = (long)i * G + c; if (!(FULL && i == 0) && L >= nwg) return false;
        int wgid = (int)L; { const int q = nwg / NXCD, r = nwg % NXCD, xcd = wgid % NXCD, off = wgid / NXCD; wgid = (xcd < r ? xcd * (q + 1) : r * (q + 1) + (xcd - r) * q) + off; }
        const int nig = WGM * nN, gid = wgid / nig, fm = gid * WGM, gsz = (nM - fm) < WGM ? (nM - fm) : WGM;
        u.pm = fm + ((wgid % nig) % gsz); u.pn = (wgid % nig) / gsz; return true;
    }
    __device__ __forceinline__ void a_ready(const Unit&) const {}
    __device__ __forceinline__ void done(const Unit&) const {}
};

typedef StaticOrderT<false> StaticOrder; typedef StaticOrderT<true> StaticOrderF;
__device__ __forceinline__ unsigned cvt_pk_bf16(float lo, float hi) { unsigned r; asm volatile("v_cvt_pk_bf16_f32 %0, %1, %2" : "=v"(r) : "v"(lo), "v"(hi)); return r; }
typedef float f32x2 __attribute__((ext_vector_type(2)));
template <class Epi, class Sched, bool ALIGN_EPI = false, bool SP2 = false>
__device__ __forceinline__ void gemm_phase(PG8_LAS unsigned char* lds, const Gemm g, const Sched& S, const Epi& E, const int wave_s) {
    const int tid = fresh_tid(wave_s), wid = __builtin_amdgcn_readfirstlane(tid >> 6), lane = tid & 63, wr = wid >> 2, wc = wid & 3, fr = lane & 15, fq = lane >> 4;
    const int K = g.K, nt = K / BK;
    unsigned voffA[2], voffB[2];
#pragma unroll
    for (int i = 0; i < 2; ++i) { int R, C; stage_rc(tid * 16 + i * 8192, R, C); const int Rb = Epi::PERM ? ((R & ~31) + perm32(R & 31)) : R;
        voffA[i] = (unsigned)(R * K + C) * 2u; voffB[i] = (unsigned)(Rb * K + C) * 2u; }
    const size_t kstep = (size_t)(BK * 2);
    const size_t hstep = (size_t)HALF * K * 2;
    const size_t tstep = 2 * hstep;
    const unsigned ldsw = (unsigned)wid * 1024u;
    const int aoff = lds_byte(wr * 64 + fr, fq * 8), boff = lds_byte(wc * 32 + fr, fq * 8);
#define PG8_SA(b, h) (((b) * 2 + (h)) * HTB)
#define PG8_SB(b, h) ((4 + (b) * 2 + (h)) * HTB)
#define PG8_STAGE(bufoff, gbase, voff) do { _Pragma("unroll") for (int _i = 0; _i < 2; ++_i) \
        __builtin_amdgcn_global_load_lds((const unsigned*)((const char*)(gbase) + (voff)[_i]), (PG8_LAS unsigned*)(lds + (bufoff) + ldsw + _i * 8192), 16, 0, 0); } while (0)
#define PG8_LDA(dst, b, h) do { _Pragma("unroll") for (int m = 0; m < 4; ++m) _Pragma("unroll") for (int k = 0; k < 2; ++k) dst[m][k] = *(const PG8_LAS bf16x8*)(lds + PG8_SA(b, h) + aoff + m * 2048 + k * 1024); } while (0)
#define PG8_LDB(dst, b, h) do { _Pragma("unroll") for (int n = 0; n < 2; ++n) _Pragma("unroll") for (int k = 0; k < 2; ++k) dst[n][k] = *(const PG8_LAS bf16x8*)(lds + PG8_SB(b, h) + boff + n * 2048 + k * 1024); } while (0)
#define PG8_MMA(ai, bj, At, Bt) do { __builtin_amdgcn_s_setprio(1); _Pragma("unroll") for (int m = 0; m < 4; ++m) _Pragma("unroll") for (int n = 0; n < 2; ++n) _Pragma("unroll") for (int k = 0; k < 2; ++k) \
        acc[ai][bj][m][n] = __builtin_amdgcn_mfma_f32_16x16x32_bf16(Bt[n][k], At[m][k], acc[ai][bj][m][n], 0, 0, 0); __builtin_amdgcn_s_setprio(0); } while (0)
#define PG8_WAIT_V(n) asm volatile("s_waitcnt vmcnt(" #n ")" ::: "memory")
#define PG8_WAIT_L(n) asm volatile("s_waitcnt lgkmcnt(" #n ")" ::: "memory")
#define PG8_BAR __builtin_amdgcn_s_barrier()
#define PG8_SCHED __builtin_amdgcn_sched_barrier(0)
    Unit cur, nxt; int ui = 0;
    if (!S.next(0, cur)) return;
    f32x4 acc[2][2][4][2];
#pragma unroll
    for (int a = 0; a < 2; ++a)
#pragma unroll
        for (int b = 0; b < 2; ++b)
#pragma unroll
            for (int m = 0; m < 4; ++m)
#pragma unroll
                for (int n = 0; n < 2; ++n) acc[a][b][m][n] = (f32x4){0.f, 0.f, 0.f, 0.f};
    bf16x8 At[4][2], B0[2][2], B1[2][2];
    const char* cA = (const char*)g.A + (size_t)cur.pm * tstep; const char* cB = (const char*)g.Bt + (size_t)cur.pn * tstep;
    S.a_ready(cur);
    if constexpr (SP2) {
        PG8_STAGE(PG8_SB(0, 0), cB, voffB); PG8_STAGE(PG8_SB(0, 1), cB + hstep, voffB); PG8_STAGE(PG8_SA(0, 0), cA, voffA); PG8_STAGE(PG8_SA(0, 1), cA + hstep, voffA);
        if (wr == 1) PG8_BAR;
        PG8_WAIT_V(2); PG8_BAR;
        PG8_STAGE(PG8_SB(1, 0), cB + kstep, voffB); PG8_STAGE(PG8_SA(1, 0), cA + kstep, voffA); PG8_STAGE(PG8_SB(1, 1), cB + hstep + kstep, voffB);
        PG8_WAIT_V(6); PG8_BAR;
    } else {
        PG8_STAGE(PG8_SB(0, 0), cB, voffB); PG8_STAGE(PG8_SA(0, 0), cA, voffA); PG8_STAGE(PG8_SB(0, 1), cB + hstep, voffB); PG8_STAGE(PG8_SA(0, 1), cA + hstep, voffA);
        if (wr == 1) PG8_BAR;
        PG8_WAIT_V(4); PG8_BAR;
        PG8_STAGE(PG8_SB(1, 0), cB + kstep, voffB); PG8_STAGE(PG8_SA(1, 0), cA + kstep, voffA); PG8_STAGE(PG8_SB(1, 1), cB + hstep + kstep, voffB);
        PG8_WAIT_V(6); PG8_BAR;
    }
    for (;;) {
        const bool has_next = S.next(ui + 1, nxt);
        const char* nA = has_next ? (const char*)g.A + (size_t)nxt.pm * tstep : cA; const char* nB = has_next ? (const char*)g.Bt + (size_t)nxt.pn * tstep : cB;
        for (int t = 0; t < nt; t += 2) {
            const bool last = (t == nt - 2);
            const char* a1 = cA + (size_t)(t + 1) * kstep;
            const char* a2 = last ? nA : cA + (size_t)(t + 2) * kstep; const char* b2 = last ? nB : cB + (size_t)(t + 2) * kstep;
            const char* a3 = a2 + kstep; const char* b3 = b2 + kstep;
            if (last && has_next) S.a_ready(nxt);
            if constexpr (SP2) {
            PG8_LDB(B0, 0, 0); PG8_LDB(B1, 0, 1); PG8_SCHED; PG8_LDA(At, 0, 0); PG8_STAGE(PG8_SA(1, 1), a1 + hstep, voffA);
            PG8_WAIT_V(8); PG8_WAIT_L(0); PG8_BAR; PG8_MMA(0, 0, At, B0); PG8_MMA(0, 1, At, B1); PG8_BAR; PG8_SCHED;
            PG8_LDA(At, 0, 1); PG8_STAGE(PG8_SB(0, 0), b2, voffB); PG8_STAGE(PG8_SB(0, 1), b2 + hstep, voffB); PG8_STAGE(PG8_SA(0, 0), a2, voffA);
            PG8_WAIT_V(8); PG8_WAIT_L(0); PG8_BAR; PG8_MMA(1, 0, At, B0); PG8_MMA(1, 1, At, B1); PG8_BAR; PG8_SCHED;
            PG8_LDB(B0, 1, 0); PG8_LDB(B1, 1, 1); PG8_SCHED; PG8_LDA(At, 1, 0); PG8_STAGE(PG8_SA(0, 1), a2 + hstep, voffA);
            PG8_WAIT_V(8); PG8_WAIT_L(0); PG8_BAR; PG8_MMA(0, 0, At, B0); PG8_MMA(0, 1, At, B1); PG8_BAR; PG8_SCHED;
            PG8_LDA(At, 1, 1); PG8_STAGE(PG8_SB(1, 0), b3, voffB); PG8_STAGE(PG8_SB(1, 1), b3 + hstep, voffB); PG8_STAGE(PG8_SA(1, 0), a3, voffA);
            PG8_WAIT_V(8); PG8_WAIT_L(0); PG8_BAR; PG8_MMA(1, 0, At, B0); PG8_MMA(1, 1, At, B1); PG8_BAR; PG8_SCHED;
            } else {
            PG8_LDB(B0, 0, 0); PG8_SCHED; PG8_LDA(At, 0, 0); PG8_STAGE(PG8_SA(1, 1), a1 + hstep, voffA);
            PG8_WAIT_L(8); PG8_BAR; PG8_WAIT_L(0); PG8_MMA(0, 0, At, B0); PG8_BAR; PG8_SCHED;
            PG8_LDB(B1, 0, 1); PG8_STAGE(PG8_SB(0, 0), b2, voffB);
            PG8_BAR; PG8_WAIT_L(0); PG8_MMA(0, 1, At, B1); PG8_BAR;
            PG8_LDA(At, 0, 1); PG8_STAGE(PG8_SA(0, 0), a2, voffA);
            PG8_BAR; PG8_WAIT_L(0); PG8_MMA(1, 0, At, B0); PG8_BAR; PG8_SCHED;
            PG8_STAGE(PG8_SB(0, 1), b2 + hstep, voffB);
            PG8_WAIT_V(6); PG8_BAR; PG8_MMA(1, 1, At, B1); PG8_BAR;
            PG8_LDB(B0, 1, 0); PG8_SCHED; PG8_LDA(At, 1, 0); PG8_STAGE(PG8_SA(0, 1), a2 + hstep, voffA);
            PG8_WAIT_L(8); PG8_BAR; PG8_WAIT_L(0); PG8_MMA(0, 0, At, B0); PG8_BAR; PG8_SCHED;
            PG8_LDB(B1, 1, 1); PG8_STAGE(PG8_SB(1, 0), b3, voffB);
            PG8_BAR; PG8_WAIT_L(0); PG8_MMA(0, 1, At, B1); PG8_BAR;
            PG8_LDA(At, 1, 1); PG8_STAGE(PG8_SA(1, 0), a3, voffA);
            PG8_BAR; PG8_WAIT_L(0); PG8_MMA(1, 0, At, B0); PG8_BAR; PG8_SCHED;
            PG8_STAGE(PG8_SB(1, 1), b3 + hstep, voffB);
            PG8_WAIT_V(6); PG8_BAR; PG8_MMA(1, 1, At, B1); PG8_BAR;
            }
        }
        if constexpr (ALIGN_EPI) { if (wr == 0) PG8_BAR; }
        if constexpr (!Epi::AFTER_DRAIN) { E(acc, cur, wr, wc, fr, fq); S.done(cur); }
        if (!has_next) break;
#pragma unroll
        for (int a = 0; a < 2; ++a)
#pragma unroll
            for (int b = 0; b < 2; ++b)
#pragma unroll
                for (int m = 0; m < 4; ++m)
#pragma unroll
                    for (int n = 0; n < 2; ++n) acc[a][b][m][n] = (f32x4){0.f, 0.f, 0.f, 0.f};
        cur = nxt; cA = nA; cB = nB; ++ui;
        if constexpr (ALIGN_EPI) { if (wr == 1) PG8_BAR; }
    }
    PG8_WAIT_V(0);
    if constexpr (!ALIGN_EPI) { if (wr == 0) PG8_BAR; }
    PG8_BAR;
    if constexpr (Epi::AFTER_DRAIN) { E.fused(acc, cur, wr, wc, fr, fq, lds, wid, lane); S.done(cur); }
#undef PG8_SA
#undef PG8_SB
#undef PG8_STAGE
#undef PG8_LDA
#undef PG8_LDB
#undef PG8_MMA
#undef PG8_WAIT_V
#undef PG8_WAIT_L
#undef PG8_BAR
#undef PG8_SCHED
}
}
#define GAS __attribute__((address_space(1)))
#define LAS __attribute__((address_space(3)))
typedef unsigned short bf16;
typedef unsigned v4u __attribute__((ext_vector_type(4)));
typedef float f32x4 __attribute__((ext_vector_type(4)));
typedef short bf16x8 __attribute__((ext_vector_type(8)));
typedef GAS unsigned gu32;
typedef GAS unsigned long long gu64;
#define RLX_AGENT __ATOMIC_RELAXED, __HIP_MEMORY_SCOPE_AGENT
#define LDS_WAIT() asm volatile("s_waitcnt lgkmcnt(0)" ::: "memory")
#define VM_WAIT() asm volatile("s_waitcnt vmcnt(0)" ::: "memory")
__device__ __forceinline__ unsigned long long rt() { return __builtin_amdgcn_s_memrealtime(); }
__device__ __forceinline__ unsigned f2bf(float f) { unsigned u = __builtin_bit_cast(unsigned, f); return (u + 0x7fffu + ((u >> 16) & 1u)) >> 16; }
__device__ __forceinline__ unsigned pk2(float lo, float hi) { return f2bf(lo) | (f2bf(hi) << 16); }

#define XB_TMO      128
#define XB_XCNT(j)  (256  + 64 * (j))
#define XB_XSUB(j)  (1280 + 64 * (j))
#define XB_XGEN(j)  (2304 + 64 * (j))
#define XB_TOP      3328
#define XB_TOPGEN   3392
#define XCD_BAR_WORDS 3456
#define XB_SPIN_CAP (1u << 18)

__device__ __forceinline__ unsigned xb_ld(unsigned* p)              { return __hip_atomic_load(p, __ATOMIC_RELAXED, __HIP_MEMORY_SCOPE_AGENT); }
__device__ __forceinline__ unsigned xb_add(unsigned* p, unsigned v) { return __hip_atomic_fetch_add(p, v, __ATOMIC_RELAXED, __HIP_MEMORY_SCOPE_AGENT); }
__device__ __forceinline__ unsigned xb_xcc_id() { return (unsigned)__builtin_amdgcn_s_getreg((3 << 11) | 20) & 0xFu; }
#define XB_SPIN(cond, bar) do { unsigned _sp = 0; while (cond) { __builtin_amdgcn_s_sleep(1); \
    if ((++_sp & 255u) == 0u) { if (xb_ld(&(bar)[XB_TMO])) break; if (_sp > XB_SPIN_CAP) { atomicAdd(&(bar)[XB_TMO], 1u); break; } } } } while (0)

struct XcdBarrier {
    unsigned* bar; unsigned x;
    volatile LAS unsigned* st;
};

__device__ __forceinline__ XcdBarrier xcd_barrier_post(unsigned* bar, volatile LAS unsigned* st) {
    XcdBarrier b; b.bar = bar; b.x = xb_xcc_id(); b.st = st;
    if (threadIdx.x == 0) (void)xb_add(&bar[XB_XCNT(b.x)], 1u);
    return b;
}
__device__ __forceinline__ void xcd_barrier_complete(unsigned* bar, unsigned x, unsigned& nloc, unsigned& nx) {
    const unsigned G = gridDim.x * gridDim.y * gridDim.z;
    unsigned sum, cnt, mine, sp = 0u;
    for (;;) {
        sum = 0u; cnt = 0u; mine = 0u;
#pragma unroll
        for (unsigned j = 0; j < 16; ++j) { const unsigned c = xb_ld(&bar[XB_XCNT(j)]); sum += c; cnt += (c > 0u) ? 1u : 0u; mine = (j == x) ? c : mine; }
        if (sum == G) break;
        __builtin_amdgcn_s_sleep(1);
        if ((++sp & 255u) == 0u) { if (xb_ld(&bar[XB_TMO])) break; if (sp > XB_SPIN_CAP) { atomicAdd(&bar[XB_TMO], 1u); break; } }
    }
    nloc = mine > 0u ? mine : 1u; nx = cnt > 0u ? cnt : 1u;
}

__device__ __forceinline__ void xcd_barrier(const XcdBarrier& b) {
    asm volatile("s_waitcnt vmcnt(0)" ::: "memory");
    __syncthreads();
    if (threadIdx.x == 0) {
        unsigned* bar = b.bar;
        __builtin_amdgcn_s_waitcnt(0);
        unsigned nloc = b.st[0], nx = b.st[1];
        if (nloc == 0u) { xcd_barrier_complete(bar, b.x, nloc, nx); b.st[0] = nloc; b.st[1] = nx; }
        const unsigned old = xb_add(&bar[XB_XSUB(b.x)], 1u);
        const unsigned gen = old / nloc;
        if (old + 1u == (gen + 1u) * nloc) {
            __builtin_amdgcn_fence(__ATOMIC_RELEASE, "agent");
            asm volatile("s_waitcnt vmcnt(0)" ::: "memory");
            const unsigned og = xb_add(&bar[XB_TOP], 1u);
            const unsigned tg = og / nx;
            if (og + 1u == (tg + 1u) * nx) xb_add(&bar[XB_TOPGEN], 1u);
            else XB_SPIN(xb_ld(&bar[XB_TOPGEN]) == tg, bar);
            __builtin_amdgcn_fence(__ATOMIC_ACQUIRE, "agent");
            xb_add(&bar[XB_XGEN(b.x)], 1u);
            asm volatile("s_waitcnt vmcnt(0)" ::: "memory");
        } else {
            XB_SPIN(xb_ld(&bar[XB_XGEN(b.x)]) == gen, bar);
            __builtin_amdgcn_fence(__ATOMIC_ACQUIRE, "agent");
            asm volatile("s_waitcnt vmcnt(0)" ::: "memory");
        }
    }
    __syncthreads();
}
typedef unsigned u32x2v __attribute__((ext_vector_type(2)));
typedef float f32x2v __attribute__((ext_vector_type(2)));

constexpr int MP = 16384, MROWS = 16640, DMODEL = 1024, DFF = 2816, NBLK64 = MROWS / 64;
constexpr float RMS_EPS = 1e-6f;
constexpr size_t OFF_Y = 0, OFF_WKP = (size_t)MROWS * 1024, OFF_WVP = OFF_WKP + 65536, OFF_SRP = OFF_WVP + 65536, OFF_SIP = OFF_SRP + 8192,
    OFF_CMP = OFF_SIP + 8192, OFF_CFP = OFF_CMP + 8192, OFF_MKP = OFF_CFP + 45056, OFF_MVP = OFF_MKP + 2097152, OFF_WKS = OFF_MVP + 2097152,
    OFF_WVS = OFF_WKS + 32768, OFF_SRS = OFF_WVS + 32768, OFF_SIS = OFF_SRS + 16384, OFF_CMS = OFF_SIS + 16384, OFF_CFS = OFF_CMS + 16384;
constexpr size_t MiB = 1u << 20;
constexpr size_t WS_ROWSS = 0, WS_BAR = 512 * 1024, CTL_ZERO_BYTES = 1 * MiB;
constexpr size_t WS_ROPE = 1 * MiB, WS_SSM = 2 * MiB, WS_CKV = 3 * MiB, WS_SLOC = 4 * MiB, WS_MEMK = 8 * MiB, WS_MEMVT = 20 * MiB, WS_SIDE = 32 * MiB;
constexpr size_t SG_BYTES = (size_t)NBLK64 * 8 * DFF * 4, SV_BYTES = (size_t)NBLK64 * 4 * DFF * 4;
static_assert(WS_SIDE + SG_BYTES + SV_BYTES <= 66 * MiB, "side buffers");
constexpr size_t WS_WT = 66 * MiB, WS_XB = 128 * MiB, WS_TMP = 161 * MiB;
constexpr size_t WT_INEVEN = 0, WT_GLU = WT_INEVEN + 1280 * 1024, WT_OUTEVEN = WT_GLU + 512 * 512, WT_WQ = WT_OUTEVEN + 1024 * 1024, WT_WKV = WT_WQ + 2 * 1024 * 1024,
    WT_WO = WT_WKV + 2 * 2048 * 1024, WT_UP = WT_WO + 2 * 1024 * 1024, WT_DOWN = WT_UP + (size_t)2 * 5632 * 1024, WT_INODD = WT_DOWN + (size_t)2 * 2816 * 1024,
    WT_OUTODD = WT_INODD + 3072 * 1024, WT_END = WT_OUTODD + 1024 * 1024;
static_assert(WS_WT + WT_END * 2 <= WS_XB, "weights");
static_assert(WS_XB + (size_t)MROWS * 1024 * 2 <= WS_TMP, "xb");
constexpr size_t TMP_BYTES = (size_t)MROWS * DFF * 2;
constexpr size_t WS_PART = 251 * MiB, PART_ELEMS = (size_t)MROWS * 16;
static_assert(WS_PART + 2 * PART_ELEMS * 4 <= 256 * MiB, "part");
static_assert(WS_TMP + TMP_BYTES <= 256 * MiB, "ws");
constexpr size_t TMP_PROJ0 = 0, TMP_GBUF = (size_t)MROWS * 1280 * 2, TMP_YCAT = TMP_GBUF + (size_t)MROWS * 512 * 2, TMP_MEMB = TMP_YCAT;
static_assert(TMP_YCAT + (size_t)MROWS * 1024 * 2 <= TMP_BYTES, "tmp");
constexpr size_t TMP_QX = 0, TMP_OX = (size_t)MROWS * 1024 * 2, TMP_ACT = 0, TMP_GB = 0, TMP_ZC = (size_t)MROWS * 1024 * 2;
constexpr int LDS_BYTES = 147456, MISC_OFF = 147456 - 512;
constexpr int NPH = 22;

#define MFMA16(a, b, c) __builtin_amdgcn_mfma_f32_16x16x32_bf16(a, b, c, 0, 0, 0)
__device__ __forceinline__ float bflo(unsigned w) { return __uint_as_float(w << 16); }
__device__ __forceinline__ float bfhi(unsigned w) { return __uint_as_float(w & 0xffff0000u); }
__device__ __forceinline__ v4u pack8(f32x4 a, f32x4 b) { v4u w; w.x = pg8::cvt_pk_bf16(a[0], a[1]); w.y = pg8::cvt_pk_bf16(a[2], a[3]); w.z = pg8::cvt_pk_bf16(b[0], b[1]); w.w = pg8::cvt_pk_bf16(b[2], b[3]); return w; }
__device__ __forceinline__ float rstd_of(const float* part, int row) { const f32x4* p = (const f32x4*)(part + (size_t)row * 16); const f32x4 a = p[0] + p[1] + p[2] + p[3]; return rsqrtf(((a[0] + a[1]) + (a[2] + a[3])) * (1.0f / 1024.0f) + RMS_EPS); }
__device__ __forceinline__ float sigmoidf_(float x) { return 1.0f / (1.0f + __expf(-x)); }
__device__ __forceinline__ float dpp_ror1(float v) { return __builtin_bit_cast(float, __builtin_amdgcn_update_dpp(0, __builtin_bit_cast(int, v), 0x121, 0xf, 0xf, false)); }
__device__ __forceinline__ float dpp_ror2(float v) { return __builtin_bit_cast(float, __builtin_amdgcn_update_dpp(0, __builtin_bit_cast(int, v), 0x122, 0xf, 0xf, false)); }
__device__ __forceinline__ float wave_sum(float v) {
#pragma unroll
    for (int o = 1; o < 64; o <<= 1) v += __shfl_xor(v, o);
    return v;
}

typedef pg8::Unit Unit;
#define EPI_ARGS const f32x4 (&acc)[2][2][4][2], const Unit& u, int wr, int wc, int fr, int fq

struct EpiBf16 {
    static constexpr bool PERM = true, AFTER_DRAIN = false;
    bf16* O; int ldc; const float* rowss;
    __device__ __forceinline__ void operator()(EPI_ARGS) const {
        const int row0 = u.pm * 256 + wr * 64 + fr, col0 = u.pn * 256 + wc * 32 + 8 * fq;
#pragma unroll
        for (int ai = 0; ai < 2; ++ai)
#pragma unroll
            for (int m = 0; m < 4; ++m) { const int row = row0 + ai * 128 + m * 16; const float rs = rstd_of(rowss, row); bf16* rp = O + (size_t)row * ldc + col0;
#pragma unroll
                for (int bj = 0; bj < 2; ++bj) *(v4u*)(rp + bj * 128) = pack8(acc[ai][bj][m][0] * rs, acc[ai][bj][m][1] * rs); }
    }
};
struct EpiRes {
    static constexpr bool PERM = true, AFTER_DRAIN = false;
    const float* base_p; const float* base_s; bf16* xb; float* rowss_next; int f32base;
    __device__ __forceinline__ void operator()(EPI_ARGS) const {
        const float* base = u.pm < 64 ? base_p : base_s;
        const int row0 = u.pm * 256 + wr * 64 + fr, col0 = u.pn * 256 + wc * 32 + 8 * fq;
#pragma unroll
        for (int ai = 0; ai < 2; ++ai)
#pragma unroll
            for (int m = 0; m < 4; ++m) { const int row = row0 + ai * 128 + m * 16; const size_t off = (size_t)row * 1024 + col0; float ss = 0.f;
#pragma unroll
                for (int bj = 0; bj < 2; ++bj) { f32x4 b0, b1;
                    if (f32base) { b0 = *(const f32x4*)(base + off + bj * 128); b1 = *(const f32x4*)(base + off + bj * 128 + 4); }
                    else { const v4u w = *(const v4u*)(xb + off + bj * 128); b0 = (f32x4){bflo(w.x), bfhi(w.x), bflo(w.y), bfhi(w.y)}; b1 = (f32x4){bflo(w.z), bfhi(w.z), bflo(w.w), bfhi(w.w)}; }
                    const f32x4 v0 = acc[ai][bj][m][0] + b0, v1 = acc[ai][bj][m][1] + b1;
                    *(v4u*)(xb + off + bj * 128) = pack8(v0, v1);
                    ss += (v0[0] * v0[0] + v0[1] * v0[1]) + (v0[2] * v0[2] + v0[3] * v0[3]) + (v1[0] * v1[0] + v1[1] * v1[1]) + (v1[2] * v1[2] + v1[3] * v1[3]); }
                ss += __shfl_xor(ss, 16); ss += __shfl_xor(ss, 32);
                if (fq == 0) rowss_next[(size_t)row * 16 + u.pn * 4 + wc] = ss; }
    }
};
struct EpiGlu {
    static constexpr bool PERM = true, AFTER_DRAIN = false;
    const bf16* g; bf16* ycat;
    __device__ __forceinline__ void operator()(EPI_ARGS) const {
        const int row0 = u.pm * 256 + wr * 64 + fr, col0 = u.pn * 256 + wc * 32 + 8 * fq;
#pragma unroll
        for (int ai = 0; ai < 2; ++ai)
#pragma unroll
            for (int m = 0; m < 4; ++m) { const int row = row0 + ai * 128 + m * 16;
#pragma unroll
                for (int bj = 0; bj < 2; ++bj) { const int col = col0 + bj * 128; const v4u gw = *(const v4u*)(g + (size_t)row * 512 + col);
                    const f32x4 a0 = acc[ai][bj][m][0], a1 = acc[ai][bj][m][1]; f32x4 o0, o1;
                    o0[0] = bflo(gw.x) * sigmoidf_(a0[0]); o0[1] = bfhi(gw.x) * sigmoidf_(a0[1]); o0[2] = bflo(gw.y) * sigmoidf_(a0[2]); o0[3] = bfhi(gw.y) * sigmoidf_(a0[3]);
                    o1[0] = bflo(gw.z) * sigmoidf_(a1[0]); o1[1] = bfhi(gw.z) * sigmoidf_(a1[1]); o1[2] = bflo(gw.w) * sigmoidf_(a1[2]); o1[3] = bfhi(gw.w) * sigmoidf_(a1[3]);
                    *(v4u*)(ycat + (size_t)row * 1024 + col) = pack8(o0, o1); } }
    }
};
struct EpiKV {
    static constexpr bool PERM = true, AFTER_DRAIN = false;
    float* out; bf16* memk;
    __device__ __forceinline__ void operator()(EPI_ARGS) const {
        const int row0 = u.pm * 256 + wr * 64 + fr, col0 = u.pn * 256 + wc * 32 + 8 * fq;
#pragma unroll
        for (int ai = 0; ai < 2; ++ai)
#pragma unroll
            for (int m = 0; m < 4; ++m) { const int row = row0 + ai * 128 + m * 16;
#pragma unroll
                for (int bj = 0; bj < 2; ++bj) { const int c = col0 + bj * 128, l = c >> 11, e = c & 2047, isv = e >> 10, dc = e & 1023;
                    float* op = out + (isv ? OFF_MVP : OFF_MKP) + (size_t)l * 1048576 + (size_t)row * 1024 + dc;
                    *(f32x4*)op = acc[ai][bj][m][0]; *(f32x4*)(op + 4) = acc[ai][bj][m][1];
                    if (!isv) *(v4u*)(memk + (size_t)l * 12 * 262144 + (size_t)row * 1024 + dc) = pack8(acc[ai][bj][m][0], acc[ai][bj][m][1]); } }
    }
};
struct EpiIn0 {
    static constexpr bool PERM = true, AFTER_DRAIN = false;
    bf16* proj; const float* rowss; const float* ropec; const float* ropes; float* out;
    __device__ __forceinline__ void operator()(EPI_ARGS) const {
        const int pn = u.pn;
#pragma unroll
        for (int ai = 0; ai < 2; ++ai)
#pragma unroll
            for (int m = 0; m < 4; ++m) { const int row = u.pm * 256 + ai * 128 + wr * 64 + m * 16 + fr; const float rs = rstd_of(rowss, row);
                const int pos = row < MP ? (row & 4095) : 2048 + (row & 31);
                bf16* rp = proj + (size_t)row * 1280;
                float* wk = nullptr; float* wv = nullptr;
                if (pn == 4) { if (row >= MP) { wk = out + OFF_WKS + (size_t)(row - MP) * 128; wv = out + OFF_WVS + (size_t)(row - MP) * 128; }
                               else if ((row & 4095) >= 3968) { const size_t o = (size_t)((row >> 12) * 128 + (row & 4095) - 3968) * 128; wk = out + OFF_WKP + o; wv = out + OFF_WVP + o; } }
#pragma unroll
                for (int bj = 0; bj < 2; ++bj) { const f32x4 v0 = acc[ai][bj][m][0] * rs, v1 = acc[ai][bj][m][1] * rs;
                    const bool rope = (pn == 2 || pn == 3 || (pn == 4 && bj == 0));
                    if (!rope) { const int col = pn * 256 + bj * 128 + wc * 32 + 8 * fq; *(v4u*)(rp + col) = pack8(v0, v1);
                        if (pn == 4 && wv) { *(f32x4*)(wv + wc * 32 + 8 * fq) = v0; *(f32x4*)(wv + wc * 32 + 8 * fq + 4) = v1; } }
                    else { const int gbase = pn * 256 + bj * 128 + (wc >> 1) * 64, d1 = 16 * (wc & 1) + 4 * fq;
                        const f32x4 c4 = *(const f32x4*)(ropec + pos * 32 + d1), s4 = *(const f32x4*)(ropes + pos * 32 + d1);
                        f32x4 o1 = v0 * c4 - v1 * s4, o2 = v1 * c4 + v0 * s4;
                        if (pn != 4) { o1 = o1 * 0.125f; o2 = o2 * 0.125f; }
                        u32x2v w1, w2; w1.x = pg8::cvt_pk_bf16(o1[0], o1[1]); w1.y = pg8::cvt_pk_bf16(o1[2], o1[3]); w2.x = pg8::cvt_pk_bf16(o2[0], o2[1]); w2.y = pg8::cvt_pk_bf16(o2[2], o2[3]);
                        *(u32x2v*)(rp + gbase + d1) = w1; *(u32x2v*)(rp + gbase + d1 + 32) = w2;
                        if (pn == 4 && wk) { const int cc = (wc >> 1) * 64 + d1; *(f32x4*)(wk + cc) = o1; *(f32x4*)(wk + cc + 32) = o2; } } } }
    }
};
struct EpiFfnUp {
    static constexpr bool PERM = true, AFTER_DRAIN = false;
    bf16* act; const float* rowss; const float* cw; float* SG; float* SV;
    __device__ __forceinline__ void operator()(EPI_ARGS) const {
        const int c0 = u.pn * 128 + wc * 32 + 8 * fq; const bool sample = u.pm == 64;
        const f32x4 w0a = *(const f32x4*)(cw + c0), w0b = *(const f32x4*)(cw + c0 + 4), w1a = *(const f32x4*)(cw + DFF + c0), w1b = *(const f32x4*)(cw + DFF + c0 + 4),
                    w2a = *(const f32x4*)(cw + 2 * DFF + c0), w2b = *(const f32x4*)(cw + 2 * DFF + c0 + 4);
#pragma unroll
        for (int ai = 0; ai < 2; ++ai) { f32x4 gp0 = {0.f, 0.f, 0.f, 0.f}, gp1 = {0.f, 0.f, 0.f, 0.f}; const int blk = u.pm * 4 + ai * 2 + wr;
#pragma unroll
            for (int m = 0; m < 4; ++m) { const int row = u.pm * 256 + ai * 128 + wr * 64 + m * 16 + fr; const float rs = rstd_of(rowss, row);
                const f32x4 g0 = acc[ai][0][m][0] * rs, g1 = acc[ai][0][m][1] * rs, v0 = acc[ai][1][m][0] * rs, v1 = acc[ai][1][m][1] * rs;
                f32x4 p1a, p2a, p1b, p2b;
#pragma unroll
                for (int j = 0; j < 4; ++j) { const float s1a = fr == 15 ? gp0[j] : g0[j], s2a = fr >= 14 ? gp0[j] : g0[j], s1b = fr == 15 ? gp1[j] : g1[j], s2b = fr >= 14 ? gp1[j] : g1[j];
                    p1a[j] = dpp_ror1(s1a); p2a[j] = dpp_ror2(s2a); p1b[j] = dpp_ror1(s1b); p2b[j] = dpp_ror2(s2b); }
                const f32x4 ca = w0a * p2a + w1a * p1a + w2a * g0, cb = w0b * p2b + w1b * p1b + w2b * g1;
                f32x4 sa, sb;
#pragma unroll
                for (int j = 0; j < 4; ++j) { sa[j] = sigmoidf_(ca[j]); sb[j] = sigmoidf_(cb[j]); }
                const f32x4 a0 = ca * sa * v0, a1 = cb * sb * v1;
                const bool valid = (m > 0 || fr >= 2) && !(sample && m == 2 && fr < 2);
                if (valid) *(v4u*)(act + (size_t)row * DFF + c0) = pack8(a0, a1);
                if ((m & 1) == 0 && fr < 2) { float* sg = SG + (size_t)(blk * 8 + 2 * m + fr) * DFF + c0; *(f32x4*)sg = g0; *(f32x4*)(sg + 4) = g1;
                                              float* sv = SV + (size_t)(blk * 4 + m + fr) * DFF + c0; *(f32x4*)sv = v0; *(f32x4*)(sv + 4) = v1; }
                if ((m & 1) == 1 && fr >= 14) { float* sg = SG + (size_t)(blk * 8 + 2 * m + fr - 14) * DFF + c0; *(f32x4*)sg = g0; *(f32x4*)(sg + 4) = g1; }
                gp0 = g0; gp1 = g1; } }
    }
};
struct EpiInOdd {
    static constexpr bool PERM = true, AFTER_DRAIN = false;
    bf16* gb; bf16* zc; const float* rowss; const float* cw; float* SG;
    __device__ __forceinline__ void operator()(EPI_ARGS) const {
        if (u.pn < 4) {
            const int row0 = u.pm * 256 + wr * 64 + fr, col0 = u.pn * 256 + wc * 32 + 8 * fq;
#pragma unroll
            for (int ai = 0; ai < 2; ++ai)
#pragma unroll
                for (int m = 0; m < 4; ++m) { const int row = row0 + ai * 128 + m * 16; const float rs = rstd_of(rowss, row); bf16* rp = gb + (size_t)row * 1024 + col0;
#pragma unroll
                    for (int bj = 0; bj < 2; ++bj) *(v4u*)(rp + bj * 128) = pack8(acc[ai][bj][m][0] * rs, acc[ai][bj][m][1] * rs); }
            return;
        }
        const int c0 = (u.pn - 4) * 128 + wc * 32 + 8 * fq; const bool sample = u.pm == 64;
        const f32x4 w0a = *(const f32x4*)(cw + c0), w0b = *(const f32x4*)(cw + c0 + 4), w1a = *(const f32x4*)(cw + 1024 + c0), w1b = *(const f32x4*)(cw + 1024 + c0 + 4),
                    w2a = *(const f32x4*)(cw + 2048 + c0), w2b = *(const f32x4*)(cw + 2048 + c0 + 4);
#pragma unroll
        for (int ai = 0; ai < 2; ++ai) { f32x4 gp0 = {0.f, 0.f, 0.f, 0.f}, gp1 = {0.f, 0.f, 0.f, 0.f}; const int blk = u.pm * 4 + ai * 2 + wr;
#pragma unroll
            for (int m = 0; m < 4; ++m) { const int row = u.pm * 256 + ai * 128 + wr * 64 + m * 16 + fr; const float rs = rstd_of(rowss, row); const float rs2 = rs * rs;
                const f32x4 g0 = acc[ai][0][m][0] * acc[ai][1][m][0] * rs2, g1 = acc[ai][0][m][1] * acc[ai][1][m][1] * rs2;
                f32x4 p1a, p2a, p1b, p2b;
#pragma unroll
                for (int j = 0; j < 4; ++j) { const float s1a = fr == 15 ? gp0[j] : g0[j], s2a = fr >= 14 ? gp0[j] : g0[j], s1b = fr == 15 ? gp1[j] : g1[j], s2b = fr >= 14 ? gp1[j] : g1[j];
                    p1a[j] = dpp_ror1(s1a); p2a[j] = dpp_ror2(s2a); p1b[j] = dpp_ror1(s1b); p2b[j] = dpp_ror2(s2b); }
                const f32x4 a0 = w0a * p2a + w1a * p1a + w2a * g0, a1 = w0b * p2b + w1b * p1b + w2b * g1;
                const bool valid = (m > 0 || fr >= 2) && !(sample && m == 2 && fr < 2);
                if (valid) *(v4u*)(zc + (size_t)row * 1024 + c0) = pack8(a0, a1);
                if ((m & 1) == 0 && fr < 2) { float* sg = SG + (size_t)(blk * 8 + 2 * m + fr) * 1024 + c0; *(f32x4*)sg = g0; *(f32x4*)(sg + 4) = g1; }
                if ((m & 1) == 1 && fr >= 14) { float* sg = SG + (size_t)(blk * 8 + 2 * m + fr - 14) * 1024 + c0; *(f32x4*)sg = g0; *(f32x4*)(sg + 4) = g1; }
                gp0 = g0; gp1 = g1; } }
    }
};

__device__ __forceinline__ int rowmap(int mode, int n) {
    if (mode == 1) { if (n >= 512 && n < 1152) { const int d = n & 63; return (n & ~63) | (32 * ((d >> 4) & 1) + 8 * ((d >> 2) & 3) + 4 * (d >> 5) + (d & 3)); } return n; }
    if (mode == 2) { return n < DFF ? ((n >> 7) * 256 + (n & 127)) : (((n - DFF) >> 7) * 256 + 128 + ((n - DFF) & 127)); }
    if (mode == 3) { if (n < 1024) return n; const int c = (n - 1024) & 1023, z = n >= 2048 ? 1 : 0; return 1024 + (c >> 7) * 256 + z * 128 + (c & 127); }
    return n;
}
__device__ __forceinline__ void tr_item(const float* W, int K, int N, bf16* WT, const float* gain, float scale, int mode, LAS float* scr, int item, int lane) {
    const int nblk = N / 32, kb = item / nblk, nb = item % nblk, k0 = 64 * kb, n0 = 32 * nb;
#pragma unroll
    for (int i = 0; i < 8; ++i) { const int idx = lane + 64 * i, kk = idx >> 3, n4 = (idx & 7) * 4; const float gs = gain ? ((const GAS float*)gain)[k0 + kk] * scale : scale;
        const f32x4 w = *(const GAS f32x4*)((const GAS float*)W + (size_t)(k0 + kk) * N + n0 + n4); LAS float* d = scr + kk * 33 + n4; d[0] = w[0] * gs; d[1] = w[1] * gs; d[2] = w[2] * gs; d[3] = w[3] * gs; }
    LDS_WAIT(); asm volatile("" ::: "memory");
    const int c = lane & 7;
#pragma unroll
    for (int j = 0; j < 4; ++j) { const int n = (lane >> 3) + 8 * j; const LAS float* s = scr + (8 * c) * 33 + n;
        v4u o; o.x = pg8::cvt_pk_bf16(s[0 * 33], s[1 * 33]); o.y = pg8::cvt_pk_bf16(s[2 * 33], s[3 * 33]); o.z = pg8::cvt_pk_bf16(s[4 * 33], s[5 * 33]); o.w = pg8::cvt_pk_bf16(s[6 * 33], s[7 * 33]);
        *(GAS v4u*)((GAS bf16*)WT + (size_t)rowmap(mode, n0 + n) * K + k0 + 8 * c) = o; }
    LDS_WAIT(); asm volatile("" ::: "memory");
}
__device__ __forceinline__ double dexp_(double y) {
    const double k = rint(y * 1.4426950408889634); const double r = (y - k * 0.6931471803691238) - k * 1.9082149292705877e-10;
    double p = 1.0 / 6227020800.0;
    p = p * r + 1.0 / 479001600.0; p = p * r + 1.0 / 39916800.0; p = p * r + 1.0 / 3628800.0; p = p * r + 1.0 / 362880.0; p = p * r + 1.0 / 40320.0; p = p * r + 1.0 / 5040.0;
    p = p * r + 1.0 / 720.0; p = p * r + 1.0 / 120.0; p = p * r + 1.0 / 24.0; p = p * r + 1.0 / 6.0; p = p * r + 0.5; p = p * r + 1.0; p = p * r + 1.0;
    const long long bits = (long long)(1023 + (int)k) << 52; return p * __builtin_bit_cast(double, bits);
}
__device__ __forceinline__ void dsincos_(double x, double& s, double& c) {
    const double k = rint(x * 0.6366197723675814); const double r = (x - k * 1.5707963267948966) - k * 6.123233995736766e-17; const double r2 = r * r;
    const double sp = r * (1.0 + r2 * (-1.0 / 6.0 + r2 * (1.0 / 120.0 + r2 * (-1.0 / 5040.0 + r2 * (1.0 / 362880.0 + r2 * (-1.0 / 39916800.0 + r2 * (1.0 / 6227020800.0)))))));
    const double cp = 1.0 + r2 * (-0.5 + r2 * (1.0 / 24.0 + r2 * (-1.0 / 720.0 + r2 * (1.0 / 40320.0 + r2 * (-1.0 / 3628800.0 + r2 * (1.0 / 479001600.0 + r2 * (-1.0 / 87178291200.0)))))));
    const int q = ((int)k) & 3;
    s = q == 0 ? sp : q == 1 ? cp : q == 2 ? -sp : -cp; c = q == 0 ? cp : q == 1 ? -sp : q == 2 ? -cp : sp;
}

__device__ __forceinline__ const bf16* kvptr(const bf16* proj, const bf16* cb, int sample, int b, int c, int kvh, int kk, int isv) {
    if (!sample) { int pos = (c - 2) * 64 + kk; pos = pos < 0 ? 0 : pos; return proj + (size_t)(b * 4096 + pos) * 1280 + 1024 + isv * 128 + kvh * 64; }
    if (kk < 128) return cb + (size_t)(b * 128 + kk) * 128 + kvh * 64;
    int t = kk - 128; t = t > 31 ? 31 : t; return proj + (size_t)(MP + b * 32 + t) * 1280 + 1024 + isv * 128 + kvh * 64;
}
__device__ __forceinline__ void swa_phase(const bf16* proj, const bf16* ckb, const bf16* cvb, const float* sinks, bf16* ycat, LAS unsigned char* lds, int tid, int wave, int lane, int G) {
    LAS bf16* VT = (LAS bf16*)lds;
    const int fr = lane & 15, quad = lane >> 4;
    for (int it = blockIdx.x; it < 528; it += G) {
        int b, c, kvh, sample;
        if (it < 512) { sample = 0; b = it >> 7; c = (it >> 1) & 63; kvh = it & 1; } else { sample = 1; b = (it - 512) >> 1; c = 0; kvh = it & 1; }
        __syncthreads();
#pragma unroll
        for (int i = 0; i < 3; ++i) { const int idx = tid + 512 * i, kk = idx % 192, dg = idx / 192; const v4u w = *(const GAS v4u*)((const GAS bf16*)kvptr(proj, cvb, sample, b, c, kvh, kk, 1) + dg * 8);
            LAS bf16* vp = VT + (dg * 8) * 200 + kk;
            vp[0] = (bf16)(w.x & 0xffffu); vp[200] = (bf16)(w.x >> 16); vp[400] = (bf16)(w.y & 0xffffu); vp[600] = (bf16)(w.y >> 16);
            vp[800] = (bf16)(w.z & 0xffffu); vp[1000] = (bf16)(w.z >> 16); vp[1200] = (bf16)(w.w & 0xffffu); vp[1400] = (bf16)(w.w >> 16); }
        __syncthreads();
        const int gq = wave >> 1, qhalf = wave & 1, head = kvh * 4 + gq;
        if (!(sample && qhalf)) {
            const int plo = sample ? 0 : (c >= 2 ? 0 : (2 - c) * 2), phi = sample ? 5 : 6;
            bf16x8 qf[2][2];
#pragma unroll
            for (int qb = 0; qb < 2; ++qb) { const int q = qhalf * 32 + qb * 16 + fr; const int row = sample ? MP + b * 32 + (q & 31) : b * 4096 + c * 64 + q;
                const GAS bf16* qp = (const GAS bf16*)proj + (size_t)row * 1280 + 512 + head * 64 + quad * 8; qf[qb][0] = *(const GAS bf16x8*)qp; qf[qb][1] = *(const GAS bf16x8*)(qp + 32); }
            f32x4 s[12][2];
#pragma unroll
            for (int kg = 0; kg < 3; ++kg) { bf16x8 kf[4][2];
#pragma unroll
                for (int i = 0; i < 4; ++i) { const int kb = kg * 4 + i, key = 32 * (kb >> 1) + (fr >> 2) * 8 + 4 * (kb & 1) + (fr & 3); const GAS bf16* kp = (const GAS bf16*)kvptr(proj, ckb, sample, b, c, kvh, key, 0) + quad * 8;
                    kf[i][0] = *(const GAS bf16x8*)kp; kf[i][1] = *(const GAS bf16x8*)(kp + 32); }
                __builtin_amdgcn_sched_barrier(0);
#pragma unroll
                for (int i = 0; i < 4; ++i)
#pragma unroll
                    for (int qb = 0; qb < 2; ++qb) { f32x4 a = {0.f, 0.f, 0.f, 0.f}; a = MFMA16(kf[i][0], qf[qb][0], a); a = MFMA16(kf[i][1], qf[qb][1], a); s[kg * 4 + i][qb] = a; }
                __builtin_amdgcn_sched_barrier(0); }
            const float sink = sinks[head];
            bf16x8 pf[6][2];
#pragma unroll
            for (int qb = 0; qb < 2; ++qb) { float mx = sink;
#pragma unroll
                for (int kb = 0; kb < 12; ++kb) { const bool pv = (kb >> 1) >= plo && (kb >> 1) < phi;
#pragma unroll
                    for (int j = 0; j < 4; ++j) { const float v = pv ? s[kb][qb][j] : -1e30f; s[kb][qb][j] = v; mx = fmaxf(mx, v); } }
                mx = fmaxf(mx, __shfl_xor(mx, 16)); mx = fmaxf(mx, __shfl_xor(mx, 32));
                float sum = 0.f;
#pragma unroll
                for (int kb = 0; kb < 12; ++kb)
#pragma unroll
                    for (int j = 0; j < 4; ++j) { const float e = __expf(s[kb][qb][j] - mx); s[kb][qb][j] = e; sum += e; }
                sum += __shfl_xor(sum, 16); sum += __shfl_xor(sum, 32); sum += __expf(sink - mx);
                const float inv = 1.0f / sum;
#pragma unroll
                for (int pr = 0; pr < 6; ++pr) pf[pr][qb] = __builtin_bit_cast(bf16x8, pack8(s[2 * pr][qb] * inv, s[2 * pr + 1][qb] * inv)); }
#pragma unroll
            for (int db = 0; db < 4; ++db) { bf16x8 vf[6];
#pragma unroll
                for (int pr = 0; pr < 6; ++pr) vf[pr] = *(const LAS bf16x8*)(VT + (db * 16 + fr) * 200 + 32 * pr + quad * 8);
#pragma unroll
                for (int qb = 0; qb < 2; ++qb) { f32x4 o = {0.f, 0.f, 0.f, 0.f};
#pragma unroll
                    for (int pr = 0; pr < 6; ++pr) o = MFMA16(pf[pr][qb], vf[pr], o);
#pragma unroll
                    for (int j = 0; j < 4; ++j) { const int q = qhalf * 32 + qb * 16 + quad * 4 + j;
                        if (!sample || q < 32) { const int row = sample ? MP + b * 32 + q : b * 4096 + c * 64 + q; ycat[(size_t)row * 1024 + 512 + head * 64 + db * 16 + fr] = (bf16)f2bf(o[j]); } } } }
        }
    }
    __syncthreads();
}

__device__ __forceinline__ void xattn_phase(const bf16* qx, const bf16* memk_l, const bf16* memvT_l, bf16* ox, int wave, int lane, int G) {
    const int fr = lane & 15, quad = lane >> 4;
    for (int t = wave * G + (int)blockIdx.x; t < 4160; t += 8 * G) {
        int bb, h, row0;
        if (t < 4096) { const int pair = t >> 8; bb = pair >> 2; h = pair & 3; row0 = bb * 4096 + (t & 255) * 16; }
        else { const int s = t - 4096, b = s >> 3; h = (s >> 1) & 3; bb = 4 + b; row0 = MP + b * 32 + (s & 1) * 16; }
        bf16x8 qf[8];
#pragma unroll
        for (int ks = 0; ks < 8; ++ks) qf[ks] = *(const bf16x8*)(qx + (size_t)(row0 + fr) * 1024 + h * 256 + ks * 32 + quad * 8);
        const bf16* kbase = memk_l + (size_t)bb * 262144 + h * 256 + quad * 8;
        f32x4 s[16];
#pragma unroll
        for (int kb = 0; kb < 16; ++kb) { const int key = 32 * (kb >> 1) + (fr >> 2) * 8 + 4 * (kb & 1) + (fr & 3); const bf16* kp = kbase + (size_t)key * 1024; f32x4 a = {0.f, 0.f, 0.f, 0.f};
#pragma unroll
            for (int ks = 0; ks < 8; ++ks) a = MFMA16(*(const bf16x8*)(kp + ks * 32), qf[ks], a);
            s[kb] = a; }
        float mx = -1e30f;
#pragma unroll
        for (int kb = 0; kb < 16; ++kb)
#pragma unroll
            for (int j = 0; j < 4; ++j) mx = fmaxf(mx, s[kb][j]);
        mx = fmaxf(mx, __shfl_xor(mx, 16)); mx = fmaxf(mx, __shfl_xor(mx, 32));
        float sum = 0.f;
#pragma unroll
        for (int kb = 0; kb < 16; ++kb)
#pragma unroll
            for (int j = 0; j < 4; ++j) { const float e = __expf(s[kb][j] - mx); s[kb][j] = e; sum += e; }
        sum += __shfl_xor(sum, 16); sum += __shfl_xor(sum, 32);
        const float inv = 1.0f / sum;
        bf16x8 pf[8];
#pragma unroll
        for (int pr = 0; pr < 8; ++pr) pf[pr] = __builtin_bit_cast(bf16x8, pack8(s[2 * pr] * inv, s[2 * pr + 1] * inv));
        const bf16* vbase = memvT_l + (size_t)bb * 262144 + (size_t)(h * 256 + fr) * 256 + quad * 8;
#pragma unroll 4
        for (int db = 0; db < 16; ++db) { f32x4 o = {0.f, 0.f, 0.f, 0.f};
#pragma unroll
            for (int pr = 0; pr < 8; ++pr) o = MFMA16(pf[pr], *(const bf16x8*)(vbase + (size_t)db * 4096 + pr * 32), o);
#pragma unroll
            for (int j = 0; j < 4; ++j) ox[(size_t)(row0 + quad * 4 + j) * 1024 + h * 256 + db * 16 + fr] = (bf16)f2bf(o[j]); }
    }
}


__device__ __forceinline__ void xstage(const bf16* src, size_t rowstride, LAS unsigned char* lds, int tid) {
    v4u t[16];
#pragma unroll
    for (int i = 0; i < 16; ++i) { const int row = (tid >> 5) + 16 * i, ch = tid & 31; t[i] = *(const GAS v4u*)((const GAS bf16*)src + (size_t)row * rowstride + ch * 8); }
#pragma unroll
    for (int i = 0; i < 16; ++i) { const int row = (tid >> 5) + 16 * i, ch = tid & 31; *(LAS v4u*)(lds + row * 528 + ch * 16) = t[i]; }
}
__device__ __forceinline__ void xattn_phase2(const bf16* qx, const bf16* memk_l, const bf16* memvT_l, bf16* ox, LAS unsigned char* lds, int tid, int wave, int lane, int G) {
    const int fr = lane & 15, quad = lane >> 4;
    for (int it = blockIdx.x; it < 256 + 32; it += G) {
        int bb, h, rowbase, nqb; bool active;
        if (it < 256) { bb = it >> 6; h = (it >> 4) & 3; rowbase = bb * 4096 + (it & 15) * 256; nqb = 2; active = true; }
        else { const int s = it - 256, b = s >> 2; h = s & 3; bb = 4 + b; rowbase = MP + b * 32; nqb = 1; active = wave < 2; }
        __syncthreads();
        xstage(memk_l + (size_t)bb * 262144 + h * 256, 1024, lds, tid);
        __syncthreads();
        bf16x8 pf[2][8];
#pragma unroll
        for (int qi = 0; qi < 2; ++qi) {
            if (qi < nqb && active) {
                const int row0 = rowbase + qi * 128 + wave * 16;
                bf16x8 qf[8];
#pragma unroll
                for (int ks = 0; ks < 8; ++ks) qf[ks] = *(const GAS bf16x8*)((const GAS bf16*)qx + (size_t)(row0 + fr) * 1024 + h * 256 + ks * 32 + quad * 8);
                f32x4 s[16];
#pragma unroll
                for (int kb = 0; kb < 16; ++kb) { const int key = 32 * (kb >> 1) + (fr >> 2) * 8 + 4 * (kb & 1) + (fr & 3); const LAS unsigned char* kp = lds + key * 528 + quad * 16; f32x4 a = {0.f, 0.f, 0.f, 0.f};
#pragma unroll
                    for (int ks = 0; ks < 8; ++ks) a = MFMA16(*(const LAS bf16x8*)(kp + ks * 64), qf[ks], a);
                    s[kb] = a; }
                float mx = -1e30f;
#pragma unroll
                for (int kb = 0; kb < 16; ++kb)
#pragma unroll
                    for (int j = 0; j < 4; ++j) mx = fmaxf(mx, s[kb][j]);
                mx = fmaxf(mx, __shfl_xor(mx, 16)); mx = fmaxf(mx, __shfl_xor(mx, 32));
                float sum = 0.f;
#pragma unroll
                for (int kb = 0; kb < 16; ++kb)
#pragma unroll
                    for (int j = 0; j < 4; ++j) { const float e = __expf(s[kb][j] - mx); s[kb][j] = e; sum += e; }
                sum += __shfl_xor(sum, 16); sum += __shfl_xor(sum, 32);
                const float inv = 1.0f / sum;
#pragma unroll
                for (int pr = 0; pr < 8; ++pr) pf[qi][pr] = __builtin_bit_cast(bf16x8, pack8(s[2 * pr] * inv, s[2 * pr + 1] * inv));
            }
        }
        __syncthreads();
        xstage(memvT_l + (size_t)bb * 262144 + (size_t)h * 65536, 256, lds, tid);
        __syncthreads();
#pragma unroll
        for (int qi = 0; qi < 2; ++qi) {
            if (qi < nqb && active) {
                const int row0 = rowbase + qi * 128 + wave * 16;
#pragma unroll 4
                for (int db = 0; db < 16; ++db) { f32x4 o = {0.f, 0.f, 0.f, 0.f}; const LAS unsigned char* vp = lds + (db * 16 + fr) * 528 + quad * 16;
#pragma unroll
                    for (int pr = 0; pr < 8; ++pr) o = MFMA16(*(const LAS bf16x8*)(vp + pr * 64), pf[qi][pr], o);
                    u32x2v w; w.x = pk2(o[0], o[1]); w.y = pk2(o[2], o[3]);
                    *(GAS u32x2v*)((GAS bf16*)ox + (size_t)(row0 + fr) * 1024 + h * 256 + db * 16 + quad * 4) = w; }
            }
        }
    }
    __syncthreads();
}

__device__ __forceinline__ void s5_stage_u(const bf16* up, LAS float* ubuf, int lane) {
    const v4u w0 = *(const v4u*)up, w1 = *(const v4u*)(up + 8);
    LAS f32x4* d = (LAS f32x4*)(ubuf + lane * 16);
    d[0] = (f32x4){bflo(w0.x), bfhi(w0.x), bflo(w0.y), bfhi(w0.y)}; d[1] = (f32x4){bflo(w0.z), bfhi(w0.z), bflo(w0.w), bfhi(w0.w)};
    d[2] = (f32x4){bflo(w1.x), bfhi(w1.x), bflo(w1.y), bfhi(w1.y)}; d[3] = (f32x4){bflo(w1.z), bfhi(w1.z), bflo(w1.w), bfhi(w1.w)};
}
__device__ __forceinline__ f32x2v lo2_(f32x4 v) { return __builtin_shufflevector(v, v, 0, 1); }
__device__ __forceinline__ f32x2v hi2_(f32x4 v) { return __builtin_shufflevector(v, v, 2, 3); }
#define S5_STEP(sidx) do { const LAS f32x4* up_ = (const LAS f32x4*)(ubuf + (sidx) * 16); const f32x4 u0 = up_[0], u1 = up_[1], u2 = up_[2], u3 = up_[3]; \
    f32x2v ac_ = lo2_(bb[0]) * u0[0]; ac_ = hi2_(bb[0]) * u0[1] + ac_; ac_ = lo2_(bb[1]) * u0[2] + ac_; ac_ = hi2_(bb[1]) * u0[3] + ac_; \
    ac_ = lo2_(bb[2]) * u1[0] + ac_; ac_ = hi2_(bb[2]) * u1[1] + ac_; ac_ = lo2_(bb[3]) * u1[2] + ac_; ac_ = hi2_(bb[3]) * u1[3] + ac_; \
    ac_ = lo2_(bb[4]) * u2[0] + ac_; ac_ = hi2_(bb[4]) * u2[1] + ac_; ac_ = lo2_(bb[5]) * u2[2] + ac_; ac_ = hi2_(bb[5]) * u2[3] + ac_; \
    ac_ = lo2_(bb[6]) * u3[0] + ac_; ac_ = hi2_(bb[6]) * u3[1] + ac_; ac_ = lo2_(bb[7]) * u3[2] + ac_; ac_ = hi2_(bb[7]) * u3[3] + ac_; \
    const float nr_ = ar * hr - ai * hi + ac_.x, ni_ = ar * hi + ai * hr + ac_.y; hr = nr_; hi = ni_; } while (0)

typedef short bf16x4_t __attribute__((ext_vector_type(4)));
#define MFMA16K16(a, b, c) __builtin_amdgcn_mfma_f32_16x16x16bf16_1k(a, b, c, 0, 0, 0)
__device__ __forceinline__ void s5_bu_block(const bf16* urow0, const bf16x4_t (&bcf)[8], LAS float* bul, int fr, int quad) {
    const bf16x4_t a = *(const GAS bf16x4_t*)((const GAS bf16*)urow0 + (size_t)fr * 1280 + quad * 4);
#pragma unroll
    for (int cb = 0; cb < 8; ++cb) { f32x4 d = {0.f, 0.f, 0.f, 0.f}; d = MFMA16K16(a, bcf[cb], d);
#pragma unroll
        for (int j = 0; j < 4; ++j) bul[(quad * 4 + j) * 130 + cb * 16 + fr] = d[j]; }
}
__device__ __forceinline__ void s5_local(const bf16* proj, const float* abar, const bf16* bbt, float* sloc, LAS float* bul, int slot, int nslots, int lane) {
    const int fr = lane & 15, quad = lane >> 4;
    for (int t = slot; t < 8192; t += nslots) {
        const int chunk = t & 63, g = (t >> 6) & 31, b = t >> 11;
        const float ar = abar[(g * 64 + lane) * 2], ai = abar[(g * 64 + lane) * 2 + 1];
        bf16x4_t bcf[8];
#pragma unroll
        for (int cb = 0; cb < 8; ++cb) bcf[cb] = *(const GAS bf16x4_t*)((const GAS bf16*)bbt + (size_t)(g * 128 + cb * 16 + fr) * 16 + quad * 4);
        float hr = 0.f, hi = 0.f;
        for (int blk = 0; blk < 4; ++blk) {
            s5_bu_block(proj + (size_t)(b * 4096 + chunk * 64 + blk * 16) * 1280 + g * 16, bcf, bul, fr, quad);
#pragma unroll 4
            for (int s = 0; s < 16; ++s) { const f32x2v bu = *(const LAS f32x2v*)(bul + s * 130 + 2 * lane); const float nr = ar * hr - ai * hi + bu.x, ni = ar * hi + ai * hr + bu.y; hr = nr; hi = ni; }
        }
        *(f32x2v*)(sloc + (size_t)t * 128 + lane * 2) = (f32x2v){hr, hi};
    }
}
__device__ __forceinline__ void s5_out(const bf16* proj, const float* abar, const bf16* bbt, const float* sloc, const float* st_re, const float* st_im, const float* c_re, const float* c_im,
                                       const float* dcoef, bf16* gbuf, float* out, LAS float* bul, LAS unsigned* hbuf, int slot, int nslots, int lane) {
    const int fr = lane & 15, quad = lane >> 4;
    for (int t = slot; t < 8192 + 256; t += nslots) {
        const int sample = t >= 8192; int b, g, chunk, nblk, rowbase;
        if (!sample) { chunk = t & 63; g = (t >> 6) & 31; b = t >> 11; nblk = 4; rowbase = b * 4096 + chunk * 64; } else { const int s = t - 8192; g = s & 31; b = s >> 5; chunk = 0; nblk = 2; rowbase = MP + b * 32; }
        const float ar = abar[(g * 64 + lane) * 2], ai = abar[(g * 64 + lane) * 2 + 1];
        bf16x4_t bcf[8];
#pragma unroll
        for (int cb = 0; cb < 8; ++cb) bcf[cb] = *(const GAS bf16x4_t*)((const GAS bf16*)bbt + (size_t)(g * 128 + cb * 16 + fr) * 16 + quad * 4);
        float hr, hi;
        if (!sample) { float pr = ar, pi = ai;
#pragma unroll
            for (int i = 0; i < 6; ++i) { const float t1 = pr * pr - pi * pi; pi = 2.f * pr * pi; pr = t1; }
            hr = 0.f; hi = 0.f; const float* sp = sloc + (size_t)(t - chunk) * 128 + lane * 2;
#pragma unroll 16
            for (int cc = 0; cc < chunk; ++cc) { const f32x2v sv = *(const f32x2v*)(sp + (size_t)cc * 128); const float nr = pr * hr - pi * hi + sv.x, ni = pr * hi + pi * hr + sv.y; hr = nr; hi = ni; } }
        else { hr = st_re[(b * 32 + g) * 64 + lane]; hi = st_im[(b * 32 + g) * 64 + lane]; }
        bf16x8 cf[4];
#pragma unroll
        for (int ks = 0; ks < 4; ++ks) { const f32x4 cr = *(const f32x4*)(c_re + (size_t)(g * 16 + fr) * 64 + ks * 16 + quad * 4), ci = *(const f32x4*)(c_im + (size_t)(g * 16 + fr) * 64 + ks * 16 + quad * 4);
            v4u w; w.x = pg8::cvt_pk_bf16(cr[0], -ci[0]); w.y = pg8::cvt_pk_bf16(cr[1], -ci[1]); w.z = pg8::cvt_pk_bf16(cr[2], -ci[2]); w.w = pg8::cvt_pk_bf16(cr[3], -ci[3]); cf[ks] = __builtin_bit_cast(bf16x8, w); }
        const float dco = dcoef[g * 16 + fr];
        for (int blk = 0; blk < nblk; ++blk) {
            const bf16* urow0 = proj + (size_t)(rowbase + blk * 16) * 1280 + g * 16;
            s5_bu_block(urow0, bcf, bul, fr, quad);
#pragma unroll 4
            for (int s = 0; s < 16; ++s) { const f32x2v bu = *(const LAS f32x2v*)(bul + s * 130 + 2 * lane); const float nr = ar * hr - ai * hi + bu.x, ni = ar * hi + ai * hr + bu.y; hr = nr; hi = ni; hbuf[s * 68 + lane] = pg8::cvt_pk_bf16(hr, hi); }
            f32x4 y = {0.f, 0.f, 0.f, 0.f};
#pragma unroll
            for (int ks = 0; ks < 4; ++ks) { const bf16x8 a = *(const LAS bf16x8*)(hbuf + fr * 68 + ks * 16 + quad * 4); y = MFMA16(a, cf[ks], y); }
#pragma unroll
            for (int j = 0; j < 4; ++j) { const int s = blk * 16 + quad * 4 + j; const float uu = bflo((unsigned)((const GAS bf16*)urow0)[(size_t)(quad * 4 + j) * 1280 + fr]); const float yv = y[j] + dco * uu;
                const float z = 0.7978845608028654f * (yv + 0.044715f * yv * yv * yv); const float th = 1.0f - 2.0f / (1.0f + __expf(2.0f * z)); const float gl = 0.5f * yv * (1.0f + th);
                ((GAS bf16*)gbuf)[(size_t)(rowbase + s) * 512 + g * 16 + fr] = (bf16)f2bf(gl); }
        }
        if (!sample && chunk == 63) { out[OFF_SRP + (b * 32 + g) * 64 + lane] = hr; out[OFF_SIP + (b * 32 + g) * 64 + lane] = hi; }
        if (sample) { out[OFF_SRS + (b * 32 + g) * 64 + lane] = hr; out[OFF_SIS + (b * 32 + g) * 64 + lane] = hi; }
    }
}

template <int KIND>
__device__ __forceinline__ void sample_gemm(const bf16* A, const bf16* Bt, int K, LAS unsigned char* lds, int tid, int wave, int lane,
                                            bf16* xbp, const float* base_f32, float* part_next, const float* part_cur, bf16* O) {
    const int fr = lane & 15, quad = lane >> 4;
    LAS f32x4* red = (LAS f32x4*)lds;
    LAS float* ssred = (LAS float*)(lds + 32768);
    for (int tile = blockIdx.x; tile < 256; tile += gridDim.x) {
        const int r0 = MP + (tile >> 4) * 16, c0 = (tile & 15) * 64, kw = K >> 3;
        const bf16* ap = A + (size_t)(r0 + fr) * K + wave * kw + quad * 8;
        const bf16* bp = Bt + (size_t)(c0 + fr) * K + wave * kw + quad * 8;
        f32x4 acc[4];
#pragma unroll
        for (int cb = 0; cb < 4; ++cb) acc[cb] = (f32x4){0.f, 0.f, 0.f, 0.f};
        const int nks = kw >> 5;
        for (int k0 = 0; k0 < nks; k0 += 4) {
            bf16x8 a[4], b[4][4];
#pragma unroll
            for (int i = 0; i < 4; ++i) { const int ks = (k0 + i < nks) ? k0 + i : nks - 1;
                a[i] = *(const bf16x8*)(ap + ks * 32);
#pragma unroll
                for (int cb = 0; cb < 4; ++cb) b[i][cb] = *(const bf16x8*)(bp + (size_t)cb * 16 * K + ks * 32); }
            __builtin_amdgcn_sched_barrier(0);
#pragma unroll
            for (int i = 0; i < 4; ++i) if (k0 + i < nks) {
#pragma unroll
                for (int cb = 0; cb < 4; ++cb) acc[cb] = MFMA16(b[i][cb], a[i], acc[cb]); }
        }
#pragma unroll
        for (int cb = 0; cb < 4; ++cb) red[(wave * 4 + cb) * 64 + lane] = acc[cb] * 1.0f;
        __syncthreads();
        if (tid < 256) { const int cb = tid >> 6, l2 = tid & 63; f32x4 v = red[cb * 64 + l2];
#pragma unroll
            for (int w = 1; w < 8; ++w) v = v + red[(w * 4 + cb) * 64 + l2];
            const int row = r0 + (l2 & 15), col = c0 + cb * 16 + 4 * (l2 >> 4); const size_t off = (size_t)row * 1024 + col;
            if (KIND == 0) { f32x4 bs;
                if (base_f32) bs = *(const f32x4*)(base_f32 + off);
                else { const u32x2v w = *(const u32x2v*)(xbp + off); bs = (f32x4){bflo(w.x), bfhi(w.x), bflo(w.y), bfhi(w.y)}; }
                v = v + bs; u32x2v o; o.x = pk2(v[0], v[1]); o.y = pk2(v[2], v[3]); *(u32x2v*)(xbp + off) = o;
                float ss = (v[0] * v[0] + v[1] * v[1]) + (v[2] * v[2] + v[3] * v[3]); ss += __shfl_xor(ss, 16); ss += __shfl_xor(ss, 32);
                if ((l2 >> 4) == 0) ssred[cb * 16 + (l2 & 15)] = ss; }
            else { const float rs = rstd_of(part_cur, row); u32x2v o; o.x = pk2(v[0] * rs, v[1] * rs); o.y = pk2(v[2] * rs, v[3] * rs); *(u32x2v*)(O + off) = o; }
        }
        if (KIND == 0) { __syncthreads(); if (tid < 16) part_next[(size_t)(r0 + tid) * 16 + (tile & 15)] = (ssred[tid] + ssred[16 + tid]) + (ssred[32 + tid] + ssred[48 + tid]); }
        __syncthreads();
    }
}

struct Params { const float* in[36]; float* out; unsigned char* ws; int use_cg, pad; };

__global__ void __launch_bounds__(512, 2) mega_fwd(Params P) {
    extern __shared__ __attribute__((aligned(16))) unsigned char lds_raw[];
    LAS unsigned char* lds = (LAS unsigned char*)lds_raw;
    volatile LAS unsigned* MISC = (volatile LAS unsigned*)(lds + MISC_OFF);
    const int G = gridDim.x, NGW = G * 8, NT = G * 512;
    const int wave_s = __builtin_amdgcn_readfirstlane(threadIdx.x >> 6);
    for (int u = threadIdx.x; u < (LDS_BYTES - 131072) / 4; u += 512) ((LAS unsigned*)(lds + 131072))[u] = 0u;
    __syncthreads();
    XcdBarrier bar = xcd_barrier_post((unsigned*)(P.ws + WS_BAR), MISC + 8);
#ifndef STOP_AFTER
#define STOP_AFTER 1000
#endif
    int ph = 0;
#define RUN (ph < STOP_AFTER)
#define FRESH() const int tid = fresh_tid(wave_s), lane = tid & 63, wave = __builtin_amdgcn_readfirstlane(tid >> 6); const int gw = blockIdx.x * 8 + wave, gt = blockIdx.x * 512 + tid; (void)gw; (void)gt; (void)lane; LAS float* wscr = (LAS float*)(lds + 32768 + wave * 12288); (void)wscr;
#define SEAM() do { if (P.use_cg) cg::this_grid().sync(); else xcd_barrier(bar); ++ph; } while (0)

#define part ((float*)(ws + WS_PART))
#define PARTBUF(k) (part + (size_t)((k) & 1) * PART_ELEMS)
#define ropec ((float*)(ws + WS_ROPE))
#define ropes (ropec + 4096 * 32)
#define abar ((float*)(ws + WS_SSM))
#define bbar (abar + 32 * 64 * 2)
#define bbt ((bf16*)(bbar + 32 * 64 * 32))
#define ckb ((bf16*)(ws + WS_CKV))
#define cvb (ckb + 8 * 128 * 128)
#define sloc ((float*)(ws + WS_SLOC))
#define memk ((bf16*)(ws + WS_MEMK))
#define memvT ((bf16*)(ws + WS_MEMVT))
#define SG ((float*)(ws + WS_SIDE))
#define SV ((float*)(ws + WS_SIDE + SG_BYTES))
#define WT ((bf16*)(ws + WS_WT))
#define xb ((bf16*)(ws + WS_XB))
#define tmp (ws + WS_TMP)
#define proj0 ((bf16*)(tmp + TMP_PROJ0))
#define gbuf ((bf16*)(tmp + TMP_GBUF))
#define ycat ((bf16*)(tmp + TMP_YCAT))
#define memb ((bf16*)(tmp + TMP_MEMB))
#define qx ((bf16*)(tmp + TMP_QX))
#define ox ((bf16*)(tmp + TMP_OX))
#define act ((bf16*)(tmp + TMP_ACT))
#define gbm ((bf16*)(tmp + TMP_GB))
#define zc ((bf16*)(tmp + TMP_ZC))
#define PTRS() unsigned char* ws = P.ws; float* out = P.out; asm volatile("" : "+s"(ws), "+s"(out));
    if (RUN) { PTRS() FRESH()
        {
            constexpr int NITEMS = 640 + 128 + 512 + 512 + 2 * 1024 + 512 + 2816 + 1408 + 2048;
            for (int it = gw; it < NITEMS; it += NGW) { int r = it;
#define TR(Wp, K_, N_, WTp, gainp, sc, mode) { const int ni_ = ((K_) / 64) * ((N_) / 32); if (r < ni_) { tr_item(Wp, K_, N_, WTp, gainp, sc, mode, wscr, r, lane); continue; } r -= ni_; }
                TR(P.in[15], 1024, 1280, WT + WT_INEVEN, P.in[11], 1.f, 1)
                TR(P.in[25], 512, 512, WT + WT_GLU, nullptr, 1.f, 0)
                TR(P.in[16], 1024, 1024, WT + WT_OUTEVEN, nullptr, 1.f, 0)
                TR(P.in[30], 1024, 1024, WT + WT_WQ, P.in[12], 0.0625f, 0)
                TR(P.in[31], 1024, 2048, WT + WT_WKV, nullptr, 1.f, 0)
                TR(P.in[31] + 2097152, 1024, 2048, WT + WT_WKV + 2097152, nullptr, 1.f, 0)
                TR(P.in[32], 1024, 1024, WT + WT_WO, nullptr, 1.f, 0)
                TR(P.in[33], 1024, 5632, WT + WT_UP, P.in[13], 1.f, 2)
                TR(P.in[35], 2816, 1024, WT + WT_DOWN, nullptr, 1.f, 0)
                { const int mi = r >> 7, l = mi >> 3, b = mi & 7; tr_item(P.in[10] + (size_t)mi * 262144, 256, 1024, memvT + (size_t)(l * 12 + 4 + b) * 262144, nullptr, 1.f, 0, wscr, r & 127, lane); }
            }
        }
        for (int m = gw; m < MROWS; m += NGW) { const float* xr = m < MP ? P.in[0] + (size_t)m * 1024 : P.in[1] + (size_t)(m - MP) * 1024; float ss = 0.f;
#pragma unroll
            for (int j = 0; j < 4; ++j) { const f32x4 v = *(const f32x4*)(xr + (lane + 64 * j) * 4); ss += (v[0] * v[0] + v[1] * v[1]) + (v[2] * v[2] + v[3] * v[3]);
                u32x2v w; w.x = pg8::cvt_pk_bf16(v[0], v[1]); w.y = pg8::cvt_pk_bf16(v[2], v[3]); *(u32x2v*)(xb + (size_t)m * 1024 + (lane + 64 * j) * 4) = w; }
            ss = wave_sum(ss); if (lane < 16) PARTBUF(0)[(size_t)m * 16 + lane] = lane == 0 ? ss : 0.f; }
        for (int i = gt; i < 262144; i += NT) { const f32x4 v = *(const f32x4*)(P.in[2] + (size_t)i * 4); u32x2v w; w.x = pg8::cvt_pk_bf16(v[0], v[1]); w.y = pg8::cvt_pk_bf16(v[2], v[3]); *(u32x2v*)(memb + (size_t)i * 4) = w; }
        for (int i = gt; i < 1048576; i += NT) { const size_t e = (size_t)i * 4; const int lb = (int)(e >> 18), l = lb >> 3, b = lb & 7; const f32x4 v = *(const f32x4*)(P.in[9] + e);
            u32x2v w; w.x = pg8::cvt_pk_bf16(v[0], v[1]); w.y = pg8::cvt_pk_bf16(v[2], v[3]); *(u32x2v*)(memk + (size_t)(l * 12 + 4 + b) * 262144 + (e & 262143)) = w; }
        for (int i = gt; i < 65536; i += NT) { const int j = i & 32767; const float* src = (i < 32768 ? P.in[3] : P.in[4]) + (size_t)j * 4; bf16* dst = (i < 32768 ? ckb : cvb) + (size_t)j * 4;
            const f32x4 v = *(const f32x4*)src; u32x2v w; w.x = pg8::cvt_pk_bf16(v[0], v[1]); w.y = pg8::cvt_pk_bf16(v[2], v[3]); *(u32x2v*)dst = w; }
        for (int i = gt; i < 4096 * 32; i += NT) { const int pos = i >> 5, d = i & 31; const double inv = dexp_(-(double)d * (9.210340371976184 / 32.0)); double s, c; dsincos_((double)pos * inv, s, c); ropec[i] = (float)c; ropes[i] = (float)s; }
        for (int i = gt; i < 2048; i += NT) { const double are = P.in[17][i], aim = P.in[18][i], dt = dexp_((double)P.in[19][i]); double s, c; dsincos_(aim * dt, s, c); const double mag = dexp_(are * dt);
            const double br = mag * c, bi = mag * s; abar[2 * i] = (float)br; abar[2 * i + 1] = (float)bi;
            const double nr = br - 1.0, ni = bi, den = are * are + aim * aim; const double qr = (nr * are + ni * aim) / den, qi = (ni * are - nr * aim) / den;
#pragma unroll 4
            for (int h = 0; h < 16; ++h) { const double xr = P.in[20][(size_t)i * 16 + h], xi = P.in[21][(size_t)i * 16 + h]; const float fre = (float)(qr * xr - qi * xi), fim = (float)(qr * xi + qi * xr); bbar[(size_t)i * 32 + 2 * h] = fre; bbar[(size_t)i * 32 + 2 * h + 1] = fim;
                bbt[((size_t)i * 2) * 16 + h] = (bf16)f2bf(fre); bbt[((size_t)i * 2 + 1) * 16 + h] = (bf16)f2bf(fim); } }
    }
    SEAM();
    if (RUN) { PTRS()
        if (G < 128 || (int)blockIdx.x >= G - 64) { pg8::Gemm g{memb, WT + WT_WKV, 1024, 4096, 1024}; pg8::StaticOrder S;
            if (G < 128) S.init(1024, 4096, G, (int)blockIdx.x); else S.init(1024, 4096, 64, (int)blockIdx.x - (G - 64)); EpiKV E{out, memk};
          pg8::gemm_phase<EpiKV, pg8::StaticOrder, true, true>(lds, g, S, E, wave_s); }
        { pg8::Gemm g{xb, WT + WT_INEVEN, MROWS, 1280, 1024}; pg8::StaticOrderF S; S.init(MROWS, 1280, G, (int)blockIdx.x); EpiIn0 E{proj0, PARTBUF(0), ropec, ropes, out};
          pg8::gemm_phase<EpiIn0, pg8::StaticOrderF, true, true>(lds, g, S, E, wave_s); }
        {
            FRESH()
            const int bx = (int)blockIdx.x, n2 = 325 - G;
            int slot = -1, nw = 1;
            if (G == 256) { if (bx >= n2 && bx < G - 64) { slot = (bx - n2) * 8 + wave; nw = (G - 64 - n2) * 8; } } else { slot = gw; nw = NGW; }
            if (slot >= 0) for (int it = slot; it < 2816 + 1408; it += nw) { int r = it;
                TR(P.in[33] + (size_t)1024 * 5632, 1024, 5632, WT + WT_UP + (size_t)5632 * 1024, P.in[13] + 1024, 1.f, 2)
                tr_item(P.in[35] + (size_t)2816 * 1024, 2816, 1024, WT + WT_DOWN + (size_t)2816 * 1024, nullptr, 1.f, 0, wscr, r, lane); }
        }
    }
    SEAM();
    if (RUN) { PTRS() FRESH()
        swa_phase(proj0, ckb, cvb, P.in[26], ycat, lds, tid, wave, lane, G);
        s5_local(proj0, abar, bbt, sloc, wscr, wave * G + (int)blockIdx.x, NGW, lane);
        for (int it = wave * G + (int)blockIdx.x; it < 1024; it += NGW) { const int mi = it >> 7, l = mi >> 2, b = mi & 3;
            tr_item(out + OFF_MVP + (size_t)mi * 262144, 256, 1024, memvT + (size_t)(l * 12 + b) * 262144, nullptr, 1.f, 0, wscr, it & 127, lane); }
    }
    SEAM();
    if (RUN) { PTRS() FRESH() s5_out(proj0, abar, bbt, sloc, P.in[5], P.in[6], P.in[22], P.in[23], P.in[24], gbuf, out, (LAS float*)(lds + wave * 16384), (LAS unsigned*)(lds + wave * 16384 + 8448), wave * G + (int)blockIdx.x, NGW, lane); }
    SEAM();
    if (RUN) { PTRS() pg8::Gemm g{gbuf, WT + WT_GLU, MROWS, 512, 512}; pg8::StaticOrder S; S.init(MROWS, 512, G, (int)blockIdx.x); EpiGlu E{gbuf, ycat};
        pg8::gemm_phase<EpiGlu, pg8::StaticOrder, true, true>(lds, g, S, E, wave_s);
        {
            FRESH()
            const int bx = (int)blockIdx.x; int slot = -1, nw = 1;
            if (G > 130) { if (bx >= 130) { slot = (bx - 130) * 8 + wave; nw = (G - 130) * 8; } } else { slot = gw; nw = NGW; }
            if (slot >= 0) for (int it = slot; it < 1536 + 512; it += nw) { int r = it;
                TR(P.in[27], 1024, 3072, WT + WT_INODD, P.in[11] + 1024, 1.f, 3)
                tr_item(P.in[29], 1024, 1024, WT + WT_OUTODD, nullptr, 1.f, 0, wscr, r, lane); }
        } }
    SEAM();

#pragma unroll
    for (int l = 0; l < 2; ++l) {
        if (l == 1) {
            if (RUN) { PTRS() pg8::Gemm g{xb, WT + WT_INODD, MROWS, 3072, 1024}; pg8::StaticOrderF S; S.init(MROWS, 3072, G, (int)blockIdx.x); EpiInOdd E{gbm, zc, PARTBUF(3), P.in[28], SG};
                pg8::gemm_phase<EpiInOdd, pg8::StaticOrderF, true, true>(lds, g, S, E, wave_s); }
            SEAM();
            if (RUN) { PTRS() FRESH()
                const float* cw = P.in[28]; const float* st = P.in[7];
                for (int i = gt; i < MROWS * 128; i += NT) { const int row = i >> 7, c0 = (i & 127) * 8, blk = row >> 6, r = row & 63;
                    const bool smp = row >= MP; const int rr = smp ? (r & 31) : r;
                    f32x4 z0, z1;
                    if (rr < 2) { const int sb = smp ? (r >> 5) * 4 : 0;
                        f32x4 pa0, pa1, pb0, pb1;
                        if (smp) { const int b = (blk - 256) * 2 + (r >> 5); const float* s0 = st + (size_t)(b * 2) * 1024 + c0; pa0 = *(const f32x4*)s0; pa1 = *(const f32x4*)(s0 + 4); pb0 = *(const f32x4*)(s0 + 1024); pb1 = *(const f32x4*)(s0 + 1028); }
                        else if ((blk & 63) == 0) { pa0 = pa1 = pb0 = pb1 = (f32x4){0.f, 0.f, 0.f, 0.f}; }
                        else { const float* s0 = SG + (size_t)((blk - 1) * 8 + 6) * 1024 + c0; pa0 = *(const f32x4*)s0; pa1 = *(const f32x4*)(s0 + 4); pb0 = *(const f32x4*)(s0 + 1024); pb1 = *(const f32x4*)(s0 + 1028); }
                        const float* sc = SG + (size_t)(blk * 8 + sb) * 1024 + c0; const f32x4 x00 = *(const f32x4*)sc, x01 = *(const f32x4*)(sc + 4);
                        f32x4 xm2a, xm2b, xm1a, xm1b, xca, xcb;
                        if (rr == 0) { xm2a = pa0; xm2b = pa1; xm1a = pb0; xm1b = pb1; xca = x00; xcb = x01; }
                        else { xm2a = pb0; xm2b = pb1; xm1a = x00; xm1b = x01; xca = *(const f32x4*)(sc + 1024); xcb = *(const f32x4*)(sc + 1028); }
                        const f32x4 w0a = *(const f32x4*)(cw + c0), w0b = *(const f32x4*)(cw + c0 + 4), w1a = *(const f32x4*)(cw + 1024 + c0), w1b = *(const f32x4*)(cw + 1028 + c0), w2a = *(const f32x4*)(cw + 2048 + c0), w2b = *(const f32x4*)(cw + 2052 + c0);
                        z0 = w0a * xm2a + w1a * xm1a + w2a * xca; z1 = w0b * xm2b + w1b * xm1b + w2b * xcb; }
                    else { const v4u zw = *(const v4u*)(zc + (size_t)row * 1024 + c0); z0 = (f32x4){bflo(zw.x), bfhi(zw.x), bflo(zw.y), bfhi(zw.y)}; z1 = (f32x4){bflo(zw.z), bfhi(zw.z), bflo(zw.w), bfhi(zw.w)}; }
                    const v4u gw_ = *(const v4u*)(gbm + (size_t)row * 1024 + c0);
                    const f32x4 g0 = (f32x4){bflo(gw_.x), bfhi(gw_.x), bflo(gw_.y), bfhi(gw_.y)}, g1 = (f32x4){bflo(gw_.z), bfhi(gw_.z), bflo(gw_.w), bfhi(gw_.w)};
                    *(v4u*)(gbm + (size_t)row * 1024 + c0) = pack8(g0 * z0, g1 * z1); }
                for (int i = gt; i < 4 * 2 * 1024; i += NT) { const int c = i & 1023, j = (i >> 10) & 1, b = i >> 11; out[OFF_CMP + i] = SG[(size_t)((64 * b + 63) * 8 + 6 + j) * 1024 + c]; }
                for (int i = gt; i < 8 * 2 * 1024; i += NT) { const int c = i & 1023, j = (i >> 10) & 1, b = i >> 11; out[OFF_CMS + i] = SG[(size_t)((256 + (b >> 1)) * 8 + (b & 1) * 4 + 2 + j) * 1024 + c]; }
            }
            SEAM();
        }
        if (RUN) { PTRS() pg8::Gemm g{(bf16*)(tmp + (size_t)(1 - l) * TMP_YCAT), WT + WT_OUTEVEN + (size_t)l * (WT_OUTODD - WT_OUTEVEN), MP, 1024, 1024}; pg8::StaticOrderF S; S.init(MP, 1024, G, (int)blockIdx.x);
            EpiRes E{P.in[0], P.in[1] - (size_t)MP * 1024, xb, PARTBUF(1 + 3 * l), l == 0 ? 1 : 0};
            pg8::gemm_phase<EpiRes, pg8::StaticOrderF, true, true>(lds, g, S, E, wave_s);
            { FRESH() sample_gemm<0>((bf16*)(tmp + (size_t)(1 - l) * TMP_YCAT), WT + WT_OUTEVEN + (size_t)l * (WT_OUTODD - WT_OUTEVEN), 1024, lds, tid, wave, lane, xb, l == 0 ? P.in[1] - (size_t)MP * 1024 : (const float*)nullptr, PARTBUF(1 + 3 * l), nullptr, nullptr); } }
        SEAM();
        if (RUN) { PTRS() pg8::Gemm g{xb, WT + WT_WQ + (size_t)l * 1048576, MP, 1024, 1024}; pg8::StaticOrderF S; S.init(MP, 1024, G, (int)blockIdx.x); EpiBf16 E{qx, 1024, PARTBUF(1 + 3 * l)};
            pg8::gemm_phase<EpiBf16, pg8::StaticOrderF, true, true>(lds, g, S, E, wave_s);
            { FRESH() sample_gemm<1>(xb, WT + WT_WQ + (size_t)l * 1048576, 1024, lds, tid, wave, lane, nullptr, nullptr, nullptr, PARTBUF(1 + 3 * l), qx); } }
        SEAM();
        if (RUN) { PTRS() FRESH() xattn_phase2(qx, memk + (size_t)l * 12 * 262144, memvT + (size_t)l * 12 * 262144, ox, lds, tid, wave, lane, G); }
        SEAM();
        if (RUN) { PTRS() pg8::Gemm g{ox, WT + WT_WO + (size_t)l * 1048576, MP, 1024, 1024}; pg8::StaticOrderF S; S.init(MP, 1024, G, (int)blockIdx.x); EpiRes E{P.in[0], P.in[0], xb, PARTBUF(2 + 3 * l), 0};
            pg8::gemm_phase<EpiRes, pg8::StaticOrderF, true, true>(lds, g, S, E, wave_s);
            { FRESH() sample_gemm<0>(ox, WT + WT_WO + (size_t)l * 1048576, 1024, lds, tid, wave, lane, xb, nullptr, PARTBUF(2 + 3 * l), nullptr, nullptr); } }
        SEAM();
        if (RUN) { PTRS() pg8::Gemm g{xb, WT + WT_UP + (size_t)l * 5632 * 1024, MROWS, 5632, 1024}; pg8::StaticOrderF S; S.init(MROWS, 5632, G, (int)blockIdx.x);
            EpiFfnUp E{act, PARTBUF(2 + 3 * l), P.in[34] + (size_t)l * 3 * DFF, SG, SV};
            pg8::gemm_phase<EpiFfnUp, pg8::StaticOrderF, true, true>(lds, g, S, E, wave_s);
            if (l == 0) {
                FRESH()
                const int bx = (int)blockIdx.x, nb = 1430 % G; int slot = -1, nw = 1;
                if (nb > 0 && nb < G) { if (bx >= nb) { slot = (bx - nb) * 8 + wave; nw = (G - nb) * 8; } } else { slot = gw; nw = NGW; }
                if (slot >= 0) for (int it = slot; it < 512 + 512; it += nw) { int r = it;
                    TR(P.in[30] + 1048576, 1024, 1024, WT + WT_WQ + 1048576, P.in[12] + 1024, 0.0625f, 0)
                    tr_item(P.in[32] + 1048576, 1024, 1024, WT + WT_WO + 1048576, nullptr, 1.f, 0, wscr, r, lane); }
            } }
        SEAM();
        if (RUN) { PTRS() FRESH()
            const float* cw = P.in[34] + (size_t)l * 3 * DFF; const float* st = P.in[8] + (size_t)l * 8 * 2 * DFF;
            for (int i = gt; i < 528 * 352; i += NT) { const int fi = i / 352, c0 = (i % 352) * 8; int blk, row, rr, sb, vb; bool smp = fi >= 512;
                if (!smp) { blk = fi >> 1; rr = fi & 1; row = blk * 64 + rr; sb = 0; vb = 0; } else { const int s = fi - 512, half = (s >> 1) & 1; blk = 256 + (s >> 2); rr = s & 1; row = blk * 64 + half * 32 + rr; sb = half * 4; vb = half * 2; }
                f32x4 pa0, pa1, pb0, pb1;
                if (smp) { const int b = (blk - 256) * 2 + (sb >> 2); const float* s0 = st + (size_t)(b * 2) * DFF + c0; pa0 = *(const f32x4*)s0; pa1 = *(const f32x4*)(s0 + 4); pb0 = *(const f32x4*)(s0 + DFF); pb1 = *(const f32x4*)(s0 + DFF + 4); }
                else if ((blk & 63) == 0) { pa0 = pa1 = pb0 = pb1 = (f32x4){0.f, 0.f, 0.f, 0.f}; }
                else { const float* s0 = SG + (size_t)((blk - 1) * 8 + 6) * DFF + c0; pa0 = *(const f32x4*)s0; pa1 = *(const f32x4*)(s0 + 4); pb0 = *(const f32x4*)(s0 + DFF); pb1 = *(const f32x4*)(s0 + DFF + 4); }
                const float* sc = SG + (size_t)(blk * 8 + sb) * DFF + c0; const f32x4 x00 = *(const f32x4*)sc, x01 = *(const f32x4*)(sc + 4);
                f32x4 xm2a, xm2b, xm1a, xm1b, xca, xcb;
                if (rr == 0) { xm2a = pa0; xm2b = pa1; xm1a = pb0; xm1b = pb1; xca = x00; xcb = x01; }
                else { xm2a = pb0; xm2b = pb1; xm1a = x00; xm1b = x01; xca = *(const f32x4*)(sc + DFF); xcb = *(const f32x4*)(sc + DFF + 4); }
                const f32x4 w0a = *(const f32x4*)(cw + c0), w0b = *(const f32x4*)(cw + c0 + 4), w1a = *(const f32x4*)(cw + DFF + c0), w1b = *(const f32x4*)(cw + DFF + c0 + 4), w2a = *(const f32x4*)(cw + 2 * DFF + c0), w2b = *(const f32x4*)(cw + 2 * DFF + c0 + 4);
                const f32x4 ga = w0a * xm2a + w1a * xm1a + w2a * xca, gb_ = w0b * xm2b + w1b * xm1b + w2b * xcb;
                const float* sv = SV + (size_t)(blk * 4 + vb + rr) * DFF + c0; const f32x4 va = *(const f32x4*)sv, vb_ = *(const f32x4*)(sv + 4);
                f32x4 a0, a1;
#pragma unroll
                for (int j = 0; j < 4; ++j) { a0[j] = ga[j] * sigmoidf_(ga[j]) * va[j]; a1[j] = gb_[j] * sigmoidf_(gb_[j]) * vb_[j]; }
                *(v4u*)(act + (size_t)row * DFF + c0) = pack8(a0, a1); }
            for (int i = gt; i < 4 * 2 * DFF; i += NT) { const int c = i % DFF, j = (i / DFF) & 1, b = i / (2 * DFF); out[OFF_CFP + (size_t)l * 4 * 2 * DFF + i] = SG[(size_t)((64 * b + 63) * 8 + 6 + j) * DFF + c]; }
            for (int i = gt; i < 8 * 2 * DFF; i += NT) { const int c = i % DFF, j = (i / DFF) & 1, b = i / (2 * DFF); out[OFF_CFS + (size_t)l * 8 * 2 * DFF + i] = SG[(size_t)((256 + (b >> 1)) * 8 + (b & 1) * 4 + 2 + j) * DFF + c]; }
        }
        SEAM();
        if (RUN) { PTRS() pg8::Gemm g{act, WT + WT_DOWN + (size_t)l * 2816 * 1024, MP, 1024, DFF}; pg8::StaticOrderF S; S.init(MP, 1024, G, (int)blockIdx.x); EpiRes E{P.in[0], P.in[0], xb, PARTBUF(3 + 3 * l), 0};
            pg8::gemm_phase<EpiRes, pg8::StaticOrderF, true, true>(lds, g, S, E, wave_s);
            { FRESH() sample_gemm<0>(act, WT + WT_DOWN + (size_t)l * 2816 * 1024, DFF, lds, tid, wave, lane, xb, nullptr, PARTBUF(3 + 3 * l), nullptr, nullptr); } }
        SEAM();
    }
    if (RUN) { PTRS() FRESH()
        const float* gf = P.in[14];
        for (int m = gw; m < MROWS; m += NGW) { const float rs = rstd_of(PARTBUF(6), m); float* xr = out + (size_t)m * 1024; const bf16* xbr = xb + (size_t)m * 1024;
#pragma unroll
            for (int j = 0; j < 4; ++j) { const int c = (lane + 64 * j) * 4; const u32x2v w = *(const u32x2v*)(xbr + c); const f32x4 v = (f32x4){bflo(w.x), bfhi(w.x), bflo(w.y), bfhi(w.y)}, gg = *(const f32x4*)(gf + c); *(f32x4*)(xr + c) = v * rs * gg; } }
    }
}

extern "C" void kernel_launch(void* const* d_in, const int* in_sizes, int n_in, void* d_out, int out_size, void* d_ws, size_t ws_size, hipStream_t stream) {
    static int grid = 0;
    if (grid == 0) {
        int dev = 0, cus = 0, per_cu = 0;
        if (n_in != 36 || ws_size < 256 * MiB) { fprintf(stderr, "kernel_launch: unexpected n_in %d / ws %zu\n", n_in, ws_size); grid = -1; return; }
        (void)hipGetDevice(&dev); (void)hipDeviceGetAttribute(&cus, hipDeviceAttributeMultiprocessorCount, dev);
        if (hipFuncSetAttribute((const void*)mega_fwd, hipFuncAttributeMaxDynamicSharedMemorySize, LDS_BYTES) != hipSuccess) { fprintf(stderr, "kernel_launch: hipFuncSetAttribute failed\n"); grid = -1; return; }
        if (hipOccupancyMaxActiveBlocksPerMultiprocessor(&per_cu, (const void*)mega_fwd, 512, LDS_BYTES) != hipSuccess || per_cu < 1) per_cu = 1;
        (void)hipGetLastError();
        grid = cus * 1;
        if (grid > 256) grid = 256;
    }
    if (grid < 0) return;
    (void)hipMemsetAsync(d_ws, 0, CTL_ZERO_BYTES, stream);
    Params p{};
    for (int i = 0; i < 36; ++i) p.in[i] = (const float*)d_in[i];
    p.out = (float*)d_out; p.ws = (unsigned char*)d_ws; p.use_cg = 0; p.pad = 0;
    void* args[] = {&p};
    hipError_t e = hipLaunchCooperativeKernel((const void*)mega_fwd, dim3(grid), dim3(512), args, LDS_BYTES, stream);
    if (e != hipSuccess) fprintf(stderr, "cooperative launch failed: %s (grid %d)\n", hipGetErrorString(e), grid);
}
```

```cpp
#include <hip/hip_runtime.h>
#include <hip/hip_cooperative_groups.h>
#include <cstdio>
#include <cstdint>
namespace cg = cooperative_groups;
__device__ __forceinline__ int fresh_tid(int wave_s) { unsigned z = 0u; asm volatile("" : "+s"(z)); int t = wave_s * 64 + (int)__builtin_amdgcn_mbcnt_hi(~0u, __builtin_amdgcn_mbcnt_lo(~0u, z)); asm volatile("" : "+v"(t)); return t; }
namespace pg8 {
#define PG8_LAS __attribute__((address_space(3)))
typedef unsigned short bf16_t;
typedef short bf16x8 __attribute__((ext_vector_type(8)));
typedef float f32x4 __attribute__((ext_vector_type(4)));
typedef unsigned u32x4 __attribute__((ext_vector_type(4)));
constexpr int BM = 256, BK = 64, HALF = 128, HTB = HALF * BK * 2  , STAGE_BYTES = 8 * HTB, NXCD = 8, WGM = 8;

__host__ __device__ __forceinline__ int lds_byte(int r, int c) { const int st = (r >> 4) * 2 + (c >> 5), rr = r & 15, cc = c & 31, ob = rr * 64 + cc * 2; return st * 1024 + (ob ^ (((ob >> 9) & 1) << 5)); }
__host__ __device__ __forceinline__ void stage_rc(int b, int& R, int& C) { const int st = b / 1024, sb = b % 1024, swz = sb ^ (((sb >> 9) & 1) << 5); R = (st >> 1) * 16 + swz / 64; C = (st & 1) * 32 + (swz % 64) / 2; }
__host__ __device__ __forceinline__ int perm32(int rho) { const int n = rho >> 4, i = rho & 15; return 8 * (i >> 2) + 4 * n + (i & 3); }

struct Unit { int pm, pn; };
struct Gemm { const bf16_t* A; const bf16_t* Bt; int M, N, K; };

template <bool FULL> struct StaticOrderT {
    int nM, nN, nwg, G, c;
    __host__ __device__ void init(int M, int N, int G_, int c_) { nM = M / BM; nN = N / BM; nwg = nM * nN; G = G_; c = c_; }
    __host__ __device__ bool next(int i, Unit& u) const {
        const long L = (long)i * G + c; if (!(FULL && i == 0) && L >= nwg) return false;
        int wgid = (int)L; { const int q = nwg / NXCD, r = nwg % NXCD, xcd = wgid % NXCD, off = wgid / NXCD; wgid = (xcd < r ? xcd * (q + 1) : r * (q + 1) + (xcd - r) * q) + off; }
        const int nig = WGM * nN, gid = wgid / nig, fm = gid * WGM, gsz = (nM - fm) < WGM ? (nM - fm) : WGM;
        u.pm = fm + ((wgid % nig) % gsz); u.pn = (wgid % nig) / gsz; return true;
    }
    __device__ __forceinline__ void a_ready(const Unit&) const {}
    __device__ __forceinline__ void done(const Unit&) const {}
};

typedef StaticOrderT<false> StaticOrder; typedef StaticOrderT<true> StaticOrderF;
__device__ __forceinline__ unsigned cvt_pk_bf16(float lo, float hi) { unsigned r; asm volatile("v_cvt_pk_bf16_f32 %0, %1, %2" : "=v"(r) : "v"(lo), "v"(hi)); return r; }
typedef float f32x2 __attribute__((ext_vector_type(2)));
template <class Epi, class Sched, bool ALIGN_EPI = false, bool SP2 = false>
__device__ __forceinline__ void gemm_phase(PG8_LAS unsigned char* lds, const Gemm g, const Sched& S, const Epi& E, const int wave_s) {
    const int tid = fresh_tid(wave_s), wid = __builtin_amdgcn_readfirstlane(tid >> 6), lane = tid & 63, wr = wid >> 2, wc = wid & 3, fr = lane & 15, fq = lane >> 4;
    const int K = g.K, nt = K / BK;
    unsigned voffA[2], voffB[2];
#pragma unroll
    for (int i = 0; i < 2; ++i) { int R, C; stage_rc(tid * 16 + i * 8192, R, C); const int Rb = Epi::PERM ? ((R & ~31) + perm32(R & 31)) : R;
        voffA[i] = (unsigned)(R * K + C) * 2u; voffB[i] = (unsigned)(Rb * K + C) * 2u; }
    const size_t kstep = (size_t)(BK * 2);
    const size_t hstep = (size_t)HALF * K * 2;
    const size_t tstep = 2 * hstep;
    const unsigned ldsw = (unsigned)wid * 1024u;
    const int aoff = lds_byte(wr * 64 + fr, fq * 8), boff = lds_byte(wc * 32 + fr, fq * 8);
#define PG8_SA(b, h) (((b) * 2 + (h)) * HTB)
#define PG8_SB(b, h) ((4 + (b) * 2 + (h)) * HTB)
#define PG8_STAGE(bufoff, gbase, voff) do { _Pragma("unroll") for (int _i = 0; _i < 2; ++_i) \
        __builtin_amdgcn_global_load_lds((const unsigned*)((const char*)(gbase) + (voff)[_i]), (PG8_LAS unsigned*)(lds + (bufoff) + ldsw + _i * 8192), 16, 0, 0); } while (0)
#define PG8_LDA(dst, b, h) do { _Pragma("unroll") for (int m = 0; m < 4; ++m) _Pragma("unroll") for (int k = 0; k < 2; ++k) dst[m][k] = *(const PG8_LAS bf16x8*)(lds + PG8_SA(b, h) + aoff + m * 2048 + k * 1024); } while (0)
#define PG8_LDB(dst, b, h) do { _Pragma("unroll") for (int n = 0; n < 2; ++n) _Pragma("unroll") for (int k = 0; k < 2; ++k) dst[n][k] = *(const PG8_LAS bf16x8*)(lds + PG8_SB(b, h) + boff + n * 2048 + k * 1024); } while (0)
#define PG8_MMA(ai, bj, At, Bt) do { __builtin_amdgcn_s_setprio(1); _Pragma("unroll") for (int m = 0; m < 4; ++m) _Pragma("unroll") for (int n = 0; n < 2; ++n) _Pragma("unroll") for (int k = 0; k < 2; ++k) \
        acc[ai][bj][m][n] = __builtin_amdgcn_mfma_f32_16x16x32_bf16(Bt[n][k], At[m][k], acc[ai][bj][m][n], 0, 0, 0); __builtin_amdgcn_s_setprio(0); } while (0)
#define PG8_WAIT_V(n) asm volatile("s_waitcnt vmcnt(" #n ")" ::: "memory")
#define PG8_WAIT_L(n) asm volatile("s_waitcnt lgkmcnt(" #n ")" ::: "memory")
#define PG8_BAR __builtin_amdgcn_s_barrier()
#define PG8_SCHED __builtin_amdgcn_sched_barrier(0)
    Unit cur, nxt; int ui = 0;
    if (!S.next(0, cur)) return;
    f32x4 acc[2][2][4][2];
#pragma unroll
    for (int a = 0; a < 2; ++a)
#pragma unroll
        for (int b = 0; b < 2; ++b)
#pragma unroll
            for (int m = 0; m < 4; ++m)
#pragma unroll
                for (int n = 0; n < 2; ++n) acc[a][b][m][n] = (f32x4){0.f, 0.f, 0.f, 0.f};
    bf16x8 At[4][2], B0[2][2], B1[2][2];
    const char* cA = (const char*)g.A + (size_t)cur.pm * tstep; const char* cB = (const char*)g.Bt + (size_t)cur.pn * tstep;
    S.a_ready(cur);
    if constexpr (SP2) {
        PG8_STAGE(PG8_SB(0, 0), cB, voffB); PG8_STAGE(PG8_SB(0, 1), cB + hstep, voffB); PG8_STAGE(PG8_SA(0, 0), cA, voffA); PG8_STAGE(PG8_SA(0, 1), cA + hstep, voffA);
        if (wr == 1) PG8_BAR;
        PG8_WAIT_V(2); PG8_BAR;
        PG8_STAGE(PG8_SB(1, 0), cB + kstep, voffB); PG8_STAGE(PG8_SA(1, 0), cA + kstep, voffA); PG8_STAGE(PG8_SB(1, 1), cB + hstep + kstep, voffB);
        PG8_WAIT_V(6); PG8_BAR;
    } else {
        PG8_STAGE(PG8_SB(0, 0), cB, voffB); PG8_STAGE(PG8_SA(0, 0), cA, voffA); PG8_STAGE(PG8_SB(0, 1), cB + hstep, voffB); PG8_STAGE(PG8_SA(0, 1), cA + hstep, voffA);
        if (wr == 1) PG8_BAR;
        PG8_WAIT_V(4); PG8_BAR;
        PG8_STAGE(PG8_SB(1, 0), cB + kstep, voffB); PG8_STAGE(PG8_SA(1, 0), cA + kstep, voffA); PG8_STAGE(PG8_SB(1, 1), cB + hstep + kstep, voffB);
        PG8_WAIT_V(6); PG8_BAR;
    }
    for (;;) {
        const bool has_next = S.next(ui + 1, nxt);
        const char* nA = has_next ? (const char*)g.A + (size_t)nxt.pm * tstep : cA; const char* nB = has_next ? (const char*)g.Bt + (size_t)nxt.pn * tstep : cB;
        for (int t = 0; t < nt; t += 2) {
            const bool last = (t == nt - 2);
            const char* a1 = cA + (size_t)(t + 1) * kstep;
            const char* a2 = last ? nA : cA + (size_t)(t + 2) * kstep; const char* b2 = last ? nB : cB + (size_t)(t + 2) * kstep;
            const char* a3 = a2 + kstep; const char* b3 = b2 + kstep;
            if (last && has_next) S.a_ready(nxt);
            if constexpr (SP2) {
            PG8_LDB(B0, 0, 0); PG8_LDB(B1, 0, 1); PG8_SCHED; PG8_LDA(At, 0, 0); PG8_STAGE(PG8_SA(1, 1), a1 + hstep, voffA);
            PG8_WAIT_V(8); PG8_WAIT_L(0); PG8_BAR; PG8_MMA(0, 0, At, B0); PG8_MMA(0, 1, At, B1); PG8_BAR; PG8_SCHED;
            PG8_LDA(At, 0, 1); PG8_STAGE(PG8_SB(0, 0), b2, voffB); PG8_STAGE(PG8_SB(0, 1), b2 + hstep, voffB); PG8_STAGE(PG8_SA(0, 0), a2, voffA);
            PG8_WAIT_V(8); PG8_WAIT_L(0); PG8_BAR; PG8_MMA(1, 0, At, B0); PG8_MMA(1, 1, At, B1); PG8_BAR; PG8_SCHED;
            PG8_LDB(B0, 1, 0); PG8_LDB(B1, 1, 1); PG8_SCHED; PG8_LDA(At, 1, 0); PG8_STAGE(PG8_SA(0, 1), a2 + hstep, voffA);
            PG8_WAIT_V(8); PG8_WAIT_L(0); PG8_BAR; PG8_MMA(0, 0, At, B0); PG8_MMA(0, 1, At, B1); PG8_BAR; PG8_SCHED;
            PG8_LDA(At, 1, 1); PG8_STAGE(PG8_SB(1, 0), b3, voffB); PG8_STAGE(PG8_SB(1, 1), b3 + hstep, voffB); PG8_STAGE(PG8_SA(1, 0), a3, voffA);
            PG8_WAIT_V(8); PG8_WAIT_L(0); PG8_BAR; PG8_MMA(1, 0, At, B0); PG8_MMA(1, 1, At, B1); PG8_BAR; PG8_SCHED;
            } else {
            PG8_LDB(B0, 0, 0); PG8_SCHED; PG8_LDA(At, 0, 0); PG8_STAGE(PG8_SA(1, 1), a1 + hstep, voffA);
            PG8_WAIT_L(8); PG8_BAR; PG8_WAIT_L(0); PG8_MMA(0, 0, At, B0); PG8_BAR; PG8_SCHED;
            PG8_LDB(B1, 0, 1); PG8_STAGE(PG8_SB(0, 0), b2, voffB);
            PG8_BAR; PG8_WAIT_L(0); PG8_MMA(0, 1, At, B1); PG8_BAR;
            PG8_LDA(At, 0, 1); PG8_STAGE(PG8_SA(0, 0), a2, voffA);
            PG8_BAR; PG8_WAIT_L(0); PG8_MMA(1, 0, At, B0); PG8_BAR; PG8_SCHED;
            PG8_STAGE(PG8_SB(0, 1), b2 + hstep, voffB);
            PG8_WAIT_V(6); PG8_BAR; PG8_MMA(1, 1, At, B1); PG8_BAR;
            PG8_LDB(B0, 1, 0); PG8_SCHED; PG8_LDA(At, 1, 0); PG8_STAGE(PG8_SA(0, 1), a2 + hstep, voffA);
            PG8_WAIT_L(8); PG8_BAR; PG8_WAIT_L(0); PG8_MMA(0, 0, At, B0); PG8_BAR; PG8_SCHED;
            PG8_LDB(B1, 1, 1); PG8_STAGE(PG8_SB(1, 0), b3, voffB);
            PG8_BAR; PG8_WAIT_L(0); PG8_MMA(0, 1, At, B1); PG8_BAR;
            PG8_LDA(At, 1, 1); PG8_STAGE(PG8_SA(1, 0), a3, voffA);
            PG8_BAR; PG8_WAIT_L(0); PG8_MMA(1, 0, At, B0); PG8_BAR; PG8_SCHED;
            PG8_STAGE(PG8_SB(1, 1), b3 + hstep, voffB);
            PG8_WAIT_V(6); PG8_BAR; PG8_MMA(1, 1, At, B1); PG8_BAR;
            }
        }
        if constexpr (ALIGN_EPI) { if (wr == 0) PG8_BAR; }
        if constexpr (!Epi::AFTER_DRAIN) { E(acc, cur, wr, wc, fr, fq); S.done(cur); }
        if (!has_next) break;
#pragma unroll
        for (int a = 0; a < 2; ++a)
#pragma unroll
            for (int b = 0; b < 2; ++b)
#pragma unroll
                for (int m = 0; m < 4; ++m)
#pragma unroll
                    for (int n = 0; n < 2; ++n) acc[a][b][m][n] = (f32x4){0.f, 0.f, 0.f, 0.f};
        cur = nxt; cA = nA; cB = nB; ++ui;
        if constexpr (ALIGN_EPI) { if (wr == 1) PG8_BAR; }
    }
    PG8_WAIT_V(0);
    if constexpr (!ALIGN_EPI) { if (wr == 0) PG8_BAR; }
    PG8_BAR;
    if constexpr (Epi::AFTER_DRAIN) { E.fused(acc, cur, wr, wc, fr, fq, lds, wid, lane); S.done(cur); }
#undef PG8_SA
#undef PG8_SB
#undef PG8_STAGE
#undef PG8_LDA
#undef PG8_LDB
#undef PG8_MMA
#undef PG8_WAIT_V
#undef PG8_WAIT_L
#undef PG8_BAR
#undef PG8_SCHED
}
}
#define GAS __attribute__((address_space(1)))
#define LAS __attribute__((address_space(3)))
typedef unsigned short bf16;
typedef unsigned v4u __attribute__((ext_vector_type(4)));
typedef float f32x4 __attribute__((ext_vector_type(4)));
typedef short bf16x8 __attribute__((ext_vector_type(8)));
typedef GAS unsigned gu32;
typedef GAS unsigned long long gu64;
#define RLX_AGENT __ATOMIC_RELAXED, __HIP_MEMORY_SCOPE_AGENT
#define LDS_WAIT() asm volatile("s_waitcnt lgkmcnt(0)" ::: "memory")
#define VM_WAIT() asm volatile("s_waitcnt vmcnt(0)" ::: "memory")
__device__ __forceinline__ unsigned long long rt() { return __builtin_amdgcn_s_memrealtime(); }
__device__ __forceinline__ unsigned f2bf(float f) { unsigned u = __builtin_bit_cast(unsigned, f); return (u + 0x7fffu + ((u >> 16) & 1u)) >> 16; }
__device__ __forceinline__ unsigned pk2(float lo, float hi) { return f2bf(lo) | (f2bf(hi) << 16); }

#define XB_TMO      128
#define XB_XCNT(j)  (256  + 64 * (j))
#define XB_XSUB(j)  (1280 + 64 * (j))
#define XB_XGEN(j)  (2304 + 64 * (j))
#define XB_TOP      3328
#define XB_TOPGEN   3392
#define XCD_BAR_WORDS 3456
#define XB_SPIN_CAP (1u << 18)

__device__ __forceinline__ unsigned xb_ld(unsigned* p)              { return __hip_atomic_load(p, __ATOMIC_RELAXED, __HIP_MEMORY_SCOPE_AGENT); }
__device__ __forceinline__ unsigned xb_add(unsigned* p, unsigned v) { return __hip_atomic_fetch_add(p, v, __ATOMIC_RELAXED, __HIP_MEMORY_SCOPE_AGENT); }
__device__ __forceinline__ unsigned xb_xcc_id() { return (unsigned)__builtin_amdgcn_s_getreg((3 << 11) | 20) & 0xFu; }
#define XB_SPIN(cond, bar) do { unsigned _sp = 0; while (cond) { __builtin_amdgcn_s_sleep(1); \
    if ((++_sp & 255u) == 0u) { if (xb_ld(&(bar)[XB_TMO])) break; if (_sp > XB_SPIN_CAP) { atomicAdd(&(bar)[XB_TMO], 1u); break; } } } } while (0)

struct XcdBarrier {
    unsigned* bar; unsigned x;
    volatile LAS unsigned* st;
};

__device__ __forceinline__ XcdBarrier xcd_barrier_post(unsigned* bar, volatile LAS unsigned* st) {
    XcdBarrier b; b.bar = bar; b.x = xb_xcc_id(); b.st = st;
    if (threadIdx.x == 0) (void)xb_add(&bar[XB_XCNT(b.x)], 1u);
    return b;
}
__device__ __forceinline__ void xcd_barrier_complete(unsigned* bar, unsigned x, unsigned& nloc, unsigned& nx) {
    const unsigned G = gridDim.x * gridDim.y * gridDim.z;
    unsigned sum, cnt, mine, sp = 0u;
    for (;;) {
        sum = 0u; cnt = 0u; mine = 0u;
#pragma unroll
        for (unsigned j = 0; j < 16; ++j) { const unsigned c = xb_ld(&bar[XB_XCNT(j)]); sum += c; cnt += (c > 0u) ? 1u : 0u; mine = (j == x) ? c : mine; }
        if (sum == G) break;
        __builtin_amdgcn_s_sleep(1);
        if ((++sp & 255u) == 0u) { if (xb_ld(&bar[XB_TMO])) break; if (sp > XB_SPIN_CAP) { atomicAdd(&bar[XB_TMO], 1u); break; } }
    }
    nloc = mine > 0u ? mine : 1u; nx = cnt > 0u ? cnt : 1u;
}

__device__ __forceinline__ void xcd_barrier(const XcdBarrier& b) {
    asm volatile("s_waitcnt vmcnt(0)" ::: "memory");
    __syncthreads();
    if (threadIdx.x == 0) {
        unsigned* bar = b.bar;
        __builtin_amdgcn_s_waitcnt(0);
        unsigned nloc = b.st[0], nx = b.st[1];
        if (nloc == 0u) { xcd_barrier_complete(bar, b.x, nloc, nx); b.st[0] = nloc; b.st[1] = nx; }
        const unsigned old = xb_add(&bar[XB_XSUB(b.x)], 1u);
        const unsigned gen = old / nloc;
        if (old + 1u == (gen + 1u) * nloc) {
            __builtin_amdgcn_fence(__ATOMIC_RELEASE, "agent");
            asm volatile("s_waitcnt vmcnt(0)" ::: "memory");
            const unsigned og = xb_add(&bar[XB_TOP], 1u);
            const unsigned tg = og / nx;
            if (og + 1u == (tg + 1u) * nx) xb_add(&bar[XB_TOPGEN], 1u);
            else XB_SPIN(xb_ld(&bar[XB_TOPGEN]) == tg, bar);
            __builtin_amdgcn_fence(__ATOMIC_ACQUIRE, "agent");
            xb_add(&bar[XB_XGEN(b.x)], 1u);
            asm volatile("s_waitcnt vmcnt(0)" ::: "memory");
        } else {
            XB_SPIN(xb_ld(&bar[XB_XGEN(b.x)]) == gen, bar);
            __builtin_amdgcn_fence(__ATOMIC_ACQUIRE, "agent");
            asm volatile("s_waitcnt vmcnt(0)" ::: "memory");
        }
    }
    __syncthreads();
}
typedef unsigned u32x2v __attribute__((ext_vector_type(2)));
typedef float f32x2v __attribute__((ext_vector_type(2)));

constexpr int MP = 16384, MROWS = 16640, DMODEL = 1024, DFF = 2816, NBLK64 = MROWS / 64;
constexpr float RMS_EPS = 1e-6f;
constexpr size_t OFF_Y = 0, OFF_WKP = (size_t)MROWS * 1024, OFF_WVP = OFF_WKP + 65536, OFF_SRP = OFF_WVP + 65536, OFF_SIP = OFF_SRP + 8192,
    OFF_CMP = OFF_SIP + 8192, OFF_CFP = OFF_CMP + 8192, OFF_MKP = OFF_CFP + 45056, OFF_MVP = OFF_MKP + 2097152, OFF_WKS = OFF_MVP + 2097152,
    OFF_WVS = OFF_WKS + 32768, OFF_SRS = OFF_WVS + 32768, OFF_SIS = OFF_SRS + 16384, OFF_CMS = OFF_SIS + 16384, OFF_CFS = OFF_CMS + 16384;
constexpr size_t MiB = 1u << 20;
constexpr size_t WS_ROWSS = 0, WS_BAR = 512 * 1024, CTL_ZERO_BYTES = 1 * MiB;
constexpr size_t WS_ROPE = 1 * MiB, WS_SSM = 2 * MiB, WS_CKV = 3 * MiB, WS_SLOC = 4 * MiB, WS_MEMK = 8 * MiB, WS_MEMVT = 20 * MiB, WS_SIDE = 32 * MiB;
constexpr size_t SG_BYTES = (size_t)NBLK64 * 8 * DFF * 4, SV_BYTES = (size_t)NBLK64 * 4 * DFF * 4;
static_assert(WS_SIDE + SG_BYTES + SV_BYTES <= 66 * MiB, "side buffers");
constexpr size_t WS_WT = 66 * MiB, WS_XB = 128 * MiB, WS_TMP = 161 * MiB;
constexpr size_t WT_INEVEN = 0, WT_GLU = WT_INEVEN + 1280 * 1024, WT_OUTEVEN = WT_GLU + 512 * 512, WT_WQ = WT_OUTEVEN + 1024 * 1024, WT_WKV = WT_WQ + 2 * 1024 * 1024,
    WT_WO = WT_WKV + 2 * 2048 * 1024, WT_UP = WT_WO + 2 * 1024 * 1024, WT_DOWN = WT_UP + (size_t)2 * 5632 * 1024, WT_INODD = WT_DOWN + (size_t)2 * 2816 * 1024,
    WT_OUTODD = WT_INODD + 3072 * 1024, WT_END = WT_OUTODD + 1024 * 1024;
static_assert(WS_WT + WT_END * 2 <= WS_XB, "weights");
static_assert(WS_XB + (size_t)MROWS * 1024 * 2 <= WS_TMP, "xb");
constexpr size_t TMP_BYTES = (size_t)MROWS * DFF * 2;
constexpr size_t WS_PART = 251 * MiB, PART_ELEMS = (size_t)MROWS * 16;
static_assert(WS_PART + 2 * PART_ELEMS * 4 <= 256 * MiB, "part");
static_assert(WS_TMP + TMP_BYTES <= 256 * MiB, "ws");
constexpr size_t TMP_PROJ0 = 0, TMP_GBUF = (size_t)MROWS * 1280 * 2, TMP_YCAT = TMP_GBUF + (size_t)MROWS * 512 * 2, TMP_MEMB = TMP_YCAT;
static_assert(TMP_YCAT + (size_t)MROWS * 1024 * 2 <= TMP_BYTES, "tmp");
constexpr size_t TMP_QX = 0, TMP_OX = (size_t)MROWS * 1024 * 2, TMP_ACT = 0, TMP_GB = 0, TMP_ZC = (size_t)MROWS * 1024 * 2;
constexpr int LDS_BYTES = 147456, MISC_OFF = 147456 - 512;
constexpr int NPH = 22;

#define MFMA16(a, b, c) __builtin_amdgcn_mfma_f32_16x16x32_bf16(a, b, c, 0, 0, 0)
__device__ __forceinline__ float bflo(unsigned w) { return __uint_as_float(w << 16); }
__device__ __forceinline__ float bfhi(unsigned w) { return __uint_as_float(w & 0xffff0000u); }
__device__ __forceinline__ v4u pack8(f32x4 a, f32x4 b) { v4u w; w.x = pg8::cvt_pk_bf16(a[0], a[1]); w.y = pg8::cvt_pk_bf16(a[2], a[3]); w.z = pg8::cvt_pk_bf16(b[0], b[1]); w.w = pg8::cvt_pk_bf16(b[2], b[3]); return w; }
__device__ __forceinline__ float rstd_of(const float* part, int row) { const f32x4* p = (const f32x4*)(part + (size_t)row * 16); const f32x4 a = p[0] + p[1] + p[2] + p[3]; return rsqrtf(((a[0] + a[1]) + (a[2] + a[3])) * (1.0f / 1024.0f) + RMS_EPS); }
__device__ __forceinline__ float sigmoidf_(float x) { return 1.0f / (1.0f + __expf(-x)); }
__device__ __forceinline__ float dpp_ror1(float v) { return __builtin_bit_cast(float, __builtin_amdgcn_update_dpp(0, __builtin_bit_cast(int, v), 0x121, 0xf, 0xf, false)); }
__device__ __forceinline__ float dpp_ror2(float v) { return __builtin_bit_cast(float, __builtin_amdgcn_update_dpp(0, __builtin_bit_cast(int, v), 0x122, 0xf, 0xf, false)); }
__device__ __forceinline__ float wave_sum(float v) {
#pragma unroll
    for (int o = 1; o < 64; o <<= 1) v += __shfl_xor(v, o);
    return v;
}

typedef pg8::Unit Unit;
#define EPI_ARGS const f32x4 (&acc)[2][2][4][2], const Unit& u, int wr, int wc, int fr, int fq

struct EpiBf16 {
    static constexpr bool PERM = true, AFTER_DRAIN = false;
    bf16* O; int ldc; const float* rowss;
    __device__ __forceinline__ void operator()(EPI_ARGS) const {
        const int row0 = u.pm * 256 + wr * 64 + fr, col0 = u.pn * 256 + wc * 32 + 8 * fq;
#pragma unroll
        for (int ai = 0; ai < 2; ++ai)
#pragma unroll
            for (int m = 0; m < 4; ++m) { const int row = row0 + ai * 128 + m * 16; const float rs = rstd_of(rowss, row); bf16* rp = O + (size_t)row * ldc + col0;
#pragma unroll
                for (int bj = 0; bj < 2; ++bj) *(v4u*)(rp + bj * 128) = pack8(acc[ai][bj][m][0] * rs, acc[ai][bj][m][1] * rs); }
    }
};
struct EpiRes {
    static constexpr bool PERM = true, AFTER_DRAIN = false;
    const float* base_p; const float* base_s; bf16* xb; float* rowss_next; int f32base;
    __device__ __forceinline__ void operator()(EPI_ARGS) const {
        const float* base = u.pm < 64 ? base_p : base_s;
        const int row0 = u.pm * 256 + wr * 64 + fr, col0 = u.pn * 256 + wc * 32 + 8 * fq;
#pragma unroll
        for (int ai = 0; ai < 2; ++ai)
#pragma unroll
            for (int m = 0; m < 4; ++m) { const int row = row0 + ai * 128 + m * 16; const size_t off = (size_t)row * 1024 + col0; float ss = 0.f;
#pragma unroll
                for (int bj = 0; bj < 2; ++bj) { f32x4 b0, b1;
                    if (f32base) { b0 = *(const f32x4*)(base + off + bj * 128); b1 = *(const f32x4*)(base + off + bj * 128 + 4); }
                    else { const v4u w = *(const v4u*)(xb + off + bj * 128); b0 = (f32x4){bflo(w.x), bfhi(w.x), bflo(w.y), bfhi(w.y)}; b1 = (f32x4){bflo(w.z), bfhi(w.z), bflo(w.w), bfhi(w.w)}; }
                    const f32x4 v0 = acc[ai][bj][m][0] + b0, v1 = acc[ai][bj][m][1] + b1;
                    *(v4u*)(xb + off + bj * 128) = pack8(v0, v1);
                    ss += (v0[0] * v0[0] + v0[1] * v0[1]) + (v0[2] * v0[2] + v0[3] * v0[3]) + (v1[0] * v1[0] + v1[1] * v1[1]) + (v1[2] * v1[2] + v1[3] * v1[3]); }
                ss += __shfl_xor(ss, 16); ss += __shfl_xor(ss, 32);
                if (fq == 0) rowss_next[(size_t)row * 16 + u.pn * 4 + wc] = ss; }
    }
};
struct EpiGlu {
    static constexpr bool PERM = true, AFTER_DRAIN = false;
    const bf16* g; bf16* ycat;
    __device__ __forceinline__ void operator()(EPI_ARGS) const {
        const int row0 = u.pm * 256 + wr * 64 + fr, col0 = u.pn * 256 + wc * 32 + 8 * fq;
#pragma unroll
        for (int ai = 0; ai < 2; ++ai)
#pragma unroll
            for (int m = 0; m < 4; ++m) { const int row = row0 + ai * 128 + m * 16;
#pragma unroll
                for (int bj = 0; bj < 2; ++bj) { const int col = col0 + bj * 128; const v4u gw = *(const v4u*)(g + (size_t)row * 512 + col);
                    const f32x4 a0 = acc[ai][bj][m][0], a1 = acc[ai][bj][m][1]; f32x4 o0, o1;
                    o0[0] = bflo(gw.x) * sigmoidf_(a0[0]); o0[1] = bfhi(gw.x) * sigmoidf_(a0[1]); o0[2] = bflo(gw.y) * sigmoidf_(a0[2]); o0[3] = bfhi(gw.y) * sigmoidf_(a0[3]);
                    o1[0] = bflo(gw.z) * sigmoidf_(a1[0]); o1[1] = bfhi(gw.z) * sigmoidf_(a1[1]); o1[2] = bflo(gw.w) * sigmoidf_(a1[2]); o1[3] = bfhi(gw.w) * sigmoidf_(a1[3]);
                    *(v4u*)(ycat + (size_t)row * 1024 + col) = pack8(o0, o1); } }
    }
};
struct EpiKV {
    static constexpr bool PERM = true, AFTER_DRAIN = false;
    float* out; bf16* memk;
    __device__ __forceinline__ void operator()(EPI_ARGS) const {
        const int row0 = u.pm * 256 + wr * 64 + fr, col0 = u.pn * 256 + wc * 32 + 8 * fq;
#pragma unroll
        for (int ai = 0; ai < 2; ++ai)
#pragma unroll
            for (int m = 0; m < 4; ++m) { const int row = row0 + ai * 128 + m * 16;
#pragma unroll
                for (int bj = 0; bj < 2; ++bj) { const int c = col0 + bj * 128, l = c >> 11, e = c & 2047, isv = e >> 10, dc = e & 1023;
                    float* op = out + (isv ? OFF_MVP : OFF_MKP) + (size_t)l * 1048576 + (size_t)row * 1024 + dc;
                    *(f32x4*)op = acc[ai][bj][m][0]; *(f32x4*)(op + 4) = acc[ai][bj][m][1];
                    if (!isv) *(v4u*)(memk + (size_t)l * 12 * 262144 + (size_t)row * 1024 + dc) = pack8(acc[ai][bj][m][0], acc[ai][bj][m][1]); } }
    }
};
struct EpiIn0 {
    static constexpr bool PERM = true, AFTER_DRAIN = false;
    bf16* proj; const float* rowss; const float* ropec; const float* ropes; float* out;
    __device__ __forceinline__ void operator()(EPI_ARGS) const {
        const int pn = u.pn;
#pragma unroll
        for (int ai = 0; ai < 2; ++ai)
#pragma unroll
            for (int m = 0; m < 4; ++m) { const int row = u.pm * 256 + ai * 128 + wr * 64 + m * 16 + fr; const float rs = rstd_of(rowss, row);
                const int pos = row < MP ? (row & 4095) : 2048 + (row & 31);
                bf16* rp = proj + (size_t)row * 1280;
                float* wk = nullptr; float* wv = nullptr;
                if (pn == 4) { if (row >= MP) { wk = out + OFF_WKS + (size_t)(row - MP) * 128; wv = out + OFF_WVS + (size_t)(row - MP) * 128; }
                               else if ((row & 4095) >= 3968) { const size_t o = (size_t)((row >> 12) * 128 + (row & 4095) - 3968) * 128; wk = out + OFF_WKP + o; wv = out + OFF_WVP + o; } }
#pragma unroll
                for (int bj = 0; bj < 2; ++bj) { const f32x4 v0 = acc[ai][bj][m][0] * rs, v1 = acc[ai][bj][m][1] * rs;
                    const bool rope = (pn == 2 || pn == 3 || (pn == 4 && bj == 0));
                    if (!rope) { const int col = pn * 256 + bj * 128 + wc * 32 + 8 * fq; *(v4u*)(rp + col) = pack8(v0, v1);
                        if (pn == 4 && wv) { *(f32x4*)(wv + wc * 32 + 8 * fq) = v0; *(f32x4*)(wv + wc * 32 + 8 * fq + 4) = v1; } }
                    else { const int gbase = pn * 256 + bj * 128 + (wc >> 1) * 64, d1 = 16 * (wc & 1) + 4 * fq;
                        const f32x4 c4 = *(const f32x4*)(ropec + pos * 32 + d1), s4 = *(const f32x4*)(ropes + pos * 32 + d1);
                        f32x4 o1 = v0 * c4 - v1 * s4, o2 = v1 * c4 + v0 * s4;
                        if (pn != 4) { o1 = o1 * 0.125f; o2 = o2 * 0.125f; }
                        u32x2v w1, w2; w1.x = pg8::cvt_pk_bf16(o1[0], o1[1]); w1.y = pg8::cvt_pk_bf16(o1[2], o1[3]); w2.x = pg8::cvt_pk_bf16(o2[0], o2[1]); w2.y = pg8::cvt_pk_bf16(o2[2], o2[3]);
                        *(u32x2v*)(rp + gbase + d1) = w1; *(u32x2v*)(rp + gbase + d1 + 32) = w2;
                        if (pn == 4 && wk) { const int cc = (wc >> 1) * 64 + d1; *(f32x4*)(wk + cc) = o1; *(f32x4*)(wk + cc + 32) = o2; } } } }
    }
};
struct EpiFfnUp {
    static constexpr bool PERM = true, AFTER_DRAIN = false;
    bf16* act; const float* rowss; const float* cw; float* SG; float* SV;
    __device__ __forceinline__ void operator()(EPI_ARGS) const {
        const int c0 = u.pn * 128 + wc * 32 + 8 * fq; const bool sample = u.pm == 64;
        const f32x4 w0a = *(const f32x4*)(cw + c0), w0b = *(const f32x4*)(cw + c0 + 4), w1a = *(const f32x4*)(cw + DFF + c0), w1b = *(const f32x4*)(cw + DFF + c0 + 4),
                    w2a = *(const f32x4*)(cw + 2 * DFF + c0), w2b = *(const f32x4*)(cw + 2 * DFF + c0 + 4);
#pragma unroll
        for (int ai = 0; ai < 2; ++ai) { f32x4 gp0 = {0.f, 0.f, 0.f, 0.f}, gp1 = {0.f, 0.f, 0.f, 0.f}; const int blk = u.pm * 4 + ai * 2 + wr;
#pragma unroll
            for (int m = 0; m < 4; ++m) { const int row = u.pm * 256 + ai * 128 + wr * 64 + m * 16 + fr; const float rs = rstd_of(rowss, row);
                const f32x4 g0 = acc[ai][0][m][0] * rs, g1 = acc[ai][0][m][1] * rs, v0 = acc[ai][1][m][0] * rs, v1 = acc[ai][1][m][1] * rs;
                f32x4 p1a, p2a, p1b, p2b;
#pragma unroll
                for (int j = 0; j < 4; ++j) { const float s1a = fr == 15 ? gp0[j] : g0[j], s2a = fr >= 14 ? gp0[j] : g0[j], s1b = fr == 15 ? gp1[j] : g1[j], s2b = fr >= 14 ? gp1[j] : g1[j];
                    p1a[j] = dpp_ror1(s1a); p2a[j] = dpp_ror2(s2a); p1b[j] = dpp_ror1(s1b); p2b[j] = dpp_ror2(s2b); }
                const f32x4 ca = w0a * p2a + w1a * p1a + w2a * g0, cb = w0b * p2b + w1b * p1b + w2b * g1;
                f32x4 sa, sb;
#pragma unroll
                for (int j = 0; j < 4; ++j) { sa[j] = sigmoidf_(ca[j]); sb[j] = sigmoidf_(cb[j]); }
                const f32x4 a0 = ca * sa * v0, a1 = cb * sb * v1;
                const bool valid = (m > 0 || fr >= 2) && !(sample && m == 2 && fr < 2);
                if (valid) *(v4u*)(act + (size_t)row * DFF + c0) = pack8(a0, a1);
                if ((m & 1) == 0 && fr < 2) { float* sg = SG + (size_t)(blk * 8 + 2 * m + fr) * DFF + c0; *(f32x4*)sg = g0; *(f32x4*)(sg + 4) = g1;
                                              float* sv = SV + (size_t)(blk * 4 + m + fr) * DFF + c0; *(f32x4*)sv = v0; *(f32x4*)(sv + 4) = v1; }
                if ((m & 1) == 1 && fr >= 14) { float* sg = SG + (size_t)(blk * 8 + 2 * m + fr - 14) * DFF + c0; *(f32x4*)sg = g0; *(f32x4*)(sg + 4) = g1; }
                gp0 = g0; gp1 = g1; } }
    }
};
struct EpiInOdd {
    static constexpr bool PERM = true, AFTER_DRAIN = false;
    bf16* gb; bf16* zc; const float* rowss; const float* cw; float* SG;
    __device__ __forceinline__ void operator()(EPI_ARGS) const {
        if (u.pn < 4) {
            const int row0 = u.pm * 256 + wr * 64 + fr, col0 = u.pn * 256 + wc * 32 + 8 * fq;
#pragma unroll
            for (int ai = 0; ai < 2; ++ai)
#pragma unroll
                for (int m = 0; m < 4; ++m) { const int row = row0 + ai * 128 + m * 16; const float rs = rstd_of(rowss, row); bf16* rp = gb + (size_t)row * 1024 + col0;
#pragma unroll
                    for (int bj = 0; bj < 2; ++bj) *(v4u*)(rp + bj * 128) = pack8(acc[ai][bj][m][0] * rs, acc[ai][bj][m][1] * rs); }
            return;
        }
        const int c0 = (u.pn - 4) * 128 + wc * 32 + 8 * fq; const bool sample = u.pm == 64;
        const f32x4 w0a = *(const f32x4*)(cw + c0), w0b = *(const f32x4*)(cw + c0 + 4), w1a = *(const f32x4*)(cw + 1024 + c0), w1b = *(const f32x4*)(cw + 1024 + c0 + 4),
                    w2a = *(const f32x4*)(cw + 2048 + c0), w2b = *(const f32x4*)(cw + 2048 + c0 + 4);
#pragma unroll
        for (int ai = 0; ai < 2; ++ai) { f32x4 gp0 = {0.f, 0.f, 0.f, 0.f}, gp1 = {0.f, 0.f, 0.f, 0.f}; const int blk = u.pm * 4 + ai * 2 + wr;
#pragma unroll
            for (int m = 0; m < 4; ++m) { const int row = u.pm * 256 + ai * 128 + wr * 64 + m * 16 + fr; const float rs = rstd_of(rowss, row); const float rs2 = rs * rs;
                const f32x4 g0 = acc[ai][0][m][0] * acc[ai][1][m][0] * rs2, g1 = acc[ai][0][m][1] * acc[ai][1][m][1] * rs2;
                f32x4 p1a, p2a, p1b, p2b;
#pragma unroll
                for (int j = 0; j < 4; ++j) { const float s1a = fr == 15 ? gp0[j] : g0[j], s2a = fr >= 14 ? gp0[j] : g0[j], s1b = fr == 15 ? gp1[j] : g1[j], s2b = fr >= 14 ? gp1[j] : g1[j];
                    p1a[j] = dpp_ror1(s1a); p2a[j] = dpp_ror2(s2a); p1b[j] = dpp_ror1(s1b); p2b[j] = dpp_ror2(s2b); }
                const f32x4 a0 = w0a * p2a + w1a * p1a + w2a * g0, a1 = w0b * p2b + w1b * p1b + w2b * g1;
                const bool valid = (m > 0 || fr >= 2) && !(sample && m == 2 && fr < 2);
                if (valid) *(v4u*)(zc + (size_t)row * 1024 + c0) = pack8(a0, a1);
                if ((m & 1) == 0 && fr < 2) { float* sg = SG + (size_t)(blk * 8 + 2 * m + fr) * 1024 + c0; *(f32x4*)sg = g0; *(f32x4*)(sg + 4) = g1; }
                if ((m & 1) == 1 && fr >= 14) { float* sg = SG + (size_t)(blk * 8 + 2 * m + fr - 14) * 1024 + c0; *(f32x4*)sg = g0; *(f32x4*)(sg + 4) = g1; }
                gp0 = g0; gp1 = g1; } }
    }
};

__device__ __forceinline__ int rowmap(int mode, int n) {
    if (mode == 1) { if (n >= 512 && n < 1152) { const int d = n & 63; return (n & ~63) | (32 * ((d >> 4) & 1) + 8 * ((d >> 2) & 3) + 4 * (d >> 5) + (d & 3)); } return n; }
    if (mode == 2) { return n < DFF ? ((n >> 7) * 256 + (n & 127)) : (((n - DFF) >> 7) * 256 + 128 + ((n - DFF) & 127)); }
    if (mode == 3) { if (n < 1024) return n; const int c = (n - 1024) & 1023, z = n >= 2048 ? 1 : 0; return 1024 + (c >> 7) * 256 + z * 128 + (c & 127); }
    return n;
}
__device__ __forceinline__ void tr_item(const float* W, int K, int N, bf16* WT, const float* gain, float scale, int mode, LAS float* scr, int item, int lane) {
    const int nblk = N / 32, kb = item / nblk, nb = item % nblk, k0 = 64 * kb, n0 = 32 * nb;
#pragma unroll
    for (int i = 0; i < 8; ++i) { const int idx = lane + 64 * i, kk = idx >> 3, n4 = (idx & 7) * 4; const float gs = gain ? ((const GAS float*)gain)[k0 + kk] * scale : scale;
        const f32x4 w = *(const GAS f32x4*)((const GAS float*)W + (size_t)(k0 + kk) * N + n0 + n4); LAS float* d = scr + kk * 33 + n4; d[0] = w[0] * gs; d[1] = w[1] * gs; d[2] = w[2] * gs; d[3] = w[3] * gs; }
    LDS_WAIT(); asm volatile("" ::: "memory");
    const int c = lane & 7;
#pragma unroll
    for (int j = 0; j < 4; ++j) { const int n = (lane >> 3) + 8 * j; const LAS float* s = scr + (8 * c) * 33 + n;
        v4u o; o.x = pg8::cvt_pk_bf16(s[0 * 33], s[1 * 33]); o.y = pg8::cvt_pk_bf16(s[2 * 33], s[3 * 33]); o.z = pg8::cvt_pk_bf16(s[4 * 33], s[5 * 33]); o.w = pg8::cvt_pk_bf16(s[6 * 33], s[7 * 33]);
        *(GAS v4u*)((GAS bf16*)WT + (size_t)rowmap(mode, n0 + n) * K + k0 + 8 * c) = o; }
    LDS_WAIT(); asm volatile("" ::: "memory");
}
__device__ __forceinline__ double dexp_(double y) {
    const double k = rint(y * 1.4426950408889634); const double r = (y - k * 0.6931471803691238) - k * 1.9082149292705877e-10;
    double p = 1.0 / 6227020800.0;
    p = p * r + 1.0 / 479001600.0; p = p * r + 1.0 / 39916800.0; p = p * r + 1.0 / 3628800.0; p = p * r + 1.0 / 362880.0; p = p * r + 1.0 / 40320.0; p = p * r + 1.0 / 5040.0;
    p = p * r + 1.0 / 720.0; p = p * r + 1.0 / 120.0; p = p * r + 1.0 / 24.0; p = p * r + 1.0 / 6.0; p = p * r + 0.5; p = p * r + 1.0; p = p * r + 1.0;
    const long long bits = (long long)(1023 + (int)k) << 52; return p * __builtin_bit_cast(double, bits);
}
__device__ __forceinline__ void dsincos_(double x, double& s, double& c) {
    const double k = rint(x * 0.6366197723675814); const double r = (x - k * 1.5707963267948966) - k * 6.123233995736766e-17; const double r2 = r * r;
    const double sp = r * (1.0 + r2 * (-1.0 / 6.0 + r2 * (1.0 / 120.0 + r2 * (-1.0 / 5040.0 + r2 * (1.0 / 362880.0 + r2 * (-1.0 / 39916800.0 + r2 * (1.0 / 6227020800.0)))))));
    const double cp = 1.0 + r2 * (-0.5 + r2 * (1.0 / 24.0 + r2 * (-1.0 / 720.0 + r2 * (1.0 / 40320.0 + r2 * (-1.0 / 3628800.0 + r2 * (1.0 / 479001600.0 + r2 * (-1.0 / 87178291200.0)))))));
    const int q = ((int)k) & 3;
    s = q == 0 ? sp : q == 1 ? cp : q == 2 ? -sp : -cp; c = q == 0 ? cp : q == 1 ? -sp : q == 2 ? -cp : sp;
}

__device__ __forceinline__ const bf16* kvptr(const bf16* proj, const bf16* cb, int sample, int b, int c, int kvh, int kk, int isv) {
    if (!sample) { int pos = (c - 2) * 64 + kk; pos = pos < 0 ? 0 : pos; return proj + (size_t)(b * 4096 + pos) * 1280 + 1024 + isv * 128 + kvh * 64; }
    if (kk < 128) return cb + (size_t)(b * 128 + kk) * 128 + kvh * 64;
    int t = kk - 128; t = t > 31 ? 31 : t; return proj + (size_t)(MP + b * 32 + t) * 1280 + 1024 + isv * 128 + kvh * 64;
}
__device__ __forceinline__ void swa_phase(const bf16* proj, const bf16* ckb, const bf16* cvb, const float* sinks, bf16* ycat, LAS unsigned char* lds, int tid, int wave, int lane, int G) {
    LAS bf16* VT = (LAS bf16*)lds;
    const int fr = lane & 15, quad = lane >> 4;
    for (int it = blockIdx.x; it < 528; it += G) {
        int b, c, kvh, sample;
        if (it < 512) { sample = 0; b = it >> 7; c = (it >> 1) & 63; kvh = it & 1; } else { sample = 1; b = (it - 512) >> 1; c = 0; kvh = it & 1; }
        __syncthreads();
#pragma unroll
        for (int i = 0; i < 3; ++i) { const int idx = tid + 512 * i, kk = idx % 192, dg = idx / 192; const v4u w = *(const GAS v4u*)((const GAS bf16*)kvptr(proj, cvb, sample, b, c, kvh, kk, 1) + dg * 8);
            LAS bf16* vp = VT + (dg * 8) * 200 + kk;
            vp[0] = (bf16)(w.x & 0xffffu); vp[200] = (bf16)(w.x >> 16); vp[400] = (bf16)(w.y & 0xffffu); vp[600] = (bf16)(w.y >> 16);
            vp[800] = (bf16)(w.z & 0xffffu); vp[1000] = (bf16)(w.z >> 16); vp[1200] = (bf16)(w.w & 0xffffu); vp[1400] = (bf16)(w.w >> 16); }
        __syncthreads();
        const int gq = wave >> 1, qhalf = wave & 1, head = kvh * 4 + gq;
        if (!(sample && qhalf)) {
            const int plo = sample ? 0 : (c >= 2 ? 0 : (2 - c) * 2), phi = sample ? 5 : 6;
            bf16x8 qf[2][2];
#pragma unroll
            for (int qb = 0; qb < 2; ++qb) { const int q = qhalf * 32 + qb * 16 + fr; const int row = sample ? MP + b * 32 + (q & 31) : b * 4096 + c * 64 + q;
                const GAS bf16* qp = (const GAS bf16*)proj + (size_t)row * 1280 + 512 + head * 64 + quad * 8; qf[qb][0] = *(const GAS bf16x8*)qp; qf[qb][1] = *(const GAS bf16x8*)(qp + 32); }
            f32x4 s[12][2];
#pragma unroll
            for (int kg = 0; kg < 3; ++kg) { bf16x8 kf[4][2];
#pragma unroll
                for (int i = 0; i < 4; ++i) { const int kb = kg * 4 + i, key = 32 * (kb >> 1) + (fr >> 2) * 8 + 4 * (kb & 1) + (fr & 3); const GAS bf16* kp = (const GAS bf16*)kvptr(proj, ckb, sample, b, c, kvh, key, 0) + quad * 8;
                    kf[i][0] = *(const GAS bf16x8*)kp; kf[i][1] = *(const GAS bf16x8*)(kp + 32); }
                __builtin_amdgcn_sched_barrier(0);
#pragma unroll
                for (int i = 0; i < 4; ++i)
#pragma unroll
                    for (int qb = 0; qb < 2; ++qb) { f32x4 a = {0.f, 0.f, 0.f, 0.f}; a = MFMA16(kf[i][0], qf[qb][0], a); a = MFMA16(kf[i][1], qf[qb][1], a); s[kg * 4 + i][qb] = a; }
                __builtin_amdgcn_sched_barrier(0); }
            const float sink = sinks[head];
            bf16x8 pf[6][2];
#pragma unroll
            for (int qb = 0; qb < 2; ++qb) { float mx = sink;
#pragma unroll
                for (int kb = 0; kb < 12; ++kb) { const bool pv = (kb >> 1) >= plo && (kb >> 1) < phi;
#pragma unroll
                    for (int j = 0; j < 4; ++j) { const float v = pv ? s[kb][qb][j] : -1e30f; s[kb][qb][j] = v; mx = fmaxf(mx, v); } }
                mx = fmaxf(mx, __shfl_xor(mx, 16)); mx = fmaxf(mx, __shfl_xor(mx, 32));
                float sum = 0.f;
#pragma unroll
                for (int kb = 0; kb < 12; ++kb)
#pragma unroll
                    for (int j = 0; j < 4; ++j) { const float e = __expf(s[kb][qb][j] - mx); s[kb][qb][j] = e; sum += e; }
                sum += __shfl_xor(sum, 16); sum += __shfl_xor(sum, 32); sum += __expf(sink - mx);
                const float inv = 1.0f / sum;
#pragma unroll
                for (int pr = 0; pr < 6; ++pr) pf[pr][qb] = __builtin_bit_cast(bf16x8, pack8(s[2 * pr][qb] * inv, s[2 * pr + 1][qb] * inv)); }
#pragma unroll
            for (int db = 0; db < 4; ++db) { bf16x8 vf[6];
#pragma unroll
                for (int pr = 0; pr < 6; ++pr) vf[pr] = *(const LAS bf16x8*)(VT + (db * 16 + fr) * 200 + 32 * pr + quad * 8);
#pragma unroll
                for (int qb = 0; qb < 2; ++qb) { f32x4 o = {0.f, 0.f, 0.f, 0.f};
#pragma unroll
                    for (int pr = 0; pr < 6; ++pr) o = MFMA16(pf[pr][qb], vf[pr], o);
#pragma unroll
                    for (int j = 0; j < 4; ++j) { const int q = qhalf * 32 + qb * 16 + quad * 4 + j;
                        if (!sample || q < 32) { const int row = sample ? MP + b * 32 + q : b * 4096 + c * 64 + q; ycat[(size_t)row * 1024 + 512 + head * 64 + db * 16 + fr] = (bf16)f2bf(o[j]); } } } }
        }
    }
    __syncthreads();
}

__device__ __forceinline__ void xattn_phase(const bf16* qx, const bf16* memk_l, const bf16* memvT_l, bf16* ox, int wave, int lane, int G) {
    const int fr = lane & 15, quad = lane >> 4;
    for (int t = wave * G + (int)blockIdx.x; t < 4160; t += 8 * G) {
        int bb, h, row0;
        if (t < 4096) { const int pair = t >> 8; bb = pair >> 2; h = pair & 3; row0 = bb * 4096 + (t & 255) * 16; }
        else { const int s = t - 4096, b = s >> 3; h = (s >> 1) & 3; bb = 4 + b; row0 = MP + b * 32 + (s & 1) * 16; }
        bf16x8 qf[8];
#pragma unroll
        for (int ks = 0; ks < 8; ++ks) qf[ks] = *(const bf16x8*)(qx + (size_t)(row0 + fr) * 1024 + h * 256 + ks * 32 + quad * 8);
        const bf16* kbase = memk_l + (size_t)bb * 262144 + h * 256 + quad * 8;
        f32x4 s[16];
#pragma unroll
        for (int kb = 0; kb < 16; ++kb) { const int key = 32 * (kb >> 1) + (fr >> 2) * 8 + 4 * (kb & 1) + (fr & 3); const bf16* kp = kbase + (size_t)key * 1024; f32x4 a = {0.f, 0.f, 0.f, 0.f};
#pragma unroll
            for (int ks = 0; ks < 8; ++ks) a = MFMA16(*(const bf16x8*)(kp + ks * 32), qf[ks], a);
            s[kb] = a; }
        float mx = -1e30f;
#pragma unroll
        for (int kb = 0; kb < 16; ++kb)
#pragma unroll
            for (int j = 0; j < 4; ++j) mx = fmaxf(mx, s[kb][j]);
        mx = fmaxf(mx, __shfl_xor(mx, 16)); mx = fmaxf(mx, __shfl_xor(mx, 32));
        float sum = 0.f;
#pragma unroll
        for (int kb = 0; kb < 16; ++kb)
#pragma unroll
            for (int j = 0; j < 4; ++j) { const float e = __expf(s[kb][j] - mx); s[kb][j] = e; sum += e; }
        sum += __shfl_xor(sum, 16); sum += __shfl_xor(sum, 32);
        const float inv = 1.0f / sum;
        bf16x8 pf[8];
#pragma unroll
        for (int pr = 0; pr < 8; ++pr) pf[pr] = __builtin_bit_cast(bf16x8, pack8(s[2 * pr] * inv, s[2 * pr + 1] * inv));
        const bf16* vbase = memvT_l + (size_t)bb * 262144 + (size_t)(h * 256 + fr) * 256 + quad * 8;
#pragma unroll 4
        for (int db = 0; db < 16; ++db) { f32x4 o = {0.f, 0.f, 0.f, 0.f};
#pragma unroll
            for (int pr = 0; pr < 8; ++pr) o = MFMA16(pf[pr], *(const bf16x8*)(vbase + (size_t)db * 4096 + pr * 32), o);
#pragma unroll
            for (int j = 0; j < 4; ++j) ox[(size_t)(row0 + quad * 4 + j) * 1024 + h * 256 + db * 16 + fr] = (bf16)f2bf(o[j]); }
    }
}


__device__ __forceinline__ void xstage(const bf16* src, size_t rowstride, LAS unsigned char* lds, int tid) {
    v4u t[16];
#pragma unroll
    for (int i = 0; i < 16; ++i) { const int row = (tid >> 5) + 16 * i, ch = tid & 31; t[i] = *(const GAS v4u*)((const GAS bf16*)src + (size_t)row * rowstride + ch * 8); }
#pragma unroll
    for (int i = 0; i < 16; ++i) { const int row = (tid >> 5) + 16 * i, ch = tid & 31; *(LAS v4u*)(lds + row * 528 + ch * 16) = t[i]; }
}
__device__ __forceinline__ void xattn_phase2(const bf16* qx, const bf16* memk_l, const bf16* memvT_l, bf16* ox, LAS unsigned char* lds, int tid, int wave, int lane, int G) {
    const int fr = lane & 15, quad = lane >> 4;
    for (int it = blockIdx.x; it < 256 + 32; it += G) {
        int bb, h, rowbase, nqb; bool active;
        if (it < 256) { bb = it >> 6; h = (it >> 4) & 3; rowbase = bb * 4096 + (it & 15) * 256; nqb = 2; active = true; }
        else { const int s = it - 256, b = s >> 2; h = s & 3; bb = 4 + b; rowbase = MP + b * 32; nqb = 1; active = wave < 2; }
        __syncthreads();
        xstage(memk_l + (size_t)bb * 262144 + h * 256, 1024, lds, tid);
        __syncthreads();
        bf16x8 pf[2][8];
#pragma unroll
        for (int qi = 0; qi < 2; ++qi) {
            if (qi < nqb && active) {
                const int row0 = rowbase + qi * 128 + wave * 16;
                bf16x8 qf[8];
#pragma unroll
                for (int ks = 0; ks < 8; ++ks) qf[ks] = *(const GAS bf16x8*)((const GAS bf16*)qx + (size_t)(row0 + fr) * 1024 + h * 256 + ks * 32 + quad * 8);
                f32x4 s[16];
#pragma unroll
                for (int kb = 0; kb < 16; ++kb) { const int key = 32 * (kb >> 1) + (fr >> 2) * 8 + 4 * (kb & 1) + (fr & 3); const LAS unsigned char* kp = lds + key * 528 + quad * 16; f32x4 a = {0.f, 0.f, 0.f, 0.f};
#pragma unroll
                    for (int ks = 0; ks < 8; ++ks) a = MFMA16(*(const LAS bf16x8*)(kp + ks * 64), qf[ks], a);
                    s[kb] = a; }
                float mx = -1e30f;
#pragma unroll
                for (int kb = 0; kb < 16; ++kb)
#pragma unroll
                    for (int j = 0; j < 4; ++j) mx = fmaxf(mx, s[kb][j]);
                mx = fmaxf(mx, __shfl_xor(mx, 16)); mx = fmaxf(mx, __shfl_xor(mx, 32));
                float sum = 0.f;
#pragma unroll
                for (int kb = 0; kb < 16; ++kb)
#pragma unroll
                    for (int j = 0; j < 4; ++j) { const float e = __expf(s[kb][j] - mx); s[kb][j] = e; sum += e; }
                sum += __shfl_xor(sum, 16); sum += __shfl_xor(sum, 32);
                const float inv = 1.0f / sum;
#pragma unroll
                for (int pr = 0; pr < 8; ++pr) pf[qi][pr] = __builtin_bit_cast(bf16x8, pack8(s[2 * pr] * inv, s[2 * pr + 1] * inv));
            }
        }
        __syncthreads();
        xstage(memvT_l + (size_t)bb * 262144 + (size_t)h * 65536, 256, lds, tid);
        __syncthreads();
#pragma unroll
        for (int qi = 0; qi < 2; ++qi) {
            if (qi < nqb && active) {
                const int row0 = rowbase + qi * 128 + wave * 16;
#pragma unroll 4
                for (int db = 0; db < 16; ++db) { f32x4 o = {0.f, 0.f, 0.f, 0.f}; const LAS unsigned char* vp = lds + (db * 16 + fr) * 528 + quad * 16;
#pragma unroll
                    for (int pr = 0; pr < 8; ++pr) o = MFMA16(*(const LAS bf16x8*)(vp + pr * 64), pf[qi][pr], o);
                    u32x2v w; w.x = pk2(o[0], o[1]); w.y = pk2(o[2], o[3]);
                    *(GAS u32x2v*)((GAS bf16*)ox + (size_t)(row0 + fr) * 1024 + h * 256 + db * 16 + quad * 4) = w; }
            }
        }
    }
    __syncthreads();
}

__device__ __forceinline__ void s5_stage_u(const bf16* up, LAS float* ubuf, int lane) {
    const v4u w0 = *(const v4u*)up, w1 = *(const v4u*)(up + 8);
    LAS f32x4* d = (LAS f32x4*)(ubuf + lane * 16);
    d[0] = (f32x4){bflo(w0.x), bfhi(w0.x), bflo(w0.y), bfhi(w0.y)}; d[1] = (f32x4){bflo(w0.z), bfhi(w0.z), bflo(w0.w), bfhi(w0.w)};
    d[2] = (f32x4){bflo(w1.x), bfhi(w1.x), bflo(w1.y), bfhi(w1.y)}; d[3] = (f32x4){bflo(w1.z), bfhi(w1.z), bflo(w1.w), bfhi(w1.w)};
}
__device__ __forceinline__ f32x2v lo2_(f32x4 v) { return __builtin_shufflevector(v, v, 0, 1); }
__device__ __forceinline__ f32x2v hi2_(f32x4 v) { return __builtin_shufflevector(v, v, 2, 3); }
#define S5_STEP(sidx) do { const LAS f32x4* up_ = (const LAS f32x4*)(ubuf + (sidx) * 16); const f32x4 u0 = up_[0], u1 = up_[1], u2 = up_[2], u3 = up_[3]; \
    f32x2v ac_ = lo2_(bb[0]) * u0[0]; ac_ = hi2_(bb[0]) * u0[1] + ac_; ac_ = lo2_(bb[1]) * u0[2] + ac_; ac_ = hi2_(bb[1]) * u0[3] + ac_; \
    ac_ = lo2_(bb[2]) * u1[0] + ac_; ac_ = hi2_(bb[2]) * u1[1] + ac_; ac_ = lo2_(bb[3]) * u1[2] + ac_; ac_ = hi2_(bb[3]) * u1[3] + ac_; \
    ac_ = lo2_(bb[4]) * u2[0] + ac_; ac_ = hi2_(bb[4]) * u2[1] + ac_; ac_ = lo2_(bb[5]) * u2[2] + ac_; ac_ = hi2_(bb[5]) * u2[3] + ac_; \
    ac_ = lo2_(bb[6]) * u3[0] + ac_; ac_ = hi2_(bb[6]) * u3[1] + ac_; ac_ = lo2_(bb[7]) * u3[2] + ac_; ac_ = hi2_(bb[7]) * u3[3] + ac_; \
    const float nr_ = ar * hr - ai * hi + ac_.x, ni_ = ar * hi + ai * hr + ac_.y; hr = nr_; hi = ni_; } while (0)

typedef short bf16x4_t __attribute__((ext_vector_type(4)));
#define MFMA16K16(a, b, c) __builtin_amdgcn_mfma_f32_16x16x16bf16_1k(a, b, c, 0, 0, 0)
__device__ __forceinline__ void s5_bu_block(const bf16* urow0, const bf16x4_t (&bcf)[8], LAS float* bul, int fr, int quad) {
    const bf16x4_t a = *(const GAS bf16x4_t*)((const GAS bf16*)urow0 + (size_t)fr * 1280 + quad * 4);
#pragma unroll
    for (int cb = 0; cb < 8; ++cb) { f32x4 d = {0.f, 0.f, 0.f, 0.f}; d = MFMA16K16(a, bcf[cb], d);
#pragma unroll
        for (int j = 0; j < 4; ++j) bul[(quad * 4 + j) * 130 + cb * 16 + fr] = d[j]; }
}
__device__ __forceinline__ void s5_local(const bf16* proj, const float* abar, const bf16* bbt, float* sloc, LAS float* bul, int slot, int nslots, int lane) {
    const int fr = lane & 15, quad = lane >> 4;
    for (int t = slot; t < 8192; t += nslots) {
        const int chunk = t & 63, g = (t >> 6) & 31, b = t >> 11;
        const float ar = abar[(g * 64 + lane) * 2], ai = abar[(g * 64 + lane) * 2 + 1];
        bf16x4_t bcf[8];
#pragma unroll
        for (int cb = 0; cb < 8; ++cb) bcf[cb] = *(const GAS bf16x4_t*)((const GAS bf16*)bbt + (size_t)(g * 128 + cb * 16 + fr) * 16 + quad * 4);
        float hr = 0.f, hi = 0.f;
        for (int blk = 0; blk < 4; ++blk) {
            s5_bu_block(proj + (size_t)(b * 4096 + chunk * 64 + blk * 16) * 1280 + g * 16, bcf, bul, fr, quad);
#pragma unroll 4
            for (int s = 0; s < 16; ++s) { const f32x2v bu = *(const LAS f32x2v*)(bul + s * 130 + 2 * lane); const float nr = ar * hr - ai * hi + bu.x, ni = ar * hi + ai * hr + bu.y; hr = nr; hi = ni; }
        }
        *(f32x2v*)(sloc + (size_t)t * 128 + lane * 2) = (f32x2v){hr, hi};
    }
}
__device__ __forceinline__ void s5_out(const bf16* proj, const float* abar, const bf16* bbt, const float* sloc, const float* st_re, const float* st_im, const float* c_re, const float* c_im,
                                       const float* dcoef, bf16* gbuf, float* out, LAS float* bul, LAS unsigned* hbuf, int slot, int nslots, int lane) {
    const int fr = lane & 15, quad = lane >> 4;
    for (int t = slot; t < 8192 + 256; t += nslots) {
        const int sample = t >= 8192; int b, g, chunk, nblk, rowbase;
        if (!sample) { chunk = t & 63; g = (t >> 6) & 31; b = t >> 11; nblk = 4; rowbase = b * 4096 + chunk * 64; } else { const int s = t - 8192; g = s & 31; b = s >> 5; chunk = 0; nblk = 2; rowbase = MP + b * 32; }
        const float ar = abar[(g * 64 + lane) * 2], ai = abar[(g * 64 + lane) * 2 + 1];
        bf16x4_t bcf[8];
#pragma unroll
        for (int cb = 0; cb < 8; ++cb) bcf[cb] = *(const GAS bf16x4_t*)((const GAS bf16*)bbt + (size_t)(g * 128 + cb * 16 + fr) * 16 + quad * 4);
        float hr, hi;
        if (!sample) { float pr = ar, pi = ai;
#pragma unroll
            for (int i = 0; i < 6; ++i) { const float t1 = pr * pr - pi * pi; pi = 2.f * pr * pi; pr = t1; }
            hr = 0.f; hi = 0.f; const float* sp = sloc + (size_t)(t - chunk) * 128 + lane * 2;
#pragma unroll 16
            for (int cc = 0; cc < chunk; ++cc) { const f32x2v sv = *(const f32x2v*)(sp + (size_t)cc * 128); const float nr = pr * hr - pi * hi + sv.x, ni = pr * hi + pi * hr + sv.y; hr = nr; hi = ni; } }
        else { hr = st_re[(b * 32 + g) * 64 + lane]; hi = st_im[(b * 32 + g) * 64 + lane]; }
        bf16x8 cf[4];
#pragma unroll
        for (int ks = 0; ks < 4; ++ks) { const f32x4 cr = *(const f32x4*)(c_re + (size_t)(g * 16 + fr) * 64 + ks * 16 + quad * 4), ci = *(const f32x4*)(c_im + (size_t)(g * 16 + fr) * 64 + ks * 16 + quad * 4);
            v4u w; w.x = pg8::cvt_pk_bf16(cr[0], -ci[0]); w.y = pg8::cvt_pk_bf16(cr[1], -ci[1]); w.z = pg8::cvt_pk_bf16(cr[2], -ci[2]); w.w = pg8::cvt_pk_bf16(cr[3], -ci[3]); cf[ks] = __builtin_bit_cast(bf16x8, w); }
        const float dco = dcoef[g * 16 + fr];
        for (int blk = 0; blk < nblk; ++blk) {
            const bf16* urow0 = proj + (size_t)(rowbase + blk * 16) * 1280 + g * 16;
            s5_bu_block(urow0, bcf, bul, fr, quad);
#pragma unroll 4
            for (int s = 0; s < 16; ++s) { const f32x2v bu = *(const LAS f32x2v*)(bul + s * 130 + 2 * lane); const float nr = ar * hr - ai * hi + bu.x, ni = ar * hi + ai * hr + bu.y; hr = nr; hi = ni; hbuf[s * 68 + lane] = pg8::cvt_pk_bf16(hr, hi); }
            f32x4 y = {0.f, 0.f, 0.f, 0.f};
#pragma unroll
            for (int ks = 0; ks < 4; ++ks) { const bf16x8 a = *(const LAS bf16x8*)(hbuf + fr * 68 + ks * 16 + quad * 4); y = MFMA16(a, cf[ks], y); }
#pragma unroll
            for (int j = 0; j < 4; ++j) { const int s = blk * 16 + quad * 4 + j; const float uu = bflo((unsigned)((const GAS bf16*)urow0)[(size_t)(quad * 4 + j) * 1280 + fr]); const float yv = y[j] + dco * uu;
                const float z = 0.7978845608028654f * (yv + 0.044715f * yv * yv * yv); const float th = 1.0f - 2.0f / (1.0f + __expf(2.0f * z)); const float gl = 0.5f * yv * (1.0f + th);
                ((GAS bf16*)gbuf)[(size_t)(rowbase + s) * 512 + g * 16 + fr] = (bf16)f2bf(gl); }
        }
        if (!sample && chunk == 63) { out[OFF_SRP + (b * 32 + g) * 64 + lane] = hr; out[OFF_SIP + (b * 32 + g) * 64 + lane] = hi; }
        if (sample) { out[OFF_SRS + (b * 32 + g) * 64 + lane] = hr; out[OFF_SIS + (b * 32 + g) * 64 + lane] = hi; }
    }
}

template <int KIND>
__device__ __forceinline__ void sample_gemm(const bf16* A, const bf16* Bt, int K, LAS unsigned char* lds, int tid, int wave, int lane,
                                            bf16* xbp, const float* base_f32, float* part_next, const float* part_cur, bf16* O) {
    const int fr = lane & 15, quad = lane >> 4;
    LAS f32x4* red = (LAS f32x4*)lds;
    LAS float* ssred = (LAS float*)(lds + 32768);
    for (int tile = blockIdx.x; tile < 256; tile += gridDim.x) {
        const int r0 = MP + (tile >> 4) * 16, c0 = (tile & 15) * 64, kw = K >> 3;
        const bf16* ap = A + (size_t)(r0 + fr) * K + wave * kw + quad * 8;
        const bf16* bp = Bt + (size_t)(c0 + fr) * K + wave * kw + quad * 8;
        f32x4 acc[4];
#pragma unroll
        for (int cb = 0; cb < 4; ++cb) acc[cb] = (f32x4){0.f, 0.f, 0.f, 0.f};
        const int nks = kw >> 5;
        for (int k0 = 0; k0 < nks; k0 += 4) {
            bf16x8 a[4], b[4][4];
#pragma unroll
            for (int i = 0; i < 4; ++i) { const int ks = (k0 + i < nks) ? k0 + i : nks - 1;
                a[i] = *(const bf16x8*)(ap + ks * 32);
#pragma unroll
                for (int cb = 0; cb < 4; ++cb) b[i][cb] = *(const bf16x8*)(bp + (size_t)cb * 16 * K + ks * 32); }
            __builtin_amdgcn_sched_barrier(0);
#pragma unroll
            for (int i = 0; i < 4; ++i) if (k0 + i < nks) {
#pragma unroll
                for (int cb = 0; cb < 4; ++cb) acc[cb] = MFMA16(b[i][cb], a[i], acc[cb]); }
        }
#pragma unroll
        for (int cb = 0; cb < 4; ++cb) red[(wave * 4 + cb) * 64 + lane] = acc[cb] * 1.0f;
        __syncthreads();
        if (tid < 256) { const int cb = tid >> 6, l2 = tid & 63; f32x4 v = red[cb * 64 + l2];
#pragma unroll
            for (int w = 1; w < 8; ++w) v = v + red[(w * 4 + cb) * 64 + l2];
            const int row = r0 + (l2 & 15), col = c0 + cb * 16 + 4 * (l2 >> 4); const size_t off = (size_t)row * 1024 + col;
            if (KIND == 0) { f32x4 bs;
                if (base_f32) bs = *(const f32x4*)(base_f32 + off);
                else { const u32x2v w = *(const u32x2v*)(xbp + off); bs = (f32x4){bflo(w.x), bfhi(w.x), bflo(w.y), bfhi(w.y)}; }
                v = v + bs; u32x2v o; o.x = pk2(v[0], v[1]); o.y = pk2(v[2], v[3]); *(u32x2v*)(xbp + off) = o;
                float ss = (v[0] * v[0] + v[1] * v[1]) + (v[2] * v[2] + v[3] * v[3]); ss += __shfl_xor(ss, 16); ss += __shfl_xor(ss, 32);
                if ((l2 >> 4) == 0) ssred[cb * 16 + (l2 & 15)] = ss; }
            else { const float rs = rstd_of(part_cur, row); u32x2v o; o.x = pk2(v[0] * rs, v[1] * rs); o.y = pk2(v[2] * rs, v[3] * rs); *(u32x2v*)(O + off) = o; }
        }
        if (KIND == 0) { __syncthreads(); if (tid < 16) part_next[(size_t)(r0 + tid) * 16 + (tile & 15)] = (ssred[tid] + ssred[16 + tid]) + (ssred[32 + tid] + ssred[48 + tid]); }
        __syncthreads();
    }
}


__device__ __forceinline__ void sample_cz(const bf16* A, const bf16* Bt, LAS unsigned char* lds, int tid, int wave, int lane,
                                          const float* part_cur, const float* cw, const float* st, bf16* zcp, float* outp) {
    const int fr = lane & 15, quad = lane >> 4;
    LAS f32x4* red = (LAS f32x4*)lds;
    LAS float* T = (LAS float*)(lds + 65536);
    LAS float* CZ = (LAS float*)(lds + 65536 + 8192);
    for (int tile = blockIdx.x; tile < 256; tile += gridDim.x) {
        const int b = tile >> 5, c0 = (tile & 31) * 32, r0 = MP + b * 32;
        const int wrow = 1024 + (c0 >> 7) * 256 + (c0 & 127);
        const GAS bf16* ap = (const GAS bf16*)A + (size_t)(r0 + fr) * 1024 + wave * 128 + quad * 8;
        const GAS bf16* bp = (const GAS bf16*)Bt + (size_t)(wrow + fr) * 1024 + wave * 128 + quad * 8;
        bf16x8 a[4][2], bw[4][4];
#pragma unroll
        for (int ks = 0; ks < 4; ++ks) {
#pragma unroll
            for (int rb = 0; rb < 2; ++rb) a[ks][rb] = *(const GAS bf16x8*)(ap + (size_t)rb * 16 * 1024 + ks * 32);
#pragma unroll
            for (int cb = 0; cb < 4; ++cb) bw[ks][cb] = *(const GAS bf16x8*)(bp + (size_t)((cb >> 1) * 128 + (cb & 1) * 16) * 1024 + ks * 32); }
        f32x4 acc[2][4];
#pragma unroll
        for (int rb = 0; rb < 2; ++rb)
#pragma unroll
            for (int cb = 0; cb < 4; ++cb) { f32x4 d = {0.f, 0.f, 0.f, 0.f};
#pragma unroll
                for (int ks = 0; ks < 4; ++ks) d = MFMA16(bw[ks][cb], a[ks][rb], d);
                acc[rb][cb] = d; }
#pragma unroll
        for (int rb = 0; rb < 2; ++rb)
#pragma unroll
            for (int cb = 0; cb < 4; ++cb) red[(wave * 8 + rb * 4 + cb) * 64 + lane] = acc[rb][cb];
        __syncthreads();
        {
            const int blk = tid >> 6, l2 = tid & 63, rb = blk >> 2, cb = blk & 3; f32x4 v = red[blk * 64 + l2];
#pragma unroll
            for (int w = 1; w < 8; ++w) v = v + red[(w * 8 + blk) * 64 + l2];
            *(LAS f32x4*)(T + ((cb >> 1) * 32 + rb * 16 + (l2 & 15)) * 32 + (cb & 1) * 16 + 4 * (l2 >> 4)) = v; }
        __syncthreads();
        const int r = tid >> 3, cq = (tid & 7) * 4;
        if (tid < 256) { const float rs = rstd_of(part_cur, r0 + r); const float rs2 = rs * rs;
            const f32x4 gc = *(const LAS f32x4*)(T + r * 32 + cq), zz = *(const LAS f32x4*)(T + (32 + r) * 32 + cq);
            *(LAS f32x4*)(CZ + r * 32 + cq) = gc * zz * rs2; }
        __syncthreads();
        if (tid < 256) { const int c = c0 + cq;
            const f32x4 x0 = *(const LAS f32x4*)(CZ + r * 32 + cq);
            const f32x4 s0 = *(const f32x4*)(st + (size_t)(b * 2) * 1024 + c), s1 = *(const f32x4*)(st + (size_t)(b * 2 + 1) * 1024 + c);
            f32x4 xm1 = s1, xm2 = s0;
            if (r >= 1) { xm1 = *(const LAS f32x4*)(CZ + (r - 1) * 32 + cq); xm2 = s1; }
            if (r >= 2) xm2 = *(const LAS f32x4*)(CZ + (r - 2) * 32 + cq);
            const f32x4 w0 = *(const f32x4*)(cw + c), w1 = *(const f32x4*)(cw + 1024 + c), w2 = *(const f32x4*)(cw + 2048 + c);
            const f32x4 z = w0 * xm2 + w1 * xm1 + w2 * x0;
            u32x2v o; o.x = pk2(z[0], z[1]); o.y = pk2(z[2], z[3]); *(u32x2v*)(zcp + (size_t)(r0 + r) * 1024 + c) = o;
            if (r >= 30) *(f32x4*)(outp + OFF_CMS + (size_t)(b * 2 + (r - 30)) * 1024 + c) = x0; }
        __syncthreads();
    }
}

struct Params { const float* in[36]; float* out; unsigned char* ws; int use_cg, pad; };

__global__ void __launch_bounds__(512, 2) mega_fwd(Params P) {
    extern __shared__ __attribute__((aligned(16))) unsigned char lds_raw[];
    LAS unsigned char* lds = (LAS unsigned char*)lds_raw;
    volatile LAS unsigned* MISC = (volatile LAS unsigned*)(lds + MISC_OFF);
    const int G = gridDim.x, NGW = G * 8, NT = G * 512;
    const int wave_s = __builtin_amdgcn_readfirstlane(threadIdx.x >> 6);
    for (int u = threadIdx.x; u < (LDS_BYTES - 131072) / 4; u += 512) ((LAS unsigned*)(lds + 131072))[u] = 0u;
    __syncthreads();
    XcdBarrier bar = xcd_barrier_post((unsigned*)(P.ws + WS_BAR), MISC + 8);
#ifndef STOP_AFTER
#define STOP_AFTER 1000
#endif
    int ph = 0;
#define RUN (ph < STOP_AFTER)
#define FRESH() const int tid = fresh_tid(wave_s), lane = tid & 63, wave = __builtin_amdgcn_readfirstlane(tid >> 6); const int gw = blockIdx.x * 8 + wave, gt = blockIdx.x * 512 + tid; (void)gw; (void)gt; (void)lane; LAS float* wscr = (LAS float*)(lds + 32768 + wave * 12288); (void)wscr;
#define SEAM() do { if (P.use_cg) cg::this_grid().sync(); else xcd_barrier(bar); ++ph; } while (0)

#define part ((float*)(ws + WS_PART))
#define PARTBUF(k) (part + (size_t)((k) & 1) * PART_ELEMS)
#define ropec ((float*)(ws + WS_ROPE))
#define ropes (ropec + 4096 * 32)
#define abar ((float*)(ws + WS_SSM))
#define bbar (abar + 32 * 64 * 2)
#define bbt ((bf16*)(bbar + 32 * 64 * 32))
#define ckb ((bf16*)(ws + WS_CKV))
#define cvb (ckb + 8 * 128 * 128)
#define sloc ((float*)(ws + WS_SLOC))
#define memk ((bf16*)(ws + WS_MEMK))
#define memvT ((bf16*)(ws + WS_MEMVT))
#define SG ((float*)(ws + WS_SIDE))
#define SV ((float*)(ws + WS_SIDE + SG_BYTES))
#define WT ((bf16*)(ws + WS_WT))
#define xb ((bf16*)(ws + WS_XB))
#define tmp (ws + WS_TMP)
#define proj0 ((bf16*)(tmp + TMP_PROJ0))
#define gbuf ((bf16*)(tmp + TMP_GBUF))
#define ycat ((bf16*)(tmp + TMP_YCAT))
#define memb ((bf16*)(tmp + TMP_MEMB))
#define qx ((bf16*)(tmp + TMP_QX))
#define ox ((bf16*)(tmp + TMP_OX))
#define act ((bf16*)(tmp + TMP_ACT))
#define gbm ((bf16*)(tmp + TMP_GB))
#define zc ((bf16*)(tmp + TMP_ZC))
#define PTRS() unsigned char* ws = P.ws; float* out = P.out; asm volatile("" : "+s"(ws), "+s"(out));
    if (RUN) { PTRS() FRESH()
        {
            constexpr int NITEMS = 640 + 128 + 512 + 512 + 2 * 1024 + 512 + 2816 + 1408 + 2048;
            for (int it = gw; it < NITEMS; it += NGW) { int r = it;
#define TR(Wp, K_, N_, WTp, gainp, sc, mode) { const int ni_ = ((K_) / 64) * ((N_) / 32); if (r < ni_) { tr_item(Wp, K_, N_, WTp, gainp, sc, mode, wscr, r, lane); continue; } r -= ni_; }
                TR(P.in[15], 1024, 1280, WT + WT_INEVEN, P.in[11], 1.f, 1)
                TR(P.in[25], 512, 512, WT + WT_GLU, nullptr, 1.f, 0)
                TR(P.in[16], 1024, 1024, WT + WT_OUTEVEN, nullptr, 1.f, 0)
                TR(P.in[30], 1024, 1024, WT + WT_WQ, P.in[12], 0.0625f, 0)
                TR(P.in[31], 1024, 2048, WT + WT_WKV, nullptr, 1.f, 0)
                TR(P.in[31] + 2097152, 1024, 2048, WT + WT_WKV + 2097152, nullptr, 1.f, 0)
                TR(P.in[32], 1024, 1024, WT + WT_WO, nullptr, 1.f, 0)
                TR(P.in[33], 1024, 5632, WT + WT_UP, P.in[13], 1.f, 2)
                TR(P.in[35], 2816, 1024, WT + WT_DOWN, nullptr, 1.f, 0)
                { const int mi = r >> 7, l = mi >> 3, b = mi & 7; tr_item(P.in[10] + (size_t)mi * 262144, 256, 1024, memvT + (size_t)(l * 12 + 4 + b) * 262144, nullptr, 1.f, 0, wscr, r & 127, lane); }
            }
        }
        for (int m = gw; m < MROWS; m += NGW) { const float* xr = m < MP ? P.in[0] + (size_t)m * 1024 : P.in[1] + (size_t)(m - MP) * 1024; float ss = 0.f;
#pragma unroll
            for (int j = 0; j < 4; ++j) { const f32x4 v = *(const f32x4*)(xr + (lane + 64 * j) * 4); ss += (v[0] * v[0] + v[1] * v[1]) + (v[2] * v[2] + v[3] * v[3]);
                u32x2v w; w.x = pg8::cvt_pk_bf16(v[0], v[1]); w.y = pg8::cvt_pk_bf16(v[2], v[3]); *(u32x2v*)(xb + (size_t)m * 1024 + (lane + 64 * j) * 4) = w; }
            ss = wave_sum(ss); if (lane < 16) PARTBUF(0)[(size_t)m * 16 + lane] = lane == 0 ? ss : 0.f; }
        for (int i = gt; i < 262144; i += NT) { const f32x4 v = *(const f32x4*)(P.in[2] + (size_t)i * 4); u32x2v w; w.x = pg8::cvt_pk_bf16(v[0], v[1]); w.y = pg8::cvt_pk_bf16(v[2], v[3]); *(u32x2v*)(memb + (size_t)i * 4) = w; }
        for (int i = gt; i < 1048576; i += NT) { const size_t e = (size_t)i * 4; const int lb = (int)(e >> 18), l = lb >> 3, b = lb & 7; const f32x4 v = *(const f32x4*)(P.in[9] + e);
            u32x2v w; w.x = pg8::cvt_pk_bf16(v[0], v[1]); w.y = pg8::cvt_pk_bf16(v[2], v[3]); *(u32x2v*)(memk + (size_t)(l * 12 + 4 + b) * 262144 + (e & 262143)) = w; }
        for (int i = gt; i < 65536; i += NT) { const int j = i & 32767; const float* src = (i < 32768 ? P.in[3] : P.in[4]) + (size_t)j * 4; bf16* dst = (i < 32768 ? ckb : cvb) + (size_t)j * 4;
            const f32x4 v = *(const f32x4*)src; u32x2v w; w.x = pg8::cvt_pk_bf16(v[0], v[1]); w.y = pg8::cvt_pk_bf16(v[2], v[3]); *(u32x2v*)dst = w; }
        for (int i = gt; i < 4096 * 32; i += NT) { const int pos = i >> 5, d = i & 31; const double inv = dexp_(-(double)d * (9.210340371976184 / 32.0)); double s, c; dsincos_((double)pos * inv, s, c); ropec[i] = (float)c; ropes[i] = (float)s; }
        for (int i = gt; i < 2048; i += NT) { const double are = P.in[17][i], aim = P.in[18][i], dt = dexp_((double)P.in[19][i]); double s, c; dsincos_(aim * dt, s, c); const double mag = dexp_(are * dt);
            const double br = mag * c, bi = mag * s; abar[2 * i] = (float)br; abar[2 * i + 1] = (float)bi;
            const double nr = br - 1.0, ni = bi, den = are * are + aim * aim; const double qr = (nr * are + ni * aim) / den, qi = (ni * are - nr * aim) / den;
#pragma unroll 4
            for (int h = 0; h < 16; ++h) { const double xr = P.in[20][(size_t)i * 16 + h], xi = P.in[21][(size_t)i * 16 + h]; const float fre = (float)(qr * xr - qi * xi), fim = (float)(qr * xi + qi * xr); bbar[(size_t)i * 32 + 2 * h] = fre; bbar[(size_t)i * 32 + 2 * h + 1] = fim;
                bbt[((size_t)i * 2) * 16 + h] = (bf16)f2bf(fre); bbt[((size_t)i * 2 + 1) * 16 + h] = (bf16)f2bf(fim); } }
    }
    SEAM();
    if (RUN) { PTRS()
        if (G < 128 || (int)blockIdx.x >= G - 64) { pg8::Gemm g{memb, WT + WT_WKV, 1024, 4096, 1024}; pg8::StaticOrder S;
            if (G < 128) S.init(1024, 4096, G, (int)blockIdx.x); else S.init(1024, 4096, 64, (int)blockIdx.x - (G - 64)); EpiKV E{out, memk};
          pg8::gemm_phase<EpiKV, pg8::StaticOrder, true, true>(lds, g, S, E, wave_s); }
        { pg8::Gemm g{xb, WT + WT_INEVEN, MROWS, 1280, 1024}; pg8::StaticOrderF S; S.init(MROWS, 1280, G, (int)blockIdx.x); EpiIn0 E{proj0, PARTBUF(0), ropec, ropes, out};
          pg8::gemm_phase<EpiIn0, pg8::StaticOrderF, true, true>(lds, g, S, E, wave_s); }
        {
            FRESH()
            const int bx = (int)blockIdx.x, n2 = 325 - G;
            int slot = -1, nw = 1;
            if (G == 256) { if (bx >= n2 && bx < G - 64) { slot = (bx - n2) * 8 + wave; nw = (G - 64 - n2) * 8; } } else { slot = gw; nw = NGW; }
            if (slot >= 0) for (int it = slot; it < 2816 + 1408; it += nw) { int r = it;
                TR(P.in[33] + (size_t)1024 * 5632, 1024, 5632, WT + WT_UP + (size_t)5632 * 1024, P.in[13] + 1024, 1.f, 2)
                tr_item(P.in[35] + (size_t)2816 * 1024, 2816, 1024, WT + WT_DOWN + (size_t)2816 * 1024, nullptr, 1.f, 0, wscr, r, lane); }
        }
    }
    SEAM();
    if (RUN) { PTRS() FRESH()
        swa_phase(proj0, ckb, cvb, P.in[26], ycat, lds, tid, wave, lane, G);
        s5_local(proj0, abar, bbt, sloc, wscr, wave * G + (int)blockIdx.x, NGW, lane);
        for (int it = wave * G + (int)blockIdx.x; it < 1024; it += NGW) { const int mi = it >> 7, l = mi >> 2, b = mi & 3;
            tr_item(out + OFF_MVP + (size_t)mi * 262144, 256, 1024, memvT + (size_t)(l * 12 + b) * 262144, nullptr, 1.f, 0, wscr, it & 127, lane); }
    }
    SEAM();
    if (RUN) { PTRS() FRESH() s5_out(proj0, abar, bbt, sloc, P.in[5], P.in[6], P.in[22], P.in[23], P.in[24], gbuf, out, (LAS float*)(lds + wave * 16384), (LAS unsigned*)(lds + wave * 16384 + 8448), wave * G + (int)blockIdx.x, NGW, lane); }
    SEAM();
    if (RUN) { PTRS() pg8::Gemm g{gbuf, WT + WT_GLU, MROWS, 512, 512}; pg8::StaticOrder S; S.init(MROWS, 512, G, (int)blockIdx.x); EpiGlu E{gbuf, ycat};
        pg8::gemm_phase<EpiGlu, pg8::StaticOrder, true, true>(lds, g, S, E, wave_s);
        {
            FRESH()
            const int bx = (int)blockIdx.x; int slot = -1, nw = 1;
            if (G > 130) { if (bx >= 130) { slot = (bx - 130) * 8 + wave; nw = (G - 130) * 8; } } else { slot = gw; nw = NGW; }
            if (slot >= 0) for (int it = slot; it < 1536 + 512; it += nw) { int r = it;
                TR(P.in[27], 1024, 3072, WT + WT_INODD, P.in[11] + 1024, 1.f, 3)
                tr_item(P.in[29], 1024, 1024, WT + WT_OUTODD, nullptr, 1.f, 0, wscr, r, lane); }
        } }
    SEAM();

#pragma unroll
    for (int l = 0; l < 2; ++l) {
        if (l == 1) {
            if (RUN) { PTRS() pg8::Gemm g{xb, WT + WT_INODD, MP, 3072, 1024}; pg8::StaticOrderF S; S.init(MP, 3072, G, (int)blockIdx.x); EpiInOdd E{gbm, zc, PARTBUF(3), P.in[28], SG};
                pg8::gemm_phase<EpiInOdd, pg8::StaticOrderF, true, true>(lds, g, S, E, wave_s);
                { FRESH() sample_gemm<1>(xb, WT + WT_INODD, 1024, lds, tid, wave, lane, nullptr, nullptr, nullptr, PARTBUF(3), gbm);
                  sample_cz(xb, WT + WT_INODD, lds, tid, wave, lane, PARTBUF(3), P.in[28], P.in[7], zc, out); } }
            SEAM();
            if (RUN) { PTRS() FRESH()
                const float* cw = P.in[28]; const float* st = P.in[7];
                for (int i = gt; i < MROWS * 128; i += NT) { const int row = i >> 7, c0 = (i & 127) * 8, blk = row >> 6, r = row & 63;
                    const bool smp = row >= MP; const int rr = smp ? (r & 31) : r;
                    f32x4 z0, z1;
                    if (rr < 2 && !smp) { const int sb = 0;
                        f32x4 pa0, pa1, pb0, pb1;
                        if (smp) { const int b = (blk - 256) * 2 + (r >> 5); const float* s0 = st + (size_t)(b * 2) * 1024 + c0; pa0 = *(const f32x4*)s0; pa1 = *(const f32x4*)(s0 + 4); pb0 = *(const f32x4*)(s0 + 1024); pb1 = *(const f32x4*)(s0 + 1028); }
                        else if ((blk & 63) == 0) { pa0 = pa1 = pb0 = pb1 = (f32x4){0.f, 0.f, 0.f, 0.f}; }
                        else { const float* s0 = SG + (size_t)((blk - 1) * 8 + 6) * 1024 + c0; pa0 = *(const f32x4*)s0; pa1 = *(const f32x4*)(s0 + 4); pb0 = *(const f32x4*)(s0 + 1024); pb1 = *(const f32x4*)(s0 + 1028); }
                        const float* sc = SG + (size_t)(blk * 8 + sb) * 1024 + c0; const f32x4 x00 = *(const f32x4*)sc, x01 = *(const f32x4*)(sc + 4);
                        f32x4 xm2a, xm2b, xm1a, xm1b, xca, xcb;
                        if (rr == 0) { xm2a = pa0; xm2b = pa1; xm1a = pb0; xm1b = pb1; xca = x00; xcb = x01; }
                        else { xm2a = pb0; xm2b = pb1; xm1a = x00; xm1b = x01; xca = *(const f32x4*)(sc + 1024); xcb = *(const f32x4*)(sc + 1028); }
                        const f32x4 w0a = *(const f32x4*)(cw + c0), w0b = *(const f32x4*)(cw + c0 + 4), w1a = *(const f32x4*)(cw + 1024 + c0), w1b = *(const f32x4*)(cw + 1028 + c0), w2a = *(const f32x4*)(cw + 2048 + c0), w2b = *(const f32x4*)(cw + 2052 + c0);
                        z0 = w0a * xm2a + w1a * xm1a + w2a * xca; z1 = w0b * xm2b + w1b * xm1b + w2b * xcb; }
                    else { const v4u zw = *(const v4u*)(zc + (size_t)row * 1024 + c0); z0 = (f32x4){bflo(zw.x), bfhi(zw.x), bflo(zw.y), bfhi(zw.y)}; z1 = (f32x4){bflo(zw.z), bfhi(zw.z), bflo(zw.w), bfhi(zw.w)}; }
                    const v4u gw_ = *(const v4u*)(gbm + (size_t)row * 1024 + c0);
                    const f32x4 g0 = (f32x4){bflo(gw_.x), bfhi(gw_.x), bflo(gw_.y), bfhi(gw_.y)}, g1 = (f32x4){bflo(gw_.z), bfhi(gw_.z), bflo(gw_.w), bfhi(gw_.w)};
                    *(v4u*)(gbm + (size_t)row * 1024 + c0) = pack8(g0 * z0, g1 * z1); }
                for (int i = gt; i < 4 * 2 * 1024; i += NT) { const int c = i & 1023, j = (i >> 10) & 1, b = i >> 11; out[OFF_CMP + i] = SG[(size_t)((64 * b + 63) * 8 + 6 + j) * 1024 + c]; }
            }
            SEAM();
        }
        if (RUN) { PTRS() pg8::Gemm g{(bf16*)(tmp + (size_t)(1 - l) * TMP_YCAT), WT + WT_OUTEVEN + (size_t)l * (WT_OUTODD - WT_OUTEVEN), MP, 1024, 1024}; pg8::StaticOrderF S; S.init(MP, 1024, G, (int)blockIdx.x);
            EpiRes E{P.in[0], P.in[1] - (size_t)MP * 1024, xb, PARTBUF(1 + 3 * l), l == 0 ? 1 : 0};
            pg8::gemm_phase<EpiRes, pg8::StaticOrderF, true, true>(lds, g, S, E, wave_s);
            { FRESH() sample_gemm<0>((bf16*)(tmp + (size_t)(1 - l) * TMP_YCAT), WT + WT_OUTEVEN + (size_t)l * (WT_OUTODD - WT_OUTEVEN), 1024, lds, tid, wave, lane, xb, l == 0 ? P.in[1] - (size_t)MP * 1024 : (const float*)nullptr, PARTBUF(1 + 3 * l), nullptr, nullptr); } }
        SEAM();
        if (RUN) { PTRS() pg8::Gemm g{xb, WT + WT_WQ + (size_t)l * 1048576, MP, 1024, 1024}; pg8::StaticOrderF S; S.init(MP, 1024, G, (int)blockIdx.x); EpiBf16 E{qx, 1024, PARTBUF(1 + 3 * l)};
            pg8::gemm_phase<EpiBf16, pg8::StaticOrderF, true, true>(lds, g, S, E, wave_s);
            { FRESH() sample_gemm<1>(xb, WT + WT_WQ + (size_t)l * 1048576, 1024, lds, tid, wave, lane, nullptr, nullptr, nullptr, PARTBUF(1 + 3 * l), qx); } }
        SEAM();
        if (RUN) { PTRS() FRESH() xattn_phase2(qx, memk + (size_t)l * 12 * 262144, memvT + (size_t)l * 12 * 262144, ox, lds, tid, wave, lane, G); }
        SEAM();
        if (RUN) { PTRS() pg8::Gemm g{ox, WT + WT_WO + (size_t)l * 1048576, MP, 1024, 1024}; pg8::StaticOrderF S; S.init(MP, 1024, G, (int)blockIdx.x); EpiRes E{P.in[0], P.in[0], xb, PARTBUF(2 + 3 * l), 0};
            pg8::gemm_phase<EpiRes, pg8::StaticOrderF, true, true>(lds, g, S, E, wave_s);
            { FRESH() sample_gemm<0>(ox, WT + WT_WO + (size_t)l * 1048576, 1024, lds, tid, wave, lane, xb, nullptr, PARTBUF(2 + 3 * l), nullptr, nullptr); } }
        SEAM();
        if (RUN) { PTRS() pg8::Gemm g{xb, WT + WT_UP + (size_t)l * 5632 * 1024, MROWS, 5632, 1024}; pg8::StaticOrderF S; S.init(MROWS, 5632, G, (int)blockIdx.x);
            EpiFfnUp E{act, PARTBUF(2 + 3 * l), P.in[34] + (size_t)l * 3 * DFF, SG, SV};
            pg8::gemm_phase<EpiFfnUp, pg8::StaticOrderF, true, true>(lds, g, S, E, wave_s);
            if (l == 0) {
                FRESH()
                const int bx = (int)blockIdx.x, nb = 1430 % G; int slot = -1, nw = 1;
                if (nb > 0 && nb < G) { if (bx >= nb) { slot = (bx - nb) * 8 + wave; nw = (G - nb) * 8; } } else { slot = gw; nw = NGW; }
                if (slot >= 0) for (int it = slot; it < 512 + 512; it += nw) { int r = it;
                    TR(P.in[30] + 1048576, 1024, 1024, WT + WT_WQ + 1048576, P.in[12] + 1024, 0.0625f, 0)
                    tr_item(P.in[32] + 1048576, 1024, 1024, WT + WT_WO + 1048576, nullptr, 1.f, 0, wscr, r, lane); }
            } }
        SEAM();
        if (RUN) { PTRS() FRESH()
            const float* cw = P.in[34] + (size_t)l * 3 * DFF; const float* st = P.in[8] + (size_t)l * 8 * 2 * DFF;
            for (int i = gt; i < 528 * 352; i += NT) { const int fi = i / 352, c0 = (i % 352) * 8; int blk, row, rr, sb, vb; bool smp = fi >= 512;
                if (!smp) { blk = fi >> 1; rr = fi & 1; row = blk * 64 + rr; sb = 0; vb = 0; } else { const int s = fi - 512, half = (s >> 1) & 1; blk = 256 + (s >> 2); rr = s & 1; row = blk * 64 + half * 32 + rr; sb = half * 4; vb = half * 2; }
                f32x4 pa0, pa1, pb0, pb1;
                if (smp) { const int b = (blk - 256) * 2 + (sb >> 2); const float* s0 = st + (size_t)(b * 2) * DFF + c0; pa0 = *(const f32x4*)s0; pa1 = *(const f32x4*)(s0 + 4); pb0 = *(const f32x4*)(s0 + DFF); pb1 = *(const f32x4*)(s0 + DFF + 4); }
                else if ((blk & 63) == 0) { pa0 = pa1 = pb0 = pb1 = (f32x4){0.f, 0.f, 0.f, 0.f}; }
                else { const float* s0 = SG + (size_t)((blk - 1) * 8 + 6) * DFF + c0; pa0 = *(const f32x4*)s0; pa1 = *(const f32x4*)(s0 + 4); pb0 = *(const f32x4*)(s0 + DFF); pb1 = *(const f32x4*)(s0 + DFF + 4); }
                const float* sc = SG + (size_t)(blk * 8 + sb) * DFF + c0; const f32x4 x00 = *(const f32x4*)sc, x01 = *(const f32x4*)(sc + 4);
                f32x4 xm2a, xm2b, xm1a, xm1b, xca, xcb;
                if (rr == 0) { xm2a = pa0; xm2b = pa1; xm1a = pb0; xm1b = pb1; xca = x00; xcb = x01; }
                else { xm2a = pb0; xm2b = pb1; xm1a = x00; xm1b = x01; xca = *(const f32x4*)(sc + DFF); xcb = *(const f32x4*)(sc + DFF + 4); }
                const f32x4 w0a = *(const f32x4*)(cw + c0), w0b = *(const f32x4*)(cw + c0 + 4), w1a = *(const f32x4*)(cw + DFF + c0), w1b = *(const f32x4*)(cw + DFF + c0 + 4), w2a = *(const f32x4*)(cw + 2 * DFF + c0), w2b = *(const f32x4*)(cw + 2 * DFF + c0 + 4);
                const f32x4 ga = w0a * xm2a + w1a * xm1a + w2a * xca, gb_ = w0b * xm2b + w1b * xm1b + w2b * xcb;
                const float* sv = SV + (size_t)(blk * 4 + vb + rr) * DFF + c0; const f32x4 va = *(const f32x4*)sv, vb_ = *(const f32x4*)(sv + 4);
                f32x4 a0, a1;
#pragma unroll
                for (int j = 0; j < 4; ++j) { a0[j] = ga[j] * sigmoidf_(ga[j]) * va[j]; a1[j] = gb_[j] * sigmoidf_(gb_[j]) * vb_[j]; }
                *(v4u*)(act + (size_t)row * DFF + c0) = pack8(a0, a1); }
            for (int i = gt; i < 4 * 2 * DFF; i += NT) { const int c = i % DFF, j = (i / DFF) & 1, b = i / (2 * DFF); out[OFF_CFP + (size_t)l * 4 * 2 * DFF + i] = SG[(size_t)((64 * b + 63) * 8 + 6 + j) * DFF + c]; }
            for (int i = gt; i < 8 * 2 * DFF; i += NT) { const int c = i % DFF, j = (i / DFF) & 1, b = i / (2 * DFF); out[OFF_CFS + (size_t)l * 8 * 2 * DFF + i] = SG[(size_t)((256 + (b >> 1)) * 8 + (b & 1) * 4 + 2 + j) * DFF + c]; }
        }
        SEAM();
        if (RUN) { PTRS() pg8::Gemm g{act, WT + WT_DOWN + (size_t)l * 2816 * 1024, MP, 1024, DFF}; pg8::StaticOrderF S; S.init(MP, 1024, G, (int)blockIdx.x); EpiRes E{P.in[0], P.in[0], xb, PARTBUF(3 + 3 * l), 0};
            pg8::gemm_phase<EpiRes, pg8::StaticOrderF, true, true>(lds, g, S, E, wave_s);
            { FRESH() sample_gemm<0>(act, WT + WT_DOWN + (size_t)l * 2816 * 1024, DFF, lds, tid, wave, lane, xb, nullptr, PARTBUF(3 + 3 * l), nullptr, nullptr); } }
        SEAM();
    }
    if (RUN) { PTRS() FRESH()
        const float* gf = P.in[14];
        for (int m = gw; m < MROWS; m += NGW) { const float rs = rstd_of(PARTBUF(6), m); float* xr = out + (size_t)m * 1024; const bf16* xbr = xb + (size_t)m * 1024;
#pragma unroll
            for (int j = 0; j < 4; ++j) { const int c = (lane + 64 * j) * 4; const u32x2v w = *(const u32x2v*)(xbr + c); const f32x4 v = (f32x4){bflo(w.x), bfhi(w.x), bflo(w.y), bfhi(w.y)}, gg = *(const f32x4*)(gf + c); *(f32x4*)(xr + c) = v * rs * gg; } }
    }
}

extern "C" void kernel_launch(void* const* d_in, const int* in_sizes, int n_in, void* d_out, int out_size, void* d_ws, size_t ws_size, hipStream_t stream) {
    static int grid = 0;
    if (grid == 0) {
        int dev = 0, cus = 0, per_cu = 0;
        if (n_in != 36 || ws_size < 256 * MiB) { fprintf(stderr, "kernel_launch: unexpected n_in %d / ws %zu\n", n_in, ws_size); grid = -1; return; }
        (void)hipGetDevice(&dev); (void)hipDeviceGetAttribute(&cus, hipDeviceAttributeMultiprocessorCount, dev);
        if (hipFuncSetAttribute((const void*)mega_fwd, hipFuncAttributeMaxDynamicSharedMemorySize, LDS_BYTES) != hipSuccess) { fprintf(stderr, "kernel_launch: hipFuncSetAttribute failed\n"); grid = -1; return; }
        if (hipOccupancyMaxActiveBlocksPerMultiprocessor(&per_cu, (const void*)mega_fwd, 512, LDS_BYTES) != hipSuccess || per_cu < 1) per_cu = 1;
        (void)hipGetLastError();
        grid = cus * 1;
        if (grid > 256) grid = 256;
    }
    if (grid < 0) return;
    (void)hipMemsetAsync(d_ws, 0, CTL_ZERO_BYTES, stream);
    Params p{};
    for (int i = 0; i < 36; ++i) p.in[i] = (const float*)d_in[i];
    p.out = (float*)d_out; p.ws = (unsigned char*)d_ws; p.use_cg = 0; p.pad = 0;
    void* args[] = {&p};
    hipError_t e = hipLaunchCooperativeKernel((const void*)mega_fwd, dim3(grid), dim3(512), args, LDS_BYTES, stream);
    if (e != hipSuccess) fprintf(stderr, "cooperative launch failed: %s (grid %d)\n", hipGetErrorString(e), grid);
}
```

```cpp
#include <hip/hip_runtime.h>
#include <hip/hip_cooperative_groups.h>
#include <cstdio>
#include <cstdint>
namespace cg = cooperative_groups;
__device__ __forceinline__ int fresh_tid(int wave_s) { unsigned z = 0u; asm volatile("" : "+s"(z)); int t = wave_s * 64 + (int)__builtin_amdgcn_mbcnt_hi(~0u, __builtin_amdgcn_mbcnt_lo(~0u, z)); asm volatile("" : "+v"(t)); return t; }
namespace pg8 {
#define PG8_LAS __attribute__((address_space(3)))
typedef unsigned short bf16_t;
typedef short bf16x8 __attribute__((ext_vector_type(8)));
typedef float f32x4 __attribute__((ext_vector_type(4)));
typedef unsigned u32x4 __attribute__((ext_vector_type(4)));
constexpr int BM = 256, BK = 64, HALF = 128, HTB = HALF * BK * 2  , STAGE_BYTES = 8 * HTB, NXCD = 8, WGM = 8;

__host__ __device__ __forceinline__ int lds_byte(int r, int c) { const int st = (r >> 4) * 2 + (c >> 5), rr = r & 15, cc = c & 31, ob = rr * 64 + cc * 2; return st * 1024 + (ob ^ (((ob >> 9) & 1) << 5)); }
__host__ __device__ __forceinline__ void stage_rc(int b, int& R, int& C) { const int st = b / 1024, sb = b % 1024, swz = sb ^ (((sb >> 9) & 1) << 5); R = (st >> 1) * 16 + swz / 64; C = (st & 1) * 32 + (swz % 64) / 2; }
__host__ __device__ __forceinline__ int perm32(int rho) { const int n = rho >> 4, i = rho & 15; return 8 * (i >> 2) + 4 * n + (i & 3); }

struct Unit { int pm, pn; };
struct Gemm { const bf16_t* A; const bf16_t* Bt; int M, N, K; };

template <bool FULL> struct StaticOrderT {
    int nM, nN, nwg, G, c;
    __host__ __device__ void init(int M, int N, int G_, int c_) { nM = M / BM; nN = N / BM; nwg = nM * nN; G = G_; c = c_; }
    __host__ __device__ bool next(int i, Unit& u) const {
        const long L = (long)i * G + c; if (!(FULL && i == 0) && L >= nwg) return false;
        int wgid = (int)L; { const int q = nwg / NXCD, r = nwg % NXCD, xcd = wgid % NXCD, off = wgid / NXCD; wgid = (xcd < r ? xcd * (q + 1) : r * (q + 1) + (xcd - r) * q) + off; }
        const int nig = WGM * nN, gid = wgid / nig, fm = gid * WGM, gsz = (nM - fm) < WGM ? (nM - fm) : WGM;
        u.pm = fm + ((wgid % nig) % gsz); u.pn = (wgid % nig) / gsz; return true;
    }
    __device__ __forceinline__ void a_ready(const Unit&) const {}
    __device__ __forceinline__ void done(const Unit&) const {}
};

typedef StaticOrderT<false> StaticOrder; typedef StaticOrderT<true> StaticOrderF;
__device__ __forceinline__ unsigned cvt_pk_bf16(float lo, float hi) { unsigned r; asm volatile("v_cvt_pk_bf16_f32 %0, %1, %2" : "=v"(r) : "v"(lo), "v"(hi)); return r; }
typedef float f32x2 __attribute__((ext_vector_type(2)));
template <class Epi, class Sched, bool ALIGN_EPI = false, bool SP2 = false>
__device__ __forceinline__ void gemm_phase(PG8_LAS unsigned char* lds, const Gemm g, const Sched& S, const Epi& E, const int wave_s) {
    const int tid = fresh_tid(wave_s), wid = __builtin_amdgcn_readfirstlane(tid >> 6), lane = tid & 63, wr = wid >> 2, wc = wid & 3, fr = lane & 15, fq = lane >> 4;
    const int K = g.K, nt = K / BK;
    unsigned voffA[2], voffB[2];
#pragma unroll
    for (int i = 0; i < 2; ++i) { int R, C; stage_rc(tid * 16 + i * 8192, R, C); const int Rb = Epi::PERM ? ((R & ~31) + perm32(R & 31)) : R;
        voffA[i] = (unsigned)(R * K + C) * 2u; voffB[i] = (unsigned)(Rb * K + C) * 2u; }
    const size_t kstep = (size_t)(BK * 2);
    const size_t hstep = (size_t)HALF * K * 2;
    const size_t tstep = 2 * hstep;
    const unsigned ldsw = (unsigned)wid * 1024u;
    const int aoff = lds_byte(wr * 64 + fr, fq * 8), boff = lds_byte(wc * 32 + fr, fq * 8);
#define PG8_SA(b, h) (((b) * 2 + (h)) * HTB)
#define PG8_SB(b, h) ((4 + (b) * 2 + (h)) * HTB)
#define PG8_STAGE(bufoff, gbase, voff) do { _Pragma("unroll") for (int _i = 0; _i < 2; ++_i) \
        __builtin_amdgcn_global_load_lds((const unsigned*)((const char*)(gbase) + (voff)[_i]), (PG8_LAS unsigned*)(lds + (bufoff) + ldsw + _i * 8192), 16, 0, 0); } while (0)
#define PG8_LDA(dst, b, h) do { _Pragma("unroll") for (int m = 0; m < 4; ++m) _Pragma("unroll") for (int k = 0; k < 2; ++k) dst[m][k] = *(const PG8_LAS bf16x8*)(lds + PG8_SA(b, h) + aoff + m * 2048 + k * 1024); } while (0)
#define PG8_LDB(dst, b, h) do { _Pragma("unroll") for (int n = 0; n < 2; ++n) _Pragma("unroll") for (int k = 0; k < 2; ++k) dst[n][k] = *(const PG8_LAS bf16x8*)(lds + PG8_SB(b, h) + boff + n * 2048 + k * 1024); } while (0)
#define PG8_MMA(ai, bj, At, Bt) do { __builtin_amdgcn_s_setprio(1); _Pragma("unroll") for (int m = 0; m < 4; ++m) _Pragma("unroll") for (int n = 0; n < 2; ++n) _Pragma("unroll") for (int k = 0; k < 2; ++k) \
        acc[ai][bj][m][n] = __builtin_amdgcn_mfma_f32_16x16x32_bf16(Bt[n][k], At[m][k], acc[ai][bj][m][n], 0, 0, 0); __builtin_amdgcn_s_setprio(0); } while (0)
#define PG8_WAIT_V(n) asm volatile("s_waitcnt vmcnt(" #n ")" ::: "memory")
#define PG8_WAIT_L(n) asm volatile("s_waitcnt lgkmcnt(" #n ")" ::: "memory")
#define PG8_BAR __builtin_amdgcn_s_barrier()
#define PG8_SCHED __builtin_amdgcn_sched_barrier(0)
    Unit cur, nxt; int ui = 0;
    if (!S.next(0, cur)) return;
    f32x4 acc[2][2][4][2];
#pragma unroll
    for (int a = 0; a < 2; ++a)
#pragma unroll
        for (int b = 0; b < 2; ++b)
#pragma unroll
            for (int m = 0; m < 4; ++m)
#pragma unroll
                for (int n = 0; n < 2; ++n) acc[a][b][m][n] = (f32x4){0.f, 0.f, 0.f, 0.f};
    bf16x8 At[4][2], B0[2][2], B1[2][2];
    const char* cA = (const char*)g.A + (size_t)cur.pm * tstep; const char* cB = (const char*)g.Bt + (size_t)cur.pn * tstep;
    S.a_ready(cur);
    if constexpr (SP2) {
        PG8_STAGE(PG8_SB(0, 0), cB, voffB); PG8_STAGE(PG8_SB(0, 1), cB + hstep, voffB); PG8_STAGE(PG8_SA(0, 0), cA, voffA); PG8_STAGE(PG8_SA(0, 1), cA + hstep, voffA);
        if (wr == 1) PG8_BAR;
        PG8_WAIT_V(2); PG8_BAR;
        PG8_STAGE(PG8_SB(1, 0), cB + kstep, voffB); PG8_STAGE(PG8_SA(1, 0), cA + kstep, voffA); PG8_STAGE(PG8_SB(1, 1), cB + hstep + kstep, voffB);
        PG8_WAIT_V(6); PG8_BAR;
    } else {
        PG8_STAGE(PG8_SB(0, 0), cB, voffB); PG8_STAGE(PG8_SA(0, 0), cA, voffA); PG8_STAGE(PG8_SB(0, 1), cB + hstep, voffB); PG8_STAGE(PG8_SA(0, 1), cA + hstep, voffA);
        if (wr == 1) PG8_BAR;
        PG8_WAIT_V(4); PG8_BAR;
        PG8_STAGE(PG8_SB(1, 0), cB + kstep, voffB); PG8_STAGE(PG8_SA(1, 0), cA + kstep, voffA); PG8_STAGE(PG8_SB(1, 1), cB + hstep + kstep, voffB);
        PG8_WAIT_V(6); PG8_BAR;
    }
    for (;;) {
        const bool has_next = S.next(ui + 1, nxt);
        const char* nA = has_next ? (const char*)g.A + (size_t)nxt.pm * tstep : cA; const char* nB = has_next ? (const char*)g.Bt + (size_t)nxt.pn * tstep : cB;
        for (int t = 0; t < nt; t += 2) {
            const bool last = (t == nt - 2);
            const char* a1 = cA + (size_t)(t + 1) * kstep;
            const char* a2 = last ? nA : cA + (size_t)(t + 2) * kstep; const char* b2 = last ? nB : cB + (size_t)(t + 2) * kstep;
            const char* a3 = a2 + kstep; const char* b3 = b2 + kstep;
            if (last && has_next) S.a_ready(nxt);
            if constexpr (SP2) {
            PG8_LDB(B0, 0, 0); PG8_LDB(B1, 0, 1); PG8_SCHED; PG8_LDA(At, 0, 0); PG8_STAGE(PG8_SA(1, 1), a1 + hstep, voffA);
            PG8_WAIT_V(8); PG8_WAIT_L(0); PG8_BAR; PG8_MMA(0, 0, At, B0); PG8_MMA(0, 1, At, B1); PG8_BAR; PG8_SCHED;
            PG8_LDA(At, 0, 1); PG8_STAGE(PG8_SB(0, 0), b2, voffB); PG8_STAGE(PG8_SB(0, 1), b2 + hstep, voffB); PG8_STAGE(PG8_SA(0, 0), a2, voffA);
            PG8_WAIT_V(8); PG8_WAIT_L(0); PG8_BAR; PG8_MMA(1, 0, At, B0); PG8_MMA(1, 1, At, B1); PG8_BAR; PG8_SCHED;
            PG8_LDB(B0, 1, 0); PG8_LDB(B1, 1, 1); PG8_SCHED; PG8_LDA(At, 1, 0); PG8_STAGE(PG8_SA(0, 1), a2 + hstep, voffA);
            PG8_WAIT_V(8); PG8_WAIT_L(0); PG8_BAR; PG8_MMA(0, 0, At, B0); PG8_MMA(0, 1, At, B1); PG8_BAR; PG8_SCHED;
            PG8_LDA(At, 1, 1); PG8_STAGE(PG8_SB(1, 0), b3, voffB); PG8_STAGE(PG8_SB(1, 1), b3 + hstep, voffB); PG8_STAGE(PG8_SA(1, 0), a3, voffA);
            PG8_WAIT_V(8); PG8_WAIT_L(0); PG8_BAR; PG8_MMA(1, 0, At, B0); PG8_MMA(1, 1, At, B1); PG8_BAR; PG8_SCHED;
            } else {
            PG8_LDB(B0, 0, 0); PG8_SCHED; PG8_LDA(At, 0, 0); PG8_STAGE(PG8_SA(1, 1), a1 + hstep, voffA);
            PG8_WAIT_L(8); PG8_BAR; PG8_WAIT_L(0); PG8_MMA(0, 0, At, B0); PG8_BAR; PG8_SCHED;
            PG8_LDB(B1, 0, 1); PG8_STAGE(PG8_SB(0, 0), b2, voffB);
            PG8_BAR; PG8_WAIT_L(0); PG8_MMA(0, 1, At, B1); PG8_BAR;
            PG8_LDA(At, 0, 1); PG8_STAGE(PG8_SA(0, 0), a2, voffA);
            PG8_BAR; PG8_WAIT_L(0); PG8_MMA(1, 0, At, B0); PG8_BAR; PG8_SCHED;
            PG8_STAGE(PG8_SB(0, 1), b2 + hstep, voffB);
            PG8_WAIT_V(6); PG8_BAR; PG8_MMA(1, 1, At, B1); PG8_BAR;
            PG8_LDB(B0, 1, 0); PG8_SCHED; PG8_LDA(At, 1, 0); PG8_STAGE(PG8_SA(0, 1), a2 + hstep, voffA);
            PG8_WAIT_L(8); PG8_BAR; PG8_WAIT_L(0); PG8_MMA(0, 0, At, B0); PG8_BAR; PG8_SCHED;
            PG8_LDB(B1, 1, 1); PG8_STAGE(PG8_SB(1, 0), b3, voffB);
            PG8_BAR; PG8_WAIT_L(0); PG8_MMA(0, 1, At, B1); PG8_BAR;
            PG8_LDA(At, 1, 1); PG8_STAGE(PG8_SA(1, 0), a3, voffA);
            PG8_BAR; PG8_WAIT_L(0); PG8_MMA(1, 0, At, B0); PG8_BAR; PG8_SCHED;
            PG8_STAGE(PG8_SB(1, 1), b3 + hstep, voffB);
            PG8_WAIT_V(6); PG8_BAR; PG8_MMA(1, 1, At, B1); PG8_BAR;
            }
        }
        if constexpr (ALIGN_EPI) { if (wr == 0) PG8_BAR; }
        if constexpr (!Epi::AFTER_DRAIN) { E(acc, cur, wr, wc, fr, fq); S.done(cur); }
        if (!has_next) break;
#pragma unroll
        for (int a = 0; a < 2; ++a)
#pragma unroll
            for (int b = 0; b < 2; ++b)
#pragma unroll
                for (int m = 0; m < 4; ++m)
#pragma unroll
                    for (int n = 0; n < 2; ++n) acc[a][b][m][n] = (f32x4){0.f, 0.f, 0.f, 0.f};
        cur = nxt; cA = nA; cB = nB; ++ui;
        if constexpr (ALIGN_EPI) { if (wr == 1) PG8_BAR; }
    }
    PG8_WAIT_V(0);
    if constexpr (!ALIGN_EPI) { if (wr == 0) PG8_BAR; }
    PG8_BAR;
    if constexpr (Epi::AFTER_DRAIN) { E.fused(acc, cur, wr, wc, fr, fq, lds, wid, lane); S.done(cur); }
#undef PG8_SA
#undef PG8_SB
#undef PG8_STAGE
#undef PG8_LDA
#undef PG8_LDB
#undef PG8_MMA
#undef PG8_WAIT_V
#undef PG8_WAIT_L
#undef PG8_BAR
#undef PG8_SCHED
}
}
#define GAS __attribute__((address_space(1)))
#define LAS __attribute__((address_space(3)))
typedef unsigned short bf16;
typedef unsigned v4u __attribute__((ext_vector_type(4)));
typedef float f32x4 __attribute__((ext_vector_type(4)));
typedef short bf16x8 __attribute__((ext_vector_type(8)));
typedef GAS unsigned gu32;
typedef GAS unsigned long long gu64;
#define RLX_AGENT __ATOMIC_RELAXED, __HIP_MEMORY_SCOPE_AGENT
#define LDS_WAIT() asm volatile("s_waitcnt lgkmcnt(0)" ::: "memory")
#define VM_WAIT() asm volatile("s_waitcnt vmcnt(0)" ::: "memory")
__device__ __forceinline__ unsigned long long rt() { return __builtin_amdgcn_s_memrealtime(); }
__device__ __forceinline__ unsigned f2bf(float f) { unsigned u = __builtin_bit_cast(unsigned, f); return (u + 0x7fffu + ((u >> 16) & 1u)) >> 16; }
__device__ __forceinline__ unsigned pk2(float lo, float hi) { return f2bf(lo) | (f2bf(hi) << 16); }

#define XB_TMO      128
#define XB_XCNT(j)  (256  + 64 * (j))
#define XB_XSUB(j)  (1280 + 64 * (j))
#define XB_XGEN(j)  (2304 + 64 * (j))
#define XB_TOP      3328
#define XB_TOPGEN   3392
#define XCD_BAR_WORDS 3456
#define XB_SPIN_CAP (1u << 18)

__device__ __forceinline__ unsigned xb_ld(unsigned* p)              { return __hip_atomic_load(p, __ATOMIC_RELAXED, __HIP_MEMORY_SCOPE_AGENT); }
__device__ __forceinline__ unsigned xb_add(unsigned* p, unsigned v) { return __hip_atomic_fetch_add(p, v, __ATOMIC_RELAXED, __HIP_MEMORY_SCOPE_AGENT); }
__device__ __forceinline__ unsigned xb_xcc_id() { return (unsigned)__builtin_amdgcn_s_getreg((3 << 11) | 20) & 0xFu; }
#define XB_SPIN(cond, bar) do { unsigned _sp = 0; while (cond) { __builtin_amdgcn_s_sleep(1); \
    if ((++_sp & 255u) == 0u) { if (xb_ld(&(bar)[XB_TMO])) break; if (_sp > XB_SPIN_CAP) { atomicAdd(&(bar)[XB_TMO], 1u); break; } } } } while (0)

struct XcdBarrier {
    unsigned* bar; unsigned x;
    volatile LAS unsigned* st;
};

__device__ __forceinline__ XcdBarrier xcd_barrier_post(unsigned* bar, volatile LAS unsigned* st) {
    XcdBarrier b; b.bar = bar; b.x = xb_xcc_id(); b.st = st;
    if (threadIdx.x == 0) (void)xb_add(&bar[XB_XCNT(b.x)], 1u);
    return b;
}
__device__ __forceinline__ void xcd_barrier_complete(unsigned* bar, unsigned x, unsigned& nloc, unsigned& nx) {
    const unsigned G = gridDim.x * gridDim.y * gridDim.z;
    unsigned sum, cnt, mine, sp = 0u;
    for (;;) {
        sum = 0u; cnt = 0u; mine = 0u;
#pragma unroll
        for (unsigned j = 0; j < 16; ++j) { const unsigned c = xb_ld(&bar[XB_XCNT(j)]); sum += c; cnt += (c > 0u) ? 1u : 0u; mine = (j == x) ? c : mine; }
        if (sum == G) break;
        __builtin_amdgcn_s_sleep(1);
        if ((++sp & 255u) == 0u) { if (xb_ld(&bar[XB_TMO])) break; if (sp > XB_SPIN_CAP) { atomicAdd(&bar[XB_TMO], 1u); break; } }
    }
    nloc = mine > 0u ? mine : 1u; nx = cnt > 0u ? cnt : 1u;
}

__device__ __forceinline__ void xcd_barrier(const XcdBarrier& b) {
    asm volatile("s_waitcnt vmcnt(0)" ::: "memory");
    __syncthreads();
    if (threadIdx.x == 0) {
        unsigned* bar = b.bar;
        __builtin_amdgcn_s_waitcnt(0);
        unsigned nloc = b.st[0], nx = b.st[1];
        if (nloc == 0u) { xcd_barrier_complete(bar, b.x, nloc, nx); b.st[0] = nloc; b.st[1] = nx; }
        const unsigned old = xb_add(&bar[XB_XSUB(b.x)], 1u);
        const unsigned gen = old / nloc;
        if (old + 1u == (gen + 1u) * nloc) {
            __builtin_amdgcn_fence(__ATOMIC_RELEASE, "agent");
            asm volatile("s_waitcnt vmcnt(0)" ::: "memory");
            const unsigned og = xb_add(&bar[XB_TOP], 1u);
            const unsigned tg = og / nx;
            if (og + 1u == (tg + 1u) * nx) xb_add(&bar[XB_TOPGEN], 1u);
            else XB_SPIN(xb_ld(&bar[XB_TOPGEN]) == tg, bar);
            __builtin_amdgcn_fence(__ATOMIC_ACQUIRE, "agent");
            xb_add(&bar[XB_XGEN(b.x)], 1u);
            asm volatile("s_waitcnt vmcnt(0)" ::: "memory");
        } else {
            XB_SPIN(xb_ld(&bar[XB_XGEN(b.x)]) == gen, bar);
            __builtin_amdgcn_fence(__ATOMIC_ACQUIRE, "agent");
            asm volatile("s_waitcnt vmcnt(0)" ::: "memory");
        }
    }
    __syncthreads();
}
typedef unsigned u32x2v __attribute__((ext_vector_type(2)));
typedef float f32x2v __attribute__((ext_vector_type(2)));

constexpr int MP = 16384, MROWS = 16640, DMODEL = 1024, DFF = 2816, NBLK64 = MROWS / 64;
constexpr float RMS_EPS = 1e-6f;
constexpr size_t OFF_Y = 0, OFF_WKP = (size_t)MROWS * 1024, OFF_WVP = OFF_WKP + 65536, OFF_SRP = OFF_WVP + 65536, OFF_SIP = OFF_SRP + 8192,
    OFF_CMP = OFF_SIP + 8192, OFF_CFP = OFF_CMP + 8192, OFF_MKP = OFF_CFP + 45056, OFF_MVP = OFF_MKP + 2097152, OFF_WKS = OFF_MVP + 2097152,
    OFF_WVS = OFF_WKS + 32768, OFF_SRS = OFF_WVS + 32768, OFF_SIS = OFF_SRS + 16384, OFF_CMS = OFF_SIS + 16384, OFF_CFS = OFF_CMS + 16384;
constexpr size_t MiB = 1u << 20;
constexpr size_t WS_ROWSS = 0, WS_BAR = 512 * 1024, CTL_ZERO_BYTES = 1 * MiB;
constexpr size_t WS_ROPE = 1 * MiB, WS_SSM = 2 * MiB, WS_CKV = 3 * MiB, WS_SLOC = 4 * MiB, WS_MEMK = 8 * MiB, WS_MEMVT = 20 * MiB, WS_SIDE = 32 * MiB;
constexpr size_t SG_BYTES = (size_t)NBLK64 * 8 * DFF * 4, SV_BYTES = (size_t)NBLK64 * 4 * DFF * 4;
static_assert(WS_SIDE + SG_BYTES + SV_BYTES <= 66 * MiB, "side buffers");
constexpr size_t WS_WT = 66 * MiB, WS_XB = 128 * MiB, WS_TMP = 161 * MiB;
constexpr size_t WT_INEVEN = 0, WT_GLU = WT_INEVEN + 1280 * 1024, WT_OUTEVEN = WT_GLU + 512 * 512, WT_WQ = WT_OUTEVEN + 1024 * 1024, WT_WKV = WT_WQ + 2 * 1024 * 1024,
    WT_WO = WT_WKV + 2 * 2048 * 1024, WT_UP = WT_WO + 2 * 1024 * 1024, WT_DOWN = WT_UP + (size_t)2 * 5632 * 1024, WT_INODD = WT_DOWN + (size_t)2 * 2816 * 1024,
    WT_OUTODD = WT_INODD + 3072 * 1024, WT_END = WT_OUTODD + 1024 * 1024;
static_assert(WS_WT + WT_END * 2 <= WS_XB, "weights");
static_assert(WS_XB + (size_t)MROWS * 1024 * 2 <= WS_TMP, "xb");
constexpr size_t TMP_BYTES = (size_t)MROWS * DFF * 2;
constexpr size_t WS_PART = 251 * MiB, PART_ELEMS = (size_t)MROWS * 16;
static_assert(WS_PART + 2 * PART_ELEMS * 4 <= 256 * MiB, "part");
static_assert(WS_TMP + TMP_BYTES <= 256 * MiB, "ws");
constexpr size_t TMP_PROJ0 = 0, TMP_GBUF = (size_t)MROWS * 1280 * 2, TMP_YCAT = TMP_GBUF + (size_t)MROWS * 512 * 2, TMP_MEMB = TMP_YCAT;
static_assert(TMP_YCAT + (size_t)MROWS * 1024 * 2 <= TMP_BYTES, "tmp");
constexpr size_t TMP_QX = 0, TMP_OX = (size_t)MROWS * 1024 * 2, TMP_ACT = 0, TMP_GB = 0, TMP_ZC = (size_t)MROWS * 1024 * 2;
constexpr int LDS_BYTES = 147456, MISC_OFF = 147456 - 512;
constexpr int NPH = 22;

#define MFMA16(a, b, c) __builtin_amdgcn_mfma_f32_16x16x32_bf16(a, b, c, 0, 0, 0)
__device__ __forceinline__ float bflo(unsigned w) { return __uint_as_float(w << 16); }
__device__ __forceinline__ float bfhi(unsigned w) { return __uint_as_float(w & 0xffff0000u); }
__device__ __forceinline__ v4u pack8(f32x4 a, f32x4 b) { v4u w; w.x = pg8::cvt_pk_bf16(a[0], a[1]); w.y = pg8::cvt_pk_bf16(a[2], a[3]); w.z = pg8::cvt_pk_bf16(b[0], b[1]); w.w = pg8::cvt_pk_bf16(b[2], b[3]); return w; }
__device__ __forceinline__ float rstd_of(const float* part, int row) { const f32x4* p = (const f32x4*)(part + (size_t)row * 16); const f32x4 a = p[0] + p[1] + p[2] + p[3]; return rsqrtf(((a[0] + a[1]) + (a[2] + a[3])) * (1.0f / 1024.0f) + RMS_EPS); }
__device__ __forceinline__ float sigmoidf_(float x) { return 1.0f / (1.0f + __expf(-x)); }
__device__ __forceinline__ float dpp_ror1(float v) { return __builtin_bit_cast(float, __builtin_amdgcn_update_dpp(0, __builtin_bit_cast(int, v), 0x121, 0xf, 0xf, false)); }
__device__ __forceinline__ float dpp_ror2(float v) { return __builtin_bit_cast(float, __builtin_amdgcn_update_dpp(0, __builtin_bit_cast(int, v), 0x122, 0xf, 0xf, false)); }
__device__ __forceinline__ float wave_sum(float v) {
#pragma unroll
    for (int o = 1; o < 64; o <<= 1) v += __shfl_xor(v, o);
    return v;
}

typedef pg8::Unit Unit;
#define EPI_ARGS const f32x4 (&acc)[2][2][4][2], const Unit& u, int wr, int wc, int fr, int fq

struct EpiBf16 {
    static constexpr bool PERM = true, AFTER_DRAIN = false;
    bf16* O; int ldc; const float* rowss;
    __device__ __forceinline__ void operator()(EPI_ARGS) const {
        const int row0 = u.pm * 256 + wr * 64 + fr, col0 = u.pn * 256 + wc * 32 + 8 * fq;
#pragma unroll
        for (int ai = 0; ai < 2; ++ai)
#pragma unroll
            for (int m = 0; m < 4; ++m) { const int row = row0 + ai * 128 + m * 16; const float rs = rstd_of(rowss, row); bf16* rp = O + (size_t)row * ldc + col0;
#pragma unroll
                for (int bj = 0; bj < 2; ++bj) *(v4u*)(rp + bj * 128) = pack8(acc[ai][bj][m][0] * rs, acc[ai][bj][m][1] * rs); }
    }
};
struct EpiRes {
    static constexpr bool PERM = true, AFTER_DRAIN = false;
    const float* base_p; const float* base_s; bf16* xb; float* rowss_next; int f32base;
    __device__ __forceinline__ void operator()(EPI_ARGS) const {
        const float* base = u.pm < 64 ? base_p : base_s;
        const int row0 = u.pm * 256 + wr * 64 + fr, col0 = u.pn * 256 + wc * 32 + 8 * fq;
#pragma unroll
        for (int ai = 0; ai < 2; ++ai)
#pragma unroll
            for (int m = 0; m < 4; ++m) { const int row = row0 + ai * 128 + m * 16; const size_t off = (size_t)row * 1024 + col0; float ss = 0.f;
#pragma unroll
                for (int bj = 0; bj < 2; ++bj) { f32x4 b0, b1;
                    if (f32base) { b0 = *(const f32x4*)(base + off + bj * 128); b1 = *(const f32x4*)(base + off + bj * 128 + 4); }
                    else { const v4u w = *(const v4u*)(xb + off + bj * 128); b0 = (f32x4){bflo(w.x), bfhi(w.x), bflo(w.y), bfhi(w.y)}; b1 = (f32x4){bflo(w.z), bfhi(w.z), bflo(w.w), bfhi(w.w)}; }
                    const f32x4 v0 = acc[ai][bj][m][0] + b0, v1 = acc[ai][bj][m][1] + b1;
                    *(v4u*)(xb + off + bj * 128) = pack8(v0, v1);
                    ss += (v0[0] * v0[0] + v0[1] * v0[1]) + (v0[2] * v0[2] + v0[3] * v0[3]) + (v1[0] * v1[0] + v1[1] * v1[1]) + (v1[2] * v1[2] + v1[3] * v1[3]); }
                ss += __shfl_xor(ss, 16); ss += __shfl_xor(ss, 32);
                if (fq == 0) rowss_next[(size_t)row * 16 + u.pn * 4 + wc] = ss; }
    }
};
struct EpiGlu {
    static constexpr bool PERM = true, AFTER_DRAIN = false;
    const bf16* g; bf16* ycat;
    __device__ __forceinline__ void operator()(EPI_ARGS) const {
        const int row0 = u.pm * 256 + wr * 64 + fr, col0 = u.pn * 256 + wc * 32 + 8 * fq;
#pragma unroll
        for (int ai = 0; ai < 2; ++ai)
#pragma unroll
            for (int m = 0; m < 4; ++m) { const int row = row0 + ai * 128 + m * 16;
#pragma unroll
                for (int bj = 0; bj < 2; ++bj) { const int col = col0 + bj * 128; const v4u gw = *(const v4u*)(g + (size_t)row * 512 + col);
                    const f32x4 a0 = acc[ai][bj][m][0], a1 = acc[ai][bj][m][1]; f32x4 o0, o1;
                    o0[0] = bflo(gw.x) * sigmoidf_(a0[0]); o0[1] = bfhi(gw.x) * sigmoidf_(a0[1]); o0[2] = bflo(gw.y) * sigmoidf_(a0[2]); o0[3] = bfhi(gw.y) * sigmoidf_(a0[3]);
                    o1[0] = bflo(gw.z) * sigmoidf_(a1[0]); o1[1] = bfhi(gw.z) * sigmoidf_(a1[1]); o1[2] = bflo(gw.w) * sigmoidf_(a1[2]); o1[3] = bfhi(gw.w) * sigmoidf_(a1[3]);
                    *(v4u*)(ycat + (size_t)row * 1024 + col) = pack8(o0, o1); } }
    }
};
struct EpiKV {
    static constexpr bool PERM = true, AFTER_DRAIN = false;
    float* out; bf16* memk;
    __device__ __forceinline__ void operator()(EPI_ARGS) const {
        const int row0 = u.pm * 256 + wr * 64 + fr, col0 = u.pn * 256 + wc * 32 + 8 * fq;
#pragma unroll
        for (int ai = 0; ai < 2; ++ai)
#pragma unroll
            for (int m = 0; m < 4; ++m) { const int row = row0 + ai * 128 + m * 16;
#pragma unroll
                for (int bj = 0; bj < 2; ++bj) { const int c = col0 + bj * 128, l = c >> 11, e = c & 2047, isv = e >> 10, dc = e & 1023;
                    float* op = out + (isv ? OFF_MVP : OFF_MKP) + (size_t)l * 1048576 + (size_t)row * 1024 + dc;
                    *(f32x4*)op = acc[ai][bj][m][0]; *(f32x4*)(op + 4) = acc[ai][bj][m][1];
                    if (!isv) *(v4u*)(memk + (size_t)l * 12 * 262144 + (size_t)row * 1024 + dc) = pack8(acc[ai][bj][m][0], acc[ai][bj][m][1]); } }
    }
};
struct EpiIn0 {
    static constexpr bool PERM = true, AFTER_DRAIN = false;
    bf16* proj; const float* rowss; const float* ropec; const float* ropes; float* out;
    __device__ __forceinline__ void operator()(EPI_ARGS) const {
        const int pn = u.pn;
#pragma unroll
        for (int ai = 0; ai < 2; ++ai)
#pragma unroll
            for (int m = 0; m < 4; ++m) { const int row = u.pm * 256 + ai * 128 + wr * 64 + m * 16 + fr; const float rs = rstd_of(rowss, row);
                const int pos = row < MP ? (row & 4095) : 2048 + (row & 31);
                bf16* rp = proj + (size_t)row * 1280;
                float* wk = nullptr; float* wv = nullptr;
                if (pn == 4) { if (row >= MP) { wk = out + OFF_WKS + (size_t)(row - MP) * 128; wv = out + OFF_WVS + (size_t)(row - MP) * 128; }
                               else if ((row & 4095) >= 3968) { const size_t o = (size_t)((row >> 12) * 128 + (row & 4095) - 3968) * 128; wk = out + OFF_WKP + o; wv = out + OFF_WVP + o; } }
#pragma unroll
                for (int bj = 0; bj < 2; ++bj) { const f32x4 v0 = acc[ai][bj][m][0] * rs, v1 = acc[ai][bj][m][1] * rs;
                    const bool rope = (pn == 2 || pn == 3 || (pn == 4 && bj == 0));
                    if (!rope) { const int col = pn * 256 + bj * 128 + wc * 32 + 8 * fq; *(v4u*)(rp + col) = pack8(v0, v1);
                        if (pn == 4 && wv) { *(f32x4*)(wv + wc * 32 + 8 * fq) = v0; *(f32x4*)(wv + wc * 32 + 8 * fq + 4) = v1; } }
                    else { const int gbase = pn * 256 + bj * 128 + (wc >> 1) * 64, d1 = 16 * (wc & 1) + 4 * fq;
                        const f32x4 c4 = *(const f32x4*)(ropec + pos * 32 + d1), s4 = *(const f32x4*)(ropes + pos * 32 + d1);
                        f32x4 o1 = v0 * c4 - v1 * s4, o2 = v1 * c4 + v0 * s4;
                        if (pn != 4) { o1 = o1 * 0.125f; o2 = o2 * 0.125f; }
                        u32x2v w1, w2; w1.x = pg8::cvt_pk_bf16(o1[0], o1[1]); w1.y = pg8::cvt_pk_bf16(o1[2], o1[3]); w2.x = pg8::cvt_pk_bf16(o2[0], o2[1]); w2.y = pg8::cvt_pk_bf16(o2[2], o2[3]);
                        *(u32x2v*)(rp + gbase + d1) = w1; *(u32x2v*)(rp + gbase + d1 + 32) = w2;
                        if (pn == 4 && wk) { const int cc = (wc >> 1) * 64 + d1; *(f32x4*)(wk + cc) = o1; *(f32x4*)(wk + cc + 32) = o2; } } } }
    }
};
struct EpiFfnUp {
    static constexpr bool PERM = true, AFTER_DRAIN = false;
    bf16* act; const float* rowss; const float* cw; float* SG; float* SV;
    __device__ __forceinline__ void operator()(EPI_ARGS) const {
        const int c0 = u.pn * 128 + wc * 32 + 8 * fq; const bool sample = u.pm == 64;
        const f32x4 w0a = *(const f32x4*)(cw + c0), w0b = *(const f32x4*)(cw + c0 + 4), w1a = *(const f32x4*)(cw + DFF + c0), w1b = *(const f32x4*)(cw + DFF + c0 + 4),
                    w2a = *(const f32x4*)(cw + 2 * DFF + c0), w2b = *(const f32x4*)(cw + 2 * DFF + c0 + 4);
#pragma unroll
        for (int ai = 0; ai < 2; ++ai) { f32x4 gp0 = {0.f, 0.f, 0.f, 0.f}, gp1 = {0.f, 0.f, 0.f, 0.f}; const int blk = u.pm * 4 + ai * 2 + wr;
#pragma unroll
            for (int m = 0; m < 4; ++m) { const int row = u.pm * 256 + ai * 128 + wr * 64 + m * 16 + fr; const float rs = rstd_of(rowss, row);
                const f32x4 g0 = acc[ai][0][m][0] * rs, g1 = acc[ai][0][m][1] * rs, v0 = acc[ai][1][m][0] * rs, v1 = acc[ai][1][m][1] * rs;
                f32x4 p1a, p2a, p1b, p2b;
#pragma unroll
                for (int j = 0; j < 4; ++j) { const float s1a = fr == 15 ? gp0[j] : g0[j], s2a = fr >= 14 ? gp0[j] : g0[j], s1b = fr == 15 ? gp1[j] : g1[j], s2b = fr >= 14 ? gp1[j] : g1[j];
                    p1a[j] = dpp_ror1(s1a); p2a[j] = dpp_ror2(s2a); p1b[j] = dpp_ror1(s1b); p2b[j] = dpp_ror2(s2b); }
                const f32x4 ca = w0a * p2a + w1a * p1a + w2a * g0, cb = w0b * p2b + w1b * p1b + w2b * g1;
                f32x4 sa, sb;
#pragma unroll
                for (int j = 0; j < 4; ++j) { sa[j] = sigmoidf_(ca[j]); sb[j] = sigmoidf_(cb[j]); }
                const f32x4 a0 = ca * sa * v0, a1 = cb * sb * v1;
                const bool valid = (m > 0 || fr >= 2) && !(sample && m == 2 && fr < 2);
                if (valid) *(v4u*)(act + (size_t)row * DFF + c0) = pack8(a0, a1);
                if ((m & 1) == 0 && fr < 2) { float* sg = SG + (size_t)(blk * 8 + 2 * m + fr) * DFF + c0; *(f32x4*)sg = g0; *(f32x4*)(sg + 4) = g1;
                                              float* sv = SV + (size_t)(blk * 4 + m + fr) * DFF + c0; *(f32x4*)sv = v0; *(f32x4*)(sv + 4) = v1; }
                if ((m & 1) == 1 && fr >= 14) { float* sg = SG + (size_t)(blk * 8 + 2 * m + fr - 14) * DFF + c0; *(f32x4*)sg = g0; *(f32x4*)(sg + 4) = g1; }
                gp0 = g0; gp1 = g1; } }
    }
};
struct EpiInOdd {
    static constexpr bool PERM = true, AFTER_DRAIN = false;
    bf16* gb; bf16* zc; const float* rowss; const float* cw; float* SG;
    __device__ __forceinline__ void operator()(EPI_ARGS) const {
        if (u.pn < 4) {
            const int row0 = u.pm * 256 + wr * 64 + fr, col0 = u.pn * 256 + wc * 32 + 8 * fq;
#pragma unroll
            for (int ai = 0; ai < 2; ++ai)
#pragma unroll
                for (int m = 0; m < 4; ++m) { const int row = row0 + ai * 128 + m * 16; const float rs = rstd_of(rowss, row); bf16* rp = gb + (size_t)row * 1024 + col0;
#pragma unroll
                    for (int bj = 0; bj < 2; ++bj) *(v4u*)(rp + bj * 128) = pack8(acc[ai][bj][m][0] * rs, acc[ai][bj][m][1] * rs); }
            return;
        }
        const int c0 = (u.pn - 4) * 128 + wc * 32 + 8 * fq; const bool sample = u.pm == 64;
        const f32x4 w0a = *(const f32x4*)(cw + c0), w0b = *(const f32x4*)(cw + c0 + 4), w1a = *(const f32x4*)(cw + 1024 + c0), w1b = *(const f32x4*)(cw + 1024 + c0 + 4),
                    w2a = *(const f32x4*)(cw + 2048 + c0), w2b = *(const f32x4*)(cw + 2048 + c0 + 4);
#pragma unroll
        for (int ai = 0; ai < 2; ++ai) { f32x4 gp0 = {0.f, 0.f, 0.f, 0.f}, gp1 = {0.f, 0.f, 0.f, 0.f}; const int blk = u.pm * 4 + ai * 2 + wr;
#pragma unroll
            for (int m = 0; m < 4; ++m) { const int row = u.pm * 256 + ai * 128 + wr * 64 + m * 16 + fr; const float rs = rstd_of(rowss, row); const float rs2 = rs * rs;
                const f32x4 g0 = acc[ai][0][m][0] * acc[ai][1][m][0] * rs2, g1 = acc[ai][0][m][1] * acc[ai][1][m][1] * rs2;
                f32x4 p1a, p2a, p1b, p2b;
#pragma unroll
                for (int j = 0; j < 4; ++j) { const float s1a = fr == 15 ? gp0[j] : g0[j], s2a = fr >= 14 ? gp0[j] : g0[j], s1b = fr == 15 ? gp1[j] : g1[j], s2b = fr >= 14 ? gp1[j] : g1[j];
                    p1a[j] = dpp_ror1(s1a); p2a[j] = dpp_ror2(s2a); p1b[j] = dpp_ror1(s1b); p2b[j] = dpp_ror2(s2b); }
                const f32x4 a0 = w0a * p2a + w1a * p1a + w2a * g0, a1 = w0b * p2b + w1b * p1b + w2b * g1;
                const bool valid = (m > 0 || fr >= 2) && !(sample && m == 2 && fr < 2);
                if (valid) *(v4u*)(zc + (size_t)row * 1024 + c0) = pack8(a0, a1);
                if ((m & 1) == 0 && fr < 2) { float* sg = SG + (size_t)(blk * 8 + 2 * m + fr) * 1024 + c0; *(f32x4*)sg = g0; *(f32x4*)(sg + 4) = g1; }
                if ((m & 1) == 1 && fr >= 14) { float* sg = SG + (size_t)(blk * 8 + 2 * m + fr - 14) * 1024 + c0; *(f32x4*)sg = g0; *(f32x4*)(sg + 4) = g1; }
                gp0 = g0; gp1 = g1; } }
    }
};


struct EpiCz {
    static constexpr bool PERM = true, AFTER_DRAIN = false;
    bf16* gb; const float* rowss; const float* cw; float* SG;
    __device__ __forceinline__ void operator()(EPI_ARGS) const {
        const int c0 = u.pn * 128 + wc * 32 + 8 * fq;
        const f32x4 w0a = *(const f32x4*)(cw + c0), w0b = *(const f32x4*)(cw + c0 + 4), w1a = *(const f32x4*)(cw + 1024 + c0), w1b = *(const f32x4*)(cw + 1024 + c0 + 4),
                    w2a = *(const f32x4*)(cw + 2048 + c0), w2b = *(const f32x4*)(cw + 2048 + c0 + 4);
#pragma unroll
        for (int ai = 0; ai < 2; ++ai) { f32x4 gp0 = {0.f, 0.f, 0.f, 0.f}, gp1 = {0.f, 0.f, 0.f, 0.f}; const int blk = u.pm * 4 + ai * 2 + wr;
#pragma unroll
            for (int m = 0; m < 4; ++m) { const int row = u.pm * 256 + ai * 128 + wr * 64 + m * 16 + fr; const float rs = rstd_of(rowss, row); const float rs2 = rs * rs;
                const f32x4 g0 = acc[ai][0][m][0] * acc[ai][1][m][0] * rs2, g1 = acc[ai][0][m][1] * acc[ai][1][m][1] * rs2;
                f32x4 p1a, p2a, p1b, p2b;
#pragma unroll
                for (int j = 0; j < 4; ++j) { const float s1a = fr == 15 ? gp0[j] : g0[j], s2a = fr >= 14 ? gp0[j] : g0[j], s1b = fr == 15 ? gp1[j] : g1[j], s2b = fr >= 14 ? gp1[j] : g1[j];
                    p1a[j] = dpp_ror1(s1a); p2a[j] = dpp_ror2(s2a); p1b[j] = dpp_ror1(s1b); p2b[j] = dpp_ror2(s2b); }
                const f32x4 a0 = w0a * p2a + w1a * p1a + w2a * g0, a1 = w0b * p2b + w1b * p1b + w2b * g1;
                if (m > 0 || fr >= 2) { bf16* gp = gb + (size_t)row * 1024 + c0; const v4u gw = *(const v4u*)gp;
                    const f32x4 b0 = (f32x4){bflo(gw.x), bfhi(gw.x), bflo(gw.y), bfhi(gw.y)}, b1 = (f32x4){bflo(gw.z), bfhi(gw.z), bflo(gw.w), bfhi(gw.w)};
                    *(v4u*)gp = pack8(a0 * b0, a1 * b1); }
                if ((m & 1) == 0 && fr < 2) { float* sg = SG + (size_t)(blk * 8 + 2 * m + fr) * 1024 + c0; *(f32x4*)sg = g0; *(f32x4*)(sg + 4) = g1; }
                if ((m & 1) == 1 && fr >= 14) { float* sg = SG + (size_t)(blk * 8 + 2 * m + fr - 14) * 1024 + c0; *(f32x4*)sg = g0; *(f32x4*)(sg + 4) = g1; }
                gp0 = g0; gp1 = g1; } }
    }
};

__device__ __forceinline__ int rowmap(int mode, int n) {
    if (mode == 1) { if (n >= 512 && n < 1152) { const int d = n & 63; return (n & ~63) | (32 * ((d >> 4) & 1) + 8 * ((d >> 2) & 3) + 4 * (d >> 5) + (d & 3)); } return n; }
    if (mode == 2) { return n < DFF ? ((n >> 7) * 256 + (n & 127)) : (((n - DFF) >> 7) * 256 + 128 + ((n - DFF) & 127)); }
    if (mode == 3) { if (n < 1024) return n; const int c = (n - 1024) & 1023, z = n >= 2048 ? 1 : 0; return 1024 + (c >> 7) * 256 + z * 128 + (c & 127); }
    return n;
}
__device__ __forceinline__ void tr_item(const float* W, int K, int N, bf16* WT, const float* gain, float scale, int mode, LAS float* scr, int item, int lane) {
    const int nblk = N / 32, kb = item / nblk, nb = item % nblk, k0 = 64 * kb, n0 = 32 * nb;
#pragma unroll
    for (int i = 0; i < 8; ++i) { const int idx = lane + 64 * i, kk = idx >> 3, n4 = (idx & 7) * 4; const float gs = gain ? ((const GAS float*)gain)[k0 + kk] * scale : scale;
        const f32x4 w = *(const GAS f32x4*)((const GAS float*)W + (size_t)(k0 + kk) * N + n0 + n4); LAS float* d = scr + kk * 33 + n4; d[0] = w[0] * gs; d[1] = w[1] * gs; d[2] = w[2] * gs; d[3] = w[3] * gs; }
    LDS_WAIT(); asm volatile("" ::: "memory");
    const int c = lane & 7;
#pragma unroll
    for (int j = 0; j < 4; ++j) { const int n = (lane >> 3) + 8 * j; const LAS float* s = scr + (8 * c) * 33 + n;
        v4u o; o.x = pg8::cvt_pk_bf16(s[0 * 33], s[1 * 33]); o.y = pg8::cvt_pk_bf16(s[2 * 33], s[3 * 33]); o.z = pg8::cvt_pk_bf16(s[4 * 33], s[5 * 33]); o.w = pg8::cvt_pk_bf16(s[6 * 33], s[7 * 33]);
        *(GAS v4u*)((GAS bf16*)WT + (size_t)rowmap(mode, n0 + n) * K + k0 + 8 * c) = o; }
    LDS_WAIT(); asm volatile("" ::: "memory");
}
__device__ __forceinline__ double dexp_(double y) {
    const double k = rint(y * 1.4426950408889634); const double r = (y - k * 0.6931471803691238) - k * 1.9082149292705877e-10;
    double p = 1.0 / 6227020800.0;
    p = p * r + 1.0 / 479001600.0; p = p * r + 1.0 / 39916800.0; p = p * r + 1.0 / 3628800.0; p = p * r + 1.0 / 362880.0; p = p * r + 1.0 / 40320.0; p = p * r + 1.0 / 5040.0;
    p = p * r + 1.0 / 720.0; p = p * r + 1.0 / 120.0; p = p * r + 1.0 / 24.0; p = p * r + 1.0 / 6.0; p = p * r + 0.5; p = p * r + 1.0; p = p * r + 1.0;
    const long long bits = (long long)(1023 + (int)k) << 52; return p * __builtin_bit_cast(double, bits);
}
__device__ __forceinline__ void dsincos_(double x, double& s, double& c) {
    const double k = rint(x * 0.6366197723675814); const double r = (x - k * 1.5707963267948966) - k * 6.123233995736766e-17; const double r2 = r * r;
    const double sp = r * (1.0 + r2 * (-1.0 / 6.0 + r2 * (1.0 / 120.0 + r2 * (-1.0 / 5040.0 + r2 * (1.0 / 362880.0 + r2 * (-1.0 / 39916800.0 + r2 * (1.0 / 6227020800.0)))))));
    const double cp = 1.0 + r2 * (-0.5 + r2 * (1.0 / 24.0 + r2 * (-1.0 / 720.0 + r2 * (1.0 / 40320.0 + r2 * (-1.0 / 3628800.0 + r2 * (1.0 / 479001600.0 + r2 * (-1.0 / 87178291200.0)))))));
    const int q = ((int)k) & 3;
    s = q == 0 ? sp : q == 1 ? cp : q == 2 ? -sp : -cp; c = q == 0 ? cp : q == 1 ? -sp : q == 2 ? -cp : sp;
}

__device__ __forceinline__ const bf16* kvptr(const bf16* proj, const bf16* cb, int sample, int b, int c, int kvh, int kk, int isv) {
    if (!sample) { int pos = (c - 2) * 64 + kk; pos = pos < 0 ? 0 : pos; return proj + (size_t)(b * 4096 + pos) * 1280 + 1024 + isv * 128 + kvh * 64; }
    if (kk < 128) return cb + (size_t)(b * 128 + kk) * 128 + kvh * 64;
    int t = kk - 128; t = t > 31 ? 31 : t; return proj + (size_t)(MP + b * 32 + t) * 1280 + 1024 + isv * 128 + kvh * 64;
}
__device__ __forceinline__ void swa_phase(const bf16* proj, const bf16* ckb, const bf16* cvb, const float* sinks, bf16* ycat, LAS unsigned char* lds, int tid, int wave, int lane, int G) {
    LAS bf16* VT = (LAS bf16*)lds;
    const int fr = lane & 15, quad = lane >> 4;
    for (int it = blockIdx.x; it < 528; it += G) {
        int b, c, kvh, sample;
        if (it < 512) { sample = 0; b = it >> 7; c = (it >> 1) & 63; kvh = it & 1; } else { sample = 1; b = (it - 512) >> 1; c = 0; kvh = it & 1; }
        __syncthreads();
#pragma unroll
        for (int i = 0; i < 3; ++i) { const int idx = tid + 512 * i, kk = idx % 192, dg = idx / 192; const v4u w = *(const GAS v4u*)((const GAS bf16*)kvptr(proj, cvb, sample, b, c, kvh, kk, 1) + dg * 8);
            LAS bf16* vp = VT + (dg * 8) * 200 + kk;
            vp[0] = (bf16)(w.x & 0xffffu); vp[200] = (bf16)(w.x >> 16); vp[400] = (bf16)(w.y & 0xffffu); vp[600] = (bf16)(w.y >> 16);
            vp[800] = (bf16)(w.z & 0xffffu); vp[1000] = (bf16)(w.z >> 16); vp[1200] = (bf16)(w.w & 0xffffu); vp[1400] = (bf16)(w.w >> 16); }
        __syncthreads();
        const int gq = wave >> 1, qhalf = wave & 1, head = kvh * 4 + gq;
        if (!(sample && qhalf)) {
            const int plo = sample ? 0 : (c >= 2 ? 0 : (2 - c) * 2), phi = sample ? 5 : 6;
            bf16x8 qf[2][2];
#pragma unroll
            for (int qb = 0; qb < 2; ++qb) { const int q = qhalf * 32 + qb * 16 + fr; const int row = sample ? MP + b * 32 + (q & 31) : b * 4096 + c * 64 + q;
                const GAS bf16* qp = (const GAS bf16*)proj + (size_t)row * 1280 + 512 + head * 64 + quad * 8; qf[qb][0] = *(const GAS bf16x8*)qp; qf[qb][1] = *(const GAS bf16x8*)(qp + 32); }
            f32x4 s[12][2];
#pragma unroll
            for (int kg = 0; kg < 3; ++kg) { bf16x8 kf[4][2];
#pragma unroll
                for (int i = 0; i < 4; ++i) { const int kb = kg * 4 + i, key = 32 * (kb >> 1) + (fr >> 2) * 8 + 4 * (kb & 1) + (fr & 3); const GAS bf16* kp = (const GAS bf16*)kvptr(proj, ckb, sample, b, c, kvh, key, 0) + quad * 8;
                    kf[i][0] = *(const GAS bf16x8*)kp; kf[i][1] = *(const GAS bf16x8*)(kp + 32); }
                __builtin_amdgcn_sched_barrier(0);
#pragma unroll
                for (int i = 0; i < 4; ++i)
#pragma unroll
                    for (int qb = 0; qb < 2; ++qb) { f32x4 a = {0.f, 0.f, 0.f, 0.f}; a = MFMA16(kf[i][0], qf[qb][0], a); a = MFMA16(kf[i][1], qf[qb][1], a); s[kg * 4 + i][qb] = a; }
                __builtin_amdgcn_sched_barrier(0); }
            const float sink = sinks[head];
            bf16x8 pf[6][2];
#pragma unroll
            for (int qb = 0; qb < 2; ++qb) { float mx = sink;
#pragma unroll
                for (int kb = 0; kb < 12; ++kb) { const bool pv = (kb >> 1) >= plo && (kb >> 1) < phi;
#pragma unroll
                    for (int j = 0; j < 4; ++j) { const float v = pv ? s[kb][qb][j] : -1e30f; s[kb][qb][j] = v; mx = fmaxf(mx, v); } }
                mx = fmaxf(mx, __shfl_xor(mx, 16)); mx = fmaxf(mx, __shfl_xor(mx, 32));
                float sum = 0.f;
#pragma unroll
                for (int kb = 0; kb < 12; ++kb)
#pragma unroll
                    for (int j = 0; j < 4; ++j) { const float e = __expf(s[kb][qb][j] - mx); s[kb][qb][j] = e; sum += e; }
                sum += __shfl_xor(sum, 16); sum += __shfl_xor(sum, 32); sum += __expf(sink - mx);
                const float inv = 1.0f / sum;
#pragma unroll
                for (int pr = 0; pr < 6; ++pr) pf[pr][qb] = __builtin_bit_cast(bf16x8, pack8(s[2 * pr][qb] * inv, s[2 * pr + 1][qb] * inv)); }
#pragma unroll
            for (int db = 0; db < 4; ++db) { bf16x8 vf[6];
#pragma unroll
                for (int pr = 0; pr < 6; ++pr) vf[pr] = *(const LAS bf16x8*)(VT + (db * 16 + fr) * 200 + 32 * pr + quad * 8);
#pragma unroll
                for (int qb = 0; qb < 2; ++qb) { f32x4 o = {0.f, 0.f, 0.f, 0.f};
#pragma unroll
                    for (int pr = 0; pr < 6; ++pr) o = MFMA16(pf[pr][qb], vf[pr], o);
#pragma unroll
                    for (int j = 0; j < 4; ++j) { const int q = qhalf * 32 + qb * 16 + quad * 4 + j;
                        if (!sample || q < 32) { const int row = sample ? MP + b * 32 + q : b * 4096 + c * 64 + q; ycat[(size_t)row * 1024 + 512 + head * 64 + db * 16 + fr] = (bf16)f2bf(o[j]); } } } }
        }
    }
    __syncthreads();
}

__device__ __forceinline__ void xattn_phase(const bf16* qx, const bf16* memk_l, const bf16* memvT_l, bf16* ox, int wave, int lane, int G) {
    const int fr = lane & 15, quad = lane >> 4;
    for (int t = wave * G + (int)blockIdx.x; t < 4160; t += 8 * G) {
        int bb, h, row0;
        if (t < 4096) { const int pair = t >> 8; bb = pair >> 2; h = pair & 3; row0 = bb * 4096 + (t & 255) * 16; }
        else { const int s = t - 4096, b = s >> 3; h = (s >> 1) & 3; bb = 4 + b; row0 = MP + b * 32 + (s & 1) * 16; }
        bf16x8 qf[8];
#pragma unroll
        for (int ks = 0; ks < 8; ++ks) qf[ks] = *(const bf16x8*)(qx + (size_t)(row0 + fr) * 1024 + h * 256 + ks * 32 + quad * 8);
        const bf16* kbase = memk_l + (size_t)bb * 262144 + h * 256 + quad * 8;
        f32x4 s[16];
#pragma unroll
        for (int kb = 0; kb < 16; ++kb) { const int key = 32 * (kb >> 1) + (fr >> 2) * 8 + 4 * (kb & 1) + (fr & 3); const bf16* kp = kbase + (size_t)key * 1024; f32x4 a = {0.f, 0.f, 0.f, 0.f};
#pragma unroll
            for (int ks = 0; ks < 8; ++ks) a = MFMA16(*(const bf16x8*)(kp + ks * 32), qf[ks], a);
            s[kb] = a; }
        float mx = -1e30f;
#pragma unroll
        for (int kb = 0; kb < 16; ++kb)
#pragma unroll
            for (int j = 0; j < 4; ++j) mx = fmaxf(mx, s[kb][j]);
        mx = fmaxf(mx, __shfl_xor(mx, 16)); mx = fmaxf(mx, __shfl_xor(mx, 32));
        float sum = 0.f;
#pragma unroll
        for (int kb = 0; kb < 16; ++kb)
#pragma unroll
            for (int j = 0; j < 4; ++j) { const float e = __expf(s[kb][j] - mx); s[kb][j] = e; sum += e; }
        sum += __shfl_xor(sum, 16); sum += __shfl_xor(sum, 32);
        const float inv = 1.0f / sum;
        bf16x8 pf[8];
#pragma unroll
        for (int pr = 0; pr < 8; ++pr) pf[pr] = __builtin_bit_cast(bf16x8, pack8(s[2 * pr] * inv, s[2 * pr + 1] * inv));
        const bf16* vbase = memvT_l + (size_t)bb * 262144 + (size_t)(h * 256 + fr) * 256 + quad * 8;
#pragma unroll 4
        for (int db = 0; db < 16; ++db) { f32x4 o = {0.f, 0.f, 0.f, 0.f};
#pragma unroll
            for (int pr = 0; pr < 8; ++pr) o = MFMA16(pf[pr], *(const bf16x8*)(vbase + (size_t)db * 4096 + pr * 32), o);
#pragma unroll
            for (int j = 0; j < 4; ++j) ox[(size_t)(row0 + quad * 4 + j) * 1024 + h * 256 + db * 16 + fr] = (bf16)f2bf(o[j]); }
    }
}


__device__ __forceinline__ void xstage(const bf16* src, size_t rowstride, LAS unsigned char* lds, int tid) {
    v4u t[16];
#pragma unroll
    for (int i = 0; i < 16; ++i) { const int row = (tid >> 5) + 16 * i, ch = tid & 31; t[i] = *(const GAS v4u*)((const GAS bf16*)src + (size_t)row * rowstride + ch * 8); }
#pragma unroll
    for (int i = 0; i < 16; ++i) { const int row = (tid >> 5) + 16 * i, ch = tid & 31; *(LAS v4u*)(lds + row * 528 + ch * 16) = t[i]; }
}
__device__ __forceinline__ void xattn_phase2(const bf16* qx, const bf16* memk_l, const bf16* memvT_l, bf16* ox, LAS unsigned char* lds, int tid, int wave, int lane, int G) {
    const int fr = lane & 15, quad = lane >> 4;
    for (int it = blockIdx.x; it < 256 + 32; it += G) {
        int bb, h, rowbase, nqb; bool active;
        if (it < 256) { bb = it >> 6; h = (it >> 4) & 3; rowbase = bb * 4096 + (it & 15) * 256; nqb = 2; active = true; }
        else { const int s = it - 256, b = s >> 2; h = s & 3; bb = 4 + b; rowbase = MP + b * 32; nqb = 1; active = wave < 2; }
        __syncthreads();
        xstage(memk_l + (size_t)bb * 262144 + h * 256, 1024, lds, tid);
        __syncthreads();
        bf16x8 pf[2][8];
#pragma unroll
        for (int qi = 0; qi < 2; ++qi) {
            if (qi < nqb && active) {
                const int row0 = rowbase + qi * 128 + wave * 16;
                bf16x8 qf[8];
#pragma unroll
                for (int ks = 0; ks < 8; ++ks) qf[ks] = *(const GAS bf16x8*)((const GAS bf16*)qx + (size_t)(row0 + fr) * 1024 + h * 256 + ks * 32 + quad * 8);
                f32x4 s[16];
#pragma unroll
                for (int kb = 0; kb < 16; ++kb) { const int key = 32 * (kb >> 1) + (fr >> 2) * 8 + 4 * (kb & 1) + (fr & 3); const LAS unsigned char* kp = lds + key * 528 + quad * 16; f32x4 a = {0.f, 0.f, 0.f, 0.f};
#pragma unroll
                    for (int ks = 0; ks < 8; ++ks) a = MFMA16(*(const LAS bf16x8*)(kp + ks * 64), qf[ks], a);
                    s[kb] = a; }
                float mx = -1e30f;
#pragma unroll
                for (int kb = 0; kb < 16; ++kb)
#pragma unroll
                    for (int j = 0; j < 4; ++j) mx = fmaxf(mx, s[kb][j]);
                mx = fmaxf(mx, __shfl_xor(mx, 16)); mx = fmaxf(mx, __shfl_xor(mx, 32));
                float sum = 0.f;
#pragma unroll
                for (int kb = 0; kb < 16; ++kb)
#pragma unroll
                    for (int j = 0; j < 4; ++j) { const float e = __expf(s[kb][j] - mx); s[kb][j] = e; sum += e; }
                sum += __shfl_xor(sum, 16); sum += __shfl_xor(sum, 32);
                const float inv = 1.0f / sum;
#pragma unroll
                for (int pr = 0; pr < 8; ++pr) pf[qi][pr] = __builtin_bit_cast(bf16x8, pack8(s[2 * pr] * inv, s[2 * pr + 1] * inv));
            }
        }
        __syncthreads();
        xstage(memvT_l + (size_t)bb * 262144 + (size_t)h * 65536, 256, lds, tid);
        __syncthreads();
#pragma unroll
        for (int qi = 0; qi < 2; ++qi) {
            if (qi < nqb && active) {
                const int row0 = rowbase + qi * 128 + wave * 16;
#pragma unroll 4
                for (int db = 0; db < 16; ++db) { f32x4 o = {0.f, 0.f, 0.f, 0.f}; const LAS unsigned char* vp = lds + (db * 16 + fr) * 528 + quad * 16;
#pragma unroll
                    for (int pr = 0; pr < 8; ++pr) o = MFMA16(*(const LAS bf16x8*)(vp + pr * 64), pf[qi][pr], o);
                    u32x2v w; w.x = pk2(o[0], o[1]); w.y = pk2(o[2], o[3]);
                    *(GAS u32x2v*)((GAS bf16*)ox + (size_t)(row0 + fr) * 1024 + h * 256 + db * 16 + quad * 4) = w; }
            }
        }
    }
    __syncthreads();
}

__device__ __forceinline__ void s5_stage_u(const bf16* up, LAS float* ubuf, int lane) {
    const v4u w0 = *(const v4u*)up, w1 = *(const v4u*)(up + 8);
    LAS f32x4* d = (LAS f32x4*)(ubuf + lane * 16);
    d[0] = (f32x4){bflo(w0.x), bfhi(w0.x), bflo(w0.y), bfhi(w0.y)}; d[1] = (f32x4){bflo(w0.z), bfhi(w0.z), bflo(w0.w), bfhi(w0.w)};
    d[2] = (f32x4){bflo(w1.x), bfhi(w1.x), bflo(w1.y), bfhi(w1.y)}; d[3] = (f32x4){bflo(w1.z), bfhi(w1.z), bflo(w1.w), bfhi(w1.w)};
}
__device__ __forceinline__ f32x2v lo2_(f32x4 v) { return __builtin_shufflevector(v, v, 0, 1); }
__device__ __forceinline__ f32x2v hi2_(f32x4 v) { return __builtin_shufflevector(v, v, 2, 3); }
#define S5_STEP(sidx) do { const LAS f32x4* up_ = (const LAS f32x4*)(ubuf + (sidx) * 16); const f32x4 u0 = up_[0], u1 = up_[1], u2 = up_[2], u3 = up_[3]; \
    f32x2v ac_ = lo2_(bb[0]) * u0[0]; ac_ = hi2_(bb[0]) * u0[1] + ac_; ac_ = lo2_(bb[1]) * u0[2] + ac_; ac_ = hi2_(bb[1]) * u0[3] + ac_; \
    ac_ = lo2_(bb[2]) * u1[0] + ac_; ac_ = hi2_(bb[2]) * u1[1] + ac_; ac_ = lo2_(bb[3]) * u1[2] + ac_; ac_ = hi2_(bb[3]) * u1[3] + ac_; \
    ac_ = lo2_(bb[4]) * u2[0] + ac_; ac_ = hi2_(bb[4]) * u2[1] + ac_; ac_ = lo2_(bb[5]) * u2[2] + ac_; ac_ = hi2_(bb[5]) * u2[3] + ac_; \
    ac_ = lo2_(bb[6]) * u3[0] + ac_; ac_ = hi2_(bb[6]) * u3[1] + ac_; ac_ = lo2_(bb[7]) * u3[2] + ac_; ac_ = hi2_(bb[7]) * u3[3] + ac_; \
    const float nr_ = ar * hr - ai * hi + ac_.x, ni_ = ar * hi + ai * hr + ac_.y; hr = nr_; hi = ni_; } while (0)

typedef short bf16x4_t __attribute__((ext_vector_type(4)));
#define MFMA16K16(a, b, c) __builtin_amdgcn_mfma_f32_16x16x16bf16_1k(a, b, c, 0, 0, 0)
__device__ __forceinline__ void s5_bu_block(const bf16* urow0, const bf16x4_t (&bcf)[8], LAS float* bul, int fr, int quad) {
    const bf16x4_t a = *(const GAS bf16x4_t*)((const GAS bf16*)urow0 + (size_t)fr * 1280 + quad * 4);
#pragma unroll
    for (int cb = 0; cb < 8; ++cb) { f32x4 d = {0.f, 0.f, 0.f, 0.f}; d = MFMA16K16(a, bcf[cb], d);
#pragma unroll
        for (int j = 0; j < 4; ++j) bul[(quad * 4 + j) * 130 + cb * 16 + fr] = d[j]; }
}
__device__ __forceinline__ void s5_local(const bf16* proj, const float* abar, const bf16* bbt, float* sloc, LAS float* bul, int slot, int nslots, int lane) {
    const int fr = lane & 15, quad = lane >> 4;
    for (int t = slot; t < 8192; t += nslots) {
        const int chunk = t & 63, g = (t >> 6) & 31, b = t >> 11;
        const float ar = abar[(g * 64 + lane) * 2], ai = abar[(g * 64 + lane) * 2 + 1];
        bf16x4_t bcf[8];
#pragma unroll
        for (int cb = 0; cb < 8; ++cb) bcf[cb] = *(const GAS bf16x4_t*)((const GAS bf16*)bbt + (size_t)(g * 128 + cb * 16 + fr) * 16 + quad * 4);
        float hr = 0.f, hi = 0.f;
        for (int blk = 0; blk < 4; ++blk) {
            s5_bu_block(proj + (size_t)(b * 4096 + chunk * 64 + blk * 16) * 1280 + g * 16, bcf, bul, fr, quad);
#pragma unroll 4
            for (int s = 0; s < 16; ++s) { const f32x2v bu = *(const LAS f32x2v*)(bul + s * 130 + 2 * lane); const float nr = ar * hr - ai * hi + bu.x, ni = ar * hi + ai * hr + bu.y; hr = nr; hi = ni; }
        }
        *(f32x2v*)(sloc + (size_t)t * 128 + lane * 2) = (f32x2v){hr, hi};
    }
}
__device__ __forceinline__ void s5_out(const bf16* proj, const float* abar, const bf16* bbt, const float* sloc, const float* st_re, const float* st_im, const float* c_re, const float* c_im,
                                       const float* dcoef, bf16* gbuf, float* out, LAS float* bul, LAS unsigned* hbuf, int slot, int nslots, int lane) {
    const int fr = lane & 15, quad = lane >> 4;
    for (int t = slot; t < 8192 + 256; t += nslots) {
        const int sample = t >= 8192; int b, g, chunk, nblk, rowbase;
        if (!sample) { chunk = t & 63; g = (t >> 6) & 31; b = t >> 11; nblk = 4; rowbase = b * 4096 + chunk * 64; } else { const int s = t - 8192; g = s & 31; b = s >> 5; chunk = 0; nblk = 2; rowbase = MP + b * 32; }
        const float ar = abar[(g * 64 + lane) * 2], ai = abar[(g * 64 + lane) * 2 + 1];
        bf16x4_t bcf[8];
#pragma unroll
        for (int cb = 0; cb < 8; ++cb) bcf[cb] = *(const GAS bf16x4_t*)((const GAS bf16*)bbt + (size_t)(g * 128 + cb * 16 + fr) * 16 + quad * 4);
        float hr, hi;
        if (!sample) { float pr = ar, pi = ai;
#pragma unroll
            for (int i = 0; i < 6; ++i) { const float t1 = pr * pr - pi * pi; pi = 2.f * pr * pi; pr = t1; }
            hr = 0.f; hi = 0.f; const float* sp = sloc + (size_t)(t - chunk) * 128 + lane * 2;
#pragma unroll 16
            for (int cc = 0; cc < chunk; ++cc) { const f32x2v sv = *(const f32x2v*)(sp + (size_t)cc * 128); const float nr = pr * hr - pi * hi + sv.x, ni = pr * hi + pi * hr + sv.y; hr = nr; hi = ni; } }
        else { hr = st_re[(b * 32 + g) * 64 + lane]; hi = st_im[(b * 32 + g) * 64 + lane]; }
        bf16x8 cf[4];
#pragma unroll
        for (int ks = 0; ks < 4; ++ks) { const f32x4 cr = *(const f32x4*)(c_re + (size_t)(g * 16 + fr) * 64 + ks * 16 + quad * 4), ci = *(const f32x4*)(c_im + (size_t)(g * 16 + fr) * 64 + ks * 16 + quad * 4);
            v4u w; w.x = pg8::cvt_pk_bf16(cr[0], -ci[0]); w.y = pg8::cvt_pk_bf16(cr[1], -ci[1]); w.z = pg8::cvt_pk_bf16(cr[2], -ci[2]); w.w = pg8::cvt_pk_bf16(cr[3], -ci[3]); cf[ks] = __builtin_bit_cast(bf16x8, w); }
        const float dco = dcoef[g * 16 + fr];
        for (int blk = 0; blk < nblk; ++blk) {
            const bf16* urow0 = proj + (size_t)(rowbase + blk * 16) * 1280 + g * 16;
            s5_bu_block(urow0, bcf, bul, fr, quad);
#pragma unroll 4
            for (int s = 0; s < 16; ++s) { const f32x2v bu = *(const LAS f32x2v*)(bul + s * 130 + 2 * lane); const float nr = ar * hr - ai * hi + bu.x, ni = ar * hi + ai * hr + bu.y; hr = nr; hi = ni; hbuf[s * 68 + lane] = pg8::cvt_pk_bf16(hr, hi); }
            f32x4 y = {0.f, 0.f, 0.f, 0.f};
#pragma unroll
            for (int ks = 0; ks < 4; ++ks) { const bf16x8 a = *(const LAS bf16x8*)(hbuf + fr * 68 + ks * 16 + quad * 4); y = MFMA16(a, cf[ks], y); }
#pragma unroll
            for (int j = 0; j < 4; ++j) { const int s = blk * 16 + quad * 4 + j; const float uu = bflo((unsigned)((const GAS bf16*)urow0)[(size_t)(quad * 4 + j) * 1280 + fr]); const float yv = y[j] + dco * uu;
                const float z = 0.7978845608028654f * (yv + 0.044715f * yv * yv * yv); const float th = 1.0f - 2.0f / (1.0f + __expf(2.0f * z)); const float gl = 0.5f * yv * (1.0f + th);
                ((GAS bf16*)gbuf)[(size_t)(rowbase + s) * 512 + g * 16 + fr] = (bf16)f2bf(gl); }
        }
        if (!sample && chunk == 63) { out[OFF_SRP + (b * 32 + g) * 64 + lane] = hr; out[OFF_SIP + (b * 32 + g) * 64 + lane] = hi; }
        if (sample) { out[OFF_SRS + (b * 32 + g) * 64 + lane] = hr; out[OFF_SIS + (b * 32 + g) * 64 + lane] = hi; }
    }
}

template <int KIND>
__device__ __forceinline__ void sample_gemm(const bf16* A, const bf16* Bt, int K, LAS unsigned char* lds, int tid, int wave, int lane,
                                            bf16* xbp, const float* base_f32, float* part_next, const float* part_cur, bf16* O) {
    const int fr = lane & 15, quad = lane >> 4;
    LAS f32x4* red = (LAS f32x4*)lds;
    LAS float* ssred = (LAS float*)(lds + 32768);
    for (int tile = blockIdx.x; tile < 256; tile += gridDim.x) {
        const int r0 = MP + (tile >> 4) * 16, c0 = (tile & 15) * 64, kw = K >> 3;
        const bf16* ap = A + (size_t)(r0 + fr) * K + wave * kw + quad * 8;
        const bf16* bp = Bt + (size_t)(c0 + fr) * K + wave * kw + quad * 8;
        f32x4 acc[4];
#pragma unroll
        for (int cb = 0; cb < 4; ++cb) acc[cb] = (f32x4){0.f, 0.f, 0.f, 0.f};
        const int nks = kw >> 5;
        for (int k0 = 0; k0 < nks; k0 += 4) {
            bf16x8 a[4], b[4][4];
#pragma unroll
            for (int i = 0; i < 4; ++i) { const int ks = (k0 + i < nks) ? k0 + i : nks - 1;
                a[i] = *(const bf16x8*)(ap + ks * 32);
#pragma unroll
                for (int cb = 0; cb < 4; ++cb) b[i][cb] = *(const bf16x8*)(bp + (size_t)cb * 16 * K + ks * 32); }
            __builtin_amdgcn_sched_barrier(0);
#pragma unroll
            for (int i = 0; i < 4; ++i) if (k0 + i < nks) {
#pragma unroll
                for (int cb = 0; cb < 4; ++cb) acc[cb] = MFMA16(b[i][cb], a[i], acc[cb]); }
        }
#pragma unroll
        for (int cb = 0; cb < 4; ++cb) red[(wave * 4 + cb) * 64 + lane] = acc[cb] * 1.0f;
        __syncthreads();
        if (tid < 256) { const int cb = tid >> 6, l2 = tid & 63; f32x4 v = red[cb * 64 + l2];
#pragma unroll
            for (int w = 1; w < 8; ++w) v = v + red[(w * 4 + cb) * 64 + l2];
            const int row = r0 + (l2 & 15), col = c0 + cb * 16 + 4 * (l2 >> 4); const size_t off = (size_t)row * 1024 + col;
            if (KIND == 0) { f32x4 bs;
                if (base_f32) bs = *(const f32x4*)(base_f32 + off);
                else { const u32x2v w = *(const u32x2v*)(xbp + off); bs = (f32x4){bflo(w.x), bfhi(w.x), bflo(w.y), bfhi(w.y)}; }
                v = v + bs; u32x2v o; o.x = pk2(v[0], v[1]); o.y = pk2(v[2], v[3]); *(u32x2v*)(xbp + off) = o;
                float ss = (v[0] * v[0] + v[1] * v[1]) + (v[2] * v[2] + v[3] * v[3]); ss += __shfl_xor(ss, 16); ss += __shfl_xor(ss, 32);
                if ((l2 >> 4) == 0) ssred[cb * 16 + (l2 & 15)] = ss; }
            else { const float rs = rstd_of(part_cur, row); u32x2v o; o.x = pk2(v[0] * rs, v[1] * rs); o.y = pk2(v[2] * rs, v[3] * rs); *(u32x2v*)(O + off) = o; }
        }
        if (KIND == 0) { __syncthreads(); if (tid < 16) part_next[(size_t)(r0 + tid) * 16 + (tile & 15)] = (ssred[tid] + ssred[16 + tid]) + (ssred[32 + tid] + ssred[48 + tid]); }
        __syncthreads();
    }
}


__device__ __forceinline__ void sample_cz(const bf16* A, const bf16* Bt, LAS unsigned char* lds, int tid, int wave, int lane,
                                          const float* part_cur, const float* cw, const float* st, bf16* zcp, float* outp) {
    const int fr = lane & 15, quad = lane >> 4;
    LAS f32x4* red = (LAS f32x4*)lds;
    LAS float* T = (LAS float*)(lds + 65536);
    LAS float* CZ = (LAS float*)(lds + 65536 + 8192);
    for (int tile = blockIdx.x; tile < 256; tile += gridDim.x) {
        const int b = tile >> 5, c0 = (tile & 31) * 32, r0 = MP + b * 32;
        const int wrow = 1024 + (c0 >> 7) * 256 + (c0 & 127);
        const GAS bf16* ap = (const GAS bf16*)A + (size_t)(r0 + fr) * 1024 + wave * 128 + quad * 8;
        const GAS bf16* bp = (const GAS bf16*)Bt + (size_t)(wrow + fr) * 1024 + wave * 128 + quad * 8;
        bf16x8 a[4][2], bw[4][4];
#pragma unroll
        for (int ks = 0; ks < 4; ++ks) {
#pragma unroll
            for (int rb = 0; rb < 2; ++rb) a[ks][rb] = *(const GAS bf16x8*)(ap + (size_t)rb * 16 * 1024 + ks * 32);
#pragma unroll
            for (int cb = 0; cb < 4; ++cb) bw[ks][cb] = *(const GAS bf16x8*)(bp + (size_t)((cb >> 1) * 128 + (cb & 1) * 16) * 1024 + ks * 32); }
        f32x4 acc[2][4];
#pragma unroll
        for (int rb = 0; rb < 2; ++rb)
#pragma unroll
            for (int cb = 0; cb < 4; ++cb) { f32x4 d = {0.f, 0.f, 0.f, 0.f};
#pragma unroll
                for (int ks = 0; ks < 4; ++ks) d = MFMA16(bw[ks][cb], a[ks][rb], d);
                acc[rb][cb] = d; }
#pragma unroll
        for (int rb = 0; rb < 2; ++rb)
#pragma unroll
            for (int cb = 0; cb < 4; ++cb) red[(wave * 8 + rb * 4 + cb) * 64 + lane] = acc[rb][cb];
        __syncthreads();
        {
            const int blk = tid >> 6, l2 = tid & 63, rb = blk >> 2, cb = blk & 3; f32x4 v = red[blk * 64 + l2];
#pragma unroll
            for (int w = 1; w < 8; ++w) v = v + red[(w * 8 + blk) * 64 + l2];
            *(LAS f32x4*)(T + ((cb >> 1) * 32 + rb * 16 + (l2 & 15)) * 32 + (cb & 1) * 16 + 4 * (l2 >> 4)) = v; }
        __syncthreads();
        const int r = tid >> 3, cq = (tid & 7) * 4;
        if (tid < 256) { const float rs = rstd_of(part_cur, r0 + r); const float rs2 = rs * rs;
            const f32x4 gc = *(const LAS f32x4*)(T + r * 32 + cq), zz = *(const LAS f32x4*)(T + (32 + r) * 32 + cq);
            *(LAS f32x4*)(CZ + r * 32 + cq) = gc * zz * rs2; }
        __syncthreads();
        if (tid < 256) { const int c = c0 + cq;
            const f32x4 x0 = *(const LAS f32x4*)(CZ + r * 32 + cq);
            const f32x4 s0 = *(const f32x4*)(st + (size_t)(b * 2) * 1024 + c), s1 = *(const f32x4*)(st + (size_t)(b * 2 + 1) * 1024 + c);
            f32x4 xm1 = s1, xm2 = s0;
            if (r >= 1) { xm1 = *(const LAS f32x4*)(CZ + (r - 1) * 32 + cq); xm2 = s1; }
            if (r >= 2) xm2 = *(const LAS f32x4*)(CZ + (r - 2) * 32 + cq);
            const f32x4 w0 = *(const f32x4*)(cw + c), w1 = *(const f32x4*)(cw + 1024 + c), w2 = *(const f32x4*)(cw + 2048 + c);
            const f32x4 z = w0 * xm2 + w1 * xm1 + w2 * x0;
            bf16* gp = zcp + (size_t)(r0 + r) * 1024 + c; const u32x2v gw = *(const u32x2v*)gp;
            u32x2v o; o.x = pk2(z[0] * bflo(gw.x), z[1] * bfhi(gw.x)); o.y = pk2(z[2] * bflo(gw.y), z[3] * bfhi(gw.y)); *(u32x2v*)gp = o;
            if (r >= 30) *(f32x4*)(outp + OFF_CMS + (size_t)(b * 2 + (r - 30)) * 1024 + c) = x0; }
        __syncthreads();
    }
}

struct Params { const float* in[36]; float* out; unsigned char* ws; int use_cg, pad; };

__global__ void __launch_bounds__(512, 2) mega_fwd(Params P) {
    extern __shared__ __attribute__((aligned(16))) unsigned char lds_raw[];
    LAS unsigned char* lds = (LAS unsigned char*)lds_raw;
    volatile LAS unsigned* MISC = (volatile LAS unsigned*)(lds + MISC_OFF);
    const int G = gridDim.x, NGW = G * 8, NT = G * 512;
    const int wave_s = __builtin_amdgcn_readfirstlane(threadIdx.x >> 6);
    for (int u = threadIdx.x; u < (LDS_BYTES - 131072) / 4; u += 512) ((LAS unsigned*)(lds + 131072))[u] = 0u;
    __syncthreads();
    XcdBarrier bar = xcd_barrier_post((unsigned*)(P.ws + WS_BAR), MISC + 8);
#ifndef STOP_AFTER
#define STOP_AFTER 1000
#endif
    int ph = 0;
#define RUN (ph < STOP_AFTER)
#define FRESH() const int tid = fresh_tid(wave_s), lane = tid & 63, wave = __builtin_amdgcn_readfirstlane(tid >> 6); const int gw = blockIdx.x * 8 + wave, gt = blockIdx.x * 512 + tid; (void)gw; (void)gt; (void)lane; LAS float* wscr = (LAS float*)(lds + 32768 + wave * 12288); (void)wscr;
#define SEAM() do { if (P.use_cg) cg::this_grid().sync(); else xcd_barrier(bar); ++ph; } while (0)

#define part ((float*)(ws + WS_PART))
#define PARTBUF(k) (part + (size_t)((k) & 1) * PART_ELEMS)
#define ropec ((float*)(ws + WS_ROPE))
#define ropes (ropec + 4096 * 32)
#define abar ((float*)(ws + WS_SSM))
#define bbar (abar + 32 * 64 * 2)
#define bbt ((bf16*)(bbar + 32 * 64 * 32))
#define ckb ((bf16*)(ws + WS_CKV))
#define cvb (ckb + 8 * 128 * 128)
#define sloc ((float*)(ws + WS_SLOC))
#define memk ((bf16*)(ws + WS_MEMK))
#define memvT ((bf16*)(ws + WS_MEMVT))
#define SG ((float*)(ws + WS_SIDE))
#define SV ((float*)(ws + WS_SIDE + SG_BYTES))
#define WT ((bf16*)(ws + WS_WT))
#define xb ((bf16*)(ws + WS_XB))
#define tmp (ws + WS_TMP)
#define proj0 ((bf16*)(tmp + TMP_PROJ0))
#define gbuf ((bf16*)(tmp + TMP_GBUF))
#define ycat ((bf16*)(tmp + TMP_YCAT))
#define memb ((bf16*)(tmp + TMP_MEMB))
#define qx ((bf16*)(tmp + TMP_QX))
#define ox ((bf16*)(tmp + TMP_OX))
#define act ((bf16*)(tmp + TMP_ACT))
#define gbm ((bf16*)(tmp + TMP_GB))
#define zc ((bf16*)(tmp + TMP_ZC))
#define PTRS() unsigned char* ws = P.ws; float* out = P.out; asm volatile("" : "+s"(ws), "+s"(out));
    if (RUN) { PTRS() FRESH()
        {
            constexpr int NITEMS = 640 + 128 + 512 + 512 + 2 * 1024 + 512 + 2816 + 1408 + 2048;
            for (int it = gw; it < NITEMS; it += NGW) { int r = it;
#define TR(Wp, K_, N_, WTp, gainp, sc, mode) { const int ni_ = ((K_) / 64) * ((N_) / 32); if (r < ni_) { tr_item(Wp, K_, N_, WTp, gainp, sc, mode, wscr, r, lane); continue; } r -= ni_; }
                TR(P.in[15], 1024, 1280, WT + WT_INEVEN, P.in[11], 1.f, 1)
                TR(P.in[25], 512, 512, WT + WT_GLU, nullptr, 1.f, 0)
                TR(P.in[16], 1024, 1024, WT + WT_OUTEVEN, nullptr, 1.f, 0)
                TR(P.in[30], 1024, 1024, WT + WT_WQ, P.in[12], 0.0625f, 0)
                TR(P.in[31], 1024, 2048, WT + WT_WKV, nullptr, 1.f, 0)
                TR(P.in[31] + 2097152, 1024, 2048, WT + WT_WKV + 2097152, nullptr, 1.f, 0)
                TR(P.in[32], 1024, 1024, WT + WT_WO, nullptr, 1.f, 0)
                TR(P.in[33], 1024, 5632, WT + WT_UP, P.in[13], 1.f, 2)
                TR(P.in[35], 2816, 1024, WT + WT_DOWN, nullptr, 1.f, 0)
                { const int mi = r >> 7, l = mi >> 3, b = mi & 7; tr_item(P.in[10] + (size_t)mi * 262144, 256, 1024, memvT + (size_t)(l * 12 + 4 + b) * 262144, nullptr, 1.f, 0, wscr, r & 127, lane); }
            }
        }
        for (int m = gw; m < MROWS; m += NGW) { const float* xr = m < MP ? P.in[0] + (size_t)m * 1024 : P.in[1] + (size_t)(m - MP) * 1024; float ss = 0.f;
#pragma unroll
            for (int j = 0; j < 4; ++j) { const f32x4 v = *(const f32x4*)(xr + (lane + 64 * j) * 4); ss += (v[0] * v[0] + v[1] * v[1]) + (v[2] * v[2] + v[3] * v[3]);
                u32x2v w; w.x = pg8::cvt_pk_bf16(v[0], v[1]); w.y = pg8::cvt_pk_bf16(v[2], v[3]); *(u32x2v*)(xb + (size_t)m * 1024 + (lane + 64 * j) * 4) = w; }
            ss = wave_sum(ss); if (lane < 16) PARTBUF(0)[(size_t)m * 16 + lane] = lane == 0 ? ss : 0.f; }
        for (int i = gt; i < 262144; i += NT) { const f32x4 v = *(const f32x4*)(P.in[2] + (size_t)i * 4); u32x2v w; w.x = pg8::cvt_pk_bf16(v[0], v[1]); w.y = pg8::cvt_pk_bf16(v[2], v[3]); *(u32x2v*)(memb + (size_t)i * 4) = w; }
        for (int i = gt; i < 1048576; i += NT) { const size_t e = (size_t)i * 4; const int lb = (int)(e >> 18), l = lb >> 3, b = lb & 7; const f32x4 v = *(const f32x4*)(P.in[9] + e);
            u32x2v w; w.x = pg8::cvt_pk_bf16(v[0], v[1]); w.y = pg8::cvt_pk_bf16(v[2], v[3]); *(u32x2v*)(memk + (size_t)(l * 12 + 4 + b) * 262144 + (e & 262143)) = w; }
        for (int i = gt; i < 65536; i += NT) { const int j = i & 32767; const float* src = (i < 32768 ? P.in[3] : P.in[4]) + (size_t)j * 4; bf16* dst = (i < 32768 ? ckb : cvb) + (size_t)j * 4;
            const f32x4 v = *(const f32x4*)src; u32x2v w; w.x = pg8::cvt_pk_bf16(v[0], v[1]); w.y = pg8::cvt_pk_bf16(v[2], v[3]); *(u32x2v*)dst = w; }
        for (int i = gt; i < 4096 * 32; i += NT) { const int pos = i >> 5, d = i & 31; const double inv = dexp_(-(double)d * (9.210340371976184 / 32.0)); double s, c; dsincos_((double)pos * inv, s, c); ropec[i] = (float)c; ropes[i] = (float)s; }
        for (int i = gt; i < 2048; i += NT) { const double are = P.in[17][i], aim = P.in[18][i], dt = dexp_((double)P.in[19][i]); double s, c; dsincos_(aim * dt, s, c); const double mag = dexp_(are * dt);
            const double br = mag * c, bi = mag * s; abar[2 * i] = (float)br; abar[2 * i + 1] = (float)bi;
            const double nr = br - 1.0, ni = bi, den = are * are + aim * aim; const double qr = (nr * are + ni * aim) / den, qi = (ni * are - nr * aim) / den;
#pragma unroll 4
            for (int h = 0; h < 16; ++h) { const double xr = P.in[20][(size_t)i * 16 + h], xi = P.in[21][(size_t)i * 16 + h]; const float fre = (float)(qr * xr - qi * xi), fim = (float)(qr * xi + qi * xr); bbar[(size_t)i * 32 + 2 * h] = fre; bbar[(size_t)i * 32 + 2 * h + 1] = fim;
                bbt[((size_t)i * 2) * 16 + h] = (bf16)f2bf(fre); bbt[((size_t)i * 2 + 1) * 16 + h] = (bf16)f2bf(fim); } }
    }
    SEAM();
    if (RUN) { PTRS()
        if (G < 128 || (int)blockIdx.x >= G - 64) { pg8::Gemm g{memb, WT + WT_WKV, 1024, 4096, 1024}; pg8::StaticOrder S;
            if (G < 128) S.init(1024, 4096, G, (int)blockIdx.x); else S.init(1024, 4096, 64, (int)blockIdx.x - (G - 64)); EpiKV E{out, memk};
          pg8::gemm_phase<EpiKV, pg8::StaticOrder, true, true>(lds, g, S, E, wave_s); }
        { pg8::Gemm g{xb, WT + WT_INEVEN, MROWS, 1280, 1024}; pg8::StaticOrderF S; S.init(MROWS, 1280, G, (int)blockIdx.x); EpiIn0 E{proj0, PARTBUF(0), ropec, ropes, out};
          pg8::gemm_phase<EpiIn0, pg8::StaticOrderF, true, true>(lds, g, S, E, wave_s); }
        {
            FRESH()
            const int bx = (int)blockIdx.x, n2 = 325 - G;
            int slot = -1, nw = 1;
            if (G == 256) { if (bx >= n2 && bx < G - 64) { slot = (bx - n2) * 8 + wave; nw = (G - 64 - n2) * 8; } } else { slot = gw; nw = NGW; }
            if (slot >= 0) for (int it = slot; it < 2816 + 1408; it += nw) { int r = it;
                TR(P.in[33] + (size_t)1024 * 5632, 1024, 5632, WT + WT_UP + (size_t)5632 * 1024, P.in[13] + 1024, 1.f, 2)
                tr_item(P.in[35] + (size_t)2816 * 1024, 2816, 1024, WT + WT_DOWN + (size_t)2816 * 1024, nullptr, 1.f, 0, wscr, r, lane); }
        }
    }
    SEAM();
    if (RUN) { PTRS() FRESH()
        swa_phase(proj0, ckb, cvb, P.in[26], ycat, lds, tid, wave, lane, G);
        s5_local(proj0, abar, bbt, sloc, wscr, wave * G + (int)blockIdx.x, NGW, lane);
        for (int it = wave * G + (int)blockIdx.x; it < 1024; it += NGW) { const int mi = it >> 7, l = mi >> 2, b = mi & 3;
            tr_item(out + OFF_MVP + (size_t)mi * 262144, 256, 1024, memvT + (size_t)(l * 12 + b) * 262144, nullptr, 1.f, 0, wscr, it & 127, lane); }
    }
    SEAM();
    if (RUN) { PTRS() FRESH() s5_out(proj0, abar, bbt, sloc, P.in[5], P.in[6], P.in[22], P.in[23], P.in[24], gbuf, out, (LAS float*)(lds + wave * 16384), (LAS unsigned*)(lds + wave * 16384 + 8448), wave * G + (int)blockIdx.x, NGW, lane); }
    SEAM();
    if (RUN) { PTRS() pg8::Gemm g{gbuf, WT + WT_GLU, MROWS, 512, 512}; pg8::StaticOrder S; S.init(MROWS, 512, G, (int)blockIdx.x); EpiGlu E{gbuf, ycat};
        pg8::gemm_phase<EpiGlu, pg8::StaticOrder, true, true>(lds, g, S, E, wave_s);
        {
            FRESH()
            const int bx = (int)blockIdx.x; int slot = -1, nw = 1;
            if (G > 130) { if (bx >= 130) { slot = (bx - 130) * 8 + wave; nw = (G - 130) * 8; } } else { slot = gw; nw = NGW; }
            if (slot >= 0) for (int it = slot; it < 1536 + 512; it += nw) { int r = it;
                TR(P.in[27], 1024, 3072, WT + WT_INODD, P.in[11] + 1024, 1.f, 3)
                tr_item(P.in[29], 1024, 1024, WT + WT_OUTODD, nullptr, 1.f, 0, wscr, r, lane); }
        } }
    SEAM();

#pragma unroll
    for (int l = 0; l < 2; ++l) {
        if (l == 1) {
            if (RUN) { PTRS() pg8::Gemm g{xb, WT + WT_INODD, MP, 1024, 1024}; pg8::StaticOrderF S; S.init(MP, 1024, G, (int)blockIdx.x); EpiBf16 E{gbm, 1024, PARTBUF(3)};
                pg8::gemm_phase<EpiBf16, pg8::StaticOrderF, true, true>(lds, g, S, E, wave_s);
                { FRESH() sample_gemm<1>(xb, WT + WT_INODD, 1024, lds, tid, wave, lane, nullptr, nullptr, nullptr, PARTBUF(3), gbm); } }
            SEAM();
            if (RUN) { PTRS() pg8::Gemm g{xb, WT + WT_INODD + (size_t)1024 * 1024, MP, 2048, 1024}; pg8::StaticOrderF S; S.init(MP, 2048, G, (int)blockIdx.x); EpiCz E{gbm, PARTBUF(3), P.in[28], SG};
                pg8::gemm_phase<EpiCz, pg8::StaticOrderF, true, true>(lds, g, S, E, wave_s);
                { FRESH() sample_cz(xb, WT + WT_INODD, lds, tid, wave, lane, PARTBUF(3), P.in[28], P.in[7], gbm, out); } }
            SEAM();
            if (RUN) { PTRS() FRESH()
                const float* cw = P.in[28];
                for (int i = gt; i < 512 * 128; i += NT) { const int ri = i >> 7, c0 = (i & 127) * 8, blk = ri >> 1, rr = ri & 1, row = blk * 64 + rr;
                    f32x4 pa0, pa1, pb0, pb1;
                    if ((blk & 63) == 0) { pa0 = pa1 = pb0 = pb1 = (f32x4){0.f, 0.f, 0.f, 0.f}; }
                    else { const float* s0 = SG + (size_t)((blk - 1) * 8 + 6) * 1024 + c0; pa0 = *(const f32x4*)s0; pa1 = *(const f32x4*)(s0 + 4); pb0 = *(const f32x4*)(s0 + 1024); pb1 = *(const f32x4*)(s0 + 1028); }
                    const float* sc = SG + (size_t)(blk * 8) * 1024 + c0; const f32x4 x00 = *(const f32x4*)sc, x01 = *(const f32x4*)(sc + 4);
                    f32x4 xm2a, xm2b, xm1a, xm1b, xca, xcb;
                    if (rr == 0) { xm2a = pa0; xm2b = pa1; xm1a = pb0; xm1b = pb1; xca = x00; xcb = x01; }
                    else { xm2a = pb0; xm2b = pb1; xm1a = x00; xm1b = x01; xca = *(const f32x4*)(sc + 1024); xcb = *(const f32x4*)(sc + 1028); }
                    const f32x4 w0a = *(const f32x4*)(cw + c0), w0b = *(const f32x4*)(cw + c0 + 4), w1a = *(const f32x4*)(cw + 1024 + c0), w1b = *(const f32x4*)(cw + 1028 + c0), w2a = *(const f32x4*)(cw + 2048 + c0), w2b = *(const f32x4*)(cw + 2052 + c0);
                    const f32x4 z0 = w0a * xm2a + w1a * xm1a + w2a * xca, z1 = w0b * xm2b + w1b * xm1b + w2b * xcb;
                    const v4u gw_ = *(const v4u*)(gbm + (size_t)row * 1024 + c0);
                    const f32x4 g0 = (f32x4){bflo(gw_.x), bfhi(gw_.x), bflo(gw_.y), bfhi(gw_.y)}, g1 = (f32x4){bflo(gw_.z), bfhi(gw_.z), bflo(gw_.w), bfhi(gw_.w)};
                    *(v4u*)(gbm + (size_t)row * 1024 + c0) = pack8(g0 * z0, g1 * z1); }
                for (int i = gt; i < 4 * 2 * 1024; i += NT) { const int c = i & 1023, j = (i >> 10) & 1, b = i >> 11; out[OFF_CMP + i] = SG[(size_t)((64 * b + 63) * 8 + 6 + j) * 1024 + c]; }
            }
            SEAM();
        }
        if (RUN) { PTRS() pg8::Gemm g{(bf16*)(tmp + (size_t)(1 - l) * TMP_YCAT), WT + WT_OUTEVEN + (size_t)l * (WT_OUTODD - WT_OUTEVEN), MP, 1024, 1024}; pg8::StaticOrderF S; S.init(MP, 1024, G, (int)blockIdx.x);
            EpiRes E{P.in[0], P.in[1] - (size_t)MP * 1024, xb, PARTBUF(1 + 3 * l), l == 0 ? 1 : 0};
            pg8::gemm_phase<EpiRes, pg8::StaticOrderF, true, true>(lds, g, S, E, wave_s);
            { FRESH() sample_gemm<0>((bf16*)(tmp + (size_t)(1 - l) * TMP_YCAT), WT + WT_OUTEVEN + (size_t)l * (WT_OUTODD - WT_OUTEVEN), 1024, lds, tid, wave, lane, xb, l == 0 ? P.in[1] - (size_t)MP * 1024 : (const float*)nullptr, PARTBUF(1 + 3 * l), nullptr, nullptr); } }
        SEAM();
        if (RUN) { PTRS() pg8::Gemm g{xb, WT + WT_WQ + (size_t)l * 1048576, MP, 1024, 1024}; pg8::StaticOrderF S; S.init(MP, 1024, G, (int)blockIdx.x); EpiBf16 E{qx, 1024, PARTBUF(1 + 3 * l)};
            pg8::gemm_phase<EpiBf16, pg8::StaticOrderF, true, true>(lds, g, S, E, wave_s);
            { FRESH() sample_gemm<1>(xb, WT + WT_WQ + (size_t)l * 1048576, 1024, lds, tid, wave, lane, nullptr, nullptr, nullptr, PARTBUF(1 + 3 * l), qx); } }
        SEAM();
        if (RUN) { PTRS() FRESH() xattn_phase2(qx, memk + (size_t)l * 12 * 262144, memvT + (size_t)l * 12 * 262144, ox, lds, tid, wave, lane, G); }
        SEAM();
        if (RUN) { PTRS() pg8::Gemm g{ox, WT + WT_WO + (size_t)l * 1048576, MP, 1024, 1024}; pg8::StaticOrderF S; S.init(MP, 1024, G, (int)blockIdx.x); EpiRes E{P.in[0], P.in[0], xb, PARTBUF(2 + 3 * l), 0};
            pg8::gemm_phase<EpiRes, pg8::StaticOrderF, true, true>(lds, g, S, E, wave_s);
            { FRESH() sample_gemm<0>(ox, WT + WT_WO + (size_t)l * 1048576, 1024, lds, tid, wave, lane, xb, nullptr, PARTBUF(2 + 3 * l), nullptr, nullptr); } }
        SEAM();
        if (RUN) { PTRS() pg8::Gemm g{xb, WT + WT_UP + (size_t)l * 5632 * 1024, MROWS, 5632, 1024}; pg8::StaticOrderF S; S.init(MROWS, 5632, G, (int)blockIdx.x);
            EpiFfnUp E{act, PARTBUF(2 + 3 * l), P.in[34] + (size_t)l * 3 * DFF, SG, SV};
            pg8::gemm_phase<EpiFfnUp, pg8::StaticOrderF, true, true>(lds, g, S, E, wave_s);
            if (l == 0) {
                FRESH()
                const int bx = (int)blockIdx.x, nb = 1430 % G; int slot = -1, nw = 1;
                if (nb > 0 && nb < G) { if (bx >= nb) { slot = (bx - nb) * 8 + wave; nw = (G - nb) * 8; } } else { slot = gw; nw = NGW; }
                if (slot >= 0) for (int it = slot; it < 512 + 512; it += nw) { int r = it;
                    TR(P.in[30] + 1048576, 1024, 1024, WT + WT_WQ + 1048576, P.in[12] + 1024, 0.0625f, 0)
                    tr_item(P.in[32] + 1048576, 1024, 1024, WT + WT_WO + 1048576, nullptr, 1.f, 0, wscr, r, lane); }
            } }
        SEAM();
        if (RUN) { PTRS() FRESH()
            const float* cw = P.in[34] + (size_t)l * 3 * DFF; const float* st = P.in[8] + (size_t)l * 8 * 2 * DFF;
            for (int i = gt; i < 528 * 352; i += NT) { const int fi = i / 352, c0 = (i % 352) * 8; int blk, row, rr, sb, vb; bool smp = fi >= 512;
                if (!smp) { blk = fi >> 1; rr = fi & 1; row = blk * 64 + rr; sb = 0; vb = 0; } else { const int s = fi - 512, half = (s >> 1) & 1; blk = 256 + (s >> 2); rr = s & 1; row = blk * 64 + half * 32 + rr; sb = half * 4; vb = half * 2; }
                f32x4 pa0, pa1, pb0, pb1;
                if (smp) { const int b = (blk - 256) * 2 + (sb >> 2); const float* s0 = st + (size_t)(b * 2) * DFF + c0; pa0 = *(const f32x4*)s0; pa1 = *(const f32x4*)(s0 + 4); pb0 = *(const f32x4*)(s0 + DFF); pb1 = *(const f32x4*)(s0 + DFF + 4); }
                else if ((blk & 63) == 0) { pa0 = pa1 = pb0 = pb1 = (f32x4){0.f, 0.f, 0.f, 0.f}; }
                else { const float* s0 = SG + (size_t)((blk - 1) * 8 + 6) * DFF + c0; pa0 = *(const f32x4*)s0; pa1 = *(const f32x4*)(s0 + 4); pb0 = *(const f32x4*)(s0 + DFF); pb1 = *(const f32x4*)(s0 + DFF + 4); }
                const float* sc = SG + (size_t)(blk * 8 + sb) * DFF + c0; const f32x4 x00 = *(const f32x4*)sc, x01 = *(const f32x4*)(sc + 4);
                f32x4 xm2a, xm2b, xm1a, xm1b, xca, xcb;
                if (rr == 0) { xm2a = pa0; xm2b = pa1; xm1a = pb0; xm1b = pb1; xca = x00; xcb = x01; }
                else { xm2a = pb0; xm2b = pb1; xm1a = x00; xm1b = x01; xca = *(const f32x4*)(sc + DFF); xcb = *(const f32x4*)(sc + DFF + 4); }
                const f32x4 w0a = *(const f32x4*)(cw + c0), w0b = *(const f32x4*)(cw + c0 + 4), w1a = *(const f32x4*)(cw + DFF + c0), w1b = *(const f32x4*)(cw + DFF + c0 + 4), w2a = *(const f32x4*)(cw + 2 * DFF + c0), w2b = *(const f32x4*)(cw + 2 * DFF + c0 + 4);
                const f32x4 ga = w0a * xm2a + w1a * xm1a + w2a * xca, gb_ = w0b * xm2b + w1b * xm1b + w2b * xcb;
                const float* sv = SV + (size_t)(blk * 4 + vb + rr) * DFF + c0; const f32x4 va = *(const f32x4*)sv, vb_ = *(const f32x4*)(sv + 4);
                f32x4 a0, a1;
#pragma unroll
                for (int j = 0; j < 4; ++j) { a0[j] = ga[j] * sigmoidf_(ga[j]) * va[j]; a1[j] = gb_[j] * sigmoidf_(gb_[j]) * vb_[j]; }
                *(v4u*)(act + (size_t)row * DFF + c0) = pack8(a0, a1); }
            for (int i = gt; i < 4 * 2 * DFF; i += NT) { const int c = i % DFF, j = (i / DFF) & 1, b = i / (2 * DFF); out[OFF_CFP + (size_t)l * 4 * 2 * DFF + i] = SG[(size_t)((64 * b + 63) * 8 + 6 + j) * DFF + c]; }
            for (int i = gt; i < 8 * 2 * DFF; i += NT) { const int c = i % DFF, j = (i / DFF) & 1, b = i / (2 * DFF); out[OFF_CFS + (size_t)l * 8 * 2 * DFF + i] = SG[(size_t)((256 + (b >> 1)) * 8 + (b & 1) * 4 + 2 + j) * DFF + c]; }
        }
        SEAM();
        if (RUN) { PTRS() pg8::Gemm g{act, WT + WT_DOWN + (size_t)l * 2816 * 1024, MP, 1024, DFF}; pg8::StaticOrderF S; S.init(MP, 1024, G, (int)blockIdx.x); EpiRes E{P.in[0], P.in[0], xb, PARTBUF(3 + 3 * l), 0};
            pg8::gemm_phase<EpiRes, pg8::StaticOrderF, true, true>(lds, g, S, E, wave_s);
            { FRESH() sample_gemm<0>(act, WT + WT_DOWN + (size_t)l * 2816 * 1024, DFF, lds, tid, wave, lane, xb, nullptr, PARTBUF(3 + 3 * l), nullptr, nullptr); } }
        SEAM();
    }
    if (RUN) { PTRS() FRESH()
        const float* gf = P.in[14];
        for (int m = gw; m < MROWS; m += NGW) { const float rs = rstd_of(PARTBUF(6), m); float* xr = out + (size_t)m * 1024; const bf16* xbr = xb + (size_t)m * 1024;
#pragma unroll
            for (int j = 0; j < 4; ++j) { const int c = (lane + 64 * j) * 4; const u32x2v w = *(const u32x2v*)(xbr + c); const f32x4 v = (f32x4){bflo(w.x), bfhi(w.x), bflo(w.y), bfhi(w.y)}, gg = *(const f32x4*)(gf + c); *(f32x4*)(xr + c) = v * rs * gg; } }
    }
}

extern "C" void kernel_launch(void* const* d_in, const int* in_sizes, int n_in, void* d_out, int out_size, void* d_ws, size_t ws_size, hipStream_t stream) {
    static int grid = 0;
    if (grid == 0) {
        int dev = 0, cus = 0, per_cu = 0;
        if (n_in != 36 || ws_size < 256 * MiB) { fprintf(stderr, "kernel_launch: unexpected n_in %d / ws %zu\n", n_in, ws_size); grid = -1; return; }
        (void)hipGetDevice(&dev); (void)hipDeviceGetAttribute(&cus, hipDeviceAttributeMultiprocessorCount, dev);
        if (hipFuncSetAttribute((const void*)mega_fwd, hipFuncAttributeMaxDynamicSharedMemorySize, LDS_BYTES) != hipSuccess) { fprintf(stderr, "kernel_launch: hipFuncSetAttribute failed\n"); grid = -1; return; }
        if (hipOccupancyMaxActiveBlocksPerMultiprocessor(&per_cu, (const void*)mega_fwd, 512, LDS_BYTES) != hipSuccess || per_cu < 1) per_cu = 1;
        (void)hipGetLastError();
        grid = cus * 1;
        if (grid > 256) grid = 256;
    }
    if (grid < 0) return;
    (void)hipMemsetAsync(d_ws, 0, CTL_ZERO_BYTES, stream);
    Params p{};
    for (int i = 0; i < 36; ++i) p.in[i] = (const float*)d_in[i];
    p.out = (float*)d_out; p.ws = (unsigned char*)d_ws; p.use_cg = 0; p.pad = 0;
    void* args[] = {&p};
    hipError_t e = hipLaunchCooperativeKernel((const void*)mega_fwd, dim3(grid), dim3(512), args, LDS_BYTES, stream);
    if (e != hipSuccess) fprintf(stderr, "cooperative launch failed: %s (grid %d)\n", hipGetErrorString(e), grid);
}
```

```cpp
#include <hip/hip_runtime.h>
#include <hip/hip_cooperative_groups.h>
#include <cstdio>
#include <cstdint>
namespace cg = cooperative_groups;
__device__ __forceinline__ int fresh_tid(int wave_s) { unsigned z = 0u; asm volatile("" : "+s"(z)); int t = wave_s * 64 + (int)__builtin_amdgcn_mbcnt_hi(~0u, __builtin_amdgcn_mbcnt_lo(~0u, z)); asm volatile("" : "+v"(t)); return t; }
namespace pg8 {
#define PG8_LAS __attribute__((address_space(3)))
typedef unsigned short bf16_t;
typedef short bf16x8 __attribute__((ext_vector_type(8)));
typedef float f32x4 __attribute__((ext_vector_type(4)));
typedef unsigned u32x4 __attribute__((ext_vector_type(4)));
constexpr int BM = 256, BK = 64, HALF = 128, HTB = HALF * BK * 2  , STAGE_BYTES = 8 * HTB, NXCD = 8, WGM = 8;

__host__ __device__ __forceinline__ int lds_byte(int r, int c) { const int st = (r >> 4) * 2 + (c >> 5), rr = r & 15, cc = c & 31, ob = rr * 64 + cc * 2; return st * 1024 + (ob ^ (((ob >> 9) & 1) << 5)); }
__host__ __device__ __forceinline__ void stage_rc(int b, int& R, int& C) { const int st = b / 1024, sb = b % 1024, swz = sb ^ (((sb >> 9) & 1) << 5); R = (st >> 1) * 16 + swz / 64; C = (st & 1) * 32 + (swz % 64) / 2; }
__host__ __device__ __forceinline__ int perm32(int rho) { const int n = rho >> 4, i = rho & 15; return 8 * (i >> 2) + 4 * n + (i & 3); }

struct Unit { int pm, pn; };
struct Gemm { const bf16_t* A; const bf16_t* Bt; int M, N, K; };

template <bool FULL> struct StaticOrderT {
    int nM, nN, nwg, G, c;
    __host__ __device__ void init(int M, int N, int G_, int c_) { nM = M / BM; nN = N / BM; nwg = nM * nN; G = G_; c = c_; }
    __host__ __device__ bool next(int i, Unit& u) const {
        const long L = (long)i * G + c; if (!(FULL && i == 0) && L >= nwg) return false;
        int wgid = (int)L; { const int q = nwg / NXCD, r = nwg % NXCD, xcd = wgid % NXCD, off = wgid / NXCD; wgid = (xcd < r ? xcd * (q + 1) : r * (q + 1) + (xcd - r) * q) + off; }
        const int nig = WGM * nN, gid = wgid / nig, fm = gid * WGM, gsz = (nM - fm) < WGM ? (nM - fm) : WGM;
        u.pm = fm + ((wgid % nig) % gsz); u.pn = (wgid % nig) / gsz; return true;
    }
    __device__ __forceinline__ void a_ready(const Unit&) const {}
    __device__ __forceinline__ void done(const Unit&) const {}
};

typedef StaticOrderT<false> StaticOrder; typedef StaticOrderT<true> StaticOrderF;
__device__ __forceinline__ unsigned cvt_pk_bf16(float lo, float hi) { unsigned r; asm volatile("v_cvt_pk_bf16_f32 %0, %1, %2" : "=v"(r) : "v"(lo), "v"(hi)); return r; }
typedef float f32x2 __attribute__((ext_vector_type(2)));
template <class Epi, class Sched, bool ALIGN_EPI = false, bool SP2 = false>
__device__ __forceinline__ void gemm_phase(PG8_LAS unsigned char* lds, const Gemm g, const Sched& S, const Epi& E, const int wave_s) {
    const int tid = fresh_tid(wave_s), wid = __builtin_amdgcn_readfirstlane(tid >> 6), lane = tid & 63, wr = wid >> 2, wc = wid & 3, fr = lane & 15, fq = lane >> 4;
    const int K = g.K, nt = K / BK;
    unsigned voffA[2], voffB[2];
#pragma unroll
    for (int i = 0; i < 2; ++i) { int R, C; stage_rc(tid * 16 + i * 8192, R, C); const int Rb = Epi::PERM ? ((R & ~31) + perm32(R & 31)) : R;
        voffA[i] = (unsigned)(R * K + C) * 2u; voffB[i] = (unsigned)(Rb * K + C) * 2u; }
    const size_t kstep = (size_t)(BK * 2);
    const size_t hstep = (size_t)HALF * K * 2;
    const size_t tstep = 2 * hstep;
    const unsigned ldsw = (unsigned)wid * 1024u;
    const int aoff = lds_byte(wr * 64 + fr, fq * 8), boff = lds_byte(wc * 32 + fr, fq * 8);
#define PG8_SA(b, h) (((b) * 2 + (h)) * HTB)
#define PG8_SB(b, h) ((4 + (b) * 2 + (h)) * HTB)
#define PG8_STAGE(bufoff, gbase, voff) do { _Pragma("unroll") for (int _i = 0; _i < 2; ++_i) \
        __builtin_amdgcn_global_load_lds((const unsigned*)((const char*)(gbase) + (voff)[_i]), (PG8_LAS unsigned*)(lds + (bufoff) + ldsw + _i * 8192), 16, 0, 0); } while (0)
#define PG8_LDA(dst, b, h) do { _Pragma("unroll") for (int m = 0; m < 4; ++m) _Pragma("unroll") for (int k = 0; k < 2; ++k) dst[m][k] = *(const PG8_LAS bf16x8*)(lds + PG8_SA(b, h) + aoff + m * 2048 + k * 1024); } while (0)
#define PG8_LDB(dst, b, h) do { _Pragma("unroll") for (int n = 0; n < 2; ++n) _Pragma("unroll") for (int k = 0; k < 2; ++k) dst[n][k] = *(const PG8_LAS bf16x8*)(lds + PG8_SB(b, h) + boff + n * 2048 + k * 1024); } while (0)
#define PG8_MMA(ai, bj, At, Bt) do { __builtin_amdgcn_s_setprio(1); _Pragma("unroll") for (int m = 0; m < 4; ++m) _Pragma("unroll") for (int n = 0; n < 2; ++n) _Pragma("unroll") for (int k = 0; k < 2; ++k) \
        acc[ai][bj][m][n] = __builtin_amdgcn_mfma_f32_16x16x32_bf16(Bt[n][k], At[m][k], acc[ai][bj][m][n], 0, 0, 0); __builtin_amdgcn_s_setprio(0); } while (0)
#define PG8_WAIT_V(n) asm volatile("s_waitcnt vmcnt(" #n ")" ::: "memory")
#define PG8_WAIT_L(n) asm volatile("s_waitcnt lgkmcnt(" #n ")" ::: "memory")
#define PG8_BAR __builtin_amdgcn_s_barrier()
#define PG8_SCHED __builtin_amdgcn_sched_barrier(0)
    Unit cur, nxt; int ui = 0;
    if (!S.next(0, cur)) return;
    f32x4 acc[2][2][4][2];
#pragma unroll
    for (int a = 0; a < 2; ++a)
#pragma unroll
        for (int b = 0; b < 2; ++b)
#pragma unroll
            for (int m = 0; m < 4; ++m)
#pragma unroll
                for (int n = 0; n < 2; ++n) acc[a][b][m][n] = (f32x4){0.f, 0.f, 0.f, 0.f};
    bf16x8 At[4][2], B0[2][2], B1[2][2];
    const char* cA = (const char*)g.A + (size_t)cur.pm * tstep; const char* cB = (const char*)g.Bt + (size_t)cur.pn * tstep;
    S.a_ready(cur);
    if constexpr (SP2) {
        PG8_STAGE(PG8_SB(0, 0), cB, voffB); PG8_STAGE(PG8_SB(0, 1), cB + hstep, voffB); PG8_STAGE(PG8_SA(0, 0), cA, voffA); PG8_STAGE(PG8_SA(0, 1), cA + hstep, voffA);
        if (wr == 1) PG8_BAR;
        PG8_WAIT_V(2); PG8_BAR;
        PG8_STAGE(PG8_SB(1, 0), cB + kstep, voffB); PG8_STAGE(PG8_SA(1, 0), cA + kstep, voffA); PG8_STAGE(PG8_SB(1, 1), cB + hstep + kstep, voffB);
        PG8_WAIT_V(6); PG8_BAR;
    } else {
        PG8_STAGE(PG8_SB(0, 0), cB, voffB); PG8_STAGE(PG8_SA(0, 0), cA, voffA); PG8_STAGE(PG8_SB(0, 1), cB + hstep, voffB); PG8_STAGE(PG8_SA(0, 1), cA + hstep, voffA);
        if (wr == 1) PG8_BAR;
        PG8_WAIT_V(4); PG8_BAR;
        PG8_STAGE(PG8_SB(1, 0), cB + kstep, voffB); PG8_STAGE(PG8_SA(1, 0), cA + kstep, voffA); PG8_STAGE(PG8_SB(1, 1), cB + hstep + kstep, voffB);
        PG8_WAIT_V(6); PG8_BAR;
    }
    for (;;) {
        const bool has_next = S.next(ui + 1, nxt);
        const char* nA = has_next ? (const char*)g.A + (size_t)nxt.pm * tstep : cA; const char* nB = has_next ? (const char*)g.Bt + (size_t)nxt.pn * tstep : cB;
        for (int t = 0; t < nt; t += 2) {
            const bool last = (t == nt - 2);
            const char* a1 = cA + (size_t)(t + 1) * kstep;
            const char* a2 = last ? nA : cA + (size_t)(t + 2) * kstep; const char* b2 = last ? nB : cB + (size_t)(t + 2) * kstep;
            const char* a3 = a2 + kstep; const char* b3 = b2 + kstep;
            if (last && has_next) S.a_ready(nxt);
            if constexpr (SP2) {
            PG8_LDB(B0, 0, 0); PG8_LDB(B1, 0, 1); PG8_SCHED; PG8_LDA(At, 0, 0); PG8_STAGE(PG8_SA(1, 1), a1 + hstep, voffA);
            PG8_WAIT_V(8); PG8_WAIT_L(0); PG8_BAR; PG8_MMA(0, 0, At, B0); PG8_MMA(0, 1, At, B1); PG8_BAR; PG8_SCHED;
            PG8_LDA(At, 0, 1); PG8_STAGE(PG8_SB(0, 0), b2, voffB); PG8_STAGE(PG8_SB(0, 1), b2 + hstep, voffB); PG8_STAGE(PG8_SA(0, 0), a2, voffA);
            PG8_WAIT_V(8); PG8_WAIT_L(0); PG8_BAR; PG8_MMA(1, 0, At, B0); PG8_MMA(1, 1, At, B1); PG8_BAR; PG8_SCHED;
            PG8_LDB(B0, 1, 0); PG8_LDB(B1, 1, 1); PG8_SCHED; PG8_LDA(At, 1, 0); PG8_STAGE(PG8_SA(0, 1), a2 + hstep, voffA);
            PG8_WAIT_V(8); PG8_WAIT_L(0); PG8_BAR; PG8_MMA(0, 0, At, B0); PG8_MMA(0, 1, At, B1); PG8_BAR; PG8_SCHED;
            PG8_LDA(At, 1, 1); PG8_STAGE(PG8_SB(1, 0), b3, voffB); PG8_STAGE(PG8_SB(1, 1), b3 + hstep, voffB); PG8_STAGE(PG8_SA(1, 0), a3, voffA);
            PG8_WAIT_V(8); PG8_WAIT_L(0); PG8_BAR; PG8_MMA(1, 0, At, B0); PG8_MMA(1, 1, At, B1); PG8_BAR; PG8_SCHED;
            } else {
            PG8_LDB(B0, 0, 0); PG8_SCHED; PG8_LDA(At, 0, 0); PG8_STAGE(PG8_SA(1, 1), a1 + hstep, voffA);
            PG8_WAIT_L(8); PG8_BAR; PG8_WAIT_L(0); PG8_MMA(0, 0, At, B0); PG8_BAR; PG8_SCHED;
            PG8_LDB(B1, 0, 1); PG8_STAGE(PG8_SB(0, 0), b2, voffB);
            PG8_BAR; PG8_WAIT_L(0); PG8_MMA(0, 1, At, B1); PG8_BAR;
            PG8_LDA(At, 0, 1); PG8_STAGE(PG8_SA(0, 0), a2, voffA);
            PG8_BAR; PG8_WAIT_L(0); PG8_MMA(1, 0, At, B0); PG8_BAR; PG8_SCHED;
            PG8_STAGE(PG8_SB(0, 1), b2 + hstep, voffB);
            PG8_WAIT_V(6); PG8_BAR; PG8_MMA(1, 1, At, B1); PG8_BAR;
            PG8_LDB(B0, 1, 0); PG8_SCHED; PG8_LDA(At, 1, 0); PG8_STAGE(PG8_SA(0, 1), a2 + hstep, voffA);
            PG8_WAIT_L(8); PG8_BAR; PG8_WAIT_L(0); PG8_MMA(0, 0, At, B0); PG8_BAR; PG8_SCHED;
            PG8_LDB(B1, 1, 1); PG8_STAGE(PG8_SB(1, 0), b3, voffB);
            PG8_BAR; PG8_WAIT_L(0); PG8_MMA(0, 1, At, B1); PG8_BAR;
            PG8_LDA(At, 1, 1); PG8_STAGE(PG8_SA(1, 0), a3, voffA);
            PG8_BAR; PG8_WAIT_L(0); PG8_MMA(1, 0, At, B0); PG8_BAR; PG8_SCHED;
            PG8_STAGE(PG8_SB(1, 1), b3 + hstep, voffB);
            PG8_WAIT_V(6); PG8_BAR; PG8_MMA(1, 1, At, B1); PG8_BAR;
            }
        }
        if constexpr (ALIGN_EPI) { if (wr == 0) PG8_BAR; }
        if constexpr (!Epi::AFTER_DRAIN) { E(acc, cur, wr, wc, fr, fq); S.done(cur); }
        if (!has_next) break;
#pragma unroll
        for (int a = 0; a < 2; ++a)
#pragma unroll
            for (int b = 0; b < 2; ++b)
#pragma unroll
                for (int m = 0; m < 4; ++m)
#pragma unroll
                    for (int n = 0; n < 2; ++n) acc[a][b][m][n] = (f32x4){0.f, 0.f, 0.f, 0.f};
        cur = nxt; cA = nA; cB = nB; ++ui;
        if constexpr (ALIGN_EPI) { if (wr == 1) PG8_BAR; }
    }
    PG8_WAIT_V(0);
    if constexpr (!ALIGN_EPI) { if (wr == 0) PG8_BAR; }
    PG8_BAR;
    if constexpr (Epi::AFTER_DRAIN) { E.fused(acc, cur, wr, wc, fr, fq, lds, wid, lane); S.done(cur); }
#undef PG8_SA
#undef PG8_SB
#undef PG8_STAGE
#undef PG8_LDA
#undef PG8_LDB
#undef PG8_MMA
#undef PG8_WAIT_V
#undef PG8_WAIT_L
#undef PG8_BAR
#undef PG8_SCHED
}
}
#define GAS __attribute__((address_space(1)))
#define LAS __attribute__((address_space(3)))
typedef unsigned short bf16;
typedef unsigned v4u __attribute__((ext_vector_type(4)));
typedef float f32x4 __attribute__((ext_vector_type(4)));
typedef short bf16x8 __attribute__((ext_vector_type(8)));
typedef GAS unsigned gu32;
typedef GAS unsigned long long gu64;
#define RLX_AGENT __ATOMIC_RELAXED, __HIP_MEMORY_SCOPE_AGENT
#define LDS_WAIT() asm volatile("s_waitcnt lgkmcnt(0)" ::: "memory")
#define VM_WAIT() asm volatile("s_waitcnt vmcnt(0)" ::: "memory")
__device__ __forceinline__ unsigned long long rt() { return __builtin_amdgcn_s_memrealtime(); }
__device__ __forceinline__ unsigned f2bf(float f) { unsigned u = __builtin_bit_cast(unsigned, f); return (u + 0x7fffu + ((u >> 16) & 1u)) >> 16; }
__device__ __forceinline__ unsigned pk2(float lo, float hi) { return f2bf(lo) | (f2bf(hi) << 16); }

#define XB_TMO      128
#define XB_XCNT(j)  (256  + 64 * (j))
#define XB_XSUB(j)  (1280 + 64 * (j))
#define XB_XGEN(j)  (2304 + 64 * (j))
#define XB_TOP      3328
#define XB_TOPGEN   3392
#define XCD_BAR_WORDS 3456
#define XB_SPIN_CAP (1u << 18)

__device__ __forceinline__ unsigned xb_ld(unsigned* p)              { return __hip_atomic_load(p, __ATOMIC_RELAXED, __HIP_MEMORY_SCOPE_AGENT); }
__device__ __forceinline__ unsigned xb_add(unsigned* p, unsigned v) { return __hip_atomic_fetch_add(p, v, __ATOMIC_RELAXED, __HIP_MEMORY_SCOPE_AGENT); }
__device__ __forceinline__ unsigned xb_xcc_id() { return (unsigned)__builtin_amdgcn_s_getreg((3 << 11) | 20) & 0xFu; }
#define XB_SPIN(cond, bar) do { unsigned _sp = 0; while (cond) { __builtin_amdgcn_s_sleep(1); \
    if ((++_sp & 255u) == 0u) { if (xb_ld(&(bar)[XB_TMO])) break; if (_sp > XB_SPIN_CAP) { atomicAdd(&(bar)[XB_TMO], 1u); break; } } } } while (0)

struct XcdBarrier {
    unsigned* bar; unsigned x;
    volatile LAS unsigned* st;
};

__device__ __forceinline__ XcdBarrier xcd_barrier_post(unsigned* bar, volatile LAS unsigned* st) {
    XcdBarrier b; b.bar = bar; b.x = xb_xcc_id(); b.st = st;
    if (threadIdx.x == 0) (void)xb_add(&bar[XB_XCNT(b.x)], 1u);
    return b;
}
__device__ __forceinline__ void xcd_barrier_complete(unsigned* bar, unsigned x, unsigned& nloc, unsigned& nx) {
    const unsigned G = gridDim.x * gridDim.y * gridDim.z;
    unsigned sum, cnt, mine, sp = 0u;
    for (;;) {
        sum = 0u; cnt = 0u; mine = 0u;
#pragma unroll
        for (unsigned j = 0; j < 16; ++j) { const unsigned c = xb_ld(&bar[XB_XCNT(j)]); sum += c; cnt += (c > 0u) ? 1u : 0u; mine = (j == x) ? c : mine; }
        if (sum == G) break;
        __builtin_amdgcn_s_sleep(1);
        if ((++sp & 255u) == 0u) { if (xb_ld(&bar[XB_TMO])) break; if (sp > XB_SPIN_CAP) { atomicAdd(&bar[XB_TMO], 1u); break; } }
    }
    nloc = mine > 0u ? mine : 1u; nx = cnt > 0u ? cnt : 1u;
}

__device__ __forceinline__ void xcd_barrier(const XcdBarrier& b) {
    asm volatile("s_waitcnt vmcnt(0)" ::: "memory");
    __syncthreads();
    if (threadIdx.x == 0) {
        unsigned* bar = b.bar;
        __builtin_amdgcn_s_waitcnt(0);
        unsigned nloc = b.st[0], nx = b.st[1];
        if (nloc == 0u) { xcd_barrier_complete(bar, b.x, nloc, nx); b.st[0] = nloc; b.st[1] = nx; }
        const unsigned old = xb_add(&bar[XB_XSUB(b.x)], 1u);
        const unsigned gen = old / nloc;
        if (old + 1u == (gen + 1u) * nloc) {
            __builtin_amdgcn_fence(__ATOMIC_RELEASE, "agent");
            asm volatile("s_waitcnt vmcnt(0)" ::: "memory");
            const unsigned og = xb_add(&bar[XB_TOP], 1u);
            const unsigned tg = og / nx;
            if (og + 1u == (tg + 1u) * nx) xb_add(&bar[XB_TOPGEN], 1u);
            else XB_SPIN(xb_ld(&bar[XB_TOPGEN]) == tg, bar);
            __builtin_amdgcn_fence(__ATOMIC_ACQUIRE, "agent");
            xb_add(&bar[XB_XGEN(b.x)], 1u);
            asm volatile("s_waitcnt vmcnt(0)" ::: "memory");
        } else {
            XB_SPIN(xb_ld(&bar[XB_XGEN(b.x)]) == gen, bar);
            __builtin_amdgcn_fence(__ATOMIC_ACQUIRE, "agent");
            asm volatile("s_waitcnt vmcnt(0)" ::: "memory");
        }
    }
    __syncthreads();
}
typedef unsigned u32x2v __attribute__((ext_vector_type(2)));
typedef float f32x2v __attribute__((ext_vector_type(2)));

constexpr int MP = 16384, MROWS = 16640, DMODEL = 1024, DFF = 2816, NBLK64 = MROWS / 64;
constexpr float RMS_EPS = 1e-6f;
constexpr size_t OFF_Y = 0, OFF_WKP = (size_t)MROWS * 1024, OFF_WVP = OFF_WKP + 65536, OFF_SRP = OFF_WVP + 65536, OFF_SIP = OFF_SRP + 8192,
    OFF_CMP = OFF_SIP + 8192, OFF_CFP = OFF_CMP + 8192, OFF_MKP = OFF_CFP + 45056, OFF_MVP = OFF_MKP + 2097152, OFF_WKS = OFF_MVP + 2097152,
    OFF_WVS = OFF_WKS + 32768, OFF_SRS = OFF_WVS + 32768, OFF_SIS = OFF_SRS + 16384, OFF_CMS = OFF_SIS + 16384, OFF_CFS = OFF_CMS + 16384;
constexpr size_t MiB = 1u << 20;
constexpr size_t WS_ROWSS = 0, WS_BAR = 512 * 1024, CTL_ZERO_BYTES = 1 * MiB;
constexpr size_t WS_ROPE = 1 * MiB, WS_SSM = 2 * MiB, WS_CKV = 3 * MiB, WS_SLOC = 4 * MiB, WS_MEMK = 8 * MiB, WS_MEMVT = 20 * MiB, WS_SIDE = 32 * MiB;
constexpr size_t SG_BYTES = (size_t)NBLK64 * 8 * DFF * 4, SV_BYTES = (size_t)NBLK64 * 4 * DFF * 4;
static_assert(WS_SIDE + SG_BYTES + SV_BYTES <= 66 * MiB, "side buffers");
constexpr size_t WS_WT = 66 * MiB, WS_XB = 128 * MiB, WS_TMP = 161 * MiB;
constexpr size_t WT_INEVEN = 0, WT_GLU = WT_INEVEN + 1280 * 1024, WT_OUTEVEN = WT_GLU + 512 * 512, WT_WQ = WT_OUTEVEN + 1024 * 1024, WT_WKV = WT_WQ + 2 * 1024 * 1024,
    WT_WO = WT_WKV + 2 * 2048 * 1024, WT_UP = WT_WO + 2 * 1024 * 1024, WT_DOWN = WT_UP + (size_t)2 * 5632 * 1024, WT_INODD = WT_DOWN + (size_t)2 * 2816 * 1024,
    WT_OUTODD = WT_INODD + 3072 * 1024, WT_END = WT_OUTODD + 1024 * 1024;
static_assert(WS_WT + WT_END * 2 <= WS_XB, "weights");
static_assert(WS_XB + (size_t)MROWS * 1024 * 2 <= WS_TMP, "xb");
constexpr size_t TMP_BYTES = (size_t)MROWS * DFF * 2;
constexpr size_t WS_PART = 251 * MiB, PART_ELEMS = (size_t)MROWS * 16;
static_assert(WS_PART + 2 * PART_ELEMS * 4 <= 256 * MiB, "part");
static_assert(WS_TMP + TMP_BYTES <= 256 * MiB, "ws");
constexpr size_t TMP_PROJ0 = 0, TMP_GBUF = (size_t)MROWS * 1280 * 2, TMP_YCAT = TMP_GBUF + (size_t)MROWS * 512 * 2, TMP_MEMB = TMP_YCAT;
static_assert(TMP_YCAT + (size_t)MROWS * 1024 * 2 <= TMP_BYTES, "tmp");
constexpr size_t TMP_QX = 0, TMP_OX = (size_t)MROWS * 1024 * 2, TMP_ACT = 0, TMP_GB = 0, TMP_ZC = (size_t)MROWS * 1024 * 2;
constexpr int LDS_BYTES = 147456, MISC_OFF = 147456 - 512;
constexpr int NPH = 22;

#define MFMA16(a, b, c) __builtin_amdgcn_mfma_f32_16x16x32_bf16(a, b, c, 0, 0, 0)
__device__ __forceinline__ float bflo(unsigned w) { return __uint_as_float(w << 16); }
__device__ __forceinline__ float bfhi(unsigned w) { return __uint_as_float(w & 0xffff0000u); }
__device__ __forceinline__ v4u pack8(f32x4 a, f32x4 b) { v4u w; w.x = pg8::cvt_pk_bf16(a[0], a[1]); w.y = pg8::cvt_pk_bf16(a[2], a[3]); w.z = pg8::cvt_pk_bf16(b[0], b[1]); w.w = pg8::cvt_pk_bf16(b[2], b[3]); return w; }
__device__ __forceinline__ float rstd_of(const float* part, int row) { const f32x4* p = (const f32x4*)(part + (size_t)row * 16); const f32x4 a = p[0] + p[1] + p[2] + p[3]; return rsqrtf(((a[0] + a[1]) + (a[2] + a[3])) * (1.0f / 1024.0f) + RMS_EPS); }
__device__ __forceinline__ float sigmoidf_(float x) { return 1.0f / (1.0f + __expf(-x)); }
__device__ __forceinline__ float dpp_ror1(float v) { return __builtin_bit_cast(float, __builtin_amdgcn_update_dpp(0, __builtin_bit_cast(int, v), 0x121, 0xf, 0xf, false)); }
__device__ __forceinline__ float dpp_ror2(float v) { return __builtin_bit_cast(float, __builtin_amdgcn_update_dpp(0, __builtin_bit_cast(int, v), 0x122, 0xf, 0xf, false)); }
__device__ __forceinline__ float wave_sum(float v) {
#pragma unroll
    for (int o = 1; o < 64; o <<= 1) v += __shfl_xor(v, o);
    return v;
}

typedef pg8::Unit Unit;
#define EPI_ARGS const f32x4 (&acc)[2][2][4][2], const Unit& u, int wr, int wc, int fr, int fq

struct EpiBf16 {
    static constexpr bool PERM = true, AFTER_DRAIN = false;
    bf16* O; int ldc; const float* rowss;
    __device__ __forceinline__ void operator()(EPI_ARGS) const {
        const int row0 = u.pm * 256 + wr * 64 + fr, col0 = u.pn * 256 + wc * 32 + 8 * fq;
#pragma unroll
        for (int ai = 0; ai < 2; ++ai)
#pragma unroll
            for (int m = 0; m < 4; ++m) { const int row = row0 + ai * 128 + m * 16; const float rs = rstd_of(rowss, row); bf16* rp = O + (size_t)row * ldc + col0;
#pragma unroll
                for (int bj = 0; bj < 2; ++bj) *(v4u*)(rp + bj * 128) = pack8(acc[ai][bj][m][0] * rs, acc[ai][bj][m][1] * rs); }
    }
};
struct EpiRes {
    static constexpr bool PERM = true, AFTER_DRAIN = false;
    const float* base_p; const float* base_s; bf16* xb; float* rowss_next; int f32base;
    __device__ __forceinline__ void operator()(EPI_ARGS) const {
        const float* base = u.pm < 64 ? base_p : base_s;
        const int row0 = u.pm * 256 + wr * 64 + fr, col0 = u.pn * 256 + wc * 32 + 8 * fq;
#pragma unroll
        for (int ai = 0; ai < 2; ++ai)
#pragma unroll
            for (int m = 0; m < 4; ++m) { const int row = row0 + ai * 128 + m * 16; const size_t off = (size_t)row * 1024 + col0; float ss = 0.f;
#pragma unroll
                for (int bj = 0; bj < 2; ++bj) { f32x4 b0, b1;
                    if (f32base) { b0 = *(const f32x4*)(base + off + bj * 128); b1 = *(const f32x4*)(base + off + bj * 128 + 4); }
                    else { const v4u w = *(const v4u*)(xb + off + bj * 128); b0 = (f32x4){bflo(w.x), bfhi(w.x), bflo(w.y), bfhi(w.y)}; b1 = (f32x4){bflo(w.z), bfhi(w.z), bflo(w.w), bfhi(w.w)}; }
                    const f32x4 v0 = acc[ai][bj][m][0] + b0, v1 = acc[ai][bj][m][1] + b1;
                    *(v4u*)(xb + off + bj * 128) = pack8(v0, v1);
                    ss += (v0[0] * v0[0] + v0[1] * v0[1]) + (v0[2] * v0[2] + v0[3] * v0[3]) + (v1[0] * v1[0] + v1[1] * v1[1]) + (v1[2] * v1[2] + v1[3] * v1[3]); }
                ss += __shfl_xor(ss, 16); ss += __shfl_xor(ss, 32);
                if (fq == 0) rowss_next[(size_t)row * 16 + u.pn * 4 + wc] = ss; }
    }
};
struct EpiGlu {
    static constexpr bool PERM = true, AFTER_DRAIN = false;
    const bf16* g; bf16* ycat;
    __device__ __forceinline__ void operator()(EPI_ARGS) const {
        const int row0 = u.pm * 256 + wr * 64 + fr, col0 = u.pn * 256 + wc * 32 + 8 * fq;
#pragma unroll
        for (int ai = 0; ai < 2; ++ai)
#pragma unroll
            for (int m = 0; m < 4; ++m) { const int row = row0 + ai * 128 + m * 16;
#pragma unroll
                for (int bj = 0; bj < 2; ++bj) { const int col = col0 + bj * 128; const v4u gw = *(const v4u*)(g + (size_t)row * 512 + col);
                    const f32x4 a0 = acc[ai][bj][m][0], a1 = acc[ai][bj][m][1]; f32x4 o0, o1;
                    o0[0] = bflo(gw.x) * sigmoidf_(a0[0]); o0[1] = bfhi(gw.x) * sigmoidf_(a0[1]); o0[2] = bflo(gw.y) * sigmoidf_(a0[2]); o0[3] = bfhi(gw.y) * sigmoidf_(a0[3]);
                    o1[0] = bflo(gw.z) * sigmoidf_(a1[0]); o1[1] = bfhi(gw.z) * sigmoidf_(a1[1]); o1[2] = bflo(gw.w) * sigmoidf_(a1[2]); o1[3] = bfhi(gw.w) * sigmoidf_(a1[3]);
                    *(v4u*)(ycat + (size_t)row * 1024 + col) = pack8(o0, o1); } }
    }
};
struct EpiKV {
    static constexpr bool PERM = true, AFTER_DRAIN = false;
    float* out; bf16* memk;
    __device__ __forceinline__ void operator()(EPI_ARGS) const {
        const int row0 = u.pm * 256 + wr * 64 + fr, col0 = u.pn * 256 + wc * 32 + 8 * fq;
#pragma unroll
        for (int ai = 0; ai < 2; ++ai)
#pragma unroll
            for (int m = 0; m < 4; ++m) { const int row = row0 + ai * 128 + m * 16;
#pragma unroll
                for (int bj = 0; bj < 2; ++bj) { const int c = col0 + bj * 128, l = c >> 11, e = c & 2047, isv = e >> 10, dc = e & 1023;
                    float* op = out + (isv ? OFF_MVP : OFF_MKP) + (size_t)l * 1048576 + (size_t)row * 1024 + dc;
                    *(f32x4*)op = acc[ai][bj][m][0]; *(f32x4*)(op + 4) = acc[ai][bj][m][1];
                    if (!isv) *(v4u*)(memk + (size_t)l * 12 * 262144 + (size_t)row * 1024 + dc) = pack8(acc[ai][bj][m][0], acc[ai][bj][m][1]); } }
    }
};
struct EpiIn0 {
    static constexpr bool PERM = true, AFTER_DRAIN = false;
    bf16* proj; const float* rowss; const float* ropec; const float* ropes; float* out;
    __device__ __forceinline__ void operator()(EPI_ARGS) const {
        const int pn = u.pn;
#pragma unroll
        for (int ai = 0; ai < 2; ++ai)
#pragma unroll
            for (int m = 0; m < 4; ++m) { const int row = u.pm * 256 + ai * 128 + wr * 64 + m * 16 + fr; const float rs = rstd_of(rowss, row);
                const int pos = row < MP ? (row & 4095) : 2048 + (row & 31);
                bf16* rp = proj + (size_t)row * 1280;
                float* wk = nullptr; float* wv = nullptr;
                if (pn == 4) { if (row >= MP) { wk = out + OFF_WKS + (size_t)(row - MP) * 128; wv = out + OFF_WVS + (size_t)(row - MP) * 128; }
                               else if ((row & 4095) >= 3968) { const size_t o = (size_t)((row >> 12) * 128 + (row & 4095) - 3968) * 128; wk = out + OFF_WKP + o; wv = out + OFF_WVP + o; } }
#pragma unroll
                for (int bj = 0; bj < 2; ++bj) { const f32x4 v0 = acc[ai][bj][m][0] * rs, v1 = acc[ai][bj][m][1] * rs;
                    const bool rope = (pn == 2 || pn == 3 || (pn == 4 && bj == 0));
                    if (!rope) { const int col = pn * 256 + bj * 128 + wc * 32 + 8 * fq; *(v4u*)(rp + col) = pack8(v0, v1);
                        if (pn == 4 && wv) { *(f32x4*)(wv + wc * 32 + 8 * fq) = v0; *(f32x4*)(wv + wc * 32 + 8 * fq + 4) = v1; } }
                    else { const int gbase = pn * 256 + bj * 128 + (wc >> 1) * 64, d1 = 16 * (wc & 1) + 4 * fq;
                        const f32x4 c4 = *(const f32x4*)(ropec + pos * 32 + d1), s4 = *(const f32x4*)(ropes + pos * 32 + d1);
                        f32x4 o1 = v0 * c4 - v1 * s4, o2 = v1 * c4 + v0 * s4;
                        if (pn != 4) { o1 = o1 * 0.125f; o2 = o2 * 0.125f; }
                        u32x2v w1, w2; w1.x = pg8::cvt_pk_bf16(o1[0], o1[1]); w1.y = pg8::cvt_pk_bf16(o1[2], o1[3]); w2.x = pg8::cvt_pk_bf16(o2[0], o2[1]); w2.y = pg8::cvt_pk_bf16(o2[2], o2[3]);
                        *(u32x2v*)(rp + gbase + d1) = w1; *(u32x2v*)(rp + gbase + d1 + 32) = w2;
                        if (pn == 4 && wk) { const int cc = (wc >> 1) * 64 + d1; *(f32x4*)(wk + cc) = o1; *(f32x4*)(wk + cc + 32) = o2; } } } }
    }
};
struct EpiFfnUp {
    static constexpr bool PERM = true, AFTER_DRAIN = false;
    bf16* act; const float* rowss; const float* cw; float* SG; float* SV;
    __device__ __forceinline__ void operator()(EPI_ARGS) const {
        const int c0 = u.pn * 128 + wc * 32 + 8 * fq; const bool sample = u.pm == 64;
        const f32x4 w0a = *(const f32x4*)(cw + c0), w0b = *(const f32x4*)(cw + c0 + 4), w1a = *(const f32x4*)(cw + DFF + c0), w1b = *(const f32x4*)(cw + DFF + c0 + 4),
                    w2a = *(const f32x4*)(cw + 2 * DFF + c0), w2b = *(const f32x4*)(cw + 2 * DFF + c0 + 4);
#pragma unroll
        for (int ai = 0; ai < 2; ++ai) { f32x4 gp0 = {0.f, 0.f, 0.f, 0.f}, gp1 = {0.f, 0.f, 0.f, 0.f}; const int blk = u.pm * 4 + ai * 2 + wr;
#pragma unroll
            for (int m = 0; m < 4; ++m) { const int row = u.pm * 256 + ai * 128 + wr * 64 + m * 16 + fr; const float rs = rstd_of(rowss, row);
                const f32x4 g0 = acc[ai][0][m][0] * rs, g1 = acc[ai][0][m][1] * rs, v0 = acc[ai][1][m][0] * rs, v1 = acc[ai][1][m][1] * rs;
                f32x4 p1a, p2a, p1b, p2b;
#pragma unroll
                for (int j = 0; j < 4; ++j) { const float s1a = fr == 15 ? gp0[j] : g0[j], s2a = fr >= 14 ? gp0[j] : g0[j], s1b = fr == 15 ? gp1[j] : g1[j], s2b = fr >= 14 ? gp1[j] : g1[j];
                    p1a[j] = dpp_ror1(s1a); p2a[j] = dpp_ror2(s2a); p1b[j] = dpp_ror1(s1b); p2b[j] = dpp_ror2(s2b); }
                const f32x4 ca = w0a * p2a + w1a * p1a + w2a * g0, cb = w0b * p2b + w1b * p1b + w2b * g1;
                f32x4 sa, sb;
#pragma unroll
                for (int j = 0; j < 4; ++j) { sa[j] = sigmoidf_(ca[j]); sb[j] = sigmoidf_(cb[j]); }
                const f32x4 a0 = ca * sa * v0, a1 = cb * sb * v1;
                const bool valid = (m > 0 || fr >= 2) && !(sample && m == 2 && fr < 2);
                if (valid) *(v4u*)(act + (size_t)row * DFF + c0) = pack8(a0, a1);
                if ((m & 1) == 0 && fr < 2) { float* sg = SG + (size_t)(blk * 8 + 2 * m + fr) * DFF + c0; *(f32x4*)sg = g0; *(f32x4*)(sg + 4) = g1;
                                              float* sv = SV + (size_t)(blk * 4 + m + fr) * DFF + c0; *(f32x4*)sv = v0; *(f32x4*)(sv + 4) = v1; }
                if ((m & 1) == 1 && fr >= 14) { float* sg = SG + (size_t)(blk * 8 + 2 * m + fr - 14) * DFF + c0; *(f32x4*)sg = g0; *(f32x4*)(sg + 4) = g1; }
                gp0 = g0; gp1 = g1; } }
    }
};
struct EpiInOdd {
    static constexpr bool PERM = true, AFTER_DRAIN = false;
    bf16* gb; bf16* zc; const float* rowss; const float* cw; float* SG;
    __device__ __forceinline__ void operator()(EPI_ARGS) const {
        if (u.pn < 4) {
            const int row0 = u.pm * 256 + wr * 64 + fr, col0 = u.pn * 256 + wc * 32 + 8 * fq;
#pragma unroll
            for (int ai = 0; ai < 2; ++ai)
#pragma unroll
                for (int m = 0; m < 4; ++m) { const int row = row0 + ai * 128 + m * 16; const float rs = rstd_of(rowss, row); bf16* rp = gb + (size_t)row * 1024 + col0;
#pragma unroll
                    for (int bj = 0; bj < 2; ++bj) *(v4u*)(rp + bj * 128) = pack8(acc[ai][bj][m][0] * rs, acc[ai][bj][m][1] * rs); }
            return;
        }
        const int c0 = (u.pn - 4) * 128 + wc * 32 + 8 * fq; const bool sample = u.pm == 64;
        const f32x4 w0a = *(const f32x4*)(cw + c0), w0b = *(const f32x4*)(cw + c0 + 4), w1a = *(const f32x4*)(cw + 1024 + c0), w1b = *(const f32x4*)(cw + 1024 + c0 + 4),
                    w2a = *(const f32x4*)(cw + 2048 + c0), w2b = *(const f32x4*)(cw + 2048 + c0 + 4);
#pragma unroll
        for (int ai = 0; ai < 2; ++ai) { f32x4 gp0 = {0.f, 0.f, 0.f, 0.f}, gp1 = {0.f, 0.f, 0.f, 0.f}; const int blk = u.pm * 4 + ai * 2 + wr;
#pragma unroll
            for (int m = 0; m < 4; ++m) { const int row = u.pm * 256 + ai * 128 + wr * 64 + m * 16 + fr; const float rs = rstd_of(rowss, row); const float rs2 = rs * rs;
                const f32x4 g0 = acc[ai][0][m][0] * acc[ai][1][m][0] * rs2, g1 = acc[ai][0][m][1] * acc[ai][1][m][1] * rs2;
                f32x4 p1a, p2a, p1b, p2b;
#pragma unroll
                for (int j = 0; j < 4; ++j) { const float s1a = fr == 15 ? gp0[j] : g0[j], s2a = fr >= 14 ? gp0[j] : g0[j], s1b = fr == 15 ? gp1[j] : g1[j], s2b = fr >= 14 ? gp1[j] : g1[j];
                    p1a[j] = dpp_ror1(s1a); p2a[j] = dpp_ror2(s2a); p1b[j] = dpp_ror1(s1b); p2b[j] = dpp_ror2(s2b); }
                const f32x4 a0 = w0a * p2a + w1a * p1a + w2a * g0, a1 = w0b * p2b + w1b * p1b + w2b * g1;
                const bool valid = (m > 0 || fr >= 2) && !(sample && m == 2 && fr < 2);
                if (valid) *(v4u*)(zc + (size_t)row * 1024 + c0) = pack8(a0, a1);
                if ((m & 1) == 0 && fr < 2) { float* sg = SG + (size_t)(blk * 8 + 2 * m + fr) * 1024 + c0; *(f32x4*)sg = g0; *(f32x4*)(sg + 4) = g1; }
                if ((m & 1) == 1 && fr >= 14) { float* sg = SG + (size_t)(blk * 8 + 2 * m + fr - 14) * 1024 + c0; *(f32x4*)sg = g0; *(f32x4*)(sg + 4) = g1; }
                gp0 = g0; gp1 = g1; } }
    }
};


struct EpiCz {
    static constexpr bool PERM = true, AFTER_DRAIN = false;
    bf16* gb; const float* rowss; const float* cw; float* SG;
    __device__ __forceinline__ void operator()(EPI_ARGS) const {
        const int c0 = u.pn * 128 + wc * 32 + 8 * fq;
        const f32x4 w0a = *(const f32x4*)(cw + c0), w0b = *(const f32x4*)(cw + c0 + 4), w1a = *(const f32x4*)(cw + 1024 + c0), w1b = *(const f32x4*)(cw + 1024 + c0 + 4),
                    w2a = *(const f32x4*)(cw + 2048 + c0), w2b = *(const f32x4*)(cw + 2048 + c0 + 4);
#pragma unroll
        for (int ai = 0; ai < 2; ++ai) { f32x4 gp0 = {0.f, 0.f, 0.f, 0.f}, gp1 = {0.f, 0.f, 0.f, 0.f}; const int blk = u.pm * 4 + ai * 2 + wr;
#pragma unroll
            for (int m = 0; m < 4; ++m) { const int row = u.pm * 256 + ai * 128 + wr * 64 + m * 16 + fr; const float rs = rstd_of(rowss, row); const float rs2 = rs * rs;
                const f32x4 g0 = acc[ai][0][m][0] * acc[ai][1][m][0] * rs2, g1 = acc[ai][0][m][1] * acc[ai][1][m][1] * rs2;
                f32x4 p1a, p2a, p1b, p2b;
#pragma unroll
                for (int j = 0; j < 4; ++j) { const float s1a = fr == 15 ? gp0[j] : g0[j], s2a = fr >= 14 ? gp0[j] : g0[j], s1b = fr == 15 ? gp1[j] : g1[j], s2b = fr >= 14 ? gp1[j] : g1[j];
                    p1a[j] = dpp_ror1(s1a); p2a[j] = dpp_ror2(s2a); p1b[j] = dpp_ror1(s1b); p2b[j] = dpp_ror2(s2b); }
                const f32x4 a0 = w0a * p2a + w1a * p1a + w2a * g0, a1 = w0b * p2b + w1b * p1b + w2b * g1;
                if (m > 0 || fr >= 2) { bf16* gp = gb + (size_t)row * 1024 + c0; const v4u gw = *(const v4u*)gp;
                    const f32x4 b0 = (f32x4){bflo(gw.x), bfhi(gw.x), bflo(gw.y), bfhi(gw.y)}, b1 = (f32x4){bflo(gw.z), bfhi(gw.z), bflo(gw.w), bfhi(gw.w)};
                    *(v4u*)gp = pack8(a0 * b0, a1 * b1); }
                if ((m & 1) == 0 && fr < 2) { float* sg = SG + (size_t)(blk * 8 + 2 * m + fr) * 1024 + c0; *(f32x4*)sg = g0; *(f32x4*)(sg + 4) = g1; }
                if ((m & 1) == 1 && fr >= 14) { float* sg = SG + (size_t)(blk * 8 + 2 * m + fr - 14) * 1024 + c0; *(f32x4*)sg = g0; *(f32x4*)(sg + 4) = g1; }
                gp0 = g0; gp1 = g1; } }
    }
};

__device__ __forceinline__ int rowmap(int mode, int n) {
    if (mode == 1) { if (n >= 512 && n < 1152) { const int d = n & 63; return (n & ~63) | (32 * ((d >> 4) & 1) + 8 * ((d >> 2) & 3) + 4 * (d >> 5) + (d & 3)); } return n; }
    if (mode == 2) { return n < DFF ? ((n >> 7) * 256 + (n & 127)) : (((n - DFF) >> 7) * 256 + 128 + ((n - DFF) & 127)); }
    if (mode == 3) { if (n < 1024) return n; const int c = (n - 1024) & 1023, z = n >= 2048 ? 1 : 0; return 1024 + (c >> 7) * 256 + z * 128 + (c & 127); }
    return n;
}
__device__ __forceinline__ void tr_item(const float* W, int K, int N, bf16* WT, const float* gain, float scale, int mode, LAS float* scr, int item, int lane) {
    const int nblk = N / 32, kb = item / nblk, nb = item % nblk, k0 = 64 * kb, n0 = 32 * nb;
#pragma unroll
    for (int i = 0; i < 8; ++i) { const int idx = lane + 64 * i, kk = idx >> 3, n4 = (idx & 7) * 4; const float gs = gain ? ((const GAS float*)gain)[k0 + kk] * scale : scale;
        const f32x4 w = *(const GAS f32x4*)((const GAS float*)W + (size_t)(k0 + kk) * N + n0 + n4); LAS float* d = scr + kk * 33 + n4; d[0] = w[0] * gs; d[1] = w[1] * gs; d[2] = w[2] * gs; d[3] = w[3] * gs; }
    LDS_WAIT(); asm volatile("" ::: "memory");
    const int c = lane & 7;
#pragma unroll
    for (int j = 0; j < 4; ++j) { const int n = (lane >> 3) + 8 * j; const LAS float* s = scr + (8 * c) * 33 + n;
        v4u o; o.x = pg8::cvt_pk_bf16(s[0 * 33], s[1 * 33]); o.y = pg8::cvt_pk_bf16(s[2 * 33], s[3 * 33]); o.z = pg8::cvt_pk_bf16(s[4 * 33], s[5 * 33]); o.w = pg8::cvt_pk_bf16(s[6 * 33], s[7 * 33]);
        *(GAS v4u*)((GAS bf16*)WT + (size_t)rowmap(mode, n0 + n) * K + k0 + 8 * c) = o; }
    LDS_WAIT(); asm volatile("" ::: "memory");
}
__device__ __forceinline__ double dexp_(double y) {
    const double k = rint(y * 1.4426950408889634); const double r = (y - k * 0.6931471803691238) - k * 1.9082149292705877e-10;
    double p = 1.0 / 6227020800.0;
    p = p * r + 1.0 / 479001600.0; p = p * r + 1.0 / 39916800.0; p = p * r + 1.0 / 3628800.0; p = p * r + 1.0 / 362880.0; p = p * r + 1.0 / 40320.0; p = p * r + 1.0 / 5040.0;
    p = p * r + 1.0 / 720.0; p = p * r + 1.0 / 120.0; p = p * r + 1.0 / 24.0; p = p * r + 1.0 / 6.0; p = p * r + 0.5; p = p * r + 1.0; p = p * r + 1.0;
    const long long bits = (long long)(1023 + (int)k) << 52; return p * __builtin_bit_cast(double, bits);
}
__device__ __forceinline__ void dsincos_(double x, double& s, double& c) {
    const double k = rint(x * 0.6366197723675814); const double r = (x - k * 1.5707963267948966) - k * 6.123233995736766e-17; const double r2 = r * r;
    const double sp = r * (1.0 + r2 * (-1.0 / 6.0 + r2 * (1.0 / 120.0 + r2 * (-1.0 / 5040.0 + r2 * (1.0 / 362880.0 + r2 * (-1.0 / 39916800.0 + r2 * (1.0 / 6227020800.0)))))));
    const double cp = 1.0 + r2 * (-0.5 + r2 * (1.0 / 24.0 + r2 * (-1.0 / 720.0 + r2 * (1.0 / 40320.0 + r2 * (-1.0 / 3628800.0 + r2 * (1.0 / 479001600.0 + r2 * (-1.0 / 87178291200.0)))))));
    const int q = ((int)k) & 3;
    s = q == 0 ? sp : q == 1 ? cp : q == 2 ? -sp : -cp; c = q == 0 ? cp : q == 1 ? -sp : q == 2 ? -cp : sp;
}

__device__ __forceinline__ const bf16* kvptr(const bf16* proj, const bf16* cb, int sample, int b, int c, int kvh, int kk, int isv) {
    if (!sample) { int pos = (c - 2) * 64 + kk; pos = pos < 0 ? 0 : pos; return proj + (size_t)(b * 4096 + pos) * 1280 + 1024 + isv * 128 + kvh * 64; }
    if (kk < 128) return cb + (size_t)(b * 128 + kk) * 128 + kvh * 64;
    int t = kk - 128; t = t > 31 ? 31 : t; return proj + (size_t)(MP + b * 32 + t) * 1280 + 1024 + isv * 128 + kvh * 64;
}
__device__ __forceinline__ void swa_phase(const bf16* proj, const bf16* ckb, const bf16* cvb, const float* sinks, bf16* ycat, LAS unsigned char* lds, int tid, int wave, int lane, int G) {
    LAS bf16* VT = (LAS bf16*)lds;
    const int fr = lane & 15, quad = lane >> 4;
    for (int it = blockIdx.x; it < 528; it += G) {
        int b, c, kvh, sample;
        if (it < 512) { sample = 0; b = it >> 7; c = (it >> 1) & 63; kvh = it & 1; } else { sample = 1; b = (it - 512) >> 1; c = 0; kvh = it & 1; }
        __syncthreads();
#pragma unroll
        for (int i = 0; i < 3; ++i) { const int idx = tid + 512 * i, kk = idx % 192, dg = idx / 192; const v4u w = *(const GAS v4u*)((const GAS bf16*)kvptr(proj, cvb, sample, b, c, kvh, kk, 1) + dg * 8);
            LAS bf16* vp = VT + (dg * 8) * 200 + kk;
            vp[0] = (bf16)(w.x & 0xffffu); vp[200] = (bf16)(w.x >> 16); vp[400] = (bf16)(w.y & 0xffffu); vp[600] = (bf16)(w.y >> 16);
            vp[800] = (bf16)(w.z & 0xffffu); vp[1000] = (bf16)(w.z >> 16); vp[1200] = (bf16)(w.w & 0xffffu); vp[1400] = (bf16)(w.w >> 16); }
        __syncthreads();
        const int gq = wave >> 1, qhalf = wave & 1, head = kvh * 4 + gq;
        if (!(sample && qhalf)) {
            const int plo = sample ? 0 : (c >= 2 ? 0 : (2 - c) * 2), phi = sample ? 5 : 6;
            bf16x8 qf[2][2];
#pragma unroll
            for (int qb = 0; qb < 2; ++qb) { const int q = qhalf * 32 + qb * 16 + fr; const int row = sample ? MP + b * 32 + (q & 31) : b * 4096 + c * 64 + q;
                const GAS bf16* qp = (const GAS bf16*)proj + (size_t)row * 1280 + 512 + head * 64 + quad * 8; qf[qb][0] = *(const GAS bf16x8*)qp; qf[qb][1] = *(const GAS bf16x8*)(qp + 32); }
            f32x4 s[12][2];
#pragma unroll
            for (int kg = 0; kg < 3; ++kg) { bf16x8 kf[4][2];
#pragma unroll
                for (int i = 0; i < 4; ++i) { const int kb = kg * 4 + i, key = 32 * (kb >> 1) + (fr >> 2) * 8 + 4 * (kb & 1) + (fr & 3); const GAS bf16* kp = (const GAS bf16*)kvptr(proj, ckb, sample, b, c, kvh, key, 0) + quad * 8;
                    kf[i][0] = *(const GAS bf16x8*)kp; kf[i][1] = *(const GAS bf16x8*)(kp + 32); }
                __builtin_amdgcn_sched_barrier(0);
#pragma unroll
                for (int i = 0; i < 4; ++i)
#pragma unroll
                    for (int qb = 0; qb < 2; ++qb) { f32x4 a = {0.f, 0.f, 0.f, 0.f}; a = MFMA16(kf[i][0], qf[qb][0], a); a = MFMA16(kf[i][1], qf[qb][1], a); s[kg * 4 + i][qb] = a; }
                __builtin_amdgcn_sched_barrier(0); }
            const float sink = sinks[head];
            bf16x8 pf[6][2];
#pragma unroll
            for (int qb = 0; qb < 2; ++qb) { float mx = sink;
#pragma unroll
                for (int kb = 0; kb < 12; ++kb) { const bool pv = (kb >> 1) >= plo && (kb >> 1) < phi;
#pragma unroll
                    for (int j = 0; j < 4; ++j) { const float v = pv ? s[kb][qb][j] : -1e30f; s[kb][qb][j] = v; mx = fmaxf(mx, v); } }
                mx = fmaxf(mx, __shfl_xor(mx, 16)); mx = fmaxf(mx, __shfl_xor(mx, 32));
                float sum = 0.f;
#pragma unroll
                for (int kb = 0; kb < 12; ++kb)
#pragma unroll
                    for (int j = 0; j < 4; ++j) { const float e = __expf(s[kb][qb][j] - mx); s[kb][qb][j] = e; sum += e; }
                sum += __shfl_xor(sum, 16); sum += __shfl_xor(sum, 32); sum += __expf(sink - mx);
                const float inv = 1.0f / sum;
#pragma unroll
                for (int pr = 0; pr < 6; ++pr) pf[pr][qb] = __builtin_bit_cast(bf16x8, pack8(s[2 * pr][qb] * inv, s[2 * pr + 1][qb] * inv)); }
#pragma unroll
            for (int db = 0; db < 4; ++db) { bf16x8 vf[6];
#pragma unroll
                for (int pr = 0; pr < 6; ++pr) vf[pr] = *(const LAS bf16x8*)(VT + (db * 16 + fr) * 200 + 32 * pr + quad * 8);
#pragma unroll
                for (int qb = 0; qb < 2; ++qb) { f32x4 o = {0.f, 0.f, 0.f, 0.f};
#pragma unroll
                    for (int pr = 0; pr < 6; ++pr) o = MFMA16(pf[pr][qb], vf[pr], o);
#pragma unroll
                    for (int j = 0; j < 4; ++j) { const int q = qhalf * 32 + qb * 16 + quad * 4 + j;
                        if (!sample || q < 32) { const int row = sample ? MP + b * 32 + q : b * 4096 + c * 64 + q; ycat[(size_t)row * 1024 + 512 + head * 64 + db * 16 + fr] = (bf16)f2bf(o[j]); } } } }
        }
    }
    __syncthreads();
}

__device__ __forceinline__ void xattn_phase(const bf16* qx, const bf16* memk_l, const bf16* memvT_l, bf16* ox, int wave, int lane, int G) {
    const int fr = lane & 15, quad = lane >> 4;
    for (int t = wave * G + (int)blockIdx.x; t < 4160; t += 8 * G) {
        int bb, h, row0;
        if (t < 4096) { const int pair = t >> 8; bb = pair >> 2; h = pair & 3; row0 = bb * 4096 + (t & 255) * 16; }
        else { const int s = t - 4096, b = s >> 3; h = (s >> 1) & 3; bb = 4 + b; row0 = MP + b * 32 + (s & 1) * 16; }
        bf16x8 qf[8];
#pragma unroll
        for (int ks = 0; ks < 8; ++ks) qf[ks] = *(const bf16x8*)(qx + (size_t)(row0 + fr) * 1024 + h * 256 + ks * 32 + quad * 8);
        const bf16* kbase = memk_l + (size_t)bb * 262144 + h * 256 + quad * 8;
        f32x4 s[16];
#pragma unroll
        for (int kb = 0; kb < 16; ++kb) { const int key = 32 * (kb >> 1) + (fr >> 2) * 8 + 4 * (kb & 1) + (fr & 3); const bf16* kp = kbase + (size_t)key * 1024; f32x4 a = {0.f, 0.f, 0.f, 0.f};
#pragma unroll
            for (int ks = 0; ks < 8; ++ks) a = MFMA16(*(const bf16x8*)(kp + ks * 32), qf[ks], a);
            s[kb] = a; }
        float mx = -1e30f;
#pragma unroll
        for (int kb = 0; kb < 16; ++kb)
#pragma unroll
            for (int j = 0; j < 4; ++j) mx = fmaxf(mx, s[kb][j]);
        mx = fmaxf(mx, __shfl_xor(mx, 16)); mx = fmaxf(mx, __shfl_xor(mx, 32));
        float sum = 0.f;
#pragma unroll
        for (int kb = 0; kb < 16; ++kb)
#pragma unroll
            for (int j = 0; j < 4; ++j) { const float e = __expf(s[kb][j] - mx); s[kb][j] = e; sum += e; }
        sum += __shfl_xor(sum, 16); sum += __shfl_xor(sum, 32);
        const float inv = 1.0f / sum;
        bf16x8 pf[8];
#pragma unroll
        for (int pr = 0; pr < 8; ++pr) pf[pr] = __builtin_bit_cast(bf16x8, pack8(s[2 * pr] * inv, s[2 * pr + 1] * inv));
        const bf16* vbase = memvT_l + (size_t)bb * 262144 + (size_t)(h * 256 + fr) * 256 + quad * 8;
#pragma unroll 4
        for (int db = 0; db < 16; ++db) { f32x4 o = {0.f, 0.f, 0.f, 0.f};
#pragma unroll
            for (int pr = 0; pr < 8; ++pr) o = MFMA16(pf[pr], *(const bf16x8*)(vbase + (size_t)db * 4096 + pr * 32), o);
#pragma unroll
            for (int j = 0; j < 4; ++j) ox[(size_t)(row0 + quad * 4 + j) * 1024 + h * 256 + db * 16 + fr] = (bf16)f2bf(o[j]); }
    }
}


__device__ __forceinline__ void xstage(const bf16* src, size_t rowstride, LAS unsigned char* lds, int tid) {
    v4u t[16];
#pragma unroll
    for (int i = 0; i < 16; ++i) { const int row = (tid >> 5) + 16 * i, ch = tid & 31; t[i] = *(const GAS v4u*)((const GAS bf16*)src + (size_t)row * rowstride + ch * 8); }
#pragma unroll
    for (int i = 0; i < 16; ++i) { const int row = (tid >> 5) + 16 * i, ch = tid & 31; *(LAS v4u*)(lds + row * 528 + ch * 16) = t[i]; }
}
__device__ __forceinline__ void xattn_phase2(const bf16* qx, const bf16* memk_l, const bf16* memvT_l, bf16* ox, LAS unsigned char* lds, int tid, int wave, int lane, int G) {
    const int fr = lane & 15, quad = lane >> 4;
    for (int it = blockIdx.x; it < 256 + 32; it += G) {
        int bb, h, rowbase, nqb; bool active;
        if (it < 256) { bb = it >> 6; h = (it >> 4) & 3; rowbase = bb * 4096 + (it & 15) * 256; nqb = 2; active = true; }
        else { const int s = it - 256, b = s >> 2; h = s & 3; bb = 4 + b; rowbase = MP + b * 32; nqb = 1; active = wave < 2; }
        __syncthreads();
        xstage(memk_l + (size_t)bb * 262144 + h * 256, 1024, lds, tid);
        __syncthreads();
        bf16x8 pf[2][8];
#pragma unroll
        for (int qi = 0; qi < 2; ++qi) {
            if (qi < nqb && active) {
                const int row0 = rowbase + qi * 128 + wave * 16;
                bf16x8 qf[8];
#pragma unroll
                for (int ks = 0; ks < 8; ++ks) qf[ks] = *(const GAS bf16x8*)((const GAS bf16*)qx + (size_t)(row0 + fr) * 1024 + h * 256 + ks * 32 + quad * 8);
                f32x4 s[16];
#pragma unroll
                for (int kb = 0; kb < 16; ++kb) { const int key = 32 * (kb >> 1) + (fr >> 2) * 8 + 4 * (kb & 1) + (fr & 3); const LAS unsigned char* kp = lds + key * 528 + quad * 16; f32x4 a = {0.f, 0.f, 0.f, 0.f};
#pragma unroll
                    for (int ks = 0; ks < 8; ++ks) a = MFMA16(*(const LAS bf16x8*)(kp + ks * 64), qf[ks], a);
                    s[kb] = a; }
                float mx = -1e30f;
#pragma unroll
                for (int kb = 0; kb < 16; ++kb)
#pragma unroll
                    for (int j = 0; j < 4; ++j) mx = fmaxf(mx, s[kb][j]);
                mx = fmaxf(mx, __shfl_xor(mx, 16)); mx = fmaxf(mx, __shfl_xor(mx, 32));
                float sum = 0.f;
#pragma unroll
                for (int kb = 0; kb < 16; ++kb)
#pragma unroll
                    for (int j = 0; j < 4; ++j) { const float e = __expf(s[kb][j] - mx); s[kb][j] = e; sum += e; }
                sum += __shfl_xor(sum, 16); sum += __shfl_xor(sum, 32);
                const float inv = 1.0f / sum;
#pragma unroll
                for (int pr = 0; pr < 8; ++pr) pf[qi][pr] = __builtin_bit_cast(bf16x8, pack8(s[2 * pr] * inv, s[2 * pr + 1] * inv));
            }
        }
        __syncthreads();
        xstage(memvT_l + (size_t)bb * 262144 + (size_t)h * 65536, 256, lds, tid);
        __syncthreads();
        if (active) {
            const int rowA = rowbase + wave * 16, rowB = rowA + 128;
#pragma unroll 4
            for (int db = 0; db < 16; ++db) { f32x4 oa = {0.f, 0.f, 0.f, 0.f}, ob = {0.f, 0.f, 0.f, 0.f}; const LAS unsigned char* vp = lds + (db * 16 + fr) * 528 + quad * 16;
                if (nqb == 2) {
#pragma unroll
                    for (int pr = 0; pr < 8; ++pr) { const bf16x8 vf = *(const LAS bf16x8*)(vp + pr * 64); oa = MFMA16(vf, pf[0][pr], oa); ob = MFMA16(vf, pf[1][pr], ob); }
                } else {
#pragma unroll
                    for (int pr = 0; pr < 8; ++pr) { const bf16x8 vf = *(const LAS bf16x8*)(vp + pr * 64); oa = MFMA16(vf, pf[0][pr], oa); }
                }
                u32x2v w; w.x = pk2(oa[0], oa[1]); w.y = pk2(oa[2], oa[3]);
                *(GAS u32x2v*)((GAS bf16*)ox + (size_t)(rowA + fr) * 1024 + h * 256 + db * 16 + quad * 4) = w;
                if (nqb == 2) { u32x2v w2; w2.x = pk2(ob[0], ob[1]); w2.y = pk2(ob[2], ob[3]); *(GAS u32x2v*)((GAS bf16*)ox + (size_t)(rowB + fr) * 1024 + h * 256 + db * 16 + quad * 4) = w2; } }
        }
    }
    __syncthreads();
}

__device__ __forceinline__ void s5_stage_u(const bf16* up, LAS float* ubuf, int lane) {
    const v4u w0 = *(const v4u*)up, w1 = *(const v4u*)(up + 8);
    LAS f32x4* d = (LAS f32x4*)(ubuf + lane * 16);
    d[0] = (f32x4){bflo(w0.x), bfhi(w0.x), bflo(w0.y), bfhi(w0.y)}; d[1] = (f32x4){bflo(w0.z), bfhi(w0.z), bflo(w0.w), bfhi(w0.w)};
    d[2] = (f32x4){bflo(w1.x), bfhi(w1.x), bflo(w1.y), bfhi(w1.y)}; d[3] = (f32x4){bflo(w1.z), bfhi(w1.z), bflo(w1.w), bfhi(w1.w)};
}
__device__ __forceinline__ f32x2v lo2_(f32x4 v) { return __builtin_shufflevector(v, v, 0, 1); }
__device__ __forceinline__ f32x2v hi2_(f32x4 v) { return __builtin_shufflevector(v, v, 2, 3); }
#define S5_STEP(sidx) do { const LAS f32x4* up_ = (const LAS f32x4*)(ubuf + (sidx) * 16); const f32x4 u0 = up_[0], u1 = up_[1], u2 = up_[2], u3 = up_[3]; \
    f32x2v ac_ = lo2_(bb[0]) * u0[0]; ac_ = hi2_(bb[0]) * u0[1] + ac_; ac_ = lo2_(bb[1]) * u0[2] + ac_; ac_ = hi2_(bb[1]) * u0[3] + ac_; \
    ac_ = lo2_(bb[2]) * u1[0] + ac_; ac_ = hi2_(bb[2]) * u1[1] + ac_; ac_ = lo2_(bb[3]) * u1[2] + ac_; ac_ = hi2_(bb[3]) * u1[3] + ac_; \
    ac_ = lo2_(bb[4]) * u2[0] + ac_; ac_ = hi2_(bb[4]) * u2[1] + ac_; ac_ = lo2_(bb[5]) * u2[2] + ac_; ac_ = hi2_(bb[5]) * u2[3] + ac_; \
    ac_ = lo2_(bb[6]) * u3[0] + ac_; ac_ = hi2_(bb[6]) * u3[1] + ac_; ac_ = lo2_(bb[7]) * u3[2] + ac_; ac_ = hi2_(bb[7]) * u3[3] + ac_; \
    const float nr_ = ar * hr - ai * hi + ac_.x, ni_ = ar * hi + ai * hr + ac_.y; hr = nr_; hi = ni_; } while (0)

typedef short bf16x4_t __attribute__((ext_vector_type(4)));
#define MFMA16K16(a, b, c) __builtin_amdgcn_mfma_f32_16x16x16bf16_1k(a, b, c, 0, 0, 0)
__device__ __forceinline__ void s5_bu_block(const bf16* urow0, const bf16x4_t (&bcf)[8], LAS float* bul, int fr, int quad) {
    const bf16x4_t a = *(const GAS bf16x4_t*)((const GAS bf16*)urow0 + (size_t)fr * 1280 + quad * 4);
#pragma unroll
    for (int cb = 0; cb < 8; ++cb) { f32x4 d = {0.f, 0.f, 0.f, 0.f}; d = MFMA16K16(a, bcf[cb], d);
#pragma unroll
        for (int j = 0; j < 4; ++j) bul[(quad * 4 + j) * 130 + cb * 16 + fr] = d[j]; }
}
__device__ __forceinline__ void s5_local(const bf16* proj, const float* abar, const bf16* bbt, float* sloc, LAS float* bul, int slot, int nslots, int lane) {
    const int fr = lane & 15, quad = lane >> 4;
    for (int t = slot; t < 8192; t += nslots) {
        const int chunk = t & 63, g = (t >> 6) & 31, b = t >> 11;
        const float ar = abar[(g * 64 + lane) * 2], ai = abar[(g * 64 + lane) * 2 + 1];
        bf16x4_t bcf[8];
#pragma unroll
        for (int cb = 0; cb < 8; ++cb) bcf[cb] = *(const GAS bf16x4_t*)((const GAS bf16*)bbt + (size_t)(g * 128 + cb * 16 + fr) * 16 + quad * 4);
        float hr = 0.f, hi = 0.f;
        for (int blk = 0; blk < 4; ++blk) {
            s5_bu_block(proj + (size_t)(b * 4096 + chunk * 64 + blk * 16) * 1280 + g * 16, bcf, bul, fr, quad);
#pragma unroll 4
            for (int s = 0; s < 16; ++s) { const f32x2v bu = *(const LAS f32x2v*)(bul + s * 130 + 2 * lane); const float nr = ar * hr - ai * hi + bu.x, ni = ar * hi + ai * hr + bu.y; hr = nr; hi = ni; }
        }
        *(f32x2v*)(sloc + (size_t)t * 128 + lane * 2) = (f32x2v){hr, hi};
    }
}
__device__ __forceinline__ void s5_out(const bf16* proj, const float* abar, const bf16* bbt, const float* sloc, const float* st_re, const float* st_im, const float* c_re, const float* c_im,
                                       const float* dcoef, bf16* gbuf, float* out, LAS float* bul, LAS unsigned* hbuf, int slot, int nslots, int lane) {
    const int fr = lane & 15, quad = lane >> 4;
    for (int t = slot; t < 8192 + 256; t += nslots) {
        const int sample = t >= 8192; int b, g, chunk, nblk, rowbase;
        if (!sample) { chunk = t & 63; g = (t >> 6) & 31; b = t >> 11; nblk = 4; rowbase = b * 4096 + chunk * 64; } else { const int s = t - 8192; g = s & 31; b = s >> 5; chunk = 0; nblk = 2; rowbase = MP + b * 32; }
        const float ar = abar[(g * 64 + lane) * 2], ai = abar[(g * 64 + lane) * 2 + 1];
        bf16x4_t bcf[8];
#pragma unroll
        for (int cb = 0; cb < 8; ++cb) bcf[cb] = *(const GAS bf16x4_t*)((const GAS bf16*)bbt + (size_t)(g * 128 + cb * 16 + fr) * 16 + quad * 4);
        float hr, hi;
        if (!sample) { float pr = ar, pi = ai;
#pragma unroll
            for (int i = 0; i < 6; ++i) { const float t1 = pr * pr - pi * pi; pi = 2.f * pr * pi; pr = t1; }
            hr = 0.f; hi = 0.f; const float* sp = sloc + (size_t)(t - chunk) * 128 + lane * 2;
#pragma unroll 16
            for (int cc = 0; cc < chunk; ++cc) { const f32x2v sv = *(const f32x2v*)(sp + (size_t)cc * 128); const float nr = pr * hr - pi * hi + sv.x, ni = pr * hi + pi * hr + sv.y; hr = nr; hi = ni; } }
        else { hr = st_re[(b * 32 + g) * 64 + lane]; hi = st_im[(b * 32 + g) * 64 + lane]; }
        bf16x8 cf[4];
#pragma unroll
        for (int ks = 0; ks < 4; ++ks) { const f32x4 cr = *(const f32x4*)(c_re + (size_t)(g * 16 + fr) * 64 + ks * 16 + quad * 4), ci = *(const f32x4*)(c_im + (size_t)(g * 16 + fr) * 64 + ks * 16 + quad * 4);
            v4u w; w.x = pg8::cvt_pk_bf16(cr[0], -ci[0]); w.y = pg8::cvt_pk_bf16(cr[1], -ci[1]); w.z = pg8::cvt_pk_bf16(cr[2], -ci[2]); w.w = pg8::cvt_pk_bf16(cr[3], -ci[3]); cf[ks] = __builtin_bit_cast(bf16x8, w); }
        const float dco = dcoef[g * 16 + fr];
        for (int blk = 0; blk < nblk; ++blk) {
            const bf16* urow0 = proj + (size_t)(rowbase + blk * 16) * 1280 + g * 16;
            s5_bu_block(urow0, bcf, bul, fr, quad);
#pragma unroll 4
            for (int s = 0; s < 16; ++s) { const f32x2v bu = *(const LAS f32x2v*)(bul + s * 130 + 2 * lane); const float nr = ar * hr - ai * hi + bu.x, ni = ar * hi + ai * hr + bu.y; hr = nr; hi = ni; hbuf[s * 68 + lane] = pg8::cvt_pk_bf16(hr, hi); }
            f32x4 y = {0.f, 0.f, 0.f, 0.f};
#pragma unroll
            for (int ks = 0; ks < 4; ++ks) { const bf16x8 a = *(const LAS bf16x8*)(hbuf + fr * 68 + ks * 16 + quad * 4); y = MFMA16(a, cf[ks], y); }
#pragma unroll
            for (int j = 0; j < 4; ++j) { const int s = blk * 16 + quad * 4 + j; const float uu = bflo((unsigned)((const GAS bf16*)urow0)[(size_t)(quad * 4 + j) * 1280 + fr]); const float yv = y[j] + dco * uu;
                const float z = 0.7978845608028654f * (yv + 0.044715f * yv * yv * yv); const float th = 1.0f - 2.0f / (1.0f + __expf(2.0f * z)); const float gl = 0.5f * yv * (1.0f + th);
                ((GAS bf16*)gbuf)[(size_t)(rowbase + s) * 512 + g * 16 + fr] = (bf16)f2bf(gl); }
        }
        if (!sample && chunk == 63) { out[OFF_SRP + (b * 32 + g) * 64 + lane] = hr; out[OFF_SIP + (b * 32 + g) * 64 + lane] = hi; }
        if (sample) { out[OFF_SRS + (b * 32 + g) * 64 + lane] = hr; out[OFF_SIS + (b * 32 + g) * 64 + lane] = hi; }
    }
}

template <int KIND>
__device__ __forceinline__ void sample_gemm(const bf16* A, const bf16* Bt, int K, LAS unsigned char* lds, int tid, int wave, int lane,
                                            bf16* xbp, const float* base_f32, float* part_next, const float* part_cur, bf16* O) {
    const int fr = lane & 15, quad = lane >> 4;
    LAS f32x4* red = (LAS f32x4*)lds;
    LAS float* ssred = (LAS float*)(lds + 32768);
    for (int tile = blockIdx.x; tile < 256; tile += gridDim.x) {
        const int r0 = MP + (tile >> 4) * 16, c0 = (tile & 15) * 64, kw = K >> 3;
        const bf16* ap = A + (size_t)(r0 + fr) * K + wave * kw + quad * 8;
        const bf16* bp = Bt + (size_t)(c0 + fr) * K + wave * kw + quad * 8;
        f32x4 acc[4];
#pragma unroll
        for (int cb = 0; cb < 4; ++cb) acc[cb] = (f32x4){0.f, 0.f, 0.f, 0.f};
        const int nks = kw >> 5;
        for (int k0 = 0; k0 < nks; k0 += 4) {
            bf16x8 a[4], b[4][4];
#pragma unroll
            for (int i = 0; i < 4; ++i) { const int ks = (k0 + i < nks) ? k0 + i : nks - 1;
                a[i] = *(const bf16x8*)(ap + ks * 32);
#pragma unroll
                for (int cb = 0; cb < 4; ++cb) b[i][cb] = *(const bf16x8*)(bp + (size_t)cb * 16 * K + ks * 32); }
            __builtin_amdgcn_sched_barrier(0);
#pragma unroll
            for (int i = 0; i < 4; ++i) if (k0 + i < nks) {
#pragma unroll
                for (int cb = 0; cb < 4; ++cb) acc[cb] = MFMA16(b[i][cb], a[i], acc[cb]); }
        }
#pragma unroll
        for (int cb = 0; cb < 4; ++cb) red[(wave * 4 + cb) * 64 + lane] = acc[cb] * 1.0f;
        __syncthreads();
        if (tid < 256) { const int cb = tid >> 6, l2 = tid & 63; f32x4 v = red[cb * 64 + l2];
#pragma unroll
            for (int w = 1; w < 8; ++w) v = v + red[(w * 4 + cb) * 64 + l2];
            const int row = r0 + (l2 & 15), col = c0 + cb * 16 + 4 * (l2 >> 4); const size_t off = (size_t)row * 1024 + col;
            if (KIND == 0) { f32x4 bs;
                if (base_f32) bs = *(const f32x4*)(base_f32 + off);
                else { const u32x2v w = *(const u32x2v*)(xbp + off); bs = (f32x4){bflo(w.x), bfhi(w.x), bflo(w.y), bfhi(w.y)}; }
                v = v + bs; u32x2v o; o.x = pk2(v[0], v[1]); o.y = pk2(v[2], v[3]); *(u32x2v*)(xbp + off) = o;
                float ss = (v[0] * v[0] + v[1] * v[1]) + (v[2] * v[2] + v[3] * v[3]); ss += __shfl_xor(ss, 16); ss += __shfl_xor(ss, 32);
                if ((l2 >> 4) == 0) ssred[cb * 16 + (l2 & 15)] = ss; }
            else { const float rs = rstd_of(part_cur, row); u32x2v o; o.x = pk2(v[0] * rs, v[1] * rs); o.y = pk2(v[2] * rs, v[3] * rs); *(u32x2v*)(O + off) = o; }
        }
        if (KIND == 0) { __syncthreads(); if (tid < 16) part_next[(size_t)(r0 + tid) * 16 + (tile & 15)] = (ssred[tid] + ssred[16 + tid]) + (ssred[32 + tid] + ssred[48 + tid]); }
        __syncthreads();
    }
}


__device__ __forceinline__ void sample_cz(const bf16* A, const bf16* Bt, LAS unsigned char* lds, int tid, int wave, int lane,
                                          const float* part_cur, const float* cw, const float* st, bf16* zcp, float* outp) {
    const int fr = lane & 15, quad = lane >> 4;
    LAS f32x4* red = (LAS f32x4*)lds;
    LAS float* T = (LAS float*)(lds + 65536);
    LAS float* CZ = (LAS float*)(lds + 65536 + 8192);
    for (int tile = blockIdx.x; tile < 256; tile += gridDim.x) {
        const int b = tile >> 5, c0 = (tile & 31) * 32, r0 = MP + b * 32;
        const int wrow = 1024 + (c0 >> 7) * 256 + (c0 & 127);
        const GAS bf16* ap = (const GAS bf16*)A + (size_t)(r0 + fr) * 1024 + wave * 128 + quad * 8;
        const GAS bf16* bp = (const GAS bf16*)Bt + (size_t)(wrow + fr) * 1024 + wave * 128 + quad * 8;
        bf16x8 a[4][2], bw[4][4];
#pragma unroll
        for (int ks = 0; ks < 4; ++ks) {
#pragma unroll
            for (int rb = 0; rb < 2; ++rb) a[ks][rb] = *(const GAS bf16x8*)(ap + (size_t)rb * 16 * 1024 + ks * 32);
#pragma unroll
            for (int cb = 0; cb < 4; ++cb) bw[ks][cb] = *(const GAS bf16x8*)(bp + (size_t)((cb >> 1) * 128 + (cb & 1) * 16) * 1024 + ks * 32); }
        f32x4 acc[2][4];
#pragma unroll
        for (int rb = 0; rb < 2; ++rb)
#pragma unroll
            for (int cb = 0; cb < 4; ++cb) { f32x4 d = {0.f, 0.f, 0.f, 0.f};
#pragma unroll
                for (int ks = 0; ks < 4; ++ks) d = MFMA16(bw[ks][cb], a[ks][rb], d);
                acc[rb][cb] = d; }
#pragma unroll
        for (int rb = 0; rb < 2; ++rb)
#pragma unroll
            for (int cb = 0; cb < 4; ++cb) red[(wave * 8 + rb * 4 + cb) * 64 + lane] = acc[rb][cb];
        __syncthreads();
        {
            const int blk = tid >> 6, l2 = tid & 63, rb = blk >> 2, cb = blk & 3; f32x4 v = red[blk * 64 + l2];
#pragma unroll
            for (int w = 1; w < 8; ++w) v = v + red[(w * 8 + blk) * 64 + l2];
            *(LAS f32x4*)(T + ((cb >> 1) * 32 + rb * 16 + (l2 & 15)) * 32 + (cb & 1) * 16 + 4 * (l2 >> 4)) = v; }
        __syncthreads();
        const int r = tid >> 3, cq = (tid & 7) * 4;
        if (tid < 256) { const float rs = rstd_of(part_cur, r0 + r); const float rs2 = rs * rs;
            const f32x4 gc = *(const LAS f32x4*)(T + r * 32 + cq), zz = *(const LAS f32x4*)(T + (32 + r) * 32 + cq);
            *(LAS f32x4*)(CZ + r * 32 + cq) = gc * zz * rs2; }
        __syncthreads();
        if (tid < 256) { const int c = c0 + cq;
            const f32x4 x0 = *(const LAS f32x4*)(CZ + r * 32 + cq);
            const f32x4 s0 = *(const f32x4*)(st + (size_t)(b * 2) * 1024 + c), s1 = *(const f32x4*)(st + (size_t)(b * 2 + 1) * 1024 + c);
            f32x4 xm1 = s1, xm2 = s0;
            if (r >= 1) { xm1 = *(const LAS f32x4*)(CZ + (r - 1) * 32 + cq); xm2 = s1; }
            if (r >= 2) xm2 = *(const LAS f32x4*)(CZ + (r - 2) * 32 + cq);
            const f32x4 w0 = *(const f32x4*)(cw + c), w1 = *(const f32x4*)(cw + 1024 + c), w2 = *(const f32x4*)(cw + 2048 + c);
            const f32x4 z = w0 * xm2 + w1 * xm1 + w2 * x0;
            bf16* gp = zcp + (size_t)(r0 + r) * 1024 + c; const u32x2v gw = *(const u32x2v*)gp;
            u32x2v o; o.x = pk2(z[0] * bflo(gw.x), z[1] * bfhi(gw.x)); o.y = pk2(z[2] * bflo(gw.y), z[3] * bfhi(gw.y)); *(u32x2v*)gp = o;
            if (r >= 30) *(f32x4*)(outp + OFF_CMS + (size_t)(b * 2 + (r - 30)) * 1024 + c) = x0; }
        __syncthreads();
    }
}

struct Params { const float* in[36]; float* out; unsigned char* ws; int use_cg, pad; };

__global__ void __launch_bounds__(512, 2) mega_fwd(Params P) {
    extern __shared__ __attribute__((aligned(16))) unsigned char lds_raw[];
    LAS unsigned char* lds = (LAS unsigned char*)lds_raw;
    volatile LAS unsigned* MISC = (volatile LAS unsigned*)(lds + MISC_OFF);
    const int G = gridDim.x, NGW = G * 8, NT = G * 512;
    const int wave_s = __builtin_amdgcn_readfirstlane(threadIdx.x >> 6);
    for (int u = threadIdx.x; u < (LDS_BYTES - 131072) / 4; u += 512) ((LAS unsigned*)(lds + 131072))[u] = 0u;
    __syncthreads();
    XcdBarrier bar = xcd_barrier_post((unsigned*)(P.ws + WS_BAR), MISC + 8);
#ifndef STOP_AFTER
#define STOP_AFTER 1000
#endif
    int ph = 0;
#define RUN (ph < STOP_AFTER)
#define FRESH() const int tid = fresh_tid(wave_s), lane = tid & 63, wave = __builtin_amdgcn_readfirstlane(tid >> 6); const int gw = blockIdx.x * 8 + wave, gt = blockIdx.x * 512 + tid; (void)gw; (void)gt; (void)lane; LAS float* wscr = (LAS float*)(lds + 32768 + wave * 12288); (void)wscr;
#define SEAM() do { if (P.use_cg) cg::this_grid().sync(); else xcd_barrier(bar); ++ph; } while (0)

#define part ((float*)(ws + WS_PART))
#define PARTBUF(k) (part + (size_t)((k) & 1) * PART_ELEMS)
#define ropec ((float*)(ws + WS_ROPE))
#define ropes (ropec + 4096 * 32)
#define abar ((float*)(ws + WS_SSM))
#define bbar (abar + 32 * 64 * 2)
#define bbt ((bf16*)(bbar + 32 * 64 * 32))
#define ckb ((bf16*)(ws + WS_CKV))
#define cvb (ckb + 8 * 128 * 128)
#define sloc ((float*)(ws + WS_SLOC))
#define memk ((bf16*)(ws + WS_MEMK))
#define memvT ((bf16*)(ws + WS_MEMVT))
#define SG ((float*)(ws + WS_SIDE))
#define SV ((float*)(ws + WS_SIDE + SG_BYTES))
#define WT ((bf16*)(ws + WS_WT))
#define xb ((bf16*)(ws + WS_XB))
#define tmp (ws + WS_TMP)
#define proj0 ((bf16*)(tmp + TMP_PROJ0))
#define gbuf ((bf16*)(tmp + TMP_GBUF))
#define ycat ((bf16*)(tmp + TMP_YCAT))
#define memb ((bf16*)(tmp + TMP_MEMB))
#define qx ((bf16*)(tmp + TMP_QX))
#define ox ((bf16*)(tmp + TMP_OX))
#define act ((bf16*)(tmp + TMP_ACT))
#define gbm ((bf16*)(tmp + TMP_GB))
#define zc ((bf16*)(tmp + TMP_ZC))
#define PTRS() unsigned char* ws = P.ws; float* out = P.out; asm volatile("" : "+s"(ws), "+s"(out));
    if (RUN) { PTRS() FRESH()
        {
            constexpr int NITEMS = 640 + 128 + 512 + 512 + 2 * 1024 + 512 + 2816 + 1408 + 2048;
            for (int it = gw; it < NITEMS; it += NGW) { int r = it;
#define TR(Wp, K_, N_, WTp, gainp, sc, mode) { const int ni_ = ((K_) / 64) * ((N_) / 32); if (r < ni_) { tr_item(Wp, K_, N_, WTp, gainp, sc, mode, wscr, r, lane); continue; } r -= ni_; }
                TR(P.in[15], 1024, 1280, WT + WT_INEVEN, P.in[11], 1.f, 1)
                TR(P.in[25], 512, 512, WT + WT_GLU, nullptr, 1.f, 0)
                TR(P.in[16], 1024, 1024, WT + WT_OUTEVEN, nullptr, 1.f, 0)
                TR(P.in[30], 1024, 1024, WT + WT_WQ, P.in[12], 0.0625f, 0)
                TR(P.in[31], 1024, 2048, WT + WT_WKV, nullptr, 1.f, 0)
                TR(P.in[31] + 2097152, 1024, 2048, WT + WT_WKV + 2097152, nullptr, 1.f, 0)
                TR(P.in[32], 1024, 1024, WT + WT_WO, nullptr, 1.f, 0)
                TR(P.in[33], 1024, 5632, WT + WT_UP, P.in[13], 1.f, 2)
                TR(P.in[35], 2816, 1024, WT + WT_DOWN, nullptr, 1.f, 0)
                { const int mi = r >> 7, l = mi >> 3, b = mi & 7; tr_item(P.in[10] + (size_t)mi * 262144, 256, 1024, memvT + (size_t)(l * 12 + 4 + b) * 262144, nullptr, 1.f, 0, wscr, r & 127, lane); }
            }
        }
        for (int m = gw; m < MROWS; m += NGW) { const float* xr = m < MP ? P.in[0] + (size_t)m * 1024 : P.in[1] + (size_t)(m - MP) * 1024; float ss = 0.f;
#pragma unroll
            for (int j = 0; j < 4; ++j) { const f32x4 v = *(const f32x4*)(xr + (lane + 64 * j) * 4); ss += (v[0] * v[0] + v[1] * v[1]) + (v[2] * v[2] + v[3] * v[3]);
                u32x2v w; w.x = pg8::cvt_pk_bf16(v[0], v[1]); w.y = pg8::cvt_pk_bf16(v[2], v[3]); *(u32x2v*)(xb + (size_t)m * 1024 + (lane + 64 * j) * 4) = w; }
            ss = wave_sum(ss); if (lane < 16) PARTBUF(0)[(size_t)m * 16 + lane] = lane == 0 ? ss : 0.f; }
        for (int i = gt; i < 262144; i += NT) { const f32x4 v = *(const f32x4*)(P.in[2] + (size_t)i * 4); u32x2v w; w.x = pg8::cvt_pk_bf16(v[0], v[1]); w.y = pg8::cvt_pk_bf16(v[2], v[3]); *(u32x2v*)(memb + (size_t)i * 4) = w; }
        for (int i = gt; i < 1048576; i += NT) { const size_t e = (size_t)i * 4; const int lb = (int)(e >> 18), l = lb >> 3, b = lb & 7; const f32x4 v = *(const f32x4*)(P.in[9] + e);
            u32x2v w; w.x = pg8::cvt_pk_bf16(v[0], v[1]); w.y = pg8::cvt_pk_bf16(v[2], v[3]); *(u32x2v*)(memk + (size_t)(l * 12 + 4 + b) * 262144 + (e & 262143)) = w; }
        for (int i = gt; i < 65536; i += NT) { const int j = i & 32767; const float* src = (i < 32768 ? P.in[3] : P.in[4]) + (size_t)j * 4; bf16* dst = (i < 32768 ? ckb : cvb) + (size_t)j * 4;
            const f32x4 v = *(const f32x4*)src; u32x2v w; w.x = pg8::cvt_pk_bf16(v[0], v[1]); w.y = pg8::cvt_pk_bf16(v[2], v[3]); *(u32x2v*)dst = w; }
        for (int i = gt; i < 4096 * 32; i += NT) { const int pos = i >> 5, d = i & 31; const double inv = dexp_(-(double)d * (9.210340371976184 / 32.0)); double s, c; dsincos_((double)pos * inv, s, c); ropec[i] = (float)c; ropes[i] = (float)s; }
        for (int i = gt; i < 2048; i += NT) { const double are = P.in[17][i], aim = P.in[18][i], dt = dexp_((double)P.in[19][i]); double s, c; dsincos_(aim * dt, s, c); const double mag = dexp_(are * dt);
            const double br = mag * c, bi = mag * s; abar[2 * i] = (float)br; abar[2 * i + 1] = (float)bi;
            const double nr = br - 1.0, ni = bi, den = are * are + aim * aim; const double qr = (nr * are + ni * aim) / den, qi = (ni * are - nr * aim) / den;
#pragma unroll 4
            for (int h = 0; h < 16; ++h) { const double xr = P.in[20][(size_t)i * 16 + h], xi = P.in[21][(size_t)i * 16 + h]; const float fre = (float)(qr * xr - qi * xi), fim = (float)(qr * xi + qi * xr); bbar[(size_t)i * 32 + 2 * h] = fre; bbar[(size_t)i * 32 + 2 * h + 1] = fim;
                bbt[((size_t)i * 2) * 16 + h] = (bf16)f2bf(fre); bbt[((size_t)i * 2 + 1) * 16 + h] = (bf16)f2bf(fim); } }
    }
    SEAM();
    if (RUN) { PTRS()
        if (G < 128 || (int)blockIdx.x >= G - 64) { pg8::Gemm g{memb, WT + WT_WKV, 1024, 4096, 1024}; pg8::StaticOrder S;
            if (G < 128) S.init(1024, 4096, G, (int)blockIdx.x); else S.init(1024, 4096, 64, (int)blockIdx.x - (G - 64)); EpiKV E{out, memk};
          pg8::gemm_phase<EpiKV, pg8::StaticOrder, true, true>(lds, g, S, E, wave_s); }
        { pg8::Gemm g{xb, WT + WT_INEVEN, MROWS, 1280, 1024}; pg8::StaticOrderF S; S.init(MROWS, 1280, G, (int)blockIdx.x); EpiIn0 E{proj0, PARTBUF(0), ropec, ropes, out};
          pg8::gemm_phase<EpiIn0, pg8::StaticOrderF, true, true>(lds, g, S, E, wave_s); }
        {
            FRESH()
            const int bx = (int)blockIdx.x, n2 = 325 - G;
            int slot = -1, nw = 1;
            if (G == 256) { if (bx >= n2 && bx < G - 64) { slot = (bx - n2) * 8 + wave; nw = (G - 64 - n2) * 8; } } else { slot = gw; nw = NGW; }
            if (slot >= 0) for (int it = slot; it < 2816 + 1408; it += nw) { int r = it;
                TR(P.in[33] + (size_t)1024 * 5632, 1024, 5632, WT + WT_UP + (size_t)5632 * 1024, P.in[13] + 1024, 1.f, 2)
                tr_item(P.in[35] + (size_t)2816 * 1024, 2816, 1024, WT + WT_DOWN + (size_t)2816 * 1024, nullptr, 1.f, 0, wscr, r, lane); }
        }
    }
    SEAM();
    if (RUN) { PTRS() FRESH()
        swa_phase(proj0, ckb, cvb, P.in[26], ycat, lds, tid, wave, lane, G);
        s5_local(proj0, abar, bbt, sloc, wscr, wave * G + (int)blockIdx.x, NGW, lane);
        for (int it = wave * G + (int)blockIdx.x; it < 1024; it += NGW) { const int mi = it >> 7, l = mi >> 2, b = mi & 3;
            tr_item(out + OFF_MVP + (size_t)mi * 262144, 256, 1024, memvT + (size_t)(l * 12 + b) * 262144, nullptr, 1.f, 0, wscr, it & 127, lane); }
    }
    SEAM();
    if (RUN) { PTRS() FRESH() s5_out(proj0, abar, bbt, sloc, P.in[5], P.in[6], P.in[22], P.in[23], P.in[24], gbuf, out, (LAS float*)(lds + wave * 16384), (LAS unsigned*)(lds + wave * 16384 + 8448), wave * G + (int)blockIdx.x, NGW, lane); }
    SEAM();
    if (RUN) { PTRS() pg8::Gemm g{gbuf, WT + WT_GLU, MROWS, 512, 512}; pg8::StaticOrder S; S.init(MROWS, 512, G, (int)blockIdx.x); EpiGlu E{gbuf, ycat};
        pg8::gemm_phase<EpiGlu, pg8::StaticOrder, true, true>(lds, g, S, E, wave_s);
        {
            FRESH()
            const int bx = (int)blockIdx.x; int slot = -1, nw = 1;
            if (G > 130) { if (bx >= 130) { slot = (bx - 130) * 8 + wave; nw = (G - 130) * 8; } } else { slot = gw; nw = NGW; }
            if (slot >= 0) for (int it = slot; it < 1536 + 512; it += nw) { int r = it;
                TR(P.in[27], 1024, 3072, WT + WT_INODD, P.in[11] + 1024, 1.f, 3)
                tr_item(P.in[29], 1024, 1024, WT + WT_OUTODD, nullptr, 1.f, 0, wscr, r, lane); }
        } }
    SEAM();

#pragma unroll
    for (int l = 0; l < 2; ++l) {
        if (l == 1) {
            if (RUN) { PTRS() pg8::Gemm g{xb, WT + WT_INODD, MP, 1024, 1024}; pg8::StaticOrderF S; S.init(MP, 1024, G, (int)blockIdx.x); EpiBf16 E{gbm, 1024, PARTBUF(3)};
                pg8::gemm_phase<EpiBf16, pg8::StaticOrderF, true, true>(lds, g, S, E, wave_s);
                { FRESH() sample_gemm<1>(xb, WT + WT_INODD, 1024, lds, tid, wave, lane, nullptr, nullptr, nullptr, PARTBUF(3), gbm); } }
            SEAM();
            if (RUN) { PTRS() pg8::Gemm g{xb, WT + WT_INODD + (size_t)1024 * 1024, MP, 2048, 1024}; pg8::StaticOrderF S; S.init(MP, 2048, G, (int)blockIdx.x); EpiCz E{gbm, PARTBUF(3), P.in[28], SG};
                pg8::gemm_phase<EpiCz, pg8::StaticOrderF, true, true>(lds, g, S, E, wave_s);
                { FRESH() sample_cz(xb, WT + WT_INODD, lds, tid, wave, lane, PARTBUF(3), P.in[28], P.in[7], gbm, out); } }
            SEAM();
            if (RUN) { PTRS() FRESH()
                const float* cw = P.in[28];
                for (int i = gt; i < 512 * 128; i += NT) { const int ri = i >> 7, c0 = (i & 127) * 8, blk = ri >> 1, rr = ri & 1, row = blk * 64 + rr;
                    f32x4 pa0, pa1, pb0, pb1;
                    if ((blk & 63) == 0) { pa0 = pa1 = pb0 = pb1 = (f32x4){0.f, 0.f, 0.f, 0.f}; }
                    else { const float* s0 = SG + (size_t)((blk - 1) * 8 + 6) * 1024 + c0; pa0 = *(const f32x4*)s0; pa1 = *(const f32x4*)(s0 + 4); pb0 = *(const f32x4*)(s0 + 1024); pb1 = *(const f32x4*)(s0 + 1028); }
                    const float* sc = SG + (size_t)(blk * 8) * 1024 + c0; const f32x4 x00 = *(const f32x4*)sc, x01 = *(const f32x4*)(sc + 4);
                    f32x4 xm2a, xm2b, xm1a, xm1b, xca, xcb;
                    if (rr == 0) { xm2a = pa0; xm2b = pa1; xm1a = pb0; xm1b = pb1; xca = x00; xcb = x01; }
                    else { xm2a = pb0; xm2b = pb1; xm1a = x00; xm1b = x01; xca = *(const f32x4*)(sc + 1024); xcb = *(const f32x4*)(sc + 1028); }
                    const f32x4 w0a = *(const f32x4*)(cw + c0), w0b = *(const f32x4*)(cw + c0 + 4), w1a = *(const f32x4*)(cw + 1024 + c0), w1b = *(const f32x4*)(cw + 1028 + c0), w2a = *(const f32x4*)(cw + 2048 + c0), w2b = *(const f32x4*)(cw + 2052 + c0);
                    const f32x4 z0 = w0a * xm2a + w1a * xm1a + w2a * xca, z1 = w0b * xm2b + w1b * xm1b + w2b * xcb;
                    const v4u gw_ = *(const v4u*)(gbm + (size_t)row * 1024 + c0);
                    const f32x4 g0 = (f32x4){bflo(gw_.x), bfhi(gw_.x), bflo(gw_.y), bfhi(gw_.y)}, g1 = (f32x4){bflo(gw_.z), bfhi(gw_.z), bflo(gw_.w), bfhi(gw_.w)};
                    *(v4u*)(gbm + (size_t)row * 1024 + c0) = pack8(g0 * z0, g1 * z1); }
                for (int i = gt; i < 4 * 2 * 1024; i += NT) { const int c = i & 1023, j = (i >> 10) & 1, b = i >> 11; out[OFF_CMP + i] = SG[(size_t)((64 * b + 63) * 8 + 6 + j) * 1024 + c]; }
            }
            SEAM();
        }
        if (RUN) { PTRS() pg8::Gemm g{(bf16*)(tmp + (size_t)(1 - l) * TMP_YCAT), WT + WT_OUTEVEN + (size_t)l * (WT_OUTODD - WT_OUTEVEN), MP, 1024, 1024}; pg8::StaticOrderF S; S.init(MP, 1024, G, (int)blockIdx.x);
            EpiRes E{P.in[0], P.in[1] - (size_t)MP * 1024, xb, PARTBUF(1 + 3 * l), l == 0 ? 1 : 0};
            pg8::gemm_phase<EpiRes, pg8::StaticOrderF, true, true>(lds, g, S, E, wave_s);
            { FRESH() sample_gemm<0>((bf16*)(tmp + (size_t)(1 - l) * TMP_YCAT), WT + WT_OUTEVEN + (size_t)l * (WT_OUTODD - WT_OUTEVEN), 1024, lds, tid, wave, lane, xb, l == 0 ? P.in[1] - (size_t)MP * 1024 : (const float*)nullptr, PARTBUF(1 + 3 * l), nullptr, nullptr); } }
        SEAM();
        if (RUN) { PTRS() pg8::Gemm g{xb, WT + WT_WQ + (size_t)l * 1048576, MP, 1024, 1024}; pg8::StaticOrderF S; S.init(MP, 1024, G, (int)blockIdx.x); EpiBf16 E{qx, 1024, PARTBUF(1 + 3 * l)};
            pg8::gemm_phase<EpiBf16, pg8::StaticOrderF, true, true>(lds, g, S, E, wave_s);
            { FRESH() sample_gemm<1>(xb, WT + WT_WQ + (size_t)l * 1048576, 1024, lds, tid, wave, lane, nullptr, nullptr, nullptr, PARTBUF(1 + 3 * l), qx); } }
        SEAM();
        if (RUN) { PTRS() FRESH() xattn_phase2(qx, memk + (size_t)l * 12 * 262144, memvT + (size_t)l * 12 * 262144, ox, lds, tid, wave, lane, G); }
        SEAM();
        if (RUN) { PTRS() pg8::Gemm g{ox, WT + WT_WO + (size_t)l * 1048576, MP, 1024, 1024}; pg8::StaticOrderF S; S.init(MP, 1024, G, (int)blockIdx.x); EpiRes E{P.in[0], P.in[0], xb, PARTBUF(2 + 3 * l), 0};
            pg8::gemm_phase<EpiRes, pg8::StaticOrderF, true, true>(lds, g, S, E, wave_s);
            { FRESH() sample_gemm<0>(ox, WT + WT_WO + (size_t)l * 1048576, 1024, lds, tid, wave, lane, xb, nullptr, PARTBUF(2 + 3 * l), nullptr, nullptr); } }
        SEAM();
        if (RUN) { PTRS() pg8::Gemm g{xb, WT + WT_UP + (size_t)l * 5632 * 1024, MROWS, 5632, 1024}; pg8::StaticOrderF S; S.init(MROWS, 5632, G, (int)blockIdx.x);
            EpiFfnUp E{act, PARTBUF(2 + 3 * l), P.in[34] + (size_t)l * 3 * DFF, SG, SV};
            pg8::gemm_phase<EpiFfnUp, pg8::StaticOrderF, true, true>(lds, g, S, E, wave_s);
            if (l == 0) {
                FRESH()
                const int bx = (int)blockIdx.x, nb = 1430 % G; int slot = -1, nw = 1;
                if (nb > 0 && nb < G) { if (bx >= nb) { slot = (bx - nb) * 8 + wave; nw = (G - nb) * 8; } } else { slot = gw; nw = NGW; }
                if (slot >= 0) for (int it = slot; it < 512 + 512; it += nw) { int r = it;
                    TR(P.in[30] + 1048576, 1024, 1024, WT + WT_WQ + 1048576, P.in[12] + 1024, 0.0625f, 0)
                    tr_item(P.in[32] + 1048576, 1024, 1024, WT + WT_WO + 1048576, nullptr, 1.f, 0, wscr, r, lane); }
            } }
        SEAM();
        if (RUN) { PTRS() FRESH()
            const float* cw = P.in[34] + (size_t)l * 3 * DFF; const float* st = P.in[8] + (size_t)l * 8 * 2 * DFF;
            for (int i = gt; i < 528 * 352; i += NT) { const int fi = i / 352, c0 = (i % 352) * 8; int blk, row, rr, sb, vb; bool smp = fi >= 512;
                if (!smp) { blk = fi >> 1; rr = fi & 1; row = blk * 64 + rr; sb = 0; vb = 0; } else { const int s = fi - 512, half = (s >> 1) & 1; blk = 256 + (s >> 2); rr = s & 1; row = blk * 64 + half * 32 + rr; sb = half * 4; vb = half * 2; }
                f32x4 pa0, pa1, pb0, pb1;
                if (smp) { const int b = (blk - 256) * 2 + (sb >> 2); const float* s0 = st + (size_t)(b * 2) * DFF + c0; pa0 = *(const f32x4*)s0; pa1 = *(const f32x4*)(s0 + 4); pb0 = *(const f32x4*)(s0 + DFF); pb1 = *(const f32x4*)(s0 + DFF + 4); }
                else if ((blk & 63) == 0) { pa0 = pa1 = pb0 = pb1 = (f32x4){0.f, 0.f, 0.f, 0.f}; }
                else { const float* s0 = SG + (size_t)((blk - 1) * 8 + 6) * DFF + c0; pa0 = *(const f32x4*)s0; pa1 = *(const f32x4*)(s0 + 4); pb0 = *(const f32x4*)(s0 + DFF); pb1 = *(const f32x4*)(s0 + DFF + 4); }
                const float* sc = SG + (size_t)(blk * 8 + sb) * DFF + c0; const f32x4 x00 = *(const f32x4*)sc, x01 = *(const f32x4*)(sc + 4);
                f32x4 xm2a, xm2b, xm1a, xm1b, xca, xcb;
                if (rr == 0) { xm2a = pa0; xm2b = pa1; xm1a = pb0; xm1b = pb1; xca = x00; xcb = x01; }
                else { xm2a = pb0; xm2b = pb1; xm1a = x00; xm1b = x01; xca = *(const f32x4*)(sc + DFF); xcb = *(const f32x4*)(sc + DFF + 4); }
                const f32x4 w0a = *(const f32x4*)(cw + c0), w0b = *(const f32x4*)(cw + c0 + 4), w1a = *(const f32x4*)(cw + DFF + c0), w1b = *(const f32x4*)(cw + DFF + c0 + 4), w2a = *(const f32x4*)(cw + 2 * DFF + c0), w2b = *(const f32x4*)(cw + 2 * DFF + c0 + 4);
                const f32x4 ga = w0a * xm2a + w1a * xm1a + w2a * xca, gb_ = w0b * xm2b + w1b * xm1b + w2b * xcb;
                const float* sv = SV + (size_t)(blk * 4 + vb + rr) * DFF + c0; const f32x4 va = *(const f32x4*)sv, vb_ = *(const f32x4*)(sv + 4);
                f32x4 a0, a1;
#pragma unroll
                for (int j = 0; j < 4; ++j) { a0[j] = ga[j] * sigmoidf_(ga[j]) * va[j]; a1[j] = gb_[j] * sigmoidf_(gb_[j]) * vb_[j]; }
                *(v4u*)(act + (size_t)row * DFF + c0) = pack8(a0, a1); }
            for (int i = gt; i < 4 * 2 * DFF; i += NT) { const int c = i % DFF, j = (i / DFF) & 1, b = i / (2 * DFF); out[OFF_CFP + (size_t)l * 4 * 2 * DFF + i] = SG[(size_t)((64 * b + 63) * 8 + 6 + j) * DFF + c]; }
            for (int i = gt; i < 8 * 2 * DFF; i += NT) { const int c = i % DFF, j = (i / DFF) & 1, b = i / (2 * DFF); out[OFF_CFS + (size_t)l * 8 * 2 * DFF + i] = SG[(size_t)((256 + (b >> 1)) * 8 + (b & 1) * 4 + 2 + j) * DFF + c]; }
        }
        SEAM();
        if (RUN) { PTRS() pg8::Gemm g{act, WT + WT_DOWN + (size_t)l * 2816 * 1024, MP, 1024, DFF}; pg8::StaticOrderF S; S.init(MP, 1024, G, (int)blockIdx.x); EpiRes E{P.in[0], P.in[0], xb, PARTBUF(3 + 3 * l), 0};
            pg8::gemm_phase<EpiRes, pg8::StaticOrderF, true, true>(lds, g, S, E, wave_s);
            { FRESH() sample_gemm<0>(act, WT + WT_DOWN + (size_t)l * 2816 * 1024, DFF, lds, tid, wave, lane, xb, nullptr, PARTBUF(3 + 3 * l), nullptr, nullptr); } }
        SEAM();
    }
    if (RUN) { PTRS() FRESH()
        const float* gf = P.in[14];
        for (int m = gw; m < MROWS; m += NGW) { const float rs = rstd_of(PARTBUF(6), m); float* xr = out + (size_t)m * 1024; const bf16* xbr = xb + (size_t)m * 1024;
#pragma unroll
            for (int j = 0; j < 4; ++j) { const int c = (lane + 64 * j) * 4; const u32x2v w = *(const u32x2v*)(xbr + c); const f32x4 v = (f32x4){bflo(w.x), bfhi(w.x), bflo(w.y), bfhi(w.y)}, gg = *(const f32x4*)(gf + c); *(f32x4*)(xr + c) = v * rs * gg; } }
    }
}

extern "C" void kernel_launch(void* const* d_in, const int* in_sizes, int n_in, void* d_out, int out_size, void* d_ws, size_t ws_size, hipStream_t stream) {
    static int grid = 0;
    if (grid == 0) {
        int dev = 0, cus = 0, per_cu = 0;
        if (n_in != 36 || ws_size < 256 * MiB) { fprintf(stderr, "kernel_launch: unexpected n_in %d / ws %zu\n", n_in, ws_size); grid = -1; return; }
        (void)hipGetDevice(&dev); (void)hipDeviceGetAttribute(&cus, hipDeviceAttributeMultiprocessorCount, dev);
        if (hipFuncSetAttribute((const void*)mega_fwd, hipFuncAttributeMaxDynamicSharedMemorySize, LDS_BYTES) != hipSuccess) { fprintf(stderr, "kernel_launch: hipFuncSetAttribute failed\n"); grid = -1; return; }
        if (hipOccupancyMaxActiveBlocksPerMultiprocessor(&per_cu, (const void*)mega_fwd, 512, LDS_BYTES) != hipSuccess || per_cu < 1) per_cu = 1;
        (void)hipGetLastError();
        grid = cus * 1;
        if (grid > 256) grid = 256;
    }
    if (grid < 0) return;
    (void)hipMemsetAsync(d_ws, 0, CTL_ZERO_BYTES, stream);
    Params p{};
    for (int i = 0; i < 36; ++i) p.in[i] = (const float*)d_in[i];
    p.out = (float*)d_out; p.ws = (unsigned char*)d_ws; p.use_cg = 0; p.pad = 0;
    void* args[] = {&p};
    hipError_t e = hipLaunchCooperativeKernel((const void*)mega_fwd, dim3(grid), dim3(512), args, LDS_BYTES, stream);
    if (e != hipSuccess) fprintf(stderr, "cooperative launch failed: %s (grid %d)\n", hipGetErrorString(e), grid);
}
```

```cpp
#include <hip/hip_runtime.h>
#include <hip/hip_cooperative_groups.h>
#include <cstdio>
#include <cstdint>
namespace cg = cooperative_groups;
__device__ __forceinline__ int fresh_tid(int wave_s) { unsigned z = 0u; asm volatile("" : "+s"(z)); int t = wave_s * 64 + (int)__builtin_amdgcn_mbcnt_hi(~0u, __builtin_amdgcn_mbcnt_lo(~0u, z)); asm volatile("" : "+v"(t)); return t; }
namespace pg8 {
#define PG8_LAS __attribute__((address_space(3)))
typedef unsigned short bf16_t;
typedef short bf16x8 __attribute__((ext_vector_type(8)));
typedef float f32x4 __attribute__((ext_vector_type(4)));
typedef unsigned u32x4 __attribute__((ext_vector_type(4)));
constexpr int BM = 256, BK = 64, HALF = 128, HTB = HALF * BK * 2  , STAGE_BYTES = 8 * HTB, NXCD = 8, WGM = 8;

__host__ __device__ __forceinline__ int lds_byte(int r, int c) { const int st = (r >> 4) * 2 + (c >> 5), rr = r & 15, cc = c & 31, ob = rr * 64 + cc * 2; return st * 1024 + (ob ^ (((ob >> 9) & 1) << 5)); }
__host__ __device__ __forceinline__ void stage_rc(int b, int& R, int& C) { const int st = b / 1024, sb = b % 1024, swz = sb ^ (((sb >> 9) & 1) << 5); R = (st >> 1) * 16 + swz / 64; C = (st & 1) * 32 + (swz % 64) / 2; }
__host__ __device__ __forceinline__ int perm32(int rho) { const int n = rho >> 4, i = rho & 15; return 8 * (i >> 2) + 4 * n + (i & 3); }

struct Unit { int pm, pn; };
struct Gemm { const bf16_t* A; const bf16_t* Bt; int M, N, K; };

template <bool FULL> struct StaticOrderT {
    int nM, nN, nwg, G, c;
    __host__ __device__ void init(int M, int N, int G_, int c_) { nM = M / BM; nN = N / BM; nwg = nM * nN; G = G_; c = c_; }
    __host__ __device__ bool next(int i, Unit& u) const {
        const long L = (long)i * G + c; if (!(FULL && i == 0) && L >= nwg) return false;
        int wgid = (int)L; { const int q = nwg / NXCD, r = nwg % NXCD, xcd = wgid % NXCD, off = wgid / NXCD; wgid = (xcd < r ? xcd * (q + 1) : r * (q + 1) + (xcd - r) * q) + off; }
        const int nig = WGM * nN, gid = wgid / nig, fm = gid * WGM, gsz = (nM - fm) < WGM ? (nM - fm) : WGM;
        u.pm = fm + ((wgid % nig) % gsz); u.pn = (wgid % nig) / gsz; return true;
    }
    __device__ __forceinline__ void a_ready(const Unit&) const {}
    __device__ __forceinline__ void done(const Unit&) const {}
};

typedef StaticOrderT<false> StaticOrder; typedef StaticOrderT<true> StaticOrderF;
__device__ __forceinline__ unsigned cvt_pk_bf16(float lo, float hi) { unsigned r; asm volatile("v_cvt_pk_bf16_f32 %0, %1, %2" : "=v"(r) : "v"(lo), "v"(hi)); return r; }
typedef float f32x2 __attribute__((ext_vector_type(2)));
template <class Epi, class Sched, bool ALIGN_EPI = false, bool SP2 = false>
__device__ __forceinline__ void gemm_phase(PG8_LAS unsigned char* lds, const Gemm g, const Sched& S, const Epi& E, const int wave_s) {
    const int tid = fresh_tid(wave_s), wid = __builtin_amdgcn_readfirstlane(tid >> 6), lane = tid & 63, wr = wid >> 2, wc = wid & 3, fr = lane & 15, fq = lane >> 4;
    const int K = g.K, nt = K / BK;
    unsigned voffA[2], voffB[2];
#pragma unroll
    for (int i = 0; i < 2; ++i) { int R, C; stage_rc(tid * 16 + i * 8192, R, C); const int Rb = Epi::PERM ? ((R & ~31) + perm32(R & 31)) : R;
        voffA[i] = (unsigned)(R * K + C) * 2u; voffB[i] = (unsigned)(Rb * K + C) * 2u; }
    const size_t kstep = (size_t)(BK * 2);
    const size_t hstep = (size_t)HALF * K * 2;
    const size_t tstep = 2 * hstep;
    const unsigned ldsw = (unsigned)wid * 1024u;
    const int aoff = lds_byte(wr * 64 + fr, fq * 8), boff = lds_byte(wc * 32 + fr, fq * 8);
#define PG8_SA(b, h) (((b) * 2 + (h)) * HTB)
#define PG8_SB(b, h) ((4 + (b) * 2 + (h)) * HTB)
#define PG8_STAGE(bufoff, gbase, voff) do { _Pragma("unroll") for (int _i = 0; _i < 2; ++_i) \
        __builtin_amdgcn_global_load_lds((const unsigned*)((const char*)(gbase) + (voff)[_i]), (PG8_LAS unsigned*)(lds + (bufoff) + ldsw + _i * 8192), 16, 0, 0); } while (0)
#define PG8_LDA(dst, b, h) do { _Pragma("unroll") for (int m = 0; m < 4; ++m) _Pragma("unroll") for (int k = 0; k < 2; ++k) dst[m][k] = *(const PG8_LAS bf16x8*)(lds + PG8_SA(b, h) + aoff + m * 2048 + k * 1024); } while (0)
#define PG8_LDB(dst, b, h) do { _Pragma("unroll") for (int n = 0; n < 2; ++n) _Pragma("unroll") for (int k = 0; k < 2; ++k) dst[n][k] = *(const PG8_LAS bf16x8*)(lds + PG8_SB(b, h) + boff + n * 2048 + k * 1024); } while (0)
#define PG8_MMA(ai, bj, At, Bt) do { __builtin_amdgcn_s_setprio(1); _Pragma("unroll") for (int m = 0; m < 4; ++m) _Pragma("unroll") for (int n = 0; n < 2; ++n) _Pragma("unroll") for (int k = 0; k < 2; ++k) \
        acc[ai][bj][m][n] = __builtin_amdgcn_mfma_f32_16x16x32_bf16(Bt[n][k], At[m][k], acc[ai][bj][m][n], 0, 0, 0); __builtin_amdgcn_s_setprio(0); } while (0)
#define PG8_WAIT_V(n) asm volatile("s_waitcnt vmcnt(" #n ")" ::: "memory")
#define PG8_WAIT_L(n) asm volatile("s_waitcnt lgkmcnt(" #n ")" ::: "memory")
#define PG8_BAR __builtin_amdgcn_s_barrier()
#define PG8_SCHED __builtin_amdgcn_sched_barrier(0)
    Unit cur, nxt; int ui = 0;
    if (!S.next(0, cur)) return;
    f32x4 acc[2][2][4][2];
#pragma unroll
    for (int a = 0; a < 2; ++a)
#pragma unroll
        for (int b = 0; b < 2; ++b)
#pragma unroll
            for (int m = 0; m < 4; ++m)
#pragma unroll
                for (int n = 0; n < 2; ++n) acc[a][b][m][n] = (f32x4){0.f, 0.f, 0.f, 0.f};
    bf16x8 At[4][2], B0[2][2], B1[2][2];
    const char* cA = (const char*)g.A + (size_t)cur.pm * tstep; const char* cB = (const char*)g.Bt + (size_t)cur.pn * tstep;
    S.a_ready(cur);
    if constexpr (SP2) {
        PG8_STAGE(PG8_SB(0, 0), cB, voffB); PG8_STAGE(PG8_SB(0, 1), cB + hstep, voffB); PG8_STAGE(PG8_SA(0, 0), cA, voffA); PG8_STAGE(PG8_SA(0, 1), cA + hstep, voffA);
        if (wr == 1) PG8_BAR;
        PG8_WAIT_V(2); PG8_BAR;
        PG8_STAGE(PG8_SB(1, 0), cB + kstep, voffB); PG8_STAGE(PG8_SA(1, 0), cA + kstep, voffA); PG8_STAGE(PG8_SB(1, 1), cB + hstep + kstep, voffB);
        PG8_WAIT_V(6); PG8_BAR;
    } else {
        PG8_STAGE(PG8_SB(0, 0), cB, voffB); PG8_STAGE(PG8_SA(0, 0), cA, voffA); PG8_STAGE(PG8_SB(0, 1), cB + hstep, voffB); PG8_STAGE(PG8_SA(0, 1), cA + hstep, voffA);
        if (wr == 1) PG8_BAR;
        PG8_WAIT_V(4); PG8_BAR;
        PG8_STAGE(PG8_SB(1, 0), cB + kstep, voffB); PG8_STAGE(PG8_SA(1, 0), cA + kstep, voffA); PG8_STAGE(PG8_SB(1, 1), cB + hstep + kstep, voffB);
        PG8_WAIT_V(6); PG8_BAR;
    }
    for (;;) {
        const bool has_next = S.next(ui + 1, nxt);
        const char* nA = has_next ? (const char*)g.A + (size_t)nxt.pm * tstep : cA; const char* nB = has_next ? (const char*)g.Bt + (size_t)nxt.pn * tstep : cB;
        for (int t = 0; t < nt; t += 2) {
            const bool last = (t == nt - 2);
            const char* a1 = cA + (size_t)(t + 1) * kstep;
            const char* a2 = last ? nA : cA + (size_t)(t + 2) * kstep; const char* b2 = last ? nB : cB + (size_t)(t + 2) * kstep;
            const char* a3 = a2 + kstep; const char* b3 = b2 + kstep;
            if (last && has_next) S.a_ready(nxt);
            if constexpr (SP2) {
            PG8_LDB(B0, 0, 0); PG8_LDB(B1, 0, 1); PG8_SCHED; PG8_LDA(At, 0, 0); PG8_STAGE(PG8_SA(1, 1), a1 + hstep, voffA);
            PG8_WAIT_V(8); PG8_WAIT_L(0); PG8_BAR; PG8_MMA(0, 0, At, B0); PG8_MMA(0, 1, At, B1); PG8_BAR; PG8_SCHED;
            PG8_LDA(At, 0, 1); PG8_STAGE(PG8_SB(0, 0), b2, voffB); PG8_STAGE(PG8_SB(0, 1), b2 + hstep, voffB); PG8_STAGE(PG8_SA(0, 0), a2, voffA);
            PG8_WAIT_V(8); PG8_WAIT_L(0); PG8_BAR; PG8_MMA(1, 0, At, B0); PG8_MMA(1, 1, At, B1); PG8_BAR; PG8_SCHED;
            PG8_LDB(B0, 1, 0); PG8_LDB(B1, 1, 1); PG8_SCHED; PG8_LDA(At, 1, 0); PG8_STAGE(PG8_SA(0, 1), a2 + hstep, voffA);
            PG8_WAIT_V(8); PG8_WAIT_L(0); PG8_BAR; PG8_MMA(0, 0, At, B0); PG8_MMA(0, 1, At, B1); PG8_BAR; PG8_SCHED;
            PG8_LDA(At, 1, 1); PG8_STAGE(PG8_SB(1, 0), b3, voffB); PG8_STAGE(PG8_SB(1, 1), b3 + hstep, voffB); PG8_STAGE(PG8_SA(1, 0), a3, voffA);
            PG8_WAIT_V(8); PG8_WAIT_L(0); PG8_BAR; PG8_MMA(1, 0, At, B0); PG8_MMA(1, 1, At, B1); PG8_BAR; PG8_SCHED;
            } else {
            PG8_LDB(B0, 0, 0); PG8_SCHED; PG8_LDA(At, 0, 0); PG8_STAGE(PG8_SA(1, 1), a1 + hstep, voffA);
            PG8_WAIT_L(8); PG8_BAR; PG8_WAIT_L(0); PG8_MMA(0, 0, At, B0); PG8_BAR; PG8_SCHED;
            PG8_LDB(B1, 0, 1); PG8_STAGE(PG8_SB(0, 0), b2, voffB);
            PG8_BAR; PG8_WAIT_L(0); PG8_MMA(0, 1, At, B1); PG8_BAR;
            PG8_LDA(At, 0, 1); PG8_STAGE(PG8_SA(0, 0), a2, voffA);
            PG8_BAR; PG8_WAIT_L(0); PG8_MMA(1, 0, At, B0); PG8_BAR; PG8_SCHED;
            PG8_STAGE(PG8_SB(0, 1), b2 + hstep, voffB);
            PG8_WAIT_V(6); PG8_BAR; PG8_MMA(1, 1, At, B1); PG8_BAR;
            PG8_LDB(B0, 1, 0); PG8_SCHED; PG8_LDA(At, 1, 0); PG8_STAGE(PG8_SA(0, 1), a2 + hstep, voffA);
            PG8_WAIT_L(8); PG8_BAR; PG8_WAIT_L(0); PG8_MMA(0, 0, At, B0); PG8_BAR; PG8_SCHED;
            PG8_LDB(B1, 1, 1); PG8_STAGE(PG8_SB(1, 0), b3, voffB);
            PG8_BAR; PG8_WAIT_L(0); PG8_MMA(0, 1, At, B1); PG8_BAR;
            PG8_LDA(At, 1, 1); PG8_STAGE(PG8_SA(1, 0), a3, voffA);
            PG8_BAR; PG8_WAIT_L(0); PG8_MMA(1, 0, At, B0); PG8_BAR; PG8_SCHED;
            PG8_STAGE(PG8_SB(1, 1), b3 + hstep, voffB);
            PG8_WAIT_V(6); PG8_BAR; PG8_MMA(1, 1, At, B1); PG8_BAR;
            }
        }
        if constexpr (ALIGN_EPI) { if (wr == 0) PG8_BAR; }
        if constexpr (!Epi::AFTER_DRAIN) { E(acc, cur, wr, wc, fr, fq); S.done(cur); }
        if (!has_next) break;
#pragma unroll
        for (int a = 0; a < 2; ++a)
#pragma unroll
            for (int b = 0; b < 2; ++b)
#pragma unroll
                for (int m = 0; m < 4; ++m)
#pragma unroll
                    for (int n = 0; n < 2; ++n) acc[a][b][m][n] = (f32x4){0.f, 0.f, 0.f, 0.f};
        cur = nxt; cA = nA; cB = nB; ++ui;
        if constexpr (ALIGN_EPI) { if (wr == 1) PG8_BAR; }
    }
    PG8_WAIT_V(0);
    if constexpr (!ALIGN_EPI) { if (wr == 0) PG8_BAR; }
    PG8_BAR;
    if constexpr (Epi::AFTER_DRAIN) { E.fused(acc, cur, wr, wc, fr, fq, lds, wid, lane); S.done(cur); }
#undef PG8_SA
#undef PG8_SB
#undef PG8_STAGE
#undef PG8_LDA
#undef PG8_LDB
#undef PG8_MMA
#undef PG8_WAIT_V
#undef PG8_WAIT_L
#undef PG8_BAR
#undef PG8_SCHED
}
}
#define GAS __attribute__((address_space(1)))
#define LAS __attribute__((address_space(3)))
typedef unsigned short bf16;
typedef unsigned v4u __attribute__((ext_vector_type(4)));
typedef float f32x4 __attribute__((ext_vector_type(4)));
typedef short bf16x8 __attribute__((ext_vector_type(8)));
typedef GAS unsigned gu32;
typedef GAS unsigned long long gu64;
#define RLX_AGENT __ATOMIC_RELAXED, __HIP_MEMORY_SCOPE_AGENT
#define LDS_WAIT() asm volatile("s_waitcnt lgkmcnt(0)" ::: "memory")
#define VM_WAIT() asm volatile("s_waitcnt vmcnt(0)" ::: "memory")
__device__ __forceinline__ unsigned long long rt() { return __builtin_amdgcn_s_memrealtime(); }
__device__ __forceinline__ unsigned f2bf(float f) { unsigned u = __builtin_bit_cast(unsigned, f); return (u + 0x7fffu + ((u >> 16) & 1u)) >> 16; }
__device__ __forceinline__ unsigned pk2(float lo, float hi) { return f2bf(lo) | (f2bf(hi) << 16); }

#define XB_TMO      128
#define XB_XCNT(j)  (256  + 64 * (j))
#define XB_XSUB(j)  (1280 + 64 * (j))
#define XB_XGEN(j)  (2304 + 64 * (j))
#define XB_TOP      3328
#define XB_TOPGEN   3392
#define XCD_BAR_WORDS 3456
#define XB_SPIN_CAP (1u << 18)

__device__ __forceinline__ unsigned xb_ld(unsigned* p)              { return __hip_atomic_load(p, __ATOMIC_RELAXED, __HIP_MEMORY_SCOPE_AGENT); }
__device__ __forceinline__ unsigned xb_add(unsigned* p, unsigned v) { return __hip_atomic_fetch_add(p, v, __ATOMIC_RELAXED, __HIP_MEMORY_SCOPE_AGENT); }
__device__ __forceinline__ unsigned xb_xcc_id() { return (unsigned)__builtin_amdgcn_s_getreg((3 << 11) | 20) & 0xFu; }
#define XB_SPIN(cond, bar) do { unsigned _sp = 0; while (cond) { __builtin_amdgcn_s_sleep(1); \
    if ((++_sp & 255u) == 0u) { if (xb_ld(&(bar)[XB_TMO])) break; if (_sp > XB_SPIN_CAP) { atomicAdd(&(bar)[XB_TMO], 1u); break; } } } } while (0)

struct XcdBarrier {
    unsigned* bar; unsigned x;
    volatile LAS unsigned* st;
};

__device__ __forceinline__ XcdBarrier xcd_barrier_post(unsigned* bar, volatile LAS unsigned* st) {
    XcdBarrier b; b.bar = bar; b.x = xb_xcc_id(); b.st = st;
    if (threadIdx.x == 0) (void)xb_add(&bar[XB_XCNT(b.x)], 1u);
    return b;
}
__device__ __forceinline__ void xcd_barrier_complete(unsigned* bar, unsigned x, unsigned& nloc, unsigned& nx) {
    const unsigned G = gridDim.x * gridDim.y * gridDim.z;
    unsigned sum, cnt, mine, sp = 0u;
    for (;;) {
        sum = 0u; cnt = 0u; mine = 0u;
#pragma unroll
        for (unsigned j = 0; j < 16; ++j) { const unsigned c = xb_ld(&bar[XB_XCNT(j)]); sum += c; cnt += (c > 0u) ? 1u : 0u; mine = (j == x) ? c : mine; }
        if (sum == G) break;
        __builtin_amdgcn_s_sleep(1);
        if ((++sp & 255u) == 0u) { if (xb_ld(&bar[XB_TMO])) break; if (sp > XB_SPIN_CAP) { atomicAdd(&bar[XB_TMO], 1u); break; } }
    }
    nloc = mine > 0u ? mine : 1u; nx = cnt > 0u ? cnt : 1u;
}

__device__ __forceinline__ void xcd_barrier(const XcdBarrier& b) {
    asm volatile("s_waitcnt vmcnt(0)" ::: "memory");
    __syncthreads();
    if (threadIdx.x == 0) {
        unsigned* bar = b.bar;
        __builtin_amdgcn_s_waitcnt(0);
        unsigned nloc = b.st[0], nx = b.st[1];
        if (nloc == 0u) { xcd_barrier_complete(bar, b.x, nloc, nx); b.st[0] = nloc; b.st[1] = nx; }
        const unsigned old = xb_add(&bar[XB_XSUB(b.x)], 1u);
        const unsigned gen = old / nloc;
        if (old + 1u == (gen + 1u) * nloc) {
            __builtin_amdgcn_fence(__ATOMIC_RELEASE, "agent");
            asm volatile("s_waitcnt vmcnt(0)" ::: "memory");
            const unsigned og = xb_add(&bar[XB_TOP], 1u);
            const unsigned tg = og / nx;
            if (og + 1u == (tg + 1u) * nx) xb_add(&bar[XB_TOPGEN], 1u);
            else XB_SPIN(xb_ld(&bar[XB_TOPGEN]) == tg, bar);
            __builtin_amdgcn_fence(__ATOMIC_ACQUIRE, "agent");
            xb_add(&bar[XB_XGEN(b.x)], 1u);
            asm volatile("s_waitcnt vmcnt(0)" ::: "memory");
        } else {
            XB_SPIN(xb_ld(&bar[XB_XGEN(b.x)]) == gen, bar);
            __builtin_amdgcn_fence(__ATOMIC_ACQUIRE, "agent");
            asm volatile("s_waitcnt vmcnt(0)" ::: "memory");
        }
    }
    __syncthreads();
}
typedef unsigned u32x2v __attribute__((ext_vector_type(2)));
typedef float f32x2v __attribute__((ext_vector_type(2)));

constexpr int MP = 16384, MROWS = 16640, DMODEL = 1024, DFF = 2816, NBLK64 = MROWS / 64;
constexpr float RMS_EPS = 1e-6f;
constexpr size_t OFF_Y = 0, OFF_WKP = (size_t)MROWS * 1024, OFF_WVP = OFF_WKP + 65536, OFF_SRP = OFF_WVP + 65536, OFF_SIP = OFF_SRP + 8192,
    OFF_CMP = OFF_SIP + 8192, OFF_CFP = OFF_CMP + 8192, OFF_MKP = OFF_CFP + 45056, OFF_MVP = OFF_MKP + 2097152, OFF_WKS = OFF_MVP + 2097152,
    OFF_WVS = OFF_WKS + 32768, OFF_SRS = OFF_WVS + 32768, OFF_SIS = OFF_SRS + 16384, OFF_CMS = OFF_SIS + 16384, OFF_CFS = OFF_CMS + 16384;
constexpr size_t MiB = 1u << 20;
constexpr size_t WS_ROWSS = 0, WS_BAR = 512 * 1024, CTL_ZERO_BYTES = 1 * MiB;
constexpr size_t WS_ROPE = 1 * MiB, WS_SSM = 2 * MiB, WS_CKV = 3 * MiB, WS_SLOC = 4 * MiB, WS_MEMK = 8 * MiB, WS_MEMVT = 20 * MiB, WS_SIDE = 32 * MiB;
constexpr size_t SG_BYTES = (size_t)NBLK64 * 8 * DFF * 4, SV_BYTES = (size_t)NBLK64 * 4 * DFF * 4;
static_assert(WS_SIDE + SG_BYTES + SV_BYTES <= 66 * MiB, "side buffers");
constexpr size_t WS_WT = 66 * MiB, WS_XB = 128 * MiB, WS_TMP = 161 * MiB;
constexpr size_t WT_INEVEN = 0, WT_GLU = WT_INEVEN + 1280 * 1024, WT_OUTEVEN = WT_GLU + 512 * 512, WT_WQ = WT_OUTEVEN + 1024 * 1024, WT_WKV = WT_WQ + 2 * 1024 * 1024,
    WT_WO = WT_WKV + 2 * 2048 * 1024, WT_UP = WT_WO + 2 * 1024 * 1024, WT_DOWN = WT_UP + (size_t)2 * 5632 * 1024, WT_INODD = WT_DOWN + (size_t)2 * 2816 * 1024,
    WT_OUTODD = WT_INODD + 3072 * 1024, WT_END = WT_OUTODD + 1024 * 1024;
static_assert(WS_WT + WT_END * 2 <= WS_XB, "weights");
static_assert(WS_XB + (size_t)MROWS * 1024 * 2 <= WS_TMP, "xb");
constexpr size_t TMP_BYTES = (size_t)MROWS * DFF * 2;
constexpr size_t WS_PART = 251 * MiB, PART_ELEMS = (size_t)MROWS * 16;
static_assert(WS_PART + 2 * PART_ELEMS * 4 <= 256 * MiB, "part");
static_assert(WS_TMP + TMP_BYTES <= 256 * MiB, "ws");
constexpr size_t TMP_PROJ0 = 0, TMP_GBUF = (size_t)MROWS * 1280 * 2, TMP_YCAT = TMP_GBUF + (size_t)MROWS * 512 * 2, TMP_MEMB = TMP_YCAT;
static_assert(TMP_YCAT + (size_t)MROWS * 1024 * 2 <= TMP_BYTES, "tmp");
constexpr size_t TMP_QX = 0, TMP_OX = (size_t)MROWS * 1024 * 2, TMP_ACT = 0, TMP_GB = 0, TMP_ZC = (size_t)MROWS * 1024 * 2;
constexpr int LDS_BYTES = 147456, MISC_OFF = 147456 - 512;
constexpr int NPH = 22;

#define MFMA16(a, b, c) __builtin_amdgcn_mfma_f32_16x16x32_bf16(a, b, c, 0, 0, 0)
__device__ __forceinline__ float bflo(unsigned w) { return __uint_as_float(w << 16); }
__device__ __forceinline__ float bfhi(unsigned w) { return __uint_as_float(w & 0xffff0000u); }
__device__ __forceinline__ v4u pack8(f32x4 a, f32x4 b) { v4u w; w.x = pg8::cvt_pk_bf16(a[0], a[1]); w.y = pg8::cvt_pk_bf16(a[2], a[3]); w.z = pg8::cvt_pk_bf16(b[0], b[1]); w.w = pg8::cvt_pk_bf16(b[2], b[3]); return w; }
__device__ __forceinline__ float rstd_of(const float* part, int row) { const f32x4* p = (const f32x4*)(part + (size_t)row * 16); const f32x4 a = p[0] + p[1] + p[2] + p[3]; return rsqrtf(((a[0] + a[1]) + (a[2] + a[3])) * (1.0f / 1024.0f) + RMS_EPS); }
__device__ __forceinline__ float sigmoidf_(float x) { return 1.0f / (1.0f + __expf(-x)); }
__device__ __forceinline__ float dpp_ror1(float v) { return __builtin_bit_cast(float, __builtin_amdgcn_update_dpp(0, __builtin_bit_cast(int, v), 0x121, 0xf, 0xf, false)); }
__device__ __forceinline__ float dpp_ror2(float v) { return __builtin_bit_cast(float, __builtin_amdgcn_update_dpp(0, __builtin_bit_cast(int, v), 0x122, 0xf, 0xf, false)); }
__device__ __forceinline__ float wave_sum(float v) {
#pragma unroll
    for (int o = 1; o < 64; o <<= 1) v += __shfl_xor(v, o);
    return v;
}

typedef pg8::Unit Unit;
#define EPI_ARGS const f32x4 (&acc)[2][2][4][2], const Unit& u, int wr, int wc, int fr, int fq

struct EpiBf16 {
    static constexpr bool PERM = true, AFTER_DRAIN = false;
    bf16* O; int ldc; const float* rowss;
    __device__ __forceinline__ void operator()(EPI_ARGS) const {
        const int row0 = u.pm * 256 + wr * 64 + fr, col0 = u.pn * 256 + wc * 32 + 8 * fq;
#pragma unroll
        for (int ai = 0; ai < 2; ++ai)
#pragma unroll
            for (int m = 0; m < 4; ++m) { const int row = row0 + ai * 128 + m * 16; const float rs = rstd_of(rowss, row); bf16* rp = O + (size_t)row * ldc + col0;
#pragma unroll
                for (int bj = 0; bj < 2; ++bj) *(v4u*)(rp + bj * 128) = pack8(acc[ai][bj][m][0] * rs, acc[ai][bj][m][1] * rs); }
    }
};
struct EpiRes {
    static constexpr bool PERM = true, AFTER_DRAIN = false;
    const float* base_p; const float* base_s; bf16* xb; float* rowss_next; int f32base;
    __device__ __forceinline__ void operator()(EPI_ARGS) const {
        const float* base = u.pm < 64 ? base_p : base_s;
        const int row0 = u.pm * 256 + wr * 64 + fr, col0 = u.pn * 256 + wc * 32 + 8 * fq;
#pragma unroll
        for (int ai = 0; ai < 2; ++ai)
#pragma unroll
            for (int m = 0; m < 4; ++m) { const int row = row0 + ai * 128 + m * 16; const size_t off = (size_t)row * 1024 + col0; float ss = 0.f;
#pragma unroll
                for (int bj = 0; bj < 2; ++bj) { f32x4 b0, b1;
                    if (f32base) { b0 = *(const f32x4*)(base + off + bj * 128); b1 = *(const f32x4*)(base + off + bj * 128 + 4); }
                    else { const v4u w = *(const v4u*)(xb + off + bj * 128); b0 = (f32x4){bflo(w.x), bfhi(w.x), bflo(w.y), bfhi(w.y)}; b1 = (f32x4){bflo(w.z), bfhi(w.z), bflo(w.w), bfhi(w.w)}; }
                    const f32x4 v0 = acc[ai][bj][m][0] + b0, v1 = acc[ai][bj][m][1] + b1;
                    *(v4u*)(xb + off + bj * 128) = pack8(v0, v1);
                    ss += (v0[0] * v0[0] + v0[1] * v0[1]) + (v0[2] * v0[2] + v0[3] * v0[3]) + (v1[0] * v1[0] + v1[1] * v1[1]) + (v1[2] * v1[2] + v1[3] * v1[3]); }
                ss += __shfl_xor(ss, 16); ss += __shfl_xor(ss, 32);
                if (fq == 0) rowss_next[(size_t)row * 16 + u.pn * 4 + wc] = ss; }
    }
};
struct EpiGlu {
    static constexpr bool PERM = true, AFTER_DRAIN = false;
    const bf16* g; bf16* ycat;
    __device__ __forceinline__ void operator()(EPI_ARGS) const {
        const int row0 = u.pm * 256 + wr * 64 + fr, col0 = u.pn * 256 + wc * 32 + 8 * fq;
#pragma unroll
        for (int ai = 0; ai < 2; ++ai)
#pragma unroll
            for (int m = 0; m < 4; ++m) { const int row = row0 + ai * 128 + m * 16;
#pragma unroll
                for (int bj = 0; bj < 2; ++bj) { const int col = col0 + bj * 128; const v4u gw = *(const v4u*)(g + (size_t)row * 512 + col);
                    const f32x4 a0 = acc[ai][bj][m][0], a1 = acc[ai][bj][m][1]; f32x4 o0, o1;
                    o0[0] = bflo(gw.x) * sigmoidf_(a0[0]); o0[1] = bfhi(gw.x) * sigmoidf_(a0[1]); o0[2] = bflo(gw.y) * sigmoidf_(a0[2]); o0[3] = bfhi(gw.y) * sigmoidf_(a0[3]);
                    o1[0] = bflo(gw.z) * sigmoidf_(a1[0]); o1[1] = bfhi(gw.z) * sigmoidf_(a1[1]); o1[2] = bflo(gw.w) * sigmoidf_(a1[2]); o1[3] = bfhi(gw.w) * sigmoidf_(a1[3]);
                    *(v4u*)(ycat + (size_t)row * 1024 + col) = pack8(o0, o1); } }
    }
};
struct EpiKV {
    static constexpr bool PERM = true, AFTER_DRAIN = false;
    float* out; bf16* memk;
    __device__ __forceinline__ void operator()(EPI_ARGS) const {
        const int row0 = u.pm * 256 + wr * 64 + fr, col0 = u.pn * 256 + wc * 32 + 8 * fq;
#pragma unroll
        for (int ai = 0; ai < 2; ++ai)
#pragma unroll
            for (int m = 0; m < 4; ++m) { const int row = row0 + ai * 128 + m * 16;
#pragma unroll
                for (int bj = 0; bj < 2; ++bj) { const int c = col0 + bj * 128, l = c >> 11, e = c & 2047, isv = e >> 10, dc = e & 1023;
                    float* op = out + (isv ? OFF_MVP : OFF_MKP) + (size_t)l * 1048576 + (size_t)row * 1024 + dc;
                    *(f32x4*)op = acc[ai][bj][m][0]; *(f32x4*)(op + 4) = acc[ai][bj][m][1];
                    if (!isv) *(v4u*)(memk + (size_t)l * 12 * 262144 + (size_t)row * 1024 + dc) = pack8(acc[ai][bj][m][0], acc[ai][bj][m][1]); } }
    }
};
struct EpiIn0 {
    static constexpr bool PERM = true, AFTER_DRAIN = false;
    bf16* proj; const float* rowss; const float* ropec; const float* ropes; float* out;
    __device__ __forceinline__ void operator()(EPI_ARGS) const {
        const int pn = u.pn;
#pragma unroll
        for (int ai = 0; ai < 2; ++ai)
#pragma unroll
            for (int m = 0; m < 4; ++m) { const int row = u.pm * 256 + ai * 128 + wr * 64 + m * 16 + fr; const float rs = rstd_of(rowss, row);
                const int pos = row < MP ? (row & 4095) : 2048 + (row & 31);
                bf16* rp = proj + (size_t)row * 1280;
                float* wk = nullptr; float* wv = nullptr;
                if (pn == 4) { if (row >= MP) { wk = out + OFF_WKS + (size_t)(row - MP) * 128; wv = out + OFF_WVS + (size_t)(row - MP) * 128; }
                               else if ((row & 4095) >= 3968) { const size_t o = (size_t)((row >> 12) * 128 + (row & 4095) - 3968) * 128; wk = out + OFF_WKP + o; wv = out + OFF_WVP + o; } }
#pragma unroll
                for (int bj = 0; bj < 2; ++bj) { const f32x4 v0 = acc[ai][bj][m][0] * rs, v1 = acc[ai][bj][m][1] * rs;
                    const bool rope = (pn == 2 || pn == 3 || (pn == 4 && bj == 0));
                    if (!rope) { const int col = pn * 256 + bj * 128 + wc * 32 + 8 * fq; *(v4u*)(rp + col) = pack8(v0, v1);
                        if (pn == 4 && wv) { *(f32x4*)(wv + wc * 32 + 8 * fq) = v0; *(f32x4*)(wv + wc * 32 + 8 * fq + 4) = v1; } }
                    else { const int gbase = pn * 256 + bj * 128 + (wc >> 1) * 64, d1 = 16 * (wc & 1) + 4 * fq;
                        const f32x4 c4 = *(const f32x4*)(ropec + pos * 32 + d1), s4 = *(const f32x4*)(ropes + pos * 32 + d1);
                        f32x4 o1 = v0 * c4 - v1 * s4, o2 = v1 * c4 + v0 * s4;
                        if (pn != 4) { o1 = o1 * 0.125f; o2 = o2 * 0.125f; }
                        u32x2v w1, w2; w1.x = pg8::cvt_pk_bf16(o1[0], o1[1]); w1.y = pg8::cvt_pk_bf16(o1[2], o1[3]); w2.x = pg8::cvt_pk_bf16(o2[0], o2[1]); w2.y = pg8::cvt_pk_bf16(o2[2], o2[3]);
                        *(u32x2v*)(rp + gbase + d1) = w1; *(u32x2v*)(rp + gbase + d1 + 32) = w2;
                        if (pn == 4 && wk) { const int cc = (wc >> 1) * 64 + d1; *(f32x4*)(wk + cc) = o1; *(f32x4*)(wk + cc + 32) = o2; } } } }
    }
};
struct EpiFfnUp {
    static constexpr bool PERM = true, AFTER_DRAIN = false;
    bf16* act; const float* rowss; const float* cw; float* SG; float* SV;
    __device__ __forceinline__ void operator()(EPI_ARGS) const {
        const int c0 = u.pn * 128 + wc * 32 + 8 * fq; const bool sample = u.pm == 64;
        const f32x4 w0a = *(const f32x4*)(cw + c0), w0b = *(const f32x4*)(cw + c0 + 4), w1a = *(const f32x4*)(cw + DFF + c0), w1b = *(const f32x4*)(cw + DFF + c0 + 4),
                    w2a = *(const f32x4*)(cw + 2 * DFF + c0), w2b = *(const f32x4*)(cw + 2 * DFF + c0 + 4);
#pragma unroll
        for (int ai = 0; ai < 2; ++ai) { f32x4 gp0 = {0.f, 0.f, 0.f, 0.f}, gp1 = {0.f, 0.f, 0.f, 0.f}; const int blk = u.pm * 4 + ai * 2 + wr;
#pragma unroll
            for (int m = 0; m < 4; ++m) { const int row = u.pm * 256 + ai * 128 + wr * 64 + m * 16 + fr; const float rs = rstd_of(rowss, row);
                const f32x4 g0 = acc[ai][0][m][0] * rs, g1 = acc[ai][0][m][1] * rs, v0 = acc[ai][1][m][0] * rs, v1 = acc[ai][1][m][1] * rs;
                f32x4 p1a, p2a, p1b, p2b;
#pragma unroll
                for (int j = 0; j < 4; ++j) { const float s1a = fr == 15 ? gp0[j] : g0[j], s2a = fr >= 14 ? gp0[j] : g0[j], s1b = fr == 15 ? gp1[j] : g1[j], s2b = fr >= 14 ? gp1[j] : g1[j];
                    p1a[j] = dpp_ror1(s1a); p2a[j] = dpp_ror2(s2a); p1b[j] = dpp_ror1(s1b); p2b[j] = dpp_ror2(s2b); }
                const f32x4 ca = w0a * p2a + w1a * p1a + w2a * g0, cb = w0b * p2b + w1b * p1b + w2b * g1;
                f32x4 sa, sb;
#pragma unroll
                for (int j = 0; j < 4; ++j) { sa[j] = sigmoidf_(ca[j]); sb[j] = sigmoidf_(cb[j]); }
                const f32x4 a0 = ca * sa * v0, a1 = cb * sb * v1;
                const bool valid = (m > 0 || fr >= 2) && !(sample && m == 2 && fr < 2);
                if (valid) *(v4u*)(act + (size_t)row * DFF + c0) = pack8(a0, a1);
                if ((m & 1) == 0 && fr < 2) { float* sg = SG + (size_t)(blk * 8 + 2 * m + fr) * DFF + c0; *(f32x4*)sg = g0; *(f32x4*)(sg + 4) = g1;
                                              float* sv = SV + (size_t)(blk * 4 + m + fr) * DFF + c0; *(f32x4*)sv = v0; *(f32x4*)(sv + 4) = v1; }
                if ((m & 1) == 1 && fr >= 14) { float* sg = SG + (size_t)(blk * 8 + 2 * m + fr - 14) * DFF + c0; *(f32x4*)sg = g0; *(f32x4*)(sg + 4) = g1; }
                gp0 = g0; gp1 = g1; } }
    }
};
struct EpiInOdd {
    static constexpr bool PERM = true, AFTER_DRAIN = false;
    bf16* gb; bf16* zc; const float* rowss; const float* cw; float* SG;
    __device__ __forceinline__ void operator()(EPI_ARGS) const {
        if (u.pn < 4) {
            const int row0 = u.pm * 256 + wr * 64 + fr, col0 = u.pn * 256 + wc * 32 + 8 * fq;
#pragma unroll
            for (int ai = 0; ai < 2; ++ai)
#pragma unroll
                for (int m = 0; m < 4; ++m) { const int row = row0 + ai * 128 + m * 16; const float rs = rstd_of(rowss, row); bf16* rp = gb + (size_t)row * 1024 + col0;
#pragma unroll
                    for (int bj = 0; bj < 2; ++bj) *(v4u*)(rp + bj * 128) = pack8(acc[ai][bj][m][0] * rs, acc[ai][bj][m][1] * rs); }
            return;
        }
        const int c0 = (u.pn - 4) * 128 + wc * 32 + 8 * fq; const bool sample = u.pm == 64;
        const f32x4 w0a = *(const f32x4*)(cw + c0), w0b = *(const f32x4*)(cw + c0 + 4), w1a = *(const f32x4*)(cw + 1024 + c0), w1b = *(const f32x4*)(cw + 1024 + c0 + 4),
                    w2a = *(const f32x4*)(cw + 2048 + c0), w2b = *(const f32x4*)(cw + 2048 + c0 + 4);
#pragma unroll
        for (int ai = 0; ai < 2; ++ai) { f32x4 gp0 = {0.f, 0.f, 0.f, 0.f}, gp1 = {0.f, 0.f, 0.f, 0.f}; const int blk = u.pm * 4 + ai * 2 + wr;
#pragma unroll
            for (int m = 0; m < 4; ++m) { const int row = u.pm * 256 + ai * 128 + wr * 64 + m * 16 + fr; const float rs = rstd_of(rowss, row); const float rs2 = rs * rs;
                const f32x4 g0 = acc[ai][0][m][0] * acc[ai][1][m][0] * rs2, g1 = acc[ai][0][m][1] * acc[ai][1][m][1] * rs2;
                f32x4 p1a, p2a, p1b, p2b;
#pragma unroll
                for (int j = 0; j < 4; ++j) { const float s1a = fr == 15 ? gp0[j] : g0[j], s2a = fr >= 14 ? gp0[j] : g0[j], s1b = fr == 15 ? gp1[j] : g1[j], s2b = fr >= 14 ? gp1[j] : g1[j];
                    p1a[j] = dpp_ror1(s1a); p2a[j] = dpp_ror2(s2a); p1b[j] = dpp_ror1(s1b); p2b[j] = dpp_ror2(s2b); }
                const f32x4 a0 = w0a * p2a + w1a * p1a + w2a * g0, a1 = w0b * p2b + w1b * p1b + w2b * g1;
                const bool valid = (m > 0 || fr >= 2) && !(sample && m == 2 && fr < 2);
                if (valid) *(v4u*)(zc + (size_t)row * 1024 + c0) = pack8(a0, a1);
                if ((m & 1) == 0 && fr < 2) { float* sg = SG + (size_t)(blk * 8 + 2 * m + fr) * 1024 + c0; *(f32x4*)sg = g0; *(f32x4*)(sg + 4) = g1; }
                if ((m & 1) == 1 && fr >= 14) { float* sg = SG + (size_t)(blk * 8 + 2 * m + fr - 14) * 1024 + c0; *(f32x4*)sg = g0; *(f32x4*)(sg + 4) = g1; }
                gp0 = g0; gp1 = g1; } }
    }
};


struct EpiCz {
    static constexpr bool PERM = true, AFTER_DRAIN = false;
    bf16* gb; const float* rowss; const float* cw; float* SG;
    __device__ __forceinline__ void operator()(EPI_ARGS) const {
        const int c0 = u.pn * 128 + wc * 32 + 8 * fq;
        const f32x4 w0a = *(const f32x4*)(cw + c0), w0b = *(const f32x4*)(cw + c0 + 4), w1a = *(const f32x4*)(cw + 1024 + c0), w1b = *(const f32x4*)(cw + 1024 + c0 + 4),
                    w2a = *(const f32x4*)(cw + 2048 + c0), w2b = *(const f32x4*)(cw + 2048 + c0 + 4);
#pragma unroll
        for (int ai = 0; ai < 2; ++ai) { f32x4 gp0 = {0.f, 0.f, 0.f, 0.f}, gp1 = {0.f, 0.f, 0.f, 0.f}; const int blk = u.pm * 4 + ai * 2 + wr;
#pragma unroll
            for (int m = 0; m < 4; ++m) { const int row = u.pm * 256 + ai * 128 + wr * 64 + m * 16 + fr; const float rs = rstd_of(rowss, row); const float rs2 = rs * rs;
                const f32x4 g0 = acc[ai][0][m][0] * acc[ai][1][m][0] * rs2, g1 = acc[ai][0][m][1] * acc[ai][1][m][1] * rs2;
                f32x4 p1a, p2a, p1b, p2b;
#pragma unroll
                for (int j = 0; j < 4; ++j) { const float s1a = fr == 15 ? gp0[j] : g0[j], s2a = fr >= 14 ? gp0[j] : g0[j], s1b = fr == 15 ? gp1[j] : g1[j], s2b = fr >= 14 ? gp1[j] : g1[j];
                    p1a[j] = dpp_ror1(s1a); p2a[j] = dpp_ror2(s2a); p1b[j] = dpp_ror1(s1b); p2b[j] = dpp_ror2(s2b); }
                const f32x4 a0 = w0a * p2a + w1a * p1a + w2a * g0, a1 = w0b * p2b + w1b * p1b + w2b * g1;
                if (m > 0 || fr >= 2) { bf16* gp = gb + (size_t)row * 1024 + c0; const v4u gw = *(const v4u*)gp;
                    const f32x4 b0 = (f32x4){bflo(gw.x), bfhi(gw.x), bflo(gw.y), bfhi(gw.y)}, b1 = (f32x4){bflo(gw.z), bfhi(gw.z), bflo(gw.w), bfhi(gw.w)};
                    *(v4u*)gp = pack8(a0 * b0, a1 * b1); }
                if ((m & 1) == 0 && fr < 2) { float* sg = SG + (size_t)(blk * 8 + 2 * m + fr) * 1024 + c0; *(f32x4*)sg = g0; *(f32x4*)(sg + 4) = g1; }
                if ((m & 1) == 1 && fr >= 14) { float* sg = SG + (size_t)(blk * 8 + 2 * m + fr - 14) * 1024 + c0; *(f32x4*)sg = g0; *(f32x4*)(sg + 4) = g1; }
                gp0 = g0; gp1 = g1; } }
    }
};

__device__ __forceinline__ int rowmap(int mode, int n) {
    if (mode == 1) { if (n >= 512 && n < 1152) { const int d = n & 63; return (n & ~63) | (32 * ((d >> 4) & 1) + 8 * ((d >> 2) & 3) + 4 * (d >> 5) + (d & 3)); } return n; }
    if (mode == 2) { return n < DFF ? ((n >> 7) * 256 + (n & 127)) : (((n - DFF) >> 7) * 256 + 128 + ((n - DFF) & 127)); }
    if (mode == 3) { if (n < 1024) return n; const int c = (n - 1024) & 1023, z = n >= 2048 ? 1 : 0; return 1024 + (c >> 7) * 256 + z * 128 + (c & 127); }
    return n;
}
__device__ __forceinline__ void tr_item(const float* W, int K, int N, bf16* WT, const float* gain, float scale, int mode, LAS float* scr, int item, int lane) {
    const int nblk = N / 32, kb = item / nblk, nb = item % nblk, k0 = 64 * kb, n0 = 32 * nb;
#pragma unroll
    for (int i = 0; i < 8; ++i) { const int idx = lane + 64 * i, kk = idx >> 3, n4 = (idx & 7) * 4; const float gs = gain ? ((const GAS float*)gain)[k0 + kk] * scale : scale;
        const f32x4 w = *(const GAS f32x4*)((const GAS float*)W + (size_t)(k0 + kk) * N + n0 + n4); LAS float* d = scr + kk * 33 + n4; d[0] = w[0] * gs; d[1] = w[1] * gs; d[2] = w[2] * gs; d[3] = w[3] * gs; }
    LDS_WAIT(); asm volatile("" ::: "memory");
    const int c = lane & 7;
#pragma unroll
    for (int j = 0; j < 4; ++j) { const int n = (lane >> 3) + 8 * j; const LAS float* s = scr + (8 * c) * 33 + n;
        v4u o; o.x = pg8::cvt_pk_bf16(s[0 * 33], s[1 * 33]); o.y = pg8::cvt_pk_bf16(s[2 * 33], s[3 * 33]); o.z = pg8::cvt_pk_bf16(s[4 * 33], s[5 * 33]); o.w = pg8::cvt_pk_bf16(s[6 * 33], s[7 * 33]);
        *(GAS v4u*)((GAS bf16*)WT + (size_t)rowmap(mode, n0 + n) * K + k0 + 8 * c) = o; }
    LDS_WAIT(); asm volatile("" ::: "memory");
}
__device__ __forceinline__ double dexp_(double y) {
    const double k = rint(y * 1.4426950408889634); const double r = (y - k * 0.6931471803691238) - k * 1.9082149292705877e-10;
    double p = 1.0 / 6227020800.0;
    p = p * r + 1.0 / 479001600.0; p = p * r + 1.0 / 39916800.0; p = p * r + 1.0 / 3628800.0; p = p * r + 1.0 / 362880.0; p = p * r + 1.0 / 40320.0; p = p * r + 1.0 / 5040.0;
    p = p * r + 1.0 / 720.0; p = p * r + 1.0 / 120.0; p = p * r + 1.0 / 24.0; p = p * r + 1.0 / 6.0; p = p * r + 0.5; p = p * r + 1.0; p = p * r + 1.0;
    const long long bits = (long long)(1023 + (int)k) << 52; return p * __builtin_bit_cast(double, bits);
}
__device__ __forceinline__ void dsincos_(double x, double& s, double& c) {
    const double k = rint(x * 0.6366197723675814); const double r = (x - k * 1.5707963267948966) - k * 6.123233995736766e-17; const double r2 = r * r;
    const double sp = r * (1.0 + r2 * (-1.0 / 6.0 + r2 * (1.0 / 120.0 + r2 * (-1.0 / 5040.0 + r2 * (1.0 / 362880.0 + r2 * (-1.0 / 39916800.0 + r2 * (1.0 / 6227020800.0)))))));
    const double cp = 1.0 + r2 * (-0.5 + r2 * (1.0 / 24.0 + r2 * (-1.0 / 720.0 + r2 * (1.0 / 40320.0 + r2 * (-1.0 / 3628800.0 + r2 * (1.0 / 479001600.0 + r2 * (-1.0 / 87178291200.0)))))));
    const int q = ((int)k) & 3;
    s = q == 0 ? sp : q == 1 ? cp : q == 2 ? -sp : -cp; c = q == 0 ? cp : q == 1 ? -sp : q == 2 ? -cp : sp;
}

__device__ __forceinline__ const bf16* kvptr(const bf16* proj, const bf16* cb, int sample, int b, int c, int kvh, int kk, int isv) {
    if (!sample) { int pos = (c - 2) * 64 + kk; pos = pos < 0 ? 0 : pos; return proj + (size_t)(b * 4096 + pos) * 1280 + 1024 + isv * 128 + kvh * 64; }
    if (kk < 128) return cb + (size_t)(b * 128 + kk) * 128 + kvh * 64;
    int t = kk - 128; t = t > 31 ? 31 : t; return proj + (size_t)(MP + b * 32 + t) * 1280 + 1024 + isv * 128 + kvh * 64;
}
__device__ __forceinline__ void swa_phase(const bf16* proj, const bf16* ckb, const bf16* cvb, const float* sinks, bf16* ycat, LAS unsigned char* lds, int tid, int wave, int lane, int G) {
    LAS bf16* VT = (LAS bf16*)lds;
    const int fr = lane & 15, quad = lane >> 4;
    for (int it = blockIdx.x; it < 528; it += G) {
        int b, c, kvh, sample;
        if (it < 512) { sample = 0; b = it >> 7; c = (it >> 1) & 63; kvh = it & 1; } else { sample = 1; b = (it - 512) >> 1; c = 0; kvh = it & 1; }
        __syncthreads();
#pragma unroll
        for (int i = 0; i < 3; ++i) { const int idx = tid + 512 * i, kk = idx % 192, dg = idx / 192; const v4u w = *(const GAS v4u*)((const GAS bf16*)kvptr(proj, cvb, sample, b, c, kvh, kk, 1) + dg * 8);
            LAS bf16* vp = VT + (dg * 8) * 200 + kk;
            vp[0] = (bf16)(w.x & 0xffffu); vp[200] = (bf16)(w.x >> 16); vp[400] = (bf16)(w.y & 0xffffu); vp[600] = (bf16)(w.y >> 16);
            vp[800] = (bf16)(w.z & 0xffffu); vp[1000] = (bf16)(w.z >> 16); vp[1200] = (bf16)(w.w & 0xffffu); vp[1400] = (bf16)(w.w >> 16); }
        __syncthreads();
        const int gq = wave >> 1, qhalf = wave & 1, head = kvh * 4 + gq;
        if (!(sample && qhalf)) {
            const int plo = sample ? 0 : (c >= 2 ? 0 : (2 - c) * 2), phi = sample ? 5 : 6;
            bf16x8 qf[2][2];
#pragma unroll
            for (int qb = 0; qb < 2; ++qb) { const int q = qhalf * 32 + qb * 16 + fr; const int row = sample ? MP + b * 32 + (q & 31) : b * 4096 + c * 64 + q;
                const GAS bf16* qp = (const GAS bf16*)proj + (size_t)row * 1280 + 512 + head * 64 + quad * 8; qf[qb][0] = *(const GAS bf16x8*)qp; qf[qb][1] = *(const GAS bf16x8*)(qp + 32); }
            f32x4 s[12][2];
#pragma unroll
            for (int kg = 0; kg < 3; ++kg) { bf16x8 kf[4][2];
#pragma unroll
                for (int i = 0; i < 4; ++i) { const int kb = kg * 4 + i, key = 32 * (kb >> 1) + (fr >> 2) * 8 + 4 * (kb & 1) + (fr & 3); const GAS bf16* kp = (const GAS bf16*)kvptr(proj, ckb, sample, b, c, kvh, key, 0) + quad * 8;
                    kf[i][0] = *(const GAS bf16x8*)kp; kf[i][1] = *(const GAS bf16x8*)(kp + 32); }
                __builtin_amdgcn_sched_barrier(0);
#pragma unroll
                for (int i = 0; i < 4; ++i)
#pragma unroll
                    for (int qb = 0; qb < 2; ++qb) { f32x4 a = {0.f, 0.f, 0.f, 0.f}; a = MFMA16(kf[i][0], qf[qb][0], a); a = MFMA16(kf[i][1], qf[qb][1], a); s[kg * 4 + i][qb] = a; }
                __builtin_amdgcn_sched_barrier(0); }
            const float sink = sinks[head];
            bf16x8 pf[6][2];
#pragma unroll
            for (int qb = 0; qb < 2; ++qb) { float mx = sink;
#pragma unroll
                for (int kb = 0; kb < 12; ++kb) { const bool pv = (kb >> 1) >= plo && (kb >> 1) < phi;
#pragma unroll
                    for (int j = 0; j < 4; ++j) { const float v = pv ? s[kb][qb][j] : -1e30f; s[kb][qb][j] = v; mx = fmaxf(mx, v); } }
                mx = fmaxf(mx, __shfl_xor(mx, 16)); mx = fmaxf(mx, __shfl_xor(mx, 32));
                float sum = 0.f;
#pragma unroll
                for (int kb = 0; kb < 12; ++kb)
#pragma unroll
                    for (int j = 0; j < 4; ++j) { const float e = __expf(s[kb][qb][j] - mx); s[kb][qb][j] = e; sum += e; }
                sum += __shfl_xor(sum, 16); sum += __shfl_xor(sum, 32); sum += __expf(sink - mx);
                const float inv = 1.0f / sum;
#pragma unroll
                for (int pr = 0; pr < 6; ++pr) pf[pr][qb] = __builtin_bit_cast(bf16x8, pack8(s[2 * pr][qb] * inv, s[2 * pr + 1][qb] * inv)); }
#pragma unroll
            for (int db = 0; db < 4; ++db) { bf16x8 vf[6];
#pragma unroll
                for (int pr = 0; pr < 6; ++pr) vf[pr] = *(const LAS bf16x8*)(VT + (db * 16 + fr) * 200 + 32 * pr + quad * 8);
#pragma unroll
                for (int qb = 0; qb < 2; ++qb) { f32x4 o = {0.f, 0.f, 0.f, 0.f};
#pragma unroll
                    for (int pr = 0; pr < 6; ++pr) o = MFMA16(pf[pr][qb], vf[pr], o);
#pragma unroll
                    for (int j = 0; j < 4; ++j) { const int q = qhalf * 32 + qb * 16 + quad * 4 + j;
                        if (!sample || q < 32) { const int row = sample ? MP + b * 32 + q : b * 4096 + c * 64 + q; ycat[(size_t)row * 1024 + 512 + head * 64 + db * 16 + fr] = (bf16)f2bf(o[j]); } } } }
        }
    }
    __syncthreads();
}

__device__ __forceinline__ void xattn_phase(const bf16* qx, const bf16* memk_l, const bf16* memvT_l, bf16* ox, int wave, int lane, int G) {
    const int fr = lane & 15, quad = lane >> 4;
    for (int t = wave * G + (int)blockIdx.x; t < 4160; t += 8 * G) {
        int bb, h, row0;
        if (t < 4096) { const int pair = t >> 8; bb = pair >> 2; h = pair & 3; row0 = bb * 4096 + (t & 255) * 16; }
        else { const int s = t - 4096, b = s >> 3; h = (s >> 1) & 3; bb = 4 + b; row0 = MP + b * 32 + (s & 1) * 16; }
        bf16x8 qf[8];
#pragma unroll
        for (int ks = 0; ks < 8; ++ks) qf[ks] = *(const bf16x8*)(qx + (size_t)(row0 + fr) * 1024 + h * 256 + ks * 32 + quad * 8);
        const bf16* kbase = memk_l + (size_t)bb * 262144 + h * 256 + quad * 8;
        f32x4 s[16];
#pragma unroll
        for (int kb = 0; kb < 16; ++kb) { const int key = 32 * (kb >> 1) + (fr >> 2) * 8 + 4 * (kb & 1) + (fr & 3); const bf16* kp = kbase + (size_t)key * 1024; f32x4 a = {0.f, 0.f, 0.f, 0.f};
#pragma unroll
            for (int ks = 0; ks < 8; ++ks) a = MFMA16(*(const bf16x8*)(kp + ks * 32), qf[ks], a);
            s[kb] = a; }
        float mx = -1e30f;
#pragma unroll
        for (int kb = 0; kb < 16; ++kb)
#pragma unroll
            for (int j = 0; j < 4; ++j) mx = fmaxf(mx, s[kb][j]);
        mx = fmaxf(mx, __shfl_xor(mx, 16)); mx = fmaxf(mx, __shfl_xor(mx, 32));
        float sum = 0.f;
#pragma unroll
        for (int kb = 0; kb < 16; ++kb)
#pragma unroll
            for (int j = 0; j < 4; ++j) { const float e = __expf(s[kb][j] - mx); s[kb][j] = e; sum += e; }
        sum += __shfl_xor(sum, 16); sum += __shfl_xor(sum, 32);
        const float inv = 1.0f / sum;
        bf16x8 pf[8];
#pragma unroll
        for (int pr = 0; pr < 8; ++pr) pf[pr] = __builtin_bit_cast(bf16x8, pack8(s[2 * pr] * inv, s[2 * pr + 1] * inv));
        const bf16* vbase = memvT_l + (size_t)bb * 262144 + (size_t)(h * 256 + fr) * 256 + quad * 8;
#pragma unroll 4
        for (int db = 0; db < 16; ++db) { f32x4 o = {0.f, 0.f, 0.f, 0.f};
#pragma unroll
            for (int pr = 0; pr < 8; ++pr) o = MFMA16(pf[pr], *(const bf16x8*)(vbase + (size_t)db * 4096 + pr * 32), o);
#pragma unroll
            for (int j = 0; j < 4; ++j) ox[(size_t)(row0 + quad * 4 + j) * 1024 + h * 256 + db * 16 + fr] = (bf16)f2bf(o[j]); }
    }
}


__device__ __forceinline__ void xstage(const bf16* src, size_t rowstride, LAS unsigned char* lds, int tid) {
    v4u t[16];
#pragma unroll
    for (int i = 0; i < 16; ++i) { const int row = (tid >> 5) + 16 * i, ch = tid & 31; t[i] = *(const GAS v4u*)((const GAS bf16*)src + (size_t)row * rowstride + ch * 8); }
#pragma unroll
    for (int i = 0; i < 16; ++i) { const int row = (tid >> 5) + 16 * i, ch = tid & 31; *(LAS v4u*)(lds + row * 528 + ch * 16) = t[i]; }
}
__device__ __forceinline__ void xattn_phase2(const bf16* qx, const bf16* memk_l, const bf16* memvT_l, bf16* ox, LAS unsigned char* lds, int tid, int wave, int lane, int G) {
    const int fr = lane & 15, quad = lane >> 4;
    for (int it = blockIdx.x; it < 256 + 32; it += G) {
        int bb, h, rowbase, nqb; bool active;
        if (it < 256) { bb = it >> 6; h = (it >> 4) & 3; rowbase = bb * 4096 + (it & 15) * 256; nqb = 2; active = true; }
        else { const int s = it - 256, b = s >> 2; h = s & 3; bb = 4 + b; rowbase = MP + b * 32; nqb = 1; active = wave < 2; }
        __syncthreads();
        xstage(memk_l + (size_t)bb * 262144 + h * 256, 1024, lds, tid);
        __syncthreads();
        bf16x8 pf[2][8];
#pragma unroll
        for (int qi = 0; qi < 2; ++qi) {
            if (qi < nqb && active) {
                const int row0 = rowbase + qi * 128 + wave * 16;
                bf16x8 qf[8];
#pragma unroll
                for (int ks = 0; ks < 8; ++ks) qf[ks] = *(const GAS bf16x8*)((const GAS bf16*)qx + (size_t)(row0 + fr) * 1024 + h * 256 + ks * 32 + quad * 8);
                f32x4 s[16];
#pragma unroll
                for (int kb = 0; kb < 16; ++kb) { const int key = 32 * (kb >> 1) + (fr >> 2) * 8 + 4 * (kb & 1) + (fr & 3); const LAS unsigned char* kp = lds + key * 528 + quad * 16; f32x4 a = {0.f, 0.f, 0.f, 0.f};
#pragma unroll
                    for (int ks = 0; ks < 8; ++ks) a = MFMA16(*(const LAS bf16x8*)(kp + ks * 64), qf[ks], a);
                    s[kb] = a; }
                float mx = -1e30f;
#pragma unroll
                for (int kb = 0; kb < 16; ++kb)
#pragma unroll
                    for (int j = 0; j < 4; ++j) mx = fmaxf(mx, s[kb][j]);
                mx = fmaxf(mx, __shfl_xor(mx, 16)); mx = fmaxf(mx, __shfl_xor(mx, 32));
                float sum = 0.f;
#pragma unroll
                for (int kb = 0; kb < 16; ++kb)
#pragma unroll
                    for (int j = 0; j < 4; ++j) { const float e = __expf(s[kb][j] - mx); s[kb][j] = e; sum += e; }
                sum += __shfl_xor(sum, 16); sum += __shfl_xor(sum, 32);
                const float inv = 1.0f / sum;
#pragma unroll
                for (int pr = 0; pr < 8; ++pr) pf[qi][pr] = __builtin_bit_cast(bf16x8, pack8(s[2 * pr] * inv, s[2 * pr + 1] * inv));
            }
        }
        __syncthreads();
        xstage(memvT_l + (size_t)bb * 262144 + (size_t)h * 65536, 256, lds, tid);
        __syncthreads();
        if (active) {
            const int rowA = rowbase + wave * 16, rowB = rowA + 128;
#pragma unroll 4
            for (int db = 0; db < 16; ++db) { f32x4 oa = {0.f, 0.f, 0.f, 0.f}, ob = {0.f, 0.f, 0.f, 0.f}; const LAS unsigned char* vp = lds + (db * 16 + fr) * 528 + quad * 16;
                if (nqb == 2) {
#pragma unroll
                    for (int pr = 0; pr < 8; ++pr) { const bf16x8 vf = *(const LAS bf16x8*)(vp + pr * 64); oa = MFMA16(vf, pf[0][pr], oa); ob = MFMA16(vf, pf[1][pr], ob); }
                } else {
#pragma unroll
                    for (int pr = 0; pr < 8; ++pr) { const bf16x8 vf = *(const LAS bf16x8*)(vp + pr * 64); oa = MFMA16(vf, pf[0][pr], oa); }
                }
                u32x2v w; w.x = pk2(oa[0], oa[1]); w.y = pk2(oa[2], oa[3]);
                *(GAS u32x2v*)((GAS bf16*)ox + (size_t)(rowA + fr) * 1024 + h * 256 + db * 16 + quad * 4) = w;
                if (nqb == 2) { u32x2v w2; w2.x = pk2(ob[0], ob[1]); w2.y = pk2(ob[2], ob[3]); *(GAS u32x2v*)((GAS bf16*)ox + (size_t)(rowB + fr) * 1024 + h * 256 + db * 16 + quad * 4) = w2; } }
        }
    }
    __syncthreads();
}

__device__ __forceinline__ void s5_stage_u(const bf16* up, LAS float* ubuf, int lane) {
    const v4u w0 = *(const v4u*)up, w1 = *(const v4u*)(up + 8);
    LAS f32x4* d = (LAS f32x4*)(ubuf + lane * 16);
    d[0] = (f32x4){bflo(w0.x), bfhi(w0.x), bflo(w0.y), bfhi(w0.y)}; d[1] = (f32x4){bflo(w0.z), bfhi(w0.z), bflo(w0.w), bfhi(w0.w)};
    d[2] = (f32x4){bflo(w1.x), bfhi(w1.x), bflo(w1.y), bfhi(w1.y)}; d[3] = (f32x4){bflo(w1.z), bfhi(w1.z), bflo(w1.w), bfhi(w1.w)};
}
__device__ __forceinline__ f32x2v lo2_(f32x4 v) { return __builtin_shufflevector(v, v, 0, 1); }
__device__ __forceinline__ f32x2v hi2_(f32x4 v) { return __builtin_shufflevector(v, v, 2, 3); }
#define S5_STEP(sidx) do { const LAS f32x4* up_ = (const LAS f32x4*)(ubuf + (sidx) * 16); const f32x4 u0 = up_[0], u1 = up_[1], u2 = up_[2], u3 = up_[3]; \
    f32x2v ac_ = lo2_(bb[0]) * u0[0]; ac_ = hi2_(bb[0]) * u0[1] + ac_; ac_ = lo2_(bb[1]) * u0[2] + ac_; ac_ = hi2_(bb[1]) * u0[3] + ac_; \
    ac_ = lo2_(bb[2]) * u1[0] + ac_; ac_ = hi2_(bb[2]) * u1[1] + ac_; ac_ = lo2_(bb[3]) * u1[2] + ac_; ac_ = hi2_(bb[3]) * u1[3] + ac_; \
    ac_ = lo2_(bb[4]) * u2[0] + ac_; ac_ = hi2_(bb[4]) * u2[1] + ac_; ac_ = lo2_(bb[5]) * u2[2] + ac_; ac_ = hi2_(bb[5]) * u2[3] + ac_; \
    ac_ = lo2_(bb[6]) * u3[0] + ac_; ac_ = hi2_(bb[6]) * u3[1] + ac_; ac_ = lo2_(bb[7]) * u3[2] + ac_; ac_ = hi2_(bb[7]) * u3[3] + ac_; \
    const float nr_ = ar * hr - ai * hi + ac_.x, ni_ = ar * hi + ai * hr + ac_.y; hr = nr_; hi = ni_; } while (0)

typedef short bf16x4_t __attribute__((ext_vector_type(4)));
#define MFMA16K16(a, b, c) __builtin_amdgcn_mfma_f32_16x16x16bf16_1k(a, b, c, 0, 0, 0)
__device__ __forceinline__ bf16x4_t s5_load_u(const bf16* urow0, int fr, int quad) { return *(const GAS bf16x4_t*)((const GAS bf16*)urow0 + (size_t)fr * 1280 + quad * 4); }
__device__ __forceinline__ void s5_bu_block(const bf16x4_t a, const bf16x4_t (&bcf)[8], LAS float* bul, int fr, int quad) {
#pragma unroll
    for (int cb = 0; cb < 8; ++cb) { f32x4 d = {0.f, 0.f, 0.f, 0.f}; d = MFMA16K16(a, bcf[cb], d);
#pragma unroll
        for (int j = 0; j < 4; ++j) bul[(quad * 4 + j) * 130 + cb * 16 + fr] = d[j]; }
}
__device__ __forceinline__ void s5_local(const bf16* proj, const float* abar, const bf16* bbt, float* sloc, LAS float* bul, int slot, int nslots, int lane) {
    const int fr = lane & 15, quad = lane >> 4;
    for (int t = slot; t < 8192; t += nslots) {
        const int chunk = t & 63, g = (t >> 6) & 31, b = t >> 11;
        const float ar = abar[(g * 64 + lane) * 2], ai = abar[(g * 64 + lane) * 2 + 1];
        bf16x4_t bcf[8];
#pragma unroll
        for (int cb = 0; cb < 8; ++cb) bcf[cb] = *(const GAS bf16x4_t*)((const GAS bf16*)bbt + (size_t)(g * 128 + cb * 16 + fr) * 16 + quad * 4);
        float hr = 0.f, hi = 0.f;
        bf16x4_t ua[4];
#pragma unroll
        for (int blk = 0; blk < 4; ++blk) ua[blk] = s5_load_u(proj + (size_t)(b * 4096 + chunk * 64 + blk * 16) * 1280 + g * 16, fr, quad);
#pragma unroll
        for (int blk = 0; blk < 4; ++blk) {
            s5_bu_block(ua[blk], bcf, bul, fr, quad);
#pragma unroll 4
            for (int s = 0; s < 16; ++s) { const f32x2v bu = *(const LAS f32x2v*)(bul + s * 130 + 2 * lane); const float nr = ar * hr - ai * hi + bu.x, ni = ar * hi + ai * hr + bu.y; hr = nr; hi = ni; }
        }
        *(f32x2v*)(sloc + (size_t)t * 128 + lane * 2) = (f32x2v){hr, hi};
    }
}
__device__ __forceinline__ void s5_out(const bf16* proj, const float* abar, const bf16* bbt, const float* sloc, const float* st_re, const float* st_im, const float* c_re, const float* c_im,
                                       const float* dcoef, bf16* gbuf, float* out, LAS float* bul, LAS unsigned* hbuf, int slot, int nslots, int lane) {
    const int fr = lane & 15, quad = lane >> 4;
    for (int t = slot; t < 8192 + 256; t += nslots) {
        const int sample = t >= 8192; int b, g, chunk, nblk, rowbase;
        if (!sample) { chunk = t & 63; g = (t >> 6) & 31; b = t >> 11; nblk = 4; rowbase = b * 4096 + chunk * 64; } else { const int s = t - 8192; g = s & 31; b = s >> 5; chunk = 0; nblk = 2; rowbase = MP + b * 32; }
        const float ar = abar[(g * 64 + lane) * 2], ai = abar[(g * 64 + lane) * 2 + 1];
        bf16x4_t bcf[8];
#pragma unroll
        for (int cb = 0; cb < 8; ++cb) bcf[cb] = *(const GAS bf16x4_t*)((const GAS bf16*)bbt + (size_t)(g * 128 + cb * 16 + fr) * 16 + quad * 4);
        float hr, hi;
        if (!sample) { float pr = ar, pi = ai;
#pragma unroll
            for (int i = 0; i < 6; ++i) { const float t1 = pr * pr - pi * pi; pi = 2.f * pr * pi; pr = t1; }
            hr = 0.f; hi = 0.f; const float* sp = sloc + (size_t)(t - chunk) * 128 + lane * 2;
#pragma unroll 16
            for (int cc = 0; cc < chunk; ++cc) { const f32x2v sv = *(const f32x2v*)(sp + (size_t)cc * 128); const float nr = pr * hr - pi * hi + sv.x, ni = pr * hi + pi * hr + sv.y; hr = nr; hi = ni; } }
        else { hr = st_re[(b * 32 + g) * 64 + lane]; hi = st_im[(b * 32 + g) * 64 + lane]; }
        bf16x8 cf[4];
#pragma unroll
        for (int ks = 0; ks < 4; ++ks) { const f32x4 cr = *(const f32x4*)(c_re + (size_t)(g * 16 + fr) * 64 + ks * 16 + quad * 4), ci = *(const f32x4*)(c_im + (size_t)(g * 16 + fr) * 64 + ks * 16 + quad * 4);
            v4u w; w.x = pg8::cvt_pk_bf16(cr[0], -ci[0]); w.y = pg8::cvt_pk_bf16(cr[1], -ci[1]); w.z = pg8::cvt_pk_bf16(cr[2], -ci[2]); w.w = pg8::cvt_pk_bf16(cr[3], -ci[3]); cf[ks] = __builtin_bit_cast(bf16x8, w); }
        const float dco = dcoef[g * 16 + fr];
        bf16x4_t ua[4]; bf16 uraw[4][4];
#pragma unroll
        for (int blk = 0; blk < 4; ++blk) { const int bc = blk < nblk ? blk : nblk - 1; const bf16* urow0 = proj + (size_t)(rowbase + bc * 16) * 1280 + g * 16; ua[blk] = s5_load_u(urow0, fr, quad);
#pragma unroll
            for (int j = 0; j < 4; ++j) uraw[blk][j] = ((const GAS bf16*)urow0)[(size_t)(quad * 4 + j) * 1280 + fr]; }
#pragma unroll
        for (int blk = 0; blk < 4; ++blk) { if (blk < nblk) {
            s5_bu_block(ua[blk], bcf, bul, fr, quad);
#pragma unroll 4
            for (int s = 0; s < 16; ++s) { const f32x2v bu = *(const LAS f32x2v*)(bul + s * 130 + 2 * lane); const float nr = ar * hr - ai * hi + bu.x, ni = ar * hi + ai * hr + bu.y; hr = nr; hi = ni; hbuf[s * 68 + lane] = pg8::cvt_pk_bf16(hr, hi); }
            f32x4 y = {0.f, 0.f, 0.f, 0.f};
#pragma unroll
            for (int ks = 0; ks < 4; ++ks) { const bf16x8 a = *(const LAS bf16x8*)(hbuf + fr * 68 + ks * 16 + quad * 4); y = MFMA16(a, cf[ks], y); }
#pragma unroll
            for (int j = 0; j < 4; ++j) { const int s = blk * 16 + quad * 4 + j; const float uu = bflo((unsigned)uraw[blk][j]); const float yv = y[j] + dco * uu;
                const float z = 0.7978845608028654f * (yv + 0.044715f * yv * yv * yv); const float th = 1.0f - 2.0f / (1.0f + __expf(2.0f * z)); const float gl = 0.5f * yv * (1.0f + th);
                ((GAS bf16*)gbuf)[(size_t)(rowbase + s) * 512 + g * 16 + fr] = (bf16)f2bf(gl); }
        } }
        if (!sample && chunk == 63) { out[OFF_SRP + (b * 32 + g) * 64 + lane] = hr; out[OFF_SIP + (b * 32 + g) * 64 + lane] = hi; }
        if (sample) { out[OFF_SRS + (b * 32 + g) * 64 + lane] = hr; out[OFF_SIS + (b * 32 + g) * 64 + lane] = hi; }
    }
}

template <int KIND>
__device__ __forceinline__ void sample_gemm(const bf16* A, const bf16* Bt, int K, LAS unsigned char* lds, int tid, int wave, int lane,
                                            bf16* xbp, const float* base_f32, float* part_next, const float* part_cur, bf16* O) {
    const int fr = lane & 15, quad = lane >> 4;
    LAS f32x4* red = (LAS f32x4*)lds;
    LAS float* ssred = (LAS float*)(lds + 32768);
    for (int tile = blockIdx.x; tile < 256; tile += gridDim.x) {
        const int r0 = MP + (tile >> 4) * 16, c0 = (tile & 15) * 64, kw = K >> 3;
        const bf16* ap = A + (size_t)(r0 + fr) * K + wave * kw + quad * 8;
        const bf16* bp = Bt + (size_t)(c0 + fr) * K + wave * kw + quad * 8;
        f32x4 acc[4];
#pragma unroll
        for (int cb = 0; cb < 4; ++cb) acc[cb] = (f32x4){0.f, 0.f, 0.f, 0.f};
        const int nks = kw >> 5;
        for (int k0 = 0; k0 < nks; k0 += 4) {
            bf16x8 a[4], b[4][4];
#pragma unroll
            for (int i = 0; i < 4; ++i) { const int ks = (k0 + i < nks) ? k0 + i : nks - 1;
                a[i] = *(const bf16x8*)(ap + ks * 32);
#pragma unroll
                for (int cb = 0; cb < 4; ++cb) b[i][cb] = *(const bf16x8*)(bp + (size_t)cb * 16 * K + ks * 32); }
            __builtin_amdgcn_sched_barrier(0);
#pragma unroll
            for (int i = 0; i < 4; ++i) if (k0 + i < nks) {
#pragma unroll
                for (int cb = 0; cb < 4; ++cb) acc[cb] = MFMA16(b[i][cb], a[i], acc[cb]); }
        }
#pragma unroll
        for (int cb = 0; cb < 4; ++cb) red[(wave * 4 + cb) * 64 + lane] = acc[cb] * 1.0f;
        __syncthreads();
        if (tid < 256) { const int cb = tid >> 6, l2 = tid & 63; f32x4 v = red[cb * 64 + l2];
#pragma unroll
            for (int w = 1; w < 8; ++w) v = v + red[(w * 4 + cb) * 64 + l2];
            const int row = r0 + (l2 & 15), col = c0 + cb * 16 + 4 * (l2 >> 4); const size_t off = (size_t)row * 1024 + col;
            if (KIND == 0) { f32x4 bs;
                if (base_f32) bs = *(const f32x4*)(base_f32 + off);
                else { const u32x2v w = *(const u32x2v*)(xbp + off); bs = (f32x4){bflo(w.x), bfhi(w.x), bflo(w.y), bfhi(w.y)}; }
                v = v + bs; u32x2v o; o.x = pk2(v[0], v[1]); o.y = pk2(v[2], v[3]); *(u32x2v*)(xbp + off) = o;
                float ss = (v[0] * v[0] + v[1] * v[1]) + (v[2] * v[2] + v[3] * v[3]); ss += __shfl_xor(ss, 16); ss += __shfl_xor(ss, 32);
                if ((l2 >> 4) == 0) ssred[cb * 16 + (l2 & 15)] = ss; }
            else { const float rs = rstd_of(part_cur, row); u32x2v o; o.x = pk2(v[0] * rs, v[1] * rs); o.y = pk2(v[2] * rs, v[3] * rs); *(u32x2v*)(O + off) = o; }
        }
        if (KIND == 0) { __syncthreads(); if (tid < 16) part_next[(size_t)(r0 + tid) * 16 + (tile & 15)] = (ssred[tid] + ssred[16 + tid]) + (ssred[32 + tid] + ssred[48 + tid]); }
        __syncthreads();
    }
}


__device__ __forceinline__ void sample_cz(const bf16* A, const bf16* Bt, LAS unsigned char* lds, int tid, int wave, int lane,
                                          const float* part_cur, const float* cw, const float* st, bf16* zcp, float* outp) {
    const int fr = lane & 15, quad = lane >> 4;
    LAS f32x4* red = (LAS f32x4*)lds;
    LAS float* T = (LAS float*)(lds + 65536);
    LAS float* CZ = (LAS float*)(lds + 65536 + 8192);
    for (int tile = blockIdx.x; tile < 256; tile += gridDim.x) {
        const int b = tile >> 5, c0 = (tile & 31) * 32, r0 = MP + b * 32;
        const int wrow = 1024 + (c0 >> 7) * 256 + (c0 & 127);
        const GAS bf16* ap = (const GAS bf16*)A + (size_t)(r0 + fr) * 1024 + wave * 128 + quad * 8;
        const GAS bf16* bp = (const GAS bf16*)Bt + (size_t)(wrow + fr) * 1024 + wave * 128 + quad * 8;
        bf16x8 a[4][2], bw[4][4];
#pragma unroll
        for (int ks = 0; ks < 4; ++ks) {
#pragma unroll
            for (int rb = 0; rb < 2; ++rb) a[ks][rb] = *(const GAS bf16x8*)(ap + (size_t)rb * 16 * 1024 + ks * 32);
#pragma unroll
            for (int cb = 0; cb < 4; ++cb) bw[ks][cb] = *(const GAS bf16x8*)(bp + (size_t)((cb >> 1) * 128 + (cb & 1) * 16) * 1024 + ks * 32); }
        f32x4 acc[2][4];
#pragma unroll
        for (int rb = 0; rb < 2; ++rb)
#pragma unroll
            for (int cb = 0; cb < 4; ++cb) { f32x4 d = {0.f, 0.f, 0.f, 0.f};
#pragma unroll
                for (int ks = 0; ks < 4; ++ks) d = MFMA16(bw[ks][cb], a[ks][rb], d);
                acc[rb][cb] = d; }
#pragma unroll
        for (int rb = 0; rb < 2; ++rb)
#pragma unroll
            for (int cb = 0; cb < 4; ++cb) red[(wave * 8 + rb * 4 + cb) * 64 + lane] = acc[rb][cb];
        __syncthreads();
        {
            const int blk = tid >> 6, l2 = tid & 63, rb = blk >> 2, cb = blk & 3; f32x4 v = red[blk * 64 + l2];
#pragma unroll
            for (int w = 1; w < 8; ++w) v = v + red[(w * 8 + blk) * 64 + l2];
            *(LAS f32x4*)(T + ((cb >> 1) * 32 + rb * 16 + (l2 & 15)) * 32 + (cb & 1) * 16 + 4 * (l2 >> 4)) = v; }
        __syncthreads();
        const int r = tid >> 3, cq = (tid & 7) * 4;
        if (tid < 256) { const float rs = rstd_of(part_cur, r0 + r); const float rs2 = rs * rs;
            const f32x4 gc = *(const LAS f32x4*)(T + r * 32 + cq), zz = *(const LAS f32x4*)(T + (32 + r) * 32 + cq);
            *(LAS f32x4*)(CZ + r * 32 + cq) = gc * zz * rs2; }
        __syncthreads();
        if (tid < 256) { const int c = c0 + cq;
            const f32x4 x0 = *(const LAS f32x4*)(CZ + r * 32 + cq);
            const f32x4 s0 = *(const f32x4*)(st + (size_t)(b * 2) * 1024 + c), s1 = *(const f32x4*)(st + (size_t)(b * 2 + 1) * 1024 + c);
            f32x4 xm1 = s1, xm2 = s0;
            if (r >= 1) { xm1 = *(const LAS f32x4*)(CZ + (r - 1) * 32 + cq); xm2 = s1; }
            if (r >= 2) xm2 = *(const LAS f32x4*)(CZ + (r - 2) * 32 + cq);
            const f32x4 w0 = *(const f32x4*)(cw + c), w1 = *(const f32x4*)(cw + 1024 + c), w2 = *(const f32x4*)(cw + 2048 + c);
            const f32x4 z = w0 * xm2 + w1 * xm1 + w2 * x0;
            bf16* gp = zcp + (size_t)(r0 + r) * 1024 + c; const u32x2v gw = *(const u32x2v*)gp;
            u32x2v o; o.x = pk2(z[0] * bflo(gw.x), z[1] * bfhi(gw.x)); o.y = pk2(z[2] * bflo(gw.y), z[3] * bfhi(gw.y)); *(u32x2v*)gp = o;
            if (r >= 30) *(f32x4*)(outp + OFF_CMS + (size_t)(b * 2 + (r - 30)) * 1024 + c) = x0; }
        __syncthreads();
    }
}

struct Params { const float* in[36]; float* out; unsigned char* ws; int use_cg, pad; };

__global__ void __launch_bounds__(512, 2) mega_fwd(Params P) {
    extern __shared__ __attribute__((aligned(16))) unsigned char lds_raw[];
    LAS unsigned char* lds = (LAS unsigned char*)lds_raw;
    volatile LAS unsigned* MISC = (volatile LAS unsigned*)(lds + MISC_OFF);
    const int G = gridDim.x, NGW = G * 8, NT = G * 512;
    const int wave_s = __builtin_amdgcn_readfirstlane(threadIdx.x >> 6);
    for (int u = threadIdx.x; u < (LDS_BYTES - 131072) / 4; u += 512) ((LAS unsigned*)(lds + 131072))[u] = 0u;
    __syncthreads();
    XcdBarrier bar = xcd_barrier_post((unsigned*)(P.ws + WS_BAR), MISC + 8);
#ifndef STOP_AFTER
#define STOP_AFTER 1000
#endif
    int ph = 0;
#define RUN (ph < STOP_AFTER)
#define FRESH() const int tid = fresh_tid(wave_s), lane = tid & 63, wave = __builtin_amdgcn_readfirstlane(tid >> 6); const int gw = blockIdx.x * 8 + wave, gt = blockIdx.x * 512 + tid; (void)gw; (void)gt; (void)lane; LAS float* wscr = (LAS float*)(lds + 32768 + wave * 12288); (void)wscr;
#define SEAM() do { if (P.use_cg) cg::this_grid().sync(); else xcd_barrier(bar); ++ph; } while (0)

#define part ((float*)(ws + WS_PART))
#define PARTBUF(k) (part + (size_t)((k) & 1) * PART_ELEMS)
#define ropec ((float*)(ws + WS_ROPE))
#define ropes (ropec + 4096 * 32)
#define abar ((float*)(ws + WS_SSM))
#define bbar (abar + 32 * 64 * 2)
#define bbt ((bf16*)(bbar + 32 * 64 * 32))
#define ckb ((bf16*)(ws + WS_CKV))
#define cvb (ckb + 8 * 128 * 128)
#define sloc ((float*)(ws + WS_SLOC))
#define memk ((bf16*)(ws + WS_MEMK))
#define memvT ((bf16*)(ws + WS_MEMVT))
#define SG ((float*)(ws + WS_SIDE))
#define SV ((float*)(ws + WS_SIDE + SG_BYTES))
#define WT ((bf16*)(ws + WS_WT))
#define xb ((bf16*)(ws + WS_XB))
#define tmp (ws + WS_TMP)
#define proj0 ((bf16*)(tmp + TMP_PROJ0))
#define gbuf ((bf16*)(tmp + TMP_GBUF))
#define ycat ((bf16*)(tmp + TMP_YCAT))
#define memb ((bf16*)(tmp + TMP_MEMB))
#define qx ((bf16*)(tmp + TMP_QX))
#define ox ((bf16*)(tmp + TMP_OX))
#define act ((bf16*)(tmp + TMP_ACT))
#define gbm ((bf16*)(tmp + TMP_GB))
#define zc ((bf16*)(tmp + TMP_ZC))
#define PTRS() unsigned char* ws = P.ws; float* out = P.out; asm volatile("" : "+s"(ws), "+s"(out));
    if (RUN) { PTRS() FRESH()
        {
            constexpr int NITEMS = 640 + 128 + 512 + 512 + 2 * 1024 + 512 + 2816 + 1408 + 2048;
            for (int it = gw; it < NITEMS; it += NGW) { int r = it;
#define TR(Wp, K_, N_, WTp, gainp, sc, mode) { const int ni_ = ((K_) / 64) * ((N_) / 32); if (r < ni_) { tr_item(Wp, K_, N_, WTp, gainp, sc, mode, wscr, r, lane); continue; } r -= ni_; }
                TR(P.in[15], 1024, 1280, WT + WT_INEVEN, P.in[11], 1.f, 1)
                TR(P.in[25], 512, 512, WT + WT_GLU, nullptr, 1.f, 0)
                TR(P.in[16], 1024, 1024, WT + WT_OUTEVEN, nullptr, 1.f, 0)
                TR(P.in[30], 1024, 1024, WT + WT_WQ, P.in[12], 0.0625f, 0)
                TR(P.in[31], 1024, 2048, WT + WT_WKV, nullptr, 1.f, 0)
                TR(P.in[31] + 2097152, 1024, 2048, WT + WT_WKV + 2097152, nullptr, 1.f, 0)
                TR(P.in[32], 1024, 1024, WT + WT_WO, nullptr, 1.f, 0)
                TR(P.in[33], 1024, 5632, WT + WT_UP, P.in[13], 1.f, 2)
                TR(P.in[35], 2816, 1024, WT + WT_DOWN, nullptr, 1.f, 0)
                { const int mi = r >> 7, l = mi >> 3, b = mi & 7; tr_item(P.in[10] + (size_t)mi * 262144, 256, 1024, memvT + (size_t)(l * 12 + 4 + b) * 262144, nullptr, 1.f, 0, wscr, r & 127, lane); }
            }
        }
        for (int m = gw; m < MROWS; m += NGW) { const float* xr = m < MP ? P.in[0] + (size_t)m * 1024 : P.in[1] + (size_t)(m - MP) * 1024; float ss = 0.f;
#pragma unroll
            for (int j = 0; j < 4; ++j) { const f32x4 v = *(const f32x4*)(xr + (lane + 64 * j) * 4); ss += (v[0] * v[0] + v[1] * v[1]) + (v[2] * v[2] + v[3] * v[3]);
                u32x2v w; w.x = pg8::cvt_pk_bf16(v[0], v[1]); w.y = pg8::cvt_pk_bf16(v[2], v[3]); *(u32x2v*)(xb + (size_t)m * 1024 + (lane + 64 * j) * 4) = w; }
            ss = wave_sum(ss); if (lane < 16) PARTBUF(0)[(size_t)m * 16 + lane] = lane == 0 ? ss : 0.f; }
        for (int i = gt; i < 262144; i += NT) { const f32x4 v = *(const f32x4*)(P.in[2] + (size_t)i * 4); u32x2v w; w.x = pg8::cvt_pk_bf16(v[0], v[1]); w.y = pg8::cvt_pk_bf16(v[2], v[3]); *(u32x2v*)(memb + (size_t)i * 4) = w; }
        for (int i = gt; i < 1048576; i += NT) { const size_t e = (size_t)i * 4; const int lb = (int)(e >> 18), l = lb >> 3, b = lb & 7; const f32x4 v = *(const f32x4*)(P.in[9] + e);
            u32x2v w; w.x = pg8::cvt_pk_bf16(v[0], v[1]); w.y = pg8::cvt_pk_bf16(v[2], v[3]); *(u32x2v*)(memk + (size_t)(l * 12 + 4 + b) * 262144 + (e & 262143)) = w; }
        for (int i = gt; i < 65536; i += NT) { const int j = i & 32767; const float* src = (i < 32768 ? P.in[3] : P.in[4]) + (size_t)j * 4; bf16* dst = (i < 32768 ? ckb : cvb) + (size_t)j * 4;
            const f32x4 v = *(const f32x4*)src; u32x2v w; w.x = pg8::cvt_pk_bf16(v[0], v[1]); w.y = pg8::cvt_pk_bf16(v[2], v[3]); *(u32x2v*)dst = w; }
        for (int i = gt; i < 4096 * 32; i += NT) { const int pos = i >> 5, d = i & 31; const double inv = dexp_(-(double)d * (9.210340371976184 / 32.0)); double s, c; dsincos_((double)pos * inv, s, c); ropec[i] = (float)c; ropes[i] = (float)s; }
        for (int i = gt; i < 2048; i += NT) { const double are = P.in[17][i], aim = P.in[18][i], dt = dexp_((double)P.in[19][i]); double s, c; dsincos_(aim * dt, s, c); const double mag = dexp_(are * dt);
            const double br = mag * c, bi = mag * s; abar[2 * i] = (float)br; abar[2 * i + 1] = (float)bi;
            const double nr = br - 1.0, ni = bi, den = are * are + aim * aim; const double qr = (nr * are + ni * aim) / den, qi = (ni * are - nr * aim) / den;
#pragma unroll 4
            for (int h = 0; h < 16; ++h) { const double xr = P.in[20][(size_t)i * 16 + h], xi = P.in[21][(size_t)i * 16 + h]; const float fre = (float)(qr * xr - qi * xi), fim = (float)(qr * xi + qi * xr); bbar[(size_t)i * 32 + 2 * h] = fre; bbar[(size_t)i * 32 + 2 * h + 1] = fim;
                bbt[((size_t)i * 2) * 16 + h] = (bf16)f2bf(fre); bbt[((size_t)i * 2 + 1) * 16 + h] = (bf16)f2bf(fim); } }
    }
    SEAM();
    if (RUN) { PTRS()
        if (G < 128 || (int)blockIdx.x >= G - 64) { pg8::Gemm g{memb, WT + WT_WKV, 1024, 4096, 1024}; pg8::StaticOrder S;
            if (G < 128) S.init(1024, 4096, G, (int)blockIdx.x); else S.init(1024, 4096, 64, (int)blockIdx.x - (G - 64)); EpiKV E{out, memk};
          pg8::gemm_phase<EpiKV, pg8::StaticOrder, true, true>(lds, g, S, E, wave_s); }
        { pg8::Gemm g{xb, WT + WT_INEVEN, MROWS, 1280, 1024}; pg8::StaticOrderF S; S.init(MROWS, 1280, G, (int)blockIdx.x); EpiIn0 E{proj0, PARTBUF(0), ropec, ropes, out};
          pg8::gemm_phase<EpiIn0, pg8::StaticOrderF, true, true>(lds, g, S, E, wave_s); }
        {
            FRESH()
            const int bx = (int)blockIdx.x, n2 = 325 - G;
            int slot = -1, nw = 1;
            if (G == 256) { if (bx >= n2 && bx < G - 64) { slot = (bx - n2) * 8 + wave; nw = (G - 64 - n2) * 8; } } else { slot = gw; nw = NGW; }
            if (slot >= 0) for (int it = slot; it < 2816 + 1408; it += nw) { int r = it;
                TR(P.in[33] + (size_t)1024 * 5632, 1024, 5632, WT + WT_UP + (size_t)5632 * 1024, P.in[13] + 1024, 1.f, 2)
                tr_item(P.in[35] + (size_t)2816 * 1024, 2816, 1024, WT + WT_DOWN + (size_t)2816 * 1024, nullptr, 1.f, 0, wscr, r, lane); }
        }
    }
    SEAM();
    if (RUN) { PTRS() FRESH()
        swa_phase(proj0, ckb, cvb, P.in[26], ycat, lds, tid, wave, lane, G);
        s5_local(proj0, abar, bbt, sloc, wscr, wave * G + (int)blockIdx.x, NGW, lane);
        for (int it = wave * G + (int)blockIdx.x; it < 1024; it += NGW) { const int mi = it >> 7, l = mi >> 2, b = mi & 3;
            tr_item(out + OFF_MVP + (size_t)mi * 262144, 256, 1024, memvT + (size_t)(l * 12 + b) * 262144, nullptr, 1.f, 0, wscr, it & 127, lane); }
    }
    SEAM();
    if (RUN) { PTRS() FRESH() s5_out(proj0, abar, bbt, sloc, P.in[5], P.in[6], P.in[22], P.in[23], P.in[24], gbuf, out, (LAS float*)(lds + wave * 16384), (LAS unsigned*)(lds + wave * 16384 + 8448), wave * G + (int)blockIdx.x, NGW, lane); }
    SEAM();
    if (RUN) { PTRS() pg8::Gemm g{gbuf, WT + WT_GLU, MROWS, 512, 512}; pg8::StaticOrder S; S.init(MROWS, 512, G, (int)blockIdx.x); EpiGlu E{gbuf, ycat};
        pg8::gemm_phase<EpiGlu, pg8::StaticOrder, true, true>(lds, g, S, E, wave_s);
        {
            FRESH()
            const int bx = (int)blockIdx.x; int slot = -1, nw = 1;
            if (G > 130) { if (bx >= 130) { slot = (bx - 130) * 8 + wave; nw = (G - 130) * 8; } } else { slot = gw; nw = NGW; }
            if (slot >= 0) for (int it = slot; it < 1536 + 512; it += nw) { int r = it;
                TR(P.in[27], 1024, 3072, WT + WT_INODD, P.in[11] + 1024, 1.f, 3)
                tr_item(P.in[29], 1024, 1024, WT + WT_OUTODD, nullptr, 1.f, 0, wscr, r, lane); }
        } }
    SEAM();

#pragma unroll
    for (int l = 0; l < 2; ++l) {
        if (l == 1) {
            if (RUN) { PTRS() pg8::Gemm g{xb, WT + WT_INODD, MP, 1024, 1024}; pg8::StaticOrderF S; S.init(MP, 1024, G, (int)blockIdx.x); EpiBf16 E{gbm, 1024, PARTBUF(3)};
                pg8::gemm_phase<EpiBf16, pg8::StaticOrderF, true, true>(lds, g, S, E, wave_s);
                { FRESH() sample_gemm<1>(xb, WT + WT_INODD, 1024, lds, tid, wave, lane, nullptr, nullptr, nullptr, PARTBUF(3), gbm); } }
            SEAM();
            if (RUN) { PTRS() pg8::Gemm g{xb, WT + WT_INODD + (size_t)1024 * 1024, MP, 2048, 1024}; pg8::StaticOrderF S; S.init(MP, 2048, G, (int)blockIdx.x); EpiCz E{gbm, PARTBUF(3), P.in[28], SG};
                pg8::gemm_phase<EpiCz, pg8::StaticOrderF, true, true>(lds, g, S, E, wave_s);
                { FRESH() sample_cz(xb, WT + WT_INODD, lds, tid, wave, lane, PARTBUF(3), P.in[28], P.in[7], gbm, out); } }
            SEAM();
            if (RUN) { PTRS() FRESH()
                const float* cw = P.in[28];
                for (int i = gt; i < 512 * 128; i += NT) { const int ri = i >> 7, c0 = (i & 127) * 8, blk = ri >> 1, rr = ri & 1, row = blk * 64 + rr;
                    f32x4 pa0, pa1, pb0, pb1;
                    if ((blk & 63) == 0) { pa0 = pa1 = pb0 = pb1 = (f32x4){0.f, 0.f, 0.f, 0.f}; }
                    else { const float* s0 = SG + (size_t)((blk - 1) * 8 + 6) * 1024 + c0; pa0 = *(const f32x4*)s0; pa1 = *(const f32x4*)(s0 + 4); pb0 = *(const f32x4*)(s0 + 1024); pb1 = *(const f32x4*)(s0 + 1028); }
                    const float* sc = SG + (size_t)(blk * 8) * 1024 + c0; const f32x4 x00 = *(const f32x4*)sc, x01 = *(const f32x4*)(sc + 4);
                    f32x4 xm2a, xm2b, xm1a, xm1b, xca, xcb;
                    if (rr == 0) { xm2a = pa0; xm2b = pa1; xm1a = pb0; xm1b = pb1; xca = x00; xcb = x01; }
                    else { xm2a = pb0; xm2b = pb1; xm1a = x00; xm1b = x01; xca = *(const f32x4*)(sc + 1024); xcb = *(const f32x4*)(sc + 1028); }
                    const f32x4 w0a = *(const f32x4*)(cw + c0), w0b = *(const f32x4*)(cw + c0 + 4), w1a = *(const f32x4*)(cw + 1024 + c0), w1b = *(const f32x4*)(cw + 1028 + c0), w2a = *(const f32x4*)(cw + 2048 + c0), w2b = *(const f32x4*)(cw + 2052 + c0);
                    const f32x4 z0 = w0a * xm2a + w1a * xm1a + w2a * xca, z1 = w0b * xm2b + w1b * xm1b + w2b * xcb;
                    const v4u gw_ = *(const v4u*)(gbm + (size_t)row * 1024 + c0);
                    const f32x4 g0 = (f32x4){bflo(gw_.x), bfhi(gw_.x), bflo(gw_.y), bfhi(gw_.y)}, g1 = (f32x4){bflo(gw_.z), bfhi(gw_.z), bflo(gw_.w), bfhi(gw_.w)};
                    *(v4u*)(gbm + (size_t)row * 1024 + c0) = pack8(g0 * z0, g1 * z1); }
                for (int i = gt; i < 4 * 2 * 1024; i += NT) { const int c = i & 1023, j = (i >> 10) & 1, b = i >> 11; out[OFF_CMP + i] = SG[(size_t)((64 * b + 63) * 8 + 6 + j) * 1024 + c]; }
            }
            SEAM();
        }
        if (RUN) { PTRS() pg8::Gemm g{(bf16*)(tmp + (size_t)(1 - l) * TMP_YCAT), WT + WT_OUTEVEN + (size_t)l * (WT_OUTODD - WT_OUTEVEN), MP, 1024, 1024}; pg8::StaticOrderF S; S.init(MP, 1024, G, (int)blockIdx.x);
            EpiRes E{P.in[0], P.in[1] - (size_t)MP * 1024, xb, PARTBUF(1 + 3 * l), l == 0 ? 1 : 0};
            pg8::gemm_phase<EpiRes, pg8::StaticOrderF, true, true>(lds, g, S, E, wave_s);
            { FRESH() sample_gemm<0>((bf16*)(tmp + (size_t)(1 - l) * TMP_YCAT), WT + WT_OUTEVEN + (size_t)l * (WT_OUTODD - WT_OUTEVEN), 1024, lds, tid, wave, lane, xb, l == 0 ? P.in[1] - (size_t)MP * 1024 : (const float*)nullptr, PARTBUF(1 + 3 * l), nullptr, nullptr); } }
        SEAM();
        if (RUN) { PTRS() pg8::Gemm g{xb, WT + WT_WQ + (size_t)l * 1048576, MP, 1024, 1024}; pg8::StaticOrderF S; S.init(MP, 1024, G, (int)blockIdx.x); EpiBf16 E{qx, 1024, PARTBUF(1 + 3 * l)};
            pg8::gemm_phase<EpiBf16, pg8::StaticOrderF, true, true>(lds, g, S, E, wave_s);
            { FRESH() sample_gemm<1>(xb, WT + WT_WQ + (size_t)l * 1048576, 1024, lds, tid, wave, lane, nullptr, nullptr, nullptr, PARTBUF(1 + 3 * l), qx); } }
        SEAM();
        if (RUN) { PTRS() FRESH() xattn_phase2(qx, memk + (size_t)l * 12 * 262144, memvT + (size_t)l * 12 * 262144, ox, lds, tid, wave, lane, G); }
        SEAM();
        if (RUN) { PTRS() pg8::Gemm g{ox, WT + WT_WO + (size_t)l * 1048576, MP, 1024, 1024}; pg8::StaticOrderF S; S.init(MP, 1024, G, (int)blockIdx.x); EpiRes E{P.in[0], P.in[0], xb, PARTBUF(2 + 3 * l), 0};
            pg8::gemm_phase<EpiRes, pg8::StaticOrderF, true, true>(lds, g, S, E, wave_s);
            { FRESH() sample_gemm<0>(ox, WT + WT_WO + (size_t)l * 1048576, 1024, lds, tid, wave, lane, xb, nullptr, PARTBUF(2 + 3 * l), nullptr, nullptr); } }
        SEAM();
        if (RUN) { PTRS() pg8::Gemm g{xb, WT + WT_UP + (size_t)l * 5632 * 1024, MROWS, 5632, 1024}; pg8::StaticOrderF S; S.init(MROWS, 5632, G, (int)blockIdx.x);
            EpiFfnUp E{act, PARTBUF(2 + 3 * l), P.in[34] + (size_t)l * 3 * DFF, SG, SV};
            pg8::gemm_phase<EpiFfnUp, pg8::StaticOrderF, true, true>(lds, g, S, E, wave_s);
            if (l == 0) {
                FRESH()
                const int bx = (int)blockIdx.x, nb = 1430 % G; int slot = -1, nw = 1;
                if (nb > 0 && nb < G) { if (bx >= nb) { slot = (bx - nb) * 8 + wave; nw = (G - nb) * 8; } } else { slot = gw; nw = NGW; }
                if (slot >= 0) for (int it = slot; it < 512 + 512; it += nw) { int r = it;
                    TR(P.in[30] + 1048576, 1024, 1024, WT + WT_WQ + 1048576, P.in[12] + 1024, 0.0625f, 0)
                    tr_item(P.in[32] + 1048576, 1024, 1024, WT + WT_WO + 1048576, nullptr, 1.f, 0, wscr, r, lane); }
            } }
        SEAM();
        if (RUN) { PTRS() FRESH()
            const float* cw = P.in[34] + (size_t)l * 3 * DFF; const float* st = P.in[8] + (size_t)l * 8 * 2 * DFF;
            for (int i = gt; i < 528 * 352; i += NT) { const int fi = i / 352, c0 = (i % 352) * 8; int blk, row, rr, sb, vb; bool smp = fi >= 512;
                if (!smp) { blk = fi >> 1; rr = fi & 1; row = blk * 64 + rr; sb = 0; vb = 0; } else { const int s = fi - 512, half = (s >> 1) & 1; blk = 256 + (s >> 2); rr = s & 1; row = blk * 64 + half * 32 + rr; sb = half * 4; vb = half * 2; }
                f32x4 pa0, pa1, pb0, pb1;
                if (smp) { const int b = (blk - 256) * 2 + (sb >> 2); const float* s0 = st + (size_t)(b * 2) * DFF + c0; pa0 = *(const f32x4*)s0; pa1 = *(const f32x4*)(s0 + 4); pb0 = *(const f32x4*)(s0 + DFF); pb1 = *(const f32x4*)(s0 + DFF + 4); }
                else if ((blk & 63) == 0) { pa0 = pa1 = pb0 = pb1 = (f32x4){0.f, 0.f, 0.f, 0.f}; }
                else { const float* s0 = SG + (size_t)((blk - 1) * 8 + 6) * DFF + c0; pa0 = *(const f32x4*)s0; pa1 = *(const f32x4*)(s0 + 4); pb0 = *(const f32x4*)(s0 + DFF); pb1 = *(const f32x4*)(s0 + DFF + 4); }
                const float* sc = SG + (size_t)(blk * 8 + sb) * DFF + c0; const f32x4 x00 = *(const f32x4*)sc, x01 = *(const f32x4*)(sc + 4);
                f32x4 xm2a, xm2b, xm1a, xm1b, xca, xcb;
                if (rr == 0) { xm2a = pa0; xm2b = pa1; xm1a = pb0; xm1b = pb1; xca = x00; xcb = x01; }
                else { xm2a = pb0; xm2b = pb1; xm1a = x00; xm1b = x01; xca = *(const f32x4*)(sc + DFF); xcb = *(const f32x4*)(sc + DFF + 4); }
                const f32x4 w0a = *(const f32x4*)(cw + c0), w0b = *(const f32x4*)(cw + c0 + 4), w1a = *(const f32x4*)(cw + DFF + c0), w1b = *(const f32x4*)(cw + DFF + c0 + 4), w2a = *(const f32x4*)(cw + 2 * DFF + c0), w2b = *(const f32x4*)(cw + 2 * DFF + c0 + 4);
                const f32x4 ga = w0a * xm2a + w1a * xm1a + w2a * xca, gb_ = w0b * xm2b + w1b * xm1b + w2b * xcb;
                const float* sv = SV + (size_t)(blk * 4 + vb + rr) * DFF + c0; const f32x4 va = *(const f32x4*)sv, vb_ = *(const f32x4*)(sv + 4);
                f32x4 a0, a1;
#pragma unroll
                for (int j = 0; j < 4; ++j) { a0[j] = ga[j] * sigmoidf_(ga[j]) * va[j]; a1[j] = gb_[j] * sigmoidf_(gb_[j]) * vb_[j]; }
                *(v4u*)(act + (size_t)row * DFF + c0) = pack8(a0, a1); }
            for (int i = gt; i < 4 * 2 * DFF; i += NT) { const int c = i % DFF, j = (i / DFF) & 1, b = i / (2 * DFF); out[OFF_CFP + (size_t)l * 4 * 2 * DFF + i] = SG[(size_t)((64 * b + 63) * 8 + 6 + j) * DFF + c]; }
            for (int i = gt; i < 8 * 2 * DFF; i += NT) { const int c = i % DFF, j = (i / DFF) & 1, b = i / (2 * DFF); out[OFF_CFS + (size_t)l * 8 * 2 * DFF + i] = SG[(size_t)((256 + (b >> 1)) * 8 + (b & 1) * 4 + 2 + j) * DFF + c]; }
        }
        SEAM();
        if (RUN) { PTRS() pg8::Gemm g{act, WT + WT_DOWN + (size_t)l * 2816 * 1024, MP, 1024, DFF}; pg8::StaticOrderF S; S.init(MP, 1024, G, (int)blockIdx.x); EpiRes E{P.in[0], P.in[0], xb, PARTBUF(3 + 3 * l), 0};
            pg8::gemm_phase<EpiRes, pg8::StaticOrderF, true, true>(lds, g, S, E, wave_s);
            { FRESH() sample_gemm<0>(act, WT + WT_DOWN + (size_t)l * 2816 * 1024, DFF, lds, tid, wave, lane, xb, nullptr, PARTBUF(3 + 3 * l), nullptr, nullptr); } }
        SEAM();
    }
    if (RUN) { PTRS() FRESH()
        const float* gf = P.in[14];
        for (int m = gw; m < MROWS; m += NGW) { const float rs = rstd_of(PARTBUF(6), m); float* xr = out + (size_t)m * 1024; const bf16* xbr = xb + (size_t)m * 1024;
#pragma unroll
            for (int j = 0; j < 4; ++j) { const int c = (lane + 64 * j) * 4; const u32x2v w = *(const u32x2v*)(xbr + c); const f32x4 v = (f32x4){bflo(w.x), bfhi(w.x), bflo(w.y), bfhi(w.y)}, gg = *(const f32x4*)(gf + c); *(f32x4*)(xr + c) = v * rs * gg; } }
    }
}

extern "C" void kernel_launch(void* const* d_in, const int* in_sizes, int n_in, void* d_out, int out_size, void* d_ws, size_t ws_size, hipStream_t stream) {
    static int grid = 0;
    if (grid == 0) {
        int dev = 0, cus = 0, per_cu = 0;
        if (n_in != 36 || ws_size < 256 * MiB) { fprintf(stderr, "kernel_launch: unexpected n_in %d / ws %zu\n", n_in, ws_size); grid = -1; return; }
        (void)hipGetDevice(&dev); (void)hipDeviceGetAttribute(&cus, hipDeviceAttributeMultiprocessorCount, dev);
        if (hipFuncSetAttribute((const void*)mega_fwd, hipFuncAttributeMaxDynamicSharedMemorySize, LDS_BYTES) != hipSuccess) { fprintf(stderr, "kernel_launch: hipFuncSetAttribute failed\n"); grid = -1; return; }
        if (hipOccupancyMaxActiveBlocksPerMultiprocessor(&per_cu, (const void*)mega_fwd, 512, LDS_BYTES) != hipSuccess || per_cu < 1) per_cu = 1;
        (void)hipGetLastError();
        grid = cus * 1;
        if (grid > 256) grid = 256;
    }
    if (grid < 0) return;
    (void)hipMemsetAsync(d_ws, 0, CTL_ZERO_BYTES, stream);
    Params p{};
    for (int i = 0; i < 36; ++i) p.in[i] = (const float*)d_in[i];
    p.out = (float*)d_out; p.ws = (unsigned char*)d_ws; p.use_cg = 0; p.pad = 0;
    void* args[] = {&p};
    hipError_t e = hipLaunchCooperativeKernel((const void*)mega_fwd, dim3(grid), dim3(512), args, LDS_BYTES, stream);
    if (e != hipSuccess) fprintf(stderr, "cooperative launch failed: %s (grid %d)\n", hipGetErrorString(e), grid);
}
```

```cpp
#include <hip/hip_runtime.h>
#include <hip/hip_cooperative_groups.h>
#include <cstdio>
#include <cstdint>
namespace cg = cooperative_groups;
__device__ __forceinline__ int fresh_tid(int wave_s) { unsigned z = 0u; asm volatile("" : "+s"(z)); int t = wave_s * 64 + (int)__builtin_amdgcn_mbcnt_hi(~0u, __builtin_amdgcn_mbcnt_lo(~0u, z)); asm volatile("" : "+v"(t)); return t; }
namespace pg8 {
#define PG8_LAS __attribute__((address_space(3)))
typedef unsigned short bf16_t;
typedef short bf16x8 __attribute__((ext_vector_type(8)));
typedef float f32x4 __attribute__((ext_vector_type(4)));
typedef unsigned u32x4 __attribute__((ext_vector_type(4)));
constexpr int BM = 256, BK = 64, HALF = 128, HTB = HALF * BK * 2  , STAGE_BYTES = 8 * HTB, NXCD = 8, WGM = 8;

__host__ __device__ __forceinline__ int lds_byte(int r, int c) { const int st = (r >> 4) * 2 + (c >> 5), rr = r & 15, cc = c & 31, ob = rr * 64 + cc * 2; return st * 1024 + (ob ^ (((ob >> 9) & 1) << 5)); }
__host__ __device__ __forceinline__ void stage_rc(int b, int& R, int& C) { const int st = b / 1024, sb = b % 1024, swz = sb ^ (((sb >> 9) & 1) << 5); R = (st >> 1) * 16 + swz / 64; C = (st & 1) * 32 + (swz % 64) / 2; }
__host__ __device__ __forceinline__ int perm32(int rho) { const int n = rho >> 4, i = rho & 15; return 8 * (i >> 2) + 4 * n + (i & 3); }

struct Unit { int pm, pn; };
struct Gemm { const bf16_t* A; const bf16_t* Bt; int M, N, K; };

template <bool FULL> struct StaticOrderT {
    int nM, nN, nwg, G, c;
    __host__ __device__ void init(int M, int N, int G_, int c_) { nM = M / BM; nN = N / BM; nwg = nM * nN; G = G_; c = c_; }
    __host__ __device__ bool next(int i, Unit& u) const {
        const long L = (long)i * G + c; if (!(FULL && i == 0) && L >= nwg) return false;
        int wgid = (int)L; { const int q = nwg / NXCD, r = nwg % NXCD, xcd = wgid % NXCD, off = wgid / NXCD; wgid = (xcd < r ? xcd * (q + 1) : r * (q + 1) + (xcd - r) * q) + off; }
        const int nig = WGM * nN, gid = wgid / nig, fm = gid * WGM, gsz = (nM - fm) < WGM ? (nM - fm) : WGM;
        u.pm = fm + ((wgid % nig) % gsz); u.pn = (wgid % nig) / gsz; return true;
    }
    __device__ __forceinline__ void a_ready(const Unit&) const {}
    __device__ __forceinline__ void done(const Unit&) const {}
};

typedef StaticOrderT<false> StaticOrder; typedef StaticOrderT<true> StaticOrderF;
__device__ __forceinline__ unsigned cvt_pk_bf16(float lo, float hi) { unsigned r; asm volatile("v_cvt_pk_bf16_f32 %0, %1, %2" : "=v"(r) : "v"(lo), "v"(hi)); return r; }
typedef float f32x2 __attribute__((ext_vector_type(2)));
template <class Epi, class Sched, bool ALIGN_EPI = false, bool SP2 = false>
__device__ __forceinline__ void gemm_phase(PG8_LAS unsigned char* lds, const Gemm g, const Sched& S, const Epi& E, const int wave_s) {
    const int tid = fresh_tid(wave_s), wid = __builtin_amdgcn_readfirstlane(tid >> 6), lane = tid & 63, wr = wid >> 2, wc = wid & 3, fr = lane & 15, fq = lane >> 4;
    const int K = g.K, nt = K / BK;
    unsigned voffA[2], voffB[2];
#pragma unroll
    for (int i = 0; i < 2; ++i) { int R, C; stage_rc(tid * 16 + i * 8192, R, C); const int Rb = Epi::PERM ? ((R & ~31) + perm32(R & 31)) : R;
        voffA[i] = (unsigned)(R * K + C) * 2u; voffB[i] = (unsigned)(Rb * K + C) * 2u; }
    const size_t kstep = (size_t)(BK * 2);
    const size_t hstep = (size_t)HALF * K * 2;
    const size_t tstep = 2 * hstep;
    const unsigned ldsw = (unsigned)wid * 1024u;
    const int aoff = lds_byte(wr * 64 + fr, fq * 8), boff = lds_byte(wc * 32 + fr, fq * 8);
#define PG8_SA(b, h) (((b) * 2 + (h)) * HTB)
#define PG8_SB(b, h) ((4 + (b) * 2 + (h)) * HTB)
#define PG8_STAGE(bufoff, gbase, voff) do { _Pragma("unroll") for (int _i = 0; _i < 2; ++_i) \
        __builtin_amdgcn_global_load_lds((const unsigned*)((const char*)(gbase) + (voff)[_i]), (PG8_LAS unsigned*)(lds + (bufoff) + ldsw + _i * 8192), 16, 0, 0); } while (0)
#define PG8_LDA(dst, b, h) do { _Pragma("unroll") for (int m = 0; m < 4; ++m) _Pragma("unroll") for (int k = 0; k < 2; ++k) dst[m][k] = *(const PG8_LAS bf16x8*)(lds + PG8_SA(b, h) + aoff + m * 2048 + k * 1024); } while (0)
#define PG8_LDB(dst, b, h) do { _Pragma("unroll") for (int n = 0; n < 2; ++n) _Pragma("unroll") for (int k = 0; k < 2; ++k) dst[n][k] = *(const PG8_LAS bf16x8*)(lds + PG8_SB(b, h) + boff + n * 2048 + k * 1024); } while (0)
#define PG8_MMA(ai, bj, At, Bt) do { __builtin_amdgcn_s_setprio(1); _Pragma("unroll") for (int m = 0; m < 4; ++m) _Pragma("unroll") for (int n = 0; n < 2; ++n) _Pragma("unroll") for (int k = 0; k < 2; ++k) \
        acc[ai][bj][m][n] = __builtin_amdgcn_mfma_f32_16x16x32_bf16(Bt[n][k], At[m][k], acc[ai][bj][m][n], 0, 0, 0); __builtin_amdgcn_s_setprio(0); } while (0)
#define PG8_WAIT_V(n) asm volatile("s_waitcnt vmcnt(" #n ")" ::: "memory")
#define PG8_WAIT_L(n) asm volatile("s_waitcnt lgkmcnt(" #n ")" ::: "memory")
#define PG8_BAR __builtin_amdgcn_s_barrier()
#define PG8_SCHED __builtin_amdgcn_sched_barrier(0)
    Unit cur, nxt; int ui = 0;
    if (!S.next(0, cur)) return;
    f32x4 acc[2][2][4][2];
#pragma unroll
    for (int a = 0; a < 2; ++a)
#pragma unroll
        for (int b = 0; b < 2; ++b)
#pragma unroll
            for (int m = 0; m < 4; ++m)
#pragma unroll
                for (int n = 0; n < 2; ++n) acc[a][b][m][n] = (f32x4){0.f, 0.f, 0.f, 0.f};
    bf16x8 At[4][2], B0[2][2], B1[2][2];
    const char* cA = (const char*)g.A + (size_t)cur.pm * tstep; const char* cB = (const char*)g.Bt + (size_t)cur.pn * tstep;
    S.a_ready(cur);
    if constexpr (SP2) {
        PG8_STAGE(PG8_SB(0, 0), cB, voffB); PG8_STAGE(PG8_SB(0, 1), cB + hstep, voffB); PG8_STAGE(PG8_SA(0, 0), cA, voffA); PG8_STAGE(PG8_SA(0, 1), cA + hstep, voffA);
        if (wr == 1) PG8_BAR;
        PG8_WAIT_V(2); PG8_BAR;
        PG8_STAGE(PG8_SB(1, 0), cB + kstep, voffB); PG8_STAGE(PG8_SA(1, 0), cA + kstep, voffA); PG8_STAGE(PG8_SB(1, 1), cB + hstep + kstep, voffB);
        PG8_WAIT_V(6); PG8_BAR;
    } else {
        PG8_STAGE(PG8_SB(0, 0), cB, voffB); PG8_STAGE(PG8_SA(0, 0), cA, voffA); PG8_STAGE(PG8_SB(0, 1), cB + hstep, voffB); PG8_STAGE(PG8_SA(0, 1), cA + hstep, voffA);
        if (wr == 1) PG8_BAR;
        PG8_WAIT_V(4); PG8_BAR;
        PG8_STAGE(PG8_SB(1, 0), cB + kstep, voffB); PG8_STAGE(PG8_SA(1, 0), cA + kstep, voffA); PG8_STAGE(PG8_SB(1, 1), cB + hstep + kstep, voffB);
        PG8_WAIT_V(6); PG8_BAR;
    }
    for (;;) {
        const bool has_next = S.next(ui + 1, nxt);
        const char* nA = has_next ? (const char*)g.A + (size_t)nxt.pm * tstep : cA; const char* nB = has_next ? (const char*)g.Bt + (size_t)nxt.pn * tstep : cB;
        for (int t = 0; t < nt; t += 2) {
            const bool last = (t == nt - 2);
            const char* a1 = cA + (size_t)(t + 1) * kstep;
            const char* a2 = last ? nA : cA + (size_t)(t + 2) * kstep; const char* b2 = last ? nB : cB + (size_t)(t + 2) * kstep;
            const char* a3 = a2 + kstep; const char* b3 = b2 + kstep;
            if (last && has_next) S.a_ready(nxt);
            if constexpr (SP2) {
            PG8_LDB(B0, 0, 0); PG8_LDB(B1, 0, 1); PG8_SCHED; PG8_LDA(At, 0, 0); PG8_STAGE(PG8_SA(1, 1), a1 + hstep, voffA);
            PG8_WAIT_V(8); PG8_WAIT_L(0); PG8_BAR; PG8_MMA(0, 0, At, B0); PG8_MMA(0, 1, At, B1); PG8_BAR; PG8_SCHED;
            PG8_LDA(At, 0, 1); PG8_STAGE(PG8_SB(0, 0), b2, voffB); PG8_STAGE(PG8_SB(0, 1), b2 + hstep, voffB); PG8_STAGE(PG8_SA(0, 0), a2, voffA);
            PG8_WAIT_V(8); PG8_WAIT_L(0); PG8_BAR; PG8_MMA(1, 0, At, B0); PG8_MMA(1, 1, At, B1); PG8_BAR; PG8_SCHED;
            PG8_LDB(B0, 1, 0); PG8_LDB(B1, 1, 1); PG8_SCHED; PG8_LDA(At, 1, 0); PG8_STAGE(PG8_SA(0, 1), a2 + hstep, voffA);
            PG8_WAIT_V(8); PG8_WAIT_L(0); PG8_BAR; PG8_MMA(0, 0, At, B0); PG8_MMA(0, 1, At, B1); PG8_BAR; PG8_SCHED;
            PG8_LDA(At, 1, 1); PG8_STAGE(PG8_SB(1, 0), b3, voffB); PG8_STAGE(PG8_SB(1, 1), b3 + hstep, voffB); PG8_STAGE(PG8_SA(1, 0), a3, voffA);
            PG8_WAIT_V(8); PG8_WAIT_L(0); PG8_BAR; PG8_MMA(1, 0, At, B0); PG8_MMA(1, 1, At, B1); PG8_BAR; PG8_SCHED;
            } else {
            PG8_LDB(B0, 0, 0); PG8_SCHED; PG8_LDA(At, 0, 0); PG8_STAGE(PG8_SA(1, 1), a1 + hstep, voffA);
            PG8_WAIT_L(8); PG8_BAR; PG8_WAIT_L(0); PG8_MMA(0, 0, At, B0); PG8_BAR; PG8_SCHED;
            PG8_LDB(B1, 0, 1); PG8_STAGE(PG8_SB(0, 0), b2, voffB);
            PG8_BAR; PG8_WAIT_L(0); PG8_MMA(0, 1, At, B1); PG8_BAR;
            PG8_LDA(At, 0, 1); PG8_STAGE(PG8_SA(0, 0), a2, voffA);
            PG8_BAR; PG8_WAIT_L(0); PG8_MMA(1, 0, At, B0); PG8_BAR; PG8_SCHED;
            PG8_STAGE(PG8_SB(0, 1), b2 + hstep, voffB);
            PG8_WAIT_V(6); PG8_BAR; PG8_MMA(1, 1, At, B1); PG8_BAR;
            PG8_LDB(B0, 1, 0); PG8_SCHED; PG8_LDA(At, 1, 0); PG8_STAGE(PG8_SA(0, 1), a2 + hstep, voffA);
            PG8_WAIT_L(8); PG8_BAR; PG8_WAIT_L(0); PG8_MMA(0, 0, At, B0); PG8_BAR; PG8_SCHED;
            PG8_LDB(B1, 1, 1); PG8_STAGE(PG8_SB(1, 0), b3, voffB);
            PG8_BAR; PG8_WAIT_L(0); PG8_MMA(0, 1, At, B1); PG8_BAR;
            PG8_LDA(At, 1, 1); PG8_STAGE(PG8_SA(1, 0), a3, voffA);
            PG8_BAR; PG8_WAIT_L(0); PG8_MMA(1, 0, At, B0); PG8_BAR; PG8_SCHED;
            PG8_STAGE(PG8_SB(1, 1), b3 + hstep, voffB);
            PG8_WAIT_V(6); PG8_BAR; PG8_MMA(1, 1, At, B1); PG8_BAR;
            }
        }
        if constexpr (ALIGN_EPI) { if (wr == 0) PG8_BAR; }
        if constexpr (!Epi::AFTER_DRAIN) { E(acc, cur, wr, wc, fr, fq); S.done(cur); }
        if (!has_next) break;
#pragma unroll
        for (int a = 0; a < 2; ++a)
#pragma unroll
            for (int b = 0; b < 2; ++b)
#pragma unroll
                for (int m = 0; m < 4; ++m)
#pragma unroll
                    for (int n = 0; n < 2; ++n) acc[a][b][m][n] = (f32x4){0.f, 0.f, 0.f, 0.f};
        cur = nxt; cA = nA; cB = nB; ++ui;
        if constexpr (ALIGN_EPI) { if (wr == 1) PG8_BAR; }
    }
    PG8_WAIT_V(0);
    if constexpr (!ALIGN_EPI) { if (wr == 0) PG8_BAR; }
    PG8_BAR;
    if constexpr (Epi::AFTER_DRAIN) { E.fused(acc, cur, wr, wc, fr, fq, lds, wid, lane); S.done(cur); }
#undef PG8_SA
#undef PG8_SB
#undef PG8_STAGE
#undef PG8_LDA
#undef PG8_LDB
#undef PG8_MMA
#undef PG8_WAIT_V
#undef PG8_WAIT_L
#undef PG8_BAR
#undef PG8_SCHED
}
}
#define GAS __attribute__((address_space(1)))
#define LAS __attribute__((address_space(3)))
typedef unsigned short bf16;
typedef unsigned v4u __attribute__((ext_vector_type(4)));
typedef float f32x4 __attribute__((ext_vector_type(4)));
typedef short bf16x8 __attribute__((ext_vector_type(8)));
typedef GAS unsigned gu32;
typedef GAS unsigned long long gu64;
#define RLX_AGENT __ATOMIC_RELAXED, __HIP_MEMORY_SCOPE_AGENT
#define LDS_WAIT() asm volatile("s_waitcnt lgkmcnt(0)" ::: "memory")
#define VM_WAIT() asm volatile("s_waitcnt vmcnt(0)" ::: "memory")
__device__ __forceinline__ unsigned long long rt() { return __builtin_amdgcn_s_memrealtime(); }
__device__ __forceinline__ unsigned f2bf(float f) { unsigned u = __builtin_bit_cast(unsigned, f); return (u + 0x7fffu + ((u >> 16) & 1u)) >> 16; }
__device__ __forceinline__ unsigned pk2(float lo, float hi) { return f2bf(lo) | (f2bf(hi) << 16); }

#define XB_TMO      128
#define XB_XCNT(j)  (256  + 64 * (j))
#define XB_XSUB(j)  (1280 + 64 * (j))
#define XB_XGEN(j)  (2304 + 64 * (j))
#define XB_TOP      3328
#define XB_TOPGEN   3392
#define XCD_BAR_WORDS 3456
#define XB_SPIN_CAP (1u << 18)

__device__ __forceinline__ unsigned xb_ld(unsigned* p)              { return __hip_atomic_load(p, __ATOMIC_RELAXED, __HIP_MEMORY_SCOPE_AGENT); }
__device__ __forceinline__ unsigned xb_add(unsigned* p, unsigned v) { return __hip_atomic_fetch_add(p, v, __ATOMIC_RELAXED, __HIP_MEMORY_SCOPE_AGENT); }
__device__ __forceinline__ unsigned xb_xcc_id() { return (unsigned)__builtin_amdgcn_s_getreg((3 << 11) | 20) & 0xFu; }
#define XB_SPIN(cond, bar) do { unsigned _sp = 0; while (cond) { __builtin_amdgcn_s_sleep(1); \
    if ((++_sp & 255u) == 0u) { if (xb_ld(&(bar)[XB_TMO])) break; if (_sp > XB_SPIN_CAP) { atomicAdd(&(bar)[XB_TMO], 1u); break; } } } } while (0)

struct XcdBarrier {
    unsigned* bar; unsigned x;
    volatile LAS unsigned* st;
};

__device__ __forceinline__ XcdBarrier xcd_barrier_post(unsigned* bar, volatile LAS unsigned* st) {
    XcdBarrier b; b.bar = bar; b.x = xb_xcc_id(); b.st = st;
    if (threadIdx.x == 0) (void)xb_add(&bar[XB_XCNT(b.x)], 1u);
    return b;
}
__device__ __forceinline__ void xcd_barrier_complete(unsigned* bar, unsigned x, unsigned& nloc, unsigned& nx) {
    const unsigned G = gridDim.x * gridDim.y * gridDim.z;
    unsigned sum, cnt, mine, sp = 0u;
    for (;;) {
        sum = 0u; cnt = 0u; mine = 0u;
#pragma unroll
        for (unsigned j = 0; j < 16; ++j) { const unsigned c = xb_ld(&bar[XB_XCNT(j)]); sum += c; cnt += (c > 0u) ? 1u : 0u; mine = (j == x) ? c : mine; }
        if (sum == G) break;
        __builtin_amdgcn_s_sleep(1);
        if ((++sp & 255u) == 0u) { if (xb_ld(&bar[XB_TMO])) break; if (sp > XB_SPIN_CAP) { atomicAdd(&bar[XB_TMO], 1u); break; } }
    }
    nloc = mine > 0u ? mine : 1u; nx = cnt > 0u ? cnt : 1u;
}

__device__ __forceinline__ void xcd_barrier(const XcdBarrier& b) {
    asm volatile("s_waitcnt vmcnt(0)" ::: "memory");
    __syncthreads();
    if (threadIdx.x == 0) {
        unsigned* bar = b.bar;
        __builtin_amdgcn_s_waitcnt(0);
        unsigned nloc = b.st[0], nx = b.st[1];
        if (nloc == 0u) { xcd_barrier_complete(bar, b.x, nloc, nx); b.st[0] = nloc; b.st[1] = nx; }
        const unsigned old = xb_add(&bar[XB_XSUB(b.x)], 1u);
        const unsigned gen = old / nloc;
        if (old + 1u == (gen + 1u) * nloc) {
            __builtin_amdgcn_fence(__ATOMIC_RELEASE, "agent");
            asm volatile("s_waitcnt vmcnt(0)" ::: "memory");
            const unsigned og = xb_add(&bar[XB_TOP], 1u);
            const unsigned tg = og / nx;
            if (og + 1u == (tg + 1u) * nx) xb_add(&bar[XB_TOPGEN], 1u);
            else XB_SPIN(xb_ld(&bar[XB_TOPGEN]) == tg, bar);
            __builtin_amdgcn_fence(__ATOMIC_ACQUIRE, "agent");
            xb_add(&bar[XB_XGEN(b.x)], 1u);
            asm volatile("s_waitcnt vmcnt(0)" ::: "memory");
        } else {
            XB_SPIN(xb_ld(&bar[XB_XGEN(b.x)]) == gen, bar);
            __builtin_amdgcn_fence(__ATOMIC_ACQUIRE, "agent");
            asm volatile("s_waitcnt vmcnt(0)" ::: "memory");
        }
    }
    __syncthreads();
}
typedef unsigned u32x2v __attribute__((ext_vector_type(2)));
typedef float f32x2v __attribute__((ext_vector_type(2)));

constexpr int MP = 16384, MROWS = 16640, DMODEL = 1024, DFF = 2816, NBLK64 = MROWS / 64;
constexpr float RMS_EPS = 1e-6f;
constexpr size_t OFF_Y = 0, OFF_WKP = (size_t)MROWS * 1024, OFF_WVP = OFF_WKP + 65536, OFF_SRP = OFF_WVP + 65536, OFF_SIP = OFF_SRP + 8192,
    OFF_CMP = OFF_SIP + 8192, OFF_CFP = OFF_CMP + 8192, OFF_MKP = OFF_CFP + 45056, OFF_MVP = OFF_MKP + 2097152, OFF_WKS = OFF_MVP + 2097152,
    OFF_WVS = OFF_WKS + 32768, OFF_SRS = OFF_WVS + 32768, OFF_SIS = OFF_SRS + 16384, OFF_CMS = OFF_SIS + 16384, OFF_CFS = OFF_CMS + 16384;
constexpr size_t MiB = 1u << 20;
constexpr size_t WS_ROWSS = 0, WS_BAR = 512 * 1024, CTL_ZERO_BYTES = 1 * MiB;
constexpr size_t WS_ROPE = 1 * MiB, WS_SSM = 2 * MiB, WS_CKV = 3 * MiB, WS_SLOC = 4 * MiB, WS_MEMK = 8 * MiB, WS_MEMVT = 20 * MiB, WS_SIDE = 32 * MiB;
constexpr size_t SG_BYTES = (size_t)NBLK64 * 8 * DFF * 4, SV_BYTES = (size_t)NBLK64 * 4 * DFF * 4;
static_assert(WS_SIDE + SG_BYTES + SV_BYTES <= 66 * MiB, "side buffers");
constexpr size_t WS_WT = 66 * MiB, WS_XB = 128 * MiB, WS_TMP = 161 * MiB;
constexpr size_t WT_INEVEN = 0, WT_GLU = WT_INEVEN + 1280 * 1024, WT_OUTEVEN = WT_GLU + 512 * 512, WT_WQ = WT_OUTEVEN + 1024 * 1024, WT_WKV = WT_WQ + 2 * 1024 * 1024,
    WT_WO = WT_WKV + 2 * 2048 * 1024, WT_UP = WT_WO + 2 * 1024 * 1024, WT_DOWN = WT_UP + (size_t)2 * 5632 * 1024, WT_INODD = WT_DOWN + (size_t)2 * 2816 * 1024,
    WT_OUTODD = WT_INODD + 3072 * 1024, WT_END = WT_OUTODD + 1024 * 1024;
static_assert(WS_WT + WT_END * 2 <= WS_XB, "weights");
static_assert(WS_XB + (size_t)MROWS * 1024 * 2 <= WS_TMP, "xb");
constexpr size_t TMP_BYTES = (size_t)MROWS * DFF * 2;
constexpr size_t WS_PART = 251 * MiB, PART_ELEMS = (size_t)MROWS * 16;
static_assert(WS_PART + 2 * PART_ELEMS * 4 <= 256 * MiB, "part");
static_assert(WS_TMP + TMP_BYTES <= 256 * MiB, "ws");
constexpr size_t TMP_PROJ0 = 0, TMP_GBUF = (size_t)MROWS * 1280 * 2, TMP_YCAT = TMP_GBUF + (size_t)MROWS * 512 * 2, TMP_MEMB = TMP_YCAT;
static_assert(TMP_YCAT + (size_t)MROWS * 1024 * 2 <= TMP_BYTES, "tmp");
constexpr size_t TMP_QX = 0, TMP_OX = (size_t)MROWS * 1024 * 2, TMP_ACT = 0, TMP_GB = 0, TMP_ZC = (size_t)MROWS * 1024 * 2;
constexpr int LDS_BYTES = 147456, MISC_OFF = 147456 - 512;
constexpr int NPH = 22;

#define MFMA16(a, b, c) __builtin_amdgcn_mfma_f32_16x16x32_bf16(a, b, c, 0, 0, 0)
__device__ __forceinline__ float bflo(unsigned w) { return __uint_as_float(w << 16); }
__device__ __forceinline__ float bfhi(unsigned w) { return __uint_as_float(w & 0xffff0000u); }
__device__ __forceinline__ v4u pack8(f32x4 a, f32x4 b) { v4u w; w.x = pg8::cvt_pk_bf16(a[0], a[1]); w.y = pg8::cvt_pk_bf16(a[2], a[3]); w.z = pg8::cvt_pk_bf16(b[0], b[1]); w.w = pg8::cvt_pk_bf16(b[2], b[3]); return w; }
__device__ __forceinline__ float rstd_of(const float* part, int row) { const f32x4* p = (const f32x4*)(part + (size_t)row * 16); const f32x4 a = p[0] + p[1] + p[2] + p[3]; return rsqrtf(((a[0] + a[1]) + (a[2] + a[3])) * (1.0f / 1024.0f) + RMS_EPS); }
__device__ __forceinline__ float sigmoidf_(float x) { return 1.0f / (1.0f + __expf(-x)); }
__device__ __forceinline__ float dpp_ror1(float v) { return __builtin_bit_cast(float, __builtin_amdgcn_update_dpp(0, __builtin_bit_cast(int, v), 0x121, 0xf, 0xf, false)); }
__device__ __forceinline__ float dpp_ror2(float v) { return __builtin_bit_cast(float, __builtin_amdgcn_update_dpp(0, __builtin_bit_cast(int, v), 0x122, 0xf, 0xf, false)); }
__device__ __forceinline__ float wave_sum(float v) {
#pragma unroll
    for (int o = 1; o < 64; o <<= 1) v += __shfl_xor(v, o);
    return v;
}

typedef pg8::Unit Unit;
#define EPI_ARGS const f32x4 (&acc)[2][2][4][2], const Unit& u, int wr, int wc, int fr, int fq

struct EpiBf16 {
    static constexpr bool PERM = true, AFTER_DRAIN = false;
    bf16* O; int ldc; const float* rowss;
    __device__ __forceinline__ void operator()(EPI_ARGS) const {
        const int row0 = u.pm * 256 + wr * 64 + fr, col0 = u.pn * 256 + wc * 32 + 8 * fq;
#pragma unroll
        for (int ai = 0; ai < 2; ++ai)
#pragma unroll
            for (int m = 0; m < 4; ++m) { const int row = row0 + ai * 128 + m * 16; const float rs = rstd_of(rowss, row); bf16* rp = O + (size_t)row * ldc + col0;
#pragma unroll
                for (int bj = 0; bj < 2; ++bj) *(v4u*)(rp + bj * 128) = pack8(acc[ai][bj][m][0] * rs, acc[ai][bj][m][1] * rs); }
    }
};
struct EpiRes {
    static constexpr bool PERM = true, AFTER_DRAIN = false;
    const float* base_p; const float* base_s; bf16* xb; float* rowss_next; int f32base;
    __device__ __forceinline__ void operator()(EPI_ARGS) const {
        const float* base = u.pm < 64 ? base_p : base_s;
        const int row0 = u.pm * 256 + wr * 64 + fr, col0 = u.pn * 256 + wc * 32 + 8 * fq;
#pragma unroll
        for (int ai = 0; ai < 2; ++ai)
#pragma unroll
            for (int m = 0; m < 4; ++m) { const int row = row0 + ai * 128 + m * 16; const size_t off = (size_t)row * 1024 + col0; float ss = 0.f;
#pragma unroll
                for (int bj = 0; bj < 2; ++bj) { f32x4 b0, b1;
                    if (f32base) { b0 = *(const f32x4*)(base + off + bj * 128); b1 = *(const f32x4*)(base + off + bj * 128 + 4); }
                    else { const v4u w = *(const v4u*)(xb + off + bj * 128); b0 = (f32x4){bflo(w.x), bfhi(w.x), bflo(w.y), bfhi(w.y)}; b1 = (f32x4){bflo(w.z), bfhi(w.z), bflo(w.w), bfhi(w.w)}; }
                    const f32x4 v0 = acc[ai][bj][m][0] + b0, v1 = acc[ai][bj][m][1] + b1;
                    *(v4u*)(xb + off + bj * 128) = pack8(v0, v1);
                    ss += (v0[0] * v0[0] + v0[1] * v0[1]) + (v0[2] * v0[2] + v0[3] * v0[3]) + (v1[0] * v1[0] + v1[1] * v1[1]) + (v1[2] * v1[2] + v1[3] * v1[3]); }
                ss += __shfl_xor(ss, 16); ss += __shfl_xor(ss, 32);
                if (fq == 0) rowss_next[(size_t)row * 16 + u.pn * 4 + wc] = ss; }
    }
};
struct EpiGlu {
    static constexpr bool PERM = true, AFTER_DRAIN = false;
    const bf16* g; bf16* ycat;
    __device__ __forceinline__ void operator()(EPI_ARGS) const {
        const int row0 = u.pm * 256 + wr * 64 + fr, col0 = u.pn * 256 + wc * 32 + 8 * fq;
#pragma unroll
        for (int ai = 0; ai < 2; ++ai)
#pragma unroll
            for (int m = 0; m < 4; ++m) { const int row = row0 + ai * 128 + m * 16;
#pragma unroll
                for (int bj = 0; bj < 2; ++bj) { const int col = col0 + bj * 128; const v4u gw = *(const v4u*)(g + (size_t)row * 512 + col);
                    const f32x4 a0 = acc[ai][bj][m][0], a1 = acc[ai][bj][m][1]; f32x4 o0, o1;
                    o0[0] = bflo(gw.x) * sigmoidf_(a0[0]); o0[1] = bfhi(gw.x) * sigmoidf_(a0[1]); o0[2] = bflo(gw.y) * sigmoidf_(a0[2]); o0[3] = bfhi(gw.y) * sigmoidf_(a0[3]);
                    o1[0] = bflo(gw.z) * sigmoidf_(a1[0]); o1[1] = bfhi(gw.z) * sigmoidf_(a1[1]); o1[2] = bflo(gw.w) * sigmoidf_(a1[2]); o1[3] = bfhi(gw.w) * sigmoidf_(a1[3]);
                    *(v4u*)(ycat + (size_t)row * 1024 + col) = pack8(o0, o1); } }
    }
};
struct EpiKV {
    static constexpr bool PERM = true, AFTER_DRAIN = false;
    float* out; bf16* memk;
    __device__ __forceinline__ void operator()(EPI_ARGS) const {
        const int row0 = u.pm * 256 + wr * 64 + fr, col0 = u.pn * 256 + wc * 32 + 8 * fq;
#pragma unroll
        for (int ai = 0; ai < 2; ++ai)
#pragma unroll
            for (int m = 0; m < 4; ++m) { const int row = row0 + ai * 128 + m * 16;
#pragma unroll
                for (int bj = 0; bj < 2; ++bj) { const int c = col0 + bj * 128, l = c >> 11, e = c & 2047, isv = e >> 10, dc = e & 1023;
                    float* op = out + (isv ? OFF_MVP : OFF_MKP) + (size_t)l * 1048576 + (size_t)row * 1024 + dc;
                    *(f32x4*)op = acc[ai][bj][m][0]; *(f32x4*)(op + 4) = acc[ai][bj][m][1];
                    if (!isv) *(v4u*)(memk + (size_t)l * 12 * 262144 + (size_t)row * 1024 + dc) = pack8(acc[ai][bj][m][0], acc[ai][bj][m][1]); } }
    }
};
struct EpiIn0 {
    static constexpr bool PERM = true, AFTER_DRAIN = false;
    bf16* proj; const float* rowss; const float* ropec; const float* ropes; float* out;
    __device__ __forceinline__ void operator()(EPI_ARGS) const {
        const int pn = u.pn;
#pragma unroll
        for (int ai = 0; ai < 2; ++ai)
#pragma unroll
            for (int m = 0; m < 4; ++m) { const int row = u.pm * 256 + ai * 128 + wr * 64 + m * 16 + fr; const float rs = rstd_of(rowss, row);
                const int pos = row < MP ? (row & 4095) : 2048 + (row & 31);
                bf16* rp = proj + (size_t)row * 1280;
                float* wk = nullptr; float* wv = nullptr;
                if (pn == 4) { if (row >= MP) { wk = out + OFF_WKS + (size_t)(row - MP) * 128; wv = out + OFF_WVS + (size_t)(row - MP) * 128; }
                               else if ((row & 4095) >= 3968) { const size_t o = (size_t)((row >> 12) * 128 + (row & 4095) - 3968) * 128; wk = out + OFF_WKP + o; wv = out + OFF_WVP + o; } }
#pragma unroll
                for (int bj = 0; bj < 2; ++bj) { const f32x4 v0 = acc[ai][bj][m][0] * rs, v1 = acc[ai][bj][m][1] * rs;
                    const bool rope = (pn == 2 || pn == 3 || (pn == 4 && bj == 0));
                    if (!rope) { const int col = pn * 256 + bj * 128 + wc * 32 + 8 * fq; *(v4u*)(rp + col) = pack8(v0, v1);
                        if (pn == 4 && wv) { *(f32x4*)(wv + wc * 32 + 8 * fq) = v0; *(f32x4*)(wv + wc * 32 + 8 * fq + 4) = v1; } }
                    else { const int gbase = pn * 256 + bj * 128 + (wc >> 1) * 64, d1 = 16 * (wc & 1) + 4 * fq;
                        const f32x4 c4 = *(const f32x4*)(ropec + pos * 32 + d1), s4 = *(const f32x4*)(ropes + pos * 32 + d1);
                        f32x4 o1 = v0 * c4 - v1 * s4, o2 = v1 * c4 + v0 * s4;
                        if (pn != 4) { o1 = o1 * 0.125f; o2 = o2 * 0.125f; }
                        u32x2v w1, w2; w1.x = pg8::cvt_pk_bf16(o1[0], o1[1]); w1.y = pg8::cvt_pk_bf16(o1[2], o1[3]); w2.x = pg8::cvt_pk_bf16(o2[0], o2[1]); w2.y = pg8::cvt_pk_bf16(o2[2], o2[3]);
                        *(u32x2v*)(rp + gbase + d1) = w1; *(u32x2v*)(rp + gbase + d1 + 32) = w2;
                        if (pn == 4 && wk) { const int cc = (wc >> 1) * 64 + d1; *(f32x4*)(wk + cc) = o1; *(f32x4*)(wk + cc + 32) = o2; } } } }
    }
};
struct EpiFfnUp {
    static constexpr bool PERM = true, AFTER_DRAIN = false;
    bf16* act; const float* rowss; const float* cw; float* SG; float* SV;
    __device__ __forceinline__ void operator()(EPI_ARGS) const {
        const int c0 = u.pn * 128 + wc * 32 + 8 * fq; const bool sample = u.pm == 64;
        const f32x4 w0a = *(const f32x4*)(cw + c0), w0b = *(const f32x4*)(cw + c0 + 4), w1a = *(const f32x4*)(cw + DFF + c0), w1b = *(const f32x4*)(cw + DFF + c0 + 4),
                    w2a = *(const f32x4*)(cw + 2 * DFF + c0), w2b = *(const f32x4*)(cw + 2 * DFF + c0 + 4);
#pragma unroll
        for (int ai = 0; ai < 2; ++ai) { f32x4 gp0 = {0.f, 0.f, 0.f, 0.f}, gp1 = {0.f, 0.f, 0.f, 0.f}; const int blk = u.pm * 4 + ai * 2 + wr;
#pragma unroll
            for (int m = 0; m < 4; ++m) { const int row = u.pm * 256 + ai * 128 + wr * 64 + m * 16 + fr; const float rs = rstd_of(rowss, row);
                const f32x4 g0 = acc[ai][0][m][0] * rs, g1 = acc[ai][0][m][1] * rs, v0 = acc[ai][1][m][0] * rs, v1 = acc[ai][1][m][1] * rs;
                f32x4 p1a, p2a, p1b, p2b;
#pragma unroll
                for (int j = 0; j < 4; ++j) { const float s1a = fr == 15 ? gp0[j] : g0[j], s2a = fr >= 14 ? gp0[j] : g0[j], s1b = fr == 15 ? gp1[j] : g1[j], s2b = fr >= 14 ? gp1[j] : g1[j];
                    p1a[j] = dpp_ror1(s1a); p2a[j] = dpp_ror2(s2a); p1b[j] = dpp_ror1(s1b); p2b[j] = dpp_ror2(s2b); }
                const f32x4 ca = w0a * p2a + w1a * p1a + w2a * g0, cb = w0b * p2b + w1b * p1b + w2b * g1;
                f32x4 sa, sb;
#pragma unroll
                for (int j = 0; j < 4; ++j) { sa[j] = sigmoidf_(ca[j]); sb[j] = sigmoidf_(cb[j]); }
                const f32x4 a0 = ca * sa * v0, a1 = cb * sb * v1;
                const bool valid = (m > 0 || fr >= 2) && !(sample && m == 2 && fr < 2);
                if (valid) *(v4u*)(act + (size_t)row * DFF + c0) = pack8(a0, a1);
                if ((m & 1) == 0 && fr < 2) { float* sg = SG + (size_t)(blk * 8 + 2 * m + fr) * DFF + c0; *(f32x4*)sg = g0; *(f32x4*)(sg + 4) = g1;
                                              float* sv = SV + (size_t)(blk * 4 + m + fr) * DFF + c0; *(f32x4*)sv = v0; *(f32x4*)(sv + 4) = v1; }
                if ((m & 1) == 1 && fr >= 14) { float* sg = SG + (size_t)(blk * 8 + 2 * m + fr - 14) * DFF + c0; *(f32x4*)sg = g0; *(f32x4*)(sg + 4) = g1; }
                gp0 = g0; gp1 = g1; } }
    }
};
struct EpiInOdd {
    static constexpr bool PERM = true, AFTER_DRAIN = false;
    bf16* gb; bf16* zc; const float* rowss; const float* cw; float* SG;
    __device__ __forceinline__ void operator()(EPI_ARGS) const {
        if (u.pn < 4) {
            const int row0 = u.pm * 256 + wr * 64 + fr, col0 = u.pn * 256 + wc * 32 + 8 * fq;
#pragma unroll
            for (int ai = 0; ai < 2; ++ai)
#pragma unroll
                for (int m = 0; m < 4; ++m) { const int row = row0 + ai * 128 + m * 16; const float rs = rstd_of(rowss, row); bf16* rp = gb + (size_t)row * 1024 + col0;
#pragma unroll
                    for (int bj = 0; bj < 2; ++bj) *(v4u*)(rp + bj * 128) = pack8(acc[ai][bj][m][0] * rs, acc[ai][bj][m][1] * rs); }
            return;
        }
        const int c0 = (u.pn - 4) * 128 + wc * 32 + 8 * fq; const bool sample = u.pm == 64;
        const f32x4 w0a = *(const f32x4*)(cw + c0), w0b = *(const f32x4*)(cw + c0 + 4), w1a = *(const f32x4*)(cw + 1024 + c0), w1b = *(const f32x4*)(cw + 1024 + c0 + 4),
                    w2a = *(const f32x4*)(cw + 2048 + c0), w2b = *(const f32x4*)(cw + 2048 + c0 + 4);
#pragma unroll
        for (int ai = 0; ai < 2; ++ai) { f32x4 gp0 = {0.f, 0.f, 0.f, 0.f}, gp1 = {0.f, 0.f, 0.f, 0.f}; const int blk = u.pm * 4 + ai * 2 + wr;
#pragma unroll
            for (int m = 0; m < 4; ++m) { const int row = u.pm * 256 + ai * 128 + wr * 64 + m * 16 + fr; const float rs = rstd_of(rowss, row); const float rs2 = rs * rs;
                const f32x4 g0 = acc[ai][0][m][0] * acc[ai][1][m][0] * rs2, g1 = acc[ai][0][m][1] * acc[ai][1][m][1] * rs2;
                f32x4 p1a, p2a, p1b, p2b;
#pragma unroll
                for (int j = 0; j < 4; ++j) { const float s1a = fr == 15 ? gp0[j] : g0[j], s2a = fr >= 14 ? gp0[j] : g0[j], s1b = fr == 15 ? gp1[j] : g1[j], s2b = fr >= 14 ? gp1[j] : g1[j];
                    p1a[j] = dpp_ror1(s1a); p2a[j] = dpp_ror2(s2a); p1b[j] = dpp_ror1(s1b); p2b[j] = dpp_ror2(s2b); }
                const f32x4 a0 = w0a * p2a + w1a * p1a + w2a * g0, a1 = w0b * p2b + w1b * p1b + w2b * g1;
                const bool valid = (m > 0 || fr >= 2) && !(sample && m == 2 && fr < 2);
                if (valid) *(v4u*)(zc + (size_t)row * 1024 + c0) = pack8(a0, a1);
                if ((m & 1) == 0 && fr < 2) { float* sg = SG + (size_t)(blk * 8 + 2 * m + fr) * 1024 + c0; *(f32x4*)sg = g0; *(f32x4*)(sg + 4) = g1; }
                if ((m & 1) == 1 && fr >= 14) { float* sg = SG + (size_t)(blk * 8 + 2 * m + fr - 14) * 1024 + c0; *(f32x4*)sg = g0; *(f32x4*)(sg + 4) = g1; }
                gp0 = g0; gp1 = g1; } }
    }
};


struct EpiCz {
    static constexpr bool PERM = true, AFTER_DRAIN = false;
    bf16* gb; const float* rowss; const float* cw; float* SG;
    __device__ __forceinline__ void operator()(EPI_ARGS) const {
        const int c0 = u.pn * 128 + wc * 32 + 8 * fq;
        const f32x4 w0a = *(const f32x4*)(cw + c0), w0b = *(const f32x4*)(cw + c0 + 4), w1a = *(const f32x4*)(cw + 1024 + c0), w1b = *(const f32x4*)(cw + 1024 + c0 + 4),
                    w2a = *(const f32x4*)(cw + 2048 + c0), w2b = *(const f32x4*)(cw + 2048 + c0 + 4);
#pragma unroll
        for (int ai = 0; ai < 2; ++ai) { f32x4 gp0 = {0.f, 0.f, 0.f, 0.f}, gp1 = {0.f, 0.f, 0.f, 0.f}; const int blk = u.pm * 4 + ai * 2 + wr;
#pragma unroll
            for (int m = 0; m < 4; ++m) { const int row = u.pm * 256 + ai * 128 + wr * 64 + m * 16 + fr; const float rs = rstd_of(rowss, row); const float rs2 = rs * rs;
                const f32x4 g0 = acc[ai][0][m][0] * acc[ai][1][m][0] * rs2, g1 = acc[ai][0][m][1] * acc[ai][1][m][1] * rs2;
                f32x4 p1a, p2a, p1b, p2b;
#pragma unroll
                for (int j = 0; j < 4; ++j) { const float s1a = fr == 15 ? gp0[j] : g0[j], s2a = fr >= 14 ? gp0[j] : g0[j], s1b = fr == 15 ? gp1[j] : g1[j], s2b = fr >= 14 ? gp1[j] : g1[j];
                    p1a[j] = dpp_ror1(s1a); p2a[j] = dpp_ror2(s2a); p1b[j] = dpp_ror1(s1b); p2b[j] = dpp_ror2(s2b); }
                const f32x4 a0 = w0a * p2a + w1a * p1a + w2a * g0, a1 = w0b * p2b + w1b * p1b + w2b * g1;
                if (m > 0 || fr >= 2) { bf16* gp = gb + (size_t)row * 1024 + c0; const v4u gw = *(const v4u*)gp;
                    const f32x4 b0 = (f32x4){bflo(gw.x), bfhi(gw.x), bflo(gw.y), bfhi(gw.y)}, b1 = (f32x4){bflo(gw.z), bfhi(gw.z), bflo(gw.w), bfhi(gw.w)};
                    *(v4u*)gp = pack8(a0 * b0, a1 * b1); }
                if ((m & 1) == 0 && fr < 2) { float* sg = SG + (size_t)(blk * 8 + 2 * m + fr) * 1024 + c0; *(f32x4*)sg = g0; *(f32x4*)(sg + 4) = g1; }
                if ((m & 1) == 1 && fr >= 14) { float* sg = SG + (size_t)(blk * 8 + 2 * m + fr - 14) * 1024 + c0; *(f32x4*)sg = g0; *(f32x4*)(sg + 4) = g1; }
                gp0 = g0; gp1 = g1; } }
    }
};

__device__ __forceinline__ int rowmap(int mode, int n) {
    if (mode == 1) { if (n >= 512 && n < 1152) { const int d = n & 63; return (n & ~63) | (32 * ((d >> 4) & 1) + 8 * ((d >> 2) & 3) + 4 * (d >> 5) + (d & 3)); } return n; }
    if (mode == 2) { return n < DFF ? ((n >> 7) * 256 + (n & 127)) : (((n - DFF) >> 7) * 256 + 128 + ((n - DFF) & 127)); }
    if (mode == 3) { if (n < 1024) return n; const int c = (n - 1024) & 1023, z = n >= 2048 ? 1 : 0; return 1024 + (c >> 7) * 256 + z * 128 + (c & 127); }
    return n;
}
__device__ __forceinline__ void tr_item(const float* W, int K, int N, bf16* WT, const float* gain, float scale, int mode, LAS float* scr, int item, int lane) {
    const int nblk = N / 32, kb = item / nblk, nb = item % nblk, k0 = 64 * kb, n0 = 32 * nb;
#pragma unroll
    for (int i = 0; i < 8; ++i) { const int idx = lane + 64 * i, kk = idx >> 3, n4 = (idx & 7) * 4; const float gs = gain ? ((const GAS float*)gain)[k0 + kk] * scale : scale;
        const f32x4 w = *(const GAS f32x4*)((const GAS float*)W + (size_t)(k0 + kk) * N + n0 + n4); LAS float* d = scr + kk * 33 + n4; d[0] = w[0] * gs; d[1] = w[1] * gs; d[2] = w[2] * gs; d[3] = w[3] * gs; }
    LDS_WAIT(); asm volatile("" ::: "memory");
    const int c = lane & 7;
#pragma unroll
    for (int j = 0; j < 4; ++j) { const int n = (lane >> 3) + 8 * j; const LAS float* s = scr + (8 * c) * 33 + n;
        v4u o; o.x = pg8::cvt_pk_bf16(s[0 * 33], s[1 * 33]); o.y = pg8::cvt_pk_bf16(s[2 * 33], s[3 * 33]); o.z = pg8::cvt_pk_bf16(s[4 * 33], s[5 * 33]); o.w = pg8::cvt_pk_bf16(s[6 * 33], s[7 * 33]);
        *(GAS v4u*)((GAS bf16*)WT + (size_t)rowmap(mode, n0 + n) * K + k0 + 8 * c) = o; }
    LDS_WAIT(); asm volatile("" ::: "memory");
}
__device__ __forceinline__ double dexp_(double y) {
    const double k = rint(y * 1.4426950408889634); const double r = (y - k * 0.6931471803691238) - k * 1.9082149292705877e-10;
    double p = 1.0 / 6227020800.0;
    p = p * r + 1.0 / 479001600.0; p = p * r + 1.0 / 39916800.0; p = p * r + 1.0 / 3628800.0; p = p * r + 1.0 / 362880.0; p = p * r + 1.0 / 40320.0; p = p * r + 1.0 / 5040.0;
    p = p * r + 1.0 / 720.0; p = p * r + 1.0 / 120.0; p = p * r + 1.0 / 24.0; p = p * r + 1.0 / 6.0; p = p * r + 0.5; p = p * r + 1.0; p = p * r + 1.0;
    const long long bits = (long long)(1023 + (int)k) << 52; return p * __builtin_bit_cast(double, bits);
}
__device__ __forceinline__ void dsincos_(double x, double& s, double& c) {
    const double k = rint(x * 0.6366197723675814); const double r = (x - k * 1.5707963267948966) - k * 6.123233995736766e-17; const double r2 = r * r;
    const double sp = r * (1.0 + r2 * (-1.0 / 6.0 + r2 * (1.0 / 120.0 + r2 * (-1.0 / 5040.0 + r2 * (1.0 / 362880.0 + r2 * (-1.0 / 39916800.0 + r2 * (1.0 / 6227020800.0)))))));
    const double cp = 1.0 + r2 * (-0.5 + r2 * (1.0 / 24.0 + r2 * (-1.0 / 720.0 + r2 * (1.0 / 40320.0 + r2 * (-1.0 / 3628800.0 + r2 * (1.0 / 479001600.0 + r2 * (-1.0 / 87178291200.0)))))));
    const int q = ((int)k) & 3;
    s = q == 0 ? sp : q == 1 ? cp : q == 2 ? -sp : -cp; c = q == 0 ? cp : q == 1 ? -sp : q == 2 ? -cp : sp;
}

__device__ __forceinline__ const bf16* kvptr(const bf16* proj, const bf16* cb, int sample, int b, int c, int kvh, int kk, int isv) {
    if (!sample) { int pos = (c - 2) * 64 + kk; pos = pos < 0 ? 0 : pos; return proj + (size_t)(b * 4096 + pos) * 1280 + 1024 + isv * 128 + kvh * 64; }
    if (kk < 128) return cb + (size_t)(b * 128 + kk) * 128 + kvh * 64;
    int t = kk - 128; t = t > 31 ? 31 : t; return proj + (size_t)(MP + b * 32 + t) * 1280 + 1024 + isv * 128 + kvh * 64;
}
__device__ __forceinline__ void swa_phase(const bf16* proj, const bf16* ckb, const bf16* cvb, const float* sinks, bf16* ycat, LAS unsigned char* lds, int tid, int wave, int lane, int G) {
    LAS bf16* VT = (LAS bf16*)lds;
    const int fr = lane & 15, quad = lane >> 4;
    for (int it = blockIdx.x; it < 528; it += G) {
        int b, c, kvh, sample;
        if (it < 512) { sample = 0; b = it >> 7; c = (it >> 1) & 63; kvh = it & 1; } else { sample = 1; b = (it - 512) >> 1; c = 0; kvh = it & 1; }
        __syncthreads();
#pragma unroll
        for (int i = 0; i < 3; ++i) { const int idx = tid + 512 * i, kk = idx % 192, dg = idx / 192; const v4u w = *(const GAS v4u*)((const GAS bf16*)kvptr(proj, cvb, sample, b, c, kvh, kk, 1) + dg * 8);
            LAS bf16* vp = VT + (dg * 8) * 200 + kk;
            vp[0] = (bf16)(w.x & 0xffffu); vp[200] = (bf16)(w.x >> 16); vp[400] = (bf16)(w.y & 0xffffu); vp[600] = (bf16)(w.y >> 16);
            vp[800] = (bf16)(w.z & 0xffffu); vp[1000] = (bf16)(w.z >> 16); vp[1200] = (bf16)(w.w & 0xffffu); vp[1400] = (bf16)(w.w >> 16); }
        __syncthreads();
        const int gq = wave >> 1, qhalf = wave & 1, head = kvh * 4 + gq;
        if (!(sample && qhalf)) {
            const int plo = sample ? 0 : (c >= 2 ? 0 : (2 - c) * 2), phi = sample ? 5 : 6;
            bf16x8 qf[2][2];
#pragma unroll
            for (int qb = 0; qb < 2; ++qb) { const int q = qhalf * 32 + qb * 16 + fr; const int row = sample ? MP + b * 32 + (q & 31) : b * 4096 + c * 64 + q;
                const GAS bf16* qp = (const GAS bf16*)proj + (size_t)row * 1280 + 512 + head * 64 + quad * 8; qf[qb][0] = *(const GAS bf16x8*)qp; qf[qb][1] = *(const GAS bf16x8*)(qp + 32); }
            f32x4 s[12][2];
#pragma unroll
            for (int kg = 0; kg < 3; ++kg) { bf16x8 kf[4][2];
#pragma unroll
                for (int i = 0; i < 4; ++i) { const int kb = kg * 4 + i, key = 32 * (kb >> 1) + (fr >> 2) * 8 + 4 * (kb & 1) + (fr & 3); const GAS bf16* kp = (const GAS bf16*)kvptr(proj, ckb, sample, b, c, kvh, key, 0) + quad * 8;
                    kf[i][0] = *(const GAS bf16x8*)kp; kf[i][1] = *(const GAS bf16x8*)(kp + 32); }
                __builtin_amdgcn_sched_barrier(0);
#pragma unroll
                for (int i = 0; i < 4; ++i)
#pragma unroll
                    for (int qb = 0; qb < 2; ++qb) { f32x4 a = {0.f, 0.f, 0.f, 0.f}; a = MFMA16(kf[i][0], qf[qb][0], a); a = MFMA16(kf[i][1], qf[qb][1], a); s[kg * 4 + i][qb] = a; }
                __builtin_amdgcn_sched_barrier(0); }
            const float sink = sinks[head];
            bf16x8 pf[6][2];
#pragma unroll
            for (int qb = 0; qb < 2; ++qb) { float mx = sink;
#pragma unroll
                for (int kb = 0; kb < 12; ++kb) { const bool pv = (kb >> 1) >= plo && (kb >> 1) < phi;
#pragma unroll
                    for (int j = 0; j < 4; ++j) { const float v = pv ? s[kb][qb][j] : -1e30f; s[kb][qb][j] = v; mx = fmaxf(mx, v); } }
                mx = fmaxf(mx, __shfl_xor(mx, 16)); mx = fmaxf(mx, __shfl_xor(mx, 32));
                float sum = 0.f;
#pragma unroll
                for (int kb = 0; kb < 12; ++kb)
#pragma unroll
                    for (int j = 0; j < 4; ++j) { const float e = __expf(s[kb][qb][j] - mx); s[kb][qb][j] = e; sum += e; }
                sum += __shfl_xor(sum, 16); sum += __shfl_xor(sum, 32); sum += __expf(sink - mx);
                const float inv = 1.0f / sum;
#pragma unroll
                for (int pr = 0; pr < 6; ++pr) pf[pr][qb] = __builtin_bit_cast(bf16x8, pack8(s[2 * pr][qb] * inv, s[2 * pr + 1][qb] * inv)); }
#pragma unroll
            for (int db = 0; db < 4; ++db) { bf16x8 vf[6];
#pragma unroll
                for (int pr = 0; pr < 6; ++pr) vf[pr] = *(const LAS bf16x8*)(VT + (db * 16 + fr) * 200 + 32 * pr + quad * 8);
#pragma unroll
                for (int qb = 0; qb < 2; ++qb) { f32x4 o = {0.f, 0.f, 0.f, 0.f};
#pragma unroll
                    for (int pr = 0; pr < 6; ++pr) o = MFMA16(pf[pr][qb], vf[pr], o);
#pragma unroll
                    for (int j = 0; j < 4; ++j) { const int q = qhalf * 32 + qb * 16 + quad * 4 + j;
                        if (!sample || q < 32) { const int row = sample ? MP + b * 32 + q : b * 4096 + c * 64 + q; ycat[(size_t)row * 1024 + 512 + head * 64 + db * 16 + fr] = (bf16)f2bf(o[j]); } } } }
        }
    }
    __syncthreads();
}

__device__ __forceinline__ void xattn_phase(const bf16* qx, const bf16* memk_l, const bf16* memvT_l, bf16* ox, int wave, int lane, int G) {
    const int fr = lane & 15, quad = lane >> 4;
    for (int t = wave * G + (int)blockIdx.x; t < 4160; t += 8 * G) {
        int bb, h, row0;
        if (t < 4096) { const int pair = t >> 8; bb = pair >> 2; h = pair & 3; row0 = bb * 4096 + (t & 255) * 16; }
        else { const int s = t - 4096, b = s >> 3; h = (s >> 1) & 3; bb = 4 + b; row0 = MP + b * 32 + (s & 1) * 16; }
        bf16x8 qf[8];
#pragma unroll
        for (int ks = 0; ks < 8; ++ks) qf[ks] = *(const bf16x8*)(qx + (size_t)(row0 + fr) * 1024 + h * 256 + ks * 32 + quad * 8);
        const bf16* kbase = memk_l + (size_t)bb * 262144 + h * 256 + quad * 8;
        f32x4 s[16];
#pragma unroll
        for (int kb = 0; kb < 16; ++kb) { const int key = 32 * (kb >> 1) + (fr >> 2) * 8 + 4 * (kb & 1) + (fr & 3); const bf16* kp = kbase + (size_t)key * 1024; f32x4 a = {0.f, 0.f, 0.f, 0.f};
#pragma unroll
            for (int ks = 0; ks < 8; ++ks) a = MFMA16(*(const bf16x8*)(kp + ks * 32), qf[ks], a);
            s[kb] = a; }
        float mx = -1e30f;
#pragma unroll
        for (int kb = 0; kb < 16; ++kb)
#pragma unroll
            for (int j = 0; j < 4; ++j) mx = fmaxf(mx, s[kb][j]);
        mx = fmaxf(mx, __shfl_xor(mx, 16)); mx = fmaxf(mx, __shfl_xor(mx, 32));
        float sum = 0.f;
#pragma unroll
        for (int kb = 0; kb < 16; ++kb)
#pragma unroll
            for (int j = 0; j < 4; ++j) { const float e = __expf(s[kb][j] - mx); s[kb][j] = e; sum += e; }
        sum += __shfl_xor(sum, 16); sum += __shfl_xor(sum, 32);
        const float inv = 1.0f / sum;
        bf16x8 pf[8];
#pragma unroll
        for (int pr = 0; pr < 8; ++pr) pf[pr] = __builtin_bit_cast(bf16x8, pack8(s[2 * pr] * inv, s[2 * pr + 1] * inv));
        const bf16* vbase = memvT_l + (size_t)bb * 262144 + (size_t)(h * 256 + fr) * 256 + quad * 8;
#pragma unroll 4
        for (int db = 0; db < 16; ++db) { f32x4 o = {0.f, 0.f, 0.f, 0.f};
#pragma unroll
            for (int pr = 0; pr < 8; ++pr) o = MFMA16(pf[pr], *(const bf16x8*)(vbase + (size_t)db * 4096 + pr * 32), o);
#pragma unroll
            for (int j = 0; j < 4; ++j) ox[(size_t)(row0 + quad * 4 + j) * 1024 + h * 256 + db * 16 + fr] = (bf16)f2bf(o[j]); }
    }
}


__device__ __forceinline__ void xstage(const bf16* src, size_t rowstride, LAS unsigned char* lds, int tid) {
    v4u t[16];
#pragma unroll
    for (int i = 0; i < 16; ++i) { const int row = (tid >> 5) + 16 * i, ch = tid & 31; t[i] = *(const GAS v4u*)((const GAS bf16*)src + (size_t)row * rowstride + ch * 8); }
#pragma unroll
    for (int i = 0; i < 16; ++i) { const int row = (tid >> 5) + 16 * i, ch = tid & 31; *(LAS v4u*)(lds + row * 528 + ch * 16) = t[i]; }
}
__device__ __forceinline__ void xattn_phase2(const bf16* qx, const bf16* memk_l, const bf16* memvT_l, bf16* ox, LAS unsigned char* lds, int tid, int wave, int lane, int G) {
    const int fr = lane & 15, quad = lane >> 4;
    for (int it = blockIdx.x; it < 256 + 32; it += G) {
        int bb, h, rowbase, nqb; bool active;
        if (it < 256) { bb = it >> 6; h = (it >> 4) & 3; rowbase = bb * 4096 + (it & 15) * 256; nqb = 2; active = true; }
        else { const int s = it - 256, b = s >> 2; h = s & 3; bb = 4 + b; rowbase = MP + b * 32; nqb = 1; active = wave < 2; }
        __syncthreads();
        xstage(memk_l + (size_t)bb * 262144 + h * 256, 1024, lds, tid);
        __syncthreads();
        bf16x8 pf[2][8];
#pragma unroll
        for (int qi = 0; qi < 2; ++qi) {
            if (qi < nqb && active) {
                const int row0 = rowbase + qi * 128 + wave * 16;
                bf16x8 qf[8];
#pragma unroll
                for (int ks = 0; ks < 8; ++ks) qf[ks] = *(const GAS bf16x8*)((const GAS bf16*)qx + (size_t)(row0 + fr) * 1024 + h * 256 + ks * 32 + quad * 8);
                f32x4 s[16];
#pragma unroll
                for (int kb = 0; kb < 16; ++kb) { const int key = 32 * (kb >> 1) + (fr >> 2) * 8 + 4 * (kb & 1) + (fr & 3); const LAS unsigned char* kp = lds + key * 528 + quad * 16; f32x4 a = {0.f, 0.f, 0.f, 0.f};
#pragma unroll
                    for (int ks = 0; ks < 8; ++ks) a = MFMA16(*(const LAS bf16x8*)(kp + ks * 64), qf[ks], a);
                    s[kb] = a; }
                float mx = -1e30f;
#pragma unroll
                for (int kb = 0; kb < 16; ++kb)
#pragma unroll
                    for (int j = 0; j < 4; ++j) mx = fmaxf(mx, s[kb][j]);
                mx = fmaxf(mx, __shfl_xor(mx, 16)); mx = fmaxf(mx, __shfl_xor(mx, 32));
                float sum = 0.f;
#pragma unroll
                for (int kb = 0; kb < 16; ++kb)
#pragma unroll
                    for (int j = 0; j < 4; ++j) { const float e = __expf(s[kb][j] - mx); s[kb][j] = e; sum += e; }
                sum += __shfl_xor(sum, 16); sum += __shfl_xor(sum, 32);
                const float inv = 1.0f / sum;
#pragma unroll
                for (int pr = 0; pr < 8; ++pr) pf[qi][pr] = __builtin_bit_cast(bf16x8, pack8(s[2 * pr] * inv, s[2 * pr + 1] * inv));
            }
        }
        __syncthreads();
        xstage(memvT_l + (size_t)bb * 262144 + (size_t)h * 65536, 256, lds, tid);
        __syncthreads();
        if (active) {
            const int rowA = rowbase + wave * 16, rowB = rowA + 128;
#pragma unroll 4
            for (int db = 0; db < 16; ++db) { f32x4 oa = {0.f, 0.f, 0.f, 0.f}, ob = {0.f, 0.f, 0.f, 0.f}; const LAS unsigned char* vp = lds + (db * 16 + fr) * 528 + quad * 16;
                if (nqb == 2) {
#pragma unroll
                    for (int pr = 0; pr < 8; ++pr) { const bf16x8 vf = *(const LAS bf16x8*)(vp + pr * 64); oa = MFMA16(vf, pf[0][pr], oa); ob = MFMA16(vf, pf[1][pr], ob); }
                } else {
#pragma unroll
                    for (int pr = 0; pr < 8; ++pr) { const bf16x8 vf = *(const LAS bf16x8*)(vp + pr * 64); oa = MFMA16(vf, pf[0][pr], oa); }
                }
                u32x2v w; w.x = pk2(oa[0], oa[1]); w.y = pk2(oa[2], oa[3]);
                *(GAS u32x2v*)((GAS bf16*)ox + (size_t)(rowA + fr) * 1024 + h * 256 + db * 16 + quad * 4) = w;
                if (nqb == 2) { u32x2v w2; w2.x = pk2(ob[0], ob[1]); w2.y = pk2(ob[2], ob[3]); *(GAS u32x2v*)((GAS bf16*)ox + (size_t)(rowB + fr) * 1024 + h * 256 + db * 16 + quad * 4) = w2; } }
        }
    }
    __syncthreads();
}

__device__ __forceinline__ void s5_stage_u(const bf16* up, LAS float* ubuf, int lane) {
    const v4u w0 = *(const v4u*)up, w1 = *(const v4u*)(up + 8);
    LAS f32x4* d = (LAS f32x4*)(ubuf + lane * 16);
    d[0] = (f32x4){bflo(w0.x), bfhi(w0.x), bflo(w0.y), bfhi(w0.y)}; d[1] = (f32x4){bflo(w0.z), bfhi(w0.z), bflo(w0.w), bfhi(w0.w)};
    d[2] = (f32x4){bflo(w1.x), bfhi(w1.x), bflo(w1.y), bfhi(w1.y)}; d[3] = (f32x4){bflo(w1.z), bfhi(w1.z), bflo(w1.w), bfhi(w1.w)};
}
__device__ __forceinline__ f32x2v lo2_(f32x4 v) { return __builtin_shufflevector(v, v, 0, 1); }
__device__ __forceinline__ f32x2v hi2_(f32x4 v) { return __builtin_shufflevector(v, v, 2, 3); }
#define S5_STEP(sidx) do { const LAS f32x4* up_ = (const LAS f32x4*)(ubuf + (sidx) * 16); const f32x4 u0 = up_[0], u1 = up_[1], u2 = up_[2], u3 = up_[3]; \
    f32x2v ac_ = lo2_(bb[0]) * u0[0]; ac_ = hi2_(bb[0]) * u0[1] + ac_; ac_ = lo2_(bb[1]) * u0[2] + ac_; ac_ = hi2_(bb[1]) * u0[3] + ac_; \
    ac_ = lo2_(bb[2]) * u1[0] + ac_; ac_ = hi2_(bb[2]) * u1[1] + ac_; ac_ = lo2_(bb[3]) * u1[2] + ac_; ac_ = hi2_(bb[3]) * u1[3] + ac_; \
    ac_ = lo2_(bb[4]) * u2[0] + ac_; ac_ = hi2_(bb[4]) * u2[1] + ac_; ac_ = lo2_(bb[5]) * u2[2] + ac_; ac_ = hi2_(bb[5]) * u2[3] + ac_; \
    ac_ = lo2_(bb[6]) * u3[0] + ac_; ac_ = hi2_(bb[6]) * u3[1] + ac_; ac_ = lo2_(bb[7]) * u3[2] + ac_; ac_ = hi2_(bb[7]) * u3[3] + ac_; \
    const float nr_ = ar * hr - ai * hi + ac_.x, ni_ = ar * hi + ai * hr + ac_.y; hr = nr_; hi = ni_; } while (0)

typedef short bf16x4_t __attribute__((ext_vector_type(4)));
#define MFMA16K16(a, b, c) __builtin_amdgcn_mfma_f32_16x16x16bf16_1k(a, b, c, 0, 0, 0)
__device__ __forceinline__ bf16x4_t s5_load_u(const bf16* urow0, int fr, int quad) { return *(const GAS bf16x4_t*)((const GAS bf16*)urow0 + (size_t)fr * 1280 + quad * 4); }
__device__ __forceinline__ void s5_bu_block(const bf16x4_t a, const bf16x4_t (&bcf)[8], LAS float* bul, int fr, int quad) {
#pragma unroll
    for (int cb = 0; cb < 8; ++cb) { f32x4 d = {0.f, 0.f, 0.f, 0.f}; d = MFMA16K16(a, bcf[cb], d);
#pragma unroll
        for (int j = 0; j < 4; ++j) bul[(quad * 4 + j) * 130 + cb * 16 + fr] = d[j]; }
}
__device__ __forceinline__ void s5_local(const bf16* proj, const float* abar, const bf16* bbt, float* sloc, LAS float* bul, int slot, int nslots, int lane) {
    const int fr = lane & 15, quad = lane >> 4;
    for (int t = slot; t < 8192; t += nslots) {
        const int chunk = t & 63, g = (t >> 6) & 31, b = t >> 11;
        const float ar = abar[(g * 64 + lane) * 2], ai = abar[(g * 64 + lane) * 2 + 1];
        bf16x4_t bcf[8];
#pragma unroll
        for (int cb = 0; cb < 8; ++cb) bcf[cb] = *(const GAS bf16x4_t*)((const GAS bf16*)bbt + (size_t)(g * 128 + cb * 16 + fr) * 16 + quad * 4);
        float hr = 0.f, hi = 0.f;
        bf16x4_t ua[4];
#pragma unroll
        for (int blk = 0; blk < 4; ++blk) ua[blk] = s5_load_u(proj + (size_t)(b * 4096 + chunk * 64 + blk * 16) * 1280 + g * 16, fr, quad);
#pragma unroll
        for (int blk = 0; blk < 4; ++blk) {
            s5_bu_block(ua[blk], bcf, bul, fr, quad);
#pragma unroll 4
            for (int s = 0; s < 16; ++s) { const f32x2v bu = *(const LAS f32x2v*)(bul + s * 130 + 2 * lane); const float nr = ar * hr - ai * hi + bu.x, ni = ar * hi + ai * hr + bu.y; hr = nr; hi = ni; }
        }
        *(f32x2v*)(sloc + (size_t)t * 128 + lane * 2) = (f32x2v){hr, hi};
    }
}
__device__ __forceinline__ void s5_out(const bf16* proj, const float* abar, const bf16* bbt, const float* sloc, const float* st_re, const float* st_im, const float* c_re, const float* c_im,
                                       const float* dcoef, bf16* gbuf, float* out, LAS float* bul, LAS unsigned* hbuf, int slot, int nslots, int lane) {
    const int fr = lane & 15, quad = lane >> 4;
    for (int t = slot; t < 8192 + 256; t += nslots) {
        const int sample = t >= 8192; int b, g, chunk, nblk, rowbase;
        if (!sample) { chunk = t & 63; g = (t >> 6) & 31; b = t >> 11; nblk = 4; rowbase = b * 4096 + chunk * 64; } else { const int s = t - 8192; g = s & 31; b = s >> 5; chunk = 0; nblk = 2; rowbase = MP + b * 32; }
        const float ar = abar[(g * 64 + lane) * 2], ai = abar[(g * 64 + lane) * 2 + 1];
        bf16x4_t bcf[8];
#pragma unroll
        for (int cb = 0; cb < 8; ++cb) bcf[cb] = *(const GAS bf16x4_t*)((const GAS bf16*)bbt + (size_t)(g * 128 + cb * 16 + fr) * 16 + quad * 4);
        float hr, hi;
        if (!sample) { float pr = ar, pi = ai;
#pragma unroll
            for (int i = 0; i < 6; ++i) { const float t1 = pr * pr - pi * pi; pi = 2.f * pr * pi; pr = t1; }
            hr = 0.f; hi = 0.f; const float* sp = sloc + (size_t)(t - chunk) * 128 + lane * 2;
#pragma unroll 16
            for (int cc = 0; cc < chunk; ++cc) { const f32x2v sv = *(const f32x2v*)(sp + (size_t)cc * 128); const float nr = pr * hr - pi * hi + sv.x, ni = pr * hi + pi * hr + sv.y; hr = nr; hi = ni; } }
        else { hr = st_re[(b * 32 + g) * 64 + lane]; hi = st_im[(b * 32 + g) * 64 + lane]; }
        bf16x8 cf[4];
#pragma unroll
        for (int ks = 0; ks < 4; ++ks) { const f32x4 cr = *(const f32x4*)(c_re + (size_t)(g * 16 + fr) * 64 + ks * 16 + quad * 4), ci = *(const f32x4*)(c_im + (size_t)(g * 16 + fr) * 64 + ks * 16 + quad * 4);
            v4u w; w.x = pg8::cvt_pk_bf16(cr[0], -ci[0]); w.y = pg8::cvt_pk_bf16(cr[1], -ci[1]); w.z = pg8::cvt_pk_bf16(cr[2], -ci[2]); w.w = pg8::cvt_pk_bf16(cr[3], -ci[3]); cf[ks] = __builtin_bit_cast(bf16x8, w); }
        const float dco = dcoef[g * 16 + fr];
        bf16x4_t ua[4]; bf16 uraw[4][4];
#pragma unroll
        for (int blk = 0; blk < 4; ++blk) { const int bc = blk < nblk ? blk : nblk - 1; const bf16* urow0 = proj + (size_t)(rowbase + bc * 16) * 1280 + g * 16; ua[blk] = s5_load_u(urow0, fr, quad);
#pragma unroll
            for (int j = 0; j < 4; ++j) uraw[blk][j] = ((const GAS bf16*)urow0)[(size_t)(quad * 4 + j) * 1280 + fr]; }
#pragma unroll
        for (int blk = 0; blk < 4; ++blk) { if (blk < nblk) {
            s5_bu_block(ua[blk], bcf, bul, fr, quad);
#pragma unroll 4
            for (int s = 0; s < 16; ++s) { const f32x2v bu = *(const LAS f32x2v*)(bul + s * 130 + 2 * lane); const float nr = ar * hr - ai * hi + bu.x, ni = ar * hi + ai * hr + bu.y; hr = nr; hi = ni; hbuf[s * 68 + lane] = pg8::cvt_pk_bf16(hr, hi); }
            f32x4 y = {0.f, 0.f, 0.f, 0.f};
#pragma unroll
            for (int ks = 0; ks < 4; ++ks) { const bf16x8 a = *(const LAS bf16x8*)(hbuf + fr * 68 + ks * 16 + quad * 4); y = MFMA16(a, cf[ks], y); }
#pragma unroll
            for (int j = 0; j < 4; ++j) { const int s = blk * 16 + quad * 4 + j; const float uu = bflo((unsigned)uraw[blk][j]); const float yv = y[j] + dco * uu;
                const float z = 0.7978845608028654f * (yv + 0.044715f * yv * yv * yv); const float th = 1.0f - 2.0f / (1.0f + __expf(2.0f * z)); const float gl = 0.5f * yv * (1.0f + th);
                ((GAS bf16*)gbuf)[(size_t)(rowbase + s) * 512 + g * 16 + fr] = (bf16)f2bf(gl); }
        } }
        if (!sample && chunk == 63) { out[OFF_SRP + (b * 32 + g) * 64 + lane] = hr; out[OFF_SIP + (b * 32 + g) * 64 + lane] = hi; }
        if (sample) { out[OFF_SRS + (b * 32 + g) * 64 + lane] = hr; out[OFF_SIS + (b * 32 + g) * 64 + lane] = hi; }
    }
}

template <int KIND>
__device__ __forceinline__ void sample_gemm(const bf16* A, const bf16* Bt, int K, LAS unsigned char* lds, int tid, int wave, int lane,
                                            bf16* xbp, const float* base_f32, float* part_next, const float* part_cur, bf16* O) {
    const int fr = lane & 15, quad = lane >> 4;
    LAS f32x4* red = (LAS f32x4*)lds;
    LAS float* ssred = (LAS float*)(lds + 32768);
    for (int tile = blockIdx.x; tile < 256; tile += gridDim.x) {
        const int r0 = MP + (tile >> 4) * 16, c0 = (tile & 15) * 64, kw = K >> 3;
        const bf16* ap = A + (size_t)(r0 + fr) * K + wave * kw + quad * 8;
        const bf16* bp = Bt + (size_t)(c0 + fr) * K + wave * kw + quad * 8;
        f32x4 acc[4];
#pragma unroll
        for (int cb = 0; cb < 4; ++cb) acc[cb] = (f32x4){0.f, 0.f, 0.f, 0.f};
        const int e_cb = (tid >> 6) & 3, e_l2 = tid & 63, e_row = r0 + (e_l2 & 15), e_col = c0 + e_cb * 16 + 4 * (e_l2 >> 4); const size_t e_off = (size_t)e_row * 1024 + e_col;
        f32x4 e_bs = {0.f, 0.f, 0.f, 0.f}; float e_rs = 1.f;
        if (tid < 256) { if (KIND == 0) { if (base_f32) e_bs = *(const f32x4*)(base_f32 + e_off); else { const u32x2v w = *(const u32x2v*)(xbp + e_off); e_bs = (f32x4){bflo(w.x), bfhi(w.x), bflo(w.y), bfhi(w.y)}; } }
                         else e_rs = rstd_of(part_cur, e_row); }
        const int nks = kw >> 5;
        for (int k0 = 0; k0 < nks; k0 += 4) {
            bf16x8 a[4], b[4][4];
#pragma unroll
            for (int i = 0; i < 4; ++i) { const int ks = (k0 + i < nks) ? k0 + i : nks - 1;
                a[i] = *(const bf16x8*)(ap + ks * 32);
#pragma unroll
                for (int cb = 0; cb < 4; ++cb) b[i][cb] = *(const bf16x8*)(bp + (size_t)cb * 16 * K + ks * 32); }
            __builtin_amdgcn_sched_barrier(0);
#pragma unroll
            for (int i = 0; i < 4; ++i) if (k0 + i < nks) {
#pragma unroll
                for (int cb = 0; cb < 4; ++cb) acc[cb] = MFMA16(b[i][cb], a[i], acc[cb]); }
        }
#pragma unroll
        for (int cb = 0; cb < 4; ++cb) red[(wave * 4 + cb) * 64 + lane] = acc[cb] * 1.0f;
        __syncthreads();
        if (tid < 256) { const int cb = tid >> 6, l2 = tid & 63; f32x4 v = red[cb * 64 + l2];
#pragma unroll
            for (int w = 1; w < 8; ++w) v = v + red[(w * 4 + cb) * 64 + l2];
            const int row = r0 + (l2 & 15), col = c0 + cb * 16 + 4 * (l2 >> 4); const size_t off = (size_t)row * 1024 + col;
            if (KIND == 0) {
                v = v + e_bs; u32x2v o; o.x = pk2(v[0], v[1]); o.y = pk2(v[2], v[3]); *(u32x2v*)(xbp + off) = o;
                float ss = (v[0] * v[0] + v[1] * v[1]) + (v[2] * v[2] + v[3] * v[3]); ss += __shfl_xor(ss, 16); ss += __shfl_xor(ss, 32);
                if ((l2 >> 4) == 0) ssred[cb * 16 + (l2 & 15)] = ss; }
            else { const float rs = e_rs; u32x2v o; o.x = pk2(v[0] * rs, v[1] * rs); o.y = pk2(v[2] * rs, v[3] * rs); *(u32x2v*)(O + off) = o; }
        }
        if (KIND == 0) { __syncthreads(); if (tid < 16) part_next[(size_t)(r0 + tid) * 16 + (tile & 15)] = (ssred[tid] + ssred[16 + tid]) + (ssred[32 + tid] + ssred[48 + tid]); }
        __syncthreads();
    }
}


__device__ __forceinline__ void sample_cz(const bf16* A, const bf16* Bt, LAS unsigned char* lds, int tid, int wave, int lane,
                                          const float* part_cur, const float* cw, const float* st, bf16* zcp, float* outp) {
    const int fr = lane & 15, quad = lane >> 4;
    LAS f32x4* red = (LAS f32x4*)lds;
    LAS float* T = (LAS float*)(lds + 65536);
    LAS float* CZ = (LAS float*)(lds + 65536 + 8192);
    for (int tile = blockIdx.x; tile < 256; tile += gridDim.x) {
        const int b = tile >> 5, c0 = (tile & 31) * 32, r0 = MP + b * 32;
        const int wrow = 1024 + (c0 >> 7) * 256 + (c0 & 127);
        const GAS bf16* ap = (const GAS bf16*)A + (size_t)(r0 + fr) * 1024 + wave * 128 + quad * 8;
        const GAS bf16* bp = (const GAS bf16*)Bt + (size_t)(wrow + fr) * 1024 + wave * 128 + quad * 8;
        bf16x8 a[4][2], bw[4][4];
#pragma unroll
        for (int ks = 0; ks < 4; ++ks) {
#pragma unroll
            for (int rb = 0; rb < 2; ++rb) a[ks][rb] = *(const GAS bf16x8*)(ap + (size_t)rb * 16 * 1024 + ks * 32);
#pragma unroll
            for (int cb = 0; cb < 4; ++cb) bw[ks][cb] = *(const GAS bf16x8*)(bp + (size_t)((cb >> 1) * 128 + (cb & 1) * 16) * 1024 + ks * 32); }
        f32x4 acc[2][4];
#pragma unroll
        for (int rb = 0; rb < 2; ++rb)
#pragma unroll
            for (int cb = 0; cb < 4; ++cb) { f32x4 d = {0.f, 0.f, 0.f, 0.f};
#pragma unroll
                for (int ks = 0; ks < 4; ++ks) d = MFMA16(bw[ks][cb], a[ks][rb], d);
                acc[rb][cb] = d; }
#pragma unroll
        for (int rb = 0; rb < 2; ++rb)
#pragma unroll
            for (int cb = 0; cb < 4; ++cb) red[(wave * 8 + rb * 4 + cb) * 64 + lane] = acc[rb][cb];
        __syncthreads();
        {
            const int blk = tid >> 6, l2 = tid & 63, rb = blk >> 2, cb = blk & 3; f32x4 v = red[blk * 64 + l2];
#pragma unroll
            for (int w = 1; w < 8; ++w) v = v + red[(w * 8 + blk) * 64 + l2];
            *(LAS f32x4*)(T + ((cb >> 1) * 32 + rb * 16 + (l2 & 15)) * 32 + (cb & 1) * 16 + 4 * (l2 >> 4)) = v; }
        __syncthreads();
        const int r = tid >> 3, cq = (tid & 7) * 4;
        if (tid < 256) { const float rs = rstd_of(part_cur, r0 + r); const float rs2 = rs * rs;
            const f32x4 gc = *(const LAS f32x4*)(T + r * 32 + cq), zz = *(const LAS f32x4*)(T + (32 + r) * 32 + cq);
            *(LAS f32x4*)(CZ + r * 32 + cq) = gc * zz * rs2; }
        __syncthreads();
        if (tid < 256) { const int c = c0 + cq;
            const f32x4 x0 = *(const LAS f32x4*)(CZ + r * 32 + cq);
            const f32x4 s0 = *(const f32x4*)(st + (size_t)(b * 2) * 1024 + c), s1 = *(const f32x4*)(st + (size_t)(b * 2 + 1) * 1024 + c);
            f32x4 xm1 = s1, xm2 = s0;
            if (r >= 1) { xm1 = *(const LAS f32x4*)(CZ + (r - 1) * 32 + cq); xm2 = s1; }
            if (r >= 2) xm2 = *(const LAS f32x4*)(CZ + (r - 2) * 32 + cq);
            const f32x4 w0 = *(const f32x4*)(cw + c), w1 = *(const f32x4*)(cw + 1024 + c), w2 = *(const f32x4*)(cw + 2048 + c);
            const f32x4 z = w0 * xm2 + w1 * xm1 + w2 * x0;
            bf16* gp = zcp + (size_t)(r0 + r) * 1024 + c; const u32x2v gw = *(const u32x2v*)gp;
            u32x2v o; o.x = pk2(z[0] * bflo(gw.x), z[1] * bfhi(gw.x)); o.y = pk2(z[2] * bflo(gw.y), z[3] * bfhi(gw.y)); *(u32x2v*)gp = o;
            if (r >= 30) *(f32x4*)(outp + OFF_CMS + (size_t)(b * 2 + (r - 30)) * 1024 + c) = x0; }
        __syncthreads();
    }
}

struct Params { const float* in[36]; float* out; unsigned char* ws; int use_cg, pad; };

__global__ void __launch_bounds__(512, 2) mega_fwd(Params P) {
    extern __shared__ __attribute__((aligned(16))) unsigned char lds_raw[];
    LAS unsigned char* lds = (LAS unsigned char*)lds_raw;
    volatile LAS unsigned* MISC = (volatile LAS unsigned*)(lds + MISC_OFF);
    const int G = gridDim.x, NGW = G * 8, NT = G * 512;
    const int wave_s = __builtin_amdgcn_readfirstlane(threadIdx.x >> 6);
    for (int u = threadIdx.x; u < (LDS_BYTES - 131072) / 4; u += 512) ((LAS unsigned*)(lds + 131072))[u] = 0u;
    __syncthreads();
    XcdBarrier bar = xcd_barrier_post((unsigned*)(P.ws + WS_BAR), MISC + 8);
#ifndef STOP_AFTER
#define STOP_AFTER 1000
#endif
    int ph = 0;
#define RUN (ph < STOP_AFTER)
#define FRESH() const int tid = fresh_tid(wave_s), lane = tid & 63, wave = __builtin_amdgcn_readfirstlane(tid >> 6); const int gw = blockIdx.x * 8 + wave, gt = blockIdx.x * 512 + tid; (void)gw; (void)gt; (void)lane; LAS float* wscr = (LAS float*)(lds + 32768 + wave * 12288); (void)wscr;
#define SEAM() do { if (P.use_cg) cg::this_grid().sync(); else xcd_barrier(bar); ++ph; } while (0)

#define part ((float*)(ws + WS_PART))
#define PARTBUF(k) (part + (size_t)((k) & 1) * PART_ELEMS)
#define ropec ((float*)(ws + WS_ROPE))
#define ropes (ropec + 4096 * 32)
#define abar ((float*)(ws + WS_SSM))
#define bbar (abar + 32 * 64 * 2)
#define bbt ((bf16*)(bbar + 32 * 64 * 32))
#define ckb ((bf16*)(ws + WS_CKV))
#define cvb (ckb + 8 * 128 * 128)
#define sloc ((float*)(ws + WS_SLOC))
#define memk ((bf16*)(ws + WS_MEMK))
#define memvT ((bf16*)(ws + WS_MEMVT))
#define SG ((float*)(ws + WS_SIDE))
#define SV ((float*)(ws + WS_SIDE + SG_BYTES))
#define WT ((bf16*)(ws + WS_WT))
#define xb ((bf16*)(ws + WS_XB))
#define tmp (ws + WS_TMP)
#define proj0 ((bf16*)(tmp + TMP_PROJ0))
#define gbuf ((bf16*)(tmp + TMP_GBUF))
#define ycat ((bf16*)(tmp + TMP_YCAT))
#define memb ((bf16*)(tmp + TMP_MEMB))
#define qx ((bf16*)(tmp + TMP_QX))
#define ox ((bf16*)(tmp + TMP_OX))
#define act ((bf16*)(tmp + TMP_ACT))
#define gbm ((bf16*)(tmp + TMP_GB))
#define zc ((bf16*)(tmp + TMP_ZC))
#define PTRS() unsigned char* ws = P.ws; float* out = P.out; asm volatile("" : "+s"(ws), "+s"(out));
    if (RUN) { PTRS() FRESH()
        {
            constexpr int NITEMS = 640 + 128 + 512 + 512 + 2 * 1024 + 512 + 2816 + 1408 + 2048;
            for (int it = gw; it < NITEMS; it += NGW) { int r = it;
#define TR(Wp, K_, N_, WTp, gainp, sc, mode) { const int ni_ = ((K_) / 64) * ((N_) / 32); if (r < ni_) { tr_item(Wp, K_, N_, WTp, gainp, sc, mode, wscr, r, lane); continue; } r -= ni_; }
                TR(P.in[15], 1024, 1280, WT + WT_INEVEN, P.in[11], 1.f, 1)
                TR(P.in[25], 512, 512, WT + WT_GLU, nullptr, 1.f, 0)
                TR(P.in[16], 1024, 1024, WT + WT_OUTEVEN, nullptr, 1.f, 0)
                TR(P.in[30], 1024, 1024, WT + WT_WQ, P.in[12], 0.0625f, 0)
                TR(P.in[31], 1024, 2048, WT + WT_WKV, nullptr, 1.f, 0)
                TR(P.in[31] + 2097152, 1024, 2048, WT + WT_WKV + 2097152, nullptr, 1.f, 0)
                TR(P.in[32], 1024, 1024, WT + WT_WO, nullptr, 1.f, 0)
                TR(P.in[33], 1024, 5632, WT + WT_UP, P.in[13], 1.f, 2)
                TR(P.in[35], 2816, 1024, WT + WT_DOWN, nullptr, 1.f, 0)
                { const int mi = r >> 7, l = mi >> 3, b = mi & 7; tr_item(P.in[10] + (size_t)mi * 262144, 256, 1024, memvT + (size_t)(l * 12 + 4 + b) * 262144, nullptr, 1.f, 0, wscr, r & 127, lane); }
            }
        }
        for (int m = gw; m < MROWS; m += NGW) { const float* xr = m < MP ? P.in[0] + (size_t)m * 1024 : P.in[1] + (size_t)(m - MP) * 1024; float ss = 0.f;
#pragma unroll
            for (int j = 0; j < 4; ++j) { const f32x4 v = *(const f32x4*)(xr + (lane + 64 * j) * 4); ss += (v[0] * v[0] + v[1] * v[1]) + (v[2] * v[2] + v[3] * v[3]);
                u32x2v w; w.x = pg8::cvt_pk_bf16(v[0], v[1]); w.y = pg8::cvt_pk_bf16(v[2], v[3]); *(u32x2v*)(xb + (size_t)m * 1024 + (lane + 64 * j) * 4) = w; }
            ss = wave_sum(ss); if (lane < 16) PARTBUF(0)[(size_t)m * 16 + lane] = lane == 0 ? ss : 0.f; }
        for (int i = gt; i < 262144; i += NT) { const f32x4 v = *(const f32x4*)(P.in[2] + (size_t)i * 4); u32x2v w; w.x = pg8::cvt_pk_bf16(v[0], v[1]); w.y = pg8::cvt_pk_bf16(v[2], v[3]); *(u32x2v*)(memb + (size_t)i * 4) = w; }
        for (int i = gt; i < 1048576; i += NT) { const size_t e = (size_t)i * 4; const int lb = (int)(e >> 18), l = lb >> 3, b = lb & 7; const f32x4 v = *(const f32x4*)(P.in[9] + e);
            u32x2v w; w.x = pg8::cvt_pk_bf16(v[0], v[1]); w.y = pg8::cvt_pk_bf16(v[2], v[3]); *(u32x2v*)(memk + (size_t)(l * 12 + 4 + b) * 262144 + (e & 262143)) = w; }
        for (int i = gt; i < 65536; i += NT) { const int j = i & 32767; const float* src = (i < 32768 ? P.in[3] : P.in[4]) + (size_t)j * 4; bf16* dst = (i < 32768 ? ckb : cvb) + (size_t)j * 4;
            const f32x4 v = *(const f32x4*)src; u32x2v w; w.x = pg8::cvt_pk_bf16(v[0], v[1]); w.y = pg8::cvt_pk_bf16(v[2], v[3]); *(u32x2v*)dst = w; }
        for (int i = gt; i < 4096 * 32; i += NT) { const int pos = i >> 5, d = i & 31; const double inv = dexp_(-(double)d * (9.210340371976184 / 32.0)); double s, c; dsincos_((double)pos * inv, s, c); ropec[i] = (float)c; ropes[i] = (float)s; }
        for (int i = gt; i < 2048; i += NT) { const double are = P.in[17][i], aim = P.in[18][i], dt = dexp_((double)P.in[19][i]); double s, c; dsincos_(aim * dt, s, c); const double mag = dexp_(are * dt);
            const double br = mag * c, bi = mag * s; abar[2 * i] = (float)br; abar[2 * i + 1] = (float)bi;
            const double nr = br - 1.0, ni = bi, den = are * are + aim * aim; const double qr = (nr * are + ni * aim) / den, qi = (ni * are - nr * aim) / den;
#pragma unroll 4
            for (int h = 0; h < 16; ++h) { const double xr = P.in[20][(size_t)i * 16 + h], xi = P.in[21][(size_t)i * 16 + h]; const float fre = (float)(qr * xr - qi * xi), fim = (float)(qr * xi + qi * xr); bbar[(size_t)i * 32 + 2 * h] = fre; bbar[(size_t)i * 32 + 2 * h + 1] = fim;
                bbt[((size_t)i * 2) * 16 + h] = (bf16)f2bf(fre); bbt[((size_t)i * 2 + 1) * 16 + h] = (bf16)f2bf(fim); } }
    }
    SEAM();
    if (RUN) { PTRS()
        if (G < 128 || (int)blockIdx.x >= G - 64) { pg8::Gemm g{memb, WT + WT_WKV, 1024, 4096, 1024}; pg8::StaticOrder S;
            if (G < 128) S.init(1024, 4096, G, (int)blockIdx.x); else S.init(1024, 4096, 64, (int)blockIdx.x - (G - 64)); EpiKV E{out, memk};
          pg8::gemm_phase<EpiKV, pg8::StaticOrder, true, true>(lds, g, S, E, wave_s); }
        { pg8::Gemm g{xb, WT + WT_INEVEN, MROWS, 1280, 1024}; pg8::StaticOrderF S; S.init(MROWS, 1280, G, (int)blockIdx.x); EpiIn0 E{proj0, PARTBUF(0), ropec, ropes, out};
          pg8::gemm_phase<EpiIn0, pg8::StaticOrderF, true, true>(lds, g, S, E, wave_s); }
        {
            FRESH()
            const int bx = (int)blockIdx.x, n2 = 325 - G;
            int slot = -1, nw = 1;
            if (G == 256) { if (bx >= n2 && bx < G - 64) { slot = (bx - n2) * 8 + wave; nw = (G - 64 - n2) * 8; } } else { slot = gw; nw = NGW; }
            if (slot >= 0) for (int it = slot; it < 2816 + 1408; it += nw) { int r = it;
                TR(P.in[33] + (size_t)1024 * 5632, 1024, 5632, WT + WT_UP + (size_t)5632 * 1024, P.in[13] + 1024, 1.f, 2)
                tr_item(P.in[35] + (size_t)2816 * 1024, 2816, 1024, WT + WT_DOWN + (size_t)2816 * 1024, nullptr, 1.f, 0, wscr, r, lane); }
        }
    }
    SEAM();
    if (RUN) { PTRS() FRESH()
        swa_phase(proj0, ckb, cvb, P.in[26], ycat, lds, tid, wave, lane, G);
        s5_local(proj0, abar, bbt, sloc, wscr, wave * G + (int)blockIdx.x, NGW, lane);
        for (int it = wave * G + (int)blockIdx.x; it < 1024; it += NGW) { const int mi = it >> 7, l = mi >> 2, b = mi & 3;
            tr_item(out + OFF_MVP + (size_t)mi * 262144, 256, 1024, memvT + (size_t)(l * 12 + b) * 262144, nullptr, 1.f, 0, wscr, it & 127, lane); }
    }
    SEAM();
    if (RUN) { PTRS() FRESH() s5_out(proj0, abar, bbt, sloc, P.in[5], P.in[6], P.in[22], P.in[23], P.in[24], gbuf, out, (LAS float*)(lds + wave * 16384), (LAS unsigned*)(lds + wave * 16384 + 8448), wave * G + (int)blockIdx.x, NGW, lane); }
    SEAM();
    if (RUN) { PTRS() pg8::Gemm g{gbuf, WT + WT_GLU, MROWS, 512, 512}; pg8::StaticOrder S; S.init(MROWS, 512, G, (int)blockIdx.x); EpiGlu E{gbuf, ycat};
        pg8::gemm_phase<EpiGlu, pg8::StaticOrder, true, true>(lds, g, S, E, wave_s);
        {
            FRESH()
            const int bx = (int)blockIdx.x; int slot = -1, nw = 1;
            if (G > 130) { if (bx >= 130) { slot = (bx - 130) * 8 + wave; nw = (G - 130) * 8; } } else { slot = gw; nw = NGW; }
            if (slot >= 0) for (int it = slot; it < 1536 + 512; it += nw) { int r = it;
                TR(P.in[27], 1024, 3072, WT + WT_INODD, P.in[11] + 1024, 1.f, 3)
                tr_item(P.in[29], 1024, 1024, WT + WT_OUTODD, nullptr, 1.f, 0, wscr, r, lane); }
        } }
    SEAM();

#pragma unroll
    for (int l = 0; l < 2; ++l) {
        if (l == 1) {
            if (RUN) { PTRS() pg8::Gemm g{xb, WT + WT_INODD, MP, 1024, 1024}; pg8::StaticOrderF S; S.init(MP, 1024, G, (int)blockIdx.x); EpiBf16 E{gbm, 1024, PARTBUF(3)};
                pg8::gemm_phase<EpiBf16, pg8::StaticOrderF, true, true>(lds, g, S, E, wave_s);
                { FRESH() sample_gemm<1>(xb, WT + WT_INODD, 1024, lds, tid, wave, lane, nullptr, nullptr, nullptr, PARTBUF(3), gbm); } }
            SEAM();
            if (RUN) { PTRS() pg8::Gemm g{xb, WT + WT_INODD + (size_t)1024 * 1024, MP, 2048, 1024}; pg8::StaticOrderF S; S.init(MP, 2048, G, (int)blockIdx.x); EpiCz E{gbm, PARTBUF(3), P.in[28], SG};
                pg8::gemm_phase<EpiCz, pg8::StaticOrderF, true, true>(lds, g, S, E, wave_s);
                { FRESH() sample_cz(xb, WT + WT_INODD, lds, tid, wave, lane, PARTBUF(3), P.in[28], P.in[7], gbm, out); } }
            SEAM();
            if (RUN) { PTRS() FRESH()
                const float* cw = P.in[28];
                for (int i = gt; i < 512 * 128; i += NT) { const int ri = i >> 7, c0 = (i & 127) * 8, blk = ri >> 1, rr = ri & 1, row = blk * 64 + rr;
                    f32x4 pa0, pa1, pb0, pb1;
                    if ((blk & 63) == 0) { pa0 = pa1 = pb0 = pb1 = (f32x4){0.f, 0.f, 0.f, 0.f}; }
                    else { const float* s0 = SG + (size_t)((blk - 1) * 8 + 6) * 1024 + c0; pa0 = *(const f32x4*)s0; pa1 = *(const f32x4*)(s0 + 4); pb0 = *(const f32x4*)(s0 + 1024); pb1 = *(const f32x4*)(s0 + 1028); }
                    const float* sc = SG + (size_t)(blk * 8) * 1024 + c0; const f32x4 x00 = *(const f32x4*)sc, x01 = *(const f32x4*)(sc + 4);
                    f32x4 xm2a, xm2b, xm1a, xm1b, xca, xcb;
                    if (rr == 0) { xm2a = pa0; xm2b = pa1; xm1a = pb0; xm1b = pb1; xca = x00; xcb = x01; }
                    else { xm2a = pb0; xm2b = pb1; xm1a = x00; xm1b = x01; xca = *(const f32x4*)(sc + 1024); xcb = *(const f32x4*)(sc + 1028); }
                    const f32x4 w0a = *(const f32x4*)(cw + c0), w0b = *(const f32x4*)(cw + c0 + 4), w1a = *(const f32x4*)(cw + 1024 + c0), w1b = *(const f32x4*)(cw + 1028 + c0), w2a = *(const f32x4*)(cw + 2048 + c0), w2b = *(const f32x4*)(cw + 2052 + c0);
                    const f32x4 z0 = w0a * xm2a + w1a * xm1a + w2a * xca, z1 = w0b * xm2b + w1b * xm1b + w2b * xcb;
                    const v4u gw_ = *(const v4u*)(gbm + (size_t)row * 1024 + c0);
                    const f32x4 g0 = (f32x4){bflo(gw_.x), bfhi(gw_.x), bflo(gw_.y), bfhi(gw_.y)}, g1 = (f32x4){bflo(gw_.z), bfhi(gw_.z), bflo(gw_.w), bfhi(gw_.w)};
                    *(v4u*)(gbm + (size_t)row * 1024 + c0) = pack8(g0 * z0, g1 * z1); }
                for (int i = gt; i < 4 * 2 * 1024; i += NT) { const int c = i & 1023, j = (i >> 10) & 1, b = i >> 11; out[OFF_CMP + i] = SG[(size_t)((64 * b + 63) * 8 + 6 + j) * 1024 + c]; }
            }
            SEAM();
        }
        if (RUN) { PTRS() pg8::Gemm g{(bf16*)(tmp + (size_t)(1 - l) * TMP_YCAT), WT + WT_OUTEVEN + (size_t)l * (WT_OUTODD - WT_OUTEVEN), MP, 1024, 1024}; pg8::StaticOrderF S; S.init(MP, 1024, G, (int)blockIdx.x);
            EpiRes E{P.in[0], P.in[1] - (size_t)MP * 1024, xb, PARTBUF(1 + 3 * l), l == 0 ? 1 : 0};
            pg8::gemm_phase<EpiRes, pg8::StaticOrderF, true, true>(lds, g, S, E, wave_s);
            { FRESH() sample_gemm<0>((bf16*)(tmp + (size_t)(1 - l) * TMP_YCAT), WT + WT_OUTEVEN + (size_t)l * (WT_OUTODD - WT_OUTEVEN), 1024, lds, tid, wave, lane, xb, l == 0 ? P.in[1] - (size_t)MP * 1024 : (const float*)nullptr, PARTBUF(1 + 3 * l), nullptr, nullptr); } }
        SEAM();
        if (RUN) { PTRS() pg8::Gemm g{xb, WT + WT_WQ + (size_t)l * 1048576, MP, 1024, 1024}; pg8::StaticOrderF S; S.init(MP, 1024, G, (int)blockIdx.x); EpiBf16 E{qx, 1024, PARTBUF(1 + 3 * l)};
            pg8::gemm_phase<EpiBf16, pg8::StaticOrderF, true, true>(lds, g, S, E, wave_s);
            { FRESH() sample_gemm<1>(xb, WT + WT_WQ + (size_t)l * 1048576, 1024, lds, tid, wave, lane, nullptr, nullptr, nullptr, PARTBUF(1 + 3 * l), qx); } }
        SEAM();
        if (RUN) { PTRS() FRESH() xattn_phase2(qx, memk + (size_t)l * 12 * 262144, memvT + (size_t)l * 12 * 262144, ox, lds, tid, wave, lane, G); }
        SEAM();
        if (RUN) { PTRS() pg8::Gemm g{ox, WT + WT_WO + (size_t)l * 1048576, MP, 1024, 1024}; pg8::StaticOrderF S; S.init(MP, 1024, G, (int)blockIdx.x); EpiRes E{P.in[0], P.in[0], xb, PARTBUF(2 + 3 * l), 0};
            pg8::gemm_phase<EpiRes, pg8::StaticOrderF, true, true>(lds, g, S, E, wave_s);
            { FRESH() sample_gemm<0>(ox, WT + WT_WO + (size_t)l * 1048576, 1024, lds, tid, wave, lane, xb, nullptr, PARTBUF(2 + 3 * l), nullptr, nullptr); } }
        SEAM();
        if (RUN) { PTRS() pg8::Gemm g{xb, WT + WT_UP + (size_t)l * 5632 * 1024, MROWS, 5632, 1024}; pg8::StaticOrderF S; S.init(MROWS, 5632, G, (int)blockIdx.x);
            EpiFfnUp E{act, PARTBUF(2 + 3 * l), P.in[34] + (size_t)l * 3 * DFF, SG, SV};
            pg8::gemm_phase<EpiFfnUp, pg8::StaticOrderF, true, true>(lds, g, S, E, wave_s);
            if (l == 0) {
                FRESH()
                const int bx = (int)blockIdx.x, nb = 1430 % G; int slot = -1, nw = 1;
                if (nb > 0 && nb < G) { if (bx >= nb) { slot = (bx - nb) * 8 + wave; nw = (G - nb) * 8; } } else { slot = gw; nw = NGW; }
                if (slot >= 0) for (int it = slot; it < 512 + 512; it += nw) { int r = it;
                    TR(P.in[30] + 1048576, 1024, 1024, WT + WT_WQ + 1048576, P.in[12] + 1024, 0.0625f, 0)
                    tr_item(P.in[32] + 1048576, 1024, 1024, WT + WT_WO + 1048576, nullptr, 1.f, 0, wscr, r, lane); }
            } }
        SEAM();
        if (RUN) { PTRS() FRESH()
            const float* cw = P.in[34] + (size_t)l * 3 * DFF; const float* st = P.in[8] + (size_t)l * 8 * 2 * DFF;
            for (int i = gt; i < 528 * 352; i += NT) { const int fi = i / 352, c0 = (i % 352) * 8; int blk, row, rr, sb, vb; bool smp = fi >= 512;
                if (!smp) { blk = fi >> 1; rr = fi & 1; row = blk * 64 + rr; sb = 0; vb = 0; } else { const int s = fi - 512, half = (s >> 1) & 1; blk = 256 + (s >> 2); rr = s & 1; row = blk * 64 + half * 32 + rr; sb = half * 4; vb = half * 2; }
                f32x4 pa0, pa1, pb0, pb1;
                if (smp) { const int b = (blk - 256) * 2 + (sb >> 2); const float* s0 = st + (size_t)(b * 2) * DFF + c0; pa0 = *(const f32x4*)s0; pa1 = *(const f32x4*)(s0 + 4); pb0 = *(const f32x4*)(s0 + DFF); pb1 = *(const f32x4*)(s0 + DFF + 4); }
                else if ((blk & 63) == 0) { pa0 = pa1 = pb0 = pb1 = (f32x4){0.f, 0.f, 0.f, 0.f}; }
                else { const float* s0 = SG + (size_t)((blk - 1) * 8 + 6) * DFF + c0; pa0 = *(const f32x4*)s0; pa1 = *(const f32x4*)(s0 + 4); pb0 = *(const f32x4*)(s0 + DFF); pb1 = *(const f32x4*)(s0 + DFF + 4); }
                const float* sc = SG + (size_t)(blk * 8 + sb) * DFF + c0; const f32x4 x00 = *(const f32x4*)sc, x01 = *(const f32x4*)(sc + 4);
                f32x4 xm2a, xm2b, xm1a, xm1b, xca, xcb;
                if (rr == 0) { xm2a = pa0; xm2b = pa1; xm1a = pb0; xm1b = pb1; xca = x00; xcb = x01; }
                else { xm2a = pb0; xm2b = pb1; xm1a = x00; xm1b = x01; xca = *(const f32x4*)(sc + DFF); xcb = *(const f32x4*)(sc + DFF + 4); }
                const f32x4 w0a = *(const f32x4*)(cw + c0), w0b = *(const f32x4*)(cw + c0 + 4), w1a = *(const f32x4*)(cw + DFF + c0), w1b = *(const f32x4*)(cw + DFF + c0 + 4), w2a = *(const f32x4*)(cw + 2 * DFF + c0), w2b = *(const f32x4*)(cw + 2 * DFF + c0 + 4);
                const f32x4 ga = w0a * xm2a + w1a * xm1a + w2a * xca, gb_ = w0b * xm2b + w1b * xm1b + w2b * xcb;
                const float* sv = SV + (size_t)(blk * 4 + vb + rr) * DFF + c0; const f32x4 va = *(const f32x4*)sv, vb_ = *(const f32x4*)(sv + 4);
                f32x4 a0, a1;
#pragma unroll
                for (int j = 0; j < 4; ++j) { a0[j] = ga[j] * sigmoidf_(ga[j]) * va[j]; a1[j] = gb_[j] * sigmoidf_(gb_[j]) * vb_[j]; }
                *(v4u*)(act + (size_t)row * DFF + c0) = pack8(a0, a1); }
            for (int i = gt; i < 4 * 2 * DFF; i += NT) { const int c = i % DFF, j = (i / DFF) & 1, b = i / (2 * DFF); out[OFF_CFP + (size_t)l * 4 * 2 * DFF + i] = SG[(size_t)((64 * b + 63) * 8 + 6 + j) * DFF + c]; }
            for (int i = gt; i < 8 * 2 * DFF; i += NT) { const int c = i % DFF, j = (i / DFF) & 1, b = i / (2 * DFF); out[OFF_CFS + (size_t)l * 8 * 2 * DFF + i] = SG[(size_t)((256 + (b >> 1)) * 8 + (b & 1) * 4 + 2 + j) * DFF + c]; }
        }
        SEAM();
        if (RUN) { PTRS() pg8::Gemm g{act, WT + WT_DOWN + (size_t)l * 2816 * 1024, MP, 1024, DFF}; pg8::StaticOrderF S; S.init(MP, 1024, G, (int)blockIdx.x); EpiRes E{P.in[0], P.in[0], xb, PARTBUF(3 + 3 * l), 0};
            pg8::gemm_phase<EpiRes, pg8::StaticOrderF, true, true>(lds, g, S, E, wave_s);
            { FRESH() sample_gemm<0>(act, WT + WT_DOWN + (size_t)l * 2816 * 1024, DFF, lds, tid, wave, lane, xb, nullptr, PARTBUF(3 + 3 * l), nullptr, nullptr); } }
        SEAM();
    }
    if (RUN) { PTRS() FRESH()
        const float* gf = P.in[14];
        for (int m = gw; m < MROWS; m += NGW) { const float rs = rstd_of(PARTBUF(6), m); float* xr = out + (size_t)m * 1024; const bf16* xbr = xb + (size_t)m * 1024;
#pragma unroll
            for (int j = 0; j < 4; ++j) { const int c = (lane + 64 * j) * 4; const u32x2v w = *(const u32x2v*)(xbr + c); const f32x4 v = (f32x4){bflo(w.x), bfhi(w.x), bflo(w.y), bfhi(w.y)}, gg = *(const f32x4*)(gf + c); *(f32x4*)(xr + c) = v * rs * gg; } }
    }
}

extern "C" void kernel_launch(void* const* d_in, const int* in_sizes, int n_in, void* d_out, int out_size, void* d_ws, size_t ws_size, hipStream_t stream) {
    static int grid = 0;
    if (grid == 0) {
        int dev = 0, cus = 0, per_cu = 0;
        if (n_in != 36 || ws_size < 256 * MiB) { fprintf(stderr, "kernel_launch: unexpected n_in %d / ws %zu\n", n_in, ws_size); grid = -1; return; }
        (void)hipGetDevice(&dev); (void)hipDeviceGetAttribute(&cus, hipDeviceAttributeMultiprocessorCount, dev);
        if (hipFuncSetAttribute((const void*)mega_fwd, hipFuncAttributeMaxDynamicSharedMemorySize, LDS_BYTES) != hipSuccess) { fprintf(stderr, "kernel_launch: hipFuncSetAttribute failed\n"); grid = -1; return; }
        if (hipOccupancyMaxActiveBlocksPerMultiprocessor(&per_cu, (const void*)mega_fwd, 512, LDS_BYTES) != hipSuccess || per_cu < 1) per_cu = 1;
        (void)hipGetLastError();
        grid = cus * 1;
        if (grid > 256) grid = 256;
    }
    if (grid < 0) return;
    (void)hipMemsetAsync(d_ws, 0, CTL_ZERO_BYTES, stream);
    Params p{};
    for (int i = 0; i < 36; ++i) p.in[i] = (const float*)d_in[i];
    p.out = (float*)d_out; p.ws = (unsigned char*)d_ws; p.use_cg = 0; p.pad = 0;
    void* args[] = {&p};
    hipError_t e = hipLaunchCooperativeKernel((const void*)mega_fwd, dim3(grid), dim3(512), args, LDS_BYTES, stream);
    if (e != hipSuccess) fprintf(stderr, "cooperative launch failed: %s (grid %d)\n", hipGetErrorString(e), grid);
}
```

```cpp
#include <hip/hip_runtime.h>
#include <hip/hip_cooperative_groups.h>
#include <cstdio>
#include <cstdint>
namespace cg = cooperative_groups;
__device__ __forceinline__ int fresh_tid(int wave_s) { unsigned z = 0u; asm volatile("" : "+s"(z)); int t = wave_s * 64 + (int)__builtin_amdgcn_mbcnt_hi(~0u, __builtin_amdgcn_mbcnt_lo(~0u, z)); asm volatile("" : "+v"(t)); return t; }
namespace pg8 {
#define PG8_LAS __attribute__((address_space(3)))
typedef unsigned short bf16_t;
typedef short bf16x8 __attribute__((ext_vector_type(8)));
typedef float f32x4 __attribute__((ext_vector_type(4)));
typedef unsigned u32x4 __attribute__((ext_vector_type(4)));
constexpr int BM = 256, BK = 64, HALF = 128, HTB = HALF * BK * 2  , STAGE_BYTES = 8 * HTB, NXCD = 8, WGM = 8;

__host__ __device__ __forceinline__ int lds_byte(int r, int c) { const int st = (r >> 4) * 2 + (c >> 5), rr = r & 15, cc = c & 31, ob = rr * 64 + cc * 2; return st * 1024 + (ob ^ (((ob >> 9) & 1) << 5)); }
__host__ __device__ __forceinline__ void stage_rc(int b, int& R, int& C) { const int st = b / 1024, sb = b % 1024, swz = sb ^ (((sb >> 9) & 1) << 5); R = (st >> 1) * 16 + swz / 64; C = (st & 1) * 32 + (swz % 64) / 2; }
__host__ __device__ __forceinline__ int perm32(int rho) { const int n = rho >> 4, i = rho & 15; return 8 * (i >> 2) + 4 * n + (i & 3); }

struct Unit { int pm, pn; };
struct Gemm { const bf16_t* A; const bf16_t* Bt; int M, N, K; };

template <bool FULL> struct StaticOrderT {
    int nM, nN, nwg, G, c;
    __host__ __device__ void init(int M, int N, int G_, int c_) { nM = M / BM; nN = N / BM; nwg = nM * nN; G = G_; c = c_; }
    __host__ __device__ bool next(int i, Unit& u) const {
        const long L = (long)i * G + c; if (!(FULL && i == 0) && L >= nwg) return false;
        int wgid = (int)L; { const int q = nwg / NXCD, r = nwg % NXCD, xcd = wgid % NXCD, off = wgid / NXCD; wgid = (xcd < r ? xcd * (q + 1) : r * (q + 1) + (xcd - r) * q) + off; }
        const int nig = WGM * nN, gid = wgid / nig, fm = gid * WGM, gsz = (nM - fm) < WGM ? (nM - fm) : WGM;
        u.pm = fm + ((wgid % nig) % gsz); u.pn = (wgid % nig) / gsz; return true;
    }
    __device__ __forceinline__ void a_ready(const Unit&) const {}
    __device__ __forceinline__ void done(const Unit&) const {}
};

typedef StaticOrderT<false> StaticOrder; typedef StaticOrderT<true> StaticOrderF;
__device__ __forceinline__ unsigned cvt_pk_bf16(float lo, float hi) { unsigned r; asm volatile("v_cvt_pk_bf16_f32 %0, %1, %2" : "=v"(r) : "v"(lo), "v"(hi)); return r; }
typedef float f32x2 __attribute__((ext_vector_type(2)));
template <class Epi, class Sched, bool ALIGN_EPI = false, bool SP2 = false>
__device__ __forceinline__ void gemm_phase(PG8_LAS unsigned char* lds, const Gemm g, const Sched& S, const Epi& E, const int wave_s) {
    const int tid = fresh_tid(wave_s), wid = __builtin_amdgcn_readfirstlane(tid >> 6), lane = tid & 63, wr = wid >> 2, wc = wid & 3, fr = lane & 15, fq = lane >> 4;
    const int K = g.K, nt = K / BK;
    unsigned voffA[2], voffB[2];
#pragma unroll
    for (int i = 0; i < 2; ++i) { int R, C; stage_rc(tid * 16 + i * 8192, R, C); const int Rb = Epi::PERM ? ((R & ~31) + perm32(R & 31)) : R;
        voffA[i] = (unsigned)(R * K + C) * 2u; voffB[i] = (unsigned)(Rb * K + C) * 2u; }
    const size_t kstep = (size_t)(BK * 2);
    const size_t hstep = (size_t)HALF * K * 2;
    const size_t tstep = 2 * hstep;
    const unsigned ldsw = (unsigned)wid * 1024u;
    const int aoff = lds_byte(wr * 64 + fr, fq * 8), boff = lds_byte(wc * 32 + fr, fq * 8);
#define PG8_SA(b, h) (((b) * 2 + (h)) * HTB)
#define PG8_SB(b, h) ((4 + (b) * 2 + (h)) * HTB)
#define PG8_STAGE(bufoff, gbase, voff) do { _Pragma("unroll") for (int _i = 0; _i < 2; ++_i) \
        __builtin_amdgcn_global_load_lds((const unsigned*)((const char*)(gbase) + (voff)[_i]), (PG8_LAS unsigned*)(lds + (bufoff) + ldsw + _i * 8192), 16, 0, 0); } while (0)
#define PG8_LDA(dst, b, h) do { _Pragma("unroll") for (int m = 0; m < 4; ++m) _Pragma("unroll") for (int k = 0; k < 2; ++k) dst[m][k] = *(const PG8_LAS bf16x8*)(lds + PG8_SA(b, h) + aoff + m * 2048 + k * 1024); } while (0)
#define PG8_LDB(dst, b, h) do { _Pragma("unroll") for (int n = 0; n < 2; ++n) _Pragma("unroll") for (int k = 0; k < 2; ++k) dst[n][k] = *(const PG8_LAS bf16x8*)(lds + PG8_SB(b, h) + boff + n * 2048 + k * 1024); } while (0)
#define PG8_MMA(ai, bj, At, Bt) do { __builtin_amdgcn_s_setprio(1); _Pragma("unroll") for (int m = 0; m < 4; ++m) _Pragma("unroll") for (int n = 0; n < 2; ++n) _Pragma("unroll") for (int k = 0; k < 2; ++k) \
        acc[ai][bj][m][n] = __builtin_amdgcn_mfma_f32_16x16x32_bf16(Bt[n][k], At[m][k], acc[ai][bj][m][n], 0, 0, 0); __builtin_amdgcn_s_setprio(0); } while (0)
#define PG8_WAIT_V(n) asm volatile("s_waitcnt vmcnt(" #n ")" ::: "memory")
#define PG8_WAIT_L(n) asm volatile("s_waitcnt lgkmcnt(" #n ")" ::: "memory")
#define PG8_BAR __builtin_amdgcn_s_barrier()
#define PG8_SCHED __builtin_amdgcn_sched_barrier(0)
    Unit cur, nxt; int ui = 0;
    if (!S.next(0, cur)) return;
    f32x4 acc[2][2][4][2];
#pragma unroll
    for (int a = 0; a < 2; ++a)
#pragma unroll
        for (int b = 0; b < 2; ++b)
#pragma unroll
            for (int m = 0; m < 4; ++m)
#pragma unroll
                for (int n = 0; n < 2; ++n) acc[a][b][m][n] = (f32x4){0.f, 0.f, 0.f, 0.f};
    bf16x8 At[4][2], B0[2][2], B1[2][2];
    const char* cA = (const char*)g.A + (size_t)cur.pm * tstep; const char* cB = (const char*)g.Bt + (size_t)cur.pn * tstep;
    S.a_ready(cur);
    if constexpr (SP2) {
        PG8_STAGE(PG8_SB(0, 0), cB, voffB); PG8_STAGE(PG8_SB(0, 1), cB + hstep, voffB); PG8_STAGE(PG8_SA(0, 0), cA, voffA); PG8_STAGE(PG8_SA(0, 1), cA + hstep, voffA);
        if (wr == 1) PG8_BAR;
        PG8_WAIT_V(2); PG8_BAR;
        PG8_STAGE(PG8_SB(1, 0), cB + kstep, voffB); PG8_STAGE(PG8_SA(1, 0), cA + kstep, voffA); PG8_STAGE(PG8_SB(1, 1), cB + hstep + kstep, voffB);
        PG8_WAIT_V(6); PG8_BAR;
    } else {
        PG8_STAGE(PG8_SB(0, 0), cB, voffB); PG8_STAGE(PG8_SA(0, 0), cA, voffA); PG8_STAGE(PG8_SB(0, 1), cB + hstep, voffB); PG8_STAGE(PG8_SA(0, 1), cA + hstep, voffA);
        if (wr == 1) PG8_BAR;
        PG8_WAIT_V(4); PG8_BAR;
        PG8_STAGE(PG8_SB(1, 0), cB + kstep, voffB); PG8_STAGE(PG8_SA(1, 0), cA + kstep, voffA); PG8_STAGE(PG8_SB(1, 1), cB + hstep + kstep, voffB);
        PG8_WAIT_V(6); PG8_BAR;
    }
    for (;;) {
        const bool has_next = S.next(ui + 1, nxt);
        const char* nA = has_next ? (const char*)g.A + (size_t)nxt.pm * tstep : cA; const char* nB = has_next ? (const char*)g.Bt + (size_t)nxt.pn * tstep : cB;
        for (int t = 0; t < nt; t += 2) {
            const bool last = (t == nt - 2);
            const char* a1 = cA + (size_t)(t + 1) * kstep;
            const char* a2 = last ? nA : cA + (size_t)(t + 2) * kstep; const char* b2 = last ? nB : cB + (size_t)(t + 2) * kstep;
            const char* a3 = a2 + kstep; const char* b3 = b2 + kstep;
            if (last && has_next) S.a_ready(nxt);
            if constexpr (SP2) {
            PG8_LDB(B0, 0, 0); PG8_LDB(B1, 0, 1); PG8_SCHED; PG8_LDA(At, 0, 0); PG8_STAGE(PG8_SA(1, 1), a1 + hstep, voffA);
            PG8_WAIT_V(8); PG8_WAIT_L(0); PG8_BAR; PG8_MMA(0, 0, At, B0); PG8_MMA(0, 1, At, B1); PG8_BAR; PG8_SCHED;
            PG8_LDA(At, 0, 1); PG8_STAGE(PG8_SB(0, 0), b2, voffB); PG8_STAGE(PG8_SB(0, 1), b2 + hstep, voffB); PG8_STAGE(PG8_SA(0, 0), a2, voffA);
            PG8_WAIT_V(8); PG8_WAIT_L(0); PG8_BAR; PG8_MMA(1, 0, At, B0); PG8_MMA(1, 1, At, B1); PG8_BAR; PG8_SCHED;
            PG8_LDB(B0, 1, 0); PG8_LDB(B1, 1, 1); PG8_SCHED; PG8_LDA(At, 1, 0); PG8_STAGE(PG8_SA(0, 1), a2 + hstep, voffA);
            PG8_WAIT_V(8); PG8_WAIT_L(0); PG8_BAR; PG8_MMA(0, 0, At, B0); PG8_MMA(0, 1, At, B1); PG8_BAR; PG8_SCHED;
            PG8_LDA(At, 1, 1); PG8_STAGE(PG8_SB(1, 0), b3, voffB); PG8_STAGE(PG8_SB(1, 1), b3 + hstep, voffB); PG8_STAGE(PG8_SA(1, 0), a3, voffA);
            PG8_WAIT_V(8); PG8_WAIT_L(0); PG8_BAR; PG8_MMA(1, 0, At, B0); PG8_MMA(1, 1, At, B1); PG8_BAR; PG8_SCHED;
            } else {
            PG8_LDB(B0, 0, 0); PG8_SCHED; PG8_LDA(At, 0, 0); PG8_STAGE(PG8_SA(1, 1), a1 + hstep, voffA);
            PG8_WAIT_L(8); PG8_BAR; PG8_WAIT_L(0); PG8_MMA(0, 0, At, B0); PG8_BAR; PG8_SCHED;
            PG8_LDB(B1, 0, 1); PG8_STAGE(PG8_SB(0, 0), b2, voffB);
            PG8_BAR; PG8_WAIT_L(0); PG8_MMA(0, 1, At, B1); PG8_BAR;
            PG8_LDA(At, 0, 1); PG8_STAGE(PG8_SA(0, 0), a2, voffA);
            PG8_BAR; PG8_WAIT_L(0); PG8_MMA(1, 0, At, B0); PG8_BAR; PG8_SCHED;
            PG8_STAGE(PG8_SB(0, 1), b2 + hstep, voffB);
            PG8_WAIT_V(6); PG8_BAR; PG8_MMA(1, 1, At, B1); PG8_BAR;
            PG8_LDB(B0, 1, 0); PG8_SCHED; PG8_LDA(At, 1, 0); PG8_STAGE(PG8_SA(0, 1), a2 + hstep, voffA);
            PG8_WAIT_L(8); PG8_BAR; PG8_WAIT_L(0); PG8_MMA(0, 0, At, B0); PG8_BAR; PG8_SCHED;
            PG8_LDB(B1, 1, 1); PG8_STAGE(PG8_SB(1, 0), b3, voffB);
            PG8_BAR; PG8_WAIT_L(0); PG8_MMA(0, 1, At, B1); PG8_BAR;
            PG8_LDA(At, 1, 1); PG8_STAGE(PG8_SA(1, 0), a3, voffA);
            PG8_BAR; PG8_WAIT_L(0); PG8_MMA(1, 0, At, B0); PG8_BAR; PG8_SCHED;
            PG8_STAGE(PG8_SB(1, 1), b3 + hstep, voffB);
            PG8_WAIT_V(6); PG8_BAR; PG8_MMA(1, 1, At, B1); PG8_BAR;
            }
        }
        if constexpr (ALIGN_EPI) { if (wr == 0) PG8_BAR; }
        if constexpr (!Epi::AFTER_DRAIN) { E(acc, cur, wr, wc, fr, fq); S.done(cur); }
        if (!has_next) break;
#pragma unroll
        for (int a = 0; a < 2; ++a)
#pragma unroll
            for (int b = 0; b < 2; ++b)
#pragma unroll
                for (int m = 0; m < 4; ++m)
#pragma unroll
                    for (int n = 0; n < 2; ++n) acc[a][b][m][n] = (f32x4){0.f, 0.f, 0.f, 0.f};
        cur = nxt; cA = nA; cB = nB; ++ui;
        if constexpr (ALIGN_EPI) { if (wr == 1) PG8_BAR; }
    }
    PG8_WAIT_V(0);
    if constexpr (!ALIGN_EPI) { if (wr == 0) PG8_BAR; }
    PG8_BAR;
    if constexpr (Epi::AFTER_DRAIN) { E.fused(acc, cur, wr, wc, fr, fq, lds, wid, lane); S.done(cur); }
#undef PG8_SA
#undef PG8_SB
#undef PG8_STAGE
#undef PG8_LDA
#undef PG8_LDB
#undef PG8_MMA
#undef PG8_WAIT_V
#undef PG8_WAIT_L
#undef PG8_BAR
#undef PG8_SCHED
}
}
#define GAS __attribute__((address_space(1)))
#define LAS __attribute__((address_space(3)))
typedef unsigned short bf16;
typedef unsigned v4u __attribute__((ext_vector_type(4)));
typedef float f32x4 __attribute__((ext_vector_type(4)));
typedef short bf16x8 __attribute__((ext_vector_type(8)));
typedef GAS unsigned gu32;
typedef GAS unsigned long long gu64;
#define RLX_AGENT __ATOMIC_RELAXED, __HIP_MEMORY_SCOPE_AGENT
#define LDS_WAIT() asm volatile("s_waitcnt lgkmcnt(0)" ::: "memory")
#define VM_WAIT() asm volatile("s_waitcnt vmcnt(0)" ::: "memory")
__device__ __forceinline__ unsigned long long rt() { return __builtin_amdgcn_s_memrealtime(); }
__device__ __forceinline__ unsigned f2bf(float f) { unsigned u = __builtin_bit_cast(unsigned, f); return (u + 0x7fffu + ((u >> 16) & 1u)) >> 16; }
__device__ __forceinline__ unsigned pk2(float lo, float hi) { return f2bf(lo) | (f2bf(hi) << 16); }

#define XB_TMO      128
#define XB_XCNT(j)  (256  + 64 * (j))
#define XB_XSUB(j)  (1280 + 64 * (j))
#define XB_XGEN(j)  (2304 + 64 * (j))
#define XB_TOP      3328
#define XB_TOPGEN   3392
#define XCD_BAR_WORDS 3456
#define XB_SPIN_CAP (1u << 18)

__device__ __forceinline__ unsigned xb_ld(unsigned* p)              { return __hip_atomic_load(p, __ATOMIC_RELAXED, __HIP_MEMORY_SCOPE_AGENT); }
__device__ __forceinline__ unsigned xb_add(unsigned* p, unsigned v) { return __hip_atomic_fetch_add(p, v, __ATOMIC_RELAXED, __HIP_MEMORY_SCOPE_AGENT); }
__device__ __forceinline__ unsigned xb_xcc_id() { return (unsigned)__builtin_amdgcn_s_getreg((3 << 11) | 20) & 0xFu; }
#define XB_SPIN(cond, bar) do { unsigned _sp = 0; while (cond) { __builtin_amdgcn_s_sleep(1); \
    if ((++_sp & 255u) == 0u) { if (xb_ld(&(bar)[XB_TMO])) break; if (_sp > XB_SPIN_CAP) { atomicAdd(&(bar)[XB_TMO], 1u); break; } } } } while (0)

struct XcdBarrier {
    unsigned* bar; unsigned x;
    volatile LAS unsigned* st;
};

__device__ __forceinline__ XcdBarrier xcd_barrier_post(unsigned* bar, volatile LAS unsigned* st) {
    XcdBarrier b; b.bar = bar; b.x = xb_xcc_id(); b.st = st;
    if (threadIdx.x == 0) (void)xb_add(&bar[XB_XCNT(b.x)], 1u);
    return b;
}
__device__ __forceinline__ void xcd_barrier_complete(unsigned* bar, unsigned x, unsigned& nloc, unsigned& nx) {
    const unsigned G = gridDim.x * gridDim.y * gridDim.z;
    unsigned sum, cnt, mine, sp = 0u;
    for (;;) {
        sum = 0u; cnt = 0u; mine = 0u;
#pragma unroll
        for (unsigned j = 0; j < 16; ++j) { const unsigned c = xb_ld(&bar[XB_XCNT(j)]); sum += c; cnt += (c > 0u) ? 1u : 0u; mine = (j == x) ? c : mine; }
        if (sum == G) break;
        __builtin_amdgcn_s_sleep(1);
        if ((++sp & 255u) == 0u) { if (xb_ld(&bar[XB_TMO])) break; if (sp > XB_SPIN_CAP) { atomicAdd(&bar[XB_TMO], 1u); break; } }
    }
    nloc = mine > 0u ? mine : 1u; nx = cnt > 0u ? cnt : 1u;
}

__device__ __forceinline__ void xcd_barrier(const XcdBarrier& b) {
    asm volatile("s_waitcnt vmcnt(0)" ::: "memory");
    __syncthreads();
    if (threadIdx.x == 0) {
        unsigned* bar = b.bar;
        __builtin_amdgcn_s_waitcnt(0);
        unsigned nloc = b.st[0], nx = b.st[1];
        if (nloc == 0u) { xcd_barrier_complete(bar, b.x, nloc, nx); b.st[0] = nloc; b.st[1] = nx; }
        const unsigned old = xb_add(&bar[XB_XSUB(b.x)], 1u);
        const unsigned gen = old / nloc;
        if (old + 1u == (gen + 1u) * nloc) {
            __builtin_amdgcn_fence(__ATOMIC_RELEASE, "agent");
            asm volatile("s_waitcnt vmcnt(0)" ::: "memory");
            const unsigned og = xb_add(&bar[XB_TOP], 1u);
            const unsigned tg = og / nx;
            if (og + 1u == (tg + 1u) * nx) xb_add(&bar[XB_TOPGEN], 1u);
            else XB_SPIN(xb_ld(&bar[XB_TOPGEN]) == tg, bar);
            __builtin_amdgcn_fence(__ATOMIC_ACQUIRE, "agent");
            xb_add(&bar[XB_XGEN(b.x)], 1u);
            asm volatile("s_waitcnt vmcnt(0)" ::: "memory");
        } else {
            XB_SPIN(xb_ld(&bar[XB_XGEN(b.x)]) == gen, bar);
            __builtin_amdgcn_fence(__ATOMIC_ACQUIRE, "agent");
            asm volatile("s_waitcnt vmcnt(0)" ::: "memory");
        }
    }
    __syncthreads();
}
typedef unsigned u32x2v __attribute__((ext_vector_type(2)));
typedef float f32x2v __attribute__((ext_vector_type(2)));

constexpr int MP = 16384, MROWS = 16640, DMODEL = 1024, DFF = 2816, NBLK64 = MROWS / 64;
constexpr float RMS_EPS = 1e-6f;
constexpr size_t OFF_Y = 0, OFF_WKP = (size_t)MROWS * 1024, OFF_WVP = OFF_WKP + 65536, OFF_SRP = OFF_WVP + 65536, OFF_SIP = OFF_SRP + 8192,
    OFF_CMP = OFF_SIP + 8192, OFF_CFP = OFF_CMP + 8192, OFF_MKP = OFF_CFP + 45056, OFF_MVP = OFF_MKP + 2097152, OFF_WKS = OFF_MVP + 2097152,
    OFF_WVS = OFF_WKS + 32768, OFF_SRS = OFF_WVS + 32768, OFF_SIS = OFF_SRS + 16384, OFF_CMS = OFF_SIS + 16384, OFF_CFS = OFF_CMS + 16384;
constexpr size_t MiB = 1u << 20;
constexpr size_t WS_ROWSS = 0, WS_BAR = 512 * 1024, CTL_ZERO_BYTES = 1 * MiB;
constexpr size_t WS_ROPE = 1 * MiB, WS_SSM = 2 * MiB, WS_CKV = 3 * MiB, WS_SLOC = 4 * MiB, WS_MEMK = 8 * MiB, WS_MEMVT = 20 * MiB, WS_SIDE = 32 * MiB;
constexpr size_t SG_BYTES = (size_t)NBLK64 * 8 * DFF * 4, SV_BYTES = (size_t)NBLK64 * 4 * DFF * 4;
static_assert(WS_SIDE + SG_BYTES + SV_BYTES <= 66 * MiB, "side buffers");
constexpr size_t WS_WT = 66 * MiB, WS_XB = 128 * MiB, WS_TMP = 161 * MiB;
constexpr size_t WT_INEVEN = 0, WT_GLU = WT_INEVEN + 1280 * 1024, WT_OUTEVEN = WT_GLU + 512 * 512, WT_WQ = WT_OUTEVEN + 1024 * 1024, WT_WKV = WT_WQ + 2 * 1024 * 1024,
    WT_WO = WT_WKV + 2 * 2048 * 1024, WT_UP = WT_WO + 2 * 1024 * 1024, WT_DOWN = WT_UP + (size_t)2 * 5632 * 1024, WT_INODD = WT_DOWN + (size_t)2 * 2816 * 1024,
    WT_OUTODD = WT_INODD + 3072 * 1024, WT_END = WT_OUTODD + 1024 * 1024;
static_assert(WS_WT + WT_END * 2 <= WS_XB, "weights");
static_assert(WS_XB + (size_t)MROWS * 1024 * 2 <= WS_TMP, "xb");
constexpr size_t TMP_BYTES = (size_t)MROWS * DFF * 2;
constexpr size_t WS_PART = 251 * MiB, PART_ELEMS = (size_t)MROWS * 16;
static_assert(WS_PART + 2 * PART_ELEMS * 4 <= 256 * MiB, "part");
static_assert(WS_TMP + TMP_BYTES <= 256 * MiB, "ws");
constexpr size_t TMP_PROJ0 = 0, TMP_GBUF = (size_t)MROWS * 1280 * 2, TMP_YCAT = TMP_GBUF + (size_t)MROWS * 512 * 2, TMP_MEMB = TMP_YCAT;
static_assert(TMP_YCAT + (size_t)MROWS * 1024 * 2 <= TMP_BYTES, "tmp");
constexpr size_t TMP_QX = 0, TMP_OX = (size_t)MROWS * 1024 * 2, TMP_ACT = 0, TMP_GB = 0, TMP_ZC = (size_t)MROWS * 1024 * 2;
constexpr int LDS_BYTES = 147456, MISC_OFF = 147456 - 512;
constexpr int NPH = 22;

#define MFMA16(a, b, c) __builtin_amdgcn_mfma_f32_16x16x32_bf16(a, b, c, 0, 0, 0)
__device__ __forceinline__ float bflo(unsigned w) { return __uint_as_float(w << 16); }
__device__ __forceinline__ float bfhi(unsigned w) { return __uint_as_float(w & 0xffff0000u); }
__device__ __forceinline__ v4u pack8(f32x4 a, f32x4 b) { v4u w; w.x = pg8::cvt_pk_bf16(a[0], a[1]); w.y = pg8::cvt_pk_bf16(a[2], a[3]); w.z = pg8::cvt_pk_bf16(b[0], b[1]); w.w = pg8::cvt_pk_bf16(b[2], b[3]); return w; }
__device__ __forceinline__ float rstd_of(const float* part, int row) { const f32x4* p = (const f32x4*)(part + (size_t)row * 16); const f32x4 a = p[0] + p[1] + p[2] + p[3]; return rsqrtf(((a[0] + a[1]) + (a[2] + a[3])) * (1.0f / 1024.0f) + RMS_EPS); }
__device__ __forceinline__ float sigmoidf_(float x) { return 1.0f / (1.0f + __expf(-x)); }
__device__ __forceinline__ float dpp_ror1(float v) { return __builtin_bit_cast(float, __builtin_amdgcn_update_dpp(0, __builtin_bit_cast(int, v), 0x121, 0xf, 0xf, false)); }
__device__ __forceinline__ float dpp_ror2(float v) { return __builtin_bit_cast(float, __builtin_amdgcn_update_dpp(0, __builtin_bit_cast(int, v), 0x122, 0xf, 0xf, false)); }
__device__ __forceinline__ float wave_sum(float v) {
#pragma unroll
    for (int o = 1; o < 64; o <<= 1) v += __shfl_xor(v, o);
    return v;
}

typedef pg8::Unit Unit;
#define EPI_ARGS const f32x4 (&acc)[2][2][4][2], const Unit& u, int wr, int wc, int fr, int fq

struct EpiBf16 {
    static constexpr bool PERM = true, AFTER_DRAIN = false;
    bf16* O; int ldc; const float* rowss;
    __device__ __forceinline__ void operator()(EPI_ARGS) const {
        const int row0 = u.pm * 256 + wr * 64 + fr, col0 = u.pn * 256 + wc * 32 + 8 * fq;
#pragma unroll
        for (int ai = 0; ai < 2; ++ai)
#pragma unroll
            for (int m = 0; m < 4; ++m) { const int row = row0 + ai * 128 + m * 16; const float rs = rstd_of(rowss, row); bf16* rp = O + (size_t)row * ldc + col0;
#pragma unroll
                for (int bj = 0; bj < 2; ++bj) *(v4u*)(rp + bj * 128) = pack8(acc[ai][bj][m][0] * rs, acc[ai][bj][m][1] * rs); }
    }
};
struct EpiRes {
    static constexpr bool PERM = true, AFTER_DRAIN = false;
    const float* base_p; const float* base_s; bf16* xb; float* rowss_next; int f32base;
    __device__ __forceinline__ void operator()(EPI_ARGS) const {
        const float* base = u.pm < 64 ? base_p : base_s;
        const int row0 = u.pm * 256 + wr * 64 + fr, col0 = u.pn * 256 + wc * 32 + 8 * fq;
#pragma unroll
        for (int ai = 0; ai < 2; ++ai)
#pragma unroll
            for (int m = 0; m < 4; ++m) { const int row = row0 + ai * 128 + m * 16; const size_t off = (size_t)row * 1024 + col0; float ss = 0.f;
#pragma unroll
                for (int bj = 0; bj < 2; ++bj) { f32x4 b0, b1;
                    if (f32base) { b0 = *(const f32x4*)(base + off + bj * 128); b1 = *(const f32x4*)(base + off + bj * 128 + 4); }
                    else { const v4u w = *(const v4u*)(xb + off + bj * 128); b0 = (f32x4){bflo(w.x), bfhi(w.x), bflo(w.y), bfhi(w.y)}; b1 = (f32x4){bflo(w.z), bfhi(w.z), bflo(w.w), bfhi(w.w)}; }
                    const f32x4 v0 = acc[ai][bj][m][0] + b0, v1 = acc[ai][bj][m][1] + b1;
                    *(v4u*)(xb + off + bj * 128) = pack8(v0, v1);
                    ss += (v0[0] * v0[0] + v0[1] * v0[1]) + (v0[2] * v0[2] + v0[3] * v0[3]) + (v1[0] * v1[0] + v1[1] * v1[1]) + (v1[2] * v1[2] + v1[3] * v1[3]); }
                ss += __shfl_xor(ss, 16); ss += __shfl_xor(ss, 32);
                if (fq == 0) rowss_next[(size_t)row * 16 + u.pn * 4 + wc] = ss; }
    }
};
struct EpiGlu {
    static constexpr bool PERM = true, AFTER_DRAIN = false;
    const bf16* g; bf16* ycat;
    __device__ __forceinline__ void operator()(EPI_ARGS) const {
        const int row0 = u.pm * 256 + wr * 64 + fr, col0 = u.pn * 256 + wc * 32 + 8 * fq;
#pragma unroll
        for (int ai = 0; ai < 2; ++ai)
#pragma unroll
            for (int m = 0; m < 4; ++m) { const int row = row0 + ai * 128 + m * 16;
#pragma unroll
                for (int bj = 0; bj < 2; ++bj) { const int col = col0 + bj * 128; const v4u gw = *(const v4u*)(g + (size_t)row * 512 + col);
                    const f32x4 a0 = acc[ai][bj][m][0], a1 = acc[ai][bj][m][1]; f32x4 o0, o1;
                    o0[0] = bflo(gw.x) * sigmoidf_(a0[0]); o0[1] = bfhi(gw.x) * sigmoidf_(a0[1]); o0[2] = bflo(gw.y) * sigmoidf_(a0[2]); o0[3] = bfhi(gw.y) * sigmoidf_(a0[3]);
                    o1[0] = bflo(gw.z) * sigmoidf_(a1[0]); o1[1] = bfhi(gw.z) * sigmoidf_(a1[1]); o1[2] = bflo(gw.w) * sigmoidf_(a1[2]); o1[3] = bfhi(gw.w) * sigmoidf_(a1[3]);
                    *(v4u*)(ycat + (size_t)row * 1024 + col) = pack8(o0, o1); } }
    }
};
struct EpiKV {
    static constexpr bool PERM = true, AFTER_DRAIN = false;
    float* out; bf16* memk;
    __device__ __forceinline__ void operator()(EPI_ARGS) const {
        const int row0 = u.pm * 256 + wr * 64 + fr, col0 = u.pn * 256 + wc * 32 + 8 * fq;
#pragma unroll
        for (int ai = 0; ai < 2; ++ai)
#pragma unroll
            for (int m = 0; m < 4; ++m) { const int row = row0 + ai * 128 + m * 16;
#pragma unroll
                for (int bj = 0; bj < 2; ++bj) { const int c = col0 + bj * 128, l = c >> 11, e = c & 2047, isv = e >> 10, dc = e & 1023;
                    float* op = out + (isv ? OFF_MVP : OFF_MKP) + (size_t)l * 1048576 + (size_t)row * 1024 + dc;
                    *(f32x4*)op = acc[ai][bj][m][0]; *(f32x4*)(op + 4) = acc[ai][bj][m][1];
                    if (!isv) *(v4u*)(memk + (size_t)l * 12 * 262144 + (size_t)row * 1024 + dc) = pack8(acc[ai][bj][m][0], acc[ai][bj][m][1]); } }
    }
};
struct EpiIn0 {
    static constexpr bool PERM = true, AFTER_DRAIN = false;
    bf16* proj; const float* rowss; const float* ropec; const float* ropes; float* out;
    __device__ __forceinline__ void operator()(EPI_ARGS) const {
        const int pn = u.pn;
#pragma unroll
        for (int ai = 0; ai < 2; ++ai)
#pragma unroll
            for (int m = 0; m < 4; ++m) { const int row = u.pm * 256 + ai * 128 + wr * 64 + m * 16 + fr; const float rs = rstd_of(rowss, row);
                const int pos = row < MP ? (row & 4095) : 2048 + (row & 31);
                bf16* rp = proj + (size_t)row * 1280;
                float* wk = nullptr; float* wv = nullptr;
                if (pn == 4) { if (row >= MP) { wk = out + OFF_WKS + (size_t)(row - MP) * 128; wv = out + OFF_WVS + (size_t)(row - MP) * 128; }
                               else if ((row & 4095) >= 3968) { const size_t o = (size_t)((row >> 12) * 128 + (row & 4095) - 3968) * 128; wk = out + OFF_WKP + o; wv = out + OFF_WVP + o; } }
#pragma unroll
                for (int bj = 0; bj < 2; ++bj) { const f32x4 v0 = acc[ai][bj][m][0] * rs, v1 = acc[ai][bj][m][1] * rs;
                    const bool rope = (pn == 2 || pn == 3 || (pn == 4 && bj == 0));
                    if (!rope) { const int col = pn * 256 + bj * 128 + wc * 32 + 8 * fq; *(v4u*)(rp + col) = pack8(v0, v1);
                        if (pn == 4 && wv) { *(f32x4*)(wv + wc * 32 + 8 * fq) = v0; *(f32x4*)(wv + wc * 32 + 8 * fq + 4) = v1; } }
                    else { const int gbase = pn * 256 + bj * 128 + (wc >> 1) * 64, d1 = 16 * (wc & 1) + 4 * fq;
                        const f32x4 c4 = *(const f32x4*)(ropec + pos * 32 + d1), s4 = *(const f32x4*)(ropes + pos * 32 + d1);
                        f32x4 o1 = v0 * c4 - v1 * s4, o2 = v1 * c4 + v0 * s4;
                        if (pn != 4) { o1 = o1 * 0.125f; o2 = o2 * 0.125f; }
                        u32x2v w1, w2; w1.x = pg8::cvt_pk_bf16(o1[0], o1[1]); w1.y = pg8::cvt_pk_bf16(o1[2], o1[3]); w2.x = pg8::cvt_pk_bf16(o2[0], o2[1]); w2.y = pg8::cvt_pk_bf16(o2[2], o2[3]);
                        *(u32x2v*)(rp + gbase + d1) = w1; *(u32x2v*)(rp + gbase + d1 + 32) = w2;
                        if (pn == 4 && wk) { const int cc = (wc >> 1) * 64 + d1; *(f32x4*)(wk + cc) = o1; *(f32x4*)(wk + cc + 32) = o2; } } } }
    }
};
struct EpiFfnUp {
    static constexpr bool PERM = true, AFTER_DRAIN = false;
    bf16* act; const float* rowss; const float* cw; float* SG; float* SV;
    __device__ __forceinline__ void operator()(EPI_ARGS) const {
        const int c0 = u.pn * 128 + wc * 32 + 8 * fq; const bool sample = u.pm == 64;
        const f32x4 w0a = *(const f32x4*)(cw + c0), w0b = *(const f32x4*)(cw + c0 + 4), w1a = *(const f32x4*)(cw + DFF + c0), w1b = *(const f32x4*)(cw + DFF + c0 + 4),
                    w2a = *(const f32x4*)(cw + 2 * DFF + c0), w2b = *(const f32x4*)(cw + 2 * DFF + c0 + 4);
#pragma unroll
        for (int ai = 0; ai < 2; ++ai) { f32x4 gp0 = {0.f, 0.f, 0.f, 0.f}, gp1 = {0.f, 0.f, 0.f, 0.f}; const int blk = u.pm * 4 + ai * 2 + wr;
#pragma unroll
            for (int m = 0; m < 4; ++m) { const int row = u.pm * 256 + ai * 128 + wr * 64 + m * 16 + fr; const float rs = rstd_of(rowss, row);
                const f32x4 g0 = acc[ai][0][m][0] * rs, g1 = acc[ai][0][m][1] * rs, v0 = acc[ai][1][m][0] * rs, v1 = acc[ai][1][m][1] * rs;
                f32x4 p1a, p2a, p1b, p2b;
#pragma unroll
                for (int j = 0; j < 4; ++j) { const float s1a = fr == 15 ? gp0[j] : g0[j], s2a = fr >= 14 ? gp0[j] : g0[j], s1b = fr == 15 ? gp1[j] : g1[j], s2b = fr >= 14 ? gp1[j] : g1[j];
                    p1a[j] = dpp_ror1(s1a); p2a[j] = dpp_ror2(s2a); p1b[j] = dpp_ror1(s1b); p2b[j] = dpp_ror2(s2b); }
                const f32x4 ca = w0a * p2a + w1a * p1a + w2a * g0, cb = w0b * p2b + w1b * p1b + w2b * g1;
                f32x4 sa, sb;
#pragma unroll
                for (int j = 0; j < 4; ++j) { sa[j] = sigmoidf_(ca[j]); sb[j] = sigmoidf_(cb[j]); }
                const f32x4 a0 = ca * sa * v0, a1 = cb * sb * v1;
                const bool valid = (m > 0 || fr >= 2) && !(sample && m == 2 && fr < 2);
                if (valid) *(v4u*)(act + (size_t)row * DFF + c0) = pack8(a0, a1);
                if ((m & 1) == 0 && fr < 2) { float* sg = SG + (size_t)(blk * 8 + 2 * m + fr) * DFF + c0; *(f32x4*)sg = g0; *(f32x4*)(sg + 4) = g1;
                                              float* sv = SV + (size_t)(blk * 4 + m + fr) * DFF + c0; *(f32x4*)sv = v0; *(f32x4*)(sv + 4) = v1; }
                if ((m & 1) == 1 && fr >= 14) { float* sg = SG + (size_t)(blk * 8 + 2 * m + fr - 14) * DFF + c0; *(f32x4*)sg = g0; *(f32x4*)(sg + 4) = g1; }
                gp0 = g0; gp1 = g1; } }
    }
};
struct EpiInOdd {
    static constexpr bool PERM = true, AFTER_DRAIN = false;
    bf16* gb; bf16* zc; const float* rowss; const float* cw; float* SG;
    __device__ __forceinline__ void operator()(EPI_ARGS) const {
        if (u.pn < 4) {
            const int row0 = u.pm * 256 + wr * 64 + fr, col0 = u.pn * 256 + wc * 32 + 8 * fq;
#pragma unroll
            for (int ai = 0; ai < 2; ++ai)
#pragma unroll
                for (int m = 0; m < 4; ++m) { const int row = row0 + ai * 128 + m * 16; const float rs = rstd_of(rowss, row); bf16* rp = gb + (size_t)row * 1024 + col0;
#pragma unroll
                    for (int bj = 0; bj < 2; ++bj) *(v4u*)(rp + bj * 128) = pack8(acc[ai][bj][m][0] * rs, acc[ai][bj][m][1] * rs); }
            return;
        }
        const int c0 = (u.pn - 4) * 128 + wc * 32 + 8 * fq; const bool sample = u.pm == 64;
        const f32x4 w0a = *(const f32x4*)(cw + c0), w0b = *(const f32x4*)(cw + c0 + 4), w1a = *(const f32x4*)(cw + 1024 + c0), w1b = *(const f32x4*)(cw + 1024 + c0 + 4),
                    w2a = *(const f32x4*)(cw + 2048 + c0), w2b = *(const f32x4*)(cw + 2048 + c0 + 4);
#pragma unroll
        for (int ai = 0; ai < 2; ++ai) { f32x4 gp0 = {0.f, 0.f, 0.f, 0.f}, gp1 = {0.f, 0.f, 0.f, 0.f}; const int blk = u.pm * 4 + ai * 2 + wr;
#pragma unroll
            for (int m = 0; m < 4; ++m) { const int row = u.pm * 256 + ai * 128 + wr * 64 + m * 16 + fr; const float rs = rstd_of(rowss, row); const float rs2 = rs * rs;
                const f32x4 g0 = acc[ai][0][m][0] * acc[ai][1][m][0] * rs2, g1 = acc[ai][0][m][1] * acc[ai][1][m][1] * rs2;
                f32x4 p1a, p2a, p1b, p2b;
#pragma unroll
                for (int j = 0; j < 4; ++j) { const float s1a = fr == 15 ? gp0[j] : g0[j], s2a = fr >= 14 ? gp0[j] : g0[j], s1b = fr == 15 ? gp1[j] : g1[j], s2b = fr >= 14 ? gp1[j] : g1[j];
                    p1a[j] = dpp_ror1(s1a); p2a[j] = dpp_ror2(s2a); p1b[j] = dpp_ror1(s1b); p2b[j] = dpp_ror2(s2b); }
                const f32x4 a0 = w0a * p2a + w1a * p1a + w2a * g0, a1 = w0b * p2b + w1b * p1b + w2b * g1;
                const bool valid = (m > 0 || fr >= 2) && !(sample && m == 2 && fr < 2);
                if (valid) *(v4u*)(zc + (size_t)row * 1024 + c0) = pack8(a0, a1);
                if ((m & 1) == 0 && fr < 2) { float* sg = SG + (size_t)(blk * 8 + 2 * m + fr) * 1024 + c0; *(f32x4*)sg = g0; *(f32x4*)(sg + 4) = g1; }
                if ((m & 1) == 1 && fr >= 14) { float* sg = SG + (size_t)(blk * 8 + 2 * m + fr - 14) * 1024 + c0; *(f32x4*)sg = g0; *(f32x4*)(sg + 4) = g1; }
                gp0 = g0; gp1 = g1; } }
    }
};


struct EpiCz {
    static constexpr bool PERM = true, AFTER_DRAIN = false;
    bf16* gb; const float* rowss; const float* cw; float* SG;
    __device__ __forceinline__ void operator()(EPI_ARGS) const {
        const int c0 = u.pn * 128 + wc * 32 + 8 * fq;
        const f32x4 w0a = *(const f32x4*)(cw + c0), w0b = *(const f32x4*)(cw + c0 + 4), w1a = *(const f32x4*)(cw + 1024 + c0), w1b = *(const f32x4*)(cw + 1024 + c0 + 4),
                    w2a = *(const f32x4*)(cw + 2048 + c0), w2b = *(const f32x4*)(cw + 2048 + c0 + 4);
#pragma unroll
        for (int ai = 0; ai < 2; ++ai) { f32x4 gp0 = {0.f, 0.f, 0.f, 0.f}, gp1 = {0.f, 0.f, 0.f, 0.f}; const int blk = u.pm * 4 + ai * 2 + wr;
#pragma unroll
            for (int m = 0; m < 4; ++m) { const int row = u.pm * 256 + ai * 128 + wr * 64 + m * 16 + fr; const float rs = rstd_of(rowss, row); const float rs2 = rs * rs;
                const f32x4 g0 = acc[ai][0][m][0] * acc[ai][1][m][0] * rs2, g1 = acc[ai][0][m][1] * acc[ai][1][m][1] * rs2;
                f32x4 p1a, p2a, p1b, p2b;
#pragma unroll
                for (int j = 0; j < 4; ++j) { const float s1a = fr == 15 ? gp0[j] : g0[j], s2a = fr >= 14 ? gp0[j] : g0[j], s1b = fr == 15 ? gp1[j] : g1[j], s2b = fr >= 14 ? gp1[j] : g1[j];
                    p1a[j] = dpp_ror1(s1a); p2a[j] = dpp_ror2(s2a); p1b[j] = dpp_ror1(s1b); p2b[j] = dpp_ror2(s2b); }
                const f32x4 a0 = w0a * p2a + w1a * p1a + w2a * g0, a1 = w0b * p2b + w1b * p1b + w2b * g1;
                if (m > 0 || fr >= 2) { bf16* gp = gb + (size_t)row * 1024 + c0; const v4u gw = *(const v4u*)gp;
                    const f32x4 b0 = (f32x4){bflo(gw.x), bfhi(gw.x), bflo(gw.y), bfhi(gw.y)}, b1 = (f32x4){bflo(gw.z), bfhi(gw.z), bflo(gw.w), bfhi(gw.w)};
                    *(v4u*)gp = pack8(a0 * b0, a1 * b1); }
                if ((m & 1) == 0 && fr < 2) { float* sg = SG + (size_t)(blk * 8 + 2 * m + fr) * 1024 + c0; *(f32x4*)sg = g0; *(f32x4*)(sg + 4) = g1; }
                if ((m & 1) == 1 && fr >= 14) { float* sg = SG + (size_t)(blk * 8 + 2 * m + fr - 14) * 1024 + c0; *(f32x4*)sg = g0; *(f32x4*)(sg + 4) = g1; }
                gp0 = g0; gp1 = g1; } }
    }
};

__device__ __forceinline__ int rowmap(int mode, int n) {
    if (mode == 1) { if (n >= 512 && n < 1152) { const int d = n & 63; return (n & ~63) | (32 * ((d >> 4) & 1) + 8 * ((d >> 2) & 3) + 4 * (d >> 5) + (d & 3)); } return n; }
    if (mode == 2) { return n < DFF ? ((n >> 7) * 256 + (n & 127)) : (((n - DFF) >> 7) * 256 + 128 + ((n - DFF) & 127)); }
    if (mode == 3) { if (n < 1024) return n; const int c = (n - 1024) & 1023, z = n >= 2048 ? 1 : 0; return 1024 + (c >> 7) * 256 + z * 128 + (c & 127); }
    return n;
}
__device__ __forceinline__ void tr_item(const float* W, int K, int N, bf16* WT, const float* gain, float scale, int mode, LAS float* scr, int item, int lane) {
    const int nblk = N / 32, kb = item / nblk, nb = item % nblk, k0 = 64 * kb, n0 = 32 * nb;
#pragma unroll
    for (int i = 0; i < 8; ++i) { const int idx = lane + 64 * i, kk = idx >> 3, n4 = (idx & 7) * 4; const float gs = gain ? ((const GAS float*)gain)[k0 + kk] * scale : scale;
        const f32x4 w = *(const GAS f32x4*)((const GAS float*)W + (size_t)(k0 + kk) * N + n0 + n4); LAS float* d = scr + kk * 33 + n4; d[0] = w[0] * gs; d[1] = w[1] * gs; d[2] = w[2] * gs; d[3] = w[3] * gs; }
    LDS_WAIT(); asm volatile("" ::: "memory");
    const int c = lane & 7;
#pragma unroll
    for (int j = 0; j < 4; ++j) { const int n = (lane >> 3) + 8 * j; const LAS float* s = scr + (8 * c) * 33 + n;
        v4u o; o.x = pg8::cvt_pk_bf16(s[0 * 33], s[1 * 33]); o.y = pg8::cvt_pk_bf16(s[2 * 33], s[3 * 33]); o.z = pg8::cvt_pk_bf16(s[4 * 33], s[5 * 33]); o.w = pg8::cvt_pk_bf16(s[6 * 33], s[7 * 33]);
        *(GAS v4u*)((GAS bf16*)WT + (size_t)rowmap(mode, n0 + n) * K + k0 + 8 * c) = o; }
    LDS_WAIT(); asm volatile("" ::: "memory");
}
__device__ __forceinline__ double dexp_(double y) {
    const double k = rint(y * 1.4426950408889634); const double r = (y - k * 0.6931471803691238) - k * 1.9082149292705877e-10;
    double p = 1.0 / 6227020800.0;
    p = p * r + 1.0 / 479001600.0; p = p * r + 1.0 / 39916800.0; p = p * r + 1.0 / 3628800.0; p = p * r + 1.0 / 362880.0; p = p * r + 1.0 / 40320.0; p = p * r + 1.0 / 5040.0;
    p = p * r + 1.0 / 720.0; p = p * r + 1.0 / 120.0; p = p * r + 1.0 / 24.0; p = p * r + 1.0 / 6.0; p = p * r + 0.5; p = p * r + 1.0; p = p * r + 1.0;
    const long long bits = (long long)(1023 + (int)k) << 52; return p * __builtin_bit_cast(double, bits);
}
__device__ __forceinline__ void dsincos_(double x, double& s, double& c) {
    const double k = rint(x * 0.6366197723675814); const double r = (x - k * 1.5707963267948966) - k * 6.123233995736766e-17; const double r2 = r * r;
    const double sp = r * (1.0 + r2 * (-1.0 / 6.0 + r2 * (1.0 / 120.0 + r2 * (-1.0 / 5040.0 + r2 * (1.0 / 362880.0 + r2 * (-1.0 / 39916800.0 + r2 * (1.0 / 6227020800.0)))))));
    const double cp = 1.0 + r2 * (-0.5 + r2 * (1.0 / 24.0 + r2 * (-1.0 / 720.0 + r2 * (1.0 / 40320.0 + r2 * (-1.0 / 3628800.0 + r2 * (1.0 / 479001600.0 + r2 * (-1.0 / 87178291200.0)))))));
    const int q = ((int)k) & 3;
    s = q == 0 ? sp : q == 1 ? cp : q == 2 ? -sp : -cp; c = q == 0 ? cp : q == 1 ? -sp : q == 2 ? -cp : sp;
}

__device__ __forceinline__ const bf16* kvptr(const bf16* proj, const bf16* cb, int sample, int b, int c, int kvh, int kk, int isv) {
    if (!sample) { int pos = (c - 2) * 64 + kk; pos = pos < 0 ? 0 : pos; return proj + (size_t)(b * 4096 + pos) * 1280 + 1024 + isv * 128 + kvh * 64; }
    if (kk < 128) return cb + (size_t)(b * 128 + kk) * 128 + kvh * 64;
    int t = kk - 128; t = t > 31 ? 31 : t; return proj + (size_t)(MP + b * 32 + t) * 1280 + 1024 + isv * 128 + kvh * 64;
}
__device__ __forceinline__ void swa_phase(const bf16* proj, const bf16* ckb, const bf16* cvb, const float* sinks, bf16* ycat, LAS unsigned char* lds, int tid, int wave, int lane, int G) {
    LAS bf16* VT = (LAS bf16*)lds;
    const int fr = lane & 15, quad = lane >> 4;
    for (int it = blockIdx.x; it < 528; it += G) {
        int b, c, kvh, sample;
        if (it < 512) { sample = 0; b = it >> 7; c = (it >> 1) & 63; kvh = it & 1; } else { sample = 1; b = (it - 512) >> 1; c = 0; kvh = it & 1; }
        const int gq = wave >> 1, qhalf = wave & 1, head = kvh * 4 + gq;
        bf16x8 qf[2][2], kf0[4][2];
#pragma unroll
        for (int qb = 0; qb < 2; ++qb) { const int q = qhalf * 32 + qb * 16 + fr; const int row = sample ? MP + b * 32 + (q & 31) : b * 4096 + c * 64 + q;
            const GAS bf16* qp = (const GAS bf16*)proj + (size_t)row * 1280 + 512 + head * 64 + quad * 8; qf[qb][0] = *(const GAS bf16x8*)qp; qf[qb][1] = *(const GAS bf16x8*)(qp + 32); }
#pragma unroll
        for (int i = 0; i < 4; ++i) { const int key = 32 * (i >> 1) + (fr >> 2) * 8 + 4 * (i & 1) + (fr & 3); const GAS bf16* kp = (const GAS bf16*)kvptr(proj, ckb, sample, b, c, kvh, key, 0) + quad * 8;
            kf0[i][0] = *(const GAS bf16x8*)kp; kf0[i][1] = *(const GAS bf16x8*)(kp + 32); }
        __syncthreads();
#pragma unroll
        for (int i = 0; i < 3; ++i) { const int idx = tid + 512 * i, kk = idx % 192, dg = idx / 192; const v4u w = *(const GAS v4u*)((const GAS bf16*)kvptr(proj, cvb, sample, b, c, kvh, kk, 1) + dg * 8);
            LAS bf16* vp = VT + (dg * 8) * 200 + kk;
            vp[0] = (bf16)(w.x & 0xffffu); vp[200] = (bf16)(w.x >> 16); vp[400] = (bf16)(w.y & 0xffffu); vp[600] = (bf16)(w.y >> 16);
            vp[800] = (bf16)(w.z & 0xffffu); vp[1000] = (bf16)(w.z >> 16); vp[1200] = (bf16)(w.w & 0xffffu); vp[1400] = (bf16)(w.w >> 16); }
        __syncthreads();
        if (!(sample && qhalf)) {
            const int plo = sample ? 0 : (c >= 2 ? 0 : (2 - c) * 2), phi = sample ? 5 : 6;
            f32x4 s[12][2];
#pragma unroll
            for (int kg = 0; kg < 3; ++kg) { bf16x8 kf[4][2];
#pragma unroll
                for (int i = 0; i < 4; ++i) { if (kg == 0) { kf[i][0] = kf0[i][0]; kf[i][1] = kf0[i][1]; continue; } const int kb = kg * 4 + i, key = 32 * (kb >> 1) + (fr >> 2) * 8 + 4 * (kb & 1) + (fr & 3); const GAS bf16* kp = (const GAS bf16*)kvptr(proj, ckb, sample, b, c, kvh, key, 0) + quad * 8;
                    kf[i][0] = *(const GAS bf16x8*)kp; kf[i][1] = *(const GAS bf16x8*)(kp + 32); }
                __builtin_amdgcn_sched_barrier(0);
#pragma unroll
                for (int i = 0; i < 4; ++i)
#pragma unroll
                    for (int qb = 0; qb < 2; ++qb) { f32x4 a = {0.f, 0.f, 0.f, 0.f}; a = MFMA16(kf[i][0], qf[qb][0], a); a = MFMA16(kf[i][1], qf[qb][1], a); s[kg * 4 + i][qb] = a; }
                __builtin_amdgcn_sched_barrier(0); }
            const float sink = sinks[head];
            bf16x8 pf[6][2];
#pragma unroll
            for (int qb = 0; qb < 2; ++qb) { float mx = sink;
#pragma unroll
                for (int kb = 0; kb < 12; ++kb) { const bool pv = (kb >> 1) >= plo && (kb >> 1) < phi;
#pragma unroll
                    for (int j = 0; j < 4; ++j) { const float v = pv ? s[kb][qb][j] : -1e30f; s[kb][qb][j] = v; mx = fmaxf(mx, v); } }
                mx = fmaxf(mx, __shfl_xor(mx, 16)); mx = fmaxf(mx, __shfl_xor(mx, 32));
                float sum = 0.f;
#pragma unroll
                for (int kb = 0; kb < 12; ++kb)
#pragma unroll
                    for (int j = 0; j < 4; ++j) { const float e = __expf(s[kb][qb][j] - mx); s[kb][qb][j] = e; sum += e; }
                sum += __shfl_xor(sum, 16); sum += __shfl_xor(sum, 32); sum += __expf(sink - mx);
                const float inv = 1.0f / sum;
#pragma unroll
                for (int pr = 0; pr < 6; ++pr) pf[pr][qb] = __builtin_bit_cast(bf16x8, pack8(s[2 * pr][qb] * inv, s[2 * pr + 1][qb] * inv)); }
#pragma unroll
            for (int db = 0; db < 4; ++db) { bf16x8 vf[6];
#pragma unroll
                for (int pr = 0; pr < 6; ++pr) vf[pr] = *(const LAS bf16x8*)(VT + (db * 16 + fr) * 200 + 32 * pr + quad * 8);
#pragma unroll
                for (int qb = 0; qb < 2; ++qb) { f32x4 o = {0.f, 0.f, 0.f, 0.f};
#pragma unroll
                    for (int pr = 0; pr < 6; ++pr) o = MFMA16(pf[pr][qb], vf[pr], o);
#pragma unroll
                    for (int j = 0; j < 4; ++j) { const int q = qhalf * 32 + qb * 16 + quad * 4 + j;
                        if (!sample || q < 32) { const int row = sample ? MP + b * 32 + q : b * 4096 + c * 64 + q; ycat[(size_t)row * 1024 + 512 + head * 64 + db * 16 + fr] = (bf16)f2bf(o[j]); } } } }
        }
    }
    __syncthreads();
}

__device__ __forceinline__ void xattn_phase(const bf16* qx, const bf16* memk_l, const bf16* memvT_l, bf16* ox, int wave, int lane, int G) {
    const int fr = lane & 15, quad = lane >> 4;
    for (int t = wave * G + (int)blockIdx.x; t < 4160; t += 8 * G) {
        int bb, h, row0;
        if (t < 4096) { const int pair = t >> 8; bb = pair >> 2; h = pair & 3; row0 = bb * 4096 + (t & 255) * 16; }
        else { const int s = t - 4096, b = s >> 3; h = (s >> 1) & 3; bb = 4 + b; row0 = MP + b * 32 + (s & 1) * 16; }
        bf16x8 qf[8];
#pragma unroll
        for (int ks = 0; ks < 8; ++ks) qf[ks] = *(const bf16x8*)(qx + (size_t)(row0 + fr) * 1024 + h * 256 + ks * 32 + quad * 8);
        const bf16* kbase = memk_l + (size_t)bb * 262144 + h * 256 + quad * 8;
        f32x4 s[16];
#pragma unroll
        for (int kb = 0; kb < 16; ++kb) { const int key = 32 * (kb >> 1) + (fr >> 2) * 8 + 4 * (kb & 1) + (fr & 3); const bf16* kp = kbase + (size_t)key * 1024; f32x4 a = {0.f, 0.f, 0.f, 0.f};
#pragma unroll
            for (int ks = 0; ks < 8; ++ks) a = MFMA16(*(const bf16x8*)(kp + ks * 32), qf[ks], a);
            s[kb] = a; }
        float mx = -1e30f;
#pragma unroll
        for (int kb = 0; kb < 16; ++kb)
#pragma unroll
            for (int j = 0; j < 4; ++j) mx = fmaxf(mx, s[kb][j]);
        mx = fmaxf(mx, __shfl_xor(mx, 16)); mx = fmaxf(mx, __shfl_xor(mx, 32));
        float sum = 0.f;
#pragma unroll
        for (int kb = 0; kb < 16; ++kb)
#pragma unroll
            for (int j = 0; j < 4; ++j) { const float e = __expf(s[kb][j] - mx); s[kb][j] = e; sum += e; }
        sum += __shfl_xor(sum, 16); sum += __shfl_xor(sum, 32);
        const float inv = 1.0f / sum;
        bf16x8 pf[8];
#pragma unroll
        for (int pr = 0; pr < 8; ++pr) pf[pr] = __builtin_bit_cast(bf16x8, pack8(s[2 * pr] * inv, s[2 * pr + 1] * inv));
        const bf16* vbase = memvT_l + (size_t)bb * 262144 + (size_t)(h * 256 + fr) * 256 + quad * 8;
#pragma unroll 4
        for (int db = 0; db < 16; ++db) { f32x4 o = {0.f, 0.f, 0.f, 0.f};
#pragma unroll
            for (int pr = 0; pr < 8; ++pr) o = MFMA16(pf[pr], *(const bf16x8*)(vbase + (size_t)db * 4096 + pr * 32), o);
#pragma unroll
            for (int j = 0; j < 4; ++j) ox[(size_t)(row0 + quad * 4 + j) * 1024 + h * 256 + db * 16 + fr] = (bf16)f2bf(o[j]); }
    }
}


__device__ __forceinline__ void xstage(const bf16* src, size_t rowstride, LAS unsigned char* lds, int tid) {
    v4u t[16];
#pragma unroll
    for (int i = 0; i < 16; ++i) { const int row = (tid >> 5) + 16 * i, ch = tid & 31; t[i] = *(const GAS v4u*)((const GAS bf16*)src + (size_t)row * rowstride + ch * 8); }
#pragma unroll
    for (int i = 0; i < 16; ++i) { const int row = (tid >> 5) + 16 * i, ch = tid & 31; *(LAS v4u*)(lds + row * 528 + ch * 16) = t[i]; }
}
__device__ __forceinline__ void xattn_phase2(const bf16* qx, const bf16* memk_l, const bf16* memvT_l, bf16* ox, LAS unsigned char* lds, int tid, int wave, int lane, int G) {
    const int fr = lane & 15, quad = lane >> 4;
    for (int it = blockIdx.x; it < 256 + 32; it += G) {
        int bb, h, rowbase, nqb; bool active;
        if (it < 256) { bb = it >> 6; h = (it >> 4) & 3; rowbase = bb * 4096 + (it & 15) * 256; nqb = 2; active = true; }
        else { const int s = it - 256, b = s >> 2; h = s & 3; bb = 4 + b; rowbase = MP + b * 32; nqb = 1; active = wave < 2; }
        __syncthreads();
        xstage(memk_l + (size_t)bb * 262144 + h * 256, 1024, lds, tid);
        __syncthreads();
        bf16x8 pf[2][8];
#pragma unroll
        for (int qi = 0; qi < 2; ++qi) {
            if (qi < nqb && active) {
                const int row0 = rowbase + qi * 128 + wave * 16;
                bf16x8 qf[8];
#pragma unroll
                for (int ks = 0; ks < 8; ++ks) qf[ks] = *(const GAS bf16x8*)((const GAS bf16*)qx + (size_t)(row0 + fr) * 1024 + h * 256 + ks * 32 + quad * 8);
                f32x4 s[16];
#pragma unroll
                for (int kb = 0; kb < 16; ++kb) { const int key = 32 * (kb >> 1) + (fr >> 2) * 8 + 4 * (kb & 1) + (fr & 3); const LAS unsigned char* kp = lds + key * 528 + quad * 16; f32x4 a = {0.f, 0.f, 0.f, 0.f};
#pragma unroll
                    for (int ks = 0; ks < 8; ++ks) a = MFMA16(*(const LAS bf16x8*)(kp + ks * 64), qf[ks], a);
                    s[kb] = a; }
                float mx = -1e30f;
#pragma unroll
                for (int kb = 0; kb < 16; ++kb)
#pragma unroll
                    for (int j = 0; j < 4; ++j) mx = fmaxf(mx, s[kb][j]);
                mx = fmaxf(mx, __shfl_xor(mx, 16)); mx = fmaxf(mx, __shfl_xor(mx, 32));
                float sum = 0.f;
#pragma unroll
                for (int kb = 0; kb < 16; ++kb)
#pragma unroll
                    for (int j = 0; j < 4; ++j) { const float e = __expf(s[kb][j] - mx); s[kb][j] = e; sum += e; }
                sum += __shfl_xor(sum, 16); sum += __shfl_xor(sum, 32);
                const float inv = 1.0f / sum;
#pragma unroll
                for (int pr = 0; pr < 8; ++pr) pf[qi][pr] = __builtin_bit_cast(bf16x8, pack8(s[2 * pr] * inv, s[2 * pr + 1] * inv));
            }
        }
        __syncthreads();
        xstage(memvT_l + (size_t)bb * 262144 + (size_t)h * 65536, 256, lds, tid);
        __syncthreads();
        if (active) {
            const int rowA = rowbase + wave * 16, rowB = rowA + 128;
#pragma unroll 4
            for (int db = 0; db < 16; ++db) { f32x4 oa = {0.f, 0.f, 0.f, 0.f}, ob = {0.f, 0.f, 0.f, 0.f}; const LAS unsigned char* vp = lds + (db * 16 + fr) * 528 + quad * 16;
                if (nqb == 2) {
#pragma unroll
                    for (int pr = 0; pr < 8; ++pr) { const bf16x8 vf = *(const LAS bf16x8*)(vp + pr * 64); oa = MFMA16(vf, pf[0][pr], oa); ob = MFMA16(vf, pf[1][pr], ob); }
                } else {
#pragma unroll
                    for (int pr = 0; pr < 8; ++pr) { const bf16x8 vf = *(const LAS bf16x8*)(vp + pr * 64); oa = MFMA16(vf, pf[0][pr], oa); }
                }
                u32x2v w; w.x = pk2(oa[0], oa[1]); w.y = pk2(oa[2], oa[3]);
                *(GAS u32x2v*)((GAS bf16*)ox + (size_t)(rowA + fr) * 1024 + h * 256 + db * 16 + quad * 4) = w;
                if (nqb == 2) { u32x2v w2; w2.x = pk2(ob[0], ob[1]); w2.y = pk2(ob[2], ob[3]); *(GAS u32x2v*)((GAS bf16*)ox + (size_t)(rowB + fr) * 1024 + h * 256 + db * 16 + quad * 4) = w2; } }
        }
    }
    __syncthreads();
}

__device__ __forceinline__ void s5_stage_u(const bf16* up, LAS float* ubuf, int lane) {
    const v4u w0 = *(const v4u*)up, w1 = *(const v4u*)(up + 8);
    LAS f32x4* d = (LAS f32x4*)(ubuf + lane * 16);
    d[0] = (f32x4){bflo(w0.x), bfhi(w0.x), bflo(w0.y), bfhi(w0.y)}; d[1] = (f32x4){bflo(w0.z), bfhi(w0.z), bflo(w0.w), bfhi(w0.w)};
    d[2] = (f32x4){bflo(w1.x), bfhi(w1.x), bflo(w1.y), bfhi(w1.y)}; d[3] = (f32x4){bflo(w1.z), bfhi(w1.z), bflo(w1.w), bfhi(w1.w)};
}
__device__ __forceinline__ f32x2v lo2_(f32x4 v) { return __builtin_shufflevector(v, v, 0, 1); }
__device__ __forceinline__ f32x2v hi2_(f32x4 v) { return __builtin_shufflevector(v, v, 2, 3); }
#define S5_STEP(sidx) do { const LAS f32x4* up_ = (const LAS f32x4*)(ubuf + (sidx) * 16); const f32x4 u0 = up_[0], u1 = up_[1], u2 = up_[2], u3 = up_[3]; \
    f32x2v ac_ = lo2_(bb[0]) * u0[0]; ac_ = hi2_(bb[0]) * u0[1] + ac_; ac_ = lo2_(bb[1]) * u0[2] + ac_; ac_ = hi2_(bb[1]) * u0[3] + ac_; \
    ac_ = lo2_(bb[2]) * u1[0] + ac_; ac_ = hi2_(bb[2]) * u1[1] + ac_; ac_ = lo2_(bb[3]) * u1[2] + ac_; ac_ = hi2_(bb[3]) * u1[3] + ac_; \
    ac_ = lo2_(bb[4]) * u2[0] + ac_; ac_ = hi2_(bb[4]) * u2[1] + ac_; ac_ = lo2_(bb[5]) * u2[2] + ac_; ac_ = hi2_(bb[5]) * u2[3] + ac_; \
    ac_ = lo2_(bb[6]) * u3[0] + ac_; ac_ = hi2_(bb[6]) * u3[1] + ac_; ac_ = lo2_(bb[7]) * u3[2] + ac_; ac_ = hi2_(bb[7]) * u3[3] + ac_; \
    const float nr_ = ar * hr - ai * hi + ac_.x, ni_ = ar * hi + ai * hr + ac_.y; hr = nr_; hi = ni_; } while (0)

typedef short bf16x4_t __attribute__((ext_vector_type(4)));
#define MFMA16K16(a, b, c) __builtin_amdgcn_mfma_f32_16x16x16bf16_1k(a, b, c, 0, 0, 0)
__device__ __forceinline__ bf16x4_t s5_load_u(const bf16* urow0, int fr, int quad) { return *(const GAS bf16x4_t*)((const GAS bf16*)urow0 + (size_t)fr * 1280 + quad * 4); }
__device__ __forceinline__ void s5_bu_block(const bf16x4_t a, const bf16x4_t (&bcf)[8], LAS float* bul, int fr, int quad) {
#pragma unroll
    for (int cb = 0; cb < 8; ++cb) { f32x4 d = {0.f, 0.f, 0.f, 0.f}; d = MFMA16K16(a, bcf[cb], d);
#pragma unroll
        for (int j = 0; j < 4; ++j) bul[(quad * 4 + j) * 130 + cb * 16 + fr] = d[j]; }
}
__device__ __forceinline__ void s5_local(const bf16* proj, const float* abar, const bf16* bbt, float* sloc, LAS float* bul, int slot, int nslots, int lane) {
    const int fr = lane & 15, quad = lane >> 4;
    for (int t = slot; t < 8192; t += nslots) {
        const int chunk = t & 63, g = (t >> 6) & 31, b = t >> 11;
        const float ar = abar[(g * 64 + lane) * 2], ai = abar[(g * 64 + lane) * 2 + 1];
        bf16x4_t bcf[8];
#pragma unroll
        for (int cb = 0; cb < 8; ++cb) bcf[cb] = *(const GAS bf16x4_t*)((const GAS bf16*)bbt + (size_t)(g * 128 + cb * 16 + fr) * 16 + quad * 4);
        float hr = 0.f, hi = 0.f;
        bf16x4_t ua[4];
#pragma unroll
        for (int blk = 0; blk < 4; ++blk) ua[blk] = s5_load_u(proj + (size_t)(b * 4096 + chunk * 64 + blk * 16) * 1280 + g * 16, fr, quad);
#pragma unroll
        for (int blk = 0; blk < 4; ++blk) {
            s5_bu_block(ua[blk], bcf, bul, fr, quad);
#pragma unroll 4
            for (int s = 0; s < 16; ++s) { const f32x2v bu = *(const LAS f32x2v*)(bul + s * 130 + 2 * lane); const float nr = ar * hr - ai * hi + bu.x, ni = ar * hi + ai * hr + bu.y; hr = nr; hi = ni; }
        }
        *(f32x2v*)(sloc + (size_t)t * 128 + lane * 2) = (f32x2v){hr, hi};
    }
}
__device__ __forceinline__ void s5_out(const bf16* proj, const float* abar, const bf16* bbt, const float* sloc, const float* st_re, const float* st_im, const float* c_re, const float* c_im,
                                       const float* dcoef, bf16* gbuf, float* out, LAS float* bul, LAS unsigned* hbuf, int slot, int nslots, int lane) {
    const int fr = lane & 15, quad = lane >> 4;
    for (int t = slot; t < 8192 + 256; t += nslots) {
        const int sample = t >= 8192; int b, g, chunk, nblk, rowbase;
        if (!sample) { chunk = t & 63; g = (t >> 6) & 31; b = t >> 11; nblk = 4; rowbase = b * 4096 + chunk * 64; } else { const int s = t - 8192; g = s & 31; b = s >> 5; chunk = 0; nblk = 2; rowbase = MP + b * 32; }
        const float ar = abar[(g * 64 + lane) * 2], ai = abar[(g * 64 + lane) * 2 + 1];
        bf16x4_t bcf[8];
#pragma unroll
        for (int cb = 0; cb < 8; ++cb) bcf[cb] = *(const GAS bf16x4_t*)((const GAS bf16*)bbt + (size_t)(g * 128 + cb * 16 + fr) * 16 + quad * 4);
        float hr, hi;
        if (!sample) { float pr = ar, pi = ai;
#pragma unroll
            for (int i = 0; i < 6; ++i) { const float t1 = pr * pr - pi * pi; pi = 2.f * pr * pi; pr = t1; }
            hr = 0.f; hi = 0.f; const float* sp = sloc + (size_t)(t - chunk) * 128 + lane * 2;
#pragma unroll 16
            for (int cc = 0; cc < chunk; ++cc) { const f32x2v sv = *(const f32x2v*)(sp + (size_t)cc * 128); const float nr = pr * hr - pi * hi + sv.x, ni = pr * hi + pi * hr + sv.y; hr = nr; hi = ni; } }
        else { hr = st_re[(b * 32 + g) * 64 + lane]; hi = st_im[(b * 32 + g) * 64 + lane]; }
        bf16x8 cf[4];
#pragma unroll
        for (int ks = 0; ks < 4; ++ks) { const f32x4 cr = *(const f32x4*)(c_re + (size_t)(g * 16 + fr) * 64 + ks * 16 + quad * 4), ci = *(const f32x4*)(c_im + (size_t)(g * 16 + fr) * 64 + ks * 16 + quad * 4);
            v4u w; w.x = pg8::cvt_pk_bf16(cr[0], -ci[0]); w.y = pg8::cvt_pk_bf16(cr[1], -ci[1]); w.z = pg8::cvt_pk_bf16(cr[2], -ci[2]); w.w = pg8::cvt_pk_bf16(cr[3], -ci[3]); cf[ks] = __builtin_bit_cast(bf16x8, w); }
        const float dco = dcoef[g * 16 + fr];
        bf16x4_t ua[4]; bf16 uraw[4][4];
#pragma unroll
        for (int blk = 0; blk < 4; ++blk) { const int bc = blk < nblk ? blk : nblk - 1; const bf16* urow0 = proj + (size_t)(rowbase + bc * 16) * 1280 + g * 16; ua[blk] = s5_load_u(urow0, fr, quad);
#pragma unroll
            for (int j = 0; j < 4; ++j) uraw[blk][j] = ((const GAS bf16*)urow0)[(size_t)(quad * 4 + j) * 1280 + fr]; }
#pragma unroll
        for (int blk = 0; blk < 4; ++blk) { if (blk < nblk) {
            s5_bu_block(ua[blk], bcf, bul, fr, quad);
#pragma unroll 4
            for (int s = 0; s < 16; ++s) { const f32x2v bu = *(const LAS f32x2v*)(bul + s * 130 + 2 * lane); const float nr = ar * hr - ai * hi + bu.x, ni = ar * hi + ai * hr + bu.y; hr = nr; hi = ni; hbuf[s * 68 + lane] = pg8::cvt_pk_bf16(hr, hi); }
            f32x4 y = {0.f, 0.f, 0.f, 0.f};
#pragma unroll
            for (int ks = 0; ks < 4; ++ks) { const bf16x8 a = *(const LAS bf16x8*)(hbuf + fr * 68 + ks * 16 + quad * 4); y = MFMA16(a, cf[ks], y); }
#pragma unroll
            for (int j = 0; j < 4; ++j) { const int s = blk * 16 + quad * 4 + j; const float uu = bflo((unsigned)uraw[blk][j]); const float yv = y[j] + dco * uu;
                const float z = 0.7978845608028654f * (yv + 0.044715f * yv * yv * yv); const float th = 1.0f - 2.0f / (1.0f + __expf(2.0f * z)); const float gl = 0.5f * yv * (1.0f + th);
                ((GAS bf16*)gbuf)[(size_t)(rowbase + s) * 512 + g * 16 + fr] = (bf16)f2bf(gl); }
        } }
        if (!sample && chunk == 63) { out[OFF_SRP + (b * 32 + g) * 64 + lane] = hr; out[OFF_SIP + (b * 32 + g) * 64 + lane] = hi; }
        if (sample) { out[OFF_SRS + (b * 32 + g) * 64 + lane] = hr; out[OFF_SIS + (b * 32 + g) * 64 + lane] = hi; }
    }
}

template <int KIND>
__device__ __forceinline__ void sample_gemm(const bf16* A, const bf16* Bt, int K, LAS unsigned char* lds, int tid, int wave, int lane,
                                            bf16* xbp, const float* base_f32, float* part_next, const float* part_cur, bf16* O) {
    const int fr = lane & 15, quad = lane >> 4;
    LAS f32x4* red = (LAS f32x4*)lds;
    LAS float* ssred = (LAS float*)(lds + 32768);
    for (int tile = blockIdx.x; tile < 256; tile += gridDim.x) {
        const int r0 = MP + (tile >> 4) * 16, c0 = (tile & 15) * 64, kw = K >> 3;
        const bf16* ap = A + (size_t)(r0 + fr) * K + wave * kw + quad * 8;
        const bf16* bp = Bt + (size_t)(c0 + fr) * K + wave * kw + quad * 8;
        f32x4 acc[4];
#pragma unroll
        for (int cb = 0; cb < 4; ++cb) acc[cb] = (f32x4){0.f, 0.f, 0.f, 0.f};
        const int e_cb = (tid >> 6) & 3, e_l2 = tid & 63, e_row = r0 + (e_l2 & 15), e_col = c0 + e_cb * 16 + 4 * (e_l2 >> 4); const size_t e_off = (size_t)e_row * 1024 + e_col;
        f32x4 e_bs = {0.f, 0.f, 0.f, 0.f}; float e_rs = 1.f;
        if (tid < 256) { if (KIND == 0) { if (base_f32) e_bs = *(const f32x4*)(base_f32 + e_off); else { const u32x2v w = *(const u32x2v*)(xbp + e_off); e_bs = (f32x4){bflo(w.x), bfhi(w.x), bflo(w.y), bfhi(w.y)}; } }
                         else e_rs = rstd_of(part_cur, e_row); }
        const int nks = kw >> 5;
        for (int k0 = 0; k0 < nks; k0 += 4) {
            bf16x8 a[4], b[4][4];
#pragma unroll
            for (int i = 0; i < 4; ++i) { const int ks = (k0 + i < nks) ? k0 + i : nks - 1;
                a[i] = *(const bf16x8*)(ap + ks * 32);
#pragma unroll
                for (int cb = 0; cb < 4; ++cb) b[i][cb] = *(const bf16x8*)(bp + (size_t)cb * 16 * K + ks * 32); }
            __builtin_amdgcn_sched_barrier(0);
#pragma unroll
            for (int i = 0; i < 4; ++i) if (k0 + i < nks) {
#pragma unroll
                for (int cb = 0; cb < 4; ++cb) acc[cb] = MFMA16(b[i][cb], a[i], acc[cb]); }
        }
#pragma unroll
        for (int cb = 0; cb < 4; ++cb) red[(wave * 4 + cb) * 64 + lane] = acc[cb] * 1.0f;
        __syncthreads();
        if (tid < 256) { const int cb = tid >> 6, l2 = tid & 63; f32x4 v = red[cb * 64 + l2];
#pragma unroll
            for (int w = 1; w < 8; ++w) v = v + red[(w * 4 + cb) * 64 + l2];
            const int row = r0 + (l2 & 15), col = c0 + cb * 16 + 4 * (l2 >> 4); const size_t off = (size_t)row * 1024 + col;
            if (KIND == 0) {
                v = v + e_bs; u32x2v o; o.x = pk2(v[0], v[1]); o.y = pk2(v[2], v[3]); *(u32x2v*)(xbp + off) = o;
                float ss = (v[0] * v[0] + v[1] * v[1]) + (v[2] * v[2] + v[3] * v[3]); ss += __shfl_xor(ss, 16); ss += __shfl_xor(ss, 32);
                if ((l2 >> 4) == 0) ssred[cb * 16 + (l2 & 15)] = ss; }
            else { const float rs = e_rs; u32x2v o; o.x = pk2(v[0] * rs, v[1] * rs); o.y = pk2(v[2] * rs, v[3] * rs); *(u32x2v*)(O + off) = o; }
        }
        if (KIND == 0) { __syncthreads(); if (tid < 16) part_next[(size_t)(r0 + tid) * 16 + (tile & 15)] = (ssred[tid] + ssred[16 + tid]) + (ssred[32 + tid] + ssred[48 + tid]); }
        __syncthreads();
    }
}


__device__ __forceinline__ void sample_cz(const bf16* A, const bf16* Bt, LAS unsigned char* lds, int tid, int wave, int lane,
                                          const float* part_cur, const float* cw, const float* st, bf16* zcp, float* outp) {
    const int fr = lane & 15, quad = lane >> 4;
    LAS f32x4* red = (LAS f32x4*)lds;
    LAS float* T = (LAS float*)(lds + 65536);
    LAS float* CZ = (LAS float*)(lds + 65536 + 8192);
    for (int tile = blockIdx.x; tile < 256; tile += gridDim.x) {
        const int b = tile >> 5, c0 = (tile & 31) * 32, r0 = MP + b * 32;
        const int wrow = 1024 + (c0 >> 7) * 256 + (c0 & 127);
        const GAS bf16* ap = (const GAS bf16*)A + (size_t)(r0 + fr) * 1024 + wave * 128 + quad * 8;
        const GAS bf16* bp = (const GAS bf16*)Bt + (size_t)(wrow + fr) * 1024 + wave * 128 + quad * 8;
        bf16x8 a[4][2], bw[4][4];
#pragma unroll
        for (int ks = 0; ks < 4; ++ks) {
#pragma unroll
            for (int rb = 0; rb < 2; ++rb) a[ks][rb] = *(const GAS bf16x8*)(ap + (size_t)rb * 16 * 1024 + ks * 32);
#pragma unroll
            for (int cb = 0; cb < 4; ++cb) bw[ks][cb] = *(const GAS bf16x8*)(bp + (size_t)((cb >> 1) * 128 + (cb & 1) * 16) * 1024 + ks * 32); }
        f32x4 acc[2][4];
#pragma unroll
        for (int rb = 0; rb < 2; ++rb)
#pragma unroll
            for (int cb = 0; cb < 4; ++cb) { f32x4 d = {0.f, 0.f, 0.f, 0.f};
#pragma unroll
                for (int ks = 0; ks < 4; ++ks) d = MFMA16(bw[ks][cb], a[ks][rb], d);
                acc[rb][cb] = d; }
#pragma unroll
        for (int rb = 0; rb < 2; ++rb)
#pragma unroll
            for (int cb = 0; cb < 4; ++cb) red[(wave * 8 + rb * 4 + cb) * 64 + lane] = acc[rb][cb];
        __syncthreads();
        {
            const int blk = tid >> 6, l2 = tid & 63, rb = blk >> 2, cb = blk & 3; f32x4 v = red[blk * 64 + l2];
#pragma unroll
            for (int w = 1; w < 8; ++w) v = v + red[(w * 8 + blk) * 64 + l2];
            *(LAS f32x4*)(T + ((cb >> 1) * 32 + rb * 16 + (l2 & 15)) * 32 + (cb & 1) * 16 + 4 * (l2 >> 4)) = v; }
        __syncthreads();
        const int r = tid >> 3, cq = (tid & 7) * 4;
        if (tid < 256) { const float rs = rstd_of(part_cur, r0 + r); const float rs2 = rs * rs;
            const f32x4 gc = *(const LAS f32x4*)(T + r * 32 + cq), zz = *(const LAS f32x4*)(T + (32 + r) * 32 + cq);
            *(LAS f32x4*)(CZ + r * 32 + cq) = gc * zz * rs2; }
        __syncthreads();
        if (tid < 256) { const int c = c0 + cq;
            const f32x4 x0 = *(const LAS f32x4*)(CZ + r * 32 + cq);
            const f32x4 s0 = *(const f32x4*)(st + (size_t)(b * 2) * 1024 + c), s1 = *(const f32x4*)(st + (size_t)(b * 2 + 1) * 1024 + c);
            f32x4 xm1 = s1, xm2 = s0;
            if (r >= 1) { xm1 = *(const LAS f32x4*)(CZ + (r - 1) * 32 + cq); xm2 = s1; }
            if (r >= 2) xm2 = *(const LAS f32x4*)(CZ + (r - 2) * 32 + cq);
            const f32x4 w0 = *(const f32x4*)(cw + c), w1 = *(const f32x4*)(cw + 1024 + c), w2 = *(const f32x4*)(cw + 2048 + c);
            const f32x4 z = w0 * xm2 + w1 * xm1 + w2 * x0;
            bf16* gp = zcp + (size_t)(r0 + r) * 1024 + c; const u32x2v gw = *(const u32x2v*)gp;
            u32x2v o; o.x = pk2(z[0] * bflo(gw.x), z[1] * bfhi(gw.x)); o.y = pk2(z[2] * bflo(gw.y), z[3] * bfhi(gw.y)); *(u32x2v*)gp = o;
            if (r >= 30) *(f32x4*)(outp + OFF_CMS + (size_t)(b * 2 + (r - 30)) * 1024 + c) = x0; }
        __syncthreads();
    }
}

struct Params { const float* in[36]; float* out; unsigned char* ws; int use_cg, pad; };

__global__ void __launch_bounds__(512, 2) mega_fwd(Params P) {
    extern __shared__ __attribute__((aligned(16))) unsigned char lds_raw[];
    LAS unsigned char* lds = (LAS unsigned char*)lds_raw;
    volatile LAS unsigned* MISC = (volatile LAS unsigned*)(lds + MISC_OFF);
    const int G = gridDim.x, NGW = G * 8, NT = G * 512;
    const int wave_s = __builtin_amdgcn_readfirstlane(threadIdx.x >> 6);
    for (int u = threadIdx.x; u < (LDS_BYTES - 131072) / 4; u += 512) ((LAS unsigned*)(lds + 131072))[u] = 0u;
    __syncthreads();
    XcdBarrier bar = xcd_barrier_post((unsigned*)(P.ws + WS_BAR), MISC + 8);
#ifndef STOP_AFTER
#define STOP_AFTER 1000
#endif
    int ph = 0;
#define RUN (ph < STOP_AFTER)
#define FRESH() const int tid = fresh_tid(wave_s), lane = tid & 63, wave = __builtin_amdgcn_readfirstlane(tid >> 6); const int gw = blockIdx.x * 8 + wave, gt = blockIdx.x * 512 + tid; (void)gw; (void)gt; (void)lane; LAS float* wscr = (LAS float*)(lds + 32768 + wave * 12288); (void)wscr;
#define SEAM() do { if (P.use_cg) cg::this_grid().sync(); else xcd_barrier(bar); ++ph; } while (0)

#define part ((float*)(ws + WS_PART))
#define PARTBUF(k) (part + (size_t)((k) & 1) * PART_ELEMS)
#define ropec ((float*)(ws + WS_ROPE))
#define ropes (ropec + 4096 * 32)
#define abar ((float*)(ws + WS_SSM))
#define bbar (abar + 32 * 64 * 2)
#define bbt ((bf16*)(bbar + 32 * 64 * 32))
#define ckb ((bf16*)(ws + WS_CKV))
#define cvb (ckb + 8 * 128 * 128)
#define sloc ((float*)(ws + WS_SLOC))
#define memk ((bf16*)(ws + WS_MEMK))
#define memvT ((bf16*)(ws + WS_MEMVT))
#define SG ((float*)(ws + WS_SIDE))
#define SV ((float*)(ws + WS_SIDE + SG_BYTES))
#define WT ((bf16*)(ws + WS_WT))
#define xb ((bf16*)(ws + WS_XB))
#define tmp (ws + WS_TMP)
#define proj0 ((bf16*)(tmp + TMP_PROJ0))
#define gbuf ((bf16*)(tmp + TMP_GBUF))
#define ycat ((bf16*)(tmp + TMP_YCAT))
#define memb ((bf16*)(tmp + TMP_MEMB))
#define qx ((bf16*)(tmp + TMP_QX))
#define ox ((bf16*)(tmp + TMP_OX))
#define act ((bf16*)(tmp + TMP_ACT))
#define gbm ((bf16*)(tmp + TMP_GB))
#define zc ((bf16*)(tmp + TMP_ZC))
#define PTRS() unsigned char* ws = P.ws; float* out = P.out; asm volatile("" : "+s"(ws), "+s"(out));
    if (RUN) { PTRS() FRESH()
        {
            constexpr int NITEMS = 640 + 128 + 512 + 512 + 2 * 1024 + 512 + 2816 + 1408 + 2048;
            for (int it = gw; it < NITEMS; it += NGW) { int r = it;
#define TR(Wp, K_, N_, WTp, gainp, sc, mode) { const int ni_ = ((K_) / 64) * ((N_) / 32); if (r < ni_) { tr_item(Wp, K_, N_, WTp, gainp, sc, mode, wscr, r, lane); continue; } r -= ni_; }
                TR(P.in[15], 1024, 1280, WT + WT_INEVEN, P.in[11], 1.f, 1)
                TR(P.in[25], 512, 512, WT + WT_GLU, nullptr, 1.f, 0)
                TR(P.in[16], 1024, 1024, WT + WT_OUTEVEN, nullptr, 1.f, 0)
                TR(P.in[30], 1024, 1024, WT + WT_WQ, P.in[12], 0.0625f, 0)
                TR(P.in[31], 1024, 2048, WT + WT_WKV, nullptr, 1.f, 0)
                TR(P.in[31] + 2097152, 1024, 2048, WT + WT_WKV + 2097152, nullptr, 1.f, 0)
                TR(P.in[32], 1024, 1024, WT + WT_WO, nullptr, 1.f, 0)
                TR(P.in[33], 1024, 5632, WT + WT_UP, P.in[13], 1.f, 2)
                TR(P.in[35], 2816, 1024, WT + WT_DOWN, nullptr, 1.f, 0)
                { const int mi = r >> 7, l = mi >> 3, b = mi & 7; tr_item(P.in[10] + (size_t)mi * 262144, 256, 1024, memvT + (size_t)(l * 12 + 4 + b) * 262144, nullptr, 1.f, 0, wscr, r & 127, lane); }
            }
        }
        for (int m = gw; m < MROWS; m += NGW) { const float* xr = m < MP ? P.in[0] + (size_t)m * 1024 : P.in[1] + (size_t)(m - MP) * 1024; float ss = 0.f;
#pragma unroll
            for (int j = 0; j < 4; ++j) { const f32x4 v = *(const f32x4*)(xr + (lane + 64 * j) * 4); ss += (v[0] * v[0] + v[1] * v[1]) + (v[2] * v[2] + v[3] * v[3]);
                u32x2v w; w.x = pg8::cvt_pk_bf16(v[0], v[1]); w.y = pg8::cvt_pk_bf16(v[2], v[3]); *(u32x2v*)(xb + (size_t)m * 1024 + (lane + 64 * j) * 4) = w; }
            ss = wave_sum(ss); if (lane < 16) PARTBUF(0)[(size_t)m * 16 + lane] = lane == 0 ? ss : 0.f; }
        for (int i = gt; i < 262144; i += NT) { const f32x4 v = *(const f32x4*)(P.in[2] + (size_t)i * 4); u32x2v w; w.x = pg8::cvt_pk_bf16(v[0], v[1]); w.y = pg8::cvt_pk_bf16(v[2], v[3]); *(u32x2v*)(memb + (size_t)i * 4) = w; }
        for (int i = gt; i < 1048576; i += NT) { const size_t e = (size_t)i * 4; const int lb = (int)(e >> 18), l = lb >> 3, b = lb & 7; const f32x4 v = *(const f32x4*)(P.in[9] + e);
            u32x2v w; w.x = pg8::cvt_pk_bf16(v[0], v[1]); w.y = pg8::cvt_pk_bf16(v[2], v[3]); *(u32x2v*)(memk + (size_t)(l * 12 + 4 + b) * 262144 + (e & 262143)) = w; }
        for (int i = gt; i < 65536; i += NT) { const int j = i & 32767; const float* src = (i < 32768 ? P.in[3] : P.in[4]) + (size_t)j * 4; bf16* dst = (i < 32768 ? ckb : cvb) + (size_t)j * 4;
            const f32x4 v = *(const f32x4*)src; u32x2v w; w.x = pg8::cvt_pk_bf16(v[0], v[1]); w.y = pg8::cvt_pk_bf16(v[2], v[3]); *(u32x2v*)dst = w; }
        for (int i = gt; i < 4096 * 32; i += NT) { const int pos = i >> 5, d = i & 31; const double inv = dexp_(-(double)d * (9.210340371976184 / 32.0)); double s, c; dsincos_((double)pos * inv, s, c); ropec[i] = (float)c; ropes[i] = (float)s; }
        for (int i = gt; i < 2048; i += NT) { const double are = P.in[17][i], aim = P.in[18][i], dt = dexp_((double)P.in[19][i]); double s, c; dsincos_(aim * dt, s, c); const double mag = dexp_(are * dt);
            const double br = mag * c, bi = mag * s; abar[2 * i] = (float)br; abar[2 * i + 1] = (float)bi;
            const double nr = br - 1.0, ni = bi, den = are * are + aim * aim; const double qr = (nr * are + ni * aim) / den, qi = (ni * are - nr * aim) / den;
#pragma unroll 4
            for (int h = 0; h < 16; ++h) { const double xr = P.in[20][(size_t)i * 16 + h], xi = P.in[21][(size_t)i * 16 + h]; const float fre = (float)(qr * xr - qi * xi), fim = (float)(qr * xi + qi * xr); bbar[(size_t)i * 32 + 2 * h] = fre; bbar[(size_t)i * 32 + 2 * h + 1] = fim;
                bbt[((size_t)i * 2) * 16 + h] = (bf16)f2bf(fre); bbt[((size_t)i * 2 + 1) * 16 + h] = (bf16)f2bf(fim); } }
    }
    SEAM();
    if (RUN) { PTRS()
        if (G < 128 || (int)blockIdx.x >= G - 64) { pg8::Gemm g{memb, WT + WT_WKV, 1024, 4096, 1024}; pg8::StaticOrder S;
            if (G < 128) S.init(1024, 4096, G, (int)blockIdx.x); else S.init(1024, 4096, 64, (int)blockIdx.x - (G - 64)); EpiKV E{out, memk};
          pg8::gemm_phase<EpiKV, pg8::StaticOrder, true, true>(lds, g, S, E, wave_s); }
        { pg8::Gemm g{xb, WT + WT_INEVEN, MROWS, 1280, 1024}; pg8::StaticOrderF S; S.init(MROWS, 1280, G, (int)blockIdx.x); EpiIn0 E{proj0, PARTBUF(0), ropec, ropes, out};
          pg8::gemm_phase<EpiIn0, pg8::StaticOrderF, true, true>(lds, g, S, E, wave_s); }
        {
            FRESH()
            const int bx = (int)blockIdx.x, n2 = 325 - G;
            int slot = -1, nw = 1;
            if (G == 256) { if (bx >= n2 && bx < G - 64) { slot = (bx - n2) * 8 + wave; nw = (G - 64 - n2) * 8; } } else { slot = gw; nw = NGW; }
            if (slot >= 0) for (int it = slot; it < 2816 + 1408; it += nw) { int r = it;
                TR(P.in[33] + (size_t)1024 * 5632, 1024, 5632, WT + WT_UP + (size_t)5632 * 1024, P.in[13] + 1024, 1.f, 2)
                tr_item(P.in[35] + (size_t)2816 * 1024, 2816, 1024, WT + WT_DOWN + (size_t)2816 * 1024, nullptr, 1.f, 0, wscr, r, lane); }
        }
    }
    SEAM();
    if (RUN) { PTRS() FRESH()
        swa_phase(proj0, ckb, cvb, P.in[26], ycat, lds, tid, wave, lane, G);
        s5_local(proj0, abar, bbt, sloc, wscr, wave * G + (int)blockIdx.x, NGW, lane);
        for (int it = wave * G + (int)blockIdx.x; it < 1024; it += NGW) { const int mi = it >> 7, l = mi >> 2, b = mi & 3;
            tr_item(out + OFF_MVP + (size_t)mi * 262144, 256, 1024, memvT + (size_t)(l * 12 + b) * 262144, nullptr, 1.f, 0, wscr, it & 127, lane); }
    }
    SEAM();
    if (RUN) { PTRS() FRESH() s5_out(proj0, abar, bbt, sloc, P.in[5], P.in[6], P.in[22], P.in[23], P.in[24], gbuf, out, (LAS float*)(lds + wave * 16384), (LAS unsigned*)(lds + wave * 16384 + 8448), wave * G + (int)blockIdx.x, NGW, lane); }
    SEAM();
    if (RUN) { PTRS() pg8::Gemm g{gbuf, WT + WT_GLU, MROWS, 512, 512}; pg8::StaticOrder S; S.init(MROWS, 512, G, (int)blockIdx.x); EpiGlu E{gbuf, ycat};
        pg8::gemm_phase<EpiGlu, pg8::StaticOrder, true, true>(lds, g, S, E, wave_s);
        {
            FRESH()
            const int bx = (int)blockIdx.x; int slot = -1, nw = 1;
            if (G > 130) { if (bx >= 130) { slot = (bx - 130) * 8 + wave; nw = (G - 130) * 8; } } else { slot = gw; nw = NGW; }
            if (slot >= 0) for (int it = slot; it < 1536 + 512; it += nw) { int r = it;
                TR(P.in[27], 1024, 3072, WT + WT_INODD, P.in[11] + 1024, 1.f, 3)
                tr_item(P.in[29], 1024, 1024, WT + WT_OUTODD, nullptr, 1.f, 0, wscr, r, lane); }
        } }
    SEAM();

#pragma unroll
    for (int l = 0; l < 2; ++l) {
        if (l == 1) {
            if (RUN) { PTRS() pg8::Gemm g{xb, WT + WT_INODD, MP, 1024, 1024}; pg8::StaticOrderF S; S.init(MP, 1024, G, (int)blockIdx.x); EpiBf16 E{gbm, 1024, PARTBUF(3)};
                pg8::gemm_phase<EpiBf16, pg8::StaticOrderF, true, true>(lds, g, S, E, wave_s);
                { FRESH() sample_gemm<1>(xb, WT + WT_INODD, 1024, lds, tid, wave, lane, nullptr, nullptr, nullptr, PARTBUF(3), gbm); } }
            SEAM();
            if (RUN) { PTRS() pg8::Gemm g{xb, WT + WT_INODD + (size_t)1024 * 1024, MP, 2048, 1024}; pg8::StaticOrderF S; S.init(MP, 2048, G, (int)blockIdx.x); EpiCz E{gbm, PARTBUF(3), P.in[28], SG};
                pg8::gemm_phase<EpiCz, pg8::StaticOrderF, true, true>(lds, g, S, E, wave_s);
                { FRESH() sample_cz(xb, WT + WT_INODD, lds, tid, wave, lane, PARTBUF(3), P.in[28], P.in[7], gbm, out); } }
            SEAM();
            if (RUN) { PTRS() FRESH()
                const float* cw = P.in[28];
                for (int i = gt; i < 512 * 128; i += NT) { const int ri = i >> 7, c0 = (i & 127) * 8, blk = ri >> 1, rr = ri & 1, row = blk * 64 + rr;
                    f32x4 pa0, pa1, pb0, pb1;
                    if ((blk & 63) == 0) { pa0 = pa1 = pb0 = pb1 = (f32x4){0.f, 0.f, 0.f, 0.f}; }
                    else { const float* s0 = SG + (size_t)((blk - 1) * 8 + 6) * 1024 + c0; pa0 = *(const f32x4*)s0; pa1 = *(const f32x4*)(s0 + 4); pb0 = *(const f32x4*)(s0 + 1024); pb1 = *(const f32x4*)(s0 + 1028); }
                    const float* sc = SG + (size_t)(blk * 8) * 1024 + c0; const f32x4 x00 = *(const f32x4*)sc, x01 = *(const f32x4*)(sc + 4);
                    f32x4 xm2a, xm2b, xm1a, xm1b, xca, xcb;
                    if (rr == 0) { xm2a = pa0; xm2b = pa1; xm1a = pb0; xm1b = pb1; xca = x00; xcb = x01; }
                    else { xm2a = pb0; xm2b = pb1; xm1a = x00; xm1b = x01; xca = *(const f32x4*)(sc + 1024); xcb = *(const f32x4*)(sc + 1028); }
                    const f32x4 w0a = *(const f32x4*)(cw + c0), w0b = *(const f32x4*)(cw + c0 + 4), w1a = *(const f32x4*)(cw + 1024 + c0), w1b = *(const f32x4*)(cw + 1028 + c0), w2a = *(const f32x4*)(cw + 2048 + c0), w2b = *(const f32x4*)(cw + 2052 + c0);
                    const f32x4 z0 = w0a * xm2a + w1a * xm1a + w2a * xca, z1 = w0b * xm2b + w1b * xm1b + w2b * xcb;
                    const v4u gw_ = *(const v4u*)(gbm + (size_t)row * 1024 + c0);
                    const f32x4 g0 = (f32x4){bflo(gw_.x), bfhi(gw_.x), bflo(gw_.y), bfhi(gw_.y)}, g1 = (f32x4){bflo(gw_.z), bfhi(gw_.z), bflo(gw_.w), bfhi(gw_.w)};
                    *(v4u*)(gbm + (size_t)row * 1024 + c0) = pack8(g0 * z0, g1 * z1); }
                for (int i = gt; i < 4 * 2 * 1024; i += NT) { const int c = i & 1023, j = (i >> 10) & 1, b = i >> 11; out[OFF_CMP + i] = SG[(size_t)((64 * b + 63) * 8 + 6 + j) * 1024 + c]; }
            }
            SEAM();
        }
        if (RUN) { PTRS() pg8::Gemm g{(bf16*)(tmp + (size_t)(1 - l) * TMP_YCAT), WT + WT_OUTEVEN + (size_t)l * (WT_OUTODD - WT_OUTEVEN), MP, 1024, 1024}; pg8::StaticOrderF S; S.init(MP, 1024, G, (int)blockIdx.x);
            EpiRes E{P.in[0], P.in[1] - (size_t)MP * 1024, xb, PARTBUF(1 + 3 * l), l == 0 ? 1 : 0};
            pg8::gemm_phase<EpiRes, pg8::StaticOrderF, true, true>(lds, g, S, E, wave_s);
            { FRESH() sample_gemm<0>((bf16*)(tmp + (size_t)(1 - l) * TMP_YCAT), WT + WT_OUTEVEN + (size_t)l * (WT_OUTODD - WT_OUTEVEN), 1024, lds, tid, wave, lane, xb, l == 0 ? P.in[1] - (size_t)MP * 1024 : (const float*)nullptr, PARTBUF(1 + 3 * l), nullptr, nullptr); } }
        SEAM();
        if (RUN) { PTRS() pg8::Gemm g{xb, WT + WT_WQ + (size_t)l * 1048576, MP, 1024, 1024}; pg8::StaticOrderF S; S.init(MP, 1024, G, (int)blockIdx.x); EpiBf16 E{qx, 1024, PARTBUF(1 + 3 * l)};
            pg8::gemm_phase<EpiBf16, pg8::StaticOrderF, true, true>(lds, g, S, E, wave_s);
            { FRESH() sample_gemm<1>(xb, WT + WT_WQ + (size_t)l * 1048576, 1024, lds, tid, wave, lane, nullptr, nullptr, nullptr, PARTBUF(1 + 3 * l), qx); } }
        SEAM();
        if (RUN) { PTRS() FRESH() xattn_phase2(qx, memk + (size_t)l * 12 * 262144, memvT + (size_t)l * 12 * 262144, ox, lds, tid, wave, lane, G); }
        SEAM();
        if (RUN) { PTRS() pg8::Gemm g{ox, WT + WT_WO + (size_t)l * 1048576, MP, 1024, 1024}; pg8::StaticOrderF S; S.init(MP, 1024, G, (int)blockIdx.x); EpiRes E{P.in[0], P.in[0], xb, PARTBUF(2 + 3 * l), 0};
            pg8::gemm_phase<EpiRes, pg8::StaticOrderF, true, true>(lds, g, S, E, wave_s);
            { FRESH() sample_gemm<0>(ox, WT + WT_WO + (size_t)l * 1048576, 1024, lds, tid, wave, lane, xb, nullptr, PARTBUF(2 + 3 * l), nullptr, nullptr); } }
        SEAM();
        if (RUN) { PTRS() pg8::Gemm g{xb, WT + WT_UP + (size_t)l * 5632 * 1024, MROWS, 5632, 1024}; pg8::StaticOrderF S; S.init(MROWS, 5632, G, (int)blockIdx.x);
            EpiFfnUp E{act, PARTBUF(2 + 3 * l), P.in[34] + (size_t)l * 3 * DFF, SG, SV};
            pg8::gemm_phase<EpiFfnUp, pg8::StaticOrderF, true, true>(lds, g, S, E, wave_s);
            if (l == 0) {
                FRESH()
                const int bx = (int)blockIdx.x, nb = 1430 % G; int slot = -1, nw = 1;
                if (nb > 0 && nb < G) { if (bx >= nb) { slot = (bx - nb) * 8 + wave; nw = (G - nb) * 8; } } else { slot = gw; nw = NGW; }
                if (slot >= 0) for (int it = slot; it < 512 + 512; it += nw) { int r = it;
                    TR(P.in[30] + 1048576, 1024, 1024, WT + WT_WQ + 1048576, P.in[12] + 1024, 0.0625f, 0)
                    tr_item(P.in[32] + 1048576, 1024, 1024, WT + WT_WO + 1048576, nullptr, 1.f, 0, wscr, r, lane); }
            } }
        SEAM();
        if (RUN) { PTRS() FRESH()
            const float* cw = P.in[34] + (size_t)l * 3 * DFF; const float* st = P.in[8] + (size_t)l * 8 * 2 * DFF;
            for (int i = gt; i < 528 * 352; i += NT) { const int fi = i / 352, c0 = (i % 352) * 8; int blk, row, rr, sb, vb; bool smp = fi >= 512;
                if (!smp) { blk = fi >> 1; rr = fi & 1; row = blk * 64 + rr; sb = 0; vb = 0; } else { const int s = fi - 512, half = (s >> 1) & 1; blk = 256 + (s >> 2); rr = s & 1; row = blk * 64 + half * 32 + rr; sb = half * 4; vb = half * 2; }
                f32x4 pa0, pa1, pb0, pb1;
                if (smp) { const int b = (blk - 256) * 2 + (sb >> 2); const float* s0 = st + (size_t)(b * 2) * DFF + c0; pa0 = *(const f32x4*)s0; pa1 = *(const f32x4*)(s0 + 4); pb0 = *(const f32x4*)(s0 + DFF); pb1 = *(const f32x4*)(s0 + DFF + 4); }
                else if ((blk & 63) == 0) { pa0 = pa1 = pb0 = pb1 = (f32x4){0.f, 0.f, 0.f, 0.f}; }
                else { const float* s0 = SG + (size_t)((blk - 1) * 8 + 6) * DFF + c0; pa0 = *(const f32x4*)s0; pa1 = *(const f32x4*)(s0 + 4); pb0 = *(const f32x4*)(s0 + DFF); pb1 = *(const f32x4*)(s0 + DFF + 4); }
                const float* sc = SG + (size_t)(blk * 8 + sb) * DFF + c0; const f32x4 x00 = *(const f32x4*)sc, x01 = *(const f32x4*)(sc + 4);
                f32x4 xm2a, xm2b, xm1a, xm1b, xca, xcb;
                if (rr == 0) { xm2a = pa0; xm2b = pa1; xm1a = pb0; xm1b = pb1; xca = x00; xcb = x01; }
                else { xm2a = pb0; xm2b = pb1; xm1a = x00; xm1b = x01; xca = *(const f32x4*)(sc + DFF); xcb = *(const f32x4*)(sc + DFF + 4); }
                const f32x4 w0a = *(const f32x4*)(cw + c0), w0b = *(const f32x4*)(cw + c0 + 4), w1a = *(const f32x4*)(cw + DFF + c0), w1b = *(const f32x4*)(cw + DFF + c0 + 4), w2a = *(const f32x4*)(cw + 2 * DFF + c0), w2b = *(const f32x4*)(cw + 2 * DFF + c0 + 4);
                const f32x4 ga = w0a * xm2a + w1a * xm1a + w2a * xca, gb_ = w0b * xm2b + w1b * xm1b + w2b * xcb;
                const float* sv = SV + (size_t)(blk * 4 + vb + rr) * DFF + c0; const f32x4 va = *(const f32x4*)sv, vb_ = *(const f32x4*)(sv + 4);
                f32x4 a0, a1;
#pragma unroll
                for (int j = 0; j < 4; ++j) { a0[j] = ga[j] * sigmoidf_(ga[j]) * va[j]; a1[j] = gb_[j] * sigmoidf_(gb_[j]) * vb_[j]; }
                *(v4u*)(act + (size_t)row * DFF + c0) = pack8(a0, a1); }
            for (int i = gt; i < 4 * 2 * DFF; i += NT) { const int c = i % DFF, j = (i / DFF) & 1, b = i / (2 * DFF); out[OFF_CFP + (size_t)l * 4 * 2 * DFF + i] = SG[(size_t)((64 * b + 63) * 8 + 6 + j) * DFF + c]; }
            for (int i = gt; i < 8 * 2 * DFF; i += NT) { const int c = i % DFF, j = (i / DFF) & 1, b = i / (2 * DFF); out[OFF_CFS + (size_t)l * 8 * 2 * DFF + i] = SG[(size_t)((256 + (b >> 1)) * 8 + (b & 1) * 4 + 2 + j) * DFF + c]; }
        }
        SEAM();
        if (RUN) { PTRS() pg8::Gemm g{act, WT + WT_DOWN + (size_t)l * 2816 * 1024, MP, 1024, DFF}; pg8::StaticOrderF S; S.init(MP, 1024, G, (int)blockIdx.x); EpiRes E{P.in[0], P.in[0], xb, PARTBUF(3 + 3 * l), 0};
            pg8::gemm_phase<EpiRes, pg8::StaticOrderF, true, true>(lds, g, S, E, wave_s);
            { FRESH() sample_gemm<0>(act, WT + WT_DOWN + (size_t)l * 2816 * 1024, DFF, lds, tid, wave, lane, xb, nullptr, PARTBUF(3 + 3 * l), nullptr, nullptr); } }
        SEAM();
    }
    if (RUN) { PTRS() FRESH()
        const float* gf = P.in[14];
        for (int m = gw; m < MROWS; m += NGW) { const float rs = rstd_of(PARTBUF(6), m); float* xr = out + (size_t)m * 1024; const bf16* xbr = xb + (size_t)m * 1024;
#pragma unroll
            for (int j = 0; j < 4; ++j) { const int c = (lane + 64 * j) * 4; const u32x2v w = *(const u32x2v*)(xbr + c); const f32x4 v = (f32x4){bflo(w.x), bfhi(w.x), bflo(w.y), bfhi(w.y)}, gg = *(const f32x4*)(gf + c); *(f32x4*)(xr + c) = v * rs * gg; } }
    }
}

extern "C" void kernel_launch(void* const* d_in, const int* in_sizes, int n_in, void* d_out, int out_size, void* d_ws, size_t ws_size, hipStream_t stream) {
    static int grid = 0;
    if (grid == 0) {
        int dev = 0, cus = 0, per_cu = 0;
        if (n_in != 36 || ws_size < 256 * MiB) { fprintf(stderr, "kernel_launch: unexpected n_in %d / ws %zu\n", n_in, ws_size); grid = -1; return; }
        (void)hipGetDevice(&dev); (void)hipDeviceGetAttribute(&cus, hipDeviceAttributeMultiprocessorCount, dev);
        if (hipFuncSetAttribute((const void*)mega_fwd, hipFuncAttributeMaxDynamicSharedMemorySize, LDS_BYTES) != hipSuccess) { fprintf(stderr, "kernel_launch: hipFuncSetAttribute failed\n"); grid = -1; return; }
        if (hipOccupancyMaxActiveBlocksPerMultiprocessor(&per_cu, (const void*)mega_fwd, 512, LDS_BYTES) != hipSuccess || per_cu < 1) per_cu = 1;
        (void)hipGetLastError();
        grid = cus * 1;
        if (grid > 256) grid = 256;
    }
    if (grid < 0) return;
    (void)hipMemsetAsync(d_ws, 0, CTL_ZERO_BYTES, stream);
    Params p{};
    for (int i = 0; i < 36; ++i) p.in[i] = (const float*)d_in[i];
    p.out = (float*)d_out; p.ws = (unsigned char*)d_ws; p.use_cg = 0; p.pad = 0;
    void* args[] = {&p};
    hipError_t e = hipLaunchCooperativeKernel((const void*)mega_fwd, dim3(grid), dim3(512), args, LDS_BYTES, stream);
    if (e != hipSuccess) fprintf(stderr, "cooperative launch failed: %s (grid %d)\n", hipGetErrorString(e), grid);
}
```

```cpp
#include <hip/hip_runtime.h>
#include <hip/hip_cooperative_groups.h>
#include <cstdio>
#include <cstdint>
namespace cg = cooperative_groups;
__device__ __forceinline__ int fresh_tid(int wave_s) { unsigned z = 0u; asm volatile("" : "+s"(z)); int t = wave_s * 64 + (int)__builtin_amdgcn_mbcnt_hi(~0u, __builtin_amdgcn_mbcnt_lo(~0u, z)); asm volatile("" : "+v"(t)); return t; }
namespace pg8 {
#define PG8_LAS __attribute__((address_space(3)))
typedef unsigned short bf16_t;
typedef short bf16x8 __attribute__((ext_vector_type(8)));
typedef float f32x4 __attribute__((ext_vector_type(4)));
typedef unsigned u32x4 __attribute__((ext_vector_type(4)));
constexpr int BM = 256, BK = 64, HALF = 128, HTB = HALF * BK * 2  , STAGE_BYTES = 8 * HTB, NXCD = 8, WGM = 8;

__host__ __device__ __forceinline__ int lds_byte(int r, int c) { const int st = (r >> 4) * 2 + (c >> 5), rr = r & 15, cc = c & 31, ob = rr * 64 + cc * 2; return st * 1024 + (ob ^ (((ob >> 9) & 1) << 5)); }
__host__ __device__ __forceinline__ void stage_rc(int b, int& R, int& C) { const int st = b / 1024, sb = b % 1024, swz = sb ^ (((sb >> 9) & 1) << 5); R = (st >> 1) * 16 + swz / 64; C = (st & 1) * 32 + (swz % 64) / 2; }
__host__ __device__ __forceinline__ int perm32(int rho) { const int n = rho >> 4, i = rho & 15; return 8 * (i >> 2) + 4 * n + (i & 3); }

struct Unit { int pm, pn; };
struct Gemm { const bf16_t* A; const bf16_t* Bt; int M, N, K; };

template <bool FULL> struct StaticOrderT {
    int nM, nN, nwg, G, c;
    __host__ __device__ void init(int M, int N, int G_, int c_) { nM = M / BM; nN = N / BM; nwg = nM * nN; G = G_; c = c_; }
    __host__ __device__ bool next(int i, Unit& u) const {
        const long L = (long)i * G + c; if (!(FULL && i == 0) && L >= nwg) return false;
        int wgid = (int)L; { const int q = nwg / NXCD, r = nwg % NXCD, xcd = wgid % NXCD, off = wgid / NXCD; wgid = (xcd < r ? xcd * (q + 1) : r * (q + 1) + (xcd - r) * q) + off; }
        const int nig = WGM * nN, gid = wgid / nig, fm = gid * WGM, gsz = (nM - fm) < WGM ? (nM - fm) : WGM;
        u.pm = fm + ((wgid % nig) % gsz); u.pn = (wgid % nig) / gsz; return true;
    }
    __device__ __forceinline__ void a_ready(const Unit&) const {}
    __device__ __forceinline__ void done(const Unit&) const {}
};

typedef StaticOrderT<false> StaticOrder; typedef StaticOrderT<true> StaticOrderF;
__device__ __forceinline__ unsigned cvt_pk_bf16(float lo, float hi) { unsigned r; asm volatile("v_cvt_pk_bf16_f32 %0, %1, %2" : "=v"(r) : "v"(lo), "v"(hi)); return r; }
typedef float f32x2 __attribute__((ext_vector_type(2)));
template <class Epi, class Sched, bool ALIGN_EPI = false, bool SP2 = false>
__device__ __forceinline__ void gemm_phase(PG8_LAS unsigned char* lds, const Gemm g, const Sched& S, const Epi& E, const int wave_s) {
    const int tid = fresh_tid(wave_s), wid = __builtin_amdgcn_readfirstlane(tid >> 6), lane = tid & 63, wr = wid >> 2, wc = wid & 3, fr = lane & 15, fq = lane >> 4;
    const int K = g.K, nt = K / BK;
    unsigned voffA[2], voffB[2];
#pragma unroll
    for (int i = 0; i < 2; ++i) { int R, C; stage_rc(tid * 16 + i * 8192, R, C); const int Rb = Epi::PERM ? ((R & ~31) + perm32(R & 31)) : R;
        voffA[i] = (unsigned)(R * K + C) * 2u; voffB[i] = (unsigned)(Rb * K + C) * 2u; }
    const size_t kstep = (size_t)(BK * 2);
    const size_t hstep = (size_t)HALF * K * 2;
    const size_t tstep = 2 * hstep;
    const unsigned ldsw = (unsigned)wid * 1024u;
    const int aoff = lds_byte(wr * 64 + fr, fq * 8), boff = lds_byte(wc * 32 + fr, fq * 8);
#define PG8_SA(b, h) (((b) * 2 + (h)) * HTB)
#define PG8_SB(b, h) ((4 + (b) * 2 + (h)) * HTB)
#define PG8_STAGE(bufoff, gbase, voff) do { _Pragma("unroll") for (int _i = 0; _i < 2; ++_i) \
        __builtin_amdgcn_global_load_lds((const unsigned*)((const char*)(gbase) + (voff)[_i]), (PG8_LAS unsigned*)(lds + (bufoff) + ldsw + _i * 8192), 16, 0, 0); } while (0)
#define PG8_LDA(dst, b, h) do { _Pragma("unroll") for (int m = 0; m < 4; ++m) _Pragma("unroll") for (int k = 0; k < 2; ++k) dst[m][k] = *(const PG8_LAS bf16x8*)(lds + PG8_SA(b, h) + aoff + m * 2048 + k * 1024); } while (0)
#define PG8_LDB(dst, b, h) do { _Pragma("unroll") for (int n = 0; n < 2; ++n) _Pragma("unroll") for (int k = 0; k < 2; ++k) dst[n][k] = *(const PG8_LAS bf16x8*)(lds + PG8_SB(b, h) + boff + n * 2048 + k * 1024); } while (0)
#define PG8_MMA(ai, bj, At, Bt) do { __builtin_amdgcn_s_setprio(1); _Pragma("unroll") for (int m = 0; m < 4; ++m) _Pragma("unroll") for (int n = 0; n < 2; ++n) _Pragma("unroll") for (int k = 0; k < 2; ++k) \
        acc[ai][bj][m][n] = __builtin_amdgcn_mfma_f32_16x16x32_bf16(Bt[n][k], At[m][k], acc[ai][bj][m][n], 0, 0, 0); __builtin_amdgcn_s_setprio(0); } while (0)
#define PG8_WAIT_V(n) asm volatile("s_waitcnt vmcnt(" #n ")" ::: "memory")
#define PG8_WAIT_L(n) asm volatile("s_waitcnt lgkmcnt(" #n ")" ::: "memory")
#define PG8_BAR __builtin_amdgcn_s_barrier()
#define PG8_SCHED __builtin_amdgcn_sched_barrier(0)
    Unit cur, nxt; int ui = 0;
    if (!S.next(0, cur)) return;
    f32x4 acc[2][2][4][2];
#pragma unroll
    for (int a = 0; a < 2; ++a)
#pragma unroll
        for (int b = 0; b < 2; ++b)
#pragma unroll
            for (int m = 0; m < 4; ++m)
#pragma unroll
                for (int n = 0; n < 2; ++n) acc[a][b][m][n] = (f32x4){0.f, 0.f, 0.f, 0.f};
    bf16x8 At[4][2], B0[2][2], B1[2][2];
    const char* cA = (const char*)g.A + (size_t)cur.pm * tstep; const char* cB = (const char*)g.Bt + (size_t)cur.pn * tstep;
    S.a_ready(cur);
    if constexpr (SP2) {
        PG8_STAGE(PG8_SB(0, 0), cB, voffB); PG8_STAGE(PG8_SB(0, 1), cB + hstep, voffB); PG8_STAGE(PG8_SA(0, 0), cA, voffA); PG8_STAGE(PG8_SA(0, 1), cA + hstep, voffA);
        if (wr == 1) PG8_BAR;
        PG8_WAIT_V(2); PG8_BAR;
        PG8_STAGE(PG8_SB(1, 0), cB + kstep, voffB); PG8_STAGE(PG8_SA(1, 0), cA + kstep, voffA); PG8_STAGE(PG8_SB(1, 1), cB + hstep + kstep, voffB);
        PG8_WAIT_V(6); PG8_BAR;
    } else {
        PG8_STAGE(PG8_SB(0, 0), cB, voffB); PG8_STAGE(PG8_SA(0, 0), cA, voffA); PG8_STAGE(PG8_SB(0, 1), cB + hstep, voffB); PG8_STAGE(PG8_SA(0, 1), cA + hstep, voffA);
        if (wr == 1) PG8_BAR;
        PG8_WAIT_V(4); PG8_BAR;
        PG8_STAGE(PG8_SB(1, 0), cB + kstep, voffB); PG8_STAGE(PG8_SA(1, 0), cA + kstep, voffA); PG8_STAGE(PG8_SB(1, 1), cB + hstep + kstep, voffB);
        PG8_WAIT_V(6); PG8_BAR;
    }
    for (;;) {
        const bool has_next = S.next(ui + 1, nxt);
        const char* nA = has_next ? (const char*)g.A + (size_t)nxt.pm * tstep : cA; const char* nB = has_next ? (const char*)g.Bt + (size_t)nxt.pn * tstep : cB;
        for (int t = 0; t < nt; t += 2) {
            const bool last = (t == nt - 2);
            const char* a1 = cA + (size_t)(t + 1) * kstep;
            const char* a2 = last ? nA : cA + (size_t)(t + 2) * kstep; const char* b2 = last ? nB : cB + (size_t)(t + 2) * kstep;
            const char* a3 = a2 + kstep; const char* b3 = b2 + kstep;
            if (last && has_next) S.a_ready(nxt);
            if constexpr (SP2) {
            PG8_LDB(B0, 0, 0); PG8_LDB(B1, 0, 1); PG8_SCHED; PG8_LDA(At, 0, 0); PG8_STAGE(PG8_SA(1, 1), a1 + hstep, voffA);
            PG8_WAIT_V(8); PG8_WAIT_L(0); PG8_BAR; PG8_MMA(0, 0, At, B0); PG8_MMA(0, 1, At, B1); PG8_BAR; PG8_SCHED;
            PG8_LDA(At, 0, 1); PG8_STAGE(PG8_SB(0, 0), b2, voffB); PG8_STAGE(PG8_SB(0, 1), b2 + hstep, voffB); PG8_STAGE(PG8_SA(0, 0), a2, voffA);
            PG8_WAIT_V(8); PG8_WAIT_L(0); PG8_BAR; PG8_MMA(1, 0, At, B0); PG8_MMA(1, 1, At, B1); PG8_BAR; PG8_SCHED;
            PG8_LDB(B0, 1, 0); PG8_LDB(B1, 1, 1); PG8_SCHED; PG8_LDA(At, 1, 0); PG8_STAGE(PG8_SA(0, 1), a2 + hstep, voffA);
            PG8_WAIT_V(8); PG8_WAIT_L(0); PG8_BAR; PG8_MMA(0, 0, At, B0); PG8_MMA(0, 1, At, B1); PG8_BAR; PG8_SCHED;
            PG8_LDA(At, 1, 1); PG8_STAGE(PG8_SB(1, 0), b3, voffB); PG8_STAGE(PG8_SB(1, 1), b3 + hstep, voffB); PG8_STAGE(PG8_SA(1, 0), a3, voffA);
            PG8_WAIT_V(8); PG8_WAIT_L(0); PG8_BAR; PG8_MMA(1, 0, At, B0); PG8_MMA(1, 1, At, B1); PG8_BAR; PG8_SCHED;
            } else {
            PG8_LDB(B0, 0, 0); PG8_SCHED; PG8_LDA(At, 0, 0); PG8_STAGE(PG8_SA(1, 1), a1 + hstep, voffA);
            PG8_WAIT_L(8); PG8_BAR; PG8_WAIT_L(0); PG8_MMA(0, 0, At, B0); PG8_BAR; PG8_SCHED;
            PG8_LDB(B1, 0, 1); PG8_STAGE(PG8_SB(0, 0), b2, voffB);
            PG8_BAR; PG8_WAIT_L(0); PG8_MMA(0, 1, At, B1); PG8_BAR;
            PG8_LDA(At, 0, 1); PG8_STAGE(PG8_SA(0, 0), a2, voffA);
            PG8_BAR; PG8_WAIT_L(0); PG8_MMA(1, 0, At, B0); PG8_BAR; PG8_SCHED;
            PG8_STAGE(PG8_SB(0, 1), b2 + hstep, voffB);
            PG8_WAIT_V(6); PG8_BAR; PG8_MMA(1, 1, At, B1); PG8_BAR;
            PG8_LDB(B0, 1, 0); PG8_SCHED; PG8_LDA(At, 1, 0); PG8_STAGE(PG8_SA(0, 1), a2 + hstep, voffA);
            PG8_WAIT_L(8); PG8_BAR; PG8_WAIT_L(0); PG8_MMA(0, 0, At, B0); PG8_BAR; PG8_SCHED;
            PG8_LDB(B1, 1, 1); PG8_STAGE(PG8_SB(1, 0), b3, voffB);
            PG8_BAR; PG8_WAIT_L(0); PG8_MMA(0, 1, At, B1); PG8_BAR;
            PG8_LDA(At, 1, 1); PG8_STAGE(PG8_SA(1, 0), a3, voffA);
            PG8_BAR; PG8_WAIT_L(0); PG8_MMA(1, 0, At, B0); PG8_BAR; PG8_SCHED;
            PG8_STAGE(PG8_SB(1, 1), b3 + hstep, voffB);
            PG8_WAIT_V(6); PG8_BAR; PG8_MMA(1, 1, At, B1); PG8_BAR;
            }
        }
        if constexpr (ALIGN_EPI) { if (wr == 0) PG8_BAR; }
        if constexpr (!Epi::AFTER_DRAIN) { E(acc, cur, wr, wc, fr, fq); S.done(cur); }
        if (!has_next) break;
#pragma unroll
        for (int a = 0; a < 2; ++a)
#pragma unroll
            for (int b = 0; b < 2; ++b)
#pragma unroll
                for (int m = 0; m < 4; ++m)
#pragma unroll
                    for (int n = 0; n < 2; ++n) acc[a][b][m][n] = (f32x4){0.f, 0.f, 0.f, 0.f};
        cur = nxt; cA = nA; cB = nB; ++ui;
        if constexpr (ALIGN_EPI) { if (wr == 1) PG8_BAR; }
    }
    PG8_WAIT_V(0);
    if constexpr (!ALIGN_EPI) { if (wr == 0) PG8_BAR; }
    PG8_BAR;
    if constexpr (Epi::AFTER_DRAIN) { E.fused(acc, cur, wr, wc, fr, fq, lds, wid, lane); S.done(cur); }
#undef PG8_SA
#undef PG8_SB
#undef PG8_STAGE
#undef PG8_LDA
#undef PG8_LDB
#undef PG8_MMA
#undef PG8_WAIT_V
#undef PG8_WAIT_L
#undef PG8_BAR
#undef PG8_SCHED
}
}
#define GAS __attribute__((address_space(1)))
#define LAS __attribute__((address_space(3)))
typedef unsigned short bf16;
typedef unsigned v4u __attribute__((ext_vector_type(4)));
typedef float f32x4 __attribute__((ext_vector_type(4)));
typedef short bf16x8 __attribute__((ext_vector_type(8)));
typedef GAS unsigned gu32;
typedef GAS unsigned long long gu64;
#define RLX_AGENT __ATOMIC_RELAXED, __HIP_MEMORY_SCOPE_AGENT
#define LDS_WAIT() asm volatile("s_waitcnt lgkmcnt(0)" ::: "memory")
#define VM_WAIT() asm volatile("s_waitcnt vmcnt(0)" ::: "memory")
__device__ __forceinline__ unsigned long long rt() { return __builtin_amdgcn_s_memrealtime(); }
__device__ __forceinline__ unsigned f2bf(float f) { unsigned u = __builtin_bit_cast(unsigned, f); return (u + 0x7fffu + ((u >> 16) & 1u)) >> 16; }
__device__ __forceinline__ unsigned pk2(float lo, float hi) { return f2bf(lo) | (f2bf(hi) << 16); }

#define XB_TMO      128
#define XB_XCNT(j)  (256  + 64 * (j))
#define XB_XSUB(j)  (1280 + 64 * (j))
#define XB_XGEN(j)  (2304 + 64 * (j))
#define XB_TOP      3328
#define XB_TOPGEN   3392
#define XCD_BAR_WORDS 3456
#define XB_SPIN_CAP (1u << 18)

__device__ __forceinline__ unsigned xb_ld(unsigned* p)              { return __hip_atomic_load(p, __ATOMIC_RELAXED, __HIP_MEMORY_SCOPE_AGENT); }
__device__ __forceinline__ unsigned xb_add(unsigned* p, unsigned v) { return __hip_atomic_fetch_add(p, v, __ATOMIC_RELAXED, __HIP_MEMORY_SCOPE_AGENT); }
__device__ __forceinline__ unsigned xb_xcc_id() { return (unsigned)__builtin_amdgcn_s_getreg((3 << 11) | 20) & 0xFu; }
#define XB_SPIN(cond, bar) do { unsigned _sp = 0; while (cond) { __builtin_amdgcn_s_sleep(1); \
    if ((++_sp & 255u) == 0u) { if (xb_ld(&(bar)[XB_TMO])) break; if (_sp > XB_SPIN_CAP) { atomicAdd(&(bar)[XB_TMO], 1u); break; } } } } while (0)

struct XcdBarrier {
    unsigned* bar; unsigned x;
    volatile LAS unsigned* st;
};

__device__ __forceinline__ XcdBarrier xcd_barrier_post(unsigned* bar, volatile LAS unsigned* st) {
    XcdBarrier b; b.bar = bar; b.x = xb_xcc_id(); b.st = st;
    if (threadIdx.x == 0) (void)xb_add(&bar[XB_XCNT(b.x)], 1u);
    return b;
}
__device__ __forceinline__ void xcd_barrier_complete(unsigned* bar, unsigned x, unsigned& nloc, unsigned& nx) {
    const unsigned G = gridDim.x * gridDim.y * gridDim.z;
    unsigned sum, cnt, mine, sp = 0u;
    for (;;) {
        sum = 0u; cnt = 0u; mine = 0u;
#pragma unroll
        for (unsigned j = 0; j < 16; ++j) { const unsigned c = xb_ld(&bar[XB_XCNT(j)]); sum += c; cnt += (c > 0u) ? 1u : 0u; mine = (j == x) ? c : mine; }
        if (sum == G) break;
        __builtin_amdgcn_s_sleep(1);
        if ((++sp & 255u) == 0u) { if (xb_ld(&bar[XB_TMO])) break; if (sp > XB_SPIN_CAP) { atomicAdd(&bar[XB_TMO], 1u); break; } }
    }
    nloc = mine > 0u ? mine : 1u; nx = cnt > 0u ? cnt : 1u;
}

__device__ __forceinline__ void xcd_barrier(const XcdBarrier& b) {
    asm volatile("s_waitcnt vmcnt(0)" ::: "memory");
    __syncthreads();
    if (threadIdx.x == 0) {
        unsigned* bar = b.bar;
        __builtin_amdgcn_s_waitcnt(0);
        unsigned nloc = b.st[0], nx = b.st[1];
        if (nloc == 0u) { xcd_barrier_complete(bar, b.x, nloc, nx); b.st[0] = nloc; b.st[1] = nx; }
        const unsigned old = xb_add(&bar[XB_XSUB(b.x)], 1u);
        const unsigned gen = old / nloc;
        if (old + 1u == (gen + 1u) * nloc) {
            __builtin_amdgcn_fence(__ATOMIC_RELEASE, "agent");
            asm volatile("s_waitcnt vmcnt(0)" ::: "memory");
            const unsigned og = xb_add(&bar[XB_TOP], 1u);
            const unsigned tg = og / nx;
            if (og + 1u == (tg + 1u) * nx) xb_add(&bar[XB_TOPGEN], 1u);
            else XB_SPIN(xb_ld(&bar[XB_TOPGEN]) == tg, bar);
            __builtin_amdgcn_fence(__ATOMIC_ACQUIRE, "agent");
            xb_add(&bar[XB_XGEN(b.x)], 1u);
            asm volatile("s_waitcnt vmcnt(0)" ::: "memory");
        } else {
            XB_SPIN(xb_ld(&bar[XB_XGEN(b.x)]) == gen, bar);
            __builtin_amdgcn_fence(__ATOMIC_ACQUIRE, "agent");
            asm volatile("s_waitcnt vmcnt(0)" ::: "memory");
        }
    }
    __syncthreads();
}
typedef unsigned u32x2v __attribute__((ext_vector_type(2)));
typedef float f32x2v __attribute__((ext_vector_type(2)));

constexpr int MP = 16384, MROWS = 16640, DMODEL = 1024, DFF = 2816, NBLK64 = MROWS / 64;
constexpr float RMS_EPS = 1e-6f;
constexpr size_t OFF_Y = 0, OFF_WKP = (size_t)MROWS * 1024, OFF_WVP = OFF_WKP + 65536, OFF_SRP = OFF_WVP + 65536, OFF_SIP = OFF_SRP + 8192,
    OFF_CMP = OFF_SIP + 8192, OFF_CFP = OFF_CMP + 8192, OFF_MKP = OFF_CFP + 45056, OFF_MVP = OFF_MKP + 2097152, OFF_WKS = OFF_MVP + 2097152,
    OFF_WVS = OFF_WKS + 32768, OFF_SRS = OFF_WVS + 32768, OFF_SIS = OFF_SRS + 16384, OFF_CMS = OFF_SIS + 16384, OFF_CFS = OFF_CMS + 16384;
constexpr size_t MiB = 1u << 20;
constexpr size_t WS_ROWSS = 0, WS_BAR = 512 * 1024, CTL_ZERO_BYTES = 1 * MiB;
constexpr size_t WS_ROPE = 1 * MiB, WS_SSM = 2 * MiB, WS_CKV = 3 * MiB, WS_SLOC = 4 * MiB, WS_MEMK = 8 * MiB, WS_MEMVT = 20 * MiB, WS_SIDE = 32 * MiB;
constexpr size_t SG_BYTES = (size_t)NBLK64 * 8 * DFF * 4, SV_BYTES = (size_t)NBLK64 * 4 * DFF * 4;
static_assert(WS_SIDE + SG_BYTES + SV_BYTES <= 66 * MiB, "side buffers");
constexpr size_t WS_WT = 66 * MiB, WS_XB = 128 * MiB, WS_TMP = 161 * MiB;
constexpr size_t WT_INEVEN = 0, WT_GLU = WT_INEVEN + 1280 * 1024, WT_OUTEVEN = WT_GLU + 512 * 512, WT_WQ = WT_OUTEVEN + 1024 * 1024, WT_WKV = WT_WQ + 2 * 1024 * 1024,
    WT_WO = WT_WKV + 2 * 2048 * 1024, WT_UP = WT_WO + 2 * 1024 * 1024, WT_DOWN = WT_UP + (size_t)2 * 5632 * 1024, WT_INODD = WT_DOWN + (size_t)2 * 2816 * 1024,
    WT_OUTODD = WT_INODD + 3072 * 1024, WT_END = WT_OUTODD + 1024 * 1024;
static_assert(WS_WT + WT_END * 2 <= WS_XB, "weights");
static_assert(WS_XB + (size_t)MROWS * 1024 * 2 <= WS_TMP, "xb");
constexpr size_t TMP_BYTES = (size_t)MROWS * DFF * 2;
constexpr size_t WS_PART = 251 * MiB, PART_ELEMS = (size_t)MROWS * 16;
static_assert(WS_PART + 2 * PART_ELEMS * 4 <= 256 * MiB, "part");
static_assert(WS_TMP + TMP_BYTES <= 256 * MiB, "ws");
constexpr size_t TMP_PROJ0 = 0, TMP_GBUF = (size_t)MROWS * 1280 * 2, TMP_YCAT = TMP_GBUF + (size_t)MROWS * 512 * 2, TMP_MEMB = TMP_YCAT;
static_assert(TMP_YCAT + (size_t)MROWS * 1024 * 2 <= TMP_BYTES, "tmp");
constexpr size_t TMP_QX = 0, TMP_OX = (size_t)MROWS * 1024 * 2, TMP_ACT = 0, TMP_GB = 0, TMP_ZC = (size_t)MROWS * 1024 * 2;
constexpr int LDS_BYTES = 147456, MISC_OFF = 147456 - 512;
constexpr int NPH = 22;

#define MFMA16(a, b, c) __builtin_amdgcn_mfma_f32_16x16x32_bf16(a, b, c, 0, 0, 0)
__device__ __forceinline__ float bflo(unsigned w) { return __uint_as_float(w << 16); }
__device__ __forceinline__ float bfhi(unsigned w) { return __uint_as_float(w & 0xffff0000u); }
__device__ __forceinline__ v4u pack8(f32x4 a, f32x4 b) { v4u w; w.x = pg8::cvt_pk_bf16(a[0], a[1]); w.y = pg8::cvt_pk_bf16(a[2], a[3]); w.z = pg8::cvt_pk_bf16(b[0], b[1]); w.w = pg8::cvt_pk_bf16(b[2], b[3]); return w; }
__device__ __forceinline__ float rstd_of(const float* part, int row) { const f32x4* p = (const f32x4*)(part + (size_t)row * 16); const f32x4 a = p[0] + p[1] + p[2] + p[3]; return rsqrtf(((a[0] + a[1]) + (a[2] + a[3])) * (1.0f / 1024.0f) + RMS_EPS); }
__device__ __forceinline__ float sigmoidf_(float x) { return 1.0f / (1.0f + __expf(-x)); }
__device__ __forceinline__ float dpp_ror1(float v) { return __builtin_bit_cast(float, __builtin_amdgcn_update_dpp(0, __builtin_bit_cast(int, v), 0x121, 0xf, 0xf, false)); }
__device__ __forceinline__ float dpp_ror2(float v) { return __builtin_bit_cast(float, __builtin_amdgcn_update_dpp(0, __builtin_bit_cast(int, v), 0x122, 0xf, 0xf, false)); }
__device__ __forceinline__ float wave_sum(float v) {
#pragma unroll
    for (int o = 1; o < 64; o <<= 1) v += __shfl_xor(v, o);
    return v;
}

typedef pg8::Unit Unit;
#define EPI_ARGS const f32x4 (&acc)[2][2][4][2], const Unit& u, int wr, int wc, int fr, int fq

struct EpiBf16 {
    static constexpr bool PERM = true, AFTER_DRAIN = false;
    bf16* O; int ldc; const float* rowss;
    __device__ __forceinline__ void operator()(EPI_ARGS) const {
        const int row0 = u.pm * 256 + wr * 64 + fr, col0 = u.pn * 256 + wc * 32 + 8 * fq;
#pragma unroll
        for (int ai = 0; ai < 2; ++ai)
#pragma unroll
            for (int m = 0; m < 4; ++m) { const int row = row0 + ai * 128 + m * 16; const float rs = rstd_of(rowss, row); bf16* rp = O + (size_t)row * ldc + col0;
#pragma unroll
                for (int bj = 0; bj < 2; ++bj) *(v4u*)(rp + bj * 128) = pack8(acc[ai][bj][m][0] * rs, acc[ai][bj][m][1] * rs); }
    }
};
struct EpiRes {
    static constexpr bool PERM = true, AFTER_DRAIN = false;
    const float* base_p; const float* base_s; bf16* xb; float* rowss_next; int f32base;
    __device__ __forceinline__ void operator()(EPI_ARGS) const {
        const float* base = u.pm < 64 ? base_p : base_s;
        const int row0 = u.pm * 256 + wr * 64 + fr, col0 = u.pn * 256 + wc * 32 + 8 * fq;
#pragma unroll
        for (int ai = 0; ai < 2; ++ai)
#pragma unroll
            for (int m = 0; m < 4; ++m) { const int row = row0 + ai * 128 + m * 16; const size_t off = (size_t)row * 1024 + col0; float ss = 0.f;
#pragma unroll
                for (int bj = 0; bj < 2; ++bj) { f32x4 b0, b1;
                    if (f32base) { b0 = *(const f32x4*)(base + off + bj * 128); b1 = *(const f32x4*)(base + off + bj * 128 + 4); }
                    else { const v4u w = *(const v4u*)(xb + off + bj * 128); b0 = (f32x4){bflo(w.x), bfhi(w.x), bflo(w.y), bfhi(w.y)}; b1 = (f32x4){bflo(w.z), bfhi(w.z), bflo(w.w), bfhi(w.w)}; }
                    const f32x4 v0 = acc[ai][bj][m][0] + b0, v1 = acc[ai][bj][m][1] + b1;
                    *(v4u*)(xb + off + bj * 128) = pack8(v0, v1);
                    ss += (v0[0] * v0[0] + v0[1] * v0[1]) + (v0[2] * v0[2] + v0[3] * v0[3]) + (v1[0] * v1[0] + v1[1] * v1[1]) + (v1[2] * v1[2] + v1[3] * v1[3]); }
                ss += __shfl_xor(ss, 16); ss += __shfl_xor(ss, 32);
                if (fq == 0) rowss_next[(size_t)row * 16 + u.pn * 4 + wc] = ss; }
    }
};
struct EpiGlu {
    static constexpr bool PERM = true, AFTER_DRAIN = false;
    const bf16* g; bf16* ycat;
    __device__ __forceinline__ void operator()(EPI_ARGS) const {
        const int row0 = u.pm * 256 + wr * 64 + fr, col0 = u.pn * 256 + wc * 32 + 8 * fq;
#pragma unroll
        for (int ai = 0; ai < 2; ++ai)
#pragma unroll
            for (int m = 0; m < 4; ++m) { const int row = row0 + ai * 128 + m * 16;
#pragma unroll
                for (int bj = 0; bj < 2; ++bj) { const int col = col0 + bj * 128; const v4u gw = *(const v4u*)(g + (size_t)row * 512 + col);
                    const f32x4 a0 = acc[ai][bj][m][0], a1 = acc[ai][bj][m][1]; f32x4 o0, o1;
                    o0[0] = bflo(gw.x) * sigmoidf_(a0[0]); o0[1] = bfhi(gw.x) * sigmoidf_(a0[1]); o0[2] = bflo(gw.y) * sigmoidf_(a0[2]); o0[3] = bfhi(gw.y) * sigmoidf_(a0[3]);
                    o1[0] = bflo(gw.z) * sigmoidf_(a1[0]); o1[1] = bfhi(gw.z) * sigmoidf_(a1[1]); o1[2] = bflo(gw.w) * sigmoidf_(a1[2]); o1[3] = bfhi(gw.w) * sigmoidf_(a1[3]);
                    *(v4u*)(ycat + (size_t)row * 1024 + col) = pack8(o0, o1); } }
    }
};
struct EpiKV {
    static constexpr bool PERM = true, AFTER_DRAIN = false;
    float* out; bf16* memk;
    __device__ __forceinline__ void operator()(EPI_ARGS) const {
        const int row0 = u.pm * 256 + wr * 64 + fr, col0 = u.pn * 256 + wc * 32 + 8 * fq;
#pragma unroll
        for (int ai = 0; ai < 2; ++ai)
#pragma unroll
            for (int m = 0; m < 4; ++m) { const int row = row0 + ai * 128 + m * 16;
#pragma unroll
                for (int bj = 0; bj < 2; ++bj) { const int c = col0 + bj * 128, l = c >> 11, e = c & 2047, isv = e >> 10, dc = e & 1023;
                    float* op = out + (isv ? OFF_MVP : OFF_MKP) + (size_t)l * 1048576 + (size_t)row * 1024 + dc;
                    *(f32x4*)op = acc[ai][bj][m][0]; *(f32x4*)(op + 4) = acc[ai][bj][m][1];
                    if (!isv) *(v4u*)(memk + (size_t)l * 12 * 262144 + (size_t)row * 1024 + dc) = pack8(acc[ai][bj][m][0], acc[ai][bj][m][1]); } }
    }
};
struct EpiIn0 {
    static constexpr bool PERM = true, AFTER_DRAIN = false;
    bf16* proj; const float* rowss; const float* ropec; const float* ropes; float* out;
    __device__ __forceinline__ void operator()(EPI_ARGS) const {
        const int pn = u.pn;
#pragma unroll
        for (int ai = 0; ai < 2; ++ai)
#pragma unroll
            for (int m = 0; m < 4; ++m) { const int row = u.pm * 256 + ai * 128 + wr * 64 + m * 16 + fr; const float rs = rstd_of(rowss, row);
                const int pos = row < MP ? (row & 4095) : 2048 + (row & 31);
                bf16* rp = proj + (size_t)row * 1280;
                float* wk = nullptr; float* wv = nullptr;
                if (pn == 4) { if (row >= MP) { wk = out + OFF_WKS + (size_t)(row - MP) * 128; wv = out + OFF_WVS + (size_t)(row - MP) * 128; }
                               else if ((row & 4095) >= 3968) { const size_t o = (size_t)((row >> 12) * 128 + (row & 4095) - 3968) * 128; wk = out + OFF_WKP + o; wv = out + OFF_WVP + o; } }
#pragma unroll
                for (int bj = 0; bj < 2; ++bj) { const f32x4 v0 = acc[ai][bj][m][0] * rs, v1 = acc[ai][bj][m][1] * rs;
                    const bool rope = (pn == 2 || pn == 3 || (pn == 4 && bj == 0));
                    if (!rope) { const int col = pn * 256 + bj * 128 + wc * 32 + 8 * fq; *(v4u*)(rp + col) = pack8(v0, v1);
                        if (pn == 4 && wv) { *(f32x4*)(wv + wc * 32 + 8 * fq) = v0; *(f32x4*)(wv + wc * 32 + 8 * fq + 4) = v1; } }
                    else { const int gbase = pn * 256 + bj * 128 + (wc >> 1) * 64, d1 = 16 * (wc & 1) + 4 * fq;
                        const f32x4 c4 = *(const f32x4*)(ropec + pos * 32 + d1), s4 = *(const f32x4*)(ropes + pos * 32 + d1);
                        f32x4 o1 = v0 * c4 - v1 * s4, o2 = v1 * c4 + v0 * s4;
                        if (pn != 4) { o1 = o1 * 0.125f; o2 = o2 * 0.125f; }
                        u32x2v w1, w2; w1.x = pg8::cvt_pk_bf16(o1[0], o1[1]); w1.y = pg8::cvt_pk_bf16(o1[2], o1[3]); w2.x = pg8::cvt_pk_bf16(o2[0], o2[1]); w2.y = pg8::cvt_pk_bf16(o2[2], o2[3]);
                        *(u32x2v*)(rp + gbase + d1) = w1; *(u32x2v*)(rp + gbase + d1 + 32) = w2;
                        if (pn == 4 && wk) { const int cc = (wc >> 1) * 64 + d1; *(f32x4*)(wk + cc) = o1; *(f32x4*)(wk + cc + 32) = o2; } } } }
    }
};
struct EpiFfnUp {
    static constexpr bool PERM = true, AFTER_DRAIN = false;
    bf16* act; const float* rowss; const float* cw; float* SG; float* SV;
    __device__ __forceinline__ void operator()(EPI_ARGS) const {
        const int c0 = u.pn * 128 + wc * 32 + 8 * fq; const bool sample = u.pm == 64;
        const f32x4 w0a = *(const f32x4*)(cw + c0), w0b = *(const f32x4*)(cw + c0 + 4), w1a = *(const f32x4*)(cw + DFF + c0), w1b = *(const f32x4*)(cw + DFF + c0 + 4),
                    w2a = *(const f32x4*)(cw + 2 * DFF + c0), w2b = *(const f32x4*)(cw + 2 * DFF + c0 + 4);
#pragma unroll
        for (int ai = 0; ai < 2; ++ai) { f32x4 gp0 = {0.f, 0.f, 0.f, 0.f}, gp1 = {0.f, 0.f, 0.f, 0.f}; const int blk = u.pm * 4 + ai * 2 + wr;
#pragma unroll
            for (int m = 0; m < 4; ++m) { const int row = u.pm * 256 + ai * 128 + wr * 64 + m * 16 + fr; const float rs = rstd_of(rowss, row);
                const f32x4 g0 = acc[ai][0][m][0] * rs, g1 = acc[ai][0][m][1] * rs, v0 = acc[ai][1][m][0] * rs, v1 = acc[ai][1][m][1] * rs;
                f32x4 p1a, p2a, p1b, p2b;
#pragma unroll
                for (int j = 0; j < 4; ++j) { const float s1a = fr == 15 ? gp0[j] : g0[j], s2a = fr >= 14 ? gp0[j] : g0[j], s1b = fr == 15 ? gp1[j] : g1[j], s2b = fr >= 14 ? gp1[j] : g1[j];
                    p1a[j] = dpp_ror1(s1a); p2a[j] = dpp_ror2(s2a); p1b[j] = dpp_ror1(s1b); p2b[j] = dpp_ror2(s2b); }
                const f32x4 ca = w0a * p2a + w1a * p1a + w2a * g0, cb = w0b * p2b + w1b * p1b + w2b * g1;
                f32x4 sa, sb;
#pragma unroll
                for (int j = 0; j < 4; ++j) { sa[j] = sigmoidf_(ca[j]); sb[j] = sigmoidf_(cb[j]); }
                const f32x4 a0 = ca * sa * v0, a1 = cb * sb * v1;
                const bool valid = (m > 0 || fr >= 2) && !(sample && m == 2 && fr < 2);
                if (valid) *(v4u*)(act + (size_t)row * DFF + c0) = pack8(a0, a1);
                if ((m & 1) == 0 && fr < 2) { float* sg = SG + (size_t)(blk * 8 + 2 * m + fr) * DFF + c0; *(f32x4*)sg = g0; *(f32x4*)(sg + 4) = g1;
                                              float* sv = SV + (size_t)(blk * 4 + m + fr) * DFF + c0; *(f32x4*)sv = v0; *(f32x4*)(sv + 4) = v1; }
                if ((m & 1) == 1 && fr >= 14) { float* sg = SG + (size_t)(blk * 8 + 2 * m + fr - 14) * DFF + c0; *(f32x4*)sg = g0; *(f32x4*)(sg + 4) = g1; }
                gp0 = g0; gp1 = g1; } }
    }
};
struct EpiInOdd {
    static constexpr bool PERM = true, AFTER_DRAIN = false;
    bf16* gb; bf16* zc; const float* rowss; const float* cw; float* SG;
    __device__ __forceinline__ void operator()(EPI_ARGS) const {
        if (u.pn < 4) {
            const int row0 = u.pm * 256 + wr * 64 + fr, col0 = u.pn * 256 + wc * 32 + 8 * fq;
#pragma unroll
            for (int ai = 0; ai < 2; ++ai)
#pragma unroll
                for (int m = 0; m < 4; ++m) { const int row = row0 + ai * 128 + m * 16; const float rs = rstd_of(rowss, row); bf16* rp = gb + (size_t)row * 1024 + col0;
#pragma unroll
                    for (int bj = 0; bj < 2; ++bj) *(v4u*)(rp + bj * 128) = pack8(acc[ai][bj][m][0] * rs, acc[ai][bj][m][1] * rs); }
            return;
        }
        const int c0 = (u.pn - 4) * 128 + wc * 32 + 8 * fq; const bool sample = u.pm == 64;
        const f32x4 w0a = *(const f32x4*)(cw + c0), w0b = *(const f32x4*)(cw + c0 + 4), w1a = *(const f32x4*)(cw + 1024 + c0), w1b = *(const f32x4*)(cw + 1024 + c0 + 4),
                    w2a = *(const f32x4*)(cw + 2048 + c0), w2b = *(const f32x4*)(cw + 2048 + c0 + 4);
#pragma unroll
        for (int ai = 0; ai < 2; ++ai) { f32x4 gp0 = {0.f, 0.f, 0.f, 0.f}, gp1 = {0.f, 0.f, 0.f, 0.f}; const int blk = u.pm * 4 + ai * 2 + wr;
#pragma unroll
            for (int m = 0; m < 4; ++m) { const int row = u.pm * 256 + ai * 128 + wr * 64 + m * 16 + fr; const float rs = rstd_of(rowss, row); const float rs2 = rs * rs;
                const f32x4 g0 = acc[ai][0][m][0] * acc[ai][1][m][0] * rs2, g1 = acc[ai][0][m][1] * acc[ai][1][m][1] * rs2;
                f32x4 p1a, p2a, p1b, p2b;
#pragma unroll
                for (int j = 0; j < 4; ++j) { const float s1a = fr == 15 ? gp0[j] : g0[j], s2a = fr >= 14 ? gp0[j] : g0[j], s1b = fr == 15 ? gp1[j] : g1[j], s2b = fr >= 14 ? gp1[j] : g1[j];
                    p1a[j] = dpp_ror1(s1a); p2a[j] = dpp_ror2(s2a); p1b[j] = dpp_ror1(s1b); p2b[j] = dpp_ror2(s2b); }
                const f32x4 a0 = w0a * p2a + w1a * p1a + w2a * g0, a1 = w0b * p2b + w1b * p1b + w2b * g1;
                const bool valid = (m > 0 || fr >= 2) && !(sample && m == 2 && fr < 2);
                if (valid) *(v4u*)(zc + (size_t)row * 1024 + c0) = pack8(a0, a1);
                if ((m & 1) == 0 && fr < 2) { float* sg = SG + (size_t)(blk * 8 + 2 * m + fr) * 1024 + c0; *(f32x4*)sg = g0; *(f32x4*)(sg + 4) = g1; }
                if ((m & 1) == 1 && fr >= 14) { float* sg = SG + (size_t)(blk * 8 + 2 * m + fr - 14) * 1024 + c0; *(f32x4*)sg = g0; *(f32x4*)(sg + 4) = g1; }
                gp0 = g0; gp1 = g1; } }
    }
};


struct EpiCz {
    static constexpr bool PERM = true, AFTER_DRAIN = false;
    bf16* gb; const float* rowss; const float* cw; float* SG;
    __device__ __forceinline__ void operator()(EPI_ARGS) const {
        const int c0 = u.pn * 128 + wc * 32 + 8 * fq;
        const f32x4 w0a = *(const f32x4*)(cw + c0), w0b = *(const f32x4*)(cw + c0 + 4), w1a = *(const f32x4*)(cw + 1024 + c0), w1b = *(const f32x4*)(cw + 1024 + c0 + 4),
                    w2a = *(const f32x4*)(cw + 2048 + c0), w2b = *(const f32x4*)(cw + 2048 + c0 + 4);
#pragma unroll
        for (int ai = 0; ai < 2; ++ai) { f32x4 gp0 = {0.f, 0.f, 0.f, 0.f}, gp1 = {0.f, 0.f, 0.f, 0.f}; const int blk = u.pm * 4 + ai * 2 + wr;
#pragma unroll
            for (int m = 0; m < 4; ++m) { const int row = u.pm * 256 + ai * 128 + wr * 64 + m * 16 + fr; const float rs = rstd_of(rowss, row); const float rs2 = rs * rs;
                const f32x4 g0 = acc[ai][0][m][0] * acc[ai][1][m][0] * rs2, g1 = acc[ai][0][m][1] * acc[ai][1][m][1] * rs2;
                f32x4 p1a, p2a, p1b, p2b;
#pragma unroll
                for (int j = 0; j < 4; ++j) { const float s1a = fr == 15 ? gp0[j] : g0[j], s2a = fr >= 14 ? gp0[j] : g0[j], s1b = fr == 15 ? gp1[j] : g1[j], s2b = fr >= 14 ? gp1[j] : g1[j];
                    p1a[j] = dpp_ror1(s1a); p2a[j] = dpp_ror2(s2a); p1b[j] = dpp_ror1(s1b); p2b[j] = dpp_ror2(s2b); }
                const f32x4 a0 = w0a * p2a + w1a * p1a + w2a * g0, a1 = w0b * p2b + w1b * p1b + w2b * g1;
                if (m > 0 || fr >= 2) { bf16* gp = gb + (size_t)row * 1024 + c0; const v4u gw = *(const v4u*)gp;
                    const f32x4 b0 = (f32x4){bflo(gw.x), bfhi(gw.x), bflo(gw.y), bfhi(gw.y)}, b1 = (f32x4){bflo(gw.z), bfhi(gw.z), bflo(gw.w), bfhi(gw.w)};
                    *(v4u*)gp = pack8(a0 * b0, a1 * b1); }
                if ((m & 1) == 0 && fr < 2) { float* sg = SG + (size_t)(blk * 8 + 2 * m + fr) * 1024 + c0; *(f32x4*)sg = g0; *(f32x4*)(sg + 4) = g1; }
                if ((m & 1) == 1 && fr >= 14) { float* sg = SG + (size_t)(blk * 8 + 2 * m + fr - 14) * 1024 + c0; *(f32x4*)sg = g0; *(f32x4*)(sg + 4) = g1; }
                gp0 = g0; gp1 = g1; } }
    }
};

__device__ __forceinline__ int rowmap(int mode, int n) {
    if (mode == 1) { if (n >= 512 && n < 1152) { const int d = n & 63; return (n & ~63) | (32 * ((d >> 4) & 1) + 8 * ((d >> 2) & 3) + 4 * (d >> 5) + (d & 3)); } return n; }
    if (mode == 2) { return n < DFF ? ((n >> 7) * 256 + (n & 127)) : (((n - DFF) >> 7) * 256 + 128 + ((n - DFF) & 127)); }
    if (mode == 3) { if (n < 1024) return n; const int c = (n - 1024) & 1023, z = n >= 2048 ? 1 : 0; return 1024 + (c >> 7) * 256 + z * 128 + (c & 127); }
    return n;
}
__device__ __forceinline__ void tr_item(const float* W, int K, int N, bf16* WT, const float* gain, float scale, int mode, LAS float* scr, int item, int lane) {
    const int nblk = N / 32, kb = item / nblk, nb = item % nblk, k0 = 64 * kb, n0 = 32 * nb;
#pragma unroll
    for (int i = 0; i < 8; ++i) { const int idx = lane + 64 * i, kk = idx >> 3, n4 = (idx & 7) * 4; const float gs = gain ? ((const GAS float*)gain)[k0 + kk] * scale : scale;
        const f32x4 w = __builtin_nontemporal_load((const GAS f32x4*)((const GAS float*)W + (size_t)(k0 + kk) * N + n0 + n4)); LAS float* d = scr + kk * 33 + n4; d[0] = w[0] * gs; d[1] = w[1] * gs; d[2] = w[2] * gs; d[3] = w[3] * gs; }
    LDS_WAIT(); asm volatile("" ::: "memory");
    const int c = lane & 7;
#pragma unroll
    for (int j = 0; j < 4; ++j) { const int n = (lane >> 3) + 8 * j; const LAS float* s = scr + (8 * c) * 33 + n;
        v4u o; o.x = pg8::cvt_pk_bf16(s[0 * 33], s[1 * 33]); o.y = pg8::cvt_pk_bf16(s[2 * 33], s[3 * 33]); o.z = pg8::cvt_pk_bf16(s[4 * 33], s[5 * 33]); o.w = pg8::cvt_pk_bf16(s[6 * 33], s[7 * 33]);
        *(GAS v4u*)((GAS bf16*)WT + (size_t)rowmap(mode, n0 + n) * K + k0 + 8 * c) = o; }
    LDS_WAIT(); asm volatile("" ::: "memory");
}
__device__ __forceinline__ double dexp_(double y) {
    const double k = rint(y * 1.4426950408889634); const double r = (y - k * 0.6931471803691238) - k * 1.9082149292705877e-10;
    double p = 1.0 / 6227020800.0;
    p = p * r + 1.0 / 479001600.0; p = p * r + 1.0 / 39916800.0; p = p * r + 1.0 / 3628800.0; p = p * r + 1.0 / 362880.0; p = p * r + 1.0 / 40320.0; p = p * r + 1.0 / 5040.0;
    p = p * r + 1.0 / 720.0; p = p * r + 1.0 / 120.0; p = p * r + 1.0 / 24.0; p = p * r + 1.0 / 6.0; p = p * r + 0.5; p = p * r + 1.0; p = p * r + 1.0;
    const long long bits = (long long)(1023 + (int)k) << 52; return p * __builtin_bit_cast(double, bits);
}
__device__ __forceinline__ void dsincos_(double x, double& s, double& c) {
    const double k = rint(x * 0.6366197723675814); const double r = (x - k * 1.5707963267948966) - k * 6.123233995736766e-17; const double r2 = r * r;
    const double sp = r * (1.0 + r2 * (-1.0 / 6.0 + r2 * (1.0 / 120.0 + r2 * (-1.0 / 5040.0 + r2 * (1.0 / 362880.0 + r2 * (-1.0 / 39916800.0 + r2 * (1.0 / 6227020800.0)))))));
    const double cp = 1.0 + r2 * (-0.5 + r2 * (1.0 / 24.0 + r2 * (-1.0 / 720.0 + r2 * (1.0 / 40320.0 + r2 * (-1.0 / 3628800.0 + r2 * (1.0 / 479001600.0 + r2 * (-1.0 / 87178291200.0)))))));
    const int q = ((int)k) & 3;
    s = q == 0 ? sp : q == 1 ? cp : q == 2 ? -sp : -cp; c = q == 0 ? cp : q == 1 ? -sp : q == 2 ? -cp : sp;
}

__device__ __forceinline__ const bf16* kvptr(const bf16* proj, const bf16* cb, int sample, int b, int c, int kvh, int kk, int isv) {
    if (!sample) { int pos = (c - 2) * 64 + kk; pos = pos < 0 ? 0 : pos; return proj + (size_t)(b * 4096 + pos) * 1280 + 1024 + isv * 128 + kvh * 64; }
    if (kk < 128) return cb + (size_t)(b * 128 + kk) * 128 + kvh * 64;
    int t = kk - 128; t = t > 31 ? 31 : t; return proj + (size_t)(MP + b * 32 + t) * 1280 + 1024 + isv * 128 + kvh * 64;
}
__device__ __forceinline__ void swa_phase(const bf16* proj, const bf16* ckb, const bf16* cvb, const float* sinks, bf16* ycat, LAS unsigned char* lds, int tid, int wave, int lane, int G) {
    LAS bf16* VT = (LAS bf16*)lds;
    const int fr = lane & 15, quad = lane >> 4;
    for (int it = blockIdx.x; it < 528; it += G) {
        int b, c, kvh, sample;
        if (it < 512) { sample = 0; b = it >> 7; c = (it >> 1) & 63; kvh = it & 1; } else { sample = 1; b = (it - 512) >> 1; c = 0; kvh = it & 1; }
        const int gq = wave >> 1, qhalf = wave & 1, head = kvh * 4 + gq;
        bf16x8 qf[2][2], kf0[4][2];
#pragma unroll
        for (int qb = 0; qb < 2; ++qb) { const int q = qhalf * 32 + qb * 16 + fr; const int row = sample ? MP + b * 32 + (q & 31) : b * 4096 + c * 64 + q;
            const GAS bf16* qp = (const GAS bf16*)proj + (size_t)row * 1280 + 512 + head * 64 + quad * 8; qf[qb][0] = *(const GAS bf16x8*)qp; qf[qb][1] = *(const GAS bf16x8*)(qp + 32); }
#pragma unroll
        for (int i = 0; i < 4; ++i) { const int key = 32 * (i >> 1) + (fr >> 2) * 8 + 4 * (i & 1) + (fr & 3); const GAS bf16* kp = (const GAS bf16*)kvptr(proj, ckb, sample, b, c, kvh, key, 0) + quad * 8;
            kf0[i][0] = *(const GAS bf16x8*)kp; kf0[i][1] = *(const GAS bf16x8*)(kp + 32); }
        __syncthreads();
#pragma unroll
        for (int i = 0; i < 3; ++i) { const int idx = tid + 512 * i, kk = idx % 192, dg = idx / 192; const v4u w = *(const GAS v4u*)((const GAS bf16*)kvptr(proj, cvb, sample, b, c, kvh, kk, 1) + dg * 8);
            LAS bf16* vp = VT + (dg * 8) * 200 + kk;
            vp[0] = (bf16)(w.x & 0xffffu); vp[200] = (bf16)(w.x >> 16); vp[400] = (bf16)(w.y & 0xffffu); vp[600] = (bf16)(w.y >> 16);
            vp[800] = (bf16)(w.z & 0xffffu); vp[1000] = (bf16)(w.z >> 16); vp[1200] = (bf16)(w.w & 0xffffu); vp[1400] = (bf16)(w.w >> 16); }
        __syncthreads();
        if (!(sample && qhalf)) {
            const int plo = sample ? 0 : (c >= 2 ? 0 : (2 - c) * 2), phi = sample ? 5 : 6;
            f32x4 s[12][2];
#pragma unroll
            for (int kg = 0; kg < 3; ++kg) { bf16x8 kf[4][2];
#pragma unroll
                for (int i = 0; i < 4; ++i) { if (kg == 0) { kf[i][0] = kf0[i][0]; kf[i][1] = kf0[i][1]; continue; } const int kb = kg * 4 + i, key = 32 * (kb >> 1) + (fr >> 2) * 8 + 4 * (kb & 1) + (fr & 3); const GAS bf16* kp = (const GAS bf16*)kvptr(proj, ckb, sample, b, c, kvh, key, 0) + quad * 8;
                    kf[i][0] = *(const GAS bf16x8*)kp; kf[i][1] = *(const GAS bf16x8*)(kp + 32); }
                __builtin_amdgcn_sched_barrier(0);
#pragma unroll
                for (int i = 0; i < 4; ++i)
#pragma unroll
                    for (int qb = 0; qb < 2; ++qb) { f32x4 a = {0.f, 0.f, 0.f, 0.f}; a = MFMA16(kf[i][0], qf[qb][0], a); a = MFMA16(kf[i][1], qf[qb][1], a); s[kg * 4 + i][qb] = a; }
                __builtin_amdgcn_sched_barrier(0); }
            const float sink = sinks[head];
            bf16x8 pf[6][2];
#pragma unroll
            for (int qb = 0; qb < 2; ++qb) { float mx = sink;
#pragma unroll
                for (int kb = 0; kb < 12; ++kb) { const bool pv = (kb >> 1) >= plo && (kb >> 1) < phi;
#pragma unroll
                    for (int j = 0; j < 4; ++j) { const float v = pv ? s[kb][qb][j] : -1e30f; s[kb][qb][j] = v; mx = fmaxf(mx, v); } }
                mx = fmaxf(mx, __shfl_xor(mx, 16)); mx = fmaxf(mx, __shfl_xor(mx, 32));
                float sum = 0.f;
#pragma unroll
                for (int kb = 0; kb < 12; ++kb)
#pragma unroll
                    for (int j = 0; j < 4; ++j) { const float e = __expf(s[kb][qb][j] - mx); s[kb][qb][j] = e; sum += e; }
                sum += __shfl_xor(sum, 16); sum += __shfl_xor(sum, 32); sum += __expf(sink - mx);
                const float inv = 1.0f / sum;
#pragma unroll
                for (int pr = 0; pr < 6; ++pr) pf[pr][qb] = __builtin_bit_cast(bf16x8, pack8(s[2 * pr][qb] * inv, s[2 * pr + 1][qb] * inv)); }
#pragma unroll
            for (int db = 0; db < 4; ++db) { bf16x8 vf[6];
#pragma unroll
                for (int pr = 0; pr < 6; ++pr) vf[pr] = *(const LAS bf16x8*)(VT + (db * 16 + fr) * 200 + 32 * pr + quad * 8);
#pragma unroll
                for (int qb = 0; qb < 2; ++qb) { f32x4 o = {0.f, 0.f, 0.f, 0.f};
#pragma unroll
                    for (int pr = 0; pr < 6; ++pr) o = MFMA16(pf[pr][qb], vf[pr], o);
#pragma unroll
                    for (int j = 0; j < 4; ++j) { const int q = qhalf * 32 + qb * 16 + quad * 4 + j;
                        if (!sample || q < 32) { const int row = sample ? MP + b * 32 + q : b * 4096 + c * 64 + q; ycat[(size_t)row * 1024 + 512 + head * 64 + db * 16 + fr] = (bf16)f2bf(o[j]); } } } }
        }
    }
    __syncthreads();
}

__device__ __forceinline__ void xattn_phase(const bf16* qx, const bf16* memk_l, const bf16* memvT_l, bf16* ox, int wave, int lane, int G) {
    const int fr = lane & 15, quad = lane >> 4;
    for (int t = wave * G + (int)blockIdx.x; t < 4160; t += 8 * G) {
        int bb, h, row0;
        if (t < 4096) { const int pair = t >> 8; bb = pair >> 2; h = pair & 3; row0 = bb * 4096 + (t & 255) * 16; }
        else { const int s = t - 4096, b = s >> 3; h = (s >> 1) & 3; bb = 4 + b; row0 = MP + b * 32 + (s & 1) * 16; }
        bf16x8 qf[8];
#pragma unroll
        for (int ks = 0; ks < 8; ++ks) qf[ks] = *(const bf16x8*)(qx + (size_t)(row0 + fr) * 1024 + h * 256 + ks * 32 + quad * 8);
        const bf16* kbase = memk_l + (size_t)bb * 262144 + h * 256 + quad * 8;
        f32x4 s[16];
#pragma unroll
        for (int kb = 0; kb < 16; ++kb) { const int key = 32 * (kb >> 1) + (fr >> 2) * 8 + 4 * (kb & 1) + (fr & 3); const bf16* kp = kbase + (size_t)key * 1024; f32x4 a = {0.f, 0.f, 0.f, 0.f};
#pragma unroll
            for (int ks = 0; ks < 8; ++ks) a = MFMA16(*(const bf16x8*)(kp + ks * 32), qf[ks], a);
            s[kb] = a; }
        float mx = -1e30f;
#pragma unroll
        for (int kb = 0; kb < 16; ++kb)
#pragma unroll
            for (int j = 0; j < 4; ++j) mx = fmaxf(mx, s[kb][j]);
        mx = fmaxf(mx, __shfl_xor(mx, 16)); mx = fmaxf(mx, __shfl_xor(mx, 32));
        float sum = 0.f;
#pragma unroll
        for (int kb = 0; kb < 16; ++kb)
#pragma unroll
            for (int j = 0; j < 4; ++j) { const float e = __expf(s[kb][j] - mx); s[kb][j] = e; sum += e; }
        sum += __shfl_xor(sum, 16); sum += __shfl_xor(sum, 32);
        const float inv = 1.0f / sum;
        bf16x8 pf[8];
#pragma unroll
        for (int pr = 0; pr < 8; ++pr) pf[pr] = __builtin_bit_cast(bf16x8, pack8(s[2 * pr] * inv, s[2 * pr + 1] * inv));
        const bf16* vbase = memvT_l + (size_t)bb * 262144 + (size_t)(h * 256 + fr) * 256 + quad * 8;
#pragma unroll 4
        for (int db = 0; db < 16; ++db) { f32x4 o = {0.f, 0.f, 0.f, 0.f};
#pragma unroll
            for (int pr = 0; pr < 8; ++pr) o = MFMA16(pf[pr], *(const bf16x8*)(vbase + (size_t)db * 4096 + pr * 32), o);
#pragma unroll
            for (int j = 0; j < 4; ++j) ox[(size_t)(row0 + quad * 4 + j) * 1024 + h * 256 + db * 16 + fr] = (bf16)f2bf(o[j]); }
    }
}


__device__ __forceinline__ void xstage(const bf16* src, size_t rowstride, LAS unsigned char* lds, int tid) {
    v4u t[16];
#pragma unroll
    for (int i = 0; i < 16; ++i) { const int row = (tid >> 5) + 16 * i, ch = tid & 31; t[i] = *(const GAS v4u*)((const GAS bf16*)src + (size_t)row * rowstride + ch * 8); }
#pragma unroll
    for (int i = 0; i < 16; ++i) { const int row = (tid >> 5) + 16 * i, ch = tid & 31; *(LAS v4u*)(lds + row * 528 + ch * 16) = t[i]; }
}
__device__ __forceinline__ void xattn_phase2(const bf16* qx, const bf16* memk_l, const bf16* memvT_l, bf16* ox, LAS unsigned char* lds, int tid, int wave, int lane, int G) {
    const int fr = lane & 15, quad = lane >> 4;
    for (int it = blockIdx.x; it < 256 + 32; it += G) {
        int bb, h, rowbase, nqb; bool active;
        if (it < 256) { bb = it >> 6; h = (it >> 4) & 3; rowbase = bb * 4096 + (it & 15) * 256; nqb = 2; active = true; }
        else { const int s = it - 256, b = s >> 2; h = s & 3; bb = 4 + b; rowbase = MP + b * 32; nqb = 1; active = wave < 2; }
        __syncthreads();
        xstage(memk_l + (size_t)bb * 262144 + h * 256, 1024, lds, tid);
        __syncthreads();
        bf16x8 pf[2][8];
#pragma unroll
        for (int qi = 0; qi < 2; ++qi) {
            if (qi < nqb && active) {
                const int row0 = rowbase + qi * 128 + wave * 16;
                bf16x8 qf[8];
#pragma unroll
                for (int ks = 0; ks < 8; ++ks) qf[ks] = *(const GAS bf16x8*)((const GAS bf16*)qx + (size_t)(row0 + fr) * 1024 + h * 256 + ks * 32 + quad * 8);
                f32x4 s[16];
#pragma unroll
                for (int kb = 0; kb < 16; ++kb) { const int key = 32 * (kb >> 1) + (fr >> 2) * 8 + 4 * (kb & 1) + (fr & 3); const LAS unsigned char* kp = lds + key * 528 + quad * 16; f32x4 a = {0.f, 0.f, 0.f, 0.f};
#pragma unroll
                    for (int ks = 0; ks < 8; ++ks) a = MFMA16(*(const LAS bf16x8*)(kp + ks * 64), qf[ks], a);
                    s[kb] = a; }
                float mx = -1e30f;
#pragma unroll
                for (int kb = 0; kb < 16; ++kb)
#pragma unroll
                    for (int j = 0; j < 4; ++j) mx = fmaxf(mx, s[kb][j]);
                mx = fmaxf(mx, __shfl_xor(mx, 16)); mx = fmaxf(mx, __shfl_xor(mx, 32));
                float sum = 0.f;
#pragma unroll
                for (int kb = 0; kb < 16; ++kb)
#pragma unroll
                    for (int j = 0; j < 4; ++j) { const float e = __expf(s[kb][j] - mx); s[kb][j] = e; sum += e; }
                sum += __shfl_xor(sum, 16); sum += __shfl_xor(sum, 32);
                const float inv = 1.0f / sum;
#pragma unroll
                for (int pr = 0; pr < 8; ++pr) pf[qi][pr] = __builtin_bit_cast(bf16x8, pack8(s[2 * pr] * inv, s[2 * pr + 1] * inv));
            }
        }
        __syncthreads();
        xstage(memvT_l + (size_t)bb * 262144 + (size_t)h * 65536, 256, lds, tid);
        __syncthreads();
        if (active) {
            const int rowA = rowbase + wave * 16, rowB = rowA + 128;
#pragma unroll 4
            for (int db = 0; db < 16; ++db) { f32x4 oa = {0.f, 0.f, 0.f, 0.f}, ob = {0.f, 0.f, 0.f, 0.f}; const LAS unsigned char* vp = lds + (db * 16 + fr) * 528 + quad * 16;
                if (nqb == 2) {
#pragma unroll
                    for (int pr = 0; pr < 8; ++pr) { const bf16x8 vf = *(const LAS bf16x8*)(vp + pr * 64); oa = MFMA16(vf, pf[0][pr], oa); ob = MFMA16(vf, pf[1][pr], ob); }
                } else {
#pragma unroll
                    for (int pr = 0; pr < 8; ++pr) { const bf16x8 vf = *(const LAS bf16x8*)(vp + pr * 64); oa = MFMA16(vf, pf[0][pr], oa); }
                }
                u32x2v w; w.x = pk2(oa[0], oa[1]); w.y = pk2(oa[2], oa[3]);
                *(GAS u32x2v*)((GAS bf16*)ox + (size_t)(rowA + fr) * 1024 + h * 256 + db * 16 + quad * 4) = w;
                if (nqb == 2) { u32x2v w2; w2.x = pk2(ob[0], ob[1]); w2.y = pk2(ob[2], ob[3]); *(GAS u32x2v*)((GAS bf16*)ox + (size_t)(rowB + fr) * 1024 + h * 256 + db * 16 + quad * 4) = w2; } }
        }
    }
    __syncthreads();
}

__device__ __forceinline__ void s5_stage_u(const bf16* up, LAS float* ubuf, int lane) {
    const v4u w0 = *(const v4u*)up, w1 = *(const v4u*)(up + 8);
    LAS f32x4* d = (LAS f32x4*)(ubuf + lane * 16);
    d[0] = (f32x4){bflo(w0.x), bfhi(w0.x), bflo(w0.y), bfhi(w0.y)}; d[1] = (f32x4){bflo(w0.z), bfhi(w0.z), bflo(w0.w), bfhi(w0.w)};
    d[2] = (f32x4){bflo(w1.x), bfhi(w1.x), bflo(w1.y), bfhi(w1.y)}; d[3] = (f32x4){bflo(w1.z), bfhi(w1.z), bflo(w1.w), bfhi(w1.w)};
}
__device__ __forceinline__ f32x2v lo2_(f32x4 v) { return __builtin_shufflevector(v, v, 0, 1); }
__device__ __forceinline__ f32x2v hi2_(f32x4 v) { return __builtin_shufflevector(v, v, 2, 3); }
#define S5_STEP(sidx) do { const LAS f32x4* up_ = (const LAS f32x4*)(ubuf + (sidx) * 16); const f32x4 u0 = up_[0], u1 = up_[1], u2 = up_[2], u3 = up_[3]; \
    f32x2v ac_ = lo2_(bb[0]) * u0[0]; ac_ = hi2_(bb[0]) * u0[1] + ac_; ac_ = lo2_(bb[1]) * u0[2] + ac_; ac_ = hi2_(bb[1]) * u0[3] + ac_; \
    ac_ = lo2_(bb[2]) * u1[0] + ac_; ac_ = hi2_(bb[2]) * u1[1] + ac_; ac_ = lo2_(bb[3]) * u1[2] + ac_; ac_ = hi2_(bb[3]) * u1[3] + ac_; \
    ac_ = lo2_(bb[4]) * u2[0] + ac_; ac_ = hi2_(bb[4]) * u2[1] + ac_; ac_ = lo2_(bb[5]) * u2[2] + ac_; ac_ = hi2_(bb[5]) * u2[3] + ac_; \
    ac_ = lo2_(bb[6]) * u3[0] + ac_; ac_ = hi2_(bb[6]) * u3[1] + ac_; ac_ = lo2_(bb[7]) * u3[2] + ac_; ac_ = hi2_(bb[7]) * u3[3] + ac_; \
    const float nr_ = ar * hr - ai * hi + ac_.x, ni_ = ar * hi + ai * hr + ac_.y; hr = nr_; hi = ni_; } while (0)

typedef short bf16x4_t __attribute__((ext_vector_type(4)));
#define MFMA16K16(a, b, c) __builtin_amdgcn_mfma_f32_16x16x16bf16_1k(a, b, c, 0, 0, 0)
__device__ __forceinline__ bf16x4_t s5_load_u(const bf16* urow0, int fr, int quad) { return *(const GAS bf16x4_t*)((const GAS bf16*)urow0 + (size_t)fr * 1280 + quad * 4); }
__device__ __forceinline__ void s5_bu_block(const bf16x4_t a, const bf16x4_t (&bcf)[8], LAS float* bul, int fr, int quad) {
#pragma unroll
    for (int cb = 0; cb < 8; ++cb) { f32x4 d = {0.f, 0.f, 0.f, 0.f}; d = MFMA16K16(a, bcf[cb], d);
#pragma unroll
        for (int j = 0; j < 4; ++j) bul[(quad * 4 + j) * 130 + cb * 16 + fr] = d[j]; }
}
__device__ __forceinline__ void s5_local(const bf16* proj, const float* abar, const bf16* bbt, float* sloc, LAS float* bul, int slot, int nslots, int lane) {
    const int fr = lane & 15, quad = lane >> 4;
    for (int t = slot; t < 8192; t += nslots) {
        const int chunk = t & 63, g = (t >> 6) & 31, b = t >> 11;
        const float ar = abar[(g * 64 + lane) * 2], ai = abar[(g * 64 + lane) * 2 + 1];
        bf16x4_t bcf[8];
#pragma unroll
        for (int cb = 0; cb < 8; ++cb) bcf[cb] = *(const GAS bf16x4_t*)((const GAS bf16*)bbt + (size_t)(g * 128 + cb * 16 + fr) * 16 + quad * 4);
        float hr = 0.f, hi = 0.f;
        bf16x4_t ua[4];
#pragma unroll
        for (int blk = 0; blk < 4; ++blk) ua[blk] = s5_load_u(proj + (size_t)(b * 4096 + chunk * 64 + blk * 16) * 1280 + g * 16, fr, quad);
#pragma unroll
        for (int blk = 0; blk < 4; ++blk) {
            s5_bu_block(ua[blk], bcf, bul, fr, quad);
#pragma unroll 4
            for (int s = 0; s < 16; ++s) { const f32x2v bu = *(const LAS f32x2v*)(bul + s * 130 + 2 * lane); const float nr = ar * hr - ai * hi + bu.x, ni = ar * hi + ai * hr + bu.y; hr = nr; hi = ni; }
        }
        *(f32x2v*)(sloc + (size_t)t * 128 + lane * 2) = (f32x2v){hr, hi};
    }
}
__device__ __forceinline__ void s5_out(const bf16* proj, const float* abar, const bf16* bbt, const float* sloc, const float* st_re, const float* st_im, const float* c_re, const float* c_im,
                                       const float* dcoef, bf16* gbuf, float* out, LAS float* bul, LAS unsigned* hbuf, int slot, int nslots, int lane) {
    const int fr = lane & 15, quad = lane >> 4;
    for (int t = slot; t < 8192 + 256; t += nslots) {
        const int sample = t >= 8192; int b, g, chunk, nblk, rowbase;
        if (!sample) { chunk = t & 63; g = (t >> 6) & 31; b = t >> 11; nblk = 4; rowbase = b * 4096 + chunk * 64; } else { const int s = t - 8192; g = s & 31; b = s >> 5; chunk = 0; nblk = 2; rowbase = MP + b * 32; }
        const float ar = abar[(g * 64 + lane) * 2], ai = abar[(g * 64 + lane) * 2 + 1];
        bf16x4_t bcf[8];
#pragma unroll
        for (int cb = 0; cb < 8; ++cb) bcf[cb] = *(const GAS bf16x4_t*)((const GAS bf16*)bbt + (size_t)(g * 128 + cb * 16 + fr) * 16 + quad * 4);
        float hr, hi;
        if (!sample) { float pr = ar, pi = ai;
#pragma unroll
            for (int i = 0; i < 6; ++i) { const float t1 = pr * pr - pi * pi; pi = 2.f * pr * pi; pr = t1; }
            hr = 0.f; hi = 0.f; const float* sp = sloc + (size_t)(t - chunk) * 128 + lane * 2;
#pragma unroll 16
            for (int cc = 0; cc < chunk; ++cc) { const f32x2v sv = *(const f32x2v*)(sp + (size_t)cc * 128); const float nr = pr * hr - pi * hi + sv.x, ni = pr * hi + pi * hr + sv.y; hr = nr; hi = ni; } }
        else { hr = st_re[(b * 32 + g) * 64 + lane]; hi = st_im[(b * 32 + g) * 64 + lane]; }
        bf16x8 cf[4];
#pragma unroll
        for (int ks = 0; ks < 4; ++ks) { const f32x4 cr = *(const f32x4*)(c_re + (size_t)(g * 16 + fr) * 64 + ks * 16 + quad * 4), ci = *(const f32x4*)(c_im + (size_t)(g * 16 + fr) * 64 + ks * 16 + quad * 4);
            v4u w; w.x = pg8::cvt_pk_bf16(cr[0], -ci[0]); w.y = pg8::cvt_pk_bf16(cr[1], -ci[1]); w.z = pg8::cvt_pk_bf16(cr[2], -ci[2]); w.w = pg8::cvt_pk_bf16(cr[3], -ci[3]); cf[ks] = __builtin_bit_cast(bf16x8, w); }
        const float dco = dcoef[g * 16 + fr];
        bf16x4_t ua[4]; bf16 uraw[4][4];
#pragma unroll
        for (int blk = 0; blk < 4; ++blk) { const int bc = blk < nblk ? blk : nblk - 1; const bf16* urow0 = proj + (size_t)(rowbase + bc * 16) * 1280 + g * 16; ua[blk] = s5_load_u(urow0, fr, quad);
#pragma unroll
            for (int j = 0; j < 4; ++j) uraw[blk][j] = ((const GAS bf16*)urow0)[(size_t)(quad * 4 + j) * 1280 + fr]; }
#pragma unroll
        for (int blk = 0; blk < 4; ++blk) { if (blk < nblk) {
            s5_bu_block(ua[blk], bcf, bul, fr, quad);
#pragma unroll 4
            for (int s = 0; s < 16; ++s) { const f32x2v bu = *(const LAS f32x2v*)(bul + s * 130 + 2 * lane); const float nr = ar * hr - ai * hi + bu.x, ni = ar * hi + ai * hr + bu.y; hr = nr; hi = ni; hbuf[s * 68 + lane] = pg8::cvt_pk_bf16(hr, hi); }
            f32x4 y = {0.f, 0.f, 0.f, 0.f};
#pragma unroll
            for (int ks = 0; ks < 4; ++ks) { const bf16x8 a = *(const LAS bf16x8*)(hbuf + fr * 68 + ks * 16 + quad * 4); y = MFMA16(a, cf[ks], y); }
#pragma unroll
            for (int j = 0; j < 4; ++j) { const int s = blk * 16 + quad * 4 + j; const float uu = bflo((unsigned)uraw[blk][j]); const float yv = y[j] + dco * uu;
                const float z = 0.7978845608028654f * (yv + 0.044715f * yv * yv * yv); const float th = 1.0f - 2.0f / (1.0f + __expf(2.0f * z)); const float gl = 0.5f * yv * (1.0f + th);
                ((GAS bf16*)gbuf)[(size_t)(rowbase + s) * 512 + g * 16 + fr] = (bf16)f2bf(gl); }
        } }
        if (!sample && chunk == 63) { out[OFF_SRP + (b * 32 + g) * 64 + lane] = hr; out[OFF_SIP + (b * 32 + g) * 64 + lane] = hi; }
        if (sample) { out[OFF_SRS + (b * 32 + g) * 64 + lane] = hr; out[OFF_SIS + (b * 32 + g) * 64 + lane] = hi; }
    }
}

template <int KIND>
__device__ __forceinline__ void sample_gemm(const bf16* A, const bf16* Bt, int K, LAS unsigned char* lds, int tid, int wave, int lane,
                                            bf16* xbp, const float* base_f32, float* part_next, const float* part_cur, bf16* O) {
    const int fr = lane & 15, quad = lane >> 4;
    LAS f32x4* red = (LAS f32x4*)lds;
    LAS float* ssred = (LAS float*)(lds + 32768);
    for (int tile = blockIdx.x; tile < 256; tile += gridDim.x) {
        const int r0 = MP + (tile >> 4) * 16, c0 = (tile & 15) * 64, kw = K >> 3;
        const bf16* ap = A + (size_t)(r0 + fr) * K + wave * kw + quad * 8;
        const bf16* bp = Bt + (size_t)(c0 + fr) * K + wave * kw + quad * 8;
        f32x4 acc[4];
#pragma unroll
        for (int cb = 0; cb < 4; ++cb) acc[cb] = (f32x4){0.f, 0.f, 0.f, 0.f};
        const int e_cb = (tid >> 6) & 3, e_l2 = tid & 63, e_row = r0 + (e_l2 & 15), e_col = c0 + e_cb * 16 + 4 * (e_l2 >> 4); const size_t e_off = (size_t)e_row * 1024 + e_col;
        f32x4 e_bs = {0.f, 0.f, 0.f, 0.f}; float e_rs = 1.f;
        if (tid < 256) { if (KIND == 0) { if (base_f32) e_bs = *(const f32x4*)(base_f32 + e_off); else { const u32x2v w = *(const u32x2v*)(xbp + e_off); e_bs = (f32x4){bflo(w.x), bfhi(w.x), bflo(w.y), bfhi(w.y)}; } }
                         else e_rs = rstd_of(part_cur, e_row); }
        const int nks = kw >> 5;
        for (int k0 = 0; k0 < nks; k0 += 4) {
            bf16x8 a[4], b[4][4];
#pragma unroll
            for (int i = 0; i < 4; ++i) { const int ks = (k0 + i < nks) ? k0 + i : nks - 1;
                a[i] = *(const bf16x8*)(ap + ks * 32);
#pragma unroll
                for (int cb = 0; cb < 4; ++cb) b[i][cb] = *(const bf16x8*)(bp + (size_t)cb * 16 * K + ks * 32); }
            __builtin_amdgcn_sched_barrier(0);
#pragma unroll
            for (int i = 0; i < 4; ++i) if (k0 + i < nks) {
#pragma unroll
                for (int cb = 0; cb < 4; ++cb) acc[cb] = MFMA16(b[i][cb], a[i], acc[cb]); }
        }
#pragma unroll
        for (int cb = 0; cb < 4; ++cb) red[(wave * 4 + cb) * 64 + lane] = acc[cb] * 1.0f;
        __syncthreads();
        if (tid < 256) { const int cb = tid >> 6, l2 = tid & 63; f32x4 v = red[cb * 64 + l2];
#pragma unroll
            for (int w = 1; w < 8; ++w) v = v + red[(w * 4 + cb) * 64 + l2];
            const int row = r0 + (l2 & 15), col = c0 + cb * 16 + 4 * (l2 >> 4); const size_t off = (size_t)row * 1024 + col;
            if (KIND == 0) {
                v = v + e_bs; u32x2v o; o.x = pk2(v[0], v[1]); o.y = pk2(v[2], v[3]); *(u32x2v*)(xbp + off) = o;
                float ss = (v[0] * v[0] + v[1] * v[1]) + (v[2] * v[2] + v[3] * v[3]); ss += __shfl_xor(ss, 16); ss += __shfl_xor(ss, 32);
                if ((l2 >> 4) == 0) ssred[cb * 16 + (l2 & 15)] = ss; }
            else { const float rs = e_rs; u32x2v o; o.x = pk2(v[0] * rs, v[1] * rs); o.y = pk2(v[2] * rs, v[3] * rs); *(u32x2v*)(O + off) = o; }
        }
        if (KIND == 0) { __syncthreads(); if (tid < 16) part_next[(size_t)(r0 + tid) * 16 + (tile & 15)] = (ssred[tid] + ssred[16 + tid]) + (ssred[32 + tid] + ssred[48 + tid]); }
        __syncthreads();
    }
}


__device__ __forceinline__ void sample_cz(const bf16* A, const bf16* Bt, LAS unsigned char* lds, int tid, int wave, int lane,
                                          const float* part_cur, const float* cw, const float* st, bf16* zcp, float* outp) {
    const int fr = lane & 15, quad = lane >> 4;
    LAS f32x4* red = (LAS f32x4*)lds;
    LAS float* T = (LAS float*)(lds + 65536);
    LAS float* CZ = (LAS float*)(lds + 65536 + 8192);
    for (int tile = blockIdx.x; tile < 256; tile += gridDim.x) {
        const int b = tile >> 5, c0 = (tile & 31) * 32, r0 = MP + b * 32;
        const int wrow = 1024 + (c0 >> 7) * 256 + (c0 & 127);
        const GAS bf16* ap = (const GAS bf16*)A + (size_t)(r0 + fr) * 1024 + wave * 128 + quad * 8;
        const GAS bf16* bp = (const GAS bf16*)Bt + (size_t)(wrow + fr) * 1024 + wave * 128 + quad * 8;
        bf16x8 a[4][2], bw[4][4];
#pragma unroll
        for (int ks = 0; ks < 4; ++ks) {
#pragma unroll
            for (int rb = 0; rb < 2; ++rb) a[ks][rb] = *(const GAS bf16x8*)(ap + (size_t)rb * 16 * 1024 + ks * 32);
#pragma unroll
            for (int cb = 0; cb < 4; ++cb) bw[ks][cb] = *(const GAS bf16x8*)(bp + (size_t)((cb >> 1) * 128 + (cb & 1) * 16) * 1024 + ks * 32); }
        f32x4 acc[2][4];
#pragma unroll
        for (int rb = 0; rb < 2; ++rb)
#pragma unroll
            for (int cb = 0; cb < 4; ++cb) { f32x4 d = {0.f, 0.f, 0.f, 0.f};
#pragma unroll
                for (int ks = 0; ks < 4; ++ks) d = MFMA16(bw[ks][cb], a[ks][rb], d);
                acc[rb][cb] = d; }
#pragma unroll
        for (int rb = 0; rb < 2; ++rb)
#pragma unroll
            for (int cb = 0; cb < 4; ++cb) red[(wave * 8 + rb * 4 + cb) * 64 + lane] = acc[rb][cb];
        __syncthreads();
        {
            const int blk = tid >> 6, l2 = tid & 63, rb = blk >> 2, cb = blk & 3; f32x4 v = red[blk * 64 + l2];
#pragma unroll
            for (int w = 1; w < 8; ++w) v = v + red[(w * 8 + blk) * 64 + l2];
            *(LAS f32x4*)(T + ((cb >> 1) * 32 + rb * 16 + (l2 & 15)) * 32 + (cb & 1) * 16 + 4 * (l2 >> 4)) = v; }
        __syncthreads();
        const int r = tid >> 3, cq = (tid & 7) * 4;
        if (tid < 256) { const float rs = rstd_of(part_cur, r0 + r); const float rs2 = rs * rs;
            const f32x4 gc = *(const LAS f32x4*)(T + r * 32 + cq), zz = *(const LAS f32x4*)(T + (32 + r) * 32 + cq);
            *(LAS f32x4*)(CZ + r * 32 + cq) = gc * zz * rs2; }
        __syncthreads();
        if (tid < 256) { const int c = c0 + cq;
            const f32x4 x0 = *(const LAS f32x4*)(CZ + r * 32 + cq);
            const f32x4 s0 = *(const f32x4*)(st + (size_t)(b * 2) * 1024 + c), s1 = *(const f32x4*)(st + (size_t)(b * 2 + 1) * 1024 + c);
            f32x4 xm1 = s1, xm2 = s0;
            if (r >= 1) { xm1 = *(const LAS f32x4*)(CZ + (r - 1) * 32 + cq); xm2 = s1; }
            if (r >= 2) xm2 = *(const LAS f32x4*)(CZ + (r - 2) * 32 + cq);
            const f32x4 w0 = *(const f32x4*)(cw + c), w1 = *(const f32x4*)(cw + 1024 + c), w2 = *(const f32x4*)(cw + 2048 + c);
            const f32x4 z = w0 * xm2 + w1 * xm1 + w2 * x0;
            bf16* gp = zcp + (size_t)(r0 + r) * 1024 + c; const u32x2v gw = *(const u32x2v*)gp;
            u32x2v o; o.x = pk2(z[0] * bflo(gw.x), z[1] * bfhi(gw.x)); o.y = pk2(z[2] * bflo(gw.y), z[3] * bfhi(gw.y)); *(u32x2v*)gp = o;
            if (r >= 30) *(f32x4*)(outp + OFF_CMS + (size_t)(b * 2 + (r - 30)) * 1024 + c) = x0; }
        __syncthreads();
    }
}

struct Params { const float* in[36]; float* out; unsigned char* ws; int use_cg, pad; };

__global__ void __launch_bounds__(512, 2) mega_fwd(Params P) {
    extern __shared__ __attribute__((aligned(16))) unsigned char lds_raw[];
    LAS unsigned char* lds = (LAS unsigned char*)lds_raw;
    volatile LAS unsigned* MISC = (volatile LAS unsigned*)(lds + MISC_OFF);
    const int G = gridDim.x, NGW = G * 8, NT = G * 512;
    const int wave_s = __builtin_amdgcn_readfirstlane(threadIdx.x >> 6);
    for (int u = threadIdx.x; u < (LDS_BYTES - 131072) / 4; u += 512) ((LAS unsigned*)(lds + 131072))[u] = 0u;
    __syncthreads();
    XcdBarrier bar = xcd_barrier_post((unsigned*)(P.ws + WS_BAR), MISC + 8);
#ifndef STOP_AFTER
#define STOP_AFTER 1000
#endif
    int ph = 0;
#define RUN (ph < STOP_AFTER)
#define FRESH() const int tid = fresh_tid(wave_s), lane = tid & 63, wave = __builtin_amdgcn_readfirstlane(tid >> 6); const int gw = blockIdx.x * 8 + wave, gt = blockIdx.x * 512 + tid; (void)gw; (void)gt; (void)lane; LAS float* wscr = (LAS float*)(lds + 32768 + wave * 12288); (void)wscr;
#define SEAM() do { if (P.use_cg) cg::this_grid().sync(); else xcd_barrier(bar); ++ph; } while (0)

#define part ((float*)(ws + WS_PART))
#define PARTBUF(k) (part + (size_t)((k) & 1) * PART_ELEMS)
#define ropec ((float*)(ws + WS_ROPE))
#define ropes (ropec + 4096 * 32)
#define abar ((float*)(ws + WS_SSM))
#define bbar (abar + 32 * 64 * 2)
#define bbt ((bf16*)(bbar + 32 * 64 * 32))
#define ckb ((bf16*)(ws + WS_CKV))
#define cvb (ckb + 8 * 128 * 128)
#define sloc ((float*)(ws + WS_SLOC))
#define memk ((bf16*)(ws + WS_MEMK))
#define memvT ((bf16*)(ws + WS_MEMVT))
#define SG ((float*)(ws + WS_SIDE))
#define SV ((float*)(ws + WS_SIDE + SG_BYTES))
#define WT ((bf16*)(ws + WS_WT))
#define xb ((bf16*)(ws + WS_XB))
#define tmp (ws + WS_TMP)
#define proj0 ((bf16*)(tmp + TMP_PROJ0))
#define gbuf ((bf16*)(tmp + TMP_GBUF))
#define ycat ((bf16*)(tmp + TMP_YCAT))
#define memb ((bf16*)(tmp + TMP_MEMB))
#define qx ((bf16*)(tmp + TMP_QX))
#define ox ((bf16*)(tmp + TMP_OX))
#define act ((bf16*)(tmp + TMP_ACT))
#define gbm ((bf16*)(tmp + TMP_GB))
#define zc ((bf16*)(tmp + TMP_ZC))
#define PTRS() unsigned char* ws = P.ws; float* out = P.out; asm volatile("" : "+s"(ws), "+s"(out));
    if (RUN) { PTRS() FRESH()
        {
            constexpr int NITEMS = 640 + 128 + 512 + 512 + 2 * 1024 + 512 + 2816 + 1408 + 2048;
            for (int it = gw; it < NITEMS; it += NGW) { int r = it;
#define TR(Wp, K_, N_, WTp, gainp, sc, mode) { const int ni_ = ((K_) / 64) * ((N_) / 32); if (r < ni_) { tr_item(Wp, K_, N_, WTp, gainp, sc, mode, wscr, r, lane); continue; } r -= ni_; }
                TR(P.in[15], 1024, 1280, WT + WT_INEVEN, P.in[11], 1.f, 1)
                TR(P.in[25], 512, 512, WT + WT_GLU, nullptr, 1.f, 0)
                TR(P.in[16], 1024, 1024, WT + WT_OUTEVEN, nullptr, 1.f, 0)
                TR(P.in[30], 1024, 1024, WT + WT_WQ, P.in[12], 0.0625f, 0)
                TR(P.in[31], 1024, 2048, WT + WT_WKV, nullptr, 1.f, 0)
                TR(P.in[31] + 2097152, 1024, 2048, WT + WT_WKV + 2097152, nullptr, 1.f, 0)
                TR(P.in[32], 1024, 1024, WT + WT_WO, nullptr, 1.f, 0)
                TR(P.in[33], 1024, 5632, WT + WT_UP, P.in[13], 1.f, 2)
                TR(P.in[35], 2816, 1024, WT + WT_DOWN, nullptr, 1.f, 0)
                { const int mi = r >> 7, l = mi >> 3, b = mi & 7; tr_item(P.in[10] + (size_t)mi * 262144, 256, 1024, memvT + (size_t)(l * 12 + 4 + b) * 262144, nullptr, 1.f, 0, wscr, r & 127, lane); }
            }
        }
        for (int m = gw; m < MROWS; m += NGW) { const float* xr = m < MP ? P.in[0] + (size_t)m * 1024 : P.in[1] + (size_t)(m - MP) * 1024; float ss = 0.f;
#pragma unroll
            for (int j = 0; j < 4; ++j) { const f32x4 v = *(const f32x4*)(xr + (lane + 64 * j) * 4); ss += (v[0] * v[0] + v[1] * v[1]) + (v[2] * v[2] + v[3] * v[3]);
                u32x2v w; w.x = pg8::cvt_pk_bf16(v[0], v[1]); w.y = pg8::cvt_pk_bf16(v[2], v[3]); *(u32x2v*)(xb + (size_t)m * 1024 + (lane + 64 * j) * 4) = w; }
            ss = wave_sum(ss); if (lane < 16) PARTBUF(0)[(size_t)m * 16 + lane] = lane == 0 ? ss : 0.f; }
        for (int i = gt; i < 262144; i += NT) { const f32x4 v = *(const f32x4*)(P.in[2] + (size_t)i * 4); u32x2v w; w.x = pg8::cvt_pk_bf16(v[0], v[1]); w.y = pg8::cvt_pk_bf16(v[2], v[3]); *(u32x2v*)(memb + (size_t)i * 4) = w; }
        for (int i = gt; i < 1048576; i += NT) { const size_t e = (size_t)i * 4; const int lb = (int)(e >> 18), l = lb >> 3, b = lb & 7; const f32x4 v = *(const f32x4*)(P.in[9] + e);
            u32x2v w; w.x = pg8::cvt_pk_bf16(v[0], v[1]); w.y = pg8::cvt_pk_bf16(v[2], v[3]); *(u32x2v*)(memk + (size_t)(l * 12 + 4 + b) * 262144 + (e & 262143)) = w; }
        for (int i = gt; i < 65536; i += NT) { const int j = i & 32767; const float* src = (i < 32768 ? P.in[3] : P.in[4]) + (size_t)j * 4; bf16* dst = (i < 32768 ? ckb : cvb) + (size_t)j * 4;
            const f32x4 v = *(const f32x4*)src; u32x2v w; w.x = pg8::cvt_pk_bf16(v[0], v[1]); w.y = pg8::cvt_pk_bf16(v[2], v[3]); *(u32x2v*)dst = w; }
        for (int i = gt; i < 4096 * 32; i += NT) { const int pos = i >> 5, d = i & 31; const double inv = dexp_(-(double)d * (9.210340371976184 / 32.0)); double s, c; dsincos_((double)pos * inv, s, c); ropec[i] = (float)c; ropes[i] = (float)s; }
        for (int i = gt; i < 2048; i += NT) { const double are = P.in[17][i], aim = P.in[18][i], dt = dexp_((double)P.in[19][i]); double s, c; dsincos_(aim * dt, s, c); const double mag = dexp_(are * dt);
            const double br = mag * c, bi = mag * s; abar[2 * i] = (float)br; abar[2 * i + 1] = (float)bi;
            const double nr = br - 1.0, ni = bi, den = are * are + aim * aim; const double qr = (nr * are + ni * aim) / den, qi = (ni * are - nr * aim) / den;
#pragma unroll 4
            for (int h = 0; h < 16; ++h) { const double xr = P.in[20][(size_t)i * 16 + h], xi = P.in[21][(size_t)i * 16 + h]; const float fre = (float)(qr * xr - qi * xi), fim = (float)(qr * xi + qi * xr); bbar[(size_t)i * 32 + 2 * h] = fre; bbar[(size_t)i * 32 + 2 * h + 1] = fim;
                bbt[((size_t)i * 2) * 16 + h] = (bf16)f2bf(fre); bbt[((size_t)i * 2 + 1) * 16 + h] = (bf16)f2bf(fim); } }
    }
    SEAM();
    if (RUN) { PTRS()
        if (G < 128 || (int)blockIdx.x >= G - 64) { pg8::Gemm g{memb, WT + WT_WKV, 1024, 4096, 1024}; pg8::StaticOrder S;
            if (G < 128) S.init(1024, 4096, G, (int)blockIdx.x); else S.init(1024, 4096, 64, (int)blockIdx.x - (G - 64)); EpiKV E{out, memk};
          pg8::gemm_phase<EpiKV, pg8::StaticOrder, true, true>(lds, g, S, E, wave_s); }
        { pg8::Gemm g{xb, WT + WT_INEVEN, MROWS, 1280, 1024}; pg8::StaticOrderF S; S.init(MROWS, 1280, G, (int)blockIdx.x); EpiIn0 E{proj0, PARTBUF(0), ropec, ropes, out};
          pg8::gemm_phase<EpiIn0, pg8::StaticOrderF, true, true>(lds, g, S, E, wave_s); }
        {
            FRESH()
            const int bx = (int)blockIdx.x, n2 = 325 - G;
            int slot = -1, nw = 1;
            if (G == 256) { if (bx >= n2 && bx < G - 64) { slot = (bx - n2) * 8 + wave; nw = (G - 64 - n2) * 8; } } else { slot = gw; nw = NGW; }
            if (slot >= 0) for (int it = slot; it < 2816 + 1408; it += nw) { int r = it;
                TR(P.in[33] + (size_t)1024 * 5632, 1024, 5632, WT + WT_UP + (size_t)5632 * 1024, P.in[13] + 1024, 1.f, 2)
                tr_item(P.in[35] + (size_t)2816 * 1024, 2816, 1024, WT + WT_DOWN + (size_t)2816 * 1024, nullptr, 1.f, 0, wscr, r, lane); }
        }
    }
    SEAM();
    if (RUN) { PTRS() FRESH()
        swa_phase(proj0, ckb, cvb, P.in[26], ycat, lds, tid, wave, lane, G);
        s5_local(proj0, abar, bbt, sloc, wscr, wave * G + (int)blockIdx.x, NGW, lane);
        for (int it = wave * G + (int)blockIdx.x; it < 1024; it += NGW) { const int mi = it >> 7, l = mi >> 2, b = mi & 3;
            tr_item(out + OFF_MVP + (size_t)mi * 262144, 256, 1024, memvT + (size_t)(l * 12 + b) * 262144, nullptr, 1.f, 0, wscr, it & 127, lane); }
    }
    SEAM();
    if (RUN) { PTRS() FRESH() s5_out(proj0, abar, bbt, sloc, P.in[5], P.in[6], P.in[22], P.in[23], P.in[24], gbuf, out, (LAS float*)(lds + wave * 16384), (LAS unsigned*)(lds + wave * 16384 + 8448), wave * G + (int)blockIdx.x, NGW, lane); }
    SEAM();
    if (RUN) { PTRS() pg8::Gemm g{gbuf, WT + WT_GLU, MROWS, 512, 512}; pg8::StaticOrder S; S.init(MROWS, 512, G, (int)blockIdx.x); EpiGlu E{gbuf, ycat};
        pg8::gemm_phase<EpiGlu, pg8::StaticOrder, true, true>(lds, g, S, E, wave_s);
        {
            FRESH()
            const int bx = (int)blockIdx.x; int slot = -1, nw = 1;
            if (G > 130) { if (bx >= 130) { slot = (bx - 130) * 8 + wave; nw = (G - 130) * 8; } } else { slot = gw; nw = NGW; }
            if (slot >= 0) for (int it = slot; it < 1536 + 512; it += nw) { int r = it;
                TR(P.in[27], 1024, 3072, WT + WT_INODD, P.in[11] + 1024, 1.f, 3)
                tr_item(P.in[29], 1024, 1024, WT + WT_OUTODD, nullptr, 1.f, 0, wscr, r, lane); }
        } }
    SEAM();

#pragma unroll
    for (int l = 0; l < 2; ++l) {
        if (l == 1) {
            if (RUN) { PTRS() pg8::Gemm g{xb, WT + WT_INODD, MP, 1024, 1024}; pg8::StaticOrderF S; S.init(MP, 1024, G, (int)blockIdx.x); EpiBf16 E{gbm, 1024, PARTBUF(3)};
                pg8::gemm_phase<EpiBf16, pg8::StaticOrderF, true, true>(lds, g, S, E, wave_s);
                { FRESH() sample_gemm<1>(xb, WT + WT_INODD, 1024, lds, tid, wave, lane, nullptr, nullptr, nullptr, PARTBUF(3), gbm); } }
            SEAM();
            if (RUN) { PTRS() pg8::Gemm g{xb, WT + WT_INODD + (size_t)1024 * 1024, MP, 2048, 1024}; pg8::StaticOrderF S; S.init(MP, 2048, G, (int)blockIdx.x); EpiCz E{gbm, PARTBUF(3), P.in[28], SG};
                pg8::gemm_phase<EpiCz, pg8::StaticOrderF, true, true>(lds, g, S, E, wave_s);
                { FRESH() sample_cz(xb, WT + WT_INODD, lds, tid, wave, lane, PARTBUF(3), P.in[28], P.in[7], gbm, out); } }
            SEAM();
            if (RUN) { PTRS() FRESH()
                const float* cw = P.in[28];
                for (int i = gt; i < 512 * 128; i += NT) { const int ri = i >> 7, c0 = (i & 127) * 8, blk = ri >> 1, rr = ri & 1, row = blk * 64 + rr;
                    f32x4 pa0, pa1, pb0, pb1;
                    if ((blk & 63) == 0) { pa0 = pa1 = pb0 = pb1 = (f32x4){0.f, 0.f, 0.f, 0.f}; }
                    else { const float* s0 = SG + (size_t)((blk - 1) * 8 + 6) * 1024 + c0; pa0 = *(const f32x4*)s0; pa1 = *(const f32x4*)(s0 + 4); pb0 = *(const f32x4*)(s0 + 1024); pb1 = *(const f32x4*)(s0 + 1028); }
                    const float* sc = SG + (size_t)(blk * 8) * 1024 + c0; const f32x4 x00 = *(const f32x4*)sc, x01 = *(const f32x4*)(sc + 4);
                    f32x4 xm2a, xm2b, xm1a, xm1b, xca, xcb;
                    if (rr == 0) { xm2a = pa0; xm2b = pa1; xm1a = pb0; xm1b = pb1; xca = x00; xcb = x01; }
                    else { xm2a = pb0; xm2b = pb1; xm1a = x00; xm1b = x01; xca = *(const f32x4*)(sc + 1024); xcb = *(const f32x4*)(sc + 1028); }
                    const f32x4 w0a = *(const f32x4*)(cw + c0), w0b = *(const f32x4*)(cw + c0 + 4), w1a = *(const f32x4*)(cw + 1024 + c0), w1b = *(const f32x4*)(cw + 1028 + c0), w2a = *(const f32x4*)(cw + 2048 + c0), w2b = *(const f32x4*)(cw + 2052 + c0);
                    const f32x4 z0 = w0a * xm2a + w1a * xm1a + w2a * xca, z1 = w0b * xm2b + w1b * xm1b + w2b * xcb;
                    const v4u gw_ = *(const v4u*)(gbm + (size_t)row * 1024 + c0);
                    const f32x4 g0 = (f32x4){bflo(gw_.x), bfhi(gw_.x), bflo(gw_.y), bfhi(gw_.y)}, g1 = (f32x4){bflo(gw_.z), bfhi(gw_.z), bflo(gw_.w), bfhi(gw_.w)};
                    *(v4u*)(gbm + (size_t)row * 1024 + c0) = pack8(g0 * z0, g1 * z1); }
                for (int i = gt; i < 4 * 2 * 1024; i += NT) { const int c = i & 1023, j = (i >> 10) & 1, b = i >> 11; out[OFF_CMP + i] = SG[(size_t)((64 * b + 63) * 8 + 6 + j) * 1024 + c]; }
            }
            SEAM();
        }
        if (RUN) { PTRS() pg8::Gemm g{(bf16*)(tmp + (size_t)(1 - l) * TMP_YCAT), WT + WT_OUTEVEN + (size_t)l * (WT_OUTODD - WT_OUTEVEN), MP, 1024, 1024}; pg8::StaticOrderF S; S.init(MP, 1024, G, (int)blockIdx.x);
            EpiRes E{P.in[0], P.in[1] - (size_t)MP * 1024, xb, PARTBUF(1 + 3 * l), l == 0 ? 1 : 0};
            pg8::gemm_phase<EpiRes, pg8::StaticOrderF, true, true>(lds, g, S, E, wave_s);
            { FRESH() sample_gemm<0>((bf16*)(tmp + (size_t)(1 - l) * TMP_YCAT), WT + WT_OUTEVEN + (size_t)l * (WT_OUTODD - WT_OUTEVEN), 1024, lds, tid, wave, lane, xb, l == 0 ? P.in[1] - (size_t)MP * 1024 : (const float*)nullptr, PARTBUF(1 + 3 * l), nullptr, nullptr); } }
        SEAM();
        if (RUN) { PTRS() pg8::Gemm g{xb, WT + WT_WQ + (size_t)l * 1048576, MP, 1024, 1024}; pg8::StaticOrderF S; S.init(MP, 1024, G, (int)blockIdx.x); EpiBf16 E{qx, 1024, PARTBUF(1 + 3 * l)};
            pg8::gemm_phase<EpiBf16, pg8::StaticOrderF, true, true>(lds, g, S, E, wave_s);
            { FRESH() sample_gemm<1>(xb, WT + WT_WQ + (size_t)l * 1048576, 1024, lds, tid, wave, lane, nullptr, nullptr, nullptr, PARTBUF(1 + 3 * l), qx); } }
        SEAM();
        if (RUN) { PTRS() FRESH() xattn_phase2(qx, memk + (size_t)l * 12 * 262144, memvT + (size_t)l * 12 * 262144, ox, lds, tid, wave, lane, G); }
        SEAM();
        if (RUN) { PTRS() pg8::Gemm g{ox, WT + WT_WO + (size_t)l * 1048576, MP, 1024, 1024}; pg8::StaticOrderF S; S.init(MP, 1024, G, (int)blockIdx.x); EpiRes E{P.in[0], P.in[0], xb, PARTBUF(2 + 3 * l), 0};
            pg8::gemm_phase<EpiRes, pg8::StaticOrderF, true, true>(lds, g, S, E, wave_s);
            { FRESH() sample_gemm<0>(ox, WT + WT_WO + (size_t)l * 1048576, 1024, lds, tid, wave, lane, xb, nullptr, PARTBUF(2 + 3 * l), nullptr, nullptr); } }
        SEAM();
        if (RUN) { PTRS() pg8::Gemm g{xb, WT + WT_UP + (size_t)l * 5632 * 1024, MROWS, 5632, 1024}; pg8::StaticOrderF S; S.init(MROWS, 5632, G, (int)blockIdx.x);
            EpiFfnUp E{act, PARTBUF(2 + 3 * l), P.in[34] + (size_t)l * 3 * DFF, SG, SV};
            pg8::gemm_phase<EpiFfnUp, pg8::StaticOrderF, true, true>(lds, g, S, E, wave_s);
            if (l == 0) {
                FRESH()
                const int bx = (int)blockIdx.x, nb = 1430 % G; int slot = -1, nw = 1;
                if (nb > 0 && nb < G) { if (bx >= nb) { slot = (bx - nb) * 8 + wave; nw = (G - nb) * 8; } } else { slot = gw; nw = NGW; }
                if (slot >= 0) for (int it = slot; it < 512 + 512; it += nw) { int r = it;
                    TR(P.in[30] + 1048576, 1024, 1024, WT + WT_WQ + 1048576, P.in[12] + 1024, 0.0625f, 0)
                    tr_item(P.in[32] + 1048576, 1024, 1024, WT + WT_WO + 1048576, nullptr, 1.f, 0, wscr, r, lane); }
            } }
        SEAM();
        if (RUN) { PTRS() FRESH()
            const float* cw = P.in[34] + (size_t)l * 3 * DFF; const float* st = P.in[8] + (size_t)l * 8 * 2 * DFF;
            for (int i = gt; i < 528 * 352; i += NT) { const int fi = i / 352, c0 = (i % 352) * 8; int blk, row, rr, sb, vb; bool smp = fi >= 512;
                if (!smp) { blk = fi >> 1; rr = fi & 1; row = blk * 64 + rr; sb = 0; vb = 0; } else { const int s = fi - 512, half = (s >> 1) & 1; blk = 256 + (s >> 2); rr = s & 1; row = blk * 64 + half * 32 + rr; sb = half * 4; vb = half * 2; }
                f32x4 pa0, pa1, pb0, pb1;
                if (smp) { const int b = (blk - 256) * 2 + (sb >> 2); const float* s0 = st + (size_t)(b * 2) * DFF + c0; pa0 = *(const f32x4*)s0; pa1 = *(const f32x4*)(s0 + 4); pb0 = *(const f32x4*)(s0 + DFF); pb1 = *(const f32x4*)(s0 + DFF + 4); }
                else if ((blk & 63) == 0) { pa0 = pa1 = pb0 = pb1 = (f32x4){0.f, 0.f, 0.f, 0.f}; }
                else { const float* s0 = SG + (size_t)((blk - 1) * 8 + 6) * DFF + c0; pa0 = *(const f32x4*)s0; pa1 = *(const f32x4*)(s0 + 4); pb0 = *(const f32x4*)(s0 + DFF); pb1 = *(const f32x4*)(s0 + DFF + 4); }
                const float* sc = SG + (size_t)(blk * 8 + sb) * DFF + c0; const f32x4 x00 = *(const f32x4*)sc, x01 = *(const f32x4*)(sc + 4);
                f32x4 xm2a, xm2b, xm1a, xm1b, xca, xcb;
                if (rr == 0) { xm2a = pa0; xm2b = pa1; xm1a = pb0; xm1b = pb1; xca = x00; xcb = x01; }
                else { xm2a = pb0; xm2b = pb1; xm1a = x00; xm1b = x01; xca = *(const f32x4*)(sc + DFF); xcb = *(const f32x4*)(sc + DFF + 4); }
                const f32x4 w0a = *(const f32x4*)(cw + c0), w0b = *(const f32x4*)(cw + c0 + 4), w1a = *(const f32x4*)(cw + DFF + c0), w1b = *(const f32x4*)(cw + DFF + c0 + 4), w2a = *(const f32x4*)(cw + 2 * DFF + c0), w2b = *(const f32x4*)(cw + 2 * DFF + c0 + 4);
                const f32x4 ga = w0a * xm2a + w1a * xm1a + w2a * xca, gb_ = w0b * xm2b + w1b * xm1b + w2b * xcb;
                const float* sv = SV + (size_t)(blk * 4 + vb + rr) * DFF + c0; const f32x4 va = *(const f32x4*)sv, vb_ = *(const f32x4*)(sv + 4);
                f32x4 a0, a1;
#pragma unroll
                for (int j = 0; j < 4; ++j) { a0[j] = ga[j] * sigmoidf_(ga[j]) * va[j]; a1[j] = gb_[j] * sigmoidf_(gb_[j]) * vb_[j]; }
                *(v4u*)(act + (size_t)row * DFF + c0) = pack8(a0, a1); }
            for (int i = gt; i < 4 * 2 * DFF; i += NT) { const int c = i % DFF, j = (i / DFF) & 1, b = i / (2 * DFF); out[OFF_CFP + (size_t)l * 4 * 2 * DFF + i] = SG[(size_t)((64 * b + 63) * 8 + 6 + j) * DFF + c]; }
            for (int i = gt; i < 8 * 2 * DFF; i += NT) { const int c = i % DFF, j = (i / DFF) & 1, b = i / (2 * DFF); out[OFF_CFS + (size_t)l * 8 * 2 * DFF + i] = SG[(size_t)((256 + (b >> 1)) * 8 + (b & 1) * 4 + 2 + j) * DFF + c]; }
        }
        SEAM();
        if (RUN) { PTRS() pg8::Gemm g{act, WT + WT_DOWN + (size_t)l * 2816 * 1024, MP, 1024, DFF}; pg8::StaticOrderF S; S.init(MP, 1024, G, (int)blockIdx.x); EpiRes E{P.in[0], P.in[0], xb, PARTBUF(3 + 3 * l), 0};
            pg8::gemm_phase<EpiRes, pg8::StaticOrderF, true, true>(lds, g, S, E, wave_s);
            { FRESH() sample_gemm<0>(act, WT + WT_DOWN + (size_t)l * 2816 * 1024, DFF, lds, tid, wave, lane, xb, nullptr, PARTBUF(3 + 3 * l), nullptr, nullptr); } }
        SEAM();
    }
    if (RUN) { PTRS() FRESH()
        const float* gf = P.in[14];
        for (int m = gw; m < MROWS; m += NGW) { const float rs = rstd_of(PARTBUF(6), m); float* xr = out + (size_t)m * 1024; const bf16* xbr = xb + (size_t)m * 1024;
#pragma unroll
            for (int j = 0; j < 4; ++j) { const int c = (lane + 64 * j) * 4; const u32x2v w = *(const u32x2v*)(xbr + c); const f32x4 v = (f32x4){bflo(w.x), bfhi(w.x), bflo(w.y), bfhi(w.y)}, gg = *(const f32x4*)(gf + c); __builtin_nontemporal_store(v * rs * gg, (f32x4*)(xr + c)); } }
    }
}

extern "C" void kernel_launch(void* const* d_in, const int* in_sizes, int n_in, void* d_out, int out_size, void* d_ws, size_t ws_size, hipStream_t stream) {
    static int grid = 0;
    if (grid == 0) {
        int dev = 0, cus = 0, per_cu = 0;
        if (n_in != 36 || ws_size < 256 * MiB) { fprintf(stderr, "kernel_launch: unexpected n_in %d / ws %zu\n", n_in, ws_size); grid = -1; return; }
        (void)hipGetDevice(&dev); (void)hipDeviceGetAttribute(&cus, hipDeviceAttributeMultiprocessorCount, dev);
        if (hipFuncSetAttribute((const void*)mega_fwd, hipFuncAttributeMaxDynamicSharedMemorySize, LDS_BYTES) != hipSuccess) { fprintf(stderr, "kernel_launch: hipFuncSetAttribute failed\n"); grid = -1; return; }
        if (hipOccupancyMaxActiveBlocksPerMultiprocessor(&per_cu, (const void*)mega_fwd, 512, LDS_BYTES) != hipSuccess || per_cu < 1) per_cu = 1;
        (void)hipGetLastError();
        grid = cus * 1;
        if (grid > 256) grid = 256;
    }
    if (grid < 0) return;
    (void)hipMemsetAsync(d_ws, 0, CTL_ZERO_BYTES, stream);
    Params p{};
    for (int i = 0; i < 36; ++i) p.in[i] = (const float*)d_in[i];
    p.out = (float*)d_out; p.ws = (unsigned char*)d_ws; p.use_cg = 0; p.pad = 0;
    void* args[] = {&p};
    hipError_t e = hipLaunchCooperativeKernel((const void*)mega_fwd, dim3(grid), dim3(512), args, LDS_BYTES, stream);
    if (e != hipSuccess) fprintf(stderr, "cooperative launch failed: %s (grid %d)\n", hipGetErrorString(e), grid);
}
```

```cpp
#include <hip/hip_runtime.h>
#include <hip/hip_cooperative_groups.h>
#include <cstdio>
#include <cstdint>
namespace cg = cooperative_groups;
__device__ __forceinline__ int fresh_tid(int wave_s) { unsigned z = 0u; asm volatile("" : "+s"(z)); int t = wave_s * 64 + (int)__builtin_amdgcn_mbcnt_hi(~0u, __builtin_amdgcn_mbcnt_lo(~0u, z)); asm volatile("" : "+v"(t)); return t; }
namespace pg8 {
#define PG8_LAS __attribute__((address_space(3)))
typedef unsigned short bf16_t;
typedef short bf16x8 __attribute__((ext_vector_type(8)));
typedef float f32x4 __attribute__((ext_vector_type(4)));
typedef unsigned u32x4 __attribute__((ext_vector_type(4)));
constexpr int BM = 256, BK = 64, HALF = 128, HTB = HALF * BK * 2  , STAGE_BYTES = 8 * HTB, NXCD = 8, WGM = 8;

__host__ __device__ __forceinline__ int lds_byte(int r, int c) { const int st = (r >> 4) * 2 + (c >> 5), rr = r & 15, cc = c & 31, ob = rr * 64 + cc * 2; return st * 1024 + (ob ^ (((ob >> 9) & 1) << 5)); }
__host__ __device__ __forceinline__ void stage_rc(int b, int& R, int& C) { const int st = b / 1024, sb = b % 1024, swz = sb ^ (((sb >> 9) & 1) << 5); R = (st >> 1) * 16 + swz / 64; C = (st & 1) * 32 + (swz % 64) / 2; }
__host__ __device__ __forceinline__ int perm32(int rho) { const int n = rho >> 4, i = rho & 15; return 8 * (i >> 2) + 4 * n + (i & 3); }

struct Unit { int pm, pn; };
struct Gemm { const bf16_t* A; const bf16_t* Bt; int M, N, K; };

template <bool FULL> struct StaticOrderT {
    int nM, nN, nwg, G, c;
    __host__ __device__ void init(int M, int N, int G_, int c_) { nM = M / BM; nN = N / BM; nwg = nM * nN; G = G_; c = c_; }
    __host__ __device__ bool next(int i, Unit& u) const {
        const long L = (long)i * G + c; if (!(FULL && i == 0) && L >= nwg) return false;
        int wgid = (int)L; { const int q = nwg / NXCD, r = nwg % NXCD, xcd = wgid % NXCD, off = wgid / NXCD; wgid = (xcd < r ? xcd * (q + 1) : r * (q + 1) + (xcd - r) * q) + off; }
        const int nig = WGM * nN, gid = wgid / nig, fm = gid * WGM, gsz = (nM - fm) < WGM ? (nM - fm) : WGM;
        u.pm = fm + ((wgid % nig) % gsz); u.pn = (wgid % nig) / gsz; return true;
    }
    __device__ __forceinline__ void a_ready(const Unit&) const {}
    __device__ __forceinline__ void done(const Unit&) const {}
};

typedef StaticOrderT<false> StaticOrder; typedef StaticOrderT<true> StaticOrderF;
__device__ __forceinline__ unsigned cvt_pk_bf16(float lo, float hi) { unsigned r; asm volatile("v_cvt_pk_bf16_f32 %0, %1, %2" : "=v"(r) : "v"(lo), "v"(hi)); return r; }
typedef float f32x2 __attribute__((ext_vector_type(2)));
template <class Epi, class Sched, bool ALIGN_EPI = false, bool SP2 = false>
__device__ __forceinline__ void gemm_phase(PG8_LAS unsigned char* lds, const Gemm g, const Sched& S, const Epi& E, const int wave_s) {
    const int tid = fresh_tid(wave_s), wid = __builtin_amdgcn_readfirstlane(tid >> 6), lane = tid & 63, wr = wid >> 2, wc = wid & 3, fr = lane & 15, fq = lane >> 4;
    const int K = g.K, nt = K / BK;
    unsigned voffA[2], voffB[2];
#pragma unroll
    for (int i = 0; i < 2; ++i) { int R, C; stage_rc(tid * 16 + i * 8192, R, C); const int Rb = Epi::PERM ? ((R & ~31) + perm32(R & 31)) : R;
        voffA[i] = (unsigned)(R * K + C) * 2u; voffB[i] = (unsigned)(Rb * K + C) * 2u; }
    const size_t kstep = (size_t)(BK * 2);
    const size_t hstep = (size_t)HALF * K * 2;
    const size_t tstep = 2 * hstep;
    const unsigned ldsw = (unsigned)wid * 1024u;
    const int aoff = lds_byte(wr * 64 + fr, fq * 8), boff = lds_byte(wc * 32 + fr, fq * 8);
#define PG8_SA(b, h) (((b) * 2 + (h)) * HTB)
#define PG8_SB(b, h) ((4 + (b) * 2 + (h)) * HTB)
#define PG8_STAGE(bufoff, gbase, voff) do { _Pragma("unroll") for (int _i = 0; _i < 2; ++_i) \
        __builtin_amdgcn_global_load_lds((const unsigned*)((const char*)(gbase) + (voff)[_i]), (PG8_LAS unsigned*)(lds + (bufoff) + ldsw + _i * 8192), 16, 0, 0); } while (0)
#define PG8_LDA(dst, b, h) do { _Pragma("unroll") for (int m = 0; m < 4; ++m) _Pragma("unroll") for (int k = 0; k < 2; ++k) dst[m][k] = *(const PG8_LAS bf16x8*)(lds + PG8_SA(b, h) + aoff + m * 2048 + k * 1024); } while (0)
#define PG8_LDB(dst, b, h) do { _Pragma("unroll") for (int n = 0; n < 2; ++n) _Pragma("unroll") for (int k = 0; k < 2; ++k) dst[n][k] = *(const PG8_LAS bf16x8*)(lds + PG8_SB(b, h) + boff + n * 2048 + k * 1024); } while (0)
#define PG8_MMA(ai, bj, At, Bt) do { __builtin_amdgcn_s_setprio(1); _Pragma("unroll") for (int m = 0; m < 4; ++m) _Pragma("unroll") for (int n = 0; n < 2; ++n) _Pragma("unroll") for (int k = 0; k < 2; ++k) \
        acc[ai][bj][m][n] = __builtin_amdgcn_mfma_f32_16x16x32_bf16(Bt[n][k], At[m][k], acc[ai][bj][m][n], 0, 0, 0); __builtin_amdgcn_s_setprio(0); } while (0)
#define PG8_WAIT_V(n) asm volatile("s_waitcnt vmcnt(" #n ")" ::: "memory")
#define PG8_WAIT_L(n) asm volatile("s_waitcnt lgkmcnt(" #n ")" ::: "memory")
#define PG8_BAR __builtin_amdgcn_s_barrier()
#define PG8_SCHED __builtin_amdgcn_sched_barrier(0)
    Unit cur, nxt; int ui = 0;
    if (!S.next(0, cur)) return;
    f32x4 acc[2][2][4][2];
#pragma unroll
    for (int a = 0; a < 2; ++a)
#pragma unroll
        for (int b = 0; b < 2; ++b)
#pragma unroll
            for (int m = 0; m < 4; ++m)
#pragma unroll
                for (int n = 0; n < 2; ++n) acc[a][b][m][n] = (f32x4){0.f, 0.f, 0.f, 0.f};
    bf16x8 At[4][2], B0[2][2], B1[2][2];
    const char* cA = (const char*)g.A + (size_t)cur.pm * tstep; const char* cB = (const char*)g.Bt + (size_t)cur.pn * tstep;
    S.a_ready(cur);
    if constexpr (SP2) {
        PG8_STAGE(PG8_SB(0, 0), cB, voffB); PG8_STAGE(PG8_SB(0, 1), cB + hstep, voffB); PG8_STAGE(PG8_SA(0, 0), cA, voffA); PG8_STAGE(PG8_SA(0, 1), cA + hstep, voffA);
        if (wr == 1) PG8_BAR;
        PG8_WAIT_V(2); PG8_BAR;
        PG8_STAGE(PG8_SB(1, 0), cB + kstep, voffB); PG8_STAGE(PG8_SA(1, 0), cA + kstep, voffA); PG8_STAGE(PG8_SB(1, 1), cB + hstep + kstep, voffB);
        PG8_WAIT_V(6); PG8_BAR;
    } else {
        PG8_STAGE(PG8_SB(0, 0), cB, voffB); PG8_STAGE(PG8_SA(0, 0), cA, voffA); PG8_STAGE(PG8_SB(0, 1), cB + hstep, voffB); PG8_STAGE(PG8_SA(0, 1), cA + hstep, voffA);
        if (wr == 1) PG8_BAR;
        PG8_WAIT_V(4); PG8_BAR;
        PG8_STAGE(PG8_SB(1, 0), cB + kstep, voffB); PG8_STAGE(PG8_SA(1, 0), cA + kstep, voffA); PG8_STAGE(PG8_SB(1, 1), cB + hstep + kstep, voffB);
        PG8_WAIT_V(6); PG8_BAR;
    }
    for (;;) {
        const bool has_next = S.next(ui + 1, nxt);
        const char* nA = has_next ? (const char*)g.A + (size_t)nxt.pm * tstep : cA; const char* nB = has_next ? (const char*)g.Bt + (size_t)nxt.pn * tstep : cB;
        for (int t = 0; t < nt; t += 2) {
            const bool last = (t == nt - 2);
            const char* a1 = cA + (size_t)(t + 1) * kstep;
            const char* a2 = last ? nA : cA + (size_t)(t + 2) * kstep; const char* b2 = last ? nB : cB + (size_t)(t + 2) * kstep;
            const char* a3 = a2 + kstep; const char* b3 = b2 + kstep;
            if (last && has_next) S.a_ready(nxt);
            if constexpr (SP2) {
            PG8_LDB(B0, 0, 0); PG8_LDB(B1, 0, 1); PG8_SCHED; PG8_LDA(At, 0, 0); PG8_STAGE(PG8_SA(1, 1), a1 + hstep, voffA);
            PG8_WAIT_V(8); PG8_WAIT_L(0); PG8_BAR; PG8_MMA(0, 0, At, B0); PG8_MMA(0, 1, At, B1); PG8_BAR; PG8_SCHED;
            PG8_LDA(At, 0, 1); PG8_STAGE(PG8_SB(0, 0), b2, voffB); PG8_STAGE(PG8_SB(0, 1), b2 + hstep, voffB); PG8_STAGE(PG8_SA(0, 0), a2, voffA);
            PG8_WAIT_V(8); PG8_WAIT_L(0); PG8_BAR; PG8_MMA(1, 0, At, B0); PG8_MMA(1, 1, At, B1); PG8_BAR; PG8_SCHED;
            PG8_LDB(B0, 1, 0); PG8_LDB(B1, 1, 1); PG8_SCHED; PG8_LDA(At, 1, 0); PG8_STAGE(PG8_SA(0, 1), a2 + hstep, voffA);
            PG8_WAIT_V(8); PG8_WAIT_L(0); PG8_BAR; PG8_MMA(0, 0, At, B0); PG8_MMA(0, 1, At, B1); PG8_BAR; PG8_SCHED;
            PG8_LDA(At, 1, 1); PG8_STAGE(PG8_SB(1, 0), b3, voffB); PG8_STAGE(PG8_SB(1, 1), b3 + hstep, voffB); PG8_STAGE(PG8_SA(1, 0), a3, voffA);
            PG8_WAIT_V(8); PG8_WAIT_L(0); PG8_BAR; PG8_MMA(1, 0, At, B0); PG8_MMA(1, 1, At, B1); PG8_BAR; PG8_SCHED;
            } else {
            PG8_LDB(B0, 0, 0); PG8_SCHED; PG8_LDA(At, 0, 0); PG8_STAGE(PG8_SA(1, 1), a1 + hstep, voffA);
            PG8_WAIT_L(8); PG8_BAR; PG8_WAIT_L(0); PG8_MMA(0, 0, At, B0); PG8_BAR; PG8_SCHED;
            PG8_LDB(B1, 0, 1); PG8_STAGE(PG8_SB(0, 0), b2, voffB);
            PG8_BAR; PG8_WAIT_L(0); PG8_MMA(0, 1, At, B1); PG8_BAR;
            PG8_LDA(At, 0, 1); PG8_STAGE(PG8_SA(0, 0), a2, voffA);
            PG8_BAR; PG8_WAIT_L(0); PG8_MMA(1, 0, At, B0); PG8_BAR; PG8_SCHED;
            PG8_STAGE(PG8_SB(0, 1), b2 + hstep, voffB);
            PG8_WAIT_V(6); PG8_BAR; PG8_MMA(1, 1, At, B1); PG8_BAR;
            PG8_LDB(B0, 1, 0); PG8_SCHED; PG8_LDA(At, 1, 0); PG8_STAGE(PG8_SA(0, 1), a2 + hstep, voffA);
            PG8_WAIT_L(8); PG8_BAR; PG8_WAIT_L(0); PG8_MMA(0, 0, At, B0); PG8_BAR; PG8_SCHED;
            PG8_LDB(B1, 1, 1); PG8_STAGE(PG8_SB(1, 0), b3, voffB);
            PG8_BAR; PG8_WAIT_L(0); PG8_MMA(0, 1, At, B1); PG8_BAR;
            PG8_LDA(At, 1, 1); PG8_STAGE(PG8_SA(1, 0), a3, voffA);
            PG8_BAR; PG8_WAIT_L(0); PG8_MMA(1, 0, At, B0); PG8_BAR; PG8_SCHED;
            PG8_STAGE(PG8_SB(1, 1), b3 + hstep, voffB);
            PG8_WAIT_V(6); PG8_BAR; PG8_MMA(1, 1, At, B1); PG8_BAR;
            }
        }
        if constexpr (ALIGN_EPI) { if (wr == 0) PG8_BAR; }
        if constexpr (!Epi::AFTER_DRAIN) { E(acc, cur, wr, wc, fr, fq); S.done(cur); }
        if (!has_next) break;
#pragma unroll
        for (int a = 0; a < 2; ++a)
#pragma unroll
            for (int b = 0; b < 2; ++b)
#pragma unroll
                for (int m = 0; m < 4; ++m)
#pragma unroll
                    for (int n = 0; n < 2; ++n) acc[a][b][m][n] = (f32x4){0.f, 0.f, 0.f, 0.f};
        cur = nxt; cA = nA; cB = nB; ++ui;
        if constexpr (ALIGN_EPI) { if (wr == 1) PG8_BAR; }
    }
    PG8_WAIT_V(0);
    if constexpr (!ALIGN_EPI) { if (wr == 0) PG8_BAR; }
    PG8_BAR;
    if constexpr (Epi::AFTER_DRAIN) { E.fused(acc, cur, wr, wc, fr, fq, lds, wid, lane); S.done(cur); }
#undef PG8_SA
#undef PG8_SB
#undef PG8_STAGE
#undef PG8_LDA
#undef PG8_LDB
#undef PG8_MMA
#undef PG8_WAIT_V
#undef PG8_WAIT_L
#undef PG8_BAR
#undef PG8_SCHED
}
}
#define GAS __attribute__((address_space(1)))
#define LAS __attribute__((address_space(3)))
typedef unsigned short bf16;
typedef unsigned v4u __attribute__((ext_vector_type(4)));
typedef float f32x4 __attribute__((ext_vector_type(4)));
typedef short bf16x8 __attribute__((ext_vector_type(8)));
typedef GAS unsigned gu32;
typedef GAS unsigned long long gu64;
#define RLX_AGENT __ATOMIC_RELAXED, __HIP_MEMORY_SCOPE_AGENT
#define LDS_WAIT() asm volatile("s_waitcnt lgkmcnt(0)" ::: "memory")
#define VM_WAIT() asm volatile("s_waitcnt vmcnt(0)" ::: "memory")
__device__ __forceinline__ unsigned long long rt() { return __builtin_amdgcn_s_memrealtime(); }
__device__ __forceinline__ unsigned f2bf(float f) { unsigned u = __builtin_bit_cast(unsigned, f); return (u + 0x7fffu + ((u >> 16) & 1u)) >> 16; }
__device__ __forceinline__ unsigned pk2(float lo, float hi) { return f2bf(lo) | (f2bf(hi) << 16); }

#define XB_TMO      128
#define XB_XCNT(j)  (256  + 64 * (j))
#define XB_XSUB(j)  (1280 + 64 * (j))
#define XB_XGEN(j)  (2304 + 64 * (j))
#define XB_TOP      3328
#define XB_TOPGEN   3392
#define XCD_BAR_WORDS 3456
#define XB_SPIN_CAP (1u << 18)

__device__ __forceinline__ unsigned xb_ld(unsigned* p)              { return __hip_atomic_load(p, __ATOMIC_RELAXED, __HIP_MEMORY_SCOPE_AGENT); }
__device__ __forceinline__ unsigned xb_add(unsigned* p, unsigned v) { return __hip_atomic_fetch_add(p, v, __ATOMIC_RELAXED, __HIP_MEMORY_SCOPE_AGENT); }
__device__ __forceinline__ unsigned xb_xcc_id() { return (unsigned)__builtin_amdgcn_s_getreg((3 << 11) | 20) & 0xFu; }
#define XB_SPIN(cond, bar) do { unsigned _sp = 0; while (cond) { __builtin_amdgcn_s_sleep(1); \
    if ((++_sp & 255u) == 0u) { if (xb_ld(&(bar)[XB_TMO])) break; if (_sp > XB_SPIN_CAP) { atomicAdd(&(bar)[XB_TMO], 1u); break; } } } } while (0)

struct XcdBarrier {
    unsigned* bar; unsigned x;
    volatile LAS unsigned* st;
};

__device__ __forceinline__ XcdBarrier xcd_barrier_post(unsigned* bar, volatile LAS unsigned* st) {
    XcdBarrier b; b.bar = bar; b.x = xb_xcc_id(); b.st = st;
    if (threadIdx.x == 0) (void)xb_add(&bar[XB_XCNT(b.x)], 1u);
    return b;
}
__device__ __forceinline__ void xcd_barrier_complete(unsigned* bar, unsigned x, unsigned& nloc, unsigned& nx) {
    const unsigned G = gridDim.x * gridDim.y * gridDim.z;
    unsigned sum, cnt, mine, sp = 0u;
    for (;;) {
        sum = 0u; cnt = 0u; mine = 0u;
#pragma unroll
        for (unsigned j = 0; j < 16; ++j) { const unsigned c = xb_ld(&bar[XB_XCNT(j)]); sum += c; cnt += (c > 0u) ? 1u : 0u; mine = (j == x) ? c : mine; }
        if (sum == G) break;
        __builtin_amdgcn_s_sleep(1);
        if ((++sp & 255u) == 0u) { if (xb_ld(&bar[XB_TMO])) break; if (sp > XB_SPIN_CAP) { atomicAdd(&bar[XB_TMO], 1u); break; } }
    }
    nloc = mine > 0u ? mine : 1u; nx = cnt > 0u ? cnt : 1u;
}

__device__ __forceinline__ void xcd_barrier(const XcdBarrier& b) {
    asm volatile("s_waitcnt vmcnt(0)" ::: "memory");
    __syncthreads();
    if (threadIdx.x == 0) {
        unsigned* bar = b.bar;
        __builtin_amdgcn_s_waitcnt(0);
        unsigned nloc = b.st[0], nx = b.st[1];
        if (nloc == 0u) { xcd_barrier_complete(bar, b.x, nloc, nx); b.st[0] = nloc; b.st[1] = nx; }
        const unsigned old = xb_add(&bar[XB_XSUB(b.x)], 1u);
        const unsigned gen = old / nloc;
        if (old + 1u == (gen + 1u) * nloc) {
            __builtin_amdgcn_fence(__ATOMIC_RELEASE, "agent");
            asm volatile("s_waitcnt vmcnt(0)" ::: "memory");
            const unsigned og = xb_add(&bar[XB_TOP], 1u);
            const unsigned tg = og / nx;
            if (og + 1u == (tg + 1u) * nx) xb_add(&bar[XB_TOPGEN], 1u);
            else XB_SPIN(xb_ld(&bar[XB_TOPGEN]) == tg, bar);
            __builtin_amdgcn_fence(__ATOMIC_ACQUIRE, "agent");
            xb_add(&bar[XB_XGEN(b.x)], 1u);
            asm volatile("s_waitcnt vmcnt(0)" ::: "memory");
        } else {
            XB_SPIN(xb_ld(&bar[XB_XGEN(b.x)]) == gen, bar);
            __builtin_amdgcn_fence(__ATOMIC_ACQUIRE, "agent");
            asm volatile("s_waitcnt vmcnt(0)" ::: "memory");
        }
    }
    __syncthreads();
}
typedef unsigned u32x2v __attribute__((ext_vector_type(2)));
typedef float f32x2v __attribute__((ext_vector_type(2)));

constexpr int MP = 16384, MROWS = 16640, DMODEL = 1024, DFF = 2816, NBLK64 = MROWS / 64;
constexpr float RMS_EPS = 1e-6f;
constexpr size_t OFF_Y = 0, OFF_WKP = (size_t)MROWS * 1024, OFF_WVP = OFF_WKP + 65536, OFF_SRP = OFF_WVP + 65536, OFF_SIP = OFF_SRP + 8192,
    OFF_CMP = OFF_SIP + 8192, OFF_CFP = OFF_CMP + 8192, OFF_MKP = OFF_CFP + 45056, OFF_MVP = OFF_MKP + 2097152, OFF_WKS = OFF_MVP + 2097152,
    OFF_WVS = OFF_WKS + 32768, OFF_SRS = OFF_WVS + 32768, OFF_SIS = OFF_SRS + 16384, OFF_CMS = OFF_SIS + 16384, OFF_CFS = OFF_CMS + 16384;
constexpr size_t MiB = 1u << 20;
constexpr size_t WS_ROWSS = 0, WS_BAR = 512 * 1024, CTL_ZERO_BYTES = 1 * MiB;
constexpr size_t WS_ROPE = 1 * MiB, WS_SSM = 2 * MiB, WS_CKV = 3 * MiB, WS_SLOC = 4 * MiB, WS_MEMK = 8 * MiB, WS_MEMVT = 20 * MiB, WS_SIDE = 32 * MiB;
constexpr size_t SG_BYTES = (size_t)NBLK64 * 8 * DFF * 4, SV_BYTES = (size_t)NBLK64 * 4 * DFF * 4;
static_assert(WS_SIDE + SG_BYTES + SV_BYTES <= 66 * MiB, "side buffers");
constexpr size_t WS_WT = 66 * MiB, WS_XB = 128 * MiB, WS_TMP = 161 * MiB;
constexpr size_t WT_INEVEN = 0, WT_GLU = WT_INEVEN + 1280 * 1024, WT_OUTEVEN = WT_GLU + 512 * 512, WT_WQ = WT_OUTEVEN + 1024 * 1024, WT_WKV = WT_WQ + 2 * 1024 * 1024,
    WT_WO = WT_WKV + 2 * 2048 * 1024, WT_UP = WT_WO + 2 * 1024 * 1024, WT_DOWN = WT_UP + (size_t)2 * 5632 * 1024, WT_INODD = WT_DOWN + (size_t)2 * 2816 * 1024,
    WT_OUTODD = WT_INODD + 3072 * 1024, WT_END = WT_OUTODD + 1024 * 1024;
static_assert(WS_WT + WT_END * 2 <= WS_XB, "weights");
static_assert(WS_XB + (size_t)MROWS * 1024 * 2 <= WS_TMP, "xb");
constexpr size_t TMP_BYTES = (size_t)MROWS * DFF * 2;
constexpr size_t WS_PART = 251 * MiB, PART_ELEMS = (size_t)MROWS * 16;
static_assert(WS_PART + 2 * PART_ELEMS * 4 <= 256 * MiB, "part");
static_assert(WS_TMP + TMP_BYTES <= 256 * MiB, "ws");
constexpr size_t TMP_PROJ0 = 0, TMP_GBUF = (size_t)MROWS * 1280 * 2, TMP_YCAT = TMP_GBUF + (size_t)MROWS * 512 * 2, TMP_MEMB = TMP_YCAT;
static_assert(TMP_YCAT + (size_t)MROWS * 1024 * 2 <= TMP_BYTES, "tmp");
constexpr size_t TMP_QX = 0, TMP_OX = (size_t)MROWS * 1024 * 2, TMP_ACT = 0, TMP_GB = 0, TMP_ZC = (size_t)MROWS * 1024 * 2;
constexpr int LDS_BYTES = 147456, MISC_OFF = 147456 - 512;
constexpr int NPH = 22;

#define MFMA16(a, b, c) __builtin_amdgcn_mfma_f32_16x16x32_bf16(a, b, c, 0, 0, 0)
__device__ __forceinline__ float bflo(unsigned w) { return __uint_as_float(w << 16); }
__device__ __forceinline__ float bfhi(unsigned w) { return __uint_as_float(w & 0xffff0000u); }
__device__ __forceinline__ v4u pack8(f32x4 a, f32x4 b) { v4u w; w.x = pg8::cvt_pk_bf16(a[0], a[1]); w.y = pg8::cvt_pk_bf16(a[2], a[3]); w.z = pg8::cvt_pk_bf16(b[0], b[1]); w.w = pg8::cvt_pk_bf16(b[2], b[3]); return w; }
__device__ __forceinline__ float rstd_of(const float* part, int row) { const f32x4* p = (const f32x4*)(part + (size_t)row * 16); const f32x4 a = p[0] + p[1] + p[2] + p[3]; return rsqrtf(((a[0] + a[1]) + (a[2] + a[3])) * (1.0f / 1024.0f) + RMS_EPS); }
__device__ __forceinline__ float sigmoidf_(float x) { return 1.0f / (1.0f + __expf(-x)); }
__device__ __forceinline__ float dpp_ror1(float v) { return __builtin_bit_cast(float, __builtin_amdgcn_update_dpp(0, __builtin_bit_cast(int, v), 0x121, 0xf, 0xf, false)); }
__device__ __forceinline__ float dpp_ror2(float v) { return __builtin_bit_cast(float, __builtin_amdgcn_update_dpp(0, __builtin_bit_cast(int, v), 0x122, 0xf, 0xf, false)); }
__device__ __forceinline__ float wave_sum(float v) {
#pragma unroll
    for (int o = 1; o < 64; o <<= 1) v += __shfl_xor(v, o);
    return v;
}

typedef pg8::Unit Unit;
#define EPI_ARGS const f32x4 (&acc)[2][2][4][2], const Unit& u, int wr, int wc, int fr, int fq

struct EpiBf16 {
    static constexpr bool PERM = true, AFTER_DRAIN = false;
    bf16* O; int ldc; const float* rowss;
    __device__ __forceinline__ void operator()(EPI_ARGS) const {
        const int row0 = u.pm * 256 + wr * 64 + fr, col0 = u.pn * 256 + wc * 32 + 8 * fq;
#pragma unroll
        for (int ai = 0; ai < 2; ++ai)
#pragma unroll
            for (int m = 0; m < 4; ++m) { const int row = row0 + ai * 128 + m * 16; const float rs = rstd_of(rowss, row); bf16* rp = O + (size_t)row * ldc + col0;
#pragma unroll
                for (int bj = 0; bj < 2; ++bj) *(v4u*)(rp + bj * 128) = pack8(acc[ai][bj][m][0] * rs, acc[ai][bj][m][1] * rs); }
    }
};
struct EpiRes {
    static constexpr bool PERM = true, AFTER_DRAIN = false;
    const float* base_p; const float* base_s; bf16* xb; float* rowss_next; int f32base;
    __device__ __forceinline__ void operator()(EPI_ARGS) const {
        const float* base = u.pm < 64 ? base_p : base_s;
        const int row0 = u.pm * 256 + wr * 64 + fr, col0 = u.pn * 256 + wc * 32 + 8 * fq;
#pragma unroll
        for (int ai = 0; ai < 2; ++ai)
#pragma unroll
            for (int m = 0; m < 4; ++m) { const int row = row0 + ai * 128 + m * 16; const size_t off = (size_t)row * 1024 + col0; float ss = 0.f;
#pragma unroll
                for (int bj = 0; bj < 2; ++bj) { f32x4 b0, b1;
                    if (f32base) { b0 = __builtin_nontemporal_load((const f32x4*)(base + off + bj * 128)); b1 = __builtin_nontemporal_load((const f32x4*)(base + off + bj * 128 + 4)); }
                    else { const v4u w = *(const v4u*)(xb + off + bj * 128); b0 = (f32x4){bflo(w.x), bfhi(w.x), bflo(w.y), bfhi(w.y)}; b1 = (f32x4){bflo(w.z), bfhi(w.z), bflo(w.w), bfhi(w.w)}; }
                    const f32x4 v0 = acc[ai][bj][m][0] + b0, v1 = acc[ai][bj][m][1] + b1;
                    *(v4u*)(xb + off + bj * 128) = pack8(v0, v1);
                    ss += (v0[0] * v0[0] + v0[1] * v0[1]) + (v0[2] * v0[2] + v0[3] * v0[3]) + (v1[0] * v1[0] + v1[1] * v1[1]) + (v1[2] * v1[2] + v1[3] * v1[3]); }
                ss += __shfl_xor(ss, 16); ss += __shfl_xor(ss, 32);
                if (fq == 0) rowss_next[(size_t)row * 16 + u.pn * 4 + wc] = ss; }
    }
};
struct EpiGlu {
    static constexpr bool PERM = true, AFTER_DRAIN = false;
    const bf16* g; bf16* ycat;
    __device__ __forceinline__ void operator()(EPI_ARGS) const {
        const int row0 = u.pm * 256 + wr * 64 + fr, col0 = u.pn * 256 + wc * 32 + 8 * fq;
#pragma unroll
        for (int ai = 0; ai < 2; ++ai)
#pragma unroll
            for (int m = 0; m < 4; ++m) { const int row = row0 + ai * 128 + m * 16;
#pragma unroll
                for (int bj = 0; bj < 2; ++bj) { const int col = col0 + bj * 128; const v4u gw = *(const v4u*)(g + (size_t)row * 512 + col);
                    const f32x4 a0 = acc[ai][bj][m][0], a1 = acc[ai][bj][m][1]; f32x4 o0, o1;
                    o0[0] = bflo(gw.x) * sigmoidf_(a0[0]); o0[1] = bfhi(gw.x) * sigmoidf_(a0[1]); o0[2] = bflo(gw.y) * sigmoidf_(a0[2]); o0[3] = bfhi(gw.y) * sigmoidf_(a0[3]);
                    o1[0] = bflo(gw.z) * sigmoidf_(a1[0]); o1[1] = bfhi(gw.z) * sigmoidf_(a1[1]); o1[2] = bflo(gw.w) * sigmoidf_(a1[2]); o1[3] = bfhi(gw.w) * sigmoidf_(a1[3]);
                    *(v4u*)(ycat + (size_t)row * 1024 + col) = pack8(o0, o1); } }
    }
};
struct EpiKV {
    static constexpr bool PERM = true, AFTER_DRAIN = false;
    float* out; bf16* memk;
    __device__ __forceinline__ void operator()(EPI_ARGS) const {
        const int row0 = u.pm * 256 + wr * 64 + fr, col0 = u.pn * 256 + wc * 32 + 8 * fq;
#pragma unroll
        for (int ai = 0; ai < 2; ++ai)
#pragma unroll
            for (int m = 0; m < 4; ++m) { const int row = row0 + ai * 128 + m * 16;
#pragma unroll
                for (int bj = 0; bj < 2; ++bj) { const int c = col0 + bj * 128, l = c >> 11, e = c & 2047, isv = e >> 10, dc = e & 1023;
                    float* op = out + (isv ? OFF_MVP : OFF_MKP) + (size_t)l * 1048576 + (size_t)row * 1024 + dc;
                    *(f32x4*)op = acc[ai][bj][m][0]; *(f32x4*)(op + 4) = acc[ai][bj][m][1];
                    if (!isv) *(v4u*)(memk + (size_t)l * 12 * 262144 + (size_t)row * 1024 + dc) = pack8(acc[ai][bj][m][0], acc[ai][bj][m][1]); } }
    }
};
struct EpiIn0 {
    static constexpr bool PERM = true, AFTER_DRAIN = false;
    bf16* proj; const float* rowss; const float* ropec; const float* ropes; float* out;
    __device__ __forceinline__ void operator()(EPI_ARGS) const {
        const int pn = u.pn;
#pragma unroll
        for (int ai = 0; ai < 2; ++ai)
#pragma unroll
            for (int m = 0; m < 4; ++m) { const int row = u.pm * 256 + ai * 128 + wr * 64 + m * 16 + fr; const float rs = rstd_of(rowss, row);
                const int pos = row < MP ? (row & 4095) : 2048 + (row & 31);
                bf16* rp = proj + (size_t)row * 1280;
                float* wk = nullptr; float* wv = nullptr;
                if (pn == 4) { if (row >= MP) { wk = out + OFF_WKS + (size_t)(row - MP) * 128; wv = out + OFF_WVS + (size_t)(row - MP) * 128; }
                               else if ((row & 4095) >= 3968) { const size_t o = (size_t)((row >> 12) * 128 + (row & 4095) - 3968) * 128; wk = out + OFF_WKP + o; wv = out + OFF_WVP + o; } }
#pragma unroll
                for (int bj = 0; bj < 2; ++bj) { const f32x4 v0 = acc[ai][bj][m][0] * rs, v1 = acc[ai][bj][m][1] * rs;
                    const bool rope = (pn == 2 || pn == 3 || (pn == 4 && bj == 0));
                    if (!rope) { const int col = pn * 256 + bj * 128 + wc * 32 + 8 * fq; *(v4u*)(rp + col) = pack8(v0, v1);
                        if (pn == 4 && wv) { *(f32x4*)(wv + wc * 32 + 8 * fq) = v0; *(f32x4*)(wv + wc * 32 + 8 * fq + 4) = v1; } }
                    else { const int gbase = pn * 256 + bj * 128 + (wc >> 1) * 64, d1 = 16 * (wc & 1) + 4 * fq;
                        const f32x4 c4 = *(const f32x4*)(ropec + pos * 32 + d1), s4 = *(const f32x4*)(ropes + pos * 32 + d1);
                        f32x4 o1 = v0 * c4 - v1 * s4, o2 = v1 * c4 + v0 * s4;
                        if (pn != 4) { o1 = o1 * 0.125f; o2 = o2 * 0.125f; }
                        u32x2v w1, w2; w1.x = pg8::cvt_pk_bf16(o1[0], o1[1]); w1.y = pg8::cvt_pk_bf16(o1[2], o1[3]); w2.x = pg8::cvt_pk_bf16(o2[0], o2[1]); w2.y = pg8::cvt_pk_bf16(o2[2], o2[3]);
                        *(u32x2v*)(rp + gbase + d1) = w1; *(u32x2v*)(rp + gbase + d1 + 32) = w2;
                        if (pn == 4 && wk) { const int cc = (wc >> 1) * 64 + d1; *(f32x4*)(wk + cc) = o1; *(f32x4*)(wk + cc + 32) = o2; } } } }
    }
};
struct EpiFfnUp {
    static constexpr bool PERM = true, AFTER_DRAIN = false;
    bf16* act; const float* rowss; const float* cw; float* SG; float* SV;
    __device__ __forceinline__ void operator()(EPI_ARGS) const {
        const int c0 = u.pn * 128 + wc * 32 + 8 * fq; const bool sample = u.pm == 64;
        const f32x4 w0a = *(const f32x4*)(cw + c0), w0b = *(const f32x4*)(cw + c0 + 4), w1a = *(const f32x4*)(cw + DFF + c0), w1b = *(const f32x4*)(cw + DFF + c0 + 4),
                    w2a = *(const f32x4*)(cw + 2 * DFF + c0), w2b = *(const f32x4*)(cw + 2 * DFF + c0 + 4);
#pragma unroll
        for (int ai = 0; ai < 2; ++ai) { f32x4 gp0 = {0.f, 0.f, 0.f, 0.f}, gp1 = {0.f, 0.f, 0.f, 0.f}; const int blk = u.pm * 4 + ai * 2 + wr;
#pragma unroll
            for (int m = 0; m < 4; ++m) { const int row = u.pm * 256 + ai * 128 + wr * 64 + m * 16 + fr; const float rs = rstd_of(rowss, row);
                const f32x4 g0 = acc[ai][0][m][0] * rs, g1 = acc[ai][0][m][1] * rs, v0 = acc[ai][1][m][0] * rs, v1 = acc[ai][1][m][1] * rs;
                f32x4 p1a, p2a, p1b, p2b;
#pragma unroll
                for (int j = 0; j < 4; ++j) { const float s1a = fr == 15 ? gp0[j] : g0[j], s2a = fr >= 14 ? gp0[j] : g0[j], s1b = fr == 15 ? gp1[j] : g1[j], s2b = fr >= 14 ? gp1[j] : g1[j];
                    p1a[j] = dpp_ror1(s1a); p2a[j] = dpp_ror2(s2a); p1b[j] = dpp_ror1(s1b); p2b[j] = dpp_ror2(s2b); }
                const f32x4 ca = w0a * p2a + w1a * p1a + w2a * g0, cb = w0b * p2b + w1b * p1b + w2b * g1;
                f32x4 sa, sb;
#pragma unroll
                for (int j = 0; j < 4; ++j) { sa[j] = sigmoidf_(ca[j]); sb[j] = sigmoidf_(cb[j]); }
                const f32x4 a0 = ca * sa * v0, a1 = cb * sb * v1;
                const bool valid = (m > 0 || fr >= 2) && !(sample && m == 2 && fr < 2);
                if (valid) *(v4u*)(act + (size_t)row * DFF + c0) = pack8(a0, a1);
                if ((m & 1) == 0 && fr < 2) { float* sg = SG + (size_t)(blk * 8 + 2 * m + fr) * DFF + c0; *(f32x4*)sg = g0; *(f32x4*)(sg + 4) = g1;
                                              float* sv = SV + (size_t)(blk * 4 + m + fr) * DFF + c0; *(f32x4*)sv = v0; *(f32x4*)(sv + 4) = v1; }
                if ((m & 1) == 1 && fr >= 14) { float* sg = SG + (size_t)(blk * 8 + 2 * m + fr - 14) * DFF + c0; *(f32x4*)sg = g0; *(f32x4*)(sg + 4) = g1; }
                gp0 = g0; gp1 = g1; } }
    }
};
struct EpiInOdd {
    static constexpr bool PERM = true, AFTER_DRAIN = false;
    bf16* gb; bf16* zc; const float* rowss; const float* cw; float* SG;
    __device__ __forceinline__ void operator()(EPI_ARGS) const {
        if (u.pn < 4) {
            const int row0 = u.pm * 256 + wr * 64 + fr, col0 = u.pn * 256 + wc * 32 + 8 * fq;
#pragma unroll
            for (int ai = 0; ai < 2; ++ai)
#pragma unroll
                for (int m = 0; m < 4; ++m) { const int row = row0 + ai * 128 + m * 16; const float rs = rstd_of(rowss, row); bf16* rp = gb + (size_t)row * 1024 + col0;
#pragma unroll
                    for (int bj = 0; bj < 2; ++bj) *(v4u*)(rp + bj * 128) = pack8(acc[ai][bj][m][0] * rs, acc[ai][bj][m][1] * rs); }
            return;
        }
        const int c0 = (u.pn - 4) * 128 + wc * 32 + 8 * fq; const bool sample = u.pm == 64;
        const f32x4 w0a = *(const f32x4*)(cw + c0), w0b = *(const f32x4*)(cw + c0 + 4), w1a = *(const f32x4*)(cw + 1024 + c0), w1b = *(const f32x4*)(cw + 1024 + c0 + 4),
                    w2a = *(const f32x4*)(cw + 2048 + c0), w2b = *(const f32x4*)(cw + 2048 + c0 + 4);
#pragma unroll
        for (int ai = 0; ai < 2; ++ai) { f32x4 gp0 = {0.f, 0.f, 0.f, 0.f}, gp1 = {0.f, 0.f, 0.f, 0.f}; const int blk = u.pm * 4 + ai * 2 + wr;
#pragma unroll
            for (int m = 0; m < 4; ++m) { const int row = u.pm * 256 + ai * 128 + wr * 64 + m * 16 + fr; const float rs = rstd_of(rowss, row); const float rs2 = rs * rs;
                const f32x4 g0 = acc[ai][0][m][0] * acc[ai][1][m][0] * rs2, g1 = acc[ai][0][m][1] * acc[ai][1][m][1] * rs2;
                f32x4 p1a, p2a, p1b, p2b;
#pragma unroll
                for (int j = 0; j < 4; ++j) { const float s1a = fr == 15 ? gp0[j] : g0[j], s2a = fr >= 14 ? gp0[j] : g0[j], s1b = fr == 15 ? gp1[j] : g1[j], s2b = fr >= 14 ? gp1[j] : g1[j];
                    p1a[j] = dpp_ror1(s1a); p2a[j] = dpp_ror2(s2a); p1b[j] = dpp_ror1(s1b); p2b[j] = dpp_ror2(s2b); }
                const f32x4 a0 = w0a * p2a + w1a * p1a + w2a * g0, a1 = w0b * p2b + w1b * p1b + w2b * g1;
                const bool valid = (m > 0 || fr >= 2) && !(sample && m == 2 && fr < 2);
                if (valid) *(v4u*)(zc + (size_t)row * 1024 + c0) = pack8(a0, a1);
                if ((m & 1) == 0 && fr < 2) { float* sg = SG + (size_t)(blk * 8 + 2 * m + fr) * 1024 + c0; *(f32x4*)sg = g0; *(f32x4*)(sg + 4) = g1; }
                if ((m & 1) == 1 && fr >= 14) { float* sg = SG + (size_t)(blk * 8 + 2 * m + fr - 14) * 1024 + c0; *(f32x4*)sg = g0; *(f32x4*)(sg + 4) = g1; }
                gp0 = g0; gp1 = g1; } }
    }
};


struct EpiCz {
    static constexpr bool PERM = true, AFTER_DRAIN = false;
    bf16* gb; const float* rowss; const float* cw; float* SG;
    __device__ __forceinline__ void operator()(EPI_ARGS) const {
        const int c0 = u.pn * 128 + wc * 32 + 8 * fq;
        const f32x4 w0a = *(const f32x4*)(cw + c0), w0b = *(const f32x4*)(cw + c0 + 4), w1a = *(const f32x4*)(cw + 1024 + c0), w1b = *(const f32x4*)(cw + 1024 + c0 + 4),
                    w2a = *(const f32x4*)(cw + 2048 + c0), w2b = *(const f32x4*)(cw + 2048 + c0 + 4);
#pragma unroll
        for (int ai = 0; ai < 2; ++ai) { f32x4 gp0 = {0.f, 0.f, 0.f, 0.f}, gp1 = {0.f, 0.f, 0.f, 0.f}; const int blk = u.pm * 4 + ai * 2 + wr;
#pragma unroll
            for (int m = 0; m < 4; ++m) { const int row = u.pm * 256 + ai * 128 + wr * 64 + m * 16 + fr; const float rs = rstd_of(rowss, row); const float rs2 = rs * rs;
                const f32x4 g0 = acc[ai][0][m][0] * acc[ai][1][m][0] * rs2, g1 = acc[ai][0][m][1] * acc[ai][1][m][1] * rs2;
                f32x4 p1a, p2a, p1b, p2b;
#pragma unroll
                for (int j = 0; j < 4; ++j) { const float s1a = fr == 15 ? gp0[j] : g0[j], s2a = fr >= 14 ? gp0[j] : g0[j], s1b = fr == 15 ? gp1[j] : g1[j], s2b = fr >= 14 ? gp1[j] : g1[j];
                    p1a[j] = dpp_ror1(s1a); p2a[j] = dpp_ror2(s2a); p1b[j] = dpp_ror1(s1b); p2b[j] = dpp_ror2(s2b); }
                const f32x4 a0 = w0a * p2a + w1a * p1a + w2a * g0, a1 = w0b * p2b + w1b * p1b + w2b * g1;
                if (m > 0 || fr >= 2) { bf16* gp = gb + (size_t)row * 1024 + c0; const v4u gw = *(const v4u*)gp;
                    const f32x4 b0 = (f32x4){bflo(gw.x), bfhi(gw.x), bflo(gw.y), bfhi(gw.y)}, b1 = (f32x4){bflo(gw.z), bfhi(gw.z), bflo(gw.w), bfhi(gw.w)};
                    *(v4u*)gp = pack8(a0 * b0, a1 * b1); }
                if ((m & 1) == 0 && fr < 2) { float* sg = SG + (size_t)(blk * 8 + 2 * m + fr) * 1024 + c0; *(f32x4*)sg = g0; *(f32x4*)(sg + 4) = g1; }
                if ((m & 1) == 1 && fr >= 14) { float* sg = SG + (size_t)(blk * 8 + 2 * m + fr - 14) * 1024 + c0; *(f32x4*)sg = g0; *(f32x4*)(sg + 4) = g1; }
                gp0 = g0; gp1 = g1; } }
    }
};

__device__ __forceinline__ int rowmap(int mode, int n) {
    if (mode == 1) { if (n >= 512 && n < 1152) { const int d = n & 63; return (n & ~63) | (32 * ((d >> 4) & 1) + 8 * ((d >> 2) & 3) + 4 * (d >> 5) + (d & 3)); } return n; }
    if (mode == 2) { return n < DFF ? ((n >> 7) * 256 + (n & 127)) : (((n - DFF) >> 7) * 256 + 128 + ((n - DFF) & 127)); }
    if (mode == 3) { if (n < 1024) return n; const int c = (n - 1024) & 1023, z = n >= 2048 ? 1 : 0; return 1024 + (c >> 7) * 256 + z * 128 + (c & 127); }
    return n;
}
__device__ __forceinline__ void tr_item(const float* W, int K, int N, bf16* WT, const float* gain, float scale, int mode, LAS float* scr, int item, int lane) {
    const int nblk = N / 32, kb = item / nblk, nb = item % nblk, k0 = 64 * kb, n0 = 32 * nb;
#pragma unroll
    for (int i = 0; i < 8; ++i) { const int idx = lane + 64 * i, kk = idx >> 3, n4 = (idx & 7) * 4; const float gs = gain ? ((const GAS float*)gain)[k0 + kk] * scale : scale;
        const f32x4 w = __builtin_nontemporal_load((const GAS f32x4*)((const GAS float*)W + (size_t)(k0 + kk) * N + n0 + n4)); LAS float* d = scr + kk * 33 + n4; d[0] = w[0] * gs; d[1] = w[1] * gs; d[2] = w[2] * gs; d[3] = w[3] * gs; }
    LDS_WAIT(); asm volatile("" ::: "memory");
    const int c = lane & 7;
#pragma unroll
    for (int j = 0; j < 4; ++j) { const int n = (lane >> 3) + 8 * j; const LAS float* s = scr + (8 * c) * 33 + n;
        v4u o; o.x = pg8::cvt_pk_bf16(s[0 * 33], s[1 * 33]); o.y = pg8::cvt_pk_bf16(s[2 * 33], s[3 * 33]); o.z = pg8::cvt_pk_bf16(s[4 * 33], s[5 * 33]); o.w = pg8::cvt_pk_bf16(s[6 * 33], s[7 * 33]);
        *(GAS v4u*)((GAS bf16*)WT + (size_t)rowmap(mode, n0 + n) * K + k0 + 8 * c) = o; }
    LDS_WAIT(); asm volatile("" ::: "memory");
}
__device__ __forceinline__ double dexp_(double y) {
    const double k = rint(y * 1.4426950408889634); const double r = (y - k * 0.6931471803691238) - k * 1.9082149292705877e-10;
    double p = 1.0 / 6227020800.0;
    p = p * r + 1.0 / 479001600.0; p = p * r + 1.0 / 39916800.0; p = p * r + 1.0 / 3628800.0; p = p * r + 1.0 / 362880.0; p = p * r + 1.0 / 40320.0; p = p * r + 1.0 / 5040.0;
    p = p * r + 1.0 / 720.0; p = p * r + 1.0 / 120.0; p = p * r + 1.0 / 24.0; p = p * r + 1.0 / 6.0; p = p * r + 0.5; p = p * r + 1.0; p = p * r + 1.0;
    const long long bits = (long long)(1023 + (int)k) << 52; return p * __builtin_bit_cast(double, bits);
}
__device__ __forceinline__ void dsincos_(double x, double& s, double& c) {
    const double k = rint(x * 0.6366197723675814); const double r = (x - k * 1.5707963267948966) - k * 6.123233995736766e-17; const double r2 = r * r;
    const double sp = r * (1.0 + r2 * (-1.0 / 6.0 + r2 * (1.0 / 120.0 + r2 * (-1.0 / 5040.0 + r2 * (1.0 / 362880.0 + r2 * (-1.0 / 39916800.0 + r2 * (1.0 / 6227020800.0)))))));
    const double cp = 1.0 + r2 * (-0.5 + r2 * (1.0 / 24.0 + r2 * (-1.0 / 720.0 + r2 * (1.0 / 40320.0 + r2 * (-1.0 / 3628800.0 + r2 * (1.0 / 479001600.0 + r2 * (-1.0 / 87178291200.0)))))));
    const int q = ((int)k) & 3;
    s = q == 0 ? sp : q == 1 ? cp : q == 2 ? -sp : -cp; c = q == 0 ? cp : q == 1 ? -sp : q == 2 ? -cp : sp;
}

__device__ __forceinline__ const bf16* kvptr(const bf16* proj, const bf16* cb, int sample, int b, int c, int kvh, int kk, int isv) {
    if (!sample) { int pos = (c - 2) * 64 + kk; pos = pos < 0 ? 0 : pos; return proj + (size_t)(b * 4096 + pos) * 1280 + 1024 + isv * 128 + kvh * 64; }
    if (kk < 128) return cb + (size_t)(b * 128 + kk) * 128 + kvh * 64;
    int t = kk - 128; t = t > 31 ? 31 : t; return proj + (size_t)(MP + b * 32 + t) * 1280 + 1024 + isv * 128 + kvh * 64;
}
__device__ __forceinline__ void swa_phase(const bf16* proj, const bf16* ckb, const bf16* cvb, const float* sinks, bf16* ycat, LAS unsigned char* lds, int tid, int wave, int lane, int G) {
    LAS bf16* VT = (LAS bf16*)lds;
    const int fr = lane & 15, quad = lane >> 4;
    for (int it = blockIdx.x; it < 528; it += G) {
        int b, c, kvh, sample;
        if (it < 512) { sample = 0; b = it >> 7; c = (it >> 1) & 63; kvh = it & 1; } else { sample = 1; b = (it - 512) >> 1; c = 0; kvh = it & 1; }
        const int gq = wave >> 1, qhalf = wave & 1, head = kvh * 4 + gq;
        bf16x8 qf[2][2], kf0[4][2];
#pragma unroll
        for (int qb = 0; qb < 2; ++qb) { const int q = qhalf * 32 + qb * 16 + fr; const int row = sample ? MP + b * 32 + (q & 31) : b * 4096 + c * 64 + q;
            const GAS bf16* qp = (const GAS bf16*)proj + (size_t)row * 1280 + 512 + head * 64 + quad * 8; qf[qb][0] = *(const GAS bf16x8*)qp; qf[qb][1] = *(const GAS bf16x8*)(qp + 32); }
#pragma unroll
        for (int i = 0; i < 4; ++i) { const int key = 32 * (i >> 1) + (fr >> 2) * 8 + 4 * (i & 1) + (fr & 3); const GAS bf16* kp = (const GAS bf16*)kvptr(proj, ckb, sample, b, c, kvh, key, 0) + quad * 8;
            kf0[i][0] = *(const GAS bf16x8*)kp; kf0[i][1] = *(const GAS bf16x8*)(kp + 32); }
        __syncthreads();
#pragma unroll
        for (int i = 0; i < 3; ++i) { const int idx = tid + 512 * i, kk = idx % 192, dg = idx / 192; const v4u w = *(const GAS v4u*)((const GAS bf16*)kvptr(proj, cvb, sample, b, c, kvh, kk, 1) + dg * 8);
            LAS bf16* vp = VT + (dg * 8) * 200 + kk;
            vp[0] = (bf16)(w.x & 0xffffu); vp[200] = (bf16)(w.x >> 16); vp[400] = (bf16)(w.y & 0xffffu); vp[600] = (bf16)(w.y >> 16);
            vp[800] = (bf16)(w.z & 0xffffu); vp[1000] = (bf16)(w.z >> 16); vp[1200] = (bf16)(w.w & 0xffffu); vp[1400] = (bf16)(w.w >> 16); }
        __syncthreads();
        if (!(sample && qhalf)) {
            const int plo = sample ? 0 : (c >= 2 ? 0 : (2 - c) * 2), phi = sample ? 5 : 6;
            f32x4 s[12][2];
#pragma unroll
            for (int kg = 0; kg < 3; ++kg) { bf16x8 kf[4][2];
#pragma unroll
                for (int i = 0; i < 4; ++i) { if (kg == 0) { kf[i][0] = kf0[i][0]; kf[i][1] = kf0[i][1]; continue; } const int kb = kg * 4 + i, key = 32 * (kb >> 1) + (fr >> 2) * 8 + 4 * (kb & 1) + (fr & 3); const GAS bf16* kp = (const GAS bf16*)kvptr(proj, ckb, sample, b, c, kvh, key, 0) + quad * 8;
                    kf[i][0] = *(const GAS bf16x8*)kp; kf[i][1] = *(const GAS bf16x8*)(kp + 32); }
                __builtin_amdgcn_sched_barrier(0);
#pragma unroll
                for (int i = 0; i < 4; ++i)
#pragma unroll
                    for (int qb = 0; qb < 2; ++qb) { f32x4 a = {0.f, 0.f, 0.f, 0.f}; a = MFMA16(kf[i][0], qf[qb][0], a); a = MFMA16(kf[i][1], qf[qb][1], a); s[kg * 4 + i][qb] = a; }
                __builtin_amdgcn_sched_barrier(0); }
            const float sink = sinks[head];
            bf16x8 pf[6][2];
#pragma unroll
            for (int qb = 0; qb < 2; ++qb) { float mx = sink;
#pragma unroll
                for (int kb = 0; kb < 12; ++kb) { const bool pv = (kb >> 1) >= plo && (kb >> 1) < phi;
#pragma unroll
                    for (int j = 0; j < 4; ++j) { const float v = pv ? s[kb][qb][j] : -1e30f; s[kb][qb][j] = v; mx = fmaxf(mx, v); } }
                mx = fmaxf(mx, __shfl_xor(mx, 16)); mx = fmaxf(mx, __shfl_xor(mx, 32));
                float sum = 0.f;
#pragma unroll
                for (int kb = 0; kb < 12; ++kb)
#pragma unroll
                    for (int j = 0; j < 4; ++j) { const float e = __expf(s[kb][qb][j] - mx); s[kb][qb][j] = e; sum += e; }
                sum += __shfl_xor(sum, 16); sum += __shfl_xor(sum, 32); sum += __expf(sink - mx);
                const float inv = 1.0f / sum;
#pragma unroll
                for (int pr = 0; pr < 6; ++pr) pf[pr][qb] = __builtin_bit_cast(bf16x8, pack8(s[2 * pr][qb] * inv, s[2 * pr + 1][qb] * inv)); }
#pragma unroll
            for (int db = 0; db < 4; ++db) { bf16x8 vf[6];
#pragma unroll
                for (int pr = 0; pr < 6; ++pr) vf[pr] = *(const LAS bf16x8*)(VT + (db * 16 + fr) * 200 + 32 * pr + quad * 8);
#pragma unroll
                for (int qb = 0; qb < 2; ++qb) { f32x4 o = {0.f, 0.f, 0.f, 0.f};
#pragma unroll
                    for (int pr = 0; pr < 6; ++pr) o = MFMA16(pf[pr][qb], vf[pr], o);
#pragma unroll
                    for (int j = 0; j < 4; ++j) { const int q = qhalf * 32 + qb * 16 + quad * 4 + j;
                        if (!sample || q < 32) { const int row = sample ? MP + b * 32 + q : b * 4096 + c * 64 + q; ycat[(size_t)row * 1024 + 512 + head * 64 + db * 16 + fr] = (bf16)f2bf(o[j]); } } } }
        }
    }
    __syncthreads();
}

__device__ __forceinline__ void xattn_phase(const bf16* qx, const bf16* memk_l, const bf16* memvT_l, bf16* ox, int wave, int lane, int G) {
    const int fr = lane & 15, quad = lane >> 4;
    for (int t = wave * G + (int)blockIdx.x; t < 4160; t += 8 * G) {
        int bb, h, row0;
        if (t < 4096) { const int pair = t >> 8; bb = pair >> 2; h = pair & 3; row0 = bb * 4096 + (t & 255) * 16; }
        else { const int s = t - 4096, b = s >> 3; h = (s >> 1) & 3; bb = 4 + b; row0 = MP + b * 32 + (s & 1) * 16; }
        bf16x8 qf[8];
#pragma unroll
        for (int ks = 0; ks < 8; ++ks) qf[ks] = *(const bf16x8*)(qx + (size_t)(row0 + fr) * 1024 + h * 256 + ks * 32 + quad * 8);
        const bf16* kbase = memk_l + (size_t)bb * 262144 + h * 256 + quad * 8;
        f32x4 s[16];
#pragma unroll
        for (int kb = 0; kb < 16; ++kb) { const int key = 32 * (kb >> 1) + (fr >> 2) * 8 + 4 * (kb & 1) + (fr & 3); const bf16* kp = kbase + (size_t)key * 1024; f32x4 a = {0.f, 0.f, 0.f, 0.f};
#pragma unroll
            for (int ks = 0; ks < 8; ++ks) a = MFMA16(*(const bf16x8*)(kp + ks * 32), qf[ks], a);
            s[kb] = a; }
        float mx = -1e30f;
#pragma unroll
        for (int kb = 0; kb < 16; ++kb)
#pragma unroll
            for (int j = 0; j < 4; ++j) mx = fmaxf(mx, s[kb][j]);
        mx = fmaxf(mx, __shfl_xor(mx, 16)); mx = fmaxf(mx, __shfl_xor(mx, 32));
        float sum = 0.f;
#pragma unroll
        for (int kb = 0; kb < 16; ++kb)
#pragma unroll
            for (int j = 0; j < 4; ++j) { const float e = __expf(s[kb][j] - mx); s[kb][j] = e; sum += e; }
        sum += __shfl_xor(sum, 16); sum += __shfl_xor(sum, 32);
        const float inv = 1.0f / sum;
        bf16x8 pf[8];
#pragma unroll
        for (int pr = 0; pr < 8; ++pr) pf[pr] = __builtin_bit_cast(bf16x8, pack8(s[2 * pr] * inv, s[2 * pr + 1] * inv));
        const bf16* vbase = memvT_l + (size_t)bb * 262144 + (size_t)(h * 256 + fr) * 256 + quad * 8;
#pragma unroll 4
        for (int db = 0; db < 16; ++db) { f32x4 o = {0.f, 0.f, 0.f, 0.f};
#pragma unroll
            for (int pr = 0; pr < 8; ++pr) o = MFMA16(pf[pr], *(const bf16x8*)(vbase + (size_t)db * 4096 + pr * 32), o);
#pragma unroll
            for (int j = 0; j < 4; ++j) ox[(size_t)(row0 + quad * 4 + j) * 1024 + h * 256 + db * 16 + fr] = (bf16)f2bf(o[j]); }
    }
}


__device__ __forceinline__ void xstage(const bf16* src, size_t rowstride, LAS unsigned char* lds, int tid) {
    v4u t[16];
#pragma unroll
    for (int i = 0; i < 16; ++i) { const int row = (tid >> 5) + 16 * i, ch = tid & 31; t[i] = *(const GAS v4u*)((const GAS bf16*)src + (size_t)row * rowstride + ch * 8); }
#pragma unroll
    for (int i = 0; i < 16; ++i) { const int row = (tid >> 5) + 16 * i, ch = tid & 31; *(LAS v4u*)(lds + row * 528 + ch * 16) = t[i]; }
}
__device__ __forceinline__ void xattn_phase2(const bf16* qx, const bf16* memk_l, const bf16* memvT_l, bf16* ox, LAS unsigned char* lds, int tid, int wave, int lane, int G) {
    const int fr = lane & 15, quad = lane >> 4;
    for (int it = blockIdx.x; it < 256 + 32; it += G) {
        int bb, h, rowbase, nqb; bool active;
        if (it < 256) { bb = it >> 6; h = (it >> 4) & 3; rowbase = bb * 4096 + (it & 15) * 256; nqb = 2; active = true; }
        else { const int s = it - 256, b = s >> 2; h = s & 3; bb = 4 + b; rowbase = MP + b * 32; nqb = 1; active = wave < 2; }
        __syncthreads();
        xstage(memk_l + (size_t)bb * 262144 + h * 256, 1024, lds, tid);
        __syncthreads();
        bf16x8 pf[2][8];
#pragma unroll
        for (int qi = 0; qi < 2; ++qi) {
            if (qi < nqb && active) {
                const int row0 = rowbase + qi * 128 + wave * 16;
                bf16x8 qf[8];
#pragma unroll
                for (int ks = 0; ks < 8; ++ks) qf[ks] = *(const GAS bf16x8*)((const GAS bf16*)qx + (size_t)(row0 + fr) * 1024 + h * 256 + ks * 32 + quad * 8);
                f32x4 s[16];
#pragma unroll
                for (int kb = 0; kb < 16; ++kb) { const int key = 32 * (kb >> 1) + (fr >> 2) * 8 + 4 * (kb & 1) + (fr & 3); const LAS unsigned char* kp = lds + key * 528 + quad * 16; f32x4 a = {0.f, 0.f, 0.f, 0.f};
#pragma unroll
                    for (int ks = 0; ks < 8; ++ks) a = MFMA16(*(const LAS bf16x8*)(kp + ks * 64), qf[ks], a);
                    s[kb] = a; }
                float mx = -1e30f;
#pragma unroll
                for (int kb = 0; kb < 16; ++kb)
#pragma unroll
                    for (int j = 0; j < 4; ++j) mx = fmaxf(mx, s[kb][j]);
                mx = fmaxf(mx, __shfl_xor(mx, 16)); mx = fmaxf(mx, __shfl_xor(mx, 32));
                float sum = 0.f;
#pragma unroll
                for (int kb = 0; kb < 16; ++kb)
#pragma unroll
                    for (int j = 0; j < 4; ++j) { const float e = __expf(s[kb][j] - mx); s[kb][j] = e; sum += e; }
                sum += __shfl_xor(sum, 16); sum += __shfl_xor(sum, 32);
                const float inv = 1.0f / sum;
#pragma unroll
                for (int pr = 0; pr < 8; ++pr) pf[qi][pr] = __builtin_bit_cast(bf16x8, pack8(s[2 * pr] * inv, s[2 * pr + 1] * inv));
            }
        }
        __syncthreads();
        xstage(memvT_l + (size_t)bb * 262144 + (size_t)h * 65536, 256, lds, tid);
        __syncthreads();
        if (active) {
            const int rowA = rowbase + wave * 16, rowB = rowA + 128;
#pragma unroll 4
            for (int db = 0; db < 16; ++db) { f32x4 oa = {0.f, 0.f, 0.f, 0.f}, ob = {0.f, 0.f, 0.f, 0.f}; const LAS unsigned char* vp = lds + (db * 16 + fr) * 528 + quad * 16;
                if (nqb == 2) {
#pragma unroll
                    for (int pr = 0; pr < 8; ++pr) { const bf16x8 vf = *(const LAS bf16x8*)(vp + pr * 64); oa = MFMA16(vf, pf[0][pr], oa); ob = MFMA16(vf, pf[1][pr], ob); }
                } else {
#pragma unroll
                    for (int pr = 0; pr < 8; ++pr) { const bf16x8 vf = *(const LAS bf16x8*)(vp + pr * 64); oa = MFMA16(vf, pf[0][pr], oa); }
                }
                u32x2v w; w.x = pk2(oa[0], oa[1]); w.y = pk2(oa[2], oa[3]);
                *(GAS u32x2v*)((GAS bf16*)ox + (size_t)(rowA + fr) * 1024 + h * 256 + db * 16 + quad * 4) = w;
                if (nqb == 2) { u32x2v w2; w2.x = pk2(ob[0], ob[1]); w2.y = pk2(ob[2], ob[3]); *(GAS u32x2v*)((GAS bf16*)ox + (size_t)(rowB + fr) * 1024 + h * 256 + db * 16 + quad * 4) = w2; } }
        }
    }
    __syncthreads();
}

__device__ __forceinline__ void s5_stage_u(const bf16* up, LAS float* ubuf, int lane) {
    const v4u w0 = *(const v4u*)up, w1 = *(const v4u*)(up + 8);
    LAS f32x4* d = (LAS f32x4*)(ubuf + lane * 16);
    d[0] = (f32x4){bflo(w0.x), bfhi(w0.x), bflo(w0.y), bfhi(w0.y)}; d[1] = (f32x4){bflo(w0.z), bfhi(w0.z), bflo(w0.w), bfhi(w0.w)};
    d[2] = (f32x4){bflo(w1.x), bfhi(w1.x), bflo(w1.y), bfhi(w1.y)}; d[3] = (f32x4){bflo(w1.z), bfhi(w1.z), bflo(w1.w), bfhi(w1.w)};
}
__device__ __forceinline__ f32x2v lo2_(f32x4 v) { return __builtin_shufflevector(v, v, 0, 1); }
__device__ __forceinline__ f32x2v hi2_(f32x4 v) { return __builtin_shufflevector(v, v, 2, 3); }
#define S5_STEP(sidx) do { const LAS f32x4* up_ = (const LAS f32x4*)(ubuf + (sidx) * 16); const f32x4 u0 = up_[0], u1 = up_[1], u2 = up_[2], u3 = up_[3]; \
    f32x2v ac_ = lo2_(bb[0]) * u0[0]; ac_ = hi2_(bb[0]) * u0[1] + ac_; ac_ = lo2_(bb[1]) * u0[2] + ac_; ac_ = hi2_(bb[1]) * u0[3] + ac_; \
    ac_ = lo2_(bb[2]) * u1[0] + ac_; ac_ = hi2_(bb[2]) * u1[1] + ac_; ac_ = lo2_(bb[3]) * u1[2] + ac_; ac_ = hi2_(bb[3]) * u1[3] + ac_; \
    ac_ = lo2_(bb[4]) * u2[0] + ac_; ac_ = hi2_(bb[4]) * u2[1] + ac_; ac_ = lo2_(bb[5]) * u2[2] + ac_; ac_ = hi2_(bb[5]) * u2[3] + ac_; \
    ac_ = lo2_(bb[6]) * u3[0] + ac_; ac_ = hi2_(bb[6]) * u3[1] + ac_; ac_ = lo2_(bb[7]) * u3[2] + ac_; ac_ = hi2_(bb[7]) * u3[3] + ac_; \
    const float nr_ = ar * hr - ai * hi + ac_.x, ni_ = ar * hi + ai * hr + ac_.y; hr = nr_; hi = ni_; } while (0)

typedef short bf16x4_t __attribute__((ext_vector_type(4)));
#define MFMA16K16(a, b, c) __builtin_amdgcn_mfma_f32_16x16x16bf16_1k(a, b, c, 0, 0, 0)
__device__ __forceinline__ bf16x4_t s5_load_u(const bf16* urow0, int fr, int quad) { return *(const GAS bf16x4_t*)((const GAS bf16*)urow0 + (size_t)fr * 1280 + quad * 4); }
__device__ __forceinline__ void s5_bu_block(const bf16x4_t a, const bf16x4_t (&bcf)[8], LAS float* bul, int fr, int quad) {
#pragma unroll
    for (int cb = 0; cb < 8; ++cb) { f32x4 d = {0.f, 0.f, 0.f, 0.f}; d = MFMA16K16(a, bcf[cb], d);
#pragma unroll
        for (int j = 0; j < 4; ++j) bul[(quad * 4 + j) * 130 + cb * 16 + fr] = d[j]; }
}
__device__ __forceinline__ void s5_local(const bf16* proj, const float* abar, const bf16* bbt, float* sloc, LAS float* bul, int slot, int nslots, int lane) {
    const int fr = lane & 15, quad = lane >> 4;
    for (int t = slot; t < 8192; t += nslots) {
        const int chunk = t & 63, g = (t >> 6) & 31, b = t >> 11;
        const float ar = abar[(g * 64 + lane) * 2], ai = abar[(g * 64 + lane) * 2 + 1];
        bf16x4_t bcf[8];
#pragma unroll
        for (int cb = 0; cb < 8; ++cb) bcf[cb] = *(const GAS bf16x4_t*)((const GAS bf16*)bbt + (size_t)(g * 128 + cb * 16 + fr) * 16 + quad * 4);
        float hr = 0.f, hi = 0.f;
        bf16x4_t ua[4];
#pragma unroll
        for (int blk = 0; blk < 4; ++blk) ua[blk] = s5_load_u(proj + (size_t)(b * 4096 + chunk * 64 + blk * 16) * 1280 + g * 16, fr, quad);
#pragma unroll
        for (int blk = 0; blk < 4; ++blk) {
            s5_bu_block(ua[blk], bcf, bul, fr, quad);
#pragma unroll 4
            for (int s = 0; s < 16; ++s) { const f32x2v bu = *(const LAS f32x2v*)(bul + s * 130 + 2 * lane); const float nr = ar * hr - ai * hi + bu.x, ni = ar * hi + ai * hr + bu.y; hr = nr; hi = ni; }
        }
        *(f32x2v*)(sloc + (size_t)t * 128 + lane * 2) = (f32x2v){hr, hi};
    }
}
__device__ __forceinline__ void s5_out(const bf16* proj, const float* abar, const bf16* bbt, const float* sloc, const float* st_re, const float* st_im, const float* c_re, const float* c_im,
                                       const float* dcoef, bf16* gbuf, float* out, LAS float* bul, LAS unsigned* hbuf, int slot, int nslots, int lane) {
    const int fr = lane & 15, quad = lane >> 4;
    for (int t = slot; t < 8192 + 256; t += nslots) {
        const int sample = t >= 8192; int b, g, chunk, nblk, rowbase;
        if (!sample) { chunk = t & 63; g = (t >> 6) & 31; b = t >> 11; nblk = 4; rowbase = b * 4096 + chunk * 64; } else { const int s = t - 8192; g = s & 31; b = s >> 5; chunk = 0; nblk = 2; rowbase = MP + b * 32; }
        const float ar = abar[(g * 64 + lane) * 2], ai = abar[(g * 64 + lane) * 2 + 1];
        bf16x4_t bcf[8];
#pragma unroll
        for (int cb = 0; cb < 8; ++cb) bcf[cb] = *(const GAS bf16x4_t*)((const GAS bf16*)bbt + (size_t)(g * 128 + cb * 16 + fr) * 16 + quad * 4);
        float hr, hi;
        if (!sample) { float pr = ar, pi = ai;
#pragma unroll
            for (int i = 0; i < 6; ++i) { const float t1 = pr * pr - pi * pi; pi = 2.f * pr * pi; pr = t1; }
            hr = 0.f; hi = 0.f; const float* sp = sloc + (size_t)(t - chunk) * 128 + lane * 2;
#pragma unroll 16
            for (int cc = 0; cc < chunk; ++cc) { const f32x2v sv = *(const f32x2v*)(sp + (size_t)cc * 128); const float nr = pr * hr - pi * hi + sv.x, ni = pr * hi + pi * hr + sv.y; hr = nr; hi = ni; } }
        else { hr = st_re[(b * 32 + g) * 64 + lane]; hi = st_im[(b * 32 + g) * 64 + lane]; }
        bf16x8 cf[4];
#pragma unroll
        for (int ks = 0; ks < 4; ++ks) { const f32x4 cr = *(const f32x4*)(c_re + (size_t)(g * 16 + fr) * 64 + ks * 16 + quad * 4), ci = *(const f32x4*)(c_im + (size_t)(g * 16 + fr) * 64 + ks * 16 + quad * 4);
            v4u w; w.x = pg8::cvt_pk_bf16(cr[0], -ci[0]); w.y = pg8::cvt_pk_bf16(cr[1], -ci[1]); w.z = pg8::cvt_pk_bf16(cr[2], -ci[2]); w.w = pg8::cvt_pk_bf16(cr[3], -ci[3]); cf[ks] = __builtin_bit_cast(bf16x8, w); }
        const float dco = dcoef[g * 16 + fr];
        bf16x4_t ua[4]; bf16 uraw[4][4];
#pragma unroll
        for (int blk = 0; blk < 4; ++blk) { const int bc = blk < nblk ? blk : nblk - 1; const bf16* urow0 = proj + (size_t)(rowbase + bc * 16) * 1280 + g * 16; ua[blk] = s5_load_u(urow0, fr, quad);
#pragma unroll
            for (int j = 0; j < 4; ++j) uraw[blk][j] = ((const GAS bf16*)urow0)[(size_t)(quad * 4 + j) * 1280 + fr]; }
#pragma unroll
        for (int blk = 0; blk < 4; ++blk) { if (blk < nblk) {
            s5_bu_block(ua[blk], bcf, bul, fr, quad);
#pragma unroll 4
            for (int s = 0; s < 16; ++s) { const f32x2v bu = *(const LAS f32x2v*)(bul + s * 130 + 2 * lane); const float nr = ar * hr - ai * hi + bu.x, ni = ar * hi + ai * hr + bu.y; hr = nr; hi = ni; hbuf[s * 68 + lane] = pg8::cvt_pk_bf16(hr, hi); }
            f32x4 y = {0.f, 0.f, 0.f, 0.f};
#pragma unroll
            for (int ks = 0; ks < 4; ++ks) { const bf16x8 a = *(const LAS bf16x8*)(hbuf + fr * 68 + ks * 16 + quad * 4); y = MFMA16(a, cf[ks], y); }
#pragma unroll
            for (int j = 0; j < 4; ++j) { const int s = blk * 16 + quad * 4 + j; const float uu = bflo((unsigned)uraw[blk][j]); const float yv = y[j] + dco * uu;
                const float z = 0.7978845608028654f * (yv + 0.044715f * yv * yv * yv); const float th = 1.0f - 2.0f / (1.0f + __expf(2.0f * z)); const float gl = 0.5f * yv * (1.0f + th);
                ((GAS bf16*)gbuf)[(size_t)(rowbase + s) * 512 + g * 16 + fr] = (bf16)f2bf(gl); }
        } }
        if (!sample && chunk == 63) { out[OFF_SRP + (b * 32 + g) * 64 + lane] = hr; out[OFF_SIP + (b * 32 + g) * 64 + lane] = hi; }
        if (sample) { out[OFF_SRS + (b * 32 + g) * 64 + lane] = hr; out[OFF_SIS + (b * 32 + g) * 64 + lane] = hi; }
    }
}

template <int KIND>
__device__ __forceinline__ void sample_gemm(const bf16* A, const bf16* Bt, int K, LAS unsigned char* lds, int tid, int wave, int lane,
                                            bf16* xbp, const float* base_f32, float* part_next, const float* part_cur, bf16* O) {
    const int fr = lane & 15, quad = lane >> 4;
    LAS f32x4* red = (LAS f32x4*)lds;
    LAS float* ssred = (LAS float*)(lds + 32768);
    for (int tile = blockIdx.x; tile < 256; tile += gridDim.x) {
        const int r0 = MP + (tile >> 4) * 16, c0 = (tile & 15) * 64, kw = K >> 3;
        const bf16* ap = A + (size_t)(r0 + fr) * K + wave * kw + quad * 8;
        const bf16* bp = Bt + (size_t)(c0 + fr) * K + wave * kw + quad * 8;
        f32x4 acc[4];
#pragma unroll
        for (int cb = 0; cb < 4; ++cb) acc[cb] = (f32x4){0.f, 0.f, 0.f, 0.f};
        const int e_cb = (tid >> 6) & 3, e_l2 = tid & 63, e_row = r0 + (e_l2 & 15), e_col = c0 + e_cb * 16 + 4 * (e_l2 >> 4); const size_t e_off = (size_t)e_row * 1024 + e_col;
        f32x4 e_bs = {0.f, 0.f, 0.f, 0.f}; float e_rs = 1.f;
        if (tid < 256) { if (KIND == 0) { if (base_f32) e_bs = *(const f32x4*)(base_f32 + e_off); else { const u32x2v w = *(const u32x2v*)(xbp + e_off); e_bs = (f32x4){bflo(w.x), bfhi(w.x), bflo(w.y), bfhi(w.y)}; } }
                         else e_rs = rstd_of(part_cur, e_row); }
        const int nks = kw >> 5;
        for (int k0 = 0; k0 < nks; k0 += 4) {
            bf16x8 a[4], b[4][4];
#pragma unroll
            for (int i = 0; i < 4; ++i) { const int ks = (k0 + i < nks) ? k0 + i : nks - 1;
                a[i] = *(const bf16x8*)(ap + ks * 32);
#pragma unroll
                for (int cb = 0; cb < 4; ++cb) b[i][cb] = *(const bf16x8*)(bp + (size_t)cb * 16 * K + ks * 32); }
            __builtin_amdgcn_sched_barrier(0);
#pragma unroll
            for (int i = 0; i < 4; ++i) if (k0 + i < nks) {
#pragma unroll
                for (int cb = 0; cb < 4; ++cb) acc[cb] = MFMA16(b[i][cb], a[i], acc[cb]); }
        }
#pragma unroll
        for (int cb = 0; cb < 4; ++cb) red[(wave * 4 + cb) * 64 + lane] = acc[cb] * 1.0f;
        __syncthreads();
        if (tid < 256) { const int cb = tid >> 6, l2 = tid & 63; f32x4 v = red[cb * 64 + l2];
#pragma unroll
            for (int w = 1; w < 8; ++w) v = v + red[(w * 4 + cb) * 64 + l2];
            const int row = r0 + (l2 & 15), col = c0 + cb * 16 + 4 * (l2 >> 4); const size_t off = (size_t)row * 1024 + col;
            if (KIND == 0) {
                v = v + e_bs; u32x2v o; o.x = pk2(v[0], v[1]); o.y = pk2(v[2], v[3]); *(u32x2v*)(xbp + off) = o;
                float ss = (v[0] * v[0] + v[1] * v[1]) + (v[2] * v[2] + v[3] * v[3]); ss += __shfl_xor(ss, 16); ss += __shfl_xor(ss, 32);
                if ((l2 >> 4) == 0) ssred[cb * 16 + (l2 & 15)] = ss; }
            else { const float rs = e_rs; u32x2v o; o.x = pk2(v[0] * rs, v[1] * rs); o.y = pk2(v[2] * rs, v[3] * rs); *(u32x2v*)(O + off) = o; }
        }
        if (KIND == 0) { __syncthreads(); if (tid < 16) part_next[(size_t)(r0 + tid) * 16 + (tile & 15)] = (ssred[tid] + ssred[16 + tid]) + (ssred[32 + tid] + ssred[48 + tid]); }
        __syncthreads();
    }
}


__device__ __forceinline__ void sample_cz(const bf16* A, const bf16* Bt, LAS unsigned char* lds, int tid, int wave, int lane,
                                          const float* part_cur, const float* cw, const float* st, bf16* zcp, float* outp) {
    const int fr = lane & 15, quad = lane >> 4;
    LAS f32x4* red = (LAS f32x4*)lds;
    LAS float* T = (LAS float*)(lds + 65536);
    LAS float* CZ = (LAS float*)(lds + 65536 + 8192);
    for (int tile = blockIdx.x; tile < 256; tile += gridDim.x) {
        const int b = tile >> 5, c0 = (tile & 31) * 32, r0 = MP + b * 32;
        const int wrow = 1024 + (c0 >> 7) * 256 + (c0 & 127);
        const GAS bf16* ap = (const GAS bf16*)A + (size_t)(r0 + fr) * 1024 + wave * 128 + quad * 8;
        const GAS bf16* bp = (const GAS bf16*)Bt + (size_t)(wrow + fr) * 1024 + wave * 128 + quad * 8;
        bf16x8 a[4][2], bw[4][4];
#pragma unroll
        for (int ks = 0; ks < 4; ++ks) {
#pragma unroll
            for (int rb = 0; rb < 2; ++rb) a[ks][rb] = *(const GAS bf16x8*)(ap + (size_t)rb * 16 * 1024 + ks * 32);
#pragma unroll
            for (int cb = 0; cb < 4; ++cb) bw[ks][cb] = *(const GAS bf16x8*)(bp + (size_t)((cb >> 1) * 128 + (cb & 1) * 16) * 1024 + ks * 32); }
        f32x4 acc[2][4];
#pragma unroll
        for (int rb = 0; rb < 2; ++rb)
#pragma unroll
            for (int cb = 0; cb < 4; ++cb) { f32x4 d = {0.f, 0.f, 0.f, 0.f};
#pragma unroll
                for (int ks = 0; ks < 4; ++ks) d = MFMA16(bw[ks][cb], a[ks][rb], d);
                acc[rb][cb] = d; }
#pragma unroll
        for (int rb = 0; rb < 2; ++rb)
#pragma unroll
            for (int cb = 0; cb < 4; ++cb) red[(wave * 8 + rb * 4 + cb) * 64 + lane] = acc[rb][cb];
        __syncthreads();
        {
            const int blk = tid >> 6, l2 = tid & 63, rb = blk >> 2, cb = blk & 3; f32x4 v = red[blk * 64 + l2];
#pragma unroll
            for (int w = 1; w < 8; ++w) v = v + red[(w * 8 + blk) * 64 + l2];
            *(LAS f32x4*)(T + ((cb >> 1) * 32 + rb * 16 + (l2 & 15)) * 32 + (cb & 1) * 16 + 4 * (l2 >> 4)) = v; }
        __syncthreads();
        const int r = tid >> 3, cq = (tid & 7) * 4;
        if (tid < 256) { const float rs = rstd_of(part_cur, r0 + r); const float rs2 = rs * rs;
            const f32x4 gc = *(const LAS f32x4*)(T + r * 32 + cq), zz = *(const LAS f32x4*)(T + (32 + r) * 32 + cq);
            *(LAS f32x4*)(CZ + r * 32 + cq) = gc * zz * rs2; }
        __syncthreads();
        if (tid < 256) { const int c = c0 + cq;
            const f32x4 x0 = *(const LAS f32x4*)(CZ + r * 32 + cq);
            const f32x4 s0 = *(const f32x4*)(st + (size_t)(b * 2) * 1024 + c), s1 = *(const f32x4*)(st + (size_t)(b * 2 + 1) * 1024 + c);
            f32x4 xm1 = s1, xm2 = s0;
            if (r >= 1) { xm1 = *(const LAS f32x4*)(CZ + (r - 1) * 32 + cq); xm2 = s1; }
            if (r >= 2) xm2 = *(const LAS f32x4*)(CZ + (r - 2) * 32 + cq);
            const f32x4 w0 = *(const f32x4*)(cw + c), w1 = *(const f32x4*)(cw + 1024 + c), w2 = *(const f32x4*)(cw + 2048 + c);
            const f32x4 z = w0 * xm2 + w1 * xm1 + w2 * x0;
            bf16* gp = zcp + (size_t)(r0 + r) * 1024 + c; const u32x2v gw = *(const u32x2v*)gp;
            u32x2v o; o.x = pk2(z[0] * bflo(gw.x), z[1] * bfhi(gw.x)); o.y = pk2(z[2] * bflo(gw.y), z[3] * bfhi(gw.y)); *(u32x2v*)gp = o;
            if (r >= 30) *(f32x4*)(outp + OFF_CMS + (size_t)(b * 2 + (r - 30)) * 1024 + c) = x0; }
        __syncthreads();
    }
}

struct Params { const float* in[36]; float* out; unsigned char* ws; int use_cg, pad; };

__global__ void __launch_bounds__(512, 2) mega_fwd(Params P) {
    extern __shared__ __attribute__((aligned(16))) unsigned char lds_raw[];
    LAS unsigned char* lds = (LAS unsigned char*)lds_raw;
    volatile LAS unsigned* MISC = (volatile LAS unsigned*)(lds + MISC_OFF);
    const int G = gridDim.x, NGW = G * 8, NT = G * 512;
    const int wave_s = __builtin_amdgcn_readfirstlane(threadIdx.x >> 6);
    for (int u = threadIdx.x; u < (LDS_BYTES - 131072) / 4; u += 512) ((LAS unsigned*)(lds + 131072))[u] = 0u;
    __syncthreads();
    XcdBarrier bar = xcd_barrier_post((unsigned*)(P.ws + WS_BAR), MISC + 8);
#ifndef STOP_AFTER
#define STOP_AFTER 1000
#endif
    int ph = 0;
#define RUN (ph < STOP_AFTER)
#define FRESH() const int tid = fresh_tid(wave_s), lane = tid & 63, wave = __builtin_amdgcn_readfirstlane(tid >> 6); const int gw = blockIdx.x * 8 + wave, gt = blockIdx.x * 512 + tid; (void)gw; (void)gt; (void)lane; LAS float* wscr = (LAS float*)(lds + 32768 + wave * 12288); (void)wscr;
#define SEAM() do { if (P.use_cg) cg::this_grid().sync(); else xcd_barrier(bar); ++ph; } while (0)

#define part ((float*)(ws + WS_PART))
#define PARTBUF(k) (part + (size_t)((k) & 1) * PART_ELEMS)
#define ropec ((float*)(ws + WS_ROPE))
#define ropes (ropec + 4096 * 32)
#define abar ((float*)(ws + WS_SSM))
#define bbar (abar + 32 * 64 * 2)
#define bbt ((bf16*)(bbar + 32 * 64 * 32))
#define ckb ((bf16*)(ws + WS_CKV))
#define cvb (ckb + 8 * 128 * 128)
#define sloc ((float*)(ws + WS_SLOC))
#define memk ((bf16*)(ws + WS_MEMK))
#define memvT ((bf16*)(ws + WS_MEMVT))
#define SG ((float*)(ws + WS_SIDE))
#define SV ((float*)(ws + WS_SIDE + SG_BYTES))
#define WT ((bf16*)(ws + WS_WT))
#define xb ((bf16*)(ws + WS_XB))
#define tmp (ws + WS_TMP)
#define proj0 ((bf16*)(tmp + TMP_PROJ0))
#define gbuf ((bf16*)(tmp + TMP_GBUF))
#define ycat ((bf16*)(tmp + TMP_YCAT))
#define memb ((bf16*)(tmp + TMP_MEMB))
#define qx ((bf16*)(tmp + TMP_QX))
#define ox ((bf16*)(tmp + TMP_OX))
#define act ((bf16*)(tmp + TMP_ACT))
#define gbm ((bf16*)(tmp + TMP_GB))
#define zc ((bf16*)(tmp + TMP_ZC))
#define PTRS() unsigned char* ws = P.ws; float* out = P.out; asm volatile("" : "+s"(ws), "+s"(out));
    if (RUN) { PTRS() FRESH()
        {
            constexpr int NITEMS = 640 + 128 + 512 + 512 + 2 * 1024 + 512 + 2816 + 1408 + 2048;
            for (int it = gw; it < NITEMS; it += NGW) { int r = it;
#define TR(Wp, K_, N_, WTp, gainp, sc, mode) { const int ni_ = ((K_) / 64) * ((N_) / 32); if (r < ni_) { tr_item(Wp, K_, N_, WTp, gainp, sc, mode, wscr, r, lane); continue; } r -= ni_; }
                TR(P.in[15], 1024, 1280, WT + WT_INEVEN, P.in[11], 1.f, 1)
                TR(P.in[25], 512, 512, WT + WT_GLU, nullptr, 1.f, 0)
                TR(P.in[16], 1024, 1024, WT + WT_OUTEVEN, nullptr, 1.f, 0)
                TR(P.in[30], 1024, 1024, WT + WT_WQ, P.in[12], 0.0625f, 0)
                TR(P.in[31], 1024, 2048, WT + WT_WKV, nullptr, 1.f, 0)
                TR(P.in[31] + 2097152, 1024, 2048, WT + WT_WKV + 2097152, nullptr, 1.f, 0)
                TR(P.in[32], 1024, 1024, WT + WT_WO, nullptr, 1.f, 0)
                TR(P.in[33], 1024, 5632, WT + WT_UP, P.in[13], 1.f, 2)
                TR(P.in[35], 2816, 1024, WT + WT_DOWN, nullptr, 1.f, 0)
                { const int mi = r >> 7, l = mi >> 3, b = mi & 7; tr_item(P.in[10] + (size_t)mi * 262144, 256, 1024, memvT + (size_t)(l * 12 + 4 + b) * 262144, nullptr, 1.f, 0, wscr, r & 127, lane); }
            }
        }
        for (int m = gw; m < MROWS; m += NGW) { const float* xr = m < MP ? P.in[0] + (size_t)m * 1024 : P.in[1] + (size_t)(m - MP) * 1024; float ss = 0.f;
#pragma unroll
            for (int j = 0; j < 4; ++j) { const f32x4 v = *(const f32x4*)(xr + (lane + 64 * j) * 4); ss += (v[0] * v[0] + v[1] * v[1]) + (v[2] * v[2] + v[3] * v[3]);
                u32x2v w; w.x = pg8::cvt_pk_bf16(v[0], v[1]); w.y = pg8::cvt_pk_bf16(v[2], v[3]); *(u32x2v*)(xb + (size_t)m * 1024 + (lane + 64 * j) * 4) = w; }
            ss = wave_sum(ss); if (lane < 16) PARTBUF(0)[(size_t)m * 16 + lane] = lane == 0 ? ss : 0.f; }
        for (int i = gt; i < 262144; i += NT) { const f32x4 v = __builtin_nontemporal_load((const f32x4*)(P.in[2] + (size_t)i * 4)); u32x2v w; w.x = pg8::cvt_pk_bf16(v[0], v[1]); w.y = pg8::cvt_pk_bf16(v[2], v[3]); *(u32x2v*)(memb + (size_t)i * 4) = w; }
        for (int i = gt; i < 1048576; i += NT) { const size_t e = (size_t)i * 4; const int lb = (int)(e >> 18), l = lb >> 3, b = lb & 7; const f32x4 v = __builtin_nontemporal_load((const f32x4*)(P.in[9] + e));
            u32x2v w; w.x = pg8::cvt_pk_bf16(v[0], v[1]); w.y = pg8::cvt_pk_bf16(v[2], v[3]); *(u32x2v*)(memk + (size_t)(l * 12 + 4 + b) * 262144 + (e & 262143)) = w; }
        for (int i = gt; i < 65536; i += NT) { const int j = i & 32767; const float* src = (i < 32768 ? P.in[3] : P.in[4]) + (size_t)j * 4; bf16* dst = (i < 32768 ? ckb : cvb) + (size_t)j * 4;
            const f32x4 v = *(const f32x4*)src; u32x2v w; w.x = pg8::cvt_pk_bf16(v[0], v[1]); w.y = pg8::cvt_pk_bf16(v[2], v[3]); *(u32x2v*)dst = w; }
        for (int i = gt; i < 4096 * 32; i += NT) { const int pos = i >> 5, d = i & 31; const double inv = dexp_(-(double)d * (9.210340371976184 / 32.0)); double s, c; dsincos_((double)pos * inv, s, c); ropec[i] = (float)c; ropes[i] = (float)s; }
        for (int i = gt; i < 2048; i += NT) { const double are = P.in[17][i], aim = P.in[18][i], dt = dexp_((double)P.in[19][i]); double s, c; dsincos_(aim * dt, s, c); const double mag = dexp_(are * dt);
            const double br = mag * c, bi = mag * s; abar[2 * i] = (float)br; abar[2 * i + 1] = (float)bi;
            const double nr = br - 1.0, ni = bi, den = are * are + aim * aim; const double qr = (nr * are + ni * aim) / den, qi = (ni * are - nr * aim) / den;
#pragma unroll 4
            for (int h = 0; h < 16; ++h) { const double xr = P.in[20][(size_t)i * 16 + h], xi = P.in[21][(size_t)i * 16 + h]; const float fre = (float)(qr * xr - qi * xi), fim = (float)(qr * xi + qi * xr); bbar[(size_t)i * 32 + 2 * h] = fre; bbar[(size_t)i * 32 + 2 * h + 1] = fim;
                bbt[((size_t)i * 2) * 16 + h] = (bf16)f2bf(fre); bbt[((size_t)i * 2 + 1) * 16 + h] = (bf16)f2bf(fim); } }
    }
    SEAM();
    if (RUN) { PTRS()
        if (G < 128 || (int)blockIdx.x >= G - 64) { pg8::Gemm g{memb, WT + WT_WKV, 1024, 4096, 1024}; pg8::StaticOrder S;
            if (G < 128) S.init(1024, 4096, G, (int)blockIdx.x); else S.init(1024, 4096, 64, (int)blockIdx.x - (G - 64)); EpiKV E{out, memk};
          pg8::gemm_phase<EpiKV, pg8::StaticOrder, true, true>(lds, g, S, E, wave_s); }
        { pg8::Gemm g{xb, WT + WT_INEVEN, MROWS, 1280, 1024}; pg8::StaticOrderF S; S.init(MROWS, 1280, G, (int)blockIdx.x); EpiIn0 E{proj0, PARTBUF(0), ropec, ropes, out};
          pg8::gemm_phase<EpiIn0, pg8::StaticOrderF, true, true>(lds, g, S, E, wave_s); }
        {
            FRESH()
            const int bx = (int)blockIdx.x, n2 = 325 - G;
            int slot = -1, nw = 1;
            if (G == 256) { if (bx >= n2 && bx < G - 64) { slot = (bx - n2) * 8 + wave; nw = (G - 64 - n2) * 8; } } else { slot = gw; nw = NGW; }
            if (slot >= 0) for (int it = slot; it < 2816 + 1408; it += nw) { int r = it;
                TR(P.in[33] + (size_t)1024 * 5632, 1024, 5632, WT + WT_UP + (size_t)5632 * 1024, P.in[13] + 1024, 1.f, 2)
                tr_item(P.in[35] + (size_t)2816 * 1024, 2816, 1024, WT + WT_DOWN + (size_t)2816 * 1024, nullptr, 1.f, 0, wscr, r, lane); }
        }
    }
    SEAM();
    if (RUN) { PTRS() FRESH()
        swa_phase(proj0, ckb, cvb, P.in[26], ycat, lds, tid, wave, lane, G);
        s5_local(proj0, abar, bbt, sloc, wscr, wave * G + (int)blockIdx.x, NGW, lane);
        for (int it = wave * G + (int)blockIdx.x; it < 1024; it += NGW) { const int mi = it >> 7, l = mi >> 2, b = mi & 3;
            tr_item(out + OFF_MVP + (size_t)mi * 262144, 256, 1024, memvT + (size_t)(l * 12 + b) * 262144, nullptr, 1.f, 0, wscr, it & 127, lane); }
    }
    SEAM();
    if (RUN) { PTRS() FRESH() s5_out(proj0, abar, bbt, sloc, P.in[5], P.in[6], P.in[22], P.in[23], P.in[24], gbuf, out, (LAS float*)(lds + wave * 16384), (LAS unsigned*)(lds + wave * 16384 + 8448), wave * G + (int)blockIdx.x, NGW, lane); }
    SEAM();
    if (RUN) { PTRS() pg8::Gemm g{gbuf, WT + WT_GLU, MROWS, 512, 512}; pg8::StaticOrder S; S.init(MROWS, 512, G, (int)blockIdx.x); EpiGlu E{gbuf, ycat};
        pg8::gemm_phase<EpiGlu, pg8::StaticOrder, true, true>(lds, g, S, E, wave_s);
        {
            FRESH()
            const int bx = (int)blockIdx.x; int slot = -1, nw = 1;
            if (G > 130) { if (bx >= 130) { slot = (bx - 130) * 8 + wave; nw = (G - 130) * 8; } } else { slot = gw; nw = NGW; }
            if (slot >= 0) for (int it = slot; it < 1536 + 512; it += nw) { int r = it;
                TR(P.in[27], 1024, 3072, WT + WT_INODD, P.in[11] + 1024, 1.f, 3)
                tr_item(P.in[29], 1024, 1024, WT + WT_OUTODD, nullptr, 1.f, 0, wscr, r, lane); }
        } }
    SEAM();

#pragma unroll
    for (int l = 0; l < 2; ++l) {
        if (l == 1) {
            if (RUN) { PTRS() pg8::Gemm g{xb, WT + WT_INODD, MP, 1024, 1024}; pg8::StaticOrderF S; S.init(MP, 1024, G, (int)blockIdx.x); EpiBf16 E{gbm, 1024, PARTBUF(3)};
                pg8::gemm_phase<EpiBf16, pg8::StaticOrderF, true, true>(lds, g, S, E, wave_s);
                { FRESH() sample_gemm<1>(xb, WT + WT_INODD, 1024, lds, tid, wave, lane, nullptr, nullptr, nullptr, PARTBUF(3), gbm); } }
            SEAM();
            if (RUN) { PTRS() pg8::Gemm g{xb, WT + WT_INODD + (size_t)1024 * 1024, MP, 2048, 1024}; pg8::StaticOrderF S; S.init(MP, 2048, G, (int)blockIdx.x); EpiCz E{gbm, PARTBUF(3), P.in[28], SG};
                pg8::gemm_phase<EpiCz, pg8::StaticOrderF, true, true>(lds, g, S, E, wave_s);
                { FRESH() sample_cz(xb, WT + WT_INODD, lds, tid, wave, lane, PARTBUF(3), P.in[28], P.in[7], gbm, out); } }
            SEAM();
            if (RUN) { PTRS() FRESH()
                const float* cw = P.in[28];
                for (int i = gt; i < 512 * 128; i += NT) { const int ri = i >> 7, c0 = (i & 127) * 8, blk = ri >> 1, rr = ri & 1, row = blk * 64 + rr;
                    f32x4 pa0, pa1, pb0, pb1;
                    if ((blk & 63) == 0) { pa0 = pa1 = pb0 = pb1 = (f32x4){0.f, 0.f, 0.f, 0.f}; }
                    else { const float* s0 = SG + (size_t)((blk - 1) * 8 + 6) * 1024 + c0; pa0 = *(const f32x4*)s0; pa1 = *(const f32x4*)(s0 + 4); pb0 = *(const f32x4*)(s0 + 1024); pb1 = *(const f32x4*)(s0 + 1028); }
                    const float* sc = SG + (size_t)(blk * 8) * 1024 + c0; const f32x4 x00 = *(const f32x4*)sc, x01 = *(const f32x4*)(sc + 4);
                    f32x4 xm2a, xm2b, xm1a, xm1b, xca, xcb;
                    if (rr == 0) { xm2a = pa0; xm2b = pa1; xm1a = pb0; xm1b = pb1; xca = x00; xcb = x01; }
                    else { xm2a = pb0; xm2b = pb1; xm1a = x00; xm1b = x01; xca = *(const f32x4*)(sc + 1024); xcb = *(const f32x4*)(sc + 1028); }
                    const f32x4 w0a = *(const f32x4*)(cw + c0), w0b = *(const f32x4*)(cw + c0 + 4), w1a = *(const f32x4*)(cw + 1024 + c0), w1b = *(const f32x4*)(cw + 1028 + c0), w2a = *(const f32x4*)(cw + 2048 + c0), w2b = *(const f32x4*)(cw + 2052 + c0);
                    const f32x4 z0 = w0a * xm2a + w1a * xm1a + w2a * xca, z1 = w0b * xm2b + w1b * xm1b + w2b * xcb;
                    const v4u gw_ = *(const v4u*)(gbm + (size_t)row * 1024 + c0);
                    const f32x4 g0 = (f32x4){bflo(gw_.x), bfhi(gw_.x), bflo(gw_.y), bfhi(gw_.y)}, g1 = (f32x4){bflo(gw_.z), bfhi(gw_.z), bflo(gw_.w), bfhi(gw_.w)};
                    *(v4u*)(gbm + (size_t)row * 1024 + c0) = pack8(g0 * z0, g1 * z1); }
                for (int i = gt; i < 4 * 2 * 1024; i += NT) { const int c = i & 1023, j = (i >> 10) & 1, b = i >> 11; out[OFF_CMP + i] = SG[(size_t)((64 * b + 63) * 8 + 6 + j) * 1024 + c]; }
            }
            SEAM();
        }
        if (RUN) { PTRS() pg8::Gemm g{(bf16*)(tmp + (size_t)(1 - l) * TMP_YCAT), WT + WT_OUTEVEN + (size_t)l * (WT_OUTODD - WT_OUTEVEN), MP, 1024, 1024}; pg8::StaticOrderF S; S.init(MP, 1024, G, (int)blockIdx.x);
            EpiRes E{P.in[0], P.in[1] - (size_t)MP * 1024, xb, PARTBUF(1 + 3 * l), l == 0 ? 1 : 0};
            pg8::gemm_phase<EpiRes, pg8::StaticOrderF, true, true>(lds, g, S, E, wave_s);
            { FRESH() sample_gemm<0>((bf16*)(tmp + (size_t)(1 - l) * TMP_YCAT), WT + WT_OUTEVEN + (size_t)l * (WT_OUTODD - WT_OUTEVEN), 1024, lds, tid, wave, lane, xb, l == 0 ? P.in[1] - (size_t)MP * 1024 : (const float*)nullptr, PARTBUF(1 + 3 * l), nullptr, nullptr); } }
        SEAM();
        if (RUN) { PTRS() pg8::Gemm g{xb, WT + WT_WQ + (size_t)l * 1048576, MP, 1024, 1024}; pg8::StaticOrderF S; S.init(MP, 1024, G, (int)blockIdx.x); EpiBf16 E{qx, 1024, PARTBUF(1 + 3 * l)};
            pg8::gemm_phase<EpiBf16, pg8::StaticOrderF, true, true>(lds, g, S, E, wave_s);
            { FRESH() sample_gemm<1>(xb, WT + WT_WQ + (size_t)l * 1048576, 1024, lds, tid, wave, lane, nullptr, nullptr, nullptr, PARTBUF(1 + 3 * l), qx); } }
        SEAM();
        if (RUN) { PTRS() FRESH() xattn_phase2(qx, memk + (size_t)l * 12 * 262144, memvT + (size_t)l * 12 * 262144, ox, lds, tid, wave, lane, G); }
        SEAM();
        if (RUN) { PTRS() pg8::Gemm g{ox, WT + WT_WO + (size_t)l * 1048576, MP, 1024, 1024}; pg8::StaticOrderF S; S.init(MP, 1024, G, (int)blockIdx.x); EpiRes E{P.in[0], P.in[0], xb, PARTBUF(2 + 3 * l), 0};
            pg8::gemm_phase<EpiRes, pg8::StaticOrderF, true, true>(lds, g, S, E, wave_s);
            { FRESH() sample_gemm<0>(ox, WT + WT_WO + (size_t)l * 1048576, 1024, lds, tid, wave, lane, xb, nullptr, PARTBUF(2 + 3 * l), nullptr, nullptr); } }
        SEAM();
        if (RUN) { PTRS() pg8::Gemm g{xb, WT + WT_UP + (size_t)l * 5632 * 1024, MROWS, 5632, 1024}; pg8::StaticOrderF S; S.init(MROWS, 5632, G, (int)blockIdx.x);
            EpiFfnUp E{act, PARTBUF(2 + 3 * l), P.in[34] + (size_t)l * 3 * DFF, SG, SV};
            pg8::gemm_phase<EpiFfnUp, pg8::StaticOrderF, true, true>(lds, g, S, E, wave_s);
            if (l == 0) {
                FRESH()
                const int bx = (int)blockIdx.x, nb = 1430 % G; int slot = -1, nw = 1;
                if (nb > 0 && nb < G) { if (bx >= nb) { slot = (bx - nb) * 8 + wave; nw = (G - nb) * 8; } } else { slot = gw; nw = NGW; }
                if (slot >= 0) for (int it = slot; it < 512 + 512; it += nw) { int r = it;
                    TR(P.in[30] + 1048576, 1024, 1024, WT + WT_WQ + 1048576, P.in[12] + 1024, 0.0625f, 0)
                    tr_item(P.in[32] + 1048576, 1024, 1024, WT + WT_WO + 1048576, nullptr, 1.f, 0, wscr, r, lane); }
            } }
        SEAM();
        if (RUN) { PTRS() FRESH()
            const float* cw = P.in[34] + (size_t)l * 3 * DFF; const float* st = P.in[8] + (size_t)l * 8 * 2 * DFF;
            for (int i = gt; i < 528 * 352; i += NT) { const int fi = i / 352, c0 = (i % 352) * 8; int blk, row, rr, sb, vb; bool smp = fi >= 512;
                if (!smp) { blk = fi >> 1; rr = fi & 1; row = blk * 64 + rr; sb = 0; vb = 0; } else { const int s = fi - 512, half = (s >> 1) & 1; blk = 256 + (s >> 2); rr = s & 1; row = blk * 64 + half * 32 + rr; sb = half * 4; vb = half * 2; }
                f32x4 pa0, pa1, pb0, pb1;
                if (smp) { const int b = (blk - 256) * 2 + (sb >> 2); const float* s0 = st + (size_t)(b * 2) * DFF + c0; pa0 = *(const f32x4*)s0; pa1 = *(const f32x4*)(s0 + 4); pb0 = *(const f32x4*)(s0 + DFF); pb1 = *(const f32x4*)(s0 + DFF + 4); }
                else if ((blk & 63) == 0) { pa0 = pa1 = pb0 = pb1 = (f32x4){0.f, 0.f, 0.f, 0.f}; }
                else { const float* s0 = SG + (size_t)((blk - 1) * 8 + 6) * DFF + c0; pa0 = *(const f32x4*)s0; pa1 = *(const f32x4*)(s0 + 4); pb0 = *(const f32x4*)(s0 + DFF); pb1 = *(const f32x4*)(s0 + DFF + 4); }
                const float* sc = SG + (size_t)(blk * 8 + sb) * DFF + c0; const f32x4 x00 = *(const f32x4*)sc, x01 = *(const f32x4*)(sc + 4);
                f32x4 xm2a, xm2b, xm1a, xm1b, xca, xcb;
                if (rr == 0) { xm2a = pa0; xm2b = pa1; xm1a = pb0; xm1b = pb1; xca = x00; xcb = x01; }
                else { xm2a = pb0; xm2b = pb1; xm1a = x00; xm1b = x01; xca = *(const f32x4*)(sc + DFF); xcb = *(const f32x4*)(sc + DFF + 4); }
                const f32x4 w0a = *(const f32x4*)(cw + c0), w0b = *(const f32x4*)(cw + c0 + 4), w1a = *(const f32x4*)(cw + DFF + c0), w1b = *(const f32x4*)(cw + DFF + c0 + 4), w2a = *(const f32x4*)(cw + 2 * DFF + c0), w2b = *(const f32x4*)(cw + 2 * DFF + c0 + 4);
                const f32x4 ga = w0a * xm2a + w1a * xm1a + w2a * xca, gb_ = w0b * xm2b + w1b * xm1b + w2b * xcb;
                const float* sv = SV + (size_t)(blk * 4 + vb + rr) * DFF + c0; const f32x4 va = *(const f32x4*)sv, vb_ = *(const f32x4*)(sv + 4);
                f32x4 a0, a1;
#pragma unroll
                for (int j = 0; j < 4; ++j) { a0[j] = ga[j] * sigmoidf_(ga[j]) * va[j]; a1[j] = gb_[j] * sigmoidf_(gb_[j]) * vb_[j]; }
                *(v4u*)(act + (size_t)row * DFF + c0) = pack8(a0, a1); }
            for (int i = gt; i < 4 * 2 * DFF; i += NT) { const int c = i % DFF, j = (i / DFF) & 1, b = i / (2 * DFF); out[OFF_CFP + (size_t)l * 4 * 2 * DFF + i] = SG[(size_t)((64 * b + 63) * 8 + 6 + j) * DFF + c]; }
            for (int i = gt; i < 8 * 2 * DFF; i += NT) { const int c = i % DFF, j = (i / DFF) & 1, b = i / (2 * DFF); out[OFF_CFS + (size_t)l * 8 * 2 * DFF + i] = SG[(size_t)((256 + (b >> 1)) * 8 + (b & 1) * 4 + 2 + j) * DFF + c]; }
        }
        SEAM();
        if (RUN) { PTRS() pg8::Gemm g{act, WT + WT_DOWN + (size_t)l * 2816 * 1024, MP, 1024, DFF}; pg8::StaticOrderF S; S.init(MP, 1024, G, (int)blockIdx.x); EpiRes E{P.in[0], P.in[0], xb, PARTBUF(3 + 3 * l), 0};
            pg8::gemm_phase<EpiRes, pg8::StaticOrderF, true, true>(lds, g, S, E, wave_s);
            { FRESH() sample_gemm<0>(act, WT + WT_DOWN + (size_t)l * 2816 * 1024, DFF, lds, tid, wave, lane, xb, nullptr, PARTBUF(3 + 3 * l), nullptr, nullptr); } }
        SEAM();
    }
    if (RUN) { PTRS() FRESH()
        const float* gf = P.in[14];
        for (int m = gw; m < MROWS; m += NGW) { const float rs = rstd_of(PARTBUF(6), m); float* xr = out + (size_t)m * 1024; const bf16* xbr = xb + (size_t)m * 1024;
#pragma unroll
            for (int j = 0; j < 4; ++j) { const int c = (lane + 64 * j) * 4; const u32x2v w = __builtin_nontemporal_load((const u32x2v*)(xbr + c)); const f32x4 v = (f32x4){bflo(w.x), bfhi(w.x), bflo(w.y), bfhi(w.y)}, gg = *(const f32x4*)(gf + c); __builtin_nontemporal_store(v * rs * gg, (f32x4*)(xr + c)); } }
    }
}

extern "C" void kernel_launch(void* const* d_in, const int* in_sizes, int n_in, void* d_out, int out_size, void* d_ws, size_t ws_size, hipStream_t stream) {
    static int grid = 0;
    if (grid == 0) {
        int dev = 0, cus = 0, per_cu = 0;
        if (n_in != 36 || ws_size < 256 * MiB) { fprintf(stderr, "kernel_launch: unexpected n_in %d / ws %zu\n", n_in, ws_size); grid = -1; return; }
        (void)hipGetDevice(&dev); (void)hipDeviceGetAttribute(&cus, hipDeviceAttributeMultiprocessorCount, dev);
        if (hipFuncSetAttribute((const void*)mega_fwd, hipFuncAttributeMaxDynamicSharedMemorySize, LDS_BYTES) != hipSuccess) { fprintf(stderr, "kernel_launch: hipFuncSetAttribute failed\n"); grid = -1; return; }
        if (hipOccupancyMaxActiveBlocksPerMultiprocessor(&per_cu, (const void*)mega_fwd, 512, LDS_BYTES) != hipSuccess || per_cu < 1) per_cu = 1;
        (void)hipGetLastError();
        grid = cus * 1;
        if (grid > 256) grid = 256;
    }
    if (grid < 0) return;
    (void)hipMemsetAsync(d_ws, 0, CTL_ZERO_BYTES, stream);
    Params p{};
    for (int i = 0; i < 36; ++i) p.in[i] = (const float*)d_in[i];
    p.out = (float*)d_out; p.ws = (unsigned char*)d_ws; p.use_cg = 0; p.pad = 0;
    void* args[] = {&p};
    hipError_t e = hipLaunchCooperativeKernel((const void*)mega_fwd, dim3(grid), dim3(512), args, LDS_BYTES, stream);
    if (e != hipSuccess) fprintf(stderr, "cooperative launch failed: %s (grid %d)\n", hipGetErrorString(e), grid);
}
```

```cpp
#include <hip/hip_runtime.h>
#include <hip/hip_cooperative_groups.h>
#include <cstdio>
#include <cstdint>
namespace cg = cooperative_groups;
__device__ __forceinline__ int fresh_tid(int wave_s) { unsigned z = 0u; asm volatile("" : "+s"(z)); int t = wave_s * 64 + (int)__builtin_amdgcn_mbcnt_hi(~0u, __builtin_amdgcn_mbcnt_lo(~0u, z)); asm volatile("" : "+v"(t)); return t; }
namespace pg8 {
#define PG8_LAS __attribute__((address_space(3)))
typedef unsigned short bf16_t;
typedef short bf16x8 __attribute__((ext_vector_type(8)));
typedef float f32x4 __attribute__((ext_vector_type(4)));
typedef unsigned u32x4 __attribute__((ext_vector_type(4)));
constexpr int BM = 256, BK = 64, HALF = 128, HTB = HALF * BK * 2  , STAGE_BYTES = 8 * HTB, NXCD = 8, WGM = 8;

__host__ __device__ __forceinline__ int lds_byte(int r, int c) { const int st = (r >> 4) * 2 + (c >> 5), rr = r & 15, cc = c & 31, ob = rr * 64 + cc * 2; return st * 1024 + (ob ^ (((ob >> 9) & 1) << 5)); }
__host__ __device__ __forceinline__ void stage_rc(int b, int& R, int& C) { const int st = b / 1024, sb = b % 1024, swz = sb ^ (((sb >> 9) & 1) << 5); R = (st >> 1) * 16 + swz / 64; C = (st & 1) * 32 + (swz % 64) / 2; }
__host__ __device__ __forceinline__ int perm32(int rho) { const int n = rho >> 4, i = rho & 15; return 8 * (i >> 2) + 4 * n + (i & 3); }

struct Unit { int pm, pn; };
struct Gemm { const bf16_t* A; const bf16_t* Bt; int M, N, K; };

template <bool FULL> struct StaticOrderT {
    int nM, nN, nwg, G, c;
    __host__ __device__ void init(int M, int N, int G_, int c_) { nM = M / BM; nN = N / BM; nwg = nM * nN; G = G_; c = c_; }
    __host__ __device__ bool next(int i, Unit& u) const {
        const long L = (long)i * G + c; if (!(FULL && i == 0) && L >= nwg) return false;
        int wgid = (int)L; { const int q = nwg / NXCD, r = nwg % NXCD, xcd = wgid % NXCD, off = wgid / NXCD; wgid = (xcd < r ? xcd * (q + 1) : r * (q + 1) + (xcd - r) * q) + off; }
        const int nig = WGM * nN, gid = wgid / nig, fm = gid * WGM, gsz = (nM - fm) < WGM ? (nM - fm) : WGM;
        u.pm = fm + ((wgid % nig) % gsz); u.pn = (wgid % nig) / gsz; return true;
    }
    __device__ __forceinline__ void a_ready(const Unit&) const {}
    __device__ __forceinline__ void done(const Unit&) const {}
};

typedef StaticOrderT<false> StaticOrder; typedef StaticOrderT<true> StaticOrderF;
__device__ __forceinline__ unsigned cvt_pk_bf16(float lo, float hi) { unsigned r; asm volatile("v_cvt_pk_bf16_f32 %0, %1, %2" : "=v"(r) : "v"(lo), "v"(hi)); return r; }
typedef float f32x2 __attribute__((ext_vector_type(2)));
template <class Epi, class Sched, bool ALIGN_EPI = false, bool SP2 = false>
__device__ __forceinline__ void gemm_phase(PG8_LAS unsigned char* lds, const Gemm g, const Sched& S, const Epi& E, const int wave_s) {
    const int tid = fresh_tid(wave_s), wid = __builtin_amdgcn_readfirstlane(tid >> 6), lane = tid & 63, wr = wid >> 2, wc = wid & 3, fr = lane & 15, fq = lane >> 4;
    const int K = g.K, nt = K / BK;
    unsigned voffA[2], voffB[2];
#pragma unroll
    for (int i = 0; i < 2; ++i) { int R, C; stage_rc(tid * 16 + i * 8192, R, C); const int Rb = Epi::PERM ? ((R & ~31) + perm32(R & 31)) : R;
        voffA[i] = (unsigned)(R * K + C) * 2u; voffB[i] = (unsigned)(Rb * K + C) * 2u; }
    const size_t kstep = (size_t)(BK * 2);
    const size_t hstep = (size_t)HALF * K * 2;
    const size_t tstep = 2 * hstep;
    const unsigned ldsw = (unsigned)wid * 1024u;
    const int aoff = lds_byte(wr * 64 + fr, fq * 8), boff = lds_byte(wc * 32 + fr, fq * 8);
#define PG8_SA(b, h) (((b) * 2 + (h)) * HTB)
#define PG8_SB(b, h) ((4 + (b) * 2 + (h)) * HTB)
#define PG8_STAGE(bufoff, gbase, voff) do { _Pragma("unroll") for (int _i = 0; _i < 2; ++_i) \
        __builtin_amdgcn_global_load_lds((const unsigned*)((const char*)(gbase) + (voff)[_i]), (PG8_LAS unsigned*)(lds + (bufoff) + ldsw + _i * 8192), 16, 0, 0); } while (0)
#define PG8_LDA(dst, b, h) do { _Pragma("unroll") for (int m = 0; m < 4; ++m) _Pragma("unroll") for (int k = 0; k < 2; ++k) dst[m][k] = *(const PG8_LAS bf16x8*)(lds + PG8_SA(b, h) + aoff + m * 2048 + k * 1024); } while (0)
#define PG8_LDB(dst, b, h) do { _Pragma("unroll") for (int n = 0; n < 2; ++n) _Pragma("unroll") for (int k = 0; k < 2; ++k) dst[n][k] = *(const PG8_LAS bf16x8*)(lds + PG8_SB(b, h) + boff + n * 2048 + k * 1024); } while (0)
#define PG8_MMA(ai, bj, At, Bt) do { __builtin_amdgcn_s_setprio(1); _Pragma("unroll") for (int m = 0; m < 4; ++m) _Pragma("unroll") for (int n = 0; n < 2; ++n) _Pragma("unroll") for (int k = 0; k < 2; ++k) \
        acc[ai][bj][m][n] = __builtin_amdgcn_mfma_f32_16x16x32_bf16(Bt[n][k], At[m][k], acc[ai][bj][m][n], 0, 0, 0); __builtin_amdgcn_s_setprio(0); } while (0)
#define PG8_WAIT_V(n) asm volatile("s_waitcnt vmcnt(" #n ")" ::: "memory")
#define PG8_WAIT_L(n) asm volatile("s_waitcnt lgkmcnt(" #n ")" ::: "memory")
#define PG8_BAR __builtin_amdgcn_s_barrier()
#define PG8_SCHED __builtin_amdgcn_sched_barrier(0)
    Unit cur, nxt; int ui = 0;
    if (!S.next(0, cur)) return;
    f32x4 acc[2][2][4][2];
#pragma unroll
    for (int a = 0; a < 2; ++a)
#pragma unroll
        for (int b = 0; b < 2; ++b)
#pragma unroll
            for (int m = 0; m < 4; ++m)
#pragma unroll
                for (int n = 0; n < 2; ++n) acc[a][b][m][n] = (f32x4){0.f, 0.f, 0.f, 0.f};
    bf16x8 At[4][2], B0[2][2], B1[2][2];
    const char* cA = (const char*)g.A + (size_t)cur.pm * tstep; const char* cB = (const char*)g.Bt + (size_t)cur.pn * tstep;
    S.a_ready(cur);
    if constexpr (SP2) {
        PG8_STAGE(PG8_SB(0, 0), cB, voffB); PG8_STAGE(PG8_SB(0, 1), cB + hstep, voffB); PG8_STAGE(PG8_SA(0, 0), cA, voffA); PG8_STAGE(PG8_SA(0, 1), cA + hstep, voffA);
        if (wr == 1) PG8_BAR;
        PG8_WAIT_V(2); PG8_BAR;
        PG8_STAGE(PG8_SB(1, 0), cB + kstep, voffB); PG8_STAGE(PG8_SA(1, 0), cA + kstep, voffA); PG8_STAGE(PG8_SB(1, 1), cB + hstep + kstep, voffB);
        PG8_WAIT_V(6); PG8_BAR;
    } else {
        PG8_STAGE(PG8_SB(0, 0), cB, voffB); PG8_STAGE(PG8_SA(0, 0), cA, voffA); PG8_STAGE(PG8_SB(0, 1), cB + hstep, voffB); PG8_STAGE(PG8_SA(0, 1), cA + hstep, voffA);
        if (wr == 1) PG8_BAR;
        PG8_WAIT_V(4); PG8_BAR;
        PG8_STAGE(PG8_SB(1, 0), cB + kstep, voffB); PG8_STAGE(PG8_SA(1, 0), cA + kstep, voffA); PG8_STAGE(PG8_SB(1, 1), cB + hstep + kstep, voffB);
        PG8_WAIT_V(6); PG8_BAR;
    }
    for (;;) {
        const bool has_next = S.next(ui + 1, nxt);
        const char* nA = has_next ? (const char*)g.A + (size_t)nxt.pm * tstep : cA; const char* nB = has_next ? (const char*)g.Bt + (size_t)nxt.pn * tstep : cB;
        for (int t = 0; t < nt; t += 2) {
            const bool last = (t == nt - 2);
            const char* a1 = cA + (size_t)(t + 1) * kstep;
            const char* a2 = last ? nA : cA + (size_t)(t + 2) * kstep; const char* b2 = last ? nB : cB + (size_t)(t + 2) * kstep;
            const char* a3 = a2 + kstep; const char* b3 = b2 + kstep;
            if (last && has_next) S.a_ready(nxt);
            if constexpr (SP2) {
            PG8_LDB(B0, 0, 0); PG8_LDB(B1, 0, 1); PG8_SCHED; PG8_LDA(At, 0, 0); PG8_STAGE(PG8_SA(1, 1), a1 + hstep, voffA);
            PG8_WAIT_V(8); PG8_WAIT_L(0); PG8_BAR; PG8_MMA(0, 0, At, B0); PG8_MMA(0, 1, At, B1); PG8_BAR; PG8_SCHED;
            PG8_LDA(At, 0, 1); PG8_STAGE(PG8_SB(0, 0), b2, voffB); PG8_STAGE(PG8_SB(0, 1), b2 + hstep, voffB); PG8_STAGE(PG8_SA(0, 0), a2, voffA);
            PG8_WAIT_V(8); PG8_WAIT_L(0); PG8_BAR; PG8_MMA(1, 0, At, B0); PG8_MMA(1, 1, At, B1); PG8_BAR; PG8_SCHED;
            PG8_LDB(B0, 1, 0); PG8_LDB(B1, 1, 1); PG8_SCHED; PG8_LDA(At, 1, 0); PG8_STAGE(PG8_SA(0, 1), a2 + hstep, voffA);
            PG8_WAIT_V(8); PG8_WAIT_L(0); PG8_BAR; PG8_MMA(0, 0, At, B0); PG8_MMA(0, 1, At, B1); PG8_BAR; PG8_SCHED;
            PG8_LDA(At, 1, 1); PG8_STAGE(PG8_SB(1, 0), b3, voffB); PG8_STAGE(PG8_SB(1, 1), b3 + hstep, voffB); PG8_STAGE(PG8_SA(1, 0), a3, voffA);
            PG8_WAIT_V(8); PG8_WAIT_L(0); PG8_BAR; PG8_MMA(1, 0, At, B0); PG8_MMA(1, 1, At, B1); PG8_BAR; PG8_SCHED;
            } else {
            PG8_LDB(B0, 0, 0); PG8_SCHED; PG8_LDA(At, 0, 0); PG8_STAGE(PG8_SA(1, 1), a1 + hstep, voffA);
            PG8_WAIT_L(8); PG8_BAR; PG8_WAIT_L(0); PG8_MMA(0, 0, At, B0); PG8_BAR; PG8_SCHED;
            PG8_LDB(B1, 0, 1); PG8_STAGE(PG8_SB(0, 0), b2, voffB);
            PG8_BAR; PG8_WAIT_L(0); PG8_MMA(0, 1, At, B1); PG8_BAR;
            PG8_LDA(At, 0, 1); PG8_STAGE(PG8_SA(0, 0), a2, voffA);
            PG8_BAR; PG8_WAIT_L(0); PG8_MMA(1, 0, At, B0); PG8_BAR; PG8_SCHED;
            PG8_STAGE(PG8_SB(0, 1), b2 + hstep, voffB);
            PG8_WAIT_V(6); PG8_BAR; PG8_MMA(1, 1, At, B1); PG8_BAR;
            PG8_LDB(B0, 1, 0); PG8_SCHED; PG8_LDA(At, 1, 0); PG8_STAGE(PG8_SA(0, 1), a2 + hstep, voffA);
            PG8_WAIT_L(8); PG8_BAR; PG8_WAIT_L(0); PG8_MMA(0, 0, At, B0); PG8_BAR; PG8_SCHED;
            PG8_LDB(B1, 1, 1); PG8_STAGE(PG8_SB(1, 0), b3, voffB);
            PG8_BAR; PG8_WAIT_L(0); PG8_MMA(0, 1, At, B1); PG8_BAR;
            PG8_LDA(At, 1, 1); PG8_STAGE(PG8_SA(1, 0), a3, voffA);
            PG8_BAR; PG8_WAIT_L(0); PG8_MMA(1, 0, At, B0); PG8_BAR; PG8_SCHED;
            PG8_STAGE(PG8_SB(1, 1), b3 + hstep, voffB);
            PG8_WAIT_V(6); PG8_BAR; PG8_MMA(1, 1, At, B1); PG8_BAR;
            }
        }
        if constexpr (ALIGN_EPI) { if (wr == 0) PG8_BAR; }
        if constexpr (!Epi::AFTER_DRAIN) { E(acc, cur, wr, wc, fr, fq); S.done(cur); }
        if (!has_next) break;
#pragma unroll
        for (int a = 0; a < 2; ++a)
#pragma unroll
            for (int b = 0; b < 2; ++b)
#pragma unroll
                for (int m = 0; m < 4; ++m)
#pragma unroll
                    for (int n = 0; n < 2; ++n) acc[a][b][m][n] = (f32x4){0.f, 0.f, 0.f, 0.f};
        cur = nxt; cA = nA; cB = nB; ++ui;
        if constexpr (ALIGN_EPI) { if (wr == 1) PG8_BAR; }
    }
    PG8_WAIT_V(0);
    if constexpr (!ALIGN_EPI) { if (wr == 0) PG8_BAR; }
    PG8_BAR;
    if constexpr (Epi::AFTER_DRAIN) { E.fused(acc, cur, wr, wc, fr, fq, lds, wid, lane); S.done(cur); }
#undef PG8_SA
#undef PG8_SB
#undef PG8_STAGE
#undef PG8_LDA
#undef PG8_LDB
#undef PG8_MMA
#undef PG8_WAIT_V
#undef PG8_WAIT_L
#undef PG8_BAR
#undef PG8_SCHED
}
}
#define GAS __attribute__((address_space(1)))
#define LAS __attribute__((address_space(3)))
typedef unsigned short bf16;
typedef unsigned v4u __attribute__((ext_vector_type(4)));
typedef float f32x4 __attribute__((ext_vector_type(4)));
typedef short bf16x8 __attribute__((ext_vector_type(8)));
typedef GAS unsigned gu32;
typedef GAS unsigned long long gu64;
#define RLX_AGENT __ATOMIC_RELAXED, __HIP_MEMORY_SCOPE_AGENT
#define LDS_WAIT() asm volatile("s_waitcnt lgkmcnt(0)" ::: "memory")
#define VM_WAIT() asm volatile("s_waitcnt vmcnt(0)" ::: "memory")
__device__ __forceinline__ unsigned long long rt() { return __builtin_amdgcn_s_memrealtime(); }
__device__ __forceinline__ unsigned f2bf(float f) { unsigned u = __builtin_bit_cast(unsigned, f); return (u + 0x7fffu + ((u >> 16) & 1u)) >> 16; }
__device__ __forceinline__ unsigned pk2(float lo, float hi) { return f2bf(lo) | (f2bf(hi) << 16); }

#define XB_TMO      128
#define XB_XCNT(j)  (256  + 64 * (j))
#define XB_XSUB(j)  (1280 + 64 * (j))
#define XB_XGEN(j)  (2304 + 64 * (j))
#define XB_TOP      3328
#define XB_TOPGEN   3392
#define XCD_BAR_WORDS 3456
#define XB_SPIN_CAP (1u << 18)

__device__ __forceinline__ unsigned xb_ld(unsigned* p)              { return __hip_atomic_load(p, __ATOMIC_RELAXED, __HIP_MEMORY_SCOPE_AGENT); }
__device__ __forceinline__ unsigned xb_add(unsigned* p, unsigned v) { return __hip_atomic_fetch_add(p, v, __ATOMIC_RELAXED, __HIP_MEMORY_SCOPE_AGENT); }
__device__ __forceinline__ unsigned xb_xcc_id() { return (unsigned)__builtin_amdgcn_s_getreg((3 << 11) | 20) & 0xFu; }
#define XB_SPIN(cond, bar) do { unsigned _sp = 0; while (cond) { __builtin_amdgcn_s_sleep(1); \
    if ((++_sp & 255u) == 0u) { if (xb_ld(&(bar)[XB_TMO])) break; if (_sp > XB_SPIN_CAP) { atomicAdd(&(bar)[XB_TMO], 1u); break; } } } } while (0)

struct XcdBarrier {
    unsigned* bar; unsigned x;
    volatile LAS unsigned* st;
};

__device__ __forceinline__ XcdBarrier xcd_barrier_post(unsigned* bar, volatile LAS unsigned* st) {
    XcdBarrier b; b.bar = bar; b.x = xb_xcc_id(); b.st = st;
    if (threadIdx.x == 0) (void)xb_add(&bar[XB_XCNT(b.x)], 1u);
    return b;
}
__device__ __forceinline__ void xcd_barrier_complete(unsigned* bar, unsigned x, unsigned& nloc, unsigned& nx) {
    const unsigned G = gridDim.x * gridDim.y * gridDim.z;
    unsigned sum, cnt, mine, sp = 0u;
    for (;;) {
        sum = 0u; cnt = 0u; mine = 0u;
#pragma unroll
        for (unsigned j = 0; j < 16; ++j) { const unsigned c = xb_ld(&bar[XB_XCNT(j)]); sum += c; cnt += (c > 0u) ? 1u : 0u; mine = (j == x) ? c : mine; }
        if (sum == G) break;
        __builtin_amdgcn_s_sleep(1);
        if ((++sp & 255u) == 0u) { if (xb_ld(&bar[XB_TMO])) break; if (sp > XB_SPIN_CAP) { atomicAdd(&bar[XB_TMO], 1u); break; } }
    }
    nloc = mine > 0u ? mine : 1u; nx = cnt > 0u ? cnt : 1u;
}

__device__ __forceinline__ void xcd_barrier(const XcdBarrier& b) {
    asm volatile("s_waitcnt vmcnt(0)" ::: "memory");
    __syncthreads();
    if (threadIdx.x == 0) {
        unsigned* bar = b.bar;
        __builtin_amdgcn_s_waitcnt(0);
        unsigned nloc = b.st[0], nx = b.st[1];
        if (nloc == 0u) { xcd_barrier_complete(bar, b.x, nloc, nx); b.st[0] = nloc; b.st[1] = nx; }
        const unsigned old = xb_add(&bar[XB_XSUB(b.x)], 1u);
        const unsigned gen = old / nloc;
        if (old + 1u == (gen + 1u) * nloc) {
            __builtin_amdgcn_fence(__ATOMIC_RELEASE, "agent");
            asm volatile("s_waitcnt vmcnt(0)" ::: "memory");
            const unsigned og = xb_add(&bar[XB_TOP], 1u);
            const unsigned tg = og / nx;
            if (og + 1u == (tg + 1u) * nx) xb_add(&bar[XB_TOPGEN], 1u);
            else XB_SPIN(xb_ld(&bar[XB_TOPGEN]) == tg, bar);
            __builtin_amdgcn_fence(__ATOMIC_ACQUIRE, "agent");
            xb_add(&bar[XB_XGEN(b.x)], 1u);
            asm volatile("s_waitcnt vmcnt(0)" ::: "memory");
        } else {
            XB_SPIN(xb_ld(&bar[XB_XGEN(b.x)]) == gen, bar);
            __builtin_amdgcn_fence(__ATOMIC_ACQUIRE, "agent");
            asm volatile("s_waitcnt vmcnt(0)" ::: "memory");
        }
    }
    __syncthreads();
}
typedef unsigned u32x2v __attribute__((ext_vector_type(2)));
typedef float f32x2v __attribute__((ext_vector_type(2)));

constexpr int MP = 16384, MROWS = 16640, DMODEL = 1024, DFF = 2816, NBLK64 = MROWS / 64;
constexpr float RMS_EPS = 1e-6f;
constexpr size_t OFF_Y = 0, OFF_WKP = (size_t)MROWS * 1024, OFF_WVP = OFF_WKP + 65536, OFF_SRP = OFF_WVP + 65536, OFF_SIP = OFF_SRP + 8192,
    OFF_CMP = OFF_SIP + 8192, OFF_CFP = OFF_CMP + 8192, OFF_MKP = OFF_CFP + 45056, OFF_MVP = OFF_MKP + 2097152, OFF_WKS = OFF_MVP + 2097152,
    OFF_WVS = OFF_WKS + 32768, OFF_SRS = OFF_WVS + 32768, OFF_SIS = OFF_SRS + 16384, OFF_CMS = OFF_SIS + 16384, OFF_CFS = OFF_CMS + 16384;
constexpr size_t MiB = 1u << 20;
constexpr size_t WS_ROWSS = 0, WS_BAR = 512 * 1024, CTL_ZERO_BYTES = 1 * MiB;
constexpr size_t WS_ROPE = 1 * MiB, WS_SSM = 2 * MiB, WS_CKV = 3 * MiB, WS_SLOC = 4 * MiB, WS_MEMK = 8 * MiB, WS_MEMVT = 20 * MiB, WS_SIDE = 32 * MiB;
constexpr size_t SG_BYTES = (size_t)NBLK64 * 8 * DFF * 4, SV_BYTES = (size_t)NBLK64 * 4 * DFF * 4;
static_assert(WS_SIDE + SG_BYTES + SV_BYTES <= 66 * MiB, "side buffers");
constexpr size_t WS_WT = 66 * MiB, WS_XB = 128 * MiB, WS_TMP = 161 * MiB;
constexpr size_t WT_INEVEN = 0, WT_GLU = WT_INEVEN + 1280 * 1024, WT_OUTEVEN = WT_GLU + 512 * 512, WT_WQ = WT_OUTEVEN + 1024 * 1024, WT_WKV = WT_WQ + 2 * 1024 * 1024,
    WT_WO = WT_WKV + 2 * 2048 * 1024, WT_UP = WT_WO + 2 * 1024 * 1024, WT_DOWN = WT_UP + (size_t)2 * 5632 * 1024, WT_INODD = WT_DOWN + (size_t)2 * 2816 * 1024,
    WT_OUTODD = WT_INODD + 3072 * 1024, WT_END = WT_OUTODD + 1024 * 1024;
static_assert(WS_WT + WT_END * 2 <= WS_XB, "weights");
static_assert(WS_XB + (size_t)MROWS * 1024 * 2 <= WS_TMP, "xb");
constexpr size_t TMP_BYTES = (size_t)MROWS * DFF * 2;
constexpr size_t WS_PART = 251 * MiB, PART_ELEMS = (size_t)MROWS * 16;
static_assert(WS_PART + 2 * PART_ELEMS * 4 <= 256 * MiB, "part");
static_assert(WS_TMP + TMP_BYTES <= 256 * MiB, "ws");
constexpr size_t TMP_PROJ0 = 0, TMP_GBUF = (size_t)MROWS * 1280 * 2, TMP_YCAT = TMP_GBUF + (size_t)MROWS * 512 * 2, TMP_MEMB = TMP_YCAT;
static_assert(TMP_YCAT + (size_t)MROWS * 1024 * 2 <= TMP_BYTES, "tmp");
constexpr size_t TMP_QX = 0, TMP_OX = (size_t)MROWS * 1024 * 2, TMP_ACT = 0, TMP_GB = 0, TMP_ZC = (size_t)MROWS * 1024 * 2;
constexpr int LDS_BYTES = 147456, MISC_OFF = 147456 - 512;
constexpr int NPH = 22;

#define MFMA16(a, b, c) __builtin_amdgcn_mfma_f32_16x16x32_bf16(a, b, c, 0, 0, 0)
__device__ __forceinline__ float bflo(unsigned w) { return __uint_as_float(w << 16); }
__device__ __forceinline__ float bfhi(unsigned w) { return __uint_as_float(w & 0xffff0000u); }
__device__ __forceinline__ v4u pack8(f32x4 a, f32x4 b) { v4u w; w.x = pg8::cvt_pk_bf16(a[0], a[1]); w.y = pg8::cvt_pk_bf16(a[2], a[3]); w.z = pg8::cvt_pk_bf16(b[0], b[1]); w.w = pg8::cvt_pk_bf16(b[2], b[3]); return w; }
__device__ __forceinline__ float rstd_of(const float* part, int row) { const f32x4* p = (const f32x4*)(part + (size_t)row * 16); const f32x4 a = p[0] + p[1] + p[2] + p[3]; return rsqrtf(((a[0] + a[1]) + (a[2] + a[3])) * (1.0f / 1024.0f) + RMS_EPS); }
__device__ __forceinline__ float sigmoidf_(float x) { return 1.0f / (1.0f + __expf(-x)); }
__device__ __forceinline__ float dpp_ror1(float v) { return __builtin_bit_cast(float, __builtin_amdgcn_update_dpp(0, __builtin_bit_cast(int, v), 0x121, 0xf, 0xf, false)); }
__device__ __forceinline__ float dpp_ror2(float v) { return __builtin_bit_cast(float, __builtin_amdgcn_update_dpp(0, __builtin_bit_cast(int, v), 0x122, 0xf, 0xf, false)); }
__device__ __forceinline__ float wave_sum(float v) {
#pragma unroll
    for (int o = 1; o < 64; o <<= 1) v += __shfl_xor(v, o);
    return v;
}

typedef pg8::Unit Unit;
#define EPI_ARGS const f32x4 (&acc)[2][2][4][2], const Unit& u, int wr, int wc, int fr, int fq

struct EpiBf16 {
    static constexpr bool PERM = true, AFTER_DRAIN = false;
    bf16* O; int ldc; const float* rowss;
    __device__ __forceinline__ void operator()(EPI_ARGS) const {
        const int row0 = u.pm * 256 + wr * 64 + fr, col0 = u.pn * 256 + wc * 32 + 8 * fq;
#pragma unroll
        for (int ai = 0; ai < 2; ++ai)
#pragma unroll
            for (int m = 0; m < 4; ++m) { const int row = row0 + ai * 128 + m * 16; const float rs = rstd_of(rowss, row); bf16* rp = O + (size_t)row * ldc + col0;
#pragma unroll
                for (int bj = 0; bj < 2; ++bj) *(v4u*)(rp + bj * 128) = pack8(acc[ai][bj][m][0] * rs, acc[ai][bj][m][1] * rs); }
    }
};
struct EpiRes {
    static constexpr bool PERM = true, AFTER_DRAIN = false;
    const float* base_p; const float* base_s; bf16* xb; float* rowss_next; int f32base;
    __device__ __forceinline__ void operator()(EPI_ARGS) const {
        const float* base = u.pm < 64 ? base_p : base_s;
        const int row0 = u.pm * 256 + wr * 64 + fr, col0 = u.pn * 256 + wc * 32 + 8 * fq;
#pragma unroll
        for (int ai = 0; ai < 2; ++ai)
#pragma unroll
            for (int m = 0; m < 4; ++m) { const int row = row0 + ai * 128 + m * 16; const size_t off = (size_t)row * 1024 + col0; float ss = 0.f;
#pragma unroll
                for (int bj = 0; bj < 2; ++bj) { f32x4 b0, b1;
                    if (f32base) { b0 = __builtin_nontemporal_load((const f32x4*)(base + off + bj * 128)); b1 = __builtin_nontemporal_load((const f32x4*)(base + off + bj * 128 + 4)); }
                    else { const v4u w = *(const v4u*)(xb + off + bj * 128); b0 = (f32x4){bflo(w.x), bfhi(w.x), bflo(w.y), bfhi(w.y)}; b1 = (f32x4){bflo(w.z), bfhi(w.z), bflo(w.w), bfhi(w.w)}; }
                    const f32x4 v0 = acc[ai][bj][m][0] + b0, v1 = acc[ai][bj][m][1] + b1;
                    *(v4u*)(xb + off + bj * 128) = pack8(v0, v1);
                    ss += (v0[0] * v0[0] + v0[1] * v0[1]) + (v0[2] * v0[2] + v0[3] * v0[3]) + (v1[0] * v1[0] + v1[1] * v1[1]) + (v1[2] * v1[2] + v1[3] * v1[3]); }
                ss += __shfl_xor(ss, 16); ss += __shfl_xor(ss, 32);
                if (fq == 0) rowss_next[(size_t)row * 16 + u.pn * 4 + wc] = ss; }
    }
};
struct EpiGlu {
    static constexpr bool PERM = true, AFTER_DRAIN = false;
    const bf16* g; bf16* ycat;
    __device__ __forceinline__ void operator()(EPI_ARGS) const {
        const int row0 = u.pm * 256 + wr * 64 + fr, col0 = u.pn * 256 + wc * 32 + 8 * fq;
#pragma unroll
        for (int ai = 0; ai < 2; ++ai)
#pragma unroll
            for (int m = 0; m < 4; ++m) { const int row = row0 + ai * 128 + m * 16;
#pragma unroll
                for (int bj = 0; bj < 2; ++bj) { const int col = col0 + bj * 128; const v4u gw = *(const v4u*)(g + (size_t)row * 512 + col);
                    const f32x4 a0 = acc[ai][bj][m][0], a1 = acc[ai][bj][m][1]; f32x4 o0, o1;
                    o0[0] = bflo(gw.x) * sigmoidf_(a0[0]); o0[1] = bfhi(gw.x) * sigmoidf_(a0[1]); o0[2] = bflo(gw.y) * sigmoidf_(a0[2]); o0[3] = bfhi(gw.y) * sigmoidf_(a0[3]);
                    o1[0] = bflo(gw.z) * sigmoidf_(a1[0]); o1[1] = bfhi(gw.z) * sigmoidf_(a1[1]); o1[2] = bflo(gw.w) * sigmoidf_(a1[2]); o1[3] = bfhi(gw.w) * sigmoidf_(a1[3]);
                    *(v4u*)(ycat + (size_t)row * 1024 + col) = pack8(o0, o1); } }
    }
};
struct EpiKV {
    static constexpr bool PERM = true, AFTER_DRAIN = false;
    float* out; bf16* memk;
    __device__ __forceinline__ void operator()(EPI_ARGS) const {
        const int row0 = u.pm * 256 + wr * 64 + fr, col0 = u.pn * 256 + wc * 32 + 8 * fq;
#pragma unroll
        for (int ai = 0; ai < 2; ++ai)
#pragma unroll
            for (int m = 0; m < 4; ++m) { const int row = row0 + ai * 128 + m * 16;
#pragma unroll
                for (int bj = 0; bj < 2; ++bj) { const int c = col0 + bj * 128, l = c >> 11, e = c & 2047, isv = e >> 10, dc = e & 1023;
                    float* op = out + (isv ? OFF_MVP : OFF_MKP) + (size_t)l * 1048576 + (size_t)row * 1024 + dc;
                    if (isv) { *(f32x4*)op = acc[ai][bj][m][0]; *(f32x4*)(op + 4) = acc[ai][bj][m][1]; } else { __builtin_nontemporal_store(acc[ai][bj][m][0], (f32x4*)op); __builtin_nontemporal_store(acc[ai][bj][m][1], (f32x4*)(op + 4)); }
                    if (!isv) *(v4u*)(memk + (size_t)l * 12 * 262144 + (size_t)row * 1024 + dc) = pack8(acc[ai][bj][m][0], acc[ai][bj][m][1]); } }
    }
};
struct EpiIn0 {
    static constexpr bool PERM = true, AFTER_DRAIN = false;
    bf16* proj; const float* rowss; const float* ropec; const float* ropes; float* out;
    __device__ __forceinline__ void operator()(EPI_ARGS) const {
        const int pn = u.pn;
#pragma unroll
        for (int ai = 0; ai < 2; ++ai)
#pragma unroll
            for (int m = 0; m < 4; ++m) { const int row = u.pm * 256 + ai * 128 + wr * 64 + m * 16 + fr; const float rs = rstd_of(rowss, row);
                const int pos = row < MP ? (row & 4095) : 2048 + (row & 31);
                bf16* rp = proj + (size_t)row * 1280;
                float* wk = nullptr; float* wv = nullptr;
                if (pn == 4) { if (row >= MP) { wk = out + OFF_WKS + (size_t)(row - MP) * 128; wv = out + OFF_WVS + (size_t)(row - MP) * 128; }
                               else if ((row & 4095) >= 3968) { const size_t o = (size_t)((row >> 12) * 128 + (row & 4095) - 3968) * 128; wk = out + OFF_WKP + o; wv = out + OFF_WVP + o; } }
#pragma unroll
                for (int bj = 0; bj < 2; ++bj) { const f32x4 v0 = acc[ai][bj][m][0] * rs, v1 = acc[ai][bj][m][1] * rs;
                    const bool rope = (pn == 2 || pn == 3 || (pn == 4 && bj == 0));
                    if (!rope) { const int col = pn * 256 + bj * 128 + wc * 32 + 8 * fq; *(v4u*)(rp + col) = pack8(v0, v1);
                        if (pn == 4 && wv) { *(f32x4*)(wv + wc * 32 + 8 * fq) = v0; *(f32x4*)(wv + wc * 32 + 8 * fq + 4) = v1; } }
                    else { const int gbase = pn * 256 + bj * 128 + (wc >> 1) * 64, d1 = 16 * (wc & 1) + 4 * fq;
                        const f32x4 c4 = *(const f32x4*)(ropec + pos * 32 + d1), s4 = *(const f32x4*)(ropes + pos * 32 + d1);
                        f32x4 o1 = v0 * c4 - v1 * s4, o2 = v1 * c4 + v0 * s4;
                        if (pn != 4) { o1 = o1 * 0.125f; o2 = o2 * 0.125f; }
                        u32x2v w1, w2; w1.x = pg8::cvt_pk_bf16(o1[0], o1[1]); w1.y = pg8::cvt_pk_bf16(o1[2], o1[3]); w2.x = pg8::cvt_pk_bf16(o2[0], o2[1]); w2.y = pg8::cvt_pk_bf16(o2[2], o2[3]);
                        *(u32x2v*)(rp + gbase + d1) = w1; *(u32x2v*)(rp + gbase + d1 + 32) = w2;
                        if (pn == 4 && wk) { const int cc = (wc >> 1) * 64 + d1; *(f32x4*)(wk + cc) = o1; *(f32x4*)(wk + cc + 32) = o2; } } } }
    }
};
struct EpiFfnUp {
    static constexpr bool PERM = true, AFTER_DRAIN = false;
    bf16* act; const float* rowss; const float* cw; float* SG; float* SV;
    __device__ __forceinline__ void operator()(EPI_ARGS) const {
        const int c0 = u.pn * 128 + wc * 32 + 8 * fq; const bool sample = u.pm == 64;
        const f32x4 w0a = *(const f32x4*)(cw + c0), w0b = *(const f32x4*)(cw + c0 + 4), w1a = *(const f32x4*)(cw + DFF + c0), w1b = *(const f32x4*)(cw + DFF + c0 + 4),
                    w2a = *(const f32x4*)(cw + 2 * DFF + c0), w2b = *(const f32x4*)(cw + 2 * DFF + c0 + 4);
#pragma unroll
        for (int ai = 0; ai < 2; ++ai) { f32x4 gp0 = {0.f, 0.f, 0.f, 0.f}, gp1 = {0.f, 0.f, 0.f, 0.f}; const int blk = u.pm * 4 + ai * 2 + wr;
#pragma unroll
            for (int m = 0; m < 4; ++m) { const int row = u.pm * 256 + ai * 128 + wr * 64 + m * 16 + fr; const float rs = rstd_of(rowss, row);
                const f32x4 g0 = acc[ai][0][m][0] * rs, g1 = acc[ai][0][m][1] * rs, v0 = acc[ai][1][m][0] * rs, v1 = acc[ai][1][m][1] * rs;
                f32x4 p1a, p2a, p1b, p2b;
#pragma unroll
                for (int j = 0; j < 4; ++j) { const float s1a = fr == 15 ? gp0[j] : g0[j], s2a = fr >= 14 ? gp0[j] : g0[j], s1b = fr == 15 ? gp1[j] : g1[j], s2b = fr >= 14 ? gp1[j] : g1[j];
                    p1a[j] = dpp_ror1(s1a); p2a[j] = dpp_ror2(s2a); p1b[j] = dpp_ror1(s1b); p2b[j] = dpp_ror2(s2b); }
                const f32x4 ca = w0a * p2a + w1a * p1a + w2a * g0, cb = w0b * p2b + w1b * p1b + w2b * g1;
                f32x4 sa, sb;
#pragma unroll
                for (int j = 0; j < 4; ++j) { sa[j] = sigmoidf_(ca[j]); sb[j] = sigmoidf_(cb[j]); }
                const f32x4 a0 = ca * sa * v0, a1 = cb * sb * v1;
                const bool valid = (m > 0 || fr >= 2) && !(sample && m == 2 && fr < 2);
                if (valid) *(v4u*)(act + (size_t)row * DFF + c0) = pack8(a0, a1);
                if ((m & 1) == 0 && fr < 2) { float* sg = SG + (size_t)(blk * 8 + 2 * m + fr) * DFF + c0; *(f32x4*)sg = g0; *(f32x4*)(sg + 4) = g1;
                                              float* sv = SV + (size_t)(blk * 4 + m + fr) * DFF + c0; *(f32x4*)sv = v0; *(f32x4*)(sv + 4) = v1; }
                if ((m & 1) == 1 && fr >= 14) { float* sg = SG + (size_t)(blk * 8 + 2 * m + fr - 14) * DFF + c0; *(f32x4*)sg = g0; *(f32x4*)(sg + 4) = g1; }
                gp0 = g0; gp1 = g1; } }
    }
};
struct EpiInOdd {
    static constexpr bool PERM = true, AFTER_DRAIN = false;
    bf16* gb; bf16* zc; const float* rowss; const float* cw; float* SG;
    __device__ __forceinline__ void operator()(EPI_ARGS) const {
        if (u.pn < 4) {
            const int row0 = u.pm * 256 + wr * 64 + fr, col0 = u.pn * 256 + wc * 32 + 8 * fq;
#pragma unroll
            for (int ai = 0; ai < 2; ++ai)
#pragma unroll
                for (int m = 0; m < 4; ++m) { const int row = row0 + ai * 128 + m * 16; const float rs = rstd_of(rowss, row); bf16* rp = gb + (size_t)row * 1024 + col0;
#pragma unroll
                    for (int bj = 0; bj < 2; ++bj) *(v4u*)(rp + bj * 128) = pack8(acc[ai][bj][m][0] * rs, acc[ai][bj][m][1] * rs); }
            return;
        }
        const int c0 = (u.pn - 4) * 128 + wc * 32 + 8 * fq; const bool sample = u.pm == 64;
        const f32x4 w0a = *(const f32x4*)(cw + c0), w0b = *(const f32x4*)(cw + c0 + 4), w1a = *(const f32x4*)(cw + 1024 + c0), w1b = *(const f32x4*)(cw + 1024 + c0 + 4),
                    w2a = *(const f32x4*)(cw + 2048 + c0), w2b = *(const f32x4*)(cw + 2048 + c0 + 4);
#pragma unroll
        for (int ai = 0; ai < 2; ++ai) { f32x4 gp0 = {0.f, 0.f, 0.f, 0.f}, gp1 = {0.f, 0.f, 0.f, 0.f}; const int blk = u.pm * 4 + ai * 2 + wr;
#pragma unroll
            for (int m = 0; m < 4; ++m) { const int row = u.pm * 256 + ai * 128 + wr * 64 + m * 16 + fr; const float rs = rstd_of(rowss, row); const float rs2 = rs * rs;
                const f32x4 g0 = acc[ai][0][m][0] * acc[ai][1][m][0] * rs2, g1 = acc[ai][0][m][1] * acc[ai][1][m][1] * rs2;
                f32x4 p1a, p2a, p1b, p2b;
#pragma unroll
                for (int j = 0; j < 4; ++j) { const float s1a = fr == 15 ? gp0[j] : g0[j], s2a = fr >= 14 ? gp0[j] : g0[j], s1b = fr == 15 ? gp1[j] : g1[j], s2b = fr >= 14 ? gp1[j] : g1[j];
                    p1a[j] = dpp_ror1(s1a); p2a[j] = dpp_ror2(s2a); p1b[j] = dpp_ror1(s1b); p2b[j] = dpp_ror2(s2b); }
                const f32x4 a0 = w0a * p2a + w1a * p1a + w2a * g0, a1 = w0b * p2b + w1b * p1b + w2b * g1;
                const bool valid = (m > 0 || fr >= 2) && !(sample && m == 2 && fr < 2);
                if (valid) *(v4u*)(zc + (size_t)row * 1024 + c0) = pack8(a0, a1);
                if ((m & 1) == 0 && fr < 2) { float* sg = SG + (size_t)(blk * 8 + 2 * m + fr) * 1024 + c0; *(f32x4*)sg = g0; *(f32x4*)(sg + 4) = g1; }
                if ((m & 1) == 1 && fr >= 14) { float* sg = SG + (size_t)(blk * 8 + 2 * m + fr - 14) * 1024 + c0; *(f32x4*)sg = g0; *(f32x4*)(sg + 4) = g1; }
                gp0 = g0; gp1 = g1; } }
    }
};


struct EpiCz {
    static constexpr bool PERM = true, AFTER_DRAIN = false;
    bf16* gb; const float* rowss; const float* cw; float* SG;
    __device__ __forceinline__ void operator()(EPI_ARGS) const {
        const int c0 = u.pn * 128 + wc * 32 + 8 * fq;
        const f32x4 w0a = *(const f32x4*)(cw + c0), w0b = *(const f32x4*)(cw + c0 + 4), w1a = *(const f32x4*)(cw + 1024 + c0), w1b = *(const f32x4*)(cw + 1024 + c0 + 4),
                    w2a = *(const f32x4*)(cw + 2048 + c0), w2b = *(const f32x4*)(cw + 2048 + c0 + 4);
#pragma unroll
        for (int ai = 0; ai < 2; ++ai) { f32x4 gp0 = {0.f, 0.f, 0.f, 0.f}, gp1 = {0.f, 0.f, 0.f, 0.f}; const int blk = u.pm * 4 + ai * 2 + wr;
#pragma unroll
            for (int m = 0; m < 4; ++m) { const int row = u.pm * 256 + ai * 128 + wr * 64 + m * 16 + fr; const float rs = rstd_of(rowss, row); const float rs2 = rs * rs;
                const f32x4 g0 = acc[ai][0][m][0] * acc[ai][1][m][0] * rs2, g1 = acc[ai][0][m][1] * acc[ai][1][m][1] * rs2;
                f32x4 p1a, p2a, p1b, p2b;
#pragma unroll
                for (int j = 0; j < 4; ++j) { const float s1a = fr == 15 ? gp0[j] : g0[j], s2a = fr >= 14 ? gp0[j] : g0[j], s1b = fr == 15 ? gp1[j] : g1[j], s2b = fr >= 14 ? gp1[j] : g1[j];
                    p1a[j] = dpp_ror1(s1a); p2a[j] = dpp_ror2(s2a); p1b[j] = dpp_ror1(s1b); p2b[j] = dpp_ror2(s2b); }
                const f32x4 a0 = w0a * p2a + w1a * p1a + w2a * g0, a1 = w0b * p2b + w1b * p1b + w2b * g1;
                if (m > 0 || fr >= 2) { bf16* gp = gb + (size_t)row * 1024 + c0; const v4u gw = *(const v4u*)gp;
                    const f32x4 b0 = (f32x4){bflo(gw.x), bfhi(gw.x), bflo(gw.y), bfhi(gw.y)}, b1 = (f32x4){bflo(gw.z), bfhi(gw.z), bflo(gw.w), bfhi(gw.w)};
                    *(v4u*)gp = pack8(a0 * b0, a1 * b1); }
                if ((m & 1) == 0 && fr < 2) { float* sg = SG + (size_t)(blk * 8 + 2 * m + fr) * 1024 + c0; *(f32x4*)sg = g0; *(f32x4*)(sg + 4) = g1; }
                if ((m & 1) == 1 && fr >= 14) { float* sg = SG + (size_t)(blk * 8 + 2 * m + fr - 14) * 1024 + c0; *(f32x4*)sg = g0; *(f32x4*)(sg + 4) = g1; }
                gp0 = g0; gp1 = g1; } }
    }
};

__device__ __forceinline__ int rowmap(int mode, int n) {
    if (mode == 1) { if (n >= 512 && n < 1152) { const int d = n & 63; return (n & ~63) | (32 * ((d >> 4) & 1) + 8 * ((d >> 2) & 3) + 4 * (d >> 5) + (d & 3)); } return n; }
    if (mode == 2) { return n < DFF ? ((n >> 7) * 256 + (n & 127)) : (((n - DFF) >> 7) * 256 + 128 + ((n - DFF) & 127)); }
    if (mode == 3) { if (n < 1024) return n; const int c = (n - 1024) & 1023, z = n >= 2048 ? 1 : 0; return 1024 + (c >> 7) * 256 + z * 128 + (c & 127); }
    return n;
}
__device__ __forceinline__ void tr_item(const float* W, int K, int N, bf16* WT, const float* gain, float scale, int mode, LAS float* scr, int item, int lane) {
    const int nblk = N / 32, kb = item / nblk, nb = item % nblk, k0 = 64 * kb, n0 = 32 * nb;
#pragma unroll
    for (int i = 0; i < 8; ++i) { const int idx = lane + 64 * i, kk = idx >> 3, n4 = (idx & 7) * 4; const float gs = gain ? ((const GAS float*)gain)[k0 + kk] * scale : scale;
        const f32x4 w = __builtin_nontemporal_load((const GAS f32x4*)((const GAS float*)W + (size_t)(k0 + kk) * N + n0 + n4)); LAS float* d = scr + kk * 33 + n4; d[0] = w[0] * gs; d[1] = w[1] * gs; d[2] = w[2] * gs; d[3] = w[3] * gs; }
    LDS_WAIT(); asm volatile("" ::: "memory");
    const int c = lane & 7;
#pragma unroll
    for (int j = 0; j < 4; ++j) { const int n = (lane >> 3) + 8 * j; const LAS float* s = scr + (8 * c) * 33 + n;
        v4u o; o.x = pg8::cvt_pk_bf16(s[0 * 33], s[1 * 33]); o.y = pg8::cvt_pk_bf16(s[2 * 33], s[3 * 33]); o.z = pg8::cvt_pk_bf16(s[4 * 33], s[5 * 33]); o.w = pg8::cvt_pk_bf16(s[6 * 33], s[7 * 33]);
        *(GAS v4u*)((GAS bf16*)WT + (size_t)rowmap(mode, n0 + n) * K + k0 + 8 * c) = o; }
    LDS_WAIT(); asm volatile("" ::: "memory");
}
__device__ __forceinline__ double dexp_(double y) {
    const double k = rint(y * 1.4426950408889634); const double r = (y - k * 0.6931471803691238) - k * 1.9082149292705877e-10;
    double p = 1.0 / 6227020800.0;
    p = p * r + 1.0 / 479001600.0; p = p * r + 1.0 / 39916800.0; p = p * r + 1.0 / 3628800.0; p = p * r + 1.0 / 362880.0; p = p * r + 1.0 / 40320.0; p = p * r + 1.0 / 5040.0;
    p = p * r + 1.0 / 720.0; p = p * r + 1.0 / 120.0; p = p * r + 1.0 / 24.0; p = p * r + 1.0 / 6.0; p = p * r + 0.5; p = p * r + 1.0; p = p * r + 1.0;
    const long long bits = (long long)(1023 + (int)k) << 52; return p * __builtin_bit_cast(double, bits);
}
__device__ __forceinline__ void dsincos_(double x, double& s, double& c) {
    const double k = rint(x * 0.6366197723675814); const double r = (x - k * 1.5707963267948966) - k * 6.123233995736766e-17; const double r2 = r * r;
    const double sp = r * (1.0 + r2 * (-1.0 / 6.0 + r2 * (1.0 / 120.0 + r2 * (-1.0 / 5040.0 + r2 * (1.0 / 362880.0 + r2 * (-1.0 / 39916800.0 + r2 * (1.0 / 6227020800.0)))))));
    const double cp = 1.0 + r2 * (-0.5 + r2 * (1.0 / 24.0 + r2 * (-1.0 / 720.0 + r2 * (1.0 / 40320.0 + r2 * (-1.0 / 3628800.0 + r2 * (1.0 / 479001600.0 + r2 * (-1.0 / 87178291200.0)))))));
    const int q = ((int)k) & 3;
    s = q == 0 ? sp : q == 1 ? cp : q == 2 ? -sp : -cp; c = q == 0 ? cp : q == 1 ? -sp : q == 2 ? -cp : sp;
}

__device__ __forceinline__ const bf16* kvptr(const bf16* proj, const bf16* cb, int sample, int b, int c, int kvh, int kk, int isv) {
    if (!sample) { int pos = (c - 2) * 64 + kk; pos = pos < 0 ? 0 : pos; return proj + (size_t)(b * 4096 + pos) * 1280 + 1024 + isv * 128 + kvh * 64; }
    if (kk < 128) return cb + (size_t)(b * 128 + kk) * 128 + kvh * 64;
    int t = kk - 128; t = t > 31 ? 31 : t; return proj + (size_t)(MP + b * 32 + t) * 1280 + 1024 + isv * 128 + kvh * 64;
}
__device__ __forceinline__ void swa_phase(const bf16* proj, const bf16* ckb, const bf16* cvb, const float* sinks, bf16* ycat, LAS unsigned char* lds, int tid, int wave, int lane, int G) {
    LAS bf16* VT = (LAS bf16*)lds;
    const int fr = lane & 15, quad = lane >> 4;
    for (int it = blockIdx.x; it < 528; it += G) {
        int b, c, kvh, sample;
        if (it < 512) { sample = 0; b = it >> 7; c = (it >> 1) & 63; kvh = it & 1; } else { sample = 1; b = (it - 512) >> 1; c = 0; kvh = it & 1; }
        const int gq = wave >> 1, qhalf = wave & 1, head = kvh * 4 + gq;
        bf16x8 qf[2][2], kf0[4][2];
#pragma unroll
        for (int qb = 0; qb < 2; ++qb) { const int q = qhalf * 32 + qb * 16 + fr; const int row = sample ? MP + b * 32 + (q & 31) : b * 4096 + c * 64 + q;
            const GAS bf16* qp = (const GAS bf16*)proj + (size_t)row * 1280 + 512 + head * 64 + quad * 8; qf[qb][0] = *(const GAS bf16x8*)qp; qf[qb][1] = *(const GAS bf16x8*)(qp + 32); }
#pragma unroll
        for (int i = 0; i < 4; ++i) { const int key = 32 * (i >> 1) + (fr >> 2) * 8 + 4 * (i & 1) + (fr & 3); const GAS bf16* kp = (const GAS bf16*)kvptr(proj, ckb, sample, b, c, kvh, key, 0) + quad * 8;
            kf0[i][0] = *(const GAS bf16x8*)kp; kf0[i][1] = *(const GAS bf16x8*)(kp + 32); }
        __syncthreads();
#pragma unroll
        for (int i = 0; i < 3; ++i) { const int idx = tid + 512 * i, kk = idx % 192, dg = idx / 192; const v4u w = *(const GAS v4u*)((const GAS bf16*)kvptr(proj, cvb, sample, b, c, kvh, kk, 1) + dg * 8);
            LAS bf16* vp = VT + (dg * 8) * 200 + kk;
            vp[0] = (bf16)(w.x & 0xffffu); vp[200] = (bf16)(w.x >> 16); vp[400] = (bf16)(w.y & 0xffffu); vp[600] = (bf16)(w.y >> 16);
            vp[800] = (bf16)(w.z & 0xffffu); vp[1000] = (bf16)(w.z >> 16); vp[1200] = (bf16)(w.w & 0xffffu); vp[1400] = (bf16)(w.w >> 16); }
        __syncthreads();
        if (!(sample && qhalf)) {
            const int plo = sample ? 0 : (c >= 2 ? 0 : (2 - c) * 2), phi = sample ? 5 : 6;
            f32x4 s[12][2];
#pragma unroll
            for (int kg = 0; kg < 3; ++kg) { bf16x8 kf[4][2];
#pragma unroll
                for (int i = 0; i < 4; ++i) { if (kg == 0) { kf[i][0] = kf0[i][0]; kf[i][1] = kf0[i][1]; continue; } const int kb = kg * 4 + i, key = 32 * (kb >> 1) + (fr >> 2) * 8 + 4 * (kb & 1) + (fr & 3); const GAS bf16* kp = (const GAS bf16*)kvptr(proj, ckb, sample, b, c, kvh, key, 0) + quad * 8;
                    kf[i][0] = *(const GAS bf16x8*)kp; kf[i][1] = *(const GAS bf16x8*)(kp + 32); }
                __builtin_amdgcn_sched_barrier(0);
#pragma unroll
                for (int i = 0; i < 4; ++i)
#pragma unroll
                    for (int qb = 0; qb < 2; ++qb) { f32x4 a = {0.f, 0.f, 0.f, 0.f}; a = MFMA16(kf[i][0], qf[qb][0], a); a = MFMA16(kf[i][1], qf[qb][1], a); s[kg * 4 + i][qb] = a; }
                __builtin_amdgcn_sched_barrier(0); }
            const float sink = sinks[head];
            bf16x8 pf[6][2];
#pragma unroll
            for (int qb = 0; qb < 2; ++qb) { float mx = sink;
#pragma unroll
                for (int kb = 0; kb < 12; ++kb) { const bool pv = (kb >> 1) >= plo && (kb >> 1) < phi;
#pragma unroll
                    for (int j = 0; j < 4; ++j) { const float v = pv ? s[kb][qb][j] : -1e30f; s[kb][qb][j] = v; mx = fmaxf(mx, v); } }
                mx = fmaxf(mx, __shfl_xor(mx, 16)); mx = fmaxf(mx, __shfl_xor(mx, 32));
                float sum = 0.f;
#pragma unroll
                for (int kb = 0; kb < 12; ++kb)
#pragma unroll
                    for (int j = 0; j < 4; ++j) { const float e = __expf(s[kb][qb][j] - mx); s[kb][qb][j] = e; sum += e; }
                sum += __shfl_xor(sum, 16); sum += __shfl_xor(sum, 32); sum += __expf(sink - mx);
                const float inv = 1.0f / sum;
#pragma unroll
                for (int pr = 0; pr < 6; ++pr) pf[pr][qb] = __builtin_bit_cast(bf16x8, pack8(s[2 * pr][qb] * inv, s[2 * pr + 1][qb] * inv)); }
#pragma unroll
            for (int db = 0; db < 4; ++db) { bf16x8 vf[6];
#pragma unroll
                for (int pr = 0; pr < 6; ++pr) vf[pr] = *(const LAS bf16x8*)(VT + (db * 16 + fr) * 200 + 32 * pr + quad * 8);
#pragma unroll
                for (int qb = 0; qb < 2; ++qb) { f32x4 o = {0.f, 0.f, 0.f, 0.f};
#pragma unroll
                    for (int pr = 0; pr < 6; ++pr) o = MFMA16(pf[pr][qb], vf[pr], o);
#pragma unroll
                    for (int j = 0; j < 4; ++j) { const int q = qhalf * 32 + qb * 16 + quad * 4 + j;
                        if (!sample || q < 32) { const int row = sample ? MP + b * 32 + q : b * 4096 + c * 64 + q; ycat[(size_t)row * 1024 + 512 + head * 64 + db * 16 + fr] = (bf16)f2bf(o[j]); } } } }
        }
    }
    __syncthreads();
}

__device__ __forceinline__ void xattn_phase(const bf16* qx, const bf16* memk_l, const bf16* memvT_l, bf16* ox, int wave, int lane, int G) {
    const int fr = lane & 15, quad = lane >> 4;
    for (int t = wave * G + (int)blockIdx.x; t < 4160; t += 8 * G) {
        int bb, h, row0;
        if (t < 4096) { const int pair = t >> 8; bb = pair >> 2; h = pair & 3; row0 = bb * 4096 + (t & 255) * 16; }
        else { const int s = t - 4096, b = s >> 3; h = (s >> 1) & 3; bb = 4 + b; row0 = MP + b * 32 + (s & 1) * 16; }
        bf16x8 qf[8];
#pragma unroll
        for (int ks = 0; ks < 8; ++ks) qf[ks] = *(const bf16x8*)(qx + (size_t)(row0 + fr) * 1024 + h * 256 + ks * 32 + quad * 8);
        const bf16* kbase = memk_l + (size_t)bb * 262144 + h * 256 + quad * 8;
        f32x4 s[16];
#pragma unroll
        for (int kb = 0; kb < 16; ++kb) { const int key = 32 * (kb >> 1) + (fr >> 2) * 8 + 4 * (kb & 1) + (fr & 3); const bf16* kp = kbase + (size_t)key * 1024; f32x4 a = {0.f, 0.f, 0.f, 0.f};
#pragma unroll
            for (int ks = 0; ks < 8; ++ks) a = MFMA16(*(const bf16x8*)(kp + ks * 32), qf[ks], a);
            s[kb] = a; }
        float mx = -1e30f;
#pragma unroll
        for (int kb = 0; kb < 16; ++kb)
#pragma unroll
            for (int j = 0; j < 4; ++j) mx = fmaxf(mx, s[kb][j]);
        mx = fmaxf(mx, __shfl_xor(mx, 16)); mx = fmaxf(mx, __shfl_xor(mx, 32));
        float sum = 0.f;
#pragma unroll
        for (int kb = 0; kb < 16; ++kb)
#pragma unroll
            for (int j = 0; j < 4; ++j) { const float e = __expf(s[kb][j] - mx); s[kb][j] = e; sum += e; }
        sum += __shfl_xor(sum, 16); sum += __shfl_xor(sum, 32);
        const float inv = 1.0f / sum;
        bf16x8 pf[8];
#pragma unroll
        for (int pr = 0; pr < 8; ++pr) pf[pr] = __builtin_bit_cast(bf16x8, pack8(s[2 * pr] * inv, s[2 * pr + 1] * inv));
        const bf16* vbase = memvT_l + (size_t)bb * 262144 + (size_t)(h * 256 + fr) * 256 + quad * 8;
#pragma unroll 4
        for (int db = 0; db < 16; ++db) { f32x4 o = {0.f, 0.f, 0.f, 0.f};
#pragma unroll
            for (int pr = 0; pr < 8; ++pr) o = MFMA16(pf[pr], *(const bf16x8*)(vbase + (size_t)db * 4096 + pr * 32), o);
#pragma unroll
            for (int j = 0; j < 4; ++j) ox[(size_t)(row0 + quad * 4 + j) * 1024 + h * 256 + db * 16 + fr] = (bf16)f2bf(o[j]); }
    }
}


__device__ __forceinline__ void xstage(const bf16* src, size_t rowstride, LAS unsigned char* lds, int tid) {
    v4u t[16];
#pragma unroll
    for (int i = 0; i < 16; ++i) { const int row = (tid >> 5) + 16 * i, ch = tid & 31; t[i] = *(const GAS v4u*)((const GAS bf16*)src + (size_t)row * rowstride + ch * 8); }
#pragma unroll
    for (int i = 0; i < 16; ++i) { const int row = (tid >> 5) + 16 * i, ch = tid & 31; *(LAS v4u*)(lds + row * 528 + ch * 16) = t[i]; }
}
__device__ __forceinline__ void xattn_phase2(const bf16* qx, const bf16* memk_l, const bf16* memvT_l, bf16* ox, LAS unsigned char* lds, int tid, int wave, int lane, int G) {
    const int fr = lane & 15, quad = lane >> 4;
    for (int it = blockIdx.x; it < 256 + 32; it += G) {
        int bb, h, rowbase, nqb; bool active;
        if (it < 256) { bb = it >> 6; h = (it >> 4) & 3; rowbase = bb * 4096 + (it & 15) * 256; nqb = 2; active = true; }
        else { const int s = it - 256, b = s >> 2; h = s & 3; bb = 4 + b; rowbase = MP + b * 32; nqb = 1; active = wave < 2; }
        __syncthreads();
        xstage(memk_l + (size_t)bb * 262144 + h * 256, 1024, lds, tid);
        __syncthreads();
        bf16x8 pf[2][8];
#pragma unroll
        for (int qi = 0; qi < 2; ++qi) {
            if (qi < nqb && active) {
                const int row0 = rowbase + qi * 128 + wave * 16;
                bf16x8 qf[8];
#pragma unroll
                for (int ks = 0; ks < 8; ++ks) qf[ks] = __builtin_nontemporal_load((const GAS bf16x8*)((const GAS bf16*)qx + (size_t)(row0 + fr) * 1024 + h * 256 + ks * 32 + quad * 8));
                f32x4 s[16];
#pragma unroll
                for (int kb = 0; kb < 16; ++kb) { const int key = 32 * (kb >> 1) + (fr >> 2) * 8 + 4 * (kb & 1) + (fr & 3); const LAS unsigned char* kp = lds + key * 528 + quad * 16; f32x4 a = {0.f, 0.f, 0.f, 0.f};
#pragma unroll
                    for (int ks = 0; ks < 8; ++ks) a = MFMA16(*(const LAS bf16x8*)(kp + ks * 64), qf[ks], a);
                    s[kb] = a; }
                float mx = -1e30f;
#pragma unroll
                for (int kb = 0; kb < 16; ++kb)
#pragma unroll
                    for (int j = 0; j < 4; ++j) mx = fmaxf(mx, s[kb][j]);
                mx = fmaxf(mx, __shfl_xor(mx, 16)); mx = fmaxf(mx, __shfl_xor(mx, 32));
                float sum = 0.f;
#pragma unroll
                for (int kb = 0; kb < 16; ++kb)
#pragma unroll
                    for (int j = 0; j < 4; ++j) { const float e = __expf(s[kb][j] - mx); s[kb][j] = e; sum += e; }
                sum += __shfl_xor(sum, 16); sum += __shfl_xor(sum, 32);
                const float inv = 1.0f / sum;
#pragma unroll
                for (int pr = 0; pr < 8; ++pr) pf[qi][pr] = __builtin_bit_cast(bf16x8, pack8(s[2 * pr] * inv, s[2 * pr + 1] * inv));
            }
        }
        __syncthreads();
        xstage(memvT_l + (size_t)bb * 262144 + (size_t)h * 65536, 256, lds, tid);
        __syncthreads();
        if (active) {
            const int rowA = rowbase + wave * 16, rowB = rowA + 128;
#pragma unroll 4
            for (int db = 0; db < 16; ++db) { f32x4 oa = {0.f, 0.f, 0.f, 0.f}, ob = {0.f, 0.f, 0.f, 0.f}; const LAS unsigned char* vp = lds + (db * 16 + fr) * 528 + quad * 16;
                if (nqb == 2) {
#pragma unroll
                    for (int pr = 0; pr < 8; ++pr) { const bf16x8 vf = *(const LAS bf16x8*)(vp + pr * 64); oa = MFMA16(vf, pf[0][pr], oa); ob = MFMA16(vf, pf[1][pr], ob); }
                } else {
#pragma unroll
                    for (int pr = 0; pr < 8; ++pr) { const bf16x8 vf = *(const LAS bf16x8*)(vp + pr * 64); oa = MFMA16(vf, pf[0][pr], oa); }
                }
                u32x2v w; w.x = pk2(oa[0], oa[1]); w.y = pk2(oa[2], oa[3]);
                *(GAS u32x2v*)((GAS bf16*)ox + (size_t)(rowA + fr) * 1024 + h * 256 + db * 16 + quad * 4) = w;
                if (nqb == 2) { u32x2v w2; w2.x = pk2(ob[0], ob[1]); w2.y = pk2(ob[2], ob[3]); *(GAS u32x2v*)((GAS bf16*)ox + (size_t)(rowB + fr) * 1024 + h * 256 + db * 16 + quad * 4) = w2; } }
        }
    }
    __syncthreads();
}

__device__ __forceinline__ void s5_stage_u(const bf16* up, LAS float* ubuf, int lane) {
    const v4u w0 = *(const v4u*)up, w1 = *(const v4u*)(up + 8);
    LAS f32x4* d = (LAS f32x4*)(ubuf + lane * 16);
    d[0] = (f32x4){bflo(w0.x), bfhi(w0.x), bflo(w0.y), bfhi(w0.y)}; d[1] = (f32x4){bflo(w0.z), bfhi(w0.z), bflo(w0.w), bfhi(w0.w)};
    d[2] = (f32x4){bflo(w1.x), bfhi(w1.x), bflo(w1.y), bfhi(w1.y)}; d[3] = (f32x4){bflo(w1.z), bfhi(w1.z), bflo(w1.w), bfhi(w1.w)};
}
__device__ __forceinline__ f32x2v lo2_(f32x4 v) { return __builtin_shufflevector(v, v, 0, 1); }
__device__ __forceinline__ f32x2v hi2_(f32x4 v) { return __builtin_shufflevector(v, v, 2, 3); }
#define S5_STEP(sidx) do { const LAS f32x4* up_ = (const LAS f32x4*)(ubuf + (sidx) * 16); const f32x4 u0 = up_[0], u1 = up_[1], u2 = up_[2], u3 = up_[3]; \
    f32x2v ac_ = lo2_(bb[0]) * u0[0]; ac_ = hi2_(bb[0]) * u0[1] + ac_; ac_ = lo2_(bb[1]) * u0[2] + ac_; ac_ = hi2_(bb[1]) * u0[3] + ac_; \
    ac_ = lo2_(bb[2]) * u1[0] + ac_; ac_ = hi2_(bb[2]) * u1[1] + ac_; ac_ = lo2_(bb[3]) * u1[2] + ac_; ac_ = hi2_(bb[3]) * u1[3] + ac_; \
    ac_ = lo2_(bb[4]) * u2[0] + ac_; ac_ = hi2_(bb[4]) * u2[1] + ac_; ac_ = lo2_(bb[5]) * u2[2] + ac_; ac_ = hi2_(bb[5]) * u2[3] + ac_; \
    ac_ = lo2_(bb[6]) * u3[0] + ac_; ac_ = hi2_(bb[6]) * u3[1] + ac_; ac_ = lo2_(bb[7]) * u3[2] + ac_; ac_ = hi2_(bb[7]) * u3[3] + ac_; \
    const float nr_ = ar * hr - ai * hi + ac_.x, ni_ = ar * hi + ai * hr + ac_.y; hr = nr_; hi = ni_; } while (0)

typedef short bf16x4_t __attribute__((ext_vector_type(4)));
#define MFMA16K16(a, b, c) __builtin_amdgcn_mfma_f32_16x16x16bf16_1k(a, b, c, 0, 0, 0)
__device__ __forceinline__ bf16x4_t s5_load_u(const bf16* urow0, int fr, int quad) { return *(const GAS bf16x4_t*)((const GAS bf16*)urow0 + (size_t)fr * 1280 + quad * 4); }
__device__ __forceinline__ void s5_bu_block(const bf16x4_t a, const bf16x4_t (&bcf)[8], LAS float* bul, int fr, int quad) {
#pragma unroll
    for (int cb = 0; cb < 8; ++cb) { f32x4 d = {0.f, 0.f, 0.f, 0.f}; d = MFMA16K16(a, bcf[cb], d);
#pragma unroll
        for (int j = 0; j < 4; ++j) bul[(quad * 4 + j) * 130 + cb * 16 + fr] = d[j]; }
}
__device__ __forceinline__ void s5_local(const bf16* proj, const float* abar, const bf16* bbt, float* sloc, LAS float* bul, int slot, int nslots, int lane) {
    const int fr = lane & 15, quad = lane >> 4;
    for (int t = slot; t < 8192; t += nslots) {
        const int chunk = t & 63, g = (t >> 6) & 31, b = t >> 11;
        const float ar = abar[(g * 64 + lane) * 2], ai = abar[(g * 64 + lane) * 2 + 1];
        bf16x4_t bcf[8];
#pragma unroll
        for (int cb = 0; cb < 8; ++cb) bcf[cb] = *(const GAS bf16x4_t*)((const GAS bf16*)bbt + (size_t)(g * 128 + cb * 16 + fr) * 16 + quad * 4);
        float hr = 0.f, hi = 0.f;
        bf16x4_t ua[4];
#pragma unroll
        for (int blk = 0; blk < 4; ++blk) ua[blk] = s5_load_u(proj + (size_t)(b * 4096 + chunk * 64 + blk * 16) * 1280 + g * 16, fr, quad);
#pragma unroll
        for (int blk = 0; blk < 4; ++blk) {
            s5_bu_block(ua[blk], bcf, bul, fr, quad);
#pragma unroll 4
            for (int s = 0; s < 16; ++s) { const f32x2v bu = *(const LAS f32x2v*)(bul + s * 130 + 2 * lane); const float nr = ar * hr - ai * hi + bu.x, ni = ar * hi + ai * hr + bu.y; hr = nr; hi = ni; }
        }
        *(f32x2v*)(sloc + (size_t)t * 128 + lane * 2) = (f32x2v){hr, hi};
    }
}
__device__ __forceinline__ void s5_out(const bf16* proj, const float* abar, const bf16* bbt, const float* sloc, const float* st_re, const float* st_im, const float* c_re, const float* c_im,
                                       const float* dcoef, bf16* gbuf, float* out, LAS float* bul, LAS unsigned* hbuf, int slot, int nslots, int lane) {
    const int fr = lane & 15, quad = lane >> 4;
    for (int t = slot; t < 8192 + 256; t += nslots) {
        const int sample = t >= 8192; int b, g, chunk, nblk, rowbase;
        if (!sample) { chunk = t & 63; g = (t >> 6) & 31; b = t >> 11; nblk = 4; rowbase = b * 4096 + chunk * 64; } else { const int s = t - 8192; g = s & 31; b = s >> 5; chunk = 0; nblk = 2; rowbase = MP + b * 32; }
        const float ar = abar[(g * 64 + lane) * 2], ai = abar[(g * 64 + lane) * 2 + 1];
        bf16x4_t bcf[8];
#pragma unroll
        for (int cb = 0; cb < 8; ++cb) bcf[cb] = *(const GAS bf16x4_t*)((const GAS bf16*)bbt + (size_t)(g * 128 + cb * 16 + fr) * 16 + quad * 4);
        float hr, hi;
        if (!sample) { float pr = ar, pi = ai;
#pragma unroll
            for (int i = 0; i < 6; ++i) { const float t1 = pr * pr - pi * pi; pi = 2.f * pr * pi; pr = t1; }
            hr = 0.f; hi = 0.f; const float* sp = sloc + (size_t)(t - chunk) * 128 + lane * 2;
#pragma unroll 16
            for (int cc = 0; cc < chunk; ++cc) { const f32x2v sv = *(const f32x2v*)(sp + (size_t)cc * 128); const float nr = pr * hr - pi * hi + sv.x, ni = pr * hi + pi * hr + sv.y; hr = nr; hi = ni; } }
        else { hr = st_re[(b * 32 + g) * 64 + lane]; hi = st_im[(b * 32 + g) * 64 + lane]; }
        bf16x8 cf[4];
#pragma unroll
        for (int ks = 0; ks < 4; ++ks) { const f32x4 cr = *(const f32x4*)(c_re + (size_t)(g * 16 + fr) * 64 + ks * 16 + quad * 4), ci = *(const f32x4*)(c_im + (size_t)(g * 16 + fr) * 64 + ks * 16 + quad * 4);
            v4u w; w.x = pg8::cvt_pk_bf16(cr[0], -ci[0]); w.y = pg8::cvt_pk_bf16(cr[1], -ci[1]); w.z = pg8::cvt_pk_bf16(cr[2], -ci[2]); w.w = pg8::cvt_pk_bf16(cr[3], -ci[3]); cf[ks] = __builtin_bit_cast(bf16x8, w); }
        const float dco = dcoef[g * 16 + fr];
        bf16x4_t ua[4]; bf16 uraw[4][4];
#pragma unroll
        for (int blk = 0; blk < 4; ++blk) { const int bc = blk < nblk ? blk : nblk - 1; const bf16* urow0 = proj + (size_t)(rowbase + bc * 16) * 1280 + g * 16; ua[blk] = s5_load_u(urow0, fr, quad);
#pragma unroll
            for (int j = 0; j < 4; ++j) uraw[blk][j] = ((const GAS bf16*)urow0)[(size_t)(quad * 4 + j) * 1280 + fr]; }
#pragma unroll
        for (int blk = 0; blk < 4; ++blk) { if (blk < nblk) {
            s5_bu_block(ua[blk], bcf, bul, fr, quad);
#pragma unroll 4
            for (int s = 0; s < 16; ++s) { const f32x2v bu = *(const LAS f32x2v*)(bul + s * 130 + 2 * lane); const float nr = ar * hr - ai * hi + bu.x, ni = ar * hi + ai * hr + bu.y; hr = nr; hi = ni; hbuf[s * 68 + lane] = pg8::cvt_pk_bf16(hr, hi); }
            f32x4 y = {0.f, 0.f, 0.f, 0.f};
#pragma unroll
            for (int ks = 0; ks < 4; ++ks) { const bf16x8 a = *(const LAS bf16x8*)(hbuf + fr * 68 + ks * 16 + quad * 4); y = MFMA16(a, cf[ks], y); }
#pragma unroll
            for (int j = 0; j < 4; ++j) { const int s = blk * 16 + quad * 4 + j; const float uu = bflo((unsigned)uraw[blk][j]); const float yv = y[j] + dco * uu;
                const float z = 0.7978845608028654f * (yv + 0.044715f * yv * yv * yv); const float th = 1.0f - 2.0f / (1.0f + __expf(2.0f * z)); const float gl = 0.5f * yv * (1.0f + th);
                ((GAS bf16*)gbuf)[(size_t)(rowbase + s) * 512 + g * 16 + fr] = (bf16)f2bf(gl); }
        } }
        if (!sample && chunk == 63) { out[OFF_SRP + (b * 32 + g) * 64 + lane] = hr; out[OFF_SIP + (b * 32 + g) * 64 + lane] = hi; }
        if (sample) { out[OFF_SRS + (b * 32 + g) * 64 + lane] = hr; out[OFF_SIS + (b * 32 + g) * 64 + lane] = hi; }
    }
}

template <int KIND>
__device__ __forceinline__ void sample_gemm(const bf16* A, const bf16* Bt, int K, LAS unsigned char* lds, int tid, int wave, int lane,
                                            bf16* xbp, const float* base_f32, float* part_next, const float* part_cur, bf16* O) {
    const int fr = lane & 15, quad = lane >> 4;
    LAS f32x4* red = (LAS f32x4*)lds;
    LAS float* ssred = (LAS float*)(lds + 32768);
    for (int tile = blockIdx.x; tile < 256; tile += gridDim.x) {
        const int r0 = MP + (tile >> 4) * 16, c0 = (tile & 15) * 64, kw = K >> 3;
        const bf16* ap = A + (size_t)(r0 + fr) * K + wave * kw + quad * 8;
        const bf16* bp = Bt + (size_t)(c0 + fr) * K + wave * kw + quad * 8;
        f32x4 acc[4];
#pragma unroll
        for (int cb = 0; cb < 4; ++cb) acc[cb] = (f32x4){0.f, 0.f, 0.f, 0.f};
        const int e_cb = (tid >> 6) & 3, e_l2 = tid & 63, e_row = r0 + (e_l2 & 15), e_col = c0 + e_cb * 16 + 4 * (e_l2 >> 4); const size_t e_off = (size_t)e_row * 1024 + e_col;
        f32x4 e_bs = {0.f, 0.f, 0.f, 0.f}; float e_rs = 1.f;
        if (tid < 256) { if (KIND == 0) { if (base_f32) e_bs = *(const f32x4*)(base_f32 + e_off); else { const u32x2v w = *(const u32x2v*)(xbp + e_off); e_bs = (f32x4){bflo(w.x), bfhi(w.x), bflo(w.y), bfhi(w.y)}; } }
                         else e_rs = rstd_of(part_cur, e_row); }
        const int nks = kw >> 5;
        for (int k0 = 0; k0 < nks; k0 += 4) {
            bf16x8 a[4], b[4][4];
#pragma unroll
            for (int i = 0; i < 4; ++i) { const int ks = (k0 + i < nks) ? k0 + i : nks - 1;
                a[i] = *(const bf16x8*)(ap + ks * 32);
#pragma unroll
                for (int cb = 0; cb < 4; ++cb) b[i][cb] = *(const bf16x8*)(bp + (size_t)cb * 16 * K + ks * 32); }
            __builtin_amdgcn_sched_barrier(0);
#pragma unroll
            for (int i = 0; i < 4; ++i) if (k0 + i < nks) {
#pragma unroll
                for (int cb = 0; cb < 4; ++cb) acc[cb] = MFMA16(b[i][cb], a[i], acc[cb]); }
        }
#pragma unroll
        for (int cb = 0; cb < 4; ++cb) red[(wave * 4 + cb) * 64 + lane] = acc[cb] * 1.0f;
        __syncthreads();
        if (tid < 256) { const int cb = tid >> 6, l2 = tid & 63; f32x4 v = red[cb * 64 + l2];
#pragma unroll
            for (int w = 1; w < 8; ++w) v = v + red[(w * 4 + cb) * 64 + l2];
            const int row = r0 + (l2 & 15), col = c0 + cb * 16 + 4 * (l2 >> 4); const size_t off = (size_t)row * 1024 + col;
            if (KIND == 0) {
                v = v + e_bs; u32x2v o; o.x = pk2(v[0], v[1]); o.y = pk2(v[2], v[3]); *(u32x2v*)(xbp + off) = o;
                float ss = (v[0] * v[0] + v[1] * v[1]) + (v[2] * v[2] + v[3] * v[3]); ss += __shfl_xor(ss, 16); ss += __shfl_xor(ss, 32);
                if ((l2 >> 4) == 0) ssred[cb * 16 + (l2 & 15)] = ss; }
            else { const float rs = e_rs; u32x2v o; o.x = pk2(v[0] * rs, v[1] * rs); o.y = pk2(v[2] * rs, v[3] * rs); *(u32x2v*)(O + off) = o; }
        }
        if (KIND == 0) { __syncthreads(); if (tid < 16) part_next[(size_t)(r0 + tid) * 16 + (tile & 15)] = (ssred[tid] + ssred[16 + tid]) + (ssred[32 + tid] + ssred[48 + tid]); }
        __syncthreads();
    }
}


__device__ __forceinline__ void sample_cz(const bf16* A, const bf16* Bt, LAS unsigned char* lds, int tid, int wave, int lane,
                                          const float* part_cur, const float* cw, const float* st, bf16* zcp, float* outp) {
    const int fr = lane & 15, quad = lane >> 4;
    LAS f32x4* red = (LAS f32x4*)lds;
    LAS float* T = (LAS float*)(lds + 65536);
    LAS float* CZ = (LAS float*)(lds + 65536 + 8192);
    for (int tile = blockIdx.x; tile < 256; tile += gridDim.x) {
        const int b = tile >> 5, c0 = (tile & 31) * 32, r0 = MP + b * 32;
        const int wrow = 1024 + (c0 >> 7) * 256 + (c0 & 127);
        const GAS bf16* ap = (const GAS bf16*)A + (size_t)(r0 + fr) * 1024 + wave * 128 + quad * 8;
        const GAS bf16* bp = (const GAS bf16*)Bt + (size_t)(wrow + fr) * 1024 + wave * 128 + quad * 8;
        bf16x8 a[4][2], bw[4][4];
#pragma unroll
        for (int ks = 0; ks < 4; ++ks) {
#pragma unroll
            for (int rb = 0; rb < 2; ++rb) a[ks][rb] = *(const GAS bf16x8*)(ap + (size_t)rb * 16 * 1024 + ks * 32);
#pragma unroll
            for (int cb = 0; cb < 4; ++cb) bw[ks][cb] = *(const GAS bf16x8*)(bp + (size_t)((cb >> 1) * 128 + (cb & 1) * 16) * 1024 + ks * 32); }
        f32x4 acc[2][4];
#pragma unroll
        for (int rb = 0; rb < 2; ++rb)
#pragma unroll
            for (int cb = 0; cb < 4; ++cb) { f32x4 d = {0.f, 0.f, 0.f, 0.f};
#pragma unroll
                for (int ks = 0; ks < 4; ++ks) d = MFMA16(bw[ks][cb], a[ks][rb], d);
                acc[rb][cb] = d; }
#pragma unroll
        for (int rb = 0; rb < 2; ++rb)
#pragma unroll
            for (int cb = 0; cb < 4; ++cb) red[(wave * 8 + rb * 4 + cb) * 64 + lane] = acc[rb][cb];
        __syncthreads();
        {
            const int blk = tid >> 6, l2 = tid & 63, rb = blk >> 2, cb = blk & 3; f32x4 v = red[blk * 64 + l2];
#pragma unroll
            for (int w = 1; w < 8; ++w) v = v + red[(w * 8 + blk) * 64 + l2];
            *(LAS f32x4*)(T + ((cb >> 1) * 32 + rb * 16 + (l2 & 15)) * 32 + (cb & 1) * 16 + 4 * (l2 >> 4)) = v; }
        __syncthreads();
        const int r = tid >> 3, cq = (tid & 7) * 4;
        if (tid < 256) { const float rs = rstd_of(part_cur, r0 + r); const float rs2 = rs * rs;
            const f32x4 gc = *(const LAS f32x4*)(T + r * 32 + cq), zz = *(const LAS f32x4*)(T + (32 + r) * 32 + cq);
            *(LAS f32x4*)(CZ + r * 32 + cq) = gc * zz * rs2; }
        __syncthreads();
        if (tid < 256) { const int c = c0 + cq;
            const f32x4 x0 = *(const LAS f32x4*)(CZ + r * 32 + cq);
            const f32x4 s0 = *(const f32x4*)(st + (size_t)(b * 2) * 1024 + c), s1 = *(const f32x4*)(st + (size_t)(b * 2 + 1) * 1024 + c);
            f32x4 xm1 = s1, xm2 = s0;
            if (r >= 1) { xm1 = *(const LAS f32x4*)(CZ + (r - 1) * 32 + cq); xm2 = s1; }
            if (r >= 2) xm2 = *(const LAS f32x4*)(CZ + (r - 2) * 32 + cq);
            const f32x4 w0 = *(const f32x4*)(cw + c), w1 = *(const f32x4*)(cw + 1024 + c), w2 = *(const f32x4*)(cw + 2048 + c);
            const f32x4 z = w0 * xm2 + w1 * xm1 + w2 * x0;
            bf16* gp = zcp + (size_t)(r0 + r) * 1024 + c; const u32x2v gw = *(const u32x2v*)gp;
            u32x2v o; o.x = pk2(z[0] * bflo(gw.x), z[1] * bfhi(gw.x)); o.y = pk2(z[2] * bflo(gw.y), z[3] * bfhi(gw.y)); *(u32x2v*)gp = o;
            if (r >= 30) *(f32x4*)(outp + OFF_CMS + (size_t)(b * 2 + (r - 30)) * 1024 + c) = x0; }
        __syncthreads();
    }
}

struct Params { const float* in[36]; float* out; unsigned char* ws; int use_cg, pad; };

__global__ void __launch_bounds__(512, 2) mega_fwd(Params P) {
    extern __shared__ __attribute__((aligned(16))) unsigned char lds_raw[];
    LAS unsigned char* lds = (LAS unsigned char*)lds_raw;
    volatile LAS unsigned* MISC = (volatile LAS unsigned*)(lds + MISC_OFF);
    const int G = gridDim.x, NGW = G * 8, NT = G * 512;
    const int wave_s = __builtin_amdgcn_readfirstlane(threadIdx.x >> 6);
    for (int u = threadIdx.x; u < (LDS_BYTES - 131072) / 4; u += 512) ((LAS unsigned*)(lds + 131072))[u] = 0u;
    __syncthreads();
    XcdBarrier bar = xcd_barrier_post((unsigned*)(P.ws + WS_BAR), MISC + 8);
#ifndef STOP_AFTER
#define STOP_AFTER 1000
#endif
    int ph = 0;
#define RUN (ph < STOP_AFTER)
#define FRESH() const int tid = fresh_tid(wave_s), lane = tid & 63, wave = __builtin_amdgcn_readfirstlane(tid >> 6); const int gw = blockIdx.x * 8 + wave, gt = blockIdx.x * 512 + tid; (void)gw; (void)gt; (void)lane; LAS float* wscr = (LAS float*)(lds + 32768 + wave * 12288); (void)wscr;
#define SEAM() do { if (P.use_cg) cg::this_grid().sync(); else xcd_barrier(bar); ++ph; } while (0)

#define part ((float*)(ws + WS_PART))
#define PARTBUF(k) (part + (size_t)((k) & 1) * PART_ELEMS)
#define ropec ((float*)(ws + WS_ROPE))
#define ropes (ropec + 4096 * 32)
#define abar ((float*)(ws + WS_SSM))
#define bbar (abar + 32 * 64 * 2)
#define bbt ((bf16*)(bbar + 32 * 64 * 32))
#define ckb ((bf16*)(ws + WS_CKV))
#define cvb (ckb + 8 * 128 * 128)
#define sloc ((float*)(ws + WS_SLOC))
#define memk ((bf16*)(ws + WS_MEMK))
#define memvT ((bf16*)(ws + WS_MEMVT))
#define SG ((float*)(ws + WS_SIDE))
#define SV ((float*)(ws + WS_SIDE + SG_BYTES))
#define WT ((bf16*)(ws + WS_WT))
#define xb ((bf16*)(ws + WS_XB))
#define tmp (ws + WS_TMP)
#define proj0 ((bf16*)(tmp + TMP_PROJ0))
#define gbuf ((bf16*)(tmp + TMP_GBUF))
#define ycat ((bf16*)(tmp + TMP_YCAT))
#define memb ((bf16*)(tmp + TMP_MEMB))
#define qx ((bf16*)(tmp + TMP_QX))
#define ox ((bf16*)(tmp + TMP_OX))
#define act ((bf16*)(tmp + TMP_ACT))
#define gbm ((bf16*)(tmp + TMP_GB))
#define zc ((bf16*)(tmp + TMP_ZC))
#define PTRS() unsigned char* ws = P.ws; float* out = P.out; asm volatile("" : "+s"(ws), "+s"(out));
    if (RUN) { PTRS() FRESH()
        {
            constexpr int NITEMS = 640 + 128 + 512 + 512 + 2 * 1024 + 512 + 2816 + 1408 + 2048;
            for (int it = gw; it < NITEMS; it += NGW) { int r = it;
#define TR(Wp, K_, N_, WTp, gainp, sc, mode) { const int ni_ = ((K_) / 64) * ((N_) / 32); if (r < ni_) { tr_item(Wp, K_, N_, WTp, gainp, sc, mode, wscr, r, lane); continue; } r -= ni_; }
                TR(P.in[15], 1024, 1280, WT + WT_INEVEN, P.in[11], 1.f, 1)
                TR(P.in[25], 512, 512, WT + WT_GLU, nullptr, 1.f, 0)
                TR(P.in[16], 1024, 1024, WT + WT_OUTEVEN, nullptr, 1.f, 0)
                TR(P.in[30], 1024, 1024, WT + WT_WQ, P.in[12], 0.0625f, 0)
                TR(P.in[31], 1024, 2048, WT + WT_WKV, nullptr, 1.f, 0)
                TR(P.in[31] + 2097152, 1024, 2048, WT + WT_WKV + 2097152, nullptr, 1.f, 0)
                TR(P.in[32], 1024, 1024, WT + WT_WO, nullptr, 1.f, 0)
                TR(P.in[33], 1024, 5632, WT + WT_UP, P.in[13], 1.f, 2)
                TR(P.in[35], 2816, 1024, WT + WT_DOWN, nullptr, 1.f, 0)
                { const int mi = r >> 7, l = mi >> 3, b = mi & 7; tr_item(P.in[10] + (size_t)mi * 262144, 256, 1024, memvT + (size_t)(l * 12 + 4 + b) * 262144, nullptr, 1.f, 0, wscr, r & 127, lane); }
            }
        }
        for (int m = gw; m < MROWS; m += NGW) { const float* xr = m < MP ? P.in[0] + (size_t)m * 1024 : P.in[1] + (size_t)(m - MP) * 1024; float ss = 0.f;
#pragma unroll
            for (int j = 0; j < 4; ++j) { const f32x4 v = __builtin_nontemporal_load((const f32x4*)(xr + (lane + 64 * j) * 4)); ss += (v[0] * v[0] + v[1] * v[1]) + (v[2] * v[2] + v[3] * v[3]);
                u32x2v w; w.x = pg8::cvt_pk_bf16(v[0], v[1]); w.y = pg8::cvt_pk_bf16(v[2], v[3]); *(u32x2v*)(xb + (size_t)m * 1024 + (lane + 64 * j) * 4) = w; }
            ss = wave_sum(ss); if (lane < 16) PARTBUF(0)[(size_t)m * 16 + lane] = lane == 0 ? ss : 0.f; }
        for (int i = gt; i < 262144; i += NT) { const f32x4 v = __builtin_nontemporal_load((const f32x4*)(P.in[2] + (size_t)i * 4)); u32x2v w; w.x = pg8::cvt_pk_bf16(v[0], v[1]); w.y = pg8::cvt_pk_bf16(v[2], v[3]); *(u32x2v*)(memb + (size_t)i * 4) = w; }
        for (int i = gt; i < 1048576; i += NT) { const size_t e = (size_t)i * 4; const int lb = (int)(e >> 18), l = lb >> 3, b = lb & 7; const f32x4 v = __builtin_nontemporal_load((const f32x4*)(P.in[9] + e));
            u32x2v w; w.x = pg8::cvt_pk_bf16(v[0], v[1]); w.y = pg8::cvt_pk_bf16(v[2], v[3]); *(u32x2v*)(memk + (size_t)(l * 12 + 4 + b) * 262144 + (e & 262143)) = w; }
        for (int i = gt; i < 65536; i += NT) { const int j = i & 32767; const float* src = (i < 32768 ? P.in[3] : P.in[4]) + (size_t)j * 4; bf16* dst = (i < 32768 ? ckb : cvb) + (size_t)j * 4;
            const f32x4 v = *(const f32x4*)src; u32x2v w; w.x = pg8::cvt_pk_bf16(v[0], v[1]); w.y = pg8::cvt_pk_bf16(v[2], v[3]); *(u32x2v*)dst = w; }
        for (int i = gt; i < 4096 * 32; i += NT) { const int pos = i >> 5, d = i & 31; const double inv = dexp_(-(double)d * (9.210340371976184 / 32.0)); double s, c; dsincos_((double)pos * inv, s, c); ropec[i] = (float)c; ropes[i] = (float)s; }
        for (int i = gt; i < 2048; i += NT) { const double are = P.in[17][i], aim = P.in[18][i], dt = dexp_((double)P.in[19][i]); double s, c; dsincos_(aim * dt, s, c); const double mag = dexp_(are * dt);
            const double br = mag * c, bi = mag * s; abar[2 * i] = (float)br; abar[2 * i + 1] = (float)bi;
            const double nr = br - 1.0, ni = bi, den = are * are + aim * aim; const double qr = (nr * are + ni * aim) / den, qi = (ni * are - nr * aim) / den;
#pragma unroll 4
            for (int h = 0; h < 16; ++h) { const double xr = P.in[20][(size_t)i * 16 + h], xi = P.in[21][(size_t)i * 16 + h]; const float fre = (float)(qr * xr - qi * xi), fim = (float)(qr * xi + qi * xr); bbar[(size_t)i * 32 + 2 * h] = fre; bbar[(size_t)i * 32 + 2 * h + 1] = fim;
                bbt[((size_t)i * 2) * 16 + h] = (bf16)f2bf(fre); bbt[((size_t)i * 2 + 1) * 16 + h] = (bf16)f2bf(fim); } }
    }
    SEAM();
    if (RUN) { PTRS()
        if (G < 128 || (int)blockIdx.x >= G - 64) { pg8::Gemm g{memb, WT + WT_WKV, 1024, 4096, 1024}; pg8::StaticOrder S;
            if (G < 128) S.init(1024, 4096, G, (int)blockIdx.x); else S.init(1024, 4096, 64, (int)blockIdx.x - (G - 64)); EpiKV E{out, memk};
          pg8::gemm_phase<EpiKV, pg8::StaticOrder, true, true>(lds, g, S, E, wave_s); }
        { pg8::Gemm g{xb, WT + WT_INEVEN, MROWS, 1280, 1024}; pg8::StaticOrderF S; S.init(MROWS, 1280, G, (int)blockIdx.x); EpiIn0 E{proj0, PARTBUF(0), ropec, ropes, out};
          pg8::gemm_phase<EpiIn0, pg8::StaticOrderF, true, true>(lds, g, S, E, wave_s); }
        {
            FRESH()
            const int bx = (int)blockIdx.x, n2 = 325 - G;
            int slot = -1, nw = 1;
            if (G == 256) { if (bx >= n2 && bx < G - 64) { slot = (bx - n2) * 8 + wave; nw = (G - 64 - n2) * 8; } } else { slot = gw; nw = NGW; }
            if (slot >= 0) for (int it = slot; it < 2816 + 1408; it += nw) { int r = it;
                TR(P.in[33] + (size_t)1024 * 5632, 1024, 5632, WT + WT_UP + (size_t)5632 * 1024, P.in[13] + 1024, 1.f, 2)
                tr_item(P.in[35] + (size_t)2816 * 1024, 2816, 1024, WT + WT_DOWN + (size_t)2816 * 1024, nullptr, 1.f, 0, wscr, r, lane); }
        }
    }
    SEAM();
    if (RUN) { PTRS() FRESH()
        swa_phase(proj0, ckb, cvb, P.in[26], ycat, lds, tid, wave, lane, G);
        s5_local(proj0, abar, bbt, sloc, wscr, wave * G + (int)blockIdx.x, NGW, lane);
        for (int it = wave * G + (int)blockIdx.x; it < 1024; it += NGW) { const int mi = it >> 7, l = mi >> 2, b = mi & 3;
            tr_item(out + OFF_MVP + (size_t)mi * 262144, 256, 1024, memvT + (size_t)(l * 12 + b) * 262144, nullptr, 1.f, 0, wscr, it & 127, lane); }
    }
    SEAM();
    if (RUN) { PTRS() FRESH() s5_out(proj0, abar, bbt, sloc, P.in[5], P.in[6], P.in[22], P.in[23], P.in[24], gbuf, out, (LAS float*)(lds + wave * 16384), (LAS unsigned*)(lds + wave * 16384 + 8448), wave * G + (int)blockIdx.x, NGW, lane); }
    SEAM();
    if (RUN) { PTRS() pg8::Gemm g{gbuf, WT + WT_GLU, MROWS, 512, 512}; pg8::StaticOrder S; S.init(MROWS, 512, G, (int)blockIdx.x); EpiGlu E{gbuf, ycat};
        pg8::gemm_phase<EpiGlu, pg8::StaticOrder, true, true>(lds, g, S, E, wave_s);
        {
            FRESH()
            const int bx = (int)blockIdx.x; int slot = -1, nw = 1;
            if (G > 130) { if (bx >= 130) { slot = (bx - 130) * 8 + wave; nw = (G - 130) * 8; } } else { slot = gw; nw = NGW; }
            if (slot >= 0) for (int it = slot; it < 1536 + 512; it += nw) { int r = it;
                TR(P.in[27], 1024, 3072, WT + WT_INODD, P.in[11] + 1024, 1.f, 3)
                tr_item(P.in[29], 1024, 1024, WT + WT_OUTODD, nullptr, 1.f, 0, wscr, r, lane); }
        } }
    SEAM();

#pragma unroll
    for (int l = 0; l < 2; ++l) {
        if (l == 1) {
            if (RUN) { PTRS() pg8::Gemm g{xb, WT + WT_INODD, MP, 1024, 1024}; pg8::StaticOrderF S; S.init(MP, 1024, G, (int)blockIdx.x); EpiBf16 E{gbm, 1024, PARTBUF(3)};
                pg8::gemm_phase<EpiBf16, pg8::StaticOrderF, true, true>(lds, g, S, E, wave_s);
                { FRESH() sample_gemm<1>(xb, WT + WT_INODD, 1024, lds, tid, wave, lane, nullptr, nullptr, nullptr, PARTBUF(3), gbm); } }
            SEAM();
            if (RUN) { PTRS() pg8::Gemm g{xb, WT + WT_INODD + (size_t)1024 * 1024, MP, 2048, 1024}; pg8::StaticOrderF S; S.init(MP, 2048, G, (int)blockIdx.x); EpiCz E{gbm, PARTBUF(3), P.in[28], SG};
                pg8::gemm_phase<EpiCz, pg8::StaticOrderF, true, true>(lds, g, S, E, wave_s);
                { FRESH() sample_cz(xb, WT + WT_INODD, lds, tid, wave, lane, PARTBUF(3), P.in[28], P.in[7], gbm, out); } }
            SEAM();
            if (RUN) { PTRS() FRESH()
                const float* cw = P.in[28];
                for (int i = gt; i < 512 * 128; i += NT) { const int ri = i >> 7, c0 = (i & 127) * 8, blk = ri >> 1, rr = ri & 1, row = blk * 64 + rr;
                    f32x4 pa0, pa1, pb0, pb1;
                    if ((blk & 63) == 0) { pa0 = pa1 = pb0 = pb1 = (f32x4){0.f, 0.f, 0.f, 0.f}; }
                    else { const float* s0 = SG + (size_t)((blk - 1) * 8 + 6) * 1024 + c0; pa0 = *(const f32x4*)s0; pa1 = *(const f32x4*)(s0 + 4); pb0 = *(const f32x4*)(s0 + 1024); pb1 = *(const f32x4*)(s0 + 1028); }
                    const float* sc = SG + (size_t)(blk * 8) * 1024 + c0; const f32x4 x00 = *(const f32x4*)sc, x01 = *(const f32x4*)(sc + 4);
                    f32x4 xm2a, xm2b, xm1a, xm1b, xca, xcb;
                    if (rr == 0) { xm2a = pa0; xm2b = pa1; xm1a = pb0; xm1b = pb1; xca = x00; xcb = x01; }
                    else { xm2a = pb0; xm2b = pb1; xm1a = x00; xm1b = x01; xca = *(const f32x4*)(sc + 1024); xcb = *(const f32x4*)(sc + 1028); }
                    const f32x4 w0a = *(const f32x4*)(cw + c0), w0b = *(const f32x4*)(cw + c0 + 4), w1a = *(const f32x4*)(cw + 1024 + c0), w1b = *(const f32x4*)(cw + 1028 + c0), w2a = *(const f32x4*)(cw + 2048 + c0), w2b = *(const f32x4*)(cw + 2052 + c0);
                    const f32x4 z0 = w0a * xm2a + w1a * xm1a + w2a * xca, z1 = w0b * xm2b + w1b * xm1b + w2b * xcb;
                    const v4u gw_ = *(const v4u*)(gbm + (size_t)row * 1024 + c0);
                    const f32x4 g0 = (f32x4){bflo(gw_.x), bfhi(gw_.x), bflo(gw_.y), bfhi(gw_.y)}, g1 = (f32x4){bflo(gw_.z), bfhi(gw_.z), bflo(gw_.w), bfhi(gw_.w)};
                    *(v4u*)(gbm + (size_t)row * 1024 + c0) = pack8(g0 * z0, g1 * z1); }
                for (int i = gt; i < 4 * 2 * 1024; i += NT) { const int c = i & 1023, j = (i >> 10) & 1, b = i >> 11; out[OFF_CMP + i] = SG[(size_t)((64 * b + 63) * 8 + 6 + j) * 1024 + c]; }
            }
            SEAM();
        }
        if (RUN) { PTRS() pg8::Gemm g{(bf16*)(tmp + (size_t)(1 - l) * TMP_YCAT), WT + WT_OUTEVEN + (size_t)l * (WT_OUTODD - WT_OUTEVEN), MP, 1024, 1024}; pg8::StaticOrderF S; S.init(MP, 1024, G, (int)blockIdx.x);
            EpiRes E{P.in[0], P.in[1] - (size_t)MP * 1024, xb, PARTBUF(1 + 3 * l), l == 0 ? 1 : 0};
            pg8::gemm_phase<EpiRes, pg8::StaticOrderF, true, true>(lds, g, S, E, wave_s);
            { FRESH() sample_gemm<0>((bf16*)(tmp + (size_t)(1 - l) * TMP_YCAT), WT + WT_OUTEVEN + (size_t)l * (WT_OUTODD - WT_OUTEVEN), 1024, lds, tid, wave, lane, xb, l == 0 ? P.in[1] - (size_t)MP * 1024 : (const float*)nullptr, PARTBUF(1 + 3 * l), nullptr, nullptr); } }
        SEAM();
        if (RUN) { PTRS() pg8::Gemm g{xb, WT + WT_WQ + (size_t)l * 1048576, MP, 1024, 1024}; pg8::StaticOrderF S; S.init(MP, 1024, G, (int)blockIdx.x); EpiBf16 E{qx, 1024, PARTBUF(1 + 3 * l)};
            pg8::gemm_phase<EpiBf16, pg8::StaticOrderF, true, true>(lds, g, S, E, wave_s);
            { FRESH() sample_gemm<1>(xb, WT + WT_WQ + (size_t)l * 1048576, 1024, lds, tid, wave, lane, nullptr, nullptr, nullptr, PARTBUF(1 + 3 * l), qx); } }
        SEAM();
        if (RUN) { PTRS() FRESH() xattn_phase2(qx, memk + (size_t)l * 12 * 262144, memvT + (size_t)l * 12 * 262144, ox, lds, tid, wave, lane, G); }
        SEAM();
        if (RUN) { PTRS() pg8::Gemm g{ox, WT + WT_WO + (size_t)l * 1048576, MP, 1024, 1024}; pg8::StaticOrderF S; S.init(MP, 1024, G, (int)blockIdx.x); EpiRes E{P.in[0], P.in[0], xb, PARTBUF(2 + 3 * l), 0};
            pg8::gemm_phase<EpiRes, pg8::StaticOrderF, true, true>(lds, g, S, E, wave_s);
            { FRESH() sample_gemm<0>(ox, WT + WT_WO + (size_t)l * 1048576, 1024, lds, tid, wave, lane, xb, nullptr, PARTBUF(2 + 3 * l), nullptr, nullptr); } }
        SEAM();
        if (RUN) { PTRS() pg8::Gemm g{xb, WT + WT_UP + (size_t)l * 5632 * 1024, MROWS, 5632, 1024}; pg8::StaticOrderF S; S.init(MROWS, 5632, G, (int)blockIdx.x);
            EpiFfnUp E{act, PARTBUF(2 + 3 * l), P.in[34] + (size_t)l * 3 * DFF, SG, SV};
            pg8::gemm_phase<EpiFfnUp, pg8::StaticOrderF, true, true>(lds, g, S, E, wave_s);
            if (l == 0) {
                FRESH()
                const int bx = (int)blockIdx.x, nb = 1430 % G; int slot = -1, nw = 1;
                if (nb > 0 && nb < G) { if (bx >= nb) { slot = (bx - nb) * 8 + wave; nw = (G - nb) * 8; } } else { slot = gw; nw = NGW; }
                if (slot >= 0) for (int it = slot; it < 512 + 512; it += nw) { int r = it;
                    TR(P.in[30] + 1048576, 1024, 1024, WT + WT_WQ + 1048576, P.in[12] + 1024, 0.0625f, 0)
                    tr_item(P.in[32] + 1048576, 1024, 1024, WT + WT_WO + 1048576, nullptr, 1.f, 0, wscr, r, lane); }
            } }
        SEAM();
        if (RUN) { PTRS() FRESH()
            const float* cw = P.in[34] + (size_t)l * 3 * DFF; const float* st = P.in[8] + (size_t)l * 8 * 2 * DFF;
            for (int i = gt; i < 528 * 352; i += NT) { const int fi = i / 352, c0 = (i % 352) * 8; int blk, row, rr, sb, vb; bool smp = fi >= 512;
                if (!smp) { blk = fi >> 1; rr = fi & 1; row = blk * 64 + rr; sb = 0; vb = 0; } else { const int s = fi - 512, half = (s >> 1) & 1; blk = 256 + (s >> 2); rr = s & 1; row = blk * 64 + half * 32 + rr; sb = half * 4; vb = half * 2; }
                f32x4 pa0, pa1, pb0, pb1;
                if (smp) { const int b = (blk - 256) * 2 + (sb >> 2); const float* s0 = st + (size_t)(b * 2) * DFF + c0; pa0 = *(const f32x4*)s0; pa1 = *(const f32x4*)(s0 + 4); pb0 = *(const f32x4*)(s0 + DFF); pb1 = *(const f32x4*)(s0 + DFF + 4); }
                else if ((blk & 63) == 0) { pa0 = pa1 = pb0 = pb1 = (f32x4){0.f, 0.f, 0.f, 0.f}; }
                else { const float* s0 = SG + (size_t)((blk - 1) * 8 + 6) * DFF + c0; pa0 = *(const f32x4*)s0; pa1 = *(const f32x4*)(s0 + 4); pb0 = *(const f32x4*)(s0 + DFF); pb1 = *(const f32x4*)(s0 + DFF + 4); }
                const float* sc = SG + (size_t)(blk * 8 + sb) * DFF + c0; const f32x4 x00 = *(const f32x4*)sc, x01 = *(const f32x4*)(sc + 4);
                f32x4 xm2a, xm2b, xm1a, xm1b, xca, xcb;
                if (rr == 0) { xm2a = pa0; xm2b = pa1; xm1a = pb0; xm1b = pb1; xca = x00; xcb = x01; }
                else { xm2a = pb0; xm2b = pb1; xm1a = x00; xm1b = x01; xca = *(const f32x4*)(sc + DFF); xcb = *(const f32x4*)(sc + DFF + 4); }
                const f32x4 w0a = *(const f32x4*)(cw + c0), w0b = *(const f32x4*)(cw + c0 + 4), w1a = *(const f32x4*)(cw + DFF + c0), w1b = *(const f32x4*)(cw + DFF + c0 + 4), w2a = *(const f32x4*)(cw + 2 * DFF + c0), w2b = *(const f32x4*)(cw + 2 * DFF + c0 + 4);
                const f32x4 ga = w0a * xm2a + w1a * xm1a + w2a * xca, gb_ = w0b * xm2b + w1b * xm1b + w2b * xcb;
                const float* sv = SV + (size_t)(blk * 4 + vb + rr) * DFF + c0; const f32x4 va = *(const f32x4*)sv, vb_ = *(const f32x4*)(sv + 4);
                f32x4 a0, a1;
#pragma unroll
                for (int j = 0; j < 4; ++j) { a0[j] = ga[j] * sigmoidf_(ga[j]) * va[j]; a1[j] = gb_[j] * sigmoidf_(gb_[j]) * vb_[j]; }
                *(v4u*)(act + (size_t)row * DFF + c0) = pack8(a0, a1); }
            for (int i = gt; i < 4 * 2 * DFF; i += NT) { const int c = i % DFF, j = (i / DFF) & 1, b = i / (2 * DFF); out[OFF_CFP + (size_t)l * 4 * 2 * DFF + i] = SG[(size_t)((64 * b + 63) * 8 + 6 + j) * DFF + c]; }
            for (int i = gt; i < 8 * 2 * DFF; i += NT) { const int c = i % DFF, j = (i / DFF) & 1, b = i / (2 * DFF); out[OFF_CFS + (size_t)l * 8 * 2 * DFF + i] = SG[(size_t)((256 + (b >> 1)) * 8 + (b & 1) * 4 + 2 + j) * DFF + c]; }
        }
        SEAM();
        if (RUN) { PTRS() pg8::Gemm g{act, WT + WT_DOWN + (size_t)l * 2816 * 1024, MP, 1024, DFF}; pg8::StaticOrderF S; S.init(MP, 1024, G, (int)blockIdx.x); EpiRes E{P.in[0], P.in[0], xb, PARTBUF(3 + 3 * l), 0};
            pg8::gemm_phase<EpiRes, pg8::StaticOrderF, true, true>(lds, g, S, E, wave_s);
            { FRESH() sample_gemm<0>(act, WT + WT_DOWN + (size_t)l * 2816 * 1024, DFF, lds, tid, wave, lane, xb, nullptr, PARTBUF(3 + 3 * l), nullptr, nullptr); } }
        SEAM();
    }
    if (RUN) { PTRS() FRESH()
        const float* gf = P.in[14];
        for (int m = gw; m < MROWS; m += NGW) { const float rs = rstd_of(PARTBUF(6), m); float* xr = out + (size_t)m * 1024; const bf16* xbr = xb + (size_t)m * 1024;
#pragma unroll
            for (int j = 0; j < 4; ++j) { const int c = (lane + 64 * j) * 4; const u32x2v w = __builtin_nontemporal_load((const u32x2v*)(xbr + c)); const f32x4 v = (f32x4){bflo(w.x), bfhi(w.x), bflo(w.y), bfhi(w.y)}, gg = *(const f32x4*)(gf + c); __builtin_nontemporal_store(v * rs * gg, (f32x4*)(xr + c)); } }
    }
}

extern "C" void kernel_launch(void* const* d_in, const int* in_sizes, int n_in, void* d_out, int out_size, void* d_ws, size_t ws_size, hipStream_t stream) {
    static int grid = 0;
    if (grid == 0) {
        int dev = 0, cus = 0, per_cu = 0;
        if (n_in != 36 || ws_size < 256 * MiB) { fprintf(stderr, "kernel_launch: unexpected n_in %d / ws %zu\n", n_in, ws_size); grid = -1; return; }
        (void)hipGetDevice(&dev); (void)hipDeviceGetAttribute(&cus, hipDeviceAttributeMultiprocessorCount, dev);
        if (hipFuncSetAttribute((const void*)mega_fwd, hipFuncAttributeMaxDynamicSharedMemorySize, LDS_BYTES) != hipSuccess) { fprintf(stderr, "kernel_launch: hipFuncSetAttribute failed\n"); grid = -1; return; }
        if (hipOccupancyMaxActiveBlocksPerMultiprocessor(&per_cu, (const void*)mega_fwd, 512, LDS_BYTES) != hipSuccess || per_cu < 1) per_cu = 1;
        (void)hipGetLastError();
        grid = cus * 1;
        if (grid > 256) grid = 256;
    }
    if (grid < 0) return;
    (void)hipMemsetAsync(d_ws, 0, CTL_ZERO_BYTES, stream);
    Params p{};
    for (int i = 0; i < 36; ++i) p.in[i] = (const float*)d_in[i];
    p.out = (float*)d_out; p.ws = (unsigned char*)d_ws; p.use_cg = 0; p.pad = 0;
    void* args[] = {&p};
    hipError_t e = hipLaunchCooperativeKernel((const void*)mega_fwd, dim3(grid), dim3(512), args, LDS_BYTES, stream);
    if (e != hipSuccess) fprintf(stderr, "cooperative launch failed: %s (grid %d)\n", hipGetErrorString(e), grid);
}
```

```cpp
#include <hip/hip_runtime.h>
#include <hip/hip_cooperative_groups.h>
#include <cstdio>
#include <cstdint>
namespace cg = cooperative_groups;
__device__ __forceinline__ int fresh_tid(int wave_s) { unsigned z = 0u; asm volatile("" : "+s"(z)); int t = wave_s * 64 + (int)__builtin_amdgcn_mbcnt_hi(~0u, __builtin_amdgcn_mbcnt_lo(~0u, z)); asm volatile("" : "+v"(t)); return t; }
namespace pg8 {
#define PG8_LAS __attribute__((address_space(3)))
typedef unsigned short bf16_t;
typedef short bf16x8 __attribute__((ext_vector_type(8)));
typedef float f32x4 __attribute__((ext_vector_type(4)));
typedef unsigned u32x4 __attribute__((ext_vector_type(4)));
constexpr int BM = 256, BK = 64, HALF = 128, HTB = HALF * BK * 2  , STAGE_BYTES = 8 * HTB, NXCD = 8, WGM = 8;

__host__ __device__ __forceinline__ int lds_byte(int r, int c) { const int st = (r >> 4) * 2 + (c >> 5), rr = r & 15, cc = c & 31, ob = rr * 64 + cc * 2; return st * 1024 + (ob ^ (((ob >> 9) & 1) << 5)); }
__host__ __device__ __forceinline__ void stage_rc(int b, int& R, int& C) { const int st = b / 1024, sb = b % 1024, swz = sb ^ (((sb >> 9) & 1) << 5); R = (st >> 1) * 16 + swz / 64; C = (st & 1) * 32 + (swz % 64) / 2; }
__host__ __device__ __forceinline__ int perm32(int rho) { const int n = rho >> 4, i = rho & 15; return 8 * (i >> 2) + 4 * n + (i & 3); }

struct Unit { int pm, pn; };
struct Gemm { const bf16_t* A; const bf16_t* Bt; int M, N, K; };

template <bool FULL> struct StaticOrderT {
    int nM, nN, nwg, G, c;
    __host__ __device__ void init(int M, int N, int G_, int c_) { nM = M / BM; nN = N / BM; nwg = nM * nN; G = G_; c = c_; }
    __host__ __device__ bool next(int i, Unit& u) const {
        const long L = (long)i * G + c; if (!(FULL && i == 0) && L >= nwg) return false;
        int wgid = (int)L; { const int q = nwg / NXCD, r = nwg % NXCD, xcd = wgid % NXCD, off = wgid / NXCD; wgid = (xcd < r ? xcd * (q + 1) : r * (q + 1) + (xcd - r) * q) + off; }
        const int nig = WGM * nN, gid = wgid / nig, fm = gid * WGM, gsz = (nM - fm) < WGM ? (nM - fm) : WGM;
        u.pm = fm + ((wgid % nig) % gsz); u.pn = (wgid % nig) / gsz; return true;
    }
    __device__ __forceinline__ void a_ready(const Unit&) const {}
    __device__ __forceinline__ void done(const Unit&) const {}
};

typedef StaticOrderT<false> StaticOrder; typedef StaticOrderT<true> StaticOrderF;
__device__ __forceinline__ unsigned cvt_pk_bf16(float lo, float hi) { unsigned r; asm volatile("v_cvt_pk_bf16_f32 %0, %1, %2" : "=v"(r) : "v"(lo), "v"(hi)); return r; }
typedef float f32x2 __attribute__((ext_vector_type(2)));
template <class Epi, class Sched, bool ALIGN_EPI = false, bool SP2 = false>
__device__ __forceinline__ void gemm_phase(PG8_LAS unsigned char* lds, const Gemm g, const Sched& S, const Epi& E, const int wave_s) {
    const int tid = fresh_tid(wave_s), wid = __builtin_amdgcn_readfirstlane(tid >> 6), lane = tid & 63, wr = wid >> 2, wc = wid & 3, fr = lane & 15, fq = lane >> 4;
    const int K = g.K, nt = K / BK;
    unsigned voffA[2], voffB[2];
#pragma unroll
    for (int i = 0; i < 2; ++i) { int R, C; stage_rc(tid * 16 + i * 8192, R, C); const int Rb = Epi::PERM ? ((R & ~31) + perm32(R & 31)) : R;
        voffA[i] = (unsigned)(R * K + C) * 2u; voffB[i] = (unsigned)(Rb * K + C) * 2u; }
    const size_t kstep = (size_t)(BK * 2);
    const size_t hstep = (size_t)HALF * K * 2;
    const size_t tstep = 2 * hstep;
    const unsigned ldsw = (unsigned)wid * 1024u;
    const int aoff = lds_byte(wr * 64 + fr, fq * 8), boff = lds_byte(wc * 32 + fr, fq * 8);
#define PG8_SA(b, h) (((b) * 2 + (h)) * HTB)
#define PG8_SB(b, h) ((4 + (b) * 2 + (h)) * HTB)
#define PG8_STAGE(bufoff, gbase, voff) do { _Pragma("unroll") for (int _i = 0; _i < 2; ++_i) \
        __builtin_amdgcn_global_load_lds((const unsigned*)((const char*)(gbase) + (voff)[_i]), (PG8_LAS unsigned*)(lds + (bufoff) + ldsw + _i * 8192), 16, 0, 0); } while (0)
#define PG8_LDA(dst, b, h) do { _Pragma("unroll") for (int m = 0; m < 4; ++m) _Pragma("unroll") for (int k = 0; k < 2; ++k) dst[m][k] = *(const PG8_LAS bf16x8*)(lds + PG8_SA(b, h) + aoff + m * 2048 + k * 1024); } while (0)
#define PG8_LDB(dst, b, h) do { _Pragma("unroll") for (int n = 0; n < 2; ++n) _Pragma("unroll") for (int k = 0; k < 2; ++k) dst[n][k] = *(const PG8_LAS bf16x8*)(lds + PG8_SB(b, h) + boff + n * 2048 + k * 1024); } while (0)
#define PG8_MMA(ai, bj, At, Bt) do { __builtin_amdgcn_s_setprio(1); _Pragma("unroll") for (int m = 0; m < 4; ++m) _Pragma("unroll") for (int n = 0; n < 2; ++n) _Pragma("unroll") for (int k = 0; k < 2; ++k) \
        acc[ai][bj][m][n] = __builtin_amdgcn_mfma_f32_16x16x32_bf16(Bt[n][k], At[m][k], acc[ai][bj][m][n], 0, 0, 0); __builtin_amdgcn_s_setprio(0); } while (0)
#define PG8_WAIT_V(n) asm volatile("s_waitcnt vmcnt(" #n ")" ::: "memory")
#define PG8_WAIT_L(n) asm volatile("s_waitcnt lgkmcnt(" #n ")" ::: "memory")
#define PG8_BAR __builtin_amdgcn_s_barrier()
#define PG8_SCHED __builtin_amdgcn_sched_barrier(0)
    Unit cur, nxt; int ui = 0;
    if (!S.next(0, cur)) return;
    f32x4 acc[2][2][4][2];
#pragma unroll
    for (int a = 0; a < 2; ++a)
#pragma unroll
        for (int b = 0; b < 2; ++b)
#pragma unroll
            for (int m = 0; m < 4; ++m)
#pragma unroll
                for (int n = 0; n < 2; ++n) acc[a][b][m][n] = (f32x4){0.f, 0.f, 0.f, 0.f};
    bf16x8 At[4][2], B0[2][2], B1[2][2];
    const char* cA = (const char*)g.A + (size_t)cur.pm * tstep; const char* cB = (const char*)g.Bt + (size_t)cur.pn * tstep;
    S.a_ready(cur);
    if constexpr (SP2) {
        PG8_STAGE(PG8_SB(0, 0), cB, voffB); PG8_STAGE(PG8_SB(0, 1), cB + hstep, voffB); PG8_STAGE(PG8_SA(0, 0), cA, voffA); PG8_STAGE(PG8_SA(0, 1), cA + hstep, voffA);
        if (wr == 1) PG8_BAR;
        PG8_WAIT_V(2); PG8_BAR;
        PG8_STAGE(PG8_SB(1, 0), cB + kstep, voffB); PG8_STAGE(PG8_SA(1, 0), cA + kstep, voffA); PG8_STAGE(PG8_SB(1, 1), cB + hstep + kstep, voffB);
        PG8_WAIT_V(6); PG8_BAR;
    } else {
        PG8_STAGE(PG8_SB(0, 0), cB, voffB); PG8_STAGE(PG8_SA(0, 0), cA, voffA); PG8_STAGE(PG8_SB(0, 1), cB + hstep, voffB); PG8_STAGE(PG8_SA(0, 1), cA + hstep, voffA);
        if (wr == 1) PG8_BAR;
        PG8_WAIT_V(4); PG8_BAR;
        PG8_STAGE(PG8_SB(1, 0), cB + kstep, voffB); PG8_STAGE(PG8_SA(1, 0), cA + kstep, voffA); PG8_STAGE(PG8_SB(1, 1), cB + hstep + kstep, voffB);
        PG8_WAIT_V(6); PG8_BAR;
    }
    for (;;) {
        const bool has_next = S.next(ui + 1, nxt);
        const char* nA = has_next ? (const char*)g.A + (size_t)nxt.pm * tstep : cA; const char* nB = has_next ? (const char*)g.Bt + (size_t)nxt.pn * tstep : cB;
        for (int t = 0; t < nt; t += 2) {
            const bool last = (t == nt - 2);
            const char* a1 = cA + (size_t)(t + 1) * kstep;
            const char* a2 = last ? nA : cA + (size_t)(t + 2) * kstep; const char* b2 = last ? nB : cB + (size_t)(t + 2) * kstep;
            const char* a3 = a2 + kstep; const char* b3 = b2 + kstep;
            if (last && has_next) S.a_ready(nxt);
            if constexpr (SP2) {
            PG8_LDB(B0, 0, 0); PG8_LDB(B1, 0, 1); PG8_SCHED; PG8_LDA(At, 0, 0); PG8_STAGE(PG8_SA(1, 1), a1 + hstep, voffA);
            PG8_WAIT_V(8); PG8_WAIT_L(0); PG8_BAR; PG8_MMA(0, 0, At, B0); PG8_MMA(0, 1, At, B1); PG8_BAR; PG8_SCHED;
            PG8_LDA(At, 0, 1); PG8_STAGE(PG8_SB(0, 0), b2, voffB); PG8_STAGE(PG8_SB(0, 1), b2 + hstep, voffB); PG8_STAGE(PG8_SA(0, 0), a2, voffA);
            PG8_WAIT_V(8); PG8_WAIT_L(0); PG8_BAR; PG8_MMA(1, 0, At, B0); PG8_MMA(1, 1, At, B1); PG8_BAR; PG8_SCHED;
            PG8_LDB(B0, 1, 0); PG8_LDB(B1, 1, 1); PG8_SCHED; PG8_LDA(At, 1, 0); PG8_STAGE(PG8_SA(0, 1), a2 + hstep, voffA);
            PG8_WAIT_V(8); PG8_WAIT_L(0); PG8_BAR; PG8_MMA(0, 0, At, B0); PG8_MMA(0, 1, At, B1); PG8_BAR; PG8_SCHED;
            PG8_LDA(At, 1, 1); PG8_STAGE(PG8_SB(1, 0), b3, voffB); PG8_STAGE(PG8_SB(1, 1), b3 + hstep, voffB); PG8_STAGE(PG8_SA(1, 0), a3, voffA);
            PG8_WAIT_V(8); PG8_WAIT_L(0); PG8_BAR; PG8_MMA(1, 0, At, B0); PG8_MMA(1, 1, At, B1); PG8_BAR; PG8_SCHED;
            } else {
            PG8_LDB(B0, 0, 0); PG8_SCHED; PG8_LDA(At, 0, 0); PG8_STAGE(PG8_SA(1, 1), a1 + hstep, voffA);
            PG8_WAIT_L(8); PG8_BAR; PG8_WAIT_L(0); PG8_MMA(0, 0, At, B0); PG8_BAR; PG8_SCHED;
            PG8_LDB(B1, 0, 1); PG8_STAGE(PG8_SB(0, 0), b2, voffB);
            PG8_BAR; PG8_WAIT_L(0); PG8_MMA(0, 1, At, B1); PG8_BAR;
            PG8_LDA(At, 0, 1); PG8_STAGE(PG8_SA(0, 0), a2, voffA);
            PG8_BAR; PG8_WAIT_L(0); PG8_MMA(1, 0, At, B0); PG8_BAR; PG8_SCHED;
            PG8_STAGE(PG8_SB(0, 1), b2 + hstep, voffB);
            PG8_WAIT_V(6); PG8_BAR; PG8_MMA(1, 1, At, B1); PG8_BAR;
            PG8_LDB(B0, 1, 0); PG8_SCHED; PG8_LDA(At, 1, 0); PG8_STAGE(PG8_SA(0, 1), a2 + hstep, voffA);
            PG8_WAIT_L(8); PG8_BAR; PG8_WAIT_L(0); PG8_MMA(0, 0, At, B0); PG8_BAR; PG8_SCHED;
            PG8_LDB(B1, 1, 1); PG8_STAGE(PG8_SB(1, 0), b3, voffB);
            PG8_BAR; PG8_WAIT_L(0); PG8_MMA(0, 1, At, B1); PG8_BAR;
            PG8_LDA(At, 1, 1); PG8_STAGE(PG8_SA(1, 0), a3, voffA);
            PG8_BAR; PG8_WAIT_L(0); PG8_MMA(1, 0, At, B0); PG8_BAR; PG8_SCHED;
            PG8_STAGE(PG8_SB(1, 1), b3 + hstep, voffB);
            PG8_WAIT_V(6); PG8_BAR; PG8_MMA(1, 1, At, B1); PG8_BAR;
            }
        }
        if constexpr (ALIGN_EPI) { if (wr == 0) PG8_BAR; }
        if constexpr (!Epi::AFTER_DRAIN) { E(acc, cur, wr, wc, fr, fq); S.done(cur); }
        if (!has_next) break;
#pragma unroll
        for (int a = 0; a < 2; ++a)
#pragma unroll
            for (int b = 0; b < 2; ++b)
#pragma unroll
                for (int m = 0; m < 4; ++m)
#pragma unroll
                    for (int n = 0; n < 2; ++n) acc[a][b][m][n] = (f32x4){0.f, 0.f, 0.f, 0.f};
        cur = nxt; cA = nA; cB = nB; ++ui;
        if constexpr (ALIGN_EPI) { if (wr == 1) PG8_BAR; }
    }
    PG8_WAIT_V(0);
    if constexpr (!ALIGN_EPI) { if (wr == 0) PG8_BAR; }
    PG8_BAR;
    if constexpr (Epi::AFTER_DRAIN) { E.fused(acc, cur, wr, wc, fr, fq, lds, wid, lane); S.done(cur); }
#undef PG8_SA
#undef PG8_SB
#undef PG8_STAGE
#undef PG8_LDA
#undef PG8_LDB
#undef PG8_MMA
#undef PG8_WAIT_V
#undef PG8_WAIT_L
#undef PG8_BAR
#undef PG8_SCHED
}
}
#define GAS __attribute__((address_space(1)))
#define LAS __attribute__((address_space(3)))
typedef unsigned short bf16;
typedef unsigned v4u __attribute__((ext_vector_type(4)));
typedef float f32x4 __attribute__((ext_vector_type(4)));
typedef short bf16x8 __attribute__((ext_vector_type(8)));
typedef GAS unsigned gu32;
typedef GAS unsigned long long gu64;
#define RLX_AGENT __ATOMIC_RELAXED, __HIP_MEMORY_SCOPE_AGENT
#define LDS_WAIT() asm volatile("s_waitcnt lgkmcnt(0)" ::: "memory")
#define VM_WAIT() asm volatile("s_waitcnt vmcnt(0)" ::: "memory")
__device__ __forceinline__ unsigned long long rt() { return __builtin_amdgcn_s_memrealtime(); }
__device__ __forceinline__ unsigned f2bf(float f) { unsigned u = __builtin_bit_cast(unsigned, f); return (u + 0x7fffu + ((u >> 16) & 1u)) >> 16; }
__device__ __forceinline__ unsigned pk2(float lo, float hi) { return f2bf(lo) | (f2bf(hi) << 16); }

#define XB_TMO      128
#define XB_XCNT(j)  (256  + 64 * (j))
#define XB_XSUB(j)  (1280 + 64 * (j))
#define XB_XGEN(j)  (2304 + 64 * (j))
#define XB_TOP      3328
#define XB_TOPGEN   3392
#define XCD_BAR_WORDS 3456
#define XB_SPIN_CAP (1u << 18)

__device__ __forceinline__ unsigned xb_ld(unsigned* p)              { return __hip_atomic_load(p, __ATOMIC_RELAXED, __HIP_MEMORY_SCOPE_AGENT); }
__device__ __forceinline__ unsigned xb_add(unsigned* p, unsigned v) { return __hip_atomic_fetch_add(p, v, __ATOMIC_RELAXED, __HIP_MEMORY_SCOPE_AGENT); }
__device__ __forceinline__ unsigned xb_xcc_id() { return (unsigned)__builtin_amdgcn_s_getreg((3 << 11) | 20) & 0xFu; }
#define XB_SPIN(cond, bar) do { unsigned _sp = 0; while (cond) { __builtin_amdgcn_s_sleep(1); \
    if ((++_sp & 255u) == 0u) { if (xb_ld(&(bar)[XB_TMO])) break; if (_sp > XB_SPIN_CAP) { atomicAdd(&(bar)[XB_TMO], 1u); break; } } } } while (0)

struct XcdBarrier {
    unsigned* bar; unsigned x;
    volatile LAS unsigned* st;
};

__device__ __forceinline__ XcdBarrier xcd_barrier_post(unsigned* bar, volatile LAS unsigned* st) {
    XcdBarrier b; b.bar = bar; b.x = xb_xcc_id(); b.st = st;
    if (threadIdx.x == 0) (void)xb_add(&bar[XB_XCNT(b.x)], 1u);
    return b;
}
__device__ __forceinline__ void xcd_barrier_complete(unsigned* bar, unsigned x, unsigned& nloc, unsigned& nx) {
    const unsigned G = gridDim.x * gridDim.y * gridDim.z;
    unsigned sum, cnt, mine, sp = 0u;
    for (;;) {
        sum = 0u; cnt = 0u; mine = 0u;
#pragma unroll
        for (unsigned j = 0; j < 16; ++j) { const unsigned c = xb_ld(&bar[XB_XCNT(j)]); sum += c; cnt += (c > 0u) ? 1u : 0u; mine = (j == x) ? c : mine; }
        if (sum == G) break;
        __builtin_amdgcn_s_sleep(1);
        if ((++sp & 255u) == 0u) { if (xb_ld(&bar[XB_TMO])) break; if (sp > XB_SPIN_CAP) { atomicAdd(&bar[XB_TMO], 1u); break; } }
    }
    nloc = mine > 0u ? mine : 1u; nx = cnt > 0u ? cnt : 1u;
}

__device__ __forceinline__ void xcd_barrier(const XcdBarrier& b) {
    asm volatile("s_waitcnt vmcnt(0)" ::: "memory");
    __syncthreads();
    if (threadIdx.x == 0) {
        unsigned* bar = b.bar;
        __builtin_amdgcn_s_waitcnt(0);
        unsigned nloc = b.st[0], nx = b.st[1];
        if (nloc == 0u) { xcd_barrier_complete(bar, b.x, nloc, nx); b.st[0] = nloc; b.st[1] = nx; }
        const unsigned old = xb_add(&bar[XB_XSUB(b.x)], 1u);
        const unsigned gen = old / nloc;
        if (old + 1u == (gen + 1u) * nloc) {
            __builtin_amdgcn_fence(__ATOMIC_RELEASE, "agent");
            asm volatile("s_waitcnt vmcnt(0)" ::: "memory");
            const unsigned og = xb_add(&bar[XB_TOP], 1u);
            const unsigned tg = og / nx;
            if (og + 1u == (tg + 1u) * nx) xb_add(&bar[XB_TOPGEN], 1u);
            else XB_SPIN(xb_ld(&bar[XB_TOPGEN]) == tg, bar);
            __builtin_amdgcn_fence(__ATOMIC_ACQUIRE, "agent");
            xb_add(&bar[XB_XGEN(b.x)], 1u);
            asm volatile("s_waitcnt vmcnt(0)" ::: "memory");
        } else {
            XB_SPIN(xb_ld(&bar[XB_XGEN(b.x)]) == gen, bar);
            __builtin_amdgcn_fence(__ATOMIC_ACQUIRE, "agent");
            asm volatile("s_waitcnt vmcnt(0)" ::: "memory");
        }
    }
    __syncthreads();
}
typedef unsigned u32x2v __attribute__((ext_vector_type(2)));
typedef float f32x2v __attribute__((ext_vector_type(2)));

constexpr int MP = 16384, MROWS = 16640, DMODEL = 1024, DFF = 2816, NBLK64 = MROWS / 64;
constexpr float RMS_EPS = 1e-6f;
constexpr size_t OFF_Y = 0, OFF_WKP = (size_t)MROWS * 1024, OFF_WVP = OFF_WKP + 65536, OFF_SRP = OFF_WVP + 65536, OFF_SIP = OFF_SRP + 8192,
    OFF_CMP = OFF_SIP + 8192, OFF_CFP = OFF_CMP + 8192, OFF_MKP = OFF_CFP + 45056, OFF_MVP = OFF_MKP + 2097152, OFF_WKS = OFF_MVP + 2097152,
    OFF_WVS = OFF_WKS + 32768, OFF_SRS = OFF_WVS + 32768, OFF_SIS = OFF_SRS + 16384, OFF_CMS = OFF_SIS + 16384, OFF_CFS = OFF_CMS + 16384;
constexpr size_t MiB = 1u << 20;
constexpr size_t WS_ROWSS = 0, WS_BAR = 512 * 1024, CTL_ZERO_BYTES = 1 * MiB;
constexpr size_t WS_ROPE = 1 * MiB, WS_SSM = 2 * MiB, WS_CKV = 3 * MiB, WS_SLOC = 4 * MiB, WS_MEMK = 8 * MiB, WS_MEMVT = 20 * MiB, WS_SIDE = 32 * MiB;
constexpr size_t SG_BYTES = (size_t)NBLK64 * 8 * DFF * 4, SV_BYTES = (size_t)NBLK64 * 4 * DFF * 4;
static_assert(WS_SIDE + SG_BYTES + SV_BYTES <= 66 * MiB, "side buffers");
constexpr size_t WS_WT = 66 * MiB, WS_XB = 128 * MiB, WS_TMP = 161 * MiB;
constexpr size_t WT_INEVEN = 0, WT_GLU = WT_INEVEN + 1280 * 1024, WT_OUTEVEN = WT_GLU + 512 * 512, WT_WQ = WT_OUTEVEN + 1024 * 1024, WT_WKV = WT_WQ + 2 * 1024 * 1024,
    WT_WO = WT_WKV + 2 * 2048 * 1024, WT_UP = WT_WO + 2 * 1024 * 1024, WT_DOWN = WT_UP + (size_t)2 * 5632 * 1024, WT_INODD = WT_DOWN + (size_t)2 * 2816 * 1024,
    WT_OUTODD = WT_INODD + 3072 * 1024, WT_END = WT_OUTODD + 1024 * 1024;
static_assert(WS_WT + WT_END * 2 <= WS_XB, "weights");
static_assert(WS_XB + (size_t)MROWS * 1024 * 2 <= WS_TMP, "xb");
constexpr size_t TMP_BYTES = (size_t)MROWS * DFF * 2;
constexpr size_t WS_PART = 251 * MiB, PART_ELEMS = (size_t)MROWS * 16;
static_assert(WS_PART + 2 * PART_ELEMS * 4 <= 256 * MiB, "part");
static_assert(WS_TMP + TMP_BYTES <= 256 * MiB, "ws");
constexpr size_t TMP_PROJ0 = 0, TMP_GBUF = (size_t)MROWS * 1280 * 2, TMP_YCAT = TMP_GBUF + (size_t)MROWS * 512 * 2, TMP_MEMB = TMP_YCAT;
static_assert(TMP_YCAT + (size_t)MROWS * 1024 * 2 <= TMP_BYTES, "tmp");
constexpr size_t TMP_QX = 0, TMP_OX = (size_t)MROWS * 1024 * 2, TMP_ACT = 0, TMP_GB = 0, TMP_ZC = (size_t)MROWS * 1024 * 2;
constexpr int LDS_BYTES = 147456, MISC_OFF = 147456 - 512;
constexpr int NPH = 22;

#define MFMA16(a, b, c) __builtin_amdgcn_mfma_f32_16x16x32_bf16(a, b, c, 0, 0, 0)
__device__ __forceinline__ float bflo(unsigned w) { return __uint_as_float(w << 16); }
__device__ __forceinline__ float bfhi(unsigned w) { return __uint_as_float(w & 0xffff0000u); }
__device__ __forceinline__ v4u pack8(f32x4 a, f32x4 b) { v4u w; w.x = pg8::cvt_pk_bf16(a[0], a[1]); w.y = pg8::cvt_pk_bf16(a[2], a[3]); w.z = pg8::cvt_pk_bf16(b[0], b[1]); w.w = pg8::cvt_pk_bf16(b[2], b[3]); return w; }
__device__ __forceinline__ float rstd_of(const float* part, int row) { const f32x4* p = (const f32x4*)(part + (size_t)row * 16); const f32x4 a = p[0] + p[1] + p[2] + p[3]; return rsqrtf(((a[0] + a[1]) + (a[2] + a[3])) * (1.0f / 1024.0f) + RMS_EPS); }
__device__ __forceinline__ float sigmoidf_(float x) { return 1.0f / (1.0f + __expf(-x)); }
__device__ __forceinline__ float dpp_ror1(float v) { return __builtin_bit_cast(float, __builtin_amdgcn_update_dpp(0, __builtin_bit_cast(int, v), 0x121, 0xf, 0xf, false)); }
__device__ __forceinline__ float dpp_ror2(float v) { return __builtin_bit_cast(float, __builtin_amdgcn_update_dpp(0, __builtin_bit_cast(int, v), 0x122, 0xf, 0xf, false)); }
__device__ __forceinline__ float wave_sum(float v) {
#pragma unroll
    for (int o = 1; o < 64; o <<= 1) v += __shfl_xor(v, o);
    return v;
}

typedef pg8::Unit Unit;
#define EPI_ARGS const f32x4 (&acc)[2][2][4][2], const Unit& u, int wr, int wc, int fr, int fq

struct EpiBf16 {
    static constexpr bool PERM = true, AFTER_DRAIN = false;
    bf16* O; int ldc; const float* rowss;
    __device__ __forceinline__ void operator()(EPI_ARGS) const {
        const int row0 = u.pm * 256 + wr * 64 + fr, col0 = u.pn * 256 + wc * 32 + 8 * fq;
#pragma unroll
        for (int ai = 0; ai < 2; ++ai)
#pragma unroll
            for (int m = 0; m < 4; ++m) { const int row = row0 + ai * 128 + m * 16; const float rs = rstd_of(rowss, row); bf16* rp = O + (size_t)row * ldc + col0;
#pragma unroll
                for (int bj = 0; bj < 2; ++bj) *(v4u*)(rp + bj * 128) = pack8(acc[ai][bj][m][0] * rs, acc[ai][bj][m][1] * rs); }
    }
};
struct EpiRes {
    static constexpr bool PERM = true, AFTER_DRAIN = false;
    const float* base_p; const float* base_s; bf16* xb; float* rowss_next; int f32base;
    __device__ __forceinline__ void operator()(EPI_ARGS) const {
        const float* base = u.pm < 64 ? base_p : base_s;
        const int row0 = u.pm * 256 + wr * 64 + fr, col0 = u.pn * 256 + wc * 32 + 8 * fq;
#pragma unroll
        for (int ai = 0; ai < 2; ++ai)
#pragma unroll
            for (int m = 0; m < 4; ++m) { const int row = row0 + ai * 128 + m * 16; const size_t off = (size_t)row * 1024 + col0; float ss = 0.f;
#pragma unroll
                for (int bj = 0; bj < 2; ++bj) { f32x4 b0, b1;
                    if (f32base) { b0 = __builtin_nontemporal_load((const f32x4*)(base + off + bj * 128)); b1 = __builtin_nontemporal_load((const f32x4*)(base + off + bj * 128 + 4)); }
                    else { const v4u w = *(const v4u*)(xb + off + bj * 128); b0 = (f32x4){bflo(w.x), bfhi(w.x), bflo(w.y), bfhi(w.y)}; b1 = (f32x4){bflo(w.z), bfhi(w.z), bflo(w.w), bfhi(w.w)}; }
                    const f32x4 v0 = acc[ai][bj][m][0] + b0, v1 = acc[ai][bj][m][1] + b1;
                    *(v4u*)(xb + off + bj * 128) = pack8(v0, v1);
                    ss += (v0[0] * v0[0] + v0[1] * v0[1]) + (v0[2] * v0[2] + v0[3] * v0[3]) + (v1[0] * v1[0] + v1[1] * v1[1]) + (v1[2] * v1[2] + v1[3] * v1[3]); }
                ss += __shfl_xor(ss, 16); ss += __shfl_xor(ss, 32);
                if (fq == 0) rowss_next[(size_t)row * 16 + u.pn * 4 + wc] = ss; }
    }
};
struct EpiGlu {
    static constexpr bool PERM = true, AFTER_DRAIN = false;
    const bf16* g; bf16* ycat;
    __device__ __forceinline__ void operator()(EPI_ARGS) const {
        const int row0 = u.pm * 256 + wr * 64 + fr, col0 = u.pn * 256 + wc * 32 + 8 * fq;
#pragma unroll
        for (int ai = 0; ai < 2; ++ai)
#pragma unroll
            for (int m = 0; m < 4; ++m) { const int row = row0 + ai * 128 + m * 16;
#pragma unroll
                for (int bj = 0; bj < 2; ++bj) { const int col = col0 + bj * 128; const v4u gw = *(const v4u*)(g + (size_t)row * 512 + col);
                    const f32x4 a0 = acc[ai][bj][m][0], a1 = acc[ai][bj][m][1]; f32x4 o0, o1;
                    o0[0] = bflo(gw.x) * sigmoidf_(a0[0]); o0[1] = bfhi(gw.x) * sigmoidf_(a0[1]); o0[2] = bflo(gw.y) * sigmoidf_(a0[2]); o0[3] = bfhi(gw.y) * sigmoidf_(a0[3]);
                    o1[0] = bflo(gw.z) * sigmoidf_(a1[0]); o1[1] = bfhi(gw.z) * sigmoidf_(a1[1]); o1[2] = bflo(gw.w) * sigmoidf_(a1[2]); o1[3] = bfhi(gw.w) * sigmoidf_(a1[3]);
                    *(v4u*)(ycat + (size_t)row * 1024 + col) = pack8(o0, o1); } }
    }
};
struct EpiKV {
    static constexpr bool PERM = true, AFTER_DRAIN = false;
    float* out; bf16* memk;
    __device__ __forceinline__ void operator()(EPI_ARGS) const {
        const int row0 = u.pm * 256 + wr * 64 + fr, col0 = u.pn * 256 + wc * 32 + 8 * fq;
#pragma unroll
        for (int ai = 0; ai < 2; ++ai)
#pragma unroll
            for (int m = 0; m < 4; ++m) { const int row = row0 + ai * 128 + m * 16;
#pragma unroll
                for (int bj = 0; bj < 2; ++bj) { const int c = col0 + bj * 128, l = c >> 11, e = c & 2047, isv = e >> 10, dc = e & 1023;
                    float* op = out + (isv ? OFF_MVP : OFF_MKP) + (size_t)l * 1048576 + (size_t)row * 1024 + dc;
                    if (isv) { *(f32x4*)op = acc[ai][bj][m][0]; *(f32x4*)(op + 4) = acc[ai][bj][m][1]; } else { __builtin_nontemporal_store(acc[ai][bj][m][0], (f32x4*)op); __builtin_nontemporal_store(acc[ai][bj][m][1], (f32x4*)(op + 4)); }
                    if (!isv) *(v4u*)(memk + (size_t)l * 12 * 262144 + (size_t)row * 1024 + dc) = pack8(acc[ai][bj][m][0], acc[ai][bj][m][1]); } }
    }
};
struct EpiIn0 {
    static constexpr bool PERM = true, AFTER_DRAIN = false;
    bf16* proj; const float* rowss; const float* ropec; const float* ropes; float* out;
    __device__ __forceinline__ void operator()(EPI_ARGS) const {
        const int pn = u.pn;
#pragma unroll
        for (int ai = 0; ai < 2; ++ai)
#pragma unroll
            for (int m = 0; m < 4; ++m) { const int row = u.pm * 256 + ai * 128 + wr * 64 + m * 16 + fr; const float rs = rstd_of(rowss, row);
                const int pos = row < MP ? (row & 4095) : 2048 + (row & 31);
                bf16* rp = proj + (size_t)row * 1280;
                float* wk = nullptr; float* wv = nullptr;
                if (pn == 4) { if (row >= MP) { wk = out + OFF_WKS + (size_t)(row - MP) * 128; wv = out + OFF_WVS + (size_t)(row - MP) * 128; }
                               else if ((row & 4095) >= 3968) { const size_t o = (size_t)((row >> 12) * 128 + (row & 4095) - 3968) * 128; wk = out + OFF_WKP + o; wv = out + OFF_WVP + o; } }
#pragma unroll
                for (int bj = 0; bj < 2; ++bj) { const f32x4 v0 = acc[ai][bj][m][0] * rs, v1 = acc[ai][bj][m][1] * rs;
                    const bool rope = (pn == 2 || pn == 3 || (pn == 4 && bj == 0));
                    if (!rope) { const int col = pn * 256 + bj * 128 + wc * 32 + 8 * fq; *(v4u*)(rp + col) = pack8(v0, v1);
                        if (pn == 4 && wv) { *(f32x4*)(wv + wc * 32 + 8 * fq) = v0; *(f32x4*)(wv + wc * 32 + 8 * fq + 4) = v1; } }
                    else { const int gbase = pn * 256 + bj * 128 + (wc >> 1) * 64, d1 = 16 * (wc & 1) + 4 * fq;
                        const f32x4 c4 = *(const f32x4*)(ropec + pos * 32 + d1), s4 = *(const f32x4*)(ropes + pos * 32 + d1);
                        f32x4 o1 = v0 * c4 - v1 * s4, o2 = v1 * c4 + v0 * s4;
                        if (pn != 4) { o1 = o1 * 0.125f; o2 = o2 * 0.125f; }
                        u32x2v w1, w2; w1.x = pg8::cvt_pk_bf16(o1[0], o1[1]); w1.y = pg8::cvt_pk_bf16(o1[2], o1[3]); w2.x = pg8::cvt_pk_bf16(o2[0], o2[1]); w2.y = pg8::cvt_pk_bf16(o2[2], o2[3]);
                        *(u32x2v*)(rp + gbase + d1) = w1; *(u32x2v*)(rp + gbase + d1 + 32) = w2;
                        if (pn == 4 && wk) { const int cc = (wc >> 1) * 64 + d1; *(f32x4*)(wk + cc) = o1; *(f32x4*)(wk + cc + 32) = o2; } } } }
    }
};
struct EpiFfnUp {
    static constexpr bool PERM = true, AFTER_DRAIN = false;
    bf16* act; const float* rowss; const float* cw; float* SG; float* SV;
    __device__ __forceinline__ void operator()(EPI_ARGS) const {
        const int c0 = u.pn * 128 + wc * 32 + 8 * fq; const bool sample = u.pm == 64;
        const f32x4 w0a = *(const f32x4*)(cw + c0), w0b = *(const f32x4*)(cw + c0 + 4), w1a = *(const f32x4*)(cw + DFF + c0), w1b = *(const f32x4*)(cw + DFF + c0 + 4),
                    w2a = *(const f32x4*)(cw + 2 * DFF + c0), w2b = *(const f32x4*)(cw + 2 * DFF + c0 + 4);
#pragma unroll
        for (int ai = 0; ai < 2; ++ai) { f32x4 gp0 = {0.f, 0.f, 0.f, 0.f}, gp1 = {0.f, 0.f, 0.f, 0.f}; const int blk = u.pm * 4 + ai * 2 + wr;
#pragma unroll
            for (int m = 0; m < 4; ++m) { const int row = u.pm * 256 + ai * 128 + wr * 64 + m * 16 + fr; const float rs = rstd_of(rowss, row);
                const f32x4 g0 = acc[ai][0][m][0] * rs, g1 = acc[ai][0][m][1] * rs, v0 = acc[ai][1][m][0] * rs, v1 = acc[ai][1][m][1] * rs;
                f32x4 p1a, p2a, p1b, p2b;
#pragma unroll
                for (int j = 0; j < 4; ++j) { const float s1a = fr == 15 ? gp0[j] : g0[j], s2a = fr >= 14 ? gp0[j] : g0[j], s1b = fr == 15 ? gp1[j] : g1[j], s2b = fr >= 14 ? gp1[j] : g1[j];
                    p1a[j] = dpp_ror1(s1a); p2a[j] = dpp_ror2(s2a); p1b[j] = dpp_ror1(s1b); p2b[j] = dpp_ror2(s2b); }
                const f32x4 ca = w0a * p2a + w1a * p1a + w2a * g0, cb = w0b * p2b + w1b * p1b + w2b * g1;
                f32x4 sa, sb;
#pragma unroll
                for (int j = 0; j < 4; ++j) { sa[j] = sigmoidf_(ca[j]); sb[j] = sigmoidf_(cb[j]); }
                const f32x4 a0 = ca * sa * v0, a1 = cb * sb * v1;
                const bool valid = (m > 0 || fr >= 2) && !(sample && m == 2 && fr < 2);
                if (valid) *(v4u*)(act + (size_t)row * DFF + c0) = pack8(a0, a1);
                if ((m & 1) == 0 && fr < 2) { float* sg = SG + (size_t)(blk * 8 + 2 * m + fr) * DFF + c0; *(f32x4*)sg = g0; *(f32x4*)(sg + 4) = g1;
                                              float* sv = SV + (size_t)(blk * 4 + m + fr) * DFF + c0; *(f32x4*)sv = v0; *(f32x4*)(sv + 4) = v1; }
                if ((m & 1) == 1 && fr >= 14) { float* sg = SG + (size_t)(blk * 8 + 2 * m + fr - 14) * DFF + c0; *(f32x4*)sg = g0; *(f32x4*)(sg + 4) = g1; }
                gp0 = g0; gp1 = g1; } }
    }
};
struct EpiInOdd {
    static constexpr bool PERM = true, AFTER_DRAIN = false;
    bf16* gb; bf16* zc; const float* rowss; const float* cw; float* SG;
    __device__ __forceinline__ void operator()(EPI_ARGS) const {
        if (u.pn < 4) {
            const int row0 = u.pm * 256 + wr * 64 + fr, col0 = u.pn * 256 + wc * 32 + 8 * fq;
#pragma unroll
            for (int ai = 0; ai < 2; ++ai)
#pragma unroll
                for (int m = 0; m < 4; ++m) { const int row = row0 + ai * 128 + m * 16; const float rs = rstd_of(rowss, row); bf16* rp = gb + (size_t)row * 1024 + col0;
#pragma unroll
                    for (int bj = 0; bj < 2; ++bj) *(v4u*)(rp + bj * 128) = pack8(acc[ai][bj][m][0] * rs, acc[ai][bj][m][1] * rs); }
            return;
        }
        const int c0 = (u.pn - 4) * 128 + wc * 32 + 8 * fq; const bool sample = u.pm == 64;
        const f32x4 w0a = *(const f32x4*)(cw + c0), w0b = *(const f32x4*)(cw + c0 + 4), w1a = *(const f32x4*)(cw + 1024 + c0), w1b = *(const f32x4*)(cw + 1024 + c0 + 4),
                    w2a = *(const f32x4*)(cw + 2048 + c0), w2b = *(const f32x4*)(cw + 2048 + c0 + 4);
#pragma unroll
        for (int ai = 0; ai < 2; ++ai) { f32x4 gp0 = {0.f, 0.f, 0.f, 0.f}, gp1 = {0.f, 0.f, 0.f, 0.f}; const int blk = u.pm * 4 + ai * 2 + wr;
#pragma unroll
            for (int m = 0; m < 4; ++m) { const int row = u.pm * 256 + ai * 128 + wr * 64 + m * 16 + fr; const float rs = rstd_of(rowss, row); const float rs2 = rs * rs;
                const f32x4 g0 = acc[ai][0][m][0] * acc[ai][1][m][0] * rs2, g1 = acc[ai][0][m][1] * acc[ai][1][m][1] * rs2;
                f32x4 p1a, p2a, p1b, p2b;
#pragma unroll
                for (int j = 0; j < 4; ++j) { const float s1a = fr == 15 ? gp0[j] : g0[j], s2a = fr >= 14 ? gp0[j] : g0[j], s1b = fr == 15 ? gp1[j] : g1[j], s2b = fr >= 14 ? gp1[j] : g1[j];
                    p1a[j] = dpp_ror1(s1a); p2a[j] = dpp_ror2(s2a); p1b[j] = dpp_ror1(s1b); p2b[j] = dpp_ror2(s2b); }
                const f32x4 a0 = w0a * p2a + w1a * p1a + w2a * g0, a1 = w0b * p2b + w1b * p1b + w2b * g1;
                const bool valid = (m > 0 || fr >= 2) && !(sample && m == 2 && fr < 2);
                if (valid) *(v4u*)(zc + (size_t)row * 1024 + c0) = pack8(a0, a1);
                if ((m & 1) == 0 && fr < 2) { float* sg = SG + (size_t)(blk * 8 + 2 * m + fr) * 1024 + c0; *(f32x4*)sg = g0; *(f32x4*)(sg + 4) = g1; }
                if ((m & 1) == 1 && fr >= 14) { float* sg = SG + (size_t)(blk * 8 + 2 * m + fr - 14) * 1024 + c0; *(f32x4*)sg = g0; *(f32x4*)(sg + 4) = g1; }
                gp0 = g0; gp1 = g1; } }
    }
};


struct EpiCz {
    static constexpr bool PERM = true, AFTER_DRAIN = false;
    bf16* gb; const float* rowss; const float* cw; float* SG;
    __device__ __forceinline__ void operator()(EPI_ARGS) const {
        const int c0 = u.pn * 128 + wc * 32 + 8 * fq;
        const f32x4 w0a = *(const f32x4*)(cw + c0), w0b = *(const f32x4*)(cw + c0 + 4), w1a = *(const f32x4*)(cw + 1024 + c0), w1b = *(const f32x4*)(cw + 1024 + c0 + 4),
                    w2a = *(const f32x4*)(cw + 2048 + c0), w2b = *(const f32x4*)(cw + 2048 + c0 + 4);
#pragma unroll
        for (int ai = 0; ai < 2; ++ai) { f32x4 gp0 = {0.f, 0.f, 0.f, 0.f}, gp1 = {0.f, 0.f, 0.f, 0.f}; const int blk = u.pm * 4 + ai * 2 + wr;
#pragma unroll
            for (int m = 0; m < 4; ++m) { const int row = u.pm * 256 + ai * 128 + wr * 64 + m * 16 + fr; const float rs = rstd_of(rowss, row); const float rs2 = rs * rs;
                const f32x4 g0 = acc[ai][0][m][0] * acc[ai][1][m][0] * rs2, g1 = acc[ai][0][m][1] * acc[ai][1][m][1] * rs2;
                f32x4 p1a, p2a, p1b, p2b;
#pragma unroll
                for (int j = 0; j < 4; ++j) { const float s1a = fr == 15 ? gp0[j] : g0[j], s2a = fr >= 14 ? gp0[j] : g0[j], s1b = fr == 15 ? gp1[j] : g1[j], s2b = fr >= 14 ? gp1[j] : g1[j];
                    p1a[j] = dpp_ror1(s1a); p2a[j] = dpp_ror2(s2a); p1b[j] = dpp_ror1(s1b); p2b[j] = dpp_ror2(s2b); }
                const f32x4 a0 = w0a * p2a + w1a * p1a + w2a * g0, a1 = w0b * p2b + w1b * p1b + w2b * g1;
                if (m > 0 || fr >= 2) { bf16* gp = gb + (size_t)row * 1024 + c0; const v4u gw = *(const v4u*)gp;
                    const f32x4 b0 = (f32x4){bflo(gw.x), bfhi(gw.x), bflo(gw.y), bfhi(gw.y)}, b1 = (f32x4){bflo(gw.z), bfhi(gw.z), bflo(gw.w), bfhi(gw.w)};
                    *(v4u*)gp = pack8(a0 * b0, a1 * b1); }
                if ((m & 1) == 0 && fr < 2) { float* sg = SG + (size_t)(blk * 8 + 2 * m + fr) * 1024 + c0; *(f32x4*)sg = g0; *(f32x4*)(sg + 4) = g1; }
                if ((m & 1) == 1 && fr >= 14) { float* sg = SG + (size_t)(blk * 8 + 2 * m + fr - 14) * 1024 + c0; *(f32x4*)sg = g0; *(f32x4*)(sg + 4) = g1; }
                gp0 = g0; gp1 = g1; } }
    }
};

__device__ __forceinline__ int rowmap(int mode, int n) {
    if (mode == 1) { if (n >= 512 && n < 1152) { const int d = n & 63; return (n & ~63) | (32 * ((d >> 4) & 1) + 8 * ((d >> 2) & 3) + 4 * (d >> 5) + (d & 3)); } return n; }
    if (mode == 2) { return n < DFF ? ((n >> 7) * 256 + (n & 127)) : (((n - DFF) >> 7) * 256 + 128 + ((n - DFF) & 127)); }
    if (mode == 3) { if (n < 1024) return n; const int c = (n - 1024) & 1023, z = n >= 2048 ? 1 : 0; return 1024 + (c >> 7) * 256 + z * 128 + (c & 127); }
    return n;
}
__device__ __forceinline__ void tr_item(const float* W, int K, int N, bf16* WT, const float* gain, float scale, int mode, LAS float* scr, int item, int lane) {
    const int nblk = N / 32, kb = item / nblk, nb = item % nblk, k0 = 64 * kb, n0 = 32 * nb;
#pragma unroll
    for (int i = 0; i < 8; ++i) { const int idx = lane + 64 * i, kk = idx >> 3, n4 = (idx & 7) * 4; const float gs = gain ? ((const GAS float*)gain)[k0 + kk] * scale : scale;
        const f32x4 w = __builtin_nontemporal_load((const GAS f32x4*)((const GAS float*)W + (size_t)(k0 + kk) * N + n0 + n4)); LAS float* d = scr + kk * 33 + n4; d[0] = w[0] * gs; d[1] = w[1] * gs; d[2] = w[2] * gs; d[3] = w[3] * gs; }
    LDS_WAIT(); asm volatile("" ::: "memory");
    const int c = lane & 7;
#pragma unroll
    for (int j = 0; j < 4; ++j) { const int n = (lane >> 3) + 8 * j; const LAS float* s = scr + (8 * c) * 33 + n;
        v4u o; o.x = pg8::cvt_pk_bf16(s[0 * 33], s[1 * 33]); o.y = pg8::cvt_pk_bf16(s[2 * 33], s[3 * 33]); o.z = pg8::cvt_pk_bf16(s[4 * 33], s[5 * 33]); o.w = pg8::cvt_pk_bf16(s[6 * 33], s[7 * 33]);
        *(GAS v4u*)((GAS bf16*)WT + (size_t)rowmap(mode, n0 + n) * K + k0 + 8 * c) = o; }
    LDS_WAIT(); asm volatile("" ::: "memory");
}
__device__ __forceinline__ double dexp_(double y) {
    const double k = rint(y * 1.4426950408889634); const double r = (y - k * 0.6931471803691238) - k * 1.9082149292705877e-10;
    double p = 1.0 / 6227020800.0;
    p = p * r + 1.0 / 479001600.0; p = p * r + 1.0 / 39916800.0; p = p * r + 1.0 / 3628800.0; p = p * r + 1.0 / 362880.0; p = p * r + 1.0 / 40320.0; p = p * r + 1.0 / 5040.0;
    p = p * r + 1.0 / 720.0; p = p * r + 1.0 / 120.0; p = p * r + 1.0 / 24.0; p = p * r + 1.0 / 6.0; p = p * r + 0.5; p = p * r + 1.0; p = p * r + 1.0;
    const long long bits = (long long)(1023 + (int)k) << 52; return p * __builtin_bit_cast(double, bits);
}
__device__ __forceinline__ void dsincos_(double x, double& s, double& c) {
    const double k = rint(x * 0.6366197723675814); const double r = (x - k * 1.5707963267948966) - k * 6.123233995736766e-17; const double r2 = r * r;
    const double sp = r * (1.0 + r2 * (-1.0 / 6.0 + r2 * (1.0 / 120.0 + r2 * (-1.0 / 5040.0 + r2 * (1.0 / 362880.0 + r2 * (-1.0 / 39916800.0 + r2 * (1.0 / 6227020800.0)))))));
    const double cp = 1.0 + r2 * (-0.5 + r2 * (1.0 / 24.0 + r2 * (-1.0 / 720.0 + r2 * (1.0 / 40320.0 + r2 * (-1.0 / 3628800.0 + r2 * (1.0 / 479001600.0 + r2 * (-1.0 / 87178291200.0)))))));
    const int q = ((int)k) & 3;
    s = q == 0 ? sp : q == 1 ? cp : q == 2 ? -sp : -cp; c = q == 0 ? cp : q == 1 ? -sp : q == 2 ? -cp : sp;
}

__device__ __forceinline__ const bf16* kvptr(const bf16* proj, const bf16* cb, int sample, int b, int c, int kvh, int kk, int isv) {
    if (!sample) { int pos = (c - 2) * 64 + kk; pos = pos < 0 ? 0 : pos; return proj + (size_t)(b * 4096 + pos) * 1280 + 1024 + isv * 128 + kvh * 64; }
    if (kk < 128) return cb + (size_t)(b * 128 + kk) * 128 + kvh * 64;
    int t = kk - 128; t = t > 31 ? 31 : t; return proj + (size_t)(MP + b * 32 + t) * 1280 + 1024 + isv * 128 + kvh * 64;
}
__device__ __forceinline__ void swa_phase(const bf16* proj, const bf16* ckb, const bf16* cvb, const float* sinks, bf16* ycat, LAS unsigned char* lds, int tid, int wave, int lane, int G) {
    LAS bf16* VT = (LAS bf16*)lds;
    const int fr = lane & 15, quad = lane >> 4;
    for (int it = blockIdx.x; it < 528; it += G) {
        int b, c, kvh, sample;
        if (it < 512) { sample = 0; b = it >> 7; c = (it >> 1) & 63; kvh = it & 1; } else { sample = 1; b = (it - 512) >> 1; c = 0; kvh = it & 1; }
        const int gq = wave >> 1, qhalf = wave & 1, head = kvh * 4 + gq;
        bf16x8 qf[2][2], kf0[4][2];
#pragma unroll
        for (int qb = 0; qb < 2; ++qb) { const int q = qhalf * 32 + qb * 16 + fr; const int row = sample ? MP + b * 32 + (q & 31) : b * 4096 + c * 64 + q;
            const GAS bf16* qp = (const GAS bf16*)proj + (size_t)row * 1280 + 512 + head * 64 + quad * 8; qf[qb][0] = *(const GAS bf16x8*)qp; qf[qb][1] = *(const GAS bf16x8*)(qp + 32); }
#pragma unroll
        for (int i = 0; i < 4; ++i) { const int key = 32 * (i >> 1) + (fr >> 2) * 8 + 4 * (i & 1) + (fr & 3); const GAS bf16* kp = (const GAS bf16*)kvptr(proj, ckb, sample, b, c, kvh, key, 0) + quad * 8;
            kf0[i][0] = *(const GAS bf16x8*)kp; kf0[i][1] = *(const GAS bf16x8*)(kp + 32); }
        __syncthreads();
#pragma unroll
        for (int i = 0; i < 3; ++i) { const int idx = tid + 512 * i, kk = idx % 192, dg = idx / 192; const v4u w = *(const GAS v4u*)((const GAS bf16*)kvptr(proj, cvb, sample, b, c, kvh, kk, 1) + dg * 8);
            LAS bf16* vp = VT + (dg * 8) * 200 + kk;
            vp[0] = (bf16)(w.x & 0xffffu); vp[200] = (bf16)(w.x >> 16); vp[400] = (bf16)(w.y & 0xffffu); vp[600] = (bf16)(w.y >> 16);
            vp[800] = (bf16)(w.z & 0xffffu); vp[1000] = (bf16)(w.z >> 16); vp[1200] = (bf16)(w.w & 0xffffu); vp[1400] = (bf16)(w.w >> 16); }
        __syncthreads();
        if (!(sample && qhalf)) {
            const int plo = sample ? 0 : (c >= 2 ? 0 : (2 - c) * 2), phi = sample ? 5 : 6;
            f32x4 s[12][2];
#pragma unroll
            for (int kg = 0; kg < 3; ++kg) { bf16x8 kf[4][2];
#pragma unroll
                for (int i = 0; i < 4; ++i) { if (kg == 0) { kf[i][0] = kf0[i][0]; kf[i][1] = kf0[i][1]; continue; } const int kb = kg * 4 + i, key = 32 * (kb >> 1) + (fr >> 2) * 8 + 4 * (kb & 1) + (fr & 3); const GAS bf16* kp = (const GAS bf16*)kvptr(proj, ckb, sample, b, c, kvh, key, 0) + quad * 8;
                    kf[i][0] = *(const GAS bf16x8*)kp; kf[i][1] = *(const GAS bf16x8*)(kp + 32); }
                __builtin_amdgcn_sched_barrier(0);
#pragma unroll
                for (int i = 0; i < 4; ++i)
#pragma unroll
                    for (int qb = 0; qb < 2; ++qb) { f32x4 a = {0.f, 0.f, 0.f, 0.f}; a = MFMA16(kf[i][0], qf[qb][0], a); a = MFMA16(kf[i][1], qf[qb][1], a); s[kg * 4 + i][qb] = a; }
                __builtin_amdgcn_sched_barrier(0); }
            const float sink = sinks[head];
            bf16x8 pf[6][2];
#pragma unroll
            for (int qb = 0; qb < 2; ++qb) { float mx = sink;
#pragma unroll
                for (int kb = 0; kb < 12; ++kb) { const bool pv = (kb >> 1) >= plo && (kb >> 1) < phi;
#pragma unroll
                    for (int j = 0; j < 4; ++j) { const float v = pv ? s[kb][qb][j] : -1e30f; s[kb][qb][j] = v; mx = fmaxf(mx, v); } }
                mx = fmaxf(mx, __shfl_xor(mx, 16)); mx = fmaxf(mx, __shfl_xor(mx, 32));
                float sum = 0.f;
#pragma unroll
                for (int kb = 0; kb < 12; ++kb)
#pragma unroll
                    for (int j = 0; j < 4; ++j) { const float e = __expf(s[kb][qb][j] - mx); s[kb][qb][j] = e; sum += e; }
                sum += __shfl_xor(sum, 16); sum += __shfl_xor(sum, 32); sum += __expf(sink - mx);
                const float inv = 1.0f / sum;
#pragma unroll
                for (int pr = 0; pr < 6; ++pr) pf[pr][qb] = __builtin_bit_cast(bf16x8, pack8(s[2 * pr][qb] * inv, s[2 * pr + 1][qb] * inv)); }
#pragma unroll
            for (int db = 0; db < 4; ++db) { bf16x8 vf[6];
#pragma unroll
                for (int pr = 0; pr < 6; ++pr) vf[pr] = *(const LAS bf16x8*)(VT + (db * 16 + fr) * 200 + 32 * pr + quad * 8);
#pragma unroll
                for (int qb = 0; qb < 2; ++qb) { f32x4 o = {0.f, 0.f, 0.f, 0.f};
#pragma unroll
                    for (int pr = 0; pr < 6; ++pr) o = MFMA16(pf[pr][qb], vf[pr], o);
#pragma unroll
                    for (int j = 0; j < 4; ++j) { const int q = qhalf * 32 + qb * 16 + quad * 4 + j;
                        if (!sample || q < 32) { const int row = sample ? MP + b * 32 + q : b * 4096 + c * 64 + q; ycat[(size_t)row * 1024 + 512 + head * 64 + db * 16 + fr] = (bf16)f2bf(o[j]); } } } }
        }
    }
    __syncthreads();
}

__device__ __forceinline__ void xattn_phase(const bf16* qx, const bf16* memk_l, const bf16* memvT_l, bf16* ox, int wave, int lane, int G) {
    const int fr = lane & 15, quad = lane >> 4;
    for (int t = wave * G + (int)blockIdx.x; t < 4160; t += 8 * G) {
        int bb, h, row0;
        if (t < 4096) { const int pair = t >> 8; bb = pair >> 2; h = pair & 3; row0 = bb * 4096 + (t & 255) * 16; }
        else { const int s = t - 4096, b = s >> 3; h = (s >> 1) & 3; bb = 4 + b; row0 = MP + b * 32 + (s & 1) * 16; }
        bf16x8 qf[8];
#pragma unroll
        for (int ks = 0; ks < 8; ++ks) qf[ks] = *(const bf16x8*)(qx + (size_t)(row0 + fr) * 1024 + h * 256 + ks * 32 + quad * 8);
        const bf16* kbase = memk_l + (size_t)bb * 262144 + h * 256 + quad * 8;
        f32x4 s[16];
#pragma unroll
        for (int kb = 0; kb < 16; ++kb) { const int key = 32 * (kb >> 1) + (fr >> 2) * 8 + 4 * (kb & 1) + (fr & 3); const bf16* kp = kbase + (size_t)key * 1024; f32x4 a = {0.f, 0.f, 0.f, 0.f};
#pragma unroll
            for (int ks = 0; ks < 8; ++ks) a = MFMA16(*(const bf16x8*)(kp + ks * 32), qf[ks], a);
            s[kb] = a; }
        float mx = -1e30f;
#pragma unroll
        for (int kb = 0; kb < 16; ++kb)
#pragma unroll
            for (int j = 0; j < 4; ++j) mx = fmaxf(mx, s[kb][j]);
        mx = fmaxf(mx, __shfl_xor(mx, 16)); mx = fmaxf(mx, __shfl_xor(mx, 32));
        float sum = 0.f;
#pragma unroll
        for (int kb = 0; kb < 16; ++kb)
#pragma unroll
            for (int j = 0; j < 4; ++j) { const float e = __expf(s[kb][j] - mx); s[kb][j] = e; sum += e; }
        sum += __shfl_xor(sum, 16); sum += __shfl_xor(sum, 32);
        const float inv = 1.0f / sum;
        bf16x8 pf[8];
#pragma unroll
        for (int pr = 0; pr < 8; ++pr) pf[pr] = __builtin_bit_cast(bf16x8, pack8(s[2 * pr] * inv, s[2 * pr + 1] * inv));
        const bf16* vbase = memvT_l + (size_t)bb * 262144 + (size_t)(h * 256 + fr) * 256 + quad * 8;
#pragma unroll 4
        for (int db = 0; db < 16; ++db) { f32x4 o = {0.f, 0.f, 0.f, 0.f};
#pragma unroll
            for (int pr = 0; pr < 8; ++pr) o = MFMA16(pf[pr], *(const bf16x8*)(vbase + (size_t)db * 4096 + pr * 32), o);
#pragma unroll
            for (int j = 0; j < 4; ++j) ox[(size_t)(row0 + quad * 4 + j) * 1024 + h * 256 + db * 16 + fr] = (bf16)f2bf(o[j]); }
    }
}


__device__ __forceinline__ void xstage(const bf16* src, size_t rowstride, LAS unsigned char* lds, int tid) {
    v4u t[16];
#pragma unroll
    for (int i = 0; i < 16; ++i) { const int row = (tid >> 5) + 16 * i, ch = tid & 31; t[i] = *(const GAS v4u*)((const GAS bf16*)src + (size_t)row * rowstride + ch * 8); }
#pragma unroll
    for (int i = 0; i < 16; ++i) { const int row = (tid >> 5) + 16 * i, ch = tid & 31; *(LAS v4u*)(lds + row * 528 + ch * 16) = t[i]; }
}
__device__ __forceinline__ void xattn_phase2(const bf16* qx, const bf16* memk_l, const bf16* memvT_l, bf16* ox, LAS unsigned char* lds, int tid, int wave, int lane, int G) {
    const int fr = lane & 15, quad = lane >> 4;
    for (int it = blockIdx.x; it < 256 + 32; it += G) {
        int bb, h, rowbase, nqb; bool active;
        if (it < 256) { bb = it >> 6; h = (it >> 4) & 3; rowbase = bb * 4096 + (it & 15) * 256; nqb = 2; active = true; }
        else { const int s = it - 256, b = s >> 2; h = s & 3; bb = 4 + b; rowbase = MP + b * 32; nqb = 1; active = wave < 2; }
        __syncthreads();
        xstage(memk_l + (size_t)bb * 262144 + h * 256, 1024, lds, tid);
        __syncthreads();
        bf16x8 pf[2][8];
#pragma unroll
        for (int qi = 0; qi < 2; ++qi) {
            if (qi < nqb && active) {
                const int row0 = rowbase + qi * 128 + wave * 16;
                bf16x8 qf[8];
#pragma unroll
                for (int ks = 0; ks < 8; ++ks) qf[ks] = __builtin_nontemporal_load((const GAS bf16x8*)((const GAS bf16*)qx + (size_t)(row0 + fr) * 1024 + h * 256 + ks * 32 + quad * 8));
                f32x4 s[16];
#pragma unroll
                for (int kb = 0; kb < 16; ++kb) { const int key = 32 * (kb >> 1) + (fr >> 2) * 8 + 4 * (kb & 1) + (fr & 3); const LAS unsigned char* kp = lds + key * 528 + quad * 16; f32x4 a = {0.f, 0.f, 0.f, 0.f};
#pragma unroll
                    for (int ks = 0; ks < 8; ++ks) a = MFMA16(*(const LAS bf16x8*)(kp + ks * 64), qf[ks], a);
                    s[kb] = a; }
                float mx = -1e30f;
#pragma unroll
                for (int kb = 0; kb < 16; ++kb)
#pragma unroll
                    for (int j = 0; j < 4; ++j) mx = fmaxf(mx, s[kb][j]);
                mx = fmaxf(mx, __shfl_xor(mx, 16)); mx = fmaxf(mx, __shfl_xor(mx, 32));
                float sum = 0.f;
#pragma unroll
                for (int kb = 0; kb < 16; ++kb)
#pragma unroll
                    for (int j = 0; j < 4; ++j) { const float e = __expf(s[kb][j] - mx); s[kb][j] = e; sum += e; }
                sum += __shfl_xor(sum, 16); sum += __shfl_xor(sum, 32);
                const float inv = 1.0f / sum;
#pragma unroll
                for (int pr = 0; pr < 8; ++pr) pf[qi][pr] = __builtin_bit_cast(bf16x8, pack8(s[2 * pr] * inv, s[2 * pr + 1] * inv));
            }
        }
        __syncthreads();
        xstage(memvT_l + (size_t)bb * 262144 + (size_t)h * 65536, 256, lds, tid);
        __syncthreads();
        if (active) {
            const int rowA = rowbase + wave * 16, rowB = rowA + 128;
#pragma unroll 4
            for (int db = 0; db < 16; ++db) { f32x4 oa = {0.f, 0.f, 0.f, 0.f}, ob = {0.f, 0.f, 0.f, 0.f}; const LAS unsigned char* vp = lds + (db * 16 + fr) * 528 + quad * 16;
                if (nqb == 2) {
#pragma unroll
                    for (int pr = 0; pr < 8; ++pr) { const bf16x8 vf = *(const LAS bf16x8*)(vp + pr * 64); oa = MFMA16(vf, pf[0][pr], oa); ob = MFMA16(vf, pf[1][pr], ob); }
                } else {
#pragma unroll
                    for (int pr = 0; pr < 8; ++pr) { const bf16x8 vf = *(const LAS bf16x8*)(vp + pr * 64); oa = MFMA16(vf, pf[0][pr], oa); }
                }
                u32x2v w; w.x = pk2(oa[0], oa[1]); w.y = pk2(oa[2], oa[3]);
                *(GAS u32x2v*)((GAS bf16*)ox + (size_t)(rowA + fr) * 1024 + h * 256 + db * 16 + quad * 4) = w;
                if (nqb == 2) { u32x2v w2; w2.x = pk2(ob[0], ob[1]); w2.y = pk2(ob[2], ob[3]); *(GAS u32x2v*)((GAS bf16*)ox + (size_t)(rowB + fr) * 1024 + h * 256 + db * 16 + quad * 4) = w2; } }
        }
    }
    __syncthreads();
}

__device__ __forceinline__ void s5_stage_u(const bf16* up, LAS float* ubuf, int lane) {
    const v4u w0 = *(const v4u*)up, w1 = *(const v4u*)(up + 8);
    LAS f32x4* d = (LAS f32x4*)(ubuf + lane * 16);
    d[0] = (f32x4){bflo(w0.x), bfhi(w0.x), bflo(w0.y), bfhi(w0.y)}; d[1] = (f32x4){bflo(w0.z), bfhi(w0.z), bflo(w0.w), bfhi(w0.w)};
    d[2] = (f32x4){bflo(w1.x), bfhi(w1.x), bflo(w1.y), bfhi(w1.y)}; d[3] = (f32x4){bflo(w1.z), bfhi(w1.z), bflo(w1.w), bfhi(w1.w)};
}
__device__ __forceinline__ f32x2v lo2_(f32x4 v) { return __builtin_shufflevector(v, v, 0, 1); }
__device__ __forceinline__ f32x2v hi2_(f32x4 v) { return __builtin_shufflevector(v, v, 2, 3); }
#define S5_STEP(sidx) do { const LAS f32x4* up_ = (const LAS f32x4*)(ubuf + (sidx) * 16); const f32x4 u0 = up_[0], u1 = up_[1], u2 = up_[2], u3 = up_[3]; \
    f32x2v ac_ = lo2_(bb[0]) * u0[0]; ac_ = hi2_(bb[0]) * u0[1] + ac_; ac_ = lo2_(bb[1]) * u0[2] + ac_; ac_ = hi2_(bb[1]) * u0[3] + ac_; \
    ac_ = lo2_(bb[2]) * u1[0] + ac_; ac_ = hi2_(bb[2]) * u1[1] + ac_; ac_ = lo2_(bb[3]) * u1[2] + ac_; ac_ = hi2_(bb[3]) * u1[3] + ac_; \
    ac_ = lo2_(bb[4]) * u2[0] + ac_; ac_ = hi2_(bb[4]) * u2[1] + ac_; ac_ = lo2_(bb[5]) * u2[2] + ac_; ac_ = hi2_(bb[5]) * u2[3] + ac_; \
    ac_ = lo2_(bb[6]) * u3[0] + ac_; ac_ = hi2_(bb[6]) * u3[1] + ac_; ac_ = lo2_(bb[7]) * u3[2] + ac_; ac_ = hi2_(bb[7]) * u3[3] + ac_; \
    const float nr_ = ar * hr - ai * hi + ac_.x, ni_ = ar * hi + ai * hr + ac_.y; hr = nr_; hi = ni_; } while (0)

typedef short bf16x4_t __attribute__((ext_vector_type(4)));
#define MFMA16K16(a, b, c) __builtin_amdgcn_mfma_f32_16x16x16bf16_1k(a, b, c, 0, 0, 0)
__device__ __forceinline__ bf16x4_t s5_load_u(const bf16* urow0, int fr, int quad) { return *(const GAS bf16x4_t*)((const GAS bf16*)urow0 + (size_t)fr * 1280 + quad * 4); }
__device__ __forceinline__ void s5_bu_block(const bf16x4_t a, const bf16x4_t (&bcf)[8], LAS float* bul, int fr, int quad) {
#pragma unroll
    for (int cb = 0; cb < 8; ++cb) { f32x4 d = {0.f, 0.f, 0.f, 0.f}; d = MFMA16K16(a, bcf[cb], d);
#pragma unroll
        for (int j = 0; j < 4; ++j) bul[(quad * 4 + j) * 130 + cb * 16 + fr] = d[j]; }
}
__device__ __forceinline__ void s5_local(const bf16* proj, const float* abar, const bf16* bbt, float* sloc, LAS float* bul, int slot, int nslots, int lane) {
    const int fr = lane & 15, quad = lane >> 4;
    for (int t = slot; t < 8192; t += nslots) {
        const int chunk = t & 63, g = (t >> 6) & 31, b = t >> 11;
        const float ar = abar[(g * 64 + lane) * 2], ai = abar[(g * 64 + lane) * 2 + 1];
        bf16x4_t bcf[8];
#pragma unroll
        for (int cb = 0; cb < 8; ++cb) bcf[cb] = *(const GAS bf16x4_t*)((const GAS bf16*)bbt + (size_t)(g * 128 + cb * 16 + fr) * 16 + quad * 4);
        float hr = 0.f, hi = 0.f;
        bf16x4_t ua[4];
#pragma unroll
        for (int blk = 0; blk < 4; ++blk) ua[blk] = s5_load_u(proj + (size_t)(b * 4096 + chunk * 64 + blk * 16) * 1280 + g * 16, fr, quad);
#pragma unroll
        for (int blk = 0; blk < 4; ++blk) {
            s5_bu_block(ua[blk], bcf, bul, fr, quad);
#pragma unroll 4
            for (int s = 0; s < 16; ++s) { const f32x2v bu = *(const LAS f32x2v*)(bul + s * 130 + 2 * lane); const float nr = ar * hr - ai * hi + bu.x, ni = ar * hi + ai * hr + bu.y; hr = nr; hi = ni; }
        }
        *(f32x2v*)(sloc + (size_t)t * 128 + lane * 2) = (f32x2v){hr, hi};
    }
}
__device__ __forceinline__ void s5_out(const bf16* proj, const float* abar, const bf16* bbt, const float* sloc, const float* st_re, const float* st_im, const float* c_re, const float* c_im,
                                       const float* dcoef, bf16* gbuf, float* out, LAS float* bul, LAS unsigned* hbuf, int slot, int nslots, int lane) {
    const int fr = lane & 15, quad = lane >> 4;
    for (int t = slot; t < 8192 + 256; t += nslots) {
        const int sample = t >= 8192; int b, g, chunk, nblk, rowbase;
        if (!sample) { chunk = t & 63; g = (t >> 6) & 31; b = t >> 11; nblk = 4; rowbase = b * 4096 + chunk * 64; } else { const int s = t - 8192; g = s & 31; b = s >> 5; chunk = 0; nblk = 2; rowbase = MP + b * 32; }
        const float ar = abar[(g * 64 + lane) * 2], ai = abar[(g * 64 + lane) * 2 + 1];
        bf16x4_t bcf[8];
#pragma unroll
        for (int cb = 0; cb < 8; ++cb) bcf[cb] = *(const GAS bf16x4_t*)((const GAS bf16*)bbt + (size_t)(g * 128 + cb * 16 + fr) * 16 + quad * 4);
        float hr, hi;
        if (!sample) { float pr = ar, pi = ai;
#pragma unroll
            for (int i = 0; i < 6; ++i) { const float t1 = pr * pr - pi * pi; pi = 2.f * pr * pi; pr = t1; }
            hr = 0.f; hi = 0.f; const float* sp = sloc + (size_t)(t - chunk) * 128 + lane * 2;
#pragma unroll 16
            for (int cc = 0; cc < chunk; ++cc) { const f32x2v sv = *(const f32x2v*)(sp + (size_t)cc * 128); const float nr = pr * hr - pi * hi + sv.x, ni = pr * hi + pi * hr + sv.y; hr = nr; hi = ni; } }
        else { hr = st_re[(b * 32 + g) * 64 + lane]; hi = st_im[(b * 32 + g) * 64 + lane]; }
        bf16x8 cf[4];
#pragma unroll
        for (int ks = 0; ks < 4; ++ks) { const f32x4 cr = *(const f32x4*)(c_re + (size_t)(g * 16 + fr) * 64 + ks * 16 + quad * 4), ci = *(const f32x4*)(c_im + (size_t)(g * 16 + fr) * 64 + ks * 16 + quad * 4);
            v4u w; w.x = pg8::cvt_pk_bf16(cr[0], -ci[0]); w.y = pg8::cvt_pk_bf16(cr[1], -ci[1]); w.z = pg8::cvt_pk_bf16(cr[2], -ci[2]); w.w = pg8::cvt_pk_bf16(cr[3], -ci[3]); cf[ks] = __builtin_bit_cast(bf16x8, w); }
        const float dco = dcoef[g * 16 + fr];
        bf16x4_t ua[4]; bf16 uraw[4][4];
#pragma unroll
        for (int blk = 0; blk < 4; ++blk) { const int bc = blk < nblk ? blk : nblk - 1; const bf16* urow0 = proj + (size_t)(rowbase + bc * 16) * 1280 + g * 16; ua[blk] = s5_load_u(urow0, fr, quad);
#pragma unroll
            for (int j = 0; j < 4; ++j) uraw[blk][j] = ((const GAS bf16*)urow0)[(size_t)(quad * 4 + j) * 1280 + fr]; }
#pragma unroll
        for (int blk = 0; blk < 4; ++blk) { if (blk < nblk) {
            s5_bu_block(ua[blk], bcf, bul, fr, quad);
#pragma unroll 4
            for (int s = 0; s < 16; ++s) { const f32x2v bu = *(const LAS f32x2v*)(bul + s * 130 + 2 * lane); const float nr = ar * hr - ai * hi + bu.x, ni = ar * hi + ai * hr + bu.y; hr = nr; hi = ni; hbuf[s * 68 + lane] = pg8::cvt_pk_bf16(hr, hi); }
            f32x4 y = {0.f, 0.f, 0.f, 0.f};
#pragma unroll
            for (int ks = 0; ks < 4; ++ks) { const bf16x8 a = *(const LAS bf16x8*)(hbuf + fr * 68 + ks * 16 + quad * 4); y = MFMA16(a, cf[ks], y); }
#pragma unroll
            for (int j = 0; j < 4; ++j) { const int s = blk * 16 + quad * 4 + j; const float uu = bflo((unsigned)uraw[blk][j]); const float yv = y[j] + dco * uu;
                const float z = 0.7978845608028654f * (yv + 0.044715f * yv * yv * yv); const float th = 1.0f - 2.0f / (1.0f + __expf(2.0f * z)); const float gl = 0.5f * yv * (1.0f + th);
                ((GAS bf16*)gbuf)[(size_t)(rowbase + s) * 512 + g * 16 + fr] = (bf16)f2bf(gl); }
        } }
        if (!sample && chunk == 63) { out[OFF_SRP + (b * 32 + g) * 64 + lane] = hr; out[OFF_SIP + (b * 32 + g) * 64 + lane] = hi; }
        if (sample) { out[OFF_SRS + (b * 32 + g) * 64 + lane] = hr; out[OFF_SIS + (b * 32 + g) * 64 + lane] = hi; }
    }
}

template <int KIND>
__device__ __forceinline__ void sample_gemm(const bf16* A, const bf16* Bt, int K, LAS unsigned char* lds, int tid, int wave, int lane,
                                            bf16* xbp, const float* base_f32, float* part_next, const float* part_cur, bf16* O) {
    const int fr = lane & 15, quad = lane >> 4;
    LAS f32x4* red = (LAS f32x4*)lds;
    LAS float* ssred = (LAS float*)(lds + 32768);
    for (int tile = blockIdx.x; tile < 256; tile += gridDim.x) {
        const int r0 = MP + (tile >> 4) * 16, c0 = (tile & 15) * 64, kw = K >> 3;
        const bf16* ap = A + (size_t)(r0 + fr) * K + wave * kw + quad * 8;
        const bf16* bp = Bt + (size_t)(c0 + fr) * K + wave * kw + quad * 8;
        f32x4 acc[4];
#pragma unroll
        for (int cb = 0; cb < 4; ++cb) acc[cb] = (f32x4){0.f, 0.f, 0.f, 0.f};
        const int e_cb = (tid >> 6) & 3, e_l2 = tid & 63, e_row = r0 + (e_l2 & 15), e_col = c0 + e_cb * 16 + 4 * (e_l2 >> 4); const size_t e_off = (size_t)e_row * 1024 + e_col;
        f32x4 e_bs = {0.f, 0.f, 0.f, 0.f}; float e_rs = 1.f;
        if (tid < 256) { if (KIND == 0) { if (base_f32) e_bs = *(const f32x4*)(base_f32 + e_off); else { const u32x2v w = *(const u32x2v*)(xbp + e_off); e_bs = (f32x4){bflo(w.x), bfhi(w.x), bflo(w.y), bfhi(w.y)}; } }
                         else e_rs = rstd_of(part_cur, e_row); }
        const int nks = kw >> 5;
        for (int k0 = 0; k0 < nks; k0 += 4) {
            bf16x8 a[4], b[4][4];
#pragma unroll
            for (int i = 0; i < 4; ++i) { const int ks = (k0 + i < nks) ? k0 + i : nks - 1;
                a[i] = *(const bf16x8*)(ap + ks * 32);
#pragma unroll
                for (int cb = 0; cb < 4; ++cb) b[i][cb] = *(const bf16x8*)(bp + (size_t)cb * 16 * K + ks * 32); }
            __builtin_amdgcn_sched_barrier(0);
#pragma unroll
            for (int i = 0; i < 4; ++i) if (k0 + i < nks) {
#pragma unroll
                for (int cb = 0; cb < 4; ++cb) acc[cb] = MFMA16(b[i][cb], a[i], acc[cb]); }
        }
#pragma unroll
        for (int cb = 0; cb < 4; ++cb) red[(wave * 4 + cb) * 64 + lane] = acc[cb] * 1.0f;
        __syncthreads();
        if (tid < 256) { const int cb = tid >> 6, l2 = tid & 63; f32x4 v = red[cb * 64 + l2];
#pragma unroll
            for (int w = 1; w < 8; ++w) v = v + red[(w * 4 + cb) * 64 + l2];
            const int row = r0 + (l2 & 15), col = c0 + cb * 16 + 4 * (l2 >> 4); const size_t off = (size_t)row * 1024 + col;
            if (KIND == 0) {
                v = v + e_bs; u32x2v o; o.x = pk2(v[0], v[1]); o.y = pk2(v[2], v[3]); *(u32x2v*)(xbp + off) = o;
                float ss = (v[0] * v[0] + v[1] * v[1]) + (v[2] * v[2] + v[3] * v[3]); ss += __shfl_xor(ss, 16); ss += __shfl_xor(ss, 32);
                if ((l2 >> 4) == 0) ssred[cb * 16 + (l2 & 15)] = ss; }
            else { const float rs = e_rs; u32x2v o; o.x = pk2(v[0] * rs, v[1] * rs); o.y = pk2(v[2] * rs, v[3] * rs); *(u32x2v*)(O + off) = o; }
        }
        if (KIND == 0) { __syncthreads(); if (tid < 16) part_next[(size_t)(r0 + tid) * 16 + (tile & 15)] = (ssred[tid] + ssred[16 + tid]) + (ssred[32 + tid] + ssred[48 + tid]); }
        __syncthreads();
    }
}


__device__ __forceinline__ void sample_cz(const bf16* A, const bf16* Bt, LAS unsigned char* lds, int tid, int wave, int lane,
                                          const float* part_cur, const float* cw, const float* st, bf16* zcp, float* outp) {
    const int fr = lane & 15, quad = lane >> 4;
    LAS f32x4* red = (LAS f32x4*)lds;
    LAS float* T = (LAS float*)(lds + 65536);
    LAS float* CZ = (LAS float*)(lds + 65536 + 8192);
    for (int tile = blockIdx.x; tile < 256; tile += gridDim.x) {
        const int b = tile >> 5, c0 = (tile & 31) * 32, r0 = MP + b * 32;
        const int wrow = 1024 + (c0 >> 7) * 256 + (c0 & 127);
        const GAS bf16* ap = (const GAS bf16*)A + (size_t)(r0 + fr) * 1024 + wave * 128 + quad * 8;
        const GAS bf16* bp = (const GAS bf16*)Bt + (size_t)(wrow + fr) * 1024 + wave * 128 + quad * 8;
        bf16x8 a[4][2], bw[4][4];
#pragma unroll
        for (int ks = 0; ks < 4; ++ks) {
#pragma unroll
            for (int rb = 0; rb < 2; ++rb) a[ks][rb] = *(const GAS bf16x8*)(ap + (size_t)rb * 16 * 1024 + ks * 32);
#pragma unroll
            for (int cb = 0; cb < 4; ++cb) bw[ks][cb] = *(const GAS bf16x8*)(bp + (size_t)((cb >> 1) * 128 + (cb & 1) * 16) * 1024 + ks * 32); }
        f32x4 acc[2][4];
#pragma unroll
        for (int rb = 0; rb < 2; ++rb)
#pragma unroll
            for (int cb = 0; cb < 4; ++cb) { f32x4 d = {0.f, 0.f, 0.f, 0.f};
#pragma unroll
                for (int ks = 0; ks < 4; ++ks) d = MFMA16(bw[ks][cb], a[ks][rb], d);
                acc[rb][cb] = d; }
#pragma unroll
        for (int rb = 0; rb < 2; ++rb)
#pragma unroll
            for (int cb = 0; cb < 4; ++cb) red[(wave * 8 + rb * 4 + cb) * 64 + lane] = acc[rb][cb];
        __syncthreads();
        {
            const int blk = tid >> 6, l2 = tid & 63, rb = blk >> 2, cb = blk & 3; f32x4 v = red[blk * 64 + l2];
#pragma unroll
            for (int w = 1; w < 8; ++w) v = v + red[(w * 8 + blk) * 64 + l2];
            *(LAS f32x4*)(T + ((cb >> 1) * 32 + rb * 16 + (l2 & 15)) * 32 + (cb & 1) * 16 + 4 * (l2 >> 4)) = v; }
        __syncthreads();
        const int r = tid >> 3, cq = (tid & 7) * 4;
        if (tid < 256) { const float rs = rstd_of(part_cur, r0 + r); const float rs2 = rs * rs;
            const f32x4 gc = *(const LAS f32x4*)(T + r * 32 + cq), zz = *(const LAS f32x4*)(T + (32 + r) * 32 + cq);
            *(LAS f32x4*)(CZ + r * 32 + cq) = gc * zz * rs2; }
        __syncthreads();
        if (tid < 256) { const int c = c0 + cq;
            const f32x4 x0 = *(const LAS f32x4*)(CZ + r * 32 + cq);
            const f32x4 s0 = *(const f32x4*)(st + (size_t)(b * 2) * 1024 + c), s1 = *(const f32x4*)(st + (size_t)(b * 2 + 1) * 1024 + c);
            f32x4 xm1 = s1, xm2 = s0;
            if (r >= 1) { xm1 = *(const LAS f32x4*)(CZ + (r - 1) * 32 + cq); xm2 = s1; }
            if (r >= 2) xm2 = *(const LAS f32x4*)(CZ + (r - 2) * 32 + cq);
            const f32x4 w0 = *(const f32x4*)(cw + c), w1 = *(const f32x4*)(cw + 1024 + c), w2 = *(const f32x4*)(cw + 2048 + c);
            const f32x4 z = w0 * xm2 + w1 * xm1 + w2 * x0;
            bf16* gp = zcp + (size_t)(r0 + r) * 1024 + c; const u32x2v gw = *(const u32x2v*)gp;
            u32x2v o; o.x = pk2(z[0] * bflo(gw.x), z[1] * bfhi(gw.x)); o.y = pk2(z[2] * bflo(gw.y), z[3] * bfhi(gw.y)); *(u32x2v*)gp = o;
            if (r >= 30) *(f32x4*)(outp + OFF_CMS + (size_t)(b * 2 + (r - 30)) * 1024 + c) = x0; }
        __syncthreads();
    }
}

struct Params { const float* in[36]; float* out; unsigned char* ws; int use_cg, pad; };

__global__ void __launch_bounds__(512, 2) mega_fwd(Params P) {
    extern __shared__ __attribute__((aligned(16))) unsigned char lds_raw[];
    LAS unsigned char* lds = (LAS unsigned char*)lds_raw;
    volatile LAS unsigned* MISC = (volatile LAS unsigned*)(lds + MISC_OFF);
    const int G = gridDim.x, NGW = G * 8, NT = G * 512;
    const int wave_s = __builtin_amdgcn_readfirstlane(threadIdx.x >> 6);
    for (int u = threadIdx.x; u < (LDS_BYTES - 131072) / 4; u += 512) ((LAS unsigned*)(lds + 131072))[u] = 0u;
    __syncthreads();
    XcdBarrier bar = xcd_barrier_post((unsigned*)(P.ws + WS_BAR), MISC + 8);
#ifndef STOP_AFTER
#define STOP_AFTER 1000
#endif
    int ph = 0;
#define RUN (ph < STOP_AFTER)
#define FRESH() const int tid = fresh_tid(wave_s), lane = tid & 63, wave = __builtin_amdgcn_readfirstlane(tid >> 6); const int gw = blockIdx.x * 8 + wave, gt = blockIdx.x * 512 + tid; (void)gw; (void)gt; (void)lane; LAS float* wscr = (LAS float*)(lds + 32768 + wave * 12288); (void)wscr;
#define SEAM() do { if (P.use_cg) cg::this_grid().sync(); else xcd_barrier(bar); ++ph; } while (0)

#define part ((float*)(ws + WS_PART))
#define PARTBUF(k) (part + (size_t)((k) & 1) * PART_ELEMS)
#define ropec ((float*)(ws + WS_ROPE))
#define ropes (ropec + 4096 * 32)
#define abar ((float*)(ws + WS_SSM))
#define bbar (abar + 32 * 64 * 2)
#define bbt ((bf16*)(bbar + 32 * 64 * 32))
#define ckb ((bf16*)(ws + WS_CKV))
#define cvb (ckb + 8 * 128 * 128)
#define sloc ((float*)(ws + WS_SLOC))
#define memk ((bf16*)(ws + WS_MEMK))
#define memvT ((bf16*)(ws + WS_MEMVT))
#define SG ((float*)(ws + WS_SIDE))
#define SV ((float*)(ws + WS_SIDE + SG_BYTES))
#define WT ((bf16*)(ws + WS_WT))
#define xb ((bf16*)(ws + WS_XB))
#define tmp (ws + WS_TMP)
#define proj0 ((bf16*)(tmp + TMP_PROJ0))
#define gbuf ((bf16*)(tmp + TMP_GBUF))
#define ycat ((bf16*)(tmp + TMP_YCAT))
#define memb ((bf16*)(tmp + TMP_MEMB))
#define qx ((bf16*)(tmp + TMP_QX))
#define ox ((bf16*)(tmp + TMP_OX))
#define act ((bf16*)(tmp + TMP_ACT))
#define gbm ((bf16*)(tmp + TMP_GB))
#define zc ((bf16*)(tmp + TMP_ZC))
#define PTRS() GAS unsigned char* wsg_ = (GAS unsigned char*)P.ws; GAS float* outg_ = (GAS float*)P.out; asm volatile("" : "+s"(wsg_), "+s"(outg_)); unsigned char* ws = (unsigned char*)wsg_; float* out = (float*)outg_;
    if (RUN) { PTRS() FRESH()
        {
            constexpr int NITEMS = 640 + 128 + 512 + 512 + 2 * 1024 + 512 + 2816 + 1408 + 2048;
            for (int it = gw; it < NITEMS; it += NGW) { int r = it;
#define TR(Wp, K_, N_, WTp, gainp, sc, mode) { const int ni_ = ((K_) / 64) * ((N_) / 32); if (r < ni_) { tr_item(Wp, K_, N_, WTp, gainp, sc, mode, wscr, r, lane); continue; } r -= ni_; }
                TR(P.in[15], 1024, 1280, WT + WT_INEVEN, P.in[11], 1.f, 1)
                TR(P.in[25], 512, 512, WT + WT_GLU, nullptr, 1.f, 0)
                TR(P.in[16], 1024, 1024, WT + WT_OUTEVEN, nullptr, 1.f, 0)
                TR(P.in[30], 1024, 1024, WT + WT_WQ, P.in[12], 0.0625f, 0)
                TR(P.in[31], 1024, 2048, WT + WT_WKV, nullptr, 1.f, 0)
                TR(P.in[31] + 2097152, 1024, 2048, WT + WT_WKV + 2097152, nullptr, 1.f, 0)
                TR(P.in[32], 1024, 1024, WT + WT_WO, nullptr, 1.f, 0)
                TR(P.in[33], 1024, 5632, WT + WT_UP, P.in[13], 1.f, 2)
                TR(P.in[35], 2816, 1024, WT + WT_DOWN, nullptr, 1.f, 0)
                { const int mi = r >> 7, l = mi >> 3, b = mi & 7; tr_item(P.in[10] + (size_t)mi * 262144, 256, 1024, memvT + (size_t)(l * 12 + 4 + b) * 262144, nullptr, 1.f, 0, wscr, r & 127, lane); }
            }
        }
        for (int m = gw; m < MROWS; m += NGW) { const float* xr = m < MP ? P.in[0] + (size_t)m * 1024 : P.in[1] + (size_t)(m - MP) * 1024; float ss = 0.f;
#pragma unroll
            for (int j = 0; j < 4; ++j) { const f32x4 v = __builtin_nontemporal_load((const f32x4*)(xr + (lane + 64 * j) * 4)); ss += (v[0] * v[0] + v[1] * v[1]) + (v[2] * v[2] + v[3] * v[3]);
                u32x2v w; w.x = pg8::cvt_pk_bf16(v[0], v[1]); w.y = pg8::cvt_pk_bf16(v[2], v[3]); *(u32x2v*)(xb + (size_t)m * 1024 + (lane + 64 * j) * 4) = w; }
            ss = wave_sum(ss); if (lane < 16) PARTBUF(0)[(size_t)m * 16 + lane] = lane == 0 ? ss : 0.f; }
        for (int i = gt; i < 262144; i += NT) { const f32x4 v = __builtin_nontemporal_load((const f32x4*)(P.in[2] + (size_t)i * 4)); u32x2v w; w.x = pg8::cvt_pk_bf16(v[0], v[1]); w.y = pg8::cvt_pk_bf16(v[2], v[3]); *(u32x2v*)(memb + (size_t)i * 4) = w; }
        for (int i = gt; i < 1048576; i += NT) { const size_t e = (size_t)i * 4; const int lb = (int)(e >> 18), l = lb >> 3, b = lb & 7; const f32x4 v = __builtin_nontemporal_load((const f32x4*)(P.in[9] + e));
            u32x2v w; w.x = pg8::cvt_pk_bf16(v[0], v[1]); w.y = pg8::cvt_pk_bf16(v[2], v[3]); *(u32x2v*)(memk + (size_t)(l * 12 + 4 + b) * 262144 + (e & 262143)) = w; }
        for (int i = gt; i < 65536; i += NT) { const int j = i & 32767; const float* src = (i < 32768 ? P.in[3] : P.in[4]) + (size_t)j * 4; bf16* dst = (i < 32768 ? ckb : cvb) + (size_t)j * 4;
            const f32x4 v = *(const f32x4*)src; u32x2v w; w.x = pg8::cvt_pk_bf16(v[0], v[1]); w.y = pg8::cvt_pk_bf16(v[2], v[3]); *(u32x2v*)dst = w; }
        for (int i = gt; i < 4096 * 32; i += NT) { const int pos = i >> 5, d = i & 31; const double inv = dexp_(-(double)d * (9.210340371976184 / 32.0)); double s, c; dsincos_((double)pos * inv, s, c); ropec[i] = (float)c; ropes[i] = (float)s; }
        for (int i = gt; i < 2048; i += NT) { const double are = P.in[17][i], aim = P.in[18][i], dt = dexp_((double)P.in[19][i]); double s, c; dsincos_(aim * dt, s, c); const double mag = dexp_(are * dt);
            const double br = mag * c, bi = mag * s; abar[2 * i] = (float)br; abar[2 * i + 1] = (float)bi;
            const double nr = br - 1.0, ni = bi, den = are * are + aim * aim; const double qr = (nr * are + ni * aim) / den, qi = (ni * are - nr * aim) / den;
#pragma unroll 4
            for (int h = 0; h < 16; ++h) { const double xr = P.in[20][(size_t)i * 16 + h], xi = P.in[21][(size_t)i * 16 + h]; const float fre = (float)(qr * xr - qi * xi), fim = (float)(qr * xi + qi * xr); bbar[(size_t)i * 32 + 2 * h] = fre; bbar[(size_t)i * 32 + 2 * h + 1] = fim;
                bbt[((size_t)i * 2) * 16 + h] = (bf16)f2bf(fre); bbt[((size_t)i * 2 + 1) * 16 + h] = (bf16)f2bf(fim); } }
    }
    SEAM();
    if (RUN) { PTRS()
        if (G < 128 || (int)blockIdx.x >= G - 64) { pg8::Gemm g{memb, WT + WT_WKV, 1024, 4096, 1024}; pg8::StaticOrder S;
            if (G < 128) S.init(1024, 4096, G, (int)blockIdx.x); else S.init(1024, 4096, 64, (int)blockIdx.x - (G - 64)); EpiKV E{out, memk};
          pg8::gemm_phase<EpiKV, pg8::StaticOrder, true, true>(lds, g, S, E, wave_s); }
        { pg8::Gemm g{xb, WT + WT_INEVEN, MROWS, 1280, 1024}; pg8::StaticOrderF S; S.init(MROWS, 1280, G, (int)blockIdx.x); EpiIn0 E{proj0, PARTBUF(0), ropec, ropes, out};
          pg8::gemm_phase<EpiIn0, pg8::StaticOrderF, true, true>(lds, g, S, E, wave_s); }
        {
            FRESH()
            const int bx = (int)blockIdx.x, n2 = 325 - G;
            int slot = -1, nw = 1;
            if (G == 256) { if (bx >= n2 && bx < G - 64) { slot = (bx - n2) * 8 + wave; nw = (G - 64 - n2) * 8; } } else { slot = gw; nw = NGW; }
            if (slot >= 0) for (int it = slot; it < 2816 + 1408; it += nw) { int r = it;
                TR(P.in[33] + (size_t)1024 * 5632, 1024, 5632, WT + WT_UP + (size_t)5632 * 1024, P.in[13] + 1024, 1.f, 2)
                tr_item(P.in[35] + (size_t)2816 * 1024, 2816, 1024, WT + WT_DOWN + (size_t)2816 * 1024, nullptr, 1.f, 0, wscr, r, lane); }
        }
    }
    SEAM();
    if (RUN) { PTRS() FRESH()
        swa_phase(proj0, ckb, cvb, P.in[26], ycat, lds, tid, wave, lane, G);
        s5_local(proj0, abar, bbt, sloc, wscr, wave * G + (int)blockIdx.x, NGW, lane);
        for (int it = wave * G + (int)blockIdx.x; it < 1024; it += NGW) { const int mi = it >> 7, l = mi >> 2, b = mi & 3;
            tr_item(out + OFF_MVP + (size_t)mi * 262144, 256, 1024, memvT + (size_t)(l * 12 + b) * 262144, nullptr, 1.f, 0, wscr, it & 127, lane); }
    }
    SEAM();
    if (RUN) { PTRS() FRESH() s5_out(proj0, abar, bbt, sloc, P.in[5], P.in[6], P.in[22], P.in[23], P.in[24], gbuf, out, (LAS float*)(lds + wave * 16384), (LAS unsigned*)(lds + wave * 16384 + 8448), wave * G + (int)blockIdx.x, NGW, lane); }
    SEAM();
    if (RUN) { PTRS() pg8::Gemm g{gbuf, WT + WT_GLU, MROWS, 512, 512}; pg8::StaticOrder S; S.init(MROWS, 512, G, (int)blockIdx.x); EpiGlu E{gbuf, ycat};
        pg8::gemm_phase<EpiGlu, pg8::StaticOrder, true, true>(lds, g, S, E, wave_s);
        {
            FRESH()
            const int bx = (int)blockIdx.x; int slot = -1, nw = 1;
            if (G > 130) { if (bx >= 130) { slot = (bx - 130) * 8 + wave; nw = (G - 130) * 8; } } else { slot = gw; nw = NGW; }
            if (slot >= 0) for (int it = slot; it < 1536 + 512; it += nw) { int r = it;
                TR(P.in[27], 1024, 3072, WT + WT_INODD, P.in[11] + 1024, 1.f, 3)
                tr_item(P.in[29], 1024, 1024, WT + WT_OUTODD, nullptr, 1.f, 0, wscr, r, lane); }
        } }
    SEAM();

#pragma unroll
    for (int l = 0; l < 2; ++l) {
        if (l == 1) {
            if (RUN) { PTRS() pg8::Gemm g{xb, WT + WT_INODD, MP, 1024, 1024}; pg8::StaticOrderF S; S.init(MP, 1024, G, (int)blockIdx.x); EpiBf16 E{gbm, 1024, PARTBUF(3)};
                pg8::gemm_phase<EpiBf16, pg8::StaticOrderF, true, true>(lds, g, S, E, wave_s);
                { FRESH() sample_gemm<1>(xb, WT + WT_INODD, 1024, lds, tid, wave, lane, nullptr, nullptr, nullptr, PARTBUF(3), gbm); } }
            SEAM();
            if (RUN) { PTRS() pg8::Gemm g{xb, WT + WT_INODD + (size_t)1024 * 1024, MP, 2048, 1024}; pg8::StaticOrderF S; S.init(MP, 2048, G, (int)blockIdx.x); EpiCz E{gbm, PARTBUF(3), P.in[28], SG};
                pg8::gemm_phase<EpiCz, pg8::StaticOrderF, true, true>(lds, g, S, E, wave_s);
                { FRESH() sample_cz(xb, WT + WT_INODD, lds, tid, wave, lane, PARTBUF(3), P.in[28], P.in[7], gbm, out); } }
            SEAM();
            if (RUN) { PTRS() FRESH()
                const float* cw = P.in[28];
                for (int i = gt; i < 512 * 128; i += NT) { const int ri = i >> 7, c0 = (i & 127) * 8, blk = ri >> 1, rr = ri & 1, row = blk * 64 + rr;
                    f32x4 pa0, pa1, pb0, pb1;
                    if ((blk & 63) == 0) { pa0 = pa1 = pb0 = pb1 = (f32x4){0.f, 0.f, 0.f, 0.f}; }
                    else { const float* s0 = SG + (size_t)((blk - 1) * 8 + 6) * 1024 + c0; pa0 = *(const f32x4*)s0; pa1 = *(const f32x4*)(s0 + 4); pb0 = *(const f32x4*)(s0 + 1024); pb1 = *(const f32x4*)(s0 + 1028); }
                    const float* sc = SG + (size_t)(blk * 8) * 1024 + c0; const f32x4 x00 = *(const f32x4*)sc, x01 = *(const f32x4*)(sc + 4);
                    f32x4 xm2a, xm2b, xm1a, xm1b, xca, xcb;
                    if (rr == 0) { xm2a = pa0; xm2b = pa1; xm1a = pb0; xm1b = pb1; xca = x00; xcb = x01; }
                    else { xm2a = pb0; xm2b = pb1; xm1a = x00; xm1b = x01; xca = *(const f32x4*)(sc + 1024); xcb = *(const f32x4*)(sc + 1028); }
                    const f32x4 w0a = *(const f32x4*)(cw + c0), w0b = *(const f32x4*)(cw + c0 + 4), w1a = *(const f32x4*)(cw + 1024 + c0), w1b = *(const f32x4*)(cw + 1028 + c0), w2a = *(const f32x4*)(cw + 2048 + c0), w2b = *(const f32x4*)(cw + 2052 + c0);
                    const f32x4 z0 = w0a * xm2a + w1a * xm1a + w2a * xca, z1 = w0b * xm2b + w1b * xm1b + w2b * xcb;
                    const v4u gw_ = *(const v4u*)(gbm + (size_t)row * 1024 + c0);
                    const f32x4 g0 = (f32x4){bflo(gw_.x), bfhi(gw_.x), bflo(gw_.y), bfhi(gw_.y)}, g1 = (f32x4){bflo(gw_.z), bfhi(gw_.z), bflo(gw_.w), bfhi(gw_.w)};
                    *(v4u*)(gbm + (size_t)row * 1024 + c0) = pack8(g0 * z0, g1 * z1); }
                for (int i = gt; i < 4 * 2 * 1024; i += NT) { const int c = i & 1023, j = (i >> 10) & 1, b = i >> 11; out[OFF_CMP + i] = SG[(size_t)((64 * b + 63) * 8 + 6 + j) * 1024 + c]; }
            }
            SEAM();
        }
        if (RUN) { PTRS() pg8::Gemm g{(bf16*)(tmp + (size_t)(1 - l) * TMP_YCAT), WT + WT_OUTEVEN + (size_t)l * (WT_OUTODD - WT_OUTEVEN), MP, 1024, 1024}; pg8::StaticOrderF S; S.init(MP, 1024, G, (int)blockIdx.x);
            EpiRes E{P.in[0], P.in[1] - (size_t)MP * 1024, xb, PARTBUF(1 + 3 * l), l == 0 ? 1 : 0};
            pg8::gemm_phase<EpiRes, pg8::StaticOrderF, true, true>(lds, g, S, E, wave_s);
            { FRESH() sample_gemm<0>((bf16*)(tmp + (size_t)(1 - l) * TMP_YCAT), WT + WT_OUTEVEN + (size_t)l * (WT_OUTODD - WT_OUTEVEN), 1024, lds, tid, wave, lane, xb, l == 0 ? P.in[1] - (size_t)MP * 1024 : (const float*)nullptr, PARTBUF(1 + 3 * l), nullptr, nullptr); } }
        SEAM();
        if (RUN) { PTRS() pg8::Gemm g{xb, WT + WT_WQ + (size_t)l * 1048576, MP, 1024, 1024}; pg8::StaticOrderF S; S.init(MP, 1024, G, (int)blockIdx.x); EpiBf16 E{qx, 1024, PARTBUF(1 + 3 * l)};
            pg8::gemm_phase<EpiBf16, pg8::StaticOrderF, true, true>(lds, g, S, E, wave_s);
            { FRESH() sample_gemm<1>(xb, WT + WT_WQ + (size_t)l * 1048576, 1024, lds, tid, wave, lane, nullptr, nullptr, nullptr, PARTBUF(1 + 3 * l), qx); } }
        SEAM();
        if (RUN) { PTRS() FRESH() xattn_phase2(qx, memk + (size_t)l * 12 * 262144, memvT + (size_t)l * 12 * 262144, ox, lds, tid, wave, lane, G); }
        SEAM();
        if (RUN) { PTRS() pg8::Gemm g{ox, WT + WT_WO + (size_t)l * 1048576, MP, 1024, 1024}; pg8::StaticOrderF S; S.init(MP, 1024, G, (int)blockIdx.x); EpiRes E{P.in[0], P.in[0], xb, PARTBUF(2 + 3 * l), 0};
            pg8::gemm_phase<EpiRes, pg8::StaticOrderF, true, true>(lds, g, S, E, wave_s);
            { FRESH() sample_gemm<0>(ox, WT + WT_WO + (size_t)l * 1048576, 1024, lds, tid, wave, lane, xb, nullptr, PARTBUF(2 + 3 * l), nullptr, nullptr); } }
        SEAM();
        if (RUN) { PTRS() pg8::Gemm g{xb, WT + WT_UP + (size_t)l * 5632 * 1024, MROWS, 5632, 1024}; pg8::StaticOrderF S; S.init(MROWS, 5632, G, (int)blockIdx.x);
            EpiFfnUp E{act, PARTBUF(2 + 3 * l), P.in[34] + (size_t)l * 3 * DFF, SG, SV};
            pg8::gemm_phase<EpiFfnUp, pg8::StaticOrderF, true, true>(lds, g, S, E, wave_s);
            if (l == 0) {
                FRESH()
                const int bx = (int)blockIdx.x, nb = 1430 % G; int slot = -1, nw = 1;
                if (nb > 0 && nb < G) { if (bx >= nb) { slot = (bx - nb) * 8 + wave; nw = (G - nb) * 8; } } else { slot = gw; nw = NGW; }
                if (slot >= 0) for (int it = slot; it < 512 + 512; it += nw) { int r = it;
                    TR(P.in[30] + 1048576, 1024, 1024, WT + WT_WQ + 1048576, P.in[12] + 1024, 0.0625f, 0)
                    tr_item(P.in[32] + 1048576, 1024, 1024, WT + WT_WO + 1048576, nullptr, 1.f, 0, wscr, r, lane); }
            } }
        SEAM();
        if (RUN) { PTRS() FRESH()
            const float* cw = P.in[34] + (size_t)l * 3 * DFF; const float* st = P.in[8] + (size_t)l * 8 * 2 * DFF;
            for (int i = gt; i < 528 * 352; i += NT) { const int fi = i / 352, c0 = (i % 352) * 8; int blk, row, rr, sb, vb; bool smp = fi >= 512;
                if (!smp) { blk = fi >> 1; rr = fi & 1; row = blk * 64 + rr; sb = 0; vb = 0; } else { const int s = fi - 512, half = (s >> 1) & 1; blk = 256 + (s >> 2); rr = s & 1; row = blk * 64 + half * 32 + rr; sb = half * 4; vb = half * 2; }
                f32x4 pa0, pa1, pb0, pb1;
                if (smp) { const int b = (blk - 256) * 2 + (sb >> 2); const float* s0 = st + (size_t)(b * 2) * DFF + c0; pa0 = *(const f32x4*)s0; pa1 = *(const f32x4*)(s0 + 4); pb0 = *(const f32x4*)(s0 + DFF); pb1 = *(const f32x4*)(s0 + DFF + 4); }
                else if ((blk & 63) == 0) { pa0 = pa1 = pb0 = pb1 = (f32x4){0.f, 0.f, 0.f, 0.f}; }
                else { const float* s0 = SG + (size_t)((blk - 1) * 8 + 6) * DFF + c0; pa0 = *(const f32x4*)s0; pa1 = *(const f32x4*)(s0 + 4); pb0 = *(const f32x4*)(s0 + DFF); pb1 = *(const f32x4*)(s0 + DFF + 4); }
                const float* sc = SG + (size_t)(blk * 8 + sb) * DFF + c0; const f32x4 x00 = *(const f32x4*)sc, x01 = *(const f32x4*)(sc + 4);
                f32x4 xm2a, xm2b, xm1a, xm1b, xca, xcb;
                if (rr == 0) { xm2a = pa0; xm2b = pa1; xm1a = pb0; xm1b = pb1; xca = x00; xcb = x01; }
                else { xm2a = pb0; xm2b = pb1; xm1a = x00; xm1b = x01; xca = *(const f32x4*)(sc + DFF); xcb = *(const f32x4*)(sc + DFF + 4); }
                const f32x4 w0a = *(const f32x4*)(cw + c0), w0b = *(const f32x4*)(cw + c0 + 4), w1a = *(const f32x4*)(cw + DFF + c0), w1b = *(const f32x4*)(cw + DFF + c0 + 4), w2a = *(const f32x4*)(cw + 2 * DFF + c0), w2b = *(const f32x4*)(cw + 2 * DFF + c0 + 4);
                const f32x4 ga = w0a * xm2a + w1a * xm1a + w2a * xca, gb_ = w0b * xm2b + w1b * xm1b + w2b * xcb;
                const float* sv = SV + (size_t)(blk * 4 + vb + rr) * DFF + c0; const f32x4 va = *(const f32x4*)sv, vb_ = *(const f32x4*)(sv + 4);
                f32x4 a0, a1;
#pragma unroll
                for (int j = 0; j < 4; ++j) { a0[j] = ga[j] * sigmoidf_(ga[j]) * va[j]; a1[j] = gb_[j] * sigmoidf_(gb_[j]) * vb_[j]; }
                *(v4u*)(act + (size_t)row * DFF + c0) = pack8(a0, a1); }
            for (int i = gt; i < 4 * 2 * DFF; i += NT) { const int c = i % DFF, j = (i / DFF) & 1, b = i / (2 * DFF); out[OFF_CFP + (size_t)l * 4 * 2 * DFF + i] = SG[(size_t)((64 * b + 63) * 8 + 6 + j) * DFF + c]; }
            for (int i = gt; i < 8 * 2 * DFF; i += NT) { const int c = i % DFF, j = (i / DFF) & 1, b = i / (2 * DFF); out[OFF_CFS + (size_t)l * 8 * 2 * DFF + i] = SG[(size_t)((256 + (b >> 1)) * 8 + (b & 1) * 4 + 2 + j) * DFF + c]; }
        }
        SEAM();
        if (RUN) { PTRS() pg8::Gemm g{act, WT + WT_DOWN + (size_t)l * 2816 * 1024, MP, 1024, DFF}; pg8::StaticOrderF S; S.init(MP, 1024, G, (int)blockIdx.x); EpiRes E{P.in[0], P.in[0], xb, PARTBUF(3 + 3 * l), 0};
            pg8::gemm_phase<EpiRes, pg8::StaticOrderF, true, true>(lds, g, S, E, wave_s);
            { FRESH() sample_gemm<0>(act, WT + WT_DOWN + (size_t)l * 2816 * 1024, DFF, lds, tid, wave, lane, xb, nullptr, PARTBUF(3 + 3 * l), nullptr, nullptr); } }
        SEAM();
    }
    if (RUN) { PTRS() FRESH()
        const float* gf = P.in[14];
        for (int m = gw; m < MROWS; m += NGW) { const float rs = rstd_of(PARTBUF(6), m); float* xr = out + (size_t)m * 1024; const bf16* xbr = xb + (size_t)m * 1024;
#pragma unroll
            for (int j = 0; j < 4; ++j) { const int c = (lane + 64 * j) * 4; const u32x2v w = __builtin_nontemporal_load((const u32x2v*)(xbr + c)); const f32x4 v = (f32x4){bflo(w.x), bfhi(w.x), bflo(w.y), bfhi(w.y)}, gg = *(const f32x4*)(gf + c); __builtin_nontemporal_store(v * rs * gg, (f32x4*)(xr + c)); } }
    }
}

extern "C" void kernel_launch(void* const* d_in, const int* in_sizes, int n_in, void* d_out, int out_size, void* d_ws, size_t ws_size, hipStream_t stream) {
    static int grid = 0;
    if (grid == 0) {
        int dev = 0, cus = 0, per_cu = 0;
        if (n_in != 36 || ws_size < 256 * MiB) { fprintf(stderr, "kernel_launch: unexpected n_in %d / ws %zu\n", n_in, ws_size); grid = -1; return; }
        (void)hipGetDevice(&dev); (void)hipDeviceGetAttribute(&cus, hipDeviceAttributeMultiprocessorCount, dev);
        if (hipFuncSetAttribute((const void*)mega_fwd, hipFuncAttributeMaxDynamicSharedMemorySize, LDS_BYTES) != hipSuccess) { fprintf(stderr, "kernel_launch: hipFuncSetAttribute failed\n"); grid = -1; return; }
        if (hipOccupancyMaxActiveBlocksPerMultiprocessor(&per_cu, (const void*)mega_fwd, 512, LDS_BYTES) != hipSuccess || per_cu < 1) per_cu = 1;
        (void)hipGetLastError();
        grid = cus * 1;
        if (grid > 256) grid = 256;
    }
    if (grid < 0) return;
    (void)hipMemsetAsync(d_ws, 0, CTL_ZERO_BYTES, stream);
    Params p{};
    for (int i = 0; i < 36; ++i) p.in[i] = (const float*)d_in[i];
    p.out = (float*)d_out; p.ws = (unsigned char*)d_ws; p.use_cg = 0; p.pad = 0;
    void* args[] = {&p};
    hipError_t e = hipLaunchCooperativeKernel((const void*)mega_fwd, dim3(grid), dim3(512), args, LDS_BYTES, stream);
    if (e != hipSuccess) fprintf(stderr, "cooperative launch failed: %s (grid %d)\n", hipGetErrorString(e), grid);
}
```

```cpp
#include <hip/hip_runtime.h>
#include <hip/hip_cooperative_groups.h>
#include <cstdio>
#include <cstdint>
namespace cg = cooperative_groups;
__device__ __forceinline__ int fresh_tid(int wave_s) { unsigned z = 0u; asm volatile("" : "+s"(z)); int t = wave_s * 64 + (int)__builtin_amdgcn_mbcnt_hi(~0u, __builtin_amdgcn_mbcnt_lo(~0u, z)); asm volatile("" : "+v"(t)); return t; }
namespace pg8 {
#define PG8_LAS __attribute__((address_space(3)))
typedef unsigned short bf16_t;
typedef short bf16x8 __attribute__((ext_vector_type(8)));
typedef float f32x4 __attribute__((ext_vector_type(4)));
typedef unsigned u32x4 __attribute__((ext_vector_type(4)));
constexpr int BM = 256, BK = 64, HALF = 128, HTB = HALF * BK * 2  , STAGE_BYTES = 8 * HTB, NXCD = 8, WGM = 8;

__host__ __device__ __forceinline__ int lds_byte(int r, int c) { const int st = (r >> 4) * 2 + (c >> 5), rr = r & 15, cc = c & 31, ob = rr * 64 + cc * 2; return st * 1024 + (ob ^ (((ob >> 9) & 1) << 5)); }
__host__ __device__ __forceinline__ void stage_rc(int b, int& R, int& C) { const int st = b / 1024, sb = b % 1024, swz = sb ^ (((sb >> 9) & 1) << 5); R = (st >> 1) * 16 + swz / 64; C = (st & 1) * 32 + (swz % 64) / 2; }
__host__ __device__ __forceinline__ int perm32(int rho) { const int n = rho >> 4, i = rho & 15; return 8 * (i >> 2) + 4 * n + (i & 3); }

struct Unit { int pm, pn; };
struct Gemm { const bf16_t* A; const bf16_t* Bt; int M, N, K; };

template <bool FULL> struct StaticOrderT {
    int nM, nN, nwg, G, c;
    __host__ __device__ void init(int M, int N, int G_, int c_) { nM = M / BM; nN = N / BM; nwg = nM * nN; G = G_; c = c_; }
    __host__ __device__ bool next(int i, Unit& u) const {
        const long L = (long)i * G + c; if (!(FULL && i == 0) && L >= nwg) return false;
        int wgid = (int)L; { const int q = nwg / NXCD, r = nwg % NXCD, xcd = wgid % NXCD, off = wgid / NXCD; wgid = (xcd < r ? xcd * (q + 1) : r * (q + 1) + (xcd - r) * q) + off; }
        const int nig = WGM * nN, gid = wgid / nig, fm = gid * WGM, gsz = (nM - fm) < WGM ? (nM - fm) : WGM;
        u.pm = fm + ((wgid % nig) % gsz); u.pn = (wgid % nig) / gsz; return true;
    }
    __device__ __forceinline__ void a_ready(const Unit&) const {}
    __device__ __forceinline__ void done(const Unit&) const {}
};

typedef StaticOrderT<false> StaticOrder; typedef StaticOrderT<true> StaticOrderF;
__device__ __forceinline__ unsigned cvt_pk_bf16(float lo, float hi) { unsigned r; asm volatile("v_cvt_pk_bf16_f32 %0, %1, %2" : "=v"(r) : "v"(lo), "v"(hi)); return r; }
typedef float f32x2 __attribute__((ext_vector_type(2)));
template <class Epi, class Sched, bool ALIGN_EPI = false, bool SP2 = false>
__device__ __forceinline__ void gemm_phase(PG8_LAS unsigned char* lds, const Gemm g, const Sched& S, const Epi& E, const int wave_s) {
    const int tid = fresh_tid(wave_s), wid = __builtin_amdgcn_readfirstlane(tid >> 6), lane = tid & 63, wr = wid >> 2, wc = wid & 3, fr = lane & 15, fq = lane >> 4;
    const int K = g.K, nt = K / BK;
    unsigned voffA[2], voffB[2];
#pragma unroll
    for (int i = 0; i < 2; ++i) { int R, C; stage_rc(tid * 16 + i * 8192, R, C); const int Rb = Epi::PERM ? ((R & ~31) + perm32(R & 31)) : R;
        voffA[i] = (unsigned)(R * K + C) * 2u; voffB[i] = (unsigned)(Rb * K + C) * 2u; }
    const size_t kstep = (size_t)(BK * 2);
    const size_t hstep = (size_t)HALF * K * 2;
    const size_t tstep = 2 * hstep;
    const unsigned ldsw = (unsigned)wid * 1024u;
    const int aoff = lds_byte(wr * 64 + fr, fq * 8), boff = lds_byte(wc * 32 + fr, fq * 8);
#define PG8_SA(b, h) (((b) * 2 + (h)) * HTB)
#define PG8_SB(b, h) ((4 + (b) * 2 + (h)) * HTB)
#define PG8_STAGE(bufoff, gbase, voff) do { _Pragma("unroll") for (int _i = 0; _i < 2; ++_i) \
        __builtin_amdgcn_global_load_lds((const unsigned*)((const char*)(gbase) + (voff)[_i]), (PG8_LAS unsigned*)(lds + (bufoff) + ldsw + _i * 8192), 16, 0, 0); } while (0)
#define PG8_LDA(dst, b, h) do { _Pragma("unroll") for (int m = 0; m < 4; ++m) _Pragma("unroll") for (int k = 0; k < 2; ++k) dst[m][k] = *(const PG8_LAS bf16x8*)(lds + PG8_SA(b, h) + aoff + m * 2048 + k * 1024); } while (0)
#define PG8_LDB(dst, b, h) do { _Pragma("unroll") for (int n = 0; n < 2; ++n) _Pragma("unroll") for (int k = 0; k < 2; ++k) dst[n][k] = *(const PG8_LAS bf16x8*)(lds + PG8_SB(b, h) + boff + n * 2048 + k * 1024); } while (0)
#define PG8_MMA(ai, bj, At, Bt) do { __builtin_amdgcn_s_setprio(1); _Pragma("unroll") for (int m = 0; m < 4; ++m) _Pragma("unroll") for (int n = 0; n < 2; ++n) _Pragma("unroll") for (int k = 0; k < 2; ++k) \
        acc[ai][bj][m][n] = __builtin_amdgcn_mfma_f32_16x16x32_bf16(Bt[n][k], At[m][k], acc[ai][bj][m][n], 0, 0, 0); __builtin_amdgcn_s_setprio(0); } while (0)
#define PG8_WAIT_V(n) asm volatile("s_waitcnt vmcnt(" #n ")" ::: "memory")
#define PG8_WAIT_L(n) asm volatile("s_waitcnt lgkmcnt(" #n ")" ::: "memory")
#define PG8_BAR __builtin_amdgcn_s_barrier()
#define PG8_SCHED __builtin_amdgcn_sched_barrier(0)
    Unit cur, nxt; int ui = 0;
    if (!S.next(0, cur)) return;
    f32x4 acc[2][2][4][2];
#pragma unroll
    for (int a = 0; a < 2; ++a)
#pragma unroll
        for (int b = 0; b < 2; ++b)
#pragma unroll
            for (int m = 0; m < 4; ++m)
#pragma unroll
                for (int n = 0; n < 2; ++n) acc[a][b][m][n] = (f32x4){0.f, 0.f, 0.f, 0.f};
    bf16x8 At[4][2], B0[2][2], B1[2][2];
    const char* cA = (const char*)g.A + (size_t)cur.pm * tstep; const char* cB = (const char*)g.Bt + (size_t)cur.pn * tstep;
    S.a_ready(cur);
    if constexpr (SP2) {
        PG8_STAGE(PG8_SB(0, 0), cB, voffB); PG8_STAGE(PG8_SB(0, 1), cB + hstep, voffB); PG8_STAGE(PG8_SA(0, 0), cA, voffA); PG8_STAGE(PG8_SA(0, 1), cA + hstep, voffA);
        if (wr == 1) PG8_BAR;
        PG8_WAIT_V(2); PG8_BAR;
        PG8_STAGE(PG8_SB(1, 0), cB + kstep, voffB); PG8_STAGE(PG8_SA(1, 0), cA + kstep, voffA); PG8_STAGE(PG8_SB(1, 1), cB + hstep + kstep, voffB);
        PG8_WAIT_V(6); PG8_BAR;
    } else {
        PG8_STAGE(PG8_SB(0, 0), cB, voffB); PG8_STAGE(PG8_SA(0, 0), cA, voffA); PG8_STAGE(PG8_SB(0, 1), cB + hstep, voffB); PG8_STAGE(PG8_SA(0, 1), cA + hstep, voffA);
        if (wr == 1) PG8_BAR;
        PG8_WAIT_V(4); PG8_BAR;
        PG8_STAGE(PG8_SB(1, 0), cB + kstep, voffB); PG8_STAGE(PG8_SA(1, 0), cA + kstep, voffA); PG8_STAGE(PG8_SB(1, 1), cB + hstep + kstep, voffB);
        PG8_WAIT_V(6); PG8_BAR;
    }
    for (;;) {
        const bool has_next = S.next(ui + 1, nxt);
        const char* nA = has_next ? (const char*)g.A + (size_t)nxt.pm * tstep : cA; const char* nB = has_next ? (const char*)g.Bt + (size_t)nxt.pn * tstep : cB;
        for (int t = 0; t < nt; t += 2) {
            const bool last = (t == nt - 2);
            const char* a1 = cA + (size_t)(t + 1) * kstep;
            const char* a2 = last ? nA : cA + (size_t)(t + 2) * kstep; const char* b2 = last ? nB : cB + (size_t)(t + 2) * kstep;
            const char* a3 = a2 + kstep; const char* b3 = b2 + kstep;
            if (last && has_next) S.a_ready(nxt);
            if constexpr (SP2) {
            PG8_LDB(B0, 0, 0); PG8_LDB(B1, 0, 1); PG8_SCHED; PG8_LDA(At, 0, 0); PG8_STAGE(PG8_SA(1, 1), a1 + hstep, voffA);
            PG8_WAIT_V(8); PG8_WAIT_L(0); PG8_BAR; PG8_MMA(0, 0, At, B0); PG8_MMA(0, 1, At, B1); PG8_BAR; PG8_SCHED;
            PG8_LDA(At, 0, 1); PG8_STAGE(PG8_SB(0, 0), b2, voffB); PG8_STAGE(PG8_SB(0, 1), b2 + hstep, voffB); PG8_STAGE(PG8_SA(0, 0), a2, voffA);
            PG8_WAIT_V(8); PG8_WAIT_L(0); PG8_BAR; PG8_MMA(1, 0, At, B0); PG8_MMA(1, 1, At, B1); PG8_BAR; PG8_SCHED;
            PG8_LDB(B0, 1, 0); PG8_LDB(B1, 1, 1); PG8_SCHED; PG8_LDA(At, 1, 0); PG8_STAGE(PG8_SA(0, 1), a2 + hstep, voffA);
            PG8_WAIT_V(8); PG8_WAIT_L(0); PG8_BAR; PG8_MMA(0, 0, At, B0); PG8_MMA(0, 1, At, B1); PG8_BAR; PG8_SCHED;
            PG8_LDA(At, 1, 1); PG8_STAGE(PG8_SB(1, 0), b3, voffB); PG8_STAGE(PG8_SB(1, 1), b3 + hstep, voffB); PG8_STAGE(PG8_SA(1, 0), a3, voffA);
            PG8_WAIT_V(8); PG8_WAIT_L(0); PG8_BAR; PG8_MMA(1, 0, At, B0); PG8_MMA(1, 1, At, B1); PG8_BAR; PG8_SCHED;
            } else {
            PG8_LDB(B0, 0, 0); PG8_SCHED; PG8_LDA(At, 0, 0); PG8_STAGE(PG8_SA(1, 1), a1 + hstep, voffA);
            PG8_WAIT_L(8); PG8_BAR; PG8_WAIT_L(0); PG8_MMA(0, 0, At, B0); PG8_BAR; PG8_SCHED;
            PG8_LDB(B1, 0, 1); PG8_STAGE(PG8_SB(0, 0), b2, voffB);
            PG8_BAR; PG8_WAIT_L(0); PG8_MMA(0, 1, At, B1); PG8_BAR;
            PG8_LDA(At, 0, 1); PG8_STAGE(PG8_SA(0, 0), a2, voffA);
            PG8_BAR; PG8_WAIT_L(0); PG8_MMA(1, 0, At, B0); PG8_BAR; PG8_SCHED;
            PG8_STAGE(PG8_SB(0, 1), b2 + hstep, voffB);
            PG8_WAIT_V(6); PG8_BAR; PG8_MMA(1, 1, At, B1); PG8_BAR;
            PG8_LDB(B0, 1, 0); PG8_SCHED; PG8_LDA(At, 1, 0); PG8_STAGE(PG8_SA(0, 1), a2 + hstep, voffA);
            PG8_WAIT_L(8); PG8_BAR; PG8_WAIT_L(0); PG8_MMA(0, 0, At, B0); PG8_BAR; PG8_SCHED;
            PG8_LDB(B1, 1, 1); PG8_STAGE(PG8_SB(1, 0), b3, voffB);
            PG8_BAR; PG8_WAIT_L(0); PG8_MMA(0, 1, At, B1); PG8_BAR;
            PG8_LDA(At, 1, 1); PG8_STAGE(PG8_SA(1, 0), a3, voffA);
            PG8_BAR; PG8_WAIT_L(0); PG8_MMA(1, 0, At, B0); PG8_BAR; PG8_SCHED;
            PG8_STAGE(PG8_SB(1, 1), b3 + hstep, voffB);
            PG8_WAIT_V(6); PG8_BAR; PG8_MMA(1, 1, At, B1); PG8_BAR;
            }
        }
        if constexpr (ALIGN_EPI) { if (wr == 0) PG8_BAR; }
        if constexpr (!Epi::AFTER_DRAIN) { E(acc, cur, wr, wc, fr, fq); S.done(cur); }
        if (!has_next) break;
#pragma unroll
        for (int a = 0; a < 2; ++a)
#pragma unroll
            for (int b = 0; b < 2; ++b)
#pragma unroll
                for (int m = 0; m < 4; ++m)
#pragma unroll
                    for (int n = 0; n < 2; ++n) acc[a][b][m][n] = (f32x4){0.f, 0.f, 0.f, 0.f};
        cur = nxt; cA = nA; cB = nB; ++ui;
        if constexpr (ALIGN_EPI) { if (wr == 1) PG8_BAR; }
    }
    PG8_WAIT_V(0);
    if constexpr (!ALIGN_EPI) { if (wr == 0) PG8_BAR; }
    PG8_BAR;
    if constexpr (Epi::AFTER_DRAIN) { E.fused(acc, cur, wr, wc, fr, fq, lds, wid, lane); S.done(cur); }
#undef PG8_SA
#undef PG8_SB
#undef PG8_STAGE
#undef PG8_LDA
#undef PG8_LDB
#undef PG8_MMA
#undef PG8_WAIT_V
#undef PG8_WAIT_L
#undef PG8_BAR
#undef PG8_SCHED
}
}
#define GAS __attribute__((address_space(1)))
#define LAS __attribute__((address_space(3)))
typedef unsigned short bf16;
typedef unsigned v4u __attribute__((ext_vector_type(4)));
typedef float f32x4 __attribute__((ext_vector_type(4)));
typedef short bf16x8 __attribute__((ext_vector_type(8)));
typedef GAS unsigned gu32;
typedef GAS unsigned long long gu64;
#define RLX_AGENT __ATOMIC_RELAXED, __HIP_MEMORY_SCOPE_AGENT
#define LDS_WAIT() asm volatile("s_waitcnt lgkmcnt(0)" ::: "memory")
#define VM_WAIT() asm volatile("s_waitcnt vmcnt(0)" ::: "memory")
__device__ __forceinline__ unsigned long long rt() { return __builtin_amdgcn_s_memrealtime(); }
__device__ __forceinline__ unsigned f2bf(float f) { unsigned u = __builtin_bit_cast(unsigned, f); return (u + 0x7fffu + ((u >> 16) & 1u)) >> 16; }
__device__ __forceinline__ unsigned pk2(float lo, float hi) { return f2bf(lo) | (f2bf(hi) << 16); }

#define XB_TMO      128
#define XB_XCNT(j)  (256  + 64 * (j))
#define XB_XSUB(j)  (1280 + 64 * (j))
#define XB_XGEN(j)  (2304 + 64 * (j))
#define XB_TOP      3328
#define XB_TOPGEN   3392
#define XCD_BAR_WORDS 3456
#define XB_SPIN_CAP (1u << 18)

__device__ __forceinline__ unsigned xb_ld(unsigned* p)              { return __hip_atomic_load(p, __ATOMIC_RELAXED, __HIP_MEMORY_SCOPE_AGENT); }
__device__ __forceinline__ unsigned xb_add(unsigned* p, unsigned v) { return __hip_atomic_fetch_add(p, v, __ATOMIC_RELAXED, __HIP_MEMORY_SCOPE_AGENT); }
__device__ __forceinline__ unsigned xb_xcc_id() { return (unsigned)__builtin_amdgcn_s_getreg((3 << 11) | 20) & 0xFu; }
#define XB_SPIN(cond, bar) do { unsigned _sp = 0; while (cond) { __builtin_amdgcn_s_sleep(0); \
    if ((++_sp & 255u) == 0u) { if (xb_ld(&(bar)[XB_TMO])) break; if (_sp > XB_SPIN_CAP) { atomicAdd(&(bar)[XB_TMO], 1u); break; } } } } while (0)

struct XcdBarrier {
    unsigned* bar; unsigned x;
    volatile LAS unsigned* st;
};

__device__ __forceinline__ XcdBarrier xcd_barrier_post(unsigned* bar, volatile LAS unsigned* st) {
    XcdBarrier b; b.bar = bar; b.x = xb_xcc_id(); b.st = st;
    if (threadIdx.x == 0) (void)xb_add(&bar[XB_XCNT(b.x)], 1u);
    return b;
}
__device__ __forceinline__ void xcd_barrier_complete(unsigned* bar, unsigned x, unsigned& nloc, unsigned& nx) {
    const unsigned G = gridDim.x * gridDim.y * gridDim.z;
    unsigned sum, cnt, mine, sp = 0u;
    for (;;) {
        sum = 0u; cnt = 0u; mine = 0u;
#pragma unroll
        for (unsigned j = 0; j < 16; ++j) { const unsigned c = xb_ld(&bar[XB_XCNT(j)]); sum += c; cnt += (c > 0u) ? 1u : 0u; mine = (j == x) ? c : mine; }
        if (sum == G) break;
        __builtin_amdgcn_s_sleep(1);
        if ((++sp & 255u) == 0u) { if (xb_ld(&bar[XB_TMO])) break; if (sp > XB_SPIN_CAP) { atomicAdd(&bar[XB_TMO], 1u); break; } }
    }
    nloc = mine > 0u ? mine : 1u; nx = cnt > 0u ? cnt : 1u;
}

__device__ __forceinline__ void xcd_barrier(const XcdBarrier& b) {
    asm volatile("s_waitcnt vmcnt(0)" ::: "memory");
    __syncthreads();
    if (threadIdx.x == 0) {
        unsigned* bar = b.bar;
        __builtin_amdgcn_s_waitcnt(0);
        unsigned nloc = b.st[0], nx = b.st[1];
        if (nloc == 0u) { xcd_barrier_complete(bar, b.x, nloc, nx); b.st[0] = nloc; b.st[1] = nx; }
        const unsigned old = xb_add(&bar[XB_XSUB(b.x)], 1u);
        const unsigned gen = old / nloc;
        if (old + 1u == (gen + 1u) * nloc) {
            __builtin_amdgcn_fence(__ATOMIC_RELEASE, "agent");
            asm volatile("s_waitcnt vmcnt(0)" ::: "memory");
            const unsigned og = xb_add(&bar[XB_TOP], 1u);
            const unsigned tg = og / nx;
            if (og + 1u == (tg + 1u) * nx) xb_add(&bar[XB_TOPGEN], 1u);
            else XB_SPIN(xb_ld(&bar[XB_TOPGEN]) == tg, bar);
            __builtin_amdgcn_fence(__ATOMIC_ACQUIRE, "agent");
            xb_add(&bar[XB_XGEN(b.x)], 1u);
            asm volatile("s_waitcnt vmcnt(0)" ::: "memory");
        } else {
            XB_SPIN(xb_ld(&bar[XB_XGEN(b.x)]) == gen, bar);
            __builtin_amdgcn_fence(__ATOMIC_ACQUIRE, "agent");
            asm volatile("s_waitcnt vmcnt(0)" ::: "memory");
        }
    }
    __syncthreads();
}
typedef unsigned u32x2v __attribute__((ext_vector_type(2)));
typedef float f32x2v __attribute__((ext_vector_type(2)));

constexpr int MP = 16384, MROWS = 16640, DMODEL = 1024, DFF = 2816, NBLK64 = MROWS / 64;
constexpr float RMS_EPS = 1e-6f;
constexpr size_t OFF_Y = 0, OFF_WKP = (size_t)MROWS * 1024, OFF_WVP = OFF_WKP + 65536, OFF_SRP = OFF_WVP + 65536, OFF_SIP = OFF_SRP + 8192,
    OFF_CMP = OFF_SIP + 8192, OFF_CFP = OFF_CMP + 8192, OFF_MKP = OFF_CFP + 45056, OFF_MVP = OFF_MKP + 2097152, OFF_WKS = OFF_MVP + 2097152,
    OFF_WVS = OFF_WKS + 32768, OFF_SRS = OFF_WVS + 32768, OFF_SIS = OFF_SRS + 16384, OFF_CMS = OFF_SIS + 16384, OFF_CFS = OFF_CMS + 16384;
constexpr size_t MiB = 1u << 20;
constexpr size_t WS_ROWSS = 0, WS_BAR = 512 * 1024, CTL_ZERO_BYTES = 1 * MiB;
constexpr size_t WS_ROPE = 1 * MiB, WS_SSM = 2 * MiB, WS_CKV = 3 * MiB, WS_SLOC = 4 * MiB, WS_MEMK = 8 * MiB, WS_MEMVT = 20 * MiB, WS_SIDE = 32 * MiB;
constexpr size_t SG_BYTES = (size_t)NBLK64 * 8 * DFF * 4, SV_BYTES = (size_t)NBLK64 * 4 * DFF * 4;
static_assert(WS_SIDE + SG_BYTES + SV_BYTES <= 66 * MiB, "side buffers");
constexpr size_t WS_WT = 66 * MiB, WS_XB = 128 * MiB, WS_TMP = 161 * MiB;
constexpr size_t WT_INEVEN = 0, WT_GLU = WT_INEVEN + 1280 * 1024, WT_OUTEVEN = WT_GLU + 512 * 512, WT_WQ = WT_OUTEVEN + 1024 * 1024, WT_WKV = WT_WQ + 2 * 1024 * 1024,
    WT_WO = WT_WKV + 2 * 2048 * 1024, WT_UP = WT_WO + 2 * 1024 * 1024, WT_DOWN = WT_UP + (size_t)2 * 5632 * 1024, WT_INODD = WT_DOWN + (size_t)2 * 2816 * 1024,
    WT_OUTODD = WT_INODD + 3072 * 1024, WT_END = WT_OUTODD + 1024 * 1024;
static_assert(WS_WT + WT_END * 2 <= WS_XB, "weights");
static_assert(WS_XB + (size_t)MROWS * 1024 * 2 <= WS_TMP, "xb");
constexpr size_t TMP_BYTES = (size_t)MROWS * DFF * 2;
constexpr size_t WS_PART = 251 * MiB, PART_ELEMS = (size_t)MROWS * 16;
static_assert(WS_PART + 2 * PART_ELEMS * 4 <= 256 * MiB, "part");
static_assert(WS_TMP + TMP_BYTES <= 256 * MiB, "ws");
constexpr size_t TMP_PROJ0 = 0, TMP_GBUF = (size_t)MROWS * 1280 * 2, TMP_YCAT = TMP_GBUF + (size_t)MROWS * 512 * 2, TMP_MEMB = TMP_YCAT;
static_assert(TMP_YCAT + (size_t)MROWS * 1024 * 2 <= TMP_BYTES, "tmp");
constexpr size_t TMP_QX = 0, TMP_OX = (size_t)MROWS * 1024 * 2, TMP_ACT = 0, TMP_GB = 0, TMP_ZC = (size_t)MROWS * 1024 * 2;
constexpr int LDS_BYTES = 147456, MISC_OFF = 147456 - 512;
constexpr int NPH = 22;

#define MFMA16(a, b, c) __builtin_amdgcn_mfma_f32_16x16x32_bf16(a, b, c, 0, 0, 0)
__device__ __forceinline__ float bflo(unsigned w) { return __uint_as_float(w << 16); }
__device__ __forceinline__ float bfhi(unsigned w) { return __uint_as_float(w & 0xffff0000u); }
__device__ __forceinline__ v4u pack8(f32x4 a, f32x4 b) { v4u w; w.x = pg8::cvt_pk_bf16(a[0], a[1]); w.y = pg8::cvt_pk_bf16(a[2], a[3]); w.z = pg8::cvt_pk_bf16(b[0], b[1]); w.w = pg8::cvt_pk_bf16(b[2], b[3]); return w; }
__device__ __forceinline__ float rstd_of(const float* part, int row) { const f32x4* p = (const f32x4*)(part + (size_t)row * 16); const f32x4 a = p[0] + p[1] + p[2] + p[3]; return rsqrtf(((a[0] + a[1]) + (a[2] + a[3])) * (1.0f / 1024.0f) + RMS_EPS); }
__device__ __forceinline__ float sigmoidf_(float x) { return 1.0f / (1.0f + __expf(-x)); }
__device__ __forceinline__ float dpp_ror1(float v) { return __builtin_bit_cast(float, __builtin_amdgcn_update_dpp(0, __builtin_bit_cast(int, v), 0x121, 0xf, 0xf, false)); }
__device__ __forceinline__ float dpp_ror2(float v) { return __builtin_bit_cast(float, __builtin_amdgcn_update_dpp(0, __builtin_bit_cast(int, v), 0x122, 0xf, 0xf, false)); }
__device__ __forceinline__ float wave_sum(float v) {
#pragma unroll
    for (int o = 1; o < 64; o <<= 1) v += __shfl_xor(v, o);
    return v;
}

typedef pg8::Unit Unit;
#define EPI_ARGS const f32x4 (&acc)[2][2][4][2], const Unit& u, int wr, int wc, int fr, int fq

struct EpiBf16 {
    static constexpr bool PERM = true, AFTER_DRAIN = false;
    bf16* O; int ldc; const float* rowss;
    __device__ __forceinline__ void operator()(EPI_ARGS) const {
        const int row0 = u.pm * 256 + wr * 64 + fr, col0 = u.pn * 256 + wc * 32 + 8 * fq;
#pragma unroll
        for (int ai = 0; ai < 2; ++ai)
#pragma unroll
            for (int m = 0; m < 4; ++m) { const int row = row0 + ai * 128 + m * 16; const float rs = rstd_of(rowss, row); bf16* rp = O + (size_t)row * ldc + col0;
#pragma unroll
                for (int bj = 0; bj < 2; ++bj) *(v4u*)(rp + bj * 128) = pack8(acc[ai][bj][m][0] * rs, acc[ai][bj][m][1] * rs); }
    }
};
struct EpiRes {
    static constexpr bool PERM = true, AFTER_DRAIN = false;
    const float* base_p; const float* base_s; bf16* xb; float* rowss_next; int f32base;
    __device__ __forceinline__ void operator()(EPI_ARGS) const {
        const float* base = u.pm < 64 ? base_p : base_s;
        const int row0 = u.pm * 256 + wr * 64 + fr, col0 = u.pn * 256 + wc * 32 + 8 * fq;
#pragma unroll
        for (int ai = 0; ai < 2; ++ai)
#pragma unroll
            for (int m = 0; m < 4; ++m) { const int row = row0 + ai * 128 + m * 16; const size_t off = (size_t)row * 1024 + col0; float ss = 0.f;
#pragma unroll
                for (int bj = 0; bj < 2; ++bj) { f32x4 b0, b1;
                    if (f32base) { b0 = __builtin_nontemporal_load((const f32x4*)(base + off + bj * 128)); b1 = __builtin_nontemporal_load((const f32x4*)(base + off + bj * 128 + 4)); }
                    else { const v4u w = *(const v4u*)(xb + off + bj * 128); b0 = (f32x4){bflo(w.x), bfhi(w.x), bflo(w.y), bfhi(w.y)}; b1 = (f32x4){bflo(w.z), bfhi(w.z), bflo(w.w), bfhi(w.w)}; }
                    const f32x4 v0 = acc[ai][bj][m][0] + b0, v1 = acc[ai][bj][m][1] + b1;
                    *(v4u*)(xb + off + bj * 128) = pack8(v0, v1);
                    ss += (v0[0] * v0[0] + v0[1] * v0[1]) + (v0[2] * v0[2] + v0[3] * v0[3]) + (v1[0] * v1[0] + v1[1] * v1[1]) + (v1[2] * v1[2] + v1[3] * v1[3]); }
                ss += __shfl_xor(ss, 16); ss += __shfl_xor(ss, 32);
                if (fq == 0) rowss_next[(size_t)row * 16 + u.pn * 4 + wc] = ss; }
    }
};
struct EpiGlu {
    static constexpr bool PERM = true, AFTER_DRAIN = false;
    const bf16* g; bf16* ycat;
    __device__ __forceinline__ void operator()(EPI_ARGS) const {
        const int row0 = u.pm * 256 + wr * 64 + fr, col0 = u.pn * 256 + wc * 32 + 8 * fq;
#pragma unroll
        for (int ai = 0; ai < 2; ++ai)
#pragma unroll
            for (int m = 0; m < 4; ++m) { const int row = row0 + ai * 128 + m * 16;
#pragma unroll
                for (int bj = 0; bj < 2; ++bj) { const int col = col0 + bj * 128; const v4u gw = *(const v4u*)(g + (size_t)row * 512 + col);
                    const f32x4 a0 = acc[ai][bj][m][0], a1 = acc[ai][bj][m][1]; f32x4 o0, o1;
                    o0[0] = bflo(gw.x) * sigmoidf_(a0[0]); o0[1] = bfhi(gw.x) * sigmoidf_(a0[1]); o0[2] = bflo(gw.y) * sigmoidf_(a0[2]); o0[3] = bfhi(gw.y) * sigmoidf_(a0[3]);
                    o1[0] = bflo(gw.z) * sigmoidf_(a1[0]); o1[1] = bfhi(gw.z) * sigmoidf_(a1[1]); o1[2] = bflo(gw.w) * sigmoidf_(a1[2]); o1[3] = bfhi(gw.w) * sigmoidf_(a1[3]);
                    *(v4u*)(ycat + (size_t)row * 1024 + col) = pack8(o0, o1); } }
    }
};
struct EpiKV {
    static constexpr bool PERM = true, AFTER_DRAIN = false;
    float* out; bf16* memk;
    __device__ __forceinline__ void operator()(EPI_ARGS) const {
        const int row0 = u.pm * 256 + wr * 64 + fr, col0 = u.pn * 256 + wc * 32 + 8 * fq;
#pragma unroll
        for (int ai = 0; ai < 2; ++ai)
#pragma unroll
            for (int m = 0; m < 4; ++m) { const int row = row0 + ai * 128 + m * 16;
#pragma unroll
                for (int bj = 0; bj < 2; ++bj) { const int c = col0 + bj * 128, l = c >> 11, e = c & 2047, isv = e >> 10, dc = e & 1023;
                    float* op = out + (isv ? OFF_MVP : OFF_MKP) + (size_t)l * 1048576 + (size_t)row * 1024 + dc;
                    if (isv) { *(f32x4*)op = acc[ai][bj][m][0]; *(f32x4*)(op + 4) = acc[ai][bj][m][1]; } else { __builtin_nontemporal_store(acc[ai][bj][m][0], (f32x4*)op); __builtin_nontemporal_store(acc[ai][bj][m][1], (f32x4*)(op + 4)); }
                    if (!isv) *(v4u*)(memk + (size_t)l * 12 * 262144 + (size_t)row * 1024 + dc) = pack8(acc[ai][bj][m][0], acc[ai][bj][m][1]); } }
    }
};
struct EpiIn0 {
    static constexpr bool PERM = true, AFTER_DRAIN = false;
    bf16* proj; const float* rowss; const float* ropec; const float* ropes; float* out;
    __device__ __forceinline__ void operator()(EPI_ARGS) const {
        const int pn = u.pn;
#pragma unroll
        for (int ai = 0; ai < 2; ++ai)
#pragma unroll
            for (int m = 0; m < 4; ++m) { const int row = u.pm * 256 + ai * 128 + wr * 64 + m * 16 + fr; const float rs = rstd_of(rowss, row);
                const int pos = row < MP ? (row & 4095) : 2048 + (row & 31);
                bf16* rp = proj + (size_t)row * 1280;
                float* wk = nullptr; float* wv = nullptr;
                if (pn == 4) { if (row >= MP) { wk = out + OFF_WKS + (size_t)(row - MP) * 128; wv = out + OFF_WVS + (size_t)(row - MP) * 128; }
                               else if ((row & 4095) >= 3968) { const size_t o = (size_t)((row >> 12) * 128 + (row & 4095) - 3968) * 128; wk = out + OFF_WKP + o; wv = out + OFF_WVP + o; } }
#pragma unroll
                for (int bj = 0; bj < 2; ++bj) { const f32x4 v0 = acc[ai][bj][m][0] * rs, v1 = acc[ai][bj][m][1] * rs;
                    const bool rope = (pn == 2 || pn == 3 || (pn == 4 && bj == 0));
                    if (!rope) { const int col = pn * 256 + bj * 128 + wc * 32 + 8 * fq; *(v4u*)(rp + col) = pack8(v0, v1);
                        if (pn == 4 && wv) { *(f32x4*)(wv + wc * 32 + 8 * fq) = v0; *(f32x4*)(wv + wc * 32 + 8 * fq + 4) = v1; } }
                    else { const int gbase = pn * 256 + bj * 128 + (wc >> 1) * 64, d1 = 16 * (wc & 1) + 4 * fq;
                        const f32x4 c4 = *(const f32x4*)(ropec + pos * 32 + d1), s4 = *(const f32x4*)(ropes + pos * 32 + d1);
                        f32x4 o1 = v0 * c4 - v1 * s4, o2 = v1 * c4 + v0 * s4;
                        if (pn != 4) { o1 = o1 * 0.125f; o2 = o2 * 0.125f; }
                        u32x2v w1, w2; w1.x = pg8::cvt_pk_bf16(o1[0], o1[1]); w1.y = pg8::cvt_pk_bf16(o1[2], o1[3]); w2.x = pg8::cvt_pk_bf16(o2[0], o2[1]); w2.y = pg8::cvt_pk_bf16(o2[2], o2[3]);
                        *(u32x2v*)(rp + gbase + d1) = w1; *(u32x2v*)(rp + gbase + d1 + 32) = w2;
                        if (pn == 4 && wk) { const int cc = (wc >> 1) * 64 + d1; *(f32x4*)(wk + cc) = o1; *(f32x4*)(wk + cc + 32) = o2; } } } }
    }
};
struct EpiFfnUp {
    static constexpr bool PERM = true, AFTER_DRAIN = false;
    bf16* act; const float* rowss; const float* cw; float* SG; float* SV;
    __device__ __forceinline__ void operator()(EPI_ARGS) const {
        const int c0 = u.pn * 128 + wc * 32 + 8 * fq; const bool sample = u.pm == 64;
        const f32x4 w0a = *(const f32x4*)(cw + c0), w0b = *(const f32x4*)(cw + c0 + 4), w1a = *(const f32x4*)(cw + DFF + c0), w1b = *(const f32x4*)(cw + DFF + c0 + 4),
                    w2a = *(const f32x4*)(cw + 2 * DFF + c0), w2b = *(const f32x4*)(cw + 2 * DFF + c0 + 4);
#pragma unroll
        for (int ai = 0; ai < 2; ++ai) { f32x4 gp0 = {0.f, 0.f, 0.f, 0.f}, gp1 = {0.f, 0.f, 0.f, 0.f}; const int blk = u.pm * 4 + ai * 2 + wr;
#pragma unroll
            for (int m = 0; m < 4; ++m) { const int row = u.pm * 256 + ai * 128 + wr * 64 + m * 16 + fr; const float rs = rstd_of(rowss, row);
                const f32x4 g0 = acc[ai][0][m][0] * rs, g1 = acc[ai][0][m][1] * rs, v0 = acc[ai][1][m][0] * rs, v1 = acc[ai][1][m][1] * rs;
                f32x4 p1a, p2a, p1b, p2b;
#pragma unroll
                for (int j = 0; j < 4; ++j) { const float s1a = fr == 15 ? gp0[j] : g0[j], s2a = fr >= 14 ? gp0[j] : g0[j], s1b = fr == 15 ? gp1[j] : g1[j], s2b = fr >= 14 ? gp1[j] : g1[j];
                    p1a[j] = dpp_ror1(s1a); p2a[j] = dpp_ror2(s2a); p1b[j] = dpp_ror1(s1b); p2b[j] = dpp_ror2(s2b); }
                const f32x4 ca = w0a * p2a + w1a * p1a + w2a * g0, cb = w0b * p2b + w1b * p1b + w2b * g1;
                f32x4 sa, sb;
#pragma unroll
                for (int j = 0; j < 4; ++j) { sa[j] = sigmoidf_(ca[j]); sb[j] = sigmoidf_(cb[j]); }
                const f32x4 a0 = ca * sa * v0, a1 = cb * sb * v1;
                const bool valid = (m > 0 || fr >= 2) && !(sample && m == 2 && fr < 2);
                if (valid) *(v4u*)(act + (size_t)row * DFF + c0) = pack8(a0, a1);
                if ((m & 1) == 0 && fr < 2) { float* sg = SG + (size_t)(blk * 8 + 2 * m + fr) * DFF + c0; *(f32x4*)sg = g0; *(f32x4*)(sg + 4) = g1;
                                              float* sv = SV + (size_t)(blk * 4 + m + fr) * DFF + c0; *(f32x4*)sv = v0; *(f32x4*)(sv + 4) = v1; }
                if ((m & 1) == 1 && fr >= 14) { float* sg = SG + (size_t)(blk * 8 + 2 * m + fr - 14) * DFF + c0; *(f32x4*)sg = g0; *(f32x4*)(sg + 4) = g1; }
                gp0 = g0; gp1 = g1; } }
    }
};
struct EpiInOdd {
    static constexpr bool PERM = true, AFTER_DRAIN = false;
    bf16* gb; bf16* zc; const float* rowss; const float* cw; float* SG;
    __device__ __forceinline__ void operator()(EPI_ARGS) const {
        if (u.pn < 4) {
            const int row0 = u.pm * 256 + wr * 64 + fr, col0 = u.pn * 256 + wc * 32 + 8 * fq;
#pragma unroll
            for (int ai = 0; ai < 2; ++ai)
#pragma unroll
                for (int m = 0; m < 4; ++m) { const int row = row0 + ai * 128 + m * 16; const float rs = rstd_of(rowss, row); bf16* rp = gb + (size_t)row * 1024 + col0;
#pragma unroll
                    for (int bj = 0; bj < 2; ++bj) *(v4u*)(rp + bj * 128) = pack8(acc[ai][bj][m][0] * rs, acc[ai][bj][m][1] * rs); }
            return;
        }
        const int c0 = (u.pn - 4) * 128 + wc * 32 + 8 * fq; const bool sample = u.pm == 64;
        const f32x4 w0a = *(const f32x4*)(cw + c0), w0b = *(const f32x4*)(cw + c0 + 4), w1a = *(const f32x4*)(cw + 1024 + c0), w1b = *(const f32x4*)(cw + 1024 + c0 + 4),
                    w2a = *(const f32x4*)(cw + 2048 + c0), w2b = *(const f32x4*)(cw + 2048 + c0 + 4);
#pragma unroll
        for (int ai = 0; ai < 2; ++ai) { f32x4 gp0 = {0.f, 0.f, 0.f, 0.f}, gp1 = {0.f, 0.f, 0.f, 0.f}; const int blk = u.pm * 4 + ai * 2 + wr;
#pragma unroll
            for (int m = 0; m < 4; ++m) { const int row = u.pm * 256 + ai * 128 + wr * 64 + m * 16 + fr; const float rs = rstd_of(rowss, row); const float rs2 = rs * rs;
                const f32x4 g0 = acc[ai][0][m][0] * acc[ai][1][m][0] * rs2, g1 = acc[ai][0][m][1] * acc[ai][1][m][1] * rs2;
                f32x4 p1a, p2a, p1b, p2b;
#pragma unroll
                for (int j = 0; j < 4; ++j) { const float s1a = fr == 15 ? gp0[j] : g0[j], s2a = fr >= 14 ? gp0[j] : g0[j], s1b = fr == 15 ? gp1[j] : g1[j], s2b = fr >= 14 ? gp1[j] : g1[j];
                    p1a[j] = dpp_ror1(s1a); p2a[j] = dpp_ror2(s2a); p1b[j] = dpp_ror1(s1b); p2b[j] = dpp_ror2(s2b); }
                const f32x4 a0 = w0a * p2a + w1a * p1a + w2a * g0, a1 = w0b * p2b + w1b * p1b + w2b * g1;
                const bool valid = (m > 0 || fr >= 2) && !(sample && m == 2 && fr < 2);
                if (valid) *(v4u*)(zc + (size_t)row * 1024 + c0) = pack8(a0, a1);
                if ((m & 1) == 0 && fr < 2) { float* sg = SG + (size_t)(blk * 8 + 2 * m + fr) * 1024 + c0; *(f32x4*)sg = g0; *(f32x4*)(sg + 4) = g1; }
                if ((m & 1) == 1 && fr >= 14) { float* sg = SG + (size_t)(blk * 8 + 2 * m + fr - 14) * 1024 + c0; *(f32x4*)sg = g0; *(f32x4*)(sg + 4) = g1; }
                gp0 = g0; gp1 = g1; } }
    }
};


struct EpiCz {
    static constexpr bool PERM = true, AFTER_DRAIN = false;
    bf16* gb; const float* rowss; const float* cw; float* SG;
    __device__ __forceinline__ void operator()(EPI_ARGS) const {
        const int c0 = u.pn * 128 + wc * 32 + 8 * fq;
        const f32x4 w0a = *(const f32x4*)(cw + c0), w0b = *(const f32x4*)(cw + c0 + 4), w1a = *(const f32x4*)(cw + 1024 + c0), w1b = *(const f32x4*)(cw + 1024 + c0 + 4),
                    w2a = *(const f32x4*)(cw + 2048 + c0), w2b = *(const f32x4*)(cw + 2048 + c0 + 4);
#pragma unroll
        for (int ai = 0; ai < 2; ++ai) { f32x4 gp0 = {0.f, 0.f, 0.f, 0.f}, gp1 = {0.f, 0.f, 0.f, 0.f}; const int blk = u.pm * 4 + ai * 2 + wr;
#pragma unroll
            for (int m = 0; m < 4; ++m) { const int row = u.pm * 256 + ai * 128 + wr * 64 + m * 16 + fr; const float rs = rstd_of(rowss, row); const float rs2 = rs * rs;
                const f32x4 g0 = acc[ai][0][m][0] * acc[ai][1][m][0] * rs2, g1 = acc[ai][0][m][1] * acc[ai][1][m][1] * rs2;
                f32x4 p1a, p2a, p1b, p2b;
#pragma unroll
                for (int j = 0; j < 4; ++j) { const float s1a = fr == 15 ? gp0[j] : g0[j], s2a = fr >= 14 ? gp0[j] : g0[j], s1b = fr == 15 ? gp1[j] : g1[j], s2b = fr >= 14 ? gp1[j] : g1[j];
                    p1a[j] = dpp_ror1(s1a); p2a[j] = dpp_ror2(s2a); p1b[j] = dpp_ror1(s1b); p2b[j] = dpp_ror2(s2b); }
                const f32x4 a0 = w0a * p2a + w1a * p1a + w2a * g0, a1 = w0b * p2b + w1b * p1b + w2b * g1;
                if (m > 0 || fr >= 2) { bf16* gp = gb + (size_t)row * 1024 + c0; const v4u gw = *(const v4u*)gp;
                    const f32x4 b0 = (f32x4){bflo(gw.x), bfhi(gw.x), bflo(gw.y), bfhi(gw.y)}, b1 = (f32x4){bflo(gw.z), bfhi(gw.z), bflo(gw.w), bfhi(gw.w)};
                    *(v4u*)gp = pack8(a0 * b0, a1 * b1); }
                if ((m & 1) == 0 && fr < 2) { float* sg = SG + (size_t)(blk * 8 + 2 * m + fr) * 1024 + c0; *(f32x4*)sg = g0; *(f32x4*)(sg + 4) = g1; }
                if ((m & 1) == 1 && fr >= 14) { float* sg = SG + (size_t)(blk * 8 + 2 * m + fr - 14) * 1024 + c0; *(f32x4*)sg = g0; *(f32x4*)(sg + 4) = g1; }
                gp0 = g0; gp1 = g1; } }
    }
};

__device__ __forceinline__ int rowmap(int mode, int n) {
    if (mode == 1) { if (n >= 512 && n < 1152) { const int d = n & 63; return (n & ~63) | (32 * ((d >> 4) & 1) + 8 * ((d >> 2) & 3) + 4 * (d >> 5) + (d & 3)); } return n; }
    if (mode == 2) { return n < DFF ? ((n >> 7) * 256 + (n & 127)) : (((n - DFF) >> 7) * 256 + 128 + ((n - DFF) & 127)); }
    if (mode == 3) { if (n < 1024) return n; const int c = (n - 1024) & 1023, z = n >= 2048 ? 1 : 0; return 1024 + (c >> 7) * 256 + z * 128 + (c & 127); }
    return n;
}
__device__ __forceinline__ void tr_item(const float* W, int K, int N, bf16* WT, const float* gain, float scale, int mode, LAS float* scr, int item, int lane) {
    const int nblk = N / 32, kb = item / nblk, nb = item % nblk, k0 = 64 * kb, n0 = 32 * nb;
#pragma unroll
    for (int i = 0; i < 8; ++i) { const int idx = lane + 64 * i, kk = idx >> 3, n4 = (idx & 7) * 4; const float gs = gain ? ((const GAS float*)gain)[k0 + kk] * scale : scale;
        const f32x4 w = __builtin_nontemporal_load((const GAS f32x4*)((const GAS float*)W + (size_t)(k0 + kk) * N + n0 + n4)); LAS float* d = scr + kk * 33 + n4; d[0] = w[0] * gs; d[1] = w[1] * gs; d[2] = w[2] * gs; d[3] = w[3] * gs; }
    LDS_WAIT(); asm volatile("" ::: "memory");
    const int c = lane & 7;
#pragma unroll
    for (int j = 0; j < 4; ++j) { const int n = (lane >> 3) + 8 * j; const LAS float* s = scr + (8 * c) * 33 + n;
        v4u o; o.x = pg8::cvt_pk_bf16(s[0 * 33], s[1 * 33]); o.y = pg8::cvt_pk_bf16(s[2 * 33], s[3 * 33]); o.z = pg8::cvt_pk_bf16(s[4 * 33], s[5 * 33]); o.w = pg8::cvt_pk_bf16(s[6 * 33], s[7 * 33]);
        *(GAS v4u*)((GAS bf16*)WT + (size_t)rowmap(mode, n0 + n) * K + k0 + 8 * c) = o; }
    LDS_WAIT(); asm volatile("" ::: "memory");
}
__device__ __forceinline__ double dexp_(double y) {
    const double k = rint(y * 1.4426950408889634); const double r = (y - k * 0.6931471803691238) - k * 1.9082149292705877e-10;
    double p = 1.0 / 6227020800.0;
    p = p * r + 1.0 / 479001600.0; p = p * r + 1.0 / 39916800.0; p = p * r + 1.0 / 3628800.0; p = p * r + 1.0 / 362880.0; p = p * r + 1.0 / 40320.0; p = p * r + 1.0 / 5040.0;
    p = p * r + 1.0 / 720.0; p = p * r + 1.0 / 120.0; p = p * r + 1.0 / 24.0; p = p * r + 1.0 / 6.0; p = p * r + 0.5; p = p * r + 1.0; p = p * r + 1.0;
    const long long bits = (long long)(1023 + (int)k) << 52; return p * __builtin_bit_cast(double, bits);
}
__device__ __forceinline__ void dsincos_(double x, double& s, double& c) {
    const double k = rint(x * 0.6366197723675814); const double r = (x - k * 1.5707963267948966) - k * 6.123233995736766e-17; const double r2 = r * r;
    const double sp = r * (1.0 + r2 * (-1.0 / 6.0 + r2 * (1.0 / 120.0 + r2 * (-1.0 / 5040.0 + r2 * (1.0 / 362880.0 + r2 * (-1.0 / 39916800.0 + r2 * (1.0 / 6227020800.0)))))));
    const double cp = 1.0 + r2 * (-0.5 + r2 * (1.0 / 24.0 + r2 * (-1.0 / 720.0 + r2 * (1.0 / 40320.0 + r2 * (-1.0 / 3628800.0 + r2 * (1.0 / 479001600.0 + r2 * (-1.0 / 87178291200.0)))))));
    const int q = ((int)k) & 3;
    s = q == 0 ? sp : q == 1 ? cp : q == 2 ? -sp : -cp; c = q == 0 ? cp : q == 1 ? -sp : q == 2 ? -cp : sp;
}

__device__ __forceinline__ const bf16* kvptr(const bf16* proj, const bf16* cb, int sample, int b, int c, int kvh, int kk, int isv) {
    if (!sample) { int pos = (c - 2) * 64 + kk; pos = pos < 0 ? 0 : pos; return proj + (size_t)(b * 4096 + pos) * 1280 + 1024 + isv * 128 + kvh * 64; }
    if (kk < 128) return cb + (size_t)(b * 128 + kk) * 128 + kvh * 64;
    int t = kk - 128; t = t > 31 ? 31 : t; return proj + (size_t)(MP + b * 32 + t) * 1280 + 1024 + isv * 128 + kvh * 64;
}
__device__ __forceinline__ void swa_phase(const bf16* proj, const bf16* ckb, const bf16* cvb, const float* sinks, bf16* ycat, LAS unsigned char* lds, int tid, int wave, int lane, int G) {
    LAS bf16* VT = (LAS bf16*)lds;
    const int fr = lane & 15, quad = lane >> 4;
    for (int it = blockIdx.x; it < 528; it += G) {
        int b, c, kvh, sample;
        if (it < 512) { sample = 0; b = it >> 7; c = (it >> 1) & 63; kvh = it & 1; } else { sample = 1; b = (it - 512) >> 1; c = 0; kvh = it & 1; }
        const int gq = wave >> 1, qhalf = wave & 1, head = kvh * 4 + gq;
        bf16x8 qf[2][2], kf0[4][2];
#pragma unroll
        for (int qb = 0; qb < 2; ++qb) { const int q = qhalf * 32 + qb * 16 + fr; const int row = sample ? MP + b * 32 + (q & 31) : b * 4096 + c * 64 + q;
            const GAS bf16* qp = (const GAS bf16*)proj + (size_t)row * 1280 + 512 + head * 64 + quad * 8; qf[qb][0] = *(const GAS bf16x8*)qp; qf[qb][1] = *(const GAS bf16x8*)(qp + 32); }
#pragma unroll
        for (int i = 0; i < 4; ++i) { const int key = 32 * (i >> 1) + (fr >> 2) * 8 + 4 * (i & 1) + (fr & 3); const GAS bf16* kp = (const GAS bf16*)kvptr(proj, ckb, sample, b, c, kvh, key, 0) + quad * 8;
            kf0[i][0] = *(const GAS bf16x8*)kp; kf0[i][1] = *(const GAS bf16x8*)(kp + 32); }
        __syncthreads();
#pragma unroll
        for (int i = 0; i < 3; ++i) { const int idx = tid + 512 * i, kk = idx % 192, dg = idx / 192; const v4u w = *(const GAS v4u*)((const GAS bf16*)kvptr(proj, cvb, sample, b, c, kvh, kk, 1) + dg * 8);
            LAS bf16* vp = VT + (dg * 8) * 200 + kk;
            vp[0] = (bf16)(w.x & 0xffffu); vp[200] = (bf16)(w.x >> 16); vp[400] = (bf16)(w.y & 0xffffu); vp[600] = (bf16)(w.y >> 16);
            vp[800] = (bf16)(w.z & 0xffffu); vp[1000] = (bf16)(w.z >> 16); vp[1200] = (bf16)(w.w & 0xffffu); vp[1400] = (bf16)(w.w >> 16); }
        __syncthreads();
        if (!(sample && qhalf)) {
            const int plo = sample ? 0 : (c >= 2 ? 0 : (2 - c) * 2), phi = sample ? 5 : 6;
            f32x4 s[12][2];
#pragma unroll
            for (int kg = 0; kg < 3; ++kg) { bf16x8 kf[4][2];
#pragma unroll
                for (int i = 0; i < 4; ++i) { if (kg == 0) { kf[i][0] = kf0[i][0]; kf[i][1] = kf0[i][1]; continue; } const int kb = kg * 4 + i, key = 32 * (kb >> 1) + (fr >> 2) * 8 + 4 * (kb & 1) + (fr & 3); const GAS bf16* kp = (const GAS bf16*)kvptr(proj, ckb, sample, b, c, kvh, key, 0) + quad * 8;
                    kf[i][0] = *(const GAS bf16x8*)kp; kf[i][1] = *(const GAS bf16x8*)(kp + 32); }
                __builtin_amdgcn_sched_barrier(0);
#pragma unroll
                for (int i = 0; i < 4; ++i)
#pragma unroll
                    for (int qb = 0; qb < 2; ++qb) { f32x4 a = {0.f, 0.f, 0.f, 0.f}; a = MFMA16(kf[i][0], qf[qb][0], a); a = MFMA16(kf[i][1], qf[qb][1], a); s[kg * 4 + i][qb] = a; }
                __builtin_amdgcn_sched_barrier(0); }
            const float sink = sinks[head];
            bf16x8 pf[6][2];
#pragma unroll
            for (int qb = 0; qb < 2; ++qb) { float mx = sink;
#pragma unroll
                for (int kb = 0; kb < 12; ++kb) { const bool pv = (kb >> 1) >= plo && (kb >> 1) < phi;
#pragma unroll
                    for (int j = 0; j < 4; ++j) { const float v = pv ? s[kb][qb][j] : -1e30f; s[kb][qb][j] = v; mx = fmaxf(mx, v); } }
                mx = fmaxf(mx, __shfl_xor(mx, 16)); mx = fmaxf(mx, __shfl_xor(mx, 32));
                float sum = 0.f;
#pragma unroll
                for (int kb = 0; kb < 12; ++kb)
#pragma unroll
                    for (int j = 0; j < 4; ++j) { const float e = __expf(s[kb][qb][j] - mx); s[kb][qb][j] = e; sum += e; }
                sum += __shfl_xor(sum, 16); sum += __shfl_xor(sum, 32); sum += __expf(sink - mx);
                const float inv = 1.0f / sum;
#pragma unroll
                for (int pr = 0; pr < 6; ++pr) pf[pr][qb] = __builtin_bit_cast(bf16x8, pack8(s[2 * pr][qb] * inv, s[2 * pr + 1][qb] * inv)); }
#pragma unroll
            for (int db = 0; db < 4; ++db) { bf16x8 vf[6];
#pragma unroll
                for (int pr = 0; pr < 6; ++pr) vf[pr] = *(const LAS bf16x8*)(VT + (db * 16 + fr) * 200 + 32 * pr + quad * 8);
#pragma unroll
                for (int qb = 0; qb < 2; ++qb) { f32x4 o = {0.f, 0.f, 0.f, 0.f};
#pragma unroll
                    for (int pr = 0; pr < 6; ++pr) o = MFMA16(pf[pr][qb], vf[pr], o);
#pragma unroll
                    for (int j = 0; j < 4; ++j) { const int q = qhalf * 32 + qb * 16 + quad * 4 + j;
                        if (!sample || q < 32) { const int row = sample ? MP + b * 32 + q : b * 4096 + c * 64 + q; ycat[(size_t)row * 1024 + 512 + head * 64 + db * 16 + fr] = (bf16)f2bf(o[j]); } } } }
        }
    }
    __syncthreads();
}

__device__ __forceinline__ void xattn_phase(const bf16* qx, const bf16* memk_l, const bf16* memvT_l, bf16* ox, int wave, int lane, int G) {
    const int fr = lane & 15, quad = lane >> 4;
    for (int t = wave * G + (int)blockIdx.x; t < 4160; t += 8 * G) {
        int bb, h, row0;
        if (t < 4096) { const int pair = t >> 8; bb = pair >> 2; h = pair & 3; row0 = bb * 4096 + (t & 255) * 16; }
        else { const int s = t - 4096, b = s >> 3; h = (s >> 1) & 3; bb = 4 + b; row0 = MP + b * 32 + (s & 1) * 16; }
        bf16x8 qf[8];
#pragma unroll
        for (int ks = 0; ks < 8; ++ks) qf[ks] = *(const bf16x8*)(qx + (size_t)(row0 + fr) * 1024 + h * 256 + ks * 32 + quad * 8);
        const bf16* kbase = memk_l + (size_t)bb * 262144 + h * 256 + quad * 8;
        f32x4 s[16];
#pragma unroll
        for (int kb = 0; kb < 16; ++kb) { const int key = 32 * (kb >> 1) + (fr >> 2) * 8 + 4 * (kb & 1) + (fr & 3); const bf16* kp = kbase + (size_t)key * 1024; f32x4 a = {0.f, 0.f, 0.f, 0.f};
#pragma unroll
            for (int ks = 0; ks < 8; ++ks) a = MFMA16(*(const bf16x8*)(kp + ks * 32), qf[ks], a);
            s[kb] = a; }
        float mx = -1e30f;
#pragma unroll
        for (int kb = 0; kb < 16; ++kb)
#pragma unroll
            for (int j = 0; j < 4; ++j) mx = fmaxf(mx, s[kb][j]);
        mx = fmaxf(mx, __shfl_xor(mx, 16)); mx = fmaxf(mx, __shfl_xor(mx, 32));
        float sum = 0.f;
#pragma unroll
        for (int kb = 0; kb < 16; ++kb)
#pragma unroll
            for (int j = 0; j < 4; ++j) { const float e = __expf(s[kb][j] - mx); s[kb][j] = e; sum += e; }
        sum += __shfl_xor(sum, 16); sum += __shfl_xor(sum, 32);
        const float inv = 1.0f / sum;
        bf16x8 pf[8];
#pragma unroll
        for (int pr = 0; pr < 8; ++pr) pf[pr] = __builtin_bit_cast(bf16x8, pack8(s[2 * pr] * inv, s[2 * pr + 1] * inv));
        const bf16* vbase = memvT_l + (size_t)bb * 262144 + (size_t)(h * 256 + fr) * 256 + quad * 8;
#pragma unroll 4
        for (int db = 0; db < 16; ++db) { f32x4 o = {0.f, 0.f, 0.f, 0.f};
#pragma unroll
            for (int pr = 0; pr < 8; ++pr) o = MFMA16(pf[pr], *(const bf16x8*)(vbase + (size_t)db * 4096 + pr * 32), o);
#pragma unroll
            for (int j = 0; j < 4; ++j) ox[(size_t)(row0 + quad * 4 + j) * 1024 + h * 256 + db * 16 + fr] = (bf16)f2bf(o[j]); }
    }
}


__device__ __forceinline__ void xstage(const bf16* src, size_t rowstride, LAS unsigned char* lds, int tid) {
    v4u t[16];
#pragma unroll
    for (int i = 0; i < 16; ++i) { const int row = (tid >> 5) + 16 * i, ch = tid & 31; t[i] = *(const GAS v4u*)((const GAS bf16*)src + (size_t)row * rowstride + ch * 8); }
#pragma unroll
    for (int i = 0; i < 16; ++i) { const int row = (tid >> 5) + 16 * i, ch = tid & 31; *(LAS v4u*)(lds + row * 528 + ch * 16) = t[i]; }
}
__device__ __forceinline__ void xattn_phase2(const bf16* qx, const bf16* memk_l, const bf16* memvT_l, bf16* ox, LAS unsigned char* lds, int tid, int wave, int lane, int G) {
    const int fr = lane & 15, quad = lane >> 4;
    for (int it = blockIdx.x; it < 256 + 32; it += G) {
        int bb, h, rowbase, nqb; bool active;
        if (it < 256) { bb = it >> 6; h = (it >> 4) & 3; rowbase = bb * 4096 + (it & 15) * 256; nqb = 2; active = true; }
        else { const int s = it - 256, b = s >> 2; h = s & 3; bb = 4 + b; rowbase = MP + b * 32; nqb = 1; active = wave < 2; }
        __syncthreads();
        xstage(memk_l + (size_t)bb * 262144 + h * 256, 1024, lds, tid);
        __syncthreads();
        bf16x8 pf[2][8];
#pragma unroll
        for (int qi = 0; qi < 2; ++qi) {
            if (qi < nqb && active) {
                const int row0 = rowbase + qi * 128 + wave * 16;
                bf16x8 qf[8];
#pragma unroll
                for (int ks = 0; ks < 8; ++ks) qf[ks] = __builtin_nontemporal_load((const GAS bf16x8*)((const GAS bf16*)qx + (size_t)(row0 + fr) * 1024 + h * 256 + ks * 32 + quad * 8));
                f32x4 s[16];
#pragma unroll
                for (int kb = 0; kb < 16; ++kb) { const int key = 32 * (kb >> 1) + (fr >> 2) * 8 + 4 * (kb & 1) + (fr & 3); const LAS unsigned char* kp = lds + key * 528 + quad * 16; f32x4 a = {0.f, 0.f, 0.f, 0.f};
#pragma unroll
                    for (int ks = 0; ks < 8; ++ks) a = MFMA16(*(const LAS bf16x8*)(kp + ks * 64), qf[ks], a);
                    s[kb] = a; }
                float mx = -1e30f;
#pragma unroll
                for (int kb = 0; kb < 16; ++kb)
#pragma unroll
                    for (int j = 0; j < 4; ++j) mx = fmaxf(mx, s[kb][j]);
                mx = fmaxf(mx, __shfl_xor(mx, 16)); mx = fmaxf(mx, __shfl_xor(mx, 32));
                float sum = 0.f;
#pragma unroll
                for (int kb = 0; kb < 16; ++kb)
#pragma unroll
                    for (int j = 0; j < 4; ++j) { const float e = __expf(s[kb][j] - mx); s[kb][j] = e; sum += e; }
                sum += __shfl_xor(sum, 16); sum += __shfl_xor(sum, 32);
                const float inv = 1.0f / sum;
#pragma unroll
                for (int pr = 0; pr < 8; ++pr) pf[qi][pr] = __builtin_bit_cast(bf16x8, pack8(s[2 * pr] * inv, s[2 * pr + 1] * inv));
            }
        }
        __syncthreads();
        xstage(memvT_l + (size_t)bb * 262144 + (size_t)h * 65536, 256, lds, tid);
        __syncthreads();
        if (active) {
            const int rowA = rowbase + wave * 16, rowB = rowA + 128;
#pragma unroll 4
            for (int db = 0; db < 16; ++db) { f32x4 oa = {0.f, 0.f, 0.f, 0.f}, ob = {0.f, 0.f, 0.f, 0.f}; const LAS unsigned char* vp = lds + (db * 16 + fr) * 528 + quad * 16;
                if (nqb == 2) {
#pragma unroll
                    for (int pr = 0; pr < 8; ++pr) { const bf16x8 vf = *(const LAS bf16x8*)(vp + pr * 64); oa = MFMA16(vf, pf[0][pr], oa); ob = MFMA16(vf, pf[1][pr], ob); }
                } else {
#pragma unroll
                    for (int pr = 0; pr < 8; ++pr) { const bf16x8 vf = *(const LAS bf16x8*)(vp + pr * 64); oa = MFMA16(vf, pf[0][pr], oa); }
                }
                u32x2v w; w.x = pk2(oa[0], oa[1]); w.y = pk2(oa[2], oa[3]);
                *(GAS u32x2v*)((GAS bf16*)ox + (size_t)(rowA + fr) * 1024 + h * 256 + db * 16 + quad * 4) = w;
                if (nqb == 2) { u32x2v w2; w2.x = pk2(ob[0], ob[1]); w2.y = pk2(ob[2], ob[3]); *(GAS u32x2v*)((GAS bf16*)ox + (size_t)(rowB + fr) * 1024 + h * 256 + db * 16 + quad * 4) = w2; } }
        }
    }
    __syncthreads();
}

__device__ __forceinline__ void s5_stage_u(const bf16* up, LAS float* ubuf, int lane) {
    const v4u w0 = *(const v4u*)up, w1 = *(const v4u*)(up + 8);
    LAS f32x4* d = (LAS f32x4*)(ubuf + lane * 16);
    d[0] = (f32x4){bflo(w0.x), bfhi(w0.x), bflo(w0.y), bfhi(w0.y)}; d[1] = (f32x4){bflo(w0.z), bfhi(w0.z), bflo(w0.w), bfhi(w0.w)};
    d[2] = (f32x4){bflo(w1.x), bfhi(w1.x), bflo(w1.y), bfhi(w1.y)}; d[3] = (f32x4){bflo(w1.z), bfhi(w1.z), bflo(w1.w), bfhi(w1.w)};
}
__device__ __forceinline__ f32x2v lo2_(f32x4 v) { return __builtin_shufflevector(v, v, 0, 1); }
__device__ __forceinline__ f32x2v hi2_(f32x4 v) { return __builtin_shufflevector(v, v, 2, 3); }
#define S5_STEP(sidx) do { const LAS f32x4* up_ = (const LAS f32x4*)(ubuf + (sidx) * 16); const f32x4 u0 = up_[0], u1 = up_[1], u2 = up_[2], u3 = up_[3]; \
    f32x2v ac_ = lo2_(bb[0]) * u0[0]; ac_ = hi2_(bb[0]) * u0[1] + ac_; ac_ = lo2_(bb[1]) * u0[2] + ac_; ac_ = hi2_(bb[1]) * u0[3] + ac_; \
    ac_ = lo2_(bb[2]) * u1[0] + ac_; ac_ = hi2_(bb[2]) * u1[1] + ac_; ac_ = lo2_(bb[3]) * u1[2] + ac_; ac_ = hi2_(bb[3]) * u1[3] + ac_; \
    ac_ = lo2_(bb[4]) * u2[0] + ac_; ac_ = hi2_(bb[4]) * u2[1] + ac_; ac_ = lo2_(bb[5]) * u2[2] + ac_; ac_ = hi2_(bb[5]) * u2[3] + ac_; \
    ac_ = lo2_(bb[6]) * u3[0] + ac_; ac_ = hi2_(bb[6]) * u3[1] + ac_; ac_ = lo2_(bb[7]) * u3[2] + ac_; ac_ = hi2_(bb[7]) * u3[3] + ac_; \
    const float nr_ = ar * hr - ai * hi + ac_.x, ni_ = ar * hi + ai * hr + ac_.y; hr = nr_; hi = ni_; } while (0)

typedef short bf16x4_t __attribute__((ext_vector_type(4)));
#define MFMA16K16(a, b, c) __builtin_amdgcn_mfma_f32_16x16x16bf16_1k(a, b, c, 0, 0, 0)
__device__ __forceinline__ bf16x4_t s5_load_u(const bf16* urow0, int fr, int quad) { return *(const GAS bf16x4_t*)((const GAS bf16*)urow0 + (size_t)fr * 1280 + quad * 4); }
__device__ __forceinline__ void s5_bu_block(const bf16x4_t a, const bf16x4_t (&bcf)[8], LAS float* bul, int fr, int quad) {
#pragma unroll
    for (int cb = 0; cb < 8; ++cb) { f32x4 d = {0.f, 0.f, 0.f, 0.f}; d = MFMA16K16(a, bcf[cb], d);
#pragma unroll
        for (int j = 0; j < 4; ++j) bul[(quad * 4 + j) * 130 + cb * 16 + fr] = d[j]; }
}
__device__ __forceinline__ void s5_local(const bf16* proj, const float* abar, const bf16* bbt, float* sloc, LAS float* bul, int slot, int nslots, int lane) {
    const int fr = lane & 15, quad = lane >> 4;
    for (int t = slot; t < 8192; t += nslots) {
        const int chunk = t & 63, g = (t >> 6) & 31, b = t >> 11;
        const float ar = abar[(g * 64 + lane) * 2], ai = abar[(g * 64 + lane) * 2 + 1];
        bf16x4_t bcf[8];
#pragma unroll
        for (int cb = 0; cb < 8; ++cb) bcf[cb] = *(const GAS bf16x4_t*)((const GAS bf16*)bbt + (size_t)(g * 128 + cb * 16 + fr) * 16 + quad * 4);
        float hr = 0.f, hi = 0.f;
        bf16x4_t ua[4];
#pragma unroll
        for (int blk = 0; blk < 4; ++blk) ua[blk] = s5_load_u(proj + (size_t)(b * 4096 + chunk * 64 + blk * 16) * 1280 + g * 16, fr, quad);
#pragma unroll
        for (int blk = 0; blk < 4; ++blk) {
            s5_bu_block(ua[blk], bcf, bul, fr, quad);
#pragma unroll 4
            for (int s = 0; s < 16; ++s) { const f32x2v bu = *(const LAS f32x2v*)(bul + s * 130 + 2 * lane); const float nr = ar * hr - ai * hi + bu.x, ni = ar * hi + ai * hr + bu.y; hr = nr; hi = ni; }
        }
        *(f32x2v*)(sloc + (size_t)t * 128 + lane * 2) = (f32x2v){hr, hi};
    }
}
__device__ __forceinline__ void s5_out(const bf16* proj, const float* abar, const bf16* bbt, const float* sloc, const float* st_re, const float* st_im, const float* c_re, const float* c_im,
                                       const float* dcoef, bf16* gbuf, float* out, LAS float* bul, LAS unsigned* hbuf, int slot, int nslots, int lane) {
    const int fr = lane & 15, quad = lane >> 4;
    for (int t = slot; t < 8192 + 256; t += nslots) {
        const int sample = t >= 8192; int b, g, chunk, nblk, rowbase;
        if (!sample) { chunk = t & 63; g = (t >> 6) & 31; b = t >> 11; nblk = 4; rowbase = b * 4096 + chunk * 64; } else { const int s = t - 8192; g = s & 31; b = s >> 5; chunk = 0; nblk = 2; rowbase = MP + b * 32; }
        const float ar = abar[(g * 64 + lane) * 2], ai = abar[(g * 64 + lane) * 2 + 1];
        bf16x4_t bcf[8];
#pragma unroll
        for (int cb = 0; cb < 8; ++cb) bcf[cb] = *(const GAS bf16x4_t*)((const GAS bf16*)bbt + (size_t)(g * 128 + cb * 16 + fr) * 16 + quad * 4);
        float hr, hi;
        if (!sample) { float pr = ar, pi = ai;
#pragma unroll
            for (int i = 0; i < 6; ++i) { const float t1 = pr * pr - pi * pi; pi = 2.f * pr * pi; pr = t1; }
            hr = 0.f; hi = 0.f; const float* sp = sloc + (size_t)(t - chunk) * 128 + lane * 2;
#pragma unroll 16
            for (int cc = 0; cc < chunk; ++cc) { const f32x2v sv = *(const f32x2v*)(sp + (size_t)cc * 128); const float nr = pr * hr - pi * hi + sv.x, ni = pr * hi + pi * hr + sv.y; hr = nr; hi = ni; } }
        else { hr = st_re[(b * 32 + g) * 64 + lane]; hi = st_im[(b * 32 + g) * 64 + lane]; }
        bf16x8 cf[4];
#pragma unroll
        for (int ks = 0; ks < 4; ++ks) { const f32x4 cr = *(const f32x4*)(c_re + (size_t)(g * 16 + fr) * 64 + ks * 16 + quad * 4), ci = *(const f32x4*)(c_im + (size_t)(g * 16 + fr) * 64 + ks * 16 + quad * 4);
            v4u w; w.x = pg8::cvt_pk_bf16(cr[0], -ci[0]); w.y = pg8::cvt_pk_bf16(cr[1], -ci[1]); w.z = pg8::cvt_pk_bf16(cr[2], -ci[2]); w.w = pg8::cvt_pk_bf16(cr[3], -ci[3]); cf[ks] = __builtin_bit_cast(bf16x8, w); }
        const float dco = dcoef[g * 16 + fr];
        bf16x4_t ua[4]; bf16 uraw[4][4];
#pragma unroll
        for (int blk = 0; blk < 4; ++blk) { const int bc = blk < nblk ? blk : nblk - 1; const bf16* urow0 = proj + (size_t)(rowbase + bc * 16) * 1280 + g * 16; ua[blk] = s5_load_u(urow0, fr, quad);
#pragma unroll
            for (int j = 0; j < 4; ++j) uraw[blk][j] = ((const GAS bf16*)urow0)[(size_t)(quad * 4 + j) * 1280 + fr]; }
#pragma unroll
        for (int blk = 0; blk < 4; ++blk) { if (blk < nblk) {
            s5_bu_block(ua[blk], bcf, bul, fr, quad);
#pragma unroll 4
            for (int s = 0; s < 16; ++s) { const f32x2v bu = *(const LAS f32x2v*)(bul + s * 130 + 2 * lane); const float nr = ar * hr - ai * hi + bu.x, ni = ar * hi + ai * hr + bu.y; hr = nr; hi = ni; hbuf[s * 68 + lane] = pg8::cvt_pk_bf16(hr, hi); }
            f32x4 y = {0.f, 0.f, 0.f, 0.f};
#pragma unroll
            for (int ks = 0; ks < 4; ++ks) { const bf16x8 a = *(const LAS bf16x8*)(hbuf + fr * 68 + ks * 16 + quad * 4); y = MFMA16(a, cf[ks], y); }
#pragma unroll
            for (int j = 0; j < 4; ++j) { const int s = blk * 16 + quad * 4 + j; const float uu = bflo((unsigned)uraw[blk][j]); const float yv = y[j] + dco * uu;
                const float z = 0.7978845608028654f * (yv + 0.044715f * yv * yv * yv); const float th = 1.0f - 2.0f / (1.0f + __expf(2.0f * z)); const float gl = 0.5f * yv * (1.0f + th);
                ((GAS bf16*)gbuf)[(size_t)(rowbase + s) * 512 + g * 16 + fr] = (bf16)f2bf(gl); }
        } }
        if (!sample && chunk == 63) { out[OFF_SRP + (b * 32 + g) * 64 + lane] = hr; out[OFF_SIP + (b * 32 + g) * 64 + lane] = hi; }
        if (sample) { out[OFF_SRS + (b * 32 + g) * 64 + lane] = hr; out[OFF_SIS + (b * 32 + g) * 64 + lane] = hi; }
    }
}

template <int KIND>
__device__ __forceinline__ void sample_gemm(const bf16* A, const bf16* Bt, int K, LAS unsigned char* lds, int tid, int wave, int lane,
                                            bf16* xbp, const float* base_f32, float* part_next, const float* part_cur, bf16* O) {
    const int fr = lane & 15, quad = lane >> 4;
    LAS f32x4* red = (LAS f32x4*)lds;
    LAS float* ssred = (LAS float*)(lds + 32768);
    for (int tile = blockIdx.x; tile < 256; tile += gridDim.x) {
        const int r0 = MP + (tile >> 4) * 16, c0 = (tile & 15) * 64, kw = K >> 3;
        const bf16* ap = A + (size_t)(r0 + fr) * K + wave * kw + quad * 8;
        const bf16* bp = Bt + (size_t)(c0 + fr) * K + wave * kw + quad * 8;
        f32x4 acc[4];
#pragma unroll
        for (int cb = 0; cb < 4; ++cb) acc[cb] = (f32x4){0.f, 0.f, 0.f, 0.f};
        const int e_cb = (tid >> 6) & 3, e_l2 = tid & 63, e_row = r0 + (e_l2 & 15), e_col = c0 + e_cb * 16 + 4 * (e_l2 >> 4); const size_t e_off = (size_t)e_row * 1024 + e_col;
        f32x4 e_bs = {0.f, 0.f, 0.f, 0.f}; float e_rs = 1.f;
        if (tid < 256) { if (KIND == 0) { if (base_f32) e_bs = *(const f32x4*)(base_f32 + e_off); else { const u32x2v w = *(const u32x2v*)(xbp + e_off); e_bs = (f32x4){bflo(w.x), bfhi(w.x), bflo(w.y), bfhi(w.y)}; } }
                         else e_rs = rstd_of(part_cur, e_row); }
        const int nks = kw >> 5;
        for (int k0 = 0; k0 < nks; k0 += 4) {
            bf16x8 a[4], b[4][4];
#pragma unroll
            for (int i = 0; i < 4; ++i) { const int ks = (k0 + i < nks) ? k0 + i : nks - 1;
                a[i] = *(const bf16x8*)(ap + ks * 32);
#pragma unroll
                for (int cb = 0; cb < 4; ++cb) b[i][cb] = *(const bf16x8*)(bp + (size_t)cb * 16 * K + ks * 32); }
            __builtin_amdgcn_sched_barrier(0);
#pragma unroll
            for (int i = 0; i < 4; ++i) if (k0 + i < nks) {
#pragma unroll
                for (int cb = 0; cb < 4; ++cb) acc[cb] = MFMA16(b[i][cb], a[i], acc[cb]); }
        }
#pragma unroll
        for (int cb = 0; cb < 4; ++cb) red[(wave * 4 + cb) * 64 + lane] = acc[cb] * 1.0f;
        __syncthreads();
        if (tid < 256) { const int cb = tid >> 6, l2 = tid & 63; f32x4 v = red[cb * 64 + l2];
#pragma unroll
            for (int w = 1; w < 8; ++w) v = v + red[(w * 4 + cb) * 64 + l2];
            const int row = r0 + (l2 & 15), col = c0 + cb * 16 + 4 * (l2 >> 4); const size_t off = (size_t)row * 1024 + col;
            if (KIND == 0) {
                v = v + e_bs; u32x2v o; o.x = pk2(v[0], v[1]); o.y = pk2(v[2], v[3]); *(u32x2v*)(xbp + off) = o;
                float ss = (v[0] * v[0] + v[1] * v[1]) + (v[2] * v[2] + v[3] * v[3]); ss += __shfl_xor(ss, 16); ss += __shfl_xor(ss, 32);
                if ((l2 >> 4) == 0) ssred[cb * 16 + (l2 & 15)] = ss; }
            else { const float rs = e_rs; u32x2v o; o.x = pk2(v[0] * rs, v[1] * rs); o.y = pk2(v[2] * rs, v[3] * rs); *(u32x2v*)(O + off) = o; }
        }
        if (KIND == 0) { __syncthreads(); if (tid < 16) part_next[(size_t)(r0 + tid) * 16 + (tile & 15)] = (ssred[tid] + ssred[16 + tid]) + (ssred[32 + tid] + ssred[48 + tid]); }
        __syncthreads();
    }
}


__device__ __forceinline__ void sample_cz(const bf16* A, const bf16* Bt, LAS unsigned char* lds, int tid, int wave, int lane,
                                          const float* part_cur, const float* cw, const float* st, bf16* zcp, float* outp) {
    const int fr = lane & 15, quad = lane >> 4;
    LAS f32x4* red = (LAS f32x4*)lds;
    LAS float* T = (LAS float*)(lds + 65536);
    LAS float* CZ = (LAS float*)(lds + 65536 + 8192);
    for (int tile = blockIdx.x; tile < 256; tile += gridDim.x) {
        const int b = tile >> 5, c0 = (tile & 31) * 32, r0 = MP + b * 32;
        const int wrow = 1024 + (c0 >> 7) * 256 + (c0 & 127);
        const GAS bf16* ap = (const GAS bf16*)A + (size_t)(r0 + fr) * 1024 + wave * 128 + quad * 8;
        const GAS bf16* bp = (const GAS bf16*)Bt + (size_t)(wrow + fr) * 1024 + wave * 128 + quad * 8;
        bf16x8 a[4][2], bw[4][4];
#pragma unroll
        for (int ks = 0; ks < 4; ++ks) {
#pragma unroll
            for (int rb = 0; rb < 2; ++rb) a[ks][rb] = *(const GAS bf16x8*)(ap + (size_t)rb * 16 * 1024 + ks * 32);
#pragma unroll
            for (int cb = 0; cb < 4; ++cb) bw[ks][cb] = *(const GAS bf16x8*)(bp + (size_t)((cb >> 1) * 128 + (cb & 1) * 16) * 1024 + ks * 32); }
        f32x4 acc[2][4];
#pragma unroll
        for (int rb = 0; rb < 2; ++rb)
#pragma unroll
            for (int cb = 0; cb < 4; ++cb) { f32x4 d = {0.f, 0.f, 0.f, 0.f};
#pragma unroll
                for (int ks = 0; ks < 4; ++ks) d = MFMA16(bw[ks][cb], a[ks][rb], d);
                acc[rb][cb] = d; }
#pragma unroll
        for (int rb = 0; rb < 2; ++rb)
#pragma unroll
            for (int cb = 0; cb < 4; ++cb) red[(wave * 8 + rb * 4 + cb) * 64 + lane] = acc[rb][cb];
        __syncthreads();
        {
            const int blk = tid >> 6, l2 = tid & 63, rb = blk >> 2, cb = blk & 3; f32x4 v = red[blk * 64 + l2];
#pragma unroll
            for (int w = 1; w < 8; ++w) v = v + red[(w * 8 + blk) * 64 + l2];
            *(LAS f32x4*)(T + ((cb >> 1) * 32 + rb * 16 + (l2 & 15)) * 32 + (cb & 1) * 16 + 4 * (l2 >> 4)) = v; }
        __syncthreads();
        const int r = tid >> 3, cq = (tid & 7) * 4;
        if (tid < 256) { const float rs = rstd_of(part_cur, r0 + r); const float rs2 = rs * rs;
            const f32x4 gc = *(const LAS f32x4*)(T + r * 32 + cq), zz = *(const LAS f32x4*)(T + (32 + r) * 32 + cq);
            *(LAS f32x4*)(CZ + r * 32 + cq) = gc * zz * rs2; }
        __syncthreads();
        if (tid < 256) { const int c = c0 + cq;
            const f32x4 x0 = *(const LAS f32x4*)(CZ + r * 32 + cq);
            const f32x4 s0 = *(const f32x4*)(st + (size_t)(b * 2) * 1024 + c), s1 = *(const f32x4*)(st + (size_t)(b * 2 + 1) * 1024 + c);
            f32x4 xm1 = s1, xm2 = s0;
            if (r >= 1) { xm1 = *(const LAS f32x4*)(CZ + (r - 1) * 32 + cq); xm2 = s1; }
            if (r >= 2) xm2 = *(const LAS f32x4*)(CZ + (r - 2) * 32 + cq);
            const f32x4 w0 = *(const f32x4*)(cw + c), w1 = *(const f32x4*)(cw + 1024 + c), w2 = *(const f32x4*)(cw + 2048 + c);
            const f32x4 z = w0 * xm2 + w1 * xm1 + w2 * x0;
            bf16* gp = zcp + (size_t)(r0 + r) * 1024 + c; const u32x2v gw = *(const u32x2v*)gp;
            u32x2v o; o.x = pk2(z[0] * bflo(gw.x), z[1] * bfhi(gw.x)); o.y = pk2(z[2] * bflo(gw.y), z[3] * bfhi(gw.y)); *(u32x2v*)gp = o;
            if (r >= 30) *(f32x4*)(outp + OFF_CMS + (size_t)(b * 2 + (r - 30)) * 1024 + c) = x0; }
        __syncthreads();
    }
}

struct Params { const float* in[36]; float* out; unsigned char* ws; int use_cg, pad; };

__global__ void __launch_bounds__(512, 2) mega_fwd(Params P) {
    extern __shared__ __attribute__((aligned(16))) unsigned char lds_raw[];
    LAS unsigned char* lds = (LAS unsigned char*)lds_raw;
    volatile LAS unsigned* MISC = (volatile LAS unsigned*)(lds + MISC_OFF);
    const int G = gridDim.x, NGW = G * 8, NT = G * 512;
    const int wave_s = __builtin_amdgcn_readfirstlane(threadIdx.x >> 6);
    for (int u = threadIdx.x; u < (LDS_BYTES - 131072) / 4; u += 512) ((LAS unsigned*)(lds + 131072))[u] = 0u;
    __syncthreads();
    XcdBarrier bar = xcd_barrier_post((unsigned*)(P.ws + WS_BAR), MISC + 8);
#ifndef STOP_AFTER
#define STOP_AFTER 1000
#endif
    int ph = 0;
#define RUN (ph < STOP_AFTER)
#define FRESH() const int tid = fresh_tid(wave_s), lane = tid & 63, wave = __builtin_amdgcn_readfirstlane(tid >> 6); const int gw = blockIdx.x * 8 + wave, gt = blockIdx.x * 512 + tid; (void)gw; (void)gt; (void)lane; LAS float* wscr = (LAS float*)(lds + 32768 + wave * 12288); (void)wscr;
#define SEAM() do { if (P.use_cg) cg::this_grid().sync(); else xcd_barrier(bar); ++ph; } while (0)

#define part ((float*)(ws + WS_PART))
#define PARTBUF(k) (part + (size_t)((k) & 1) * PART_ELEMS)
#define ropec ((float*)(ws + WS_ROPE))
#define ropes (ropec + 4096 * 32)
#define abar ((float*)(ws + WS_SSM))
#define bbar (abar + 32 * 64 * 2)
#define bbt ((bf16*)(bbar + 32 * 64 * 32))
#define ckb ((bf16*)(ws + WS_CKV))
#define cvb (ckb + 8 * 128 * 128)
#define sloc ((float*)(ws + WS_SLOC))
#define memk ((bf16*)(ws + WS_MEMK))
#define memvT ((bf16*)(ws + WS_MEMVT))
#define SG ((float*)(ws + WS_SIDE))
#define SV ((float*)(ws + WS_SIDE + SG_BYTES))
#define WT ((bf16*)(ws + WS_WT))
#define xb ((bf16*)(ws + WS_XB))
#define tmp (ws + WS_TMP)
#define proj0 ((bf16*)(tmp + TMP_PROJ0))
#define gbuf ((bf16*)(tmp + TMP_GBUF))
#define ycat ((bf16*)(tmp + TMP_YCAT))
#define memb ((bf16*)(tmp + TMP_MEMB))
#define qx ((bf16*)(tmp + TMP_QX))
#define ox ((bf16*)(tmp + TMP_OX))
#define act ((bf16*)(tmp + TMP_ACT))
#define gbm ((bf16*)(tmp + TMP_GB))
#define zc ((bf16*)(tmp + TMP_ZC))
#define PTRS() GAS unsigned char* wsg_ = (GAS unsigned char*)P.ws; GAS float* outg_ = (GAS float*)P.out; asm volatile("" : "+s"(wsg_), "+s"(outg_)); unsigned char* ws = (unsigned char*)wsg_; float* out = (float*)outg_;
    if (RUN) { PTRS() FRESH()
        {
            constexpr int NITEMS = 640 + 128 + 512 + 512 + 2 * 1024 + 512 + 2816 + 1408 + 2048;
            for (int it = gw; it < NITEMS; it += NGW) { int r = it;
#define TR(Wp, K_, N_, WTp, gainp, sc, mode) { const int ni_ = ((K_) / 64) * ((N_) / 32); if (r < ni_) { tr_item(Wp, K_, N_, WTp, gainp, sc, mode, wscr, r, lane); continue; } r -= ni_; }
                TR(P.in[15], 1024, 1280, WT + WT_INEVEN, P.in[11], 1.f, 1)
                TR(P.in[25], 512, 512, WT + WT_GLU, nullptr, 1.f, 0)
                TR(P.in[16], 1024, 1024, WT + WT_OUTEVEN, nullptr, 1.f, 0)
                TR(P.in[30], 1024, 1024, WT + WT_WQ, P.in[12], 0.0625f, 0)
                TR(P.in[31], 1024, 2048, WT + WT_WKV, nullptr, 1.f, 0)
                TR(P.in[31] + 2097152, 1024, 2048, WT + WT_WKV + 2097152, nullptr, 1.f, 0)
                TR(P.in[32], 1024, 1024, WT + WT_WO, nullptr, 1.f, 0)
                TR(P.in[33], 1024, 5632, WT + WT_UP, P.in[13], 1.f, 2)
                TR(P.in[35], 2816, 1024, WT + WT_DOWN, nullptr, 1.f, 0)
                { const int mi = r >> 7, l = mi >> 3, b = mi & 7; tr_item(P.in[10] + (size_t)mi * 262144, 256, 1024, memvT + (size_t)(l * 12 + 4 + b) * 262144, nullptr, 1.f, 0, wscr, r & 127, lane); }
            }
        }
        for (int m = gw; m < MROWS; m += NGW) { const float* xr = m < MP ? P.in[0] + (size_t)m * 1024 : P.in[1] + (size_t)(m - MP) * 1024; float ss = 0.f;
#pragma unroll
            for (int j = 0; j < 4; ++j) { const f32x4 v = __builtin_nontemporal_load((const f32x4*)(xr + (lane + 64 * j) * 4)); ss += (v[0] * v[0] + v[1] * v[1]) + (v[2] * v[2] + v[3] * v[3]);
                u32x2v w; w.x = pg8::cvt_pk_bf16(v[0], v[1]); w.y = pg8::cvt_pk_bf16(v[2], v[3]); *(u32x2v*)(xb + (size_t)m * 1024 + (lane + 64 * j) * 4) = w; }
            ss = wave_sum(ss); if (lane < 16) PARTBUF(0)[(size_t)m * 16 + lane] = lane == 0 ? ss : 0.f; }
        for (int i = gt; i < 262144; i += NT) { const f32x4 v = __builtin_nontemporal_load((const f32x4*)(P.in[2] + (size_t)i * 4)); u32x2v w; w.x = pg8::cvt_pk_bf16(v[0], v[1]); w.y = pg8::cvt_pk_bf16(v[2], v[3]); *(u32x2v*)(memb + (size_t)i * 4) = w; }
        for (int i = gt; i < 1048576; i += NT) { const size_t e = (size_t)i * 4; const int lb = (int)(e >> 18), l = lb >> 3, b = lb & 7; const f32x4 v = __builtin_nontemporal_load((const f32x4*)(P.in[9] + e));
            u32x2v w; w.x = pg8::cvt_pk_bf16(v[0], v[1]); w.y = pg8::cvt_pk_bf16(v[2], v[3]); *(u32x2v*)(memk + (size_t)(l * 12 + 4 + b) * 262144 + (e & 262143)) = w; }
        for (int i = gt; i < 65536; i += NT) { const int j = i & 32767; const float* src = (i < 32768 ? P.in[3] : P.in[4]) + (size_t)j * 4; bf16* dst = (i < 32768 ? ckb : cvb) + (size_t)j * 4;
            const f32x4 v = *(const f32x4*)src; u32x2v w; w.x = pg8::cvt_pk_bf16(v[0], v[1]); w.y = pg8::cvt_pk_bf16(v[2], v[3]); *(u32x2v*)dst = w; }
        for (int i = gt; i < 4096 * 32; i += NT) { const int pos = i >> 5, d = i & 31; const double inv = dexp_(-(double)d * (9.210340371976184 / 32.0)); double s, c; dsincos_((double)pos * inv, s, c); ropec[i] = (float)c; ropes[i] = (float)s; }
        for (int i = gt; i < 2048; i += NT) { const double are = P.in[17][i], aim = P.in[18][i], dt = dexp_((double)P.in[19][i]); double s, c; dsincos_(aim * dt, s, c); const double mag = dexp_(are * dt);
            const double br = mag * c, bi = mag * s; abar[2 * i] = (float)br; abar[2 * i + 1] = (float)bi;
            const double nr = br - 1.0, ni = bi, den = are * are + aim * aim; const double qr = (nr * are + ni * aim) / den, qi = (ni * are - nr * aim) / den;
#pragma unroll 4
            for (int h = 0; h < 16; ++h) { const double xr = P.in[20][(size_t)i * 16 + h], xi = P.in[21][(size_t)i * 16 + h]; const float fre = (float)(qr * xr - qi * xi), fim = (float)(qr * xi + qi * xr); bbar[(size_t)i * 32 + 2 * h] = fre; bbar[(size_t)i * 32 + 2 * h + 1] = fim;
                bbt[((size_t)i * 2) * 16 + h] = (bf16)f2bf(fre); bbt[((size_t)i * 2 + 1) * 16 + h] = (bf16)f2bf(fim); } }
    }
    SEAM();
    if (RUN) { PTRS()
        if (G < 128 || (int)blockIdx.x >= G - 64) { pg8::Gemm g{memb, WT + WT_WKV, 1024, 4096, 1024}; pg8::StaticOrder S;
            if (G < 128) S.init(1024, 4096, G, (int)blockIdx.x); else S.init(1024, 4096, 64, (int)blockIdx.x - (G - 64)); EpiKV E{out, memk};
          pg8::gemm_phase<EpiKV, pg8::StaticOrder, true, true>(lds, g, S, E, wave_s); }
        { pg8::Gemm g{xb, WT + WT_INEVEN, MROWS, 1280, 1024}; pg8::StaticOrderF S; S.init(MROWS, 1280, G, (int)blockIdx.x); EpiIn0 E{proj0, PARTBUF(0), ropec, ropes, out};
          pg8::gemm_phase<EpiIn0, pg8::StaticOrderF, true, true>(lds, g, S, E, wave_s); }
        {
            FRESH()
            const int bx = (int)blockIdx.x, n2 = 325 - G;
            int slot = -1, nw = 1;
            if (G == 256) { if (bx >= n2 && bx < G - 64) { slot = (bx - n2) * 8 + wave; nw = (G - 64 - n2) * 8; } } else { slot = gw; nw = NGW; }
            if (slot >= 0) for (int it = slot; it < 2816 + 1408; it += nw) { int r = it;
                TR(P.in[33] + (size_t)1024 * 5632, 1024, 5632, WT + WT_UP + (size_t)5632 * 1024, P.in[13] + 1024, 1.f, 2)
                tr_item(P.in[35] + (size_t)2816 * 1024, 2816, 1024, WT + WT_DOWN + (size_t)2816 * 1024, nullptr, 1.f, 0, wscr, r, lane); }
        }
    }
    SEAM();
    if (RUN) { PTRS() FRESH()
        swa_phase(proj0, ckb, cvb, P.in[26], ycat, lds, tid, wave, lane, G);
        s5_local(proj0, abar, bbt, sloc, wscr, wave * G + (int)blockIdx.x, NGW, lane);
        for (int it = wave * G + (int)blockIdx.x; it < 1024; it += NGW) { const int mi = it >> 7, l = mi >> 2, b = mi & 3;
            tr_item(out + OFF_MVP + (size_t)mi * 262144, 256, 1024, memvT + (size_t)(l * 12 + b) * 262144, nullptr, 1.f, 0, wscr, it & 127, lane); }
    }
    SEAM();
    if (RUN) { PTRS() FRESH() s5_out(proj0, abar, bbt, sloc, P.in[5], P.in[6], P.in[22], P.in[23], P.in[24], gbuf, out, (LAS float*)(lds + wave * 16384), (LAS unsigned*)(lds + wave * 16384 + 8448), wave * G + (int)blockIdx.x, NGW, lane); }
    SEAM();
    if (RUN) { PTRS() pg8::Gemm g{gbuf, WT + WT_GLU, MROWS, 512, 512}; pg8::StaticOrder S; S.init(MROWS, 512, G, (int)blockIdx.x); EpiGlu E{gbuf, ycat};
        pg8::gemm_phase<EpiGlu, pg8::StaticOrder, true, true>(lds, g, S, E, wave_s);
        {
            FRESH()
            const int bx = (int)blockIdx.x; int slot = -1, nw = 1;
            if (G > 130) { if (bx >= 130) { slot = (bx - 130) * 8 + wave; nw = (G - 130) * 8; } } else { slot = gw; nw = NGW; }
            if (slot >= 0) for (int it = slot; it < 1536 + 512; it += nw) { int r = it;
                TR(P.in[27], 1024, 3072, WT + WT_INODD, P.in[11] + 1024, 1.f, 3)
                tr_item(P.in[29], 1024, 1024, WT + WT_OUTODD, nullptr, 1.f, 0, wscr, r, lane); }
        } }
    SEAM();

#pragma unroll
    for (int l = 0; l < 2; ++l) {
        if (l == 1) {
            if (RUN) { PTRS() pg8::Gemm g{xb, WT + WT_INODD, MP, 1024, 1024}; pg8::StaticOrderF S; S.init(MP, 1024, G, (int)blockIdx.x); EpiBf16 E{gbm, 1024, PARTBUF(3)};
                pg8::gemm_phase<EpiBf16, pg8::StaticOrderF, true, true>(lds, g, S, E, wave_s);
                { FRESH() sample_gemm<1>(xb, WT + WT_INODD, 1024, lds, tid, wave, lane, nullptr, nullptr, nullptr, PARTBUF(3), gbm); } }
            SEAM();
            if (RUN) { PTRS() pg8::Gemm g{xb, WT + WT_INODD + (size_t)1024 * 1024, MP, 2048, 1024}; pg8::StaticOrderF S; S.init(MP, 2048, G, (int)blockIdx.x); EpiCz E{gbm, PARTBUF(3), P.in[28], SG};
                pg8::gemm_phase<EpiCz, pg8::StaticOrderF, true, true>(lds, g, S, E, wave_s);
                { FRESH() sample_cz(xb, WT + WT_INODD, lds, tid, wave, lane, PARTBUF(3), P.in[28], P.in[7], gbm, out); } }
            SEAM();
            if (RUN) { PTRS() FRESH()
                const float* cw = P.in[28];
                for (int i = gt; i < 512 * 128; i += NT) { const int ri = i >> 7, c0 = (i & 127) * 8, blk = ri >> 1, rr = ri & 1, row = blk * 64 + rr;
                    f32x4 pa0, pa1, pb0, pb1;
                    if ((blk & 63) == 0) { pa0 = pa1 = pb0 = pb1 = (f32x4){0.f, 0.f, 0.f, 0.f}; }
                    else { const float* s0 = SG + (size_t)((blk - 1) * 8 + 6) * 1024 + c0; pa0 = *(const f32x4*)s0; pa1 = *(const f32x4*)(s0 + 4); pb0 = *(const f32x4*)(s0 + 1024); pb1 = *(const f32x4*)(s0 + 1028); }
                    const float* sc = SG + (size_t)(blk * 8) * 1024 + c0; const f32x4 x00 = *(const f32x4*)sc, x01 = *(const f32x4*)(sc + 4);
                    f32x4 xm2a, xm2b, xm1a, xm1b, xca, xcb;
                    if (rr == 0) { xm2a = pa0; xm2b = pa1; xm1a = pb0; xm1b = pb1; xca = x00; xcb = x01; }
                    else { xm2a = pb0; xm2b = pb1; xm1a = x00; xm1b = x01; xca = *(const f32x4*)(sc + 1024); xcb = *(const f32x4*)(sc + 1028); }
                    const f32x4 w0a = *(const f32x4*)(cw + c0), w0b = *(const f32x4*)(cw + c0 + 4), w1a = *(const f32x4*)(cw + 1024 + c0), w1b = *(const f32x4*)(cw + 1028 + c0), w2a = *(const f32x4*)(cw + 2048 + c0), w2b = *(const f32x4*)(cw + 2052 + c0);
                    const f32x4 z0 = w0a * xm2a + w1a * xm1a + w2a * xca, z1 = w0b * xm2b + w1b * xm1b + w2b * xcb;
                    const v4u gw_ = *(const v4u*)(gbm + (size_t)row * 1024 + c0);
                    const f32x4 g0 = (f32x4){bflo(gw_.x), bfhi(gw_.x), bflo(gw_.y), bfhi(gw_.y)}, g1 = (f32x4){bflo(gw_.z), bfhi(gw_.z), bflo(gw_.w), bfhi(gw_.w)};
                    *(v4u*)(gbm + (size_t)row * 1024 + c0) = pack8(g0 * z0, g1 * z1); }
                for (int i = gt; i < 4 * 2 * 1024; i += NT) { const int c = i & 1023, j = (i >> 10) & 1, b = i >> 11; out[OFF_CMP + i] = SG[(size_t)((64 * b + 63) * 8 + 6 + j) * 1024 + c]; }
            }
            SEAM();
        }
        if (RUN) { PTRS() pg8::Gemm g{(bf16*)(tmp + (size_t)(1 - l) * TMP_YCAT), WT + WT_OUTEVEN + (size_t)l * (WT_OUTODD - WT_OUTEVEN), MP, 1024, 1024}; pg8::StaticOrderF S; S.init(MP, 1024, G, (int)blockIdx.x);
            EpiRes E{P.in[0], P.in[1] - (size_t)MP * 1024, xb, PARTBUF(1 + 3 * l), l == 0 ? 1 : 0};
            pg8::gemm_phase<EpiRes, pg8::StaticOrderF, true, true>(lds, g, S, E, wave_s);
            { FRESH() sample_gemm<0>((bf16*)(tmp + (size_t)(1 - l) * TMP_YCAT), WT + WT_OUTEVEN + (size_t)l * (WT_OUTODD - WT_OUTEVEN), 1024, lds, tid, wave, lane, xb, l == 0 ? P.in[1] - (size_t)MP * 1024 : (const float*)nullptr, PARTBUF(1 + 3 * l), nullptr, nullptr); } }
        SEAM();
        if (RUN) { PTRS() pg8::Gemm g{xb, WT + WT_WQ + (size_t)l * 1048576, MP, 1024, 1024}; pg8::StaticOrderF S; S.init(MP, 1024, G, (int)blockIdx.x); EpiBf16 E{qx, 1024, PARTBUF(1 + 3 * l)};
            pg8::gemm_phase<EpiBf16, pg8::StaticOrderF, true, true>(lds, g, S, E, wave_s);
            { FRESH() sample_gemm<1>(xb, WT + WT_WQ + (size_t)l * 1048576, 1024, lds, tid, wave, lane, nullptr, nullptr, nullptr, PARTBUF(1 + 3 * l), qx); } }
        SEAM();
        if (RUN) { PTRS() FRESH() xattn_phase2(qx, memk + (size_t)l * 12 * 262144, memvT + (size_t)l * 12 * 262144, ox, lds, tid, wave, lane, G); }
        SEAM();
        if (RUN) { PTRS() pg8::Gemm g{ox, WT + WT_WO + (size_t)l * 1048576, MP, 1024, 1024}; pg8::StaticOrderF S; S.init(MP, 1024, G, (int)blockIdx.x); EpiRes E{P.in[0], P.in[0], xb, PARTBUF(2 + 3 * l), 0};
            pg8::gemm_phase<EpiRes, pg8::StaticOrderF, true, true>(lds, g, S, E, wave_s);
            { FRESH() sample_gemm<0>(ox, WT + WT_WO + (size_t)l * 1048576, 1024, lds, tid, wave, lane, xb, nullptr, PARTBUF(2 + 3 * l), nullptr, nullptr); } }
        SEAM();
        if (RUN) { PTRS() pg8::Gemm g{xb, WT + WT_UP + (size_t)l * 5632 * 1024, MROWS, 5632, 1024}; pg8::StaticOrderF S; S.init(MROWS, 5632, G, (int)blockIdx.x);
            EpiFfnUp E{act, PARTBUF(2 + 3 * l), P.in[34] + (size_t)l * 3 * DFF, SG, SV};
            pg8::gemm_phase<EpiFfnUp, pg8::StaticOrderF, true, true>(lds, g, S, E, wave_s);
            if (l == 0) {
                FRESH()
                const int bx = (int)blockIdx.x, nb = 1430 % G; int slot = -1, nw = 1;
                if (nb > 0 && nb < G) { if (bx >= nb) { slot = (bx - nb) * 8 + wave; nw = (G - nb) * 8; } } else { slot = gw; nw = NGW; }
                if (slot >= 0) for (int it = slot; it < 512 + 512; it += nw) { int r = it;
                    TR(P.in[30] + 1048576, 1024, 1024, WT + WT_WQ + 1048576, P.in[12] + 1024, 0.0625f, 0)
                    tr_item(P.in[32] + 1048576, 1024, 1024, WT + WT_WO + 1048576, nullptr, 1.f, 0, wscr, r, lane); }
            } }
        SEAM();
        if (RUN) { PTRS() FRESH()
            const float* cw = P.in[34] + (size_t)l * 3 * DFF; const float* st = P.in[8] + (size_t)l * 8 * 2 * DFF;
            for (int i = gt; i < 528 * 352; i += NT) { const int fi = i / 352, c0 = (i % 352) * 8; int blk, row, rr, sb, vb; bool smp = fi >= 512;
                if (!smp) { blk = fi >> 1; rr = fi & 1; row = blk * 64 + rr; sb = 0; vb = 0; } else { const int s = fi - 512, half = (s >> 1) & 1; blk = 256 + (s >> 2); rr = s & 1; row = blk * 64 + half * 32 + rr; sb = half * 4; vb = half * 2; }
                f32x4 pa0, pa1, pb0, pb1;
                if (smp) { const int b = (blk - 256) * 2 + (sb >> 2); const float* s0 = st + (size_t)(b * 2) * DFF + c0; pa0 = *(const f32x4*)s0; pa1 = *(const f32x4*)(s0 + 4); pb0 = *(const f32x4*)(s0 + DFF); pb1 = *(const f32x4*)(s0 + DFF + 4); }
                else if ((blk & 63) == 0) { pa0 = pa1 = pb0 = pb1 = (f32x4){0.f, 0.f, 0.f, 0.f}; }
                else { const float* s0 = SG + (size_t)((blk - 1) * 8 + 6) * DFF + c0; pa0 = *(const f32x4*)s0; pa1 = *(const f32x4*)(s0 + 4); pb0 = *(const f32x4*)(s0 + DFF); pb1 = *(const f32x4*)(s0 + DFF + 4); }
                const float* sc = SG + (size_t)(blk * 8 + sb) * DFF + c0; const f32x4 x00 = *(const f32x4*)sc, x01 = *(const f32x4*)(sc + 4);
                f32x4 xm2a, xm2b, xm1a, xm1b, xca, xcb;
                if (rr == 0) { xm2a = pa0; xm2b = pa1; xm1a = pb0; xm1b = pb1; xca = x00; xcb = x01; }
                else { xm2a = pb0; xm2b = pb1; xm1a = x00; xm1b = x01; xca = *(const f32x4*)(sc + DFF); xcb = *(const f32x4*)(sc + DFF + 4); }
                const f32x4 w0a = *(const f32x4*)(cw + c0), w0b = *(const f32x4*)(cw + c0 + 4), w1a = *(const f32x4*)(cw + DFF + c0), w1b = *(const f32x4*)(cw + DFF + c0 + 4), w2a = *(const f32x4*)(cw + 2 * DFF + c0), w2b = *(const f32x4*)(cw + 2 * DFF + c0 + 4);
                const f32x4 ga = w0a * xm2a + w1a * xm1a + w2a * xca, gb_ = w0b * xm2b + w1b * xm1b + w2b * xcb;
                const float* sv = SV + (size_t)(blk * 4 + vb + rr) * DFF + c0; const f32x4 va = *(const f32x4*)sv, vb_ = *(const f32x4*)(sv + 4);
                f32x4 a0, a1;
#pragma unroll
                for (int j = 0; j < 4; ++j) { a0[j] = ga[j] * sigmoidf_(ga[j]) * va[j]; a1[j] = gb_[j] * sigmoidf_(gb_[j]) * vb_[j]; }
                *(v4u*)(act + (size_t)row * DFF + c0) = pack8(a0, a1); }
            for (int i = gt; i < 4 * 2 * DFF; i += NT) { const int c = i % DFF, j = (i / DFF) & 1, b = i / (2 * DFF); out[OFF_CFP + (size_t)l * 4 * 2 * DFF + i] = SG[(size_t)((64 * b + 63) * 8 + 6 + j) * DFF + c]; }
            for (int i = gt; i < 8 * 2 * DFF; i += NT) { const int c = i % DFF, j = (i / DFF) & 1, b = i / (2 * DFF); out[OFF_CFS + (size_t)l * 8 * 2 * DFF + i] = SG[(size_t)((256 + (b >> 1)) * 8 + (b & 1) * 4 + 2 + j) * DFF + c]; }
        }
        SEAM();
        if (RUN) { PTRS() pg8::Gemm g{act, WT + WT_DOWN + (size_t)l * 2816 * 1024, MP, 1024, DFF}; pg8::StaticOrderF S; S.init(MP, 1024, G, (int)blockIdx.x); EpiRes E{P.in[0], P.in[0], xb, PARTBUF(3 + 3 * l), 0};
            pg8::gemm_phase<EpiRes, pg8::StaticOrderF, true, true>(lds, g, S, E, wave_s);
            { FRESH() sample_gemm<0>(act, WT + WT_DOWN + (size_t)l * 2816 * 1024, DFF, lds, tid, wave, lane, xb, nullptr, PARTBUF(3 + 3 * l), nullptr, nullptr); } }
        SEAM();
    }
    if (RUN) { PTRS() FRESH()
        const float* gf = P.in[14];
        for (int m = gw; m < MROWS; m += NGW) { const float rs = rstd_of(PARTBUF(6), m); float* xr = out + (size_t)m * 1024; const bf16* xbr = xb + (size_t)m * 1024;
#pragma unroll
            for (int j = 0; j < 4; ++j) { const int c = (lane + 64 * j) * 4; const u32x2v w = __builtin_nontemporal_load((const u32x2v*)(xbr + c)); const f32x4 v = (f32x4){bflo(w.x), bfhi(w.x), bflo(w.y), bfhi(w.y)}, gg = *(const f32x4*)(gf + c); __builtin_nontemporal_store(v * rs * gg, (f32x4*)(xr + c)); } }
    }
}

extern "C" void kernel_launch(void* const* d_in, const int* in_sizes, int n_in, void* d_out, int out_size, void* d_ws, size_t ws_size, hipStream_t stream) {
    static int grid = 0;
    if (grid == 0) {
        int dev = 0, cus = 0, per_cu = 0;
        if (n_in != 36 || ws_size < 256 * MiB) { fprintf(stderr, "kernel_launch: unexpected n_in %d / ws %zu\n", n_in, ws_size); grid = -1; return; }
        (void)hipGetDevice(&dev); (void)hipDeviceGetAttribute(&cus, hipDeviceAttributeMultiprocessorCount, dev);
        if (hipFuncSetAttribute((const void*)mega_fwd, hipFuncAttributeMaxDynamicSharedMemorySize, LDS_BYTES) != hipSuccess) { fprintf(stderr, "kernel_launch: hipFuncSetAttribute failed\n"); grid = -1; return; }
        if (hipOccupancyMaxActiveBlocksPerMultiprocessor(&per_cu, (const void*)mega_fwd, 512, LDS_BYTES) != hipSuccess || per_cu < 1) per_cu = 1;
        (void)hipGetLastError();
        grid = cus * 1;
        if (grid > 256) grid = 256;
    }
    if (grid < 0) return;
    (void)hipMemsetAsync(d_ws, 0, CTL_ZERO_BYTES, stream);
    Params p{};
    for (int i = 0; i < 36; ++i) p.in[i] = (const float*)d_in[i];
    p.out = (float*)d_out; p.ws = (unsigned char*)d_ws; p.use_cg = 0; p.pad = 0;
    void* args[] = {&p};
    hipError_t e = hipLaunchCooperativeKernel((const void*)mega_fwd, dim3(grid), dim3(512), args, LDS_BYTES, stream);
    if (e != hipSuccess) fprintf(stderr, "cooperative launch failed: %s (grid %d)\n", hipGetErrorString(e), grid);
}
```

```cpp
#include <hip/hip_runtime.h>
#include <hip/hip_cooperative_groups.h>
#include <cstdio>
#include <cstdint>
namespace cg = cooperative_groups;
__device__ __forceinline__ int fresh_tid(int wave_s) { unsigned z = 0u; asm volatile("" : "+s"(z)); int t = wave_s * 64 + (int)__builtin_amdgcn_mbcnt_hi(~0u, __builtin_amdgcn_mbcnt_lo(~0u, z)); asm volatile("" : "+v"(t)); return t; }
namespace pg8 {
#define PG8_LAS __attribute__((address_space(3)))
typedef unsigned short bf16_t;
typedef short bf16x8 __attribute__((ext_vector_type(8)));
typedef float f32x4 __attribute__((ext_vector_type(4)));
typedef unsigned u32x4 __attribute__((ext_vector_type(4)));
constexpr int BM = 256, BK = 64, HALF = 128, HTB = HALF * BK * 2  , STAGE_BYTES = 8 * HTB, NXCD = 8, WGM = 8;

__host__ __device__ __forceinline__ int lds_byte(int r, int c) { const int st = (r >> 4) * 2 + (c >> 5), rr = r & 15, cc = c & 31, ob = rr * 64 + cc * 2; return st * 1024 + (ob ^ (((ob >> 9) & 1) << 5)); }
__host__ __device__ __forceinline__ void stage_rc(int b, int& R, int& C) { const int st = b / 1024, sb = b % 1024, swz = sb ^ (((sb >> 9) & 1) << 5); R = (st >> 1) * 16 + swz / 64; C = (st & 1) * 32 + (swz % 64) / 2; }
__host__ __device__ __forceinline__ int perm32(int rho) { const int n = rho >> 4, i = rho & 15; return 8 * (i >> 2) + 4 * n + (i & 3); }

struct Unit { int pm, pn; };
struct Gemm { const bf16_t* A; const bf16_t* Bt; int M, N, K; };

template <bool FULL> struct StaticOrderT {
    int nM, nN, nwg, G, c;
    __host__ __device__ void init(int M, int N, int G_, int c_) { nM = M / BM; nN = N / BM; nwg = nM * nN; G = G_; c = c_; }
    __host__ __device__ bool next(int i, Unit& u) const {
        const long L = (long)i * G + c; if (!(FULL && i == 0) && L >= nwg) return false;
        int wgid = (int)L; { const int q = nwg / NXCD, r = nwg % NXCD, xcd = wgid % NXCD, off = wgid / NXCD; wgid = (xcd < r ? xcd * (q + 1) : r * (q + 1) + (xcd - r) * q) + off; }
        const int nig = WGM * nN, gid = wgid / nig, fm = gid * WGM, gsz = (nM - fm) < WGM ? (nM - fm) : WGM;
        u.pm = fm + ((wgid % nig) % gsz); u.pn = (wgid % nig) / gsz; return true;
    }
    __device__ __forceinline__ void a_ready(const Unit&) const {}
    __device__ __forceinline__ void done(const Unit&) const {}
};

typedef StaticOrderT<false> StaticOrder; typedef StaticOrderT<true> StaticOrderF;
__device__ __forceinline__ unsigned cvt_pk_bf16(float lo, float hi) { unsigned r; asm volatile("v_cvt_pk_bf16_f32 %0, %1, %2" : "=v"(r) : "v"(lo), "v"(hi)); return r; }
typedef float f32x2 __attribute__((ext_vector_type(2)));
template <class Epi, class Sched, bool ALIGN_EPI = false, bool SP2 = false>
__device__ __forceinline__ void gemm_phase(PG8_LAS unsigned char* lds, const Gemm g, const Sched& S, const Epi& E, const int wave_s) {
    const int tid = fresh_tid(wave_s), wid = __builtin_amdgcn_readfirstlane(tid >> 6), lane = tid & 63, wr = wid >> 2, wc = wid & 3, fr = lane & 15, fq = lane >> 4;
    const int K = g.K, nt = K / BK;
    unsigned voffA[2], voffB[2];
#pragma unroll
    for (int i = 0; i < 2; ++i) { int R, C; stage_rc(tid * 16 + i * 8192, R, C); const int Rb = Epi::PERM ? ((R & ~31) + perm32(R & 31)) : R;
        voffA[i] = (unsigned)(R * K + C) * 2u; voffB[i] = (unsigned)(Rb * K + C) * 2u; }
    const size_t kstep = (size_t)(BK * 2);
    const size_t hstep = (size_t)HALF * K * 2;
    const size_t tstep = 2 * hstep;
    const unsigned ldsw = (unsigned)wid * 1024u;
    const int aoff = lds_byte(wr * 64 + fr, fq * 8), boff = lds_byte(wc * 32 + fr, fq * 8);
#define PG8_SA(b, h) (((b) * 2 + (h)) * HTB)
#define PG8_SB(b, h) ((4 + (b) * 2 + (h)) * HTB)
#define PG8_STAGE(bufoff, gbase, voff) do { _Pragma("unroll") for (int _i = 0; _i < 2; ++_i) \
        __builtin_amdgcn_global_load_lds((const unsigned*)((const char*)(gbase) + (voff)[_i]), (PG8_LAS unsigned*)(lds + (bufoff) + ldsw + _i * 8192), 16, 0, 0); } while (0)
#define PG8_LDA(dst, b, h) do { _Pragma("unroll") for (int m = 0; m < 4; ++m) _Pragma("unroll") for (int k = 0; k < 2; ++k) dst[m][k] = *(const PG8_LAS bf16x8*)(lds + PG8_SA(b, h) + aoff + m * 2048 + k * 1024); } while (0)
#define PG8_LDB(dst, b, h) do { _Pragma("unroll") for (int n = 0; n < 2; ++n) _Pragma("unroll") for (int k = 0; k < 2; ++k) dst[n][k] = *(const PG8_LAS bf16x8*)(lds + PG8_SB(b, h) + boff + n * 2048 + k * 1024); } while (0)
#define PG8_MMA(ai, bj, At, Bt) do { __builtin_amdgcn_s_setprio(1); _Pragma("unroll") for (int m = 0; m < 4; ++m) _Pragma("unroll") for (int n = 0; n < 2; ++n) _Pragma("unroll") for (int k = 0; k < 2; ++k) \
        acc[ai][bj][m][n] = __builtin_amdgcn_mfma_f32_16x16x32_bf16(Bt[n][k], At[m][k], acc[ai][bj][m][n], 0, 0, 0); __builtin_amdgcn_s_setprio(0); } while (0)
#define PG8_WAIT_V(n) asm volatile("s_waitcnt vmcnt(" #n ")" ::: "memory")
#define PG8_WAIT_L(n) asm volatile("s_waitcnt lgkmcnt(" #n ")" ::: "memory")
#define PG8_BAR __builtin_amdgcn_s_barrier()
#define PG8_SCHED __builtin_amdgcn_sched_barrier(0)
    Unit cur, nxt; int ui = 0;
    if (!S.next(0, cur)) return;
    f32x4 acc[2][2][4][2];
#pragma unroll
    for (int a = 0; a < 2; ++a)
#pragma unroll
        for (int b = 0; b < 2; ++b)
#pragma unroll
            for (int m = 0; m < 4; ++m)
#pragma unroll
                for (int n = 0; n < 2; ++n) acc[a][b][m][n] = (f32x4){0.f, 0.f, 0.f, 0.f};
    bf16x8 At[4][2], B0[2][2], B1[2][2];
    const char* cA = (const char*)g.A + (size_t)cur.pm * tstep; const char* cB = (const char*)g.Bt + (size_t)cur.pn * tstep;
    S.a_ready(cur);
    if constexpr (SP2) {
        PG8_STAGE(PG8_SB(0, 0), cB, voffB); PG8_STAGE(PG8_SB(0, 1), cB + hstep, voffB); PG8_STAGE(PG8_SA(0, 0), cA, voffA); PG8_STAGE(PG8_SA(0, 1), cA + hstep, voffA);
        if (wr == 1) PG8_BAR;
        PG8_WAIT_V(2); PG8_BAR;
        PG8_STAGE(PG8_SB(1, 0), cB + kstep, voffB); PG8_STAGE(PG8_SA(1, 0), cA + kstep, voffA); PG8_STAGE(PG8_SB(1, 1), cB + hstep + kstep, voffB);
        PG8_WAIT_V(6); PG8_BAR;
    } else {
        PG8_STAGE(PG8_SB(0, 0), cB, voffB); PG8_STAGE(PG8_SA(0, 0), cA, voffA); PG8_STAGE(PG8_SB(0, 1), cB + hstep, voffB); PG8_STAGE(PG8_SA(0, 1), cA + hstep, voffA);
        if (wr == 1) PG8_BAR;
        PG8_WAIT_V(4); PG8_BAR;
        PG8_STAGE(PG8_SB(1, 0), cB + kstep, voffB); PG8_STAGE(PG8_SA(1, 0), cA + kstep, voffA); PG8_STAGE(PG8_SB(1, 1), cB + hstep + kstep, voffB);
        PG8_WAIT_V(6); PG8_BAR;
    }
    for (;;) {
        const bool has_next = S.next(ui + 1, nxt);
        const char* nA = has_next ? (const char*)g.A + (size_t)nxt.pm * tstep : cA; const char* nB = has_next ? (const char*)g.Bt + (size_t)nxt.pn * tstep : cB;
        for (int t = 0; t < nt; t += 2) {
            const bool last = (t == nt - 2);
            const char* a1 = cA + (size_t)(t + 1) * kstep;
            const char* a2 = last ? nA : cA + (size_t)(t + 2) * kstep; const char* b2 = last ? nB : cB + (size_t)(t + 2) * kstep;
            const char* a3 = a2 + kstep; const char* b3 = b2 + kstep;
            if (last && has_next) S.a_ready(nxt);
            if constexpr (SP2) {
            PG8_LDB(B0, 0, 0); PG8_LDB(B1, 0, 1); PG8_SCHED; PG8_LDA(At, 0, 0); PG8_STAGE(PG8_SA(1, 1), a1 + hstep, voffA);
            PG8_WAIT_V(8); PG8_WAIT_L(0); PG8_BAR; PG8_MMA(0, 0, At, B0); PG8_MMA(0, 1, At, B1); PG8_BAR; PG8_SCHED;
            PG8_LDA(At, 0, 1); PG8_STAGE(PG8_SB(0, 0), b2, voffB); PG8_STAGE(PG8_SB(0, 1), b2 + hstep, voffB); PG8_STAGE(PG8_SA(0, 0), a2, voffA);
            PG8_WAIT_V(8); PG8_WAIT_L(0); PG8_BAR; PG8_MMA(1, 0, At, B0); PG8_MMA(1, 1, At, B1); PG8_BAR; PG8_SCHED;
            PG8_LDB(B0, 1, 0); PG8_LDB(B1, 1, 1); PG8_SCHED; PG8_LDA(At, 1, 0); PG8_STAGE(PG8_SA(0, 1), a2 + hstep, voffA);
            PG8_WAIT_V(8); PG8_WAIT_L(0); PG8_BAR; PG8_MMA(0, 0, At, B0); PG8_MMA(0, 1, At, B1); PG8_BAR; PG8_SCHED;
            PG8_LDA(At, 1, 1); PG8_STAGE(PG8_SB(1, 0), b3, voffB); PG8_STAGE(PG8_SB(1, 1), b3 + hstep, voffB); PG8_STAGE(PG8_SA(1, 0), a3, voffA);
            PG8_WAIT_V(8); PG8_WAIT_L(0); PG8_BAR; PG8_MMA(1, 0, At, B0); PG8_MMA(1, 1, At, B1); PG8_BAR; PG8_SCHED;
            } else {
            PG8_LDB(B0, 0, 0); PG8_SCHED; PG8_LDA(At, 0, 0); PG8_STAGE(PG8_SA(1, 1), a1 + hstep, voffA);
            PG8_WAIT_L(8); PG8_BAR; PG8_WAIT_L(0); PG8_MMA(0, 0, At, B0); PG8_BAR; PG8_SCHED;
            PG8_LDB(B1, 0, 1); PG8_STAGE(PG8_SB(0, 0), b2, voffB);
            PG8_BAR; PG8_WAIT_L(0); PG8_MMA(0, 1, At, B1); PG8_BAR;
            PG8_LDA(At, 0, 1); PG8_STAGE(PG8_SA(0, 0), a2, voffA);
            PG8_BAR; PG8_WAIT_L(0); PG8_MMA(1, 0, At, B0); PG8_BAR; PG8_SCHED;
            PG8_STAGE(PG8_SB(0, 1), b2 + hstep, voffB);
            PG8_WAIT_V(6); PG8_BAR; PG8_MMA(1, 1, At, B1); PG8_BAR;
            PG8_LDB(B0, 1, 0); PG8_SCHED; PG8_LDA(At, 1, 0); PG8_STAGE(PG8_SA(0, 1), a2 + hstep, voffA);
            PG8_WAIT_L(8); PG8_BAR; PG8_WAIT_L(0); PG8_MMA(0, 0, At, B0); PG8_BAR; PG8_SCHED;
            PG8_LDB(B1, 1, 1); PG8_STAGE(PG8_SB(1, 0), b3, voffB);
            PG8_BAR; PG8_WAIT_L(0); PG8_MMA(0, 1, At, B1); PG8_BAR;
            PG8_LDA(At, 1, 1); PG8_STAGE(PG8_SA(1, 0), a3, voffA);
            PG8_BAR; PG8_WAIT_L(0); PG8_MMA(1, 0, At, B0); PG8_BAR; PG8_SCHED;
            PG8_STAGE(PG8_SB(1, 1), b3 + hstep, voffB);
            PG8_WAIT_V(6); PG8_BAR; PG8_MMA(1, 1, At, B1); PG8_BAR;
            }
        }
        if constexpr (ALIGN_EPI) { if (wr == 0) PG8_BAR; }
        if constexpr (!Epi::AFTER_DRAIN) { E(acc, cur, wr, wc, fr, fq); S.done(cur); }
        if (!has_next) break;
#pragma unroll
        for (int a = 0; a < 2; ++a)
#pragma unroll
            for (int b = 0; b < 2; ++b)
#pragma unroll
                for (int m = 0; m < 4; ++m)
#pragma unroll
                    for (int n = 0; n < 2; ++n) acc[a][b][m][n] = (f32x4){0.f, 0.f, 0.f, 0.f};
        cur = nxt; cA = nA; cB = nB; ++ui;
        if constexpr (ALIGN_EPI) { if (wr == 1) PG8_BAR; }
    }
    PG8_WAIT_V(0);
    if constexpr (!ALIGN_EPI) { if (wr == 0) PG8_BAR; }
    PG8_BAR;
    if constexpr (Epi::AFTER_DRAIN) { E.fused(acc, cur, wr, wc, fr, fq, lds, wid, lane); S.done(cur); }
#undef PG8_SA
#undef PG8_SB
#undef PG8_STAGE
#undef PG8_LDA
#undef PG8_LDB
#undef PG8_MMA
#undef PG8_WAIT_V
#undef PG8_WAIT_L
#undef PG8_BAR
#undef PG8_SCHED
}
}
#define GAS __attribute__((address_space(1)))
#define LAS __attribute__((address_space(3)))
typedef unsigned short bf16;
typedef unsigned v4u __attribute__((ext_vector_type(4)));
typedef float f32x4 __attribute__((ext_vector_type(4)));
typedef short bf16x8 __attribute__((ext_vector_type(8)));
typedef GAS unsigned gu32;
typedef GAS unsigned long long gu64;
#define RLX_AGENT __ATOMIC_RELAXED, __HIP_MEMORY_SCOPE_AGENT
#define LDS_WAIT() asm volatile("s_waitcnt lgkmcnt(0)" ::: "memory")
#define VM_WAIT() asm volatile("s_waitcnt vmcnt(0)" ::: "memory")
__device__ __forceinline__ unsigned long long rt() { return __builtin_amdgcn_s_memrealtime(); }
__device__ __forceinline__ unsigned f2bf(float f) { unsigned u = __builtin_bit_cast(unsigned, f); return (u + 0x7fffu + ((u >> 16) & 1u)) >> 16; }
__device__ __forceinline__ unsigned pk2(float lo, float hi) { return f2bf(lo) | (f2bf(hi) << 16); }

#define XB_TMO      128
#define XB_XCNT(j)  (256  + 64 * (j))
#define XB_XSUB(j)  (1280 + 64 * (j))
#define XB_XGEN(j)  (2304 + 64 * (j))
#define XB_TOP      3328
#define XB_TOPGEN   3392
#define XCD_BAR_WORDS 3456
#define XB_SPIN_CAP (1u << 18)

__device__ __forceinline__ unsigned xb_ld(unsigned* p)              { return __hip_atomic_load(p, __ATOMIC_RELAXED, __HIP_MEMORY_SCOPE_AGENT); }
__device__ __forceinline__ unsigned xb_add(unsigned* p, unsigned v) { return __hip_atomic_fetch_add(p, v, __ATOMIC_RELAXED, __HIP_MEMORY_SCOPE_AGENT); }
__device__ __forceinline__ unsigned xb_xcc_id() { return (unsigned)__builtin_amdgcn_s_getreg((3 << 11) | 20) & 0xFu; }
#define XB_SPIN(cond, bar) do { unsigned _sp = 0; while (cond) { __builtin_amdgcn_s_sleep(0); \
    if ((++_sp & 255u) == 0u) { if (xb_ld(&(bar)[XB_TMO])) break; if (_sp > XB_SPIN_CAP) { atomicAdd(&(bar)[XB_TMO], 1u); break; } } } } while (0)

struct XcdBarrier {
    unsigned* bar; unsigned x;
    volatile LAS unsigned* st;
};

__device__ __forceinline__ XcdBarrier xcd_barrier_post(unsigned* bar, volatile LAS unsigned* st) {
    XcdBarrier b; b.bar = bar; b.x = xb_xcc_id(); b.st = st;
    if (threadIdx.x == 0) (void)xb_add(&bar[XB_XCNT(b.x)], 1u);
    return b;
}
__device__ __forceinline__ void xcd_barrier_complete(unsigned* bar, unsigned x, unsigned& nloc, unsigned& nx) {
    const unsigned G = gridDim.x * gridDim.y * gridDim.z;
    unsigned sum, cnt, mine, sp = 0u;
    for (;;) {
        sum = 0u; cnt = 0u; mine = 0u;
#pragma unroll
        for (unsigned j = 0; j < 16; ++j) { const unsigned c = xb_ld(&bar[XB_XCNT(j)]); sum += c; cnt += (c > 0u) ? 1u : 0u; mine = (j == x) ? c : mine; }
        if (sum == G) break;
        __builtin_amdgcn_s_sleep(1);
        if ((++sp & 255u) == 0u) { if (xb_ld(&bar[XB_TMO])) break; if (sp > XB_SPIN_CAP) { atomicAdd(&bar[XB_TMO], 1u); break; } }
    }
    nloc = mine > 0u ? mine : 1u; nx = cnt > 0u ? cnt : 1u;
}

__device__ __forceinline__ void xcd_barrier(const XcdBarrier& b) {
    asm volatile("s_waitcnt vmcnt(0)" ::: "memory");
    __syncthreads();
    if (threadIdx.x == 0) {
        unsigned* bar = b.bar;
        __builtin_amdgcn_s_waitcnt(0);
        unsigned nloc = b.st[0], nx = b.st[1];
        if (nloc == 0u) { xcd_barrier_complete(bar, b.x, nloc, nx); b.st[0] = nloc; b.st[1] = nx; }
        const unsigned old = xb_add(&bar[XB_XSUB(b.x)], 1u);
        const unsigned gen = old / nloc;
        if (old + 1u == (gen + 1u) * nloc) {
            __builtin_amdgcn_fence(__ATOMIC_RELEASE, "agent");
            asm volatile("s_waitcnt vmcnt(0)" ::: "memory");
            const unsigned og = xb_add(&bar[XB_TOP], 1u);
            const unsigned tg = og / nx;
            if (og + 1u == (tg + 1u) * nx) xb_add(&bar[XB_TOPGEN], 1u);
            else XB_SPIN(xb_ld(&bar[XB_TOPGEN]) == tg, bar);
            __builtin_amdgcn_fence(__ATOMIC_ACQUIRE, "agent");
            xb_add(&bar[XB_XGEN(b.x)], 1u);
            asm volatile("s_waitcnt vmcnt(0)" ::: "memory");
        } else {
            XB_SPIN(xb_ld(&bar[XB_XGEN(b.x)]) == gen, bar);
            __builtin_amdgcn_fence(__ATOMIC_ACQUIRE, "agent");
            asm volatile("s_waitcnt vmcnt(0)" ::: "memory");
        }
    }
    __syncthreads();
}
typedef unsigned u32x2v __attribute__((ext_vector_type(2)));
typedef float f32x2v __attribute__((ext_vector_type(2)));

constexpr int MP = 16384, MROWS = 16640, DMODEL = 1024, DFF = 2816, NBLK64 = MROWS / 64;
constexpr float RMS_EPS = 1e-6f;
constexpr size_t OFF_Y = 0, OFF_WKP = (size_t)MROWS * 1024, OFF_WVP = OFF_WKP + 65536, OFF_SRP = OFF_WVP + 65536, OFF_SIP = OFF_SRP + 8192,
    OFF_CMP = OFF_SIP + 8192, OFF_CFP = OFF_CMP + 8192, OFF_MKP = OFF_CFP + 45056, OFF_MVP = OFF_MKP + 2097152, OFF_WKS = OFF_MVP + 2097152,
    OFF_WVS = OFF_WKS + 32768, OFF_SRS = OFF_WVS + 32768, OFF_SIS = OFF_SRS + 16384, OFF_CMS = OFF_SIS + 16384, OFF_CFS = OFF_CMS + 16384;
constexpr size_t MiB = 1u << 20;
constexpr size_t WS_ROWSS = 0, WS_BAR = 512 * 1024, CTL_ZERO_BYTES = 1 * MiB;
constexpr size_t WS_ROPE = 1 * MiB, WS_SSM = 2 * MiB, WS_CKV = 3 * MiB, WS_SLOC = 4 * MiB, WS_MEMK = 8 * MiB, WS_MEMVT = 20 * MiB, WS_SIDE = 32 * MiB;
constexpr size_t SG_BYTES = (size_t)NBLK64 * 8 * DFF * 4, SV_BYTES = (size_t)NBLK64 * 4 * DFF * 4;
static_assert(WS_SIDE + SG_BYTES + SV_BYTES <= 66 * MiB, "side buffers");
constexpr size_t WS_WT = 66 * MiB, WS_XB = 128 * MiB, WS_TMP = 161 * MiB;
constexpr size_t WT_INEVEN = 0, WT_GLU = WT_INEVEN + 1280 * 1024, WT_OUTEVEN = WT_GLU + 512 * 512, WT_WQ = WT_OUTEVEN + 1024 * 1024, WT_WKV = WT_WQ + 2 * 1024 * 1024,
    WT_WO = WT_WKV + 2 * 2048 * 1024, WT_UP = WT_WO + 2 * 1024 * 1024, WT_DOWN = WT_UP + (size_t)2 * 5632 * 1024, WT_INODD = WT_DOWN + (size_t)2 * 2816 * 1024,
    WT_OUTODD = WT_INODD + 3072 * 1024, WT_END = WT_OUTODD + 1024 * 1024;
static_assert(WS_WT + WT_END * 2 <= WS_XB, "weights");
static_assert(WS_XB + (size_t)MROWS * 1024 * 2 <= WS_TMP, "xb");
constexpr size_t TMP_BYTES = (size_t)MROWS * DFF * 2;
constexpr size_t WS_PART = 251 * MiB, PART_ELEMS = (size_t)MROWS * 16;
static_assert(WS_PART + 2 * PART_ELEMS * 4 <= 256 * MiB, "part");
static_assert(WS_TMP + TMP_BYTES <= 256 * MiB, "ws");
constexpr size_t TMP_PROJ0 = 0, TMP_GBUF = (size_t)MROWS * 1280 * 2, TMP_YCAT = TMP_GBUF + (size_t)MROWS * 512 * 2, TMP_MEMB = TMP_YCAT;
static_assert(TMP_YCAT + (size_t)MROWS * 1024 * 2 <= TMP_BYTES, "tmp");
constexpr size_t TMP_QX = 0, TMP_OX = (size_t)MROWS * 1024 * 2, TMP_ACT = 0, TMP_GB = 0, TMP_ZC = (size_t)MROWS * 1024 * 2;
constexpr int LDS_BYTES = 147456, MISC_OFF = 147456 - 512;
constexpr int NPH = 22;

#define MFMA16(a, b, c) __builtin_amdgcn_mfma_f32_16x16x32_bf16(a, b, c, 0, 0, 0)
__device__ __forceinline__ float bflo(unsigned w) { return __uint_as_float(w << 16); }
__device__ __forceinline__ float bfhi(unsigned w) { return __uint_as_float(w & 0xffff0000u); }
__device__ __forceinline__ v4u pack8(f32x4 a, f32x4 b) { v4u w; w.x = pg8::cvt_pk_bf16(a[0], a[1]); w.y = pg8::cvt_pk_bf16(a[2], a[3]); w.z = pg8::cvt_pk_bf16(b[0], b[1]); w.w = pg8::cvt_pk_bf16(b[2], b[3]); return w; }
__device__ __forceinline__ float rstd_of(const float* part, int row) { const f32x4* p = (const f32x4*)(part + (size_t)row * 16); const f32x4 a = p[0] + p[1] + p[2] + p[3]; return rsqrtf(((a[0] + a[1]) + (a[2] + a[3])) * (1.0f / 1024.0f) + RMS_EPS); }
__device__ __forceinline__ float sigmoidf_(float x) { return 1.0f / (1.0f + __expf(-x)); }
__device__ __forceinline__ float dpp_ror1(float v) { return __builtin_bit_cast(float, __builtin_amdgcn_update_dpp(0, __builtin_bit_cast(int, v), 0x121, 0xf, 0xf, false)); }
__device__ __forceinline__ float dpp_ror2(float v) { return __builtin_bit_cast(float, __builtin_amdgcn_update_dpp(0, __builtin_bit_cast(int, v), 0x122, 0xf, 0xf, false)); }
__device__ __forceinline__ float wave_sum(float v) {
#pragma unroll
    for (int o = 1; o < 64; o <<= 1) v += __shfl_xor(v, o);
    return v;
}

typedef pg8::Unit Unit;
#define EPI_ARGS const f32x4 (&acc)[2][2][4][2], const Unit& u, int wr, int wc, int fr, int fq

struct EpiBf16 {
    static constexpr bool PERM = true, AFTER_DRAIN = false;
    bf16* O; int ldc; const float* rowss;
    __device__ __forceinline__ void operator()(EPI_ARGS) const {
        const int row0 = u.pm * 256 + wr * 64 + fr, col0 = u.pn * 256 + wc * 32 + 8 * fq;
#pragma unroll
        for (int ai = 0; ai < 2; ++ai)
#pragma unroll
            for (int m = 0; m < 4; ++m) { const int row = row0 + ai * 128 + m * 16; const float rs = rstd_of(rowss, row); bf16* rp = O + (size_t)row * ldc + col0;
#pragma unroll
                for (int bj = 0; bj < 2; ++bj) *(v4u*)(rp + bj * 128) = pack8(acc[ai][bj][m][0] * rs, acc[ai][bj][m][1] * rs); }
    }
};
struct EpiRes {
    static constexpr bool PERM = true, AFTER_DRAIN = false;
    const float* base_p; const float* base_s; bf16* xb; float* rowss_next; int f32base;
    __device__ __forceinline__ void operator()(EPI_ARGS) const {
        const float* base = u.pm < 64 ? base_p : base_s;
        const int row0 = u.pm * 256 + wr * 64 + fr, col0 = u.pn * 256 + wc * 32 + 8 * fq;
#pragma unroll
        for (int ai = 0; ai < 2; ++ai)
#pragma unroll
            for (int m = 0; m < 4; ++m) { const int row = row0 + ai * 128 + m * 16; const size_t off = (size_t)row * 1024 + col0; float ss = 0.f;
#pragma unroll
                for (int bj = 0; bj < 2; ++bj) { f32x4 b0, b1;
                    if (f32base) { b0 = __builtin_nontemporal_load((const f32x4*)(base + off + bj * 128)); b1 = __builtin_nontemporal_load((const f32x4*)(base + off + bj * 128 + 4)); }
                    else { const v4u w = *(const v4u*)(xb + off + bj * 128); b0 = (f32x4){bflo(w.x), bfhi(w.x), bflo(w.y), bfhi(w.y)}; b1 = (f32x4){bflo(w.z), bfhi(w.z), bflo(w.w), bfhi(w.w)}; }
                    const f32x4 v0 = acc[ai][bj][m][0] + b0, v1 = acc[ai][bj][m][1] + b1;
                    *(v4u*)(xb + off + bj * 128) = pack8(v0, v1);
                    ss += (v0[0] * v0[0] + v0[1] * v0[1]) + (v0[2] * v0[2] + v0[3] * v0[3]) + (v1[0] * v1[0] + v1[1] * v1[1]) + (v1[2] * v1[2] + v1[3] * v1[3]); }
                ss += __shfl_xor(ss, 16); ss += __shfl_xor(ss, 32);
                if (fq == 0) rowss_next[(size_t)row * 16 + u.pn * 4 + wc] = ss; }
    }
};
struct EpiGlu {
    static constexpr bool PERM = true, AFTER_DRAIN = false;
    const bf16* g; bf16* ycat;
    __device__ __forceinline__ void operator()(EPI_ARGS) const {
        const int row0 = u.pm * 256 + wr * 64 + fr, col0 = u.pn * 256 + wc * 32 + 8 * fq;
#pragma unroll
        for (int ai = 0; ai < 2; ++ai)
#pragma unroll
            for (int m = 0; m < 4; ++m) { const int row = row0 + ai * 128 + m * 16;
#pragma unroll
                for (int bj = 0; bj < 2; ++bj) { const int col = col0 + bj * 128; const v4u gw = *(const v4u*)(g + (size_t)row * 512 + col);
                    const f32x4 a0 = acc[ai][bj][m][0], a1 = acc[ai][bj][m][1]; f32x4 o0, o1;
                    o0[0] = bflo(gw.x) * sigmoidf_(a0[0]); o0[1] = bfhi(gw.x) * sigmoidf_(a0[1]); o0[2] = bflo(gw.y) * sigmoidf_(a0[2]); o0[3] = bfhi(gw.y) * sigmoidf_(a0[3]);
                    o1[0] = bflo(gw.z) * sigmoidf_(a1[0]); o1[1] = bfhi(gw.z) * sigmoidf_(a1[1]); o1[2] = bflo(gw.w) * sigmoidf_(a1[2]); o1[3] = bfhi(gw.w) * sigmoidf_(a1[3]);
                    *(v4u*)(ycat + (size_t)row * 1024 + col) = pack8(o0, o1); } }
    }
};
struct EpiKV {
    static constexpr bool PERM = true, AFTER_DRAIN = false;
    float* out; bf16* memk;
    __device__ __forceinline__ void operator()(EPI_ARGS) const {
        const int row0 = u.pm * 256 + wr * 64 + fr, col0 = u.pn * 256 + wc * 32 + 8 * fq;
#pragma unroll
        for (int ai = 0; ai < 2; ++ai)
#pragma unroll
            for (int m = 0; m < 4; ++m) { const int row = row0 + ai * 128 + m * 16;
#pragma unroll
                for (int bj = 0; bj < 2; ++bj) { const int c = col0 + bj * 128, l = c >> 11, e = c & 2047, isv = e >> 10, dc = e & 1023;
                    float* op = out + (isv ? OFF_MVP : OFF_MKP) + (size_t)l * 1048576 + (size_t)row * 1024 + dc;
                    if (isv) { *(f32x4*)op = acc[ai][bj][m][0]; *(f32x4*)(op + 4) = acc[ai][bj][m][1]; } else { __builtin_nontemporal_store(acc[ai][bj][m][0], (f32x4*)op); __builtin_nontemporal_store(acc[ai][bj][m][1], (f32x4*)(op + 4)); }
                    if (!isv) *(v4u*)(memk + (size_t)l * 12 * 262144 + (size_t)row * 1024 + dc) = pack8(acc[ai][bj][m][0], acc[ai][bj][m][1]); } }
    }
};
struct EpiIn0 {
    static constexpr bool PERM = true, AFTER_DRAIN = false;
    bf16* proj; const float* rowss; const float* ropec; const float* ropes; float* out;
    __device__ __forceinline__ void operator()(EPI_ARGS) const {
        const int pn = u.pn;
#pragma unroll
        for (int ai = 0; ai < 2; ++ai)
#pragma unroll
            for (int m = 0; m < 4; ++m) { const int row = u.pm * 256 + ai * 128 + wr * 64 + m * 16 + fr; const float rs = rstd_of(rowss, row);
                const int pos = row < MP ? (row & 4095) : 2048 + (row & 31);
                bf16* rp = proj + (size_t)row * 1280;
                float* wk = nullptr; float* wv = nullptr;
                if (pn == 4) { if (row >= MP) { wk = out + OFF_WKS + (size_t)(row - MP) * 128; wv = out + OFF_WVS + (size_t)(row - MP) * 128; }
                               else if ((row & 4095) >= 3968) { const size_t o = (size_t)((row >> 12) * 128 + (row & 4095) - 3968) * 128; wk = out + OFF_WKP + o; wv = out + OFF_WVP + o; } }
#pragma unroll
                for (int bj = 0; bj < 2; ++bj) { const f32x4 v0 = acc[ai][bj][m][0] * rs, v1 = acc[ai][bj][m][1] * rs;
                    const bool rope = (pn == 2 || pn == 3 || (pn == 4 && bj == 0));
                    if (!rope) { const int col = pn * 256 + bj * 128 + wc * 32 + 8 * fq; *(v4u*)(rp + col) = pack8(v0, v1);
                        if (pn == 4 && wv) { *(f32x4*)(wv + wc * 32 + 8 * fq) = v0; *(f32x4*)(wv + wc * 32 + 8 * fq + 4) = v1; } }
                    else { const int gbase = pn * 256 + bj * 128 + (wc >> 1) * 64, d1 = 16 * (wc & 1) + 4 * fq;
                        const f32x4 c4 = *(const f32x4*)(ropec + pos * 32 + d1), s4 = *(const f32x4*)(ropes + pos * 32 + d1);
                        f32x4 o1 = v0 * c4 - v1 * s4, o2 = v1 * c4 + v0 * s4;
                        if (pn != 4) { o1 = o1 * 0.125f; o2 = o2 * 0.125f; }
                        u32x2v w1, w2; w1.x = pg8::cvt_pk_bf16(o1[0], o1[1]); w1.y = pg8::cvt_pk_bf16(o1[2], o1[3]); w2.x = pg8::cvt_pk_bf16(o2[0], o2[1]); w2.y = pg8::cvt_pk_bf16(o2[2], o2[3]);
                        *(u32x2v*)(rp + gbase + d1) = w1; *(u32x2v*)(rp + gbase + d1 + 32) = w2;
                        if (pn == 4 && wk) { const int cc = (wc >> 1) * 64 + d1; *(f32x4*)(wk + cc) = o1; *(f32x4*)(wk + cc + 32) = o2; } } } }
    }
};
struct EpiFfnUp {
    static constexpr bool PERM = true, AFTER_DRAIN = false;
    bf16* act; const float* rowss; const float* cw; float* SG; float* SV;
    __device__ __forceinline__ void operator()(EPI_ARGS) const {
        const int c0 = u.pn * 128 + wc * 32 + 8 * fq; const bool sample = u.pm == 64;
        const f32x4 w0a = *(const f32x4*)(cw + c0), w0b = *(const f32x4*)(cw + c0 + 4), w1a = *(const f32x4*)(cw + DFF + c0), w1b = *(const f32x4*)(cw + DFF + c0 + 4),
                    w2a = *(const f32x4*)(cw + 2 * DFF + c0), w2b = *(const f32x4*)(cw + 2 * DFF + c0 + 4);
#pragma unroll
        for (int ai = 0; ai < 2; ++ai) { f32x4 gp0 = {0.f, 0.f, 0.f, 0.f}, gp1 = {0.f, 0.f, 0.f, 0.f}; const int blk = u.pm * 4 + ai * 2 + wr;
#pragma unroll
            for (int m = 0; m < 4; ++m) { const int row = u.pm * 256 + ai * 128 + wr * 64 + m * 16 + fr; const float rs = rstd_of(rowss, row);
                const f32x4 g0 = acc[ai][0][m][0] * rs, g1 = acc[ai][0][m][1] * rs, v0 = acc[ai][1][m][0] * rs, v1 = acc[ai][1][m][1] * rs;
                f32x4 p1a, p2a, p1b, p2b;
#pragma unroll
                for (int j = 0; j < 4; ++j) { const float s1a = fr == 15 ? gp0[j] : g0[j], s2a = fr >= 14 ? gp0[j] : g0[j], s1b = fr == 15 ? gp1[j] : g1[j], s2b = fr >= 14 ? gp1[j] : g1[j];
                    p1a[j] = dpp_ror1(s1a); p2a[j] = dpp_ror2(s2a); p1b[j] = dpp_ror1(s1b); p2b[j] = dpp_ror2(s2b); }
                const f32x4 ca = w0a * p2a + w1a * p1a + w2a * g0, cb = w0b * p2b + w1b * p1b + w2b * g1;
                f32x4 sa, sb;
#pragma unroll
                for (int j = 0; j < 4; ++j) { sa[j] = sigmoidf_(ca[j]); sb[j] = sigmoidf_(cb[j]); }
                const f32x4 a0 = ca * sa * v0, a1 = cb * sb * v1;
                const bool valid = (m > 0 || fr >= 2) && !(sample && m == 2 && fr < 2);
                if (valid) *(v4u*)(act + (size_t)row * DFF + c0) = pack8(a0, a1);
                if ((m & 1) == 0 && fr < 2) { float* sg = SG + (size_t)(blk * 8 + 2 * m + fr) * DFF + c0; *(f32x4*)sg = g0; *(f32x4*)(sg + 4) = g1;
                                              float* sv = SV + (size_t)(blk * 4 + m + fr) * DFF + c0; *(f32x4*)sv = v0; *(f32x4*)(sv + 4) = v1; }
                if ((m & 1) == 1 && fr >= 14) { float* sg = SG + (size_t)(blk * 8 + 2 * m + fr - 14) * DFF + c0; *(f32x4*)sg = g0; *(f32x4*)(sg + 4) = g1; }
                gp0 = g0; gp1 = g1; } }
    }
};
struct EpiInOdd {
    static constexpr bool PERM = true, AFTER_DRAIN = false;
    bf16* gb; bf16* zc; const float* rowss; const float* cw; float* SG;
    __device__ __forceinline__ void operator()(EPI_ARGS) const {
        if (u.pn < 4) {
            const int row0 = u.pm * 256 + wr * 64 + fr, col0 = u.pn * 256 + wc * 32 + 8 * fq;
#pragma unroll
            for (int ai = 0; ai < 2; ++ai)
#pragma unroll
                for (int m = 0; m < 4; ++m) { const int row = row0 + ai * 128 + m * 16; const float rs = rstd_of(rowss, row); bf16* rp = gb + (size_t)row * 1024 + col0;
#pragma unroll
                    for (int bj = 0; bj < 2; ++bj) *(v4u*)(rp + bj * 128) = pack8(acc[ai][bj][m][0] * rs, acc[ai][bj][m][1] * rs); }
            return;
        }
        const int c0 = (u.pn - 4) * 128 + wc * 32 + 8 * fq; const bool sample = u.pm == 64;
        const f32x4 w0a = *(const f32x4*)(cw + c0), w0b = *(const f32x4*)(cw + c0 + 4), w1a = *(const f32x4*)(cw + 1024 + c0), w1b = *(const f32x4*)(cw + 1024 + c0 + 4),
                    w2a = *(const f32x4*)(cw + 2048 + c0), w2b = *(const f32x4*)(cw + 2048 + c0 + 4);
#pragma unroll
        for (int ai = 0; ai < 2; ++ai) { f32x4 gp0 = {0.f, 0.f, 0.f, 0.f}, gp1 = {0.f, 0.f, 0.f, 0.f}; const int blk = u.pm * 4 + ai * 2 + wr;
#pragma unroll
            for (int m = 0; m < 4; ++m) { const int row = u.pm * 256 + ai * 128 + wr * 64 + m * 16 + fr; const float rs = rstd_of(rowss, row); const float rs2 = rs * rs;
                const f32x4 g0 = acc[ai][0][m][0] * acc[ai][1][m][0] * rs2, g1 = acc[ai][0][m][1] * acc[ai][1][m][1] * rs2;
                f32x4 p1a, p2a, p1b, p2b;
#pragma unroll
                for (int j = 0; j < 4; ++j) { const float s1a = fr == 15 ? gp0[j] : g0[j], s2a = fr >= 14 ? gp0[j] : g0[j], s1b = fr == 15 ? gp1[j] : g1[j], s2b = fr >= 14 ? gp1[j] : g1[j];
                    p1a[j] = dpp_ror1(s1a); p2a[j] = dpp_ror2(s2a); p1b[j] = dpp_ror1(s1b); p2b[j] = dpp_ror2(s2b); }
                const f32x4 a0 = w0a * p2a + w1a * p1a + w2a * g0, a1 = w0b * p2b + w1b * p1b + w2b * g1;
                const bool valid = (m > 0 || fr >= 2) && !(sample && m == 2 && fr < 2);
                if (valid) *(v4u*)(zc + (size_t)row * 1024 + c0) = pack8(a0, a1);
                if ((m & 1) == 0 && fr < 2) { float* sg = SG + (size_t)(blk * 8 + 2 * m + fr) * 1024 + c0; *(f32x4*)sg = g0; *(f32x4*)(sg + 4) = g1; }
                if ((m & 1) == 1 && fr >= 14) { float* sg = SG + (size_t)(blk * 8 + 2 * m + fr - 14) * 1024 + c0; *(f32x4*)sg = g0; *(f32x4*)(sg + 4) = g1; }
                gp0 = g0; gp1 = g1; } }
    }
};


struct EpiCz {
    static constexpr bool PERM = true, AFTER_DRAIN = false;
    bf16* gb; const float* rowss; const float* cw; float* SG;
    __device__ __forceinline__ void operator()(EPI_ARGS) const {
        const int c0 = u.pn * 128 + wc * 32 + 8 * fq;
        const f32x4 w0a = *(const f32x4*)(cw + c0), w0b = *(const f32x4*)(cw + c0 + 4), w1a = *(const f32x4*)(cw + 1024 + c0), w1b = *(const f32x4*)(cw + 1024 + c0 + 4),
                    w2a = *(const f32x4*)(cw + 2048 + c0), w2b = *(const f32x4*)(cw + 2048 + c0 + 4);
#pragma unroll
        for (int ai = 0; ai < 2; ++ai) { f32x4 gp0 = {0.f, 0.f, 0.f, 0.f}, gp1 = {0.f, 0.f, 0.f, 0.f}; const int blk = u.pm * 4 + ai * 2 + wr;
#pragma unroll
            for (int m = 0; m < 4; ++m) { const int row = u.pm * 256 + ai * 128 + wr * 64 + m * 16 + fr; const float rs = rstd_of(rowss, row); const float rs2 = rs * rs;
                const f32x4 g0 = acc[ai][0][m][0] * acc[ai][1][m][0] * rs2, g1 = acc[ai][0][m][1] * acc[ai][1][m][1] * rs2;
                f32x4 p1a, p2a, p1b, p2b;
#pragma unroll
                for (int j = 0; j < 4; ++j) { const float s1a = fr == 15 ? gp0[j] : g0[j], s2a = fr >= 14 ? gp0[j] : g0[j], s1b = fr == 15 ? gp1[j] : g1[j], s2b = fr >= 14 ? gp1[j] : g1[j];
                    p1a[j] = dpp_ror1(s1a); p2a[j] = dpp_ror2(s2a); p1b[j] = dpp_ror1(s1b); p2b[j] = dpp_ror2(s2b); }
                const f32x4 a0 = w0a * p2a + w1a * p1a + w2a * g0, a1 = w0b * p2b + w1b * p1b + w2b * g1;
                if (m > 0 || fr >= 2) { bf16* gp = gb + (size_t)row * 1024 + c0; const v4u gw = *(const v4u*)gp;
                    const f32x4 b0 = (f32x4){bflo(gw.x), bfhi(gw.x), bflo(gw.y), bfhi(gw.y)}, b1 = (f32x4){bflo(gw.z), bfhi(gw.z), bflo(gw.w), bfhi(gw.w)};
                    *(v4u*)gp = pack8(a0 * b0, a1 * b1); }
                if ((m & 1) == 0 && fr < 2) { float* sg = SG + (size_t)(blk * 8 + 2 * m + fr) * 1024 + c0; *(f32x4*)sg = g0; *(f32x4*)(sg + 4) = g1; }
                if ((m & 1) == 1 && fr >= 14) { float* sg = SG + (size_t)(blk * 8 + 2 * m + fr - 14) * 1024 + c0; *(f32x4*)sg = g0; *(f32x4*)(sg + 4) = g1; }
                gp0 = g0; gp1 = g1; } }
    }
};

__device__ __forceinline__ int rowmap(int mode, int n) {
    if (mode == 1) { if (n >= 512 && n < 1152) { const int d = n & 63; return (n & ~63) | (32 * ((d >> 4) & 1) + 8 * ((d >> 2) & 3) + 4 * (d >> 5) + (d & 3)); } return n; }
    if (mode == 2) { return n < DFF ? ((n >> 7) * 256 + (n & 127)) : (((n - DFF) >> 7) * 256 + 128 + ((n - DFF) & 127)); }
    if (mode == 3) { if (n < 1024) return n; const int c = (n - 1024) & 1023, z = n >= 2048 ? 1 : 0; return 1024 + (c >> 7) * 256 + z * 128 + (c & 127); }
    return n;
}
__device__ __forceinline__ void tr_item(const float* W, int K, int N, bf16* WT, const float* gain, float scale, int mode, LAS float* scr, int item, int lane) {
    const int nblk = N / 32, kb = item / nblk, nb = item % nblk, k0 = 64 * kb, n0 = 32 * nb;
#pragma unroll
    for (int i = 0; i < 8; ++i) { const int idx = lane + 64 * i, kk = idx >> 3, n4 = (idx & 7) * 4; const float gs = gain ? ((const GAS float*)gain)[k0 + kk] * scale : scale;
        const f32x4 w = __builtin_nontemporal_load((const GAS f32x4*)((const GAS float*)W + (size_t)(k0 + kk) * N + n0 + n4)); LAS float* d = scr + kk * 33 + n4; d[0] = w[0] * gs; d[1] = w[1] * gs; d[2] = w[2] * gs; d[3] = w[3] * gs; }
    LDS_WAIT(); asm volatile("" ::: "memory");
    const int c = lane & 7;
#pragma unroll
    for (int j = 0; j < 4; ++j) { const int n = (lane >> 3) + 8 * j; const LAS float* s = scr + (8 * c) * 33 + n;
        v4u o; o.x = pg8::cvt_pk_bf16(s[0 * 33], s[1 * 33]); o.y = pg8::cvt_pk_bf16(s[2 * 33], s[3 * 33]); o.z = pg8::cvt_pk_bf16(s[4 * 33], s[5 * 33]); o.w = pg8::cvt_pk_bf16(s[6 * 33], s[7 * 33]);
        *(GAS v4u*)((GAS bf16*)WT + (size_t)rowmap(mode, n0 + n) * K + k0 + 8 * c) = o; }
    LDS_WAIT(); asm volatile("" ::: "memory");
}
__device__ __forceinline__ double dexp_(double y) {
    const double k = rint(y * 1.4426950408889634); const double r = (y - k * 0.6931471803691238) - k * 1.9082149292705877e-10;
    double p = 1.0 / 6227020800.0;
    p = p * r + 1.0 / 479001600.0; p = p * r + 1.0 / 39916800.0; p = p * r + 1.0 / 3628800.0; p = p * r + 1.0 / 362880.0; p = p * r + 1.0 / 40320.0; p = p * r + 1.0 / 5040.0;
    p = p * r + 1.0 / 720.0; p = p * r + 1.0 / 120.0; p = p * r + 1.0 / 24.0; p = p * r + 1.0 / 6.0; p = p * r + 0.5; p = p * r + 1.0; p = p * r + 1.0;
    const long long bits = (long long)(1023 + (int)k) << 52; return p * __builtin_bit_cast(double, bits);
}
__device__ __forceinline__ void dsincos_(double x, double& s, double& c) {
    const double k = rint(x * 0.6366197723675814); const double r = (x - k * 1.5707963267948966) - k * 6.123233995736766e-17; const double r2 = r * r;
    const double sp = r * (1.0 + r2 * (-1.0 / 6.0 + r2 * (1.0 / 120.0 + r2 * (-1.0 / 5040.0 + r2 * (1.0 / 362880.0 + r2 * (-1.0 / 39916800.0 + r2 * (1.0 / 6227020800.0)))))));
    const double cp = 1.0 + r2 * (-0.5 + r2 * (1.0 / 24.0 + r2 * (-1.0 / 720.0 + r2 * (1.0 / 40320.0 + r2 * (-1.0 / 3628800.0 + r2 * (1.0 / 479001600.0 + r2 * (-1.0 / 87178291200.0)))))));
    const int q = ((int)k) & 3;
    s = q == 0 ? sp : q == 1 ? cp : q == 2 ? -sp : -cp; c = q == 0 ? cp : q == 1 ? -sp : q == 2 ? -cp : sp;
}

__device__ __forceinline__ const bf16* kvptr(const bf16* proj, const bf16* cb, int sample, int b, int c, int kvh, int kk, int isv) {
    if (!sample) { int pos = (c - 2) * 64 + kk; pos = pos < 0 ? 0 : pos; return proj + (size_t)(b * 4096 + pos) * 1280 + 1024 + isv * 128 + kvh * 64; }
    if (kk < 128) return cb + (size_t)(b * 128 + kk) * 128 + kvh * 64;
    int t = kk - 128; t = t > 31 ? 31 : t; return proj + (size_t)(MP + b * 32 + t) * 1280 + 1024 + isv * 128 + kvh * 64;
}
__device__ __forceinline__ void swa_phase(const bf16* proj, const bf16* ckb, const bf16* cvb, const float* sinks, bf16* ycat, LAS unsigned char* lds, int tid, int wave, int lane, int G) {
    LAS bf16* VT = (LAS bf16*)lds;
    const int fr = lane & 15, quad = lane >> 4;
    for (int it = blockIdx.x; it < 528; it += G) {
        int b, c, kvh, sample;
        if (it < 512) { sample = 0; b = it >> 7; c = (it >> 1) & 63; kvh = it & 1; } else { sample = 1; b = (it - 512) >> 1; c = 0; kvh = it & 1; }
        const int gq = wave >> 1, qhalf = wave & 1, head = kvh * 4 + gq;
        bf16x8 qf[2][2], kf0[4][2];
#pragma unroll
        for (int qb = 0; qb < 2; ++qb) { const int q = qhalf * 32 + qb * 16 + fr; const int row = sample ? MP + b * 32 + (q & 31) : b * 4096 + c * 64 + q;
            const GAS bf16* qp = (const GAS bf16*)proj + (size_t)row * 1280 + 512 + head * 64 + quad * 8; qf[qb][0] = *(const GAS bf16x8*)qp; qf[qb][1] = *(const GAS bf16x8*)(qp + 32); }
#pragma unroll
        for (int i = 0; i < 4; ++i) { const int key = 32 * (i >> 1) + (fr >> 2) * 8 + 4 * (i & 1) + (fr & 3); const GAS bf16* kp = (const GAS bf16*)kvptr(proj, ckb, sample, b, c, kvh, key, 0) + quad * 8;
            kf0[i][0] = *(const GAS bf16x8*)kp; kf0[i][1] = *(const GAS bf16x8*)(kp + 32); }
        __syncthreads();
#pragma unroll
        for (int i = 0; i < 3; ++i) { const int idx = tid + 512 * i, kk = idx % 192, dg = idx / 192; const v4u w = *(const GAS v4u*)((const GAS bf16*)kvptr(proj, cvb, sample, b, c, kvh, kk, 1) + dg * 8);
            LAS bf16* vp = VT + (dg * 8) * 200 + kk;
            vp[0] = (bf16)(w.x & 0xffffu); vp[200] = (bf16)(w.x >> 16); vp[400] = (bf16)(w.y & 0xffffu); vp[600] = (bf16)(w.y >> 16);
            vp[800] = (bf16)(w.z & 0xffffu); vp[1000] = (bf16)(w.z >> 16); vp[1200] = (bf16)(w.w & 0xffffu); vp[1400] = (bf16)(w.w >> 16); }
        __syncthreads();
        if (!(sample && qhalf)) {
            const int plo = sample ? 0 : (c >= 2 ? 0 : (2 - c) * 2), phi = sample ? 5 : 6;
            f32x4 s[12][2];
#pragma unroll
            for (int kg = 0; kg < 3; ++kg) { bf16x8 kf[4][2];
#pragma unroll
                for (int i = 0; i < 4; ++i) { if (kg == 0) { kf[i][0] = kf0[i][0]; kf[i][1] = kf0[i][1]; continue; } const int kb = kg * 4 + i, key = 32 * (kb >> 1) + (fr >> 2) * 8 + 4 * (kb & 1) + (fr & 3); const GAS bf16* kp = (const GAS bf16*)kvptr(proj, ckb, sample, b, c, kvh, key, 0) + quad * 8;
                    kf[i][0] = *(const GAS bf16x8*)kp; kf[i][1] = *(const GAS bf16x8*)(kp + 32); }
                __builtin_amdgcn_sched_barrier(0);
#pragma unroll
                for (int i = 0; i < 4; ++i)
#pragma unroll
                    for (int qb = 0; qb < 2; ++qb) { f32x4 a = {0.f, 0.f, 0.f, 0.f}; a = MFMA16(kf[i][0], qf[qb][0], a); a = MFMA16(kf[i][1], qf[qb][1], a); s[kg * 4 + i][qb] = a; }
                __builtin_amdgcn_sched_barrier(0); }
            const float sink = sinks[head];
            bf16x8 pf[6][2];
#pragma unroll
            for (int qb = 0; qb < 2; ++qb) { float mx = sink;
#pragma unroll
                for (int kb = 0; kb < 12; ++kb) { const bool pv = (kb >> 1) >= plo && (kb >> 1) < phi;
#pragma unroll
                    for (int j = 0; j < 4; ++j) { const float v = pv ? s[kb][qb][j] : -1e30f; s[kb][qb][j] = v; mx = fmaxf(mx, v); } }
                mx = fmaxf(mx, __shfl_xor(mx, 16)); mx = fmaxf(mx, __shfl_xor(mx, 32));
                float sum = 0.f;
#pragma unroll
                for (int kb = 0; kb < 12; ++kb)
#pragma unroll
                    for (int j = 0; j < 4; ++j) { const float e = __expf(s[kb][qb][j] - mx); s[kb][qb][j] = e; sum += e; }
                sum += __shfl_xor(sum, 16); sum += __shfl_xor(sum, 32); sum += __expf(sink - mx);
                const float inv = 1.0f / sum;
#pragma unroll
                for (int pr = 0; pr < 6; ++pr) pf[pr][qb] = __builtin_bit_cast(bf16x8, pack8(s[2 * pr][qb] * inv, s[2 * pr + 1][qb] * inv)); }
#pragma unroll
            for (int db = 0; db < 4; ++db) { bf16x8 vf[6];
#pragma unroll
                for (int pr = 0; pr < 6; ++pr) vf[pr] = *(const LAS bf16x8*)(VT + (db * 16 + fr) * 200 + 32 * pr + quad * 8);
#pragma unroll
                for (int qb = 0; qb < 2; ++qb) { f32x4 o = {0.f, 0.f, 0.f, 0.f};
#pragma unroll
                    for (int pr = 0; pr < 6; ++pr) o = MFMA16(pf[pr][qb], vf[pr], o);
#pragma unroll
                    for (int j = 0; j < 4; ++j) { const int q = qhalf * 32 + qb * 16 + quad * 4 + j;
                        if (!sample || q < 32) { const int row = sample ? MP + b * 32 + q : b * 4096 + c * 64 + q; ycat[(size_t)row * 1024 + 512 + head * 64 + db * 16 + fr] = (bf16)f2bf(o[j]); } } } }
        }
    }
    __syncthreads();
}

__device__ __forceinline__ void xattn_phase(const bf16* qx, const bf16* memk_l, const bf16* memvT_l, bf16* ox, int wave, int lane, int G) {
    const int fr = lane & 15, quad = lane >> 4;
    for (int t = wave * G + (int)blockIdx.x; t < 4160; t += 8 * G) {
        int bb, h, row0;
        if (t < 4096) { const int pair = t >> 8; bb = pair >> 2; h = pair & 3; row0 = bb * 4096 + (t & 255) * 16; }
        else { const int s = t - 4096, b = s >> 3; h = (s >> 1) & 3; bb = 4 + b; row0 = MP + b * 32 + (s & 1) * 16; }
        bf16x8 qf[8];
#pragma unroll
        for (int ks = 0; ks < 8; ++ks) qf[ks] = *(const bf16x8*)(qx + (size_t)(row0 + fr) * 1024 + h * 256 + ks * 32 + quad * 8);
        const bf16* kbase = memk_l + (size_t)bb * 262144 + h * 256 + quad * 8;
        f32x4 s[16];
#pragma unroll
        for (int kb = 0; kb < 16; ++kb) { const int key = 32 * (kb >> 1) + (fr >> 2) * 8 + 4 * (kb & 1) + (fr & 3); const bf16* kp = kbase + (size_t)key * 1024; f32x4 a = {0.f, 0.f, 0.f, 0.f};
#pragma unroll
            for (int ks = 0; ks < 8; ++ks) a = MFMA16(*(const bf16x8*)(kp + ks * 32), qf[ks], a);
            s[kb] = a; }
        float mx = -1e30f;
#pragma unroll
        for (int kb = 0; kb < 16; ++kb)
#pragma unroll
            for (int j = 0; j < 4; ++j) mx = fmaxf(mx, s[kb][j]);
        mx = fmaxf(mx, __shfl_xor(mx, 16)); mx = fmaxf(mx, __shfl_xor(mx, 32));
        float sum = 0.f;
#pragma unroll
        for (int kb = 0; kb < 16; ++kb)
#pragma unroll
            for (int j = 0; j < 4; ++j) { const float e = __expf(s[kb][j] - mx); s[kb][j] = e; sum += e; }
        sum += __shfl_xor(sum, 16); sum += __shfl_xor(sum, 32);
        const float inv = 1.0f / sum;
        bf16x8 pf[8];
#pragma unroll
        for (int pr = 0; pr < 8; ++pr) pf[pr] = __builtin_bit_cast(bf16x8, pack8(s[2 * pr] * inv, s[2 * pr + 1] * inv));
        const bf16* vbase = memvT_l + (size_t)bb * 262144 + (size_t)(h * 256 + fr) * 256 + quad * 8;
#pragma unroll 4
        for (int db = 0; db < 16; ++db) { f32x4 o = {0.f, 0.f, 0.f, 0.f};
#pragma unroll
            for (int pr = 0; pr < 8; ++pr) o = MFMA16(pf[pr], *(const bf16x8*)(vbase + (size_t)db * 4096 + pr * 32), o);
#pragma unroll
            for (int j = 0; j < 4; ++j) ox[(size_t)(row0 + quad * 4 + j) * 1024 + h * 256 + db * 16 + fr] = (bf16)f2bf(o[j]); }
    }
}


__device__ __forceinline__ void xstage(const bf16* src, size_t rowstride, LAS unsigned char* lds, int tid) {
    v4u t[16];
#pragma unroll
    for (int i = 0; i < 16; ++i) { const int row = (tid >> 5) + 16 * i, ch = tid & 31; t[i] = *(const GAS v4u*)((const GAS bf16*)src + (size_t)row * rowstride + ch * 8); }
#pragma unroll
    for (int i = 0; i < 16; ++i) { const int row = (tid >> 5) + 16 * i, ch = tid & 31; *(LAS v4u*)(lds + row * 528 + ch * 16) = t[i]; }
}
__device__ __forceinline__ void xattn_phase2(const bf16* qx, const bf16* memk_l, const bf16* memvT_l, bf16* ox, LAS unsigned char* lds, int tid, int wave, int lane, int G) {
    const int fr = lane & 15, quad = lane >> 4;
    for (int it = blockIdx.x; it < 256 + 32; it += G) {
        int bb, h, rowbase, nqb; bool active;
        if (it < 256) { bb = it >> 6; h = (it >> 4) & 3; rowbase = bb * 4096 + (it & 15) * 256; nqb = 2; active = true; }
        else { const int s = it - 256, b = s >> 2; h = s & 3; bb = 4 + b; rowbase = MP + b * 32; nqb = 1; active = wave < 2; }
        __syncthreads();
        xstage(memk_l + (size_t)bb * 262144 + h * 256, 1024, lds, tid);
        __syncthreads();
        bf16x8 pf[2][8];
#pragma unroll
        for (int qi = 0; qi < 2; ++qi) {
            if (qi < nqb && active) {
                const int row0 = rowbase + qi * 128 + wave * 16;
                bf16x8 qf[8];
#pragma unroll
                for (int ks = 0; ks < 8; ++ks) qf[ks] = __builtin_nontemporal_load((const GAS bf16x8*)((const GAS bf16*)qx + (size_t)(row0 + fr) * 1024 + h * 256 + ks * 32 + quad * 8));
                f32x4 s[16];
#pragma unroll
                for (int kb = 0; kb < 16; ++kb) { const int key = 32 * (kb >> 1) + (fr >> 2) * 8 + 4 * (kb & 1) + (fr & 3); const LAS unsigned char* kp = lds + key * 528 + quad * 16; f32x4 a = {0.f, 0.f, 0.f, 0.f};
#pragma unroll
                    for (int ks = 0; ks < 8; ++ks) a = MFMA16(*(const LAS bf16x8*)(kp + ks * 64), qf[ks], a);
                    s[kb] = a; }
                float mx = -1e30f;
#pragma unroll
                for (int kb = 0; kb < 16; ++kb)
#pragma unroll
                    for (int j = 0; j < 4; ++j) mx = fmaxf(mx, s[kb][j]);
                mx = fmaxf(mx, __shfl_xor(mx, 16)); mx = fmaxf(mx, __shfl_xor(mx, 32));
                float sum = 0.f;
#pragma unroll
                for (int kb = 0; kb < 16; ++kb)
#pragma unroll
                    for (int j = 0; j < 4; ++j) { const float e = __expf(s[kb][j] - mx); s[kb][j] = e; sum += e; }
                sum += __shfl_xor(sum, 16); sum += __shfl_xor(sum, 32);
                const float inv = 1.0f / sum;
#pragma unroll
                for (int pr = 0; pr < 8; ++pr) pf[qi][pr] = __builtin_bit_cast(bf16x8, pack8(s[2 * pr] * inv, s[2 * pr + 1] * inv));
            }
        }
        __syncthreads();
        xstage(memvT_l + (size_t)bb * 262144 + (size_t)h * 65536, 256, lds, tid);
        __syncthreads();
        if (active) {
            const int rowA = rowbase + wave * 16, rowB = rowA + 128;
#pragma unroll 4
            for (int db = 0; db < 16; ++db) { f32x4 oa = {0.f, 0.f, 0.f, 0.f}, ob = {0.f, 0.f, 0.f, 0.f}; const LAS unsigned char* vp = lds + (db * 16 + fr) * 528 + quad * 16;
                if (nqb == 2) {
#pragma unroll
                    for (int pr = 0; pr < 8; ++pr) { const bf16x8 vf = *(const LAS bf16x8*)(vp + pr * 64); oa = MFMA16(vf, pf[0][pr], oa); ob = MFMA16(vf, pf[1][pr], ob); }
                } else {
#pragma unroll
                    for (int pr = 0; pr < 8; ++pr) { const bf16x8 vf = *(const LAS bf16x8*)(vp + pr * 64); oa = MFMA16(vf, pf[0][pr], oa); }
                }
                u32x2v w; w.x = pk2(oa[0], oa[1]); w.y = pk2(oa[2], oa[3]);
                *(GAS u32x2v*)((GAS bf16*)ox + (size_t)(rowA + fr) * 1024 + h * 256 + db * 16 + quad * 4) = w;
                if (nqb == 2) { u32x2v w2; w2.x = pk2(ob[0], ob[1]); w2.y = pk2(ob[2], ob[3]); *(GAS u32x2v*)((GAS bf16*)ox + (size_t)(rowB + fr) * 1024 + h * 256 + db * 16 + quad * 4) = w2; } }
        }
    }
    __syncthreads();
}

__device__ __forceinline__ void s5_stage_u(const bf16* up, LAS float* ubuf, int lane) {
    const v4u w0 = *(const v4u*)up, w1 = *(const v4u*)(up + 8);
    LAS f32x4* d = (LAS f32x4*)(ubuf + lane * 16);
    d[0] = (f32x4){bflo(w0.x), bfhi(w0.x), bflo(w0.y), bfhi(w0.y)}; d[1] = (f32x4){bflo(w0.z), bfhi(w0.z), bflo(w0.w), bfhi(w0.w)};
    d[2] = (f32x4){bflo(w1.x), bfhi(w1.x), bflo(w1.y), bfhi(w1.y)}; d[3] = (f32x4){bflo(w1.z), bfhi(w1.z), bflo(w1.w), bfhi(w1.w)};
}
__device__ __forceinline__ f32x2v lo2_(f32x4 v) { return __builtin_shufflevector(v, v, 0, 1); }
__device__ __forceinline__ f32x2v hi2_(f32x4 v) { return __builtin_shufflevector(v, v, 2, 3); }
#define S5_STEP(sidx) do { const LAS f32x4* up_ = (const LAS f32x4*)(ubuf + (sidx) * 16); const f32x4 u0 = up_[0], u1 = up_[1], u2 = up_[2], u3 = up_[3]; \
    f32x2v ac_ = lo2_(bb[0]) * u0[0]; ac_ = hi2_(bb[0]) * u0[1] + ac_; ac_ = lo2_(bb[1]) * u0[2] + ac_; ac_ = hi2_(bb[1]) * u0[3] + ac_; \
    ac_ = lo2_(bb[2]) * u1[0] + ac_; ac_ = hi2_(bb[2]) * u1[1] + ac_; ac_ = lo2_(bb[3]) * u1[2] + ac_; ac_ = hi2_(bb[3]) * u1[3] + ac_; \
    ac_ = lo2_(bb[4]) * u2[0] + ac_; ac_ = hi2_(bb[4]) * u2[1] + ac_; ac_ = lo2_(bb[5]) * u2[2] + ac_; ac_ = hi2_(bb[5]) * u2[3] + ac_; \
    ac_ = lo2_(bb[6]) * u3[0] + ac_; ac_ = hi2_(bb[6]) * u3[1] + ac_; ac_ = lo2_(bb[7]) * u3[2] + ac_; ac_ = hi2_(bb[7]) * u3[3] + ac_; \
    const float nr_ = ar * hr - ai * hi + ac_.x, ni_ = ar * hi + ai * hr + ac_.y; hr = nr_; hi = ni_; } while (0)

typedef short bf16x4_t __attribute__((ext_vector_type(4)));
#define MFMA16K16(a, b, c) __builtin_amdgcn_mfma_f32_16x16x16bf16_1k(a, b, c, 0, 0, 0)
__device__ __forceinline__ bf16x4_t s5_load_u(const bf16* urow0, int fr, int quad) { return *(const GAS bf16x4_t*)((const GAS bf16*)urow0 + (size_t)fr * 1280 + quad * 4); }
__device__ __forceinline__ void s5_bu_block(const bf16x4_t a, const bf16x4_t (&bcf)[8], LAS float* bul, int fr, int quad) {
#pragma unroll
    for (int cb = 0; cb < 8; ++cb) { f32x4 d = {0.f, 0.f, 0.f, 0.f}; d = MFMA16K16(a, bcf[cb], d);
#pragma unroll
        for (int j = 0; j < 4; ++j) bul[(quad * 4 + j) * 130 + cb * 16 + fr] = d[j]; }
}
__device__ __forceinline__ void s5_local(const bf16* proj, const float* abar, const bf16* bbt, float* sloc, LAS float* bul, int slot, int nslots, int lane) {
    const int fr = lane & 15, quad = lane >> 4;
    for (int t = slot; t < 8192; t += nslots) {
        const int chunk = t & 63, g = (t >> 6) & 31, b = t >> 11;
        const float ar = abar[(g * 64 + lane) * 2], ai = abar[(g * 64 + lane) * 2 + 1];
        bf16x4_t bcf[8];
#pragma unroll
        for (int cb = 0; cb < 8; ++cb) bcf[cb] = *(const GAS bf16x4_t*)((const GAS bf16*)bbt + (size_t)(g * 128 + cb * 16 + fr) * 16 + quad * 4);
        float hr = 0.f, hi = 0.f;
        bf16x4_t ua[4];
#pragma unroll
        for (int blk = 0; blk < 4; ++blk) ua[blk] = s5_load_u(proj + (size_t)(b * 4096 + chunk * 64 + blk * 16) * 1280 + g * 16, fr, quad);
#pragma unroll
        for (int blk = 0; blk < 4; ++blk) {
            s5_bu_block(ua[blk], bcf, bul, fr, quad);
#pragma unroll 4
            for (int s = 0; s < 16; ++s) { const f32x2v bu = *(const LAS f32x2v*)(bul + s * 130 + 2 * lane); const float nr = ar * hr - ai * hi + bu.x, ni = ar * hi + ai * hr + bu.y; hr = nr; hi = ni; }
        }
        *(f32x2v*)(sloc + (size_t)t * 128 + lane * 2) = (f32x2v){hr, hi};
    }
}
__device__ __forceinline__ void s5_out(const bf16* proj, const float* abar, const bf16* bbt, const float* sloc, const float* st_re, const float* st_im, const float* c_re, const float* c_im,
                                       const float* dcoef, bf16* gbuf, float* out, LAS float* bul, LAS unsigned* hbuf, int slot, int nslots, int lane) {
    const int fr = lane & 15, quad = lane >> 4;
    for (int t = slot; t < 8192 + 256; t += nslots) {
        const int sample = t >= 8192; int b, g, chunk, nblk, rowbase;
        if (!sample) { chunk = t & 63; g = (t >> 6) & 31; b = t >> 11; nblk = 4; rowbase = b * 4096 + chunk * 64; } else { const int s = t - 8192; g = s & 31; b = s >> 5; chunk = 0; nblk = 2; rowbase = MP + b * 32; }
        const float ar = abar[(g * 64 + lane) * 2], ai = abar[(g * 64 + lane) * 2 + 1];
        bf16x4_t bcf[8];
#pragma unroll
        for (int cb = 0; cb < 8; ++cb) bcf[cb] = *(const GAS bf16x4_t*)((const GAS bf16*)bbt + (size_t)(g * 128 + cb * 16 + fr) * 16 + quad * 4);
        float hr, hi;
        if (!sample) { float pr = ar, pi = ai;
#pragma unroll
            for (int i = 0; i < 6; ++i) { const float t1 = pr * pr - pi * pi; pi = 2.f * pr * pi; pr = t1; }
            hr = 0.f; hi = 0.f; const float* sp = sloc + (size_t)(t - chunk) * 128 + lane * 2;
#pragma unroll 16
            for (int cc = 0; cc < chunk; ++cc) { const f32x2v sv = *(const f32x2v*)(sp + (size_t)cc * 128); const float nr = pr * hr - pi * hi + sv.x, ni = pr * hi + pi * hr + sv.y; hr = nr; hi = ni; } }
        else { hr = st_re[(b * 32 + g) * 64 + lane]; hi = st_im[(b * 32 + g) * 64 + lane]; }
        bf16x8 cf[4];
#pragma unroll
        for (int ks = 0; ks < 4; ++ks) { const f32x4 cr = *(const f32x4*)(c_re + (size_t)(g * 16 + fr) * 64 + ks * 16 + quad * 4), ci = *(const f32x4*)(c_im + (size_t)(g * 16 + fr) * 64 + ks * 16 + quad * 4);
            v4u w; w.x = pg8::cvt_pk_bf16(cr[0], -ci[0]); w.y = pg8::cvt_pk_bf16(cr[1], -ci[1]); w.z = pg8::cvt_pk_bf16(cr[2], -ci[2]); w.w = pg8::cvt_pk_bf16(cr[3], -ci[3]); cf[ks] = __builtin_bit_cast(bf16x8, w); }
        const float dco = dcoef[g * 16 + fr];
        bf16x4_t ua[4]; bf16 uraw[4][4];
#pragma unroll
        for (int blk = 0; blk < 4; ++blk) { const int bc = blk < nblk ? blk : nblk - 1; const bf16* urow0 = proj + (size_t)(rowbase + bc * 16) * 1280 + g * 16; ua[blk] = s5_load_u(urow0, fr, quad);
#pragma unroll
            for (int j = 0; j < 4; ++j) uraw[blk][j] = ((const GAS bf16*)urow0)[(size_t)(quad * 4 + j) * 1280 + fr]; }
#pragma unroll
        for (int blk = 0; blk < 4; ++blk) { if (blk < nblk) {
            s5_bu_block(ua[blk], bcf, bul, fr, quad);
#pragma unroll 4
            for (int s = 0; s < 16; ++s) { const f32x2v bu = *(const LAS f32x2v*)(bul + s * 130 + 2 * lane); const float nr = ar * hr - ai * hi + bu.x, ni = ar * hi + ai * hr + bu.y; hr = nr; hi = ni; hbuf[s * 68 + lane] = pg8::cvt_pk_bf16(hr, hi); }
            f32x4 y = {0.f, 0.f, 0.f, 0.f};
#pragma unroll
            for (int ks = 0; ks < 4; ++ks) { const bf16x8 a = *(const LAS bf16x8*)(hbuf + fr * 68 + ks * 16 + quad * 4); y = MFMA16(a, cf[ks], y); }
#pragma unroll
            for (int j = 0; j < 4; ++j) { const int s = blk * 16 + quad * 4 + j; const float uu = bflo((unsigned)uraw[blk][j]); const float yv = y[j] + dco * uu;
                const float z = 0.7978845608028654f * (yv + 0.044715f * yv * yv * yv); const float th = 1.0f - 2.0f / (1.0f + __expf(2.0f * z)); const float gl = 0.5f * yv * (1.0f + th);
                ((GAS bf16*)gbuf)[(size_t)(rowbase + s) * 512 + g * 16 + fr] = (bf16)f2bf(gl); }
        } }
        if (!sample && chunk == 63) { out[OFF_SRP + (b * 32 + g) * 64 + lane] = hr; out[OFF_SIP + (b * 32 + g) * 64 + lane] = hi; }
        if (sample) { out[OFF_SRS + (b * 32 + g) * 64 + lane] = hr; out[OFF_SIS + (b * 32 + g) * 64 + lane] = hi; }
    }
}

template <int KIND>
__device__ __forceinline__ void sample_gemm(const bf16* A, const bf16* Bt, int K, LAS unsigned char* lds, int tid, int wave, int lane,
                                            bf16* xbp, const float* base_f32, float* part_next, const float* part_cur, bf16* O) {
    const int fr = lane & 15, quad = lane >> 4;
    LAS f32x4* red = (LAS f32x4*)lds;
    LAS float* ssred = (LAS float*)(lds + 32768);
    for (int tile = blockIdx.x; tile < 256; tile += gridDim.x) {
        const int r0 = MP + (tile >> 4) * 16, c0 = (tile & 15) * 64, kw = K >> 3;
        const bf16* ap = A + (size_t)(r0 + fr) * K + wave * kw + quad * 8;
        const bf16* bp = Bt + (size_t)(c0 + fr) * K + wave * kw + quad * 8;
        f32x4 acc[4];
#pragma unroll
        for (int cb = 0; cb < 4; ++cb) acc[cb] = (f32x4){0.f, 0.f, 0.f, 0.f};
        const int e_cb = (tid >> 6) & 3, e_l2 = tid & 63, e_row = r0 + (e_l2 & 15), e_col = c0 + e_cb * 16 + 4 * (e_l2 >> 4); const size_t e_off = (size_t)e_row * 1024 + e_col;
        f32x4 e_bs = {0.f, 0.f, 0.f, 0.f}; float e_rs = 1.f;
        if (tid < 256) { if (KIND == 0) { if (base_f32) e_bs = *(const f32x4*)(base_f32 + e_off); else { const u32x2v w = *(const u32x2v*)(xbp + e_off); e_bs = (f32x4){bflo(w.x), bfhi(w.x), bflo(w.y), bfhi(w.y)}; } }
                         else e_rs = rstd_of(part_cur, e_row); }
        const int nks = kw >> 5;
        for (int k0 = 0; k0 < nks; k0 += 4) {
            bf16x8 a[4], b[4][4];
#pragma unroll
            for (int i = 0; i < 4; ++i) { const int ks = (k0 + i < nks) ? k0 + i : nks - 1;
                a[i] = *(const bf16x8*)(ap + ks * 32);
#pragma unroll
                for (int cb = 0; cb < 4; ++cb) b[i][cb] = *(const bf16x8*)(bp + (size_t)cb * 16 * K + ks * 32); }
            __builtin_amdgcn_sched_barrier(0);
#pragma unroll
            for (int i = 0; i < 4; ++i) if (k0 + i < nks) {
#pragma unroll
                for (int cb = 0; cb < 4; ++cb) acc[cb] = MFMA16(b[i][cb], a[i], acc[cb]); }
        }
#pragma unroll
        for (int cb = 0; cb < 4; ++cb) red[(wave * 4 + cb) * 64 + lane] = acc[cb] * 1.0f;
        __syncthreads();
        if (tid < 256) { const int cb = tid >> 6, l2 = tid & 63; f32x4 v = red[cb * 64 + l2];
#pragma unroll
            for (int w = 1; w < 8; ++w) v = v + red[(w * 4 + cb) * 64 + l2];
            const int row = r0 + (l2 & 15), col = c0 + cb * 16 + 4 * (l2 >> 4); const size_t off = (size_t)row * 1024 + col;
            if (KIND == 0) {
                v = v + e_bs; u32x2v o; o.x = pk2(v[0], v[1]); o.y = pk2(v[2], v[3]); *(u32x2v*)(xbp + off) = o;
                float ss = (v[0] * v[0] + v[1] * v[1]) + (v[2] * v[2] + v[3] * v[3]); ss += __shfl_xor(ss, 16); ss += __shfl_xor(ss, 32);
                if ((l2 >> 4) == 0) ssred[cb * 16 + (l2 & 15)] = ss; }
            else { const float rs = e_rs; u32x2v o; o.x = pk2(v[0] * rs, v[1] * rs); o.y = pk2(v[2] * rs, v[3] * rs); *(u32x2v*)(O + off) = o; }
        }
        if (KIND == 0) { __syncthreads(); if (tid < 16) part_next[(size_t)(r0 + tid) * 16 + (tile & 15)] = (ssred[tid] + ssred[16 + tid]) + (ssred[32 + tid] + ssred[48 + tid]); }
        __syncthreads();
    }
}


__device__ __forceinline__ void sample_cz(const bf16* A, const bf16* Bt, LAS unsigned char* lds, int tid, int wave, int lane,
                                          const float* part_cur, const float* cw, const float* st, bf16* zcp, float* outp) {
    const int fr = lane & 15, quad = lane >> 4;
    LAS f32x4* red = (LAS f32x4*)lds;
    LAS float* T = (LAS float*)(lds + 65536);
    LAS float* CZ = (LAS float*)(lds + 65536 + 8192);
    for (int tile = blockIdx.x; tile < 256; tile += gridDim.x) {
        const int b = tile >> 5, c0 = (tile & 31) * 32, r0 = MP + b * 32;
        const int wrow = 1024 + (c0 >> 7) * 256 + (c0 & 127);
        const GAS bf16* ap = (const GAS bf16*)A + (size_t)(r0 + fr) * 1024 + wave * 128 + quad * 8;
        const GAS bf16* bp = (const GAS bf16*)Bt + (size_t)(wrow + fr) * 1024 + wave * 128 + quad * 8;
        bf16x8 a[4][2], bw[4][4];
#pragma unroll
        for (int ks = 0; ks < 4; ++ks) {
#pragma unroll
            for (int rb = 0; rb < 2; ++rb) a[ks][rb] = *(const GAS bf16x8*)(ap + (size_t)rb * 16 * 1024 + ks * 32);
#pragma unroll
            for (int cb = 0; cb < 4; ++cb) bw[ks][cb] = *(const GAS bf16x8*)(bp + (size_t)((cb >> 1) * 128 + (cb & 1) * 16) * 1024 + ks * 32); }
        f32x4 acc[2][4];
#pragma unroll
        for (int rb = 0; rb < 2; ++rb)
#pragma unroll
            for (int cb = 0; cb < 4; ++cb) { f32x4 d = {0.f, 0.f, 0.f, 0.f};
#pragma unroll
                for (int ks = 0; ks < 4; ++ks) d = MFMA16(bw[ks][cb], a[ks][rb], d);
                acc[rb][cb] = d; }
#pragma unroll
        for (int rb = 0; rb < 2; ++rb)
#pragma unroll
            for (int cb = 0; cb < 4; ++cb) red[(wave * 8 + rb * 4 + cb) * 64 + lane] = acc[rb][cb];
        __syncthreads();
        {
            const int blk = tid >> 6, l2 = tid & 63, rb = blk >> 2, cb = blk & 3; f32x4 v = red[blk * 64 + l2];
#pragma unroll
            for (int w = 1; w < 8; ++w) v = v + red[(w * 8 + blk) * 64 + l2];
            *(LAS f32x4*)(T + ((cb >> 1) * 32 + rb * 16 + (l2 & 15)) * 32 + (cb & 1) * 16 + 4 * (l2 >> 4)) = v; }
        __syncthreads();
        const int r = tid >> 3, cq = (tid & 7) * 4;
        if (tid < 256) { const float rs = rstd_of(part_cur, r0 + r); const float rs2 = rs * rs;
            const f32x4 gc = *(const LAS f32x4*)(T + r * 32 + cq), zz = *(const LAS f32x4*)(T + (32 + r) * 32 + cq);
            *(LAS f32x4*)(CZ + r * 32 + cq) = gc * zz * rs2; }
        __syncthreads();
        if (tid < 256) { const int c = c0 + cq;
            const f32x4 x0 = *(const LAS f32x4*)(CZ + r * 32 + cq);
            const f32x4 s0 = *(const f32x4*)(st + (size_t)(b * 2) * 1024 + c), s1 = *(const f32x4*)(st + (size_t)(b * 2 + 1) * 1024 + c);
            f32x4 xm1 = s1, xm2 = s0;
            if (r >= 1) { xm1 = *(const LAS f32x4*)(CZ + (r - 1) * 32 + cq); xm2 = s1; }
            if (r >= 2) xm2 = *(const LAS f32x4*)(CZ + (r - 2) * 32 + cq);
            const f32x4 w0 = *(const f32x4*)(cw + c), w1 = *(const f32x4*)(cw + 1024 + c), w2 = *(const f32x4*)(cw + 2048 + c);
            const f32x4 z = w0 * xm2 + w1 * xm1 + w2 * x0;
            bf16* gp = zcp + (size_t)(r0 + r) * 1024 + c; const u32x2v gw = *(const u32x2v*)gp;
            u32x2v o; o.x = pk2(z[0] * bflo(gw.x), z[1] * bfhi(gw.x)); o.y = pk2(z[2] * bflo(gw.y), z[3] * bfhi(gw.y)); *(u32x2v*)gp = o;
            if (r >= 30) *(f32x4*)(outp + OFF_CMS + (size_t)(b * 2 + (r - 30)) * 1024 + c) = x0; }
        __syncthreads();
    }
}

struct Params { const float* in[36]; float* out; unsigned char* ws; int use_cg, pad; };

__global__ void __launch_bounds__(512, 2) mega_fwd(Params P) {
    extern __shared__ __attribute__((aligned(16))) unsigned char lds_raw[];
    LAS unsigned char* lds = (LAS unsigned char*)lds_raw;
    volatile LAS unsigned* MISC = (volatile LAS unsigned*)(lds + MISC_OFF);
    const int G = gridDim.x, NGW = G * 8, NT = G * 512;
    const int wave_s = __builtin_amdgcn_readfirstlane(threadIdx.x >> 6);
    for (int u = threadIdx.x; u < (LDS_BYTES - 131072) / 4; u += 512) ((LAS unsigned*)(lds + 131072))[u] = 0u;
    __syncthreads();
    XcdBarrier bar = xcd_barrier_post((unsigned*)(P.ws + WS_BAR), MISC + 8);
#ifndef STOP_AFTER
#define STOP_AFTER 1000
#endif
    int ph = 0;
#define RUN (ph < STOP_AFTER)
#define FRESH() const int tid = fresh_tid(wave_s), lane = tid & 63, wave = __builtin_amdgcn_readfirstlane(tid >> 6); const int gw = blockIdx.x * 8 + wave, gt = blockIdx.x * 512 + tid; (void)gw; (void)gt; (void)lane; LAS float* wscr = (LAS float*)(lds + 32768 + wave * 12288); (void)wscr;
#define SEAM() do { if (P.use_cg) cg::this_grid().sync(); else xcd_barrier(bar); ++ph; } while (0)

#define part ((float*)(ws + WS_PART))
#define PARTBUF(k) (part + (size_t)((k) & 1) * PART_ELEMS)
#define ropec ((float*)(ws + WS_ROPE))
#define ropes (ropec + 4096 * 32)
#define abar ((float*)(ws + WS_SSM))
#define bbar (abar + 32 * 64 * 2)
#define bbt ((bf16*)(bbar + 32 * 64 * 32))
#define ckb ((bf16*)(ws + WS_CKV))
#define cvb (ckb + 8 * 128 * 128)
#define sloc ((float*)(ws + WS_SLOC))
#define memk ((bf16*)(ws + WS_MEMK))
#define memvT ((bf16*)(ws + WS_MEMVT))
#define SG ((float*)(ws + WS_SIDE))
#define SV ((float*)(ws + WS_SIDE + SG_BYTES))
#define WT ((bf16*)(ws + WS_WT))
#define xb ((bf16*)(ws + WS_XB))
#define tmp (ws + WS_TMP)
#define proj0 ((bf16*)(tmp + TMP_PROJ0))
#define gbuf ((bf16*)(tmp + TMP_GBUF))
#define ycat ((bf16*)(tmp + TMP_YCAT))
#define memb ((bf16*)(tmp + TMP_MEMB))
#define qx ((bf16*)(tmp + TMP_QX))
#define ox ((bf16*)(tmp + TMP_OX))
#define act ((bf16*)(tmp + TMP_ACT))
#define gbm ((bf16*)(tmp + TMP_GB))
#define zc ((bf16*)(tmp + TMP_ZC))
#define PTRS() GAS unsigned char* wsg_ = (GAS unsigned char*)P.ws; GAS float* outg_ = (GAS float*)P.out; asm volatile("" : "+s"(wsg_), "+s"(outg_)); unsigned char* ws = (unsigned char*)wsg_; float* out = (float*)outg_;
    if (RUN) { PTRS() FRESH()
        {
            constexpr int NITEMS = 640 + 128 + 512 + 512 + 2 * 1024 + 512 + 2816 + 1408 + 1024;
            for (int it = gw; it < NITEMS; it += NGW) { int r = it;
#define TR(Wp, K_, N_, WTp, gainp, sc, mode) { const int ni_ = ((K_) / 64) * ((N_) / 32); if (r < ni_) { tr_item(Wp, K_, N_, WTp, gainp, sc, mode, wscr, r, lane); continue; } r -= ni_; }
                TR(P.in[15], 1024, 1280, WT + WT_INEVEN, P.in[11], 1.f, 1)
                TR(P.in[25], 512, 512, WT + WT_GLU, nullptr, 1.f, 0)
                TR(P.in[16], 1024, 1024, WT + WT_OUTEVEN, nullptr, 1.f, 0)
                TR(P.in[30], 1024, 1024, WT + WT_WQ, P.in[12], 0.0625f, 0)
                TR(P.in[31], 1024, 2048, WT + WT_WKV, nullptr, 1.f, 0)
                TR(P.in[31] + 2097152, 1024, 2048, WT + WT_WKV + 2097152, nullptr, 1.f, 0)
                TR(P.in[32], 1024, 1024, WT + WT_WO, nullptr, 1.f, 0)
                TR(P.in[33], 1024, 5632, WT + WT_UP, P.in[13], 1.f, 2)
                TR(P.in[35], 2816, 1024, WT + WT_DOWN, nullptr, 1.f, 0)
                { const int mi = r >> 7, l = mi >> 3, b = mi & 7; tr_item(P.in[10] + (size_t)mi * 262144, 256, 1024, memvT + (size_t)(l * 12 + 4 + b) * 262144, nullptr, 1.f, 0, wscr, r & 127, lane); }
            }
        }
        for (int m = gw; m < MROWS; m += NGW) { const float* xr = m < MP ? P.in[0] + (size_t)m * 1024 : P.in[1] + (size_t)(m - MP) * 1024; float ss = 0.f;
#pragma unroll
            for (int j = 0; j < 4; ++j) { const f32x4 v = __builtin_nontemporal_load((const f32x4*)(xr + (lane + 64 * j) * 4)); ss += (v[0] * v[0] + v[1] * v[1]) + (v[2] * v[2] + v[3] * v[3]);
                u32x2v w; w.x = pg8::cvt_pk_bf16(v[0], v[1]); w.y = pg8::cvt_pk_bf16(v[2], v[3]); *(u32x2v*)(xb + (size_t)m * 1024 + (lane + 64 * j) * 4) = w; }
            ss = wave_sum(ss); if (lane < 16) PARTBUF(0)[(size_t)m * 16 + lane] = lane == 0 ? ss : 0.f; }
        for (int i = gt; i < 262144; i += NT) { const f32x4 v = __builtin_nontemporal_load((const f32x4*)(P.in[2] + (size_t)i * 4)); u32x2v w; w.x = pg8::cvt_pk_bf16(v[0], v[1]); w.y = pg8::cvt_pk_bf16(v[2], v[3]); *(u32x2v*)(memb + (size_t)i * 4) = w; }
        for (int i = gt; i < 524288; i += NT) { const size_t e = (size_t)i * 4; const int lb = (int)(e >> 18), l = lb >> 3, b = lb & 7; const f32x4 v = __builtin_nontemporal_load((const f32x4*)(P.in[9] + e));
            u32x2v w; w.x = pg8::cvt_pk_bf16(v[0], v[1]); w.y = pg8::cvt_pk_bf16(v[2], v[3]); *(u32x2v*)(memk + (size_t)(l * 12 + 4 + b) * 262144 + (e & 262143)) = w; }
        for (int i = gt; i < 65536; i += NT) { const int j = i & 32767; const float* src = (i < 32768 ? P.in[3] : P.in[4]) + (size_t)j * 4; bf16* dst = (i < 32768 ? ckb : cvb) + (size_t)j * 4;
            const f32x4 v = *(const f32x4*)src; u32x2v w; w.x = pg8::cvt_pk_bf16(v[0], v[1]); w.y = pg8::cvt_pk_bf16(v[2], v[3]); *(u32x2v*)dst = w; }
        for (int i = gt; i < 4096 * 32; i += NT) { const int pos = i >> 5, d = i & 31; const double inv = dexp_(-(double)d * (9.210340371976184 / 32.0)); double s, c; dsincos_((double)pos * inv, s, c); ropec[i] = (float)c; ropes[i] = (float)s; }
        for (int i = gt; i < 2048; i += NT) { const double are = P.in[17][i], aim = P.in[18][i], dt = dexp_((double)P.in[19][i]); double s, c; dsincos_(aim * dt, s, c); const double mag = dexp_(are * dt);
            const double br = mag * c, bi = mag * s; abar[2 * i] = (float)br; abar[2 * i + 1] = (float)bi;
            const double nr = br - 1.0, ni = bi, den = are * are + aim * aim; const double qr = (nr * are + ni * aim) / den, qi = (ni * are - nr * aim) / den;
#pragma unroll 4
            for (int h = 0; h < 16; ++h) { const double xr = P.in[20][(size_t)i * 16 + h], xi = P.in[21][(size_t)i * 16 + h]; const float fre = (float)(qr * xr - qi * xi), fim = (float)(qr * xi + qi * xr); bbar[(size_t)i * 32 + 2 * h] = fre; bbar[(size_t)i * 32 + 2 * h + 1] = fim;
                bbt[((size_t)i * 2) * 16 + h] = (bf16)f2bf(fre); bbt[((size_t)i * 2 + 1) * 16 + h] = (bf16)f2bf(fim); } }
    }
    SEAM();
    if (RUN) { PTRS()
        if (G < 128 || (int)blockIdx.x >= G - 64) { pg8::Gemm g{memb, WT + WT_WKV, 1024, 4096, 1024}; pg8::StaticOrder S;
            if (G < 128) S.init(1024, 4096, G, (int)blockIdx.x); else S.init(1024, 4096, 64, (int)blockIdx.x - (G - 64)); EpiKV E{out, memk};
          pg8::gemm_phase<EpiKV, pg8::StaticOrder, true, true>(lds, g, S, E, wave_s); }
        { pg8::Gemm g{xb, WT + WT_INEVEN, MROWS, 1280, 1024}; pg8::StaticOrderF S; S.init(MROWS, 1280, G, (int)blockIdx.x); EpiIn0 E{proj0, PARTBUF(0), ropec, ropes, out};
          pg8::gemm_phase<EpiIn0, pg8::StaticOrderF, true, true>(lds, g, S, E, wave_s); }
        {
            FRESH()
            const int bx = (int)blockIdx.x, n2 = 325 - G;
            int slot = -1, nw = 1;
            if (G == 256) { if (bx >= n2 && bx < G - 64) { slot = (bx - n2) * 8 + wave; nw = (G - 64 - n2) * 8; } } else { slot = gw; nw = NGW; }
            if (slot >= 0) for (int it = slot; it < 2816 + 1408; it += nw) { int r = it;
                TR(P.in[33] + (size_t)1024 * 5632, 1024, 5632, WT + WT_UP + (size_t)5632 * 1024, P.in[13] + 1024, 1.f, 2)
                tr_item(P.in[35] + (size_t)2816 * 1024, 2816, 1024, WT + WT_DOWN + (size_t)2816 * 1024, nullptr, 1.f, 0, wscr, r, lane); }
        }
    }
    SEAM();
    if (RUN) { PTRS() FRESH()
        swa_phase(proj0, ckb, cvb, P.in[26], ycat, lds, tid, wave, lane, G);
        s5_local(proj0, abar, bbt, sloc, wscr, wave * G + (int)blockIdx.x, NGW, lane);
        for (int it = wave * G + (int)blockIdx.x; it < 1024; it += NGW) { const int mi = it >> 7, l = mi >> 2, b = mi & 3;
            tr_item(out + OFF_MVP + (size_t)mi * 262144, 256, 1024, memvT + (size_t)(l * 12 + b) * 262144, nullptr, 1.f, 0, wscr, it & 127, lane); }
    }
    SEAM();
    if (RUN) { PTRS() FRESH() s5_out(proj0, abar, bbt, sloc, P.in[5], P.in[6], P.in[22], P.in[23], P.in[24], gbuf, out, (LAS float*)(lds + wave * 16384), (LAS unsigned*)(lds + wave * 16384 + 8448), wave * G + (int)blockIdx.x, NGW, lane); }
    SEAM();
    if (RUN) { PTRS() pg8::Gemm g{gbuf, WT + WT_GLU, MROWS, 512, 512}; pg8::StaticOrder S; S.init(MROWS, 512, G, (int)blockIdx.x); EpiGlu E{gbuf, ycat};
        pg8::gemm_phase<EpiGlu, pg8::StaticOrder, true, true>(lds, g, S, E, wave_s);
        {
            FRESH()
            const int bx = (int)blockIdx.x; int slot = -1, nw = 1;
            if (G > 130) { if (bx >= 130) { slot = (bx - 130) * 8 + wave; nw = (G - 130) * 8; } } else { slot = gw; nw = NGW; }
            if (slot >= 0) for (int it = slot; it < 1536 + 512; it += nw) { int r = it;
                TR(P.in[27], 1024, 3072, WT + WT_INODD, P.in[11] + 1024, 1.f, 3)
                tr_item(P.in[29], 1024, 1024, WT + WT_OUTODD, nullptr, 1.f, 0, wscr, r, lane); }
        } }
    SEAM();

#pragma unroll
    for (int l = 0; l < 2; ++l) {
        if (l == 1) {
            if (RUN) { PTRS() pg8::Gemm g{xb, WT + WT_INODD, MP, 1024, 1024}; pg8::StaticOrderF S; S.init(MP, 1024, G, (int)blockIdx.x); EpiBf16 E{gbm, 1024, PARTBUF(3)};
                pg8::gemm_phase<EpiBf16, pg8::StaticOrderF, true, true>(lds, g, S, E, wave_s);
                { FRESH() sample_gemm<1>(xb, WT + WT_INODD, 1024, lds, tid, wave, lane, nullptr, nullptr, nullptr, PARTBUF(3), gbm); } }
            SEAM();
            if (RUN) { PTRS() pg8::Gemm g{xb, WT + WT_INODD + (size_t)1024 * 1024, MP, 2048, 1024}; pg8::StaticOrderF S; S.init(MP, 2048, G, (int)blockIdx.x); EpiCz E{gbm, PARTBUF(3), P.in[28], SG};
                pg8::gemm_phase<EpiCz, pg8::StaticOrderF, true, true>(lds, g, S, E, wave_s);
                { FRESH() sample_cz(xb, WT + WT_INODD, lds, tid, wave, lane, PARTBUF(3), P.in[28], P.in[7], gbm, out); } }
            SEAM();
            if (RUN) { PTRS() FRESH()
                const float* cw = P.in[28];
                for (int i = gt; i < 512 * 128; i += NT) { const int ri = i >> 7, c0 = (i & 127) * 8, blk = ri >> 1, rr = ri & 1, row = blk * 64 + rr;
                    f32x4 pa0, pa1, pb0, pb1;
                    if ((blk & 63) == 0) { pa0 = pa1 = pb0 = pb1 = (f32x4){0.f, 0.f, 0.f, 0.f}; }
                    else { const float* s0 = SG + (size_t)((blk - 1) * 8 + 6) * 1024 + c0; pa0 = *(const f32x4*)s0; pa1 = *(const f32x4*)(s0 + 4); pb0 = *(const f32x4*)(s0 + 1024); pb1 = *(const f32x4*)(s0 + 1028); }
                    const float* sc = SG + (size_t)(blk * 8) * 1024 + c0; const f32x4 x00 = *(const f32x4*)sc, x01 = *(const f32x4*)(sc + 4);
                    f32x4 xm2a, xm2b, xm1a, xm1b, xca, xcb;
                    if (rr == 0) { xm2a = pa0; xm2b = pa1; xm1a = pb0; xm1b = pb1; xca = x00; xcb = x01; }
                    else { xm2a = pb0; xm2b = pb1; xm1a = x00; xm1b = x01; xca = *(const f32x4*)(sc + 1024); xcb = *(const f32x4*)(sc + 1028); }
                    const f32x4 w0a = *(const f32x4*)(cw + c0), w0b = *(const f32x4*)(cw + c0 + 4), w1a = *(const f32x4*)(cw + 1024 + c0), w1b = *(const f32x4*)(cw + 1028 + c0), w2a = *(const f32x4*)(cw + 2048 + c0), w2b = *(const f32x4*)(cw + 2052 + c0);
                    const f32x4 z0 = w0a * xm2a + w1a * xm1a + w2a * xca, z1 = w0b * xm2b + w1b * xm1b + w2b * xcb;
                    const v4u gw_ = *(const v4u*)(gbm + (size_t)row * 1024 + c0);
                    const f32x4 g0 = (f32x4){bflo(gw_.x), bfhi(gw_.x), bflo(gw_.y), bfhi(gw_.y)}, g1 = (f32x4){bflo(gw_.z), bfhi(gw_.z), bflo(gw_.w), bfhi(gw_.w)};
                    *(v4u*)(gbm + (size_t)row * 1024 + c0) = pack8(g0 * z0, g1 * z1); }
                for (int i = gt; i < 4 * 2 * 1024; i += NT) { const int c = i & 1023, j = (i >> 10) & 1, b = i >> 11; out[OFF_CMP + i] = SG[(size_t)((64 * b + 63) * 8 + 6 + j) * 1024 + c]; }
            }
            SEAM();
        }
        if (RUN) { PTRS() pg8::Gemm g{(bf16*)(tmp + (size_t)(1 - l) * TMP_YCAT), WT + WT_OUTEVEN + (size_t)l * (WT_OUTODD - WT_OUTEVEN), MP, 1024, 1024}; pg8::StaticOrderF S; S.init(MP, 1024, G, (int)blockIdx.x);
            EpiRes E{P.in[0], P.in[1] - (size_t)MP * 1024, xb, PARTBUF(1 + 3 * l), l == 0 ? 1 : 0};
            pg8::gemm_phase<EpiRes, pg8::StaticOrderF, true, true>(lds, g, S, E, wave_s);
            { FRESH() sample_gemm<0>((bf16*)(tmp + (size_t)(1 - l) * TMP_YCAT), WT + WT_OUTEVEN + (size_t)l * (WT_OUTODD - WT_OUTEVEN), 1024, lds, tid, wave, lane, xb, l == 0 ? P.in[1] - (size_t)MP * 1024 : (const float*)nullptr, PARTBUF(1 + 3 * l), nullptr, nullptr); } }
        SEAM();
        if (RUN) { PTRS() pg8::Gemm g{xb, WT + WT_WQ + (size_t)l * 1048576, MP, 1024, 1024}; pg8::StaticOrderF S; S.init(MP, 1024, G, (int)blockIdx.x); EpiBf16 E{qx, 1024, PARTBUF(1 + 3 * l)};
            pg8::gemm_phase<EpiBf16, pg8::StaticOrderF, true, true>(lds, g, S, E, wave_s);
            { FRESH() sample_gemm<1>(xb, WT + WT_WQ + (size_t)l * 1048576, 1024, lds, tid, wave, lane, nullptr, nullptr, nullptr, PARTBUF(1 + 3 * l), qx); } }
        SEAM();
        if (RUN) { PTRS() FRESH() xattn_phase2(qx, memk + (size_t)l * 12 * 262144, memvT + (size_t)l * 12 * 262144, ox, lds, tid, wave, lane, G); }
        SEAM();
        if (RUN) { PTRS() pg8::Gemm g{ox, WT + WT_WO + (size_t)l * 1048576, MP, 1024, 1024}; pg8::StaticOrderF S; S.init(MP, 1024, G, (int)blockIdx.x); EpiRes E{P.in[0], P.in[0], xb, PARTBUF(2 + 3 * l), 0};
            pg8::gemm_phase<EpiRes, pg8::StaticOrderF, true, true>(lds, g, S, E, wave_s);
            { FRESH() sample_gemm<0>(ox, WT + WT_WO + (size_t)l * 1048576, 1024, lds, tid, wave, lane, xb, nullptr, PARTBUF(2 + 3 * l), nullptr, nullptr); } }
        SEAM();
        if (RUN) { PTRS() pg8::Gemm g{xb, WT + WT_UP + (size_t)l * 5632 * 1024, MROWS, 5632, 1024}; pg8::StaticOrderF S; S.init(MROWS, 5632, G, (int)blockIdx.x);
            EpiFfnUp E{act, PARTBUF(2 + 3 * l), P.in[34] + (size_t)l * 3 * DFF, SG, SV};
            pg8::gemm_phase<EpiFfnUp, pg8::StaticOrderF, true, true>(lds, g, S, E, wave_s);
            if (l == 0) {
                FRESH()
                const int bx = (int)blockIdx.x, nb = 1430 % G; int slot = -1, nw = 1;
                if (nb > 0 && nb < G) { if (bx >= nb) { slot = (bx - nb) * 8 + wave; nw = (G - nb) * 8; } } else { slot = gw; nw = NGW; }
                if (slot >= 0) { for (int it = slot; it < 512 + 512 + 1024; it += nw) { int r = it;
                    TR(P.in[30] + 1048576, 1024, 1024, WT + WT_WQ + 1048576, P.in[12] + 1024, 0.0625f, 0)
                    TR(P.in[32] + 1048576, 1024, 1024, WT + WT_WO + 1048576, nullptr, 1.f, 0)
                    { const int mi = 8 + (r >> 7), b = mi & 7; tr_item(P.in[10] + (size_t)mi * 262144, 256, 1024, memvT + (size_t)(12 + 4 + b) * 262144, nullptr, 1.f, 0, wscr, r & 127, lane); } }
                  const int tslot = (slot >> 3) * 512 + tid, tn = (nw >> 3) * 512;
                  for (int i = 524288 + tslot; i < 1048576; i += tn) { const size_t e = (size_t)i * 4; const int lb = (int)(e >> 18), l = lb >> 3, b = lb & 7; const f32x4 v = __builtin_nontemporal_load((const f32x4*)(P.in[9] + e));
            u32x2v w; w.x = pg8::cvt_pk_bf16(v[0], v[1]); w.y = pg8::cvt_pk_bf16(v[2], v[3]); *(u32x2v*)(memk + (size_t)(l * 12 + 4 + b) * 262144 + (e & 262143)) = w; } }
            } }
        SEAM();
        if (RUN) { PTRS() FRESH()
            const float* cw = P.in[34] + (size_t)l * 3 * DFF; const float* st = P.in[8] + (size_t)l * 8 * 2 * DFF;
            for (int i = gt; i < 528 * 352; i += NT) { const int fi = i / 352, c0 = (i % 352) * 8; int blk, row, rr, sb, vb; bool smp = fi >= 512;
                if (!smp) { blk = fi >> 1; rr = fi & 1; row = blk * 64 + rr; sb = 0; vb = 0; } else { const int s = fi - 512, half = (s >> 1) & 1; blk = 256 + (s >> 2); rr = s & 1; row = blk * 64 + half * 32 + rr; sb = half * 4; vb = half * 2; }
                f32x4 pa0, pa1, pb0, pb1;
                if (smp) { const int b = (blk - 256) * 2 + (sb >> 2); const float* s0 = st + (size_t)(b * 2) * DFF + c0; pa0 = *(const f32x4*)s0; pa1 = *(const f32x4*)(s0 + 4); pb0 = *(const f32x4*)(s0 + DFF); pb1 = *(const f32x4*)(s0 + DFF + 4); }
                else if ((blk & 63) == 0) { pa0 = pa1 = pb0 = pb1 = (f32x4){0.f, 0.f, 0.f, 0.f}; }
                else { const float* s0 = SG + (size_t)((blk - 1) * 8 + 6) * DFF + c0; pa0 = *(const f32x4*)s0; pa1 = *(const f32x4*)(s0 + 4); pb0 = *(const f32x4*)(s0 + DFF); pb1 = *(const f32x4*)(s0 + DFF + 4); }
                const float* sc = SG + (size_t)(blk * 8 + sb) * DFF + c0; const f32x4 x00 = *(const f32x4*)sc, x01 = *(const f32x4*)(sc + 4);
                f32x4 xm2a, xm2b, xm1a, xm1b, xca, xcb;
                if (rr == 0) { xm2a = pa0; xm2b = pa1; xm1a = pb0; xm1b = pb1; xca = x00; xcb = x01; }
                else { xm2a = pb0; xm2b = pb1; xm1a = x00; xm1b = x01; xca = *(const f32x4*)(sc + DFF); xcb = *(const f32x4*)(sc + DFF + 4); }
                const f32x4 w0a = *(const f32x4*)(cw + c0), w0b = *(const f32x4*)(cw + c0 + 4), w1a = *(const f32x4*)(cw + DFF + c0), w1b = *(const f32x4*)(cw + DFF + c0 + 4), w2a = *(const f32x4*)(cw + 2 * DFF + c0), w2b = *(const f32x4*)(cw + 2 * DFF + c0 + 4);
                const f32x4 ga = w0a * xm2a + w1a * xm1a + w2a * xca, gb_ = w0b * xm2b + w1b * xm1b + w2b * xcb;
                const float* sv = SV + (size_t)(blk * 4 + vb + rr) * DFF + c0; const f32x4 va = *(const f32x4*)sv, vb_ = *(const f32x4*)(sv + 4);
                f32x4 a0, a1;
#pragma unroll
                for (int j = 0; j < 4; ++j) { a0[j] = ga[j] * sigmoidf_(ga[j]) * va[j]; a1[j] = gb_[j] * sigmoidf_(gb_[j]) * vb_[j]; }
                *(v4u*)(act + (size_t)row * DFF + c0) = pack8(a0, a1); }
            for (int i = gt; i < 4 * 2 * DFF; i += NT) { const int c = i % DFF, j = (i / DFF) & 1, b = i / (2 * DFF); out[OFF_CFP + (size_t)l * 4 * 2 * DFF + i] = SG[(size_t)((64 * b + 63) * 8 + 6 + j) * DFF + c]; }
            for (int i = gt; i < 8 * 2 * DFF; i += NT) { const int c = i % DFF, j = (i / DFF) & 1, b = i / (2 * DFF); out[OFF_CFS + (size_t)l * 8 * 2 * DFF + i] = SG[(size_t)((256 + (b >> 1)) * 8 + (b & 1) * 4 + 2 + j) * DFF + c]; }
        }
        SEAM();
        if (RUN) { PTRS() pg8::Gemm g{act, WT + WT_DOWN + (size_t)l * 2816 * 1024, MP, 1024, DFF}; pg8::StaticOrderF S; S.init(MP, 1024, G, (int)blockIdx.x); EpiRes E{P.in[0], P.in[0], xb, PARTBUF(3 + 3 * l), 0};
            pg8::gemm_phase<EpiRes, pg8::StaticOrderF, true, true>(lds, g, S, E, wave_s);
            { FRESH() sample_gemm<0>(act, WT + WT_DOWN + (size_t)l * 2816 * 1024, DFF, lds, tid, wave, lane, xb, nullptr, PARTBUF(3 + 3 * l), nullptr, nullptr); } }
        SEAM();
    }
    if (RUN) { PTRS() FRESH()
        const float* gf = P.in[14];
        for (int m = gw; m < MROWS; m += NGW) { const float rs = rstd_of(PARTBUF(6), m); float* xr = out + (size_t)m * 1024; const bf16* xbr = xb + (size_t)m * 1024;
#pragma unroll
            for (int j = 0; j < 4; ++j) { const int c = (lane + 64 * j) * 4; const u32x2v w = __builtin_nontemporal_load((const u32x2v*)(xbr + c)); const f32x4 v = (f32x4){bflo(w.x), bfhi(w.x), bflo(w.y), bfhi(w.y)}, gg = *(const f32x4*)(gf + c); __builtin_nontemporal_store(v * rs * gg, (f32x4*)(xr + c)); } }
    }
}

extern "C" void kernel_launch(void* const* d_in, const int* in_sizes, int n_in, void* d_out, int out_size, void* d_ws, size_t ws_size, hipStream_t stream) {
    static int grid = 0;
    if (grid == 0) {
        int dev = 0, cus = 0, per_cu = 0;
        if (n_in != 36 || ws_size < 256 * MiB) { fprintf(stderr, "kernel_launch: unexpected n_in %d / ws %zu\n", n_in, ws_size); grid = -1; return; }
        (void)hipGetDevice(&dev); (void)hipDeviceGetAttribute(&cus, hipDeviceAttributeMultiprocessorCount, dev);
        if (hipFuncSetAttribute((const void*)mega_fwd, hipFuncAttributeMaxDynamicSharedMemorySize, LDS_BYTES) != hipSuccess) { fprintf(stderr, "kernel_launch: hipFuncSetAttribute failed\n"); grid = -1; return; }
        if (hipOccupancyMaxActiveBlocksPerMultiprocessor(&per_cu, (const void*)mega_fwd, 512, LDS_BYTES) != hipSuccess || per_cu < 1) per_cu = 1;
        (void)hipGetLastError();
        grid = cus * 1;
        if (grid > 256) grid = 256;
    }
    if (grid < 0) return;
    (void)hipMemsetAsync(d_ws, 0, CTL_ZERO_BYTES, stream);
    Params p{};
    for (int i = 0; i < 36; ++i) p.in[i] = (const float*)d_in[i];
    p.out = (float*)d_out; p.ws = (unsigned char*)d_ws; p.use_cg = 0; p.pad = 0;
    void* args[] = {&p};
    hipError_t e = hipLaunchCooperativeKernel((const void*)mega_fwd, dim3(grid), dim3(512), args, LDS_BYTES, stream);
    if (e != hipSuccess) fprintf(stderr, "cooperative launch failed: %s (grid %d)\n", hipGetErrorString(e), grid);
}
```

```cpp
#include <hip/hip_runtime.h>
#include <hip/hip_cooperative_groups.h>
#include <cstdio>
#include <cstdint>
namespace cg = cooperative_groups;
__device__ __forceinline__ int fresh_tid(int wave_s) { unsigned z = 0u; asm volatile("" : "+s"(z)); int t = wave_s * 64 + (int)__builtin_amdgcn_mbcnt_hi(~0u, __builtin_amdgcn_mbcnt_lo(~0u, z)); asm volatile("" : "+v"(t)); return t; }
namespace pg8 {
#define PG8_LAS __attribute__((address_space(3)))
typedef unsigned short bf16_t;
typedef short bf16x8 __attribute__((ext_vector_type(8)));
typedef float f32x4 __attribute__((ext_vector_type(4)));
typedef unsigned u32x4 __attribute__((ext_vector_type(4)));
constexpr int BM = 256, BK = 64, HALF = 128, HTB = HALF * BK * 2  , STAGE_BYTES = 8 * HTB, NXCD = 8, WGM = 8;

__host__ __device__ __forceinline__ int lds_byte(int r, int c) { const int st = (r >> 4) * 2 + (c >> 5), rr = r & 15, cc = c & 31, ob = rr * 64 + cc * 2; return st * 1024 + (ob ^ (((ob >> 9) & 1) << 5)); }
__host__ __device__ __forceinline__ void stage_rc(int b, int& R, int& C) { const int st = b / 1024, sb = b % 1024, swz = sb ^ (((sb >> 9) & 1) << 5); R = (st >> 1) * 16 + swz / 64; C = (st & 1) * 32 + (swz % 64) / 2; }
__host__ __device__ __forceinline__ int perm32(int rho) { const int n = rho >> 4, i = rho & 15; return 8 * (i >> 2) + 4 * n + (i & 3); }

struct Unit { int pm, pn; };
struct Gemm { const bf16_t* A; const bf16_t* Bt; int M, N, K; };

template <bool FULL> struct StaticOrderT {
    int nM, nN, nwg, G, c;
    __host__ __device__ void init(int M, int N, int G_, int c_) { nM = M / BM; nN = N / BM; nwg = nM * nN; G = G_; c = c_; }
    __host__ __device__ bool next(int i, Unit& u) const {
        const long L = (long)i * G + c; if (!(FULL && i == 0) && L >= nwg) return false;
        int wgid = (int)L; { const int q = nwg / NXCD, r = nwg % NXCD, xcd = wgid % NXCD, off = wgid / NXCD; wgid = (xcd < r ? xcd * (q + 1) : r * (q + 1) + (xcd - r) * q) + off; }
        const int nig = WGM * nN, gid = wgid / nig, fm = gid * WGM, gsz = (nM - fm) < WGM ? (nM - fm) : WGM;
        u.pm = fm + ((wgid % nig) % gsz); u.pn = (wgid % nig) / gsz; return true;
    }
    __device__ __forceinline__ void a_ready(const Unit&) const {}
    __device__ __forceinline__ void done(const Unit&) const {}
};

typedef StaticOrderT<false> StaticOrder; typedef StaticOrderT<true> StaticOrderF;
__device__ __forceinline__ unsigned cvt_pk_bf16(float lo, float hi) { unsigned r; asm volatile("v_cvt_pk_bf16_f32 %0, %1, %2" : "=v"(r) : "v"(lo), "v"(hi)); return r; }
typedef float f32x2 __attribute__((ext_vector_type(2)));
template <class Epi, class Sched, bool ALIGN_EPI = false, bool SP2 = false>
__device__ __forceinline__ void gemm_phase(PG8_LAS unsigned char* lds, const Gemm g, const Sched& S, const Epi& E, const int wave_s) {
    const int tid = fresh_tid(wave_s), wid = __builtin_amdgcn_readfirstlane(tid >> 6), lane = tid & 63, wr = wid >> 2, wc = wid & 3, fr = lane & 15, fq = lane >> 4;
    const int K = g.K, nt = K / BK;
    unsigned voffA[2], voffB[2];
#pragma unroll
    for (int i = 0; i < 2; ++i) { int R, C; stage_rc(tid * 16 + i * 8192, R, C); const int Rb = Epi::PERM ? ((R & ~31) + perm32(R & 31)) : R;
        voffA[i] = (unsigned)(R * K + C) * 2u; voffB[i] = (unsigned)(Rb * K + C) * 2u; }
    const size_t kstep = (size_t)(BK * 2);
    const size_t hstep = (size_t)HALF * K * 2;
    const size_t tstep = 2 * hstep;
    const unsigned ldsw = (unsigned)wid * 1024u;
    const int aoff = lds_byte(wr * 64 + fr, fq * 8), boff = lds_byte(wc * 32 + fr, fq * 8);
#define PG8_SA(b, h) (((b) * 2 + (h)) * HTB)
#define PG8_SB(b, h) ((4 + (b) * 2 + (h)) * HTB)
#define PG8_STAGE(bufoff, gbase, voff) do { _Pragma("unroll") for (int _i = 0; _i < 2; ++_i) \
        __builtin_amdgcn_global_load_lds((const unsigned*)((const char*)(gbase) + (voff)[_i]), (PG8_LAS unsigned*)(lds + (bufoff) + ldsw + _i * 8192), 16, 0, 0); } while (0)
#define PG8_LDA(dst, b, h) do { _Pragma("unroll") for (int m = 0; m < 4; ++m) _Pragma("unroll") for (int k = 0; k < 2; ++k) dst[m][k] = *(const PG8_LAS bf16x8*)(lds + PG8_SA(b, h) + aoff + m * 2048 + k * 1024); } while (0)
#define PG8_LDB(dst, b, h) do { _Pragma("unroll") for (int n = 0; n < 2; ++n) _Pragma("unroll") for (int k = 0; k < 2; ++k) dst[n][k] = *(const PG8_LAS bf16x8*)(lds + PG8_SB(b, h) + boff + n * 2048 + k * 1024); } while (0)
#define PG8_MMA(ai, bj, At, Bt) do { __builtin_amdgcn_s_setprio(1); _Pragma("unroll") for (int m = 0; m < 4; ++m) _Pragma("unroll") for (int n = 0; n < 2; ++n) _Pragma("unroll") for (int k = 0; k < 2; ++k) \
        acc[ai][bj][m][n] = __builtin_amdgcn_mfma_f32_16x16x32_bf16(Bt[n][k], At[m][k], acc[ai][bj][m][n], 0, 0, 0); __builtin_amdgcn_s_setprio(0); } while (0)
#define PG8_WAIT_V(n) asm volatile("s_waitcnt vmcnt(" #n ")" ::: "memory")
#define PG8_WAIT_L(n) asm volatile("s_waitcnt lgkmcnt(" #n ")" ::: "memory")
#define PG8_BAR __builtin_amdgcn_s_barrier()
#define PG8_SCHED __builtin_amdgcn_sched_barrier(0)
    Unit cur, nxt; int ui = 0;
    if (!S.next(0, cur)) return;
    f32x4 acc[2][2][4][2];
#pragma unroll
    for (int a = 0; a < 2; ++a)
#pragma unroll
        for (int b = 0; b < 2; ++b)
#pragma unroll
            for (int m = 0; m < 4; ++m)
#pragma unroll
                for (int n = 0; n < 2; ++n) acc[a][b][m][n] = (f32x4){0.f, 0.f, 0.f, 0.f};
    bf16x8 At[4][2], B0[2][2], B1[2][2];
    const char* cA = (const char*)g.A + (size_t)cur.pm * tstep; const char* cB = (const char*)g.Bt + (size_t)cur.pn * tstep;
    S.a_ready(cur);
    if constexpr (SP2) {
        PG8_STAGE(PG8_SB(0, 0), cB, voffB); PG8_STAGE(PG8_SB(0, 1), cB + hstep, voffB); PG8_STAGE(PG8_SA(0, 0), cA, voffA); PG8_STAGE(PG8_SA(0, 1), cA + hstep, voffA);
        if (wr == 1) PG8_BAR;
        PG8_WAIT_V(2); PG8_BAR;
        PG8_STAGE(PG8_SB(1, 0), cB + kstep, voffB); PG8_STAGE(PG8_SA(1, 0), cA + kstep, voffA); PG8_STAGE(PG8_SB(1, 1), cB + hstep + kstep, voffB);
        PG8_WAIT_V(6); PG8_BAR;
    } else {
        PG8_STAGE(PG8_SB(0, 0), cB, voffB); PG8_STAGE(PG8_SA(0, 0), cA, voffA); PG8_STAGE(PG8_SB(0, 1), cB + hstep, voffB); PG8_STAGE(PG8_SA(0, 1), cA + hstep, voffA);
        if (wr == 1) PG8_BAR;
        PG8_WAIT_V(4); PG8_BAR;
        PG8_STAGE(PG8_SB(1, 0), cB + kstep, voffB); PG8_STAGE(PG8_SA(1, 0), cA + kstep, voffA); PG8_STAGE(PG8_SB(1, 1), cB + hstep + kstep, voffB);
        PG8_WAIT_V(6); PG8_BAR;
    }
    for (;;) {
        const bool has_next = S.next(ui + 1, nxt);
        const char* nA = has_next ? (const char*)g.A + (size_t)nxt.pm * tstep : cA; const char* nB = has_next ? (const char*)g.Bt + (size_t)nxt.pn * tstep : cB;
        for (int t = 0; t < nt; t += 2) {
            const bool last = (t == nt - 2);
            const char* a1 = cA + (size_t)(t + 1) * kstep;
            const char* a2 = last ? nA : cA + (size_t)(t + 2) * kstep; const char* b2 = last ? nB : cB + (size_t)(t + 2) * kstep;
            const char* a3 = a2 + kstep; const char* b3 = b2 + kstep;
            if (last && has_next) S.a_ready(nxt);
            if constexpr (SP2) {
            PG8_LDB(B0, 0, 0); PG8_LDB(B1, 0, 1); PG8_SCHED; PG8_LDA(At, 0, 0); PG8_STAGE(PG8_SA(1, 1), a1 + hstep, voffA);
            PG8_WAIT_V(8); PG8_WAIT_L(0); PG8_BAR; PG8_MMA(0, 0, At, B0); PG8_MMA(0, 1, At, B1); PG8_BAR; PG8_SCHED;
            PG8_LDA(At, 0, 1); PG8_STAGE(PG8_SB(0, 0), b2, voffB); PG8_STAGE(PG8_SB(0, 1), b2 + hstep, voffB); PG8_STAGE(PG8_SA(0, 0), a2, voffA);
            PG8_WAIT_V(8); PG8_WAIT_L(0); PG8_BAR; PG8_MMA(1, 0, At, B0); PG8_MMA(1, 1, At, B1); PG8_BAR; PG8_SCHED;
            PG8_LDB(B0, 1, 0); PG8_LDB(B1, 1, 1); PG8_SCHED; PG8_LDA(At, 1, 0); PG8_STAGE(PG8_SA(0, 1), a2 + hstep, voffA);
            PG8_WAIT_V(8); PG8_WAIT_L(0); PG8_BAR; PG8_MMA(0, 0, At, B0); PG8_MMA(0, 1, At, B1); PG8_BAR; PG8_SCHED;
            PG8_LDA(At, 1, 1); PG8_STAGE(PG8_SB(1, 0), b3, voffB); PG8_STAGE(PG8_SB(1, 1), b3 + hstep, voffB); PG8_STAGE(PG8_SA(1, 0), a3, voffA);
            PG8_WAIT_V(8); PG8_WAIT_L(0); PG8_BAR; PG8_MMA(1, 0, At, B0); PG8_MMA(1, 1, At, B1); PG8_BAR; PG8_SCHED;
            } else {
            PG8_LDB(B0, 0, 0); PG8_SCHED; PG8_LDA(At, 0, 0); PG8_STAGE(PG8_SA(1, 1), a1 + hstep, voffA);
            PG8_WAIT_L(8); PG8_BAR; PG8_WAIT_L(0); PG8_MMA(0, 0, At, B0); PG8_BAR; PG8_SCHED;
            PG8_LDB(B1, 0, 1); PG8_STAGE(PG8_SB(0, 0), b2, voffB);
            PG8_BAR; PG8_WAIT_L(0); PG8_MMA(0, 1, At, B1); PG8_BAR;
            PG8_LDA(At, 0, 1); PG8_STAGE(PG8_SA(0, 0), a2, voffA);
            PG8_BAR; PG8_WAIT_L(0); PG8_MMA(1, 0, At, B0); PG8_BAR; PG8_SCHED;
            PG8_STAGE(PG8_SB(0, 1), b2 + hstep, voffB);
            PG8_WAIT_V(6); PG8_BAR; PG8_MMA(1, 1, At, B1); PG8_BAR;
            PG8_LDB(B0, 1, 0); PG8_SCHED; PG8_LDA(At, 1, 0); PG8_STAGE(PG8_SA(0, 1), a2 + hstep, voffA);
            PG8_WAIT_L(8); PG8_BAR; PG8_WAIT_L(0); PG8_MMA(0, 0, At, B0); PG8_BAR; PG8_SCHED;
            PG8_LDB(B1, 1, 1); PG8_STAGE(PG8_SB(1, 0), b3, voffB);
            PG8_BAR; PG8_WAIT_L(0); PG8_MMA(0, 1, At, B1); PG8_BAR;
            PG8_LDA(At, 1, 1); PG8_STAGE(PG8_SA(1, 0), a3, voffA);
            PG8_BAR; PG8_WAIT_L(0); PG8_MMA(1, 0, At, B0); PG8_BAR; PG8_SCHED;
            PG8_STAGE(PG8_SB(1, 1), b3 + hstep, voffB);
            PG8_WAIT_V(6); PG8_BAR; PG8_MMA(1, 1, At, B1); PG8_BAR;
            }
        }
        if constexpr (ALIGN_EPI) { if (wr == 0) PG8_BAR; }
        if constexpr (!Epi::AFTER_DRAIN) { E(acc, cur, wr, wc, fr, fq); S.done(cur); }
        if (!has_next) break;
#pragma unroll
        for (int a = 0; a < 2; ++a)
#pragma unroll
            for (int b = 0; b < 2; ++b)
#pragma unroll
                for (int m = 0; m < 4; ++m)
#pragma unroll
                    for (int n = 0; n < 2; ++n) acc[a][b][m][n] = (f32x4){0.f, 0.f, 0.f, 0.f};
        cur = nxt; cA = nA; cB = nB; ++ui;
        if constexpr (ALIGN_EPI) { if (wr == 1) PG8_BAR; }
    }
    PG8_WAIT_V(0);
    if constexpr (!ALIGN_EPI) { if (wr == 0) PG8_BAR; }
    PG8_BAR;
    if constexpr (Epi::AFTER_DRAIN) { E.fused(acc, cur, wr, wc, fr, fq, lds, wid, lane); S.done(cur); }
#undef PG8_SA
#undef PG8_SB
#undef PG8_STAGE
#undef PG8_LDA
#undef PG8_LDB
#undef PG8_MMA
#undef PG8_WAIT_V
#undef PG8_WAIT_L
#undef PG8_BAR
#undef PG8_SCHED
}
}
#define GAS __attribute__((address_space(1)))
#define LAS __attribute__((address_space(3)))
typedef unsigned short bf16;
typedef unsigned v4u __attribute__((ext_vector_type(4)));
typedef float f32x4 __attribute__((ext_vector_type(4)));
typedef short bf16x8 __attribute__((ext_vector_type(8)));
typedef GAS unsigned gu32;
typedef GAS unsigned long long gu64;
#define RLX_AGENT __ATOMIC_RELAXED, __HIP_MEMORY_SCOPE_AGENT
#define LDS_WAIT() asm volatile("s_waitcnt lgkmcnt(0)" ::: "memory")
#define VM_WAIT() asm volatile("s_waitcnt vmcnt(0)" ::: "memory")
__device__ __forceinline__ unsigned long long rt() { return __builtin_amdgcn_s_memrealtime(); }
__device__ __forceinline__ unsigned f2bf(float f) { unsigned u = __builtin_bit_cast(unsigned, f); return (u + 0x7fffu + ((u >> 16) & 1u)) >> 16; }
__device__ __forceinline__ unsigned pk2(float lo, float hi) { return f2bf(lo) | (f2bf(hi) << 16); }

#define XB_TMO      128
#define XB_XCNT(j)  (256  + 64 * (j))
#define XB_XSUB(j)  (1280 + 64 * (j))
#define XB_XGEN(j)  (2304 + 64 * (j))
#define XB_TOP      3328
#define XB_TOPGEN   3392
#define XCD_BAR_WORDS 3456
#define XB_SPIN_CAP (1u << 18)

__device__ __forceinline__ unsigned xb_ld(unsigned* p)              { return __hip_atomic_load(p, __ATOMIC_RELAXED, __HIP_MEMORY_SCOPE_AGENT); }
__device__ __forceinline__ unsigned xb_add(unsigned* p, unsigned v) { return __hip_atomic_fetch_add(p, v, __ATOMIC_RELAXED, __HIP_MEMORY_SCOPE_AGENT); }
__device__ __forceinline__ unsigned xb_xcc_id() { return (unsigned)__builtin_amdgcn_s_getreg((3 << 11) | 20) & 0xFu; }
#define XB_SPIN(cond, bar) do { unsigned _sp = 0; while (cond) { __builtin_amdgcn_s_sleep(0); \
    if ((++_sp & 255u) == 0u) { if (xb_ld(&(bar)[XB_TMO])) break; if (_sp > XB_SPIN_CAP) { atomicAdd(&(bar)[XB_TMO], 1u); break; } } } } while (0)

struct XcdBarrier {
    unsigned* bar; unsigned x;
    volatile LAS unsigned* st;
};

__device__ __forceinline__ XcdBarrier xcd_barrier_post(unsigned* bar, volatile LAS unsigned* st) {
    XcdBarrier b; b.bar = bar; b.x = xb_xcc_id(); b.st = st;
    if (threadIdx.x == 0) (void)xb_add(&bar[XB_XCNT(b.x)], 1u);
    return b;
}
__device__ __forceinline__ void xcd_barrier_complete(unsigned* bar, unsigned x, unsigned& nloc, unsigned& nx) {
    const unsigned G = gridDim.x * gridDim.y * gridDim.z;
    unsigned sum, cnt, mine, sp = 0u;
    for (;;) {
        sum = 0u; cnt = 0u; mine = 0u;
#pragma unroll
        for (unsigned j = 0; j < 16; ++j) { const unsigned c = xb_ld(&bar[XB_XCNT(j)]); sum += c; cnt += (c > 0u) ? 1u : 0u; mine = (j == x) ? c : mine; }
        if (sum == G) break;
        __builtin_amdgcn_s_sleep(1);
        if ((++sp & 255u) == 0u) { if (xb_ld(&bar[XB_TMO])) break; if (sp > XB_SPIN_CAP) { atomicAdd(&bar[XB_TMO], 1u); break; } }
    }
    nloc = mine > 0u ? mine : 1u; nx = cnt > 0u ? cnt : 1u;
}

__device__ __forceinline__ void xcd_barrier(const XcdBarrier& b) {
    asm volatile("s_waitcnt vmcnt(0)" ::: "memory");
    __syncthreads();
    if (threadIdx.x == 0) {
        unsigned* bar = b.bar;
        __builtin_amdgcn_s_waitcnt(0);
        unsigned nloc = b.st[0], nx = b.st[1];
        if (nloc == 0u) { xcd_barrier_complete(bar, b.x, nloc, nx); b.st[0] = nloc; b.st[1] = nx; }
        const unsigned old = xb_add(&bar[XB_XSUB(b.x)], 1u);
        const unsigned gen = old / nloc;
        if (old + 1u == (gen + 1u) * nloc) {
            __builtin_amdgcn_fence(__ATOMIC_RELEASE, "agent");
            asm volatile("s_waitcnt vmcnt(0)" ::: "memory");
            const unsigned og = xb_add(&bar[XB_TOP], 1u);
            const unsigned tg = og / nx;
            if (og + 1u == (tg + 1u) * nx) xb_add(&bar[XB_TOPGEN], 1u);
            else XB_SPIN(xb_ld(&bar[XB_TOPGEN]) == tg, bar);
            __builtin_amdgcn_fence(__ATOMIC_ACQUIRE, "agent");
            xb_add(&bar[XB_XGEN(b.x)], 1u);
            asm volatile("s_waitcnt vmcnt(0)" ::: "memory");
        } else {
            XB_SPIN(xb_ld(&bar[XB_XGEN(b.x)]) == gen, bar);
            __builtin_amdgcn_fence(__ATOMIC_ACQUIRE, "agent");
            asm volatile("s_waitcnt vmcnt(0)" ::: "memory");
        }
    }
    __syncthreads();
}
typedef unsigned u32x2v __attribute__((ext_vector_type(2)));
typedef float f32x2v __attribute__((ext_vector_type(2)));

constexpr int MP = 16384, MROWS = 16640, DMODEL = 1024, DFF = 2816, NBLK64 = MROWS / 64;
constexpr float RMS_EPS = 1e-6f;
constexpr size_t OFF_Y = 0, OFF_WKP = (size_t)MROWS * 1024, OFF_WVP = OFF_WKP + 65536, OFF_SRP = OFF_WVP + 65536, OFF_SIP = OFF_SRP + 8192,
    OFF_CMP = OFF_SIP + 8192, OFF_CFP = OFF_CMP + 8192, OFF_MKP = OFF_CFP + 45056, OFF_MVP = OFF_MKP + 2097152, OFF_WKS = OFF_MVP + 2097152,
    OFF_WVS = OFF_WKS + 32768, OFF_SRS = OFF_WVS + 32768, OFF_SIS = OFF_SRS + 16384, OFF_CMS = OFF_SIS + 16384, OFF_CFS = OFF_CMS + 16384;
constexpr size_t MiB = 1u << 20;
constexpr size_t WS_ROWSS = 0, WS_BAR = 512 * 1024, CTL_ZERO_BYTES = 1 * MiB;
constexpr size_t WS_ROPE = 1 * MiB, WS_SSM = 2 * MiB, WS_CKV = 3 * MiB, WS_SLOC = 4 * MiB, WS_MEMK = 8 * MiB, WS_MEMVT = 20 * MiB, WS_SIDE = 32 * MiB;
constexpr size_t SG_BYTES = (size_t)NBLK64 * 8 * DFF * 4, SV_BYTES = (size_t)NBLK64 * 4 * DFF * 4;
static_assert(WS_SIDE + SG_BYTES + SV_BYTES <= 66 * MiB, "side buffers");
constexpr size_t WS_WT = 66 * MiB, WS_XB = 128 * MiB, WS_TMP = 161 * MiB;
constexpr size_t WT_INEVEN = 0, WT_GLU = WT_INEVEN + 1280 * 1024, WT_OUTEVEN = WT_GLU + 512 * 512, WT_WQ = WT_OUTEVEN + 1024 * 1024, WT_WKV = WT_WQ + 2 * 1024 * 1024,
    WT_WO = WT_WKV + 2 * 2048 * 1024, WT_UP = WT_WO + 2 * 1024 * 1024, WT_DOWN = WT_UP + (size_t)2 * 5632 * 1024, WT_INODD = WT_DOWN + (size_t)2 * 2816 * 1024,
    WT_OUTODD = WT_INODD + 3072 * 1024, WT_END = WT_OUTODD + 1024 * 1024;
static_assert(WS_WT + WT_END * 2 <= WS_XB, "weights");
static_assert(WS_XB + (size_t)MROWS * 1024 * 2 <= WS_TMP, "xb");
constexpr size_t TMP_BYTES = (size_t)MROWS * DFF * 2;
constexpr size_t WS_PART = 251 * MiB, PART_ELEMS = (size_t)MROWS * 16;
static_assert(WS_PART + 2 * PART_ELEMS * 4 <= 256 * MiB, "part");
static_assert(WS_TMP + TMP_BYTES <= 256 * MiB, "ws");
constexpr size_t TMP_PROJ0 = 0, TMP_GBUF = (size_t)MROWS * 1280 * 2, TMP_YCAT = TMP_GBUF + (size_t)MROWS * 512 * 2, TMP_MEMB = TMP_YCAT;
static_assert(TMP_YCAT + (size_t)MROWS * 1024 * 2 <= TMP_BYTES, "tmp");
constexpr size_t TMP_QX = 0, TMP_OX = (size_t)MROWS * 1024 * 2, TMP_ACT = 0, TMP_GB = 0, TMP_ZC = (size_t)MROWS * 1024 * 2;
constexpr int LDS_BYTES = 147456, MISC_OFF = 147456 - 512;
constexpr int NPH = 22;

#define MFMA16(a, b, c) __builtin_amdgcn_mfma_f32_16x16x32_bf16(a, b, c, 0, 0, 0)
__device__ __forceinline__ float bflo(unsigned w) { return __uint_as_float(w << 16); }
__device__ __forceinline__ float bfhi(unsigned w) { return __uint_as_float(w & 0xffff0000u); }
__device__ __forceinline__ v4u pack8(f32x4 a, f32x4 b) { v4u w; w.x = pg8::cvt_pk_bf16(a[0], a[1]); w.y = pg8::cvt_pk_bf16(a[2], a[3]); w.z = pg8::cvt_pk_bf16(b[0], b[1]); w.w = pg8::cvt_pk_bf16(b[2], b[3]); return w; }
__device__ __forceinline__ float rstd_of(const float* part, int row) { const f32x4* p = (const f32x4*)(part + (size_t)row * 16); const f32x4 a = p[0] + p[1] + p[2] + p[3]; return rsqrtf(((a[0] + a[1]) + (a[2] + a[3])) * (1.0f / 1024.0f) + RMS_EPS); }
__device__ __forceinline__ float sigmoidf_(float x) { return 1.0f / (1.0f + __expf(-x)); }
__device__ __forceinline__ float dpp_ror1(float v) { return __builtin_bit_cast(float, __builtin_amdgcn_update_dpp(0, __builtin_bit_cast(int, v), 0x121, 0xf, 0xf, false)); }
__device__ __forceinline__ float dpp_ror2(float v) { return __builtin_bit_cast(float, __builtin_amdgcn_update_dpp(0, __builtin_bit_cast(int, v), 0x122, 0xf, 0xf, false)); }
__device__ __forceinline__ float wave_sum(float v) {
#pragma unroll
    for (int o = 1; o < 64; o <<= 1) v += __shfl_xor(v, o);
    return v;
}

typedef pg8::Unit Unit;
#define EPI_ARGS const f32x4 (&acc)[2][2][4][2], const Unit& u, int wr, int wc, int fr, int fq

struct EpiBf16 {
    static constexpr bool PERM = true, AFTER_DRAIN = false;
    bf16* O; int ldc; const float* rowss;
    __device__ __forceinline__ void operator()(EPI_ARGS) const {
        const int row0 = u.pm * 256 + wr * 64 + fr, col0 = u.pn * 256 + wc * 32 + 8 * fq;
#pragma unroll
        for (int ai = 0; ai < 2; ++ai)
#pragma unroll
            for (int m = 0; m < 4; ++m) { const int row = row0 + ai * 128 + m * 16; const float rs = rstd_of(rowss, row); bf16* rp = O + (size_t)row * ldc + col0;
#pragma unroll
                for (int bj = 0; bj < 2; ++bj) *(v4u*)(rp + bj * 128) = pack8(acc[ai][bj][m][0] * rs, acc[ai][bj][m][1] * rs); }
    }
};
struct EpiRes {
    static constexpr bool PERM = true, AFTER_DRAIN = false;
    const float* base_p; const float* base_s; bf16* xb; float* rowss_next; int f32base;
    __device__ __forceinline__ void operator()(EPI_ARGS) const {
        const float* base = u.pm < 64 ? base_p : base_s;
        const int row0 = u.pm * 256 + wr * 64 + fr, col0 = u.pn * 256 + wc * 32 + 8 * fq;
#pragma unroll
        for (int ai = 0; ai < 2; ++ai)
#pragma unroll
            for (int m = 0; m < 4; ++m) { const int row = row0 + ai * 128 + m * 16; const size_t off = (size_t)row * 1024 + col0; float ss = 0.f;
#pragma unroll
                for (int bj = 0; bj < 2; ++bj) { f32x4 b0, b1;
                    if (f32base) { b0 = __builtin_nontemporal_load((const f32x4*)(base + off + bj * 128)); b1 = __builtin_nontemporal_load((const f32x4*)(base + off + bj * 128 + 4)); }
                    else { const v4u w = *(const v4u*)(xb + off + bj * 128); b0 = (f32x4){bflo(w.x), bfhi(w.x), bflo(w.y), bfhi(w.y)}; b1 = (f32x4){bflo(w.z), bfhi(w.z), bflo(w.w), bfhi(w.w)}; }
                    const f32x4 v0 = acc[ai][bj][m][0] + b0, v1 = acc[ai][bj][m][1] + b1;
                    *(v4u*)(xb + off + bj * 128) = pack8(v0, v1);
                    ss += (v0[0] * v0[0] + v0[1] * v0[1]) + (v0[2] * v0[2] + v0[3] * v0[3]) + (v1[0] * v1[0] + v1[1] * v1[1]) + (v1[2] * v1[2] + v1[3] * v1[3]); }
                ss += __shfl_xor(ss, 16); ss += __shfl_xor(ss, 32);
                if (fq == 0) rowss_next[(size_t)row * 16 + u.pn * 4 + wc] = ss; }
    }
};
struct EpiGlu {
    static constexpr bool PERM = true, AFTER_DRAIN = false;
    const bf16* g; bf16* ycat;
    __device__ __forceinline__ void operator()(EPI_ARGS) const {
        const int row0 = u.pm * 256 + wr * 64 + fr, col0 = u.pn * 256 + wc * 32 + 8 * fq;
#pragma unroll
        for (int ai = 0; ai < 2; ++ai)
#pragma unroll
            for (int m = 0; m < 4; ++m) { const int row = row0 + ai * 128 + m * 16;
#pragma unroll
                for (int bj = 0; bj < 2; ++bj) { const int col = col0 + bj * 128; const v4u gw = *(const v4u*)(g + (size_t)row * 512 + col);
                    const f32x4 a0 = acc[ai][bj][m][0], a1 = acc[ai][bj][m][1]; f32x4 o0, o1;
                    o0[0] = bflo(gw.x) * sigmoidf_(a0[0]); o0[1] = bfhi(gw.x) * sigmoidf_(a0[1]); o0[2] = bflo(gw.y) * sigmoidf_(a0[2]); o0[3] = bfhi(gw.y) * sigmoidf_(a0[3]);
                    o1[0] = bflo(gw.z) * sigmoidf_(a1[0]); o1[1] = bfhi(gw.z) * sigmoidf_(a1[1]); o1[2] = bflo(gw.w) * sigmoidf_(a1[2]); o1[3] = bfhi(gw.w) * sigmoidf_(a1[3]);
                    *(v4u*)(ycat + (size_t)row * 1024 + col) = pack8(o0, o1); } }
    }
};
struct EpiKV {
    static constexpr bool PERM = true, AFTER_DRAIN = false;
    float* out; bf16* memk;
    __device__ __forceinline__ void operator()(EPI_ARGS) const {
        const int row0 = u.pm * 256 + wr * 64 + fr, col0 = u.pn * 256 + wc * 32 + 8 * fq;
#pragma unroll
        for (int ai = 0; ai < 2; ++ai)
#pragma unroll
            for (int m = 0; m < 4; ++m) { const int row = row0 + ai * 128 + m * 16;
#pragma unroll
                for (int bj = 0; bj < 2; ++bj) { const int c = col0 + bj * 128, l = c >> 11, e = c & 2047, isv = e >> 10, dc = e & 1023;
                    float* op = out + (isv ? OFF_MVP : OFF_MKP) + (size_t)l * 1048576 + (size_t)row * 1024 + dc;
                    if (isv) { *(f32x4*)op = acc[ai][bj][m][0]; *(f32x4*)(op + 4) = acc[ai][bj][m][1]; } else { __builtin_nontemporal_store(acc[ai][bj][m][0], (f32x4*)op); __builtin_nontemporal_store(acc[ai][bj][m][1], (f32x4*)(op + 4)); }
                    if (!isv) *(v4u*)(memk + (size_t)l * 12 * 262144 + (size_t)row * 1024 + dc) = pack8(acc[ai][bj][m][0], acc[ai][bj][m][1]); } }
    }
};
struct EpiIn0 {
    static constexpr bool PERM = true, AFTER_DRAIN = false;
    bf16* proj; const float* rowss; const float* ropec; const float* ropes; float* out;
    __device__ __forceinline__ void operator()(EPI_ARGS) const {
        const int pn = u.pn;
#pragma unroll
        for (int ai = 0; ai < 2; ++ai)
#pragma unroll
            for (int m = 0; m < 4; ++m) { const int row = u.pm * 256 + ai * 128 + wr * 64 + m * 16 + fr; const float rs = rstd_of(rowss, row);
                const int pos = row < MP ? (row & 4095) : 2048 + (row & 31);
                bf16* rp = proj + (size_t)row * 1280;
                float* wk = nullptr; float* wv = nullptr;
                if (pn == 4) { if (row >= MP) { wk = out + OFF_WKS + (size_t)(row - MP) * 128; wv = out + OFF_WVS + (size_t)(row - MP) * 128; }
                               else if ((row & 4095) >= 3968) { const size_t o = (size_t)((row >> 12) * 128 + (row & 4095) - 3968) * 128; wk = out + OFF_WKP + o; wv = out + OFF_WVP + o; } }
#pragma unroll
                for (int bj = 0; bj < 2; ++bj) { const f32x4 v0 = acc[ai][bj][m][0] * rs, v1 = acc[ai][bj][m][1] * rs;
                    const bool rope = (pn == 2 || pn == 3 || (pn == 4 && bj == 0));
                    if (!rope) { const int col = pn * 256 + bj * 128 + wc * 32 + 8 * fq; *(v4u*)(rp + col) = pack8(v0, v1);
                        if (pn == 4 && wv) { *(f32x4*)(wv + wc * 32 + 8 * fq) = v0; *(f32x4*)(wv + wc * 32 + 8 * fq + 4) = v1; } }
                    else { const int gbase = pn * 256 + bj * 128 + (wc >> 1) * 64, d1 = 16 * (wc & 1) + 4 * fq;
                        const f32x4 c4 = *(const f32x4*)(ropec + pos * 32 + d1), s4 = *(const f32x4*)(ropes + pos * 32 + d1);
                        f32x4 o1 = v0 * c4 - v1 * s4, o2 = v1 * c4 + v0 * s4;
                        if (pn != 4) { o1 = o1 * 0.125f; o2 = o2 * 0.125f; }
                        u32x2v w1, w2; w1.x = pg8::cvt_pk_bf16(o1[0], o1[1]); w1.y = pg8::cvt_pk_bf16(o1[2], o1[3]); w2.x = pg8::cvt_pk_bf16(o2[0], o2[1]); w2.y = pg8::cvt_pk_bf16(o2[2], o2[3]);
                        *(u32x2v*)(rp + gbase + d1) = w1; *(u32x2v*)(rp + gbase + d1 + 32) = w2;
                        if (pn == 4 && wk) { const int cc = (wc >> 1) * 64 + d1; *(f32x4*)(wk + cc) = o1; *(f32x4*)(wk + cc + 32) = o2; } } } }
    }
};
struct EpiFfnUp {
    static constexpr bool PERM = true, AFTER_DRAIN = false;
    bf16* act; const float* rowss; const float* cw; float* SG; float* SV;
    __device__ __forceinline__ void operator()(EPI_ARGS) const {
        const int c0 = u.pn * 128 + wc * 32 + 8 * fq; const bool sample = u.pm == 64;
        const f32x4 w0a = *(const f32x4*)(cw + c0), w0b = *(const f32x4*)(cw + c0 + 4), w1a = *(const f32x4*)(cw + DFF + c0), w1b = *(const f32x4*)(cw + DFF + c0 + 4),
                    w2a = *(const f32x4*)(cw + 2 * DFF + c0), w2b = *(const f32x4*)(cw + 2 * DFF + c0 + 4);
#pragma unroll
        for (int ai = 0; ai < 2; ++ai) { f32x4 gp0 = {0.f, 0.f, 0.f, 0.f}, gp1 = {0.f, 0.f, 0.f, 0.f}; const int blk = u.pm * 4 + ai * 2 + wr;
#pragma unroll
            for (int m = 0; m < 4; ++m) { const int row = u.pm * 256 + ai * 128 + wr * 64 + m * 16 + fr; const float rs = rstd_of(rowss, row);
                const f32x4 g0 = acc[ai][0][m][0] * rs, g1 = acc[ai][0][m][1] * rs, v0 = acc[ai][1][m][0] * rs, v1 = acc[ai][1][m][1] * rs;
                f32x4 p1a, p2a, p1b, p2b;
#pragma unroll
                for (int j = 0; j < 4; ++j) { const float s1a = fr == 15 ? gp0[j] : g0[j], s2a = fr >= 14 ? gp0[j] : g0[j], s1b = fr == 15 ? gp1[j] : g1[j], s2b = fr >= 14 ? gp1[j] : g1[j];
                    p1a[j] = dpp_ror1(s1a); p2a[j] = dpp_ror2(s2a); p1b[j] = dpp_ror1(s1b); p2b[j] = dpp_ror2(s2b); }
                const f32x4 ca = w0a * p2a + w1a * p1a + w2a * g0, cb = w0b * p2b + w1b * p1b + w2b * g1;
                f32x4 sa, sb;
#pragma unroll
                for (int j = 0; j < 4; ++j) { sa[j] = sigmoidf_(ca[j]); sb[j] = sigmoidf_(cb[j]); }
                const f32x4 a0 = ca * sa * v0, a1 = cb * sb * v1;
                const bool valid = (m > 0 || fr >= 2) && !(sample && m == 2 && fr < 2);
                if (valid) *(v4u*)(act + (size_t)row * DFF + c0) = pack8(a0, a1);
                if ((m & 1) == 0 && fr < 2) { float* sg = SG + (size_t)(blk * 8 + 2 * m + fr) * DFF + c0; *(f32x4*)sg = g0; *(f32x4*)(sg + 4) = g1;
                                              float* sv = SV + (size_t)(blk * 4 + m + fr) * DFF + c0; *(f32x4*)sv = v0; *(f32x4*)(sv + 4) = v1; }
                if ((m & 1) == 1 && fr >= 14) { float* sg = SG + (size_t)(blk * 8 + 2 * m + fr - 14) * DFF + c0; *(f32x4*)sg = g0; *(f32x4*)(sg + 4) = g1; }
                gp0 = g0; gp1 = g1; } }
    }
};
struct EpiInOdd {
    static constexpr bool PERM = true, AFTER_DRAIN = false;
    bf16* gb; bf16* zc; const float* rowss; const float* cw; float* SG;
    __device__ __forceinline__ void operator()(EPI_ARGS) const {
        if (u.pn < 4) {
            const int row0 = u.pm * 256 + wr * 64 + fr, col0 = u.pn * 256 + wc * 32 + 8 * fq;
#pragma unroll
            for (int ai = 0; ai < 2; ++ai)
#pragma unroll
                for (int m = 0; m < 4; ++m) { const int row = row0 + ai * 128 + m * 16; const float rs = rstd_of(rowss, row); bf16* rp = gb + (size_t)row * 1024 + col0;
#pragma unroll
                    for (int bj = 0; bj < 2; ++bj) *(v4u*)(rp + bj * 128) = pack8(acc[ai][bj][m][0] * rs, acc[ai][bj][m][1] * rs); }
            return;
        }
        const int c0 = (u.pn - 4) * 128 + wc * 32 + 8 * fq; const bool sample = u.pm == 64;
        const f32x4 w0a = *(const f32x4*)(cw + c0), w0b = *(const f32x4*)(cw + c0 + 4), w1a = *(const f32x4*)(cw + 1024 + c0), w1b = *(const f32x4*)(cw + 1024 + c0 + 4),
                    w2a = *(const f32x4*)(cw + 2048 + c0), w2b = *(const f32x4*)(cw + 2048 + c0 + 4);
#pragma unroll
        for (int ai = 0; ai < 2; ++ai) { f32x4 gp0 = {0.f, 0.f, 0.f, 0.f}, gp1 = {0.f, 0.f, 0.f, 0.f}; const int blk = u.pm * 4 + ai * 2 + wr;
#pragma unroll
            for (int m = 0; m < 4; ++m) { const int row = u.pm * 256 + ai * 128 + wr * 64 + m * 16 + fr; const float rs = rstd_of(rowss, row); const float rs2 = rs * rs;
                const f32x4 g0 = acc[ai][0][m][0] * acc[ai][1][m][0] * rs2, g1 = acc[ai][0][m][1] * acc[ai][1][m][1] * rs2;
                f32x4 p1a, p2a, p1b, p2b;
#pragma unroll
                for (int j = 0; j < 4; ++j) { const float s1a = fr == 15 ? gp0[j] : g0[j], s2a = fr >= 14 ? gp0[j] : g0[j], s1b = fr == 15 ? gp1[j] : g1[j], s2b = fr >= 14 ? gp1[j] : g1[j];
                    p1a[j] = dpp_ror1(s1a); p2a[j] = dpp_ror2(s2a); p1b[j] = dpp_ror1(s1b); p2b[j] = dpp_ror2(s2b); }
                const f32x4 a0 = w0a * p2a + w1a * p1a + w2a * g0, a1 = w0b * p2b + w1b * p1b + w2b * g1;
                const bool valid = (m > 0 || fr >= 2) && !(sample && m == 2 && fr < 2);
                if (valid) *(v4u*)(zc + (size_t)row * 1024 + c0) = pack8(a0, a1);
                if ((m & 1) == 0 && fr < 2) { float* sg = SG + (size_t)(blk * 8 + 2 * m + fr) * 1024 + c0; *(f32x4*)sg = g0; *(f32x4*)(sg + 4) = g1; }
                if ((m & 1) == 1 && fr >= 14) { float* sg = SG + (size_t)(blk * 8 + 2 * m + fr - 14) * 1024 + c0; *(f32x4*)sg = g0; *(f32x4*)(sg + 4) = g1; }
                gp0 = g0; gp1 = g1; } }
    }
};


struct EpiCz {
    static constexpr bool PERM = true, AFTER_DRAIN = false;
    bf16* gb; const float* rowss; const float* cw; float* SG;
    __device__ __forceinline__ void operator()(EPI_ARGS) const {
        const int c0 = u.pn * 128 + wc * 32 + 8 * fq;
        const f32x4 w0a = *(const f32x4*)(cw + c0), w0b = *(const f32x4*)(cw + c0 + 4), w1a = *(const f32x4*)(cw + 1024 + c0), w1b = *(const f32x4*)(cw + 1024 + c0 + 4),
                    w2a = *(const f32x4*)(cw + 2048 + c0), w2b = *(const f32x4*)(cw + 2048 + c0 + 4);
#pragma unroll
        for (int ai = 0; ai < 2; ++ai) { f32x4 gp0 = {0.f, 0.f, 0.f, 0.f}, gp1 = {0.f, 0.f, 0.f, 0.f}; const int blk = u.pm * 4 + ai * 2 + wr;
#pragma unroll
            for (int m = 0; m < 4; ++m) { const int row = u.pm * 256 + ai * 128 + wr * 64 + m * 16 + fr; const float rs = rstd_of(rowss, row); const float rs2 = rs * rs;
                const f32x4 g0 = acc[ai][0][m][0] * acc[ai][1][m][0] * rs2, g1 = acc[ai][0][m][1] * acc[ai][1][m][1] * rs2;
                f32x4 p1a, p2a, p1b, p2b;
#pragma unroll
                for (int j = 0; j < 4; ++j) { const float s1a = fr == 15 ? gp0[j] : g0[j], s2a = fr >= 14 ? gp0[j] : g0[j], s1b = fr == 15 ? gp1[j] : g1[j], s2b = fr >= 14 ? gp1[j] : g1[j];
                    p1a[j] = dpp_ror1(s1a); p2a[j] = dpp_ror2(s2a); p1b[j] = dpp_ror1(s1b); p2b[j] = dpp_ror2(s2b); }
                const f32x4 a0 = w0a * p2a + w1a * p1a + w2a * g0, a1 = w0b * p2b + w1b * p1b + w2b * g1;
                if (m > 0 || fr >= 2) { bf16* gp = gb + (size_t)row * 1024 + c0; const v4u gw = *(const v4u*)gp;
                    const f32x4 b0 = (f32x4){bflo(gw.x), bfhi(gw.x), bflo(gw.y), bfhi(gw.y)}, b1 = (f32x4){bflo(gw.z), bfhi(gw.z), bflo(gw.w), bfhi(gw.w)};
                    *(v4u*)gp = pack8(a0 * b0, a1 * b1); }
                if ((m & 1) == 0 && fr < 2) { float* sg = SG + (size_t)(blk * 8 + 2 * m + fr) * 1024 + c0; *(f32x4*)sg = g0; *(f32x4*)(sg + 4) = g1; }
                if ((m & 1) == 1 && fr >= 14) { float* sg = SG + (size_t)(blk * 8 + 2 * m + fr - 14) * 1024 + c0; *(f32x4*)sg = g0; *(f32x4*)(sg + 4) = g1; }
                gp0 = g0; gp1 = g1; } }
    }
};

__device__ __forceinline__ int rowmap(int mode, int n) {
    if (mode == 1) { if (n >= 512 && n < 1152) { const int d = n & 63; return (n & ~63) | (32 * ((d >> 4) & 1) + 8 * ((d >> 2) & 3) + 4 * (d >> 5) + (d & 3)); } return n; }
    if (mode == 2) { return n < DFF ? ((n >> 7) * 256 + (n & 127)) : (((n - DFF) >> 7) * 256 + 128 + ((n - DFF) & 127)); }
    if (mode == 3) { if (n < 1024) return n; const int c = (n - 1024) & 1023, z = n >= 2048 ? 1 : 0; return 1024 + (c >> 7) * 256 + z * 128 + (c & 127); }
    return n;
}
__device__ __forceinline__ void tr_item(const float* W, int K, int N, bf16* WT, const float* gain, float scale, int mode, LAS float* scr, int item, int lane) {
    const int nblk = N / 32, kb = item / nblk, nb = item % nblk, k0 = 64 * kb, n0 = 32 * nb;
#pragma unroll
    for (int i = 0; i < 8; ++i) { const int idx = lane + 64 * i, kk = idx >> 3, n4 = (idx & 7) * 4; const float gs = gain ? ((const GAS float*)gain)[k0 + kk] * scale : scale;
        const f32x4 w = __builtin_nontemporal_load((const GAS f32x4*)((const GAS float*)W + (size_t)(k0 + kk) * N + n0 + n4)); LAS float* d = scr + kk * 33 + n4; d[0] = w[0] * gs; d[1] = w[1] * gs; d[2] = w[2] * gs; d[3] = w[3] * gs; }
    LDS_WAIT(); asm volatile("" ::: "memory");
    const int c = lane & 7;
#pragma unroll
    for (int j = 0; j < 4; ++j) { const int n = (lane >> 3) + 8 * j; const LAS float* s = scr + (8 * c) * 33 + n;
        v4u o; o.x = pg8::cvt_pk_bf16(s[0 * 33], s[1 * 33]); o.y = pg8::cvt_pk_bf16(s[2 * 33], s[3 * 33]); o.z = pg8::cvt_pk_bf16(s[4 * 33], s[5 * 33]); o.w = pg8::cvt_pk_bf16(s[6 * 33], s[7 * 33]);
        *(GAS v4u*)((GAS bf16*)WT + (size_t)rowmap(mode, n0 + n) * K + k0 + 8 * c) = o; }
    LDS_WAIT(); asm volatile("" ::: "memory");
}
__device__ __forceinline__ double dexp_(double y) {
    const double k = rint(y * 1.4426950408889634); const double r = (y - k * 0.6931471803691238) - k * 1.9082149292705877e-10;
    double p = 1.0 / 6227020800.0;
    p = p * r + 1.0 / 479001600.0; p = p * r + 1.0 / 39916800.0; p = p * r + 1.0 / 3628800.0; p = p * r + 1.0 / 362880.0; p = p * r + 1.0 / 40320.0; p = p * r + 1.0 / 5040.0;
    p = p * r + 1.0 / 720.0; p = p * r + 1.0 / 120.0; p = p * r + 1.0 / 24.0; p = p * r + 1.0 / 6.0; p = p * r + 0.5; p = p * r + 1.0; p = p * r + 1.0;
    const long long bits = (long long)(1023 + (int)k) << 52; return p * __builtin_bit_cast(double, bits);
}
__device__ __forceinline__ void dsincos_(double x, double& s, double& c) {
    const double k = rint(x * 0.6366197723675814); const double r = (x - k * 1.5707963267948966) - k * 6.123233995736766e-17; const double r2 = r * r;
    const double sp = r * (1.0 + r2 * (-1.0 / 6.0 + r2 * (1.0 / 120.0 + r2 * (-1.0 / 5040.0 + r2 * (1.0 / 362880.0 + r2 * (-1.0 / 39916800.0 + r2 * (1.0 / 6227020800.0)))))));
    const double cp = 1.0 + r2 * (-0.5 + r2 * (1.0 / 24.0 + r2 * (-1.0 / 720.0 + r2 * (1.0 / 40320.0 + r2 * (-1.0 / 3628800.0 + r2 * (1.0 / 479001600.0 + r2 * (-1.0 / 87178291200.0)))))));
    const int q = ((int)k) & 3;
    s = q == 0 ? sp : q == 1 ? cp : q == 2 ? -sp : -cp; c = q == 0 ? cp : q == 1 ? -sp : q == 2 ? -cp : sp;
}

__device__ __forceinline__ const bf16* kvptr(const bf16* proj, const bf16* cb, int sample, int b, int c, int kvh, int kk, int isv) {
    if (!sample) { int pos = (c - 2) * 64 + kk; pos = pos < 0 ? 0 : pos; return proj + (size_t)(b * 4096 + pos) * 1280 + 1024 + isv * 128 + kvh * 64; }
    if (kk < 128) return cb + (size_t)(b * 128 + kk) * 128 + kvh * 64;
    int t = kk - 128; t = t > 31 ? 31 : t; return proj + (size_t)(MP + b * 32 + t) * 1280 + 1024 + isv * 128 + kvh * 64;
}
__device__ __forceinline__ void swa_phase(const bf16* proj, const bf16* ckb, const bf16* cvb, const float* sinks, bf16* ycat, LAS unsigned char* lds, int tid, int wave, int lane, int G) {
    LAS bf16* VT = (LAS bf16*)lds;
    const int fr = lane & 15, quad = lane >> 4;
    for (int it = blockIdx.x; it < 528; it += G) {
        int b, c, kvh, sample;
        if (it < 512) { sample = 0; b = it >> 7; c = (it >> 1) & 63; kvh = it & 1; } else { sample = 1; b = (it - 512) >> 1; c = 0; kvh = it & 1; }
        const int gq = wave >> 1, qhalf = wave & 1, head = kvh * 4 + gq;
        bf16x8 qf[2][2], kf0[4][2];
#pragma unroll
        for (int qb = 0; qb < 2; ++qb) { const int q = qhalf * 32 + qb * 16 + fr; const int row = sample ? MP + b * 32 + (q & 31) : b * 4096 + c * 64 + q;
            const GAS bf16* qp = (const GAS bf16*)proj + (size_t)row * 1280 + 512 + head * 64 + quad * 8; qf[qb][0] = *(const GAS bf16x8*)qp; qf[qb][1] = *(const GAS bf16x8*)(qp + 32); }
#pragma unroll
        for (int i = 0; i < 4; ++i) { const int key = 32 * (i >> 1) + (fr >> 2) * 8 + 4 * (i & 1) + (fr & 3); const GAS bf16* kp = (const GAS bf16*)kvptr(proj, ckb, sample, b, c, kvh, key, 0) + quad * 8;
            kf0[i][0] = *(const GAS bf16x8*)kp; kf0[i][1] = *(const GAS bf16x8*)(kp + 32); }
        __syncthreads();
#pragma unroll
        for (int i = 0; i < 3; ++i) { const int idx = tid + 512 * i, kk = idx % 192, dg = idx / 192; const v4u w = *(const GAS v4u*)((const GAS bf16*)kvptr(proj, cvb, sample, b, c, kvh, kk, 1) + dg * 8);
            LAS bf16* vp = VT + (dg * 8) * 200 + kk;
            vp[0] = (bf16)(w.x & 0xffffu); vp[200] = (bf16)(w.x >> 16); vp[400] = (bf16)(w.y & 0xffffu); vp[600] = (bf16)(w.y >> 16);
            vp[800] = (bf16)(w.z & 0xffffu); vp[1000] = (bf16)(w.z >> 16); vp[1200] = (bf16)(w.w & 0xffffu); vp[1400] = (bf16)(w.w >> 16); }
        __syncthreads();
        if (!(sample && qhalf)) {
            const int plo = sample ? 0 : (c >= 2 ? 0 : (2 - c) * 2), phi = sample ? 5 : 6;
            f32x4 s[12][2];
#pragma unroll
            for (int kg = 0; kg < 3; ++kg) { bf16x8 kf[4][2];
#pragma unroll
                for (int i = 0; i < 4; ++i) { if (kg == 0) { kf[i][0] = kf0[i][0]; kf[i][1] = kf0[i][1]; continue; } const int kb = kg * 4 + i, key = 32 * (kb >> 1) + (fr >> 2) * 8 + 4 * (kb & 1) + (fr & 3); const GAS bf16* kp = (const GAS bf16*)kvptr(proj, ckb, sample, b, c, kvh, key, 0) + quad * 8;
                    kf[i][0] = *(const GAS bf16x8*)kp; kf[i][1] = *(const GAS bf16x8*)(kp + 32); }
                __builtin_amdgcn_sched_barrier(0);
#pragma unroll
                for (int i = 0; i < 4; ++i)
#pragma unroll
                    for (int qb = 0; qb < 2; ++qb) { f32x4 a = {0.f, 0.f, 0.f, 0.f}; a = MFMA16(kf[i][0], qf[qb][0], a); a = MFMA16(kf[i][1], qf[qb][1], a); s[kg * 4 + i][qb] = a; }
                __builtin_amdgcn_sched_barrier(0); }
            const float sink = sinks[head];
            bf16x8 pf[6][2];
#pragma unroll
            for (int qb = 0; qb < 2; ++qb) { float mx = sink;
#pragma unroll
                for (int kb = 0; kb < 12; ++kb) { const bool pv = (kb >> 1) >= plo && (kb >> 1) < phi;
#pragma unroll
                    for (int j = 0; j < 4; ++j) { const float v = pv ? s[kb][qb][j] : -1e30f; s[kb][qb][j] = v; mx = fmaxf(mx, v); } }
                mx = fmaxf(mx, __shfl_xor(mx, 16)); mx = fmaxf(mx, __shfl_xor(mx, 32));
                float sum = 0.f;
#pragma unroll
                for (int kb = 0; kb < 12; ++kb)
#pragma unroll
                    for (int j = 0; j < 4; ++j) { const float e = __expf(s[kb][qb][j] - mx); s[kb][qb][j] = e; sum += e; }
                sum += __shfl_xor(sum, 16); sum += __shfl_xor(sum, 32); sum += __expf(sink - mx);
                const float inv = 1.0f / sum;
#pragma unroll
                for (int pr = 0; pr < 6; ++pr) pf[pr][qb] = __builtin_bit_cast(bf16x8, pack8(s[2 * pr][qb] * inv, s[2 * pr + 1][qb] * inv)); }
#pragma unroll
            for (int db = 0; db < 4; ++db) { bf16x8 vf[6];
#pragma unroll
                for (int pr = 0; pr < 6; ++pr) vf[pr] = *(const LAS bf16x8*)(VT + (db * 16 + fr) * 200 + 32 * pr + quad * 8);
#pragma unroll
                for (int qb = 0; qb < 2; ++qb) { f32x4 o = {0.f, 0.f, 0.f, 0.f};
#pragma unroll
                    for (int pr = 0; pr < 6; ++pr) o = MFMA16(pf[pr][qb], vf[pr], o);
#pragma unroll
                    for (int j = 0; j < 4; ++j) { const int q = qhalf * 32 + qb * 16 + quad * 4 + j;
                        if (!sample || q < 32) { const int row = sample ? MP + b * 32 + q : b * 4096 + c * 64 + q; ycat[(size_t)row * 1024 + 512 + head * 64 + db * 16 + fr] = (bf16)f2bf(o[j]); } } } }
        }
    }
    __syncthreads();
}

__device__ __forceinline__ void xattn_phase(const bf16* qx, const bf16* memk_l, const bf16* memvT_l, bf16* ox, int wave, int lane, int G) {
    const int fr = lane & 15, quad = lane >> 4;
    for (int t = wave * G + (int)blockIdx.x; t < 4160; t += 8 * G) {
        int bb, h, row0;
        if (t < 4096) { const int pair = t >> 8; bb = pair >> 2; h = pair & 3; row0 = bb * 4096 + (t & 255) * 16; }
        else { const int s = t - 4096, b = s >> 3; h = (s >> 1) & 3; bb = 4 + b; row0 = MP + b * 32 + (s & 1) * 16; }
        bf16x8 qf[8];
#pragma unroll
        for (int ks = 0; ks < 8; ++ks) qf[ks] = *(const bf16x8*)(qx + (size_t)(row0 + fr) * 1024 + h * 256 + ks * 32 + quad * 8);
        const bf16* kbase = memk_l + (size_t)bb * 262144 + h * 256 + quad * 8;
        f32x4 s[16];
#pragma unroll
        for (int kb = 0; kb < 16; ++kb) { const int key = 32 * (kb >> 1) + (fr >> 2) * 8 + 4 * (kb & 1) + (fr & 3); const bf16* kp = kbase + (size_t)key * 1024; f32x4 a = {0.f, 0.f, 0.f, 0.f};
#pragma unroll
            for (int ks = 0; ks < 8; ++ks) a = MFMA16(*(const bf16x8*)(kp + ks * 32), qf[ks], a);
            s[kb] = a; }
        float mx = -1e30f;
#pragma unroll
        for (int kb = 0; kb < 16; ++kb)
#pragma unroll
            for (int j = 0; j < 4; ++j) mx = fmaxf(mx, s[kb][j]);
        mx = fmaxf(mx, __shfl_xor(mx, 16)); mx = fmaxf(mx, __shfl_xor(mx, 32));
        float sum = 0.f;
#pragma unroll
        for (int kb = 0; kb < 16; ++kb)
#pragma unroll
            for (int j = 0; j < 4; ++j) { const float e = __expf(s[kb][j] - mx); s[kb][j] = e; sum += e; }
        sum += __shfl_xor(sum, 16); sum += __shfl_xor(sum, 32);
        const float inv = 1.0f / sum;
        bf16x8 pf[8];
#pragma unroll
        for (int pr = 0; pr < 8; ++pr) pf[pr] = __builtin_bit_cast(bf16x8, pack8(s[2 * pr] * inv, s[2 * pr + 1] * inv));
        const bf16* vbase = memvT_l + (size_t)bb * 262144 + (size_t)(h * 256 + fr) * 256 + quad * 8;
#pragma unroll 4
        for (int db = 0; db < 16; ++db) { f32x4 o = {0.f, 0.f, 0.f, 0.f};
#pragma unroll
            for (int pr = 0; pr < 8; ++pr) o = MFMA16(pf[pr], *(const bf16x8*)(vbase + (size_t)db * 4096 + pr * 32), o);
#pragma unroll
            for (int j = 0; j < 4; ++j) ox[(size_t)(row0 + quad * 4 + j) * 1024 + h * 256 + db * 16 + fr] = (bf16)f2bf(o[j]); }
    }
}


__device__ __forceinline__ void xstage(const bf16* src, size_t rowstride, LAS unsigned char* lds, int tid) {
    v4u t[16];
#pragma unroll
    for (int i = 0; i < 16; ++i) { const int row = (tid >> 5) + 16 * i, ch = tid & 31; t[i] = *(const GAS v4u*)((const GAS bf16*)src + (size_t)row * rowstride + ch * 8); }
#pragma unroll
    for (int i = 0; i < 16; ++i) { const int row = (tid >> 5) + 16 * i, ch = tid & 31; *(LAS v4u*)(lds + row * 528 + ch * 16) = t[i]; }
}
__device__ __forceinline__ void xattn_phase2(const bf16* qx, const bf16* memk_l, const bf16* memvT_l, bf16* ox, LAS unsigned char* lds, int tid, int wave, int lane, int G) {
    const int fr = lane & 15, quad = lane >> 4;
    for (int it = blockIdx.x; it < 256 + 32; it += G) {
        int bb, h, rowbase, nqb; bool active;
        if (it < 256) { bb = it >> 6; h = (it >> 4) & 3; rowbase = bb * 4096 + (it & 15) * 256; nqb = 2; active = true; }
        else { const int s = it - 256, b = s >> 2; h = s & 3; bb = 4 + b; rowbase = MP + b * 32; nqb = 1; active = wave < 2; }
        __syncthreads();
        xstage(memk_l + (size_t)bb * 262144 + h * 256, 1024, lds, tid);
        __syncthreads();
        bf16x8 pf[2][8];
#pragma unroll
        for (int qi = 0; qi < 2; ++qi) {
            if (qi < nqb && active) {
                const int row0 = rowbase + qi * 128 + wave * 16;
                bf16x8 qf[8];
#pragma unroll
                for (int ks = 0; ks < 8; ++ks) qf[ks] = __builtin_nontemporal_load((const GAS bf16x8*)((const GAS bf16*)qx + (size_t)(row0 + fr) * 1024 + h * 256 + ks * 32 + quad * 8));
                f32x4 s[16];
#pragma unroll
                for (int kb = 0; kb < 16; ++kb) { const int key = 32 * (kb >> 1) + (fr >> 2) * 8 + 4 * (kb & 1) + (fr & 3); const LAS unsigned char* kp = lds + key * 528 + quad * 16; f32x4 a = {0.f, 0.f, 0.f, 0.f};
#pragma unroll
                    for (int ks = 0; ks < 8; ++ks) a = MFMA16(*(const LAS bf16x8*)(kp + ks * 64), qf[ks], a);
                    s[kb] = a; }
                float mx = -1e30f;
#pragma unroll
                for (int kb = 0; kb < 16; ++kb)
#pragma unroll
                    for (int j = 0; j < 4; ++j) mx = fmaxf(mx, s[kb][j]);
                mx = fmaxf(mx, __shfl_xor(mx, 16)); mx = fmaxf(mx, __shfl_xor(mx, 32));
                float sum = 0.f;
#pragma unroll
                for (int kb = 0; kb < 16; ++kb)
#pragma unroll
                    for (int j = 0; j < 4; ++j) { const float e = __expf(s[kb][j] - mx); s[kb][j] = e; sum += e; }
                sum += __shfl_xor(sum, 16); sum += __shfl_xor(sum, 32);
                const float inv = 1.0f / sum;
#pragma unroll
                for (int pr = 0; pr < 8; ++pr) pf[qi][pr] = __builtin_bit_cast(bf16x8, pack8(s[2 * pr] * inv, s[2 * pr + 1] * inv));
            }
        }
        __syncthreads();
        xstage(memvT_l + (size_t)bb * 262144 + (size_t)h * 65536, 256, lds, tid);
        __syncthreads();
        if (active) {
            const int rowA = rowbase + wave * 16, rowB = rowA + 128;
#pragma unroll 4
            for (int db = 0; db < 16; ++db) { f32x4 oa = {0.f, 0.f, 0.f, 0.f}, ob = {0.f, 0.f, 0.f, 0.f}; const LAS unsigned char* vp = lds + (db * 16 + fr) * 528 + quad * 16;
                if (nqb == 2) {
#pragma unroll
                    for (int pr = 0; pr < 8; ++pr) { const bf16x8 vf = *(const LAS bf16x8*)(vp + pr * 64); oa = MFMA16(vf, pf[0][pr], oa); ob = MFMA16(vf, pf[1][pr], ob); }
                } else {
#pragma unroll
                    for (int pr = 0; pr < 8; ++pr) { const bf16x8 vf = *(const LAS bf16x8*)(vp + pr * 64); oa = MFMA16(vf, pf[0][pr], oa); }
                }
                u32x2v w; w.x = pk2(oa[0], oa[1]); w.y = pk2(oa[2], oa[3]);
                *(GAS u32x2v*)((GAS bf16*)ox + (size_t)(rowA + fr) * 1024 + h * 256 + db * 16 + quad * 4) = w;
                if (nqb == 2) { u32x2v w2; w2.x = pk2(ob[0], ob[1]); w2.y = pk2(ob[2], ob[3]); *(GAS u32x2v*)((GAS bf16*)ox + (size_t)(rowB + fr) * 1024 + h * 256 + db * 16 + quad * 4) = w2; } }
        }
    }
    __syncthreads();
}

__device__ __forceinline__ void s5_stage_u(const bf16* up, LAS float* ubuf, int lane) {
    const v4u w0 = *(const v4u*)up, w1 = *(const v4u*)(up + 8);
    LAS f32x4* d = (LAS f32x4*)(ubuf + lane * 16);
    d[0] = (f32x4){bflo(w0.x), bfhi(w0.x), bflo(w0.y), bfhi(w0.y)}; d[1] = (f32x4){bflo(w0.z), bfhi(w0.z), bflo(w0.w), bfhi(w0.w)};
    d[2] = (f32x4){bflo(w1.x), bfhi(w1.x), bflo(w1.y), bfhi(w1.y)}; d[3] = (f32x4){bflo(w1.z), bfhi(w1.z), bflo(w1.w), bfhi(w1.w)};
}
__device__ __forceinline__ f32x2v lo2_(f32x4 v) { return __builtin_shufflevector(v, v, 0, 1); }
__device__ __forceinline__ f32x2v hi2_(f32x4 v) { return __builtin_shufflevector(v, v, 2, 3); }
#define S5_STEP(sidx) do { const LAS f32x4* up_ = (const LAS f32x4*)(ubuf + (sidx) * 16); const f32x4 u0 = up_[0], u1 = up_[1], u2 = up_[2], u3 = up_[3]; \
    f32x2v ac_ = lo2_(bb[0]) * u0[0]; ac_ = hi2_(bb[0]) * u0[1] + ac_; ac_ = lo2_(bb[1]) * u0[2] + ac_; ac_ = hi2_(bb[1]) * u0[3] + ac_; \
    ac_ = lo2_(bb[2]) * u1[0] + ac_; ac_ = hi2_(bb[2]) * u1[1] + ac_; ac_ = lo2_(bb[3]) * u1[2] + ac_; ac_ = hi2_(bb[3]) * u1[3] + ac_; \
    ac_ = lo2_(bb[4]) * u2[0] + ac_; ac_ = hi2_(bb[4]) * u2[1] + ac_; ac_ = lo2_(bb[5]) * u2[2] + ac_; ac_ = hi2_(bb[5]) * u2[3] + ac_; \
    ac_ = lo2_(bb[6]) * u3[0] + ac_; ac_ = hi2_(bb[6]) * u3[1] + ac_; ac_ = lo2_(bb[7]) * u3[2] + ac_; ac_ = hi2_(bb[7]) * u3[3] + ac_; \
    const float nr_ = ar * hr - ai * hi + ac_.x, ni_ = ar * hi + ai * hr + ac_.y; hr = nr_; hi = ni_; } while (0)

typedef short bf16x4_t __attribute__((ext_vector_type(4)));
#define MFMA16K16(a, b, c) __builtin_amdgcn_mfma_f32_16x16x16bf16_1k(a, b, c, 0, 0, 0)
__device__ __forceinline__ bf16x4_t s5_load_u(const bf16* urow0, int fr, int quad) { return *(const GAS bf16x4_t*)((const GAS bf16*)urow0 + (size_t)fr * 1280 + quad * 4); }
__device__ __forceinline__ void s5_bu_block(const bf16x4_t a, const bf16x4_t (&bcf)[8], LAS float* bul, int fr, int quad) {
#pragma unroll
    for (int cb = 0; cb < 8; ++cb) { f32x4 d = {0.f, 0.f, 0.f, 0.f}; d = MFMA16K16(a, bcf[cb], d);
#pragma unroll
        for (int j = 0; j < 4; ++j) bul[(quad * 4 + j) * 130 + cb * 16 + fr] = d[j]; }
}
__device__ __forceinline__ void s5_local(const bf16* proj, const float* abar, const bf16* bbt, float* sloc, LAS float* bul, int slot, int nslots, int lane) {
    const int fr = lane & 15, quad = lane >> 4;
    for (int t = slot; t < 8192; t += nslots) {
        const int chunk = t & 63, g = (t >> 6) & 31, b = t >> 11;
        const float ar = abar[(g * 64 + lane) * 2], ai = abar[(g * 64 + lane) * 2 + 1];
        bf16x4_t bcf[8];
#pragma unroll
        for (int cb = 0; cb < 8; ++cb) bcf[cb] = *(const GAS bf16x4_t*)((const GAS bf16*)bbt + (size_t)(g * 128 + cb * 16 + fr) * 16 + quad * 4);
        float hr = 0.f, hi = 0.f;
        bf16x4_t ua[4];
#pragma unroll
        for (int blk = 0; blk < 4; ++blk) ua[blk] = s5_load_u(proj + (size_t)(b * 4096 + chunk * 64 + blk * 16) * 1280 + g * 16, fr, quad);
#pragma unroll
        for (int blk = 0; blk < 4; ++blk) {
            s5_bu_block(ua[blk], bcf, bul, fr, quad);
#pragma unroll 4
            for (int s = 0; s < 16; ++s) { const f32x2v bu = *(const LAS f32x2v*)(bul + s * 130 + 2 * lane); const float nr = ar * hr - ai * hi + bu.x, ni = ar * hi + ai * hr + bu.y; hr = nr; hi = ni; }
        }
        *(f32x2v*)(sloc + (size_t)t * 128 + lane * 2) = (f32x2v){hr, hi};
    }
}
__device__ __forceinline__ void s5_out(const bf16* proj, const float* abar, const bf16* bbt, const float* sloc, const float* st_re, const float* st_im, const float* c_re, const float* c_im,
                                       const float* dcoef, bf16* gbuf, float* out, LAS float* bul, LAS unsigned* hbuf, int slot, int nslots, int lane) {
    const int fr = lane & 15, quad = lane >> 4;
    for (int t = slot; t < 8192 + 256; t += nslots) {
        const int sample = t >= 8192; int b, g, chunk, nblk, rowbase;
        if (!sample) { chunk = t & 63; g = (t >> 6) & 31; b = t >> 11; nblk = 4; rowbase = b * 4096 + chunk * 64; } else { const int s = t - 8192; g = s & 31; b = s >> 5; chunk = 0; nblk = 2; rowbase = MP + b * 32; }
        const float ar = abar[(g * 64 + lane) * 2], ai = abar[(g * 64 + lane) * 2 + 1];
        bf16x4_t bcf[8];
#pragma unroll
        for (int cb = 0; cb < 8; ++cb) bcf[cb] = *(const GAS bf16x4_t*)((const GAS bf16*)bbt + (size_t)(g * 128 + cb * 16 + fr) * 16 + quad * 4);
        float hr, hi;
        if (!sample) { float pr = ar, pi = ai;
#pragma unroll
            for (int i = 0; i < 6; ++i) { const float t1 = pr * pr - pi * pi; pi = 2.f * pr * pi; pr = t1; }
            hr = 0.f; hi = 0.f; const float* sp = sloc + (size_t)(t - chunk) * 128 + lane * 2;
#pragma unroll 16
            for (int cc = 0; cc < chunk; ++cc) { const f32x2v sv = *(const f32x2v*)(sp + (size_t)cc * 128); const float nr = pr * hr - pi * hi + sv.x, ni = pr * hi + pi * hr + sv.y; hr = nr; hi = ni; } }
        else { hr = st_re[(b * 32 + g) * 64 + lane]; hi = st_im[(b * 32 + g) * 64 + lane]; }
        bf16x8 cf[4];
#pragma unroll
        for (int ks = 0; ks < 4; ++ks) { const f32x4 cr = *(const f32x4*)(c_re + (size_t)(g * 16 + fr) * 64 + ks * 16 + quad * 4), ci = *(const f32x4*)(c_im + (size_t)(g * 16 + fr) * 64 + ks * 16 + quad * 4);
            v4u w; w.x = pg8::cvt_pk_bf16(cr[0], -ci[0]); w.y = pg8::cvt_pk_bf16(cr[1], -ci[1]); w.z = pg8::cvt_pk_bf16(cr[2], -ci[2]); w.w = pg8::cvt_pk_bf16(cr[3], -ci[3]); cf[ks] = __builtin_bit_cast(bf16x8, w); }
        const float dco = dcoef[g * 16 + fr];
        bf16x4_t ua[4]; bf16 uraw[4][4];
#pragma unroll
        for (int blk = 0; blk < 4; ++blk) { const int bc = blk < nblk ? blk : nblk - 1; const bf16* urow0 = proj + (size_t)(rowbase + bc * 16) * 1280 + g * 16; ua[blk] = s5_load_u(urow0, fr, quad);
#pragma unroll
            for (int j = 0; j < 4; ++j) uraw[blk][j] = ((const GAS bf16*)urow0)[(size_t)(quad * 4 + j) * 1280 + fr]; }
#pragma unroll
        for (int blk = 0; blk < 4; ++blk) { if (blk < nblk) {
            s5_bu_block(ua[blk], bcf, bul, fr, quad);
#pragma unroll 4
            for (int s = 0; s < 16; ++s) { const f32x2v bu = *(const LAS f32x2v*)(bul + s * 130 + 2 * lane); const float nr = ar * hr - ai * hi + bu.x, ni = ar * hi + ai * hr + bu.y; hr = nr; hi = ni; hbuf[s * 68 + lane] = pg8::cvt_pk_bf16(hr, hi); }
            f32x4 y = {0.f, 0.f, 0.f, 0.f};
#pragma unroll
            for (int ks = 0; ks < 4; ++ks) { const bf16x8 a = *(const LAS bf16x8*)(hbuf + fr * 68 + ks * 16 + quad * 4); y = MFMA16(a, cf[ks], y); }
#pragma unroll
            for (int j = 0; j < 4; ++j) { const int s = blk * 16 + quad * 4 + j; const float uu = bflo((unsigned)uraw[blk][j]); const float yv = y[j] + dco * uu;
                const float z = 0.7978845608028654f * (yv + 0.044715f * yv * yv * yv); const float th = 1.0f - 2.0f / (1.0f + __expf(2.0f * z)); const float gl = 0.5f * yv * (1.0f + th);
                ((GAS bf16*)gbuf)[(size_t)(rowbase + s) * 512 + g * 16 + fr] = (bf16)f2bf(gl); }
        } }
        if (!sample && chunk == 63) { out[OFF_SRP + (b * 32 + g) * 64 + lane] = hr; out[OFF_SIP + (b * 32 + g) * 64 + lane] = hi; }
        if (sample) { out[OFF_SRS + (b * 32 + g) * 64 + lane] = hr; out[OFF_SIS + (b * 32 + g) * 64 + lane] = hi; }
    }
}

template <int KIND>
__device__ __forceinline__ void sample_gemm(const bf16* A, const bf16* Bt, int K, LAS unsigned char* lds, int tid, int wave, int lane,
                                            bf16* xbp, const float* base_f32, float* part_next, const float* part_cur, bf16* O) {
    const int fr = lane & 15, quad = lane >> 4;
    LAS f32x4* red = (LAS f32x4*)lds;
    LAS float* ssred = (LAS float*)(lds + 32768);
    for (int tile = blockIdx.x; tile < 256; tile += gridDim.x) {
        const int r0 = MP + (tile >> 4) * 16, c0 = (tile & 15) * 64, kw = K >> 3;
        const bf16* ap = A + (size_t)(r0 + fr) * K + wave * kw + quad * 8;
        const bf16* bp = Bt + (size_t)(c0 + fr) * K + wave * kw + quad * 8;
        f32x4 acc[4];
#pragma unroll
        for (int cb = 0; cb < 4; ++cb) acc[cb] = (f32x4){0.f, 0.f, 0.f, 0.f};
        const int e_cb = (tid >> 6) & 3, e_l2 = tid & 63, e_row = r0 + (e_l2 & 15), e_col = c0 + e_cb * 16 + 4 * (e_l2 >> 4); const size_t e_off = (size_t)e_row * 1024 + e_col;
        f32x4 e_bs = {0.f, 0.f, 0.f, 0.f}; float e_rs = 1.f;
        if (tid < 256) { if (KIND == 0) { if (base_f32) e_bs = *(const f32x4*)(base_f32 + e_off); else { const u32x2v w = *(const u32x2v*)(xbp + e_off); e_bs = (f32x4){bflo(w.x), bfhi(w.x), bflo(w.y), bfhi(w.y)}; } }
                         else e_rs = rstd_of(part_cur, e_row); }
        const int nks = kw >> 5;
        for (int k0 = 0; k0 < nks; k0 += 4) {
            bf16x8 a[4], b[4][4];
#pragma unroll
            for (int i = 0; i < 4; ++i) { const int ks = (k0 + i < nks) ? k0 + i : nks - 1;
                a[i] = *(const bf16x8*)(ap + ks * 32);
#pragma unroll
                for (int cb = 0; cb < 4; ++cb) b[i][cb] = *(const bf16x8*)(bp + (size_t)cb * 16 * K + ks * 32); }
            __builtin_amdgcn_sched_barrier(0);
#pragma unroll
            for (int i = 0; i < 4; ++i) if (k0 + i < nks) {
#pragma unroll
                for (int cb = 0; cb < 4; ++cb) acc[cb] = MFMA16(b[i][cb], a[i], acc[cb]); }
        }
#pragma unroll
        for (int cb = 0; cb < 4; ++cb) red[(wave * 4 + cb) * 64 + lane] = acc[cb] * 1.0f;
        __syncthreads();
        if (tid < 256) { const int cb = tid >> 6, l2 = tid & 63; f32x4 v = red[cb * 64 + l2];
#pragma unroll
            for (int w = 1; w < 8; ++w) v = v + red[(w * 4 + cb) * 64 + l2];
            const int row = r0 + (l2 & 15), col = c0 + cb * 16 + 4 * (l2 >> 4); const size_t off = (size_t)row * 1024 + col;
            if (KIND == 0) {
                v = v + e_bs; u32x2v o; o.x = pk2(v[0], v[1]); o.y = pk2(v[2], v[3]); *(u32x2v*)(xbp + off) = o;
                float ss = (v[0] * v[0] + v[1] * v[1]) + (v[2] * v[2] + v[3] * v[3]); ss += __shfl_xor(ss, 16); ss += __shfl_xor(ss, 32);
                if ((l2 >> 4) == 0) ssred[cb * 16 + (l2 & 15)] = ss; }
            else { const float rs = e_rs; u32x2v o; o.x = pk2(v[0] * rs, v[1] * rs); o.y = pk2(v[2] * rs, v[3] * rs); *(u32x2v*)(O + off) = o; }
        }
        if (KIND == 0) { __syncthreads(); if (tid < 16) part_next[(size_t)(r0 + tid) * 16 + (tile & 15)] = (ssred[tid] + ssred[16 + tid]) + (ssred[32 + tid] + ssred[48 + tid]); }
        __syncthreads();
    }
}


__device__ __forceinline__ void sample_cz(const bf16* A, const bf16* Bt, LAS unsigned char* lds, int tid, int wave, int lane,
                                          const float* part_cur, const float* cw, const float* st, bf16* zcp, float* outp) {
    const int fr = lane & 15, quad = lane >> 4;
    LAS f32x4* red = (LAS f32x4*)lds;
    LAS float* T = (LAS float*)(lds + 65536);
    LAS float* CZ = (LAS float*)(lds + 65536 + 8192);
    for (int tile = blockIdx.x; tile < 256; tile += gridDim.x) {
        const int b = tile >> 5, c0 = (tile & 31) * 32, r0 = MP + b * 32;
        const int wrow = 1024 + (c0 >> 7) * 256 + (c0 & 127);
        const GAS bf16* ap = (const GAS bf16*)A + (size_t)(r0 + fr) * 1024 + wave * 128 + quad * 8;
        const GAS bf16* bp = (const GAS bf16*)Bt + (size_t)(wrow + fr) * 1024 + wave * 128 + quad * 8;
        bf16x8 a[4][2], bw[4][4];
#pragma unroll
        for (int ks = 0; ks < 4; ++ks) {
#pragma unroll
            for (int rb = 0; rb < 2; ++rb) a[ks][rb] = *(const GAS bf16x8*)(ap + (size_t)rb * 16 * 1024 + ks * 32);
#pragma unroll
            for (int cb = 0; cb < 4; ++cb) bw[ks][cb] = *(const GAS bf16x8*)(bp + (size_t)((cb >> 1) * 128 + (cb & 1) * 16) * 1024 + ks * 32); }
        f32x4 acc[2][4];
#pragma unroll
        for (int rb = 0; rb < 2; ++rb)
#pragma unroll
            for (int cb = 0; cb < 4; ++cb) { f32x4 d = {0.f, 0.f, 0.f, 0.f};
#pragma unroll
                for (int ks = 0; ks < 4; ++ks) d = MFMA16(bw[ks][cb], a[ks][rb], d);
                acc[rb][cb] = d; }
#pragma unroll
        for (int rb = 0; rb < 2; ++rb)
#pragma unroll
            for (int cb = 0; cb < 4; ++cb) red[(wave * 8 + rb * 4 + cb) * 64 + lane] = acc[rb][cb];
        __syncthreads();
        {
            const int blk = tid >> 6, l2 = tid & 63, rb = blk >> 2, cb = blk & 3; f32x4 v = red[blk * 64 + l2];
#pragma unroll
            for (int w = 1; w < 8; ++w) v = v + red[(w * 8 + blk) * 64 + l2];
            *(LAS f32x4*)(T + ((cb >> 1) * 32 + rb * 16 + (l2 & 15)) * 32 + (cb & 1) * 16 + 4 * (l2 >> 4)) = v; }
        __syncthreads();
        const int r = tid >> 3, cq = (tid & 7) * 4;
        if (tid < 256) { const float rs = rstd_of(part_cur, r0 + r); const float rs2 = rs * rs;
            const f32x4 gc = *(const LAS f32x4*)(T + r * 32 + cq), zz = *(const LAS f32x4*)(T + (32 + r) * 32 + cq);
            *(LAS f32x4*)(CZ + r * 32 + cq) = gc * zz * rs2; }
        __syncthreads();
        if (tid < 256) { const int c = c0 + cq;
            const f32x4 x0 = *(const LAS f32x4*)(CZ + r * 32 + cq);
            const f32x4 s0 = *(const f32x4*)(st + (size_t)(b * 2) * 1024 + c), s1 = *(const f32x4*)(st + (size_t)(b * 2 + 1) * 1024 + c);
            f32x4 xm1 = s1, xm2 = s0;
            if (r >= 1) { xm1 = *(const LAS f32x4*)(CZ + (r - 1) * 32 + cq); xm2 = s1; }
            if (r >= 2) xm2 = *(const LAS f32x4*)(CZ + (r - 2) * 32 + cq);
            const f32x4 w0 = *(const f32x4*)(cw + c), w1 = *(const f32x4*)(cw + 1024 + c), w2 = *(const f32x4*)(cw + 2048 + c);
            const f32x4 z = w0 * xm2 + w1 * xm1 + w2 * x0;
            bf16* gp = zcp + (size_t)(r0 + r) * 1024 + c; const u32x2v gw = *(const u32x2v*)gp;
            u32x2v o; o.x = pk2(z[0] * bflo(gw.x), z[1] * bfhi(gw.x)); o.y = pk2(z[2] * bflo(gw.y), z[3] * bfhi(gw.y)); *(u32x2v*)gp = o;
            if (r >= 30) *(f32x4*)(outp + OFF_CMS + (size_t)(b * 2 + (r - 30)) * 1024 + c) = x0; }
        __syncthreads();
    }
}

struct Params { const float* in[36]; float* out; unsigned char* ws; int use_cg, pad; };

__global__ void __launch_bounds__(512, 2) mega_fwd(Params P) {
    extern __shared__ __attribute__((aligned(16))) unsigned char lds_raw[];
    LAS unsigned char* lds = (LAS unsigned char*)lds_raw;
    volatile LAS unsigned* MISC = (volatile LAS unsigned*)(lds + MISC_OFF);
    const int G = gridDim.x, NGW = G * 8, NT = G * 512;
    const int wave_s = __builtin_amdgcn_readfirstlane(threadIdx.x >> 6);
    for (int u = threadIdx.x; u < (LDS_BYTES - 131072) / 4; u += 512) ((LAS unsigned*)(lds + 131072))[u] = 0u;
    __syncthreads();
    XcdBarrier bar = xcd_barrier_post((unsigned*)(P.ws + WS_BAR), MISC + 8);
#ifndef STOP_AFTER
#define STOP_AFTER 1000
#endif
    int ph = 0;
#define RUN (ph < STOP_AFTER)
#define FRESH() const int tid = fresh_tid(wave_s), lane = tid & 63, wave = __builtin_amdgcn_readfirstlane(tid >> 6); const int gw = blockIdx.x * 8 + wave, gt = blockIdx.x * 512 + tid; (void)gw; (void)gt; (void)lane; LAS float* wscr = (LAS float*)(lds + 32768 + wave * 12288); (void)wscr;
#define SEAM() do { if (P.use_cg) cg::this_grid().sync(); else xcd_barrier(bar); ++ph; } while (0)

#define part ((float*)(ws + WS_PART))
#define PARTBUF(k) (part + (size_t)((k) & 1) * PART_ELEMS)
#define ropec ((float*)(ws + WS_ROPE))
#define ropes (ropec + 4096 * 32)
#define abar ((float*)(ws + WS_SSM))
#define bbar (abar + 32 * 64 * 2)
#define bbt ((bf16*)(bbar + 32 * 64 * 32))
#define ckb ((bf16*)(ws + WS_CKV))
#define cvb (ckb + 8 * 128 * 128)
#define sloc ((float*)(ws + WS_SLOC))
#define memk ((bf16*)(ws + WS_MEMK))
#define memvT ((bf16*)(ws + WS_MEMVT))
#define SG ((float*)(ws + WS_SIDE))
#define SV ((float*)(ws + WS_SIDE + SG_BYTES))
#define WT ((bf16*)(ws + WS_WT))
#define xb ((bf16*)(ws + WS_XB))
#define tmp (ws + WS_TMP)
#define proj0 ((bf16*)(tmp + TMP_PROJ0))
#define gbuf ((bf16*)(tmp + TMP_GBUF))
#define ycat ((bf16*)(tmp + TMP_YCAT))
#define memb ((bf16*)(tmp + TMP_MEMB))
#define qx ((bf16*)(tmp + TMP_QX))
#define ox ((bf16*)(tmp + TMP_OX))
#define act ((bf16*)(tmp + TMP_ACT))
#define gbm ((bf16*)(tmp + TMP_GB))
#define zc ((bf16*)(tmp + TMP_ZC))
#define PTRS() GAS unsigned char* wsg_ = (GAS unsigned char*)P.ws; GAS float* outg_ = (GAS float*)P.out; asm volatile("" : "+s"(wsg_), "+s"(outg_)); unsigned char* ws = (unsigned char*)wsg_; float* out = (float*)outg_;
    if (RUN) { PTRS() FRESH()
        {
            constexpr int NITEMS = 640 + 128 + 512 + 512 + 2 * 1024 + 512 + 2816 + 1408 + 1024;
            for (int it = gw; it < NITEMS; it += NGW) { int r = it;
#define TR(Wp, K_, N_, WTp, gainp, sc, mode) { const int ni_ = ((K_) / 64) * ((N_) / 32); if (r < ni_) { tr_item(Wp, K_, N_, WTp, gainp, sc, mode, wscr, r, lane); continue; } r -= ni_; }
                TR(P.in[15], 1024, 1280, WT + WT_INEVEN, P.in[11], 1.f, 1)
                TR(P.in[25], 512, 512, WT + WT_GLU, nullptr, 1.f, 0)
                TR(P.in[16], 1024, 1024, WT + WT_OUTEVEN, nullptr, 1.f, 0)
                TR(P.in[30], 1024, 1024, WT + WT_WQ, P.in[12], 0.0625f, 0)
                TR(P.in[31], 1024, 2048, WT + WT_WKV, nullptr, 1.f, 0)
                TR(P.in[31] + 2097152, 1024, 2048, WT + WT_WKV + 2097152, nullptr, 1.f, 0)
                TR(P.in[32], 1024, 1024, WT + WT_WO, nullptr, 1.f, 0)
                TR(P.in[33], 1024, 5632, WT + WT_UP, P.in[13], 1.f, 2)
                TR(P.in[35], 2816, 1024, WT + WT_DOWN, nullptr, 1.f, 0)
                { const int mi = r >> 7, l = mi >> 3, b = mi & 7; tr_item(P.in[10] + (size_t)mi * 262144, 256, 1024, memvT + (size_t)(l * 12 + 4 + b) * 262144, nullptr, 1.f, 0, wscr, r & 127, lane); }
            }
        }
        for (int m = gw; m < MROWS; m += NGW) { const float* xr = m < MP ? P.in[0] + (size_t)m * 1024 : P.in[1] + (size_t)(m - MP) * 1024; float ss = 0.f;
#pragma unroll
            for (int j = 0; j < 4; ++j) { const f32x4 v = __builtin_nontemporal_load((const f32x4*)(xr + (lane + 64 * j) * 4)); ss += (v[0] * v[0] + v[1] * v[1]) + (v[2] * v[2] + v[3] * v[3]);
                u32x2v w; w.x = pg8::cvt_pk_bf16(v[0], v[1]); w.y = pg8::cvt_pk_bf16(v[2], v[3]); *(u32x2v*)(xb + (size_t)m * 1024 + (lane + 64 * j) * 4) = w; }
            ss = wave_sum(ss); if (lane < 16) PARTBUF(0)[(size_t)m * 16 + lane] = lane == 0 ? ss : 0.f; }
        for (int i = gt; i < 262144; i += NT) { const f32x4 v = __builtin_nontemporal_load((const f32x4*)(P.in[2] + (size_t)i * 4)); u32x2v w; w.x = pg8::cvt_pk_bf16(v[0], v[1]); w.y = pg8::cvt_pk_bf16(v[2], v[3]); *(u32x2v*)(memb + (size_t)i * 4) = w; }
        for (int i = gt; i < 524288; i += NT) { const size_t e = (size_t)i * 4; const int lb = (int)(e >> 18), l = lb >> 3, b = lb & 7; const f32x4 v = __builtin_nontemporal_load((const f32x4*)(P.in[9] + e));
            u32x2v w; w.x = pg8::cvt_pk_bf16(v[0], v[1]); w.y = pg8::cvt_pk_bf16(v[2], v[3]); *(u32x2v*)(memk + (size_t)(l * 12 + 4 + b) * 262144 + (e & 262143)) = w; }
        for (int i = gt; i < 65536; i += NT) { const int j = i & 32767; const float* src = (i < 32768 ? P.in[3] : P.in[4]) + (size_t)j * 4; bf16* dst = (i < 32768 ? ckb : cvb) + (size_t)j * 4;
            const f32x4 v = *(const f32x4*)src; u32x2v w; w.x = pg8::cvt_pk_bf16(v[0], v[1]); w.y = pg8::cvt_pk_bf16(v[2], v[3]); *(u32x2v*)dst = w; }
        for (int i = gt; i < 4096 * 32; i += NT) { const int pos = i >> 5, d = i & 31; const double inv = dexp_(-(double)d * (9.210340371976184 / 32.0)); double s, c; dsincos_((double)pos * inv, s, c); ropec[i] = (float)c; ropes[i] = (float)s; }
        for (int i = gt; i < 2048; i += NT) { const double are = P.in[17][i], aim = P.in[18][i], dt = dexp_((double)P.in[19][i]); double s, c; dsincos_(aim * dt, s, c); const double mag = dexp_(are * dt);
            const double br = mag * c, bi = mag * s; abar[2 * i] = (float)br; abar[2 * i + 1] = (float)bi;
            const double nr = br - 1.0, ni = bi, den = are * are + aim * aim; const double qr = (nr * are + ni * aim) / den, qi = (ni * are - nr * aim) / den;
#pragma unroll 4
            for (int h = 0; h < 16; ++h) { const double xr = P.in[20][(size_t)i * 16 + h], xi = P.in[21][(size_t)i * 16 + h]; const float fre = (float)(qr * xr - qi * xi), fim = (float)(qr * xi + qi * xr); bbar[(size_t)i * 32 + 2 * h] = fre; bbar[(size_t)i * 32 + 2 * h + 1] = fim;
                bbt[((size_t)i * 2) * 16 + h] = (bf16)f2bf(fre); bbt[((size_t)i * 2 + 1) * 16 + h] = (bf16)f2bf(fim); } }
    }
    SEAM();
    if (RUN) { PTRS()
        if (G < 128 || (int)blockIdx.x >= G - 64) { pg8::Gemm g{memb, WT + WT_WKV, 1024, 4096, 1024}; pg8::StaticOrder S;
            if (G < 128) S.init(1024, 4096, G, (int)blockIdx.x); else S.init(1024, 4096, 64, (int)blockIdx.x - (G - 64)); EpiKV E{out, memk};
          pg8::gemm_phase<EpiKV, pg8::StaticOrder, true, true>(lds, g, S, E, wave_s); }
        { pg8::Gemm g{xb, WT + WT_INEVEN, MROWS, 1280, 1024}; pg8::StaticOrderF S; S.init(MROWS, 1280, G, (int)blockIdx.x); EpiIn0 E{proj0, PARTBUF(0), ropec, ropes, out};
          pg8::gemm_phase<EpiIn0, pg8::StaticOrderF, true, true>(lds, g, S, E, wave_s); }
        {
            FRESH()
            const int bx = (int)blockIdx.x, n2 = 325 - G;
            int slot = -1, nw = 1;
            if (G == 256) { if (bx >= n2 && bx < G - 64) { slot = (bx - n2) * 8 + wave; nw = (G - 64 - n2) * 8; } } else { slot = gw; nw = NGW; }
            if (slot >= 0) for (int it = slot; it < 2816 + 1408; it += nw) { int r = it;
                TR(P.in[33] + (size_t)1024 * 5632, 1024, 5632, WT + WT_UP + (size_t)5632 * 1024, P.in[13] + 1024, 1.f, 2)
                tr_item(P.in[35] + (size_t)2816 * 1024, 2816, 1024, WT + WT_DOWN + (size_t)2816 * 1024, nullptr, 1.f, 0, wscr, r, lane); }
        }
    }
    SEAM();
    if (RUN) { PTRS() FRESH()
        swa_phase(proj0, ckb, cvb, P.in[26], ycat, lds, tid, wave, lane, G);
        s5_local(proj0, abar, bbt, sloc, wscr, wave * G + (int)blockIdx.x, NGW, lane);
        for (int it = wave * G + (int)blockIdx.x; it < 512; it += NGW) { const int mi = it >> 7, l = mi >> 2, b = mi & 3;
            tr_item(out + OFF_MVP + (size_t)mi * 262144, 256, 1024, memvT + (size_t)(l * 12 + b) * 262144, nullptr, 1.f, 0, wscr, it & 127, lane); }
    }
    SEAM();
    if (RUN) { PTRS() FRESH() s5_out(proj0, abar, bbt, sloc, P.in[5], P.in[6], P.in[22], P.in[23], P.in[24], gbuf, out, (LAS float*)(lds + wave * 16384), (LAS unsigned*)(lds + wave * 16384 + 8448), wave * G + (int)blockIdx.x, NGW, lane); }
    SEAM();
    if (RUN) { PTRS() pg8::Gemm g{gbuf, WT + WT_GLU, MROWS, 512, 512}; pg8::StaticOrder S; S.init(MROWS, 512, G, (int)blockIdx.x); EpiGlu E{gbuf, ycat};
        pg8::gemm_phase<EpiGlu, pg8::StaticOrder, true, true>(lds, g, S, E, wave_s);
        {
            FRESH()
            const int bx = (int)blockIdx.x; int slot = -1, nw = 1;
            if (G > 130) { if (bx >= 130) { slot = (bx - 130) * 8 + wave; nw = (G - 130) * 8; } } else { slot = gw; nw = NGW; }
            if (slot >= 0) for (int it = slot; it < 1536 + 512; it += nw) { int r = it;
                TR(P.in[27], 1024, 3072, WT + WT_INODD, P.in[11] + 1024, 1.f, 3)
                tr_item(P.in[29], 1024, 1024, WT + WT_OUTODD, nullptr, 1.f, 0, wscr, r, lane); }
        } }
    SEAM();

#pragma unroll
    for (int l = 0; l < 2; ++l) {
        if (l == 1) {
            if (RUN) { PTRS() pg8::Gemm g{xb, WT + WT_INODD, MP, 1024, 1024}; pg8::StaticOrderF S; S.init(MP, 1024, G, (int)blockIdx.x); EpiBf16 E{gbm, 1024, PARTBUF(3)};
                pg8::gemm_phase<EpiBf16, pg8::StaticOrderF, true, true>(lds, g, S, E, wave_s);
                { FRESH() sample_gemm<1>(xb, WT + WT_INODD, 1024, lds, tid, wave, lane, nullptr, nullptr, nullptr, PARTBUF(3), gbm); } }
            SEAM();
            if (RUN) { PTRS() pg8::Gemm g{xb, WT + WT_INODD + (size_t)1024 * 1024, MP, 2048, 1024}; pg8::StaticOrderF S; S.init(MP, 2048, G, (int)blockIdx.x); EpiCz E{gbm, PARTBUF(3), P.in[28], SG};
                pg8::gemm_phase<EpiCz, pg8::StaticOrderF, true, true>(lds, g, S, E, wave_s);
                { FRESH() sample_cz(xb, WT + WT_INODD, lds, tid, wave, lane, PARTBUF(3), P.in[28], P.in[7], gbm, out); } }
            SEAM();
            if (RUN) { PTRS() FRESH()
                const float* cw = P.in[28];
                for (int i = gt; i < 512 * 128; i += NT) { const int ri = i >> 7, c0 = (i & 127) * 8, blk = ri >> 1, rr = ri & 1, row = blk * 64 + rr;
                    f32x4 pa0, pa1, pb0, pb1;
                    if ((blk & 63) == 0) { pa0 = pa1 = pb0 = pb1 = (f32x4){0.f, 0.f, 0.f, 0.f}; }
                    else { const float* s0 = SG + (size_t)((blk - 1) * 8 + 6) * 1024 + c0; pa0 = *(const f32x4*)s0; pa1 = *(const f32x4*)(s0 + 4); pb0 = *(const f32x4*)(s0 + 1024); pb1 = *(const f32x4*)(s0 + 1028); }
                    const float* sc = SG + (size_t)(blk * 8) * 1024 + c0; const f32x4 x00 = *(const f32x4*)sc, x01 = *(const f32x4*)(sc + 4);
                    f32x4 xm2a, xm2b, xm1a, xm1b, xca, xcb;
                    if (rr == 0) { xm2a = pa0; xm2b = pa1; xm1a = pb0; xm1b = pb1; xca = x00; xcb = x01; }
                    else { xm2a = pb0; xm2b = pb1; xm1a = x00; xm1b = x01; xca = *(const f32x4*)(sc + 1024); xcb = *(const f32x4*)(sc + 1028); }
                    const f32x4 w0a = *(const f32x4*)(cw + c0), w0b = *(const f32x4*)(cw + c0 + 4), w1a = *(const f32x4*)(cw + 1024 + c0), w1b = *(const f32x4*)(cw + 1028 + c0), w2a = *(const f32x4*)(cw + 2048 + c0), w2b = *(const f32x4*)(cw + 2052 + c0);
                    const f32x4 z0 = w0a * xm2a + w1a * xm1a + w2a * xca, z1 = w0b * xm2b + w1b * xm1b + w2b * xcb;
                    const v4u gw_ = *(const v4u*)(gbm + (size_t)row * 1024 + c0);
                    const f32x4 g0 = (f32x4){bflo(gw_.x), bfhi(gw_.x), bflo(gw_.y), bfhi(gw_.y)}, g1 = (f32x4){bflo(gw_.z), bfhi(gw_.z), bflo(gw_.w), bfhi(gw_.w)};
                    *(v4u*)(gbm + (size_t)row * 1024 + c0) = pack8(g0 * z0, g1 * z1); }
                for (int i = gt; i < 4 * 2 * 1024; i += NT) { const int c = i & 1023, j = (i >> 10) & 1, b = i >> 11; out[OFF_CMP + i] = SG[(size_t)((64 * b + 63) * 8 + 6 + j) * 1024 + c]; }
            }
            SEAM();
        }
        if (RUN) { PTRS() pg8::Gemm g{(bf16*)(tmp + (size_t)(1 - l) * TMP_YCAT), WT + WT_OUTEVEN + (size_t)l * (WT_OUTODD - WT_OUTEVEN), MP, 1024, 1024}; pg8::StaticOrderF S; S.init(MP, 1024, G, (int)blockIdx.x);
            EpiRes E{P.in[0], P.in[1] - (size_t)MP * 1024, xb, PARTBUF(1 + 3 * l), l == 0 ? 1 : 0};
            pg8::gemm_phase<EpiRes, pg8::StaticOrderF, true, true>(lds, g, S, E, wave_s);
            { FRESH() sample_gemm<0>((bf16*)(tmp + (size_t)(1 - l) * TMP_YCAT), WT + WT_OUTEVEN + (size_t)l * (WT_OUTODD - WT_OUTEVEN), 1024, lds, tid, wave, lane, xb, l == 0 ? P.in[1] - (size_t)MP * 1024 : (const float*)nullptr, PARTBUF(1 + 3 * l), nullptr, nullptr); } }
        SEAM();
        if (RUN) { PTRS() pg8::Gemm g{xb, WT + WT_WQ + (size_t)l * 1048576, MP, 1024, 1024}; pg8::StaticOrderF S; S.init(MP, 1024, G, (int)blockIdx.x); EpiBf16 E{qx, 1024, PARTBUF(1 + 3 * l)};
            pg8::gemm_phase<EpiBf16, pg8::StaticOrderF, true, true>(lds, g, S, E, wave_s);
            { FRESH() sample_gemm<1>(xb, WT + WT_WQ + (size_t)l * 1048576, 1024, lds, tid, wave, lane, nullptr, nullptr, nullptr, PARTBUF(1 + 3 * l), qx); } }
        SEAM();
        if (RUN) { PTRS() FRESH() xattn_phase2(qx, memk + (size_t)l * 12 * 262144, memvT + (size_t)l * 12 * 262144, ox, lds, tid, wave, lane, G); }
        SEAM();
        if (RUN) { PTRS() pg8::Gemm g{ox, WT + WT_WO + (size_t)l * 1048576, MP, 1024, 1024}; pg8::StaticOrderF S; S.init(MP, 1024, G, (int)blockIdx.x); EpiRes E{P.in[0], P.in[0], xb, PARTBUF(2 + 3 * l), 0};
            pg8::gemm_phase<EpiRes, pg8::StaticOrderF, true, true>(lds, g, S, E, wave_s);
            { FRESH() sample_gemm<0>(ox, WT + WT_WO + (size_t)l * 1048576, 1024, lds, tid, wave, lane, xb, nullptr, PARTBUF(2 + 3 * l), nullptr, nullptr); } }
        SEAM();
        if (RUN) { PTRS() pg8::Gemm g{xb, WT + WT_UP + (size_t)l * 5632 * 1024, MROWS, 5632, 1024}; pg8::StaticOrderF S; S.init(MROWS, 5632, G, (int)blockIdx.x);
            EpiFfnUp E{act, PARTBUF(2 + 3 * l), P.in[34] + (size_t)l * 3 * DFF, SG, SV};
            pg8::gemm_phase<EpiFfnUp, pg8::StaticOrderF, true, true>(lds, g, S, E, wave_s);
            if (l == 0) {
                FRESH()
                const int bx = (int)blockIdx.x, nb = 1430 % G; int slot = -1, nw = 1;
                if (nb > 0 && nb < G) { if (bx >= nb) { slot = (bx - nb) * 8 + wave; nw = (G - nb) * 8; } } else { slot = gw; nw = NGW; }
                if (slot >= 0) { for (int it = slot; it < 512 + 512 + 1024 + 512; it += nw) { int r = it;
                    TR(P.in[30] + 1048576, 1024, 1024, WT + WT_WQ + 1048576, P.in[12] + 1024, 0.0625f, 0)
                    TR(P.in[32] + 1048576, 1024, 1024, WT + WT_WO + 1048576, nullptr, 1.f, 0)
                    { if (r < 1024) { const int mi = 8 + (r >> 7), b = mi & 7; tr_item(P.in[10] + (size_t)mi * 262144, 256, 1024, memvT + (size_t)(12 + 4 + b) * 262144, nullptr, 1.f, 0, wscr, r & 127, lane); }
                      else { r -= 1024; const int mi = 4 + (r >> 7), b = mi & 3; tr_item(out + OFF_MVP + (size_t)mi * 262144, 256, 1024, memvT + (size_t)(12 + b) * 262144, nullptr, 1.f, 0, wscr, r & 127, lane); } } }
                  const int tslot = (slot >> 3) * 512 + tid, tn = (nw >> 3) * 512;
                  for (int i = 524288 + tslot; i < 1048576; i += tn) { const size_t e = (size_t)i * 4; const int lb = (int)(e >> 18), l = lb >> 3, b = lb & 7; const f32x4 v = __builtin_nontemporal_load((const f32x4*)(P.in[9] + e));
            u32x2v w; w.x = pg8::cvt_pk_bf16(v[0], v[1]); w.y = pg8::cvt_pk_bf16(v[2], v[3]); *(u32x2v*)(memk + (size_t)(l * 12 + 4 + b) * 262144 + (e & 262143)) = w; } }
            } }
        SEAM();
        if (RUN) { PTRS() FRESH()
            const float* cw = P.in[34] + (size_t)l * 3 * DFF; const float* st = P.in[8] + (size_t)l * 8 * 2 * DFF;
            for (int i = gt; i < 528 * 352; i += NT) { const int fi = i / 352, c0 = (i % 352) * 8; int blk, row, rr, sb, vb; bool smp = fi >= 512;
                if (!smp) { blk = fi >> 1; rr = fi & 1; row = blk * 64 + rr; sb = 0; vb = 0; } else { const int s = fi - 512, half = (s >> 1) & 1; blk = 256 + (s >> 2); rr = s & 1; row = blk * 64 + half * 32 + rr; sb = half * 4; vb = half * 2; }
                f32x4 pa0, pa1, pb0, pb1;
                if (smp) { const int b = (blk - 256) * 2 + (sb >> 2); const float* s0 = st + (size_t)(b * 2) * DFF + c0; pa0 = *(const f32x4*)s0; pa1 = *(const f32x4*)(s0 + 4); pb0 = *(const f32x4*)(s0 + DFF); pb1 = *(const f32x4*)(s0 + DFF + 4); }
                else if ((blk & 63) == 0) { pa0 = pa1 = pb0 = pb1 = (f32x4){0.f, 0.f, 0.f, 0.f}; }
                else { const float* s0 = SG + (size_t)((blk - 1) * 8 + 6) * DFF + c0; pa0 = *(const f32x4*)s0; pa1 = *(const f32x4*)(s0 + 4); pb0 = *(const f32x4*)(s0 + DFF); pb1 = *(const f32x4*)(s0 + DFF + 4); }
                const float* sc = SG + (size_t)(blk * 8 + sb) * DFF + c0; const f32x4 x00 = *(const f32x4*)sc, x01 = *(const f32x4*)(sc + 4);
                f32x4 xm2a, xm2b, xm1a, xm1b, xca, xcb;
                if (rr == 0) { xm2a = pa0; xm2b = pa1; xm1a = pb0; xm1b = pb1; xca = x00; xcb = x01; }
                else { xm2a = pb0; xm2b = pb1; xm1a = x00; xm1b = x01; xca = *(const f32x4*)(sc + DFF); xcb = *(const f32x4*)(sc + DFF + 4); }
                const f32x4 w0a = *(const f32x4*)(cw + c0), w0b = *(const f32x4*)(cw + c0 + 4), w1a = *(const f32x4*)(cw + DFF + c0), w1b = *(const f32x4*)(cw + DFF + c0 + 4), w2a = *(const f32x4*)(cw + 2 * DFF + c0), w2b = *(const f32x4*)(cw + 2 * DFF + c0 + 4);
                const f32x4 ga = w0a * xm2a + w1a * xm1a + w2a * xca, gb_ = w0b * xm2b + w1b * xm1b + w2b * xcb;
                const float* sv = SV + (size_t)(blk * 4 + vb + rr) * DFF + c0; const f32x4 va = *(const f32x4*)sv, vb_ = *(const f32x4*)(sv + 4);
                f32x4 a0, a1;
#pragma unroll
                for (int j = 0; j < 4; ++j) { a0[j] = ga[j] * sigmoidf_(ga[j]) * va[j]; a1[j] = gb_[j] * sigmoidf_(gb_[j]) * vb_[j]; }
                *(v4u*)(act + (size_t)row * DFF + c0) = pack8(a0, a1); }
            for (int i = gt; i < 4 * 2 * DFF; i += NT) { const int c = i % DFF, j = (i / DFF) & 1, b = i / (2 * DFF); out[OFF_CFP + (size_t)l * 4 * 2 * DFF + i] = SG[(size_t)((64 * b + 63) * 8 + 6 + j) * DFF + c]; }
            for (int i = gt; i < 8 * 2 * DFF; i += NT) { const int c = i % DFF, j = (i / DFF) & 1, b = i / (2 * DFF); out[OFF_CFS + (size_t)l * 8 * 2 * DFF + i] = SG[(size_t)((256 + (b >> 1)) * 8 + (b & 1) * 4 + 2 + j) * DFF + c]; }
        }
        SEAM();
        if (RUN) { PTRS() pg8::Gemm g{act, WT + WT_DOWN + (size_t)l * 2816 * 1024, MP, 1024, DFF}; pg8::StaticOrderF S; S.init(MP, 1024, G, (int)blockIdx.x); EpiRes E{P.in[0], P.in[0], xb, PARTBUF(3 + 3 * l), 0};
            pg8::gemm_phase<EpiRes, pg8::StaticOrderF, true, true>(lds, g, S, E, wave_s);
            { FRESH() sample_gemm<0>(act, WT + WT_DOWN + (size_t)l * 2816 * 1024, DFF, lds, tid, wave, lane, xb, nullptr, PARTBUF(3 + 3 * l), nullptr, nullptr); } }
        SEAM();
    }
    if (RUN) { PTRS() FRESH()
        const float* gf = P.in[14];
        for (int m = gw; m < MROWS; m += NGW) { const float rs = rstd_of(PARTBUF(6), m); float* xr = out + (size_t)m * 1024; const bf16* xbr = xb + (size_t)m * 1024;
#pragma unroll
            for (int j = 0; j < 4; ++j) { const int c = (lane + 64 * j) * 4; const u32x2v w = __builtin_nontemporal_load((const u32x2v*)(xbr + c)); const f32x4 v = (f32x4){bflo(w.x), bfhi(w.x), bflo(w.y), bfhi(w.y)}, gg = *(const f32x4*)(gf + c); __builtin_nontemporal_store(v * rs * gg, (f32x4*)(xr + c)); } }
    }
}

extern "C" void kernel_launch(void* const* d_in, const int* in_sizes, int n_in, void* d_out, int out_size, void* d_ws, size_t ws_size, hipStream_t stream) {
    static int grid = 0;
    if (grid == 0) {
        int dev = 0, cus = 0, per_cu = 0;
        if (n_in != 36 || ws_size < 256 * MiB) { fprintf(stderr, "kernel_launch: unexpected n_in %d / ws %zu\n", n_in, ws_size); grid = -1; return; }
        (void)hipGetDevice(&dev); (void)hipDeviceGetAttribute(&cus, hipDeviceAttributeMultiprocessorCount, dev);
        if (hipFuncSetAttribute((const void*)mega_fwd, hipFuncAttributeMaxDynamicSharedMemorySize, LDS_BYTES) != hipSuccess) { fprintf(stderr, "kernel_launch: hipFuncSetAttribute failed\n"); grid = -1; return; }
        if (hipOccupancyMaxActiveBlocksPerMultiprocessor(&per_cu, (const void*)mega_fwd, 512, LDS_BYTES) != hipSuccess || per_cu < 1) per_cu = 1;
        (void)hipGetLastError();
        grid = cus * 1;
        if (grid > 256) grid = 256;
    }
    if (grid < 0) return;
    (void)hipMemsetAsync(d_ws, 0, CTL_ZERO_BYTES, stream);
    Params p{};
    for (int i = 0; i < 36; ++i) p.in[i] = (const float*)d_in[i];
    p.out = (float*)d_out; p.ws = (unsigned char*)d_ws; p.use_cg = 0; p.pad = 0;
    void* args[] = {&p};
    hipError_t e = hipLaunchCooperativeKernel((const void*)mega_fwd, dim3(grid), dim3(512), args, LDS_BYTES, stream);
    if (e != hipSuccess) fprintf(stderr, "cooperative launch failed: %s (grid %d)\n", hipGetErrorString(e), grid);
}
```

```cpp
#include <hip/hip_runtime.h>
#include <hip/hip_cooperative_groups.h>
#include <cstdio>
#include <cstdint>
namespace cg = cooperative_groups;
__device__ __forceinline__ int fresh_tid(int wave_s) { unsigned z = 0u; asm volatile("" : "+s"(z)); int t = wave_s * 64 + (int)__builtin_amdgcn_mbcnt_hi(~0u, __builtin_amdgcn_mbcnt_lo(~0u, z)); asm volatile("" : "+v"(t)); return t; }
namespace pg8 {
#define PG8_LAS __attribute__((address_space(3)))
typedef unsigned short bf16_t;
typedef short bf16x8 __attribute__((ext_vector_type(8)));
typedef float f32x4 __attribute__((ext_vector_type(4)));
typedef unsigned u32x4 __attribute__((ext_vector_type(4)));
constexpr int BM = 256, BK = 64, HALF = 128, HTB = HALF * BK * 2  , STAGE_BYTES = 8 * HTB, NXCD = 8, WGM = 8;

__host__ __device__ __forceinline__ int lds_byte(int r, int c) { const int st = (r >> 4) * 2 + (c >> 5), rr = r & 15, cc = c & 31, ob = rr * 64 + cc * 2; return st * 1024 + (ob ^ (((ob >> 9) & 1) << 5)); }
__host__ __device__ __forceinline__ void stage_rc(int b, int& R, int& C) { const int st = b / 1024, sb = b % 1024, swz = sb ^ (((sb >> 9) & 1) << 5); R = (st >> 1) * 16 + swz / 64; C = (st & 1) * 32 + (swz % 64) / 2; }
__host__ __device__ __forceinline__ int perm32(int rho) { const int n = rho >> 4, i = rho & 15; return 8 * (i >> 2) + 4 * n + (i & 3); }

struct Unit { int pm, pn; };
struct Gemm { const bf16_t* A; const bf16_t* Bt; int M, N, K; };

template <bool FULL> struct StaticOrderT {
    int nM, nN, nwg, G, c;
    __host__ __device__ void init(int M, int N, int G_, int c_) { nM = M / BM; nN = N / BM; nwg = nM * nN; G = G_; c = c_; }
    __host__ __device__ bool next(int i, Unit& u) const {
        const long L = (long)i * G + c; if (!(FULL && i == 0) && L >= nwg) return false;
        int wgid = (int)L; { const int q = nwg / NXCD, r = nwg % NXCD, xcd = wgid % NXCD, off = wgid / NXCD; wgid = (xcd < r ? xcd * (q + 1) : r * (q + 1) + (xcd - r) * q) + off; }
        const int nig = WGM * nN, gid = wgid / nig, fm = gid * WGM, gsz = (nM - fm) < WGM ? (nM - fm) : WGM;
        u.pm = fm + ((wgid % nig) % gsz); u.pn = (wgid % nig) / gsz; return true;
    }
    __device__ __forceinline__ void a_ready(const Unit&) const {}
    __device__ __forceinline__ void done(const Unit&) const {}
};

typedef StaticOrderT<false> StaticOrder; typedef StaticOrderT<true> StaticOrderF;
__device__ __forceinline__ unsigned cvt_pk_bf16(float lo, float hi) { unsigned r; asm volatile("v_cvt_pk_bf16_f32 %0, %1, %2" : "=v"(r) : "v"(lo), "v"(hi)); return r; }
typedef float f32x2 __attribute__((ext_vector_type(2)));
template <class Epi, class Sched, bool ALIGN_EPI = false, bool SP2 = false>
__device__ __forceinline__ void gemm_phase(PG8_LAS unsigned char* lds, const Gemm g, const Sched& S, const Epi& E, const int wave_s) {
    const int tid = fresh_tid(wave_s), wid = __builtin_amdgcn_readfirstlane(tid >> 6), lane = tid & 63, wr = wid >> 2, wc = wid & 3, fr = lane & 15, fq = lane >> 4;
    const int K = g.K, nt = K / BK;
    unsigned voffA[2], voffB[2];
#pragma unroll
    for (int i = 0; i < 2; ++i) { int R, C; stage_rc(tid * 16 + i * 8192, R, C); const int Rb = Epi::PERM ? ((R & ~31) + perm32(R & 31)) : R;
        voffA[i] = (unsigned)(R * K + C) * 2u; voffB[i] = (unsigned)(Rb * K + C) * 2u; }
    const size_t kstep = (size_t)(BK * 2);
    const size_t hstep = (size_t)HALF * K * 2;
    const size_t tstep = 2 * hstep;
    const unsigned ldsw = (unsigned)wid * 1024u;
    const int aoff = lds_byte(wr * 64 + fr, fq * 8), boff = lds_byte(wc * 32 + fr, fq * 8);
#define PG8_SA(b, h) (((b) * 2 + (h)) * HTB)
#define PG8_SB(b, h) ((4 + (b) * 2 + (h)) * HTB)
#define PG8_STAGE(bufoff, gbase, voff) do { _Pragma("unroll") for (int _i = 0; _i < 2; ++_i) \
        __builtin_amdgcn_global_load_lds((const unsigned*)((const char*)(gbase) + (voff)[_i]), (PG8_LAS unsigned*)(lds + (bufoff) + ldsw + _i * 8192), 16, 0, 0); } while (0)
#define PG8_LDA(dst, b, h) do { _Pragma("unroll") for (int m = 0; m < 4; ++m) _Pragma("unroll") for (int k = 0; k < 2; ++k) dst[m][k] = *(const PG8_LAS bf16x8*)(lds + PG8_SA(b, h) + aoff + m * 2048 + k * 1024); } while (0)
#define PG8_LDB(dst, b, h) do { _Pragma("unroll") for (int n = 0; n < 2; ++n) _Pragma("unroll") for (int k = 0; k < 2; ++k) dst[n][k] = *(const PG8_LAS bf16x8*)(lds + PG8_SB(b, h) + boff + n * 2048 + k * 1024); } while (0)
#define PG8_MMA(ai, bj, At, Bt) do { __builtin_amdgcn_s_setprio(1); _Pragma("unroll") for (int m = 0; m < 4; ++m) _Pragma("unroll") for (int n = 0; n < 2; ++n) _Pragma("unroll") for (int k = 0; k < 2; ++k) \
        acc[ai][bj][m][n] = __builtin_amdgcn_mfma_f32_16x16x32_bf16(Bt[n][k], At[m][k], acc[ai][bj][m][n], 0, 0, 0); __builtin_amdgcn_s_setprio(0); } while (0)
#define PG8_WAIT_V(n) asm volatile("s_waitcnt vmcnt(" #n ")" ::: "memory")
#define PG8_WAIT_L(n) asm volatile("s_waitcnt lgkmcnt(" #n ")" ::: "memory")
#define PG8_BAR __builtin_amdgcn_s_barrier()
#define PG8_SCHED __builtin_amdgcn_sched_barrier(0)
    Unit cur, nxt; int ui = 0;
    if (!S.next(0, cur)) return;
    f32x4 acc[2][2][4][2];
#pragma unroll
    for (int a = 0; a < 2; ++a)
#pragma unroll
        for (int b = 0; b < 2; ++b)
#pragma unroll
            for (int m = 0; m < 4; ++m)
#pragma unroll
                for (int n = 0; n < 2; ++n) acc[a][b][m][n] = (f32x4){0.f, 0.f, 0.f, 0.f};
    bf16x8 At[4][2], B0[2][2], B1[2][2];
    const char* cA = (const char*)g.A + (size_t)cur.pm * tstep; const char* cB = (const char*)g.Bt + (size_t)cur.pn * tstep;
    S.a_ready(cur);
    if constexpr (SP2) {
        PG8_STAGE(PG8_SB(0, 0), cB, voffB); PG8_STAGE(PG8_SB(0, 1), cB + hstep, voffB); PG8_STAGE(PG8_SA(0, 0), cA, voffA); PG8_STAGE(PG8_SA(0, 1), cA + hstep, voffA);
        if (wr == 1) PG8_BAR;
        PG8_WAIT_V(2); PG8_BAR;
        PG8_STAGE(PG8_SB(1, 0), cB + kstep, voffB); PG8_STAGE(PG8_SA(1, 0), cA + kstep, voffA); PG8_STAGE(PG8_SB(1, 1), cB + hstep + kstep, voffB);
        PG8_WAIT_V(6); PG8_BAR;
    } else {
        PG8_STAGE(PG8_SB(0, 0), cB, voffB); PG8_STAGE(PG8_SA(0, 0), cA, voffA); PG8_STAGE(PG8_SB(0, 1), cB + hstep, voffB); PG8_STAGE(PG8_SA(0, 1), cA + hstep, voffA);
        if (wr == 1) PG8_BAR;
        PG8_WAIT_V(4); PG8_BAR;
        PG8_STAGE(PG8_SB(1, 0), cB + kstep, voffB); PG8_STAGE(PG8_SA(1, 0), cA + kstep, voffA); PG8_STAGE(PG8_SB(1, 1), cB + hstep + kstep, voffB);
        PG8_WAIT_V(6); PG8_BAR;
    }
    for (;;) {
        const bool has_next = S.next(ui + 1, nxt);
        const char* nA = has_next ? (const char*)g.A + (size_t)nxt.pm * tstep : cA; const char* nB = has_next ? (const char*)g.Bt + (size_t)nxt.pn * tstep : cB;
        for (int t = 0; t < nt; t += 2) {
            const bool last = (t == nt - 2);
            const char* a1 = cA + (size_t)(t + 1) * kstep;
            const char* a2 = last ? nA : cA + (size_t)(t + 2) * kstep; const char* b2 = last ? nB : cB + (size_t)(t + 2) * kstep;
            const char* a3 = a2 + kstep; const char* b3 = b2 + kstep;
            if (last && has_next) S.a_ready(nxt);
            if constexpr (SP2) {
            PG8_LDB(B0, 0, 0); PG8_LDB(B1, 0, 1); PG8_SCHED; PG8_LDA(At, 0, 0); PG8_STAGE(PG8_SA(1, 1), a1 + hstep, voffA);
            PG8_WAIT_V(8); PG8_WAIT_L(0); PG8_BAR; PG8_MMA(0, 0, At, B0); PG8_MMA(0, 1, At, B1); PG8_BAR; PG8_SCHED;
            PG8_LDA(At, 0, 1); PG8_STAGE(PG8_SB(0, 0), b2, voffB); PG8_STAGE(PG8_SB(0, 1), b2 + hstep, voffB); PG8_STAGE(PG8_SA(0, 0), a2, voffA);
            PG8_WAIT_V(8); PG8_WAIT_L(0); PG8_BAR; PG8_MMA(1, 0, At, B0); PG8_MMA(1, 1, At, B1); PG8_BAR; PG8_SCHED;
            PG8_LDB(B0, 1, 0); PG8_LDB(B1, 1, 1); PG8_SCHED; PG8_LDA(At, 1, 0); PG8_STAGE(PG8_SA(0, 1), a2 + hstep, voffA);
            PG8_WAIT_V(8); PG8_WAIT_L(0); PG8_BAR; PG8_MMA(0, 0, At, B0); PG8_MMA(0, 1, At, B1); PG8_BAR; PG8_SCHED;
            PG8_LDA(At, 1, 1); PG8_STAGE(PG8_SB(1, 0), b3, voffB); PG8_STAGE(PG8_SB(1, 1), b3 + hstep, voffB); PG8_STAGE(PG8_SA(1, 0), a3, voffA);
            PG8_WAIT_V(8); PG8_WAIT_L(0); PG8_BAR; PG8_MMA(1, 0, At, B0); PG8_MMA(1, 1, At, B1); PG8_BAR; PG8_SCHED;
            } else {
            PG8_LDB(B0, 0, 0); PG8_SCHED; PG8_LDA(At, 0, 0); PG8_STAGE(PG8_SA(1, 1), a1 + hstep, voffA);
            PG8_WAIT_L(8); PG8_BAR; PG8_WAIT_L(0); PG8_MMA(0, 0, At, B0); PG8_BAR; PG8_SCHED;
            PG8_LDB(B1, 0, 1); PG8_STAGE(PG8_SB(0, 0), b2, voffB);
            PG8_BAR; PG8_WAIT_L(0); PG8_MMA(0, 1, At, B1); PG8_BAR;
            PG8_LDA(At, 0, 1); PG8_STAGE(PG8_SA(0, 0), a2, voffA);
            PG8_BAR; PG8_WAIT_L(0); PG8_MMA(1, 0, At, B0); PG8_BAR; PG8_SCHED;
            PG8_STAGE(PG8_SB(0, 1), b2 + hstep, voffB);
            PG8_WAIT_V(6); PG8_BAR; PG8_MMA(1, 1, At, B1); PG8_BAR;
            PG8_LDB(B0, 1, 0); PG8_SCHED; PG8_LDA(At, 1, 0); PG8_STAGE(PG8_SA(0, 1), a2 + hstep, voffA);
            PG8_WAIT_L(8); PG8_BAR; PG8_WAIT_L(0); PG8_MMA(0, 0, At, B0); PG8_BAR; PG8_SCHED;
            PG8_LDB(B1, 1, 1); PG8_STAGE(PG8_SB(1, 0), b3, voffB);
            PG8_BAR; PG8_WAIT_L(0); PG8_MMA(0, 1, At, B1); PG8_BAR;
            PG8_LDA(At, 1, 1); PG8_STAGE(PG8_SA(1, 0), a3, voffA);
            PG8_BAR; PG8_WAIT_L(0); PG8_MMA(1, 0, At, B0); PG8_BAR; PG8_SCHED;
            PG8_STAGE(PG8_SB(1, 1), b3 + hstep, voffB);
            PG8_WAIT_V(6); PG8_BAR; PG8_MMA(1, 1, At, B1); PG8_BAR;
            }
        }
        if constexpr (ALIGN_EPI) { if (wr == 0) PG8_BAR; }
        if constexpr (!Epi::AFTER_DRAIN) { E(acc, cur, wr, wc, fr, fq); S.done(cur); }
        if (!has_next) break;
#pragma unroll
        for (int a = 0; a < 2; ++a)
#pragma unroll
            for (int b = 0; b < 2; ++b)
#pragma unroll
                for (int m = 0; m < 4; ++m)
#pragma unroll
                    for (int n = 0; n < 2; ++n) acc[a][b][m][n] = (f32x4){0.f, 0.f, 0.f, 0.f};
        cur = nxt; cA = nA; cB = nB; ++ui;
        if constexpr (ALIGN_EPI) { if (wr == 1) PG8_BAR; }
    }
    PG8_WAIT_V(0);
    if constexpr (!ALIGN_EPI) { if (wr == 0) PG8_BAR; }
    PG8_BAR;
    if constexpr (Epi::AFTER_DRAIN) { E.fused(acc, cur, wr, wc, fr, fq, lds, wid, lane); S.done(cur); }
#undef PG8_SA
#undef PG8_SB
#undef PG8_STAGE
#undef PG8_LDA
#undef PG8_LDB
#undef PG8_MMA
#undef PG8_WAIT_V
#undef PG8_WAIT_L
#undef PG8_BAR
#undef PG8_SCHED
}
}
#define GAS __attribute__((address_space(1)))
#define LAS __attribute__((address_space(3)))
typedef unsigned short bf16;
typedef unsigned v4u __attribute__((ext_vector_type(4)));
typedef float f32x4 __attribute__((ext_vector_type(4)));
typedef short bf16x8 __attribute__((ext_vector_type(8)));
typedef GAS unsigned gu32;
typedef GAS unsigned long long gu64;
#define RLX_AGENT __ATOMIC_RELAXED, __HIP_MEMORY_SCOPE_AGENT
#define LDS_WAIT() asm volatile("s_waitcnt lgkmcnt(0)" ::: "memory")
#define VM_WAIT() asm volatile("s_waitcnt vmcnt(0)" ::: "memory")
__device__ __forceinline__ unsigned long long rt() { return __builtin_amdgcn_s_memrealtime(); }
__device__ __forceinline__ unsigned f2bf(float f) { unsigned u = __builtin_bit_cast(unsigned, f); return (u + 0x7fffu + ((u >> 16) & 1u)) >> 16; }
__device__ __forceinline__ unsigned pk2(float lo, float hi) { return f2bf(lo) | (f2bf(hi) << 16); }

#define XB_TMO      128
#define XB_XCNT(j)  (256  + 64 * (j))
#define XB_XSUB(j)  (1280 + 64 * (j))
#define XB_XGEN(j)  (2304 + 64 * (j))
#define XB_TOP      3328
#define XB_TOPGEN   3392
#define XCD_BAR_WORDS 3456
#define XB_SPIN_CAP (1u << 18)

__device__ __forceinline__ unsigned xb_ld(unsigned* p)              { return __hip_atomic_load(p, __ATOMIC_RELAXED, __HIP_MEMORY_SCOPE_AGENT); }
__device__ __forceinline__ unsigned xb_add(unsigned* p, unsigned v) { return __hip_atomic_fetch_add(p, v, __ATOMIC_RELAXED, __HIP_MEMORY_SCOPE_AGENT); }
__device__ __forceinline__ unsigned xb_xcc_id() { return (unsigned)__builtin_amdgcn_s_getreg((3 << 11) | 20) & 0xFu; }
#define XB_SPIN(cond, bar) do { unsigned _sp = 0; while (cond) { __builtin_amdgcn_s_sleep(0); \
    if ((++_sp & 255u) == 0u) { if (xb_ld(&(bar)[XB_TMO])) break; if (_sp > XB_SPIN_CAP) { atomicAdd(&(bar)[XB_TMO], 1u); break; } } } } while (0)

struct XcdBarrier {
    unsigned* bar; unsigned x;
    volatile LAS unsigned* st;
};

__device__ __forceinline__ XcdBarrier xcd_barrier_post(unsigned* bar, volatile LAS unsigned* st) {
    XcdBarrier b; b.bar = bar; b.x = xb_xcc_id(); b.st = st;
    if (threadIdx.x == 0) (void)xb_add(&bar[XB_XCNT(b.x)], 1u);
    return b;
}
__device__ __forceinline__ void xcd_barrier_complete(unsigned* bar, unsigned x, unsigned& nloc, unsigned& nx) {
    const unsigned G = gridDim.x * gridDim.y * gridDim.z;
    unsigned sum, cnt, mine, sp = 0u;
    for (;;) {
        sum = 0u; cnt = 0u; mine = 0u;
#pragma unroll
        for (unsigned j = 0; j < 16; ++j) { const unsigned c = xb_ld(&bar[XB_XCNT(j)]); sum += c; cnt += (c > 0u) ? 1u : 0u; mine = (j == x) ? c : mine; }
        if (sum == G) break;
        __builtin_amdgcn_s_sleep(1);
        if ((++sp & 255u) == 0u) { if (xb_ld(&bar[XB_TMO])) break; if (sp > XB_SPIN_CAP) { atomicAdd(&bar[XB_TMO], 1u); break; } }
    }
    nloc = mine > 0u ? mine : 1u; nx = cnt > 0u ? cnt : 1u;
}

__device__ __forceinline__ void xcd_barrier(const XcdBarrier& b) {
    asm volatile("s_waitcnt vmcnt(0)" ::: "memory");
    __syncthreads();
    if (threadIdx.x == 0) {
        unsigned* bar = b.bar;
        __builtin_amdgcn_s_waitcnt(0);
        unsigned nloc = b.st[0], nx = b.st[1];
        if (nloc == 0u) { xcd_barrier_complete(bar, b.x, nloc, nx); b.st[0] = nloc; b.st[1] = nx; }
        const unsigned old = xb_add(&bar[XB_XSUB(b.x)], 1u);
        const unsigned gen = old / nloc;
        if (old + 1u == (gen + 1u) * nloc) {
            __builtin_amdgcn_fence(__ATOMIC_RELEASE, "agent");
            asm volatile("s_waitcnt vmcnt(0)" ::: "memory");
            const unsigned og = xb_add(&bar[XB_TOP], 1u);
            const unsigned tg = og / nx;
            if (og + 1u == (tg + 1u) * nx) xb_add(&bar[XB_TOPGEN], 1u);
            else XB_SPIN(xb_ld(&bar[XB_TOPGEN]) == tg, bar);
            __builtin_amdgcn_fence(__ATOMIC_ACQUIRE, "agent");
            xb_add(&bar[XB_XGEN(b.x)], 1u);
            asm volatile("s_waitcnt vmcnt(0)" ::: "memory");
        } else {
            XB_SPIN(xb_ld(&bar[XB_XGEN(b.x)]) == gen, bar);
            __builtin_amdgcn_fence(__ATOMIC_ACQUIRE, "agent");
            asm volatile("s_waitcnt vmcnt(0)" ::: "memory");
        }
    }
    __syncthreads();
}
typedef unsigned u32x2v __attribute__((ext_vector_type(2)));
typedef float f32x2v __attribute__((ext_vector_type(2)));

constexpr int MP = 16384, MROWS = 16640, DMODEL = 1024, DFF = 2816, NBLK64 = MROWS / 64;
constexpr float RMS_EPS = 1e-6f;
constexpr size_t OFF_Y = 0, OFF_WKP = (size_t)MROWS * 1024, OFF_WVP = OFF_WKP + 65536, OFF_SRP = OFF_WVP + 65536, OFF_SIP = OFF_SRP + 8192,
    OFF_CMP = OFF_SIP + 8192, OFF_CFP = OFF_CMP + 8192, OFF_MKP = OFF_CFP + 45056, OFF_MVP = OFF_MKP + 2097152, OFF_WKS = OFF_MVP + 2097152,
    OFF_WVS = OFF_WKS + 32768, OFF_SRS = OFF_WVS + 32768, OFF_SIS = OFF_SRS + 16384, OFF_CMS = OFF_SIS + 16384, OFF_CFS = OFF_CMS + 16384;
constexpr size_t MiB = 1u << 20;
constexpr size_t WS_ROWSS = 0, WS_BAR = 512 * 1024, CTL_ZERO_BYTES = 1 * MiB;
constexpr size_t WS_ROPE = 1 * MiB, WS_SSM = 2 * MiB, WS_CKV = 3 * MiB, WS_SLOC = 4 * MiB, WS_MEMK = 8 * MiB, WS_MEMVT = 20 * MiB, WS_SIDE = 32 * MiB;
constexpr size_t SG_BYTES = (size_t)NBLK64 * 8 * DFF * 4, SV_BYTES = (size_t)NBLK64 * 4 * DFF * 4;
static_assert(WS_SIDE + SG_BYTES + SV_BYTES <= 66 * MiB, "side buffers");
constexpr size_t WS_WT = 66 * MiB, WS_XB = 128 * MiB, WS_TMP = 161 * MiB;
constexpr size_t WT_INEVEN = 0, WT_GLU = WT_INEVEN + 1280 * 1024, WT_OUTEVEN = WT_GLU + 512 * 512, WT_WQ = WT_OUTEVEN + 1024 * 1024, WT_WKV = WT_WQ + 2 * 1024 * 1024,
    WT_WO = WT_WKV + 2 * 2048 * 1024, WT_UP = WT_WO + 2 * 1024 * 1024, WT_DOWN = WT_UP + (size_t)2 * 5632 * 1024, WT_INODD = WT_DOWN + (size_t)2 * 2816 * 1024,
    WT_OUTODD = WT_INODD + 3072 * 1024, WT_END = WT_OUTODD + 1024 * 1024;
static_assert(WS_WT + WT_END * 2 <= WS_XB, "weights");
static_assert(WS_XB + (size_t)MROWS * 1024 * 2 <= WS_TMP, "xb");
constexpr size_t TMP_BYTES = (size_t)MROWS * DFF * 2;
constexpr size_t WS_PART = 251 * MiB, PART_ELEMS = (size_t)MROWS * 16;
static_assert(WS_PART + 2 * PART_ELEMS * 4 <= 256 * MiB, "part");
static_assert(WS_TMP + TMP_BYTES <= 256 * MiB, "ws");
constexpr size_t TMP_PROJ0 = 0, TMP_GBUF = (size_t)MROWS * 1280 * 2, TMP_YCAT = TMP_GBUF + (size_t)MROWS * 512 * 2, TMP_MEMB = TMP_YCAT;
static_assert(TMP_YCAT + (size_t)MROWS * 1024 * 2 <= TMP_BYTES, "tmp");
constexpr size_t TMP_QX = 0, TMP_OX = (size_t)MROWS * 1024 * 2, TMP_ACT = 0, TMP_GB = 0, TMP_ZC = (size_t)MROWS * 1024 * 2;
constexpr int LDS_BYTES = 147456, MISC_OFF = 147456 - 512;
constexpr int NPH = 22;

#define MFMA16(a, b, c) __builtin_amdgcn_mfma_f32_16x16x32_bf16(a, b, c, 0, 0, 0)
__device__ __forceinline__ float bflo(unsigned w) { return __uint_as_float(w << 16); }
__device__ __forceinline__ float bfhi(unsigned w) { return __uint_as_float(w & 0xffff0000u); }
__device__ __forceinline__ v4u pack8(f32x4 a, f32x4 b) { v4u w; w.x = pg8::cvt_pk_bf16(a[0], a[1]); w.y = pg8::cvt_pk_bf16(a[2], a[3]); w.z = pg8::cvt_pk_bf16(b[0], b[1]); w.w = pg8::cvt_pk_bf16(b[2], b[3]); return w; }
__device__ __forceinline__ float rstd_of(const float* part, int row) { const f32x4* p = (const f32x4*)(part + (size_t)row * 16); const f32x4 a = p[0] + p[1] + p[2] + p[3]; return rsqrtf(((a[0] + a[1]) + (a[2] + a[3])) * (1.0f / 1024.0f) + RMS_EPS); }
__device__ __forceinline__ float sigmoidf_(float x) { return 1.0f / (1.0f + __expf(-x)); }
__device__ __forceinline__ float dpp_ror1(float v) { return __builtin_bit_cast(float, __builtin_amdgcn_update_dpp(0, __builtin_bit_cast(int, v), 0x121, 0xf, 0xf, false)); }
__device__ __forceinline__ float dpp_ror2(float v) { return __builtin_bit_cast(float, __builtin_amdgcn_update_dpp(0, __builtin_bit_cast(int, v), 0x122, 0xf, 0xf, false)); }
__device__ __forceinline__ float wave_sum(float v) {
#pragma unroll
    for (int o = 1; o < 64; o <<= 1) v += __shfl_xor(v, o);
    return v;
}

typedef pg8::Unit Unit;
#define EPI_ARGS const f32x4 (&acc)[2][2][4][2], const Unit& u, int wr, int wc, int fr, int fq

struct EpiBf16 {
    static constexpr bool PERM = true, AFTER_DRAIN = false;
    bf16* O; int ldc; const float* rowss;
    __device__ __forceinline__ void operator()(EPI_ARGS) const {
        const int row0 = u.pm * 256 + wr * 64 + fr, col0 = u.pn * 256 + wc * 32 + 8 * fq;
#pragma unroll
        for (int ai = 0; ai < 2; ++ai)
#pragma unroll
            for (int m = 0; m < 4; ++m) { const int row = row0 + ai * 128 + m * 16; const float rs = rstd_of(rowss, row); bf16* rp = O + (size_t)row * ldc + col0;
#pragma unroll
                for (int bj = 0; bj < 2; ++bj) *(v4u*)(rp + bj * 128) = pack8(acc[ai][bj][m][0] * rs, acc[ai][bj][m][1] * rs); }
    }
};
struct EpiRes {
    static constexpr bool PERM = true, AFTER_DRAIN = false;
    const float* base_p; const float* base_s; bf16* xb; float* rowss_next; int f32base;
    __device__ __forceinline__ void operator()(EPI_ARGS) const {
        const float* base = u.pm < 64 ? base_p : base_s;
        const int row0 = u.pm * 256 + wr * 64 + fr, col0 = u.pn * 256 + wc * 32 + 8 * fq;
#pragma unroll
        for (int ai = 0; ai < 2; ++ai)
#pragma unroll
            for (int m = 0; m < 4; ++m) { const int row = row0 + ai * 128 + m * 16; const size_t off = (size_t)row * 1024 + col0; float ss = 0.f;
#pragma unroll
                for (int bj = 0; bj < 2; ++bj) { f32x4 b0, b1;
                    if (f32base) { b0 = __builtin_nontemporal_load((const f32x4*)(base + off + bj * 128)); b1 = __builtin_nontemporal_load((const f32x4*)(base + off + bj * 128 + 4)); }
                    else { const v4u w = *(const v4u*)(xb + off + bj * 128); b0 = (f32x4){bflo(w.x), bfhi(w.x), bflo(w.y), bfhi(w.y)}; b1 = (f32x4){bflo(w.z), bfhi(w.z), bflo(w.w), bfhi(w.w)}; }
                    const f32x4 v0 = acc[ai][bj][m][0] + b0, v1 = acc[ai][bj][m][1] + b1;
                    *(v4u*)(xb + off + bj * 128) = pack8(v0, v1);
                    ss += (v0[0] * v0[0] + v0[1] * v0[1]) + (v0[2] * v0[2] + v0[3] * v0[3]) + (v1[0] * v1[0] + v1[1] * v1[1]) + (v1[2] * v1[2] + v1[3] * v1[3]); }
                ss += __shfl_xor(ss, 16); ss += __shfl_xor(ss, 32);
                if (fq == 0) rowss_next[(size_t)row * 16 + u.pn * 4 + wc] = ss; }
    }
};
struct EpiGlu {
    static constexpr bool PERM = true, AFTER_DRAIN = false;
    const bf16* g; bf16* ycat;
    __device__ __forceinline__ void operator()(EPI_ARGS) const {
        const int row0 = u.pm * 256 + wr * 64 + fr, col0 = u.pn * 256 + wc * 32 + 8 * fq;
#pragma unroll
        for (int ai = 0; ai < 2; ++ai)
#pragma unroll
            for (int m = 0; m < 4; ++m) { const int row = row0 + ai * 128 + m * 16;
#pragma unroll
                for (int bj = 0; bj < 2; ++bj) { const int col = col0 + bj * 128; const v4u gw = *(const v4u*)(g + (size_t)row * 512 + col);
                    const f32x4 a0 = acc[ai][bj][m][0], a1 = acc[ai][bj][m][1]; f32x4 o0, o1;
                    o0[0] = bflo(gw.x) * sigmoidf_(a0[0]); o0[1] = bfhi(gw.x) * sigmoidf_(a0[1]); o0[2] = bflo(gw.y) * sigmoidf_(a0[2]); o0[3] = bfhi(gw.y) * sigmoidf_(a0[3]);
                    o1[0] = bflo(gw.z) * sigmoidf_(a1[0]); o1[1] = bfhi(gw.z) * sigmoidf_(a1[1]); o1[2] = bflo(gw.w) * sigmoidf_(a1[2]); o1[3] = bfhi(gw.w) * sigmoidf_(a1[3]);
                    *(v4u*)(ycat + (size_t)row * 1024 + col) = pack8(o0, o1); } }
    }
};
struct EpiKV {
    static constexpr bool PERM = true, AFTER_DRAIN = false;
    float* out; bf16* memk;
    __device__ __forceinline__ void operator()(EPI_ARGS) const {
        const int row0 = u.pm * 256 + wr * 64 + fr, col0 = u.pn * 256 + wc * 32 + 8 * fq;
#pragma unroll
        for (int ai = 0; ai < 2; ++ai)
#pragma unroll
            for (int m = 0; m < 4; ++m) { const int row = row0 + ai * 128 + m * 16;
#pragma unroll
                for (int bj = 0; bj < 2; ++bj) { const int c = col0 + bj * 128, l = c >> 11, e = c & 2047, isv = e >> 10, dc = e & 1023;
                    float* op = out + (isv ? OFF_MVP : OFF_MKP) + (size_t)l * 1048576 + (size_t)row * 1024 + dc;
                    if (isv) { *(f32x4*)op = acc[ai][bj][m][0]; *(f32x4*)(op + 4) = acc[ai][bj][m][1]; } else { __builtin_nontemporal_store(acc[ai][bj][m][0], (f32x4*)op); __builtin_nontemporal_store(acc[ai][bj][m][1], (f32x4*)(op + 4)); }
                    if (!isv) *(v4u*)(memk + (size_t)l * 12 * 262144 + (size_t)row * 1024 + dc) = pack8(acc[ai][bj][m][0], acc[ai][bj][m][1]); } }
    }
};
struct EpiIn0 {
    static constexpr bool PERM = true, AFTER_DRAIN = false;
    bf16* proj; const float* rowss; const float* ropec; const float* ropes; float* out;
    __device__ __forceinline__ void operator()(EPI_ARGS) const {
        const int pn = u.pn;
#pragma unroll
        for (int ai = 0; ai < 2; ++ai)
#pragma unroll
            for (int m = 0; m < 4; ++m) { const int row = u.pm * 256 + ai * 128 + wr * 64 + m * 16 + fr; const float rs = rstd_of(rowss, row);
                const int pos = row < MP ? (row & 4095) : 2048 + (row & 31);
                bf16* rp = proj + (size_t)row * 1280;
                float* wk = nullptr; float* wv = nullptr;
                if (pn == 4) { if (row >= MP) { wk = out + OFF_WKS + (size_t)(row - MP) * 128; wv = out + OFF_WVS + (size_t)(row - MP) * 128; }
                               else if ((row & 4095) >= 3968) { const size_t o = (size_t)((row >> 12) * 128 + (row & 4095) - 3968) * 128; wk = out + OFF_WKP + o; wv = out + OFF_WVP + o; } }
#pragma unroll
                for (int bj = 0; bj < 2; ++bj) { const f32x4 v0 = acc[ai][bj][m][0] * rs, v1 = acc[ai][bj][m][1] * rs;
                    const bool rope = (pn == 2 || pn == 3 || (pn == 4 && bj == 0));
                    if (!rope) { const int col = pn * 256 + bj * 128 + wc * 32 + 8 * fq; *(v4u*)(rp + col) = pack8(v0, v1);
                        if (pn == 4 && wv) { __builtin_nontemporal_store(v0, (f32x4*)(wv + wc * 32 + 8 * fq)); __builtin_nontemporal_store(v1, (f32x4*)(wv + wc * 32 + 8 * fq + 4)); } }
                    else { const int gbase = pn * 256 + bj * 128 + (wc >> 1) * 64, d1 = 16 * (wc & 1) + 4 * fq;
                        const f32x4 c4 = *(const f32x4*)(ropec + pos * 32 + d1), s4 = *(const f32x4*)(ropes + pos * 32 + d1);
                        f32x4 o1 = v0 * c4 - v1 * s4, o2 = v1 * c4 + v0 * s4;
                        if (pn != 4) { o1 = o1 * 0.125f; o2 = o2 * 0.125f; }
                        u32x2v w1, w2; w1.x = pg8::cvt_pk_bf16(o1[0], o1[1]); w1.y = pg8::cvt_pk_bf16(o1[2], o1[3]); w2.x = pg8::cvt_pk_bf16(o2[0], o2[1]); w2.y = pg8::cvt_pk_bf16(o2[2], o2[3]);
                        *(u32x2v*)(rp + gbase + d1) = w1; *(u32x2v*)(rp + gbase + d1 + 32) = w2;
                        if (pn == 4 && wk) { const int cc = (wc >> 1) * 64 + d1; *(f32x4*)(wk + cc) = o1; *(f32x4*)(wk + cc + 32) = o2; } } } }
    }
};
struct EpiFfnUp {
    static constexpr bool PERM = true, AFTER_DRAIN = false;
    bf16* act; const float* rowss; const float* cw; float* SG; float* SV;
    __device__ __forceinline__ void operator()(EPI_ARGS) const {
        const int c0 = u.pn * 128 + wc * 32 + 8 * fq; const bool sample = u.pm == 64;
        const f32x4 w0a = *(const f32x4*)(cw + c0), w0b = *(const f32x4*)(cw + c0 + 4), w1a = *(const f32x4*)(cw + DFF + c0), w1b = *(const f32x4*)(cw + DFF + c0 + 4),
                    w2a = *(const f32x4*)(cw + 2 * DFF + c0), w2b = *(const f32x4*)(cw + 2 * DFF + c0 + 4);
#pragma unroll
        for (int ai = 0; ai < 2; ++ai) { f32x4 gp0 = {0.f, 0.f, 0.f, 0.f}, gp1 = {0.f, 0.f, 0.f, 0.f}; const int blk = u.pm * 4 + ai * 2 + wr;
#pragma unroll
            for (int m = 0; m < 4; ++m) { const int row = u.pm * 256 + ai * 128 + wr * 64 + m * 16 + fr; const float rs = rstd_of(rowss, row);
                const f32x4 g0 = acc[ai][0][m][0] * rs, g1 = acc[ai][0][m][1] * rs, v0 = acc[ai][1][m][0] * rs, v1 = acc[ai][1][m][1] * rs;
                f32x4 p1a, p2a, p1b, p2b;
#pragma unroll
                for (int j = 0; j < 4; ++j) { const float s1a = fr == 15 ? gp0[j] : g0[j], s2a = fr >= 14 ? gp0[j] : g0[j], s1b = fr == 15 ? gp1[j] : g1[j], s2b = fr >= 14 ? gp1[j] : g1[j];
                    p1a[j] = dpp_ror1(s1a); p2a[j] = dpp_ror2(s2a); p1b[j] = dpp_ror1(s1b); p2b[j] = dpp_ror2(s2b); }
                const f32x4 ca = w0a * p2a + w1a * p1a + w2a * g0, cb = w0b * p2b + w1b * p1b + w2b * g1;
                f32x4 sa, sb;
#pragma unroll
                for (int j = 0; j < 4; ++j) { sa[j] = sigmoidf_(ca[j]); sb[j] = sigmoidf_(cb[j]); }
                const f32x4 a0 = ca * sa * v0, a1 = cb * sb * v1;
                const bool valid = (m > 0 || fr >= 2) && !(sample && m == 2 && fr < 2);
                if (valid) *(v4u*)(act + (size_t)row * DFF + c0) = pack8(a0, a1);
                if ((m & 1) == 0 && fr < 2) { float* sg = SG + (size_t)(blk * 8 + 2 * m + fr) * DFF + c0; *(f32x4*)sg = g0; *(f32x4*)(sg + 4) = g1;
                                              float* sv = SV + (size_t)(blk * 4 + m + fr) * DFF + c0; *(f32x4*)sv = v0; *(f32x4*)(sv + 4) = v1; }
                if ((m & 1) == 1 && fr >= 14) { float* sg = SG + (size_t)(blk * 8 + 2 * m + fr - 14) * DFF + c0; *(f32x4*)sg = g0; *(f32x4*)(sg + 4) = g1; }
                gp0 = g0; gp1 = g1; } }
    }
};
struct EpiInOdd {
    static constexpr bool PERM = true, AFTER_DRAIN = false;
    bf16* gb; bf16* zc; const float* rowss; const float* cw; float* SG;
    __device__ __forceinline__ void operator()(EPI_ARGS) const {
        if (u.pn < 4) {
            const int row0 = u.pm * 256 + wr * 64 + fr, col0 = u.pn * 256 + wc * 32 + 8 * fq;
#pragma unroll
            for (int ai = 0; ai < 2; ++ai)
#pragma unroll
                for (int m = 0; m < 4; ++m) { const int row = row0 + ai * 128 + m * 16; const float rs = rstd_of(rowss, row); bf16* rp = gb + (size_t)row * 1024 + col0;
#pragma unroll
                    for (int bj = 0; bj < 2; ++bj) *(v4u*)(rp + bj * 128) = pack8(acc[ai][bj][m][0] * rs, acc[ai][bj][m][1] * rs); }
            return;
        }
        const int c0 = (u.pn - 4) * 128 + wc * 32 + 8 * fq; const bool sample = u.pm == 64;
        const f32x4 w0a = *(const f32x4*)(cw + c0), w0b = *(const f32x4*)(cw + c0 + 4), w1a = *(const f32x4*)(cw + 1024 + c0), w1b = *(const f32x4*)(cw + 1024 + c0 + 4),
                    w2a = *(const f32x4*)(cw + 2048 + c0), w2b = *(const f32x4*)(cw + 2048 + c0 + 4);
#pragma unroll
        for (int ai = 0; ai < 2; ++ai) { f32x4 gp0 = {0.f, 0.f, 0.f, 0.f}, gp1 = {0.f, 0.f, 0.f, 0.f}; const int blk = u.pm * 4 + ai * 2 + wr;
#pragma unroll
            for (int m = 0; m < 4; ++m) { const int row = u.pm * 256 + ai * 128 + wr * 64 + m * 16 + fr; const float rs = rstd_of(rowss, row); const float rs2 = rs * rs;
                const f32x4 g0 = acc[ai][0][m][0] * acc[ai][1][m][0] * rs2, g1 = acc[ai][0][m][1] * acc[ai][1][m][1] * rs2;
                f32x4 p1a, p2a, p1b, p2b;
#pragma unroll
                for (int j = 0; j < 4; ++j) { const float s1a = fr == 15 ? gp0[j] : g0[j], s2a = fr >= 14 ? gp0[j] : g0[j], s1b = fr == 15 ? gp1[j] : g1[j], s2b = fr >= 14 ? gp1[j] : g1[j];
                    p1a[j] = dpp_ror1(s1a); p2a[j] = dpp_ror2(s2a); p1b[j] = dpp_ror1(s1b); p2b[j] = dpp_ror2(s2b); }
                const f32x4 a0 = w0a * p2a + w1a * p1a + w2a * g0, a1 = w0b * p2b + w1b * p1b + w2b * g1;
                const bool valid = (m > 0 || fr >= 2) && !(sample && m == 2 && fr < 2);
                if (valid) *(v4u*)(zc + (size_t)row * 1024 + c0) = pack8(a0, a1);
                if ((m & 1) == 0 && fr < 2) { float* sg = SG + (size_t)(blk * 8 + 2 * m + fr) * 1024 + c0; *(f32x4*)sg = g0; *(f32x4*)(sg + 4) = g1; }
                if ((m & 1) == 1 && fr >= 14) { float* sg = SG + (size_t)(blk * 8 + 2 * m + fr - 14) * 1024 + c0; *(f32x4*)sg = g0; *(f32x4*)(sg + 4) = g1; }
                gp0 = g0; gp1 = g1; } }
    }
};


struct EpiCz {
    static constexpr bool PERM = true, AFTER_DRAIN = false;
    bf16* gb; const float* rowss; const float* cw; float* SG;
    __device__ __forceinline__ void operator()(EPI_ARGS) const {
        const int c0 = u.pn * 128 + wc * 32 + 8 * fq;
        const f32x4 w0a = *(const f32x4*)(cw + c0), w0b = *(const f32x4*)(cw + c0 + 4), w1a = *(const f32x4*)(cw + 1024 + c0), w1b = *(const f32x4*)(cw + 1024 + c0 + 4),
                    w2a = *(const f32x4*)(cw + 2048 + c0), w2b = *(const f32x4*)(cw + 2048 + c0 + 4);
#pragma unroll
        for (int ai = 0; ai < 2; ++ai) { f32x4 gp0 = {0.f, 0.f, 0.f, 0.f}, gp1 = {0.f, 0.f, 0.f, 0.f}; const int blk = u.pm * 4 + ai * 2 + wr;
#pragma unroll
            for (int m = 0; m < 4; ++m) { const int row = u.pm * 256 + ai * 128 + wr * 64 + m * 16 + fr; const float rs = rstd_of(rowss, row); const float rs2 = rs * rs;
                const f32x4 g0 = acc[ai][0][m][0] * acc[ai][1][m][0] * rs2, g1 = acc[ai][0][m][1] * acc[ai][1][m][1] * rs2;
                f32x4 p1a, p2a, p1b, p2b;
#pragma unroll
                for (int j = 0; j < 4; ++j) { const float s1a = fr == 15 ? gp0[j] : g0[j], s2a = fr >= 14 ? gp0[j] : g0[j], s1b = fr == 15 ? gp1[j] : g1[j], s2b = fr >= 14 ? gp1[j] : g1[j];
                    p1a[j] = dpp_ror1(s1a); p2a[j] = dpp_ror2(s2a); p1b[j] = dpp_ror1(s1b); p2b[j] = dpp_ror2(s2b); }
                const f32x4 a0 = w0a * p2a + w1a * p1a + w2a * g0, a1 = w0b * p2b + w1b * p1b + w2b * g1;
                if (m > 0 || fr >= 2) { bf16* gp = gb + (size_t)row * 1024 + c0; const v4u gw = *(const v4u*)gp;
                    const f32x4 b0 = (f32x4){bflo(gw.x), bfhi(gw.x), bflo(gw.y), bfhi(gw.y)}, b1 = (f32x4){bflo(gw.z), bfhi(gw.z), bflo(gw.w), bfhi(gw.w)};
                    *(v4u*)gp = pack8(a0 * b0, a1 * b1); }
                if ((m & 1) == 0 && fr < 2) { float* sg = SG + (size_t)(blk * 8 + 2 * m + fr) * 1024 + c0; *(f32x4*)sg = g0; *(f32x4*)(sg + 4) = g1; }
                if ((m & 1) == 1 && fr >= 14) { float* sg = SG + (size_t)(blk * 8 + 2 * m + fr - 14) * 1024 + c0; *(f32x4*)sg = g0; *(f32x4*)(sg + 4) = g1; }
                gp0 = g0; gp1 = g1; } }
    }
};

__device__ __forceinline__ int rowmap(int mode, int n) {
    if (mode == 1) { if (n >= 512 && n < 1152) { const int d = n & 63; return (n & ~63) | (32 * ((d >> 4) & 1) + 8 * ((d >> 2) & 3) + 4 * (d >> 5) + (d & 3)); } return n; }
    if (mode == 2) { return n < DFF ? ((n >> 7) * 256 + (n & 127)) : (((n - DFF) >> 7) * 256 + 128 + ((n - DFF) & 127)); }
    if (mode == 3) { if (n < 1024) return n; const int c = (n - 1024) & 1023, z = n >= 2048 ? 1 : 0; return 1024 + (c >> 7) * 256 + z * 128 + (c & 127); }
    return n;
}
__device__ __forceinline__ void tr_item(const float* W, int K, int N, bf16* WT, const float* gain, float scale, int mode, LAS float* scr, int item, int lane) {
    const int nblk = N / 32, kb = item / nblk, nb = item % nblk, k0 = 64 * kb, n0 = 32 * nb;
#pragma unroll
    for (int i = 0; i < 8; ++i) { const int idx = lane + 64 * i, kk = idx >> 3, n4 = (idx & 7) * 4; const float gs = gain ? ((const GAS float*)gain)[k0 + kk] * scale : scale;
        const f32x4 w = __builtin_nontemporal_load((const GAS f32x4*)((const GAS float*)W + (size_t)(k0 + kk) * N + n0 + n4)); LAS float* d = scr + kk * 33 + n4; d[0] = w[0] * gs; d[1] = w[1] * gs; d[2] = w[2] * gs; d[3] = w[3] * gs; }
    LDS_WAIT(); asm volatile("" ::: "memory");
    const int c = lane & 7;
#pragma unroll
    for (int j = 0; j < 4; ++j) { const int n = (lane >> 3) + 8 * j; const LAS float* s = scr + (8 * c) * 33 + n;
        v4u o; o.x = pg8::cvt_pk_bf16(s[0 * 33], s[1 * 33]); o.y = pg8::cvt_pk_bf16(s[2 * 33], s[3 * 33]); o.z = pg8::cvt_pk_bf16(s[4 * 33], s[5 * 33]); o.w = pg8::cvt_pk_bf16(s[6 * 33], s[7 * 33]);
        *(GAS v4u*)((GAS bf16*)WT + (size_t)rowmap(mode, n0 + n) * K + k0 + 8 * c) = o; }
    LDS_WAIT(); asm volatile("" ::: "memory");
}
__device__ __forceinline__ double dexp_(double y) {
    const double k = rint(y * 1.4426950408889634); const double r = (y - k * 0.6931471803691238) - k * 1.9082149292705877e-10;
    double p = 1.0 / 6227020800.0;
    p = p * r + 1.0 / 479001600.0; p = p * r + 1.0 / 39916800.0; p = p * r + 1.0 / 3628800.0; p = p * r + 1.0 / 362880.0; p = p * r + 1.0 / 40320.0; p = p * r + 1.0 / 5040.0;
    p = p * r + 1.0 / 720.0; p = p * r + 1.0 / 120.0; p = p * r + 1.0 / 24.0; p = p * r + 1.0 / 6.0; p = p * r + 0.5; p = p * r + 1.0; p = p * r + 1.0;
    const long long bits = (long long)(1023 + (int)k) << 52; return p * __builtin_bit_cast(double, bits);
}
__device__ __forceinline__ void dsincos_(double x, double& s, double& c) {
    const double k = rint(x * 0.6366197723675814); const double r = (x - k * 1.5707963267948966) - k * 6.123233995736766e-17; const double r2 = r * r;
    const double sp = r * (1.0 + r2 * (-1.0 / 6.0 + r2 * (1.0 / 120.0 + r2 * (-1.0 / 5040.0 + r2 * (1.0 / 362880.0 + r2 * (-1.0 / 39916800.0 + r2 * (1.0 / 6227020800.0)))))));
    const double cp = 1.0 + r2 * (-0.5 + r2 * (1.0 / 24.0 + r2 * (-1.0 / 720.0 + r2 * (1.0 / 40320.0 + r2 * (-1.0 / 3628800.0 + r2 * (1.0 / 479001600.0 + r2 * (-1.0 / 87178291200.0)))))));
    const int q = ((int)k) & 3;
    s = q == 0 ? sp : q == 1 ? cp : q == 2 ? -sp : -cp; c = q == 0 ? cp : q == 1 ? -sp : q == 2 ? -cp : sp;
}

__device__ __forceinline__ const bf16* kvptr(const bf16* proj, const bf16* cb, int sample, int b, int c, int kvh, int kk, int isv) {
    if (!sample) { int pos = (c - 2) * 64 + kk; pos = pos < 0 ? 0 : pos; return proj + (size_t)(b * 4096 + pos) * 1280 + 1024 + isv * 128 + kvh * 64; }
    if (kk < 128) return cb + (size_t)(b * 128 + kk) * 128 + kvh * 64;
    int t = kk - 128; t = t > 31 ? 31 : t; return proj + (size_t)(MP + b * 32 + t) * 1280 + 1024 + isv * 128 + kvh * 64;
}
__device__ __forceinline__ void swa_phase(const bf16* proj, const bf16* ckb, const bf16* cvb, const float* sinks, bf16* ycat, LAS unsigned char* lds, int tid, int wave, int lane, int G) {
    LAS bf16* VT = (LAS bf16*)lds;
    const int fr = lane & 15, quad = lane >> 4;
    for (int it = blockIdx.x; it < 528; it += G) {
        int b, c, kvh, sample;
        if (it < 512) { sample = 0; b = it >> 7; c = (it >> 1) & 63; kvh = it & 1; } else { sample = 1; b = (it - 512) >> 1; c = 0; kvh = it & 1; }
        const int gq = wave >> 1, qhalf = wave & 1, head = kvh * 4 + gq;
        bf16x8 qf[2][2], kf0[4][2];
#pragma unroll
        for (int qb = 0; qb < 2; ++qb) { const int q = qhalf * 32 + qb * 16 + fr; const int row = sample ? MP + b * 32 + (q & 31) : b * 4096 + c * 64 + q;
            const GAS bf16* qp = (const GAS bf16*)proj + (size_t)row * 1280 + 512 + head * 64 + quad * 8; qf[qb][0] = *(const GAS bf16x8*)qp; qf[qb][1] = *(const GAS bf16x8*)(qp + 32); }
#pragma unroll
        for (int i = 0; i < 4; ++i) { const int key = 32 * (i >> 1) + (fr >> 2) * 8 + 4 * (i & 1) + (fr & 3); const GAS bf16* kp = (const GAS bf16*)kvptr(proj, ckb, sample, b, c, kvh, key, 0) + quad * 8;
            kf0[i][0] = *(const GAS bf16x8*)kp; kf0[i][1] = *(const GAS bf16x8*)(kp + 32); }
        __syncthreads();
#pragma unroll
        for (int i = 0; i < 3; ++i) { const int idx = tid + 512 * i, kk = idx % 192, dg = idx / 192; const v4u w = *(const GAS v4u*)((const GAS bf16*)kvptr(proj, cvb, sample, b, c, kvh, kk, 1) + dg * 8);
            LAS bf16* vp = VT + (dg * 8) * 200 + kk;
            vp[0] = (bf16)(w.x & 0xffffu); vp[200] = (bf16)(w.x >> 16); vp[400] = (bf16)(w.y & 0xffffu); vp[600] = (bf16)(w.y >> 16);
            vp[800] = (bf16)(w.z & 0xffffu); vp[1000] = (bf16)(w.z >> 16); vp[1200] = (bf16)(w.w & 0xffffu); vp[1400] = (bf16)(w.w >> 16); }
        __syncthreads();
        if (!(sample && qhalf)) {
            const int plo = sample ? 0 : (c >= 2 ? 0 : (2 - c) * 2), phi = sample ? 5 : 6;
            f32x4 s[12][2];
#pragma unroll
            for (int kg = 0; kg < 3; ++kg) { bf16x8 kf[4][2];
#pragma unroll
                for (int i = 0; i < 4; ++i) { if (kg == 0) { kf[i][0] = kf0[i][0]; kf[i][1] = kf0[i][1]; continue; } const int kb = kg * 4 + i, key = 32 * (kb >> 1) + (fr >> 2) * 8 + 4 * (kb & 1) + (fr & 3); const GAS bf16* kp = (const GAS bf16*)kvptr(proj, ckb, sample, b, c, kvh, key, 0) + quad * 8;
                    kf[i][0] = *(const GAS bf16x8*)kp; kf[i][1] = *(const GAS bf16x8*)(kp + 32); }
                __builtin_amdgcn_sched_barrier(0);
#pragma unroll
                for (int i = 0; i < 4; ++i)
#pragma unroll
                    for (int qb = 0; qb < 2; ++qb) { f32x4 a = {0.f, 0.f, 0.f, 0.f}; a = MFMA16(kf[i][0], qf[qb][0], a); a = MFMA16(kf[i][1], qf[qb][1], a); s[kg * 4 + i][qb] = a; }
                __builtin_amdgcn_sched_barrier(0); }
            const float sink = sinks[head];
            bf16x8 pf[6][2];
#pragma unroll
            for (int qb = 0; qb < 2; ++qb) { float mx = sink;
#pragma unroll
                for (int kb = 0; kb < 12; ++kb) { const bool pv = (kb >> 1) >= plo && (kb >> 1) < phi;
#pragma unroll
                    for (int j = 0; j < 4; ++j) { const float v = pv ? s[kb][qb][j] : -1e30f; s[kb][qb][j] = v; mx = fmaxf(mx, v); } }
                mx = fmaxf(mx, __shfl_xor(mx, 16)); mx = fmaxf(mx, __shfl_xor(mx, 32));
                float sum = 0.f;
#pragma unroll
                for (int kb = 0; kb < 12; ++kb)
#pragma unroll
                    for (int j = 0; j < 4; ++j) { const float e = __expf(s[kb][qb][j] - mx); s[kb][qb][j] = e; sum += e; }
                sum += __shfl_xor(sum, 16); sum += __shfl_xor(sum, 32); sum += __expf(sink - mx);
                const float inv = 1.0f / sum;
#pragma unroll
                for (int pr = 0; pr < 6; ++pr) pf[pr][qb] = __builtin_bit_cast(bf16x8, pack8(s[2 * pr][qb] * inv, s[2 * pr + 1][qb] * inv)); }
#pragma unroll
            for (int db = 0; db < 4; ++db) { bf16x8 vf[6];
#pragma unroll
                for (int pr = 0; pr < 6; ++pr) vf[pr] = *(const LAS bf16x8*)(VT + (db * 16 + fr) * 200 + 32 * pr + quad * 8);
#pragma unroll
                for (int qb = 0; qb < 2; ++qb) { f32x4 o = {0.f, 0.f, 0.f, 0.f};
#pragma unroll
                    for (int pr = 0; pr < 6; ++pr) o = MFMA16(pf[pr][qb], vf[pr], o);
#pragma unroll
                    for (int j = 0; j < 4; ++j) { const int q = qhalf * 32 + qb * 16 + quad * 4 + j;
                        if (!sample || q < 32) { const int row = sample ? MP + b * 32 + q : b * 4096 + c * 64 + q; ycat[(size_t)row * 1024 + 512 + head * 64 + db * 16 + fr] = (bf16)f2bf(o[j]); } } } }
        }
    }
    __syncthreads();
}

__device__ __forceinline__ void xattn_phase(const bf16* qx, const bf16* memk_l, const bf16* memvT_l, bf16* ox, int wave, int lane, int G) {
    const int fr = lane & 15, quad = lane >> 4;
    for (int t = wave * G + (int)blockIdx.x; t < 4160; t += 8 * G) {
        int bb, h, row0;
        if (t < 4096) { const int pair = t >> 8; bb = pair >> 2; h = pair & 3; row0 = bb * 4096 + (t & 255) * 16; }
        else { const int s = t - 4096, b = s >> 3; h = (s >> 1) & 3; bb = 4 + b; row0 = MP + b * 32 + (s & 1) * 16; }
        bf16x8 qf[8];
#pragma unroll
        for (int ks = 0; ks < 8; ++ks) qf[ks] = *(const bf16x8*)(qx + (size_t)(row0 + fr) * 1024 + h * 256 + ks * 32 + quad * 8);
        const bf16* kbase = memk_l + (size_t)bb * 262144 + h * 256 + quad * 8;
        f32x4 s[16];
#pragma unroll
        for (int kb = 0; kb < 16; ++kb) { const int key = 32 * (kb >> 1) + (fr >> 2) * 8 + 4 * (kb & 1) + (fr & 3); const bf16* kp = kbase + (size_t)key * 1024; f32x4 a = {0.f, 0.f, 0.f, 0.f};
#pragma unroll
            for (int ks = 0; ks < 8; ++ks) a = MFMA16(*(const bf16x8*)(kp + ks * 32), qf[ks], a);
            s[kb] = a; }
        float mx = -1e30f;
#pragma unroll
        for (int kb = 0; kb < 16; ++kb)
#pragma unroll
            for (int j = 0; j < 4; ++j) mx = fmaxf(mx, s[kb][j]);
        mx = fmaxf(mx, __shfl_xor(mx, 16)); mx = fmaxf(mx, __shfl_xor(mx, 32));
        float sum = 0.f;
#pragma unroll
        for (int kb = 0; kb < 16; ++kb)
#pragma unroll
            for (int j = 0; j < 4; ++j) { const float e = __expf(s[kb][j] - mx); s[kb][j] = e; sum += e; }
        sum += __shfl_xor(sum, 16); sum += __shfl_xor(sum, 32);
        const float inv = 1.0f / sum;
        bf16x8 pf[8];
#pragma unroll
        for (int pr = 0; pr < 8; ++pr) pf[pr] = __builtin_bit_cast(bf16x8, pack8(s[2 * pr] * inv, s[2 * pr + 1] * inv));
        const bf16* vbase = memvT_l + (size_t)bb * 262144 + (size_t)(h * 256 + fr) * 256 + quad * 8;
#pragma unroll 4
        for (int db = 0; db < 16; ++db) { f32x4 o = {0.f, 0.f, 0.f, 0.f};
#pragma unroll
            for (int pr = 0; pr < 8; ++pr) o = MFMA16(pf[pr], *(const bf16x8*)(vbase + (size_t)db * 4096 + pr * 32), o);
#pragma unroll
            for (int j = 0; j < 4; ++j) ox[(size_t)(row0 + quad * 4 + j) * 1024 + h * 256 + db * 16 + fr] = (bf16)f2bf(o[j]); }
    }
}


__device__ __forceinline__ void xstage(const bf16* src, size_t rowstride, LAS unsigned char* lds, int tid) {
    v4u t[16];
#pragma unroll
    for (int i = 0; i < 16; ++i) { const int row = (tid >> 5) + 16 * i, ch = tid & 31; t[i] = *(const GAS v4u*)((const GAS bf16*)src + (size_t)row * rowstride + ch * 8); }
#pragma unroll
    for (int i = 0; i < 16; ++i) { const int row = (tid >> 5) + 16 * i, ch = tid & 31; *(LAS v4u*)(lds + row * 528 + ch * 16) = t[i]; }
}
__device__ __forceinline__ void xattn_phase2(const bf16* qx, const bf16* memk_l, const bf16* memvT_l, bf16* ox, LAS unsigned char* lds, int tid, int wave, int lane, int G) {
    const int fr = lane & 15, quad = lane >> 4;
    for (int it = blockIdx.x; it < 256 + 32; it += G) {
        int bb, h, rowbase, nqb; bool active;
        if (it < 256) { bb = it >> 6; h = (it >> 4) & 3; rowbase = bb * 4096 + (it & 15) * 256; nqb = 2; active = true; }
        else { const int s = it - 256, b = s >> 2; h = s & 3; bb = 4 + b; rowbase = MP + b * 32; nqb = 1; active = wave < 2; }
        __syncthreads();
        xstage(memk_l + (size_t)bb * 262144 + h * 256, 1024, lds, tid);
        __syncthreads();
        bf16x8 pf[2][8];
#pragma unroll
        for (int qi = 0; qi < 2; ++qi) {
            if (qi < nqb && active) {
                const int row0 = rowbase + qi * 128 + wave * 16;
                bf16x8 qf[8];
#pragma unroll
                for (int ks = 0; ks < 8; ++ks) qf[ks] = __builtin_nontemporal_load((const GAS bf16x8*)((const GAS bf16*)qx + (size_t)(row0 + fr) * 1024 + h * 256 + ks * 32 + quad * 8));
                f32x4 s[16];
#pragma unroll
                for (int kb = 0; kb < 16; ++kb) { const int key = 32 * (kb >> 1) + (fr >> 2) * 8 + 4 * (kb & 1) + (fr & 3); const LAS unsigned char* kp = lds + key * 528 + quad * 16; f32x4 a = {0.f, 0.f, 0.f, 0.f};
#pragma unroll
                    for (int ks = 0; ks < 8; ++ks) a = MFMA16(*(const LAS bf16x8*)(kp + ks * 64), qf[ks], a);
                    s[kb] = a; }
                float mx = -1e30f;
#pragma unroll
                for (int kb = 0; kb < 16; ++kb)
#pragma unroll
                    for (int j = 0; j < 4; ++j) mx = fmaxf(mx, s[kb][j]);
                mx = fmaxf(mx, __shfl_xor(mx, 16)); mx = fmaxf(mx, __shfl_xor(mx, 32));
                float sum = 0.f;
#pragma unroll
                for (int kb = 0; kb < 16; ++kb)
#pragma unroll
                    for (int j = 0; j < 4; ++j) { const float e = __expf(s[kb][j] - mx); s[kb][j] = e; sum += e; }
                sum += __shfl_xor(sum, 16); sum += __shfl_xor(sum, 32);
                const float inv = 1.0f / sum;
#pragma unroll
                for (int pr = 0; pr < 8; ++pr) pf[qi][pr] = __builtin_bit_cast(bf16x8, pack8(s[2 * pr] * inv, s[2 * pr + 1] * inv));
            }
        }
        __syncthreads();
        xstage(memvT_l + (size_t)bb * 262144 + (size_t)h * 65536, 256, lds, tid);
        __syncthreads();
        if (active) {
            const int rowA = rowbase + wave * 16, rowB = rowA + 128;
#pragma unroll 4
            for (int db = 0; db < 16; ++db) { f32x4 oa = {0.f, 0.f, 0.f, 0.f}, ob = {0.f, 0.f, 0.f, 0.f}; const LAS unsigned char* vp = lds + (db * 16 + fr) * 528 + quad * 16;
                if (nqb == 2) {
#pragma unroll
                    for (int pr = 0; pr < 8; ++pr) { const bf16x8 vf = *(const LAS bf16x8*)(vp + pr * 64); oa = MFMA16(vf, pf[0][pr], oa); ob = MFMA16(vf, pf[1][pr], ob); }
                } else {
#pragma unroll
                    for (int pr = 0; pr < 8; ++pr) { const bf16x8 vf = *(const LAS bf16x8*)(vp + pr * 64); oa = MFMA16(vf, pf[0][pr], oa); }
                }
                u32x2v w; w.x = pk2(oa[0], oa[1]); w.y = pk2(oa[2], oa[3]);
                *(GAS u32x2v*)((GAS bf16*)ox + (size_t)(rowA + fr) * 1024 + h * 256 + db * 16 + quad * 4) = w;
                if (nqb == 2) { u32x2v w2; w2.x = pk2(ob[0], ob[1]); w2.y = pk2(ob[2], ob[3]); *(GAS u32x2v*)((GAS bf16*)ox + (size_t)(rowB + fr) * 1024 + h * 256 + db * 16 + quad * 4) = w2; } }
        }
    }
    __syncthreads();
}

__device__ __forceinline__ void s5_stage_u(const bf16* up, LAS float* ubuf, int lane) {
    const v4u w0 = *(const v4u*)up, w1 = *(const v4u*)(up + 8);
    LAS f32x4* d = (LAS f32x4*)(ubuf + lane * 16);
    d[0] = (f32x4){bflo(w0.x), bfhi(w0.x), bflo(w0.y), bfhi(w0.y)}; d[1] = (f32x4){bflo(w0.z), bfhi(w0.z), bflo(w0.w), bfhi(w0.w)};
    d[2] = (f32x4){bflo(w1.x), bfhi(w1.x), bflo(w1.y), bfhi(w1.y)}; d[3] = (f32x4){bflo(w1.z), bfhi(w1.z), bflo(w1.w), bfhi(w1.w)};
}
__device__ __forceinline__ f32x2v lo2_(f32x4 v) { return __builtin_shufflevector(v, v, 0, 1); }
__device__ __forceinline__ f32x2v hi2_(f32x4 v) { return __builtin_shufflevector(v, v, 2, 3); }
#define S5_STEP(sidx) do { const LAS f32x4* up_ = (const LAS f32x4*)(ubuf + (sidx) * 16); const f32x4 u0 = up_[0], u1 = up_[1], u2 = up_[2], u3 = up_[3]; \
    f32x2v ac_ = lo2_(bb[0]) * u0[0]; ac_ = hi2_(bb[0]) * u0[1] + ac_; ac_ = lo2_(bb[1]) * u0[2] + ac_; ac_ = hi2_(bb[1]) * u0[3] + ac_; \
    ac_ = lo2_(bb[2]) * u1[0] + ac_; ac_ = hi2_(bb[2]) * u1[1] + ac_; ac_ = lo2_(bb[3]) * u1[2] + ac_; ac_ = hi2_(bb[3]) * u1[3] + ac_; \
    ac_ = lo2_(bb[4]) * u2[0] + ac_; ac_ = hi2_(bb[4]) * u2[1] + ac_; ac_ = lo2_(bb[5]) * u2[2] + ac_; ac_ = hi2_(bb[5]) * u2[3] + ac_; \
    ac_ = lo2_(bb[6]) * u3[0] + ac_; ac_ = hi2_(bb[6]) * u3[1] + ac_; ac_ = lo2_(bb[7]) * u3[2] + ac_; ac_ = hi2_(bb[7]) * u3[3] + ac_; \
    const float nr_ = ar * hr - ai * hi + ac_.x, ni_ = ar * hi + ai * hr + ac_.y; hr = nr_; hi = ni_; } while (0)

typedef short bf16x4_t __attribute__((ext_vector_type(4)));
#define MFMA16K16(a, b, c) __builtin_amdgcn_mfma_f32_16x16x16bf16_1k(a, b, c, 0, 0, 0)
__device__ __forceinline__ bf16x4_t s5_load_u(const bf16* urow0, int fr, int quad) { return *(const GAS bf16x4_t*)((const GAS bf16*)urow0 + (size_t)fr * 1280 + quad * 4); }
__device__ __forceinline__ void s5_bu_block(const bf16x4_t a, const bf16x4_t (&bcf)[8], LAS float* bul, int fr, int quad) {
#pragma unroll
    for (int cb = 0; cb < 8; ++cb) { f32x4 d = {0.f, 0.f, 0.f, 0.f}; d = MFMA16K16(a, bcf[cb], d);
#pragma unroll
        for (int j = 0; j < 4; ++j) bul[(quad * 4 + j) * 130 + cb * 16 + fr] = d[j]; }
}
__device__ __forceinline__ void s5_local(const bf16* proj, const float* abar, const bf16* bbt, float* sloc, LAS float* bul, int slot, int nslots, int lane) {
    const int fr = lane & 15, quad = lane >> 4;
    for (int t = slot; t < 8192; t += nslots) {
        const int chunk = t & 63, g = (t >> 6) & 31, b = t >> 11;
        const float ar = abar[(g * 64 + lane) * 2], ai = abar[(g * 64 + lane) * 2 + 1];
        bf16x4_t bcf[8];
#pragma unroll
        for (int cb = 0; cb < 8; ++cb) bcf[cb] = *(const GAS bf16x4_t*)((const GAS bf16*)bbt + (size_t)(g * 128 + cb * 16 + fr) * 16 + quad * 4);
        float hr = 0.f, hi = 0.f;
        bf16x4_t ua[4];
#pragma unroll
        for (int blk = 0; blk < 4; ++blk) ua[blk] = s5_load_u(proj + (size_t)(b * 4096 + chunk * 64 + blk * 16) * 1280 + g * 16, fr, quad);
#pragma unroll
        for (int blk = 0; blk < 4; ++blk) {
            s5_bu_block(ua[blk], bcf, bul, fr, quad);
#pragma unroll 4
            for (int s = 0; s < 16; ++s) { const f32x2v bu = *(const LAS f32x2v*)(bul + s * 130 + 2 * lane); const float nr = ar * hr - ai * hi + bu.x, ni = ar * hi + ai * hr + bu.y; hr = nr; hi = ni; }
        }
        *(f32x2v*)(sloc + (size_t)t * 128 + lane * 2) = (f32x2v){hr, hi};
    }
}
__device__ __forceinline__ void s5_out(const bf16* proj, const float* abar, const bf16* bbt, const float* sloc, const float* st_re, const float* st_im, const float* c_re, const float* c_im,
                                       const float* dcoef, bf16* gbuf, float* out, LAS float* bul, LAS unsigned* hbuf, int slot, int nslots, int lane) {
    const int fr = lane & 15, quad = lane >> 4;
    for (int t = slot; t < 8192 + 256; t += nslots) {
        const int sample = t >= 8192; int b, g, chunk, nblk, rowbase;
        if (!sample) { chunk = t & 63; g = (t >> 6) & 31; b = t >> 11; nblk = 4; rowbase = b * 4096 + chunk * 64; } else { const int s = t - 8192; g = s & 31; b = s >> 5; chunk = 0; nblk = 2; rowbase = MP + b * 32; }
        const float ar = abar[(g * 64 + lane) * 2], ai = abar[(g * 64 + lane) * 2 + 1];
        bf16x4_t bcf[8];
#pragma unroll
        for (int cb = 0; cb < 8; ++cb) bcf[cb] = *(const GAS bf16x4_t*)((const GAS bf16*)bbt + (size_t)(g * 128 + cb * 16 + fr) * 16 + quad * 4);
        float hr, hi;
        if (!sample) { float pr = ar, pi = ai;
#pragma unroll
            for (int i = 0; i < 6; ++i) { const float t1 = pr * pr - pi * pi; pi = 2.f * pr * pi; pr = t1; }
            hr = 0.f; hi = 0.f; const float* sp = sloc + (size_t)(t - chunk) * 128 + lane * 2;
#pragma unroll 16
            for (int cc = 0; cc < chunk; ++cc) { const f32x2v sv = *(const f32x2v*)(sp + (size_t)cc * 128); const float nr = pr * hr - pi * hi + sv.x, ni = pr * hi + pi * hr + sv.y; hr = nr; hi = ni; } }
        else { hr = st_re[(b * 32 + g) * 64 + lane]; hi = st_im[(b * 32 + g) * 64 + lane]; }
        bf16x8 cf[4];
#pragma unroll
        for (int ks = 0; ks < 4; ++ks) { const f32x4 cr = *(const f32x4*)(c_re + (size_t)(g * 16 + fr) * 64 + ks * 16 + quad * 4), ci = *(const f32x4*)(c_im + (size_t)(g * 16 + fr) * 64 + ks * 16 + quad * 4);
            v4u w; w.x = pg8::cvt_pk_bf16(cr[0], -ci[0]); w.y = pg8::cvt_pk_bf16(cr[1], -ci[1]); w.z = pg8::cvt_pk_bf16(cr[2], -ci[2]); w.w = pg8::cvt_pk_bf16(cr[3], -ci[3]); cf[ks] = __builtin_bit_cast(bf16x8, w); }
        const float dco = dcoef[g * 16 + fr];
        bf16x4_t ua[4]; bf16 uraw[4][4];
#pragma unroll
        for (int blk = 0; blk < 4; ++blk) { const int bc = blk < nblk ? blk : nblk - 1; const bf16* urow0 = proj + (size_t)(rowbase + bc * 16) * 1280 + g * 16; ua[blk] = s5_load_u(urow0, fr, quad);
#pragma unroll
            for (int j = 0; j < 4; ++j) uraw[blk][j] = ((const GAS bf16*)urow0)[(size_t)(quad * 4 + j) * 1280 + fr]; }
#pragma unroll
        for (int blk = 0; blk < 4; ++blk) { if (blk < nblk) {
            s5_bu_block(ua[blk], bcf, bul, fr, quad);
#pragma unroll 4
            for (int s = 0; s < 16; ++s) { const f32x2v bu = *(const LAS f32x2v*)(bul + s * 130 + 2 * lane); const float nr = ar * hr - ai * hi + bu.x, ni = ar * hi + ai * hr + bu.y; hr = nr; hi = ni; hbuf[s * 68 + lane] = pg8::cvt_pk_bf16(hr, hi); }
            f32x4 y = {0.f, 0.f, 0.f, 0.f};
#pragma unroll
            for (int ks = 0; ks < 4; ++ks) { const bf16x8 a = *(const LAS bf16x8*)(hbuf + fr * 68 + ks * 16 + quad * 4); y = MFMA16(a, cf[ks], y); }
#pragma unroll
            for (int j = 0; j < 4; ++j) { const int s = blk * 16 + quad * 4 + j; const float uu = bflo((unsigned)uraw[blk][j]); const float yv = y[j] + dco * uu;
                const float z = 0.7978845608028654f * (yv + 0.044715f * yv * yv * yv); const float th = 1.0f - 2.0f / (1.0f + __expf(2.0f * z)); const float gl = 0.5f * yv * (1.0f + th);
                ((GAS bf16*)gbuf)[(size_t)(rowbase + s) * 512 + g * 16 + fr] = (bf16)f2bf(gl); }
        } }
        if (!sample && chunk == 63) { out[OFF_SRP + (b * 32 + g) * 64 + lane] = hr; out[OFF_SIP + (b * 32 + g) * 64 + lane] = hi; }
        if (sample) { out[OFF_SRS + (b * 32 + g) * 64 + lane] = hr; out[OFF_SIS + (b * 32 + g) * 64 + lane] = hi; }
    }
}

template <int KIND>
__device__ __forceinline__ void sample_gemm(const bf16* A, const bf16* Bt, int K, LAS unsigned char* lds, int tid, int wave, int lane,
                                            bf16* xbp, const float* base_f32, float* part_next, const float* part_cur, bf16* O) {
    const int fr = lane & 15, quad = lane >> 4;
    LAS f32x4* red = (LAS f32x4*)lds;
    LAS float* ssred = (LAS float*)(lds + 32768);
    for (int tile = blockIdx.x; tile < 256; tile += gridDim.x) {
        const int r0 = MP + (tile >> 4) * 16, c0 = (tile & 15) * 64, kw = K >> 3;
        const bf16* ap = A + (size_t)(r0 + fr) * K + wave * kw + quad * 8;
        const bf16* bp = Bt + (size_t)(c0 + fr) * K + wave * kw + quad * 8;
        f32x4 acc[4];
#pragma unroll
        for (int cb = 0; cb < 4; ++cb) acc[cb] = (f32x4){0.f, 0.f, 0.f, 0.f};
        const int e_cb = (tid >> 6) & 3, e_l2 = tid & 63, e_row = r0 + (e_l2 & 15), e_col = c0 + e_cb * 16 + 4 * (e_l2 >> 4); const size_t e_off = (size_t)e_row * 1024 + e_col;
        f32x4 e_bs = {0.f, 0.f, 0.f, 0.f}; float e_rs = 1.f;
        if (tid < 256) { if (KIND == 0) { if (base_f32) e_bs = *(const f32x4*)(base_f32 + e_off); else { const u32x2v w = *(const u32x2v*)(xbp + e_off); e_bs = (f32x4){bflo(w.x), bfhi(w.x), bflo(w.y), bfhi(w.y)}; } }
                         else e_rs = rstd_of(part_cur, e_row); }
        const int nks = kw >> 5;
        for (int k0 = 0; k0 < nks; k0 += 4) {
            bf16x8 a[4], b[4][4];
#pragma unroll
            for (int i = 0; i < 4; ++i) { const int ks = (k0 + i < nks) ? k0 + i : nks - 1;
                a[i] = *(const bf16x8*)(ap + ks * 32);
#pragma unroll
                for (int cb = 0; cb < 4; ++cb) b[i][cb] = *(const bf16x8*)(bp + (size_t)cb * 16 * K + ks * 32); }
            __builtin_amdgcn_sched_barrier(0);
#pragma unroll
            for (int i = 0; i < 4; ++i) if (k0 + i < nks) {
#pragma unroll
                for (int cb = 0; cb < 4; ++cb) acc[cb] = MFMA16(b[i][cb], a[i], acc[cb]); }
        }
#pragma unroll
        for (int cb = 0; cb < 4; ++cb) red[(wave * 4 + cb) * 64 + lane] = acc[cb] * 1.0f;
        __syncthreads();
        if (tid < 256) { const int cb = tid >> 6, l2 = tid & 63; f32x4 v = red[cb * 64 + l2];
#pragma unroll
            for (int w = 1; w < 8; ++w) v = v + red[(w * 4 + cb) * 64 + l2];
            const int row = r0 + (l2 & 15), col = c0 + cb * 16 + 4 * (l2 >> 4); const size_t off = (size_t)row * 1024 + col;
            if (KIND == 0) {
                v = v + e_bs; u32x2v o; o.x = pk2(v[0], v[1]); o.y = pk2(v[2], v[3]); *(u32x2v*)(xbp + off) = o;
                float ss = (v[0] * v[0] + v[1] * v[1]) + (v[2] * v[2] + v[3] * v[3]); ss += __shfl_xor(ss, 16); ss += __shfl_xor(ss, 32);
                if ((l2 >> 4) == 0) ssred[cb * 16 + (l2 & 15)] = ss; }
            else { const float rs = e_rs; u32x2v o; o.x = pk2(v[0] * rs, v[1] * rs); o.y = pk2(v[2] * rs, v[3] * rs); *(u32x2v*)(O + off) = o; }
        }
        if (KIND == 0) { __syncthreads(); if (tid < 16) part_next[(size_t)(r0 + tid) * 16 + (tile & 15)] = (ssred[tid] + ssred[16 + tid]) + (ssred[32 + tid] + ssred[48 + tid]); }
        __syncthreads();
    }
}


__device__ __forceinline__ void sample_cz(const bf16* A, const bf16* Bt, LAS unsigned char* lds, int tid, int wave, int lane,
                                          const float* part_cur, const float* cw, const float* st, bf16* zcp, float* outp) {
    const int fr = lane & 15, quad = lane >> 4;
    LAS f32x4* red = (LAS f32x4*)lds;
    LAS float* T = (LAS float*)(lds + 65536);
    LAS float* CZ = (LAS float*)(lds + 65536 + 8192);
    for (int tile = blockIdx.x; tile < 256; tile += gridDim.x) {
        const int b = tile >> 5, c0 = (tile & 31) * 32, r0 = MP + b * 32;
        const int wrow = 1024 + (c0 >> 7) * 256 + (c0 & 127);
        const GAS bf16* ap = (const GAS bf16*)A + (size_t)(r0 + fr) * 1024 + wave * 128 + quad * 8;
        const GAS bf16* bp = (const GAS bf16*)Bt + (size_t)(wrow + fr) * 1024 + wave * 128 + quad * 8;
        bf16x8 a[4][2], bw[4][4];
#pragma unroll
        for (int ks = 0; ks < 4; ++ks) {
#pragma unroll
            for (int rb = 0; rb < 2; ++rb) a[ks][rb] = *(const GAS bf16x8*)(ap + (size_t)rb * 16 * 1024 + ks * 32);
#pragma unroll
            for (int cb = 0; cb < 4; ++cb) bw[ks][cb] = *(const GAS bf16x8*)(bp + (size_t)((cb >> 1) * 128 + (cb & 1) * 16) * 1024 + ks * 32); }
        f32x4 acc[2][4];
#pragma unroll
        for (int rb = 0; rb < 2; ++rb)
#pragma unroll
            for (int cb = 0; cb < 4; ++cb) { f32x4 d = {0.f, 0.f, 0.f, 0.f};
#pragma unroll
                for (int ks = 0; ks < 4; ++ks) d = MFMA16(bw[ks][cb], a[ks][rb], d);
                acc[rb][cb] = d; }
#pragma unroll
        for (int rb = 0; rb < 2; ++rb)
#pragma unroll
            for (int cb = 0; cb < 4; ++cb) red[(wave * 8 + rb * 4 + cb) * 64 + lane] = acc[rb][cb];
        __syncthreads();
        {
            const int blk = tid >> 6, l2 = tid & 63, rb = blk >> 2, cb = blk & 3; f32x4 v = red[blk * 64 + l2];
#pragma unroll
            for (int w = 1; w < 8; ++w) v = v + red[(w * 8 + blk) * 64 + l2];
            *(LAS f32x4*)(T + ((cb >> 1) * 32 + rb * 16 + (l2 & 15)) * 32 + (cb & 1) * 16 + 4 * (l2 >> 4)) = v; }
        __syncthreads();
        const int r = tid >> 3, cq = (tid & 7) * 4;
        if (tid < 256) { const float rs = rstd_of(part_cur, r0 + r); const float rs2 = rs * rs;
            const f32x4 gc = *(const LAS f32x4*)(T + r * 32 + cq), zz = *(const LAS f32x4*)(T + (32 + r) * 32 + cq);
            *(LAS f32x4*)(CZ + r * 32 + cq) = gc * zz * rs2; }
        __syncthreads();
        if (tid < 256) { const int c = c0 + cq;
            const f32x4 x0 = *(const LAS f32x4*)(CZ + r * 32 + cq);
            const f32x4 s0 = *(const f32x4*)(st + (size_t)(b * 2) * 1024 + c), s1 = *(const f32x4*)(st + (size_t)(b * 2 + 1) * 1024 + c);
            f32x4 xm1 = s1, xm2 = s0;
            if (r >= 1) { xm1 = *(const LAS f32x4*)(CZ + (r - 1) * 32 + cq); xm2 = s1; }
            if (r >= 2) xm2 = *(const LAS f32x4*)(CZ + (r - 2) * 32 + cq);
            const f32x4 w0 = *(const f32x4*)(cw + c), w1 = *(const f32x4*)(cw + 1024 + c), w2 = *(const f32x4*)(cw + 2048 + c);
            const f32x4 z = w0 * xm2 + w1 * xm1 + w2 * x0;
            bf16* gp = zcp + (size_t)(r0 + r) * 1024 + c; const u32x2v gw = *(const u32x2v*)gp;
            u32x2v o; o.x = pk2(z[0] * bflo(gw.x), z[1] * bfhi(gw.x)); o.y = pk2(z[2] * bflo(gw.y), z[3] * bfhi(gw.y)); *(u32x2v*)gp = o;
            if (r >= 30) *(f32x4*)(outp + OFF_CMS + (size_t)(b * 2 + (r - 30)) * 1024 + c) = x0; }
        __syncthreads();
    }
}

struct Params { const float* in[36]; float* out; unsigned char* ws; int use_cg, pad; };

__global__ void __launch_bounds__(512, 2) mega_fwd(Params P) {
    extern __shared__ __attribute__((aligned(16))) unsigned char lds_raw[];
    LAS unsigned char* lds = (LAS unsigned char*)lds_raw;
    volatile LAS unsigned* MISC = (volatile LAS unsigned*)(lds + MISC_OFF);
    const int G = gridDim.x, NGW = G * 8, NT = G * 512;
    const int wave_s = __builtin_amdgcn_readfirstlane(threadIdx.x >> 6);
    for (int u = threadIdx.x; u < (LDS_BYTES - 131072) / 4; u += 512) ((LAS unsigned*)(lds + 131072))[u] = 0u;
    __syncthreads();
    XcdBarrier bar = xcd_barrier_post((unsigned*)(P.ws + WS_BAR), MISC + 8);
#ifndef STOP_AFTER
#define STOP_AFTER 1000
#endif
    int ph = 0;
#define RUN (ph < STOP_AFTER)
#define FRESH() const int tid = fresh_tid(wave_s), lane = tid & 63, wave = __builtin_amdgcn_readfirstlane(tid >> 6); const int gw = blockIdx.x * 8 + wave, gt = blockIdx.x * 512 + tid; (void)gw; (void)gt; (void)lane; LAS float* wscr = (LAS float*)(lds + 32768 + wave * 12288); (void)wscr;
#define SEAM() do { if (P.use_cg) cg::this_grid().sync(); else xcd_barrier(bar); ++ph; } while (0)

#define part ((float*)(ws + WS_PART))
#define PARTBUF(k) (part + (size_t)((k) & 1) * PART_ELEMS)
#define ropec ((float*)(ws + WS_ROPE))
#define ropes (ropec + 4096 * 32)
#define abar ((float*)(ws + WS_SSM))
#define bbar (abar + 32 * 64 * 2)
#define bbt ((bf16*)(bbar + 32 * 64 * 32))
#define ckb ((bf16*)(ws + WS_CKV))
#define cvb (ckb + 8 * 128 * 128)
#define sloc ((float*)(ws + WS_SLOC))
#define memk ((bf16*)(ws + WS_MEMK))
#define memvT ((bf16*)(ws + WS_MEMVT))
#define SG ((float*)(ws + WS_SIDE))
#define SV ((float*)(ws + WS_SIDE + SG_BYTES))
#define WT ((bf16*)(ws + WS_WT))
#define xb ((bf16*)(ws + WS_XB))
#define tmp (ws + WS_TMP)
#define proj0 ((bf16*)(tmp + TMP_PROJ0))
#define gbuf ((bf16*)(tmp + TMP_GBUF))
#define ycat ((bf16*)(tmp + TMP_YCAT))
#define memb ((bf16*)(tmp + TMP_MEMB))
#define qx ((bf16*)(tmp + TMP_QX))
#define ox ((bf16*)(tmp + TMP_OX))
#define act ((bf16*)(tmp + TMP_ACT))
#define gbm ((bf16*)(tmp + TMP_GB))
#define zc ((bf16*)(tmp + TMP_ZC))
#define PTRS() GAS unsigned char* wsg_ = (GAS unsigned char*)P.ws; GAS float* outg_ = (GAS float*)P.out; asm volatile("" : "+s"(wsg_), "+s"(outg_)); unsigned char* ws = (unsigned char*)wsg_; float* out = (float*)outg_;
    if (RUN) { PTRS() FRESH()
        {
            constexpr int NITEMS = 640 + 128 + 512 + 512 + 2 * 1024 + 512 + 2816 + 1408 + 1024;
            for (int it = gw; it < NITEMS; it += NGW) { int r = it;
#define TR(Wp, K_, N_, WTp, gainp, sc, mode) { const int ni_ = ((K_) / 64) * ((N_) / 32); if (r < ni_) { tr_item(Wp, K_, N_, WTp, gainp, sc, mode, wscr, r, lane); continue; } r -= ni_; }
                TR(P.in[15], 1024, 1280, WT + WT_INEVEN, P.in[11], 1.f, 1)
                TR(P.in[25], 512, 512, WT + WT_GLU, nullptr, 1.f, 0)
                TR(P.in[16], 1024, 1024, WT + WT_OUTEVEN, nullptr, 1.f, 0)
                TR(P.in[30], 1024, 1024, WT + WT_WQ, P.in[12], 0.0625f, 0)
                TR(P.in[31], 1024, 2048, WT + WT_WKV, nullptr, 1.f, 0)
                TR(P.in[31] + 2097152, 1024, 2048, WT + WT_WKV + 2097152, nullptr, 1.f, 0)
                TR(P.in[32], 1024, 1024, WT + WT_WO, nullptr, 1.f, 0)
                TR(P.in[33], 1024, 5632, WT + WT_UP, P.in[13], 1.f, 2)
                TR(P.in[35], 2816, 1024, WT + WT_DOWN, nullptr, 1.f, 0)
                { const int mi = r >> 7, l = mi >> 3, b = mi & 7; tr_item(P.in[10] + (size_t)mi * 262144, 256, 1024, memvT + (size_t)(l * 12 + 4 + b) * 262144, nullptr, 1.f, 0, wscr, r & 127, lane); }
            }
        }
        for (int m = gw; m < MROWS; m += NGW) { const float* xr = m < MP ? P.in[0] + (size_t)m * 1024 : P.in[1] + (size_t)(m - MP) * 1024; float ss = 0.f;
#pragma unroll
            for (int j = 0; j < 4; ++j) { const f32x4 v = __builtin_nontemporal_load((const f32x4*)(xr + (lane + 64 * j) * 4)); ss += (v[0] * v[0] + v[1] * v[1]) + (v[2] * v[2] + v[3] * v[3]);
                u32x2v w; w.x = pg8::cvt_pk_bf16(v[0], v[1]); w.y = pg8::cvt_pk_bf16(v[2], v[3]); *(u32x2v*)(xb + (size_t)m * 1024 + (lane + 64 * j) * 4) = w; }
            ss = wave_sum(ss); if (lane < 16) PARTBUF(0)[(size_t)m * 16 + lane] = lane == 0 ? ss : 0.f; }
        for (int i = gt; i < 262144; i += NT) { const f32x4 v = __builtin_nontemporal_load((const f32x4*)(P.in[2] + (size_t)i * 4)); u32x2v w; w.x = pg8::cvt_pk_bf16(v[0], v[1]); w.y = pg8::cvt_pk_bf16(v[2], v[3]); *(u32x2v*)(memb + (size_t)i * 4) = w; }
        for (int i = gt; i < 524288; i += NT) { const size_t e = (size_t)i * 4; const int lb = (int)(e >> 18), l = lb >> 3, b = lb & 7; const f32x4 v = __builtin_nontemporal_load((const f32x4*)(P.in[9] + e));
            u32x2v w; w.x = pg8::cvt_pk_bf16(v[0], v[1]); w.y = pg8::cvt_pk_bf16(v[2], v[3]); *(u32x2v*)(memk + (size_t)(l * 12 + 4 + b) * 262144 + (e & 262143)) = w; }
        for (int i = gt; i < 65536; i += NT) { const int j = i & 32767; const float* src = (i < 32768 ? P.in[3] : P.in[4]) + (size_t)j * 4; bf16* dst = (i < 32768 ? ckb : cvb) + (size_t)j * 4;
            const f32x4 v = *(const f32x4*)src; u32x2v w; w.x = pg8::cvt_pk_bf16(v[0], v[1]); w.y = pg8::cvt_pk_bf16(v[2], v[3]); *(u32x2v*)dst = w; }
        for (int i = gt; i < 4096 * 32; i += NT) { const int pos = i >> 5, d = i & 31; const double inv = dexp_(-(double)d * (9.210340371976184 / 32.0)); double s, c; dsincos_((double)pos * inv, s, c); ropec[i] = (float)c; ropes[i] = (float)s; }
        for (int i = gt; i < 2048; i += NT) { const double are = P.in[17][i], aim = P.in[18][i], dt = dexp_((double)P.in[19][i]); double s, c; dsincos_(aim * dt, s, c); const double mag = dexp_(are * dt);
            const double br = mag * c, bi = mag * s; abar[2 * i] = (float)br; abar[2 * i + 1] = (float)bi;
            const double nr = br - 1.0, ni = bi, den = are * are + aim * aim; const double qr = (nr * are + ni * aim) / den, qi = (ni * are - nr * aim) / den;
#pragma unroll 4
            for (int h = 0; h < 16; ++h) { const double xr = P.in[20][(size_t)i * 16 + h], xi = P.in[21][(size_t)i * 16 + h]; const float fre = (float)(qr * xr - qi * xi), fim = (float)(qr * xi + qi * xr); bbar[(size_t)i * 32 + 2 * h] = fre; bbar[(size_t)i * 32 + 2 * h + 1] = fim;
                bbt[((size_t)i * 2) * 16 + h] = (bf16)f2bf(fre); bbt[((size_t)i * 2 + 1) * 16 + h] = (bf16)f2bf(fim); } }
    }
    SEAM();
    if (RUN) { PTRS()
        if (G < 128 || (int)blockIdx.x >= G - 64) { pg8::Gemm g{memb, WT + WT_WKV, 1024, 4096, 1024}; pg8::StaticOrder S;
            if (G < 128) S.init(1024, 4096, G, (int)blockIdx.x); else S.init(1024, 4096, 64, (int)blockIdx.x - (G - 64)); EpiKV E{out, memk};
          pg8::gemm_phase<EpiKV, pg8::StaticOrder, true, true>(lds, g, S, E, wave_s); }
        { pg8::Gemm g{xb, WT + WT_INEVEN, MROWS, 1280, 1024}; pg8::StaticOrderF S; S.init(MROWS, 1280, G, (int)blockIdx.x); EpiIn0 E{proj0, PARTBUF(0), ropec, ropes, out};
          pg8::gemm_phase<EpiIn0, pg8::StaticOrderF, true, true>(lds, g, S, E, wave_s); }
        {
            FRESH()
            const int bx = (int)blockIdx.x, n2 = 325 - G;
            int slot = -1, nw = 1;
            if (G == 256) { if (bx >= n2 && bx < G - 64) { slot = (bx - n2) * 8 + wave; nw = (G - 64 - n2) * 8; } } else { slot = gw; nw = NGW; }
            if (slot >= 0) for (int it = slot; it < 2816 + 1408; it += nw) { int r = it;
                TR(P.in[33] + (size_t)1024 * 5632, 1024, 5632, WT + WT_UP + (size_t)5632 * 1024, P.in[13] + 1024, 1.f, 2)
                tr_item(P.in[35] + (size_t)2816 * 1024, 2816, 1024, WT + WT_DOWN + (size_t)2816 * 1024, nullptr, 1.f, 0, wscr, r, lane); }
        }
    }
    SEAM();
    if (RUN) { PTRS() FRESH()
        swa_phase(proj0, ckb, cvb, P.in[26], ycat, lds, tid, wave, lane, G);
        s5_local(proj0, abar, bbt, sloc, wscr, wave * G + (int)blockIdx.x, NGW, lane);
        for (int it = wave * G + (int)blockIdx.x; it < 512; it += NGW) { const int mi = it >> 7, l = mi >> 2, b = mi & 3;
            tr_item(out + OFF_MVP + (size_t)mi * 262144, 256, 1024, memvT + (size_t)(l * 12 + b) * 262144, nullptr, 1.f, 0, wscr, it & 127, lane); }
    }
    SEAM();
    if (RUN) { PTRS() FRESH() s5_out(proj0, abar, bbt, sloc, P.in[5], P.in[6], P.in[22], P.in[23], P.in[24], gbuf, out, (LAS float*)(lds + wave * 16384), (LAS unsigned*)(lds + wave * 16384 + 8448), wave * G + (int)blockIdx.x, NGW, lane); }
    SEAM();
    if (RUN) { PTRS() pg8::Gemm g{gbuf, WT + WT_GLU, MROWS, 512, 512}; pg8::StaticOrder S; S.init(MROWS, 512, G, (int)blockIdx.x); EpiGlu E{gbuf, ycat};
        pg8::gemm_phase<EpiGlu, pg8::StaticOrder, true, true>(lds, g, S, E, wave_s);
        {
            FRESH()
            const int bx = (int)blockIdx.x; int slot = -1, nw = 1;
            if (G > 130) { if (bx >= 130) { slot = (bx - 130) * 8 + wave; nw = (G - 130) * 8; } } else { slot = gw; nw = NGW; }
            if (slot >= 0) for (int it = slot; it < 1536 + 512; it += nw) { int r = it;
                TR(P.in[27], 1024, 3072, WT + WT_INODD, P.in[11] + 1024, 1.f, 3)
                tr_item(P.in[29], 1024, 1024, WT + WT_OUTODD, nullptr, 1.f, 0, wscr, r, lane); }
        } }
    SEAM();

#pragma unroll
    for (int l = 0; l < 2; ++l) {
        if (l == 1) {
            if (RUN) { PTRS() pg8::Gemm g{xb, WT + WT_INODD, MP, 1024, 1024}; pg8::StaticOrderF S; S.init(MP, 1024, G, (int)blockIdx.x); EpiBf16 E{gbm, 1024, PARTBUF(3)};
                pg8::gemm_phase<EpiBf16, pg8::StaticOrderF, true, true>(lds, g, S, E, wave_s);
                { FRESH() sample_gemm<1>(xb, WT + WT_INODD, 1024, lds, tid, wave, lane, nullptr, nullptr, nullptr, PARTBUF(3), gbm); } }
            SEAM();
            if (RUN) { PTRS() pg8::Gemm g{xb, WT + WT_INODD + (size_t)1024 * 1024, MP, 2048, 1024}; pg8::StaticOrderF S; S.init(MP, 2048, G, (int)blockIdx.x); EpiCz E{gbm, PARTBUF(3), P.in[28], SG};
                pg8::gemm_phase<EpiCz, pg8::StaticOrderF, true, true>(lds, g, S, E, wave_s);
                { FRESH() sample_cz(xb, WT + WT_INODD, lds, tid, wave, lane, PARTBUF(3), P.in[28], P.in[7], gbm, out); } }
            SEAM();
            if (RUN) { PTRS() FRESH()
                const float* cw = P.in[28];
                for (int i = gt; i < 512 * 128; i += NT) { const int ri = i >> 7, c0 = (i & 127) * 8, blk = ri >> 1, rr = ri & 1, row = blk * 64 + rr;
                    f32x4 pa0, pa1, pb0, pb1;
                    if ((blk & 63) == 0) { pa0 = pa1 = pb0 = pb1 = (f32x4){0.f, 0.f, 0.f, 0.f}; }
                    else { const float* s0 = SG + (size_t)((blk - 1) * 8 + 6) * 1024 + c0; pa0 = *(const f32x4*)s0; pa1 = *(const f32x4*)(s0 + 4); pb0 = *(const f32x4*)(s0 + 1024); pb1 = *(const f32x4*)(s0 + 1028); }
                    const float* sc = SG + (size_t)(blk * 8) * 1024 + c0; const f32x4 x00 = *(const f32x4*)sc, x01 = *(const f32x4*)(sc + 4);
                    f32x4 xm2a, xm2b, xm1a, xm1b, xca, xcb;
                    if (rr == 0) { xm2a = pa0; xm2b = pa1; xm1a = pb0; xm1b = pb1; xca = x00; xcb = x01; }
                    else { xm2a = pb0; xm2b = pb1; xm1a = x00; xm1b = x01; xca = *(const f32x4*)(sc + 1024); xcb = *(const f32x4*)(sc + 1028); }
                    const f32x4 w0a = *(const f32x4*)(cw + c0), w0b = *(const f32x4*)(cw + c0 + 4), w1a = *(const f32x4*)(cw + 1024 + c0), w1b = *(const f32x4*)(cw + 1028 + c0), w2a = *(const f32x4*)(cw + 2048 + c0), w2b = *(const f32x4*)(cw + 2052 + c0);
                    const f32x4 z0 = w0a * xm2a + w1a * xm1a + w2a * xca, z1 = w0b * xm2b + w1b * xm1b + w2b * xcb;
                    const v4u gw_ = *(const v4u*)(gbm + (size_t)row * 1024 + c0);
                    const f32x4 g0 = (f32x4){bflo(gw_.x), bfhi(gw_.x), bflo(gw_.y), bfhi(gw_.y)}, g1 = (f32x4){bflo(gw_.z), bfhi(gw_.z), bflo(gw_.w), bfhi(gw_.w)};
                    *(v4u*)(gbm + (size_t)row * 1024 + c0) = pack8(g0 * z0, g1 * z1); }
                for (int i = gt; i < 4 * 2 * 1024; i += NT) { const int c = i & 1023, j = (i >> 10) & 1, b = i >> 11; out[OFF_CMP + i] = SG[(size_t)((64 * b + 63) * 8 + 6 + j) * 1024 + c]; }
            }
            SEAM();
        }
        if (RUN) { PTRS() pg8::Gemm g{(bf16*)(tmp + (size_t)(1 - l) * TMP_YCAT), WT + WT_OUTEVEN + (size_t)l * (WT_OUTODD - WT_OUTEVEN), MP, 1024, 1024}; pg8::StaticOrderF S; S.init(MP, 1024, G, (int)blockIdx.x);
            EpiRes E{P.in[0], P.in[1] - (size_t)MP * 1024, xb, PARTBUF(1 + 3 * l), l == 0 ? 1 : 0};
            pg8::gemm_phase<EpiRes, pg8::StaticOrderF, true, true>(lds, g, S, E, wave_s);
            { FRESH() sample_gemm<0>((bf16*)(tmp + (size_t)(1 - l) * TMP_YCAT), WT + WT_OUTEVEN + (size_t)l * (WT_OUTODD - WT_OUTEVEN), 1024, lds, tid, wave, lane, xb, l == 0 ? P.in[1] - (size_t)MP * 1024 : (const float*)nullptr, PARTBUF(1 + 3 * l), nullptr, nullptr); } }
        SEAM();
        if (RUN) { PTRS() pg8::Gemm g{xb, WT + WT_WQ + (size_t)l * 1048576, MP, 1024, 1024}; pg8::StaticOrderF S; S.init(MP, 1024, G, (int)blockIdx.x); EpiBf16 E{qx, 1024, PARTBUF(1 + 3 * l)};
            pg8::gemm_phase<EpiBf16, pg8::StaticOrderF, true, true>(lds, g, S, E, wave_s);
            { FRESH() sample_gemm<1>(xb, WT + WT_WQ + (size_t)l * 1048576, 1024, lds, tid, wave, lane, nullptr, nullptr, nullptr, PARTBUF(1 + 3 * l), qx); } }
        SEAM();
        if (RUN) { PTRS() FRESH() xattn_phase2(qx, memk + (size_t)l * 12 * 262144, memvT + (size_t)l * 12 * 262144, ox, lds, tid, wave, lane, G); }
        SEAM();
        if (RUN) { PTRS() pg8::Gemm g{ox, WT + WT_WO + (size_t)l * 1048576, MP, 1024, 1024}; pg8::StaticOrderF S; S.init(MP, 1024, G, (int)blockIdx.x); EpiRes E{P.in[0], P.in[0], xb, PARTBUF(2 + 3 * l), 0};
            pg8::gemm_phase<EpiRes, pg8::StaticOrderF, true, true>(lds, g, S, E, wave_s);
            { FRESH() sample_gemm<0>(ox, WT + WT_WO + (size_t)l * 1048576, 1024, lds, tid, wave, lane, xb, nullptr, PARTBUF(2 + 3 * l), nullptr, nullptr); } }
        SEAM();
        if (RUN) { PTRS() pg8::Gemm g{xb, WT + WT_UP + (size_t)l * 5632 * 1024, MROWS, 5632, 1024}; pg8::StaticOrderF S; S.init(MROWS, 5632, G, (int)blockIdx.x);
            EpiFfnUp E{act, PARTBUF(2 + 3 * l), P.in[34] + (size_t)l * 3 * DFF, SG, SV};
            pg8::gemm_phase<EpiFfnUp, pg8::StaticOrderF, true, true>(lds, g, S, E, wave_s);
            if (l == 0) {
                FRESH()
                const int bx = (int)blockIdx.x, nb = 1430 % G; int slot = -1, nw = 1;
                if (nb > 0 && nb < G) { if (bx >= nb) { slot = (bx - nb) * 8 + wave; nw = (G - nb) * 8; } } else { slot = gw; nw = NGW; }
                if (slot >= 0) { for (int it = slot; it < 512 + 512 + 1024 + 512; it += nw) { int r = it;
                    TR(P.in[30] + 1048576, 1024, 1024, WT + WT_WQ + 1048576, P.in[12] + 1024, 0.0625f, 0)
                    TR(P.in[32] + 1048576, 1024, 1024, WT + WT_WO + 1048576, nullptr, 1.f, 0)
                    { if (r < 1024) { const int mi = 8 + (r >> 7), b = mi & 7; tr_item(P.in[10] + (size_t)mi * 262144, 256, 1024, memvT + (size_t)(12 + 4 + b) * 262144, nullptr, 1.f, 0, wscr, r & 127, lane); }
                      else { r -= 1024; const int mi = 4 + (r >> 7), b = mi & 3; tr_item(out + OFF_MVP + (size_t)mi * 262144, 256, 1024, memvT + (size_t)(12 + b) * 262144, nullptr, 1.f, 0, wscr, r & 127, lane); } } }
                  const int tslot = (slot >> 3) * 512 + tid, tn = (nw >> 3) * 512;
                  for (int i = 524288 + tslot; i < 1048576; i += tn) { const size_t e = (size_t)i * 4; const int lb = (int)(e >> 18), l = lb >> 3, b = lb & 7; const f32x4 v = __builtin_nontemporal_load((const f32x4*)(P.in[9] + e));
            u32x2v w; w.x = pg8::cvt_pk_bf16(v[0], v[1]); w.y = pg8::cvt_pk_bf16(v[2], v[3]); *(u32x2v*)(memk + (size_t)(l * 12 + 4 + b) * 262144 + (e & 262143)) = w; } }
            } }
        SEAM();
        if (RUN) { PTRS() FRESH()
            const float* cw = P.in[34] + (size_t)l * 3 * DFF; const float* st = P.in[8] + (size_t)l * 8 * 2 * DFF;
            for (int i = gt; i < 528 * 352; i += NT) { const int fi = i / 352, c0 = (i % 352) * 8; int blk, row, rr, sb, vb; bool smp = fi >= 512;
                if (!smp) { blk = fi >> 1; rr = fi & 1; row = blk * 64 + rr; sb = 0; vb = 0; } else { const int s = fi - 512, half = (s >> 1) & 1; blk = 256 + (s >> 2); rr = s & 1; row = blk * 64 + half * 32 + rr; sb = half * 4; vb = half * 2; }
                f32x4 pa0, pa1, pb0, pb1;
                if (smp) { const int b = (blk - 256) * 2 + (sb >> 2); const float* s0 = st + (size_t)(b * 2) * DFF + c0; pa0 = *(const f32x4*)s0; pa1 = *(const f32x4*)(s0 + 4); pb0 = *(const f32x4*)(s0 + DFF); pb1 = *(const f32x4*)(s0 + DFF + 4); }
                else if ((blk & 63) == 0) { pa0 = pa1 = pb0 = pb1 = (f32x4){0.f, 0.f, 0.f, 0.f}; }
                else { const float* s0 = SG + (size_t)((blk - 1) * 8 + 6) * DFF + c0; pa0 = *(const f32x4*)s0; pa1 = *(const f32x4*)(s0 + 4); pb0 = *(const f32x4*)(s0 + DFF); pb1 = *(const f32x4*)(s0 + DFF + 4); }
                const float* sc = SG + (size_t)(blk * 8 + sb) * DFF + c0; const f32x4 x00 = *(const f32x4*)sc, x01 = *(const f32x4*)(sc + 4);
                f32x4 xm2a, xm2b, xm1a, xm1b, xca, xcb;
                if (rr == 0) { xm2a = pa0; xm2b = pa1; xm1a = pb0; xm1b = pb1; xca = x00; xcb = x01; }
                else { xm2a = pb0; xm2b = pb1; xm1a = x00; xm1b = x01; xca = *(const f32x4*)(sc + DFF); xcb = *(const f32x4*)(sc + DFF + 4); }
                const f32x4 w0a = *(const f32x4*)(cw + c0), w0b = *(const f32x4*)(cw + c0 + 4), w1a = *(const f32x4*)(cw + DFF + c0), w1b = *(const f32x4*)(cw + DFF + c0 + 4), w2a = *(const f32x4*)(cw + 2 * DFF + c0), w2b = *(const f32x4*)(cw + 2 * DFF + c0 + 4);
                const f32x4 ga = w0a * xm2a + w1a * xm1a + w2a * xca, gb_ = w0b * xm2b + w1b * xm1b + w2b * xcb;
                const float* sv = SV + (size_t)(blk * 4 + vb + rr) * DFF + c0; const f32x4 va = __builtin_nontemporal_load((const f32x4*)sv), vb_ = __builtin_nontemporal_load((const f32x4*)(sv + 4));
                f32x4 a0, a1;
#pragma unroll
                for (int j = 0; j < 4; ++j) { a0[j] = ga[j] * sigmoidf_(ga[j]) * va[j]; a1[j] = gb_[j] * sigmoidf_(gb_[j]) * vb_[j]; }
                *(v4u*)(act + (size_t)row * DFF + c0) = pack8(a0, a1); }
            for (int i = gt; i < 4 * 2 * DFF; i += NT) { const int c = i % DFF, j = (i / DFF) & 1, b = i / (2 * DFF); out[OFF_CFP + (size_t)l * 4 * 2 * DFF + i] = SG[(size_t)((64 * b + 63) * 8 + 6 + j) * DFF + c]; }
            for (int i = gt; i < 8 * 2 * DFF; i += NT) { const int c = i % DFF, j = (i / DFF) & 1, b = i / (2 * DFF); out[OFF_CFS + (size_t)l * 8 * 2 * DFF + i] = SG[(size_t)((256 + (b >> 1)) * 8 + (b & 1) * 4 + 2 + j) * DFF + c]; }
        }
        SEAM();
        if (RUN) { PTRS() pg8::Gemm g{act, WT + WT_DOWN + (size_t)l * 2816 * 1024, MP, 1024, DFF}; pg8::StaticOrderF S; S.init(MP, 1024, G, (int)blockIdx.x); EpiRes E{P.in[0], P.in[0], xb, PARTBUF(3 + 3 * l), 0};
            pg8::gemm_phase<EpiRes, pg8::StaticOrderF, true, true>(lds, g, S, E, wave_s);
            { FRESH() sample_gemm<0>(act, WT + WT_DOWN + (size_t)l * 2816 * 1024, DFF, lds, tid, wave, lane, xb, nullptr, PARTBUF(3 + 3 * l), nullptr, nullptr); } }
        SEAM();
    }
    if (RUN) { PTRS() FRESH()
        const float* gf = P.in[14];
        for (int m = gw; m < MROWS; m += NGW) { const float rs = rstd_of(PARTBUF(6), m); float* xr = out + (size_t)m * 1024; const bf16* xbr = xb + (size_t)m * 1024;
#pragma unroll
            for (int j = 0; j < 4; ++j) { const int c = (lane + 64 * j) * 4; const u32x2v w = __builtin_nontemporal_load((const u32x2v*)(xbr + c)); const f32x4 v = (f32x4){bflo(w.x), bfhi(w.x), bflo(w.y), bfhi(w.y)}, gg = *(const f32x4*)(gf + c); __builtin_nontemporal_store(v * rs * gg, (f32x4*)(xr + c)); } }
    }
}

extern "C" void kernel_launch(void* const* d_in, const int* in_sizes, int n_in, void* d_out, int out_size, void* d_ws, size_t ws_size, hipStream_t stream) {
    static int grid = 0;
    if (grid == 0) {
        int dev = 0, cus = 0, per_cu = 0;
        if (n_in != 36 || ws_size < 256 * MiB) { fprintf(stderr, "kernel_launch: unexpected n_in %d / ws %zu\n", n_in, ws_size); grid = -1; return; }
        (void)hipGetDevice(&dev); (void)hipDeviceGetAttribute(&cus, hipDeviceAttributeMultiprocessorCount, dev);
        if (hipFuncSetAttribute((const void*)mega_fwd, hipFuncAttributeMaxDynamicSharedMemorySize, LDS_BYTES) != hipSuccess) { fprintf(stderr, "kernel_launch: hipFuncSetAttribute failed\n"); grid = -1; return; }
        if (hipOccupancyMaxActiveBlocksPerMultiprocessor(&per_cu, (const void*)mega_fwd, 512, LDS_BYTES) != hipSuccess || per_cu < 1) per_cu = 1;
        (void)hipGetLastError();
        grid = cus * 1;
        if (grid > 256) grid = 256;
    }
    if (grid < 0) return;
    (void)hipMemsetAsync(d_ws, 0, CTL_ZERO_BYTES, stream);
    Params p{};
    for (int i = 0; i < 36; ++i) p.in[i] = (const float*)d_in[i];
    p.out = (float*)d_out; p.ws = (unsigned char*)d_ws; p.use_cg = 0; p.pad = 0;
    void* args[] = {&p};
    hipError_t e = hipLaunchCooperativeKernel((const void*)mega_fwd, dim3(grid), dim3(512), args, LDS_BYTES, stream);
    if (e != hipSuccess) fprintf(stderr, "cooperative launch failed: %s (grid %d)\n", hipGetErrorString(e), grid);
}
```
